# Optimizing an MI355X kernel written in HIP

```python
import math
import jax, jax.numpy as jnp
from jax import lax
import numpy as np

D_MODEL = 1024
BATCH = 4
SEQ = 4096
DEPTH = 1

CHUNK = 64
Q_BLOCK = 128
EPS = 1e-6

DA_HEADS = 4
DA_HEAD_DIM = 64
DA_V_DIM = 2 * DA_HEAD_DIM
DA_WIDTH = DA_HEADS * 2 * DA_HEAD_DIM

HG_HEADS = 4
HG_EXPAND = 128
HG_V_DIM = 128
HG_WIDTH = HG_HEADS * HG_EXPAND

N_BRANCH = 2
IN_SPLITS = [DA_WIDTH] * 3 + [HG_WIDTH] * 4 + [D_MODEL] * N_BRANCH
IN_COLS = sum(IN_SPLITS)

N_GROUPS = 4
EXPERTS_PER_GROUP = 8
N_EXPERTS = N_GROUPS * EXPERTS_PER_GROUP
TOP_K = 2
D_EXPERT = D_MODEL // 2
MOE_BLOCK = 128

kernel_name = "hybrid_diffattn_hgrn2_hmoe_block"


def rmsnorm(x, g):
    xf = x.astype(jnp.float32)
    y = xf * lax.rsqrt(jnp.mean(xf * xf, axis=-1, keepdims=True) + EPS)
    return (y * g.astype(jnp.float32)).astype(x.dtype)


def alibi_slopes(n):
    return jnp.array([2.0 ** (-8.0 * (h + 1) / n) for h in range(n)], dtype=jnp.float32)


def diff_attention(q, k, v, lam, lam_init, subln_g):
    B, S, _ = q.shape
    H, d, dv = DA_HEADS, DA_HEAD_DIM, DA_V_DIM
    nq = S // Q_BLOCK
    qf = q.astype(jnp.float32).reshape(B, S, H, 2, d).transpose(0, 2, 3, 1, 4)
    kf = k.astype(jnp.float32).reshape(B, S, H, 2, d).transpose(0, 2, 3, 1, 4)
    vf = v.astype(jnp.float32).reshape(B, S, H, dv).transpose(0, 2, 1, 3)
    qb = jnp.moveaxis(qf.reshape(B, H, 2, nq, Q_BLOCK, d), 3, 0)
    slopes = alibi_slopes(H)
    key_pos = jnp.arange(S, dtype=jnp.int32)
    scale = 1.0 / math.sqrt(d)

    def one_block(args):
        qblk, bi = args
        q_pos = bi * Q_BLOCK + jnp.arange(Q_BLOCK, dtype=jnp.int32)
        s = jnp.einsum('bhmqd,bhmkd->bhmqk', qblk, kf) * scale
        dist = jnp.abs(q_pos[:, None] - key_pos[None, :]).astype(jnp.float32)
        bias = -slopes[:, None, None] * dist
        allowed = (key_pos // CHUNK)[None, :] <= (q_pos // CHUNK)[:, None]
        s = jnp.where(allowed, s + bias[None, :, None], -jnp.inf)
        p = jax.nn.softmax(s, axis=-1)
        attn = p[:, :, 0] - lam * p[:, :, 1]
        return jnp.einsum('bhqk,bhkv->bhqv', attn, vf)

    o = lax.map(one_block, (qb, jnp.arange(nq, dtype=jnp.int32)))
    o = o.transpose(1, 0, 3, 2, 4).reshape(B, S, H, dv)
    o = rmsnorm(o, subln_g) * (1.0 - lam_init)
    return o.reshape(B, S, H * dv).astype(q.dtype)


def hgrn2(q, f_logit, i, g, lb, norm_g):
    B, S, _ = q.shape
    H, dk, dv, C = HG_HEADS, HG_EXPAND, HG_V_DIM, CHUNK
    N = S // C
    f = lb + (1.0 - lb) * jax.nn.sigmoid(f_logit.astype(jnp.float32))
    logf = jnp.log(f)
    kk = 1.0 - f
    qq = jax.nn.silu(q.astype(jnp.float32))

    def to_chunks(t, width):
        return t.reshape(B, N, C, H, width).transpose(0, 3, 1, 2, 4)

    qc = to_chunks(qq, dk)
    kc = to_chunks(kk, dk)
    vc = to_chunks(i.astype(jnp.float32), dv)
    A = jnp.cumsum(to_chunks(logf, dk), axis=3)
    A_last = A[:, :, :, -1:, :]
    q_dec = qc * jnp.exp(A)
    k_dec = kc * jnp.exp(-A)
    k_end = kc * jnp.exp(A_last - A)

    tri = jnp.tril(jnp.ones((C, C), dtype=bool))
    scores = jnp.einsum('bhnik,bhnjk->bhnij', q_dec, k_dec)
    o_intra = jnp.einsum('bhnij,bhnjv->bhniv', jnp.where(tri, scores, 0.0), vc)

    dS = jnp.einsum('bhnck,bhncv->bhnkv', k_end, vc)
    decay = jnp.exp(A_last[:, :, :, 0, :])

    def step(state, inp):
        dS_n, d_n = inp
        return d_n[..., None] * state + dS_n, state

    S0 = jnp.zeros((B, H, dk, dv), jnp.float32)
    _, S_start = lax.scan(step, S0, (jnp.moveaxis(dS, 2, 0), jnp.moveaxis(decay, 2, 0)))
    S_start = jnp.moveaxis(S_start, 0, 2)
    o = o_intra + jnp.einsum('bhnck,bhnkv->bhncv', q_dec, S_start)
    o = o.transpose(0, 2, 3, 1, 4).reshape(B, S, H, dv)
    gg = g.astype(jnp.float32).reshape(B, S, H, dv)
    o = rmsnorm(o, norm_g) * jax.nn.silu(gg)
    return o.reshape(B, S, H * dv).astype(q.dtype)


def hier_moe(h, w_rg, b_rg, w_re, b_re, w1, w3, w2):
    B, S, D = h.shape
    T = B * S
    hf = h.reshape(T, D)
    g_logits = (hf @ w_rg + b_rg).astype(jnp.float32)
    pg = jax.nn.softmax(g_logits, axis=-1)
    g_idx = jnp.argmax(pg, axis=-1).astype(jnp.int32)
    g_p = jnp.take_along_axis(pg, g_idx[:, None], axis=-1)[:, 0]
    e_logits = (hf @ w_re + b_re).astype(jnp.float32).reshape(T, N_GROUPS, EXPERTS_PER_GROUP)
    sel = jnp.take_along_axis(e_logits, g_idx[:, None, None], axis=1)[:, 0]
    pe = jax.nn.softmax(sel, axis=-1)
    top_w, top_i = lax.top_k(pe, TOP_K)
    top_w = top_w / jnp.sum(top_w, axis=-1, keepdims=True)
    weights = g_p[:, None] * top_w
    experts = g_idx[:, None] * EXPERTS_PER_GROUP + top_i.astype(jnp.int32)

    M = T * TOP_K
    P = M + N_EXPERTS * MOE_BLOCK
    n_blk = P // MOE_BLOCK
    assign_e = experts.reshape(M)
    assign_tok = jnp.broadcast_to(jnp.arange(T, dtype=jnp.int32)[:, None], (T, TOP_K)).reshape(M)
    assign_w = weights.reshape(M)
    order = jnp.argsort(assign_e)
    sorted_e = assign_e[order]
    counts = jnp.bincount(assign_e, length=N_EXPERTS)
    starts = jnp.cumsum(counts) - counts
    pcounts = (counts + MOE_BLOCK - 1) // MOE_BLOCK * MOE_BLOCK
    pends = jnp.cumsum(pcounts)
    pstarts = pends - pcounts
    dest = pstarts[sorted_e] + (jnp.arange(M, dtype=jnp.int32) - starts[sorted_e])
    slot_tok = jnp.zeros((P,), jnp.int32).at[dest].set(assign_tok[order])
    slot_w = jnp.zeros((P,), jnp.float32).at[dest].set(assign_w[order])
    blk_e = jnp.minimum(
        jnp.searchsorted(pends, jnp.arange(n_blk, dtype=jnp.int32) * MOE_BLOCK, side='right'),
        N_EXPERTS - 1).astype(jnp.int32)
    xs = hf[slot_tok].reshape(n_blk, MOE_BLOCK, D)

    def expert_block(args):
        xb, e = args
        return (jax.nn.silu(xb @ w1[e]) * (xb @ w3[e])) @ w2[e]

    ys = lax.map(expert_block, (xs, blk_e)).reshape(P, D)
    out = jnp.zeros((T, D), ys.dtype).at[slot_tok].add(ys * slot_w[:, None].astype(ys.dtype))
    return out.reshape(B, S, D).astype(h.dtype)


def setup_inputs(seed: int = 0) -> dict:
    key = jax.random.key(seed)
    ks = jax.random.split(key, 32)
    f32 = jnp.float32

    def nrm(k, shape, scale):
        return jax.random.normal(k, shape, f32) * scale

    def gain(k, shape):
        return 1.0 + 0.02 * jax.random.normal(k, shape, f32)

    D, L = D_MODEL, DEPTH
    return {
        "x": nrm(ks[0], (BATCH, SEQ, D), 1.0),
        "c": nrm(ks[1], (BATCH, D), 1.0),
        "w_ada": nrm(ks[2], (L, D, 6 * D), 0.5 * D ** -0.5),
        "b_ada": nrm(ks[3], (L, 6 * D), 0.02),
        "norm1_g": gain(ks[4], (L, D)),
        "w_in": nrm(ks[5], (L, D, IN_COLS), D ** -0.5),
        "lambda_q1": nrm(ks[6], (L, DA_HEAD_DIM), 0.1),
        "lambda_k1": nrm(ks[7], (L, DA_HEAD_DIM), 0.1),
        "lambda_q2": nrm(ks[8], (L, DA_HEAD_DIM), 0.1),
        "lambda_k2": nrm(ks[9], (L, DA_HEAD_DIM), 0.1),
        "da_subln_g": gain(ks[10], (L, DA_V_DIM)),
        "hg_lb_logits": nrm(ks[11], (L + 1, HG_WIDTH), 0.1),
        "hg_norm_g": gain(ks[12], (L, HG_V_DIM)),
        "w_up_da": nrm(ks[13], (L, DA_WIDTH, D), DA_WIDTH ** -0.5),
        "w_up_hg": nrm(ks[14], (L, HG_WIDTH, D), HG_WIDTH ** -0.5),
        "w_out": nrm(ks[15], (L, D, D), D ** -0.5),
        "norm2_g": gain(ks[16], (L, D)),
        "w_rg": nrm(ks[17], (L, D, N_GROUPS), D ** -0.5),
        "b_rg": nrm(ks[18], (L, N_GROUPS), 0.01),
        "w_re": nrm(ks[19], (L, D, N_EXPERTS), D ** -0.5),
        "b_re": nrm(ks[20], (L, N_EXPERTS), 0.01),
        "w1": nrm(ks[21], (L, N_EXPERTS, D, D_EXPERT), D ** -0.5),
        "w3": nrm(ks[22], (L, N_EXPERTS, D, D_EXPERT), D ** -0.5),
        "w2": nrm(ks[23], (L, N_EXPERTS, D_EXPERT, D), D_EXPERT ** -0.5),
        "final_g": gain(ks[24], (D,)),
    }


def reference(x, c, w_ada, b_ada, norm1_g, w_in, lambda_q1, lambda_k1, lambda_q2, lambda_k2,
              da_subln_g, hg_lb_logits, hg_norm_g, w_up_da, w_up_hg, w_out, norm2_g,
              w_rg, b_rg, w_re, b_re, w1, w3, w2, final_g):
    split_idx = [int(v) for v in np.cumsum(IN_SPLITS)[:-1]]
    lb_all = jnp.cumsum(jax.nn.softmax(hg_lb_logits.astype(jnp.float32), axis=0), axis=0)
    c_act = jax.nn.silu(c)
    for l in range(DEPTH):
        mod = (c_act @ w_ada[l] + b_ada[l])[:, None, :]
        sh1, sc1, gt1, sh2, sc2, gt2 = jnp.split(mod, 6, axis=-1)

        h = rmsnorm(x, norm1_g[l]) * (1.0 + sc1) + sh1
        proj = h @ w_in[l]
        q_da, k_da, v_da, q_hg, f_hg, i_hg, g_hg, gate_da, gate_hg = jnp.split(proj, split_idx, axis=-1)
        lam_init = 0.8 - 0.6 * math.exp(-0.3 * l)
        lam = (jnp.exp(jnp.sum(lambda_q1[l].astype(jnp.float32) * lambda_k1[l].astype(jnp.float32)))
               - jnp.exp(jnp.sum(lambda_q2[l].astype(jnp.float32) * lambda_k2[l].astype(jnp.float32)))
               + lam_init)
        y_da = diff_attention(q_da, k_da, v_da, lam, lam_init, da_subln_g[l])
        y_hg = hgrn2(q_hg, f_hg, i_hg, g_hg, lb_all[l], hg_norm_g[l])
        merged = (jax.nn.sigmoid(gate_da) * (y_da @ w_up_da[l])
                  + jax.nn.sigmoid(gate_hg) * (y_hg @ w_up_hg[l]))
        x = x + gt1 * (merged @ w_out[l])

        h2 = rmsnorm(x, norm2_g[l]) * (1.0 + sc2) + sh2
        x = x + gt2 * hier_moe(h2, w_rg[l], b_rg[l], w_re[l], b_re[l], w1[l], w3[l], w2[l])
    return rmsnorm(x, final_g)
```

```cpp
#include <hip/hip_runtime.h>
#include <hip/hip_cooperative_groups.h>
#include <cstdio>
#include <cstdint>
namespace cg = cooperative_groups;

#ifndef MK_N_LAUNCHES
#define MK_N_LAUNCHES 10
#endif

#define LAS __attribute__((address_space(3)))
typedef unsigned short bf16_t;
typedef short bf16x8 __attribute__((ext_vector_type(8)));
typedef float f32x4 __attribute__((ext_vector_type(4)));
typedef float f32x2 __attribute__((ext_vector_type(2)));
typedef unsigned u32x4 __attribute__((ext_vector_type(4)));
typedef unsigned u32x2 __attribute__((ext_vector_type(2)));

constexpr int NB = 4, SEQ = 4096, D = 1024, T = NB * SEQ;
constexpr int INC = 5632;
constexpr int C_QDA = 0, C_KDA = 512, C_VDA = 1024, C_QHG = 1536, C_FHG = 2048, C_IHG = 2560, C_GHG = 3072, C_GDA = 3584, C_GHGATE = 4608;
constexpr int NEXP = 32, DEXP = 512;
constexpr int PMAX = 40960;
constexpr float EPS = 1e-6f;
constexpr int NWAVES = 8, NTHR = 512;

constexpr size_t MiB = 1u << 20;
constexpr size_t WS_CTL = 0, CTL_ZERO_BYTES = 64 * 1024;
constexpr size_t WS_MODP = 1 * MiB;
constexpr size_t WS_MOD = 5 * MiB / 2;
constexpr size_t WS_SMALL = 11 * MiB / 4;
constexpr size_t WS_TOKINFO = 3 * MiB;
constexpr size_t WS_TOKLIST = 4 * MiB;
constexpr size_t WS_WIN = 8 * MiB;
constexpr size_t WS_WUPDA = 20 * MiB, WS_WUPHG = 21 * MiB, WS_WOUT = 22 * MiB;
constexpr size_t WS_ACT = 24 * MiB;
constexpr size_t WS_PROJ = 56 * MiB;
constexpr size_t WS_YDA = 232 * MiB, WS_YHG = 248 * MiB;
constexpr size_t WS_W13 = 56 * MiB;
constexpr size_t WS_W2 = 120 * MiB;
constexpr size_t WS_HS = 152 * MiB;
constexpr size_t WS_YS = 192 * MiB;
constexpr size_t WS_END = 272 * MiB;
constexpr int CW_COUNTS = 64;

constexpr int LDS_BYTES = 160 * 1024;

__device__ __forceinline__ float bf2f(unsigned v) { return __uint_as_float(v << 16); }
__device__ __forceinline__ unsigned f2bf(float f) { unsigned u = __float_as_uint(f); return (u + 0x7fffu + ((u >> 16) & 1u)) >> 16; }
__device__ __forceinline__ unsigned pk2(float lo, float hi) { return f2bf(lo) | (f2bf(hi) << 16); }
__device__ __forceinline__ float sigmoidf_(float x) { return 1.0f / (1.0f + __expf(-x)); }
__device__ __forceinline__ float siluf_(float x) { return x / (1.0f + __expf(-x)); }
__device__ __forceinline__ float wave_sum(float v) {
#pragma unroll
    for (int o = 1; o < 64; o <<= 1) v += __shfl_xor(v, o);
    return v;
}

namespace pg8 {
constexpr int BM = 256, BK = 64, HALF = 128, HTB = HALF * BK * 2, STAGE_BYTES = 8 * HTB;
__host__ __device__ __forceinline__ int lds_byte(int r, int c) { const int st = (r >> 4) * 2 + (c >> 5), rr = r & 15, cc = c & 31, ob = rr * 64 + cc * 2; return st * 1024 + (ob ^ (((ob >> 9) & 1) << 5)); }
__host__ __device__ __forceinline__ void stage_rc(int b, int& R, int& C) { const int st = b / 1024, sb = b % 1024, swz = sb ^ (((sb >> 9) & 1) << 5); R = (st >> 1) * 16 + swz / 64; C = (st & 1) * 32 + (swz % 64) / 2; }
__host__ __device__ __forceinline__ int perm32(int rho) { const int n = rho >> 4, i = rho & 15; return 8 * (i >> 2) + 4 * n + (i & 3); }

struct Unit { int pm, pn; const char* A; const char* B; int aux; };
__device__ __forceinline__ unsigned cvt_pk_bf16(float lo, float hi) { unsigned r; asm volatile("v_cvt_pk_bf16_f32 %0, %1, %2" : "=v"(r) : "v"(lo), "v"(hi)); return r; }

template <class Epi, class Sched>
__device__ __forceinline__ void gemm_phase(LAS unsigned char* lds, const int K, const Sched& S, const Epi& E) {
    const int tid = threadIdx.x, wid = __builtin_amdgcn_readfirstlane(tid >> 6), lane = tid & 63, wr = wid >> 2, wc = wid & 3, fr = lane & 15, fq = lane >> 4;
    const int nt = K / BK;
    int RA[2], CA[2]; unsigned voffB[2];
#pragma unroll
    for (int i = 0; i < 2; ++i) { int R, C; stage_rc(tid * 16 + i * 8192, R, C); const int Rb = Epi::PERM ? ((R & ~31) + perm32(R & 31)) : R;
        RA[i] = R; CA[i] = C; voffB[i] = (unsigned)(Rb * K + C) * 2u; }
    const size_t kstep = (size_t)(BK * 2);
    const size_t hstep = (size_t)HALF * K * 2;
    const unsigned ldsw = (unsigned)wid * 1024u;
    const int aoff = lds_byte(wr * 64 + fr, fq * 8), boff = lds_byte(wc * 32 + fr, fq * 8);
#define PG8_SA(b, h) (((b) * 2 + (h)) * HTB)
#define PG8_SB(b, h) ((4 + (b) * 2 + (h)) * HTB)
#define PG8_STAGE(bufoff, gbase, voff) do { _Pragma("unroll") for (int _i = 0; _i < 2; ++_i) \
        __builtin_amdgcn_global_load_lds((const unsigned*)((const char*)(gbase) + (voff)[_i]), (LAS unsigned*)(lds + (bufoff) + ldsw + _i * 8192), 16, 0, 0); } while (0)
#define PG8_LDA(dst, b, h) do { _Pragma("unroll") for (int m = 0; m < 4; ++m) _Pragma("unroll") for (int k = 0; k < 2; ++k) dst[m][k] = *(const LAS bf16x8*)(lds + PG8_SA(b, h) + aoff + m * 2048 + k * 1024); } while (0)
#define PG8_LDB(dst, b, h) do { _Pragma("unroll") for (int n = 0; n < 2; ++n) _Pragma("unroll") for (int k = 0; k < 2; ++k) dst[n][k] = *(const LAS bf16x8*)(lds + PG8_SB(b, h) + boff + n * 2048 + k * 1024); } while (0)
#define PG8_MMA(ai, bj, At, Bt) do { __builtin_amdgcn_s_setprio(1); _Pragma("unroll") for (int m = 0; m < 4; ++m) _Pragma("unroll") for (int n = 0; n < 2; ++n) _Pragma("unroll") for (int k = 0; k < 2; ++k) \
        acc[ai][bj][m][n] = __builtin_amdgcn_mfma_f32_16x16x32_bf16(Bt[n][k], At[m][k], acc[ai][bj][m][n], 0, 0, 0); __builtin_amdgcn_s_setprio(0); } while (0)
#define PG8_WAIT_V(n) asm volatile("s_waitcnt vmcnt(" #n ")" ::: "memory")
#define PG8_WAIT_L(n) asm volatile("s_waitcnt lgkmcnt(" #n ")" ::: "memory")
#define PG8_BAR __builtin_amdgcn_s_barrier()
#define PG8_SCHED __builtin_amdgcn_sched_barrier(0)
#define PG8_SETA(vo, u) do { _Pragma("unroll") for (int _h = 0; _h < 2; ++_h) _Pragma("unroll") for (int _i = 0; _i < 2; ++_i) \
        vo[_h][_i] = (unsigned)((size_t)S.arow(u, _h * HALF + RA[_i]) * (size_t)K + CA[_i]) * 2u; if (Sched::GATHER) PG8_WAIT_V(0); } while (0)
    Unit cur, nxt; int ui = 0;
    if (!S.next(0, cur)) return;
    f32x4 acc[2][2][4][2];
#pragma unroll
    for (int a = 0; a < 2; ++a)
#pragma unroll
        for (int b = 0; b < 2; ++b)
#pragma unroll
            for (int m = 0; m < 4; ++m)
#pragma unroll
                for (int n = 0; n < 2; ++n) acc[a][b][m][n] = (f32x4){0.f, 0.f, 0.f, 0.f};
    bf16x8 At[4][2], B0[2][2], B1[2][2];
    unsigned voC[2][2], voN[2][2];
    PG8_SETA(voC, cur);
    const char* cA = cur.A; const char* cB = cur.B;
    PG8_STAGE(PG8_SB(0, 0), cB, voffB); PG8_STAGE(PG8_SB(0, 1), cB + hstep, voffB); PG8_STAGE(PG8_SA(0, 0), cA, voC[0]); PG8_STAGE(PG8_SA(0, 1), cA, voC[1]);
    if (wr == 1) PG8_BAR;
    PG8_WAIT_V(2); PG8_BAR;
    PG8_STAGE(PG8_SB(1, 0), cB + kstep, voffB); PG8_STAGE(PG8_SA(1, 0), cA + kstep, voC[0]); PG8_STAGE(PG8_SB(1, 1), cB + hstep + kstep, voffB);
    PG8_WAIT_V(6); PG8_BAR;
    for (;;) {
        const bool has_next = S.next(ui + 1, nxt);
        if (has_next) { PG8_SETA(voN, nxt); }
        else {
#pragma unroll
            for (int h = 0; h < 2; ++h)
#pragma unroll
                for (int i = 0; i < 2; ++i) voN[h][i] = voC[h][i];
        }
        const char* nA = has_next ? nxt.A : cA; const char* nB = has_next ? nxt.B : cB;
        for (int t = 0; t < nt; t += 2) {
            const bool last = (t == nt - 2);
            const char* a1 = cA + (size_t)(t + 1) * kstep;
            const char* a2 = last ? nA : cA + (size_t)(t + 2) * kstep; const char* b2 = last ? nB : cB + (size_t)(t + 2) * kstep;
            const char* a3 = a2 + kstep; const char* b3 = b2 + kstep;
            unsigned vo2[2][2];
#pragma unroll
            for (int h = 0; h < 2; ++h)
#pragma unroll
                for (int i = 0; i < 2; ++i) vo2[h][i] = last ? voN[h][i] : voC[h][i];
            PG8_LDB(B0, 0, 0); PG8_LDB(B1, 0, 1); PG8_SCHED; PG8_LDA(At, 0, 0); PG8_STAGE(PG8_SA(1, 1), a1, voC[1]);
            PG8_WAIT_V(8); PG8_WAIT_L(0); PG8_BAR; PG8_MMA(0, 0, At, B0); PG8_MMA(0, 1, At, B1); PG8_BAR; PG8_SCHED;
            PG8_LDA(At, 0, 1); PG8_STAGE(PG8_SB(0, 0), b2, voffB); PG8_STAGE(PG8_SB(0, 1), b2 + hstep, voffB); PG8_STAGE(PG8_SA(0, 0), a2, vo2[0]);
            PG8_WAIT_V(8); PG8_WAIT_L(0); PG8_BAR; PG8_MMA(1, 0, At, B0); PG8_MMA(1, 1, At, B1); PG8_BAR; PG8_SCHED;
            PG8_LDB(B0, 1, 0); PG8_LDB(B1, 1, 1); PG8_SCHED; PG8_LDA(At, 1, 0); PG8_STAGE(PG8_SA(0, 1), a2, vo2[1]);
            PG8_WAIT_V(8); PG8_WAIT_L(0); PG8_BAR; PG8_MMA(0, 0, At, B0); PG8_MMA(0, 1, At, B1); PG8_BAR; PG8_SCHED;
            PG8_LDA(At, 1, 1); PG8_STAGE(PG8_SB(1, 0), b3, voffB); PG8_STAGE(PG8_SB(1, 1), b3 + hstep, voffB); PG8_STAGE(PG8_SA(1, 0), a3, vo2[0]);
            PG8_WAIT_V(8); PG8_WAIT_L(0); PG8_BAR; PG8_MMA(1, 0, At, B0); PG8_MMA(1, 1, At, B1); PG8_BAR; PG8_SCHED;
        }
        if (wr == 0) PG8_BAR;
        const bool keep = E(acc, cur, wr, wc, fr, fq);
        if (!has_next) break;
        if (!keep) {
#pragma unroll
            for (int a = 0; a < 2; ++a)
#pragma unroll
                for (int b = 0; b < 2; ++b)
#pragma unroll
                    for (int m = 0; m < 4; ++m)
#pragma unroll
                        for (int n = 0; n < 2; ++n) acc[a][b][m][n] = (f32x4){0.f, 0.f, 0.f, 0.f};
        }
        cur = nxt; cA = nA; cB = nB; ++ui;
#pragma unroll
        for (int h = 0; h < 2; ++h)
#pragma unroll
            for (int i = 0; i < 2; ++i) voC[h][i] = voN[h][i];
        if (wr == 1) PG8_BAR;
    }
    PG8_WAIT_V(0);
    PG8_BAR;
#undef PG8_SA
#undef PG8_SB
#undef PG8_STAGE
#undef PG8_LDA
#undef PG8_LDB
#undef PG8_MMA
#undef PG8_WAIT_V
#undef PG8_WAIT_L
#undef PG8_BAR
#undef PG8_SCHED
#undef PG8_SETA
}
}

struct Args { const float* in[25]; float* out; unsigned char* ws; int ph_lo, ph_hi; };
enum { I_X = 0, I_C, I_WADA, I_BADA, I_N1G, I_WIN, I_LQ1, I_LK1, I_LQ2, I_LK2, I_SUBG, I_LBL, I_HGNG, I_WUPDA, I_WUPHG, I_WOUT, I_N2G, I_WRG, I_BRG, I_WRE, I_BRE, I_W1, I_W3, I_W2, I_FG };

struct DenseOrder {
    static constexpr bool GATHER = false;
    const char* A; const char* Bt; int K, nM, nN, G, c;
    __device__ __forceinline__ bool next(int i, pg8::Unit& u) const {
        const int L = i * G + c, nwg = nM * nN; if (L >= nwg) return false;
        int wgid = L; { const int q = nwg / 8, r = nwg % 8, xcd = wgid % 8, off = wgid / 8; wgid = (xcd < r ? xcd * (q + 1) : r * (q + 1) + (xcd - r) * q) + off; }
        const int nig = 8 * nN, gid = wgid / nig, fm = gid * 8, gsz = (nM - fm) < 8 ? (nM - fm) : 8;
        u.pm = fm + ((wgid % nig) % gsz); u.pn = (wgid % nig) / gsz; u.A = A; u.B = Bt + (size_t)u.pn * 256 * K * 2; u.aux = 0; return true;
    }
    __device__ __forceinline__ unsigned arow(const pg8::Unit& u, int r) const { return (unsigned)(u.pm * 256 + r); }
};
struct UpOrder {
    static constexpr bool GATHER = false;
    const char* A0; const char* A1; const char* B0; const char* B1; int G, c;
    __device__ __forceinline__ bool next(int i, pg8::Unit& u) const {
        const int tile = (i >> 1) * G + c; if (tile >= 256) return false;
        u.pm = tile >> 2; u.pn = tile & 3; u.aux = i & 1;
        u.A = (i & 1) ? A1 : A0; u.B = ((i & 1) ? B1 : B0) + (size_t)u.pn * 256 * 512 * 2; return true;
    }
    __device__ __forceinline__ unsigned arow(const pg8::Unit& u, int r) const { return (unsigned)(u.pm * 256 + r); }
};
struct MoeTab { int nt; int pad[3]; int tile_e[176]; int tile_m[176]; int cnt[32]; int tbase[33]; };
struct Moe1Order {
    static constexpr bool GATHER = true;
    const LAS MoeTab* tab; const char* A; const char* W; const int* toklist; int G, c;
    __device__ __forceinline__ bool next(int i, pg8::Unit& u) const {
        const int L = i * G + c; if (L >= tab->nt * 4) return false;
        const int ti = L >> 2; u.pm = ti; u.pn = L & 3; u.aux = ti; u.A = A;
        u.B = W + ((size_t)tab->tile_e[ti] * 1024 + (size_t)u.pn * 256) * 1024 * 2; return true;
    }
    __device__ __forceinline__ unsigned arow(const pg8::Unit& u, int r) const {
        const int e = tab->tile_e[u.aux], rr = tab->tile_m[u.aux] * 256 + r;
        return rr < tab->cnt[e] ? (unsigned)toklist[e * T + rr] : 0u;
    }
};
struct Moe2Order {
    static constexpr bool GATHER = false;
    const LAS MoeTab* tab; const char* A; const char* W; int G, c;
    __device__ __forceinline__ bool next(int i, pg8::Unit& u) const {
        const int L = i * G + c; if (L >= tab->nt * 4) return false;
        const int ti = L >> 2; u.pm = ti; u.pn = L & 3; u.aux = ti; u.A = A;
        u.B = W + ((size_t)tab->tile_e[ti] * 1024 + (size_t)u.pn * 256) * 512 * 2; return true;
    }
    __device__ __forceinline__ unsigned arow(const pg8::Unit& u, int r) const { return (unsigned)(u.pm * 256 + r); }
};

using pg8::Unit; using pg8::cvt_pk_bf16;
struct EpiStoreBf16 {
    static constexpr bool PERM = true;
    bf16_t* O; int ldc;
    __device__ __forceinline__ bool operator()(f32x4 (&acc)[2][2][4][2], const Unit& u, int wr, int wc, int fr, int fq) const {
        const int row0 = u.pm * 256 + wr * 64 + fr, col0 = u.pn * 256 + wc * 32 + 8 * fq;
#pragma unroll
        for (int ai = 0; ai < 2; ++ai)
#pragma unroll
            for (int m = 0; m < 4; ++m) { bf16_t* rowp = O + (size_t)(row0 + ai * 128 + m * 16) * ldc + col0;
#pragma unroll
                for (int bj = 0; bj < 2; ++bj) { const f32x4 v0 = acc[ai][bj][m][0], v1 = acc[ai][bj][m][1];
                    u32x4 w; w.x = cvt_pk_bf16(v0[0], v0[1]); w.y = cvt_pk_bf16(v0[2], v0[3]); w.z = cvt_pk_bf16(v1[0], v1[1]); w.w = cvt_pk_bf16(v1[2], v1[3]);
                    *(u32x4*)(rowp + bj * 128) = w; } }
        return false;
    }
};
struct EpiUp {
    static constexpr bool PERM = true;
    const bf16_t* proj; bf16_t* O;
    __device__ __forceinline__ bool operator()(f32x4 (&acc)[2][2][4][2], const Unit& u, int wr, int wc, int fr, int fq) const {
        const int row0 = u.pm * 256 + wr * 64 + fr, col0 = u.pn * 256 + wc * 32 + 8 * fq;
#pragma unroll
        for (int ai = 0; ai < 2; ++ai)
#pragma unroll
            for (int m = 0; m < 4; ++m) { const size_t row = (size_t)(row0 + ai * 128 + m * 16);
#pragma unroll
                for (int bj = 0; bj < 2; ++bj) {
                    const int col = col0 + bj * 128;
                    const u32x4 gh = *(const u32x4*)(proj + row * INC + C_GHGATE + col);
                    float sh[8];
#pragma unroll
                    for (int j = 0; j < 4; ++j) { sh[2 * j] = 1.0f + __expf(-bf2f(gh[j] & 0xffffu)); sh[2 * j + 1] = 1.0f + __expf(-bf2f(gh[j] >> 16)); }
                    if (u.aux == 0) {
                        const u32x4 gd = *(const u32x4*)(proj + row * INC + C_GDA + col);
#pragma unroll
                        for (int j = 0; j < 4; ++j) {
                            const float d0 = 1.0f + __expf(-bf2f(gd[j] & 0xffffu)), d1 = 1.0f + __expf(-bf2f(gd[j] >> 16));
                            const float r0 = sh[2 * j] / d0, r1 = sh[2 * j + 1] / d1;
                            if (j < 2) { acc[ai][bj][m][0][2 * j] *= r0; acc[ai][bj][m][0][2 * j + 1] *= r1; }
                            else { acc[ai][bj][m][1][2 * j - 4] *= r0; acc[ai][bj][m][1][2 * j - 3] *= r1; }
                        }
                    } else {
                        const f32x4 v0 = acc[ai][bj][m][0], v1 = acc[ai][bj][m][1];
                        u32x4 w; w.x = cvt_pk_bf16(v0[0] / sh[0], v0[1] / sh[1]); w.y = cvt_pk_bf16(v0[2] / sh[2], v0[3] / sh[3]);
                        w.z = cvt_pk_bf16(v1[0] / sh[4], v1[1] / sh[5]); w.w = cvt_pk_bf16(v1[2] / sh[6], v1[3] / sh[7]);
                        *(u32x4*)(O + row * D + col) = w;
                    }
                } }
        return u.aux == 0;
    }
};
struct EpiOut {
    static constexpr bool PERM = false;
    const float* x; const float* mod; float* O;
    __device__ __forceinline__ bool operator()(f32x4 (&acc)[2][2][4][2], const Unit& u, int wr, int wc, int fr, int fq) const {
        const int row0 = u.pm * 256 + wr * 64 + fr, col0 = u.pn * 256 + wc * 32 + 4 * fq;
        const int b = (u.pm * 256) / SEQ;
        f32x4 gt[2][2];
#pragma unroll
        for (int bj = 0; bj < 2; ++bj)
#pragma unroll
            for (int n = 0; n < 2; ++n) gt[bj][n] = *(const f32x4*)(mod + b * 6144 + 2048 + col0 + bj * 128 + n * 16);
#pragma unroll
        for (int ai = 0; ai < 2; ++ai)
#pragma unroll
            for (int m = 0; m < 4; ++m) { const size_t off = (size_t)(row0 + ai * 128 + m * 16) * D + col0;
#pragma unroll
                for (int bj = 0; bj < 2; ++bj)
#pragma unroll
                    for (int n = 0; n < 2; ++n) { const f32x4 xv = *(const f32x4*)(x + off + bj * 128 + n * 16);
                        *(f32x4*)(O + off + bj * 128 + n * 16) = xv + gt[bj][n] * acc[ai][bj][m][n]; } }
        return false;
    }
};
struct EpiMoe1 {
    static constexpr bool PERM = true;
    bf16_t* O;
    __device__ __forceinline__ bool operator()(f32x4 (&acc)[2][2][4][2], const Unit& u, int wr, int wc, int fr, int fq) const {
        const int row0 = u.pm * 256 + wr * 64 + fr, col0 = u.pn * 128 + wc * 32 + 8 * fq;
#pragma unroll
        for (int ai = 0; ai < 2; ++ai)
#pragma unroll
            for (int m = 0; m < 4; ++m) { bf16_t* rowp = O + (size_t)(row0 + ai * 128 + m * 16) * DEXP + col0;
                float h[8];
#pragma unroll
                for (int n = 0; n < 2; ++n)
#pragma unroll
                    for (int e = 0; e < 4; ++e) h[n * 4 + e] = siluf_(acc[ai][0][m][n][e]) * acc[ai][1][m][n][e];
                u32x4 w; w.x = cvt_pk_bf16(h[0], h[1]); w.y = cvt_pk_bf16(h[2], h[3]); w.z = cvt_pk_bf16(h[4], h[5]); w.w = cvt_pk_bf16(h[6], h[7]);
                *(u32x4*)rowp = w; }
        return false;
    }
};

struct Frame { LAS unsigned char* lds; int tid, lane, wave, G, bid; };

__device__ __forceinline__ void transpose_item(const float* Wsrc, int ldw, bf16_t* dst, int ldd, LAS float* scr, int lane) {
#pragma unroll 8
    for (int i = 0; i < 32; ++i) { const int kk = 2 * i + (lane >> 5); scr[kk * 33 + (lane & 31)] = Wsrc[(size_t)kk * ldw + (lane & 31)]; }
    asm volatile("s_waitcnt lgkmcnt(0)" ::: "memory");
    const int c = lane & 7;
#pragma unroll
    for (int j = 0; j < 4; ++j) { const int n = (lane >> 3) + 8 * j; const LAS float* s = scr + (8 * c) * 33 + n;
        u32x4 o; o.x = pk2(s[0 * 33], s[1 * 33]); o.y = pk2(s[2 * 33], s[3 * 33]); o.z = pk2(s[4 * 33], s[5 * 33]); o.w = pk2(s[6 * 33], s[7 * 33]);
        *(u32x4*)(dst + (size_t)n * ldd + 8 * c) = o; }
    asm volatile("s_waitcnt lgkmcnt(0)" ::: "memory");
}
__device__ __forceinline__ void transpose_matrix(const Frame& F, const float* W, int K, int N, bf16_t* WT) {
    LAS float* scr = (LAS float*)(F.lds + F.wave * 8448);
    const int gw = F.bid * NWAVES + F.wave, NGW = F.G * NWAVES, nblk = N / 32, items = (K / 64) * nblk;
    for (int it = gw; it < items; it += NGW) { const int kb = it / nblk, nb = it % nblk;
        transpose_item(W + (size_t)(64 * kb) * N + 32 * nb, N, WT + (size_t)(32 * nb) * K + 64 * kb, K, scr, F.lane); }
}

__device__ __forceinline__ void phase0(const Frame& F, const Args& a) {
    unsigned char* ws = a.ws;
    {
        float* modp = (float*)(ws + WS_MODP);
        const float* c = a.in[I_C]; const float* wada = a.in[I_WADA];
        for (int wt = F.bid + 256 * F.wave; wt < 384; wt += 256 * NWAVES) {
            if (F.G != 256) break;
            const int ks = wt / 24, jw = wt % 24, j = jw * 256 + F.lane * 4;
            f32x4 s[4] = {{0, 0, 0, 0}, {0, 0, 0, 0}, {0, 0, 0, 0}, {0, 0, 0, 0}};
            for (int k = ks * 64; k < ks * 64 + 64; ++k) {
                const f32x4 w = *(const f32x4*)(wada + (size_t)k * 6144 + j);
#pragma unroll
                for (int b = 0; b < 4; ++b) { const float cv = siluf_(c[b * D + k]); s[b] += w * cv; }
            }
#pragma unroll
            for (int b = 0; b < 4; ++b) *(f32x4*)(modp + ((size_t)ks * 4 + b) * 6144 + j) = s[b];
        }
        if (F.G != 256) {
            const int gw = F.bid * NWAVES + F.wave, NGW = F.G * NWAVES;
            for (int wt = gw; wt < 384; wt += NGW) {
                const int ks = wt / 24, jw = wt % 24, j = jw * 256 + F.lane * 4;
                f32x4 s[4] = {{0, 0, 0, 0}, {0, 0, 0, 0}, {0, 0, 0, 0}, {0, 0, 0, 0}};
                for (int k = ks * 64; k < ks * 64 + 64; ++k) {
                    const f32x4 w = *(const f32x4*)(wada + (size_t)k * 6144 + j);
#pragma unroll
                    for (int b = 0; b < 4; ++b) { const float cv = siluf_(c[b * D + k]); s[b] += w * cv; }
                }
#pragma unroll
                for (int b = 0; b < 4; ++b) *(f32x4*)(modp + ((size_t)ks * 4 + b) * 6144 + j) = s[b];
            }
        }
    }
    transpose_matrix(F, a.in[I_WIN], D, INC, (bf16_t*)(ws + WS_WIN));
    transpose_matrix(F, a.in[I_WUPDA], 512, D, (bf16_t*)(ws + WS_WUPDA));
    transpose_matrix(F, a.in[I_WUPHG], 512, D, (bf16_t*)(ws + WS_WUPHG));
    transpose_matrix(F, a.in[I_WOUT], D, D, (bf16_t*)(ws + WS_WOUT));
    if (F.bid == 0) {
        float* sm = (float*)(ws + WS_SMALL);
        if (F.tid == 0) {
            float s1 = 0.f, s2 = 0.f;
            for (int i = 0; i < 64; ++i) { s1 += a.in[I_LQ1][i] * a.in[I_LK1][i]; s2 += a.in[I_LQ2][i] * a.in[I_LK2][i]; }
            sm[0] = expf(s1) - expf(s2) + 0.2f;
        }
        { const float l0 = a.in[I_LBL][F.tid], l1 = a.in[I_LBL][512 + F.tid]; const float mx = fmaxf(l0, l1);
          const float e0 = expf(l0 - mx), e1 = expf(l1 - mx); sm[16 + F.tid] = e0 / (e0 + e1); }
    }
}
__device__ __forceinline__ void moe_weight_convert(const Frame& F, const Args& a) {
    LAS float* scr = (LAS float*)(F.lds + F.wave * 8448);
    const int gw = F.bid * NWAVES + F.wave, NGW = F.G * NWAVES;
    bf16_t* w13 = (bf16_t*)(a.ws + WS_W13); bf16_t* w2t = (bf16_t*)(a.ws + WS_W2);
    for (int it = gw; it < 2 * NEXP * 256; it += NGW) {
        const int which = it / (NEXP * 256), r = it % (NEXP * 256), e = r >> 8, kb = (r >> 4) & 15, nb = r & 15, n0 = 32 * nb;
        const float* W = a.in[which ? I_W3 : I_W1] + (size_t)e * 1024 * 512;
        const int drow = 256 * (n0 >> 7) + (which ? 128 : 0) + (n0 & 127);
        transpose_item(W + (size_t)(64 * kb) * 512 + n0, 512, w13 + ((size_t)e * 1024 + drow) * 1024 + 64 * kb, 1024, scr, F.lane);
    }
    for (int it = gw; it < NEXP * 256; it += NGW) {
        const int e = it >> 8, kb = (it >> 5) & 7, nb = it & 31;
        const float* W = a.in[I_W2] + (size_t)e * 512 * 1024;
        transpose_item(W + (size_t)(64 * kb) * 1024 + 32 * nb, 1024, w2t + ((size_t)e * 1024 + 32 * nb) * 512 + 64 * kb, 512, scr, F.lane);
    }
}

__device__ __forceinline__ void phase1(const Frame& F, const Args& a) {
    const float* modp = (const float*)(a.ws + WS_MODP); float* mod = (float*)(a.ws + WS_MOD);
    for (int i = F.bid * NTHR + F.tid; i < 4 * 6144; i += F.G * NTHR) {
        float s = a.in[I_BADA][i % 6144];
        for (int ks = 0; ks < 16; ++ks) s += modp[(size_t)ks * 4 * 6144 + i];
        mod[i] = s;
    }
    LAS float* Gs = (LAS float*)F.lds;
    LAS float* Ss = Gs + 1024;
    bf16_t* H = (bf16_t*)(a.ws + WS_ACT);
    const int rows_per_blk = T / F.G;
    const int r0 = F.bid * rows_per_blk, b = r0 / SEQ;
    for (int k = F.tid; k < 1024; k += NTHR) {
        float sh = a.in[I_BADA][k], sc = a.in[I_BADA][1024 + k];
        for (int ks = 0; ks < 16; ++ks) { sh += modp[((size_t)ks * 4 + b) * 6144 + k]; sc += modp[((size_t)ks * 4 + b) * 6144 + 1024 + k]; }
        Gs[k] = a.in[I_N1G][k] * (1.0f + sc); Ss[k] = sh;
    }
    __syncthreads();
    for (int r = r0 + F.wave; r < r0 + rows_per_blk; r += NWAVES) {
        const f32x4* xr = (const f32x4*)(a.in[I_X] + (size_t)r * D) + F.lane;
        f32x4 v[4]; float s = 0.f;
#pragma unroll
        for (int j = 0; j < 4; ++j) { v[j] = xr[64 * j]; s += (v[j].x * v[j].x + v[j].y * v[j].y) + (v[j].z * v[j].z + v[j].w * v[j].w); }
        const float rs = rsqrtf(wave_sum(s) * (1.0f / D) + EPS);
        unsigned long long* o8 = (unsigned long long*)(H + (size_t)r * D) + F.lane;
#pragma unroll
        for (int j = 0; j < 4; ++j) { const f32x4 g = *(const LAS f32x4*)(Gs + 256 * j + 4 * F.lane), sh = *(const LAS f32x4*)(Ss + 256 * j + 4 * F.lane);
            const f32x4 h = v[j] * rs * g + sh;
            o8[64 * j] = (unsigned long long)pk2(h.x, h.y) | ((unsigned long long)pk2(h.z, h.w) << 32); }
    }
}

constexpr int KPAD = 132;
__device__ __forceinline__ void attn_naive_unit(const Frame& F, const Args& a, int unit) {
    const bf16_t* proj = (const bf16_t*)(a.ws + WS_PROJ);
    const float lam = ((const float*)(a.ws + WS_SMALL))[0];
    const int b = unit >> 8, h = (unit >> 6) & 3, qc = unit & 63;
    LAS float* Ks = (LAS float*)F.lds;
    LAS float* Vs = Ks + 64 * KPAD;
    LAS float* Ps = Vs + 64 * KPAD;
    const int tid = F.tid, map = tid >> 8, qi = (tid >> 2) & 63, g = tid & 3;
    const float slope = exp2f(-2.0f * (h + 1));
    const size_t trow0 = (size_t)b * SEQ + qc * 64;
    float q[64];
    {
        const bf16_t* qp = proj + (trow0 + qi) * INC + C_QDA + h * 128 + map * 64;
#pragma unroll
        for (int d = 0; d < 64; d += 8) { const u32x4 w = *(const u32x4*)(qp + d);
#pragma unroll
            for (int j = 0; j < 4; ++j) { q[d + 2 * j] = bf2f(w[j] & 0xffffu) * 0.125f; q[d + 2 * j + 1] = bf2f(w[j] >> 16) * 0.125f; } }
    }
    float O[32];
#pragma unroll
    for (int i = 0; i < 32; ++i) O[i] = 0.f;
    float mrun = -INFINITY, lrun = 0.f;
    const int qpos = qc * 64 + qi;
    for (int kt = 0; kt <= qc; ++kt) {
        __syncthreads();
        for (int i = tid; i < 64 * 16; i += NTHR) {
            const int r = i >> 4, c8 = (i & 15) * 8; const size_t rowp = ((size_t)b * SEQ + kt * 64 + r) * INC;
            const u32x4 kw = *(const u32x4*)(proj + rowp + C_KDA + h * 128 + c8), vw = *(const u32x4*)(proj + rowp + C_VDA + h * 128 + c8);
#pragma unroll
            for (int j = 0; j < 4; ++j) { Ks[r * KPAD + c8 + 2 * j] = bf2f(kw[j] & 0xffffu); Ks[r * KPAD + c8 + 2 * j + 1] = bf2f(kw[j] >> 16);
                Vs[r * KPAD + c8 + 2 * j] = bf2f(vw[j] & 0xffffu); Vs[r * KPAD + c8 + 2 * j + 1] = bf2f(vw[j] >> 16); }
        }
        __syncthreads();
        float s[16]; float mx = -INFINITY;
#pragma unroll
        for (int jj = 0; jj < 16; ++jj) {
            const int j = jj * 4 + g; const LAS float* kr = Ks + j * KPAD + map * 64; float d = 0.f;
#pragma unroll
            for (int dd = 0; dd < 64; dd += 4) { const f32x4 kv = *(const LAS f32x4*)(kr + dd); d += q[dd] * kv.x + q[dd + 1] * kv.y + q[dd + 2] * kv.z + q[dd + 3] * kv.w; }
            const int kpos = kt * 64 + j; const int dist = qpos > kpos ? qpos - kpos : kpos - qpos;
            s[jj] = d - slope * (float)dist; mx = fmaxf(mx, s[jj]);
        }
        mx = fmaxf(mx, __shfl_xor(mx, 1)); mx = fmaxf(mx, __shfl_xor(mx, 2));
        const float mnew = fmaxf(mrun, mx), alpha = __expf(mrun - mnew);
        float ps = 0.f;
#pragma unroll
        for (int jj = 0; jj < 16; ++jj) { const float p = __expf(s[jj] - mnew); ps += p; Ps[(map * 64 + qi) * 64 + jj * 4 + g] = p; }
        ps += __shfl_xor(ps, 1); ps += __shfl_xor(ps, 2);
        lrun = lrun * alpha + ps; mrun = mnew;
        __syncthreads();
#pragma unroll
        for (int i = 0; i < 32; ++i) O[i] *= alpha;
        for (int j = 0; j < 64; ++j) { const float p = Ps[(map * 64 + qi) * 64 + j]; const LAS float* vr = Vs + j * KPAD + g * 32;
#pragma unroll
            for (int i = 0; i < 32; i += 4) { const f32x4 vv = *(const LAS f32x4*)(vr + i); O[i] += p * vv.x; O[i + 1] += p * vv.y; O[i + 2] += p * vv.z; O[i + 3] += p * vv.w; } }
    }
    __syncthreads();
    const float inv = 1.0f / lrun;
    LAS float* Ox = Ks;
    if (map == 1) {
#pragma unroll
        for (int i = 0; i < 32; ++i) Ox[qi * 128 + g * 32 + i] = O[i] * inv;
    }
    __syncthreads();
    if (map == 0) {
        float ss = 0.f;
#pragma unroll
        for (int i = 0; i < 32; ++i) { O[i] = O[i] * inv - lam * Ox[qi * 128 + g * 32 + i]; ss += O[i] * O[i]; }
        ss += __shfl_xor(ss, 1); ss += __shfl_xor(ss, 2);
        const float rs = rsqrtf(ss * (1.0f / 128.0f) + EPS) * 0.8f;
        bf16_t* yp = (bf16_t*)(a.ws + WS_YDA) + (trow0 + qi) * 512 + h * 128 + g * 32;
        const float* sg = a.in[I_SUBG] + g * 32;
#pragma unroll
        for (int i = 0; i < 32; i += 8) { u32x4 w; w.x = pk2(O[i] * rs * sg[i], O[i + 1] * rs * sg[i + 1]); w.y = pk2(O[i + 2] * rs * sg[i + 2], O[i + 3] * rs * sg[i + 3]);
            w.z = pk2(O[i + 4] * rs * sg[i + 4], O[i + 5] * rs * sg[i + 5]); w.w = pk2(O[i + 6] * rs * sg[i + 6], O[i + 7] * rs * sg[i + 7]); *(u32x4*)(yp + i) = w; }
    }
}
__device__ __forceinline__ void hgrn_naive_unit(const Frame& F, const Args& a, int unit) {
    const bf16_t* proj = (const bf16_t*)(a.ws + WS_PROJ);
    const float* lbv = (const float*)(a.ws + WS_SMALL) + 16;
    const int b = unit >> 2, h = unit & 3, tid = F.tid;
    LAS float* qs = (LAS float*)F.lds;
    LAS float* fs = qs + 4096;
    LAS float* ks = fs + 4096;
    LAS float* vs = ks + 4096;
    LAS float* gs = vs + 4096;
    LAS float* op = gs + 4096;
    const int v = tid & 127, kg = tid >> 7;
    float s[32];
#pragma unroll
    for (int i = 0; i < 32; ++i) s[i] = 0.f;
    for (int ch = 0; ch < SEQ / 32; ++ch) {
        const size_t t0 = (size_t)b * SEQ + ch * 32;
        __syncthreads();
        for (int i = tid; i < 32 * 16; i += NTHR) {
            const int r = i >> 4, c8 = (i & 15) * 8; const bf16_t* rp = proj + (t0 + r) * INC + h * 128 + c8;
            const u32x4 qw = *(const u32x4*)(rp + C_QHG), fw = *(const u32x4*)(rp + C_FHG), iw = *(const u32x4*)(rp + C_IHG), gw = *(const u32x4*)(rp + C_GHG);
#pragma unroll
            for (int j = 0; j < 8; ++j) {
                const unsigned sel = (j & 1) ? 16u : 0u;
                const float qv = bf2f((qw[j >> 1] >> sel) & 0xffffu), fv = bf2f((fw[j >> 1] >> sel) & 0xffffu), iv = bf2f((iw[j >> 1] >> sel) & 0xffffu), gv = bf2f((gw[j >> 1] >> sel) & 0xffffu);
                const float lb = lbv[h * 128 + c8 + j]; const float f = lb + (1.0f - lb) * sigmoidf_(fv);
                const int o = r * 128 + c8 + j;
                qs[o] = siluf_(qv); fs[o] = f; ks[o] = 1.0f - f; vs[o] = iv; gs[o] = siluf_(gv);
            }
        }
        __syncthreads();
        for (int r = 0; r < 32; ++r) {
            const float vt = vs[r * 128 + v]; float o = 0.f;
            const LAS float* fr_ = fs + r * 128 + kg * 32; const LAS float* kr_ = ks + r * 128 + kg * 32; const LAS float* qr_ = qs + r * 128 + kg * 32;
#pragma unroll
            for (int i = 0; i < 32; i += 4) { const f32x4 f4 = *(const LAS f32x4*)(fr_ + i), k4 = *(const LAS f32x4*)(kr_ + i), q4 = *(const LAS f32x4*)(qr_ + i);
                s[i] = f4.x * s[i] + k4.x * vt; o += s[i] * q4.x; s[i + 1] = f4.y * s[i + 1] + k4.y * vt; o += s[i + 1] * q4.y;
                s[i + 2] = f4.z * s[i + 2] + k4.z * vt; o += s[i + 2] * q4.z; s[i + 3] = f4.w * s[i + 3] + k4.w * vt; o += s[i + 3] * q4.w; }
            op[(kg * 32 + r) * 128 + v] = o;
        }
        __syncthreads();
        {
            const int r = tid >> 4, sub = tid & 15; float o[8]; float ss = 0.f;
#pragma unroll
            for (int j = 0; j < 8; ++j) { const int vv = sub * 8 + j; o[j] = (op[(0 * 32 + r) * 128 + vv] + op[(1 * 32 + r) * 128 + vv]) + (op[(2 * 32 + r) * 128 + vv] + op[(3 * 32 + r) * 128 + vv]); ss += o[j] * o[j]; }
            ss += __shfl_xor(ss, 1); ss += __shfl_xor(ss, 2); ss += __shfl_xor(ss, 4); ss += __shfl_xor(ss, 8);
            const float rs = rsqrtf(ss * (1.0f / 128.0f) + EPS);
            const float* ng = a.in[I_HGNG] + sub * 8;
            float y[8];
#pragma unroll
            for (int j = 0; j < 8; ++j) y[j] = o[j] * rs * ng[j] * gs[r * 128 + sub * 8 + j];
            u32x4 w; w.x = pk2(y[0], y[1]); w.y = pk2(y[2], y[3]); w.z = pk2(y[4], y[5]); w.w = pk2(y[6], y[7]);
            *(u32x4*)((bf16_t*)(a.ws + WS_YHG) + (t0 + r) * 512 + h * 128 + sub * 8) = w;
        }
    }
}

__device__ __forceinline__ void phase_router(const Frame& F, const Args& a) {
    LAS float* Wr = (LAS float*)F.lds;
    for (int i = F.tid; i < 36 * 1024; i += NTHR) { const int o = i >> 10, k = i & 1023; Wr[i] = o < 4 ? a.in[I_WRG][k * 4 + o] : a.in[I_WRE][k * 32 + (o - 4)]; }
    __syncthreads();
    const float* mod = (const float*)(a.ws + WS_MOD);
    const float* x1 = a.out; bf16_t* H2 = (bf16_t*)(a.ws + WS_ACT);
    unsigned* counts = (unsigned*)(a.ws + WS_CTL) + CW_COUNTS; unsigned* tokinfo = (unsigned*)(a.ws + WS_TOKINFO); int* toklist = (int*)(a.ws + WS_TOKLIST);
    const int rows_per_blk = T / F.G, r0 = F.bid * rows_per_blk;
    for (int r = r0 + F.wave; r < r0 + rows_per_blk; r += NWAVES) {
        const int b = r / SEQ;
        const f32x4* xr = (const f32x4*)(x1 + (size_t)r * D) + F.lane;
        f32x4 v[4]; float s = 0.f;
#pragma unroll
        for (int j = 0; j < 4; ++j) { v[j] = xr[64 * j]; s += (v[j].x * v[j].x + v[j].y * v[j].y) + (v[j].z * v[j].z + v[j].w * v[j].w); }
        const float rs = rsqrtf(wave_sum(s) * (1.0f / D) + EPS);
        unsigned long long* o8 = (unsigned long long*)(H2 + (size_t)r * D) + F.lane;
#pragma unroll
        for (int j = 0; j < 4; ++j) { const int k = 256 * j + 4 * F.lane;
            const f32x4 g = *(const f32x4*)(a.in[I_N2G] + k), sc = *(const f32x4*)(mod + b * 6144 + 4 * 1024 + k), sh = *(const f32x4*)(mod + b * 6144 + 3 * 1024 + k);
            v[j] = v[j] * rs * g * (1.0f + sc) + sh;
            o8[64 * j] = (unsigned long long)pk2(v[j].x, v[j].y) | ((unsigned long long)pk2(v[j].z, v[j].w) << 32); }
        float mylg = 0.f;
#pragma unroll 2
        for (int o = 0; o < 36; ++o) { float p = 0.f;
#pragma unroll
            for (int j = 0; j < 4; ++j) { const f32x4 w = *(const LAS f32x4*)(Wr + o * 1024 + 256 * j + 4 * F.lane); p += (v[j].x * w.x + v[j].y * w.y) + (v[j].z * w.z + v[j].w * w.w); }
            p = wave_sum(p); if (F.lane == o) mylg = p; }
        if (F.lane < 4) mylg += a.in[I_BRG][F.lane]; else if (F.lane < 36) mylg += a.in[I_BRE][F.lane - 4];
        float gl[4]; int gi = 0;
#pragma unroll
        for (int o = 0; o < 4; ++o) gl[o] = __shfl(mylg, o);
        float gm = gl[0];
#pragma unroll
        for (int o = 1; o < 4; ++o) if (gl[o] > gm) { gm = gl[o]; gi = o; }
        float gsum = 0.f;
#pragma unroll
        for (int o = 0; o < 4; ++o) gsum += expf(gl[o] - gm);
        const float gp = 1.0f / gsum;
        float el[8];
#pragma unroll
        for (int o = 0; o < 8; ++o) el[o] = __shfl(mylg, 4 + gi * 8 + o);
        int i0 = 0; float m0 = el[0];
#pragma unroll
        for (int o = 1; o < 8; ++o) if (el[o] > m0) { m0 = el[o]; i0 = o; }
        int i1 = -1; float m1 = -INFINITY;
#pragma unroll
        for (int o = 0; o < 8; ++o) if (o != i0 && el[o] > m1) { m1 = el[o]; i1 = o; }
        const float e1 = expf(m1 - m0); const float w0 = gp / (1.0f + e1), w1 = gp * e1 / (1.0f + e1);
        if (F.lane == 0) {
            const int ex0 = gi * 8 + i0, ex1 = gi * 8 + i1;
            const unsigned r0_ = atomicAdd(counts + ex0, 1u), r1_ = atomicAdd(counts + ex1, 1u);
            toklist[ex0 * T + r0_] = r; toklist[ex1 * T + r1_] = r;
            u32x4 t0; t0.x = (unsigned)ex0; t0.y = r0_; t0.z = (unsigned)ex1; t0.w = r1_;
            *(u32x4*)(tokinfo + (size_t)r * 8) = t0;
            tokinfo[(size_t)r * 8 + 4] = __float_as_uint(w0); tokinfo[(size_t)r * 8 + 5] = __float_as_uint(w1);
        }
    }
}
__device__ __forceinline__ void build_moe_tab(const Frame& F, const Args& a, LAS MoeTab* tab) {
    if (F.tid == 0) {
        const unsigned* counts = (const unsigned*)(a.ws + WS_CTL) + CW_COUNTS; int nt = 0;
        for (int e = 0; e < NEXP; ++e) { const int c = (int)__hip_atomic_load(counts + e, __ATOMIC_RELAXED, __HIP_MEMORY_SCOPE_AGENT); tab->cnt[e] = c; tab->tbase[e] = nt;
            const int n = (c + 255) >> 8; for (int m = 0; m < n; ++m) { tab->tile_e[nt] = e; tab->tile_m[nt] = m; ++nt; } }
        tab->tbase[NEXP] = nt; tab->nt = nt;
    }
    __syncthreads();
}
__device__ __forceinline__ void phase_final(const Frame& F, const Args& a, const LAS MoeTab* tab) {
    const float* mod = (const float*)(a.ws + WS_MOD); const unsigned* tokinfo = (const unsigned*)(a.ws + WS_TOKINFO); const bf16_t* Ys = (const bf16_t*)(a.ws + WS_YS);
    const int rows_per_blk = T / F.G, r0 = F.bid * rows_per_blk;
    for (int r = r0 + F.wave; r < r0 + rows_per_blk; r += NWAVES) {
        const int b = r / SEQ;
        const u32x4 ti = *(const u32x4*)(tokinfo + (size_t)r * 8);
        const float w0 = __uint_as_float(tokinfo[(size_t)r * 8 + 4]), w1 = __uint_as_float(tokinfo[(size_t)r * 8 + 5]);
        const size_t s0 = (size_t)tab->tbase[ti.x] * 256 + ti.y, s1 = (size_t)tab->tbase[ti.z] * 256 + ti.w;
        f32x4* xr = (f32x4*)(a.out + (size_t)r * D) + F.lane;
        const u32x2* y0 = (const u32x2*)(Ys + s0 * D) + F.lane; const u32x2* y1 = (const u32x2*)(Ys + s1 * D) + F.lane;
        f32x4 v[4]; float s = 0.f;
#pragma unroll
        for (int j = 0; j < 4; ++j) { const int k = 256 * j + 4 * F.lane;
            const f32x4 gt = *(const f32x4*)(mod + b * 6144 + 5 * 1024 + k); const u32x2 a0 = y0[64 * j], a1 = y1[64 * j];
            f32x4 m; m.x = w0 * bf2f(a0.x & 0xffffu) + w1 * bf2f(a1.x & 0xffffu); m.y = w0 * bf2f(a0.x >> 16) + w1 * bf2f(a1.x >> 16);
            m.z = w0 * bf2f(a0.y & 0xffffu) + w1 * bf2f(a1.y & 0xffffu); m.w = w0 * bf2f(a0.y >> 16) + w1 * bf2f(a1.y >> 16);
            v[j] = xr[64 * j] + gt * m; s += (v[j].x * v[j].x + v[j].y * v[j].y) + (v[j].z * v[j].z + v[j].w * v[j].w); }
        const float rs = rsqrtf(wave_sum(s) * (1.0f / D) + EPS);
#pragma unroll
        for (int j = 0; j < 4; ++j) { const f32x4 g = *(const f32x4*)(a.in[I_FG] + 256 * j + 4 * F.lane); xr[64 * j] = v[j] * rs * g; }
    }
}

constexpr int N_PHASES = 10;
__global__ void __launch_bounds__(NTHR, 2) mk_fwd(Args a) {
    extern __shared__ __attribute__((aligned(16))) unsigned char lds_raw[];
    Frame F; F.lds = (LAS unsigned char*)lds_raw; F.tid = threadIdx.x; F.lane = F.tid & 63; F.wave = __builtin_amdgcn_readfirstlane(F.tid >> 6); F.G = gridDim.x; F.bid = blockIdx.x;
    unsigned char* ws = a.ws;
    const int lo = a.ph_lo, hi = a.ph_hi;
#if MK_N_LAUNCHES == 1
    cg::grid_group grid = cg::this_grid();
#define SEAM(k) do { if (IN(k) && IN((k) + 1)) grid.sync(); } while (0)
#else
#define SEAM(k) do { } while (0)
#endif
#ifndef PHASE_MASK
#define PHASE_MASK 0x3ff
#endif
#define IN(k) (((PHASE_MASK >> (k)) & 1) && lo <= (k) && (k) < hi)
    LAS MoeTab* tab = (LAS MoeTab*)(F.lds + 144 * 1024);

    if (IN(0)) { phase0(F, a); } SEAM(0);
    if (IN(1)) { phase1(F, a); } SEAM(1);
    if (IN(2)) {
        DenseOrder S{(const char*)(ws + WS_ACT), (const char*)(ws + WS_WIN), D, T / 256, INC / 256, F.G, F.bid};
        EpiStoreBf16 E{(bf16_t*)(ws + WS_PROJ), INC};
        pg8::gemm_phase(F.lds, D, S, E);
    } SEAM(2);
    if (IN(3)) {
        for (int u = F.bid; u < 16; u += F.G) hgrn_naive_unit(F, a, u);
        for (int u = F.bid; u < 1024; u += F.G) attn_naive_unit(F, a, (u & ~63) | (63 - (u & 63)));
        __syncthreads();
    } SEAM(3);
    if (IN(4)) {
        UpOrder S{(const char*)(ws + WS_YDA), (const char*)(ws + WS_YHG), (const char*)(ws + WS_WUPDA), (const char*)(ws + WS_WUPHG), F.G, F.bid};
        EpiUp E{(const bf16_t*)(ws + WS_PROJ), (bf16_t*)(ws + WS_ACT)};
        pg8::gemm_phase(F.lds, 512, S, E);
    } SEAM(4);
    if (IN(5)) {
        DenseOrder S{(const char*)(ws + WS_ACT), (const char*)(ws + WS_WOUT), D, T / 256, D / 256, F.G, F.bid};
        EpiOut E{a.in[I_X], (const float*)(ws + WS_MOD), a.out};
        pg8::gemm_phase(F.lds, D, S, E);
        moe_weight_convert(F, a);
    } SEAM(5);
    if (IN(6)) { phase_router(F, a); __syncthreads(); } SEAM(6);
    if (IN(7)) {
        build_moe_tab(F, a, tab);
        Moe1Order S{tab, (const char*)(ws + WS_ACT), (const char*)(ws + WS_W13), (const int*)(ws + WS_TOKLIST), F.G, F.bid};
        EpiMoe1 E{(bf16_t*)(ws + WS_HS)};
        pg8::gemm_phase(F.lds, D, S, E);
    } SEAM(7);
    if (IN(8)) {
        build_moe_tab(F, a, tab);
        Moe2Order S{tab, (const char*)(ws + WS_HS), (const char*)(ws + WS_W2), F.G, F.bid};
        EpiStoreBf16 E{(bf16_t*)(ws + WS_YS), D};
        pg8::gemm_phase(F.lds, DEXP, S, E);
    } SEAM(8);
    if (IN(9)) { build_moe_tab(F, a, tab); phase_final(F, a, tab); }
#undef IN
#undef SEAM
}

extern "C" void kernel_launch(void* const* d_in, const int* in_sizes, int n_in, void* d_out, int out_size, void* d_ws, size_t ws_size, hipStream_t stream) {
    static int grid = 0;
    if (grid == 0) {
        if (n_in != 25 || in_sizes[0] != T * D || out_size != T * D || ws_size < WS_END) { fprintf(stderr, "kernel_launch: unexpected shapes (n_in %d, in0 %d, out %d, ws %zu)\n", n_in, n_in > 0 ? in_sizes[0] : -1, out_size, ws_size); grid = -1; return; }
        int dev = 0, cus = 0, per_cu = 0;
        if (hipGetDevice(&dev) != hipSuccess || hipDeviceGetAttribute(&cus, hipDeviceAttributeMultiprocessorCount, dev) != hipSuccess) { grid = -1; return; }
        if (hipFuncSetAttribute((const void*)mk_fwd, hipFuncAttributeMaxDynamicSharedMemorySize, LDS_BYTES) != hipSuccess) { fprintf(stderr, "kernel_launch: hipFuncSetAttribute failed\n"); grid = -1; return; }
        if (hipOccupancyMaxActiveBlocksPerMultiprocessor(&per_cu, (const void*)mk_fwd, NTHR, LDS_BYTES) != hipSuccess || per_cu < 1) { fprintf(stderr, "kernel_launch: occupancy query says %d\n", per_cu); per_cu = 1; }
        (void)hipGetLastError();
        grid = cus;
        if (grid > 256) grid = 256;
        while (T % grid) --grid;
    }
    if (grid < 0) return;
    (void)hipMemsetAsync((char*)d_ws + WS_CTL, 0, CTL_ZERO_BYTES, stream);
    Args a{};
    for (int i = 0; i < 25; ++i) a.in[i] = (const float*)d_in[i];
    a.out = (float*)d_out; a.ws = (unsigned char*)d_ws;
#if MK_N_LAUNCHES == 1
    a.ph_lo = 0; a.ph_hi = N_PHASES;
    void* args[] = {&a};
    hipError_t e = hipLaunchCooperativeKernel((const void*)mk_fwd, dim3(grid), dim3(NTHR), args, LDS_BYTES, stream);
    if (e != hipSuccess) fprintf(stderr, "cooperative launch failed: %s (grid %d)\n", hipGetErrorString(e), grid);
#else
    for (int p = 0; p < N_PHASES; ++p) {
        a.ph_lo = p; a.ph_hi = p + 1;
        hipLaunchKernelGGL(mk_fwd, dim3(grid), dim3(NTHR), LDS_BYTES, stream, a);
    }
#endif
}
```

```cpp
#include <hip/hip_runtime.h>
#include <hip/hip_cooperative_groups.h>
#include <cstdio>
#include <cstdint>
namespace cg = cooperative_groups;

#ifndef MK_N_LAUNCHES
#define MK_N_LAUNCHES 1
#endif

#define LAS __attribute__((address_space(3)))
typedef unsigned short bf16_t;
typedef short bf16x8 __attribute__((ext_vector_type(8)));
typedef float f32x4 __attribute__((ext_vector_type(4)));
typedef float f32x2 __attribute__((ext_vector_type(2)));
typedef unsigned u32x4 __attribute__((ext_vector_type(4)));
typedef unsigned u32x2 __attribute__((ext_vector_type(2)));

constexpr int NB = 4, SEQ = 4096, D = 1024, T = NB * SEQ;
constexpr int INC = 5632;
constexpr int C_QDA = 0, C_KDA = 512, C_VDA = 1024, C_QHG = 1536, C_FHG = 2048, C_IHG = 2560, C_GHG = 3072, C_GDA = 3584, C_GHGATE = 4608;
constexpr int NEXP = 32, DEXP = 512;
constexpr int PMAX = 40960;
constexpr float EPS = 1e-6f;
constexpr int NWAVES = 8, NTHR = 512;

constexpr size_t MiB = 1u << 20;
constexpr size_t WS_CTL = 0, CTL_ZERO_BYTES = 64 * 1024;
constexpr size_t WS_MODP = 1 * MiB;
constexpr size_t WS_MOD = 5 * MiB / 2;
constexpr size_t WS_SMALL = 11 * MiB / 4;
constexpr size_t WS_TOKINFO = 3 * MiB;
constexpr size_t WS_TOKLIST = 4 * MiB;
constexpr size_t WS_WIN = 8 * MiB;
constexpr size_t WS_WUPDA = 20 * MiB, WS_WUPHG = 21 * MiB, WS_WOUT = 22 * MiB;
constexpr size_t WS_ACT = 24 * MiB;
constexpr size_t WS_PROJ = 56 * MiB;
constexpr size_t WS_YDA = 232 * MiB, WS_YHG = 248 * MiB;
constexpr size_t WS_W13 = 56 * MiB;
constexpr size_t WS_W2 = 120 * MiB;
constexpr size_t WS_HS = 152 * MiB;
constexpr size_t WS_YS = 192 * MiB;
constexpr size_t WS_END = 272 * MiB;
constexpr int CW_COUNTS = 64;

constexpr int LDS_BYTES = 160 * 1024;

__device__ __forceinline__ float bf2f(unsigned v) { return __uint_as_float(v << 16); }
__device__ __forceinline__ unsigned f2bf(float f) { unsigned u = __float_as_uint(f); return (u + 0x7fffu + ((u >> 16) & 1u)) >> 16; }
__device__ __forceinline__ unsigned pk2(float lo, float hi) { return f2bf(lo) | (f2bf(hi) << 16); }
__device__ __forceinline__ float sigmoidf_(float x) { return 1.0f / (1.0f + __expf(-x)); }
__device__ __forceinline__ float siluf_(float x) { return x / (1.0f + __expf(-x)); }
__device__ __forceinline__ float wave_sum(float v) {
#pragma unroll
    for (int o = 1; o < 64; o <<= 1) v += __shfl_xor(v, o);
    return v;
}

namespace pg8 {
constexpr int BM = 256, BK = 64, HALF = 128, HTB = HALF * BK * 2, STAGE_BYTES = 8 * HTB;
__host__ __device__ __forceinline__ int lds_byte(int r, int c) { const int st = (r >> 4) * 2 + (c >> 5), rr = r & 15, cc = c & 31, ob = rr * 64 + cc * 2; return st * 1024 + (ob ^ (((ob >> 9) & 1) << 5)); }
__host__ __device__ __forceinline__ void stage_rc(int b, int& R, int& C) { const int st = b / 1024, sb = b % 1024, swz = sb ^ (((sb >> 9) & 1) << 5); R = (st >> 1) * 16 + swz / 64; C = (st & 1) * 32 + (swz % 64) / 2; }
__host__ __device__ __forceinline__ int perm32(int rho) { const int n = rho >> 4, i = rho & 15; return 8 * (i >> 2) + 4 * n + (i & 3); }

struct Unit { int pm, pn; const char* A; const char* B; int aux; };
__device__ __forceinline__ unsigned cvt_pk_bf16(float lo, float hi) { unsigned r; asm volatile("v_cvt_pk_bf16_f32 %0, %1, %2" : "=v"(r) : "v"(lo), "v"(hi)); return r; }

template <class Epi, class Sched>
__device__ __forceinline__ void gemm_phase(LAS unsigned char* lds, const int K, const Sched& S, const Epi& E) {
    const int tid = threadIdx.x, wid = __builtin_amdgcn_readfirstlane(tid >> 6), lane = tid & 63, wr = wid >> 2, wc = wid & 3, fr = lane & 15, fq = lane >> 4;
    const int nt = K / BK;
    int RA[2], CA[2]; unsigned voffB[2];
#pragma unroll
    for (int i = 0; i < 2; ++i) { int R, C; stage_rc(tid * 16 + i * 8192, R, C); const int Rb = Epi::PERM ? ((R & ~31) + perm32(R & 31)) : R;
        RA[i] = R; CA[i] = C; voffB[i] = (unsigned)(Rb * K + C) * 2u; }
    const size_t kstep = (size_t)(BK * 2);
    const size_t hstep = (size_t)HALF * K * 2;
    const unsigned ldsw = (unsigned)wid * 1024u;
    const int aoff = lds_byte(wr * 64 + fr, fq * 8), boff = lds_byte(wc * 32 + fr, fq * 8);
#define PG8_SA(b, h) (((b) * 2 + (h)) * HTB)
#define PG8_SB(b, h) ((4 + (b) * 2 + (h)) * HTB)
#define PG8_STAGE(bufoff, gbase, voff) do { _Pragma("unroll") for (int _i = 0; _i < 2; ++_i) \
        __builtin_amdgcn_global_load_lds((const unsigned*)((const char*)(gbase) + (voff)[_i]), (LAS unsigned*)(lds + (bufoff) + ldsw + _i * 8192), 16, 0, 0); } while (0)
#define PG8_LDA(dst, b, h) do { _Pragma("unroll") for (int m = 0; m < 4; ++m) _Pragma("unroll") for (int k = 0; k < 2; ++k) dst[m][k] = *(const LAS bf16x8*)(lds + PG8_SA(b, h) + aoff + m * 2048 + k * 1024); } while (0)
#define PG8_LDB(dst, b, h) do { _Pragma("unroll") for (int n = 0; n < 2; ++n) _Pragma("unroll") for (int k = 0; k < 2; ++k) dst[n][k] = *(const LAS bf16x8*)(lds + PG8_SB(b, h) + boff + n * 2048 + k * 1024); } while (0)
#define PG8_MMA(ai, bj, At, Bt) do { __builtin_amdgcn_s_setprio(1); _Pragma("unroll") for (int m = 0; m < 4; ++m) _Pragma("unroll") for (int n = 0; n < 2; ++n) _Pragma("unroll") for (int k = 0; k < 2; ++k) \
        acc[ai][bj][m][n] = __builtin_amdgcn_mfma_f32_16x16x32_bf16(Bt[n][k], At[m][k], acc[ai][bj][m][n], 0, 0, 0); __builtin_amdgcn_s_setprio(0); } while (0)
#define PG8_WAIT_V(n) asm volatile("s_waitcnt vmcnt(" #n ")" ::: "memory")
#define PG8_WAIT_L(n) asm volatile("s_waitcnt lgkmcnt(" #n ")" ::: "memory")
#define PG8_BAR __builtin_amdgcn_s_barrier()
#define PG8_SCHED __builtin_amdgcn_sched_barrier(0)
#define PG8_SETA(vo, u) do { _Pragma("unroll") for (int _h = 0; _h < 2; ++_h) _Pragma("unroll") for (int _i = 0; _i < 2; ++_i) \
        vo[_h][_i] = (unsigned)((size_t)S.arow(u, _h * HALF + RA[_i]) * (size_t)K + CA[_i]) * 2u; if (Sched::GATHER) PG8_WAIT_V(0); } while (0)
    Unit cur, nxt; int ui = 0;
    if (!S.next(0, cur)) return;
    f32x4 acc[2][2][4][2];
#pragma unroll
    for (int a = 0; a < 2; ++a)
#pragma unroll
        for (int b = 0; b < 2; ++b)
#pragma unroll
            for (int m = 0; m < 4; ++m)
#pragma unroll
                for (int n = 0; n < 2; ++n) acc[a][b][m][n] = (f32x4){0.f, 0.f, 0.f, 0.f};
    bf16x8 At[4][2], B0[2][2], B1[2][2];
    unsigned voC[2][2], voN[2][2];
    PG8_SETA(voC, cur);
    const char* cA = cur.A; const char* cB = cur.B;
    PG8_STAGE(PG8_SB(0, 0), cB, voffB); PG8_STAGE(PG8_SB(0, 1), cB + hstep, voffB); PG8_STAGE(PG8_SA(0, 0), cA, voC[0]); PG8_STAGE(PG8_SA(0, 1), cA, voC[1]);
    if (wr == 1) PG8_BAR;
    PG8_WAIT_V(2); PG8_BAR;
    PG8_STAGE(PG8_SB(1, 0), cB + kstep, voffB); PG8_STAGE(PG8_SA(1, 0), cA + kstep, voC[0]); PG8_STAGE(PG8_SB(1, 1), cB + hstep + kstep, voffB);
    PG8_WAIT_V(6); PG8_BAR;
    for (;;) {
        const bool has_next = S.next(ui + 1, nxt);
        if (has_next) { PG8_SETA(voN, nxt); }
        else {
#pragma unroll
            for (int h = 0; h < 2; ++h)
#pragma unroll
                for (int i = 0; i < 2; ++i) voN[h][i] = voC[h][i];
        }
        const char* nA = has_next ? nxt.A : cA; const char* nB = has_next ? nxt.B : cB;
        for (int t = 0; t < nt; t += 2) {
            const bool last = (t == nt - 2);
            const char* a1 = cA + (size_t)(t + 1) * kstep;
            const char* a2 = last ? nA : cA + (size_t)(t + 2) * kstep; const char* b2 = last ? nB : cB + (size_t)(t + 2) * kstep;
            const char* a3 = a2 + kstep; const char* b3 = b2 + kstep;
            unsigned vo2[2][2];
#pragma unroll
            for (int h = 0; h < 2; ++h)
#pragma unroll
                for (int i = 0; i < 2; ++i) vo2[h][i] = last ? voN[h][i] : voC[h][i];
            PG8_LDB(B0, 0, 0); PG8_LDB(B1, 0, 1); PG8_SCHED; PG8_LDA(At, 0, 0); PG8_STAGE(PG8_SA(1, 1), a1, voC[1]);
            PG8_WAIT_V(8); PG8_WAIT_L(0); PG8_BAR; PG8_MMA(0, 0, At, B0); PG8_MMA(0, 1, At, B1); PG8_BAR; PG8_SCHED;
            PG8_LDA(At, 0, 1); PG8_STAGE(PG8_SB(0, 0), b2, voffB); PG8_STAGE(PG8_SB(0, 1), b2 + hstep, voffB); PG8_STAGE(PG8_SA(0, 0), a2, vo2[0]);
            PG8_WAIT_V(8); PG8_WAIT_L(0); PG8_BAR; PG8_MMA(1, 0, At, B0); PG8_MMA(1, 1, At, B1); PG8_BAR; PG8_SCHED;
            PG8_LDB(B0, 1, 0); PG8_LDB(B1, 1, 1); PG8_SCHED; PG8_LDA(At, 1, 0); PG8_STAGE(PG8_SA(0, 1), a2, vo2[1]);
            PG8_WAIT_V(8); PG8_WAIT_L(0); PG8_BAR; PG8_MMA(0, 0, At, B0); PG8_MMA(0, 1, At, B1); PG8_BAR; PG8_SCHED;
            PG8_LDA(At, 1, 1); PG8_STAGE(PG8_SB(1, 0), b3, voffB); PG8_STAGE(PG8_SB(1, 1), b3 + hstep, voffB); PG8_STAGE(PG8_SA(1, 0), a3, vo2[0]);
            PG8_WAIT_V(8); PG8_WAIT_L(0); PG8_BAR; PG8_MMA(1, 0, At, B0); PG8_MMA(1, 1, At, B1); PG8_BAR; PG8_SCHED;
        }
        if (wr == 0) PG8_BAR;
        const bool keep = E(acc, cur, wr, wc, fr, fq);
        if (!has_next) break;
        if (!keep) {
#pragma unroll
            for (int a = 0; a < 2; ++a)
#pragma unroll
                for (int b = 0; b < 2; ++b)
#pragma unroll
                    for (int m = 0; m < 4; ++m)
#pragma unroll
                        for (int n = 0; n < 2; ++n) acc[a][b][m][n] = (f32x4){0.f, 0.f, 0.f, 0.f};
        }
        cur = nxt; cA = nA; cB = nB; ++ui;
#pragma unroll
        for (int h = 0; h < 2; ++h)
#pragma unroll
            for (int i = 0; i < 2; ++i) voC[h][i] = voN[h][i];
        if (wr == 1) PG8_BAR;
    }
    PG8_WAIT_V(0);
    PG8_BAR;
#undef PG8_SA
#undef PG8_SB
#undef PG8_STAGE
#undef PG8_LDA
#undef PG8_LDB
#undef PG8_MMA
#undef PG8_WAIT_V
#undef PG8_WAIT_L
#undef PG8_BAR
#undef PG8_SCHED
#undef PG8_SETA
}
}

struct Args { const float* in[25]; float* out; unsigned char* ws; int ph_lo, ph_hi; };
enum { I_X = 0, I_C, I_WADA, I_BADA, I_N1G, I_WIN, I_LQ1, I_LK1, I_LQ2, I_LK2, I_SUBG, I_LBL, I_HGNG, I_WUPDA, I_WUPHG, I_WOUT, I_N2G, I_WRG, I_BRG, I_WRE, I_BRE, I_W1, I_W3, I_W2, I_FG };

struct DenseOrder {
    static constexpr bool GATHER = false;
    const char* A; const char* Bt; int K, nM, nN, G, c;
    __device__ __forceinline__ bool next(int i, pg8::Unit& u) const {
        const int L = i * G + c, nwg = nM * nN; if (L >= nwg) return false;
        int wgid = L; { const int q = nwg / 8, r = nwg % 8, xcd = wgid % 8, off = wgid / 8; wgid = (xcd < r ? xcd * (q + 1) : r * (q + 1) + (xcd - r) * q) + off; }
        const int nig = 8 * nN, gid = wgid / nig, fm = gid * 8, gsz = (nM - fm) < 8 ? (nM - fm) : 8;
        u.pm = fm + ((wgid % nig) % gsz); u.pn = (wgid % nig) / gsz; u.A = A; u.B = Bt + (size_t)u.pn * 256 * K * 2; u.aux = 0; return true;
    }
    __device__ __forceinline__ unsigned arow(const pg8::Unit& u, int r) const { return (unsigned)(u.pm * 256 + r); }
};
struct UpOrder {
    static constexpr bool GATHER = false;
    const char* A0; const char* A1; const char* B0; const char* B1; int G, c;
    __device__ __forceinline__ bool next(int i, pg8::Unit& u) const {
        const int tile = (i >> 1) * G + c; if (tile >= 256) return false;
        u.pm = tile >> 2; u.pn = tile & 3; u.aux = i & 1;
        u.A = (i & 1) ? A1 : A0; u.B = ((i & 1) ? B1 : B0) + (size_t)u.pn * 256 * 512 * 2; return true;
    }
    __device__ __forceinline__ unsigned arow(const pg8::Unit& u, int r) const { return (unsigned)(u.pm * 256 + r); }
};
struct MoeTab { int nt; int pad[3]; int tile_e[176]; int tile_m[176]; int cnt[32]; int tbase[33]; };
struct Moe1Order {
    static constexpr bool GATHER = true;
    const LAS MoeTab* tab; const char* A; const char* W; const int* toklist; int G, c;
    __device__ __forceinline__ bool next(int i, pg8::Unit& u) const {
        const int L = i * G + c; if (L >= tab->nt * 4) return false;
        const int ti = L >> 2; u.pm = ti; u.pn = L & 3; u.aux = ti; u.A = A;
        u.B = W + ((size_t)tab->tile_e[ti] * 1024 + (size_t)u.pn * 256) * 1024 * 2; return true;
    }
    __device__ __forceinline__ unsigned arow(const pg8::Unit& u, int r) const {
        const int e = tab->tile_e[u.aux], rr = tab->tile_m[u.aux] * 256 + r;
        return rr < tab->cnt[e] ? (unsigned)toklist[e * T + rr] : 0u;
    }
};
struct Moe2Order {
    static constexpr bool GATHER = false;
    const LAS MoeTab* tab; const char* A; const char* W; int G, c;
    __device__ __forceinline__ bool next(int i, pg8::Unit& u) const {
        const int L = i * G + c; if (L >= tab->nt * 4) return false;
        const int ti = L >> 2; u.pm = ti; u.pn = L & 3; u.aux = ti; u.A = A;
        u.B = W + ((size_t)tab->tile_e[ti] * 1024 + (size_t)u.pn * 256) * 512 * 2; return true;
    }
    __device__ __forceinline__ unsigned arow(const pg8::Unit& u, int r) const { return (unsigned)(u.pm * 256 + r); }
};

using pg8::Unit; using pg8::cvt_pk_bf16;
struct EpiStoreBf16 {
    static constexpr bool PERM = true;
    bf16_t* O; int ldc;
    __device__ __forceinline__ bool operator()(f32x4 (&acc)[2][2][4][2], const Unit& u, int wr, int wc, int fr, int fq) const {
        const int row0 = u.pm * 256 + wr * 64 + fr, col0 = u.pn * 256 + wc * 32 + 8 * fq;
#pragma unroll
        for (int ai = 0; ai < 2; ++ai)
#pragma unroll
            for (int m = 0; m < 4; ++m) { bf16_t* rowp = O + (size_t)(row0 + ai * 128 + m * 16) * ldc + col0;
#pragma unroll
                for (int bj = 0; bj < 2; ++bj) { const f32x4 v0 = acc[ai][bj][m][0], v1 = acc[ai][bj][m][1];
                    u32x4 w; w.x = cvt_pk_bf16(v0[0], v0[1]); w.y = cvt_pk_bf16(v0[2], v0[3]); w.z = cvt_pk_bf16(v1[0], v1[1]); w.w = cvt_pk_bf16(v1[2], v1[3]);
                    *(u32x4*)(rowp + bj * 128) = w; } }
        return false;
    }
};
struct EpiUp {
    static constexpr bool PERM = true;
    const bf16_t* proj; bf16_t* O;
    __device__ __forceinline__ bool operator()(f32x4 (&acc)[2][2][4][2], const Unit& u, int wr, int wc, int fr, int fq) const {
        const int row0 = u.pm * 256 + wr * 64 + fr, col0 = u.pn * 256 + wc * 32 + 8 * fq;
#pragma unroll
        for (int ai = 0; ai < 2; ++ai)
#pragma unroll
            for (int m = 0; m < 4; ++m) { const size_t row = (size_t)(row0 + ai * 128 + m * 16);
#pragma unroll
                for (int bj = 0; bj < 2; ++bj) {
                    const int col = col0 + bj * 128;
                    const u32x4 gh = *(const u32x4*)(proj + row * INC + C_GHGATE + col);
                    float sh[8];
#pragma unroll
                    for (int j = 0; j < 4; ++j) { sh[2 * j] = 1.0f + __expf(-bf2f(gh[j] & 0xffffu)); sh[2 * j + 1] = 1.0f + __expf(-bf2f(gh[j] >> 16)); }
                    if (u.aux == 0) {
                        const u32x4 gd = *(const u32x4*)(proj + row * INC + C_GDA + col);
#pragma unroll
                        for (int j = 0; j < 4; ++j) {
                            const float d0 = 1.0f + __expf(-bf2f(gd[j] & 0xffffu)), d1 = 1.0f + __expf(-bf2f(gd[j] >> 16));
                            const float r0 = sh[2 * j] / d0, r1 = sh[2 * j + 1] / d1;
                            if (j < 2) { acc[ai][bj][m][0][2 * j] *= r0; acc[ai][bj][m][0][2 * j + 1] *= r1; }
                            else { acc[ai][bj][m][1][2 * j - 4] *= r0; acc[ai][bj][m][1][2 * j - 3] *= r1; }
                        }
                    } else {
                        const f32x4 v0 = acc[ai][bj][m][0], v1 = acc[ai][bj][m][1];
                        u32x4 w; w.x = cvt_pk_bf16(v0[0] / sh[0], v0[1] / sh[1]); w.y = cvt_pk_bf16(v0[2] / sh[2], v0[3] / sh[3]);
                        w.z = cvt_pk_bf16(v1[0] / sh[4], v1[1] / sh[5]); w.w = cvt_pk_bf16(v1[2] / sh[6], v1[3] / sh[7]);
                        *(u32x4*)(O + row * D + col) = w;
                    }
                } }
        return u.aux == 0;
    }
};
struct EpiOut {
    static constexpr bool PERM = false;
    const float* x; const float* mod; float* O;
    __device__ __forceinline__ bool operator()(f32x4 (&acc)[2][2][4][2], const Unit& u, int wr, int wc, int fr, int fq) const {
        const int row0 = u.pm * 256 + wr * 64 + fr, col0 = u.pn * 256 + wc * 32 + 4 * fq;
        const int b = (u.pm * 256) / SEQ;
        f32x4 gt[2][2];
#pragma unroll
        for (int bj = 0; bj < 2; ++bj)
#pragma unroll
            for (int n = 0; n < 2; ++n) gt[bj][n] = *(const f32x4*)(mod + b * 6144 + 2048 + col0 + bj * 128 + n * 16);
#pragma unroll
        for (int ai = 0; ai < 2; ++ai)
#pragma unroll
            for (int m = 0; m < 4; ++m) { const size_t off = (size_t)(row0 + ai * 128 + m * 16) * D + col0;
#pragma unroll
                for (int bj = 0; bj < 2; ++bj)
#pragma unroll
                    for (int n = 0; n < 2; ++n) { const f32x4 xv = *(const f32x4*)(x + off + bj * 128 + n * 16);
                        *(f32x4*)(O + off + bj * 128 + n * 16) = xv + gt[bj][n] * acc[ai][bj][m][n]; } }
        return false;
    }
};
struct EpiMoe1 {
    static constexpr bool PERM = true;
    bf16_t* O;
    __device__ __forceinline__ bool operator()(f32x4 (&acc)[2][2][4][2], const Unit& u, int wr, int wc, int fr, int fq) const {
        const int row0 = u.pm * 256 + wr * 64 + fr, col0 = u.pn * 128 + wc * 32 + 8 * fq;
#pragma unroll
        for (int ai = 0; ai < 2; ++ai)
#pragma unroll
            for (int m = 0; m < 4; ++m) { bf16_t* rowp = O + (size_t)(row0 + ai * 128 + m * 16) * DEXP + col0;
                float h[8];
#pragma unroll
                for (int n = 0; n < 2; ++n)
#pragma unroll
                    for (int e = 0; e < 4; ++e) h[n * 4 + e] = siluf_(acc[ai][0][m][n][e]) * acc[ai][1][m][n][e];
                u32x4 w; w.x = cvt_pk_bf16(h[0], h[1]); w.y = cvt_pk_bf16(h[2], h[3]); w.z = cvt_pk_bf16(h[4], h[5]); w.w = cvt_pk_bf16(h[6], h[7]);
                *(u32x4*)rowp = w; }
        return false;
    }
};

struct Frame { LAS unsigned char* lds; int tid, lane, wave, G, bid; };

__device__ __forceinline__ void transpose_item(const float* Wsrc, int ldw, bf16_t* dst, int ldd, LAS float* scr, int lane) {
#pragma unroll 8
    for (int i = 0; i < 32; ++i) { const int kk = 2 * i + (lane >> 5); scr[kk * 33 + (lane & 31)] = Wsrc[(size_t)kk * ldw + (lane & 31)]; }
    asm volatile("s_waitcnt lgkmcnt(0)" ::: "memory");
    const int c = lane & 7;
#pragma unroll
    for (int j = 0; j < 4; ++j) { const int n = (lane >> 3) + 8 * j; const LAS float* s = scr + (8 * c) * 33 + n;
        u32x4 o; o.x = pk2(s[0 * 33], s[1 * 33]); o.y = pk2(s[2 * 33], s[3 * 33]); o.z = pk2(s[4 * 33], s[5 * 33]); o.w = pk2(s[6 * 33], s[7 * 33]);
        *(u32x4*)(dst + (size_t)n * ldd + 8 * c) = o; }
    asm volatile("s_waitcnt lgkmcnt(0)" ::: "memory");
}
__device__ __forceinline__ void transpose_matrix(const Frame& F, const float* W, int K, int N, bf16_t* WT) {
    LAS float* scr = (LAS float*)(F.lds + F.wave * 8448);
    const int gw = F.bid * NWAVES + F.wave, NGW = F.G * NWAVES, nblk = N / 32, items = (K / 64) * nblk;
    for (int it = gw; it < items; it += NGW) { const int kb = it / nblk, nb = it % nblk;
        transpose_item(W + (size_t)(64 * kb) * N + 32 * nb, N, WT + (size_t)(32 * nb) * K + 64 * kb, K, scr, F.lane); }
}

__device__ __forceinline__ void phase0(const Frame& F, const Args& a) {
    unsigned char* ws = a.ws;
    {
        float* modp = (float*)(ws + WS_MODP);
        const float* c = a.in[I_C]; const float* wada = a.in[I_WADA];
        for (int wt = F.bid + 256 * F.wave; wt < 384; wt += 256 * NWAVES) {
            if (F.G != 256) break;
            const int ks = wt / 24, jw = wt % 24, j = jw * 256 + F.lane * 4;
            f32x4 s[4] = {{0, 0, 0, 0}, {0, 0, 0, 0}, {0, 0, 0, 0}, {0, 0, 0, 0}};
            for (int k = ks * 64; k < ks * 64 + 64; ++k) {
                const f32x4 w = *(const f32x4*)(wada + (size_t)k * 6144 + j);
#pragma unroll
                for (int b = 0; b < 4; ++b) { const float cv = siluf_(c[b * D + k]); s[b] += w * cv; }
            }
#pragma unroll
            for (int b = 0; b < 4; ++b) *(f32x4*)(modp + ((size_t)ks * 4 + b) * 6144 + j) = s[b];
        }
        if (F.G != 256) {
            const int gw = F.bid * NWAVES + F.wave, NGW = F.G * NWAVES;
            for (int wt = gw; wt < 384; wt += NGW) {
                const int ks = wt / 24, jw = wt % 24, j = jw * 256 + F.lane * 4;
                f32x4 s[4] = {{0, 0, 0, 0}, {0, 0, 0, 0}, {0, 0, 0, 0}, {0, 0, 0, 0}};
                for (int k = ks * 64; k < ks * 64 + 64; ++k) {
                    const f32x4 w = *(const f32x4*)(wada + (size_t)k * 6144 + j);
#pragma unroll
                    for (int b = 0; b < 4; ++b) { const float cv = siluf_(c[b * D + k]); s[b] += w * cv; }
                }
#pragma unroll
                for (int b = 0; b < 4; ++b) *(f32x4*)(modp + ((size_t)ks * 4 + b) * 6144 + j) = s[b];
            }
        }
    }
    transpose_matrix(F, a.in[I_WIN], D, INC, (bf16_t*)(ws + WS_WIN));
    transpose_matrix(F, a.in[I_WUPDA], 512, D, (bf16_t*)(ws + WS_WUPDA));
    transpose_matrix(F, a.in[I_WUPHG], 512, D, (bf16_t*)(ws + WS_WUPHG));
    transpose_matrix(F, a.in[I_WOUT], D, D, (bf16_t*)(ws + WS_WOUT));
    if (F.bid == 0) {
        float* sm = (float*)(ws + WS_SMALL);
        if (F.tid == 0) {
            float s1 = 0.f, s2 = 0.f;
            for (int i = 0; i < 64; ++i) { s1 += a.in[I_LQ1][i] * a.in[I_LK1][i]; s2 += a.in[I_LQ2][i] * a.in[I_LK2][i]; }
            sm[0] = expf(s1) - expf(s2) + 0.2f;
        }
        { const float l0 = a.in[I_LBL][F.tid], l1 = a.in[I_LBL][512 + F.tid]; const float mx = fmaxf(l0, l1);
          const float e0 = expf(l0 - mx), e1 = expf(l1 - mx); sm[16 + F.tid] = e0 / (e0 + e1); }
    }
}
__device__ __forceinline__ void moe_weight_convert(const Frame& F, const Args& a) {
    LAS float* scr = (LAS float*)(F.lds + F.wave * 8448);
    const int gw = F.bid * NWAVES + F.wave, NGW = F.G * NWAVES;
    bf16_t* w13 = (bf16_t*)(a.ws + WS_W13); bf16_t* w2t = (bf16_t*)(a.ws + WS_W2);
    for (int it = gw; it < 2 * NEXP * 256; it += NGW) {
        const int which = it / (NEXP * 256), r = it % (NEXP * 256), e = r >> 8, kb = (r >> 4) & 15, nb = r & 15, n0 = 32 * nb;
        const float* W = a.in[which ? I_W3 : I_W1] + (size_t)e * 1024 * 512;
        const int drow = 256 * (n0 >> 7) + (which ? 128 : 0) + (n0 & 127);
        transpose_item(W + (size_t)(64 * kb) * 512 + n0, 512, w13 + ((size_t)e * 1024 + drow) * 1024 + 64 * kb, 1024, scr, F.lane);
    }
    for (int it = gw; it < NEXP * 256; it += NGW) {
        const int e = it >> 8, kb = (it >> 5) & 7, nb = it & 31;
        const float* W = a.in[I_W2] + (size_t)e * 512 * 1024;
        transpose_item(W + (size_t)(64 * kb) * 1024 + 32 * nb, 1024, w2t + ((size_t)e * 1024 + 32 * nb) * 512 + 64 * kb, 512, scr, F.lane);
    }
}

__device__ __forceinline__ void phase1(const Frame& F, const Args& a) {
    const float* modp = (const float*)(a.ws + WS_MODP); float* mod = (float*)(a.ws + WS_MOD);
    for (int i = F.bid * NTHR + F.tid; i < 4 * 6144; i += F.G * NTHR) {
        float s = a.in[I_BADA][i % 6144];
        for (int ks = 0; ks < 16; ++ks) s += modp[(size_t)ks * 4 * 6144 + i];
        mod[i] = s;
    }
    LAS float* Gs = (LAS float*)F.lds;
    LAS float* Ss = Gs + 1024;
    bf16_t* H = (bf16_t*)(a.ws + WS_ACT);
    const int rows_per_blk = T / F.G;
    const int r0 = F.bid * rows_per_blk, b = r0 / SEQ;
    for (int k = F.tid; k < 1024; k += NTHR) {
        float sh = a.in[I_BADA][k], sc = a.in[I_BADA][1024 + k];
        for (int ks = 0; ks < 16; ++ks) { sh += modp[((size_t)ks * 4 + b) * 6144 + k]; sc += modp[((size_t)ks * 4 + b) * 6144 + 1024 + k]; }
        Gs[k] = a.in[I_N1G][k] * (1.0f + sc); Ss[k] = sh;
    }
    __syncthreads();
    for (int r = r0 + F.wave; r < r0 + rows_per_blk; r += NWAVES) {
        const f32x4* xr = (const f32x4*)(a.in[I_X] + (size_t)r * D) + F.lane;
        f32x4 v[4]; float s = 0.f;
#pragma unroll
        for (int j = 0; j < 4; ++j) { v[j] = xr[64 * j]; s += (v[j].x * v[j].x + v[j].y * v[j].y) + (v[j].z * v[j].z + v[j].w * v[j].w); }
        const float rs = rsqrtf(wave_sum(s) * (1.0f / D) + EPS);
        unsigned long long* o8 = (unsigned long long*)(H + (size_t)r * D) + F.lane;
#pragma unroll
        for (int j = 0; j < 4; ++j) { const f32x4 g = *(const LAS f32x4*)(Gs + 256 * j + 4 * F.lane), sh = *(const LAS f32x4*)(Ss + 256 * j + 4 * F.lane);
            const f32x4 h = v[j] * rs * g + sh;
            o8[64 * j] = (unsigned long long)pk2(h.x, h.y) | ((unsigned long long)pk2(h.z, h.w) << 32); }
    }
}

constexpr int KPAD = 132;
__device__ __forceinline__ void attn_naive_unit(const Frame& F, const Args& a, int unit) {
    const bf16_t* proj = (const bf16_t*)(a.ws + WS_PROJ);
    const float lam = ((const float*)(a.ws + WS_SMALL))[0];
    const int b = unit >> 8, h = (unit >> 6) & 3, qc = unit & 63;
    LAS float* Ks = (LAS float*)F.lds;
    LAS float* Vs = Ks + 64 * KPAD;
    LAS float* Ps = Vs + 64 * KPAD;
    const int tid = F.tid, map = tid >> 8, qi = (tid >> 2) & 63, g = tid & 3;
    const float slope = exp2f(-2.0f * (h + 1));
    const size_t trow0 = (size_t)b * SEQ + qc * 64;
    float q[64];
    {
        const bf16_t* qp = proj + (trow0 + qi) * INC + C_QDA + h * 128 + map * 64;
#pragma unroll
        for (int d = 0; d < 64; d += 8) { const u32x4 w = *(const u32x4*)(qp + d);
#pragma unroll
            for (int j = 0; j < 4; ++j) { q[d + 2 * j] = bf2f(w[j] & 0xffffu) * 0.125f; q[d + 2 * j + 1] = bf2f(w[j] >> 16) * 0.125f; } }
    }
    float O[32];
#pragma unroll
    for (int i = 0; i < 32; ++i) O[i] = 0.f;
    float mrun = -INFINITY, lrun = 0.f;
    const int qpos = qc * 64 + qi;
    for (int kt = 0; kt <= qc; ++kt) {
        __syncthreads();
        for (int i = tid; i < 64 * 16; i += NTHR) {
            const int r = i >> 4, c8 = (i & 15) * 8; const size_t rowp = ((size_t)b * SEQ + kt * 64 + r) * INC;
            const u32x4 kw = *(const u32x4*)(proj + rowp + C_KDA + h * 128 + c8), vw = *(const u32x4*)(proj + rowp + C_VDA + h * 128 + c8);
#pragma unroll
            for (int j = 0; j < 4; ++j) { Ks[r * KPAD + c8 + 2 * j] = bf2f(kw[j] & 0xffffu); Ks[r * KPAD + c8 + 2 * j + 1] = bf2f(kw[j] >> 16);
                Vs[r * KPAD + c8 + 2 * j] = bf2f(vw[j] & 0xffffu); Vs[r * KPAD + c8 + 2 * j + 1] = bf2f(vw[j] >> 16); }
        }
        __syncthreads();
        float s[16]; float mx = -INFINITY;
#pragma unroll
        for (int jj = 0; jj < 16; ++jj) {
            const int j = jj * 4 + g; const LAS float* kr = Ks + j * KPAD + map * 64; float d = 0.f;
#pragma unroll
            for (int dd = 0; dd < 64; dd += 4) { const f32x4 kv = *(const LAS f32x4*)(kr + dd); d += q[dd] * kv.x + q[dd + 1] * kv.y + q[dd + 2] * kv.z + q[dd + 3] * kv.w; }
            const int kpos = kt * 64 + j; const int dist = qpos > kpos ? qpos - kpos : kpos - qpos;
            s[jj] = d - slope * (float)dist; mx = fmaxf(mx, s[jj]);
        }
        mx = fmaxf(mx, __shfl_xor(mx, 1)); mx = fmaxf(mx, __shfl_xor(mx, 2));
        const float mnew = fmaxf(mrun, mx), alpha = __expf(mrun - mnew);
        float ps = 0.f;
#pragma unroll
        for (int jj = 0; jj < 16; ++jj) { const float p = __expf(s[jj] - mnew); ps += p; Ps[(map * 64 + qi) * 64 + jj * 4 + g] = p; }
        ps += __shfl_xor(ps, 1); ps += __shfl_xor(ps, 2);
        lrun = lrun * alpha + ps; mrun = mnew;
        __syncthreads();
#pragma unroll
        for (int i = 0; i < 32; ++i) O[i] *= alpha;
        for (int j = 0; j < 64; ++j) { const float p = Ps[(map * 64 + qi) * 64 + j]; const LAS float* vr = Vs + j * KPAD + g * 32;
#pragma unroll
            for (int i = 0; i < 32; i += 4) { const f32x4 vv = *(const LAS f32x4*)(vr + i); O[i] += p * vv.x; O[i + 1] += p * vv.y; O[i + 2] += p * vv.z; O[i + 3] += p * vv.w; } }
    }
    __syncthreads();
    const float inv = 1.0f / lrun;
    LAS float* Ox = Ks;
    if (map == 1) {
#pragma unroll
        for (int i = 0; i < 32; ++i) Ox[qi * 128 + g * 32 + i] = O[i] * inv;
    }
    __syncthreads();
    if (map == 0) {
        float ss = 0.f;
#pragma unroll
        for (int i = 0; i < 32; ++i) { O[i] = O[i] * inv - lam * Ox[qi * 128 + g * 32 + i]; ss += O[i] * O[i]; }
        ss += __shfl_xor(ss, 1); ss += __shfl_xor(ss, 2);
        const float rs = rsqrtf(ss * (1.0f / 128.0f) + EPS) * 0.8f;
        bf16_t* yp = (bf16_t*)(a.ws + WS_YDA) + (trow0 + qi) * 512 + h * 128 + g * 32;
        const float* sg = a.in[I_SUBG] + g * 32;
#pragma unroll
        for (int i = 0; i < 32; i += 8) { u32x4 w; w.x = pk2(O[i] * rs * sg[i], O[i + 1] * rs * sg[i + 1]); w.y = pk2(O[i + 2] * rs * sg[i + 2], O[i + 3] * rs * sg[i + 3]);
            w.z = pk2(O[i + 4] * rs * sg[i + 4], O[i + 5] * rs * sg[i + 5]); w.w = pk2(O[i + 6] * rs * sg[i + 6], O[i + 7] * rs * sg[i + 7]); *(u32x4*)(yp + i) = w; }
    }
}
__device__ __forceinline__ void hgrn_naive_unit(const Frame& F, const Args& a, int unit) {
    const bf16_t* proj = (const bf16_t*)(a.ws + WS_PROJ);
    const float* lbv = (const float*)(a.ws + WS_SMALL) + 16;
    const int b = unit >> 2, h = unit & 3, tid = F.tid;
    LAS float* qs = (LAS float*)F.lds;
    LAS float* fs = qs + 4096;
    LAS float* ks = fs + 4096;
    LAS float* vs = ks + 4096;
    LAS float* gs = vs + 4096;
    LAS float* op = gs + 4096;
    const int v = tid & 127, kg = tid >> 7;
    float s[32];
#pragma unroll
    for (int i = 0; i < 32; ++i) s[i] = 0.f;
    for (int ch = 0; ch < SEQ / 32; ++ch) {
        const size_t t0 = (size_t)b * SEQ + ch * 32;
        __syncthreads();
        for (int i = tid; i < 32 * 16; i += NTHR) {
            const int r = i >> 4, c8 = (i & 15) * 8; const bf16_t* rp = proj + (t0 + r) * INC + h * 128 + c8;
            const u32x4 qw = *(const u32x4*)(rp + C_QHG), fw = *(const u32x4*)(rp + C_FHG), iw = *(const u32x4*)(rp + C_IHG), gw = *(const u32x4*)(rp + C_GHG);
#pragma unroll
            for (int j = 0; j < 8; ++j) {
                const unsigned sel = (j & 1) ? 16u : 0u;
                const float qv = bf2f((qw[j >> 1] >> sel) & 0xffffu), fv = bf2f((fw[j >> 1] >> sel) & 0xffffu), iv = bf2f((iw[j >> 1] >> sel) & 0xffffu), gv = bf2f((gw[j >> 1] >> sel) & 0xffffu);
                const float lb = lbv[h * 128 + c8 + j]; const float f = lb + (1.0f - lb) * sigmoidf_(fv);
                const int o = r * 128 + c8 + j;
                qs[o] = siluf_(qv); fs[o] = f; ks[o] = 1.0f - f; vs[o] = iv; gs[o] = siluf_(gv);
            }
        }
        __syncthreads();
        for (int r = 0; r < 32; ++r) {
            const float vt = vs[r * 128 + v]; float o = 0.f;
            const LAS float* fr_ = fs + r * 128 + kg * 32; const LAS float* kr_ = ks + r * 128 + kg * 32; const LAS float* qr_ = qs + r * 128 + kg * 32;
#pragma unroll
            for (int i = 0; i < 32; i += 4) { const f32x4 f4 = *(const LAS f32x4*)(fr_ + i), k4 = *(const LAS f32x4*)(kr_ + i), q4 = *(const LAS f32x4*)(qr_ + i);
                s[i] = f4.x * s[i] + k4.x * vt; o += s[i] * q4.x; s[i + 1] = f4.y * s[i + 1] + k4.y * vt; o += s[i + 1] * q4.y;
                s[i + 2] = f4.z * s[i + 2] + k4.z * vt; o += s[i + 2] * q4.z; s[i + 3] = f4.w * s[i + 3] + k4.w * vt; o += s[i + 3] * q4.w; }
            op[(kg * 32 + r) * 128 + v] = o;
        }
        __syncthreads();
        {
            const int r = tid >> 4, sub = tid & 15; float o[8]; float ss = 0.f;
#pragma unroll
            for (int j = 0; j < 8; ++j) { const int vv = sub * 8 + j; o[j] = (op[(0 * 32 + r) * 128 + vv] + op[(1 * 32 + r) * 128 + vv]) + (op[(2 * 32 + r) * 128 + vv] + op[(3 * 32 + r) * 128 + vv]); ss += o[j] * o[j]; }
            ss += __shfl_xor(ss, 1); ss += __shfl_xor(ss, 2); ss += __shfl_xor(ss, 4); ss += __shfl_xor(ss, 8);
            const float rs = rsqrtf(ss * (1.0f / 128.0f) + EPS);
            const float* ng = a.in[I_HGNG] + sub * 8;
            float y[8];
#pragma unroll
            for (int j = 0; j < 8; ++j) y[j] = o[j] * rs * ng[j] * gs[r * 128 + sub * 8 + j];
            u32x4 w; w.x = pk2(y[0], y[1]); w.y = pk2(y[2], y[3]); w.z = pk2(y[4], y[5]); w.w = pk2(y[6], y[7]);
            *(u32x4*)((bf16_t*)(a.ws + WS_YHG) + (t0 + r) * 512 + h * 128 + sub * 8) = w;
        }
    }
}

__device__ __forceinline__ void phase_router(const Frame& F, const Args& a) {
    LAS float* Wr = (LAS float*)F.lds;
    for (int i = F.tid; i < 36 * 1024; i += NTHR) { const int o = i >> 10, k = i & 1023; Wr[i] = o < 4 ? a.in[I_WRG][k * 4 + o] : a.in[I_WRE][k * 32 + (o - 4)]; }
    __syncthreads();
    const float* mod = (const float*)(a.ws + WS_MOD);
    const float* x1 = a.out; bf16_t* H2 = (bf16_t*)(a.ws + WS_ACT);
    unsigned* counts = (unsigned*)(a.ws + WS_CTL) + CW_COUNTS; unsigned* tokinfo = (unsigned*)(a.ws + WS_TOKINFO); int* toklist = (int*)(a.ws + WS_TOKLIST);
    const int rows_per_blk = T / F.G, r0 = F.bid * rows_per_blk;
    for (int r = r0 + F.wave; r < r0 + rows_per_blk; r += NWAVES) {
        const int b = r / SEQ;
        const f32x4* xr = (const f32x4*)(x1 + (size_t)r * D) + F.lane;
        f32x4 v[4]; float s = 0.f;
#pragma unroll
        for (int j = 0; j < 4; ++j) { v[j] = xr[64 * j]; s += (v[j].x * v[j].x + v[j].y * v[j].y) + (v[j].z * v[j].z + v[j].w * v[j].w); }
        const float rs = rsqrtf(wave_sum(s) * (1.0f / D) + EPS);
        unsigned long long* o8 = (unsigned long long*)(H2 + (size_t)r * D) + F.lane;
#pragma unroll
        for (int j = 0; j < 4; ++j) { const int k = 256 * j + 4 * F.lane;
            const f32x4 g = *(const f32x4*)(a.in[I_N2G] + k), sc = *(const f32x4*)(mod + b * 6144 + 4 * 1024 + k), sh = *(const f32x4*)(mod + b * 6144 + 3 * 1024 + k);
            v[j] = v[j] * rs * g * (1.0f + sc) + sh;
            o8[64 * j] = (unsigned long long)pk2(v[j].x, v[j].y) | ((unsigned long long)pk2(v[j].z, v[j].w) << 32); }
        float mylg = 0.f;
#pragma unroll 2
        for (int o = 0; o < 36; ++o) { float p = 0.f;
#pragma unroll
            for (int j = 0; j < 4; ++j) { const f32x4 w = *(const LAS f32x4*)(Wr + o * 1024 + 256 * j + 4 * F.lane); p += (v[j].x * w.x + v[j].y * w.y) + (v[j].z * w.z + v[j].w * w.w); }
            p = wave_sum(p); if (F.lane == o) mylg = p; }
        if (F.lane < 4) mylg += a.in[I_BRG][F.lane]; else if (F.lane < 36) mylg += a.in[I_BRE][F.lane - 4];
        float gl[4]; int gi = 0;
#pragma unroll
        for (int o = 0; o < 4; ++o) gl[o] = __shfl(mylg, o);
        float gm = gl[0];
#pragma unroll
        for (int o = 1; o < 4; ++o) if (gl[o] > gm) { gm = gl[o]; gi = o; }
        float gsum = 0.f;
#pragma unroll
        for (int o = 0; o < 4; ++o) gsum += expf(gl[o] - gm);
        const float gp = 1.0f / gsum;
        float el[8];
#pragma unroll
        for (int o = 0; o < 8; ++o) el[o] = __shfl(mylg, 4 + gi * 8 + o);
        int i0 = 0; float m0 = el[0];
#pragma unroll
        for (int o = 1; o < 8; ++o) if (el[o] > m0) { m0 = el[o]; i0 = o; }
        int i1 = -1; float m1 = -INFINITY;
#pragma unroll
        for (int o = 0; o < 8; ++o) if (o != i0 && el[o] > m1) { m1 = el[o]; i1 = o; }
        const float e1 = expf(m1 - m0); const float w0 = gp / (1.0f + e1), w1 = gp * e1 / (1.0f + e1);
        if (F.lane == 0) {
            const int ex0 = gi * 8 + i0, ex1 = gi * 8 + i1;
            const unsigned r0_ = atomicAdd(counts + ex0, 1u), r1_ = atomicAdd(counts + ex1, 1u);
            toklist[ex0 * T + r0_] = r; toklist[ex1 * T + r1_] = r;
            u32x4 t0; t0.x = (unsigned)ex0; t0.y = r0_; t0.z = (unsigned)ex1; t0.w = r1_;
            *(u32x4*)(tokinfo + (size_t)r * 8) = t0;
            tokinfo[(size_t)r * 8 + 4] = __float_as_uint(w0); tokinfo[(size_t)r * 8 + 5] = __float_as_uint(w1);
        }
    }
}
__device__ __forceinline__ void build_moe_tab(const Frame& F, const Args& a, LAS MoeTab* tab) {
    if (F.tid == 0) {
        const unsigned* counts = (const unsigned*)(a.ws + WS_CTL) + CW_COUNTS; int nt = 0;
        for (int e = 0; e < NEXP; ++e) { const int c = (int)__hip_atomic_load(counts + e, __ATOMIC_RELAXED, __HIP_MEMORY_SCOPE_AGENT); tab->cnt[e] = c; tab->tbase[e] = nt;
            const int n = (c + 255) >> 8; for (int m = 0; m < n; ++m) { tab->tile_e[nt] = e; tab->tile_m[nt] = m; ++nt; } }
        tab->tbase[NEXP] = nt; tab->nt = nt;
    }
    __syncthreads();
}
__device__ __forceinline__ void phase_final(const Frame& F, const Args& a, const LAS MoeTab* tab) {
    const float* mod = (const float*)(a.ws + WS_MOD); const unsigned* tokinfo = (const unsigned*)(a.ws + WS_TOKINFO); const bf16_t* Ys = (const bf16_t*)(a.ws + WS_YS);
    const int rows_per_blk = T / F.G, r0 = F.bid * rows_per_blk;
    for (int r = r0 + F.wave; r < r0 + rows_per_blk; r += NWAVES) {
        const int b = r / SEQ;
        const u32x4 ti = *(const u32x4*)(tokinfo + (size_t)r * 8);
        const float w0 = __uint_as_float(tokinfo[(size_t)r * 8 + 4]), w1 = __uint_as_float(tokinfo[(size_t)r * 8 + 5]);
        const size_t s0 = (size_t)tab->tbase[ti.x] * 256 + ti.y, s1 = (size_t)tab->tbase[ti.z] * 256 + ti.w;
        f32x4* xr = (f32x4*)(a.out + (size_t)r * D) + F.lane;
        const u32x2* y0 = (const u32x2*)(Ys + s0 * D) + F.lane; const u32x2* y1 = (const u32x2*)(Ys + s1 * D) + F.lane;
        f32x4 v[4]; float s = 0.f;
#pragma unroll
        for (int j = 0; j < 4; ++j) { const int k = 256 * j + 4 * F.lane;
            const f32x4 gt = *(const f32x4*)(mod + b * 6144 + 5 * 1024 + k); const u32x2 a0 = y0[64 * j], a1 = y1[64 * j];
            f32x4 m; m.x = w0 * bf2f(a0.x & 0xffffu) + w1 * bf2f(a1.x & 0xffffu); m.y = w0 * bf2f(a0.x >> 16) + w1 * bf2f(a1.x >> 16);
            m.z = w0 * bf2f(a0.y & 0xffffu) + w1 * bf2f(a1.y & 0xffffu); m.w = w0 * bf2f(a0.y >> 16) + w1 * bf2f(a1.y >> 16);
            v[j] = xr[64 * j] + gt * m; s += (v[j].x * v[j].x + v[j].y * v[j].y) + (v[j].z * v[j].z + v[j].w * v[j].w); }
        const float rs = rsqrtf(wave_sum(s) * (1.0f / D) + EPS);
#pragma unroll
        for (int j = 0; j < 4; ++j) { const f32x4 g = *(const f32x4*)(a.in[I_FG] + 256 * j + 4 * F.lane); xr[64 * j] = v[j] * rs * g; }
    }
}

constexpr int N_PHASES = 10;
__global__ void __launch_bounds__(NTHR, 2) mk_fwd(Args a) {
    extern __shared__ __attribute__((aligned(16))) unsigned char lds_raw[];
    Frame F; F.lds = (LAS unsigned char*)lds_raw; F.tid = threadIdx.x; F.lane = F.tid & 63; F.wave = __builtin_amdgcn_readfirstlane(F.tid >> 6); F.G = gridDim.x; F.bid = blockIdx.x;
    unsigned char* ws = a.ws;
    const int lo = a.ph_lo, hi = a.ph_hi;
#if MK_N_LAUNCHES == 1
    cg::grid_group grid = cg::this_grid();
#define SEAM(k) do { if (IN(k) && IN((k) + 1)) grid.sync(); } while (0)
#else
#define SEAM(k) do { } while (0)
#endif
#ifndef PHASE_MASK
#define PHASE_MASK 0x3ff
#endif
#define IN(k) (((PHASE_MASK >> (k)) & 1) && lo <= (k) && (k) < hi)
    LAS MoeTab* tab = (LAS MoeTab*)(F.lds + 144 * 1024);

    if (IN(0)) { phase0(F, a); } SEAM(0);
    if (IN(1)) { phase1(F, a); } SEAM(1);
    if (IN(2)) {
        DenseOrder S{(const char*)(ws + WS_ACT), (const char*)(ws + WS_WIN), D, T / 256, INC / 256, F.G, F.bid};
        EpiStoreBf16 E{(bf16_t*)(ws + WS_PROJ), INC};
        pg8::gemm_phase(F.lds, D, S, E);
    } SEAM(2);
    if (IN(3)) {
        for (int u = F.bid; u < 16; u += F.G) hgrn_naive_unit(F, a, u);
        for (int u = F.bid; u < 1024; u += F.G) attn_naive_unit(F, a, (u & ~63) | (63 - (u & 63)));
        __syncthreads();
    } SEAM(3);
    if (IN(4)) {
        UpOrder S{(const char*)(ws + WS_YDA), (const char*)(ws + WS_YHG), (const char*)(ws + WS_WUPDA), (const char*)(ws + WS_WUPHG), F.G, F.bid};
        EpiUp E{(const bf16_t*)(ws + WS_PROJ), (bf16_t*)(ws + WS_ACT)};
        pg8::gemm_phase(F.lds, 512, S, E);
    } SEAM(4);
    if (IN(5)) {
        DenseOrder S{(const char*)(ws + WS_ACT), (const char*)(ws + WS_WOUT), D, T / 256, D / 256, F.G, F.bid};
        EpiOut E{a.in[I_X], (const float*)(ws + WS_MOD), a.out};
        pg8::gemm_phase(F.lds, D, S, E);
        moe_weight_convert(F, a);
    } SEAM(5);
    if (IN(6)) { phase_router(F, a); __syncthreads(); } SEAM(6);
    if (IN(7)) {
        build_moe_tab(F, a, tab);
        Moe1Order S{tab, (const char*)(ws + WS_ACT), (const char*)(ws + WS_W13), (const int*)(ws + WS_TOKLIST), F.G, F.bid};
        EpiMoe1 E{(bf16_t*)(ws + WS_HS)};
        pg8::gemm_phase(F.lds, D, S, E);
    } SEAM(7);
    if (IN(8)) {
        build_moe_tab(F, a, tab);
        Moe2Order S{tab, (const char*)(ws + WS_HS), (const char*)(ws + WS_W2), F.G, F.bid};
        EpiStoreBf16 E{(bf16_t*)(ws + WS_YS), D};
        pg8::gemm_phase(F.lds, DEXP, S, E);
    } SEAM(8);
    if (IN(9)) { build_moe_tab(F, a, tab); phase_final(F, a, tab); }
#undef IN
#undef SEAM
}

extern "C" void kernel_launch(void* const* d_in, const int* in_sizes, int n_in, void* d_out, int out_size, void* d_ws, size_t ws_size, hipStream_t stream) {
    static int grid = 0;
    if (grid == 0) {
        if (n_in != 25 || in_sizes[0] != T * D || out_size != T * D || ws_size < WS_END) { fprintf(stderr, "kernel_launch: unexpected shapes (n_in %d, in0 %d, out %d, ws %zu)\n", n_in, n_in > 0 ? in_sizes[0] : -1, out_size, ws_size); grid = -1; return; }
        int dev = 0, cus = 0, per_cu = 0;
        if (hipGetDevice(&dev) != hipSuccess || hipDeviceGetAttribute(&cus, hipDeviceAttributeMultiprocessorCount, dev) != hipSuccess) { grid = -1; return; }
        if (hipFuncSetAttribute((const void*)mk_fwd, hipFuncAttributeMaxDynamicSharedMemorySize, LDS_BYTES) != hipSuccess) { fprintf(stderr, "kernel_launch: hipFuncSetAttribute failed\n"); grid = -1; return; }
        if (hipOccupancyMaxActiveBlocksPerMultiprocessor(&per_cu, (const void*)mk_fwd, NTHR, LDS_BYTES) != hipSuccess || per_cu < 1) { fprintf(stderr, "kernel_launch: occupancy query says %d\n", per_cu); per_cu = 1; }
        (void)hipGetLastError();
        grid = cus;
        if (grid > 256) grid = 256;
        while (T % grid) --grid;
    }
    if (grid < 0) return;
    (void)hipMemsetAsync((char*)d_ws + WS_CTL, 0, CTL_ZERO_BYTES, stream);
    Args a{};
    for (int i = 0; i < 25; ++i) a.in[i] = (const float*)d_in[i];
    a.out = (float*)d_out; a.ws = (unsigned char*)d_ws;
#if MK_N_LAUNCHES == 1
    a.ph_lo = 0; a.ph_hi = N_PHASES;
    void* args[] = {&a};
    hipError_t e = hipLaunchCooperativeKernel((const void*)mk_fwd, dim3(grid), dim3(NTHR), args, LDS_BYTES, stream);
    if (e != hipSuccess) fprintf(stderr, "cooperative launch failed: %s (grid %d)\n", hipGetErrorString(e), grid);
#else
    for (int p = 0; p < N_PHASES; ++p) {
        a.ph_lo = p; a.ph_hi = p + 1;
        hipLaunchKernelGGL(mk_fwd, dim3(grid), dim3(NTHR), LDS_BYTES, stream, a);
    }
#endif
}
```

```cpp
#include <hip/hip_runtime.h>
#include <hip/hip_cooperative_groups.h>
#include <cstdio>
#include <cstdint>
namespace cg = cooperative_groups;

#ifndef MK_N_LAUNCHES
#define MK_N_LAUNCHES 1
#endif

#define LAS __attribute__((address_space(3)))
typedef unsigned short bf16_t;
typedef short bf16x8 __attribute__((ext_vector_type(8)));
typedef float f32x4 __attribute__((ext_vector_type(4)));
typedef float f32x2 __attribute__((ext_vector_type(2)));
typedef unsigned u32x4 __attribute__((ext_vector_type(4)));
typedef unsigned u32x2 __attribute__((ext_vector_type(2)));

constexpr int NB = 4, SEQ = 4096, D = 1024, T = NB * SEQ;
constexpr int INC = 5632;
constexpr int C_QDA = 0, C_KDA = 512, C_VDA = 1024, C_QHG = 1536, C_FHG = 2048, C_IHG = 2560, C_GHG = 3072, C_GDA = 3584, C_GHGATE = 4608;
constexpr int NEXP = 32, DEXP = 512;
constexpr int PMAX = 40960;
constexpr float EPS = 1e-6f;
constexpr int NWAVES = 8, NTHR = 512;

constexpr size_t MiB = 1u << 20;
constexpr size_t WS_CTL = 0, CTL_ZERO_BYTES = 64 * 1024;
constexpr size_t WS_MODP = 1 * MiB;
constexpr size_t WS_MOD = 5 * MiB / 2;
constexpr size_t WS_SMALL = 11 * MiB / 4;
constexpr size_t WS_TOKINFO = 3 * MiB;
constexpr size_t WS_TOKLIST = 4 * MiB;
constexpr size_t WS_WIN = 8 * MiB;
constexpr size_t WS_WUPDA = 20 * MiB, WS_WUPHG = 21 * MiB, WS_WOUT = 22 * MiB;
constexpr size_t WS_ACT = 24 * MiB;
constexpr size_t WS_PROJ = 56 * MiB;
constexpr size_t WS_YDA = 232 * MiB, WS_YHG = 248 * MiB;
constexpr size_t WS_OA = 264 * MiB;
constexpr size_t WS_W13 = 56 * MiB;
constexpr size_t WS_W2 = 120 * MiB;
constexpr size_t WS_HS = 152 * MiB;
constexpr size_t WS_YS = 192 * MiB;
constexpr size_t WS_END = 296 * MiB;
constexpr int CW_COUNTS = 64;

constexpr int LDS_BYTES = 160 * 1024;

__device__ __forceinline__ float bf2f(unsigned v) { return __uint_as_float(v << 16); }
__device__ __forceinline__ unsigned f2bf(float f) { unsigned u = __float_as_uint(f); return (u + 0x7fffu + ((u >> 16) & 1u)) >> 16; }
__device__ __forceinline__ unsigned pk2(float lo, float hi) { return f2bf(lo) | (f2bf(hi) << 16); }
__device__ __forceinline__ float sigmoidf_(float x) { return 1.0f / (1.0f + __expf(-x)); }
__device__ __forceinline__ float siluf_(float x) { return x / (1.0f + __expf(-x)); }
__device__ __forceinline__ float wave_sum(float v) {
#pragma unroll
    for (int o = 1; o < 64; o <<= 1) v += __shfl_xor(v, o);
    return v;
}

namespace pg8 {
constexpr int BM = 256, BK = 64, HALF = 128, HTB = HALF * BK * 2, STAGE_BYTES = 8 * HTB;
__host__ __device__ __forceinline__ int lds_byte(int r, int c) { const int st = (r >> 4) * 2 + (c >> 5), rr = r & 15, cc = c & 31, ob = rr * 64 + cc * 2; return st * 1024 + (ob ^ (((ob >> 9) & 1) << 5)); }
__host__ __device__ __forceinline__ void stage_rc(int b, int& R, int& C) { const int st = b / 1024, sb = b % 1024, swz = sb ^ (((sb >> 9) & 1) << 5); R = (st >> 1) * 16 + swz / 64; C = (st & 1) * 32 + (swz % 64) / 2; }
__host__ __device__ __forceinline__ int perm32(int rho) { const int n = rho >> 4, i = rho & 15; return 8 * (i >> 2) + 4 * n + (i & 3); }

struct Unit { int pm, pn; const char* A; const char* B; int aux; };
__device__ __forceinline__ unsigned cvt_pk_bf16(float lo, float hi) { unsigned r; asm volatile("v_cvt_pk_bf16_f32 %0, %1, %2" : "=v"(r) : "v"(lo), "v"(hi)); return r; }

template <class Epi, class Sched>
__device__ __forceinline__ void gemm_phase(LAS unsigned char* lds, const int K, const Sched& S, const Epi& E) {
    const int tid = threadIdx.x, wid = __builtin_amdgcn_readfirstlane(tid >> 6), lane = tid & 63, wr = wid >> 2, wc = wid & 3, fr = lane & 15, fq = lane >> 4;
    const int nt = K / BK;
    int RA[2], CA[2]; unsigned voffB[2];
#pragma unroll
    for (int i = 0; i < 2; ++i) { int R, C; stage_rc(tid * 16 + i * 8192, R, C); const int Rb = Epi::PERM ? ((R & ~31) + perm32(R & 31)) : R;
        RA[i] = R; CA[i] = C; voffB[i] = (unsigned)(Rb * K + C) * 2u; }
    const size_t kstep = (size_t)(BK * 2);
    const size_t hstep = (size_t)HALF * K * 2;
    const unsigned ldsw = (unsigned)wid * 1024u;
    const int aoff = lds_byte(wr * 64 + fr, fq * 8), boff = lds_byte(wc * 32 + fr, fq * 8);
#define PG8_SA(b, h) (((b) * 2 + (h)) * HTB)
#define PG8_SB(b, h) ((4 + (b) * 2 + (h)) * HTB)
#define PG8_STAGE(bufoff, gbase, voff) do { _Pragma("unroll") for (int _i = 0; _i < 2; ++_i) \
        __builtin_amdgcn_global_load_lds((const unsigned*)((const char*)(gbase) + (voff)[_i]), (LAS unsigned*)(lds + (bufoff) + ldsw + _i * 8192), 16, 0, 0); } while (0)
#define PG8_LDA(dst, b, h) do { _Pragma("unroll") for (int m = 0; m < 4; ++m) _Pragma("unroll") for (int k = 0; k < 2; ++k) dst[m][k] = *(const LAS bf16x8*)(lds + PG8_SA(b, h) + aoff + m * 2048 + k * 1024); } while (0)
#define PG8_LDB(dst, b, h) do { _Pragma("unroll") for (int n = 0; n < 2; ++n) _Pragma("unroll") for (int k = 0; k < 2; ++k) dst[n][k] = *(const LAS bf16x8*)(lds + PG8_SB(b, h) + boff + n * 2048 + k * 1024); } while (0)
#define PG8_MMA(ai, bj, At, Bt) do { __builtin_amdgcn_s_setprio(1); _Pragma("unroll") for (int m = 0; m < 4; ++m) _Pragma("unroll") for (int n = 0; n < 2; ++n) _Pragma("unroll") for (int k = 0; k < 2; ++k) \
        acc[ai][bj][m][n] = __builtin_amdgcn_mfma_f32_16x16x32_bf16(Bt[n][k], At[m][k], acc[ai][bj][m][n], 0, 0, 0); __builtin_amdgcn_s_setprio(0); } while (0)
#define PG8_WAIT_V(n) asm volatile("s_waitcnt vmcnt(" #n ")" ::: "memory")
#define PG8_WAIT_L(n) asm volatile("s_waitcnt lgkmcnt(" #n ")" ::: "memory")
#define PG8_BAR __builtin_amdgcn_s_barrier()
#define PG8_SCHED __builtin_amdgcn_sched_barrier(0)
#define PG8_SETA(vo, u) do { _Pragma("unroll") for (int _h = 0; _h < 2; ++_h) _Pragma("unroll") for (int _i = 0; _i < 2; ++_i) \
        vo[_h][_i] = (unsigned)((size_t)S.arow(u, _h * HALF + RA[_i]) * (size_t)K + CA[_i]) * 2u; if (Sched::GATHER) PG8_WAIT_V(0); } while (0)
    Unit cur, nxt; int ui = 0;
    if (!S.next(0, cur)) return;
    f32x4 acc[2][2][4][2];
#pragma unroll
    for (int a = 0; a < 2; ++a)
#pragma unroll
        for (int b = 0; b < 2; ++b)
#pragma unroll
            for (int m = 0; m < 4; ++m)
#pragma unroll
                for (int n = 0; n < 2; ++n) acc[a][b][m][n] = (f32x4){0.f, 0.f, 0.f, 0.f};
    bf16x8 At[4][2], B0[2][2], B1[2][2];
    unsigned voC[2][2], voN[2][2];
    PG8_SETA(voC, cur);
    const char* cA = cur.A; const char* cB = cur.B;
    PG8_STAGE(PG8_SB(0, 0), cB, voffB); PG8_STAGE(PG8_SB(0, 1), cB + hstep, voffB); PG8_STAGE(PG8_SA(0, 0), cA, voC[0]); PG8_STAGE(PG8_SA(0, 1), cA, voC[1]);
    if (wr == 1) PG8_BAR;
    PG8_WAIT_V(2); PG8_BAR;
    PG8_STAGE(PG8_SB(1, 0), cB + kstep, voffB); PG8_STAGE(PG8_SA(1, 0), cA + kstep, voC[0]); PG8_STAGE(PG8_SB(1, 1), cB + hstep + kstep, voffB);
    PG8_WAIT_V(6); PG8_BAR;
    for (;;) {
        const bool has_next = S.next(ui + 1, nxt);
        if (has_next) { PG8_SETA(voN, nxt); }
        else {
#pragma unroll
            for (int h = 0; h < 2; ++h)
#pragma unroll
                for (int i = 0; i < 2; ++i) voN[h][i] = voC[h][i];
        }
        const char* nA = has_next ? nxt.A : cA; const char* nB = has_next ? nxt.B : cB;
        for (int t = 0; t < nt; t += 2) {
            const bool last = (t == nt - 2);
            const char* a1 = cA + (size_t)(t + 1) * kstep;
            const char* a2 = last ? nA : cA + (size_t)(t + 2) * kstep; const char* b2 = last ? nB : cB + (size_t)(t + 2) * kstep;
            const char* a3 = a2 + kstep; const char* b3 = b2 + kstep;
            unsigned vo2[2][2];
#pragma unroll
            for (int h = 0; h < 2; ++h)
#pragma unroll
                for (int i = 0; i < 2; ++i) vo2[h][i] = last ? voN[h][i] : voC[h][i];
            PG8_LDB(B0, 0, 0); PG8_LDB(B1, 0, 1); PG8_SCHED; PG8_LDA(At, 0, 0); PG8_STAGE(PG8_SA(1, 1), a1, voC[1]);
            PG8_WAIT_V(8); PG8_WAIT_L(0); PG8_BAR; PG8_MMA(0, 0, At, B0); PG8_MMA(0, 1, At, B1); PG8_BAR; PG8_SCHED;
            PG8_LDA(At, 0, 1); PG8_STAGE(PG8_SB(0, 0), b2, voffB); PG8_STAGE(PG8_SB(0, 1), b2 + hstep, voffB); PG8_STAGE(PG8_SA(0, 0), a2, vo2[0]);
            PG8_WAIT_V(8); PG8_WAIT_L(0); PG8_BAR; PG8_MMA(1, 0, At, B0); PG8_MMA(1, 1, At, B1); PG8_BAR; PG8_SCHED;
            PG8_LDB(B0, 1, 0); PG8_LDB(B1, 1, 1); PG8_SCHED; PG8_LDA(At, 1, 0); PG8_STAGE(PG8_SA(0, 1), a2, vo2[1]);
            PG8_WAIT_V(8); PG8_WAIT_L(0); PG8_BAR; PG8_MMA(0, 0, At, B0); PG8_MMA(0, 1, At, B1); PG8_BAR; PG8_SCHED;
            PG8_LDA(At, 1, 1); PG8_STAGE(PG8_SB(1, 0), b3, voffB); PG8_STAGE(PG8_SB(1, 1), b3 + hstep, voffB); PG8_STAGE(PG8_SA(1, 0), a3, vo2[0]);
            PG8_WAIT_V(8); PG8_WAIT_L(0); PG8_BAR; PG8_MMA(1, 0, At, B0); PG8_MMA(1, 1, At, B1); PG8_BAR; PG8_SCHED;
        }
        if (wr == 0) PG8_BAR;
        const bool keep = E(acc, cur, wr, wc, fr, fq);
        if (!has_next) break;
        if (!keep) {
#pragma unroll
            for (int a = 0; a < 2; ++a)
#pragma unroll
                for (int b = 0; b < 2; ++b)
#pragma unroll
                    for (int m = 0; m < 4; ++m)
#pragma unroll
                        for (int n = 0; n < 2; ++n) acc[a][b][m][n] = (f32x4){0.f, 0.f, 0.f, 0.f};
        }
        cur = nxt; cA = nA; cB = nB; ++ui;
#pragma unroll
        for (int h = 0; h < 2; ++h)
#pragma unroll
            for (int i = 0; i < 2; ++i) voC[h][i] = voN[h][i];
        if (wr == 1) PG8_BAR;
    }
    PG8_WAIT_V(0);
    PG8_BAR;
#undef PG8_SA
#undef PG8_SB
#undef PG8_STAGE
#undef PG8_LDA
#undef PG8_LDB
#undef PG8_MMA
#undef PG8_WAIT_V
#undef PG8_WAIT_L
#undef PG8_BAR
#undef PG8_SCHED
#undef PG8_SETA
}
}

struct Args { const float* in[25]; float* out; unsigned char* ws; int ph_lo, ph_hi; };
enum { I_X = 0, I_C, I_WADA, I_BADA, I_N1G, I_WIN, I_LQ1, I_LK1, I_LQ2, I_LK2, I_SUBG, I_LBL, I_HGNG, I_WUPDA, I_WUPHG, I_WOUT, I_N2G, I_WRG, I_BRG, I_WRE, I_BRE, I_W1, I_W3, I_W2, I_FG };

struct DenseOrder {
    static constexpr bool GATHER = false;
    const char* A; const char* Bt; int K, nM, nN, G, c;
    __device__ __forceinline__ bool next(int i, pg8::Unit& u) const {
        const int L = i * G + c, nwg = nM * nN; if (L >= nwg) return false;
        int wgid = L; { const int q = nwg / 8, r = nwg % 8, xcd = wgid % 8, off = wgid / 8; wgid = (xcd < r ? xcd * (q + 1) : r * (q + 1) + (xcd - r) * q) + off; }
        const int nig = 8 * nN, gid = wgid / nig, fm = gid * 8, gsz = (nM - fm) < 8 ? (nM - fm) : 8;
        u.pm = fm + ((wgid % nig) % gsz); u.pn = (wgid % nig) / gsz; u.A = A; u.B = Bt + (size_t)u.pn * 256 * K * 2; u.aux = 0; return true;
    }
    __device__ __forceinline__ unsigned arow(const pg8::Unit& u, int r) const { return (unsigned)(u.pm * 256 + r); }
};
struct UpOrder {
    static constexpr bool GATHER = false;
    const char* A0; const char* A1; const char* B0; const char* B1; int G, c;
    __device__ __forceinline__ bool next(int i, pg8::Unit& u) const {
        const int tile = (i >> 1) * G + c; if (tile >= 256) return false;
        u.pm = tile >> 2; u.pn = tile & 3; u.aux = i & 1;
        u.A = (i & 1) ? A1 : A0; u.B = ((i & 1) ? B1 : B0) + (size_t)u.pn * 256 * 512 * 2; return true;
    }
    __device__ __forceinline__ unsigned arow(const pg8::Unit& u, int r) const { return (unsigned)(u.pm * 256 + r); }
};
struct MoeTab { int nt; int pad[3]; int tile_e[176]; int tile_m[176]; int cnt[32]; int tbase[33]; };
struct Moe1Order {
    static constexpr bool GATHER = true;
    const LAS MoeTab* tab; const char* A; const char* W; const int* toklist; int G, c;
    __device__ __forceinline__ bool next(int i, pg8::Unit& u) const {
        const int L = i * G + c; if (L >= tab->nt * 4) return false;
        const int ti = L >> 2; u.pm = ti; u.pn = L & 3; u.aux = ti; u.A = A;
        u.B = W + ((size_t)tab->tile_e[ti] * 1024 + (size_t)u.pn * 256) * 1024 * 2; return true;
    }
    __device__ __forceinline__ unsigned arow(const pg8::Unit& u, int r) const {
        const int e = tab->tile_e[u.aux], rr = tab->tile_m[u.aux] * 256 + r;
        return rr < tab->cnt[e] ? (unsigned)toklist[e * T + rr] : 0u;
    }
};
struct Moe2Order {
    static constexpr bool GATHER = false;
    const LAS MoeTab* tab; const char* A; const char* W; int G, c;
    __device__ __forceinline__ bool next(int i, pg8::Unit& u) const {
        const int L = i * G + c; if (L >= tab->nt * 4) return false;
        const int ti = L >> 2; u.pm = ti; u.pn = L & 3; u.aux = ti; u.A = A;
        u.B = W + ((size_t)tab->tile_e[ti] * 1024 + (size_t)u.pn * 256) * 512 * 2; return true;
    }
    __device__ __forceinline__ unsigned arow(const pg8::Unit& u, int r) const { return (unsigned)(u.pm * 256 + r); }
};

using pg8::Unit; using pg8::cvt_pk_bf16;
struct EpiStoreBf16 {
    static constexpr bool PERM = true;
    bf16_t* O; int ldc; int nscale; float scale0;
    __device__ __forceinline__ bool operator()(f32x4 (&acc)[2][2][4][2], const Unit& u, int wr, int wc, int fr, int fq) const {
        const int row0 = u.pm * 256 + wr * 64 + fr, col0 = u.pn * 256 + wc * 32 + 8 * fq;
        const float sc = u.pn < nscale ? scale0 : 1.0f;
#pragma unroll
        for (int ai = 0; ai < 2; ++ai)
#pragma unroll
            for (int m = 0; m < 4; ++m) { bf16_t* rowp = O + (size_t)(row0 + ai * 128 + m * 16) * ldc + col0;
#pragma unroll
                for (int bj = 0; bj < 2; ++bj) { const f32x4 v0 = acc[ai][bj][m][0] * sc, v1 = acc[ai][bj][m][1] * sc;
                    u32x4 w; w.x = cvt_pk_bf16(v0[0], v0[1]); w.y = cvt_pk_bf16(v0[2], v0[3]); w.z = cvt_pk_bf16(v1[0], v1[1]); w.w = cvt_pk_bf16(v1[2], v1[3]);
                    *(u32x4*)(rowp + bj * 128) = w; } }
        return false;
    }
};
struct EpiUp {
    static constexpr bool PERM = true;
    const bf16_t* proj; bf16_t* O;
    __device__ __forceinline__ bool operator()(f32x4 (&acc)[2][2][4][2], const Unit& u, int wr, int wc, int fr, int fq) const {
        const int row0 = u.pm * 256 + wr * 64 + fr, col0 = u.pn * 256 + wc * 32 + 8 * fq;
#pragma unroll
        for (int ai = 0; ai < 2; ++ai)
#pragma unroll
            for (int m = 0; m < 4; ++m) { const size_t row = (size_t)(row0 + ai * 128 + m * 16);
#pragma unroll
                for (int bj = 0; bj < 2; ++bj) {
                    const int col = col0 + bj * 128;
                    const u32x4 gh = *(const u32x4*)(proj + row * INC + C_GHGATE + col);
                    float sh[8];
#pragma unroll
                    for (int j = 0; j < 4; ++j) { sh[2 * j] = 1.0f + __expf(-bf2f(gh[j] & 0xffffu)); sh[2 * j + 1] = 1.0f + __expf(-bf2f(gh[j] >> 16)); }
                    if (u.aux == 0) {
                        const u32x4 gd = *(const u32x4*)(proj + row * INC + C_GDA + col);
#pragma unroll
                        for (int j = 0; j < 4; ++j) {
                            const float d0 = 1.0f + __expf(-bf2f(gd[j] & 0xffffu)), d1 = 1.0f + __expf(-bf2f(gd[j] >> 16));
                            const float r0 = sh[2 * j] / d0, r1 = sh[2 * j + 1] / d1;
                            if (j < 2) { acc[ai][bj][m][0][2 * j] *= r0; acc[ai][bj][m][0][2 * j + 1] *= r1; }
                            else { acc[ai][bj][m][1][2 * j - 4] *= r0; acc[ai][bj][m][1][2 * j - 3] *= r1; }
                        }
                    } else {
                        const f32x4 v0 = acc[ai][bj][m][0], v1 = acc[ai][bj][m][1];
                        u32x4 w; w.x = cvt_pk_bf16(v0[0] / sh[0], v0[1] / sh[1]); w.y = cvt_pk_bf16(v0[2] / sh[2], v0[3] / sh[3]);
                        w.z = cvt_pk_bf16(v1[0] / sh[4], v1[1] / sh[5]); w.w = cvt_pk_bf16(v1[2] / sh[6], v1[3] / sh[7]);
                        *(u32x4*)(O + row * D + col) = w;
                    }
                } }
        return u.aux == 0;
    }
};
struct EpiOut {
    static constexpr bool PERM = false;
    const float* x; const float* mod; float* O;
    __device__ __forceinline__ bool operator()(f32x4 (&acc)[2][2][4][2], const Unit& u, int wr, int wc, int fr, int fq) const {
        const int row0 = u.pm * 256 + wr * 64 + fr, col0 = u.pn * 256 + wc * 32 + 4 * fq;
        const int b = (u.pm * 256) / SEQ;
        f32x4 gt[2][2];
#pragma unroll
        for (int bj = 0; bj < 2; ++bj)
#pragma unroll
            for (int n = 0; n < 2; ++n) gt[bj][n] = *(const f32x4*)(mod + b * 6144 + 2048 + col0 + bj * 128 + n * 16);
#pragma unroll
        for (int ai = 0; ai < 2; ++ai)
#pragma unroll
            for (int m = 0; m < 4; ++m) { const size_t off = (size_t)(row0 + ai * 128 + m * 16) * D + col0;
#pragma unroll
                for (int bj = 0; bj < 2; ++bj)
#pragma unroll
                    for (int n = 0; n < 2; ++n) { const f32x4 xv = *(const f32x4*)(x + off + bj * 128 + n * 16);
                        *(f32x4*)(O + off + bj * 128 + n * 16) = xv + gt[bj][n] * acc[ai][bj][m][n]; } }
        return false;
    }
};
struct EpiMoe1 {
    static constexpr bool PERM = true;
    bf16_t* O;
    __device__ __forceinline__ bool operator()(f32x4 (&acc)[2][2][4][2], const Unit& u, int wr, int wc, int fr, int fq) const {
        const int row0 = u.pm * 256 + wr * 64 + fr, col0 = u.pn * 128 + wc * 32 + 8 * fq;
#pragma unroll
        for (int ai = 0; ai < 2; ++ai)
#pragma unroll
            for (int m = 0; m < 4; ++m) { bf16_t* rowp = O + (size_t)(row0 + ai * 128 + m * 16) * DEXP + col0;
                float h[8];
#pragma unroll
                for (int n = 0; n < 2; ++n)
#pragma unroll
                    for (int e = 0; e < 4; ++e) h[n * 4 + e] = siluf_(acc[ai][0][m][n][e]) * acc[ai][1][m][n][e];
                u32x4 w; w.x = cvt_pk_bf16(h[0], h[1]); w.y = cvt_pk_bf16(h[2], h[3]); w.z = cvt_pk_bf16(h[4], h[5]); w.w = cvt_pk_bf16(h[6], h[7]);
                *(u32x4*)rowp = w; }
        return false;
    }
};

struct Frame { LAS unsigned char* lds; int tid, lane, wave, G, bid; };

__device__ __forceinline__ void transpose_item(const float* Wsrc, int ldw, bf16_t* dst, int ldd, LAS float* scr, int lane) {
#pragma unroll 8
    for (int i = 0; i < 32; ++i) { const int kk = 2 * i + (lane >> 5); scr[kk * 33 + (lane & 31)] = Wsrc[(size_t)kk * ldw + (lane & 31)]; }
    asm volatile("s_waitcnt lgkmcnt(0)" ::: "memory");
    const int c = lane & 7;
#pragma unroll
    for (int j = 0; j < 4; ++j) { const int n = (lane >> 3) + 8 * j; const LAS float* s = scr + (8 * c) * 33 + n;
        u32x4 o; o.x = pk2(s[0 * 33], s[1 * 33]); o.y = pk2(s[2 * 33], s[3 * 33]); o.z = pk2(s[4 * 33], s[5 * 33]); o.w = pk2(s[6 * 33], s[7 * 33]);
        *(u32x4*)(dst + (size_t)n * ldd + 8 * c) = o; }
    asm volatile("s_waitcnt lgkmcnt(0)" ::: "memory");
}
__device__ __forceinline__ void transpose_matrix(const Frame& F, const float* W, int K, int N, bf16_t* WT) {
    LAS float* scr = (LAS float*)(F.lds + F.wave * 8448);
    const int gw = F.bid * NWAVES + F.wave, NGW = F.G * NWAVES, nblk = N / 32, items = (K / 64) * nblk;
    for (int it = gw; it < items; it += NGW) { const int kb = it / nblk, nb = it % nblk;
        transpose_item(W + (size_t)(64 * kb) * N + 32 * nb, N, WT + (size_t)(32 * nb) * K + 64 * kb, K, scr, F.lane); }
}

__device__ __forceinline__ void phase0(const Frame& F, const Args& a) {
    unsigned char* ws = a.ws;
    {
        float* modp = (float*)(ws + WS_MODP);
        const float* c = a.in[I_C]; const float* wada = a.in[I_WADA];
        for (int wt = F.bid + 256 * F.wave; wt < 384; wt += 256 * NWAVES) {
            if (F.G != 256) break;
            const int ks = wt / 24, jw = wt % 24, j = jw * 256 + F.lane * 4;
            f32x4 s[4] = {{0, 0, 0, 0}, {0, 0, 0, 0}, {0, 0, 0, 0}, {0, 0, 0, 0}};
            for (int k = ks * 64; k < ks * 64 + 64; ++k) {
                const f32x4 w = *(const f32x4*)(wada + (size_t)k * 6144 + j);
#pragma unroll
                for (int b = 0; b < 4; ++b) { const float cv = siluf_(c[b * D + k]); s[b] += w * cv; }
            }
#pragma unroll
            for (int b = 0; b < 4; ++b) *(f32x4*)(modp + ((size_t)ks * 4 + b) * 6144 + j) = s[b];
        }
        if (F.G != 256) {
            const int gw = F.bid * NWAVES + F.wave, NGW = F.G * NWAVES;
            for (int wt = gw; wt < 384; wt += NGW) {
                const int ks = wt / 24, jw = wt % 24, j = jw * 256 + F.lane * 4;
                f32x4 s[4] = {{0, 0, 0, 0}, {0, 0, 0, 0}, {0, 0, 0, 0}, {0, 0, 0, 0}};
                for (int k = ks * 64; k < ks * 64 + 64; ++k) {
                    const f32x4 w = *(const f32x4*)(wada + (size_t)k * 6144 + j);
#pragma unroll
                    for (int b = 0; b < 4; ++b) { const float cv = siluf_(c[b * D + k]); s[b] += w * cv; }
                }
#pragma unroll
                for (int b = 0; b < 4; ++b) *(f32x4*)(modp + ((size_t)ks * 4 + b) * 6144 + j) = s[b];
            }
        }
    }
    transpose_matrix(F, a.in[I_WIN], D, INC, (bf16_t*)(ws + WS_WIN));
    transpose_matrix(F, a.in[I_WUPDA], 512, D, (bf16_t*)(ws + WS_WUPDA));
    transpose_matrix(F, a.in[I_WUPHG], 512, D, (bf16_t*)(ws + WS_WUPHG));
    transpose_matrix(F, a.in[I_WOUT], D, D, (bf16_t*)(ws + WS_WOUT));
    if (F.bid == 0) {
        float* sm = (float*)(ws + WS_SMALL);
        if (F.tid == 0) {
            float s1 = 0.f, s2 = 0.f;
            for (int i = 0; i < 64; ++i) { s1 += a.in[I_LQ1][i] * a.in[I_LK1][i]; s2 += a.in[I_LQ2][i] * a.in[I_LK2][i]; }
            sm[0] = expf(s1) - expf(s2) + 0.2f;
        }
        { const float l0 = a.in[I_LBL][F.tid], l1 = a.in[I_LBL][512 + F.tid]; const float mx = fmaxf(l0, l1);
          const float e0 = expf(l0 - mx), e1 = expf(l1 - mx); sm[16 + F.tid] = e0 / (e0 + e1); }
    }
}
__device__ __forceinline__ void moe_weight_convert(const Frame& F, const Args& a) {
    LAS float* scr = (LAS float*)(F.lds + F.wave * 8448);
    const int gw = F.bid * NWAVES + F.wave, NGW = F.G * NWAVES;
    bf16_t* w13 = (bf16_t*)(a.ws + WS_W13); bf16_t* w2t = (bf16_t*)(a.ws + WS_W2);
    for (int it = gw; it < 2 * NEXP * 256; it += NGW) {
        const int which = it / (NEXP * 256), r = it % (NEXP * 256), e = r >> 8, kb = (r >> 4) & 15, nb = r & 15, n0 = 32 * nb;
        const float* W = a.in[which ? I_W3 : I_W1] + (size_t)e * 1024 * 512;
        const int drow = 256 * (n0 >> 7) + (which ? 128 : 0) + (n0 & 127);
        transpose_item(W + (size_t)(64 * kb) * 512 + n0, 512, w13 + ((size_t)e * 1024 + drow) * 1024 + 64 * kb, 1024, scr, F.lane);
    }
    for (int it = gw; it < NEXP * 256; it += NGW) {
        const int e = it >> 8, kb = (it >> 5) & 7, nb = it & 31;
        const float* W = a.in[I_W2] + (size_t)e * 512 * 1024;
        transpose_item(W + (size_t)(64 * kb) * 1024 + 32 * nb, 1024, w2t + ((size_t)e * 1024 + 32 * nb) * 512 + 64 * kb, 512, scr, F.lane);
    }
}

__device__ __forceinline__ void phase1(const Frame& F, const Args& a) {
    const float* modp = (const float*)(a.ws + WS_MODP); float* mod = (float*)(a.ws + WS_MOD);
    for (int i = F.bid * NTHR + F.tid; i < 4 * 6144; i += F.G * NTHR) {
        float s = a.in[I_BADA][i % 6144];
        for (int ks = 0; ks < 16; ++ks) s += modp[(size_t)ks * 4 * 6144 + i];
        mod[i] = s;
    }
    LAS float* Gs = (LAS float*)F.lds;
    LAS float* Ss = Gs + 1024;
    bf16_t* H = (bf16_t*)(a.ws + WS_ACT);
    const int rows_per_blk = T / F.G;
    const int r0 = F.bid * rows_per_blk, b = r0 / SEQ;
    for (int k = F.tid; k < 1024; k += NTHR) {
        float sh = a.in[I_BADA][k], sc = a.in[I_BADA][1024 + k];
        for (int ks = 0; ks < 16; ++ks) { sh += modp[((size_t)ks * 4 + b) * 6144 + k]; sc += modp[((size_t)ks * 4 + b) * 6144 + 1024 + k]; }
        Gs[k] = a.in[I_N1G][k] * (1.0f + sc); Ss[k] = sh;
    }
    __syncthreads();
    for (int r = r0 + F.wave; r < r0 + rows_per_blk; r += NWAVES) {
        const f32x4* xr = (const f32x4*)(a.in[I_X] + (size_t)r * D) + F.lane;
        f32x4 v[4]; float s = 0.f;
#pragma unroll
        for (int j = 0; j < 4; ++j) { v[j] = xr[64 * j]; s += (v[j].x * v[j].x + v[j].y * v[j].y) + (v[j].z * v[j].z + v[j].w * v[j].w); }
        const float rs = rsqrtf(wave_sum(s) * (1.0f / D) + EPS);
        unsigned long long* o8 = (unsigned long long*)(H + (size_t)r * D) + F.lane;
#pragma unroll
        for (int j = 0; j < 4; ++j) { const f32x4 g = *(const LAS f32x4*)(Gs + 256 * j + 4 * F.lane), sh = *(const LAS f32x4*)(Ss + 256 * j + 4 * F.lane);
            const f32x4 h = v[j] * rs * g + sh;
            o8[64 * j] = (unsigned long long)pk2(h.x, h.y) | ((unsigned long long)pk2(h.z, h.w) << 32); }
    }
}

namespace attn_body {
using s16x4=__attribute__((ext_vector_type(4)))short;
using f32x16=__attribute__((ext_vector_type(16)))float;
constexpr int NW=8,QBLK=32,QB=QBLK*NW,KVBLK=64,NQB=SEQ/QB;
constexpr int PIN=INC, POUT=1024;
__device__ __forceinline__ int crow(int r,int hi){return (r&3)+8*(r>>2)+4*hi;}
#define SBAR() __builtin_amdgcn_sched_barrier(0)
__device__ __forceinline__ void bmask(f32x16&p0,f32x16&p1,int jb,int wch,int il,int hi,float s2x2){
  if(jb>wch){
    #pragma unroll
    for(int r=0;r<16;++r){p0[r]=-INFINITY;p1[r]=-INFINITY;}
  } else if(jb==wch){
    float fb=(float)(4*hi-il); asm volatile("":"+v"(fb));
    #pragma unroll
    for(int r=0;r<16;++r){const float c=(float)((r&3)+8*(r>>2)); p0[r]-=s2x2*__builtin_fmaxf(fb+c,0.f); p1[r]-=s2x2*__builtin_fmaxf(fb+(c+32.f),0.f);}
  }
}
constexpr int NSLOT=3, SLOTB=8192;
constexpr int LDS_K=0, LDS_V=NSLOT*SLOTB, LDS_WS=2*NSLOT*SLOTB, LDS_OST=LDS_WS+NW*64*4, ATT_LDS_BYTES=LDS_OST+NW*4096;
constexpr float C2=0.125f*1.4426950408889634f;
__device__ __forceinline__ void glds16(const void*gsrc,unsigned lds_dst){unsigned keep;
  asm volatile("s_mov_b32 %0, m0\n\ts_mov_b32 m0, %2\n\ts_nop 0\n\tglobal_load_lds_dwordx4 %1, off\n\ts_mov_b32 m0, %0":"=&s"(keep):"v"(gsrc),"s"(lds_dst):"memory");}
__device__ __forceinline__ float max3f(float a,float b,float c){float r;asm("v_max3_f32 %0, %1, %2, %3":"=v"(r):"v"(a),"v"(b),"v"(c));return r;}
__device__ __forceinline__ float max2f(float a,float b){float r;asm("v_max_f32_e32 %0, %1, %2":"=v"(r):"v"(a),"v"(b));return r;}
__device__ __forceinline__ float fadd_s(float a,float b){float r;asm("v_add_f32_e32 %0, %1, %2":"=v"(r):"v"(a),"v"(b));return r;}
__device__ __forceinline__ float fsub_s(float a,float b){float r;asm("v_sub_f32_e32 %0, %1, %2":"=v"(r):"v"(a),"v"(b));return r;}
typedef float f32x2_t __attribute__((ext_vector_type(2))); typedef __bf16 bf16x2_t __attribute__((ext_vector_type(2)));
__device__ __forceinline__ unsigned cvtpk_s(float lo,float hi){f32x2_t v={lo,hi};bf16x2_t b=__builtin_convertvector(v,bf16x2_t);return __builtin_bit_cast(unsigned,b);}
#define WAIT_BAR(N) asm volatile("s_waitcnt vmcnt(" #N ") lgkmcnt(0)\n\ts_barrier":::"memory")

__device__ __forceinline__ void qkt(f32x16&p0,f32x16&p1,const char*Kslot,const bf16x8*qr,const f32x16&c0,const f32x16&c1,int r32,int hi){
  const char*kb=Kslot+hi*1024+r32*16;
  #pragma unroll
  for(int d0=0;d0<4;++d0){
    const bf16x8 b0=*reinterpret_cast<const bf16x8*>(kb+d0*2048);
    const bf16x8 b1=*reinterpret_cast<const bf16x8*>(kb+d0*2048+512);
    if(d0==0){p0=__builtin_amdgcn_mfma_f32_32x32x16_bf16(b0,qr[0],c0,0,0,0);p1=__builtin_amdgcn_mfma_f32_32x32x16_bf16(b1,qr[0],c1,0,0,0);}
    else{p0=__builtin_amdgcn_mfma_f32_32x32x16_bf16(b0,qr[d0],p0,0,0,0);p1=__builtin_amdgcn_mfma_f32_32x32x16_bf16(b1,qr[d0],p1,0,0,0);}}
}
typedef __attribute__((address_space(3))) const char* lds_cptr;
typedef short v4i16_t __attribute__((ext_vector_type(4)));
__device__ __forceinline__ void kload8(bf16x8*kf,lds_cptr kp){
  kf[0]=*(const __attribute__((address_space(3))) bf16x8*)(kp);      kf[1]=*(const __attribute__((address_space(3))) bf16x8*)(kp+512);
  kf[2]=*(const __attribute__((address_space(3))) bf16x8*)(kp+2048); kf[3]=*(const __attribute__((address_space(3))) bf16x8*)(kp+2560);
  kf[4]=*(const __attribute__((address_space(3))) bf16x8*)(kp+4096); kf[5]=*(const __attribute__((address_space(3))) bf16x8*)(kp+4608);
  kf[6]=*(const __attribute__((address_space(3))) bf16x8*)(kp+6144); kf[7]=*(const __attribute__((address_space(3))) bf16x8*)(kp+6656);
}
__device__ __forceinline__ void kload2(bf16x8*kf,lds_cptr kp,int j){ kf[2*j]=*(const __attribute__((address_space(3))) bf16x8*)(kp+j*2048); kf[2*j+1]=*(const __attribute__((address_space(3))) bf16x8*)(kp+j*2048+512); }
__device__ __forceinline__ s16x4 vtr(lds_cptr p){ return __builtin_bit_cast(s16x4,__builtin_amdgcn_ds_read_tr16_b64_v4i16((__attribute__((address_space(3))) v4i16_t*)p)); }
__device__ __forceinline__ float rowmax(const f32x16&p0,const f32x16&p1){
  float a=max3f(p0[0],p0[1],p1[0]),b=max3f(p0[2],p0[3],p1[1]);a=max3f(a,p1[2],p1[3]);
  #pragma unroll
  for(int r=4;r<16;r+=4){a=max3f(a,p0[r],p0[r+1]);b=max3f(b,p0[r+2],p0[r+3]);a=max3f(a,p1[r],p1[r+1]);b=max3f(b,p1[r+2],p1[r+3]);}
  const float m=max2f(a,b);
  auto rr=__builtin_amdgcn_permlane32_swap(__float_as_uint(m),__float_as_uint(m),false,false);
  return max2f(__uint_as_float(rr[0]),__uint_as_float(rr[1]));
}
__device__ __forceinline__ void pv(f32x16*o,int vb,bf16x8 pa0,bf16x8 pa1,bf16x8 pa2,bf16x8 pa3){
  #pragma unroll
  for(int d0=0;d0<2;++d0){s16x4 lo[4],hi[4];
    #pragma unroll
    for(int ks=0;ks<4;++ks){
      asm volatile("ds_read_b64_tr_b16 %0,%1 offset:%c2":"=&v"(lo[ks]):"v"(vb),"i"(d0*4096+ks*1024):"memory");
      asm volatile("ds_read_b64_tr_b16 %0,%1 offset:%c2":"=&v"(hi[ks]):"v"(vb),"i"(d0*4096+ks*1024+512):"memory");}
    asm volatile("s_waitcnt lgkmcnt(0)":::"memory");SBAR();
    #define PK(k) (bf16x8){lo[k][0],lo[k][1],lo[k][2],lo[k][3],hi[k][0],hi[k][1],hi[k][2],hi[k][3]}
    o[d0]=__builtin_amdgcn_mfma_f32_32x32x16_bf16(pa0,PK(0),o[d0],0,0,0);
    o[d0]=__builtin_amdgcn_mfma_f32_32x32x16_bf16(pa1,PK(1),o[d0],0,0,0);
    o[d0]=__builtin_amdgcn_mfma_f32_32x32x16_bf16(pa2,PK(2),o[d0],0,0,0);
    o[d0]=__builtin_amdgcn_mfma_f32_32x32x16_bf16(pa3,PK(3),o[d0],0,0,0);
    #undef PK
  }
}
#define ATTN_STORE16(p,v) (*(u32x4*)(p)=(v))
template<int THRL> __device__ __forceinline__ void attn_unit(int qb,const bf16_t*Qb,const bf16_t*__restrict__ Kh,const bf16_t*__restrict__ Vh,bf16_t*Ob,float slope2,char*shm){
  const int tid=threadIdx.x,lane=tid&63,r32=lane&31,hi=lane>>5; const int wid=__builtin_amdgcn_readfirstlane(tid>>6);
  const int q0=qb*QB;
  const bf16_t*Qw=Qb+(long)(q0+wid*QBLK)*PIN;
  const unsigned lds0=(unsigned)(uintptr_t)shm;
  float*wsf=(float*)(shm+LDS_WS)+wid*64;
  const bf16_t*ksrc=Kh+(long)lane*PIN+wid*8;
  const bf16_t*vsrc=Vh+(long)(16*(wid&3)+(lane>>2))*PIN+(wid>>2)*32+(lane&3)*8;
  const unsigned kdst=lds0+LDS_K+wid*1024, vdst=lds0+LDS_V+wid*1024;
  #define DMA_K(t,slot) glds16(ksrc+(long)(t)*KVBLK*PIN,(unsigned)__builtin_amdgcn_readfirstlane(kdst+(slot)))
  #define DMA_V(t,slot) glds16(vsrc+(long)(t)*KVBLK*PIN,(unsigned)__builtin_amdgcn_readfirstlane(vdst+(slot)))
  const int vb0=(int)(lds0+LDS_V)+((lane>>4)&1)*32+(lane&3)*8+(4*hi+((lane&15)>>2))*64;
  const char*Kbase=shm+LDS_K; bf16x8 kf[8];
  const lds_cptr shm3=(lds_cptr)shm; const lds_cptr kp0=shm3+LDS_K+hi*1024+r32*16; const lds_cptr vp0=shm3+LDS_V+((lane>>4)&1)*32+(lane&3)*8+(4*hi+((lane&15)>>2))*64;
  const int NT=(q0+QB)/KVBLK;
  DMA_K(0,0);DMA_V(0,0);DMA_K(1,SLOTB);
  bf16x8 qr[4];
  #pragma unroll
  for(int d0=0;d0<4;++d0)qr[d0]=*reinterpret_cast<const bf16x8*>(&Qw[(long)r32*PIN+d0*16+hi*8]);
  float mhat=0.f,l_reg=0.f;f32x16 o[2];o[0]=f32x16{};o[1]=f32x16{};
  const float s64=slope2*64.f, s32=slope2*32.f, s2x2=2.f*slope2, s4hi=slope2*4.f*(float)hi;
  const int wch=wid>>1, il=32*(wid&1)+r32;
  #define CMASK(P0,P1,t) do{int jb_=(t)-(NT-4); if(jb_>=0)bmask(P0,P1,jb_,wch,il,hi,s2x2);}while(0)
  #define CINIT0(C0,t) do{ const float bt_=s64*(float)((t)-NT)-mhat+s4hi; _Pragma("unroll") for(int r=0;r<16;++r){C0[r]=__builtin_fmaf(slope2,(float)((r&3)+8*(r>>2)),bt_);} }while(0)
  #define CINIT1(C1,t) do{ const float bu_=s64*(float)((t)-NT)-mhat+s4hi+s32; _Pragma("unroll") for(int r=0;r<16;++r){C1[r]=__builtin_fmaf(slope2,(float)((r&3)+8*(r>>2)),bu_);} }while(0)
  bool resc=false;
  #define START(P0,P1) do{ const float rm=rowmax(P0,P1); resc=false; \
    { const float dl=rm; mhat=fadd_s(mhat,dl); \
      _Pragma("unroll") for(int r=0;r<16;++r){P0[r]=fsub_s(P0[r],dl);P1[r]=fsub_s(P1[r],dl);} } \
    _Pragma("unroll") for(int r=0;r<16;++r)P0[r]=__builtin_amdgcn_exp2f(P0[r]); }while(0)
  #define RESC() do{ if(resc){ asm volatile("s_waitcnt lgkmcnt(0)":::"memory"); \
      _Pragma("unroll") for(int d_=0;d_<2;++d_) _Pragma("unroll") for(int r=0;r<16;++r)o[d_][r]*=wsf[crow(r,hi)]; } }while(0)
  f32x16 pA0,pA1,pB0,pB1;
  int sl_prev=0,sl_cur=0,sl_next=SLOTB;
  #define ROT() do{sl_prev=sl_cur;sl_cur=sl_next;sl_next=(sl_next==(NSLOT-1)*SLOTB)?0:sl_next+SLOTB;}while(0)
  DMA_K(2,2*SLOTB);
  WAIT_BAR(3);
  { f32x16 c0,c1; CINIT0(c0,0); CINIT1(c1,0); qkt(pA0,pA1,Kbase,qr,c0,c1,r32,hi); }
  asm volatile("s_nop 15\n\ts_nop 7":"+v"(pA0),"+v"(pA1));CMASK(pA0,pA1,0);
  START(pA0,pA1);
  _Pragma("unroll") for(int r=0;r<16;++r)pA1[r]=__builtin_amdgcn_exp2f(pA1[r]);
  WAIT_BAR(0);
  DMA_K(3,0);DMA_V(1,SLOTB);
  ROT();
  kload8(kf,kp0+sl_cur);
  WAIT_BAR(2);
  s16x4 vlo[8],vhi[8]; u32x4 pw0,pw1,pw2,pw3;
  #define PKW(P,B) cvtpk_s(P[B],P[B+1])
  #define PAF(k) __builtin_bit_cast(bf16x8,pw##k)
  #define VFR(i) (bf16x8){vlo[i][0],vlo[i][1],vlo[i][2],vlo[i][3],vhi[i][0],vhi[i][1],vhi[i][2],vhi[i][3]}
  #define PIN_(x) asm volatile("":"+v"(x))
  #define MX3(a,b,c) __builtin_fmaxf(__builtin_fmaxf((a),(b)),(c))
  #define GAPA(MF,A0,A1,A2,A3,W0,W1,PW) do{ MF; sacc+=A0; sacc+=A1; sacc+=A2; sacc+=A3; PIN_(sacc); W0; W1; PIN_(PW); SBAR(); }while(0)
  #define EX(v) __builtin_amdgcn_exp2f(v)
  #define GAPB(MF,X,B) do{ MF; X[B]=EX(X[B]); X[B+1]=EX(X[B+1]); X[B+2]=EX(X[B+2]); X[B+3]=EX(X[B+3]); PIN_(X); SBAR(); }while(0)
  #define VRD(i) do{ vlo[i]=vtr(vp_+(((i)>>2)*4096+((i)&3)*1024)); vhi[i]=vtr(vp_+(((i)>>2)*4096+((i)&3)*1024+512)); }while(0)
  #define KRD(G,j) do{ if(G){ kload2(kf,kp0+sl_next,j); SBAR(); } }while(0)
  #define STEP(C0,C1,P0,P1,t,GK,GV,GL) do{ SBAR(); \
    CINIT0(C0,t); SBAR(); \
    const lds_cptr vp_=vp0+sl_prev; \
    VRD(0); SBAR(); float sacc=(P0[0]+P0[1]); \
    GAPA(C0=__builtin_amdgcn_mfma_f32_32x32x16_bf16(kf[0],qr[0],C0,0,0,0), P0[2],P0[3],P0[4],P0[5],     pw0[0]=PKW(P0,0), pw0[1]=PKW(P0,2), pw0); \
    CINIT1(C1,t); VRD(4); SBAR(); GAPA(C1=__builtin_amdgcn_mfma_f32_32x32x16_bf16(kf[1],qr[0],C1,0,0,0), P0[6],P0[7],P0[8],P0[9],     pw0[2]=PKW(P0,4), pw0[3]=PKW(P0,6), pw0); \
    VRD(1); SBAR(); GAPA(C0=__builtin_amdgcn_mfma_f32_32x32x16_bf16(kf[2],qr[1],C0,0,0,0),   P0[10],P0[11],P0[12],P0[13], pw1[0]=PKW(P0,8), pw1[1]=PKW(P0,10), pw1); \
    VRD(5); SBAR(); GAPA(C1=__builtin_amdgcn_mfma_f32_32x32x16_bf16(kf[3],qr[1],C1,0,0,0),   P0[14],P0[15],P1[0],P1[1],   pw1[2]=PKW(P0,12),pw1[3]=PKW(P0,14), pw1); \
    VRD(2); SBAR(); GAPA(C0=__builtin_amdgcn_mfma_f32_32x32x16_bf16(kf[4],qr[2],C0,0,0,0),   P1[2],P1[3],P1[4],P1[5],     pw2[0]=PKW(P1,0), pw2[1]=PKW(P1,2), pw2); \
    VRD(6); SBAR(); GAPA(C1=__builtin_amdgcn_mfma_f32_32x32x16_bf16(kf[5],qr[2],C1,0,0,0),   P1[6],P1[7],P1[8],P1[9],     pw2[2]=PKW(P1,4), pw2[3]=PKW(P1,6), pw2); \
    VRD(3); SBAR(); GAPA(C0=__builtin_amdgcn_mfma_f32_32x32x16_bf16(kf[6],qr[3],C0,0,0,0),   P1[10],P1[11],P1[12],P1[13], pw3[0]=PKW(P1,8), pw3[1]=PKW(P1,10), pw3); \
    VRD(7); SBAR(); GAPA(C1=__builtin_amdgcn_mfma_f32_32x32x16_bf16(kf[7],qr[3],C1,0,0,0),   P1[14],P1[15],0.f,0.f,       pw3[2]=PKW(P1,12),pw3[3]=PKW(P1,14), pw3); \
    l_reg+=sacc; \
    if(GK){DMA_K((t)+3,sl_cur);} if(GV){DMA_V((t)+1,sl_next);} \
    CMASK(C0,C1,t); \
    { float a=MX3(C0[0],C0[1],C1[0]),b=MX3(C0[2],C0[3],C1[1]); a=MX3(a,C1[2],C1[3]); \
      _Pragma("unroll") for(int r=4;r<16;r+=4){a=MX3(a,C0[r],C0[r+1]);b=MX3(b,C0[r+2],C0[r+3]);a=MX3(a,C1[r],C1[r+1]);b=MX3(b,C1[r+2],C1[r+3]);} \
      float rm=__builtin_fmaxf(a,b); { auto rr=__builtin_amdgcn_permlane32_swap(__float_as_uint(rm),__float_as_uint(rm),false,false); rm=__builtin_fmaxf(__uint_as_float(rr[0]),__uint_as_float(rr[1])); } \
      resc=false; \
      if(__builtin_expect(__any(rm>(float)THRL),0)){ const float dl=__builtin_fmaxf(rm,0.f); mhat+=dl; \
        _Pragma("unroll") for(int r=0;r<16;++r){C0[r]-=dl;C1[r]-=dl;} \
        const float f=__builtin_amdgcn_exp2f(-dl); l_reg*=f; if(hi==0)wsf[r32]=f; resc=true; } } \
    SBAR(); \
    GAPB(o[0]=__builtin_amdgcn_mfma_f32_32x32x16_bf16(PAF(0),VFR(0),o[0],0,0,0), C0,0); \
    GAPB(o[1]=__builtin_amdgcn_mfma_f32_32x32x16_bf16(PAF(0),VFR(4),o[1],0,0,0), C0,4); \
    KRD(GL,0); GAPB(o[0]=__builtin_amdgcn_mfma_f32_32x32x16_bf16(PAF(1),VFR(1),o[0],0,0,0), C0,8); \
    KRD(GL,1); GAPB(o[1]=__builtin_amdgcn_mfma_f32_32x32x16_bf16(PAF(1),VFR(5),o[1],0,0,0), C0,12); \
    KRD(GL,2); GAPB(o[0]=__builtin_amdgcn_mfma_f32_32x32x16_bf16(PAF(2),VFR(2),o[0],0,0,0), C1,0); \
    KRD(GL,3); GAPB(o[1]=__builtin_amdgcn_mfma_f32_32x32x16_bf16(PAF(2),VFR(6),o[1],0,0,0), C1,4); \
    GAPB(o[0]=__builtin_amdgcn_mfma_f32_32x32x16_bf16(PAF(3),VFR(3),o[0],0,0,0), C1,8); \
    GAPB(o[1]=__builtin_amdgcn_mfma_f32_32x32x16_bf16(PAF(3),VFR(7),o[1],0,0,0), C1,12); \
    }while(0)
  int t=1;
  #undef CMASK
  #define CMASK(P0,P1,t) do{}while(0)
  for(;t+5<NT;t+=2){
    STEP(pB0,pB1,pA0,pA1,t,true,true,true);     WAIT_BAR(2); RESC(); ROT();
    STEP(pA0,pA1,pB0,pB1,t+1,true,true,true);   WAIT_BAR(2); RESC(); ROT();
  }
  #undef CMASK
  #define CMASK(P0,P1,t) do{int jb_=(t)-(NT-4); if(jb_>=0)bmask(P0,P1,jb_,wch,il,hi,s2x2);}while(0)
  #define ENDW(tt) do{ if((tt)+3<NT){WAIT_BAR(2);} else if((tt)+2<NT){WAIT_BAR(1);} else {WAIT_BAR(0);} }while(0)
  for(;t+1<NT;t+=2){
    STEP(pB0,pB1,pA0,pA1,t,(t+3<NT),(t+1<NT),(t+1<NT));       ENDW(t);   RESC(); ROT();
    STEP(pA0,pA1,pB0,pB1,t+1,(t+4<NT),(t+2<NT),(t+2<NT));     ENDW(t+1); RESC(); ROT();
  }
  STEP(pB0,pB1,pA0,pA1,NT-1,false,false,false); RESC();
  { float sacc=pB0[0]+pB0[1]; _Pragma("unroll") for(int r=2;r<16;++r)sacc+=pB0[r]; _Pragma("unroll") for(int r=0;r<16;++r)sacc+=pB1[r]; l_reg+=sacc;
    pw0=(u32x4){PKW(pB0,0),PKW(pB0,2),PKW(pB0,4),PKW(pB0,6)};pw1=(u32x4){PKW(pB0,8),PKW(pB0,10),PKW(pB0,12),PKW(pB0,14)};pw2=(u32x4){PKW(pB1,0),PKW(pB1,2),PKW(pB1,4),PKW(pB1,6)};pw3=(u32x4){PKW(pB1,8),PKW(pB1,10),PKW(pB1,12),PKW(pB1,14)};
    SBAR(); pv(o,vb0+sl_cur,PAF(0),PAF(1),PAF(2),PAF(3)); }
  #undef PKW
  #undef PAF
  #undef VFR
  #undef PIN_
  #undef MX3
  #undef GAPA
  #undef GAPB
  #undef EX
  #undef VRD
  #undef KRD
  #undef STEP
  #undef ENDW
  {auto rr=__builtin_amdgcn_permlane32_swap(__float_as_uint(l_reg),__float_as_uint(l_reg),false,false);l_reg=__uint_as_float(rr[0])+__uint_as_float(rr[1]);}
  if(hi==0)wsf[32+r32]=l_reg;asm volatile("s_waitcnt lgkmcnt(0)":::"memory");
  float rli[16];
  #pragma unroll
  for(int r=0;r<16;++r)rli[r]=__builtin_amdgcn_rcpf(wsf[32+crow(r,hi)]);
  bf16_t*Ow=Ob+(long)(q0+wid*QBLK)*POUT;
  { bf16_t*stg=(bf16_t*)(shm+LDS_OST)+wid*2048;
    #pragma unroll
    for(int r=0;r<16;++r){const int orow=crow(r,hi);
      #pragma unroll
      for(int d0=0;d0<2;++d0)stg[orow*64+d0*32+r32]=(bf16_t)f2bf(o[d0][r]*rli[r]);}
    asm volatile("s_waitcnt lgkmcnt(0)":::"memory");
    #pragma unroll
    for(int i=0;i<4;++i){const int row=i*8+(lane>>3),ch=lane&7; const u32x4 v=*(const u32x4*)(stg+row*64+ch*8); ATTN_STORE16(Ow+(long)row*POUT+ch*8,v);} }
  asm volatile("s_waitcnt lgkmcnt(0)\n\ts_barrier":::"memory");
  #undef DMA_K
  #undef DMA_V
  #undef CMASK
  #undef CINIT0
  #undef CINIT1
  #undef START
  #undef RESC
  #undef ROT
}
#undef SBAR
#undef WAIT_BAR
}

__device__ __forceinline__ void attn_phase(const Frame& F, const Args& a) {
    const bf16_t* proj = (const bf16_t*)(a.ws + WS_PROJ); bf16_t* OA = (bf16_t*)(a.ws + WS_OA);
    const int vcu = (F.G % 8 == 0) ? (F.bid % 8) * (F.G / 8) + F.bid / 8 : F.bid;
    for (int i = 0;; ++i) {
        int bvh, qb;
        if (F.G == 256) { if (i >= 4) break; const int s = vcu & 3; bvh = vcu >> 2; qb = (i == 0) ? s : (i == 1) ? 7 - s : (i == 2) ? 8 + s : 15 - s; }
        else { const int u = i * F.G + F.bid; if (u >= 1024) break; bvh = u >> 4; qb = 15 - (u & 15); }
        const int b = bvh >> 4, vh = bvh & 15, h = vh >> 2, map = (vh >> 1) & 1, dvh = vh & 1;
        const bf16_t* base = proj + (size_t)b * SEQ * INC;
        const float slope2 = exp2f(-2.0f * (h + 1)) * 1.4426950408889634f;
        attn_body::attn_unit<8>(qb, base + C_QDA + h * 128 + map * 64, base + C_KDA + h * 128 + map * 64, base + C_VDA + h * 128 + dvh * 64,
                                OA + (size_t)b * SEQ * 1024 + vh * 64, slope2, (char*)F.lds);
    }
}
__device__ __forceinline__ void attn_combine(const Frame& F, const Args& a) {
    const bf16_t* OA = (const bf16_t*)(a.ws + WS_OA); bf16_t* Y = (bf16_t*)(a.ws + WS_YDA);
    const float lam = ((const float*)(a.ws + WS_SMALL))[0];
    const float g0 = a.in[I_SUBG][2 * F.lane] * 0.8f, g1 = a.in[I_SUBG][2 * F.lane + 1] * 0.8f;
    const int gw = F.bid * NWAVES + F.wave, NGW = F.G * NWAVES;
    for (int r = gw; r < T; r += NGW) {
        const unsigned* orow = (const unsigned*)(OA + (size_t)r * 1024); unsigned* yrow = (unsigned*)(Y + (size_t)r * 512);
        unsigned w0[4], w1[4];
#pragma unroll
        for (int h = 0; h < 4; ++h) { w0[h] = orow[h * 128 + F.lane]; w1[h] = orow[h * 128 + 64 + F.lane]; }
#pragma unroll
        for (int h = 0; h < 4; ++h) {
            const float x0 = bf2f(w0[h] & 0xffffu) - lam * bf2f(w1[h] & 0xffffu), x1 = bf2f(w0[h] >> 16) - lam * bf2f(w1[h] >> 16);
            const float rs = rsqrtf(wave_sum(x0 * x0 + x1 * x1) * (1.0f / 128.0f) + EPS);
            yrow[h * 64 + F.lane] = pk2(x0 * rs * g0, x1 * rs * g1);
        }
    }
}
__device__ __forceinline__ void hgrn_naive_unit(const Frame& F, const Args& a, int unit) {
    const bf16_t* proj = (const bf16_t*)(a.ws + WS_PROJ);
    const float* lbv = (const float*)(a.ws + WS_SMALL) + 16;
    const int b = unit >> 2, h = unit & 3, tid = F.tid;
    LAS float* qs = (LAS float*)F.lds;
    LAS float* fs = qs + 4096;
    LAS float* ks = fs + 4096;
    LAS float* vs = ks + 4096;
    LAS float* gs = vs + 4096;
    LAS float* op = gs + 4096;
    const int v = tid & 127, kg = tid >> 7;
    float s[32];
#pragma unroll
    for (int i = 0; i < 32; ++i) s[i] = 0.f;
    for (int ch = 0; ch < SEQ / 32; ++ch) {
        const size_t t0 = (size_t)b * SEQ + ch * 32;
        __syncthreads();
        for (int i = tid; i < 32 * 16; i += NTHR) {
            const int r = i >> 4, c8 = (i & 15) * 8; const bf16_t* rp = proj + (t0 + r) * INC + h * 128 + c8;
            const u32x4 qw = *(const u32x4*)(rp + C_QHG), fw = *(const u32x4*)(rp + C_FHG), iw = *(const u32x4*)(rp + C_IHG), gw = *(const u32x4*)(rp + C_GHG);
#pragma unroll
            for (int j = 0; j < 8; ++j) {
                const unsigned sel = (j & 1) ? 16u : 0u;
                const float qv = bf2f((qw[j >> 1] >> sel) & 0xffffu), fv = bf2f((fw[j >> 1] >> sel) & 0xffffu), iv = bf2f((iw[j >> 1] >> sel) & 0xffffu), gv = bf2f((gw[j >> 1] >> sel) & 0xffffu);
                const float lb = lbv[h * 128 + c8 + j]; const float f = lb + (1.0f - lb) * sigmoidf_(fv);
                const int o = r * 128 + c8 + j;
                qs[o] = siluf_(qv); fs[o] = f; ks[o] = 1.0f - f; vs[o] = iv; gs[o] = siluf_(gv);
            }
        }
        __syncthreads();
        for (int r = 0; r < 32; ++r) {
            const float vt = vs[r * 128 + v]; float o = 0.f;
            const LAS float* fr_ = fs + r * 128 + kg * 32; const LAS float* kr_ = ks + r * 128 + kg * 32; const LAS float* qr_ = qs + r * 128 + kg * 32;
#pragma unroll
            for (int i = 0; i < 32; i += 4) { const f32x4 f4 = *(const LAS f32x4*)(fr_ + i), k4 = *(const LAS f32x4*)(kr_ + i), q4 = *(const LAS f32x4*)(qr_ + i);
                s[i] = f4.x * s[i] + k4.x * vt; o += s[i] * q4.x; s[i + 1] = f4.y * s[i + 1] + k4.y * vt; o += s[i + 1] * q4.y;
                s[i + 2] = f4.z * s[i + 2] + k4.z * vt; o += s[i + 2] * q4.z; s[i + 3] = f4.w * s[i + 3] + k4.w * vt; o += s[i + 3] * q4.w; }
            op[(kg * 32 + r) * 128 + v] = o;
        }
        __syncthreads();
        {
            const int r = tid >> 4, sub = tid & 15; float o[8]; float ss = 0.f;
#pragma unroll
            for (int j = 0; j < 8; ++j) { const int vv = sub * 8 + j; o[j] = (op[(0 * 32 + r) * 128 + vv] + op[(1 * 32 + r) * 128 + vv]) + (op[(2 * 32 + r) * 128 + vv] + op[(3 * 32 + r) * 128 + vv]); ss += o[j] * o[j]; }
            ss += __shfl_xor(ss, 1); ss += __shfl_xor(ss, 2); ss += __shfl_xor(ss, 4); ss += __shfl_xor(ss, 8);
            const float rs = rsqrtf(ss * (1.0f / 128.0f) + EPS);
            const float* ng = a.in[I_HGNG] + sub * 8;
            float y[8];
#pragma unroll
            for (int j = 0; j < 8; ++j) y[j] = o[j] * rs * ng[j] * gs[r * 128 + sub * 8 + j];
            u32x4 w; w.x = pk2(y[0], y[1]); w.y = pk2(y[2], y[3]); w.z = pk2(y[4], y[5]); w.w = pk2(y[6], y[7]);
            *(u32x4*)((bf16_t*)(a.ws + WS_YHG) + (t0 + r) * 512 + h * 128 + sub * 8) = w;
        }
    }
}

__device__ __forceinline__ void phase_router(const Frame& F, const Args& a) {
    LAS float* Wr = (LAS float*)F.lds;
    for (int i = F.tid; i < 36 * 1024; i += NTHR) { const int o = i >> 10, k = i & 1023; Wr[i] = o < 4 ? a.in[I_WRG][k * 4 + o] : a.in[I_WRE][k * 32 + (o - 4)]; }
    __syncthreads();
    const float* mod = (const float*)(a.ws + WS_MOD);
    const float* x1 = a.out; bf16_t* H2 = (bf16_t*)(a.ws + WS_ACT);
    unsigned* counts = (unsigned*)(a.ws + WS_CTL) + CW_COUNTS; unsigned* tokinfo = (unsigned*)(a.ws + WS_TOKINFO); int* toklist = (int*)(a.ws + WS_TOKLIST);
    const int rows_per_blk = T / F.G, r0 = F.bid * rows_per_blk;
    for (int r = r0 + F.wave; r < r0 + rows_per_blk; r += NWAVES) {
        const int b = r / SEQ;
        const f32x4* xr = (const f32x4*)(x1 + (size_t)r * D) + F.lane;
        f32x4 v[4]; float s = 0.f;
#pragma unroll
        for (int j = 0; j < 4; ++j) { v[j] = xr[64 * j]; s += (v[j].x * v[j].x + v[j].y * v[j].y) + (v[j].z * v[j].z + v[j].w * v[j].w); }
        const float rs = rsqrtf(wave_sum(s) * (1.0f / D) + EPS);
        unsigned long long* o8 = (unsigned long long*)(H2 + (size_t)r * D) + F.lane;
#pragma unroll
        for (int j = 0; j < 4; ++j) { const int k = 256 * j + 4 * F.lane;
            const f32x4 g = *(const f32x4*)(a.in[I_N2G] + k), sc = *(const f32x4*)(mod + b * 6144 + 4 * 1024 + k), sh = *(const f32x4*)(mod + b * 6144 + 3 * 1024 + k);
            v[j] = v[j] * rs * g * (1.0f + sc) + sh;
            o8[64 * j] = (unsigned long long)pk2(v[j].x, v[j].y) | ((unsigned long long)pk2(v[j].z, v[j].w) << 32); }
        float mylg = 0.f;
#pragma unroll 2
        for (int o = 0; o < 36; ++o) { float p = 0.f;
#pragma unroll
            for (int j = 0; j < 4; ++j) { const f32x4 w = *(const LAS f32x4*)(Wr + o * 1024 + 256 * j + 4 * F.lane); p += (v[j].x * w.x + v[j].y * w.y) + (v[j].z * w.z + v[j].w * w.w); }
            p = wave_sum(p); if (F.lane == o) mylg = p; }
        if (F.lane < 4) mylg += a.in[I_BRG][F.lane]; else if (F.lane < 36) mylg += a.in[I_BRE][F.lane - 4];
        float gl[4]; int gi = 0;
#pragma unroll
        for (int o = 0; o < 4; ++o) gl[o] = __shfl(mylg, o);
        float gm = gl[0];
#pragma unroll
        for (int o = 1; o < 4; ++o) if (gl[o] > gm) { gm = gl[o]; gi = o; }
        float gsum = 0.f;
#pragma unroll
        for (int o = 0; o < 4; ++o) gsum += expf(gl[o] - gm);
        const float gp = 1.0f / gsum;
        float el[8];
#pragma unroll
        for (int o = 0; o < 8; ++o) el[o] = __shfl(mylg, 4 + gi * 8 + o);
        int i0 = 0; float m0 = el[0];
#pragma unroll
        for (int o = 1; o < 8; ++o) if (el[o] > m0) { m0 = el[o]; i0 = o; }
        int i1 = -1; float m1 = -INFINITY;
#pragma unroll
        for (int o = 0; o < 8; ++o) if (o != i0 && el[o] > m1) { m1 = el[o]; i1 = o; }
        const float e1 = expf(m1 - m0); const float w0 = gp / (1.0f + e1), w1 = gp * e1 / (1.0f + e1);
        if (F.lane == 0) {
            const int ex0 = gi * 8 + i0, ex1 = gi * 8 + i1;
            const unsigned r0_ = atomicAdd(counts + ex0, 1u), r1_ = atomicAdd(counts + ex1, 1u);
            toklist[ex0 * T + r0_] = r; toklist[ex1 * T + r1_] = r;
            u32x4 t0; t0.x = (unsigned)ex0; t0.y = r0_; t0.z = (unsigned)ex1; t0.w = r1_;
            *(u32x4*)(tokinfo + (size_t)r * 8) = t0;
            tokinfo[(size_t)r * 8 + 4] = __float_as_uint(w0); tokinfo[(size_t)r * 8 + 5] = __float_as_uint(w1);
        }
    }
}
__device__ __forceinline__ void build_moe_tab(const Frame& F, const Args& a, LAS MoeTab* tab) {
    if (F.tid == 0) {
        const unsigned* counts = (const unsigned*)(a.ws + WS_CTL) + CW_COUNTS; int nt = 0;
        for (int e = 0; e < NEXP; ++e) { const int c = (int)__hip_atomic_load(counts + e, __ATOMIC_RELAXED, __HIP_MEMORY_SCOPE_AGENT); tab->cnt[e] = c; tab->tbase[e] = nt;
            const int n = (c + 255) >> 8; for (int m = 0; m < n; ++m) { tab->tile_e[nt] = e; tab->tile_m[nt] = m; ++nt; } }
        tab->tbase[NEXP] = nt; tab->nt = nt;
    }
    __syncthreads();
}
__device__ __forceinline__ void phase_final(const Frame& F, const Args& a, const LAS MoeTab* tab) {
    const float* mod = (const float*)(a.ws + WS_MOD); const unsigned* tokinfo = (const unsigned*)(a.ws + WS_TOKINFO); const bf16_t* Ys = (const bf16_t*)(a.ws + WS_YS);
    const int rows_per_blk = T / F.G, r0 = F.bid * rows_per_blk;
    for (int r = r0 + F.wave; r < r0 + rows_per_blk; r += NWAVES) {
        const int b = r / SEQ;
        const u32x4 ti = *(const u32x4*)(tokinfo + (size_t)r * 8);
        const float w0 = __uint_as_float(tokinfo[(size_t)r * 8 + 4]), w1 = __uint_as_float(tokinfo[(size_t)r * 8 + 5]);
        const size_t s0 = (size_t)tab->tbase[ti.x] * 256 + ti.y, s1 = (size_t)tab->tbase[ti.z] * 256 + ti.w;
        f32x4* xr = (f32x4*)(a.out + (size_t)r * D) + F.lane;
        const u32x2* y0 = (const u32x2*)(Ys + s0 * D) + F.lane; const u32x2* y1 = (const u32x2*)(Ys + s1 * D) + F.lane;
        f32x4 v[4]; float s = 0.f;
#pragma unroll
        for (int j = 0; j < 4; ++j) { const int k = 256 * j + 4 * F.lane;
            const f32x4 gt = *(const f32x4*)(mod + b * 6144 + 5 * 1024 + k); const u32x2 a0 = y0[64 * j], a1 = y1[64 * j];
            f32x4 m; m.x = w0 * bf2f(a0.x & 0xffffu) + w1 * bf2f(a1.x & 0xffffu); m.y = w0 * bf2f(a0.x >> 16) + w1 * bf2f(a1.x >> 16);
            m.z = w0 * bf2f(a0.y & 0xffffu) + w1 * bf2f(a1.y & 0xffffu); m.w = w0 * bf2f(a0.y >> 16) + w1 * bf2f(a1.y >> 16);
            v[j] = xr[64 * j] + gt * m; s += (v[j].x * v[j].x + v[j].y * v[j].y) + (v[j].z * v[j].z + v[j].w * v[j].w); }
        const float rs = rsqrtf(wave_sum(s) * (1.0f / D) + EPS);
#pragma unroll
        for (int j = 0; j < 4; ++j) { const f32x4 g = *(const f32x4*)(a.in[I_FG] + 256 * j + 4 * F.lane); xr[64 * j] = v[j] * rs * g; }
    }
}

constexpr int N_PHASES = 11;
__global__ void __launch_bounds__(NTHR, 2) mk_fwd(Args a) {
    extern __shared__ __attribute__((aligned(16))) unsigned char lds_raw[];
    Frame F; F.lds = (LAS unsigned char*)lds_raw; F.tid = threadIdx.x; F.lane = F.tid & 63; F.wave = __builtin_amdgcn_readfirstlane(F.tid >> 6); F.G = gridDim.x; F.bid = blockIdx.x;
    unsigned char* ws = a.ws;
    const int lo = a.ph_lo, hi = a.ph_hi;
#if MK_N_LAUNCHES == 1
    cg::grid_group grid = cg::this_grid();
#define SEAM(k) do { if (IN(k) && IN((k) + 1)) grid.sync(); } while (0)
#else
#define SEAM(k) do { } while (0)
#endif
#ifndef PHASE_MASK
#define PHASE_MASK 0x7ff
#endif
#define IN(k) (((PHASE_MASK >> (k)) & 1) && lo <= (k) && (k) < hi)
    LAS MoeTab* tab = (LAS MoeTab*)(F.lds + 144 * 1024);

    if (IN(0)) { phase0(F, a); } SEAM(0);
    if (IN(1)) { phase1(F, a); } SEAM(1);
    if (IN(2)) {
        DenseOrder S{(const char*)(ws + WS_ACT), (const char*)(ws + WS_WIN), D, T / 256, INC / 256, F.G, F.bid};
        EpiStoreBf16 E{(bf16_t*)(ws + WS_PROJ), INC, 2, attn_body::C2};
        pg8::gemm_phase(F.lds, D, S, E);
    } SEAM(2);
    if (IN(3)) {
        for (int u = F.bid; u < 16; u += F.G) hgrn_naive_unit(F, a, u);
        __syncthreads();
        attn_phase(F, a);
    } SEAM(3);
    if (IN(4)) { attn_combine(F, a); } SEAM(4);
    if (IN(5)) {
        UpOrder S{(const char*)(ws + WS_YDA), (const char*)(ws + WS_YHG), (const char*)(ws + WS_WUPDA), (const char*)(ws + WS_WUPHG), F.G, F.bid};
        EpiUp E{(const bf16_t*)(ws + WS_PROJ), (bf16_t*)(ws + WS_ACT)};
        pg8::gemm_phase(F.lds, 512, S, E);
    } SEAM(5);
    if (IN(6)) {
        DenseOrder S{(const char*)(ws + WS_ACT), (const char*)(ws + WS_WOUT), D, T / 256, D / 256, F.G, F.bid};
        EpiOut E{a.in[I_X], (const float*)(ws + WS_MOD), a.out};
        pg8::gemm_phase(F.lds, D, S, E);
        moe_weight_convert(F, a);
    } SEAM(6);
    if (IN(7)) { phase_router(F, a); __syncthreads(); } SEAM(7);
    if (IN(8)) {
        build_moe_tab(F, a, tab);
        Moe1Order S{tab, (const char*)(ws + WS_ACT), (const char*)(ws + WS_W13), (const int*)(ws + WS_TOKLIST), F.G, F.bid};
        EpiMoe1 E{(bf16_t*)(ws + WS_HS)};
        pg8::gemm_phase(F.lds, D, S, E);
    } SEAM(8);
    if (IN(9)) {
        build_moe_tab(F, a, tab);
        Moe2Order S{tab, (const char*)(ws + WS_HS), (const char*)(ws + WS_W2), F.G, F.bid};
        EpiStoreBf16 E{(bf16_t*)(ws + WS_YS), D, 0, 1.0f};
        pg8::gemm_phase(F.lds, DEXP, S, E);
    } SEAM(9);
    if (IN(10)) { build_moe_tab(F, a, tab); phase_final(F, a, tab); }
#undef IN
#undef SEAM
}

extern "C" void kernel_launch(void* const* d_in, const int* in_sizes, int n_in, void* d_out, int out_size, void* d_ws, size_t ws_size, hipStream_t stream) {
    static int grid = 0;
    if (grid == 0) {
        if (n_in != 25 || in_sizes[0] != T * D || out_size != T * D || ws_size < WS_END) { fprintf(stderr, "kernel_launch: unexpected shapes (n_in %d, in0 %d, out %d, ws %zu)\n", n_in, n_in > 0 ? in_sizes[0] : -1, out_size, ws_size); grid = -1; return; }
        int dev = 0, cus = 0, per_cu = 0;
        if (hipGetDevice(&dev) != hipSuccess || hipDeviceGetAttribute(&cus, hipDeviceAttributeMultiprocessorCount, dev) != hipSuccess) { grid = -1; return; }
        if (hipFuncSetAttribute((const void*)mk_fwd, hipFuncAttributeMaxDynamicSharedMemorySize, LDS_BYTES) != hipSuccess) { fprintf(stderr, "kernel_launch: hipFuncSetAttribute failed\n"); grid = -1; return; }
        if (hipOccupancyMaxActiveBlocksPerMultiprocessor(&per_cu, (const void*)mk_fwd, NTHR, LDS_BYTES) != hipSuccess || per_cu < 1) { fprintf(stderr, "kernel_launch: occupancy query says %d\n", per_cu); per_cu = 1; }
        (void)hipGetLastError();
        grid = cus;
        if (grid > 256) grid = 256;
        while (T % grid) --grid;
    }
    if (grid < 0) return;
    (void)hipMemsetAsync((char*)d_ws + WS_CTL, 0, CTL_ZERO_BYTES, stream);
    Args a{};
    for (int i = 0; i < 25; ++i) a.in[i] = (const float*)d_in[i];
    a.out = (float*)d_out; a.ws = (unsigned char*)d_ws;
#if MK_N_LAUNCHES == 1
    a.ph_lo = 0; a.ph_hi = N_PHASES;
    void* args[] = {&a};
    hipError_t e = hipLaunchCooperativeKernel((const void*)mk_fwd, dim3(grid), dim3(NTHR), args, LDS_BYTES, stream);
    if (e != hipSuccess) fprintf(stderr, "cooperative launch failed: %s (grid %d)\n", hipGetErrorString(e), grid);
#else
    for (int p = 0; p < N_PHASES; ++p) {
        a.ph_lo = p; a.ph_hi = p + 1;
        hipLaunchKernelGGL(mk_fwd, dim3(grid), dim3(NTHR), LDS_BYTES, stream, a);
    }
#endif
}
```

```cpp
#include <hip/hip_runtime.h>
#include <hip/hip_cooperative_groups.h>
#include <cstdio>
#include <cstdint>
namespace cg = cooperative_groups;

#ifndef MK_N_LAUNCHES
#define MK_N_LAUNCHES 1
#endif

#define LAS __attribute__((address_space(3)))
typedef unsigned short bf16_t;
typedef short bf16x8 __attribute__((ext_vector_type(8)));
typedef float f32x4 __attribute__((ext_vector_type(4)));
typedef float f32x2 __attribute__((ext_vector_type(2)));
typedef unsigned u32x4 __attribute__((ext_vector_type(4)));
typedef unsigned u32x2 __attribute__((ext_vector_type(2)));

constexpr int NB = 4, SEQ = 4096, D = 1024, T = NB * SEQ;
constexpr int INC = 5632;
constexpr int C_QDA = 0, C_KDA = 512, C_VDA = 1024, C_QHG = 1536, C_FHG = 2048, C_IHG = 2560, C_GHG = 3072, C_GDA = 3584, C_GHGATE = 4608;
constexpr int NEXP = 32, DEXP = 512;
constexpr int PMAX = 40960;
constexpr float EPS = 1e-6f;
constexpr int NWAVES = 8, NTHR = 512;

constexpr size_t MiB = 1u << 20;
constexpr size_t WS_CTL = 0, CTL_ZERO_BYTES = 64 * 1024;
constexpr size_t WS_MODP = 1 * MiB;
constexpr size_t WS_MOD = 5 * MiB / 2;
constexpr size_t WS_SMALL = 11 * MiB / 4;
constexpr size_t WS_TOKINFO = 3 * MiB;
constexpr size_t WS_TOKLIST = 4 * MiB;
constexpr size_t WS_DEC = 6 * MiB;
constexpr size_t WS_DS = 24 * MiB;
constexpr size_t WS_WIN = 8 * MiB;
constexpr size_t WS_WUPDA = 20 * MiB, WS_WUPHG = 21 * MiB, WS_WOUT = 22 * MiB;
constexpr size_t WS_ACT = 24 * MiB;
constexpr size_t WS_PROJ = 56 * MiB;
constexpr size_t WS_YDA = 232 * MiB, WS_YHG = 248 * MiB;
constexpr size_t WS_OA = 264 * MiB;
constexpr size_t WS_W13 = 56 * MiB;
constexpr size_t WS_W2 = 120 * MiB;
constexpr size_t WS_HS = 152 * MiB;
constexpr size_t WS_YS = 192 * MiB;
constexpr size_t WS_END = 296 * MiB;
constexpr int CW_COUNTS = 64;
constexpr int CW_BAR = 4096;

constexpr int LDS_BYTES = 160 * 1024;

__device__ __forceinline__ float bf2f(unsigned v) { return __uint_as_float(v << 16); }
__device__ __forceinline__ unsigned f2bf(float f) { unsigned u = __float_as_uint(f); return (u + 0x7fffu + ((u >> 16) & 1u)) >> 16; }
__device__ __forceinline__ unsigned pk2(float lo, float hi) { return f2bf(lo) | (f2bf(hi) << 16); }
__device__ __forceinline__ float sigmoidf_(float x) { return 1.0f / (1.0f + __expf(-x)); }
__device__ __forceinline__ float siluf_(float x) { return x / (1.0f + __expf(-x)); }
__device__ __forceinline__ float wave_sum(float v) {
#pragma unroll
    for (int o = 1; o < 64; o <<= 1) v += __shfl_xor(v, o);
    return v;
}

namespace pg8 {
constexpr int BM = 256, BK = 64, HALF = 128, HTB = HALF * BK * 2, STAGE_BYTES = 8 * HTB;
__host__ __device__ __forceinline__ int lds_byte(int r, int c) { const int st = (r >> 4) * 2 + (c >> 5), rr = r & 15, cc = c & 31, ob = rr * 64 + cc * 2; return st * 1024 + (ob ^ (((ob >> 9) & 1) << 5)); }
__host__ __device__ __forceinline__ void stage_rc(int b, int& R, int& C) { const int st = b / 1024, sb = b % 1024, swz = sb ^ (((sb >> 9) & 1) << 5); R = (st >> 1) * 16 + swz / 64; C = (st & 1) * 32 + (swz % 64) / 2; }
__host__ __device__ __forceinline__ int perm32(int rho) { const int n = rho >> 4, i = rho & 15; return 8 * (i >> 2) + 4 * n + (i & 3); }

struct Unit { int pm, pn; const char* A; const char* B; int aux; };
__device__ __forceinline__ unsigned cvt_pk_bf16(float lo, float hi) { unsigned r; asm volatile("v_cvt_pk_bf16_f32 %0, %1, %2" : "=v"(r) : "v"(lo), "v"(hi)); return r; }

template <class Epi, class Sched>
__device__ __forceinline__ void gemm_phase(LAS unsigned char* lds, const int K, const Sched& S, const Epi& E) {
    const int tid = threadIdx.x, wid = __builtin_amdgcn_readfirstlane(tid >> 6), lane = tid & 63, wr = wid >> 2, wc = wid & 3, fr = lane & 15, fq = lane >> 4;
    const int nt = K / BK;
    int RA[2], CA[2]; unsigned voffB[2];
#pragma unroll
    for (int i = 0; i < 2; ++i) { int R, C; stage_rc(tid * 16 + i * 8192, R, C); const int Rb = Epi::PERM ? ((R & ~31) + perm32(R & 31)) : R;
        RA[i] = R; CA[i] = C; voffB[i] = (unsigned)(Rb * K + C) * 2u; }
    const size_t kstep = (size_t)(BK * 2);
    const size_t hstep = (size_t)HALF * K * 2;
    const unsigned ldsw = (unsigned)wid * 1024u;
    const int aoff = lds_byte(wr * 64 + fr, fq * 8), boff = lds_byte(wc * 32 + fr, fq * 8);
#define PG8_SA(b, h) (((b) * 2 + (h)) * HTB)
#define PG8_SB(b, h) ((4 + (b) * 2 + (h)) * HTB)
#define PG8_STAGE(bufoff, gbase, voff) do { _Pragma("unroll") for (int _i = 0; _i < 2; ++_i) \
        __builtin_amdgcn_global_load_lds((const unsigned*)((const char*)(gbase) + (voff)[_i]), (LAS unsigned*)(lds + (bufoff) + ldsw + _i * 8192), 16, 0, 0); } while (0)
#define PG8_LDA(dst, b, h) do { _Pragma("unroll") for (int m = 0; m < 4; ++m) _Pragma("unroll") for (int k = 0; k < 2; ++k) dst[m][k] = *(const LAS bf16x8*)(lds + PG8_SA(b, h) + aoff + m * 2048 + k * 1024); } while (0)
#define PG8_LDB(dst, b, h) do { _Pragma("unroll") for (int n = 0; n < 2; ++n) _Pragma("unroll") for (int k = 0; k < 2; ++k) dst[n][k] = *(const LAS bf16x8*)(lds + PG8_SB(b, h) + boff + n * 2048 + k * 1024); } while (0)
#define PG8_MMA(ai, bj, At, Bt) do { __builtin_amdgcn_s_setprio(1); _Pragma("unroll") for (int m = 0; m < 4; ++m) _Pragma("unroll") for (int n = 0; n < 2; ++n) _Pragma("unroll") for (int k = 0; k < 2; ++k) \
        acc[ai][bj][m][n] = __builtin_amdgcn_mfma_f32_16x16x32_bf16(Bt[n][k], At[m][k], acc[ai][bj][m][n], 0, 0, 0); __builtin_amdgcn_s_setprio(0); } while (0)
#define PG8_WAIT_V(n) asm volatile("s_waitcnt vmcnt(" #n ")" ::: "memory")
#define PG8_WAIT_L(n) asm volatile("s_waitcnt lgkmcnt(" #n ")" ::: "memory")
#define PG8_BAR __builtin_amdgcn_s_barrier()
#define PG8_SCHED __builtin_amdgcn_sched_barrier(0)
#define PG8_SETA(vo, u) do { _Pragma("unroll") for (int _h = 0; _h < 2; ++_h) _Pragma("unroll") for (int _i = 0; _i < 2; ++_i) \
        vo[_h][_i] = (unsigned)((size_t)S.arow(u, _h * HALF + RA[_i]) * (size_t)K + CA[_i]) * 2u; if (Sched::GATHER) PG8_WAIT_V(0); } while (0)
    Unit cur, nxt; int ui = 0;
    if (!S.next(0, cur)) return;
    f32x4 acc[2][2][4][2];
#pragma unroll
    for (int a = 0; a < 2; ++a)
#pragma unroll
        for (int b = 0; b < 2; ++b)
#pragma unroll
            for (int m = 0; m < 4; ++m)
#pragma unroll
                for (int n = 0; n < 2; ++n) acc[a][b][m][n] = (f32x4){0.f, 0.f, 0.f, 0.f};
    bf16x8 At[4][2], B0[2][2], B1[2][2];
    unsigned voC[2][2], voN[2][2];
    PG8_SETA(voC, cur);
    const char* cA = cur.A; const char* cB = cur.B;
    PG8_STAGE(PG8_SB(0, 0), cB, voffB); PG8_STAGE(PG8_SB(0, 1), cB + hstep, voffB); PG8_STAGE(PG8_SA(0, 0), cA, voC[0]); PG8_STAGE(PG8_SA(0, 1), cA, voC[1]);
    if (wr == 1) PG8_BAR;
    PG8_WAIT_V(2); PG8_BAR;
    PG8_STAGE(PG8_SB(1, 0), cB + kstep, voffB); PG8_STAGE(PG8_SA(1, 0), cA + kstep, voC[0]); PG8_STAGE(PG8_SB(1, 1), cB + hstep + kstep, voffB);
    PG8_WAIT_V(6); PG8_BAR;
    for (;;) {
        const bool has_next = S.next(ui + 1, nxt);
        if (has_next) { PG8_SETA(voN, nxt); }
        else {
#pragma unroll
            for (int h = 0; h < 2; ++h)
#pragma unroll
                for (int i = 0; i < 2; ++i) voN[h][i] = voC[h][i];
        }
        const char* nA = has_next ? nxt.A : cA; const char* nB = has_next ? nxt.B : cB;
        for (int t = 0; t < nt; t += 2) {
            const bool last = (t == nt - 2);
            const char* a1 = cA + (size_t)(t + 1) * kstep;
            const char* a2 = last ? nA : cA + (size_t)(t + 2) * kstep; const char* b2 = last ? nB : cB + (size_t)(t + 2) * kstep;
            const char* a3 = a2 + kstep; const char* b3 = b2 + kstep;
            unsigned vo2[2][2];
#pragma unroll
            for (int h = 0; h < 2; ++h)
#pragma unroll
                for (int i = 0; i < 2; ++i) vo2[h][i] = last ? voN[h][i] : voC[h][i];
            PG8_LDB(B0, 0, 0); PG8_LDB(B1, 0, 1); PG8_SCHED; PG8_LDA(At, 0, 0); PG8_STAGE(PG8_SA(1, 1), a1, voC[1]);
            PG8_WAIT_V(8); PG8_WAIT_L(0); PG8_BAR; PG8_MMA(0, 0, At, B0); PG8_MMA(0, 1, At, B1); PG8_BAR; PG8_SCHED;
            PG8_LDA(At, 0, 1); PG8_STAGE(PG8_SB(0, 0), b2, voffB); PG8_STAGE(PG8_SB(0, 1), b2 + hstep, voffB); PG8_STAGE(PG8_SA(0, 0), a2, vo2[0]);
            PG8_WAIT_V(8); PG8_WAIT_L(0); PG8_BAR; PG8_MMA(1, 0, At, B0); PG8_MMA(1, 1, At, B1); PG8_BAR; PG8_SCHED;
            PG8_LDB(B0, 1, 0); PG8_LDB(B1, 1, 1); PG8_SCHED; PG8_LDA(At, 1, 0); PG8_STAGE(PG8_SA(0, 1), a2, vo2[1]);
            PG8_WAIT_V(8); PG8_WAIT_L(0); PG8_BAR; PG8_MMA(0, 0, At, B0); PG8_MMA(0, 1, At, B1); PG8_BAR; PG8_SCHED;
            PG8_LDA(At, 1, 1); PG8_STAGE(PG8_SB(1, 0), b3, voffB); PG8_STAGE(PG8_SB(1, 1), b3 + hstep, voffB); PG8_STAGE(PG8_SA(1, 0), a3, vo2[0]);
            PG8_WAIT_V(8); PG8_WAIT_L(0); PG8_BAR; PG8_MMA(1, 0, At, B0); PG8_MMA(1, 1, At, B1); PG8_BAR; PG8_SCHED;
        }
        if (wr == 0) PG8_BAR;
        const bool keep = E(acc, cur, wr, wc, fr, fq);
        if (!has_next) break;
        if (!keep) {
#pragma unroll
            for (int a = 0; a < 2; ++a)
#pragma unroll
                for (int b = 0; b < 2; ++b)
#pragma unroll
                    for (int m = 0; m < 4; ++m)
#pragma unroll
                        for (int n = 0; n < 2; ++n) acc[a][b][m][n] = (f32x4){0.f, 0.f, 0.f, 0.f};
        }
        cur = nxt; cA = nA; cB = nB; ++ui;
#pragma unroll
        for (int h = 0; h < 2; ++h)
#pragma unroll
            for (int i = 0; i < 2; ++i) voC[h][i] = voN[h][i];
        if (wr == 1) PG8_BAR;
    }
    PG8_WAIT_V(0);
    PG8_BAR;
#undef PG8_SA
#undef PG8_SB
#undef PG8_STAGE
#undef PG8_LDA
#undef PG8_LDB
#undef PG8_MMA
#undef PG8_WAIT_V
#undef PG8_WAIT_L
#undef PG8_BAR
#undef PG8_SCHED
#undef PG8_SETA
}
}

struct Args { const float* in[25]; float* out; unsigned char* ws; int ph_lo, ph_hi; };
enum { I_X = 0, I_C, I_WADA, I_BADA, I_N1G, I_WIN, I_LQ1, I_LK1, I_LQ2, I_LK2, I_SUBG, I_LBL, I_HGNG, I_WUPDA, I_WUPHG, I_WOUT, I_N2G, I_WRG, I_BRG, I_WRE, I_BRE, I_W1, I_W3, I_W2, I_FG };

struct DenseOrder {
    static constexpr bool GATHER = false;
    const char* A; const char* Bt; int K, nM, nN, G, c;
    __device__ __forceinline__ bool next(int i, pg8::Unit& u) const {
        const int L = i * G + c, nwg = nM * nN; if (L >= nwg) return false;
        int wgid = L; { const int q = nwg / 8, r = nwg % 8, xcd = wgid % 8, off = wgid / 8; wgid = (xcd < r ? xcd * (q + 1) : r * (q + 1) + (xcd - r) * q) + off; }
        const int nig = 8 * nN, gid = wgid / nig, fm = gid * 8, gsz = (nM - fm) < 8 ? (nM - fm) : 8;
        u.pm = fm + ((wgid % nig) % gsz); u.pn = (wgid % nig) / gsz; u.A = A; u.B = Bt + (size_t)u.pn * 256 * K * 2; u.aux = 0; return true;
    }
    __device__ __forceinline__ unsigned arow(const pg8::Unit& u, int r) const { return (unsigned)(u.pm * 256 + r); }
};
struct UpOrder {
    static constexpr bool GATHER = false;
    const char* A0; const char* A1; const char* B0; const char* B1; int G, c;
    __device__ __forceinline__ bool next(int i, pg8::Unit& u) const {
        const int tile = (i >> 1) * G + c; if (tile >= 256) return false;
        u.pm = tile >> 2; u.pn = tile & 3; u.aux = i & 1;
        u.A = (i & 1) ? A1 : A0; u.B = ((i & 1) ? B1 : B0) + (size_t)u.pn * 256 * 512 * 2; return true;
    }
    __device__ __forceinline__ unsigned arow(const pg8::Unit& u, int r) const { return (unsigned)(u.pm * 256 + r); }
};
struct MoeTab { int nt; int pad[3]; int tile_e[176]; int tile_m[176]; int cnt[32]; int tbase[33]; };
struct Moe1Order {
    static constexpr bool GATHER = true;
    const LAS MoeTab* tab; const char* A; const char* W; const int* toklist; int G, c;
    __device__ __forceinline__ bool next(int i, pg8::Unit& u) const {
        const int L = i * G + c; if (L >= tab->nt * 4) return false;
        const int ti = L >> 2; u.pm = ti; u.pn = L & 3; u.aux = ti; u.A = A;
        u.B = W + ((size_t)tab->tile_e[ti] * 1024 + (size_t)u.pn * 256) * 1024 * 2; return true;
    }
    __device__ __forceinline__ unsigned arow(const pg8::Unit& u, int r) const {
        const int e = tab->tile_e[u.aux], rr = tab->tile_m[u.aux] * 256 + r;
        return rr < tab->cnt[e] ? (unsigned)toklist[e * T + rr] : 0u;
    }
};
struct Moe2Order {
    static constexpr bool GATHER = false;
    const LAS MoeTab* tab; const char* A; const char* W; int G, c;
    __device__ __forceinline__ bool next(int i, pg8::Unit& u) const {
        const int L = i * G + c; if (L >= tab->nt * 4) return false;
        const int ti = L >> 2; u.pm = ti; u.pn = L & 3; u.aux = ti; u.A = A;
        u.B = W + ((size_t)tab->tile_e[ti] * 1024 + (size_t)u.pn * 256) * 512 * 2; return true;
    }
    __device__ __forceinline__ unsigned arow(const pg8::Unit& u, int r) const { return (unsigned)(u.pm * 256 + r); }
};

using pg8::Unit; using pg8::cvt_pk_bf16;
struct EpiStoreBf16 {
    static constexpr bool PERM = true;
    bf16_t* O; int ldc; int nscale; float scale0;
    __device__ __forceinline__ bool operator()(f32x4 (&acc)[2][2][4][2], const Unit& u, int wr, int wc, int fr, int fq) const {
        const int row0 = u.pm * 256 + wr * 64 + fr, col0 = u.pn * 256 + wc * 32 + 8 * fq;
        const float sc = u.pn < nscale ? scale0 : 1.0f;
#pragma unroll
        for (int ai = 0; ai < 2; ++ai)
#pragma unroll
            for (int m = 0; m < 4; ++m) { bf16_t* rowp = O + (size_t)(row0 + ai * 128 + m * 16) * ldc + col0;
#pragma unroll
                for (int bj = 0; bj < 2; ++bj) { const f32x4 v0 = acc[ai][bj][m][0] * sc, v1 = acc[ai][bj][m][1] * sc;
                    u32x4 w; w.x = cvt_pk_bf16(v0[0], v0[1]); w.y = cvt_pk_bf16(v0[2], v0[3]); w.z = cvt_pk_bf16(v1[0], v1[1]); w.w = cvt_pk_bf16(v1[2], v1[3]);
                    *(u32x4*)(rowp + bj * 128) = w; } }
        return false;
    }
};
struct EpiUp {
    static constexpr bool PERM = true;
    const bf16_t* proj; bf16_t* O;
    __device__ __forceinline__ bool operator()(f32x4 (&acc)[2][2][4][2], const Unit& u, int wr, int wc, int fr, int fq) const {
        const int row0 = u.pm * 256 + wr * 64 + fr, col0 = u.pn * 256 + wc * 32 + 8 * fq;
#pragma unroll
        for (int ai = 0; ai < 2; ++ai)
#pragma unroll
            for (int m = 0; m < 4; ++m) { const size_t row = (size_t)(row0 + ai * 128 + m * 16);
#pragma unroll
                for (int bj = 0; bj < 2; ++bj) {
                    const int col = col0 + bj * 128;
                    const u32x4 gh = *(const u32x4*)(proj + row * INC + C_GHGATE + col);
                    float sh[8];
#pragma unroll
                    for (int j = 0; j < 4; ++j) { sh[2 * j] = 1.0f + __expf(-bf2f(gh[j] & 0xffffu)); sh[2 * j + 1] = 1.0f + __expf(-bf2f(gh[j] >> 16)); }
                    if (u.aux == 0) {
                        const u32x4 gd = *(const u32x4*)(proj + row * INC + C_GDA + col);
#pragma unroll
                        for (int j = 0; j < 4; ++j) {
                            const float d0 = 1.0f + __expf(-bf2f(gd[j] & 0xffffu)), d1 = 1.0f + __expf(-bf2f(gd[j] >> 16));
                            const float r0 = sh[2 * j] / d0, r1 = sh[2 * j + 1] / d1;
                            if (j < 2) { acc[ai][bj][m][0][2 * j] *= r0; acc[ai][bj][m][0][2 * j + 1] *= r1; }
                            else { acc[ai][bj][m][1][2 * j - 4] *= r0; acc[ai][bj][m][1][2 * j - 3] *= r1; }
                        }
                    } else {
                        const f32x4 v0 = acc[ai][bj][m][0], v1 = acc[ai][bj][m][1];
                        u32x4 w; w.x = cvt_pk_bf16(v0[0] / sh[0], v0[1] / sh[1]); w.y = cvt_pk_bf16(v0[2] / sh[2], v0[3] / sh[3]);
                        w.z = cvt_pk_bf16(v1[0] / sh[4], v1[1] / sh[5]); w.w = cvt_pk_bf16(v1[2] / sh[6], v1[3] / sh[7]);
                        *(u32x4*)(O + row * D + col) = w;
                    }
                } }
        return u.aux == 0;
    }
};
struct EpiOut {
    static constexpr bool PERM = false;
    const float* x; const float* mod; float* O;
    __device__ __forceinline__ bool operator()(f32x4 (&acc)[2][2][4][2], const Unit& u, int wr, int wc, int fr, int fq) const {
        const int row0 = u.pm * 256 + wr * 64 + fr, col0 = u.pn * 256 + wc * 32 + 4 * fq;
        const int b = (u.pm * 256) / SEQ;
        f32x4 gt[2][2];
#pragma unroll
        for (int bj = 0; bj < 2; ++bj)
#pragma unroll
            for (int n = 0; n < 2; ++n) gt[bj][n] = *(const f32x4*)(mod + b * 6144 + 2048 + col0 + bj * 128 + n * 16);
#pragma unroll
        for (int ai = 0; ai < 2; ++ai)
#pragma unroll
            for (int m = 0; m < 4; ++m) { const size_t off = (size_t)(row0 + ai * 128 + m * 16) * D + col0;
#pragma unroll
                for (int bj = 0; bj < 2; ++bj)
#pragma unroll
                    for (int n = 0; n < 2; ++n) { const f32x4 xv = *(const f32x4*)(x + off + bj * 128 + n * 16);
                        *(f32x4*)(O + off + bj * 128 + n * 16) = xv + gt[bj][n] * acc[ai][bj][m][n]; } }
        return false;
    }
};
struct EpiMoe1 {
    static constexpr bool PERM = true;
    bf16_t* O;
    __device__ __forceinline__ bool operator()(f32x4 (&acc)[2][2][4][2], const Unit& u, int wr, int wc, int fr, int fq) const {
        const int row0 = u.pm * 256 + wr * 64 + fr, col0 = u.pn * 128 + wc * 32 + 8 * fq;
#pragma unroll
        for (int ai = 0; ai < 2; ++ai)
#pragma unroll
            for (int m = 0; m < 4; ++m) { bf16_t* rowp = O + (size_t)(row0 + ai * 128 + m * 16) * DEXP + col0;
                float h[8];
#pragma unroll
                for (int n = 0; n < 2; ++n)
#pragma unroll
                    for (int e = 0; e < 4; ++e) h[n * 4 + e] = siluf_(acc[ai][0][m][n][e]) * acc[ai][1][m][n][e];
                u32x4 w; w.x = cvt_pk_bf16(h[0], h[1]); w.y = cvt_pk_bf16(h[2], h[3]); w.z = cvt_pk_bf16(h[4], h[5]); w.w = cvt_pk_bf16(h[6], h[7]);
                *(u32x4*)rowp = w; }
        return false;
    }
};

struct Frame { LAS unsigned char* lds; int tid, lane, wave, G, bid; };

__device__ __forceinline__ void transpose_item(const float* Wsrc, int ldw, bf16_t* dst, int ldd, LAS float* scr, int lane) {
#pragma unroll 8
    for (int i = 0; i < 32; ++i) { const int kk = 2 * i + (lane >> 5); scr[kk * 33 + (lane & 31)] = Wsrc[(size_t)kk * ldw + (lane & 31)]; }
    asm volatile("s_waitcnt lgkmcnt(0)" ::: "memory");
    const int c = lane & 7;
#pragma unroll
    for (int j = 0; j < 4; ++j) { const int n = (lane >> 3) + 8 * j; const LAS float* s = scr + (8 * c) * 33 + n;
        u32x4 o; o.x = pk2(s[0 * 33], s[1 * 33]); o.y = pk2(s[2 * 33], s[3 * 33]); o.z = pk2(s[4 * 33], s[5 * 33]); o.w = pk2(s[6 * 33], s[7 * 33]);
        *(u32x4*)(dst + (size_t)n * ldd + 8 * c) = o; }
    asm volatile("s_waitcnt lgkmcnt(0)" ::: "memory");
}
__device__ __forceinline__ void transpose_matrix(const Frame& F, const float* W, int K, int N, bf16_t* WT) {
    LAS float* scr = (LAS float*)(F.lds + F.wave * 8448);
    const int gw = F.bid * NWAVES + F.wave, NGW = F.G * NWAVES, nblk = N / 32, items = (K / 64) * nblk;
    for (int it = gw; it < items; it += NGW) { const int kb = it / nblk, nb = it % nblk;
        transpose_item(W + (size_t)(64 * kb) * N + 32 * nb, N, WT + (size_t)(32 * nb) * K + 64 * kb, K, scr, F.lane); }
}

__device__ __forceinline__ void phase0(const Frame& F, const Args& a) {
    unsigned char* ws = a.ws;
    {
        float* modp = (float*)(ws + WS_MODP);
        const float* c = a.in[I_C]; const float* wada = a.in[I_WADA];
        for (int wt = F.bid + 256 * F.wave; wt < 384; wt += 256 * NWAVES) {
            if (F.G != 256) break;
            const int ks = wt / 24, jw = wt % 24, j = jw * 256 + F.lane * 4;
            f32x4 s[4] = {{0, 0, 0, 0}, {0, 0, 0, 0}, {0, 0, 0, 0}, {0, 0, 0, 0}};
            for (int k = ks * 64; k < ks * 64 + 64; ++k) {
                const f32x4 w = *(const f32x4*)(wada + (size_t)k * 6144 + j);
#pragma unroll
                for (int b = 0; b < 4; ++b) { const float cv = siluf_(c[b * D + k]); s[b] += w * cv; }
            }
#pragma unroll
            for (int b = 0; b < 4; ++b) *(f32x4*)(modp + ((size_t)ks * 4 + b) * 6144 + j) = s[b];
        }
        if (F.G != 256) {
            const int gw = F.bid * NWAVES + F.wave, NGW = F.G * NWAVES;
            for (int wt = gw; wt < 384; wt += NGW) {
                const int ks = wt / 24, jw = wt % 24, j = jw * 256 + F.lane * 4;
                f32x4 s[4] = {{0, 0, 0, 0}, {0, 0, 0, 0}, {0, 0, 0, 0}, {0, 0, 0, 0}};
                for (int k = ks * 64; k < ks * 64 + 64; ++k) {
                    const f32x4 w = *(const f32x4*)(wada + (size_t)k * 6144 + j);
#pragma unroll
                    for (int b = 0; b < 4; ++b) { const float cv = siluf_(c[b * D + k]); s[b] += w * cv; }
                }
#pragma unroll
                for (int b = 0; b < 4; ++b) *(f32x4*)(modp + ((size_t)ks * 4 + b) * 6144 + j) = s[b];
            }
        }
    }
    transpose_matrix(F, a.in[I_WIN], D, INC, (bf16_t*)(ws + WS_WIN));
    transpose_matrix(F, a.in[I_WUPDA], 512, D, (bf16_t*)(ws + WS_WUPDA));
    transpose_matrix(F, a.in[I_WUPHG], 512, D, (bf16_t*)(ws + WS_WUPHG));
    transpose_matrix(F, a.in[I_WOUT], D, D, (bf16_t*)(ws + WS_WOUT));
    if (F.bid == 0) {
        float* sm = (float*)(ws + WS_SMALL);
        if (F.tid == 0) {
            float s1 = 0.f, s2 = 0.f;
            for (int i = 0; i < 64; ++i) { s1 += a.in[I_LQ1][i] * a.in[I_LK1][i]; s2 += a.in[I_LQ2][i] * a.in[I_LK2][i]; }
            sm[0] = expf(s1) - expf(s2) + 0.2f;
        }
        { const float l0 = a.in[I_LBL][F.tid], l1 = a.in[I_LBL][512 + F.tid]; const float mx = fmaxf(l0, l1);
          const float e0 = expf(l0 - mx), e1 = expf(l1 - mx); sm[16 + F.tid] = e0 / (e0 + e1); }
    }
}
__device__ __forceinline__ void moe_weight_convert(const Frame& F, const Args& a) {
    LAS float* scr = (LAS float*)(F.lds + F.wave * 8448);
    const int gw = F.bid * NWAVES + F.wave, NGW = F.G * NWAVES;
    bf16_t* w13 = (bf16_t*)(a.ws + WS_W13); bf16_t* w2t = (bf16_t*)(a.ws + WS_W2);
    for (int it = gw; it < 2 * NEXP * 256; it += NGW) {
        const int which = it / (NEXP * 256), r = it % (NEXP * 256), e = r >> 8, kb = (r >> 4) & 15, nb = r & 15, n0 = 32 * nb;
        const float* W = a.in[which ? I_W3 : I_W1] + (size_t)e * 1024 * 512;
        const int drow = 256 * (n0 >> 7) + (which ? 128 : 0) + (n0 & 127);
        transpose_item(W + (size_t)(64 * kb) * 512 + n0, 512, w13 + ((size_t)e * 1024 + drow) * 1024 + 64 * kb, 1024, scr, F.lane);
    }
    for (int it = gw; it < NEXP * 256; it += NGW) {
        const int e = it >> 8, kb = (it >> 5) & 7, nb = it & 31;
        const float* W = a.in[I_W2] + (size_t)e * 512 * 1024;
        transpose_item(W + (size_t)(64 * kb) * 1024 + 32 * nb, 1024, w2t + ((size_t)e * 1024 + 32 * nb) * 512 + 64 * kb, 512, scr, F.lane);
    }
}

__device__ __forceinline__ void phase1(const Frame& F, const Args& a) {
    const float* modp = (const float*)(a.ws + WS_MODP); float* mod = (float*)(a.ws + WS_MOD);
    for (int i = F.bid * NTHR + F.tid; i < 4 * 6144; i += F.G * NTHR) {
        float s = a.in[I_BADA][i % 6144];
        for (int ks = 0; ks < 16; ++ks) s += modp[(size_t)ks * 4 * 6144 + i];
        mod[i] = s;
    }
    LAS float* Gs = (LAS float*)F.lds;
    LAS float* Ss = Gs + 1024;
    bf16_t* H = (bf16_t*)(a.ws + WS_ACT);
    const int rows_per_blk = T / F.G;
    const int r0 = F.bid * rows_per_blk, b = r0 / SEQ;
    for (int k = F.tid; k < 1024; k += NTHR) {
        float sh = a.in[I_BADA][k], sc = a.in[I_BADA][1024 + k];
        for (int ks = 0; ks < 16; ++ks) { sh += modp[((size_t)ks * 4 + b) * 6144 + k]; sc += modp[((size_t)ks * 4 + b) * 6144 + 1024 + k]; }
        Gs[k] = a.in[I_N1G][k] * (1.0f + sc); Ss[k] = sh;
    }
    __syncthreads();
    for (int r = r0 + F.wave; r < r0 + rows_per_blk; r += NWAVES) {
        const f32x4* xr = (const f32x4*)(a.in[I_X] + (size_t)r * D) + F.lane;
        f32x4 v[4]; float s = 0.f;
#pragma unroll
        for (int j = 0; j < 4; ++j) { v[j] = xr[64 * j]; s += (v[j].x * v[j].x + v[j].y * v[j].y) + (v[j].z * v[j].z + v[j].w * v[j].w); }
        const float rs = rsqrtf(wave_sum(s) * (1.0f / D) + EPS);
        unsigned long long* o8 = (unsigned long long*)(H + (size_t)r * D) + F.lane;
#pragma unroll
        for (int j = 0; j < 4; ++j) { const f32x4 g = *(const LAS f32x4*)(Gs + 256 * j + 4 * F.lane), sh = *(const LAS f32x4*)(Ss + 256 * j + 4 * F.lane);
            const f32x4 h = v[j] * rs * g + sh;
            o8[64 * j] = (unsigned long long)pk2(h.x, h.y) | ((unsigned long long)pk2(h.z, h.w) << 32); }
    }
}

namespace attn_body {
using s16x4=__attribute__((ext_vector_type(4)))short;
using f32x16=__attribute__((ext_vector_type(16)))float;
constexpr int NW=8,QBLK=32,QB=QBLK*NW,KVBLK=64,NQB=SEQ/QB;
constexpr int PIN=INC, POUT=1024;
__device__ __forceinline__ int crow(int r,int hi){return (r&3)+8*(r>>2)+4*hi;}
#define SBAR() __builtin_amdgcn_sched_barrier(0)
__device__ __forceinline__ void bmask(f32x16&p0,f32x16&p1,int jb,int wch,int il,int hi,float s2x2){
  if(jb>wch){
    #pragma unroll
    for(int r=0;r<16;++r){p0[r]=-INFINITY;p1[r]=-INFINITY;}
  } else if(jb==wch){
    float fb=(float)(4*hi-il); asm volatile("":"+v"(fb));
    #pragma unroll
    for(int r=0;r<16;++r){const float c=(float)((r&3)+8*(r>>2)); p0[r]-=s2x2*__builtin_fmaxf(fb+c,0.f); p1[r]-=s2x2*__builtin_fmaxf(fb+(c+32.f),0.f);}
  }
}
constexpr int NSLOT=3, SLOTB=8192;
constexpr int LDS_K=0, LDS_V=NSLOT*SLOTB, LDS_WS=2*NSLOT*SLOTB, LDS_OST=LDS_WS+NW*64*4, ATT_LDS_BYTES=LDS_OST+NW*4096;
constexpr float C2=0.125f*1.4426950408889634f;
__device__ __forceinline__ void glds16(const void*gsrc,unsigned lds_dst){unsigned keep;
  asm volatile("s_mov_b32 %0, m0\n\ts_mov_b32 m0, %2\n\ts_nop 0\n\tglobal_load_lds_dwordx4 %1, off\n\ts_mov_b32 m0, %0":"=&s"(keep):"v"(gsrc),"s"(lds_dst):"memory");}
__device__ __forceinline__ float max3f(float a,float b,float c){float r;asm("v_max3_f32 %0, %1, %2, %3":"=v"(r):"v"(a),"v"(b),"v"(c));return r;}
__device__ __forceinline__ float max2f(float a,float b){float r;asm("v_max_f32_e32 %0, %1, %2":"=v"(r):"v"(a),"v"(b));return r;}
__device__ __forceinline__ float fadd_s(float a,float b){float r;asm("v_add_f32_e32 %0, %1, %2":"=v"(r):"v"(a),"v"(b));return r;}
__device__ __forceinline__ float fsub_s(float a,float b){float r;asm("v_sub_f32_e32 %0, %1, %2":"=v"(r):"v"(a),"v"(b));return r;}
typedef float f32x2_t __attribute__((ext_vector_type(2))); typedef __bf16 bf16x2_t __attribute__((ext_vector_type(2)));
__device__ __forceinline__ unsigned cvtpk_s(float lo,float hi){f32x2_t v={lo,hi};bf16x2_t b=__builtin_convertvector(v,bf16x2_t);return __builtin_bit_cast(unsigned,b);}
#define WAIT_BAR(N) asm volatile("s_waitcnt vmcnt(" #N ") lgkmcnt(0)\n\ts_barrier":::"memory")

__device__ __forceinline__ void qkt(f32x16&p0,f32x16&p1,const char*Kslot,const bf16x8*qr,const f32x16&c0,const f32x16&c1,int r32,int hi){
  const char*kb=Kslot+hi*1024+r32*16;
  #pragma unroll
  for(int d0=0;d0<4;++d0){
    const bf16x8 b0=*reinterpret_cast<const bf16x8*>(kb+d0*2048);
    const bf16x8 b1=*reinterpret_cast<const bf16x8*>(kb+d0*2048+512);
    if(d0==0){p0=__builtin_amdgcn_mfma_f32_32x32x16_bf16(b0,qr[0],c0,0,0,0);p1=__builtin_amdgcn_mfma_f32_32x32x16_bf16(b1,qr[0],c1,0,0,0);}
    else{p0=__builtin_amdgcn_mfma_f32_32x32x16_bf16(b0,qr[d0],p0,0,0,0);p1=__builtin_amdgcn_mfma_f32_32x32x16_bf16(b1,qr[d0],p1,0,0,0);}}
}
typedef __attribute__((address_space(3))) const char* lds_cptr;
typedef short v4i16_t __attribute__((ext_vector_type(4)));
__device__ __forceinline__ void kload8(bf16x8*kf,lds_cptr kp){
  kf[0]=*(const __attribute__((address_space(3))) bf16x8*)(kp);      kf[1]=*(const __attribute__((address_space(3))) bf16x8*)(kp+512);
  kf[2]=*(const __attribute__((address_space(3))) bf16x8*)(kp+2048); kf[3]=*(const __attribute__((address_space(3))) bf16x8*)(kp+2560);
  kf[4]=*(const __attribute__((address_space(3))) bf16x8*)(kp+4096); kf[5]=*(const __attribute__((address_space(3))) bf16x8*)(kp+4608);
  kf[6]=*(const __attribute__((address_space(3))) bf16x8*)(kp+6144); kf[7]=*(const __attribute__((address_space(3))) bf16x8*)(kp+6656);
}
__device__ __forceinline__ void kload2(bf16x8*kf,lds_cptr kp,int j){ kf[2*j]=*(const __attribute__((address_space(3))) bf16x8*)(kp+j*2048); kf[2*j+1]=*(const __attribute__((address_space(3))) bf16x8*)(kp+j*2048+512); }
__device__ __forceinline__ s16x4 vtr(lds_cptr p){ return __builtin_bit_cast(s16x4,__builtin_amdgcn_ds_read_tr16_b64_v4i16((__attribute__((address_space(3))) v4i16_t*)p)); }
__device__ __forceinline__ float rowmax(const f32x16&p0,const f32x16&p1){
  float a=max3f(p0[0],p0[1],p1[0]),b=max3f(p0[2],p0[3],p1[1]);a=max3f(a,p1[2],p1[3]);
  #pragma unroll
  for(int r=4;r<16;r+=4){a=max3f(a,p0[r],p0[r+1]);b=max3f(b,p0[r+2],p0[r+3]);a=max3f(a,p1[r],p1[r+1]);b=max3f(b,p1[r+2],p1[r+3]);}
  const float m=max2f(a,b);
  auto rr=__builtin_amdgcn_permlane32_swap(__float_as_uint(m),__float_as_uint(m),false,false);
  return max2f(__uint_as_float(rr[0]),__uint_as_float(rr[1]));
}
__device__ __forceinline__ void pv(f32x16*o,int vb,bf16x8 pa0,bf16x8 pa1,bf16x8 pa2,bf16x8 pa3){
  #pragma unroll
  for(int d0=0;d0<2;++d0){s16x4 lo[4],hi[4];
    #pragma unroll
    for(int ks=0;ks<4;++ks){
      asm volatile("ds_read_b64_tr_b16 %0,%1 offset:%c2":"=&v"(lo[ks]):"v"(vb),"i"(d0*4096+ks*1024):"memory");
      asm volatile("ds_read_b64_tr_b16 %0,%1 offset:%c2":"=&v"(hi[ks]):"v"(vb),"i"(d0*4096+ks*1024+512):"memory");}
    asm volatile("s_waitcnt lgkmcnt(0)":::"memory");SBAR();
    #define PK(k) (bf16x8){lo[k][0],lo[k][1],lo[k][2],lo[k][3],hi[k][0],hi[k][1],hi[k][2],hi[k][3]}
    o[d0]=__builtin_amdgcn_mfma_f32_32x32x16_bf16(pa0,PK(0),o[d0],0,0,0);
    o[d0]=__builtin_amdgcn_mfma_f32_32x32x16_bf16(pa1,PK(1),o[d0],0,0,0);
    o[d0]=__builtin_amdgcn_mfma_f32_32x32x16_bf16(pa2,PK(2),o[d0],0,0,0);
    o[d0]=__builtin_amdgcn_mfma_f32_32x32x16_bf16(pa3,PK(3),o[d0],0,0,0);
    #undef PK
  }
}
#define ATTN_STORE16(p,v) (*(u32x4*)(p)=(v))
template<int THRL> __device__ __forceinline__ void attn_unit(int qb,const bf16_t*Qb,const bf16_t*__restrict__ Kh,const bf16_t*__restrict__ Vh,bf16_t*Ob,float slope2,char*shm){
  const int tid=threadIdx.x,lane=tid&63,r32=lane&31,hi=lane>>5; const int wid=__builtin_amdgcn_readfirstlane(tid>>6);
  const int q0=qb*QB;
  const bf16_t*Qw=Qb+(long)(q0+wid*QBLK)*PIN;
  const unsigned lds0=(unsigned)(uintptr_t)shm;
  float*wsf=(float*)(shm+LDS_WS)+wid*64;
  const bf16_t*ksrc=Kh+(long)lane*PIN+wid*8;
  const bf16_t*vsrc=Vh+(long)(16*(wid&3)+(lane>>2))*PIN+(wid>>2)*32+(lane&3)*8;
  const unsigned kdst=lds0+LDS_K+wid*1024, vdst=lds0+LDS_V+wid*1024;
  #define DMA_K(t,slot) glds16(ksrc+(long)(t)*KVBLK*PIN,(unsigned)__builtin_amdgcn_readfirstlane(kdst+(slot)))
  #define DMA_V(t,slot) glds16(vsrc+(long)(t)*KVBLK*PIN,(unsigned)__builtin_amdgcn_readfirstlane(vdst+(slot)))
  const int vb0=(int)(lds0+LDS_V)+((lane>>4)&1)*32+(lane&3)*8+(4*hi+((lane&15)>>2))*64;
  const char*Kbase=shm+LDS_K; bf16x8 kf[8];
  const lds_cptr shm3=(lds_cptr)shm; const lds_cptr kp0=shm3+LDS_K+hi*1024+r32*16; const lds_cptr vp0=shm3+LDS_V+((lane>>4)&1)*32+(lane&3)*8+(4*hi+((lane&15)>>2))*64;
  const int NT=(q0+QB)/KVBLK;
  DMA_K(0,0);DMA_V(0,0);DMA_K(1,SLOTB);
  bf16x8 qr[4];
  #pragma unroll
  for(int d0=0;d0<4;++d0)qr[d0]=*reinterpret_cast<const bf16x8*>(&Qw[(long)r32*PIN+d0*16+hi*8]);
  float mhat=0.f,l_reg=0.f;f32x16 o[2];o[0]=f32x16{};o[1]=f32x16{};
  const float s64=slope2*64.f, s32=slope2*32.f, s2x2=2.f*slope2, s4hi=slope2*4.f*(float)hi;
  const int wch=wid>>1, il=32*(wid&1)+r32;
  #define CMASK(P0,P1,t) do{int jb_=(t)-(NT-4); if(jb_>=0)bmask(P0,P1,jb_,wch,il,hi,s2x2);}while(0)
  #define CINIT0(C0,t) do{ const float bt_=s64*(float)((t)-NT)-mhat+s4hi; _Pragma("unroll") for(int r=0;r<16;++r){C0[r]=__builtin_fmaf(slope2,(float)((r&3)+8*(r>>2)),bt_);} }while(0)
  #define CINIT1(C1,t) do{ const float bu_=s64*(float)((t)-NT)-mhat+s4hi+s32; _Pragma("unroll") for(int r=0;r<16;++r){C1[r]=__builtin_fmaf(slope2,(float)((r&3)+8*(r>>2)),bu_);} }while(0)
  bool resc=false;
  #define START(P0,P1) do{ const float rm=rowmax(P0,P1); resc=false; \
    { const float dl=rm; mhat=fadd_s(mhat,dl); \
      _Pragma("unroll") for(int r=0;r<16;++r){P0[r]=fsub_s(P0[r],dl);P1[r]=fsub_s(P1[r],dl);} } \
    _Pragma("unroll") for(int r=0;r<16;++r)P0[r]=__builtin_amdgcn_exp2f(P0[r]); }while(0)
  #define RESC() do{ if(resc){ asm volatile("s_waitcnt lgkmcnt(0)":::"memory"); \
      _Pragma("unroll") for(int d_=0;d_<2;++d_) _Pragma("unroll") for(int r=0;r<16;++r)o[d_][r]*=wsf[crow(r,hi)]; } }while(0)
  f32x16 pA0,pA1,pB0,pB1;
  int sl_prev=0,sl_cur=0,sl_next=SLOTB;
  #define ROT() do{sl_prev=sl_cur;sl_cur=sl_next;sl_next=(sl_next==(NSLOT-1)*SLOTB)?0:sl_next+SLOTB;}while(0)
  DMA_K(2,2*SLOTB);
  WAIT_BAR(3);
  { f32x16 c0,c1; CINIT0(c0,0); CINIT1(c1,0); qkt(pA0,pA1,Kbase,qr,c0,c1,r32,hi); }
  asm volatile("s_nop 15\n\ts_nop 7":"+v"(pA0),"+v"(pA1));CMASK(pA0,pA1,0);
  START(pA0,pA1);
  _Pragma("unroll") for(int r=0;r<16;++r)pA1[r]=__builtin_amdgcn_exp2f(pA1[r]);
  WAIT_BAR(0);
  DMA_K(3,0);DMA_V(1,SLOTB);
  ROT();
  kload8(kf,kp0+sl_cur);
  WAIT_BAR(2);
  s16x4 vlo[8],vhi[8]; u32x4 pw0,pw1,pw2,pw3;
  #define PKW(P,B) cvtpk_s(P[B],P[B+1])
  #define PAF(k) __builtin_bit_cast(bf16x8,pw##k)
  #define VFR(i) (bf16x8){vlo[i][0],vlo[i][1],vlo[i][2],vlo[i][3],vhi[i][0],vhi[i][1],vhi[i][2],vhi[i][3]}
  #define PIN_(x) asm volatile("":"+v"(x))
  #define MX3(a,b,c) __builtin_fmaxf(__builtin_fmaxf((a),(b)),(c))
  #define GAPA(MF,A0,A1,A2,A3,W0,W1,PW) do{ MF; sacc+=A0; sacc+=A1; sacc+=A2; sacc+=A3; PIN_(sacc); W0; W1; PIN_(PW); SBAR(); }while(0)
  #define EX(v) __builtin_amdgcn_exp2f(v)
  #define GAPB(MF,X,B) do{ MF; X[B]=EX(X[B]); X[B+1]=EX(X[B+1]); X[B+2]=EX(X[B+2]); X[B+3]=EX(X[B+3]); PIN_(X); SBAR(); }while(0)
  #define VRD(i) do{ vlo[i]=vtr(vp_+(((i)>>2)*4096+((i)&3)*1024)); vhi[i]=vtr(vp_+(((i)>>2)*4096+((i)&3)*1024+512)); }while(0)
  #define KRD(G,j) do{ if(G){ kload2(kf,kp0+sl_next,j); SBAR(); } }while(0)
  #define STEP(C0,C1,P0,P1,t,GK,GV,GL) do{ SBAR(); \
    CINIT0(C0,t); SBAR(); \
    const lds_cptr vp_=vp0+sl_prev; \
    VRD(0); SBAR(); float sacc=(P0[0]+P0[1]); \
    GAPA(C0=__builtin_amdgcn_mfma_f32_32x32x16_bf16(kf[0],qr[0],C0,0,0,0), P0[2],P0[3],P0[4],P0[5],     pw0[0]=PKW(P0,0), pw0[1]=PKW(P0,2), pw0); \
    CINIT1(C1,t); VRD(4); SBAR(); GAPA(C1=__builtin_amdgcn_mfma_f32_32x32x16_bf16(kf[1],qr[0],C1,0,0,0), P0[6],P0[7],P0[8],P0[9],     pw0[2]=PKW(P0,4), pw0[3]=PKW(P0,6), pw0); \
    VRD(1); SBAR(); GAPA(C0=__builtin_amdgcn_mfma_f32_32x32x16_bf16(kf[2],qr[1],C0,0,0,0),   P0[10],P0[11],P0[12],P0[13], pw1[0]=PKW(P0,8), pw1[1]=PKW(P0,10), pw1); \
    VRD(5); SBAR(); GAPA(C1=__builtin_amdgcn_mfma_f32_32x32x16_bf16(kf[3],qr[1],C1,0,0,0),   P0[14],P0[15],P1[0],P1[1],   pw1[2]=PKW(P0,12),pw1[3]=PKW(P0,14), pw1); \
    VRD(2); SBAR(); GAPA(C0=__builtin_amdgcn_mfma_f32_32x32x16_bf16(kf[4],qr[2],C0,0,0,0),   P1[2],P1[3],P1[4],P1[5],     pw2[0]=PKW(P1,0), pw2[1]=PKW(P1,2), pw2); \
    VRD(6); SBAR(); GAPA(C1=__builtin_amdgcn_mfma_f32_32x32x16_bf16(kf[5],qr[2],C1,0,0,0),   P1[6],P1[7],P1[8],P1[9],     pw2[2]=PKW(P1,4), pw2[3]=PKW(P1,6), pw2); \
    VRD(3); SBAR(); GAPA(C0=__builtin_amdgcn_mfma_f32_32x32x16_bf16(kf[6],qr[3],C0,0,0,0),   P1[10],P1[11],P1[12],P1[13], pw3[0]=PKW(P1,8), pw3[1]=PKW(P1,10), pw3); \
    VRD(7); SBAR(); GAPA(C1=__builtin_amdgcn_mfma_f32_32x32x16_bf16(kf[7],qr[3],C1,0,0,0),   P1[14],P1[15],0.f,0.f,       pw3[2]=PKW(P1,12),pw3[3]=PKW(P1,14), pw3); \
    l_reg+=sacc; \
    if(GK){DMA_K((t)+3,sl_cur);} if(GV){DMA_V((t)+1,sl_next);} \
    CMASK(C0,C1,t); \
    { float a=MX3(C0[0],C0[1],C1[0]),b=MX3(C0[2],C0[3],C1[1]); a=MX3(a,C1[2],C1[3]); \
      _Pragma("unroll") for(int r=4;r<16;r+=4){a=MX3(a,C0[r],C0[r+1]);b=MX3(b,C0[r+2],C0[r+3]);a=MX3(a,C1[r],C1[r+1]);b=MX3(b,C1[r+2],C1[r+3]);} \
      float rm=__builtin_fmaxf(a,b); { auto rr=__builtin_amdgcn_permlane32_swap(__float_as_uint(rm),__float_as_uint(rm),false,false); rm=__builtin_fmaxf(__uint_as_float(rr[0]),__uint_as_float(rr[1])); } \
      resc=false; \
      if(__builtin_expect(__any(rm>(float)THRL),0)){ const float dl=__builtin_fmaxf(rm,0.f); mhat+=dl; \
        _Pragma("unroll") for(int r=0;r<16;++r){C0[r]-=dl;C1[r]-=dl;} \
        const float f=__builtin_amdgcn_exp2f(-dl); l_reg*=f; if(hi==0)wsf[r32]=f; resc=true; } } \
    SBAR(); \
    GAPB(o[0]=__builtin_amdgcn_mfma_f32_32x32x16_bf16(PAF(0),VFR(0),o[0],0,0,0), C0,0); \
    GAPB(o[1]=__builtin_amdgcn_mfma_f32_32x32x16_bf16(PAF(0),VFR(4),o[1],0,0,0), C0,4); \
    KRD(GL,0); GAPB(o[0]=__builtin_amdgcn_mfma_f32_32x32x16_bf16(PAF(1),VFR(1),o[0],0,0,0), C0,8); \
    KRD(GL,1); GAPB(o[1]=__builtin_amdgcn_mfma_f32_32x32x16_bf16(PAF(1),VFR(5),o[1],0,0,0), C0,12); \
    KRD(GL,2); GAPB(o[0]=__builtin_amdgcn_mfma_f32_32x32x16_bf16(PAF(2),VFR(2),o[0],0,0,0), C1,0); \
    KRD(GL,3); GAPB(o[1]=__builtin_amdgcn_mfma_f32_32x32x16_bf16(PAF(2),VFR(6),o[1],0,0,0), C1,4); \
    GAPB(o[0]=__builtin_amdgcn_mfma_f32_32x32x16_bf16(PAF(3),VFR(3),o[0],0,0,0), C1,8); \
    GAPB(o[1]=__builtin_amdgcn_mfma_f32_32x32x16_bf16(PAF(3),VFR(7),o[1],0,0,0), C1,12); \
    }while(0)
  int t=1;
  #undef CMASK
  #define CMASK(P0,P1,t) do{}while(0)
  for(;t+5<NT;t+=2){
    STEP(pB0,pB1,pA0,pA1,t,true,true,true);     WAIT_BAR(2); RESC(); ROT();
    STEP(pA0,pA1,pB0,pB1,t+1,true,true,true);   WAIT_BAR(2); RESC(); ROT();
  }
  #undef CMASK
  #define CMASK(P0,P1,t) do{int jb_=(t)-(NT-4); if(jb_>=0)bmask(P0,P1,jb_,wch,il,hi,s2x2);}while(0)
  #define ENDW(tt) do{ if((tt)+3<NT){WAIT_BAR(2);} else if((tt)+2<NT){WAIT_BAR(1);} else {WAIT_BAR(0);} }while(0)
  for(;t+1<NT;t+=2){
    STEP(pB0,pB1,pA0,pA1,t,(t+3<NT),(t+1<NT),(t+1<NT));       ENDW(t);   RESC(); ROT();
    STEP(pA0,pA1,pB0,pB1,t+1,(t+4<NT),(t+2<NT),(t+2<NT));     ENDW(t+1); RESC(); ROT();
  }
  STEP(pB0,pB1,pA0,pA1,NT-1,false,false,false); RESC();
  { float sacc=pB0[0]+pB0[1]; _Pragma("unroll") for(int r=2;r<16;++r)sacc+=pB0[r]; _Pragma("unroll") for(int r=0;r<16;++r)sacc+=pB1[r]; l_reg+=sacc;
    pw0=(u32x4){PKW(pB0,0),PKW(pB0,2),PKW(pB0,4),PKW(pB0,6)};pw1=(u32x4){PKW(pB0,8),PKW(pB0,10),PKW(pB0,12),PKW(pB0,14)};pw2=(u32x4){PKW(pB1,0),PKW(pB1,2),PKW(pB1,4),PKW(pB1,6)};pw3=(u32x4){PKW(pB1,8),PKW(pB1,10),PKW(pB1,12),PKW(pB1,14)};
    SBAR(); pv(o,vb0+sl_cur,PAF(0),PAF(1),PAF(2),PAF(3)); }
  #undef PKW
  #undef PAF
  #undef VFR
  #undef PIN_
  #undef MX3
  #undef GAPA
  #undef GAPB
  #undef EX
  #undef VRD
  #undef KRD
  #undef STEP
  #undef ENDW
  {auto rr=__builtin_amdgcn_permlane32_swap(__float_as_uint(l_reg),__float_as_uint(l_reg),false,false);l_reg=__uint_as_float(rr[0])+__uint_as_float(rr[1]);}
  if(hi==0)wsf[32+r32]=l_reg;asm volatile("s_waitcnt lgkmcnt(0)":::"memory");
  float rli[16];
  #pragma unroll
  for(int r=0;r<16;++r)rli[r]=__builtin_amdgcn_rcpf(wsf[32+crow(r,hi)]);
  bf16_t*Ow=Ob+(long)(q0+wid*QBLK)*POUT;
  { bf16_t*stg=(bf16_t*)(shm+LDS_OST)+wid*2048;
    #pragma unroll
    for(int r=0;r<16;++r){const int orow=crow(r,hi);
      #pragma unroll
      for(int d0=0;d0<2;++d0)stg[orow*64+d0*32+r32]=(bf16_t)f2bf(o[d0][r]*rli[r]);}
    asm volatile("s_waitcnt lgkmcnt(0)":::"memory");
    #pragma unroll
    for(int i=0;i<4;++i){const int row=i*8+(lane>>3),ch=lane&7; const u32x4 v=*(const u32x4*)(stg+row*64+ch*8); ATTN_STORE16(Ow+(long)row*POUT+ch*8,v);} }
  asm volatile("s_waitcnt lgkmcnt(0)\n\ts_barrier":::"memory");
  #undef DMA_K
  #undef DMA_V
  #undef CMASK
  #undef CINIT0
  #undef CINIT1
  #undef START
  #undef RESC
  #undef ROT
}
#undef SBAR
#undef WAIT_BAR
}

__device__ __forceinline__ void attn_phase(const Frame& F, const Args& a) {
    const bf16_t* proj = (const bf16_t*)(a.ws + WS_PROJ); bf16_t* OA = (bf16_t*)(a.ws + WS_OA);
    const int vcu = (F.G % 8 == 0) ? (F.bid % 8) * (F.G / 8) + F.bid / 8 : F.bid;
    for (int i = 0;; ++i) {
        int bvh, qb;
        if (F.G == 256) { if (i >= 4) break; const int s = vcu & 3; bvh = vcu >> 2; qb = (i == 0) ? s : (i == 1) ? 7 - s : (i == 2) ? 8 + s : 15 - s; }
        else { const int u = i * F.G + F.bid; if (u >= 1024) break; bvh = u >> 4; qb = 15 - (u & 15); }
        const int b = bvh >> 4, vh = bvh & 15, h = vh >> 2, map = (vh >> 1) & 1, dvh = vh & 1;
        const bf16_t* base = proj + (size_t)b * SEQ * INC;
        const float slope2 = exp2f(-2.0f * (h + 1)) * 1.4426950408889634f;
        attn_body::attn_unit<8>(qb, base + C_QDA + h * 128 + map * 64, base + C_KDA + h * 128 + map * 64, base + C_VDA + h * 128 + dvh * 64,
                                OA + (size_t)b * SEQ * 1024 + vh * 64, slope2, (char*)F.lds);
    }
}
__device__ __forceinline__ void attn_combine(const Frame& F, const Args& a) {
    const bf16_t* OA = (const bf16_t*)(a.ws + WS_OA); bf16_t* Y = (bf16_t*)(a.ws + WS_YDA);
    const float lam = ((const float*)(a.ws + WS_SMALL))[0];
    const float g0 = a.in[I_SUBG][2 * F.lane] * 0.8f, g1 = a.in[I_SUBG][2 * F.lane + 1] * 0.8f;
    const int gw = F.bid * NWAVES + F.wave, NGW = F.G * NWAVES;
    for (int r = gw; r < T; r += NGW) {
        const unsigned* orow = (const unsigned*)(OA + (size_t)r * 1024); unsigned* yrow = (unsigned*)(Y + (size_t)r * 512);
        unsigned w0[4], w1[4];
#pragma unroll
        for (int h = 0; h < 4; ++h) { w0[h] = orow[h * 128 + F.lane]; w1[h] = orow[h * 128 + 64 + F.lane]; }
#pragma unroll
        for (int h = 0; h < 4; ++h) {
            const float x0 = bf2f(w0[h] & 0xffffu) - lam * bf2f(w1[h] & 0xffffu), x1 = bf2f(w0[h] >> 16) - lam * bf2f(w1[h] >> 16);
            const float rs = rsqrtf(wave_sum(x0 * x0 + x1 * x1) * (1.0f / 128.0f) + EPS);
            yrow[h * 64 + F.lane] = pk2(x0 * rs * g0, x1 * rs * g1);
        }
    }
}
namespace hg {
constexpr int QP = 136;
constexpr int TP = 72;
constexpr int L_SEG = 0, L_QD = 2048, L_KD = L_QD + 64 * QP * 2, L_VT = L_KD + 64 * QP * 2, L_KE = L_VT + 128 * TP * 2, L_SSQ = L_KE + 128 * TP * 2;
__device__ __forceinline__ f32x4 mfma16(bf16x8 a, bf16x8 b, f32x4 c) { return __builtin_amdgcn_mfma_f32_16x16x32_bf16(a, b, c, 0, 0, 0); }
template <int STAGE> __device__ __forceinline__ void prep(const Frame& F, const Args& a, int bh, int n) {
    const bf16_t* proj = (const bf16_t*)(a.ws + WS_PROJ);
    const int b = bh >> 2, h = bh & 3, k = F.tid & 127, seg = F.tid >> 7;
    LAS float* SEG = (LAS float*)(F.lds + L_SEG);
    const bf16_t* pf = proj + ((size_t)b * SEQ + n * 64 + 16 * seg) * INC + h * 128 + k;
    const float lb = ((const float*)(a.ws + WS_SMALL))[16 + h * 128 + k];
    float f[16], c[16]; float run = 0.f;
#pragma unroll
    for (int i = 0; i < 16; ++i) { const float fl = bf2f(pf[(size_t)i * INC + C_FHG]); f[i] = lb + (1.0f - lb) * sigmoidf_(fl); run += __logf(f[i]); c[i] = run; }
    SEG[seg * 128 + k] = run;
    {
        unsigned w[8];
#pragma unroll
        for (int i = 0; i < 8; ++i) w[i] = (unsigned)pf[(size_t)(2 * i) * INC + C_IHG] | ((unsigned)pf[(size_t)(2 * i + 1) * INC + C_IHG] << 16);
        LAS u32x4* vt = (LAS u32x4*)(F.lds + L_VT + (k * TP + 16 * seg) * 2);
        vt[0] = (u32x4){w[0], w[1], w[2], w[3]}; vt[1] = (u32x4){w[4], w[5], w[6], w[7]};
    }
    __syncthreads();
    float pre = 0.f, alast = 0.f;
#pragma unroll
    for (int sg = 0; sg < 4; ++sg) { const float v = SEG[sg * 128 + k]; alast += v; pre += (sg < seg) ? v : 0.f; }
    if (STAGE == 1) {
        unsigned w[8];
#pragma unroll
        for (int i = 0; i < 8; ++i) { const float e0 = (1.0f - f[2 * i]) * __expf(alast - (pre + c[2 * i])), e1 = (1.0f - f[2 * i + 1]) * __expf(alast - (pre + c[2 * i + 1])); w[i] = pk2(e0, e1); }
        LAS u32x4* ke = (LAS u32x4*)(F.lds + L_KE + (k * TP + 16 * seg) * 2);
        ke[0] = (u32x4){w[0], w[1], w[2], w[3]}; ke[1] = (u32x4){w[4], w[5], w[6], w[7]};
        if (seg == 0) ((float*)(a.ws + WS_DEC))[((size_t)bh * 64 + n) * 128 + k] = __expf(alast);
    } else {
        LAS bf16_t* QD = (LAS bf16_t*)(F.lds + L_QD); LAS bf16_t* KD = (LAS bf16_t*)(F.lds + L_KD);
#pragma unroll
        for (int i = 0; i < 16; ++i) { const float A = pre + c[i]; const float q = bf2f(pf[(size_t)i * INC + C_QHG]);
            QD[(16 * seg + i) * QP + k] = (bf16_t)f2bf(siluf_(q) * __expf(A)); KD[(16 * seg + i) * QP + k] = (bf16_t)f2bf((1.0f - f[i]) * __expf(-A)); }
    }
    __syncthreads();
}
__device__ __forceinline__ void stage1_unit(const Frame& F, const Args& a, int unit) {
    const int bh = unit >> 6, n = unit & 63;
    prep<1>(F, a, bh, n);
    const int wk = F.wave >> 1, wv = F.wave & 1, fr = F.lane & 15, fq = F.lane >> 4;
    f32x4 acc[2][4];
#pragma unroll
    for (int i = 0; i < 2; ++i)
#pragma unroll
        for (int j = 0; j < 4; ++j) acc[i][j] = (f32x4){0.f, 0.f, 0.f, 0.f};
#pragma unroll
    for (int s2 = 0; s2 < 2; ++s2) {
        bf16x8 af[2], bv[4];
#pragma unroll
        for (int kt = 0; kt < 2; ++kt) af[kt] = *(const LAS bf16x8*)(F.lds + L_KE + ((32 * wk + 16 * kt + fr) * TP + 32 * s2 + 8 * fq) * 2);
#pragma unroll
        for (int vt = 0; vt < 4; ++vt) bv[vt] = *(const LAS bf16x8*)(F.lds + L_VT + ((64 * wv + 16 * vt + fr) * TP + 32 * s2 + 8 * fq) * 2);
#pragma unroll
        for (int kt = 0; kt < 2; ++kt)
#pragma unroll
            for (int vt = 0; vt < 4; ++vt) acc[kt][vt] = mfma16(af[kt], bv[vt], acc[kt][vt]);
    }
    bf16_t* ds = (bf16_t*)(a.ws + WS_DS) + ((size_t)bh * 64 + n) * 16384;
#pragma unroll
    for (int kt = 0; kt < 2; ++kt)
#pragma unroll
        for (int vt = 0; vt < 4; ++vt) { const int v = 64 * wv + 16 * vt + fr, k = 32 * wk + 16 * kt + 4 * fq;
            u32x2 w; w.x = pk2(acc[kt][vt][0], acc[kt][vt][1]); w.y = pk2(acc[kt][vt][2], acc[kt][vt][3]); *(u32x2*)(ds + v * 128 + k) = w; }
    __syncthreads();
}
__device__ __forceinline__ void stage2_scan(const Frame& F, const Args& a) {
    unsigned* ds = (unsigned*)(a.ws + WS_DS); const float* dec = (const float*)(a.ws + WS_DEC);
    for (int gt = F.bid * NTHR + F.tid; gt < 16 * 8192; gt += F.G * NTHR) {
        const int bh = gt >> 13, e2 = gt & 8191, k = (2 * e2) & 127;
        unsigned* p = ds + (size_t)bh * 64 * 8192 + e2; const float* dp = dec + (size_t)bh * 64 * 128 + k;
        float s0 = 0.f, s1 = 0.f;
#pragma unroll 8
        for (int n = 0; n < 64; ++n) { const unsigned u = p[(size_t)n * 8192]; const f32x2 d = *(const f32x2*)(dp + n * 128);
            p[(size_t)n * 8192] = pk2(s0, s1); s0 = d.x * s0 + bf2f(u & 0xffffu); s1 = d.y * s1 + bf2f(u >> 16); }
    }
}
__device__ __forceinline__ void stage3_unit(const Frame& F, const Args& a, int unit) {
    const int bh = unit >> 6, n = unit & 63, b = bh >> 2, h = bh & 3;
    prep<3>(F, a, bh, n);
    const int tb = F.wave >> 1, vh = F.wave & 1, fr = F.lane & 15, fq = F.lane >> 4;
    bf16x8 qf[4];
#pragma unroll
    for (int ks = 0; ks < 4; ++ks) qf[ks] = *(const LAS bf16x8*)(F.lds + L_QD + ((16 * tb + fr) * QP + 32 * ks + 8 * fq) * 2);
    unsigned pk[4][2];
#pragma unroll
    for (int jt = 0; jt < 4; ++jt) { pk[jt][0] = 0u; pk[jt][1] = 0u;
        if (jt <= tb) { f32x4 sc = (f32x4){0.f, 0.f, 0.f, 0.f};
#pragma unroll
            for (int ks = 0; ks < 4; ++ks) { const bf16x8 kf = *(const LAS bf16x8*)(F.lds + L_KD + ((16 * jt + fr) * QP + 32 * ks + 8 * fq) * 2); sc = mfma16(kf, qf[ks], sc); }
            if (jt == tb) {
#pragma unroll
                for (int r = 0; r < 4; ++r) if (4 * fq + r > fr) sc[r] = 0.f;
            }
            pk[jt][0] = pk2(sc[0], sc[1]); pk[jt][1] = pk2(sc[2], sc[3]); } }
    f32x4 o[4];
#pragma unroll
    for (int vt = 0; vt < 4; ++vt) o[vt] = (f32x4){0.f, 0.f, 0.f, 0.f};
#pragma unroll
    for (int s2 = 0; s2 < 2; ++s2) if (2 * s2 <= tb) {
        const u32x4 aw = (u32x4){pk[2 * s2][0], pk[2 * s2][1], pk[2 * s2 + 1][0], pk[2 * s2 + 1][1]};
        const bf16x8 af = __builtin_bit_cast(bf16x8, aw);
#pragma unroll
        for (int vt = 0; vt < 4; ++vt) { const LAS unsigned char* vrow = F.lds + L_VT + ((64 * vh + 16 * vt + fr) * TP + 32 * s2 + 4 * fq) * 2;
            const u32x2 lo = *(const LAS u32x2*)vrow, hi = *(const LAS u32x2*)(vrow + 32);
            const u32x4 bw = (u32x4){lo.x, lo.y, hi.x, hi.y}; o[vt] = mfma16(af, __builtin_bit_cast(bf16x8, bw), o[vt]); }
    }
    const bf16_t* sst = (const bf16_t*)(a.ws + WS_DS) + ((size_t)bh * 64 + n) * 16384;
#pragma unroll
    for (int ks = 0; ks < 4; ++ks)
#pragma unroll
        for (int vt = 0; vt < 4; ++vt) { const bf16x8 sb = *(const bf16x8*)(sst + (64 * vh + 16 * vt + fr) * 128 + 32 * ks + 8 * fq); o[vt] = mfma16(qf[ks], sb, o[vt]); }
    float ss[4];
#pragma unroll
    for (int r = 0; r < 4; ++r) { float v = 0.f;
#pragma unroll
        for (int vt = 0; vt < 4; ++vt) v += o[vt][r] * o[vt][r];
        v += __shfl_xor(v, 1); v += __shfl_xor(v, 2); v += __shfl_xor(v, 4); v += __shfl_xor(v, 8); ss[r] = v; }
    LAS float* SSQ = (LAS float*)(F.lds + L_SSQ);
    if (fr == 0) {
#pragma unroll
        for (int r = 0; r < 4; ++r) SSQ[(tb * 2 + vh) * 16 + 4 * fq + r] = ss[r]; }
    __syncthreads();
    const size_t t0 = (size_t)b * SEQ + n * 64 + 16 * tb + 4 * fq;
    const bf16_t* gp = (const bf16_t*)(a.ws + WS_PROJ) + t0 * INC + C_GHG + h * 128 + 64 * vh + fr;
    bf16_t* yp = (bf16_t*)(a.ws + WS_YHG) + t0 * 512 + h * 128 + 64 * vh + fr;
#pragma unroll
    for (int r = 0; r < 4; ++r) { const float tot = SSQ[(tb * 2) * 16 + 4 * fq + r] + SSQ[(tb * 2 + 1) * 16 + 4 * fq + r]; const float rs = rsqrtf(tot * (1.0f / 128.0f) + EPS);
#pragma unroll
        for (int vt = 0; vt < 4; ++vt) { const float g = bf2f(gp[(size_t)r * INC + 16 * vt]); const float ng = a.in[I_HGNG][64 * vh + 16 * vt + fr];
            yp[(size_t)r * 512 + 16 * vt] = (bf16_t)f2bf(o[vt][r] * rs * ng * siluf_(g)); } }
    __syncthreads();
}
}

__device__ __forceinline__ void phase_router(const Frame& F, const Args& a) {
    LAS float* Wr = (LAS float*)F.lds;
    for (int i = F.tid; i < 36 * 1024; i += NTHR) { const int o = i >> 10, k = i & 1023; Wr[i] = o < 4 ? a.in[I_WRG][k * 4 + o] : a.in[I_WRE][k * 32 + (o - 4)]; }
    __syncthreads();
    const float* mod = (const float*)(a.ws + WS_MOD);
    const float* x1 = a.out; bf16_t* H2 = (bf16_t*)(a.ws + WS_ACT);
    unsigned* counts = (unsigned*)(a.ws + WS_CTL) + CW_COUNTS; unsigned* tokinfo = (unsigned*)(a.ws + WS_TOKINFO); int* toklist = (int*)(a.ws + WS_TOKLIST);
    const int rows_per_blk = T / F.G, r0 = F.bid * rows_per_blk;
    for (int r = r0 + F.wave; r < r0 + rows_per_blk; r += NWAVES) {
        const int b = r / SEQ;
        const f32x4* xr = (const f32x4*)(x1 + (size_t)r * D) + F.lane;
        f32x4 v[4]; float s = 0.f;
#pragma unroll
        for (int j = 0; j < 4; ++j) { v[j] = xr[64 * j]; s += (v[j].x * v[j].x + v[j].y * v[j].y) + (v[j].z * v[j].z + v[j].w * v[j].w); }
        const float rs = rsqrtf(wave_sum(s) * (1.0f / D) + EPS);
        unsigned long long* o8 = (unsigned long long*)(H2 + (size_t)r * D) + F.lane;
#pragma unroll
        for (int j = 0; j < 4; ++j) { const int k = 256 * j + 4 * F.lane;
            const f32x4 g = *(const f32x4*)(a.in[I_N2G] + k), sc = *(const f32x4*)(mod + b * 6144 + 4 * 1024 + k), sh = *(const f32x4*)(mod + b * 6144 + 3 * 1024 + k);
            v[j] = v[j] * rs * g * (1.0f + sc) + sh;
            o8[64 * j] = (unsigned long long)pk2(v[j].x, v[j].y) | ((unsigned long long)pk2(v[j].z, v[j].w) << 32); }
        float mylg = 0.f;
#pragma unroll 2
        for (int o = 0; o < 36; ++o) { float p = 0.f;
#pragma unroll
            for (int j = 0; j < 4; ++j) { const f32x4 w = *(const LAS f32x4*)(Wr + o * 1024 + 256 * j + 4 * F.lane); p += (v[j].x * w.x + v[j].y * w.y) + (v[j].z * w.z + v[j].w * w.w); }
            p = wave_sum(p); if (F.lane == o) mylg = p; }
        if (F.lane < 4) mylg += a.in[I_BRG][F.lane]; else if (F.lane < 36) mylg += a.in[I_BRE][F.lane - 4];
        float gl[4]; int gi = 0;
#pragma unroll
        for (int o = 0; o < 4; ++o) gl[o] = __shfl(mylg, o);
        float gm = gl[0];
#pragma unroll
        for (int o = 1; o < 4; ++o) if (gl[o] > gm) { gm = gl[o]; gi = o; }
        float gsum = 0.f;
#pragma unroll
        for (int o = 0; o < 4; ++o) gsum += expf(gl[o] - gm);
        const float gp = 1.0f / gsum;
        float el[8];
#pragma unroll
        for (int o = 0; o < 8; ++o) el[o] = __shfl(mylg, 4 + gi * 8 + o);
        int i0 = 0; float m0 = el[0];
#pragma unroll
        for (int o = 1; o < 8; ++o) if (el[o] > m0) { m0 = el[o]; i0 = o; }
        int i1 = -1; float m1 = -INFINITY;
#pragma unroll
        for (int o = 0; o < 8; ++o) if (o != i0 && el[o] > m1) { m1 = el[o]; i1 = o; }
        const float e1 = expf(m1 - m0); const float w0 = gp / (1.0f + e1), w1 = gp * e1 / (1.0f + e1);
        if (F.lane == 0) {
            const int ex0 = gi * 8 + i0, ex1 = gi * 8 + i1;
            const unsigned r0_ = atomicAdd(counts + ex0, 1u), r1_ = atomicAdd(counts + ex1, 1u);
            toklist[ex0 * T + r0_] = r; toklist[ex1 * T + r1_] = r;
            u32x4 t0; t0.x = (unsigned)ex0; t0.y = r0_; t0.z = (unsigned)ex1; t0.w = r1_;
            *(u32x4*)(tokinfo + (size_t)r * 8) = t0;
            tokinfo[(size_t)r * 8 + 4] = __float_as_uint(w0); tokinfo[(size_t)r * 8 + 5] = __float_as_uint(w1);
        }
    }
}
__device__ __forceinline__ void build_moe_tab(const Frame& F, const Args& a, LAS MoeTab* tab) {
    if (F.tid == 0) {
        const unsigned* counts = (const unsigned*)(a.ws + WS_CTL) + CW_COUNTS; int nt = 0;
        for (int e = 0; e < NEXP; ++e) { const int c = (int)__hip_atomic_load(counts + e, __ATOMIC_RELAXED, __HIP_MEMORY_SCOPE_AGENT); tab->cnt[e] = c; tab->tbase[e] = nt;
            const int n = (c + 255) >> 8; for (int m = 0; m < n; ++m) { tab->tile_e[nt] = e; tab->tile_m[nt] = m; ++nt; } }
        tab->tbase[NEXP] = nt; tab->nt = nt;
    }
    __syncthreads();
}
__device__ __forceinline__ void phase_final(const Frame& F, const Args& a, const LAS MoeTab* tab) {
    const float* mod = (const float*)(a.ws + WS_MOD); const unsigned* tokinfo = (const unsigned*)(a.ws + WS_TOKINFO); const bf16_t* Ys = (const bf16_t*)(a.ws + WS_YS);
    const int rows_per_blk = T / F.G, r0 = F.bid * rows_per_blk;
    for (int r = r0 + F.wave; r < r0 + rows_per_blk; r += NWAVES) {
        const int b = r / SEQ;
        const u32x4 ti = *(const u32x4*)(tokinfo + (size_t)r * 8);
        const float w0 = __uint_as_float(tokinfo[(size_t)r * 8 + 4]), w1 = __uint_as_float(tokinfo[(size_t)r * 8 + 5]);
        const size_t s0 = (size_t)tab->tbase[ti.x] * 256 + ti.y, s1 = (size_t)tab->tbase[ti.z] * 256 + ti.w;
        f32x4* xr = (f32x4*)(a.out + (size_t)r * D) + F.lane;
        const u32x2* y0 = (const u32x2*)(Ys + s0 * D) + F.lane; const u32x2* y1 = (const u32x2*)(Ys + s1 * D) + F.lane;
        f32x4 v[4]; float s = 0.f;
#pragma unroll
        for (int j = 0; j < 4; ++j) { const int k = 256 * j + 4 * F.lane;
            const f32x4 gt = *(const f32x4*)(mod + b * 6144 + 5 * 1024 + k); const u32x2 a0 = y0[64 * j], a1 = y1[64 * j];
            f32x4 m; m.x = w0 * bf2f(a0.x & 0xffffu) + w1 * bf2f(a1.x & 0xffffu); m.y = w0 * bf2f(a0.x >> 16) + w1 * bf2f(a1.x >> 16);
            m.z = w0 * bf2f(a0.y & 0xffffu) + w1 * bf2f(a1.y & 0xffffu); m.w = w0 * bf2f(a0.y >> 16) + w1 * bf2f(a1.y >> 16);
            v[j] = xr[64 * j] + gt * m; s += (v[j].x * v[j].x + v[j].y * v[j].y) + (v[j].z * v[j].z + v[j].w * v[j].w); }
        const float rs = rsqrtf(wave_sum(s) * (1.0f / D) + EPS);
#pragma unroll
        for (int j = 0; j < 4; ++j) { const f32x4 g = *(const f32x4*)(a.in[I_FG] + 256 * j + 4 * F.lane); xr[64 * j] = v[j] * rs * g; }
    }
}

#define XB_TMO      128
#define XB_XCNT(j)  (256  + 64 * (j))
#define XB_XSUB(j)  (1280 + 64 * (j))
#define XB_XGEN(j)  (2304 + 64 * (j))
#define XB_TOP      3328
#define XB_TOPGEN   3392
#define XCD_BAR_WORDS 3456
#define XB_SPIN_CAP (1u << 18)
__device__ __forceinline__ unsigned xb_ld(unsigned* p)              { return __hip_atomic_load(p, __ATOMIC_RELAXED, __HIP_MEMORY_SCOPE_AGENT); }
__device__ __forceinline__ unsigned xb_add(unsigned* p, unsigned v) { return __hip_atomic_fetch_add(p, v, __ATOMIC_RELAXED, __HIP_MEMORY_SCOPE_AGENT); }
__device__ __forceinline__ unsigned xb_xcc_id() { return (unsigned)__builtin_amdgcn_s_getreg((3 << 11) | 20) & 0xFu; }
#define XB_SPIN(cond, bar) do { unsigned _sp = 0; while (cond) { __builtin_amdgcn_s_sleep(1); \
    if ((++_sp & 255u) == 0u) { if (xb_ld(&(bar)[XB_TMO])) break; if (_sp > XB_SPIN_CAP) { atomicAdd(&(bar)[XB_TMO], 1u); break; } } } } while (0)
struct XcdBarrier { unsigned* bar; unsigned x; volatile LAS unsigned* st; };
__device__ __forceinline__ XcdBarrier xcd_barrier_post(unsigned* bar, volatile LAS unsigned* st) {
    XcdBarrier b; b.bar = bar; b.x = xb_xcc_id(); b.st = st;
    if (threadIdx.x == 0) (void)xb_add(&bar[XB_XCNT(b.x)], 1u);
    return b;
}
__device__ __forceinline__ void xcd_barrier_complete(unsigned* bar, unsigned x, unsigned& nloc, unsigned& nx) {
    const unsigned G = gridDim.x * gridDim.y * gridDim.z;
    unsigned sum, cnt, mine, sp = 0u;
    for (;;) {
        sum = 0u; cnt = 0u; mine = 0u;
#pragma unroll
        for (unsigned j = 0; j < 16; ++j) { const unsigned c = xb_ld(&bar[XB_XCNT(j)]); sum += c; cnt += (c > 0u) ? 1u : 0u; mine = (j == x) ? c : mine; }
        if (sum == G) break;
        __builtin_amdgcn_s_sleep(1);
        if ((++sp & 255u) == 0u) { if (xb_ld(&bar[XB_TMO])) break; if (sp > XB_SPIN_CAP) { atomicAdd(&bar[XB_TMO], 1u); break; } }
    }
    nloc = mine > 0u ? mine : 1u; nx = cnt > 0u ? cnt : 1u;
}
__device__ __forceinline__ void xcd_barrier(const XcdBarrier& b) {
    asm volatile("s_waitcnt vmcnt(0)" ::: "memory");
    __syncthreads();
    if (threadIdx.x == 0) {
        unsigned* bar = b.bar;
        __builtin_amdgcn_s_waitcnt(0);
        unsigned nloc = b.st[0], nx = b.st[1];
        if (nloc == 0u) { xcd_barrier_complete(bar, b.x, nloc, nx); b.st[0] = nloc; b.st[1] = nx; }
        const unsigned old = xb_add(&bar[XB_XSUB(b.x)], 1u);
        const unsigned gen = old / nloc;
        if (old + 1u == (gen + 1u) * nloc) {
            __builtin_amdgcn_fence(__ATOMIC_RELEASE, "agent");
            asm volatile("s_waitcnt vmcnt(0)" ::: "memory");
            const unsigned og = xb_add(&bar[XB_TOP], 1u);
            const unsigned tg = og / nx;
            if (og + 1u == (tg + 1u) * nx) xb_add(&bar[XB_TOPGEN], 1u);
            else XB_SPIN(xb_ld(&bar[XB_TOPGEN]) == tg, bar);
            __builtin_amdgcn_fence(__ATOMIC_ACQUIRE, "agent");
            xb_add(&bar[XB_XGEN(b.x)], 1u);
            asm volatile("s_waitcnt vmcnt(0)" ::: "memory");
        } else {
            XB_SPIN(xb_ld(&bar[XB_XGEN(b.x)]) == gen, bar);
            __builtin_amdgcn_fence(__ATOMIC_ACQUIRE, "agent");
            asm volatile("s_waitcnt vmcnt(0)" ::: "memory");
        }
    }
    __syncthreads();
}

constexpr int N_PHASES = 12;
__global__ void __launch_bounds__(NTHR, 2) mk_fwd(Args a) {
    extern __shared__ __attribute__((aligned(16))) unsigned char lds_raw[];
    Frame F; F.lds = (LAS unsigned char*)lds_raw; F.tid = threadIdx.x; F.lane = F.tid & 63; F.wave = __builtin_amdgcn_readfirstlane(F.tid >> 6); F.G = gridDim.x; F.bid = blockIdx.x;
    unsigned char* ws = a.ws;
    const int lo = a.ph_lo, hi = a.ph_hi;
#if MK_N_LAUNCHES == 1
    volatile LAS unsigned* MISC = (volatile LAS unsigned*)(F.lds + 152 * 1024);
    if (F.tid < 4) MISC[F.tid] = 0u;
    __syncthreads();
    XcdBarrier xbar = xcd_barrier_post((unsigned*)(ws + WS_CTL) + CW_BAR, MISC);
#define SEAM(k) do { if (IN(k) && IN((k) + 1)) xcd_barrier(xbar); } while (0)
#else
#define SEAM(k) do { } while (0)
#endif
#ifndef PHASE_MASK
#define PHASE_MASK 0xfff
#endif
#define IN(k) (((PHASE_MASK >> (k)) & 1) && lo <= (k) && (k) < hi)
    LAS MoeTab* tab = (LAS MoeTab*)(F.lds + 144 * 1024);

#ifndef REPEAT_PHASE
#define REPEAT_PHASE -1
#endif
#if MK_N_LAUNCHES == 1
#define RUNPH(k, ...) if (IN(k)) { __VA_ARGS__ if (REPEAT_PHASE == (k)) { xcd_barrier(xbar); __VA_ARGS__ } }
#else
#define RUNPH(k, ...) if (IN(k)) { __VA_ARGS__ }
#endif
    RUNPH(0, { phase0(F, a); }) SEAM(0);
    RUNPH(1, { phase1(F, a); }) SEAM(1);
    RUNPH(2, {
        DenseOrder S{(const char*)(ws + WS_ACT), (const char*)(ws + WS_WIN), D, T / 256, INC / 256, F.G, F.bid};
        EpiStoreBf16 E{(bf16_t*)(ws + WS_PROJ), INC, 2, attn_body::C2};
        pg8::gemm_phase(F.lds, D, S, E);
    }) SEAM(2);
    RUNPH(3, {
        for (int u = F.bid; u < 1024; u += F.G) hg::stage1_unit(F, a, u);
        attn_phase(F, a);
    }) SEAM(3);
    RUNPH(4, { hg::stage2_scan(F, a); attn_combine(F, a); }) SEAM(4);
    RUNPH(5, { for (int u = F.bid; u < 1024; u += F.G) hg::stage3_unit(F, a, u); }) SEAM(5);
    RUNPH(6, {
        UpOrder S{(const char*)(ws + WS_YDA), (const char*)(ws + WS_YHG), (const char*)(ws + WS_WUPDA), (const char*)(ws + WS_WUPHG), F.G, F.bid};
        EpiUp E{(const bf16_t*)(ws + WS_PROJ), (bf16_t*)(ws + WS_ACT)};
        pg8::gemm_phase(F.lds, 512, S, E);
    }) SEAM(6);
    RUNPH(7, {
        DenseOrder S{(const char*)(ws + WS_ACT), (const char*)(ws + WS_WOUT), D, T / 256, D / 256, F.G, F.bid};
        EpiOut E{a.in[I_X], (const float*)(ws + WS_MOD), a.out};
        pg8::gemm_phase(F.lds, D, S, E);
        moe_weight_convert(F, a);
    }) SEAM(7);
    RUNPH(8, { phase_router(F, a); __syncthreads(); }) SEAM(8);
    RUNPH(9, {
        build_moe_tab(F, a, tab);
        Moe1Order S{tab, (const char*)(ws + WS_ACT), (const char*)(ws + WS_W13), (const int*)(ws + WS_TOKLIST), F.G, F.bid};
        EpiMoe1 E{(bf16_t*)(ws + WS_HS)};
        pg8::gemm_phase(F.lds, D, S, E);
    }) SEAM(9);
    RUNPH(10, {
        build_moe_tab(F, a, tab);
        Moe2Order S{tab, (const char*)(ws + WS_HS), (const char*)(ws + WS_W2), F.G, F.bid};
        EpiStoreBf16 E{(bf16_t*)(ws + WS_YS), D, 0, 1.0f};
        pg8::gemm_phase(F.lds, DEXP, S, E);
    }) SEAM(10);
    RUNPH(11, { build_moe_tab(F, a, tab); phase_final(F, a, tab); })
#undef IN
#undef SEAM
}

extern "C" void kernel_launch(void* const* d_in, const int* in_sizes, int n_in, void* d_out, int out_size, void* d_ws, size_t ws_size, hipStream_t stream) {
    static int grid = 0;
    if (grid == 0) {
        if (n_in != 25 || in_sizes[0] != T * D || out_size != T * D || ws_size < WS_END) { fprintf(stderr, "kernel_launch: unexpected shapes (n_in %d, in0 %d, out %d, ws %zu)\n", n_in, n_in > 0 ? in_sizes[0] : -1, out_size, ws_size); grid = -1; return; }
        int dev = 0, cus = 0, per_cu = 0;
        if (hipGetDevice(&dev) != hipSuccess || hipDeviceGetAttribute(&cus, hipDeviceAttributeMultiprocessorCount, dev) != hipSuccess) { grid = -1; return; }
        if (hipFuncSetAttribute((const void*)mk_fwd, hipFuncAttributeMaxDynamicSharedMemorySize, LDS_BYTES) != hipSuccess) { fprintf(stderr, "kernel_launch: hipFuncSetAttribute failed\n"); grid = -1; return; }
        if (hipOccupancyMaxActiveBlocksPerMultiprocessor(&per_cu, (const void*)mk_fwd, NTHR, LDS_BYTES) != hipSuccess || per_cu < 1) { fprintf(stderr, "kernel_launch: occupancy query says %d\n", per_cu); per_cu = 1; }
        (void)hipGetLastError();
        grid = cus;
        if (grid > 256) grid = 256;
        while (T % grid) --grid;
    }
    if (grid < 0) return;
    (void)hipMemsetAsync((char*)d_ws + WS_CTL, 0, CTL_ZERO_BYTES, stream);
    Args a{};
    for (int i = 0; i < 25; ++i) a.in[i] = (const float*)d_in[i];
    a.out = (float*)d_out; a.ws = (unsigned char*)d_ws;
#if MK_N_LAUNCHES == 1
    a.ph_lo = 0; a.ph_hi = N_PHASES;
    void* args[] = {&a};
    hipError_t e = hipLaunchCooperativeKernel((const void*)mk_fwd, dim3(grid), dim3(NTHR), args, LDS_BYTES, stream);
    if (e != hipSuccess) fprintf(stderr, "cooperative launch failed: %s (grid %d)\n", hipGetErrorString(e), grid);
#else
    for (int p = 0; p < N_PHASES; ++p) {
        a.ph_lo = p; a.ph_hi = p + 1;
        hipLaunchKernelGGL(mk_fwd, dim3(grid), dim3(NTHR), LDS_BYTES, stream, a);
    }
#endif
}
```

```cpp
#include <hip/hip_runtime.h>
#include <hip/hip_cooperative_groups.h>
#include <cstdio>
#include <cstdint>
namespace cg = cooperative_groups;

#ifndef MK_N_LAUNCHES
#define MK_N_LAUNCHES 1
#endif

#define LAS __attribute__((address_space(3)))
typedef unsigned short bf16_t;
typedef short bf16x8 __attribute__((ext_vector_type(8)));
typedef float f32x4 __attribute__((ext_vector_type(4)));
typedef float f32x2 __attribute__((ext_vector_type(2)));
typedef unsigned u32x4 __attribute__((ext_vector_type(4)));
typedef unsigned u32x2 __attribute__((ext_vector_type(2)));

constexpr int NB = 4, SEQ = 4096, D = 1024, T = NB * SEQ;
constexpr int INC = 5632;
constexpr int C_QDA = 0, C_KDA = 512, C_VDA = 1024, C_QHG = 1536, C_FHG = 2048, C_IHG = 2560, C_GHG = 3072, C_GDA = 3584, C_GHGATE = 4608;
constexpr int C_HGT = 1536;
constexpr int NEXP = 32, DEXP = 512;
constexpr int PMAX = 40960;
constexpr float EPS = 1e-6f;
constexpr int NWAVES = 8, NTHR = 512;

constexpr size_t MiB = 1u << 20;
constexpr size_t WS_CTL = 0, CTL_ZERO_BYTES = 64 * 1024;
constexpr size_t WS_MODP = 1 * MiB;
constexpr size_t WS_MOD = 5 * MiB / 2;
constexpr size_t WS_SMALL = 11 * MiB / 4;
constexpr size_t WS_TOKINFO = 3 * MiB;
constexpr size_t WS_TOKLIST = 4 * MiB;
constexpr size_t WS_DEC = 6 * MiB;
constexpr size_t WS_DS = 24 * MiB;
constexpr size_t WS_WIN = 8 * MiB;
constexpr size_t WS_WUPDA = 20 * MiB, WS_WUPHG = 21 * MiB, WS_WOUT = 22 * MiB;
constexpr size_t WS_ACT = 24 * MiB;
constexpr size_t WS_PROJ = 56 * MiB;
constexpr size_t WS_YDA = 232 * MiB, WS_YHG = 248 * MiB;
constexpr size_t WS_OA = 264 * MiB;
constexpr size_t WS_W13 = 56 * MiB;
constexpr size_t WS_W2 = 120 * MiB;
constexpr size_t WS_HS = 152 * MiB;
constexpr size_t WS_YS = 192 * MiB;
constexpr size_t WS_END = 296 * MiB;
constexpr int CW_COUNTS = 64;
constexpr int CW_BAR = 4096;

constexpr int LDS_BYTES = 160 * 1024;

__device__ __forceinline__ float bf2f(unsigned v) { return __uint_as_float(v << 16); }
__device__ __forceinline__ unsigned f2bf(float f) { unsigned u = __float_as_uint(f); return (u + 0x7fffu + ((u >> 16) & 1u)) >> 16; }
__device__ __forceinline__ unsigned pk2(float lo, float hi) { return f2bf(lo) | (f2bf(hi) << 16); }
__device__ __forceinline__ float sigmoidf_(float x) { return 1.0f / (1.0f + __expf(-x)); }
__device__ __forceinline__ float siluf_(float x) { return x / (1.0f + __expf(-x)); }
__device__ __forceinline__ int lane_now() { int l; asm volatile("v_mbcnt_lo_u32_b32 %0, -1, 0\n\tv_mbcnt_hi_u32_b32 %0, -1, %0" : "=v"(l)); return l; }
__device__ __forceinline__ float wave_sum(float v) {
#pragma unroll
    for (int o = 1; o < 64; o <<= 1) v += __shfl_xor(v, o);
    return v;
}

namespace pg8 {
constexpr int BM = 256, BK = 64, HALF = 128, HTB = HALF * BK * 2, STAGE_BYTES = 8 * HTB;
__host__ __device__ __forceinline__ int lds_byte(int r, int c) { const int st = (r >> 4) * 2 + (c >> 5), rr = r & 15, cc = c & 31, ob = rr * 64 + cc * 2; return st * 1024 + (ob ^ (((ob >> 9) & 1) << 5)); }
__host__ __device__ __forceinline__ void stage_rc(int b, int& R, int& C) { const int st = b / 1024, sb = b % 1024, swz = sb ^ (((sb >> 9) & 1) << 5); R = (st >> 1) * 16 + swz / 64; C = (st & 1) * 32 + (swz % 64) / 2; }
__host__ __device__ __forceinline__ int perm32(int rho) { const int n = rho >> 4, i = rho & 15; return 8 * (i >> 2) + 4 * n + (i & 3); }

struct Unit { int pm, pn; const char* A; const char* B; int aux; };
__device__ __forceinline__ unsigned cvt_pk_bf16(float lo, float hi) { unsigned r; asm volatile("v_cvt_pk_bf16_f32 %0, %1, %2" : "=v"(r) : "v"(lo), "v"(hi)); return r; }

template <class Epi, class Sched>
__device__ __forceinline__ void gemm_phase(LAS unsigned char* lds, const int K, const Sched& S, const Epi& E) {
    const int tid = threadIdx.x, wid = __builtin_amdgcn_readfirstlane(tid >> 6), lane = tid & 63, wr = wid >> 2, wc = wid & 3, fr = lane & 15, fq = lane >> 4;
    const int nt = K / BK;
    unsigned voffB[2];
#pragma unroll
    for (int i = 0; i < 2; ++i) { int R, C; stage_rc(tid * 16 + i * 8192, R, C); const int Rb = Epi::PERM ? ((R & ~31) + perm32(R & 31)) : R;
        voffB[i] = (unsigned)(Rb * K + C) * 2u; }
    const size_t kstep = (size_t)(BK * 2);
    const size_t hstep = (size_t)HALF * K * 2;
    const unsigned ldsw = (unsigned)wid * 1024u;
    const int aoff = lds_byte(wr * 64 + fr, fq * 8), boff = lds_byte(wc * 32 + fr, fq * 8);
#define PG8_SA(b, h) (((b) * 2 + (h)) * HTB)
#define PG8_SB(b, h) ((4 + (b) * 2 + (h)) * HTB)
#define PG8_STAGE(bufoff, gbase, voff) do { _Pragma("unroll") for (int _i = 0; _i < 2; ++_i) \
        __builtin_amdgcn_global_load_lds((const unsigned*)((const char*)(gbase) + (voff)[_i]), (LAS unsigned*)(lds + (bufoff) + ldsw + _i * 8192), 16, 0, 0); } while (0)
#define PG8_LDA(dst, b, h) do { _Pragma("unroll") for (int m = 0; m < 4; ++m) _Pragma("unroll") for (int k = 0; k < 2; ++k) dst[m][k] = *(const LAS bf16x8*)(lds + PG8_SA(b, h) + aoff + m * 2048 + k * 1024); } while (0)
#define PG8_LDB(dst, b, h) do { _Pragma("unroll") for (int n = 0; n < 2; ++n) _Pragma("unroll") for (int k = 0; k < 2; ++k) dst[n][k] = *(const LAS bf16x8*)(lds + PG8_SB(b, h) + boff + n * 2048 + k * 1024); } while (0)
#define PG8_MMA(ai, bj, At, Bt) do { __builtin_amdgcn_s_setprio(1); _Pragma("unroll") for (int m = 0; m < 4; ++m) _Pragma("unroll") for (int n = 0; n < 2; ++n) _Pragma("unroll") for (int k = 0; k < 2; ++k) \
        acc[ai][bj][m][n] = __builtin_amdgcn_mfma_f32_16x16x32_bf16(Bt[n][k], At[m][k], acc[ai][bj][m][n], 0, 0, 0); __builtin_amdgcn_s_setprio(0); } while (0)
#define PG8_WAIT_V(n) asm volatile("s_waitcnt vmcnt(" #n ")" ::: "memory")
#define PG8_WAIT_L(n) asm volatile("s_waitcnt lgkmcnt(" #n ")" ::: "memory")
#define PG8_BAR __builtin_amdgcn_s_barrier()
#define PG8_SCHED __builtin_amdgcn_sched_barrier(0)
#define PG8_SETA(vo, u) do { const int _t = wid * 64 + lane_now(); _Pragma("unroll") for (int _i = 0; _i < 2; ++_i) { int _R, _C; stage_rc(_t * 16 + _i * 8192, _R, _C); \
        _Pragma("unroll") for (int _h = 0; _h < 2; ++_h) vo[_h][_i] = (unsigned)((size_t)S.arow(u, _h * HALF + _R) * (size_t)K + _C) * 2u; } if (Sched::GATHER) PG8_WAIT_V(0); } while (0)
    Unit cur, nxt; int ui = 0;
    if (!S.next(0, cur)) return;
    f32x4 acc[2][2][4][2];
#pragma unroll
    for (int a = 0; a < 2; ++a)
#pragma unroll
        for (int b = 0; b < 2; ++b)
#pragma unroll
            for (int m = 0; m < 4; ++m)
#pragma unroll
                for (int n = 0; n < 2; ++n) acc[a][b][m][n] = (f32x4){0.f, 0.f, 0.f, 0.f};
    bf16x8 At[4][2], B0[2][2], B1[2][2];
    unsigned voC[2][2], voN[2][2];
    PG8_SETA(voC, cur);
    const char* cA = cur.A; const char* cB = cur.B;
    PG8_STAGE(PG8_SB(0, 0), cB, voffB); PG8_STAGE(PG8_SB(0, 1), cB + hstep, voffB); PG8_STAGE(PG8_SA(0, 0), cA, voC[0]); PG8_STAGE(PG8_SA(0, 1), cA, voC[1]);
    if (wr == 1) PG8_BAR;
    PG8_WAIT_V(2); PG8_BAR;
    PG8_STAGE(PG8_SB(1, 0), cB + kstep, voffB); PG8_STAGE(PG8_SA(1, 0), cA + kstep, voC[0]); PG8_STAGE(PG8_SB(1, 1), cB + hstep + kstep, voffB);
    PG8_WAIT_V(6); PG8_BAR;
    for (;;) {
        const bool has_next = S.next(ui + 1, nxt);
        if (has_next) { PG8_SETA(voN, nxt); }
        else {
#pragma unroll
            for (int h = 0; h < 2; ++h)
#pragma unroll
                for (int i = 0; i < 2; ++i) voN[h][i] = voC[h][i];
        }
        const char* nA = has_next ? nxt.A : cA; const char* nB = has_next ? nxt.B : cB;
        for (int t = 0; t < nt; t += 2) {
            const bool last = (t == nt - 2);
            const char* a1 = cA + (size_t)(t + 1) * kstep;
            const char* a2 = last ? nA : cA + (size_t)(t + 2) * kstep; const char* b2 = last ? nB : cB + (size_t)(t + 2) * kstep;
            const char* a3 = a2 + kstep; const char* b3 = b2 + kstep;
            unsigned vo2[2][2];
#pragma unroll
            for (int h = 0; h < 2; ++h)
#pragma unroll
                for (int i = 0; i < 2; ++i) vo2[h][i] = last ? voN[h][i] : voC[h][i];
            PG8_LDB(B0, 0, 0); PG8_LDB(B1, 0, 1); PG8_SCHED; PG8_LDA(At, 0, 0); PG8_STAGE(PG8_SA(1, 1), a1, voC[1]);
            PG8_WAIT_V(8); PG8_WAIT_L(0); PG8_BAR; PG8_MMA(0, 0, At, B0); PG8_MMA(0, 1, At, B1); PG8_BAR; PG8_SCHED;
            PG8_LDA(At, 0, 1); PG8_STAGE(PG8_SB(0, 0), b2, voffB); PG8_STAGE(PG8_SB(0, 1), b2 + hstep, voffB); PG8_STAGE(PG8_SA(0, 0), a2, vo2[0]);
            PG8_WAIT_V(8); PG8_WAIT_L(0); PG8_BAR; PG8_MMA(1, 0, At, B0); PG8_MMA(1, 1, At, B1); PG8_BAR; PG8_SCHED;
            PG8_LDB(B0, 1, 0); PG8_LDB(B1, 1, 1); PG8_SCHED; PG8_LDA(At, 1, 0); PG8_STAGE(PG8_SA(0, 1), a2, vo2[1]);
            PG8_WAIT_V(8); PG8_WAIT_L(0); PG8_BAR; PG8_MMA(0, 0, At, B0); PG8_MMA(0, 1, At, B1); PG8_BAR; PG8_SCHED;
            PG8_LDA(At, 1, 1); PG8_STAGE(PG8_SB(1, 0), b3, voffB); PG8_STAGE(PG8_SB(1, 1), b3 + hstep, voffB); PG8_STAGE(PG8_SA(1, 0), a3, vo2[0]);
            PG8_WAIT_V(8); PG8_WAIT_L(0); PG8_BAR; PG8_MMA(1, 0, At, B0); PG8_MMA(1, 1, At, B1); PG8_BAR; PG8_SCHED;
        }
        if (wr == 0) PG8_BAR;
        const bool keep = E(acc, cur, wr, wc, fr, fq);
        if (!has_next) break;
        if (!keep) {
#pragma unroll
            for (int a = 0; a < 2; ++a)
#pragma unroll
                for (int b = 0; b < 2; ++b)
#pragma unroll
                    for (int m = 0; m < 4; ++m)
#pragma unroll
                        for (int n = 0; n < 2; ++n) acc[a][b][m][n] = (f32x4){0.f, 0.f, 0.f, 0.f};
        }
        cur = nxt; cA = nA; cB = nB; ++ui;
        if (Sched::GATHER) {
#pragma unroll
            for (int h = 0; h < 2; ++h)
#pragma unroll
                for (int i = 0; i < 2; ++i) voC[h][i] = voN[h][i];
        } else { PG8_SETA(voC, cur); }
        if (wr == 1) PG8_BAR;
    }
    PG8_WAIT_V(0);
    PG8_BAR;
#undef PG8_SA
#undef PG8_SB
#undef PG8_STAGE
#undef PG8_LDA
#undef PG8_LDB
#undef PG8_MMA
#undef PG8_WAIT_V
#undef PG8_WAIT_L
#undef PG8_BAR
#undef PG8_SCHED
#undef PG8_SETA
}
}

struct Args { const float* in[25]; float* out; unsigned char* ws; int ph_lo, ph_hi; };
enum { I_X = 0, I_C, I_WADA, I_BADA, I_N1G, I_WIN, I_LQ1, I_LK1, I_LQ2, I_LK2, I_SUBG, I_LBL, I_HGNG, I_WUPDA, I_WUPHG, I_WOUT, I_N2G, I_WRG, I_BRG, I_WRE, I_BRE, I_W1, I_W3, I_W2, I_FG };

struct DenseOrder {
    static constexpr bool GATHER = false;
    const char* A; const char* Bt; int K, nM, nN, G, c;
    __device__ __forceinline__ bool next(int i, pg8::Unit& u) const {
        const int L = i * G + c, nwg = nM * nN; if (L >= nwg) return false;
        int wgid = L; { const int q = nwg / 8, r = nwg % 8, xcd = wgid % 8, off = wgid / 8; wgid = (xcd < r ? xcd * (q + 1) : r * (q + 1) + (xcd - r) * q) + off; }
        const int nig = 8 * nN, gid = wgid / nig, fm = gid * 8, gsz = (nM - fm) < 8 ? (nM - fm) : 8;
        u.pm = fm + ((wgid % nig) % gsz); u.pn = (wgid % nig) / gsz; u.A = A; u.B = Bt + (size_t)u.pn * 256 * K * 2; u.aux = 0; return true;
    }
    __device__ __forceinline__ unsigned arow(const pg8::Unit& u, int r) const { return (unsigned)(u.pm * 256 + r); }
};
struct InProjOrder {
    static constexpr bool GATHER = false;
    const char* A; const char* Bt; int G, c;
    __device__ __forceinline__ bool next(int i, pg8::Unit& u) const {
        u.A = A; u.aux = 0;
        if (G == 256) {
            if (i == 0) { const int x = c & 7, j = c >> 3; u.pm = 8 * x + (j >> 2); u.pn = 6 + (j & 3); }
            else { const int L = (i - 1) * G + c, nwg = 64 * 18; if (L >= nwg) return false;
                const int q = nwg / 8, xcd = L % 8, off = L / 8, wgid = xcd * q + off, nig = 8 * 18;
                u.pm = (wgid / nig) * 8 + ((wgid % nig) & 7); const int pp = (wgid % nig) >> 3; u.pn = pp < 6 ? pp : pp + 4; }
        } else { const int L = i * G + c; if (L >= 64 * 22) return false; u.pm = L / 22; u.pn = L % 22; }
        u.B = Bt + (size_t)u.pn * 256 * D * 2; return true;
    }
    __device__ __forceinline__ unsigned arow(const pg8::Unit& u, int r) const { return (unsigned)(u.pm * 256 + r); }
};
struct UpOrder {
    static constexpr bool GATHER = false;
    const char* A0; const char* A1; const char* B0; const char* B1; int G, c;
    __device__ __forceinline__ bool next(int i, pg8::Unit& u) const {
        const int tile = (i >> 1) * G + c; if (tile >= 256) return false;
        u.pm = tile >> 2; u.pn = tile & 3; u.aux = i & 1;
        u.A = (i & 1) ? A1 : A0; u.B = ((i & 1) ? B1 : B0) + (size_t)u.pn * 256 * 512 * 2; return true;
    }
    __device__ __forceinline__ unsigned arow(const pg8::Unit& u, int r) const { return (unsigned)(u.pm * 256 + r); }
};
struct MoeTab { int nt; int pad[3]; int tile_e[176]; int tile_m[176]; int cnt[32]; int tbase[33]; };
struct Moe1Order {
    static constexpr bool GATHER = true;
    const LAS MoeTab* tab; const char* A; const char* W; const int* toklist; int G, c;
    __device__ __forceinline__ bool next(int i, pg8::Unit& u) const {
        const int L = i * G + c; if (L >= tab->nt * 4) return false;
        const int ti = L >> 2; u.pm = ti; u.pn = L & 3; u.aux = ti; u.A = A;
        u.B = W + ((size_t)tab->tile_e[ti] * 1024 + (size_t)u.pn * 256) * 1024 * 2; return true;
    }
    __device__ __forceinline__ unsigned arow(const pg8::Unit& u, int r) const {
        const int e = tab->tile_e[u.aux], rr = tab->tile_m[u.aux] * 256 + r;
        return rr < tab->cnt[e] ? (unsigned)toklist[e * T + rr] : 0u;
    }
};
struct Moe2Order {
    static constexpr bool GATHER = false;
    const LAS MoeTab* tab; const char* A; const char* W; int G, c;
    __device__ __forceinline__ bool next(int i, pg8::Unit& u) const {
        const int L = i * G + c; if (L >= tab->nt * 4) return false;
        const int ti = L >> 2; u.pm = ti; u.pn = L & 3; u.aux = ti; u.A = A;
        u.B = W + ((size_t)tab->tile_e[ti] * 1024 + (size_t)u.pn * 256) * 512 * 2; return true;
    }
    __device__ __forceinline__ unsigned arow(const pg8::Unit& u, int r) const { return (unsigned)(u.pm * 256 + r); }
};

using pg8::Unit; using pg8::cvt_pk_bf16;
struct EpiStoreBf16 {
    static constexpr bool PERM = true;
    bf16_t* O; int ldc; int nscale; float scale0;
    __device__ __forceinline__ bool operator()(f32x4 (&acc)[2][2][4][2], const Unit& u, int wr, int wc, int fr, int fq) const {
        const int row0 = u.pm * 256 + wr * 64 + fr, col0 = u.pn * 256 + wc * 32 + 8 * fq;
        const float sc = u.pn < nscale ? scale0 : 1.0f;
#pragma unroll
        for (int ai = 0; ai < 2; ++ai)
#pragma unroll
            for (int m = 0; m < 4; ++m) { bf16_t* rowp = O + (size_t)(row0 + ai * 128 + m * 16) * ldc + col0;
#pragma unroll
                for (int bj = 0; bj < 2; ++bj) { const f32x4 v0 = acc[ai][bj][m][0] * sc, v1 = acc[ai][bj][m][1] * sc;
                    u32x4 w; w.x = cvt_pk_bf16(v0[0], v0[1]); w.y = cvt_pk_bf16(v0[2], v0[3]); w.z = cvt_pk_bf16(v1[0], v1[1]); w.w = cvt_pk_bf16(v1[2], v1[3]);
                    *(u32x4*)(rowp + bj * 128) = w; } }
        return false;
    }
};
template <int N> __device__ __forceinline__ float dpp_shr(float x) { return __builtin_bit_cast(float, __builtin_amdgcn_update_dpp(0, __builtin_bit_cast(int, x), 0x110 + N, 0xf, 0xf, true)); }
__device__ __forceinline__ float scan16(float x) { x += dpp_shr<1>(x); x += dpp_shr<2>(x); x += dpp_shr<4>(x); x += dpp_shr<8>(x); return x; }
struct EpiInProj {
    static constexpr bool PERM = true;
    bf16_t* O; bf16_t* KE; float* DEC; const float* lbv; float scale0;
    __device__ __forceinline__ bool operator()(f32x4 (&acc)[2][2][4][2], const Unit& u, int wr, int wc, int fr, int fq) const {
        { const int l_ = lane_now(); fr = l_ & 15; fq = l_ >> 4; }
        const int row0 = u.pm * 256 + wr * 64 + fr, col0 = u.pn * 256 + wc * 32 + 8 * fq;
        if (u.pn >= 6 && u.pn < 10) {
            const int h = u.pn - 6, lane = 16 * fq + fr, kb = wc * 32 + 8 * fq, bsrc = (lane & 48) | 15;
            const int bb = (u.pm * 256) / SEQ, ch0 = ((u.pm * 256) % SEQ + wr * 64) >> 6;
#pragma unroll
            for (int ai = 0; ai < 2; ++ai) {
#pragma unroll
                for (int n = 0; n < 2; ++n)
#pragma unroll
                    for (int ep = 0; ep < 2; ++ep) {
                        float ke2[2][4];
#pragma unroll
                        for (int z = 0; z < 2; ++z) {
                            const int e = 2 * ep + z; const float lb = lbv[h * 128 + kb + 4 * n + e];
                            float f[4], c[4], tot[4];
#pragma unroll
                            for (int m = 0; m < 4; ++m) { const float fl = acc[ai][1][m][n][e]; f[m] = lb + (1.0f - lb) * __builtin_amdgcn_rcpf(1.0f + __builtin_amdgcn_exp2f(-1.4426950408889634f * fl)); c[m] = scan16(__logf(f[m])); }
#pragma unroll
                            for (int m = 0; m < 4; ++m) tot[m] = __shfl(c[m], bsrc);
                            const float alast = (tot[0] + tot[1]) + (tot[2] + tot[3]);
                            float pre = 0.f;
#pragma unroll
                            for (int m = 0; m < 4; ++m) { const float A = c[m] + pre; pre += tot[m]; const float q = acc[ai][0][m][n][e]; const float kk = 1.0f - f[m];
                                acc[ai][0][m][n][e] = q * __builtin_amdgcn_rcpf(1.0f + __builtin_amdgcn_exp2f(-1.4426950408889634f * q)) * __expf(A);
                                acc[ai][1][m][n][e] = kk * __expf(-A); ke2[z][m] = kk * __expf(alast - A); }
                            if (fr == 0) DEC[((size_t)(bb * 4 + h) * 64 + ch0 + 2 * ai) * 128 + kb + 4 * n + e] = __expf(alast);
                        }
#pragma unroll
                        for (int m = 0; m < 4; ++m) *(unsigned*)(KE + (size_t)(row0 + ai * 128 + m * 16) * 512 + h * 128 + kb + 4 * n + 2 * ep) = cvt_pk_bf16(ke2[0][m], ke2[1][m]);
                        __builtin_amdgcn_sched_barrier(0);
                    }
            }
        }
        const float sc = u.pn < 2 ? scale0 : 1.0f;
#pragma unroll
        for (int ai = 0; ai < 2; ++ai)
#pragma unroll
            for (int m = 0; m < 4; ++m) { bf16_t* rowp = O + (size_t)(row0 + ai * 128 + m * 16) * INC + col0;
#pragma unroll
                for (int bj = 0; bj < 2; ++bj) { const f32x4 v0 = acc[ai][bj][m][0] * sc, v1 = acc[ai][bj][m][1] * sc;
                    u32x4 w; w.x = cvt_pk_bf16(v0[0], v0[1]); w.y = cvt_pk_bf16(v0[2], v0[3]); w.z = cvt_pk_bf16(v1[0], v1[1]); w.w = cvt_pk_bf16(v1[2], v1[3]);
                    *(u32x4*)(rowp + bj * 128) = w; } }
        return false;
    }
};
struct EpiUp {
    static constexpr bool PERM = true;
    const bf16_t* proj; bf16_t* O;
    __device__ __forceinline__ bool operator()(f32x4 (&acc)[2][2][4][2], const Unit& u, int wr, int wc, int fr, int fq) const {
        const int row0 = u.pm * 256 + wr * 64 + fr, col0 = u.pn * 256 + wc * 32 + 8 * fq;
#pragma unroll
        for (int ai = 0; ai < 2; ++ai)
#pragma unroll
            for (int m = 0; m < 4; ++m) { const size_t row = (size_t)(row0 + ai * 128 + m * 16);
#pragma unroll
                for (int bj = 0; bj < 2; ++bj) {
                    const int col = col0 + bj * 128;
                    const u32x4 gh = *(const u32x4*)(proj + row * INC + C_GHGATE + col);
                    float sh[8];
#pragma unroll
                    for (int j = 0; j < 4; ++j) { sh[2 * j] = 1.0f + __builtin_amdgcn_exp2f(-1.4426950408889634f * bf2f(gh[j] & 0xffffu)); sh[2 * j + 1] = 1.0f + __builtin_amdgcn_exp2f(-1.4426950408889634f * bf2f(gh[j] >> 16)); }
                    if (u.aux == 0) {
                        const u32x4 gd = *(const u32x4*)(proj + row * INC + C_GDA + col);
#pragma unroll
                        for (int j = 0; j < 4; ++j) {
                            const float d0 = 1.0f + __builtin_amdgcn_exp2f(-1.4426950408889634f * bf2f(gd[j] & 0xffffu)), d1 = 1.0f + __builtin_amdgcn_exp2f(-1.4426950408889634f * bf2f(gd[j] >> 16));
                            const float r0 = sh[2 * j] * __builtin_amdgcn_rcpf(d0), r1 = sh[2 * j + 1] * __builtin_amdgcn_rcpf(d1);
                            if (j < 2) { acc[ai][bj][m][0][2 * j] *= r0; acc[ai][bj][m][0][2 * j + 1] *= r1; }
                            else { acc[ai][bj][m][1][2 * j - 4] *= r0; acc[ai][bj][m][1][2 * j - 3] *= r1; }
                        }
                    } else {
                        const f32x4 v0 = acc[ai][bj][m][0], v1 = acc[ai][bj][m][1];
#pragma unroll
                        for (int j = 0; j < 8; ++j) sh[j] = __builtin_amdgcn_rcpf(sh[j]);
                        u32x4 w; w.x = cvt_pk_bf16(v0[0] * sh[0], v0[1] * sh[1]); w.y = cvt_pk_bf16(v0[2] * sh[2], v0[3] * sh[3]);
                        w.z = cvt_pk_bf16(v1[0] * sh[4], v1[1] * sh[5]); w.w = cvt_pk_bf16(v1[2] * sh[6], v1[3] * sh[7]);
                        *(u32x4*)(O + row * D + col) = w;
                    }
                } }
        return u.aux == 0;
    }
};
struct EpiOut {
    static constexpr bool PERM = false;
    const float* x; const float* mod; float* O;
    __device__ __forceinline__ bool operator()(f32x4 (&acc)[2][2][4][2], const Unit& u, int wr, int wc, int fr, int fq) const {
        const int row0 = u.pm * 256 + wr * 64 + fr, col0 = u.pn * 256 + wc * 32 + 4 * fq;
        const int b = (u.pm * 256) / SEQ;
        f32x4 gt[2][2];
#pragma unroll
        for (int bj = 0; bj < 2; ++bj)
#pragma unroll
            for (int n = 0; n < 2; ++n) gt[bj][n] = *(const f32x4*)(mod + b * 6144 + 2048 + col0 + bj * 128 + n * 16);
#pragma unroll
        for (int ai = 0; ai < 2; ++ai)
#pragma unroll
            for (int m = 0; m < 4; ++m) { const size_t off = (size_t)(row0 + ai * 128 + m * 16) * D + col0;
#pragma unroll
                for (int bj = 0; bj < 2; ++bj)
#pragma unroll
                    for (int n = 0; n < 2; ++n) { const f32x4 xv = *(const f32x4*)(x + off + bj * 128 + n * 16);
                        *(f32x4*)(O + off + bj * 128 + n * 16) = xv + gt[bj][n] * acc[ai][bj][m][n]; } }
        return false;
    }
};
struct EpiMoe1 {
    static constexpr bool PERM = true;
    bf16_t* O;
    __device__ __forceinline__ bool operator()(f32x4 (&acc)[2][2][4][2], const Unit& u, int wr, int wc, int fr, int fq) const {
        const int row0 = u.pm * 256 + wr * 64 + fr, col0 = u.pn * 128 + wc * 32 + 8 * fq;
#pragma unroll
        for (int ai = 0; ai < 2; ++ai)
#pragma unroll
            for (int m = 0; m < 4; ++m) { bf16_t* rowp = O + (size_t)(row0 + ai * 128 + m * 16) * DEXP + col0;
                float h[8];
#pragma unroll
                for (int n = 0; n < 2; ++n)
#pragma unroll
                    for (int e = 0; e < 4; ++e) h[n * 4 + e] = siluf_(acc[ai][0][m][n][e]) * acc[ai][1][m][n][e];
                u32x4 w; w.x = cvt_pk_bf16(h[0], h[1]); w.y = cvt_pk_bf16(h[2], h[3]); w.z = cvt_pk_bf16(h[4], h[5]); w.w = cvt_pk_bf16(h[6], h[7]);
                *(u32x4*)rowp = w; }
        return false;
    }
};

struct Frame { LAS unsigned char* lds; int tid, lane, wave, G, bid; };

__device__ __forceinline__ void transpose_item(const float* Wsrc, int ldw, bf16_t* dst, int ldd, LAS float* scr, int lane) {
#pragma unroll 8
    for (int i = 0; i < 32; ++i) { const int kk = 2 * i + (lane >> 5); scr[kk * 33 + (lane & 31)] = Wsrc[(size_t)kk * ldw + (lane & 31)]; }
    asm volatile("s_waitcnt lgkmcnt(0)" ::: "memory");
    const int c = lane & 7;
#pragma unroll
    for (int j = 0; j < 4; ++j) { const int n = (lane >> 3) + 8 * j; const LAS float* s = scr + (8 * c) * 33 + n;
        u32x4 o; o.x = pk2(s[0 * 33], s[1 * 33]); o.y = pk2(s[2 * 33], s[3 * 33]); o.z = pk2(s[4 * 33], s[5 * 33]); o.w = pk2(s[6 * 33], s[7 * 33]);
        *(u32x4*)(dst + (size_t)n * ldd + 8 * c) = o; }
    asm volatile("s_waitcnt lgkmcnt(0)" ::: "memory");
}
__device__ __forceinline__ void transpose_matrix(const Frame& F, const float* W, int K, int N, bf16_t* WT) {
    LAS float* scr = (LAS float*)(F.lds + F.wave * 8448);
    const int gw = F.bid * NWAVES + F.wave, NGW = F.G * NWAVES, nblk = N / 32, items = (K / 64) * nblk;
    for (int it = gw; it < items; it += NGW) { const int kb = it / nblk, nb = it % nblk;
        transpose_item(W + (size_t)(64 * kb) * N + 32 * nb, N, WT + (size_t)(32 * nb) * K + 64 * kb, K, scr, F.lane); }
}

__device__ __forceinline__ void phase0(const Frame& F, const Args& a) {
    unsigned char* ws = a.ws;
    {
        float* modp = (float*)(ws + WS_MODP);
        const float* c = a.in[I_C]; const float* wada = a.in[I_WADA];
        LAS float* cs = (LAS float*)(F.lds + 72 * 1024);
        for (int i = F.tid; i < 4 * D; i += NTHR) cs[i] = siluf_(c[i]);
        __syncthreads();
        for (int wt = F.bid + 256 * F.wave; wt < 384; wt += 256 * NWAVES) {
            if (F.G != 256) break;
            const int ks = wt / 24, jw = wt % 24, j = jw * 256 + F.lane * 4;
            f32x4 s[4] = {{0, 0, 0, 0}, {0, 0, 0, 0}, {0, 0, 0, 0}, {0, 0, 0, 0}};
#pragma unroll 8
            for (int k = ks * 64; k < ks * 64 + 64; ++k) {
                const f32x4 w = *(const f32x4*)(wada + (size_t)k * 6144 + j);
#pragma unroll
                for (int b = 0; b < 4; ++b) s[b] += w * cs[b * D + k];
            }
#pragma unroll
            for (int b = 0; b < 4; ++b) *(f32x4*)(modp + ((size_t)ks * 4 + b) * 6144 + j) = s[b];
        }
        if (F.G != 256) {
            const int gw = F.bid * NWAVES + F.wave, NGW = F.G * NWAVES;
            for (int wt = gw; wt < 384; wt += NGW) {
                const int ks = wt / 24, jw = wt % 24, j = jw * 256 + F.lane * 4;
                f32x4 s[4] = {{0, 0, 0, 0}, {0, 0, 0, 0}, {0, 0, 0, 0}, {0, 0, 0, 0}};
                for (int k = ks * 64; k < ks * 64 + 64; ++k) {
                    const f32x4 w = *(const f32x4*)(wada + (size_t)k * 6144 + j);
#pragma unroll
                    for (int b = 0; b < 4; ++b) { const float cv = siluf_(c[b * D + k]); s[b] += w * cv; }
                }
#pragma unroll
                for (int b = 0; b < 4; ++b) *(f32x4*)(modp + ((size_t)ks * 4 + b) * 6144 + j) = s[b];
            }
        }
    }
    {
        LAS float* scr = (LAS float*)(F.lds + F.wave * 8448);
        const int gw = F.bid * NWAVES + F.wave, NGW = F.G * NWAVES, nblk = INC / 32, items = (D / 64) * nblk;
        bf16_t* WT = (bf16_t*)(ws + WS_WIN);
        for (int it = gw; it < items; it += NGW) { const int kb = it / nblk, n0 = 32 * (it % nblk); int dr = n0;
            if (n0 >= C_QHG && n0 < C_FHG) dr = C_HGT + 256 * ((n0 - C_QHG) >> 7) + ((n0 - C_QHG) & 127);
            else if (n0 >= C_FHG && n0 < C_IHG) dr = C_HGT + 256 * ((n0 - C_FHG) >> 7) + 128 + ((n0 - C_FHG) & 127);
            transpose_item(a.in[I_WIN] + (size_t)(64 * kb) * INC + n0, INC, WT + (size_t)dr * D + 64 * kb, D, scr, F.lane); }
    }
    transpose_matrix(F, a.in[I_WUPDA], 512, D, (bf16_t*)(ws + WS_WUPDA));
    transpose_matrix(F, a.in[I_WUPHG], 512, D, (bf16_t*)(ws + WS_WUPHG));
    transpose_matrix(F, a.in[I_WOUT], D, D, (bf16_t*)(ws + WS_WOUT));
    if (F.bid == 0) {
        float* sm = (float*)(ws + WS_SMALL);
        if (F.tid == 0) {
            float s1 = 0.f, s2 = 0.f;
            for (int i = 0; i < 64; ++i) { s1 += a.in[I_LQ1][i] * a.in[I_LK1][i]; s2 += a.in[I_LQ2][i] * a.in[I_LK2][i]; }
            sm[0] = expf(s1) - expf(s2) + 0.2f;
        }
        { const float l0 = a.in[I_LBL][F.tid], l1 = a.in[I_LBL][512 + F.tid]; const float mx = fmaxf(l0, l1);
          const float e0 = expf(l0 - mx), e1 = expf(l1 - mx); sm[16 + F.tid] = e0 / (e0 + e1); }
    }
}
__device__ __forceinline__ void moe_weight_convert(const Frame& F, const Args& a) {
    LAS float* scr = (LAS float*)(F.lds + F.wave * 8448);
    const int gw = F.bid * NWAVES + F.wave, NGW = F.G * NWAVES;
    bf16_t* w13 = (bf16_t*)(a.ws + WS_W13); bf16_t* w2t = (bf16_t*)(a.ws + WS_W2);
    for (int it = gw; it < 2 * NEXP * 256; it += NGW) {
        const int which = it / (NEXP * 256), r = it % (NEXP * 256), e = r >> 8, kb = (r >> 4) & 15, nb = r & 15, n0 = 32 * nb;
        const float* W = a.in[which ? I_W3 : I_W1] + (size_t)e * 1024 * 512;
        const int drow = 256 * (n0 >> 7) + (which ? 128 : 0) + (n0 & 127);
        transpose_item(W + (size_t)(64 * kb) * 512 + n0, 512, w13 + ((size_t)e * 1024 + drow) * 1024 + 64 * kb, 1024, scr, F.lane);
    }
}
__device__ __forceinline__ void moe_w2_convert(const Frame& F, const Args& a, int myidx, int nidle) {
    LAS float* scr = (LAS float*)(F.lds + F.wave * 8448);
    bf16_t* w2t = (bf16_t*)(a.ws + WS_W2);
    for (int it = myidx * NWAVES + F.wave; it < NEXP * 256; it += nidle * NWAVES) {
        const int e = it >> 8, kb = (it >> 5) & 7, nb = it & 31;
        const float* W = a.in[I_W2] + (size_t)e * 512 * 1024;
        transpose_item(W + (size_t)(64 * kb) * 1024 + 32 * nb, 1024, w2t + ((size_t)e * 1024 + 32 * nb) * 512 + 64 * kb, 512, scr, F.lane);
    }
}

__device__ __forceinline__ void phase1(const Frame& F, const Args& a) {
    const float* modp = (const float*)(a.ws + WS_MODP); float* mod = (float*)(a.ws + WS_MOD);
    for (int i = F.bid * NTHR + F.tid; i < 4 * 6144; i += F.G * NTHR) {
        float s = a.in[I_BADA][i % 6144];
        for (int ks = 0; ks < 16; ++ks) s += modp[(size_t)ks * 4 * 6144 + i];
        mod[i] = s;
    }
    LAS float* Gs = (LAS float*)F.lds;
    LAS float* Ss = Gs + 1024;
    bf16_t* H = (bf16_t*)(a.ws + WS_ACT);
    const int rows_per_blk = T / F.G;
    const int r0 = F.bid * rows_per_blk, b = r0 / SEQ;
    for (int k = F.tid; k < 1024; k += NTHR) {
        float sh = a.in[I_BADA][k], sc = a.in[I_BADA][1024 + k];
        for (int ks = 0; ks < 16; ++ks) { sh += modp[((size_t)ks * 4 + b) * 6144 + k]; sc += modp[((size_t)ks * 4 + b) * 6144 + 1024 + k]; }
        Gs[k] = a.in[I_N1G][k] * (1.0f + sc); Ss[k] = sh;
    }
    __syncthreads();
    for (int r = r0 + F.wave; r < r0 + rows_per_blk; r += NWAVES) {
        const f32x4* xr = (const f32x4*)(a.in[I_X] + (size_t)r * D) + F.lane;
        f32x4 v[4]; float s = 0.f;
#pragma unroll
        for (int j = 0; j < 4; ++j) { v[j] = xr[64 * j]; s += (v[j].x * v[j].x + v[j].y * v[j].y) + (v[j].z * v[j].z + v[j].w * v[j].w); }
        const float rs = rsqrtf(wave_sum(s) * (1.0f / D) + EPS);
        unsigned long long* o8 = (unsigned long long*)(H + (size_t)r * D) + F.lane;
#pragma unroll
        for (int j = 0; j < 4; ++j) { const f32x4 g = *(const LAS f32x4*)(Gs + 256 * j + 4 * F.lane), sh = *(const LAS f32x4*)(Ss + 256 * j + 4 * F.lane);
            const f32x4 h = v[j] * rs * g + sh;
            o8[64 * j] = (unsigned long long)pk2(h.x, h.y) | ((unsigned long long)pk2(h.z, h.w) << 32); }
    }
}

namespace attn_body {
using s16x4=__attribute__((ext_vector_type(4)))short;
using f32x16=__attribute__((ext_vector_type(16)))float;
constexpr int NW=8,QBLK=32,QB=QBLK*NW,KVBLK=64,NQB=SEQ/QB;
constexpr int PIN=INC, POUT=1024;
__device__ __forceinline__ int crow(int r,int hi){return (r&3)+8*(r>>2)+4*hi;}
#define SBAR() __builtin_amdgcn_sched_barrier(0)
__device__ __forceinline__ void bmask(f32x16&p0,f32x16&p1,int jb,int wch,int il,int hi,float s2x2){
  if(jb>wch){
    #pragma unroll
    for(int r=0;r<16;++r){p0[r]=-INFINITY;p1[r]=-INFINITY;}
  } else if(jb==wch){
    float fb=(float)(4*hi-il); asm volatile("":"+v"(fb));
    #pragma unroll
    for(int r=0;r<16;++r){const float c=(float)((r&3)+8*(r>>2)); p0[r]-=s2x2*__builtin_fmaxf(fb+c,0.f); p1[r]-=s2x2*__builtin_fmaxf(fb+(c+32.f),0.f);}
  }
}
constexpr int NSLOT=3, SLOTB=8192;
constexpr int LDS_K=0, LDS_V=NSLOT*SLOTB, LDS_WS=2*NSLOT*SLOTB, LDS_OST=LDS_WS+NW*64*4, ATT_LDS_BYTES=LDS_OST+NW*4096;
constexpr float C2=0.125f*1.4426950408889634f;
__device__ __forceinline__ void glds16(const void*gsrc,unsigned lds_dst){unsigned keep;
  asm volatile("s_mov_b32 %0, m0\n\ts_mov_b32 m0, %2\n\ts_nop 0\n\tglobal_load_lds_dwordx4 %1, off\n\ts_mov_b32 m0, %0":"=&s"(keep):"v"(gsrc),"s"(lds_dst):"memory");}
__device__ __forceinline__ float max3f(float a,float b,float c){float r;asm("v_max3_f32 %0, %1, %2, %3":"=v"(r):"v"(a),"v"(b),"v"(c));return r;}
__device__ __forceinline__ float max2f(float a,float b){float r;asm("v_max_f32_e32 %0, %1, %2":"=v"(r):"v"(a),"v"(b));return r;}
__device__ __forceinline__ float fadd_s(float a,float b){float r;asm("v_add_f32_e32 %0, %1, %2":"=v"(r):"v"(a),"v"(b));return r;}
__device__ __forceinline__ float fsub_s(float a,float b){float r;asm("v_sub_f32_e32 %0, %1, %2":"=v"(r):"v"(a),"v"(b));return r;}
typedef float f32x2_t __attribute__((ext_vector_type(2))); typedef __bf16 bf16x2_t __attribute__((ext_vector_type(2)));
__device__ __forceinline__ unsigned cvtpk_s(float lo,float hi){f32x2_t v={lo,hi};bf16x2_t b=__builtin_convertvector(v,bf16x2_t);return __builtin_bit_cast(unsigned,b);}
#define WAIT_BAR(N) asm volatile("s_waitcnt vmcnt(" #N ") lgkmcnt(0)\n\ts_barrier":::"memory")

__device__ __forceinline__ void qkt(f32x16&p0,f32x16&p1,const char*Kslot,const bf16x8*qr,const f32x16&c0,const f32x16&c1,int r32,int hi){
  const char*kb=Kslot+hi*1024+r32*16;
  #pragma unroll
  for(int d0=0;d0<4;++d0){
    const bf16x8 b0=*reinterpret_cast<const bf16x8*>(kb+d0*2048);
    const bf16x8 b1=*reinterpret_cast<const bf16x8*>(kb+d0*2048+512);
    if(d0==0){p0=__builtin_amdgcn_mfma_f32_32x32x16_bf16(b0,qr[0],c0,0,0,0);p1=__builtin_amdgcn_mfma_f32_32x32x16_bf16(b1,qr[0],c1,0,0,0);}
    else{p0=__builtin_amdgcn_mfma_f32_32x32x16_bf16(b0,qr[d0],p0,0,0,0);p1=__builtin_amdgcn_mfma_f32_32x32x16_bf16(b1,qr[d0],p1,0,0,0);}}
}
typedef __attribute__((address_space(3))) const char* lds_cptr;
typedef short v4i16_t __attribute__((ext_vector_type(4)));
__device__ __forceinline__ void kload8(bf16x8*kf,lds_cptr kp){
  kf[0]=*(const __attribute__((address_space(3))) bf16x8*)(kp);      kf[1]=*(const __attribute__((address_space(3))) bf16x8*)(kp+512);
  kf[2]=*(const __attribute__((address_space(3))) bf16x8*)(kp+2048); kf[3]=*(const __attribute__((address_space(3))) bf16x8*)(kp+2560);
  kf[4]=*(const __attribute__((address_space(3))) bf16x8*)(kp+4096); kf[5]=*(const __attribute__((address_space(3))) bf16x8*)(kp+4608);
  kf[6]=*(const __attribute__((address_space(3))) bf16x8*)(kp+6144); kf[7]=*(const __attribute__((address_space(3))) bf16x8*)(kp+6656);
}
__device__ __forceinline__ void kload2(bf16x8*kf,lds_cptr kp,int j){ kf[2*j]=*(const __attribute__((address_space(3))) bf16x8*)(kp+j*2048); kf[2*j+1]=*(const __attribute__((address_space(3))) bf16x8*)(kp+j*2048+512); }
__device__ __forceinline__ s16x4 vtr(lds_cptr p){ return __builtin_bit_cast(s16x4,__builtin_amdgcn_ds_read_tr16_b64_v4i16((__attribute__((address_space(3))) v4i16_t*)p)); }
__device__ __forceinline__ float rowmax(const f32x16&p0,const f32x16&p1){
  float a=max3f(p0[0],p0[1],p1[0]),b=max3f(p0[2],p0[3],p1[1]);a=max3f(a,p1[2],p1[3]);
  #pragma unroll
  for(int r=4;r<16;r+=4){a=max3f(a,p0[r],p0[r+1]);b=max3f(b,p0[r+2],p0[r+3]);a=max3f(a,p1[r],p1[r+1]);b=max3f(b,p1[r+2],p1[r+3]);}
  const float m=max2f(a,b);
  auto rr=__builtin_amdgcn_permlane32_swap(__float_as_uint(m),__float_as_uint(m),false,false);
  return max2f(__uint_as_float(rr[0]),__uint_as_float(rr[1]));
}
__device__ __forceinline__ void pv(f32x16*o,int vb,bf16x8 pa0,bf16x8 pa1,bf16x8 pa2,bf16x8 pa3){
  #pragma unroll
  for(int d0=0;d0<2;++d0){s16x4 lo[4],hi[4];
    #pragma unroll
    for(int ks=0;ks<4;++ks){
      asm volatile("ds_read_b64_tr_b16 %0,%1 offset:%c2":"=&v"(lo[ks]):"v"(vb),"i"(d0*4096+ks*1024):"memory");
      asm volatile("ds_read_b64_tr_b16 %0,%1 offset:%c2":"=&v"(hi[ks]):"v"(vb),"i"(d0*4096+ks*1024+512):"memory");}
    asm volatile("s_waitcnt lgkmcnt(0)":::"memory");SBAR();
    #define PK(k) (bf16x8){lo[k][0],lo[k][1],lo[k][2],lo[k][3],hi[k][0],hi[k][1],hi[k][2],hi[k][3]}
    o[d0]=__builtin_amdgcn_mfma_f32_32x32x16_bf16(pa0,PK(0),o[d0],0,0,0);
    o[d0]=__builtin_amdgcn_mfma_f32_32x32x16_bf16(pa1,PK(1),o[d0],0,0,0);
    o[d0]=__builtin_amdgcn_mfma_f32_32x32x16_bf16(pa2,PK(2),o[d0],0,0,0);
    o[d0]=__builtin_amdgcn_mfma_f32_32x32x16_bf16(pa3,PK(3),o[d0],0,0,0);
    #undef PK
  }
}
#define ATTN_STORE16(p,v) (*(u32x4*)(p)=(v))
template<int THRL> __device__ __forceinline__ void attn_unit(int qb,const bf16_t*Qb,const bf16_t*__restrict__ Kh,const bf16_t*__restrict__ Vh,bf16_t*Ob,float slope2,char*shm){
  const int tid=threadIdx.x,lane=tid&63,r32=lane&31,hi=lane>>5; const int wid=__builtin_amdgcn_readfirstlane(tid>>6);
  const int q0=qb*QB;
  const bf16_t*Qw=Qb+(long)(q0+wid*QBLK)*PIN;
  const unsigned lds0=(unsigned)(uintptr_t)shm;
  float*wsf=(float*)(shm+LDS_WS)+wid*64;
  const bf16_t*ksrc=Kh+(long)lane*PIN+wid*8;
  const bf16_t*vsrc=Vh+(long)(16*(wid&3)+(lane>>2))*PIN+(wid>>2)*32+(lane&3)*8;
  const unsigned kdst=lds0+LDS_K+wid*1024, vdst=lds0+LDS_V+wid*1024;
  #define DMA_K(t,slot) glds16(ksrc+(long)(t)*KVBLK*PIN,(unsigned)__builtin_amdgcn_readfirstlane(kdst+(slot)))
  #define DMA_V(t,slot) glds16(vsrc+(long)(t)*KVBLK*PIN,(unsigned)__builtin_amdgcn_readfirstlane(vdst+(slot)))
  const int vb0=(int)(lds0+LDS_V)+((lane>>4)&1)*32+(lane&3)*8+(4*hi+((lane&15)>>2))*64;
  const char*Kbase=shm+LDS_K; bf16x8 kf[8];
  const lds_cptr shm3=(lds_cptr)shm; const lds_cptr kp0=shm3+LDS_K+hi*1024+r32*16; const lds_cptr vp0=shm3+LDS_V+((lane>>4)&1)*32+(lane&3)*8+(4*hi+((lane&15)>>2))*64;
  const int NT=(q0+QB)/KVBLK;
  DMA_K(0,0);DMA_V(0,0);DMA_K(1,SLOTB);
  bf16x8 qr[4];
  #pragma unroll
  for(int d0=0;d0<4;++d0)qr[d0]=*reinterpret_cast<const bf16x8*>(&Qw[(long)r32*PIN+d0*16+hi*8]);
  float mhat=0.f,l_reg=0.f;f32x16 o[2];o[0]=f32x16{};o[1]=f32x16{};
  const float s64=slope2*64.f, s32=slope2*32.f, s2x2=2.f*slope2, s4hi=slope2*4.f*(float)hi;
  const int wch=wid>>1, il=32*(wid&1)+r32;
  #define CMASK(P0,P1,t) do{int jb_=(t)-(NT-4); if(jb_>=0)bmask(P0,P1,jb_,wch,il,hi,s2x2);}while(0)
  #define CINIT0(C0,t) do{ const float bt_=s64*(float)((t)-NT)-mhat+s4hi; _Pragma("unroll") for(int r=0;r<16;++r){C0[r]=__builtin_fmaf(slope2,(float)((r&3)+8*(r>>2)),bt_);} }while(0)
  #define CINIT1(C1,t) do{ const float bu_=s64*(float)((t)-NT)-mhat+s4hi+s32; _Pragma("unroll") for(int r=0;r<16;++r){C1[r]=__builtin_fmaf(slope2,(float)((r&3)+8*(r>>2)),bu_);} }while(0)
  bool resc=false;
  #define START(P0,P1) do{ const float rm=rowmax(P0,P1); resc=false; \
    { const float dl=rm; mhat=fadd_s(mhat,dl); \
      _Pragma("unroll") for(int r=0;r<16;++r){P0[r]=fsub_s(P0[r],dl);P1[r]=fsub_s(P1[r],dl);} } \
    _Pragma("unroll") for(int r=0;r<16;++r)P0[r]=__builtin_amdgcn_exp2f(P0[r]); }while(0)
  #define RESC() do{ if(resc){ asm volatile("s_waitcnt lgkmcnt(0)":::"memory"); \
      _Pragma("unroll") for(int d_=0;d_<2;++d_) _Pragma("unroll") for(int r=0;r<16;++r)o[d_][r]*=wsf[crow(r,hi)]; } }while(0)
  f32x16 pA0,pA1,pB0,pB1;
  int sl_prev=0,sl_cur=0,sl_next=SLOTB;
  #define ROT() do{sl_prev=sl_cur;sl_cur=sl_next;sl_next=(sl_next==(NSLOT-1)*SLOTB)?0:sl_next+SLOTB;}while(0)
  DMA_K(2,2*SLOTB);
  WAIT_BAR(3);
  { f32x16 c0,c1; CINIT0(c0,0); CINIT1(c1,0); qkt(pA0,pA1,Kbase,qr,c0,c1,r32,hi); }
  asm volatile("s_nop 15\n\ts_nop 7":"+v"(pA0),"+v"(pA1));CMASK(pA0,pA1,0);
  START(pA0,pA1);
  _Pragma("unroll") for(int r=0;r<16;++r)pA1[r]=__builtin_amdgcn_exp2f(pA1[r]);
  WAIT_BAR(0);
  DMA_K(3,0);DMA_V(1,SLOTB);
  ROT();
  kload8(kf,kp0+sl_cur);
  WAIT_BAR(2);
  s16x4 vlo[8],vhi[8]; u32x4 pw0,pw1,pw2,pw3;
  #define PKW(P,B) cvtpk_s(P[B],P[B+1])
  #define PAF(k) __builtin_bit_cast(bf16x8,pw##k)
  #define VFR(i) (bf16x8){vlo[i][0],vlo[i][1],vlo[i][2],vlo[i][3],vhi[i][0],vhi[i][1],vhi[i][2],vhi[i][3]}
  #define PIN_(x) asm volatile("":"+v"(x))
  #define MX3(a,b,c) __builtin_fmaxf(__builtin_fmaxf((a),(b)),(c))
  #define GAPA(MF,A0,A1,A2,A3,W0,W1,PW) do{ MF; sacc+=A0; sacc+=A1; sacc+=A2; sacc+=A3; PIN_(sacc); W0; W1; PIN_(PW); SBAR(); }while(0)
  #define EX(v) __builtin_amdgcn_exp2f(v)
  #define GAPB(MF,X,B) do{ MF; X[B]=EX(X[B]); X[B+1]=EX(X[B+1]); X[B+2]=EX(X[B+2]); X[B+3]=EX(X[B+3]); PIN_(X); SBAR(); }while(0)
  #define VRD(i) do{ vlo[i]=vtr(vp_+(((i)>>2)*4096+((i)&3)*1024)); vhi[i]=vtr(vp_+(((i)>>2)*4096+((i)&3)*1024+512)); }while(0)
  #define KRD(G,j) do{ if(G){ kload2(kf,kp0+sl_next,j); SBAR(); } }while(0)
  #define STEP(C0,C1,P0,P1,t,GK,GV,GL) do{ SBAR(); \
    CINIT0(C0,t); SBAR(); \
    const lds_cptr vp_=vp0+sl_prev; \
    VRD(0); SBAR(); float sacc=(P0[0]+P0[1]); \
    GAPA(C0=__builtin_amdgcn_mfma_f32_32x32x16_bf16(kf[0],qr[0],C0,0,0,0), P0[2],P0[3],P0[4],P0[5],     pw0[0]=PKW(P0,0), pw0[1]=PKW(P0,2), pw0); \
    CINIT1(C1,t); VRD(4); SBAR(); GAPA(C1=__builtin_amdgcn_mfma_f32_32x32x16_bf16(kf[1],qr[0],C1,0,0,0), P0[6],P0[7],P0[8],P0[9],     pw0[2]=PKW(P0,4), pw0[3]=PKW(P0,6), pw0); \
    VRD(1); SBAR(); GAPA(C0=__builtin_amdgcn_mfma_f32_32x32x16_bf16(kf[2],qr[1],C0,0,0,0),   P0[10],P0[11],P0[12],P0[13], pw1[0]=PKW(P0,8), pw1[1]=PKW(P0,10), pw1); \
    VRD(5); SBAR(); GAPA(C1=__builtin_amdgcn_mfma_f32_32x32x16_bf16(kf[3],qr[1],C1,0,0,0),   P0[14],P0[15],P1[0],P1[1],   pw1[2]=PKW(P0,12),pw1[3]=PKW(P0,14), pw1); \
    VRD(2); SBAR(); GAPA(C0=__builtin_amdgcn_mfma_f32_32x32x16_bf16(kf[4],qr[2],C0,0,0,0),   P1[2],P1[3],P1[4],P1[5],     pw2[0]=PKW(P1,0), pw2[1]=PKW(P1,2), pw2); \
    VRD(6); SBAR(); GAPA(C1=__builtin_amdgcn_mfma_f32_32x32x16_bf16(kf[5],qr[2],C1,0,0,0),   P1[6],P1[7],P1[8],P1[9],     pw2[2]=PKW(P1,4), pw2[3]=PKW(P1,6), pw2); \
    VRD(3); SBAR(); GAPA(C0=__builtin_amdgcn_mfma_f32_32x32x16_bf16(kf[6],qr[3],C0,0,0,0),   P1[10],P1[11],P1[12],P1[13], pw3[0]=PKW(P1,8), pw3[1]=PKW(P1,10), pw3); \
    VRD(7); SBAR(); GAPA(C1=__builtin_amdgcn_mfma_f32_32x32x16_bf16(kf[7],qr[3],C1,0,0,0),   P1[14],P1[15],0.f,0.f,       pw3[2]=PKW(P1,12),pw3[3]=PKW(P1,14), pw3); \
    l_reg+=sacc; \
    if(GK){DMA_K((t)+3,sl_cur);} if(GV){DMA_V((t)+1,sl_next);} \
    CMASK(C0,C1,t); \
    { float a=MX3(C0[0],C0[1],C1[0]),b=MX3(C0[2],C0[3],C1[1]); a=MX3(a,C1[2],C1[3]); \
      _Pragma("unroll") for(int r=4;r<16;r+=4){a=MX3(a,C0[r],C0[r+1]);b=MX3(b,C0[r+2],C0[r+3]);a=MX3(a,C1[r],C1[r+1]);b=MX3(b,C1[r+2],C1[r+3]);} \
      float rm=__builtin_fmaxf(a,b); { auto rr=__builtin_amdgcn_permlane32_swap(__float_as_uint(rm),__float_as_uint(rm),false,false); rm=__builtin_fmaxf(__uint_as_float(rr[0]),__uint_as_float(rr[1])); } \
      resc=false; \
      if(__builtin_expect(__any(rm>(float)THRL),0)){ const float dl=__builtin_fmaxf(rm,0.f); mhat+=dl; \
        _Pragma("unroll") for(int r=0;r<16;++r){C0[r]-=dl;C1[r]-=dl;} \
        const float f=__builtin_amdgcn_exp2f(-dl); l_reg*=f; if(hi==0)wsf[r32]=f; resc=true; } } \
    SBAR(); \
    GAPB(o[0]=__builtin_amdgcn_mfma_f32_32x32x16_bf16(PAF(0),VFR(0),o[0],0,0,0), C0,0); \
    GAPB(o[1]=__builtin_amdgcn_mfma_f32_32x32x16_bf16(PAF(0),VFR(4),o[1],0,0,0), C0,4); \
    KRD(GL,0); GAPB(o[0]=__builtin_amdgcn_mfma_f32_32x32x16_bf16(PAF(1),VFR(1),o[0],0,0,0), C0,8); \
    KRD(GL,1); GAPB(o[1]=__builtin_amdgcn_mfma_f32_32x32x16_bf16(PAF(1),VFR(5),o[1],0,0,0), C0,12); \
    KRD(GL,2); GAPB(o[0]=__builtin_amdgcn_mfma_f32_32x32x16_bf16(PAF(2),VFR(2),o[0],0,0,0), C1,0); \
    KRD(GL,3); GAPB(o[1]=__builtin_amdgcn_mfma_f32_32x32x16_bf16(PAF(2),VFR(6),o[1],0,0,0), C1,4); \
    GAPB(o[0]=__builtin_amdgcn_mfma_f32_32x32x16_bf16(PAF(3),VFR(3),o[0],0,0,0), C1,8); \
    GAPB(o[1]=__builtin_amdgcn_mfma_f32_32x32x16_bf16(PAF(3),VFR(7),o[1],0,0,0), C1,12); \
    }while(0)
  int t=1;
  #undef CMASK
  #define CMASK(P0,P1,t) do{}while(0)
  for(;t+5<NT;t+=2){
    STEP(pB0,pB1,pA0,pA1,t,true,true,true);     WAIT_BAR(2); RESC(); ROT();
    STEP(pA0,pA1,pB0,pB1,t+1,true,true,true);   WAIT_BAR(2); RESC(); ROT();
  }
  #undef CMASK
  #define CMASK(P0,P1,t) do{int jb_=(t)-(NT-4); if(jb_>=0)bmask(P0,P1,jb_,wch,il,hi,s2x2);}while(0)
  #define ENDW(tt) do{ if((tt)+3<NT){WAIT_BAR(2);} else if((tt)+2<NT){WAIT_BAR(1);} else {WAIT_BAR(0);} }while(0)
  for(;t+1<NT;t+=2){
    STEP(pB0,pB1,pA0,pA1,t,(t+3<NT),(t+1<NT),(t+1<NT));       ENDW(t);   RESC(); ROT();
    STEP(pA0,pA1,pB0,pB1,t+1,(t+4<NT),(t+2<NT),(t+2<NT));     ENDW(t+1); RESC(); ROT();
  }
  STEP(pB0,pB1,pA0,pA1,NT-1,false,false,false); RESC();
  { float sacc=pB0[0]+pB0[1]; _Pragma("unroll") for(int r=2;r<16;++r)sacc+=pB0[r]; _Pragma("unroll") for(int r=0;r<16;++r)sacc+=pB1[r]; l_reg+=sacc;
    pw0=(u32x4){PKW(pB0,0),PKW(pB0,2),PKW(pB0,4),PKW(pB0,6)};pw1=(u32x4){PKW(pB0,8),PKW(pB0,10),PKW(pB0,12),PKW(pB0,14)};pw2=(u32x4){PKW(pB1,0),PKW(pB1,2),PKW(pB1,4),PKW(pB1,6)};pw3=(u32x4){PKW(pB1,8),PKW(pB1,10),PKW(pB1,12),PKW(pB1,14)};
    SBAR(); pv(o,vb0+sl_cur,PAF(0),PAF(1),PAF(2),PAF(3)); }
  #undef PKW
  #undef PAF
  #undef VFR
  #undef PIN_
  #undef MX3
  #undef GAPA
  #undef GAPB
  #undef EX
  #undef VRD
  #undef KRD
  #undef STEP
  #undef ENDW
  {auto rr=__builtin_amdgcn_permlane32_swap(__float_as_uint(l_reg),__float_as_uint(l_reg),false,false);l_reg=__uint_as_float(rr[0])+__uint_as_float(rr[1]);}
  if(hi==0)wsf[32+r32]=l_reg;asm volatile("s_waitcnt lgkmcnt(0)":::"memory");
  float rli[16];
  #pragma unroll
  for(int r=0;r<16;++r)rli[r]=__builtin_amdgcn_rcpf(wsf[32+crow(r,hi)]);
  bf16_t*Ow=Ob+(long)(q0+wid*QBLK)*POUT;
  { bf16_t*stg=(bf16_t*)(shm+LDS_OST)+wid*2048;
    #pragma unroll
    for(int r=0;r<16;++r){const int orow=crow(r,hi);
      #pragma unroll
      for(int d0=0;d0<2;++d0)stg[orow*64+d0*32+r32]=(bf16_t)f2bf(o[d0][r]*rli[r]);}
    asm volatile("s_waitcnt lgkmcnt(0)":::"memory");
    #pragma unroll
    for(int i=0;i<4;++i){const int row=i*8+(lane>>3),ch=lane&7; const u32x4 v=*(const u32x4*)(stg+row*64+ch*8); ATTN_STORE16(Ow+(long)row*POUT+ch*8,v);} }
  asm volatile("s_waitcnt lgkmcnt(0)\n\ts_barrier":::"memory");
  #undef DMA_K
  #undef DMA_V
  #undef CMASK
  #undef CINIT0
  #undef CINIT1
  #undef START
  #undef RESC
  #undef ROT
}
#undef SBAR
#undef WAIT_BAR
}

__device__ __forceinline__ void attn_phase(const Frame& F, const Args& a) {
    const bf16_t* proj = (const bf16_t*)(a.ws + WS_PROJ); bf16_t* OA = (bf16_t*)(a.ws + WS_OA);
    const int vcu = (F.G % 8 == 0) ? (F.bid % 8) * (F.G / 8) + F.bid / 8 : F.bid;
    for (int i = 0;; ++i) {
        int bvh, qb;
        if (F.G == 256) { if (i >= 4) break; const int s = vcu & 3; bvh = vcu >> 2; qb = (i == 0) ? s : (i == 1) ? 7 - s : (i == 2) ? 8 + s : 15 - s; }
        else { const int u = i * F.G + F.bid; if (u >= 1024) break; bvh = u >> 4; qb = 15 - (u & 15); }
        const int b = bvh >> 4, vh = bvh & 15, h = vh >> 2, map = (vh >> 1) & 1, dvh = vh & 1;
        const bf16_t* base = proj + (size_t)b * SEQ * INC;
        const float slope2 = exp2f(-2.0f * (h + 1)) * 1.4426950408889634f;
        attn_body::attn_unit<8>(qb, base + C_QDA + h * 128 + map * 64, base + C_KDA + h * 128 + map * 64, base + C_VDA + h * 128 + dvh * 64,
                                OA + (size_t)b * SEQ * 1024 + vh * 64, slope2, (char*)F.lds);
    }
}
__device__ __forceinline__ void attn_combine(const Frame& F, const Args& a) {
    const bf16_t* OA = (const bf16_t*)(a.ws + WS_OA); bf16_t* Y = (bf16_t*)(a.ws + WS_YDA);
    const float lam = ((const float*)(a.ws + WS_SMALL))[0];
    const float g0 = a.in[I_SUBG][2 * F.lane] * 0.8f, g1 = a.in[I_SUBG][2 * F.lane + 1] * 0.8f;
    const int gw = F.bid * NWAVES + F.wave, NGW = F.G * NWAVES;
    for (int r = gw; r < T; r += NGW) {
        const unsigned* orow = (const unsigned*)(OA + (size_t)r * 1024); unsigned* yrow = (unsigned*)(Y + (size_t)r * 512);
        unsigned w0[4], w1[4];
#pragma unroll
        for (int h = 0; h < 4; ++h) { w0[h] = orow[h * 128 + F.lane]; w1[h] = orow[h * 128 + 64 + F.lane]; }
#pragma unroll
        for (int h = 0; h < 4; ++h) {
            const float x0 = bf2f(w0[h] & 0xffffu) - lam * bf2f(w1[h] & 0xffffu), x1 = bf2f(w0[h] >> 16) - lam * bf2f(w1[h] >> 16);
            const float rs = rsqrtf(wave_sum(x0 * x0 + x1 * x1) * (1.0f / 128.0f) + EPS);
            yrow[h * 64 + F.lane] = pk2(x0 * rs * g0, x1 * rs * g1);
        }
    }
}
namespace hg {
constexpr int QP = 136;
constexpr int L_QD = 0, L_KD = 64 * QP * 2, L_V = 2 * 64 * QP * 2, L_KE = 3 * 64 * QP * 2, L_SSQ = 4 * 64 * QP * 2;
__device__ __forceinline__ f32x4 mfma16(bf16x8 a, bf16x8 b, f32x4 c) { return __builtin_amdgcn_mfma_f32_16x16x32_bf16(a, b, c, 0, 0, 0); }
#define HG_BAR() do { asm volatile("s_waitcnt lgkmcnt(0)" ::: "memory"); __builtin_amdgcn_s_barrier(); asm volatile("" ::: "memory"); } while (0)
typedef short v4i16_t __attribute__((ext_vector_type(4)));
__device__ __forceinline__ bf16x8 tr8(const LAS unsigned char* img, int ra, int rb, int col0, int lane) {
    const int q = (lane & 15) >> 2, p = lane & 3;
    const v4i16_t lo = __builtin_amdgcn_ds_read_tr16_b64_v4i16((LAS v4i16_t*)(img + ((ra + q) * QP + col0 + 4 * p) * 2));
    const v4i16_t hi = __builtin_amdgcn_ds_read_tr16_b64_v4i16((LAS v4i16_t*)(img + ((rb + q) * QP + col0 + 4 * p) * 2));
    return (bf16x8){lo[0], lo[1], lo[2], lo[3], hi[0], hi[1], hi[2], hi[3]};
}
struct Tile { u32x4 p[2]; };
__device__ __forceinline__ void tile_load(Tile& t, const bf16_t* src, size_t pitch, int tid) {
#pragma unroll
    for (int i = 0; i < 2; ++i) { const int pc = tid + NTHR * i; t.p[i] = *(const u32x4*)(src + (size_t)(pc >> 4) * pitch + (pc & 15) * 8); }
}
__device__ __forceinline__ void tile_put(const Tile& t, LAS unsigned char* img, int tid) {
#pragma unroll
    for (int i = 0; i < 2; ++i) { const int pc = tid + NTHR * i; *(LAS u32x4*)(img + ((pc >> 4) * QP + (pc & 15) * 8) * 2) = t.p[i]; }
}
struct In1 { Tile ke, v; };
__device__ __forceinline__ void load1(In1& r, const Frame& F, const Args& a, int unit) {
    const int bh = unit >> 6, n = unit & 63, b = bh >> 2, h = bh & 3; const size_t t0 = (size_t)b * SEQ + n * 64;
    tile_load(r.ke, (const bf16_t*)a.out + t0 * 512 + h * 128, 512, F.tid);
    tile_load(r.v, (const bf16_t*)(a.ws + WS_PROJ) + t0 * INC + C_IHG + h * 128, INC, F.tid);
}
__device__ __forceinline__ void stage1_unit(const In1& raw, const Frame& F, const Args& a, int unit) {
    const int bh = unit >> 6, n = unit & 63;
    tile_put(raw.ke, F.lds + L_KE, F.tid); tile_put(raw.v, F.lds + L_V, F.tid);
    HG_BAR();
    const int wk = F.wave >> 1, wv = F.wave & 1, fr = F.lane & 15, fq = F.lane >> 4;
    f32x4 acc[2][4];
#pragma unroll
    for (int i = 0; i < 2; ++i)
#pragma unroll
        for (int j = 0; j < 4; ++j) acc[i][j] = (f32x4){0.f, 0.f, 0.f, 0.f};
#pragma unroll
    for (int s2 = 0; s2 < 2; ++s2) {
        bf16x8 af[2], bv[4];
#pragma unroll
        for (int kt = 0; kt < 2; ++kt) af[kt] = tr8(F.lds + L_KE, 32 * s2 + 8 * fq, 32 * s2 + 8 * fq + 4, 32 * wk + 16 * kt, F.lane);
#pragma unroll
        for (int vt = 0; vt < 4; ++vt) bv[vt] = tr8(F.lds + L_V, 32 * s2 + 8 * fq, 32 * s2 + 8 * fq + 4, 64 * wv + 16 * vt, F.lane);
#pragma unroll
        for (int kt = 0; kt < 2; ++kt)
#pragma unroll
            for (int vt = 0; vt < 4; ++vt) acc[kt][vt] = mfma16(af[kt], bv[vt], acc[kt][vt]);
    }
    bf16_t* ds = (bf16_t*)(a.ws + WS_DS) + ((size_t)bh * 64 + n) * 16384;
#pragma unroll
    for (int kt = 0; kt < 2; ++kt)
#pragma unroll
        for (int vt = 0; vt < 4; ++vt) { const int v = 64 * wv + 16 * vt + fr, k = 32 * wk + 16 * kt + 4 * fq;
            u32x2 w; w.x = pk2(acc[kt][vt][0], acc[kt][vt][1]); w.y = pk2(acc[kt][vt][2], acc[kt][vt][3]); *(u32x2*)(ds + v * 128 + k) = w; }
    HG_BAR();
}
__device__ __forceinline__ void stage1_all(const Frame& F, const Args& a) {
    int u = F.bid; if (u >= 1024) return;
    In1 cur, nxt; load1(cur, F, a, u);
    for (; u < 1024; u += F.G) { const int un = (u + F.G < 1024) ? u + F.G : u; load1(nxt, F, a, un); stage1_unit(cur, F, a, u); cur = nxt; }
}
__device__ __forceinline__ void stage2_scan(const Frame& F, const Args& a) {
    unsigned* ds = (unsigned*)(a.ws + WS_DS); const float* dec = (const float*)(a.ws + WS_DEC);
    for (int gt = F.bid * NTHR + F.tid; gt < 16 * 8192; gt += F.G * NTHR) {
        const int bh = gt >> 13, e2 = gt & 8191, k = (2 * e2) & 127;
        unsigned* p = ds + (size_t)bh * 64 * 8192 + e2; const float* dp = dec + (size_t)bh * 64 * 128 + k;
        float s0 = 0.f, s1 = 0.f;
#pragma unroll 8
        for (int n = 0; n < 64; ++n) { const unsigned u = p[(size_t)n * 8192]; const f32x2 d = *(const f32x2*)(dp + n * 128);
            p[(size_t)n * 8192] = pk2(s0, s1); s0 = d.x * s0 + bf2f(u & 0xffffu); s1 = d.y * s1 + bf2f(u >> 16); }
    }
}
struct In3 { Tile qd, kd, v; };
__device__ __forceinline__ void load3(In3& r, const Frame& F, const Args& a, int unit) {
    const int bh = unit >> 6, n = unit & 63, b = bh >> 2, h = bh & 3;
    const bf16_t* base = (const bf16_t*)(a.ws + WS_PROJ) + ((size_t)b * SEQ + n * 64) * INC;
    tile_load(r.qd, base + C_HGT + 256 * h, INC, F.tid); tile_load(r.kd, base + C_HGT + 256 * h + 128, INC, F.tid); tile_load(r.v, base + C_IHG + h * 128, INC, F.tid);
}
__device__ __forceinline__ void stage3_unit(const In3& raw, const Frame& F, const Args& a, int unit) {
    const int bh = unit >> 6, n = unit & 63, b = bh >> 2, h = bh & 3;
    const int tb = F.wave >> 1, vh = F.wave & 1, fr = F.lane & 15, fq = F.lane >> 4;
    const bf16_t* sst = (const bf16_t*)(a.ws + WS_DS) + ((size_t)bh * 64 + n) * 16384;
    bf16x8 sb[4][4];
#pragma unroll
    for (int ks = 0; ks < 4; ++ks)
#pragma unroll
        for (int vt = 0; vt < 4; ++vt) sb[ks][vt] = *(const bf16x8*)(sst + (64 * vh + 16 * vt + fr) * 128 + 32 * ks + 8 * fq);
    const size_t t0 = (size_t)b * SEQ + n * 64 + 16 * tb + 4 * fq;
    const bf16_t* gp = (const bf16_t*)(a.ws + WS_PROJ) + t0 * INC + C_GHG + h * 128 + 64 * vh + fr;
    unsigned short gv[4][4];
#pragma unroll
    for (int r = 0; r < 4; ++r)
#pragma unroll
        for (int vt = 0; vt < 4; ++vt) gv[r][vt] = gp[(size_t)r * INC + 16 * vt];
    tile_put(raw.qd, F.lds + L_QD, F.tid); tile_put(raw.kd, F.lds + L_KD, F.tid); tile_put(raw.v, F.lds + L_V, F.tid);
    HG_BAR();
    bf16x8 qf[4];
#pragma unroll
    for (int ks = 0; ks < 4; ++ks) qf[ks] = *(const LAS bf16x8*)(F.lds + L_QD + ((16 * tb + fr) * QP + 32 * ks + 8 * fq) * 2);
    unsigned pk[4][2];
#pragma unroll
    for (int jt = 0; jt < 4; ++jt) { pk[jt][0] = 0u; pk[jt][1] = 0u;
        if (jt <= tb) { f32x4 sc = (f32x4){0.f, 0.f, 0.f, 0.f};
#pragma unroll
            for (int ks = 0; ks < 4; ++ks) { const bf16x8 kf = *(const LAS bf16x8*)(F.lds + L_KD + ((16 * jt + fr) * QP + 32 * ks + 8 * fq) * 2); sc = mfma16(kf, qf[ks], sc); }
            if (jt == tb) {
#pragma unroll
                for (int r = 0; r < 4; ++r) if (4 * fq + r > fr) sc[r] = 0.f;
            }
            pk[jt][0] = pk2(sc[0], sc[1]); pk[jt][1] = pk2(sc[2], sc[3]); } }
    f32x4 o[4];
#pragma unroll
    for (int vt = 0; vt < 4; ++vt) o[vt] = (f32x4){0.f, 0.f, 0.f, 0.f};
#pragma unroll
    for (int s2 = 0; s2 < 2; ++s2) if (2 * s2 <= tb) {
        const u32x4 aw = (u32x4){pk[2 * s2][0], pk[2 * s2][1], pk[2 * s2 + 1][0], pk[2 * s2 + 1][1]};
        const bf16x8 af = __builtin_bit_cast(bf16x8, aw);
#pragma unroll
        for (int vt = 0; vt < 4; ++vt) o[vt] = mfma16(af, tr8(F.lds + L_V, 32 * s2 + 4 * fq, 32 * s2 + 16 + 4 * fq, 64 * vh + 16 * vt, F.lane), o[vt]);
    }
#pragma unroll
    for (int ks = 0; ks < 4; ++ks)
#pragma unroll
        for (int vt = 0; vt < 4; ++vt) o[vt] = mfma16(qf[ks], sb[ks][vt], o[vt]);
    float ss[4];
#pragma unroll
    for (int r = 0; r < 4; ++r) { float v = 0.f;
#pragma unroll
        for (int vt = 0; vt < 4; ++vt) v += o[vt][r] * o[vt][r];
        v += __shfl_xor(v, 1); v += __shfl_xor(v, 2); v += __shfl_xor(v, 4); v += __shfl_xor(v, 8); ss[r] = v; }
    LAS float* SSQ = (LAS float*)(F.lds + L_SSQ);
    if (fr == 0) {
#pragma unroll
        for (int r = 0; r < 4; ++r) SSQ[(tb * 2 + vh) * 16 + 4 * fq + r] = ss[r]; }
    HG_BAR();
    bf16_t* yp = (bf16_t*)(a.ws + WS_YHG) + t0 * 512 + h * 128 + 64 * vh + fr;
#pragma unroll
    for (int r = 0; r < 4; ++r) { const float tot = SSQ[(tb * 2) * 16 + 4 * fq + r] + SSQ[(tb * 2 + 1) * 16 + 4 * fq + r]; const float rs = rsqrtf(tot * (1.0f / 128.0f) + EPS);
#pragma unroll
        for (int vt = 0; vt < 4; ++vt) { const float g = bf2f(gv[r][vt]); const float ng = a.in[I_HGNG][64 * vh + 16 * vt + fr];
            yp[(size_t)r * 512 + 16 * vt] = (bf16_t)f2bf(o[vt][r] * rs * ng * siluf_(g)); } }
    HG_BAR();
}
__device__ __forceinline__ void stage3_all(const Frame& F, const Args& a) {
    int u = F.bid; if (u >= 1024) return;
    In3 cur, nxt; load3(cur, F, a, u);
    for (; u < 1024; u += F.G) { const int un = (u + F.G < 1024) ? u + F.G : u; load3(nxt, F, a, un); stage3_unit(cur, F, a, u); cur = nxt; }
}
#undef HG_BAR
}

__device__ __forceinline__ float rs4(float a0, float a1, float a2, float a3, int lane) {
    const bool hi = (lane & 32) != 0;
    const float s0 = hi ? a0 : a2, s1 = hi ? a1 : a3;
    const float k0 = (hi ? a2 : a0) + __shfl_xor(s0, 32), k1 = (hi ? a3 : a1) + __shfl_xor(s1, 32);
    const bool b4 = (lane & 16) != 0;
    const float sd = b4 ? k0 : k1;
    float k = (b4 ? k1 : k0) + __shfl_xor(sd, 16);
    k += __shfl_xor(k, 8); k += __shfl_xor(k, 4); k += __shfl_xor(k, 2); k += __shfl_xor(k, 1);
    return k;
}
__device__ __forceinline__ void phase_router(const Frame& F, const Args& a) {
    LAS float* Wr = (LAS float*)F.lds;
    LAS unsigned* LH = (LAS unsigned*)(F.lds + 147 * 1024);
    LAS unsigned* LB = LH + 32;
    LAS unsigned* LR = LH + 64;
    if (F.tid < NEXP) LH[F.tid] = 0u;
    for (int i = F.tid; i < 1024 * 9; i += NTHR) {
        if (i < 1024 * 8) { const int k = i >> 3, o4 = (i & 7) * 4; const f32x4 w = *(const f32x4*)(a.in[I_WRE] + k * 32 + o4);
            Wr[(4 + o4) * 1024 + k] = w.x; Wr[(5 + o4) * 1024 + k] = w.y; Wr[(6 + o4) * 1024 + k] = w.z; Wr[(7 + o4) * 1024 + k] = w.w; }
        else { const int k = i - 1024 * 8; const f32x4 w = *(const f32x4*)(a.in[I_WRG] + k * 4);
            Wr[k] = w.x; Wr[1024 + k] = w.y; Wr[2048 + k] = w.z; Wr[3072 + k] = w.w; }
    }
    __syncthreads();
    const float* mod = (const float*)(a.ws + WS_MOD);
    const float* x1 = a.out; bf16_t* H2 = (bf16_t*)(a.ws + WS_ACT);
    unsigned* counts = (unsigned*)(a.ws + WS_CTL) + CW_COUNTS; unsigned* tokinfo = (unsigned*)(a.ws + WS_TOKINFO); int* toklist = (int*)(a.ws + WS_TOKLIST);
    const int rows_per_blk = T / F.G, r0 = F.bid * rows_per_blk, b = r0 / SEQ;
    const int lane = F.lane, li = lane & 15, lbase = lane & 48;
    for (int rb = r0 + 4 * F.wave; rb < r0 + rows_per_blk; rb += 4 * NWAVES) {
        f32x4 v[4][4]; float sq[4];
#pragma unroll
        for (int q = 0; q < 4; ++q) { const f32x4* xr = (const f32x4*)(x1 + (size_t)(rb + q) * D) + lane; float s = 0.f;
#pragma unroll
            for (int j = 0; j < 4; ++j) { v[q][j] = xr[64 * j]; s += (v[q][j].x * v[q][j].x + v[q][j].y * v[q][j].y) + (v[q][j].z * v[q][j].z + v[q][j].w * v[q][j].w); }
            sq[q] = s; }
        const float tot = rs4(sq[0], sq[1], sq[2], sq[3], lane);
        const float rsl = rsqrtf(tot * (1.0f / D) + EPS);
        float rs[4];
#pragma unroll
        for (int q = 0; q < 4; ++q) rs[q] = __shfl(rsl, 16 * q);
#pragma unroll
        for (int j = 0; j < 4; ++j) { const int k = 256 * j + 4 * lane;
            const f32x4 g = *(const f32x4*)(a.in[I_N2G] + k), sc = *(const f32x4*)(mod + b * 6144 + 4 * 1024 + k), sh = *(const f32x4*)(mod + b * 6144 + 3 * 1024 + k);
            const f32x4 gg = g * (1.0f + sc);
#pragma unroll
            for (int q = 0; q < 4; ++q) { v[q][j] = v[q][j] * rs[q] * gg + sh;
                ((unsigned long long*)(H2 + (size_t)(rb + q) * D))[64 * j + lane] = (unsigned long long)pk2(v[q][j].x, v[q][j].y) | ((unsigned long long)pk2(v[q][j].z, v[q][j].w) << 32); } }
        float slot[3];
#pragma unroll
        for (int oc = 0; oc < 3; ++oc) { float sl = 0.f;
#pragma unroll 4
            for (int oo = 0; oo < (oc < 2 ? 16 : 4); ++oo) { const int o = 16 * oc + oo; f32x2 p[4] = {{0.f, 0.f}, {0.f, 0.f}, {0.f, 0.f}, {0.f, 0.f}};
#pragma unroll
                for (int j = 0; j < 4; ++j) { const f32x4 w = *(const LAS f32x4*)(Wr + o * 1024 + 256 * j + 4 * lane); const f32x2 wl = {w.x, w.y}, wh = {w.z, w.w};
#pragma unroll
                    for (int q = 0; q < 4; ++q) { p[q] = __builtin_elementwise_fma((f32x2){v[q][j].x, v[q][j].y}, wl, p[q]); p[q] = __builtin_elementwise_fma((f32x2){v[q][j].z, v[q][j].w}, wh, p[q]); } }
                const float k = rs4(p[0].x + p[0].y, p[1].x + p[1].y, p[2].x + p[2].y, p[3].x + p[3].y, lane); sl = (li == oo) ? k : sl; }
            slot[oc] = sl; }
        if (li < 4) slot[0] += a.in[I_BRG][li]; else slot[0] += a.in[I_BRE][li - 4];
        slot[1] += a.in[I_BRE][12 + li];
        if (li < 4) slot[2] += a.in[I_BRE][28 + li];
        float gl[4]; int gi = 0;
#pragma unroll
        for (int o = 0; o < 4; ++o) gl[o] = __shfl(slot[0], lbase + o);
        float gm = gl[0];
#pragma unroll
        for (int o = 1; o < 4; ++o) if (gl[o] > gm) { gm = gl[o]; gi = o; }
        float gsum = 0.f;
#pragma unroll
        for (int o = 0; o < 4; ++o) gsum += expf(gl[o] - gm);
        const float gp = 1.0f / gsum;
        float el[8];
#pragma unroll
        for (int e = 0; e < 8; ++e) { const int o = 4 + gi * 8 + e, src = lbase + (o & 15);
            const float c0 = __shfl(slot[0], src), c1 = __shfl(slot[1], src), c2 = __shfl(slot[2], src);
            el[e] = (o < 16) ? c0 : (o < 32) ? c1 : c2; }
        int i0 = 0; float m0 = el[0];
#pragma unroll
        for (int o = 1; o < 8; ++o) if (el[o] > m0) { m0 = el[o]; i0 = o; }
        int i1 = -1; float m1 = -INFINITY;
#pragma unroll
        for (int o = 0; o < 8; ++o) if (o != i0 && el[o] > m1) { m1 = el[o]; i1 = o; }
        const float e1 = expf(m1 - m0); const float w0 = gp / (1.0f + e1), w1 = gp * e1 / (1.0f + e1);
        if (li == 0) {
            const int rl = rb - r0 + (lane >> 4);
            const int ex0 = gi * 8 + i0, ex1 = gi * 8 + i1;
            const unsigned l0 = atomicAdd((unsigned*)(LH + ex0), 1u), l1 = atomicAdd((unsigned*)(LH + ex1), 1u);
            LAS unsigned* ri = LR + rl * 6;
            ri[0] = (unsigned)ex0; ri[1] = l0; ri[2] = (unsigned)ex1; ri[3] = l1; ri[4] = __float_as_uint(w0); ri[5] = __float_as_uint(w1);
        }
    }
    __syncthreads();
    if (F.tid < NEXP) LB[F.tid] = atomicAdd(counts + 64 * F.tid, LH[F.tid]);
    __syncthreads();
    for (int rl = F.tid; rl < rows_per_blk; rl += NTHR) {
        const LAS unsigned* ri = LR + rl * 6; const int r = r0 + rl;
        const unsigned ex0 = ri[0], ex1 = ri[2], k0 = LB[ex0] + ri[1], k1 = LB[ex1] + ri[3];
        toklist[ex0 * T + k0] = r; toklist[ex1 * T + k1] = r;
        u32x4 t0; t0.x = ex0; t0.y = k0; t0.z = ex1; t0.w = k1;
        *(u32x4*)(tokinfo + (size_t)r * 8) = t0;
        tokinfo[(size_t)r * 8 + 4] = ri[4]; tokinfo[(size_t)r * 8 + 5] = ri[5];
    }
}
__device__ __forceinline__ void build_moe_tab(const Frame& F, const Args& a, LAS MoeTab* tab) {
    if (F.tid == 0) {
        const unsigned* counts = (const unsigned*)(a.ws + WS_CTL) + CW_COUNTS; int nt = 0;
        for (int e = 0; e < NEXP; ++e) { const int c = (int)__hip_atomic_load(counts + 64 * e, __ATOMIC_RELAXED, __HIP_MEMORY_SCOPE_AGENT); tab->cnt[e] = c; tab->tbase[e] = nt;
            const int n = (c + 255) >> 8; for (int m = 0; m < n; ++m) { tab->tile_e[nt] = e; tab->tile_m[nt] = m; ++nt; } }
        tab->tbase[NEXP] = nt; tab->nt = nt;
    }
    __syncthreads();
}
__device__ __forceinline__ void phase_final(const Frame& F, const Args& a, const LAS MoeTab* tab) {
    const float* mod = (const float*)(a.ws + WS_MOD); const unsigned* tokinfo = (const unsigned*)(a.ws + WS_TOKINFO); const bf16_t* Ys = (const bf16_t*)(a.ws + WS_YS);
    const int rows_per_blk = T / F.G, r0 = F.bid * rows_per_blk;
    for (int r = r0 + F.wave; r < r0 + rows_per_blk; r += NWAVES) {
        const int b = r / SEQ;
        const u32x4 ti = *(const u32x4*)(tokinfo + (size_t)r * 8);
        const float w0 = __uint_as_float(tokinfo[(size_t)r * 8 + 4]), w1 = __uint_as_float(tokinfo[(size_t)r * 8 + 5]);
        const size_t s0 = (size_t)tab->tbase[ti.x] * 256 + ti.y, s1 = (size_t)tab->tbase[ti.z] * 256 + ti.w;
        f32x4* xr = (f32x4*)(a.out + (size_t)r * D) + F.lane;
        const u32x2* y0 = (const u32x2*)(Ys + s0 * D) + F.lane; const u32x2* y1 = (const u32x2*)(Ys + s1 * D) + F.lane;
        f32x4 v[4]; float s = 0.f;
#pragma unroll
        for (int j = 0; j < 4; ++j) { const int k = 256 * j + 4 * F.lane;
            const f32x4 gt = *(const f32x4*)(mod + b * 6144 + 5 * 1024 + k); const u32x2 a0 = y0[64 * j], a1 = y1[64 * j];
            f32x4 m; m.x = w0 * bf2f(a0.x & 0xffffu) + w1 * bf2f(a1.x & 0xffffu); m.y = w0 * bf2f(a0.x >> 16) + w1 * bf2f(a1.x >> 16);
            m.z = w0 * bf2f(a0.y & 0xffffu) + w1 * bf2f(a1.y & 0xffffu); m.w = w0 * bf2f(a0.y >> 16) + w1 * bf2f(a1.y >> 16);
            v[j] = xr[64 * j] + gt * m; s += (v[j].x * v[j].x + v[j].y * v[j].y) + (v[j].z * v[j].z + v[j].w * v[j].w); }
        const float rs = rsqrtf(wave_sum(s) * (1.0f / D) + EPS);
#pragma unroll
        for (int j = 0; j < 4; ++j) { const f32x4 g = *(const f32x4*)(a.in[I_FG] + 256 * j + 4 * F.lane); xr[64 * j] = v[j] * rs * g; }
    }
}

#define XB_TMO      128
#define XB_XCNT(j)  (256  + 64 * (j))
#define XB_XSUB(j)  (1280 + 64 * (j))
#define XB_XGEN(j)  (2304 + 64 * (j))
#define XB_TOP      3328
#define XB_TOPGEN   3392
#define XCD_BAR_WORDS 3456
#define XB_SPIN_CAP (1u << 18)
__device__ __forceinline__ unsigned xb_ld(unsigned* p)              { return __hip_atomic_load(p, __ATOMIC_RELAXED, __HIP_MEMORY_SCOPE_AGENT); }
__device__ __forceinline__ unsigned xb_add(unsigned* p, unsigned v) { return __hip_atomic_fetch_add(p, v, __ATOMIC_RELAXED, __HIP_MEMORY_SCOPE_AGENT); }
__device__ __forceinline__ unsigned xb_xcc_id() { return (unsigned)__builtin_amdgcn_s_getreg((3 << 11) | 20) & 0xFu; }
#define XB_SPIN(cond, bar) do { unsigned _sp = 0; while (cond) { __builtin_amdgcn_s_sleep(1); \
    if ((++_sp & 255u) == 0u) { if (xb_ld(&(bar)[XB_TMO])) break; if (_sp > XB_SPIN_CAP) { atomicAdd(&(bar)[XB_TMO], 1u); break; } } } } while (0)
struct XcdBarrier { unsigned* bar; unsigned x; volatile LAS unsigned* st; };
__device__ __forceinline__ XcdBarrier xcd_barrier_post(unsigned* bar, volatile LAS unsigned* st) {
    XcdBarrier b; b.bar = bar; b.x = xb_xcc_id(); b.st = st;
    if (threadIdx.x == 0) (void)xb_add(&bar[XB_XCNT(b.x)], 1u);
    return b;
}
__device__ __forceinline__ void xcd_barrier_complete(unsigned* bar, unsigned x, unsigned& nloc, unsigned& nx) {
    const unsigned G = gridDim.x * gridDim.y * gridDim.z;
    unsigned sum, cnt, mine, sp = 0u;
    for (;;) {
        sum = 0u; cnt = 0u; mine = 0u;
#pragma unroll
        for (unsigned j = 0; j < 16; ++j) { const unsigned c = xb_ld(&bar[XB_XCNT(j)]); sum += c; cnt += (c > 0u) ? 1u : 0u; mine = (j == x) ? c : mine; }
        if (sum == G) break;
        __builtin_amdgcn_s_sleep(1);
        if ((++sp & 255u) == 0u) { if (xb_ld(&bar[XB_TMO])) break; if (sp > XB_SPIN_CAP) { atomicAdd(&bar[XB_TMO], 1u); break; } }
    }
    nloc = mine > 0u ? mine : 1u; nx = cnt > 0u ? cnt : 1u;
}
__device__ __forceinline__ void xcd_barrier(const XcdBarrier& b) {
    asm volatile("s_waitcnt vmcnt(0)" ::: "memory");
    __syncthreads();
    if (threadIdx.x == 0) {
        unsigned* bar = b.bar;
        __builtin_amdgcn_s_waitcnt(0);
        unsigned nloc = b.st[0], nx = b.st[1];
        if (nloc == 0u) { xcd_barrier_complete(bar, b.x, nloc, nx); b.st[0] = nloc; b.st[1] = nx; }
        const unsigned old = xb_add(&bar[XB_XSUB(b.x)], 1u);
        const unsigned gen = old / nloc;
        if (old + 1u == (gen + 1u) * nloc) {
            __builtin_amdgcn_fence(__ATOMIC_RELEASE, "agent");
            asm volatile("s_waitcnt vmcnt(0)" ::: "memory");
            const unsigned og = xb_add(&bar[XB_TOP], 1u);
            const unsigned tg = og / nx;
            if (og + 1u == (tg + 1u) * nx) xb_add(&bar[XB_TOPGEN], 1u);
            else XB_SPIN(xb_ld(&bar[XB_TOPGEN]) == tg, bar);
            __builtin_amdgcn_fence(__ATOMIC_ACQUIRE, "agent");
            xb_add(&bar[XB_XGEN(b.x)], 1u);
            asm volatile("s_waitcnt vmcnt(0)" ::: "memory");
        } else {
            XB_SPIN(xb_ld(&bar[XB_XGEN(b.x)]) == gen, bar);
            __builtin_amdgcn_fence(__ATOMIC_ACQUIRE, "agent");
            asm volatile("s_waitcnt vmcnt(0)" ::: "memory");
        }
    }
    __syncthreads();
}

constexpr int N_PHASES = 12;
__global__ void __launch_bounds__(NTHR, 2) mk_fwd(Args a) {
    extern __shared__ __attribute__((aligned(16))) unsigned char lds_raw[];
    Frame F; F.lds = (LAS unsigned char*)lds_raw; F.tid = threadIdx.x; F.lane = F.tid & 63; F.wave = __builtin_amdgcn_readfirstlane(F.tid >> 6); F.G = gridDim.x; F.bid = blockIdx.x;
    unsigned char* ws = a.ws;
    const int lo = a.ph_lo, hi = a.ph_hi;
#if MK_N_LAUNCHES == 1
    volatile LAS unsigned* MISC = (volatile LAS unsigned*)(F.lds + 152 * 1024);
    if (F.tid < 4) MISC[F.tid] = 0u;
    __syncthreads();
    XcdBarrier xbar = xcd_barrier_post((unsigned*)(ws + WS_CTL) + CW_BAR, MISC);
#ifndef PROBE_TS
#define PROBE_TS -1
#endif
#define STAMP(k) do { if (PROBE_TS >= 0 && F.bid == 0 && F.tid == 0) { const unsigned long long t_ = __builtin_amdgcn_s_memrealtime(); MISC[16 + 2 * (k)] = (unsigned)t_; MISC[17 + 2 * (k)] = (unsigned)(t_ >> 32); } } while (0)
#define SEAM(k) do { if (IN(k) && IN((k) + 1)) xcd_barrier(xbar); STAMP((k) + 1); } while (0)
    STAMP(0);
#else
#define SEAM(k) do { } while (0)
#endif
#ifndef PHASE_MASK
#define PHASE_MASK 0xfff
#endif
#define IN(k) (((PHASE_MASK >> (k)) & 1) && lo <= (k) && (k) < hi)
    LAS MoeTab* tab = (LAS MoeTab*)(F.lds + 144 * 1024);

#ifndef REPEAT_PHASE
#define REPEAT_PHASE -1
#endif
#if MK_N_LAUNCHES == 1
#define RUNPH(k, ...) if (IN(k)) { F.lane = lane_now(); F.tid = F.wave * 64 + F.lane; __VA_ARGS__ if (REPEAT_PHASE == (k)) { xcd_barrier(xbar); __VA_ARGS__ } }
#else
#define RUNPH(k, ...) if (IN(k)) { F.lane = lane_now(); F.tid = F.wave * 64 + F.lane; __VA_ARGS__ }
#endif
    RUNPH(0, { phase0(F, a); }) SEAM(0);
    RUNPH(1, { phase1(F, a); }) SEAM(1);
    RUNPH(2, {
        InProjOrder S{(const char*)(ws + WS_ACT), (const char*)(ws + WS_WIN), F.G, F.bid};
        EpiInProj E{(bf16_t*)(ws + WS_PROJ), (bf16_t*)a.out, (float*)(ws + WS_DEC), (const float*)(ws + WS_SMALL) + 16, attn_body::C2};
        pg8::gemm_phase(F.lds, D, S, E);
    }) SEAM(2);
    RUNPH(3, {
        hg::stage1_all(F, a);
        __syncthreads();
        attn_phase(F, a);
    }) SEAM(3);
    RUNPH(4, { hg::stage2_scan(F, a); attn_combine(F, a); }) SEAM(4);
    RUNPH(5, { hg::stage3_all(F, a); }) SEAM(5);
    RUNPH(6, {
        UpOrder S{(const char*)(ws + WS_YDA), (const char*)(ws + WS_YHG), (const char*)(ws + WS_WUPDA), (const char*)(ws + WS_WUPHG), F.G, F.bid};
        EpiUp E{(const bf16_t*)(ws + WS_PROJ), (bf16_t*)(ws + WS_ACT)};
        pg8::gemm_phase(F.lds, 512, S, E);
    }) SEAM(6);
    RUNPH(7, {
        DenseOrder S{(const char*)(ws + WS_ACT), (const char*)(ws + WS_WOUT), D, T / 256, D / 256, F.G, F.bid};
        EpiOut E{a.in[I_X], (const float*)(ws + WS_MOD), a.out};
        pg8::gemm_phase(F.lds, D, S, E);
        moe_weight_convert(F, a);
    }) SEAM(7);
    RUNPH(8, { phase_router(F, a); __syncthreads(); }) SEAM(8);
    RUNPH(9, {
        build_moe_tab(F, a, tab);
        Moe1Order S{tab, (const char*)(ws + WS_ACT), (const char*)(ws + WS_W13), (const int*)(ws + WS_TOKLIST), F.G, F.bid};
        EpiMoe1 E{(bf16_t*)(ws + WS_HS)};
        pg8::gemm_phase(F.lds, D, S, E);
        { const int n1 = tab->nt * 4, r = n1 % F.G; const int nidle = r ? F.G - r : F.G, myidx = r ? F.bid - r : F.bid;
          if (myidx >= 0) moe_w2_convert(F, a, myidx, nidle); }
    }) SEAM(9);
    RUNPH(10, {
        build_moe_tab(F, a, tab);
        Moe2Order S{tab, (const char*)(ws + WS_HS), (const char*)(ws + WS_W2), F.G, F.bid};
        EpiStoreBf16 E{(bf16_t*)(ws + WS_YS), D, 0, 1.0f};
        pg8::gemm_phase(F.lds, DEXP, S, E);
    }) SEAM(10);
    RUNPH(11, { build_moe_tab(F, a, tab); phase_final(F, a, tab); })
#if MK_N_LAUNCHES == 1
    if (PROBE_TS >= 0) {
        __syncthreads(); STAMP(12);
        if (F.bid == 0 && F.tid == 0) {
            const int ka = PROBE_TS & 15, kb = (PROBE_TS >> 4) & 15;
            const unsigned long long a0 = ((unsigned long long)MISC[17 + 2 * ka] << 32) | MISC[16 + 2 * ka], a1 = ((unsigned long long)MISC[19 + 2 * ka] << 32) | MISC[18 + 2 * ka];
            const unsigned long long b0 = ((unsigned long long)MISC[17 + 2 * kb] << 32) | MISC[16 + 2 * kb], b1 = ((unsigned long long)MISC[19 + 2 * kb] << 32) | MISC[18 + 2 * kb];
            const float da = (float)(a1 - a0) * 0.01f, db = (float)(b1 - b0) * 0.01f;
            asm volatile("s_waitcnt vmcnt(0)" ::: "memory");
            a.out[0] += sqrtf(da * 16.78f); a.out[1] += db * 0.1f;
        }
    }
#endif
#undef IN
#undef SEAM
}

extern "C" void kernel_launch(void* const* d_in, const int* in_sizes, int n_in, void* d_out, int out_size, void* d_ws, size_t ws_size, hipStream_t stream) {
    static int grid = 0;
    if (grid == 0) {
        if (n_in != 25 || in_sizes[0] != T * D || out_size != T * D || ws_size < WS_END) { fprintf(stderr, "kernel_launch: unexpected shapes (n_in %d, in0 %d, out %d, ws %zu)\n", n_in, n_in > 0 ? in_sizes[0] : -1, out_size, ws_size); grid = -1; return; }
        int dev = 0, cus = 0, per_cu = 0;
        if (hipGetDevice(&dev) != hipSuccess || hipDeviceGetAttribute(&cus, hipDeviceAttributeMultiprocessorCount, dev) != hipSuccess) { grid = -1; return; }
        if (hipFuncSetAttribute((const void*)mk_fwd, hipFuncAttributeMaxDynamicSharedMemorySize, LDS_BYTES) != hipSuccess) { fprintf(stderr, "kernel_launch: hipFuncSetAttribute failed\n"); grid = -1; return; }
        if (hipOccupancyMaxActiveBlocksPerMultiprocessor(&per_cu, (const void*)mk_fwd, NTHR, LDS_BYTES) != hipSuccess || per_cu < 1) { fprintf(stderr, "kernel_launch: occupancy query says %d\n", per_cu); per_cu = 1; }
        (void)hipGetLastError();
        grid = cus;
        if (grid > 256) grid = 256;
        while (T % grid) --grid;
    }
    if (grid < 0) return;
    (void)hipMemsetAsync((char*)d_ws + WS_CTL, 0, CTL_ZERO_BYTES, stream);
    Args a{};
    for (int i = 0; i < 25; ++i) a.in[i] = (const float*)d_in[i];
    a.out = (float*)d_out; a.ws = (unsigned char*)d_ws;
#if MK_N_LAUNCHES == 1
    a.ph_lo = 0; a.ph_hi = N_PHASES;
    void* args[] = {&a};
    hipError_t e = hipLaunchCooperativeKernel((const void*)mk_fwd, dim3(grid), dim3(NTHR), args, LDS_BYTES, stream);
    if (e != hipSuccess) fprintf(stderr, "cooperative launch failed: %s (grid %d)\n", hipGetErrorString(e), grid);
#else
    for (int p = 0; p < N_PHASES; ++p) {
        a.ph_lo = p; a.ph_hi = p + 1;
        hipLaunchKernelGGL(mk_fwd, dim3(grid), dim3(NTHR), LDS_BYTES, stream, a);
    }
#endif
}
```

```cpp
#include <hip/hip_runtime.h>
#include <hip/hip_cooperative_groups.h>
#include <cstdio>
#include <cstdint>
namespace cg = cooperative_groups;

#ifndef MK_N_LAUNCHES
#define MK_N_LAUNCHES 1
#endif

#define LAS __attribute__((address_space(3)))
typedef unsigned short bf16_t;
typedef short bf16x8 __attribute__((ext_vector_type(8)));
typedef float f32x4 __attribute__((ext_vector_type(4)));
typedef float f32x2 __attribute__((ext_vector_type(2)));
typedef unsigned u32x4 __attribute__((ext_vector_type(4)));
typedef unsigned u32x2 __attribute__((ext_vector_type(2)));

constexpr int NB = 4, SEQ = 4096, D = 1024, T = NB * SEQ;
constexpr int INC = 5632;
constexpr int C_QDA = 0, C_KDA = 512, C_VDA = 1024, C_QHG = 1536, C_FHG = 2048, C_IHG = 2560, C_GHG = 3072, C_GDA = 3584, C_GHGATE = 4608;
constexpr int C_HGT = 1536;
constexpr int NEXP = 32, DEXP = 512;
constexpr int PMAX = 40960;
constexpr float EPS = 1e-6f;
constexpr int NWAVES = 8, NTHR = 512;

constexpr size_t MiB = 1u << 20;
constexpr size_t WS_CTL = 0, CTL_ZERO_BYTES = 64 * 1024;
constexpr size_t WS_MODP = 1 * MiB;
constexpr size_t WS_MOD = 5 * MiB / 2;
constexpr size_t WS_SMALL = 11 * MiB / 4;
constexpr size_t WS_TOKINFO = 3 * MiB;
constexpr size_t WS_TOKLIST = 4 * MiB;
constexpr size_t WS_DEC = 6 * MiB;
constexpr size_t WS_DS = 24 * MiB;
constexpr size_t WS_WIN = 8 * MiB;
constexpr size_t WS_WUPDA = 20 * MiB, WS_WUPHG = 21 * MiB, WS_WOUT = 22 * MiB;
constexpr size_t WS_ACT = 24 * MiB;
constexpr size_t WS_PROJ = 56 * MiB;
constexpr size_t WS_YDA = 232 * MiB, WS_YHG = 248 * MiB;
constexpr size_t WS_OA = 264 * MiB;
constexpr size_t WS_W13 = 56 * MiB;
constexpr size_t WS_W2 = 120 * MiB;
constexpr size_t WS_HS = 152 * MiB;
constexpr size_t WS_YS = 192 * MiB;
constexpr size_t WS_END = 296 * MiB;
constexpr int CW_COUNTS = 64;
constexpr int CW_BAR = 4096;

constexpr int LDS_BYTES = 160 * 1024;

__device__ __forceinline__ float bf2f(unsigned v) { return __uint_as_float(v << 16); }
__device__ __forceinline__ unsigned f2bf(float f) { unsigned u = __float_as_uint(f); return (u + 0x7fffu + ((u >> 16) & 1u)) >> 16; }
__device__ __forceinline__ unsigned pk2(float lo, float hi) { return f2bf(lo) | (f2bf(hi) << 16); }
__device__ __forceinline__ float sigmoidf_(float x) { return 1.0f / (1.0f + __expf(-x)); }
__device__ __forceinline__ float siluf_(float x) { return x / (1.0f + __expf(-x)); }
__device__ __forceinline__ int lane_now() { int l; asm volatile("v_mbcnt_lo_u32_b32 %0, -1, 0\n\tv_mbcnt_hi_u32_b32 %0, -1, %0" : "=v"(l)); return l; }
__device__ __forceinline__ float wave_sum(float v) {
#pragma unroll
    for (int o = 1; o < 64; o <<= 1) v += __shfl_xor(v, o);
    return v;
}

namespace pg8 {
constexpr int BM = 256, BK = 64, HALF = 128, HTB = HALF * BK * 2, STAGE_BYTES = 8 * HTB;
__host__ __device__ __forceinline__ int lds_byte(int r, int c) { const int st = (r >> 4) * 2 + (c >> 5), rr = r & 15, cc = c & 31, ob = rr * 64 + cc * 2; return st * 1024 + (ob ^ (((ob >> 9) & 1) << 5)); }
__host__ __device__ __forceinline__ void stage_rc(int b, int& R, int& C) { const int st = b / 1024, sb = b % 1024, swz = sb ^ (((sb >> 9) & 1) << 5); R = (st >> 1) * 16 + swz / 64; C = (st & 1) * 32 + (swz % 64) / 2; }
__host__ __device__ __forceinline__ int perm32(int rho) { const int n = rho >> 4, i = rho & 15; return 8 * (i >> 2) + 4 * n + (i & 3); }

struct Unit { int pm, pn; const char* A; const char* B; int aux; };
__device__ __forceinline__ unsigned cvt_pk_bf16(float lo, float hi) { unsigned r; asm volatile("v_cvt_pk_bf16_f32 %0, %1, %2" : "=v"(r) : "v"(lo), "v"(hi)); return r; }

template <class Epi, class Sched>
__device__ __forceinline__ void gemm_phase(LAS unsigned char* lds, const int K, const Sched& S, const Epi& E) {
    const int tid = threadIdx.x, wid = __builtin_amdgcn_readfirstlane(tid >> 6), lane = tid & 63, wr = wid >> 2, wc = wid & 3, fr = lane & 15, fq = lane >> 4;
    const int nt = K / BK;
    unsigned voffB[2];
#define PG8_SETLANE() do { const int _l = lane_now(), _t = wid * 64 + _l; _Pragma("unroll") for (int _i = 0; _i < 2; ++_i) { int _R, _C; stage_rc(_t * 16 + _i * 8192, _R, _C); \
        const int _Rb = Epi::PERM ? ((_R & ~31) + perm32(_R & 31)) : _R; voffB[_i] = (unsigned)(_Rb * K + _C) * 2u; } \
        aoff = lds_byte(wr * 64 + (_l & 15), (_l >> 4) * 8); boff = lds_byte(wc * 32 + (_l & 15), (_l >> 4) * 8); } while (0)
    const size_t kstep = (size_t)(BK * 2);
    const size_t hstep = (size_t)HALF * K * 2;
    const unsigned ldsw = (unsigned)wid * 1024u;
    int aoff, boff; PG8_SETLANE();
#define PG8_SA(b, h) (((b) * 2 + (h)) * HTB)
#define PG8_SB(b, h) ((4 + (b) * 2 + (h)) * HTB)
#define PG8_STAGE(bufoff, gbase, voff) do { _Pragma("unroll") for (int _i = 0; _i < 2; ++_i) \
        __builtin_amdgcn_global_load_lds((const unsigned*)((const char*)(gbase) + (voff)[_i]), (LAS unsigned*)(lds + (bufoff) + ldsw + _i * 8192), 16, 0, 0); } while (0)
#define PG8_LDA(dst, b, h) do { _Pragma("unroll") for (int m = 0; m < 4; ++m) _Pragma("unroll") for (int k = 0; k < 2; ++k) dst[m][k] = *(const LAS bf16x8*)(lds + PG8_SA(b, h) + aoff + m * 2048 + k * 1024); } while (0)
#define PG8_LDB(dst, b, h) do { _Pragma("unroll") for (int n = 0; n < 2; ++n) _Pragma("unroll") for (int k = 0; k < 2; ++k) dst[n][k] = *(const LAS bf16x8*)(lds + PG8_SB(b, h) + boff + n * 2048 + k * 1024); } while (0)
#define PG8_MMA(ai, bj, At, Bt) do { __builtin_amdgcn_s_setprio(1); _Pragma("unroll") for (int m = 0; m < 4; ++m) _Pragma("unroll") for (int n = 0; n < 2; ++n) _Pragma("unroll") for (int k = 0; k < 2; ++k) \
        acc[ai][bj][m][n] = __builtin_amdgcn_mfma_f32_16x16x32_bf16(Bt[n][k], At[m][k], acc[ai][bj][m][n], 0, 0, 0); __builtin_amdgcn_s_setprio(0); } while (0)
#define PG8_WAIT_V(n) asm volatile("s_waitcnt vmcnt(" #n ")" ::: "memory")
#define PG8_WAIT_L(n) asm volatile("s_waitcnt lgkmcnt(" #n ")" ::: "memory")
#define PG8_BAR __builtin_amdgcn_s_barrier()
#define PG8_SCHED __builtin_amdgcn_sched_barrier(0)
#define PG8_SETA(vo, u) do { const int _t = wid * 64 + lane_now(); _Pragma("unroll") for (int _i = 0; _i < 2; ++_i) { int _R, _C; stage_rc(_t * 16 + _i * 8192, _R, _C); \
        _Pragma("unroll") for (int _h = 0; _h < 2; ++_h) vo[_h][_i] = (unsigned)((size_t)S.arow(u, _h * HALF + _R) * (size_t)K + _C) * 2u; } if (Sched::GATHER) PG8_WAIT_V(0); } while (0)
    Unit cur, nxt; int ui = 0;
    if (!S.next(0, cur)) return;
    f32x4 acc[2][2][4][2];
#pragma unroll
    for (int a = 0; a < 2; ++a)
#pragma unroll
        for (int b = 0; b < 2; ++b)
#pragma unroll
            for (int m = 0; m < 4; ++m)
#pragma unroll
                for (int n = 0; n < 2; ++n) acc[a][b][m][n] = (f32x4){0.f, 0.f, 0.f, 0.f};
    bf16x8 At[4][2], B0[2][2], B1[2][2];
    unsigned voC[2][2], voN[2][2];
    PG8_SETA(voC, cur);
    const char* cA = cur.A; const char* cB = cur.B;
    PG8_STAGE(PG8_SB(0, 0), cB, voffB); PG8_STAGE(PG8_SB(0, 1), cB + hstep, voffB); PG8_STAGE(PG8_SA(0, 0), cA, voC[0]); PG8_STAGE(PG8_SA(0, 1), cA, voC[1]);
    if (wr == 1) PG8_BAR;
    PG8_WAIT_V(2); PG8_BAR;
    PG8_STAGE(PG8_SB(1, 0), cB + kstep, voffB); PG8_STAGE(PG8_SA(1, 0), cA + kstep, voC[0]); PG8_STAGE(PG8_SB(1, 1), cB + hstep + kstep, voffB);
    PG8_WAIT_V(6); PG8_BAR;
    for (;;) {
        const bool has_next = S.next(ui + 1, nxt);
        if (has_next) { PG8_SETA(voN, nxt); }
        else {
#pragma unroll
            for (int h = 0; h < 2; ++h)
#pragma unroll
                for (int i = 0; i < 2; ++i) voN[h][i] = voC[h][i];
        }
        const char* nA = has_next ? nxt.A : cA; const char* nB = has_next ? nxt.B : cB;
        for (int t = 0; t < nt; t += 2) {
            const bool last = (t == nt - 2);
            const char* a1 = cA + (size_t)(t + 1) * kstep;
            const char* a2 = last ? nA : cA + (size_t)(t + 2) * kstep; const char* b2 = last ? nB : cB + (size_t)(t + 2) * kstep;
            const char* a3 = a2 + kstep; const char* b3 = b2 + kstep;
            unsigned vo2[2][2];
#pragma unroll
            for (int h = 0; h < 2; ++h)
#pragma unroll
                for (int i = 0; i < 2; ++i) vo2[h][i] = last ? voN[h][i] : voC[h][i];
            PG8_LDB(B0, 0, 0); PG8_LDB(B1, 0, 1); PG8_SCHED; PG8_LDA(At, 0, 0); PG8_STAGE(PG8_SA(1, 1), a1, voC[1]);
            PG8_WAIT_V(8); PG8_WAIT_L(0); PG8_BAR; PG8_MMA(0, 0, At, B0); PG8_MMA(0, 1, At, B1); PG8_BAR; PG8_SCHED;
            PG8_LDA(At, 0, 1); PG8_STAGE(PG8_SB(0, 0), b2, voffB); PG8_STAGE(PG8_SB(0, 1), b2 + hstep, voffB); PG8_STAGE(PG8_SA(0, 0), a2, vo2[0]);
            PG8_WAIT_V(8); PG8_WAIT_L(0); PG8_BAR; PG8_MMA(1, 0, At, B0); PG8_MMA(1, 1, At, B1); PG8_BAR; PG8_SCHED;
            PG8_LDB(B0, 1, 0); PG8_LDB(B1, 1, 1); PG8_SCHED; PG8_LDA(At, 1, 0); PG8_STAGE(PG8_SA(0, 1), a2, vo2[1]);
            PG8_WAIT_V(8); PG8_WAIT_L(0); PG8_BAR; PG8_MMA(0, 0, At, B0); PG8_MMA(0, 1, At, B1); PG8_BAR; PG8_SCHED;
            PG8_LDA(At, 1, 1); PG8_STAGE(PG8_SB(1, 0), b3, voffB); PG8_STAGE(PG8_SB(1, 1), b3 + hstep, voffB); PG8_STAGE(PG8_SA(1, 0), a3, vo2[0]);
            PG8_WAIT_V(8); PG8_WAIT_L(0); PG8_BAR; PG8_MMA(1, 0, At, B0); PG8_MMA(1, 1, At, B1); PG8_BAR; PG8_SCHED;
        }
        if (wr == 0) PG8_BAR;
        const bool keep = E(acc, cur, wr, wc, fr, fq);
        if (!has_next) break;
        if (!keep) {
#pragma unroll
            for (int a = 0; a < 2; ++a)
#pragma unroll
                for (int b = 0; b < 2; ++b)
#pragma unroll
                    for (int m = 0; m < 4; ++m)
#pragma unroll
                        for (int n = 0; n < 2; ++n) acc[a][b][m][n] = (f32x4){0.f, 0.f, 0.f, 0.f};
        }
        cur = nxt; cA = nA; cB = nB; ++ui;
        if (Sched::GATHER) {
#pragma unroll
            for (int h = 0; h < 2; ++h)
#pragma unroll
                for (int i = 0; i < 2; ++i) voC[h][i] = voN[h][i];
        } else { PG8_SETA(voC, cur); }
        PG8_SETLANE();
        if (wr == 1) PG8_BAR;
    }
    PG8_WAIT_V(0);
    PG8_BAR;
#undef PG8_SA
#undef PG8_SB
#undef PG8_STAGE
#undef PG8_LDA
#undef PG8_LDB
#undef PG8_MMA
#undef PG8_WAIT_V
#undef PG8_WAIT_L
#undef PG8_BAR
#undef PG8_SCHED
#undef PG8_SETA
#undef PG8_SETLANE
}
}

struct Args { const float* in[25]; float* out; unsigned char* ws; int ph_lo, ph_hi; };
enum { I_X = 0, I_C, I_WADA, I_BADA, I_N1G, I_WIN, I_LQ1, I_LK1, I_LQ2, I_LK2, I_SUBG, I_LBL, I_HGNG, I_WUPDA, I_WUPHG, I_WOUT, I_N2G, I_WRG, I_BRG, I_WRE, I_BRE, I_W1, I_W3, I_W2, I_FG };

struct DenseOrder {
    static constexpr bool GATHER = false;
    const char* A; const char* Bt; int K, nM, nN, G, c;
    __device__ __forceinline__ bool next(int i, pg8::Unit& u) const {
        const int L = i * G + c, nwg = nM * nN; if (L >= nwg) return false;
        int wgid = L; { const int q = nwg / 8, r = nwg % 8, xcd = wgid % 8, off = wgid / 8; wgid = (xcd < r ? xcd * (q + 1) : r * (q + 1) + (xcd - r) * q) + off; }
        const int nig = 8 * nN, gid = wgid / nig, fm = gid * 8, gsz = (nM - fm) < 8 ? (nM - fm) : 8;
        u.pm = fm + ((wgid % nig) % gsz); u.pn = (wgid % nig) / gsz; u.A = A; u.B = Bt + (size_t)u.pn * 256 * K * 2; u.aux = 0; return true;
    }
    __device__ __forceinline__ unsigned arow(const pg8::Unit& u, int r) const { return (unsigned)(u.pm * 256 + r); }
};
struct UpOrder {
    static constexpr bool GATHER = false;
    const char* A0; const char* A1; const char* B0; const char* B1; int G, c;
    __device__ __forceinline__ bool next(int i, pg8::Unit& u) const {
        const int tile = (i >> 1) * G + c; if (tile >= 256) return false;
        u.pm = tile >> 2; u.pn = tile & 3; u.aux = i & 1;
        u.A = (i & 1) ? A1 : A0; u.B = ((i & 1) ? B1 : B0) + (size_t)u.pn * 256 * 512 * 2; return true;
    }
    __device__ __forceinline__ unsigned arow(const pg8::Unit& u, int r) const { return (unsigned)(u.pm * 256 + r); }
};
struct MoeTab { int nt; int pad[3]; int tile_e[176]; int tile_m[176]; int cnt[32]; int tbase[33]; };
struct Moe1Order {
    static constexpr bool GATHER = true;
    const LAS MoeTab* tab; const char* A; const char* W; const int* toklist; int G, c;
    __device__ __forceinline__ bool next(int i, pg8::Unit& u) const {
        const int L = i * G + c; if (L >= tab->nt * 4) return false;
        const int ti = L >> 2; u.pm = ti; u.pn = L & 3; u.aux = ti; u.A = A;
        u.B = W + ((size_t)tab->tile_e[ti] * 1024 + (size_t)u.pn * 256) * 1024 * 2; return true;
    }
    __device__ __forceinline__ unsigned arow(const pg8::Unit& u, int r) const {
        const int e = tab->tile_e[u.aux], rr = tab->tile_m[u.aux] * 256 + r;
        return rr < tab->cnt[e] ? (unsigned)toklist[e * T + rr] : 0u;
    }
};
struct Moe2Order {
    static constexpr bool GATHER = false;
    const LAS MoeTab* tab; const char* A; const char* W; int G, c;
    __device__ __forceinline__ bool next(int i, pg8::Unit& u) const {
        const int L = i * G + c; if (L >= tab->nt * 4) return false;
        const int ti = L >> 2; u.pm = ti; u.pn = L & 3; u.aux = ti; u.A = A;
        u.B = W + ((size_t)tab->tile_e[ti] * 1024 + (size_t)u.pn * 256) * 512 * 2; return true;
    }
    __device__ __forceinline__ unsigned arow(const pg8::Unit& u, int r) const { return (unsigned)(u.pm * 256 + r); }
};

using pg8::Unit; using pg8::cvt_pk_bf16;
struct EpiStoreBf16 {
    static constexpr bool PERM = true;
    bf16_t* O; int ldc; int nscale; float scale0;
    __device__ __forceinline__ bool operator()(f32x4 (&acc)[2][2][4][2], const Unit& u, int wr, int wc, int fr, int fq) const {
        const int row0 = u.pm * 256 + wr * 64 + fr, col0 = u.pn * 256 + wc * 32 + 8 * fq;
        const float sc = u.pn < nscale ? scale0 : 1.0f;
#pragma unroll
        for (int ai = 0; ai < 2; ++ai)
#pragma unroll
            for (int m = 0; m < 4; ++m) { bf16_t* rowp = O + (size_t)(row0 + ai * 128 + m * 16) * ldc + col0;
#pragma unroll
                for (int bj = 0; bj < 2; ++bj) { const f32x4 v0 = acc[ai][bj][m][0] * sc, v1 = acc[ai][bj][m][1] * sc;
                    u32x4 w; w.x = cvt_pk_bf16(v0[0], v0[1]); w.y = cvt_pk_bf16(v0[2], v0[3]); w.z = cvt_pk_bf16(v1[0], v1[1]); w.w = cvt_pk_bf16(v1[2], v1[3]);
                    *(u32x4*)(rowp + bj * 128) = w; } }
        return false;
    }
};
template <int N> __device__ __forceinline__ float dpp_shr(float x) { return __builtin_bit_cast(float, __builtin_amdgcn_update_dpp(0, __builtin_bit_cast(int, x), 0x110 + N, 0xf, 0xf, true)); }
__device__ __forceinline__ float scan16(float x) { x += dpp_shr<1>(x); x += dpp_shr<2>(x); x += dpp_shr<4>(x); x += dpp_shr<8>(x); return x; }
struct EpiInProj {
    static constexpr bool PERM = true;
    bf16_t* O; bf16_t* KE; float* DEC; const float* lbv; float scale0;
    __device__ __forceinline__ bool operator()(f32x4 (&acc)[2][2][4][2], const Unit& u, int wr, int wc, int fr, int fq) const {
        { const int l_ = lane_now(); fr = l_ & 15; fq = l_ >> 4; }
        const int row0 = u.pm * 256 + wr * 64 + fr, col0 = u.pn * 256 + wc * 32 + 8 * fq;
        if (u.pn >= 6 && u.pn < 10) {
            const int h = u.pn - 6, lane = 16 * fq + fr, kb = wc * 32 + 8 * fq, bsrc = (lane & 48) | 15;
            const int bb = (u.pm * 256) / SEQ, ch0 = ((u.pm * 256) % SEQ + wr * 64) >> 6;
#pragma unroll
            for (int ai = 0; ai < 2; ++ai) {
                unsigned kep[4][4];
#pragma unroll
                for (int n = 0; n < 2; ++n) {
#pragma unroll
                    for (int ep = 0; ep < 2; ++ep) {
                        float ke2[2][4];
#pragma unroll
                        for (int z = 0; z < 2; ++z) {
                            const int e = 2 * ep + z; const float lb = lbv[h * 128 + kb + 4 * n + e];
                            float f[4], c[4], tot[4];
#pragma unroll
                            for (int m = 0; m < 4; ++m) { const float fl = acc[ai][1][m][n][e]; f[m] = lb + (1.0f - lb) * __builtin_amdgcn_rcpf(1.0f + __builtin_amdgcn_exp2f(-1.4426950408889634f * fl)); c[m] = scan16(__logf(f[m])); }
#pragma unroll
                            for (int m = 0; m < 4; ++m) tot[m] = __shfl(c[m], bsrc);
                            const float alast = (tot[0] + tot[1]) + (tot[2] + tot[3]);
                            float pre = 0.f;
#pragma unroll
                            for (int m = 0; m < 4; ++m) { const float A = c[m] + pre; pre += tot[m]; const float q = acc[ai][0][m][n][e]; const float kk = 1.0f - f[m];
                                acc[ai][0][m][n][e] = q * __builtin_amdgcn_rcpf(1.0f + __builtin_amdgcn_exp2f(-1.4426950408889634f * q)) * __expf(A);
                                acc[ai][1][m][n][e] = kk * __expf(-A); ke2[z][m] = kk * __expf(alast - A); }
                            if (fr == 0) DEC[((size_t)(bb * 4 + h) * 64 + ch0 + 2 * ai) * 128 + kb + 4 * n + e] = __expf(alast);
                        }
#pragma unroll
                        for (int m = 0; m < 4; ++m) kep[m][2 * n + ep] = cvt_pk_bf16(ke2[0][m], ke2[1][m]);
                        __builtin_amdgcn_sched_barrier(0);
                    }
                }
#pragma unroll
                for (int m = 0; m < 4; ++m) *(u32x4*)(KE + (size_t)(row0 + ai * 128 + m * 16) * 512 + h * 128 + kb) = (u32x4){kep[m][0], kep[m][1], kep[m][2], kep[m][3]};
            }
        }
        const float sc = u.pn < 2 ? scale0 : 1.0f;
#pragma unroll
        for (int ai = 0; ai < 2; ++ai)
#pragma unroll
            for (int m = 0; m < 4; ++m) { bf16_t* rowp = O + (size_t)(row0 + ai * 128 + m * 16) * INC + col0;
#pragma unroll
                for (int bj = 0; bj < 2; ++bj) { const f32x4 v0 = acc[ai][bj][m][0] * sc, v1 = acc[ai][bj][m][1] * sc;
                    u32x4 w; w.x = cvt_pk_bf16(v0[0], v0[1]); w.y = cvt_pk_bf16(v0[2], v0[3]); w.z = cvt_pk_bf16(v1[0], v1[1]); w.w = cvt_pk_bf16(v1[2], v1[3]);
                    *(u32x4*)(rowp + bj * 128) = w; } }
        return false;
    }
};
struct EpiUp {
    static constexpr bool PERM = true;
    const bf16_t* proj; bf16_t* O;
    __device__ __forceinline__ bool operator()(f32x4 (&acc)[2][2][4][2], const Unit& u, int wr, int wc, int fr, int fq) const {
        const int row0 = u.pm * 256 + wr * 64 + fr, col0 = u.pn * 256 + wc * 32 + 8 * fq;
#pragma unroll
        for (int ai = 0; ai < 2; ++ai)
#pragma unroll
            for (int m = 0; m < 4; ++m) { const size_t row = (size_t)(row0 + ai * 128 + m * 16);
#pragma unroll
                for (int bj = 0; bj < 2; ++bj) {
                    const int col = col0 + bj * 128;
                    const u32x4 gh = *(const u32x4*)(proj + row * INC + C_GHGATE + col);
                    float sh[8];
#pragma unroll
                    for (int j = 0; j < 4; ++j) { sh[2 * j] = 1.0f + __builtin_amdgcn_exp2f(-1.4426950408889634f * bf2f(gh[j] & 0xffffu)); sh[2 * j + 1] = 1.0f + __builtin_amdgcn_exp2f(-1.4426950408889634f * bf2f(gh[j] >> 16)); }
                    if (u.aux == 0) {
                        const u32x4 gd = *(const u32x4*)(proj + row * INC + C_GDA + col);
#pragma unroll
                        for (int j = 0; j < 4; ++j) {
                            const float d0 = 1.0f + __builtin_amdgcn_exp2f(-1.4426950408889634f * bf2f(gd[j] & 0xffffu)), d1 = 1.0f + __builtin_amdgcn_exp2f(-1.4426950408889634f * bf2f(gd[j] >> 16));
                            const float r0 = sh[2 * j] * __builtin_amdgcn_rcpf(d0), r1 = sh[2 * j + 1] * __builtin_amdgcn_rcpf(d1);
                            if (j < 2) { acc[ai][bj][m][0][2 * j] *= r0; acc[ai][bj][m][0][2 * j + 1] *= r1; }
                            else { acc[ai][bj][m][1][2 * j - 4] *= r0; acc[ai][bj][m][1][2 * j - 3] *= r1; }
                        }
                    } else {
                        const f32x4 v0 = acc[ai][bj][m][0], v1 = acc[ai][bj][m][1];
#pragma unroll
                        for (int j = 0; j < 8; ++j) sh[j] = __builtin_amdgcn_rcpf(sh[j]);
                        u32x4 w; w.x = cvt_pk_bf16(v0[0] * sh[0], v0[1] * sh[1]); w.y = cvt_pk_bf16(v0[2] * sh[2], v0[3] * sh[3]);
                        w.z = cvt_pk_bf16(v1[0] * sh[4], v1[1] * sh[5]); w.w = cvt_pk_bf16(v1[2] * sh[6], v1[3] * sh[7]);
                        *(u32x4*)(O + row * D + col) = w;
                    }
                } }
        return u.aux == 0;
    }
};
struct EpiOut {
    static constexpr bool PERM = false;
    const float* x; const float* mod; float* O;
    __device__ __forceinline__ bool operator()(f32x4 (&acc)[2][2][4][2], const Unit& u, int wr, int wc, int fr, int fq) const {
        const int row0 = u.pm * 256 + wr * 64 + fr, col0 = u.pn * 256 + wc * 32 + 4 * fq;
        const int b = (u.pm * 256) / SEQ;
        f32x4 gt[2][2];
#pragma unroll
        for (int bj = 0; bj < 2; ++bj)
#pragma unroll
            for (int n = 0; n < 2; ++n) gt[bj][n] = *(const f32x4*)(mod + b * 6144 + 2048 + col0 + bj * 128 + n * 16);
#pragma unroll
        for (int ai = 0; ai < 2; ++ai)
#pragma unroll
            for (int m = 0; m < 4; ++m) { const size_t off = (size_t)(row0 + ai * 128 + m * 16) * D + col0;
#pragma unroll
                for (int bj = 0; bj < 2; ++bj)
#pragma unroll
                    for (int n = 0; n < 2; ++n) { const f32x4 xv = *(const f32x4*)(x + off + bj * 128 + n * 16);
                        *(f32x4*)(O + off + bj * 128 + n * 16) = xv + gt[bj][n] * acc[ai][bj][m][n]; } }
        return false;
    }
};
struct EpiMoe1 {
    static constexpr bool PERM = true;
    bf16_t* O;
    __device__ __forceinline__ bool operator()(f32x4 (&acc)[2][2][4][2], const Unit& u, int wr, int wc, int fr, int fq) const {
        const int row0 = u.pm * 256 + wr * 64 + fr, col0 = u.pn * 128 + wc * 32 + 8 * fq;
#pragma unroll
        for (int ai = 0; ai < 2; ++ai)
#pragma unroll
            for (int m = 0; m < 4; ++m) { bf16_t* rowp = O + (size_t)(row0 + ai * 128 + m * 16) * DEXP + col0;
                float h[8];
#pragma unroll
                for (int n = 0; n < 2; ++n)
#pragma unroll
                    for (int e = 0; e < 4; ++e) h[n * 4 + e] = siluf_(acc[ai][0][m][n][e]) * acc[ai][1][m][n][e];
                u32x4 w; w.x = cvt_pk_bf16(h[0], h[1]); w.y = cvt_pk_bf16(h[2], h[3]); w.z = cvt_pk_bf16(h[4], h[5]); w.w = cvt_pk_bf16(h[6], h[7]);
                *(u32x4*)rowp = w; }
        return false;
    }
};

struct Frame { LAS unsigned char* lds; int tid, lane, wave, G, bid; };

__device__ __forceinline__ void transpose_item(const float* Wsrc, int ldw, bf16_t* dst, int ldd, LAS float* scr, int lane) {
#pragma unroll 8
    for (int i = 0; i < 32; ++i) { const int kk = 2 * i + (lane >> 5); scr[kk * 33 + (lane & 31)] = Wsrc[(size_t)kk * ldw + (lane & 31)]; }
    asm volatile("s_waitcnt lgkmcnt(0)" ::: "memory");
    const int c = lane & 7;
#pragma unroll
    for (int j = 0; j < 4; ++j) { const int n = (lane >> 3) + 8 * j; const LAS float* s = scr + (8 * c) * 33 + n;
        u32x4 o; o.x = pk2(s[0 * 33], s[1 * 33]); o.y = pk2(s[2 * 33], s[3 * 33]); o.z = pk2(s[4 * 33], s[5 * 33]); o.w = pk2(s[6 * 33], s[7 * 33]);
        *(u32x4*)(dst + (size_t)n * ldd + 8 * c) = o; }
    asm volatile("s_waitcnt lgkmcnt(0)" ::: "memory");
}
__device__ __forceinline__ void transpose_matrix(const Frame& F, const float* W, int K, int N, bf16_t* WT) {
    LAS float* scr = (LAS float*)(F.lds + F.wave * 8448);
    const int gw = F.bid * NWAVES + F.wave, NGW = F.G * NWAVES, nblk = N / 32, items = (K / 64) * nblk;
    for (int it = gw; it < items; it += NGW) { const int kb = it / nblk, nb = it % nblk;
        transpose_item(W + (size_t)(64 * kb) * N + 32 * nb, N, WT + (size_t)(32 * nb) * K + 64 * kb, K, scr, F.lane); }
}

__device__ __forceinline__ void phase0(const Frame& F, const Args& a) {
    unsigned char* ws = a.ws;
    {
        float* modp = (float*)(ws + WS_MODP);
        const float* c = a.in[I_C]; const float* wada = a.in[I_WADA];
        LAS float* cs = (LAS float*)(F.lds + 72 * 1024);
        for (int i = F.tid; i < 4 * D; i += NTHR) cs[i] = siluf_(c[i]);
        __syncthreads();
        for (int wt = F.bid + 256 * F.wave; wt < 384; wt += 256 * NWAVES) {
            if (F.G != 256) break;
            const int ks = wt / 24, jw = wt % 24, j = jw * 256 + F.lane * 4;
            f32x4 s[4] = {{0, 0, 0, 0}, {0, 0, 0, 0}, {0, 0, 0, 0}, {0, 0, 0, 0}};
#pragma unroll 8
            for (int k = ks * 64; k < ks * 64 + 64; ++k) {
                const f32x4 w = *(const f32x4*)(wada + (size_t)k * 6144 + j);
#pragma unroll
                for (int b = 0; b < 4; ++b) s[b] += w * cs[b * D + k];
            }
#pragma unroll
            for (int b = 0; b < 4; ++b) *(f32x4*)(modp + ((size_t)ks * 4 + b) * 6144 + j) = s[b];
        }
        if (F.G != 256) {
            const int gw = F.bid * NWAVES + F.wave, NGW = F.G * NWAVES;
            for (int wt = gw; wt < 384; wt += NGW) {
                const int ks = wt / 24, jw = wt % 24, j = jw * 256 + F.lane * 4;
                f32x4 s[4] = {{0, 0, 0, 0}, {0, 0, 0, 0}, {0, 0, 0, 0}, {0, 0, 0, 0}};
                for (int k = ks * 64; k < ks * 64 + 64; ++k) {
                    const f32x4 w = *(const f32x4*)(wada + (size_t)k * 6144 + j);
#pragma unroll
                    for (int b = 0; b < 4; ++b) { const float cv = siluf_(c[b * D + k]); s[b] += w * cv; }
                }
#pragma unroll
                for (int b = 0; b < 4; ++b) *(f32x4*)(modp + ((size_t)ks * 4 + b) * 6144 + j) = s[b];
            }
        }
    }
    {
        LAS float* scr = (LAS float*)(F.lds + F.wave * 8448);
        const int gw = F.bid * NWAVES + F.wave, NGW = F.G * NWAVES, nblk = INC / 32, items = (D / 64) * nblk;
        bf16_t* WT = (bf16_t*)(ws + WS_WIN);
        for (int it = gw; it < items; it += NGW) { const int kb = it / nblk, n0 = 32 * (it % nblk); int dr = n0;
            if (n0 >= C_QHG && n0 < C_FHG) dr = C_HGT + 256 * ((n0 - C_QHG) >> 7) + ((n0 - C_QHG) & 127);
            else if (n0 >= C_FHG && n0 < C_IHG) dr = C_HGT + 256 * ((n0 - C_FHG) >> 7) + 128 + ((n0 - C_FHG) & 127);
            transpose_item(a.in[I_WIN] + (size_t)(64 * kb) * INC + n0, INC, WT + (size_t)dr * D + 64 * kb, D, scr, F.lane); }
    }
    transpose_matrix(F, a.in[I_WUPDA], 512, D, (bf16_t*)(ws + WS_WUPDA));
    transpose_matrix(F, a.in[I_WUPHG], 512, D, (bf16_t*)(ws + WS_WUPHG));
    transpose_matrix(F, a.in[I_WOUT], D, D, (bf16_t*)(ws + WS_WOUT));
    if (F.bid == 0) {
        float* sm = (float*)(ws + WS_SMALL);
        if (F.tid == 0) {
            float s1 = 0.f, s2 = 0.f;
            for (int i = 0; i < 64; ++i) { s1 += a.in[I_LQ1][i] * a.in[I_LK1][i]; s2 += a.in[I_LQ2][i] * a.in[I_LK2][i]; }
            sm[0] = expf(s1) - expf(s2) + 0.2f;
        }
        { const float l0 = a.in[I_LBL][F.tid], l1 = a.in[I_LBL][512 + F.tid]; const float mx = fmaxf(l0, l1);
          const float e0 = expf(l0 - mx), e1 = expf(l1 - mx); sm[16 + F.tid] = e0 / (e0 + e1); }
    }
}
__device__ __forceinline__ void moe_weight_convert(const Frame& F, const Args& a) {
    LAS float* scr = (LAS float*)(F.lds + F.wave * 8448);
    const int gw = F.bid * NWAVES + F.wave, NGW = F.G * NWAVES;
    bf16_t* w13 = (bf16_t*)(a.ws + WS_W13); bf16_t* w2t = (bf16_t*)(a.ws + WS_W2);
    for (int it = gw; it < 2 * NEXP * 256; it += NGW) {
        const int which = it / (NEXP * 256), r = it % (NEXP * 256), e = r >> 8, kb = (r >> 4) & 15, nb = r & 15, n0 = 32 * nb;
        const float* W = a.in[which ? I_W3 : I_W1] + (size_t)e * 1024 * 512;
        const int drow = 256 * (n0 >> 7) + (which ? 128 : 0) + (n0 & 127);
        transpose_item(W + (size_t)(64 * kb) * 512 + n0, 512, w13 + ((size_t)e * 1024 + drow) * 1024 + 64 * kb, 1024, scr, F.lane);
    }
}
__device__ __forceinline__ void moe_w2_convert(const Frame& F, const Args& a, int myidx, int nidle) {
    LAS float* scr = (LAS float*)(F.lds + F.wave * 8448);
    bf16_t* w2t = (bf16_t*)(a.ws + WS_W2);
    for (int it = myidx * NWAVES + F.wave; it < NEXP * 256; it += nidle * NWAVES) {
        const int e = it >> 8, kb = (it >> 5) & 7, nb = it & 31;
        const float* W = a.in[I_W2] + (size_t)e * 512 * 1024;
        transpose_item(W + (size_t)(64 * kb) * 1024 + 32 * nb, 1024, w2t + ((size_t)e * 1024 + 32 * nb) * 512 + 64 * kb, 512, scr, F.lane);
    }
}

__device__ __forceinline__ void phase1(const Frame& F, const Args& a) {
    const float* modp = (const float*)(a.ws + WS_MODP); float* mod = (float*)(a.ws + WS_MOD);
    for (int i = F.bid * NTHR + F.tid; i < 4 * 6144; i += F.G * NTHR) {
        float s = a.in[I_BADA][i % 6144];
        for (int ks = 0; ks < 16; ++ks) s += modp[(size_t)ks * 4 * 6144 + i];
        mod[i] = s;
    }
    LAS float* Gs = (LAS float*)F.lds;
    LAS float* Ss = Gs + 1024;
    bf16_t* H = (bf16_t*)(a.ws + WS_ACT);
    const int rows_per_blk = T / F.G;
    const int r0 = F.bid * rows_per_blk, b = r0 / SEQ;
    for (int k = F.tid; k < 1024; k += NTHR) {
        float sh = a.in[I_BADA][k], sc = a.in[I_BADA][1024 + k];
        for (int ks = 0; ks < 16; ++ks) { sh += modp[((size_t)ks * 4 + b) * 6144 + k]; sc += modp[((size_t)ks * 4 + b) * 6144 + 1024 + k]; }
        Gs[k] = a.in[I_N1G][k] * (1.0f + sc); Ss[k] = sh;
    }
    __syncthreads();
    for (int r = r0 + F.wave; r < r0 + rows_per_blk; r += NWAVES) {
        const f32x4* xr = (const f32x4*)(a.in[I_X] + (size_t)r * D) + F.lane;
        f32x4 v[4]; float s = 0.f;
#pragma unroll
        for (int j = 0; j < 4; ++j) { v[j] = xr[64 * j]; s += (v[j].x * v[j].x + v[j].y * v[j].y) + (v[j].z * v[j].z + v[j].w * v[j].w); }
        const float rs = rsqrtf(wave_sum(s) * (1.0f / D) + EPS);
        unsigned long long* o8 = (unsigned long long*)(H + (size_t)r * D) + F.lane;
#pragma unroll
        for (int j = 0; j < 4; ++j) { const f32x4 g = *(const LAS f32x4*)(Gs + 256 * j + 4 * F.lane), sh = *(const LAS f32x4*)(Ss + 256 * j + 4 * F.lane);
            const f32x4 h = v[j] * rs * g + sh;
            o8[64 * j] = (unsigned long long)pk2(h.x, h.y) | ((unsigned long long)pk2(h.z, h.w) << 32); }
    }
}

namespace attn_body {
using s16x4=__attribute__((ext_vector_type(4)))short;
using f32x16=__attribute__((ext_vector_type(16)))float;
constexpr int NW=8,QBLK=32,QB=QBLK*NW,KVBLK=64,NQB=SEQ/QB;
constexpr int PIN=INC, POUT=1024;
__device__ __forceinline__ int crow(int r,int hi){return (r&3)+8*(r>>2)+4*hi;}
#define SBAR() __builtin_amdgcn_sched_barrier(0)
__device__ __forceinline__ void bmask(f32x16&p0,f32x16&p1,int jb,int wch,int il,int hi,float s2x2){
  if(jb>wch){
    #pragma unroll
    for(int r=0;r<16;++r){p0[r]=-INFINITY;p1[r]=-INFINITY;}
  } else if(jb==wch){
    float fb=(float)(4*hi-il); asm volatile("":"+v"(fb));
    #pragma unroll
    for(int r=0;r<16;++r){const float c=(float)((r&3)+8*(r>>2)); p0[r]-=s2x2*__builtin_fmaxf(fb+c,0.f); p1[r]-=s2x2*__builtin_fmaxf(fb+(c+32.f),0.f);}
  }
}
constexpr int NSLOT=3, SLOTB=8192;
constexpr int LDS_K=0, LDS_V=NSLOT*SLOTB, LDS_WS=2*NSLOT*SLOTB, LDS_OST=LDS_WS+NW*64*4, ATT_LDS_BYTES=LDS_OST+NW*4096;
constexpr float C2=0.125f*1.4426950408889634f;
__device__ __forceinline__ void glds16(const void*gsrc,unsigned lds_dst){unsigned keep;
  asm volatile("s_mov_b32 %0, m0\n\ts_mov_b32 m0, %2\n\ts_nop 0\n\tglobal_load_lds_dwordx4 %1, off\n\ts_mov_b32 m0, %0":"=&s"(keep):"v"(gsrc),"s"(lds_dst):"memory");}
__device__ __forceinline__ float max3f(float a,float b,float c){float r;asm("v_max3_f32 %0, %1, %2, %3":"=v"(r):"v"(a),"v"(b),"v"(c));return r;}
__device__ __forceinline__ float max2f(float a,float b){float r;asm("v_max_f32_e32 %0, %1, %2":"=v"(r):"v"(a),"v"(b));return r;}
__device__ __forceinline__ float fadd_s(float a,float b){float r;asm("v_add_f32_e32 %0, %1, %2":"=v"(r):"v"(a),"v"(b));return r;}
__device__ __forceinline__ float fsub_s(float a,float b){float r;asm("v_sub_f32_e32 %0, %1, %2":"=v"(r):"v"(a),"v"(b));return r;}
typedef float f32x2_t __attribute__((ext_vector_type(2))); typedef __bf16 bf16x2_t __attribute__((ext_vector_type(2)));
__device__ __forceinline__ unsigned cvtpk_s(float lo,float hi){f32x2_t v={lo,hi};bf16x2_t b=__builtin_convertvector(v,bf16x2_t);return __builtin_bit_cast(unsigned,b);}
#define WAIT_BAR(N) asm volatile("s_waitcnt vmcnt(" #N ") lgkmcnt(0)\n\ts_barrier":::"memory")

__device__ __forceinline__ void qkt(f32x16&p0,f32x16&p1,const char*Kslot,const bf16x8*qr,const f32x16&c0,const f32x16&c1,int r32,int hi){
  const char*kb=Kslot+hi*1024+r32*16;
  #pragma unroll
  for(int d0=0;d0<4;++d0){
    const bf16x8 b0=*reinterpret_cast<const bf16x8*>(kb+d0*2048);
    const bf16x8 b1=*reinterpret_cast<const bf16x8*>(kb+d0*2048+512);
    if(d0==0){p0=__builtin_amdgcn_mfma_f32_32x32x16_bf16(b0,qr[0],c0,0,0,0);p1=__builtin_amdgcn_mfma_f32_32x32x16_bf16(b1,qr[0],c1,0,0,0);}
    else{p0=__builtin_amdgcn_mfma_f32_32x32x16_bf16(b0,qr[d0],p0,0,0,0);p1=__builtin_amdgcn_mfma_f32_32x32x16_bf16(b1,qr[d0],p1,0,0,0);}}
}
typedef __attribute__((address_space(3))) const char* lds_cptr;
typedef short v4i16_t __attribute__((ext_vector_type(4)));
__device__ __forceinline__ void kload8(bf16x8*kf,lds_cptr kp){
  kf[0]=*(const __attribute__((address_space(3))) bf16x8*)(kp);      kf[1]=*(const __attribute__((address_space(3))) bf16x8*)(kp+512);
  kf[2]=*(const __attribute__((address_space(3))) bf16x8*)(kp+2048); kf[3]=*(const __attribute__((address_space(3))) bf16x8*)(kp+2560);
  kf[4]=*(const __attribute__((address_space(3))) bf16x8*)(kp+4096); kf[5]=*(const __attribute__((address_space(3))) bf16x8*)(kp+4608);
  kf[6]=*(const __attribute__((address_space(3))) bf16x8*)(kp+6144); kf[7]=*(const __attribute__((address_space(3))) bf16x8*)(kp+6656);
}
__device__ __forceinline__ void kload2(bf16x8*kf,lds_cptr kp,int j){ kf[2*j]=*(const __attribute__((address_space(3))) bf16x8*)(kp+j*2048); kf[2*j+1]=*(const __attribute__((address_space(3))) bf16x8*)(kp+j*2048+512); }
__device__ __forceinline__ s16x4 vtr(lds_cptr p){ return __builtin_bit_cast(s16x4,__builtin_amdgcn_ds_read_tr16_b64_v4i16((__attribute__((address_space(3))) v4i16_t*)p)); }
__device__ __forceinline__ float rowmax(const f32x16&p0,const f32x16&p1){
  float a=max3f(p0[0],p0[1],p1[0]),b=max3f(p0[2],p0[3],p1[1]);a=max3f(a,p1[2],p1[3]);
  #pragma unroll
  for(int r=4;r<16;r+=4){a=max3f(a,p0[r],p0[r+1]);b=max3f(b,p0[r+2],p0[r+3]);a=max3f(a,p1[r],p1[r+1]);b=max3f(b,p1[r+2],p1[r+3]);}
  const float m=max2f(a,b);
  auto rr=__builtin_amdgcn_permlane32_swap(__float_as_uint(m),__float_as_uint(m),false,false);
  return max2f(__uint_as_float(rr[0]),__uint_as_float(rr[1]));
}
__device__ __forceinline__ void pv(f32x16*o,int vb,bf16x8 pa0,bf16x8 pa1,bf16x8 pa2,bf16x8 pa3){
  #pragma unroll
  for(int d0=0;d0<2;++d0){s16x4 lo[4],hi[4];
    #pragma unroll
    for(int ks=0;ks<4;++ks){
      asm volatile("ds_read_b64_tr_b16 %0,%1 offset:%c2":"=&v"(lo[ks]):"v"(vb),"i"(d0*4096+ks*1024):"memory");
      asm volatile("ds_read_b64_tr_b16 %0,%1 offset:%c2":"=&v"(hi[ks]):"v"(vb),"i"(d0*4096+ks*1024+512):"memory");}
    asm volatile("s_waitcnt lgkmcnt(0)":::"memory");SBAR();
    #define PK(k) (bf16x8){lo[k][0],lo[k][1],lo[k][2],lo[k][3],hi[k][0],hi[k][1],hi[k][2],hi[k][3]}
    o[d0]=__builtin_amdgcn_mfma_f32_32x32x16_bf16(pa0,PK(0),o[d0],0,0,0);
    o[d0]=__builtin_amdgcn_mfma_f32_32x32x16_bf16(pa1,PK(1),o[d0],0,0,0);
    o[d0]=__builtin_amdgcn_mfma_f32_32x32x16_bf16(pa2,PK(2),o[d0],0,0,0);
    o[d0]=__builtin_amdgcn_mfma_f32_32x32x16_bf16(pa3,PK(3),o[d0],0,0,0);
    #undef PK
  }
}
#define ATTN_STORE16(p,v) (*(u32x4*)(p)=(v))
template<int THRL> __device__ __forceinline__ void attn_unit(int qb,const bf16_t*Qb,const bf16_t*__restrict__ Kh,const bf16_t*__restrict__ Vh,bf16_t*Ob,float slope2,char*shm){
  const int tid=threadIdx.x,lane=tid&63,r32=lane&31,hi=lane>>5; const int wid=__builtin_amdgcn_readfirstlane(tid>>6);
  const int q0=qb*QB;
  const bf16_t*Qw=Qb+(long)(q0+wid*QBLK)*PIN;
  const unsigned lds0=(unsigned)(uintptr_t)shm;
  float*wsf=(float*)(shm+LDS_WS)+wid*64;
  const bf16_t*ksrc=Kh+(long)lane*PIN+wid*8;
  const bf16_t*vsrc=Vh+(long)(16*(wid&3)+(lane>>2))*PIN+(wid>>2)*32+(lane&3)*8;
  const unsigned kdst=lds0+LDS_K+wid*1024, vdst=lds0+LDS_V+wid*1024;
  #define DMA_K(t,slot) glds16(ksrc+(long)(t)*KVBLK*PIN,(unsigned)__builtin_amdgcn_readfirstlane(kdst+(slot)))
  #define DMA_V(t,slot) glds16(vsrc+(long)(t)*KVBLK*PIN,(unsigned)__builtin_amdgcn_readfirstlane(vdst+(slot)))
  const int vb0=(int)(lds0+LDS_V)+((lane>>4)&1)*32+(lane&3)*8+(4*hi+((lane&15)>>2))*64;
  const char*Kbase=shm+LDS_K; bf16x8 kf[8];
  const lds_cptr shm3=(lds_cptr)shm; const lds_cptr kp0=shm3+LDS_K+hi*1024+r32*16; const lds_cptr vp0=shm3+LDS_V+((lane>>4)&1)*32+(lane&3)*8+(4*hi+((lane&15)>>2))*64;
  const int NT=(q0+QB)/KVBLK;
  DMA_K(0,0);DMA_V(0,0);DMA_K(1,SLOTB);
  bf16x8 qr[4];
  #pragma unroll
  for(int d0=0;d0<4;++d0)qr[d0]=*reinterpret_cast<const bf16x8*>(&Qw[(long)r32*PIN+d0*16+hi*8]);
  float mhat=0.f,l_reg=0.f;f32x16 o[2];o[0]=f32x16{};o[1]=f32x16{};
  const float s64=slope2*64.f, s32=slope2*32.f, s2x2=2.f*slope2, s4hi=slope2*4.f*(float)hi;
  const int wch=wid>>1, il=32*(wid&1)+r32;
  #define CMASK(P0,P1,t) do{int jb_=(t)-(NT-4); if(jb_>=0)bmask(P0,P1,jb_,wch,il,hi,s2x2);}while(0)
  #define CINIT0(C0,t) do{ const float bt_=s64*(float)((t)-NT)-mhat+s4hi; _Pragma("unroll") for(int r=0;r<16;++r){C0[r]=__builtin_fmaf(slope2,(float)((r&3)+8*(r>>2)),bt_);} }while(0)
  #define CINIT1(C1,t) do{ const float bu_=s64*(float)((t)-NT)-mhat+s4hi+s32; _Pragma("unroll") for(int r=0;r<16;++r){C1[r]=__builtin_fmaf(slope2,(float)((r&3)+8*(r>>2)),bu_);} }while(0)
  bool resc=false;
  #define START(P0,P1) do{ const float rm=rowmax(P0,P1); resc=false; \
    { const float dl=rm; mhat=fadd_s(mhat,dl); \
      _Pragma("unroll") for(int r=0;r<16;++r){P0[r]=fsub_s(P0[r],dl);P1[r]=fsub_s(P1[r],dl);} } \
    _Pragma("unroll") for(int r=0;r<16;++r)P0[r]=__builtin_amdgcn_exp2f(P0[r]); }while(0)
  #define RESC() do{ if(resc){ asm volatile("s_waitcnt lgkmcnt(0)":::"memory"); \
      _Pragma("unroll") for(int d_=0;d_<2;++d_) _Pragma("unroll") for(int r=0;r<16;++r)o[d_][r]*=wsf[crow(r,hi)]; } }while(0)
  f32x16 pA0,pA1,pB0,pB1;
  int sl_prev=0,sl_cur=0,sl_next=SLOTB;
  #define ROT() do{sl_prev=sl_cur;sl_cur=sl_next;sl_next=(sl_next==(NSLOT-1)*SLOTB)?0:sl_next+SLOTB;}while(0)
  DMA_K(2,2*SLOTB);
  WAIT_BAR(3);
  { f32x16 c0,c1; CINIT0(c0,0); CINIT1(c1,0); qkt(pA0,pA1,Kbase,qr,c0,c1,r32,hi); }
  asm volatile("s_nop 15\n\ts_nop 7":"+v"(pA0),"+v"(pA1));CMASK(pA0,pA1,0);
  START(pA0,pA1);
  _Pragma("unroll") for(int r=0;r<16;++r)pA1[r]=__builtin_amdgcn_exp2f(pA1[r]);
  WAIT_BAR(0);
  DMA_K(3,0);DMA_V(1,SLOTB);
  ROT();
  kload8(kf,kp0+sl_cur);
  WAIT_BAR(2);
  s16x4 vlo[8],vhi[8]; u32x4 pw0,pw1,pw2,pw3;
  #define PKW(P,B) cvtpk_s(P[B],P[B+1])
  #define PAF(k) __builtin_bit_cast(bf16x8,pw##k)
  #define VFR(i) (bf16x8){vlo[i][0],vlo[i][1],vlo[i][2],vlo[i][3],vhi[i][0],vhi[i][1],vhi[i][2],vhi[i][3]}
  #define PIN_(x) asm volatile("":"+v"(x))
  #define MX3(a,b,c) __builtin_fmaxf(__builtin_fmaxf((a),(b)),(c))
  #define GAPA(MF,A0,A1,A2,A3,W0,W1,PW) do{ MF; sacc+=A0; sacc+=A1; sacc+=A2; sacc+=A3; PIN_(sacc); W0; W1; PIN_(PW); SBAR(); }while(0)
  #define EX(v) __builtin_amdgcn_exp2f(v)
  #define GAPB(MF,X,B) do{ MF; X[B]=EX(X[B]); X[B+1]=EX(X[B+1]); X[B+2]=EX(X[B+2]); X[B+3]=EX(X[B+3]); PIN_(X); SBAR(); }while(0)
  #define VRD(i) do{ vlo[i]=vtr(vp_+(((i)>>2)*4096+((i)&3)*1024)); vhi[i]=vtr(vp_+(((i)>>2)*4096+((i)&3)*1024+512)); }while(0)
  #define KRD(G,j) do{ if(G){ kload2(kf,kp0+sl_next,j); SBAR(); } }while(0)
  #define STEP(C0,C1,P0,P1,t,GK,GV,GL) do{ SBAR(); \
    CINIT0(C0,t); SBAR(); \
    const lds_cptr vp_=vp0+sl_prev; \
    VRD(0); SBAR(); float sacc=(P0[0]+P0[1]); \
    GAPA(C0=__builtin_amdgcn_mfma_f32_32x32x16_bf16(kf[0],qr[0],C0,0,0,0), P0[2],P0[3],P0[4],P0[5],     pw0[0]=PKW(P0,0), pw0[1]=PKW(P0,2), pw0); \
    CINIT1(C1,t); VRD(4); SBAR(); GAPA(C1=__builtin_amdgcn_mfma_f32_32x32x16_bf16(kf[1],qr[0],C1,0,0,0), P0[6],P0[7],P0[8],P0[9],     pw0[2]=PKW(P0,4), pw0[3]=PKW(P0,6), pw0); \
    VRD(1); SBAR(); GAPA(C0=__builtin_amdgcn_mfma_f32_32x32x16_bf16(kf[2],qr[1],C0,0,0,0),   P0[10],P0[11],P0[12],P0[13], pw1[0]=PKW(P0,8), pw1[1]=PKW(P0,10), pw1); \
    VRD(5); SBAR(); GAPA(C1=__builtin_amdgcn_mfma_f32_32x32x16_bf16(kf[3],qr[1],C1,0,0,0),   P0[14],P0[15],P1[0],P1[1],   pw1[2]=PKW(P0,12),pw1[3]=PKW(P0,14), pw1); \
    VRD(2); SBAR(); GAPA(C0=__builtin_amdgcn_mfma_f32_32x32x16_bf16(kf[4],qr[2],C0,0,0,0),   P1[2],P1[3],P1[4],P1[5],     pw2[0]=PKW(P1,0), pw2[1]=PKW(P1,2), pw2); \
    VRD(6); SBAR(); GAPA(C1=__builtin_amdgcn_mfma_f32_32x32x16_bf16(kf[5],qr[2],C1,0,0,0),   P1[6],P1[7],P1[8],P1[9],     pw2[2]=PKW(P1,4), pw2[3]=PKW(P1,6), pw2); \
    VRD(3); SBAR(); GAPA(C0=__builtin_amdgcn_mfma_f32_32x32x16_bf16(kf[6],qr[3],C0,0,0,0),   P1[10],P1[11],P1[12],P1[13], pw3[0]=PKW(P1,8), pw3[1]=PKW(P1,10), pw3); \
    VRD(7); SBAR(); GAPA(C1=__builtin_amdgcn_mfma_f32_32x32x16_bf16(kf[7],qr[3],C1,0,0,0),   P1[14],P1[15],0.f,0.f,       pw3[2]=PKW(P1,12),pw3[3]=PKW(P1,14), pw3); \
    l_reg+=sacc; \
    if(GK){DMA_K((t)+3,sl_cur);} if(GV){DMA_V((t)+1,sl_next);} \
    CMASK(C0,C1,t); \
    { float a=MX3(C0[0],C0[1],C1[0]),b=MX3(C0[2],C0[3],C1[1]); a=MX3(a,C1[2],C1[3]); \
      _Pragma("unroll") for(int r=4;r<16;r+=4){a=MX3(a,C0[r],C0[r+1]);b=MX3(b,C0[r+2],C0[r+3]);a=MX3(a,C1[r],C1[r+1]);b=MX3(b,C1[r+2],C1[r+3]);} \
      float rm=__builtin_fmaxf(a,b); { auto rr=__builtin_amdgcn_permlane32_swap(__float_as_uint(rm),__float_as_uint(rm),false,false); rm=__builtin_fmaxf(__uint_as_float(rr[0]),__uint_as_float(rr[1])); } \
      resc=false; \
      if(__builtin_expect(__any(rm>(float)THRL),0)){ const float dl=__builtin_fmaxf(rm,0.f); mhat+=dl; \
        _Pragma("unroll") for(int r=0;r<16;++r){C0[r]-=dl;C1[r]-=dl;} \
        const float f=__builtin_amdgcn_exp2f(-dl); l_reg*=f; if(hi==0)wsf[r32]=f; resc=true; } } \
    SBAR(); \
    GAPB(o[0]=__builtin_amdgcn_mfma_f32_32x32x16_bf16(PAF(0),VFR(0),o[0],0,0,0), C0,0); \
    GAPB(o[1]=__builtin_amdgcn_mfma_f32_32x32x16_bf16(PAF(0),VFR(4),o[1],0,0,0), C0,4); \
    KRD(GL,0); GAPB(o[0]=__builtin_amdgcn_mfma_f32_32x32x16_bf16(PAF(1),VFR(1),o[0],0,0,0), C0,8); \
    KRD(GL,1); GAPB(o[1]=__builtin_amdgcn_mfma_f32_32x32x16_bf16(PAF(1),VFR(5),o[1],0,0,0), C0,12); \
    KRD(GL,2); GAPB(o[0]=__builtin_amdgcn_mfma_f32_32x32x16_bf16(PAF(2),VFR(2),o[0],0,0,0), C1,0); \
    KRD(GL,3); GAPB(o[1]=__builtin_amdgcn_mfma_f32_32x32x16_bf16(PAF(2),VFR(6),o[1],0,0,0), C1,4); \
    GAPB(o[0]=__builtin_amdgcn_mfma_f32_32x32x16_bf16(PAF(3),VFR(3),o[0],0,0,0), C1,8); \
    GAPB(o[1]=__builtin_amdgcn_mfma_f32_32x32x16_bf16(PAF(3),VFR(7),o[1],0,0,0), C1,12); \
    }while(0)
  int t=1;
  #undef CMASK
  #define CMASK(P0,P1,t) do{}while(0)
  for(;t+5<NT;t+=2){
    STEP(pB0,pB1,pA0,pA1,t,true,true,true);     WAIT_BAR(2); RESC(); ROT();
    STEP(pA0,pA1,pB0,pB1,t+1,true,true,true);   WAIT_BAR(2); RESC(); ROT();
  }
  #undef CMASK
  #define CMASK(P0,P1,t) do{int jb_=(t)-(NT-4); if(jb_>=0)bmask(P0,P1,jb_,wch,il,hi,s2x2);}while(0)
  #define ENDW(tt) do{ if((tt)+3<NT){WAIT_BAR(2);} else if((tt)+2<NT){WAIT_BAR(1);} else {WAIT_BAR(0);} }while(0)
  for(;t+1<NT;t+=2){
    STEP(pB0,pB1,pA0,pA1,t,(t+3<NT),(t+1<NT),(t+1<NT));       ENDW(t);   RESC(); ROT();
    STEP(pA0,pA1,pB0,pB1,t+1,(t+4<NT),(t+2<NT),(t+2<NT));     ENDW(t+1); RESC(); ROT();
  }
  STEP(pB0,pB1,pA0,pA1,NT-1,false,false,false); RESC();
  { float sacc=pB0[0]+pB0[1]; _Pragma("unroll") for(int r=2;r<16;++r)sacc+=pB0[r]; _Pragma("unroll") for(int r=0;r<16;++r)sacc+=pB1[r]; l_reg+=sacc;
    pw0=(u32x4){PKW(pB0,0),PKW(pB0,2),PKW(pB0,4),PKW(pB0,6)};pw1=(u32x4){PKW(pB0,8),PKW(pB0,10),PKW(pB0,12),PKW(pB0,14)};pw2=(u32x4){PKW(pB1,0),PKW(pB1,2),PKW(pB1,4),PKW(pB1,6)};pw3=(u32x4){PKW(pB1,8),PKW(pB1,10),PKW(pB1,12),PKW(pB1,14)};
    SBAR(); pv(o,vb0+sl_cur,PAF(0),PAF(1),PAF(2),PAF(3)); }
  #undef PKW
  #undef PAF
  #undef VFR
  #undef PIN_
  #undef MX3
  #undef GAPA
  #undef GAPB
  #undef EX
  #undef VRD
  #undef KRD
  #undef STEP
  #undef ENDW
  {auto rr=__builtin_amdgcn_permlane32_swap(__float_as_uint(l_reg),__float_as_uint(l_reg),false,false);l_reg=__uint_as_float(rr[0])+__uint_as_float(rr[1]);}
  if(hi==0)wsf[32+r32]=l_reg;asm volatile("s_waitcnt lgkmcnt(0)":::"memory");
  float rli[16];
  #pragma unroll
  for(int r=0;r<16;++r)rli[r]=__builtin_amdgcn_rcpf(wsf[32+crow(r,hi)]);
  bf16_t*Ow=Ob+(long)(q0+wid*QBLK)*POUT;
  { bf16_t*stg=(bf16_t*)(shm+LDS_OST)+wid*2048;
    #pragma unroll
    for(int r=0;r<16;++r){const int orow=crow(r,hi);
      #pragma unroll
      for(int d0=0;d0<2;++d0)stg[orow*64+d0*32+r32]=(bf16_t)f2bf(o[d0][r]*rli[r]);}
    asm volatile("s_waitcnt lgkmcnt(0)":::"memory");
    #pragma unroll
    for(int i=0;i<4;++i){const int row=i*8+(lane>>3),ch=lane&7; const u32x4 v=*(const u32x4*)(stg+row*64+ch*8); ATTN_STORE16(Ow+(long)row*POUT+ch*8,v);} }
  asm volatile("s_waitcnt lgkmcnt(0)\n\ts_barrier":::"memory");
  #undef DMA_K
  #undef DMA_V
  #undef CMASK
  #undef CINIT0
  #undef CINIT1
  #undef START
  #undef RESC
  #undef ROT
}
#undef SBAR
#undef WAIT_BAR
}

__device__ __forceinline__ void attn_phase(const Frame& F, const Args& a) {
    const bf16_t* proj = (const bf16_t*)(a.ws + WS_PROJ); bf16_t* OA = (bf16_t*)(a.ws + WS_OA);
    const int vcu = (F.G % 8 == 0) ? (F.bid % 8) * (F.G / 8) + F.bid / 8 : F.bid;
    for (int i = 0;; ++i) {
        int bvh, qb;
        if (F.G == 256) { if (i >= 4) break; const int s = vcu & 3; bvh = vcu >> 2; qb = (i == 0) ? s : (i == 1) ? 7 - s : (i == 2) ? 8 + s : 15 - s; }
        else { const int u = i * F.G + F.bid; if (u >= 1024) break; bvh = u >> 4; qb = 15 - (u & 15); }
        const int b = bvh >> 4, vh = bvh & 15, h = vh >> 2, map = (vh >> 1) & 1, dvh = vh & 1;
        const bf16_t* base = proj + (size_t)b * SEQ * INC;
        const float slope2 = exp2f(-2.0f * (h + 1)) * 1.4426950408889634f;
        attn_body::attn_unit<8>(qb, base + C_QDA + h * 128 + map * 64, base + C_KDA + h * 128 + map * 64, base + C_VDA + h * 128 + dvh * 64,
                                OA + (size_t)b * SEQ * 1024 + vh * 64, slope2, (char*)F.lds);
    }
}
__device__ __forceinline__ void attn_combine(const Frame& F, const Args& a) {
    const bf16_t* OA = (const bf16_t*)(a.ws + WS_OA); bf16_t* Y = (bf16_t*)(a.ws + WS_YDA);
    const float lam = ((const float*)(a.ws + WS_SMALL))[0];
    const float g0 = a.in[I_SUBG][2 * F.lane] * 0.8f, g1 = a.in[I_SUBG][2 * F.lane + 1] * 0.8f;
    const int gw = F.bid * NWAVES + F.wave, NGW = F.G * NWAVES;
    for (int r = gw; r < T; r += NGW) {
        const unsigned* orow = (const unsigned*)(OA + (size_t)r * 1024); unsigned* yrow = (unsigned*)(Y + (size_t)r * 512);
        unsigned w0[4], w1[4];
#pragma unroll
        for (int h = 0; h < 4; ++h) { w0[h] = orow[h * 128 + F.lane]; w1[h] = orow[h * 128 + 64 + F.lane]; }
#pragma unroll
        for (int h = 0; h < 4; ++h) {
            const float x0 = bf2f(w0[h] & 0xffffu) - lam * bf2f(w1[h] & 0xffffu), x1 = bf2f(w0[h] >> 16) - lam * bf2f(w1[h] >> 16);
            const float rs = rsqrtf(wave_sum(x0 * x0 + x1 * x1) * (1.0f / 128.0f) + EPS);
            yrow[h * 64 + F.lane] = pk2(x0 * rs * g0, x1 * rs * g1);
        }
    }
}
namespace hg {
constexpr int QP = 136;
constexpr int L_QD = 0, L_KD = 64 * QP * 2, L_V = 2 * 64 * QP * 2, L_KE = 3 * 64 * QP * 2, L_SSQ = 4 * 64 * QP * 2;
__device__ __forceinline__ f32x4 mfma16(bf16x8 a, bf16x8 b, f32x4 c) { return __builtin_amdgcn_mfma_f32_16x16x32_bf16(a, b, c, 0, 0, 0); }
#define HG_BAR() do { asm volatile("s_waitcnt lgkmcnt(0)" ::: "memory"); __builtin_amdgcn_s_barrier(); asm volatile("" ::: "memory"); } while (0)
typedef short v4i16_t __attribute__((ext_vector_type(4)));
__device__ __forceinline__ bf16x8 tr8(const LAS unsigned char* img, int ra, int rb, int col0, int lane) {
    const int q = (lane & 15) >> 2, p = lane & 3;
    const v4i16_t lo = __builtin_amdgcn_ds_read_tr16_b64_v4i16((LAS v4i16_t*)(img + ((ra + q) * QP + col0 + 4 * p) * 2));
    const v4i16_t hi = __builtin_amdgcn_ds_read_tr16_b64_v4i16((LAS v4i16_t*)(img + ((rb + q) * QP + col0 + 4 * p) * 2));
    return (bf16x8){lo[0], lo[1], lo[2], lo[3], hi[0], hi[1], hi[2], hi[3]};
}
struct Tile { u32x4 p[2]; };
__device__ __forceinline__ void tile_load(Tile& t, const bf16_t* src, size_t pitch, int tid) {
#pragma unroll
    for (int i = 0; i < 2; ++i) { const int pc = tid + NTHR * i; t.p[i] = *(const u32x4*)(src + (size_t)(pc >> 4) * pitch + (pc & 15) * 8); }
}
__device__ __forceinline__ void tile_put(const Tile& t, LAS unsigned char* img, int tid) {
#pragma unroll
    for (int i = 0; i < 2; ++i) { const int pc = tid + NTHR * i; *(LAS u32x4*)(img + ((pc >> 4) * QP + (pc & 15) * 8) * 2) = t.p[i]; }
}
struct In1 { Tile ke, v; };
__device__ __forceinline__ void load1(In1& r, const Frame& F, const Args& a, int unit) {
    const int bh = unit >> 6, n = unit & 63, b = bh >> 2, h = bh & 3; const size_t t0 = (size_t)b * SEQ + n * 64;
    tile_load(r.ke, (const bf16_t*)a.out + t0 * 512 + h * 128, 512, F.tid);
    tile_load(r.v, (const bf16_t*)(a.ws + WS_PROJ) + t0 * INC + C_IHG + h * 128, INC, F.tid);
}
__device__ __forceinline__ void stage1_unit(const In1& raw, const Frame& F, const Args& a, int unit) {
    const int bh = unit >> 6, n = unit & 63;
    tile_put(raw.ke, F.lds + L_KE, F.tid); tile_put(raw.v, F.lds + L_V, F.tid);
    HG_BAR();
    const int wk = F.wave >> 1, wv = F.wave & 1, fr = F.lane & 15, fq = F.lane >> 4;
    f32x4 acc[2][4];
#pragma unroll
    for (int i = 0; i < 2; ++i)
#pragma unroll
        for (int j = 0; j < 4; ++j) acc[i][j] = (f32x4){0.f, 0.f, 0.f, 0.f};
#pragma unroll
    for (int s2 = 0; s2 < 2; ++s2) {
        bf16x8 af[2], bv[4];
#pragma unroll
        for (int kt = 0; kt < 2; ++kt) af[kt] = tr8(F.lds + L_KE, 32 * s2 + 8 * fq, 32 * s2 + 8 * fq + 4, 32 * wk + 16 * kt, F.lane);
#pragma unroll
        for (int vt = 0; vt < 4; ++vt) bv[vt] = tr8(F.lds + L_V, 32 * s2 + 8 * fq, 32 * s2 + 8 * fq + 4, 64 * wv + 16 * vt, F.lane);
#pragma unroll
        for (int kt = 0; kt < 2; ++kt)
#pragma unroll
            for (int vt = 0; vt < 4; ++vt) acc[kt][vt] = mfma16(af[kt], bv[vt], acc[kt][vt]);
    }
    bf16_t* ds = (bf16_t*)(a.ws + WS_DS) + ((size_t)bh * 64 + n) * 16384;
#pragma unroll
    for (int kt = 0; kt < 2; ++kt)
#pragma unroll
        for (int vt = 0; vt < 4; ++vt) { const int v = 64 * wv + 16 * vt + fr, k = 32 * wk + 16 * kt + 4 * fq;
            u32x2 w; w.x = pk2(acc[kt][vt][0], acc[kt][vt][1]); w.y = pk2(acc[kt][vt][2], acc[kt][vt][3]); *(u32x2*)(ds + v * 128 + k) = w; }
    HG_BAR();
}
__device__ __forceinline__ void stage1_all(const Frame& F, const Args& a) {
    int u = F.bid; if (u >= 1024) return;
    In1 cur, nxt; load1(cur, F, a, u);
    for (; u < 1024; u += F.G) { const int un = (u + F.G < 1024) ? u + F.G : u; load1(nxt, F, a, un); stage1_unit(cur, F, a, u); cur = nxt; }
}
__device__ __forceinline__ void stage2_scan(const Frame& F, const Args& a) {
    unsigned* ds = (unsigned*)(a.ws + WS_DS); const float* dec = (const float*)(a.ws + WS_DEC);
    for (int gt = F.bid * NTHR + F.tid; gt < 16 * 8192; gt += F.G * NTHR) {
        const int bh = gt >> 13, e2 = gt & 8191, k = (2 * e2) & 127;
        unsigned* p = ds + (size_t)bh * 64 * 8192 + e2; const float* dp = dec + (size_t)bh * 64 * 128 + k;
        float s0 = 0.f, s1 = 0.f;
#pragma unroll 8
        for (int n = 0; n < 64; ++n) { const unsigned u = p[(size_t)n * 8192]; const f32x2 d = *(const f32x2*)(dp + n * 128);
            p[(size_t)n * 8192] = pk2(s0, s1); s0 = d.x * s0 + bf2f(u & 0xffffu); s1 = d.y * s1 + bf2f(u >> 16); }
    }
}
struct In3 { Tile qd, kd, v; };
__device__ __forceinline__ void load3(In3& r, const Frame& F, const Args& a, int unit) {
    const int bh = unit >> 6, n = unit & 63, b = bh >> 2, h = bh & 3;
    const bf16_t* base = (const bf16_t*)(a.ws + WS_PROJ) + ((size_t)b * SEQ + n * 64) * INC;
    tile_load(r.qd, base + C_HGT + 256 * h, INC, F.tid); tile_load(r.kd, base + C_HGT + 256 * h + 128, INC, F.tid); tile_load(r.v, base + C_IHG + h * 128, INC, F.tid);
}
__device__ __forceinline__ void stage3_unit(const In3& raw, const Frame& F, const Args& a, int unit) {
    const int bh = unit >> 6, n = unit & 63, b = bh >> 2, h = bh & 3;
    const int tb = F.wave >> 1, vh = F.wave & 1, fr = F.lane & 15, fq = F.lane >> 4;
    const bf16_t* sst = (const bf16_t*)(a.ws + WS_DS) + ((size_t)bh * 64 + n) * 16384;
    bf16x8 sb[4][4];
#pragma unroll
    for (int ks = 0; ks < 4; ++ks)
#pragma unroll
        for (int vt = 0; vt < 4; ++vt) sb[ks][vt] = *(const bf16x8*)(sst + (64 * vh + 16 * vt + fr) * 128 + 32 * ks + 8 * fq);
    const size_t t0 = (size_t)b * SEQ + n * 64 + 16 * tb + 4 * fq;
    const bf16_t* gp = (const bf16_t*)(a.ws + WS_PROJ) + t0 * INC + C_GHG + h * 128 + 64 * vh + fr;
    unsigned short gv[4][4];
#pragma unroll
    for (int r = 0; r < 4; ++r)
#pragma unroll
        for (int vt = 0; vt < 4; ++vt) gv[r][vt] = gp[(size_t)r * INC + 16 * vt];
    tile_put(raw.qd, F.lds + L_QD, F.tid); tile_put(raw.kd, F.lds + L_KD, F.tid); tile_put(raw.v, F.lds + L_V, F.tid);
    HG_BAR();
    bf16x8 qf[4];
#pragma unroll
    for (int ks = 0; ks < 4; ++ks) qf[ks] = *(const LAS bf16x8*)(F.lds + L_QD + ((16 * tb + fr) * QP + 32 * ks + 8 * fq) * 2);
    unsigned pk[4][2];
#pragma unroll
    for (int jt = 0; jt < 4; ++jt) { pk[jt][0] = 0u; pk[jt][1] = 0u;
        if (jt <= tb) { f32x4 sc = (f32x4){0.f, 0.f, 0.f, 0.f};
#pragma unroll
            for (int ks = 0; ks < 4; ++ks) { const bf16x8 kf = *(const LAS bf16x8*)(F.lds + L_KD + ((16 * jt + fr) * QP + 32 * ks + 8 * fq) * 2); sc = mfma16(kf, qf[ks], sc); }
            if (jt == tb) {
#pragma unroll
                for (int r = 0; r < 4; ++r) if (4 * fq + r > fr) sc[r] = 0.f;
            }
            pk[jt][0] = pk2(sc[0], sc[1]); pk[jt][1] = pk2(sc[2], sc[3]); } }
    f32x4 o[4];
#pragma unroll
    for (int vt = 0; vt < 4; ++vt) o[vt] = (f32x4){0.f, 0.f, 0.f, 0.f};
#pragma unroll
    for (int s2 = 0; s2 < 2; ++s2) if (2 * s2 <= tb) {
        const u32x4 aw = (u32x4){pk[2 * s2][0], pk[2 * s2][1], pk[2 * s2 + 1][0], pk[2 * s2 + 1][1]};
        const bf16x8 af = __builtin_bit_cast(bf16x8, aw);
#pragma unroll
        for (int vt = 0; vt < 4; ++vt) o[vt] = mfma16(af, tr8(F.lds + L_V, 32 * s2 + 4 * fq, 32 * s2 + 16 + 4 * fq, 64 * vh + 16 * vt, F.lane), o[vt]);
    }
#pragma unroll
    for (int ks = 0; ks < 4; ++ks)
#pragma unroll
        for (int vt = 0; vt < 4; ++vt) o[vt] = mfma16(qf[ks], sb[ks][vt], o[vt]);
    float ss[4];
#pragma unroll
    for (int r = 0; r < 4; ++r) { float v = 0.f;
#pragma unroll
        for (int vt = 0; vt < 4; ++vt) v += o[vt][r] * o[vt][r];
        v += __shfl_xor(v, 1); v += __shfl_xor(v, 2); v += __shfl_xor(v, 4); v += __shfl_xor(v, 8); ss[r] = v; }
    LAS float* SSQ = (LAS float*)(F.lds + L_SSQ);
    if (fr == 0) {
#pragma unroll
        for (int r = 0; r < 4; ++r) SSQ[(tb * 2 + vh) * 16 + 4 * fq + r] = ss[r]; }
    HG_BAR();
    bf16_t* yp = (bf16_t*)(a.ws + WS_YHG) + t0 * 512 + h * 128 + 64 * vh + fr;
#pragma unroll
    for (int r = 0; r < 4; ++r) { const float tot = SSQ[(tb * 2) * 16 + 4 * fq + r] + SSQ[(tb * 2 + 1) * 16 + 4 * fq + r]; const float rs = rsqrtf(tot * (1.0f / 128.0f) + EPS);
#pragma unroll
        for (int vt = 0; vt < 4; ++vt) { const float g = bf2f(gv[r][vt]); const float ng = a.in[I_HGNG][64 * vh + 16 * vt + fr];
            yp[(size_t)r * 512 + 16 * vt] = (bf16_t)f2bf(o[vt][r] * rs * ng * siluf_(g)); } }
    HG_BAR();
}
__device__ __forceinline__ void stage3_all(const Frame& F, const Args& a) {
    int u = F.bid; if (u >= 1024) return;
    In3 cur, nxt; load3(cur, F, a, u);
    for (; u < 1024; u += F.G) { const int un = (u + F.G < 1024) ? u + F.G : u; load3(nxt, F, a, un); stage3_unit(cur, F, a, u); cur = nxt; }
}
#undef HG_BAR
}

__device__ __forceinline__ float rs4(float a0, float a1, float a2, float a3, int lane) {
    const bool hi = (lane & 32) != 0;
    const float s0 = hi ? a0 : a2, s1 = hi ? a1 : a3;
    const float k0 = (hi ? a2 : a0) + __shfl_xor(s0, 32), k1 = (hi ? a3 : a1) + __shfl_xor(s1, 32);
    const bool b4 = (lane & 16) != 0;
    const float sd = b4 ? k0 : k1;
    float k = (b4 ? k1 : k0) + __shfl_xor(sd, 16);
    k += __shfl_xor(k, 8); k += __shfl_xor(k, 4); k += __shfl_xor(k, 2); k += __shfl_xor(k, 1);
    return k;
}
__device__ __forceinline__ void phase_router(const Frame& F, const Args& a) {
    constexpr int AP = 1032;
    LAS bf16_t* AH = (LAS bf16_t*)F.lds;
    LAS bf16_t* AL = AH + 16 * AP;
    LAS float* PART = (LAS float*)(F.lds + 2 * 16 * AP * 2);
    LAS float* LG = PART + 8 * 16 * 48;
    LAS unsigned* LH = (LAS unsigned*)(LG + 16 * 48);
    LAS unsigned* LB = LH + 32;
    LAS unsigned* LR = LH + 64;
    if (F.tid < NEXP) LH[F.tid] = 0u;
    const float* mod = (const float*)(a.ws + WS_MOD);
    const float* x1 = a.out; bf16_t* H2 = (bf16_t*)(a.ws + WS_ACT);
    unsigned* counts = (unsigned*)(a.ws + WS_CTL) + CW_COUNTS; unsigned* tokinfo = (unsigned*)(a.ws + WS_TOKINFO); int* toklist = (int*)(a.ws + WS_TOKLIST);
    const int rows_per_blk = T / F.G, r0 = F.bid * rows_per_blk, b = r0 / SEQ;
    const int lane = F.lane, w = F.wave, fr = lane & 15, fq = lane >> 4;
    f32x4 v[2][4], vn[2][4];
#define RT_LOAD(V, rb_) do { _Pragma("unroll") for (int q = 0; q < 2; ++q) { const f32x4* xr_ = (const f32x4*)(x1 + (size_t)((rb_) + 2 * w + q) * D) + lane; \
        _Pragma("unroll") for (int j = 0; j < 4; ++j) V[q][j] = xr_[64 * j]; } } while (0)
    RT_LOAD(v, r0);
    bf16x8 Bh[4][3], Bl[4][3];
    {
        const float* wre = a.in[I_WRE]; const float* wrg = a.in[I_WRG];
#pragma unroll
        for (int ks = 0; ks < 4; ++ks)
#pragma unroll
            for (int ct = 0; ct < 3; ++ct) {
                unsigned hw[4], lw[4];
#pragma unroll
                for (int jp = 0; jp < 4; ++jp) { float x[2];
#pragma unroll
                    for (int z = 0; z < 2; ++z) { const int k = 128 * w + 32 * ks + 8 * fq + 2 * jp + z;
                        if (ct == 0) { const float g = wrg[k * 4 + (fr & 3)], e = wre[k * 32 + ((fr + 28) & 31)]; x[z] = fr < 4 ? g : e; }
                        else if (ct == 1) x[z] = wre[k * 32 + 12 + fr];
                        else { const float e = wre[k * 32 + 28 + (fr & 3)]; x[z] = fr < 4 ? e : 0.f; } }
                    const unsigned h0 = f2bf(x[0]), h1 = f2bf(x[1]); hw[jp] = h0 | (h1 << 16);
                    lw[jp] = pk2(x[0] - bf2f(h0), x[1] - bf2f(h1)); }
                Bh[ks][ct] = __builtin_bit_cast(bf16x8, (u32x4){hw[0], hw[1], hw[2], hw[3]}); Bl[ks][ct] = __builtin_bit_cast(bf16x8, (u32x4){lw[0], lw[1], lw[2], lw[3]});
            }
    }
    for (int g = 0; g < rows_per_blk / 16; ++g) {
        const int rg = r0 + 16 * g;
        { const int gn = g + 1 < rows_per_blk / 16 ? g + 1 : g; RT_LOAD(vn, r0 + 16 * gn); }
#pragma unroll
        for (int q = 0; q < 2; ++q) { float sq = 0.f;
#pragma unroll
            for (int j = 0; j < 4; ++j) sq += (v[q][j].x * v[q][j].x + v[q][j].y * v[q][j].y) + (v[q][j].z * v[q][j].z + v[q][j].w * v[q][j].w);
            const float rs = rsqrtf(wave_sum(sq) * (1.0f / D) + EPS); const int row = 2 * w + q;
#pragma unroll
            for (int j = 0; j < 4; ++j) { const int k = 256 * j + 4 * lane;
                const f32x4 gg = *(const f32x4*)(a.in[I_N2G] + k) * (1.0f + *(const f32x4*)(mod + b * 6144 + 4 * 1024 + k)), sh = *(const f32x4*)(mod + b * 6144 + 3 * 1024 + k);
                const f32x4 hv = v[q][j] * rs * gg + sh;
                const unsigned h0 = f2bf(hv.x), h1 = f2bf(hv.y), h2_ = f2bf(hv.z), h3 = f2bf(hv.w);
                const u32x2 hw = (u32x2){h0 | (h1 << 16), h2_ | (h3 << 16)};
                *(u32x2*)(H2 + (size_t)(rg + row) * D + k) = hw;
                *(LAS u32x2*)(AH + row * AP + k) = hw;
                *(LAS u32x2*)(AL + row * AP + k) = (u32x2){pk2(hv.x - bf2f(h0), hv.y - bf2f(h1)), pk2(hv.z - bf2f(h2_), hv.w - bf2f(h3))}; } }
        __syncthreads();
        f32x4 acc[3] = {{0.f, 0.f, 0.f, 0.f}, {0.f, 0.f, 0.f, 0.f}, {0.f, 0.f, 0.f, 0.f}};
#pragma unroll
        for (int ks = 0; ks < 4; ++ks) { const bf16x8 ah = *(const LAS bf16x8*)(AH + fr * AP + 128 * w + 32 * ks + 8 * fq), al = *(const LAS bf16x8*)(AL + fr * AP + 128 * w + 32 * ks + 8 * fq);
#pragma unroll
            for (int ct = 0; ct < 3; ++ct) { acc[ct] = __builtin_amdgcn_mfma_f32_16x16x32_bf16(ah, Bh[ks][ct], acc[ct], 0, 0, 0);
                acc[ct] = __builtin_amdgcn_mfma_f32_16x16x32_bf16(al, Bh[ks][ct], acc[ct], 0, 0, 0); acc[ct] = __builtin_amdgcn_mfma_f32_16x16x32_bf16(ah, Bl[ks][ct], acc[ct], 0, 0, 0); } }
#pragma unroll
        for (int ct = 0; ct < 3; ++ct)
#pragma unroll
            for (int r = 0; r < 4; ++r) PART[(w * 16 + 4 * fq + r) * 48 + 16 * ct + fr] = acc[ct][r];
        __syncthreads();
        for (int t = F.tid; t < 16 * 48; t += NTHR) { const int row = t / 48, o = t % 48; float sacc = 0.f;
#pragma unroll
            for (int ww = 0; ww < 8; ++ww) sacc += PART[(ww * 16 + row) * 48 + o];
            if (o < 36) LG[row * 48 + o] = sacc + (o < 4 ? a.in[I_BRG][o & 3] : a.in[I_BRE][(o + 28) & 31]); }
        __syncthreads();
        if (F.tid < 16) {
            const LAS float* lg = LG + F.tid * 48;
            float gl[4]; int gi = 0;
#pragma unroll
            for (int o = 0; o < 4; ++o) gl[o] = lg[o];
            float gm = gl[0];
#pragma unroll
            for (int o = 1; o < 4; ++o) if (gl[o] > gm) { gm = gl[o]; gi = o; }
            float gsum = 0.f;
#pragma unroll
            for (int o = 0; o < 4; ++o) gsum += expf(gl[o] - gm);
            const float gp = 1.0f / gsum;
            float el[8];
#pragma unroll
            for (int e = 0; e < 8; ++e) el[e] = lg[4 + gi * 8 + e];
            int i0 = 0; float m0 = el[0];
#pragma unroll
            for (int o = 1; o < 8; ++o) if (el[o] > m0) { m0 = el[o]; i0 = o; }
            int i1 = -1; float m1 = -INFINITY;
#pragma unroll
            for (int o = 0; o < 8; ++o) if (o != i0 && el[o] > m1) { m1 = el[o]; i1 = o; }
            const float e1 = expf(m1 - m0); const float w0 = gp / (1.0f + e1), w1 = gp * e1 / (1.0f + e1);
            const int rl = 16 * g + F.tid, ex0 = gi * 8 + i0, ex1 = gi * 8 + i1;
            const unsigned l0 = atomicAdd((unsigned*)(LH + ex0), 1u), l1 = atomicAdd((unsigned*)(LH + ex1), 1u);
            LAS unsigned* ri = LR + rl * 6;
            ri[0] = (unsigned)ex0; ri[1] = l0; ri[2] = (unsigned)ex1; ri[3] = l1; ri[4] = __float_as_uint(w0); ri[5] = __float_as_uint(w1);
        }
#pragma unroll
        for (int q = 0; q < 2; ++q)
#pragma unroll
            for (int j = 0; j < 4; ++j) v[q][j] = vn[q][j];
    }
#undef RT_LOAD
    __syncthreads();
    if (F.tid < NEXP) LB[F.tid] = atomicAdd(counts + 64 * F.tid, LH[F.tid]);
    __syncthreads();
    for (int rl = F.tid; rl < rows_per_blk; rl += NTHR) {
        const LAS unsigned* ri = LR + rl * 6; const int r = r0 + rl;
        const unsigned ex0 = ri[0], ex1 = ri[2], k0 = LB[ex0] + ri[1], k1 = LB[ex1] + ri[3];
        toklist[ex0 * T + k0] = r; toklist[ex1 * T + k1] = r;
        u32x4 t0; t0.x = ex0; t0.y = k0; t0.z = ex1; t0.w = k1;
        *(u32x4*)(tokinfo + (size_t)r * 8) = t0;
        tokinfo[(size_t)r * 8 + 4] = ri[4]; tokinfo[(size_t)r * 8 + 5] = ri[5];
    }
}
__device__ __forceinline__ void build_moe_tab(const Frame& F, const Args& a, LAS MoeTab* tab) {
    if (F.tid == 0) {
        const unsigned* counts = (const unsigned*)(a.ws + WS_CTL) + CW_COUNTS; int nt = 0;
        for (int e = 0; e < NEXP; ++e) { const int c = (int)__hip_atomic_load(counts + 64 * e, __ATOMIC_RELAXED, __HIP_MEMORY_SCOPE_AGENT); tab->cnt[e] = c; tab->tbase[e] = nt;
            const int n = (c + 255) >> 8; for (int m = 0; m < n; ++m) { tab->tile_e[nt] = e; tab->tile_m[nt] = m; ++nt; } }
        tab->tbase[NEXP] = nt; tab->nt = nt;
    }
    __syncthreads();
}
__device__ __forceinline__ void phase_final(const Frame& F, const Args& a, const LAS MoeTab* tab) {
    const float* mod = (const float*)(a.ws + WS_MOD); const unsigned* tokinfo = (const unsigned*)(a.ws + WS_TOKINFO); const bf16_t* Ys = (const bf16_t*)(a.ws + WS_YS);
    const int rows_per_blk = T / F.G, r0 = F.bid * rows_per_blk;
    for (int r = r0 + F.wave; r < r0 + rows_per_blk; r += NWAVES) {
        const int b = r / SEQ;
        const u32x4 ti = *(const u32x4*)(tokinfo + (size_t)r * 8);
        const float w0 = __uint_as_float(tokinfo[(size_t)r * 8 + 4]), w1 = __uint_as_float(tokinfo[(size_t)r * 8 + 5]);
        const size_t s0 = (size_t)tab->tbase[ti.x] * 256 + ti.y, s1 = (size_t)tab->tbase[ti.z] * 256 + ti.w;
        f32x4* xr = (f32x4*)(a.out + (size_t)r * D) + F.lane;
        const u32x2* y0 = (const u32x2*)(Ys + s0 * D) + F.lane; const u32x2* y1 = (const u32x2*)(Ys + s1 * D) + F.lane;
        f32x4 v[4]; float s = 0.f;
#pragma unroll
        for (int j = 0; j < 4; ++j) { const int k = 256 * j + 4 * F.lane;
            const f32x4 gt = *(const f32x4*)(mod + b * 6144 + 5 * 1024 + k); const u32x2 a0 = y0[64 * j], a1 = y1[64 * j];
            f32x4 m; m.x = w0 * bf2f(a0.x & 0xffffu) + w1 * bf2f(a1.x & 0xffffu); m.y = w0 * bf2f(a0.x >> 16) + w1 * bf2f(a1.x >> 16);
            m.z = w0 * bf2f(a0.y & 0xffffu) + w1 * bf2f(a1.y & 0xffffu); m.w = w0 * bf2f(a0.y >> 16) + w1 * bf2f(a1.y >> 16);
            v[j] = xr[64 * j] + gt * m; s += (v[j].x * v[j].x + v[j].y * v[j].y) + (v[j].z * v[j].z + v[j].w * v[j].w); }
        const float rs = rsqrtf(wave_sum(s) * (1.0f / D) + EPS);
#pragma unroll
        for (int j = 0; j < 4; ++j) { const f32x4 g = *(const f32x4*)(a.in[I_FG] + 256 * j + 4 * F.lane); xr[64 * j] = v[j] * rs * g; }
    }
}

#define XB_TMO      128
#define XB_XCNT(j)  (256  + 64 * (j))
#define XB_XSUB(j)  (1280 + 64 * (j))
#define XB_XGEN(j)  (2304 + 64 * (j))
#define XB_TOP      3328
#define XB_TOPGEN   3392
#define XCD_BAR_WORDS 3456
#define XB_SPIN_CAP (1u << 18)
__device__ __forceinline__ unsigned xb_ld(unsigned* p)              { return __hip_atomic_load(p, __ATOMIC_RELAXED, __HIP_MEMORY_SCOPE_AGENT); }
__device__ __forceinline__ unsigned xb_add(unsigned* p, unsigned v) { return __hip_atomic_fetch_add(p, v, __ATOMIC_RELAXED, __HIP_MEMORY_SCOPE_AGENT); }
__device__ __forceinline__ unsigned xb_xcc_id() { return (unsigned)__builtin_amdgcn_s_getreg((3 << 11) | 20) & 0xFu; }
#define XB_SPIN(cond, bar) do { unsigned _sp = 0; while (cond) { __builtin_amdgcn_s_sleep(1); \
    if ((++_sp & 255u) == 0u) { if (xb_ld(&(bar)[XB_TMO])) break; if (_sp > XB_SPIN_CAP) { atomicAdd(&(bar)[XB_TMO], 1u); break; } } } } while (0)
struct XcdBarrier { unsigned* bar; unsigned x; volatile LAS unsigned* st; };
__device__ __forceinline__ XcdBarrier xcd_barrier_post(unsigned* bar, volatile LAS unsigned* st) {
    XcdBarrier b; b.bar = bar; b.x = xb_xcc_id(); b.st = st;
    if (threadIdx.x == 0) (void)xb_add(&bar[XB_XCNT(b.x)], 1u);
    return b;
}
__device__ __forceinline__ void xcd_barrier_complete(unsigned* bar, unsigned x, unsigned& nloc, unsigned& nx) {
    const unsigned G = gridDim.x * gridDim.y * gridDim.z;
    unsigned sum, cnt, mine, sp = 0u;
    for (;;) {
        sum = 0u; cnt = 0u; mine = 0u;
#pragma unroll
        for (unsigned j = 0; j < 16; ++j) { const unsigned c = xb_ld(&bar[XB_XCNT(j)]); sum += c; cnt += (c > 0u) ? 1u : 0u; mine = (j == x) ? c : mine; }
        if (sum == G) break;
        __builtin_amdgcn_s_sleep(1);
        if ((++sp & 255u) == 0u) { if (xb_ld(&bar[XB_TMO])) break; if (sp > XB_SPIN_CAP) { atomicAdd(&bar[XB_TMO], 1u); break; } }
    }
    nloc = mine > 0u ? mine : 1u; nx = cnt > 0u ? cnt : 1u;
}
__device__ __forceinline__ void xcd_barrier(const XcdBarrier& b) {
    asm volatile("s_waitcnt vmcnt(0)" ::: "memory");
    __syncthreads();
    if (threadIdx.x == 0) {
        unsigned* bar = b.bar;
        __builtin_amdgcn_s_waitcnt(0);
        unsigned nloc = b.st[0], nx = b.st[1];
        if (nloc == 0u) { xcd_barrier_complete(bar, b.x, nloc, nx); b.st[0] = nloc; b.st[1] = nx; }
        const unsigned old = xb_add(&bar[XB_XSUB(b.x)], 1u);
        const unsigned gen = old / nloc;
        if (old + 1u == (gen + 1u) * nloc) {
            __builtin_amdgcn_fence(__ATOMIC_RELEASE, "agent");
            asm volatile("s_waitcnt vmcnt(0)" ::: "memory");
            const unsigned og = xb_add(&bar[XB_TOP], 1u);
            const unsigned tg = og / nx;
            if (og + 1u == (tg + 1u) * nx) xb_add(&bar[XB_TOPGEN], 1u);
            else XB_SPIN(xb_ld(&bar[XB_TOPGEN]) == tg, bar);
            __builtin_amdgcn_fence(__ATOMIC_ACQUIRE, "agent");
            xb_add(&bar[XB_XGEN(b.x)], 1u);
            asm volatile("s_waitcnt vmcnt(0)" ::: "memory");
        } else {
            XB_SPIN(xb_ld(&bar[XB_XGEN(b.x)]) == gen, bar);
            __builtin_amdgcn_fence(__ATOMIC_ACQUIRE, "agent");
            asm volatile("s_waitcnt vmcnt(0)" ::: "memory");
        }
    }
    __syncthreads();
}

constexpr int N_PHASES = 12;
__global__ void __launch_bounds__(NTHR, 2) mk_fwd(Args a) {
    extern __shared__ __attribute__((aligned(16))) unsigned char lds_raw[];
    Frame F; F.lds = (LAS unsigned char*)lds_raw; F.tid = threadIdx.x; F.lane = F.tid & 63; F.wave = __builtin_amdgcn_readfirstlane(F.tid >> 6); F.G = gridDim.x; F.bid = blockIdx.x;
    unsigned char* ws = a.ws;
    const int lo = a.ph_lo, hi = a.ph_hi;
#if MK_N_LAUNCHES == 1
    volatile LAS unsigned* MISC = (volatile LAS unsigned*)(F.lds + 152 * 1024);
    if (F.tid < 4) MISC[F.tid] = 0u;
    __syncthreads();
    XcdBarrier xbar = xcd_barrier_post((unsigned*)(ws + WS_CTL) + CW_BAR, MISC);
#ifndef PROBE_TS
#define PROBE_TS -1
#endif
#define STAMP(k) do { if (PROBE_TS >= 0 && F.bid == 0 && F.tid == 0) { const unsigned long long t_ = __builtin_amdgcn_s_memrealtime(); MISC[16 + 2 * (k)] = (unsigned)t_; MISC[17 + 2 * (k)] = (unsigned)(t_ >> 32); } } while (0)
#define SEAM(k) do { if (IN(k) && IN((k) + 1)) xcd_barrier(xbar); STAMP((k) + 1); } while (0)
    STAMP(0);
#else
#define SEAM(k) do { } while (0)
#endif
#ifndef PHASE_MASK
#define PHASE_MASK 0xfff
#endif
#define IN(k) (((PHASE_MASK >> (k)) & 1) && lo <= (k) && (k) < hi)
    LAS MoeTab* tab = (LAS MoeTab*)(F.lds + 144 * 1024);

#ifndef REPEAT_PHASE
#define REPEAT_PHASE -1
#endif
#if MK_N_LAUNCHES == 1
#define RUNPH(k, ...) if (IN(k)) { F.lane = lane_now(); F.tid = F.wave * 64 + F.lane; __VA_ARGS__ if (REPEAT_PHASE == (k)) { xcd_barrier(xbar); __VA_ARGS__ } }
#else
#define RUNPH(k, ...) if (IN(k)) { F.lane = lane_now(); F.tid = F.wave * 64 + F.lane; __VA_ARGS__ }
#endif
    RUNPH(0, { phase0(F, a); }) SEAM(0);
    RUNPH(1, { phase1(F, a); }) SEAM(1);
    RUNPH(2, {
        DenseOrder S{(const char*)(ws + WS_ACT), (const char*)(ws + WS_WIN), D, T / 256, INC / 256, F.G, F.bid};
        EpiInProj E{(bf16_t*)(ws + WS_PROJ), (bf16_t*)a.out, (float*)(ws + WS_DEC), (const float*)(ws + WS_SMALL) + 16, attn_body::C2};
        pg8::gemm_phase(F.lds, D, S, E);
    }) SEAM(2);
    RUNPH(3, {
        hg::stage1_all(F, a);
        __syncthreads();
        attn_phase(F, a);
    }) SEAM(3);
    RUNPH(4, { hg::stage2_scan(F, a); attn_combine(F, a); }) SEAM(4);
    RUNPH(5, { hg::stage3_all(F, a); }) SEAM(5);
    RUNPH(6, {
        UpOrder S{(const char*)(ws + WS_YDA), (const char*)(ws + WS_YHG), (const char*)(ws + WS_WUPDA), (const char*)(ws + WS_WUPHG), F.G, F.bid};
        EpiUp E{(const bf16_t*)(ws + WS_PROJ), (bf16_t*)(ws + WS_ACT)};
        pg8::gemm_phase(F.lds, 512, S, E);
    }) SEAM(6);
    RUNPH(7, {
        DenseOrder S{(const char*)(ws + WS_ACT), (const char*)(ws + WS_WOUT), D, T / 256, D / 256, F.G, F.bid};
        EpiOut E{a.in[I_X], (const float*)(ws + WS_MOD), a.out};
        pg8::gemm_phase(F.lds, D, S, E);
        moe_weight_convert(F, a);
    }) SEAM(7);
    RUNPH(8, { phase_router(F, a); __syncthreads(); }) SEAM(8);
    RUNPH(9, {
        build_moe_tab(F, a, tab);
        Moe1Order S{tab, (const char*)(ws + WS_ACT), (const char*)(ws + WS_W13), (const int*)(ws + WS_TOKLIST), F.G, F.bid};
        EpiMoe1 E{(bf16_t*)(ws + WS_HS)};
        pg8::gemm_phase(F.lds, D, S, E);
        { const int n1 = tab->nt * 4, r = n1 % F.G; const int nidle = r ? F.G - r : F.G, myidx = r ? F.bid - r : F.bid;
          if (myidx >= 0) moe_w2_convert(F, a, myidx, nidle); }
    }) SEAM(9);
    RUNPH(10, {
        build_moe_tab(F, a, tab);
        Moe2Order S{tab, (const char*)(ws + WS_HS), (const char*)(ws + WS_W2), F.G, F.bid};
        EpiStoreBf16 E{(bf16_t*)(ws + WS_YS), D, 0, 1.0f};
        pg8::gemm_phase(F.lds, DEXP, S, E);
    }) SEAM(10);
    RUNPH(11, { build_moe_tab(F, a, tab); phase_final(F, a, tab); })
#if MK_N_LAUNCHES == 1
    if (PROBE_TS >= 0) {
        __syncthreads(); STAMP(12);
        if (F.bid == 0 && F.tid == 0) {
            const int ka = PROBE_TS & 15, kb = (PROBE_TS >> 4) & 15;
            const unsigned long long a0 = ((unsigned long long)MISC[17 + 2 * ka] << 32) | MISC[16 + 2 * ka], a1 = ((unsigned long long)MISC[19 + 2 * ka] << 32) | MISC[18 + 2 * ka];
            const unsigned long long b0 = ((unsigned long long)MISC[17 + 2 * kb] << 32) | MISC[16 + 2 * kb], b1 = ((unsigned long long)MISC[19 + 2 * kb] << 32) | MISC[18 + 2 * kb];
            const float da = (float)(a1 - a0) * 0.01f, db = (float)(b1 - b0) * 0.01f;
            asm volatile("s_waitcnt vmcnt(0)" ::: "memory");
            a.out[0] += sqrtf(da * 16.78f); a.out[1] += db * 0.1f;
        }
    }
#endif
#undef IN
#undef SEAM
}

extern "C" void kernel_launch(void* const* d_in, const int* in_sizes, int n_in, void* d_out, int out_size, void* d_ws, size_t ws_size, hipStream_t stream) {
    static int grid = 0;
    if (grid == 0) {
        if (n_in != 25 || in_sizes[0] != T * D || out_size != T * D || ws_size < WS_END) { fprintf(stderr, "kernel_launch: unexpected shapes (n_in %d, in0 %d, out %d, ws %zu)\n", n_in, n_in > 0 ? in_sizes[0] : -1, out_size, ws_size); grid = -1; return; }
        int dev = 0, cus = 0, per_cu = 0;
        if (hipGetDevice(&dev) != hipSuccess || hipDeviceGetAttribute(&cus, hipDeviceAttributeMultiprocessorCount, dev) != hipSuccess) { grid = -1; return; }
        if (hipFuncSetAttribute((const void*)mk_fwd, hipFuncAttributeMaxDynamicSharedMemorySize, LDS_BYTES) != hipSuccess) { fprintf(stderr, "kernel_launch: hipFuncSetAttribute failed\n"); grid = -1; return; }
        if (hipOccupancyMaxActiveBlocksPerMultiprocessor(&per_cu, (const void*)mk_fwd, NTHR, LDS_BYTES) != hipSuccess || per_cu < 1) { fprintf(stderr, "kernel_launch: occupancy query says %d\n", per_cu); per_cu = 1; }
        (void)hipGetLastError();
        grid = cus;
        if (grid > 256) grid = 256;
        while (T % grid) --grid;
    }
    if (grid < 0) return;
    (void)hipMemsetAsync((char*)d_ws + WS_CTL, 0, CTL_ZERO_BYTES, stream);
    Args a{};
    for (int i = 0; i < 25; ++i) a.in[i] = (const float*)d_in[i];
    a.out = (float*)d_out; a.ws = (unsigned char*)d_ws;
#if MK_N_LAUNCHES == 1
    a.ph_lo = 0; a.ph_hi = N_PHASES;
    void* args[] = {&a};
    hipError_t e = hipLaunchCooperativeKernel((const void*)mk_fwd, dim3(grid), dim3(NTHR), args, LDS_BYTES, stream);
    if (e != hipSuccess) fprintf(stderr, "cooperative launch failed: %s (grid %d)\n", hipGetErrorString(e), grid);
#else
    for (int p = 0; p < N_PHASES; ++p) {
        a.ph_lo = p; a.ph_hi = p + 1;
        hipLaunchKernelGGL(mk_fwd, dim3(grid), dim3(NTHR), LDS_BYTES, stream, a);
    }
#endif
}
```

```cpp
#include <hip/hip_runtime.h>
#include <hip/hip_cooperative_groups.h>
#include <cstdio>
#include <cstdint>
namespace cg = cooperative_groups;

#ifndef MK_N_LAUNCHES
#define MK_N_LAUNCHES 1
#endif

#define LAS __attribute__((address_space(3)))
typedef unsigned short bf16_t;
typedef short bf16x8 __attribute__((ext_vector_type(8)));
typedef float f32x4 __attribute__((ext_vector_type(4)));
typedef float f32x2 __attribute__((ext_vector_type(2)));
typedef unsigned u32x4 __attribute__((ext_vector_type(4)));
typedef unsigned u32x2 __attribute__((ext_vector_type(2)));

constexpr int NB = 4, SEQ = 4096, D = 1024, T = NB * SEQ;
constexpr int INC = 5632;
constexpr int C_QDA = 0, C_KDA = 512, C_VDA = 1024, C_QHG = 1536, C_FHG = 2048, C_IHG = 2560, C_GHG = 3072, C_GDA = 3584, C_GHGATE = 4608;
constexpr int C_HGT = 1536;
constexpr int NEXP = 32, DEXP = 512;
constexpr int PMAX = 40960;
constexpr float EPS = 1e-6f;
constexpr int NWAVES = 8, NTHR = 512;

constexpr size_t MiB = 1u << 20;
constexpr size_t WS_CTL = 0, CTL_ZERO_BYTES = 64 * 1024;
constexpr size_t WS_MODP = 1 * MiB;
constexpr size_t WS_MOD = 5 * MiB / 2;
constexpr size_t WS_SMALL = 11 * MiB / 4;
constexpr size_t WS_TOKINFO = 3 * MiB;
constexpr size_t WS_TOKLIST = 4 * MiB;
constexpr size_t WS_DEC = 6 * MiB;
constexpr size_t WS_DS = 24 * MiB;
constexpr size_t WS_WIN = 8 * MiB;
constexpr size_t WS_WUPDA = 20 * MiB, WS_WUPHG = 21 * MiB, WS_WOUT = 22 * MiB;
constexpr size_t WS_ACT = 24 * MiB;
constexpr size_t WS_PROJ = 56 * MiB;
constexpr size_t WS_YDA = 232 * MiB, WS_YHG = 248 * MiB;
constexpr size_t WS_OA = 264 * MiB;
constexpr size_t WS_W13 = 56 * MiB;
constexpr size_t WS_W2 = 120 * MiB;
constexpr size_t WS_HS = 152 * MiB;
constexpr size_t WS_YS = 192 * MiB;
constexpr size_t WS_END = 296 * MiB;
constexpr int CW_COUNTS = 64;
constexpr int CW_BAR = 4096;
constexpr int CW_TILE = 8192;
constexpr int CW_TMO = 32;

constexpr int LDS_BYTES = 160 * 1024;

__device__ __forceinline__ float bf2f(unsigned v) { return __uint_as_float(v << 16); }
__device__ __forceinline__ unsigned f2bf(float f) { unsigned u = __float_as_uint(f); return (u + 0x7fffu + ((u >> 16) & 1u)) >> 16; }
__device__ __forceinline__ unsigned pk2(float lo, float hi) { return f2bf(lo) | (f2bf(hi) << 16); }
__device__ __forceinline__ float sigmoidf_(float x) { return 1.0f / (1.0f + __expf(-x)); }
__device__ __forceinline__ float siluf_(float x) { return x / (1.0f + __expf(-x)); }
__device__ __forceinline__ int lane_now() { int l; asm volatile("v_mbcnt_lo_u32_b32 %0, -1, 0\n\tv_mbcnt_hi_u32_b32 %0, -1, %0" : "=v"(l)); return l; }
__device__ __forceinline__ float wave_sum(float v) {
#pragma unroll
    for (int o = 1; o < 64; o <<= 1) v += __shfl_xor(v, o);
    return v;
}

namespace pg8 {
constexpr int BM = 256, BK = 64, HALF = 128, HTB = HALF * BK * 2, STAGE_BYTES = 8 * HTB;
__host__ __device__ __forceinline__ int lds_byte(int r, int c) { const int st = (r >> 4) * 2 + (c >> 5), rr = r & 15, cc = c & 31, ob = rr * 64 + cc * 2; return st * 1024 + (ob ^ (((ob >> 9) & 1) << 5)); }
__host__ __device__ __forceinline__ void stage_rc(int b, int& R, int& C) { const int st = b / 1024, sb = b % 1024, swz = sb ^ (((sb >> 9) & 1) << 5); R = (st >> 1) * 16 + swz / 64; C = (st & 1) * 32 + (swz % 64) / 2; }
__host__ __device__ __forceinline__ int perm32(int rho) { const int n = rho >> 4, i = rho & 15; return 8 * (i >> 2) + 4 * n + (i & 3); }

struct Unit { int pm, pn; const char* A; const char* B; int aux; };
__device__ __forceinline__ unsigned cvt_pk_bf16(float lo, float hi) { unsigned r; asm volatile("v_cvt_pk_bf16_f32 %0, %1, %2" : "=v"(r) : "v"(lo), "v"(hi)); return r; }

template <class Epi, class Sched>
__device__ __forceinline__ void gemm_phase(LAS unsigned char* lds, const int K, const Sched& S, const Epi& E) {
    const int tid = threadIdx.x, wid = __builtin_amdgcn_readfirstlane(tid >> 6), lane = tid & 63, wr = wid >> 2, wc = wid & 3, fr = lane & 15, fq = lane >> 4;
    const int nt = K / BK;
    unsigned voffB[2];
#define PG8_SETLANE() do { const int _l = lane_now(), _t = wid * 64 + _l; _Pragma("unroll") for (int _i = 0; _i < 2; ++_i) { int _R, _C; stage_rc(_t * 16 + _i * 8192, _R, _C); \
        const int _Rb = Epi::PERM ? ((_R & ~31) + perm32(_R & 31)) : _R; voffB[_i] = (unsigned)(_Rb * K + _C) * 2u; } \
        aoff = lds_byte(wr * 64 + (_l & 15), (_l >> 4) * 8); boff = lds_byte(wc * 32 + (_l & 15), (_l >> 4) * 8); } while (0)
    const size_t kstep = (size_t)(BK * 2);
    const size_t hstep = (size_t)HALF * K * 2;
    const unsigned ldsw = (unsigned)wid * 1024u;
    int aoff, boff; PG8_SETLANE();
#define PG8_SA(b, h) (((b) * 2 + (h)) * HTB)
#define PG8_SB(b, h) ((4 + (b) * 2 + (h)) * HTB)
#define PG8_STAGE(bufoff, gbase, voff) do { _Pragma("unroll") for (int _i = 0; _i < 2; ++_i) \
        __builtin_amdgcn_global_load_lds((const unsigned*)((const char*)(gbase) + (voff)[_i]), (LAS unsigned*)(lds + (bufoff) + ldsw + _i * 8192), 16, 0, 0); } while (0)
#define PG8_LDA(dst, b, h) do { _Pragma("unroll") for (int m = 0; m < 4; ++m) _Pragma("unroll") for (int k = 0; k < 2; ++k) dst[m][k] = *(const LAS bf16x8*)(lds + PG8_SA(b, h) + aoff + m * 2048 + k * 1024); } while (0)
#define PG8_LDB(dst, b, h) do { _Pragma("unroll") for (int n = 0; n < 2; ++n) _Pragma("unroll") for (int k = 0; k < 2; ++k) dst[n][k] = *(const LAS bf16x8*)(lds + PG8_SB(b, h) + boff + n * 2048 + k * 1024); } while (0)
#define PG8_MMA(ai, bj, At, Bt) do { __builtin_amdgcn_s_setprio(1); _Pragma("unroll") for (int m = 0; m < 4; ++m) _Pragma("unroll") for (int n = 0; n < 2; ++n) _Pragma("unroll") for (int k = 0; k < 2; ++k) \
        acc[ai][bj][m][n] = __builtin_amdgcn_mfma_f32_16x16x32_bf16(Bt[n][k], At[m][k], acc[ai][bj][m][n], 0, 0, 0); __builtin_amdgcn_s_setprio(0); } while (0)
#define PG8_WAIT_V(n) asm volatile("s_waitcnt vmcnt(" #n ")" ::: "memory")
#define PG8_WAIT_L(n) asm volatile("s_waitcnt lgkmcnt(" #n ")" ::: "memory")
#define PG8_BAR __builtin_amdgcn_s_barrier()
#define PG8_SCHED __builtin_amdgcn_sched_barrier(0)
#define PG8_SETA(vo, u) do { const int _t = wid * 64 + lane_now(); _Pragma("unroll") for (int _i = 0; _i < 2; ++_i) { int _R, _C; stage_rc(_t * 16 + _i * 8192, _R, _C); \
        _Pragma("unroll") for (int _h = 0; _h < 2; ++_h) vo[_h][_i] = (unsigned)((size_t)S.arow(u, _h * HALF + _R) * (size_t)K + _C) * 2u; } if (Sched::GATHER) PG8_WAIT_V(0); } while (0)
    Unit cur, nxt; int ui = 0;
    if (!S.next(0, cur)) return;
    f32x4 acc[2][2][4][2];
#pragma unroll
    for (int a = 0; a < 2; ++a)
#pragma unroll
        for (int b = 0; b < 2; ++b)
#pragma unroll
            for (int m = 0; m < 4; ++m)
#pragma unroll
                for (int n = 0; n < 2; ++n) acc[a][b][m][n] = (f32x4){0.f, 0.f, 0.f, 0.f};
    bf16x8 At[4][2], B0[2][2], B1[2][2];
    unsigned voC[2][2], voN[2][2];
    S.a_ready(cur);
    PG8_SETA(voC, cur);
    const char* cA = cur.A; const char* cB = cur.B;
    PG8_STAGE(PG8_SB(0, 0), cB, voffB); PG8_STAGE(PG8_SB(0, 1), cB + hstep, voffB); PG8_STAGE(PG8_SA(0, 0), cA, voC[0]); PG8_STAGE(PG8_SA(0, 1), cA, voC[1]);
    if (wr == 1) PG8_BAR;
    PG8_WAIT_V(2); PG8_BAR;
    PG8_STAGE(PG8_SB(1, 0), cB + kstep, voffB); PG8_STAGE(PG8_SA(1, 0), cA + kstep, voC[0]); PG8_STAGE(PG8_SB(1, 1), cB + hstep + kstep, voffB);
    PG8_WAIT_V(6); PG8_BAR;
    for (;;) {
        const bool has_next = S.next(ui + 1, nxt);
        if (has_next) { PG8_SETA(voN, nxt); }
        else {
#pragma unroll
            for (int h = 0; h < 2; ++h)
#pragma unroll
                for (int i = 0; i < 2; ++i) voN[h][i] = voC[h][i];
        }
        const char* nA = has_next ? nxt.A : cA; const char* nB = has_next ? nxt.B : cB;
        for (int t = 0; t < nt; t += 2) {
            const bool last = (t == nt - 2);
            if (last && has_next) S.a_ready(nxt);
            const char* a1 = cA + (size_t)(t + 1) * kstep;
            const char* a2 = last ? nA : cA + (size_t)(t + 2) * kstep; const char* b2 = last ? nB : cB + (size_t)(t + 2) * kstep;
            const char* a3 = a2 + kstep; const char* b3 = b2 + kstep;
            unsigned vo2[2][2];
#pragma unroll
            for (int h = 0; h < 2; ++h)
#pragma unroll
                for (int i = 0; i < 2; ++i) vo2[h][i] = last ? voN[h][i] : voC[h][i];
            PG8_LDB(B0, 0, 0); PG8_LDB(B1, 0, 1); PG8_SCHED; PG8_LDA(At, 0, 0); PG8_STAGE(PG8_SA(1, 1), a1, voC[1]);
            PG8_WAIT_V(8); PG8_WAIT_L(0); PG8_BAR; PG8_MMA(0, 0, At, B0); PG8_MMA(0, 1, At, B1); PG8_BAR; PG8_SCHED;
            PG8_LDA(At, 0, 1); PG8_STAGE(PG8_SB(0, 0), b2, voffB); PG8_STAGE(PG8_SB(0, 1), b2 + hstep, voffB); PG8_STAGE(PG8_SA(0, 0), a2, vo2[0]);
            PG8_WAIT_V(8); PG8_WAIT_L(0); PG8_BAR; PG8_MMA(1, 0, At, B0); PG8_MMA(1, 1, At, B1); PG8_BAR; PG8_SCHED;
            PG8_LDB(B0, 1, 0); PG8_LDB(B1, 1, 1); PG8_SCHED; PG8_LDA(At, 1, 0); PG8_STAGE(PG8_SA(0, 1), a2, vo2[1]);
            PG8_WAIT_V(8); PG8_WAIT_L(0); PG8_BAR; PG8_MMA(0, 0, At, B0); PG8_MMA(0, 1, At, B1); PG8_BAR; PG8_SCHED;
            PG8_LDA(At, 1, 1); PG8_STAGE(PG8_SB(1, 0), b3, voffB); PG8_STAGE(PG8_SB(1, 1), b3 + hstep, voffB); PG8_STAGE(PG8_SA(1, 0), a3, vo2[0]);
            PG8_WAIT_V(8); PG8_WAIT_L(0); PG8_BAR; PG8_MMA(1, 0, At, B0); PG8_MMA(1, 1, At, B1); PG8_BAR; PG8_SCHED;
        }
        if (wr == 0) PG8_BAR;
        const bool keep = E(acc, cur, wr, wc, fr, fq);
        if (!has_next) break;
        if (!keep) {
#pragma unroll
            for (int a = 0; a < 2; ++a)
#pragma unroll
                for (int b = 0; b < 2; ++b)
#pragma unroll
                    for (int m = 0; m < 4; ++m)
#pragma unroll
                        for (int n = 0; n < 2; ++n) acc[a][b][m][n] = (f32x4){0.f, 0.f, 0.f, 0.f};
        }
        cur = nxt; cA = nA; cB = nB; ++ui;
        if (Sched::GATHER) {
#pragma unroll
            for (int h = 0; h < 2; ++h)
#pragma unroll
                for (int i = 0; i < 2; ++i) voC[h][i] = voN[h][i];
        } else { PG8_SETA(voC, cur); }
        PG8_SETLANE();
        if (wr == 1) PG8_BAR;
    }
    PG8_WAIT_V(0);
    PG8_BAR;
#undef PG8_SA
#undef PG8_SB
#undef PG8_STAGE
#undef PG8_LDA
#undef PG8_LDB
#undef PG8_MMA
#undef PG8_WAIT_V
#undef PG8_WAIT_L
#undef PG8_BAR
#undef PG8_SCHED
#undef PG8_SETA
#undef PG8_SETLANE
}
}

struct Args { const float* in[25]; float* out; unsigned char* ws; int ph_lo, ph_hi; };
enum { I_X = 0, I_C, I_WADA, I_BADA, I_N1G, I_WIN, I_LQ1, I_LK1, I_LQ2, I_LK2, I_SUBG, I_LBL, I_HGNG, I_WUPDA, I_WUPHG, I_WOUT, I_N2G, I_WRG, I_BRG, I_WRE, I_BRE, I_W1, I_W3, I_W2, I_FG };

struct DenseOrder {
    static constexpr bool GATHER = false;
    const char* A; const char* Bt; int K, nM, nN, G, c;
    __device__ __forceinline__ bool next(int i, pg8::Unit& u) const {
        const int L = i * G + c, nwg = nM * nN; if (L >= nwg) return false;
        int wgid = L; { const int q = nwg / 8, r = nwg % 8, xcd = wgid % 8, off = wgid / 8; wgid = (xcd < r ? xcd * (q + 1) : r * (q + 1) + (xcd - r) * q) + off; }
        const int nig = 8 * nN, gid = wgid / nig, fm = gid * 8, gsz = (nM - fm) < 8 ? (nM - fm) : 8;
        u.pm = fm + ((wgid % nig) % gsz); u.pn = (wgid % nig) / gsz; u.A = A; u.B = Bt + (size_t)u.pn * 256 * K * 2; u.aux = 0; return true;
    }
    __device__ __forceinline__ void a_ready(const pg8::Unit&) const {}
    __device__ __forceinline__ unsigned arow(const pg8::Unit& u, int r) const { return (unsigned)(u.pm * 256 + r); }
};
struct UpOrder {
    static constexpr bool GATHER = false;
    const char* A0; const char* A1; const char* B0; const char* B1; int G, c;
    __device__ __forceinline__ bool next(int i, pg8::Unit& u) const {
        const int tile = (i >> 1) * G + c; if (tile >= 256) return false;
        u.pm = tile >> 2; u.pn = tile & 3; u.aux = i & 1;
        u.A = (i & 1) ? A1 : A0; u.B = ((i & 1) ? B1 : B0) + (size_t)u.pn * 256 * 512 * 2; return true;
    }
    __device__ __forceinline__ void a_ready(const pg8::Unit&) const {}
    __device__ __forceinline__ unsigned arow(const pg8::Unit& u, int r) const { return (unsigned)(u.pm * 256 + r); }
};
struct MoeTab { int nt; int pad[3]; int tile_e[176]; int tile_m[176]; int cnt[32]; int tbase[33]; };
struct Moe1Order {
    static constexpr bool GATHER = true;
    const LAS MoeTab* tab; const char* A; const char* W; const int* toklist; int G, c;
    __device__ __forceinline__ bool next(int i, pg8::Unit& u) const {
        const int L = i * G + c; if (L >= tab->nt * 4) return false;
        const int ti = L >> 2; u.pm = ti; u.pn = L & 3; u.aux = ti; u.A = A;
        u.B = W + ((size_t)tab->tile_e[ti] * 1024 + (size_t)u.pn * 256) * 1024 * 2; return true;
    }
    __device__ __forceinline__ void a_ready(const pg8::Unit&) const {}
    __device__ __forceinline__ unsigned arow(const pg8::Unit& u, int r) const {
        const int e = tab->tile_e[u.aux], rr = tab->tile_m[u.aux] * 256 + r;
        return rr < tab->cnt[e] ? (unsigned)toklist[e * T + rr] : 0u;
    }
};
struct Moe2Order {
    static constexpr bool GATHER = false;
    const LAS MoeTab* tab; const char* A; const char* W; unsigned* done; unsigned* tmo; int G, c;
    __device__ __forceinline__ bool next(int i, pg8::Unit& u) const {
        const int n1 = tab->nt * 4, r = n1 % G, nl = G - r; int j;
        if (r > 0 && c >= r) { if (i < 2) j = (c - r) + i * nl; else j = 2 * nl + (c - r) + (i - 2) * G; }
        else j = (r > 0 ? 2 * nl : 0) + ((c - r + G) % G) + i * G;
        if (j >= n1) return false;
        const int ti = j >> 2; u.pm = ti; u.pn = j & 3; u.aux = ti; u.A = A;
        u.B = W + ((size_t)tab->tile_e[ti] * 1024 + (size_t)u.pn * 256) * 512 * 2; return true;
    }
    __device__ __forceinline__ unsigned arow(const pg8::Unit& u, int r) const { return (unsigned)(u.pm * 256 + r); }
    __device__ __forceinline__ void a_ready(const pg8::Unit& u) const {
        if (threadIdx.x < 64) {
            unsigned polls = 0;
            while ((unsigned)__builtin_amdgcn_readfirstlane(__hip_atomic_load(done + 16 * u.pm, __ATOMIC_RELAXED, __HIP_MEMORY_SCOPE_AGENT)) < 32u) {
                if (++polls > (1u << 22)) { if (threadIdx.x == 0) __hip_atomic_store(tmo, 1u, __ATOMIC_RELAXED, __HIP_MEMORY_SCOPE_AGENT); break; }
                __builtin_amdgcn_s_sleep(2); }
            __builtin_amdgcn_fence(__ATOMIC_ACQUIRE, "agent");
            asm volatile("s_waitcnt vmcnt(0)" ::: "memory");
        }
        asm volatile("" ::: "memory"); __builtin_amdgcn_s_barrier(); asm volatile("" ::: "memory");
    }
};

using pg8::Unit; using pg8::cvt_pk_bf16;
struct EpiStoreBf16 {
    static constexpr bool PERM = true;
    bf16_t* O; int ldc; int nscale; float scale0;
    __device__ __forceinline__ bool operator()(f32x4 (&acc)[2][2][4][2], const Unit& u, int wr, int wc, int fr, int fq) const {
        const int row0 = u.pm * 256 + wr * 64 + fr, col0 = u.pn * 256 + wc * 32 + 8 * fq;
        const float sc = u.pn < nscale ? scale0 : 1.0f;
#pragma unroll
        for (int ai = 0; ai < 2; ++ai)
#pragma unroll
            for (int m = 0; m < 4; ++m) { bf16_t* rowp = O + (size_t)(row0 + ai * 128 + m * 16) * ldc + col0;
#pragma unroll
                for (int bj = 0; bj < 2; ++bj) { const f32x4 v0 = acc[ai][bj][m][0] * sc, v1 = acc[ai][bj][m][1] * sc;
                    u32x4 w; w.x = cvt_pk_bf16(v0[0], v0[1]); w.y = cvt_pk_bf16(v0[2], v0[3]); w.z = cvt_pk_bf16(v1[0], v1[1]); w.w = cvt_pk_bf16(v1[2], v1[3]);
                    *(u32x4*)(rowp + bj * 128) = w; } }
        return false;
    }
};
template <int N> __device__ __forceinline__ float dpp_shr(float x) { return __builtin_bit_cast(float, __builtin_amdgcn_update_dpp(0, __builtin_bit_cast(int, x), 0x110 + N, 0xf, 0xf, true)); }
__device__ __forceinline__ float scan16(float x) { x += dpp_shr<1>(x); x += dpp_shr<2>(x); x += dpp_shr<4>(x); x += dpp_shr<8>(x); return x; }
struct EpiInProj {
    static constexpr bool PERM = true;
    bf16_t* O; bf16_t* KE; float* DEC; const float* lbv; float scale0;
    __device__ __forceinline__ bool operator()(f32x4 (&acc)[2][2][4][2], const Unit& u, int wr, int wc, int fr, int fq) const {
        { const int l_ = lane_now(); fr = l_ & 15; fq = l_ >> 4; }
        const int row0 = u.pm * 256 + wr * 64 + fr, col0 = u.pn * 256 + wc * 32 + 8 * fq;
        if (u.pn >= 6 && u.pn < 10) {
            const int h = u.pn - 6, lane = 16 * fq + fr, kb = wc * 32 + 8 * fq, bsrc = (lane & 48) | 15;
            const int bb = (u.pm * 256) / SEQ, ch0 = ((u.pm * 256) % SEQ + wr * 64) >> 6;
#pragma unroll
            for (int ai = 0; ai < 2; ++ai) {
                unsigned kep[4][4];
#pragma unroll
                for (int n = 0; n < 2; ++n) {
#pragma unroll
                    for (int ep = 0; ep < 2; ++ep) {
                        float ke2[2][4];
#pragma unroll
                        for (int z = 0; z < 2; ++z) {
                            const int e = 2 * ep + z; const float lb = lbv[h * 128 + kb + 4 * n + e];
                            float f[4], c[4], tot[4];
#pragma unroll
                            for (int m = 0; m < 4; ++m) { const float fl = acc[ai][1][m][n][e]; f[m] = lb + (1.0f - lb) * __builtin_amdgcn_rcpf(1.0f + __builtin_amdgcn_exp2f(-1.4426950408889634f * fl)); c[m] = scan16(__logf(f[m])); }
#pragma unroll
                            for (int m = 0; m < 4; ++m) tot[m] = __shfl(c[m], bsrc);
                            const float alast = (tot[0] + tot[1]) + (tot[2] + tot[3]);
                            float pre = 0.f;
#pragma unroll
                            for (int m = 0; m < 4; ++m) { const float A = c[m] + pre; pre += tot[m]; const float q = acc[ai][0][m][n][e]; const float kk = 1.0f - f[m];
                                acc[ai][0][m][n][e] = q * __builtin_amdgcn_rcpf(1.0f + __builtin_amdgcn_exp2f(-1.4426950408889634f * q)) * __expf(A);
                                acc[ai][1][m][n][e] = kk * __expf(-A); ke2[z][m] = kk * __expf(alast - A); }
                            if (fr == 0) DEC[((size_t)(bb * 4 + h) * 64 + ch0 + 2 * ai) * 128 + kb + 4 * n + e] = __expf(alast);
                        }
#pragma unroll
                        for (int m = 0; m < 4; ++m) kep[m][2 * n + ep] = cvt_pk_bf16(ke2[0][m], ke2[1][m]);
                        __builtin_amdgcn_sched_barrier(0);
                    }
                }
#pragma unroll
                for (int m = 0; m < 4; ++m) *(u32x4*)(KE + (size_t)(row0 + ai * 128 + m * 16) * 512 + h * 128 + kb) = (u32x4){kep[m][0], kep[m][1], kep[m][2], kep[m][3]};
            }
        }
        const float sc = u.pn < 2 ? scale0 : 1.0f;
#pragma unroll
        for (int ai = 0; ai < 2; ++ai)
#pragma unroll
            for (int m = 0; m < 4; ++m) { bf16_t* rowp = O + (size_t)(row0 + ai * 128 + m * 16) * INC + col0;
#pragma unroll
                for (int bj = 0; bj < 2; ++bj) { const f32x4 v0 = acc[ai][bj][m][0] * sc, v1 = acc[ai][bj][m][1] * sc;
                    u32x4 w; w.x = cvt_pk_bf16(v0[0], v0[1]); w.y = cvt_pk_bf16(v0[2], v0[3]); w.z = cvt_pk_bf16(v1[0], v1[1]); w.w = cvt_pk_bf16(v1[2], v1[3]);
                    *(u32x4*)(rowp + bj * 128) = w; } }
        return false;
    }
};
struct EpiUp {
    static constexpr bool PERM = true;
    const bf16_t* proj; bf16_t* O;
    __device__ __forceinline__ bool operator()(f32x4 (&acc)[2][2][4][2], const Unit& u, int wr, int wc, int fr, int fq) const {
        const int row0 = u.pm * 256 + wr * 64 + fr, col0 = u.pn * 256 + wc * 32 + 8 * fq;
#pragma unroll
        for (int ai = 0; ai < 2; ++ai)
#pragma unroll
            for (int m = 0; m < 4; ++m) { const size_t row = (size_t)(row0 + ai * 128 + m * 16);
#pragma unroll
                for (int bj = 0; bj < 2; ++bj) {
                    const int col = col0 + bj * 128;
                    const u32x4 gh = *(const u32x4*)(proj + row * INC + C_GHGATE + col);
                    float sh[8];
#pragma unroll
                    for (int j = 0; j < 4; ++j) { sh[2 * j] = 1.0f + __builtin_amdgcn_exp2f(-1.4426950408889634f * bf2f(gh[j] & 0xffffu)); sh[2 * j + 1] = 1.0f + __builtin_amdgcn_exp2f(-1.4426950408889634f * bf2f(gh[j] >> 16)); }
                    if (u.aux == 0) {
                        const u32x4 gd = *(const u32x4*)(proj + row * INC + C_GDA + col);
#pragma unroll
                        for (int j = 0; j < 4; ++j) {
                            const float d0 = 1.0f + __builtin_amdgcn_exp2f(-1.4426950408889634f * bf2f(gd[j] & 0xffffu)), d1 = 1.0f + __builtin_amdgcn_exp2f(-1.4426950408889634f * bf2f(gd[j] >> 16));
                            const float r0 = sh[2 * j] * __builtin_amdgcn_rcpf(d0), r1 = sh[2 * j + 1] * __builtin_amdgcn_rcpf(d1);
                            if (j < 2) { acc[ai][bj][m][0][2 * j] *= r0; acc[ai][bj][m][0][2 * j + 1] *= r1; }
                            else { acc[ai][bj][m][1][2 * j - 4] *= r0; acc[ai][bj][m][1][2 * j - 3] *= r1; }
                        }
                    } else {
                        const f32x4 v0 = acc[ai][bj][m][0], v1 = acc[ai][bj][m][1];
#pragma unroll
                        for (int j = 0; j < 8; ++j) sh[j] = __builtin_amdgcn_rcpf(sh[j]);
                        u32x4 w; w.x = cvt_pk_bf16(v0[0] * sh[0], v0[1] * sh[1]); w.y = cvt_pk_bf16(v0[2] * sh[2], v0[3] * sh[3]);
                        w.z = cvt_pk_bf16(v1[0] * sh[4], v1[1] * sh[5]); w.w = cvt_pk_bf16(v1[2] * sh[6], v1[3] * sh[7]);
                        *(u32x4*)(O + row * D + col) = w;
                    }
                } }
        return u.aux == 0;
    }
};
struct EpiOut {
    static constexpr bool PERM = false;
    const float* x; const float* mod; float* O;
    __device__ __forceinline__ bool operator()(f32x4 (&acc)[2][2][4][2], const Unit& u, int wr, int wc, int fr, int fq) const {
        const int row0 = u.pm * 256 + wr * 64 + fr, col0 = u.pn * 256 + wc * 32 + 4 * fq;
        const int b = (u.pm * 256) / SEQ;
        f32x4 gt[2][2];
#pragma unroll
        for (int bj = 0; bj < 2; ++bj)
#pragma unroll
            for (int n = 0; n < 2; ++n) gt[bj][n] = *(const f32x4*)(mod + b * 6144 + 2048 + col0 + bj * 128 + n * 16);
#pragma unroll
        for (int ai = 0; ai < 2; ++ai)
#pragma unroll
            for (int m = 0; m < 4; ++m) { const size_t off = (size_t)(row0 + ai * 128 + m * 16) * D + col0;
#pragma unroll
                for (int bj = 0; bj < 2; ++bj)
#pragma unroll
                    for (int n = 0; n < 2; ++n) { const f32x4 xv = *(const f32x4*)(x + off + bj * 128 + n * 16);
                        *(f32x4*)(O + off + bj * 128 + n * 16) = xv + gt[bj][n] * acc[ai][bj][m][n]; } }
        return false;
    }
};
struct EpiMoe1 {
    static constexpr bool PERM = true;
    bf16_t* O; unsigned* done;
    __device__ __forceinline__ bool operator()(f32x4 (&acc)[2][2][4][2], const Unit& u, int wr, int wc, int fr, int fq) const {
        const int row0 = u.pm * 256 + wr * 64 + fr, col0 = u.pn * 128 + wc * 32 + 8 * fq;
#pragma unroll
        for (int ai = 0; ai < 2; ++ai)
#pragma unroll
            for (int m = 0; m < 4; ++m) { bf16_t* rowp = O + (size_t)(row0 + ai * 128 + m * 16) * DEXP + col0;
                float h[8];
#pragma unroll
                for (int n = 0; n < 2; ++n)
#pragma unroll
                    for (int e = 0; e < 4; ++e) { const float x_ = acc[ai][0][m][n][e]; h[n * 4 + e] = x_ * __builtin_amdgcn_rcpf(1.0f + __builtin_amdgcn_exp2f(-1.4426950408889634f * x_)) * acc[ai][1][m][n][e]; }
                u32x4 w; w.x = cvt_pk_bf16(h[0], h[1]); w.y = cvt_pk_bf16(h[2], h[3]); w.z = cvt_pk_bf16(h[4], h[5]); w.w = cvt_pk_bf16(h[6], h[7]);
                asm volatile("global_store_dwordx4 %0, %1, off sc1\n\ts_nop 1" :: "v"(rowp), "v"(w) : "memory"); }
        asm volatile("s_waitcnt vmcnt(0)" ::: "memory");
        if ((threadIdx.x & 63) == 0) __hip_atomic_fetch_add(done + 16 * u.pm, 1u, __ATOMIC_RELAXED, __HIP_MEMORY_SCOPE_AGENT);
        return false;
    }
};

struct Frame { LAS unsigned char* lds; int tid, lane, wave, G, bid; };

__device__ __forceinline__ void transpose_item(const float* Wsrc, int ldw, bf16_t* dst, int ldd, LAS float* scr, int lane) {
#pragma unroll 8
    for (int i = 0; i < 32; ++i) { const int kk = 2 * i + (lane >> 5); scr[kk * 33 + (lane & 31)] = Wsrc[(size_t)kk * ldw + (lane & 31)]; }
    asm volatile("s_waitcnt lgkmcnt(0)" ::: "memory");
    const int c = lane & 7;
#pragma unroll
    for (int j = 0; j < 4; ++j) { const int n = (lane >> 3) + 8 * j; const LAS float* s = scr + (8 * c) * 33 + n;
        u32x4 o; o.x = pk2(s[0 * 33], s[1 * 33]); o.y = pk2(s[2 * 33], s[3 * 33]); o.z = pk2(s[4 * 33], s[5 * 33]); o.w = pk2(s[6 * 33], s[7 * 33]);
        *(u32x4*)(dst + (size_t)n * ldd + 8 * c) = o; }
    asm volatile("s_waitcnt lgkmcnt(0)" ::: "memory");
}
__device__ __forceinline__ void transpose_matrix(const Frame& F, const float* W, int K, int N, bf16_t* WT) {
    LAS float* scr = (LAS float*)(F.lds + F.wave * 8448);
    const int gw = F.bid * NWAVES + F.wave, NGW = F.G * NWAVES, nblk = N / 32, items = (K / 64) * nblk;
    for (int it = gw; it < items; it += NGW) { const int kb = it / nblk, nb = it % nblk;
        transpose_item(W + (size_t)(64 * kb) * N + 32 * nb, N, WT + (size_t)(32 * nb) * K + 64 * kb, K, scr, F.lane); }
}

__device__ __forceinline__ void phase0(const Frame& F, const Args& a) {
    unsigned char* ws = a.ws;
    {
        float* modp = (float*)(ws + WS_MODP);
        const float* c = a.in[I_C]; const float* wada = a.in[I_WADA];
        LAS float* cs = (LAS float*)(F.lds + 72 * 1024);
        for (int i = F.tid; i < 4 * D; i += NTHR) cs[i] = siluf_(c[i]);
        __syncthreads();
        for (int wt = F.bid + 256 * F.wave; wt < 384; wt += 256 * NWAVES) {
            if (F.G != 256) break;
            const int ks = wt / 24, jw = wt % 24, j = jw * 256 + F.lane * 4;
            f32x4 s[4] = {{0, 0, 0, 0}, {0, 0, 0, 0}, {0, 0, 0, 0}, {0, 0, 0, 0}};
#pragma unroll 8
            for (int k = ks * 64; k < ks * 64 + 64; ++k) {
                const f32x4 w = *(const f32x4*)(wada + (size_t)k * 6144 + j);
#pragma unroll
                for (int b = 0; b < 4; ++b) s[b] += w * cs[b * D + k];
            }
#pragma unroll
            for (int b = 0; b < 4; ++b) *(f32x4*)(modp + ((size_t)ks * 4 + b) * 6144 + j) = s[b];
        }
        if (F.G != 256) {
            const int gw = F.bid * NWAVES + F.wave, NGW = F.G * NWAVES;
            for (int wt = gw; wt < 384; wt += NGW) {
                const int ks = wt / 24, jw = wt % 24, j = jw * 256 + F.lane * 4;
                f32x4 s[4] = {{0, 0, 0, 0}, {0, 0, 0, 0}, {0, 0, 0, 0}, {0, 0, 0, 0}};
                for (int k = ks * 64; k < ks * 64 + 64; ++k) {
                    const f32x4 w = *(const f32x4*)(wada + (size_t)k * 6144 + j);
#pragma unroll
                    for (int b = 0; b < 4; ++b) { const float cv = siluf_(c[b * D + k]); s[b] += w * cv; }
                }
#pragma unroll
                for (int b = 0; b < 4; ++b) *(f32x4*)(modp + ((size_t)ks * 4 + b) * 6144 + j) = s[b];
            }
        }
    }
    {
        LAS float* scr = (LAS float*)(F.lds + F.wave * 8448);
        const int gw = F.bid * NWAVES + F.wave, NGW = F.G * NWAVES, nblk = INC / 32, items = (D / 64) * nblk;
        bf16_t* WT = (bf16_t*)(ws + WS_WIN);
        for (int it = gw; it < items; it += NGW) { const int kb = it / nblk, n0 = 32 * (it % nblk); int dr = n0;
            if (n0 >= C_QHG && n0 < C_FHG) dr = C_HGT + 256 * ((n0 - C_QHG) >> 7) + ((n0 - C_QHG) & 127);
            else if (n0 >= C_FHG && n0 < C_IHG) dr = C_HGT + 256 * ((n0 - C_FHG) >> 7) + 128 + ((n0 - C_FHG) & 127);
            transpose_item(a.in[I_WIN] + (size_t)(64 * kb) * INC + n0, INC, WT + (size_t)dr * D + 64 * kb, D, scr, F.lane); }
    }
    transpose_matrix(F, a.in[I_WUPDA], 512, D, (bf16_t*)(ws + WS_WUPDA));
    transpose_matrix(F, a.in[I_WUPHG], 512, D, (bf16_t*)(ws + WS_WUPHG));
    transpose_matrix(F, a.in[I_WOUT], D, D, (bf16_t*)(ws + WS_WOUT));
    if (F.bid == 0) {
        float* sm = (float*)(ws + WS_SMALL);
        if (F.tid == 0) {
            float s1 = 0.f, s2 = 0.f;
            for (int i = 0; i < 64; ++i) { s1 += a.in[I_LQ1][i] * a.in[I_LK1][i]; s2 += a.in[I_LQ2][i] * a.in[I_LK2][i]; }
            sm[0] = expf(s1) - expf(s2) + 0.2f;
        }
        { const float l0 = a.in[I_LBL][F.tid], l1 = a.in[I_LBL][512 + F.tid]; const float mx = fmaxf(l0, l1);
          const float e0 = expf(l0 - mx), e1 = expf(l1 - mx); sm[16 + F.tid] = e0 / (e0 + e1); }
    }
}
__device__ __forceinline__ void moe_weight_convert(const Frame& F, const Args& a) {
    LAS float* scr = (LAS float*)(F.lds + F.wave * 8448);
    const int gw = F.bid * NWAVES + F.wave, NGW = F.G * NWAVES;
    bf16_t* w13 = (bf16_t*)(a.ws + WS_W13); bf16_t* w2t = (bf16_t*)(a.ws + WS_W2);
    for (int it = gw; it < 2 * NEXP * 256; it += NGW) {
        const int which = it / (NEXP * 256), r = it % (NEXP * 256), e = r >> 8, kb = (r >> 4) & 15, nb = r & 15, n0 = 32 * nb;
        const float* W = a.in[which ? I_W3 : I_W1] + (size_t)e * 1024 * 512;
        const int drow = 256 * (n0 >> 7) + (which ? 128 : 0) + (n0 & 127);
        transpose_item(W + (size_t)(64 * kb) * 512 + n0, 512, w13 + ((size_t)e * 1024 + drow) * 1024 + 64 * kb, 1024, scr, F.lane);
    }
    for (int it = gw; it < NEXP * 256; it += NGW) {
        const int e = it >> 8, kb = (it >> 5) & 7, nb = it & 31;
        const float* W = a.in[I_W2] + (size_t)e * 512 * 1024;
        transpose_item(W + (size_t)(64 * kb) * 1024 + 32 * nb, 1024, w2t + ((size_t)e * 1024 + 32 * nb) * 512 + 64 * kb, 512, scr, F.lane);
    }
}

__device__ __forceinline__ void phase1(const Frame& F, const Args& a) {
    const float* modp = (const float*)(a.ws + WS_MODP); float* mod = (float*)(a.ws + WS_MOD);
    for (int i = F.bid * NTHR + F.tid; i < 4 * 6144; i += F.G * NTHR) {
        float s = a.in[I_BADA][i % 6144];
        for (int ks = 0; ks < 16; ++ks) s += modp[(size_t)ks * 4 * 6144 + i];
        mod[i] = s;
    }
    LAS float* Gs = (LAS float*)F.lds;
    LAS float* Ss = Gs + 1024;
    bf16_t* H = (bf16_t*)(a.ws + WS_ACT);
    const int rows_per_blk = T / F.G;
    const int r0 = F.bid * rows_per_blk, b = r0 / SEQ;
    for (int k = F.tid; k < 1024; k += NTHR) {
        float sh = a.in[I_BADA][k], sc = a.in[I_BADA][1024 + k];
        for (int ks = 0; ks < 16; ++ks) { sh += modp[((size_t)ks * 4 + b) * 6144 + k]; sc += modp[((size_t)ks * 4 + b) * 6144 + 1024 + k]; }
        Gs[k] = a.in[I_N1G][k] * (1.0f + sc); Ss[k] = sh;
    }
    __syncthreads();
    for (int r = r0 + F.wave; r < r0 + rows_per_blk; r += NWAVES) {
        const f32x4* xr = (const f32x4*)(a.in[I_X] + (size_t)r * D) + F.lane;
        f32x4 v[4]; float s = 0.f;
#pragma unroll
        for (int j = 0; j < 4; ++j) { v[j] = xr[64 * j]; s += (v[j].x * v[j].x + v[j].y * v[j].y) + (v[j].z * v[j].z + v[j].w * v[j].w); }
        const float rs = rsqrtf(wave_sum(s) * (1.0f / D) + EPS);
        unsigned long long* o8 = (unsigned long long*)(H + (size_t)r * D) + F.lane;
#pragma unroll
        for (int j = 0; j < 4; ++j) { const f32x4 g = *(const LAS f32x4*)(Gs + 256 * j + 4 * F.lane), sh = *(const LAS f32x4*)(Ss + 256 * j + 4 * F.lane);
            const f32x4 h = v[j] * rs * g + sh;
            o8[64 * j] = (unsigned long long)pk2(h.x, h.y) | ((unsigned long long)pk2(h.z, h.w) << 32); }
    }
}

namespace attn_body {
using s16x4=__attribute__((ext_vector_type(4)))short;
using f32x16=__attribute__((ext_vector_type(16)))float;
constexpr int NW=8,QBLK=32,QB=QBLK*NW,KVBLK=64,NQB=SEQ/QB;
constexpr int PIN=INC, POUT=1024;
__device__ __forceinline__ int crow(int r,int hi){return (r&3)+8*(r>>2)+4*hi;}
#define SBAR() __builtin_amdgcn_sched_barrier(0)
__device__ __forceinline__ void bmask(f32x16&p0,f32x16&p1,int jb,int wch,int il,int hi,float s2x2){
  if(jb>wch){
    #pragma unroll
    for(int r=0;r<16;++r){p0[r]=-INFINITY;p1[r]=-INFINITY;}
  } else if(jb==wch){
    float fb=(float)(4*hi-il); asm volatile("":"+v"(fb));
    #pragma unroll
    for(int r=0;r<16;++r){const float c=(float)((r&3)+8*(r>>2)); p0[r]-=s2x2*__builtin_fmaxf(fb+c,0.f); p1[r]-=s2x2*__builtin_fmaxf(fb+(c+32.f),0.f);}
  }
}
constexpr int NSLOT=3, SLOTB=8192;
constexpr int LDS_K=0, LDS_V=NSLOT*SLOTB, LDS_WS=2*NSLOT*SLOTB, LDS_OST=LDS_WS+NW*64*4, ATT_LDS_BYTES=LDS_OST+NW*4096;
constexpr float C2=0.125f*1.4426950408889634f;
__device__ __forceinline__ void glds16(const void*gsrc,unsigned lds_dst){unsigned keep;
  asm volatile("s_mov_b32 %0, m0\n\ts_mov_b32 m0, %2\n\ts_nop 0\n\tglobal_load_lds_dwordx4 %1, off\n\ts_mov_b32 m0, %0":"=&s"(keep):"v"(gsrc),"s"(lds_dst):"memory");}
__device__ __forceinline__ float max3f(float a,float b,float c){float r;asm("v_max3_f32 %0, %1, %2, %3":"=v"(r):"v"(a),"v"(b),"v"(c));return r;}
__device__ __forceinline__ float max2f(float a,float b){float r;asm("v_max_f32_e32 %0, %1, %2":"=v"(r):"v"(a),"v"(b));return r;}
__device__ __forceinline__ float fadd_s(float a,float b){float r;asm("v_add_f32_e32 %0, %1, %2":"=v"(r):"v"(a),"v"(b));return r;}
__device__ __forceinline__ float fsub_s(float a,float b){float r;asm("v_sub_f32_e32 %0, %1, %2":"=v"(r):"v"(a),"v"(b));return r;}
typedef float f32x2_t __attribute__((ext_vector_type(2))); typedef __bf16 bf16x2_t __attribute__((ext_vector_type(2)));
__device__ __forceinline__ unsigned cvtpk_s(float lo,float hi){f32x2_t v={lo,hi};bf16x2_t b=__builtin_convertvector(v,bf16x2_t);return __builtin_bit_cast(unsigned,b);}
#define WAIT_BAR(N) asm volatile("s_waitcnt vmcnt(" #N ") lgkmcnt(0)\n\ts_barrier":::"memory")

__device__ __forceinline__ void qkt(f32x16&p0,f32x16&p1,const char*Kslot,const bf16x8*qr,const f32x16&c0,const f32x16&c1,int r32,int hi){
  const char*kb=Kslot+hi*1024+r32*16;
  #pragma unroll
  for(int d0=0;d0<4;++d0){
    const bf16x8 b0=*reinterpret_cast<const bf16x8*>(kb+d0*2048);
    const bf16x8 b1=*reinterpret_cast<const bf16x8*>(kb+d0*2048+512);
    if(d0==0){p0=__builtin_amdgcn_mfma_f32_32x32x16_bf16(b0,qr[0],c0,0,0,0);p1=__builtin_amdgcn_mfma_f32_32x32x16_bf16(b1,qr[0],c1,0,0,0);}
    else{p0=__builtin_amdgcn_mfma_f32_32x32x16_bf16(b0,qr[d0],p0,0,0,0);p1=__builtin_amdgcn_mfma_f32_32x32x16_bf16(b1,qr[d0],p1,0,0,0);}}
}
typedef __attribute__((address_space(3))) const char* lds_cptr;
typedef short v4i16_t __attribute__((ext_vector_type(4)));
__device__ __forceinline__ void kload8(bf16x8*kf,lds_cptr kp){
  kf[0]=*(const __attribute__((address_space(3))) bf16x8*)(kp);      kf[1]=*(const __attribute__((address_space(3))) bf16x8*)(kp+512);
  kf[2]=*(const __attribute__((address_space(3))) bf16x8*)(kp+2048); kf[3]=*(const __attribute__((address_space(3))) bf16x8*)(kp+2560);
  kf[4]=*(const __attribute__((address_space(3))) bf16x8*)(kp+4096); kf[5]=*(const __attribute__((address_space(3))) bf16x8*)(kp+4608);
  kf[6]=*(const __attribute__((address_space(3))) bf16x8*)(kp+6144); kf[7]=*(const __attribute__((address_space(3))) bf16x8*)(kp+6656);
}
__device__ __forceinline__ void kload2(bf16x8*kf,lds_cptr kp,int j){ kf[2*j]=*(const __attribute__((address_space(3))) bf16x8*)(kp+j*2048); kf[2*j+1]=*(const __attribute__((address_space(3))) bf16x8*)(kp+j*2048+512); }
__device__ __forceinline__ s16x4 vtr(lds_cptr p){ return __builtin_bit_cast(s16x4,__builtin_amdgcn_ds_read_tr16_b64_v4i16((__attribute__((address_space(3))) v4i16_t*)p)); }
__device__ __forceinline__ float rowmax(const f32x16&p0,const f32x16&p1){
  float a=max3f(p0[0],p0[1],p1[0]),b=max3f(p0[2],p0[3],p1[1]);a=max3f(a,p1[2],p1[3]);
  #pragma unroll
  for(int r=4;r<16;r+=4){a=max3f(a,p0[r],p0[r+1]);b=max3f(b,p0[r+2],p0[r+3]);a=max3f(a,p1[r],p1[r+1]);b=max3f(b,p1[r+2],p1[r+3]);}
  const float m=max2f(a,b);
  auto rr=__builtin_amdgcn_permlane32_swap(__float_as_uint(m),__float_as_uint(m),false,false);
  return max2f(__uint_as_float(rr[0]),__uint_as_float(rr[1]));
}
__device__ __forceinline__ void pv(f32x16*o,int vb,bf16x8 pa0,bf16x8 pa1,bf16x8 pa2,bf16x8 pa3){
  #pragma unroll
  for(int d0=0;d0<2;++d0){s16x4 lo[4],hi[4];
    #pragma unroll
    for(int ks=0;ks<4;++ks){
      asm volatile("ds_read_b64_tr_b16 %0,%1 offset:%c2":"=&v"(lo[ks]):"v"(vb),"i"(d0*4096+ks*1024):"memory");
      asm volatile("ds_read_b64_tr_b16 %0,%1 offset:%c2":"=&v"(hi[ks]):"v"(vb),"i"(d0*4096+ks*1024+512):"memory");}
    asm volatile("s_waitcnt lgkmcnt(0)":::"memory");SBAR();
    #define PK(k) (bf16x8){lo[k][0],lo[k][1],lo[k][2],lo[k][3],hi[k][0],hi[k][1],hi[k][2],hi[k][3]}
    o[d0]=__builtin_amdgcn_mfma_f32_32x32x16_bf16(pa0,PK(0),o[d0],0,0,0);
    o[d0]=__builtin_amdgcn_mfma_f32_32x32x16_bf16(pa1,PK(1),o[d0],0,0,0);
    o[d0]=__builtin_amdgcn_mfma_f32_32x32x16_bf16(pa2,PK(2),o[d0],0,0,0);
    o[d0]=__builtin_amdgcn_mfma_f32_32x32x16_bf16(pa3,PK(3),o[d0],0,0,0);
    #undef PK
  }
}
#define ATTN_STORE16(p,v) (*(u32x4*)(p)=(v))
template<int THRL> __device__ __forceinline__ void attn_unit(int qb,const bf16_t*Qb,const bf16_t*__restrict__ Kh,const bf16_t*__restrict__ Vh,bf16_t*Ob,float slope2,char*shm){
  const int tid=threadIdx.x,lane=tid&63,r32=lane&31,hi=lane>>5; const int wid=__builtin_amdgcn_readfirstlane(tid>>6);
  const int q0=qb*QB;
  const bf16_t*Qw=Qb+(long)(q0+wid*QBLK)*PIN;
  const unsigned lds0=(unsigned)(uintptr_t)shm;
  float*wsf=(float*)(shm+LDS_WS)+wid*64;
  const bf16_t*ksrc=Kh+(long)lane*PIN+wid*8;
  const bf16_t*vsrc=Vh+(long)(16*(wid&3)+(lane>>2))*PIN+(wid>>2)*32+(lane&3)*8;
  const unsigned kdst=lds0+LDS_K+wid*1024, vdst=lds0+LDS_V+wid*1024;
  #define DMA_K(t,slot) glds16(ksrc+(long)(t)*KVBLK*PIN,(unsigned)__builtin_amdgcn_readfirstlane(kdst+(slot)))
  #define DMA_V(t,slot) glds16(vsrc+(long)(t)*KVBLK*PIN,(unsigned)__builtin_amdgcn_readfirstlane(vdst+(slot)))
  const int vb0=(int)(lds0+LDS_V)+((lane>>4)&1)*32+(lane&3)*8+(4*hi+((lane&15)>>2))*64;
  const char*Kbase=shm+LDS_K; bf16x8 kf[8];
  const lds_cptr shm3=(lds_cptr)shm; const lds_cptr kp0=shm3+LDS_K+hi*1024+r32*16; const lds_cptr vp0=shm3+LDS_V+((lane>>4)&1)*32+(lane&3)*8+(4*hi+((lane&15)>>2))*64;
  const int NT=(q0+QB)/KVBLK;
  DMA_K(0,0);DMA_V(0,0);DMA_K(1,SLOTB);
  bf16x8 qr[4];
  #pragma unroll
  for(int d0=0;d0<4;++d0)qr[d0]=*reinterpret_cast<const bf16x8*>(&Qw[(long)r32*PIN+d0*16+hi*8]);
  float mhat=0.f,l_reg=0.f;f32x16 o[2];o[0]=f32x16{};o[1]=f32x16{};
  const float s64=slope2*64.f, s32=slope2*32.f, s2x2=2.f*slope2, s4hi=slope2*4.f*(float)hi;
  const int wch=wid>>1, il=32*(wid&1)+r32;
  #define CMASK(P0,P1,t) do{int jb_=(t)-(NT-4); if(jb_>=0)bmask(P0,P1,jb_,wch,il,hi,s2x2);}while(0)
  #define CINIT0(C0,t) do{ const float bt_=s64*(float)((t)-NT)-mhat+s4hi; _Pragma("unroll") for(int r=0;r<16;++r){C0[r]=__builtin_fmaf(slope2,(float)((r&3)+8*(r>>2)),bt_);} }while(0)
  #define CINIT1(C1,t) do{ const float bu_=s64*(float)((t)-NT)-mhat+s4hi+s32; _Pragma("unroll") for(int r=0;r<16;++r){C1[r]=__builtin_fmaf(slope2,(float)((r&3)+8*(r>>2)),bu_);} }while(0)
  bool resc=false;
  #define START(P0,P1) do{ const float rm=rowmax(P0,P1); resc=false; \
    { const float dl=rm; mhat=fadd_s(mhat,dl); \
      _Pragma("unroll") for(int r=0;r<16;++r){P0[r]=fsub_s(P0[r],dl);P1[r]=fsub_s(P1[r],dl);} } \
    _Pragma("unroll") for(int r=0;r<16;++r)P0[r]=__builtin_amdgcn_exp2f(P0[r]); }while(0)
  #define RESC() do{ if(resc){ asm volatile("s_waitcnt lgkmcnt(0)":::"memory"); \
      _Pragma("unroll") for(int d_=0;d_<2;++d_) _Pragma("unroll") for(int r=0;r<16;++r)o[d_][r]*=wsf[crow(r,hi)]; } }while(0)
  f32x16 pA0,pA1,pB0,pB1;
  int sl_prev=0,sl_cur=0,sl_next=SLOTB;
  #define ROT() do{sl_prev=sl_cur;sl_cur=sl_next;sl_next=(sl_next==(NSLOT-1)*SLOTB)?0:sl_next+SLOTB;}while(0)
  DMA_K(2,2*SLOTB);
  WAIT_BAR(3);
  { f32x16 c0,c1; CINIT0(c0,0); CINIT1(c1,0); qkt(pA0,pA1,Kbase,qr,c0,c1,r32,hi); }
  asm volatile("s_nop 15\n\ts_nop 7":"+v"(pA0),"+v"(pA1));CMASK(pA0,pA1,0);
  START(pA0,pA1);
  _Pragma("unroll") for(int r=0;r<16;++r)pA1[r]=__builtin_amdgcn_exp2f(pA1[r]);
  WAIT_BAR(0);
  DMA_K(3,0);DMA_V(1,SLOTB);
  ROT();
  kload8(kf,kp0+sl_cur);
  WAIT_BAR(2);
  s16x4 vlo[8],vhi[8]; u32x4 pw0,pw1,pw2,pw3;
  #define PKW(P,B) cvtpk_s(P[B],P[B+1])
  #define PAF(k) __builtin_bit_cast(bf16x8,pw##k)
  #define VFR(i) (bf16x8){vlo[i][0],vlo[i][1],vlo[i][2],vlo[i][3],vhi[i][0],vhi[i][1],vhi[i][2],vhi[i][3]}
  #define PIN_(x) asm volatile("":"+v"(x))
  #define MX3(a,b,c) __builtin_fmaxf(__builtin_fmaxf((a),(b)),(c))
  #define GAPA(MF,A0,A1,A2,A3,W0,W1,PW) do{ MF; sacc+=A0; sacc+=A1; sacc+=A2; sacc+=A3; PIN_(sacc); W0; W1; PIN_(PW); SBAR(); }while(0)
  #define EX(v) __builtin_amdgcn_exp2f(v)
  #define GAPB(MF,X,B) do{ MF; X[B]=EX(X[B]); X[B+1]=EX(X[B+1]); X[B+2]=EX(X[B+2]); X[B+3]=EX(X[B+3]); PIN_(X); SBAR(); }while(0)
  #define VRD(i) do{ vlo[i]=vtr(vp_+(((i)>>2)*4096+((i)&3)*1024)); vhi[i]=vtr(vp_+(((i)>>2)*4096+((i)&3)*1024+512)); }while(0)
  #define KRD(G,j) do{ if(G){ kload2(kf,kp0+sl_next,j); SBAR(); } }while(0)
  #define STEP(C0,C1,P0,P1,t,GK,GV,GL) do{ SBAR(); \
    CINIT0(C0,t); SBAR(); \
    const lds_cptr vp_=vp0+sl_prev; \
    VRD(0); SBAR(); float sacc=(P0[0]+P0[1]); \
    GAPA(C0=__builtin_amdgcn_mfma_f32_32x32x16_bf16(kf[0],qr[0],C0,0,0,0), P0[2],P0[3],P0[4],P0[5],     pw0[0]=PKW(P0,0), pw0[1]=PKW(P0,2), pw0); \
    CINIT1(C1,t); VRD(4); SBAR(); GAPA(C1=__builtin_amdgcn_mfma_f32_32x32x16_bf16(kf[1],qr[0],C1,0,0,0), P0[6],P0[7],P0[8],P0[9],     pw0[2]=PKW(P0,4), pw0[3]=PKW(P0,6), pw0); \
    VRD(1); SBAR(); GAPA(C0=__builtin_amdgcn_mfma_f32_32x32x16_bf16(kf[2],qr[1],C0,0,0,0),   P0[10],P0[11],P0[12],P0[13], pw1[0]=PKW(P0,8), pw1[1]=PKW(P0,10), pw1); \
    VRD(5); SBAR(); GAPA(C1=__builtin_amdgcn_mfma_f32_32x32x16_bf16(kf[3],qr[1],C1,0,0,0),   P0[14],P0[15],P1[0],P1[1],   pw1[2]=PKW(P0,12),pw1[3]=PKW(P0,14), pw1); \
    VRD(2); SBAR(); GAPA(C0=__builtin_amdgcn_mfma_f32_32x32x16_bf16(kf[4],qr[2],C0,0,0,0),   P1[2],P1[3],P1[4],P1[5],     pw2[0]=PKW(P1,0), pw2[1]=PKW(P1,2), pw2); \
    VRD(6); SBAR(); GAPA(C1=__builtin_amdgcn_mfma_f32_32x32x16_bf16(kf[5],qr[2],C1,0,0,0),   P1[6],P1[7],P1[8],P1[9],     pw2[2]=PKW(P1,4), pw2[3]=PKW(P1,6), pw2); \
    VRD(3); SBAR(); GAPA(C0=__builtin_amdgcn_mfma_f32_32x32x16_bf16(kf[6],qr[3],C0,0,0,0),   P1[10],P1[11],P1[12],P1[13], pw3[0]=PKW(P1,8), pw3[1]=PKW(P1,10), pw3); \
    VRD(7); SBAR(); GAPA(C1=__builtin_amdgcn_mfma_f32_32x32x16_bf16(kf[7],qr[3],C1,0,0,0),   P1[14],P1[15],0.f,0.f,       pw3[2]=PKW(P1,12),pw3[3]=PKW(P1,14), pw3); \
    l_reg+=sacc; \
    if(GK){DMA_K((t)+3,sl_cur);} if(GV){DMA_V((t)+1,sl_next);} \
    CMASK(C0,C1,t); \
    { float a=MX3(C0[0],C0[1],C1[0]),b=MX3(C0[2],C0[3],C1[1]); a=MX3(a,C1[2],C1[3]); \
      _Pragma("unroll") for(int r=4;r<16;r+=4){a=MX3(a,C0[r],C0[r+1]);b=MX3(b,C0[r+2],C0[r+3]);a=MX3(a,C1[r],C1[r+1]);b=MX3(b,C1[r+2],C1[r+3]);} \
      float rm=__builtin_fmaxf(a,b); { auto rr=__builtin_amdgcn_permlane32_swap(__float_as_uint(rm),__float_as_uint(rm),false,false); rm=__builtin_fmaxf(__uint_as_float(rr[0]),__uint_as_float(rr[1])); } \
      resc=false; \
      if(__builtin_expect(__any(rm>(float)THRL),0)){ const float dl=__builtin_fmaxf(rm,0.f); mhat+=dl; \
        _Pragma("unroll") for(int r=0;r<16;++r){C0[r]-=dl;C1[r]-=dl;} \
        const float f=__builtin_amdgcn_exp2f(-dl); l_reg*=f; if(hi==0)wsf[r32]=f; resc=true; } } \
    SBAR(); \
    GAPB(o[0]=__builtin_amdgcn_mfma_f32_32x32x16_bf16(PAF(0),VFR(0),o[0],0,0,0), C0,0); \
    GAPB(o[1]=__builtin_amdgcn_mfma_f32_32x32x16_bf16(PAF(0),VFR(4),o[1],0,0,0), C0,4); \
    KRD(GL,0); GAPB(o[0]=__builtin_amdgcn_mfma_f32_32x32x16_bf16(PAF(1),VFR(1),o[0],0,0,0), C0,8); \
    KRD(GL,1); GAPB(o[1]=__builtin_amdgcn_mfma_f32_32x32x16_bf16(PAF(1),VFR(5),o[1],0,0,0), C0,12); \
    KRD(GL,2); GAPB(o[0]=__builtin_amdgcn_mfma_f32_32x32x16_bf16(PAF(2),VFR(2),o[0],0,0,0), C1,0); \
    KRD(GL,3); GAPB(o[1]=__builtin_amdgcn_mfma_f32_32x32x16_bf16(PAF(2),VFR(6),o[1],0,0,0), C1,4); \
    GAPB(o[0]=__builtin_amdgcn_mfma_f32_32x32x16_bf16(PAF(3),VFR(3),o[0],0,0,0), C1,8); \
    GAPB(o[1]=__builtin_amdgcn_mfma_f32_32x32x16_bf16(PAF(3),VFR(7),o[1],0,0,0), C1,12); \
    }while(0)
  int t=1;
  #undef CMASK
  #define CMASK(P0,P1,t) do{}while(0)
  for(;t+5<NT;t+=2){
    STEP(pB0,pB1,pA0,pA1,t,true,true,true);     WAIT_BAR(2); RESC(); ROT();
    STEP(pA0,pA1,pB0,pB1,t+1,true,true,true);   WAIT_BAR(2); RESC(); ROT();
  }
  #undef CMASK
  #define CMASK(P0,P1,t) do{int jb_=(t)-(NT-4); if(jb_>=0)bmask(P0,P1,jb_,wch,il,hi,s2x2);}while(0)
  #define ENDW(tt) do{ if((tt)+3<NT){WAIT_BAR(2);} else if((tt)+2<NT){WAIT_BAR(1);} else {WAIT_BAR(0);} }while(0)
  for(;t+1<NT;t+=2){
    STEP(pB0,pB1,pA0,pA1,t,(t+3<NT),(t+1<NT),(t+1<NT));       ENDW(t);   RESC(); ROT();
    STEP(pA0,pA1,pB0,pB1,t+1,(t+4<NT),(t+2<NT),(t+2<NT));     ENDW(t+1); RESC(); ROT();
  }
  STEP(pB0,pB1,pA0,pA1,NT-1,false,false,false); RESC();
  { float sacc=pB0[0]+pB0[1]; _Pragma("unroll") for(int r=2;r<16;++r)sacc+=pB0[r]; _Pragma("unroll") for(int r=0;r<16;++r)sacc+=pB1[r]; l_reg+=sacc;
    pw0=(u32x4){PKW(pB0,0),PKW(pB0,2),PKW(pB0,4),PKW(pB0,6)};pw1=(u32x4){PKW(pB0,8),PKW(pB0,10),PKW(pB0,12),PKW(pB0,14)};pw2=(u32x4){PKW(pB1,0),PKW(pB1,2),PKW(pB1,4),PKW(pB1,6)};pw3=(u32x4){PKW(pB1,8),PKW(pB1,10),PKW(pB1,12),PKW(pB1,14)};
    SBAR(); pv(o,vb0+sl_cur,PAF(0),PAF(1),PAF(2),PAF(3)); }
  #undef PKW
  #undef PAF
  #undef VFR
  #undef PIN_
  #undef MX3
  #undef GAPA
  #undef GAPB
  #undef EX
  #undef VRD
  #undef KRD
  #undef STEP
  #undef ENDW
  {auto rr=__builtin_amdgcn_permlane32_swap(__float_as_uint(l_reg),__float_as_uint(l_reg),false,false);l_reg=__uint_as_float(rr[0])+__uint_as_float(rr[1]);}
  if(hi==0)wsf[32+r32]=l_reg;asm volatile("s_waitcnt lgkmcnt(0)":::"memory");
  float rli[16];
  #pragma unroll
  for(int r=0;r<16;++r)rli[r]=__builtin_amdgcn_rcpf(wsf[32+crow(r,hi)]);
  bf16_t*Ow=Ob+(long)(q0+wid*QBLK)*POUT;
  { bf16_t*stg=(bf16_t*)(shm+LDS_OST)+wid*2048;
    #pragma unroll
    for(int r=0;r<16;++r){const int orow=crow(r,hi);
      #pragma unroll
      for(int d0=0;d0<2;++d0)stg[orow*64+d0*32+r32]=(bf16_t)f2bf(o[d0][r]*rli[r]);}
    asm volatile("s_waitcnt lgkmcnt(0)":::"memory");
    #pragma unroll
    for(int i=0;i<4;++i){const int row=i*8+(lane>>3),ch=lane&7; const u32x4 v=*(const u32x4*)(stg+row*64+ch*8); ATTN_STORE16(Ow+(long)row*POUT+ch*8,v);} }
  asm volatile("s_waitcnt lgkmcnt(0)\n\ts_barrier":::"memory");
  #undef DMA_K
  #undef DMA_V
  #undef CMASK
  #undef CINIT0
  #undef CINIT1
  #undef START
  #undef RESC
  #undef ROT
}
#undef SBAR
#undef WAIT_BAR
}

__device__ __forceinline__ void attn_phase(const Frame& F, const Args& a) {
    const bf16_t* proj = (const bf16_t*)(a.ws + WS_PROJ); bf16_t* OA = (bf16_t*)(a.ws + WS_OA);
    const int vcu = (F.G % 8 == 0) ? (F.bid % 8) * (F.G / 8) + F.bid / 8 : F.bid;
    for (int i = 0;; ++i) {
        int bvh, qb;
        if (F.G == 256) { if (i >= 4) break; const int s = vcu & 3; bvh = vcu >> 2; qb = (i == 0) ? s : (i == 1) ? 7 - s : (i == 2) ? 8 + s : 15 - s; }
        else { const int u = i * F.G + F.bid; if (u >= 1024) break; bvh = u >> 4; qb = 15 - (u & 15); }
        const int b = bvh >> 4, vh = bvh & 15, h = vh >> 2, map = (vh >> 1) & 1, dvh = vh & 1;
        const bf16_t* base = proj + (size_t)b * SEQ * INC;
        const float slope2 = exp2f(-2.0f * (h + 1)) * 1.4426950408889634f;
        attn_body::attn_unit<8>(qb, base + C_QDA + h * 128 + map * 64, base + C_KDA + h * 128 + map * 64, base + C_VDA + h * 128 + dvh * 64,
                                OA + (size_t)b * SEQ * 1024 + vh * 64, slope2, (char*)F.lds);
    }
}
__device__ __forceinline__ void attn_combine(const Frame& F, const Args& a) {
    const bf16_t* OA = (const bf16_t*)(a.ws + WS_OA); bf16_t* Y = (bf16_t*)(a.ws + WS_YDA);
    const float lam = ((const float*)(a.ws + WS_SMALL))[0];
    const float g0 = a.in[I_SUBG][2 * F.lane] * 0.8f, g1 = a.in[I_SUBG][2 * F.lane + 1] * 0.8f;
    const int gw = F.bid * NWAVES + F.wave, NGW = F.G * NWAVES;
    for (int r = gw; r < T; r += NGW) {
        const unsigned* orow = (const unsigned*)(OA + (size_t)r * 1024); unsigned* yrow = (unsigned*)(Y + (size_t)r * 512);
        unsigned w0[4], w1[4];
#pragma unroll
        for (int h = 0; h < 4; ++h) { w0[h] = orow[h * 128 + F.lane]; w1[h] = orow[h * 128 + 64 + F.lane]; }
#pragma unroll
        for (int h = 0; h < 4; ++h) {
            const float x0 = bf2f(w0[h] & 0xffffu) - lam * bf2f(w1[h] & 0xffffu), x1 = bf2f(w0[h] >> 16) - lam * bf2f(w1[h] >> 16);
            const float rs = rsqrtf(wave_sum(x0 * x0 + x1 * x1) * (1.0f / 128.0f) + EPS);
            yrow[h * 64 + F.lane] = pk2(x0 * rs * g0, x1 * rs * g1);
        }
    }
}
namespace hg {
constexpr int QP = 136;
constexpr int L_QD = 0, L_KD = 64 * QP * 2, L_V = 2 * 64 * QP * 2, L_KE = 3 * 64 * QP * 2, L_SSQ = 4 * 64 * QP * 2;
__device__ __forceinline__ f32x4 mfma16(bf16x8 a, bf16x8 b, f32x4 c) { return __builtin_amdgcn_mfma_f32_16x16x32_bf16(a, b, c, 0, 0, 0); }
#define HG_BAR() do { asm volatile("s_waitcnt lgkmcnt(0)" ::: "memory"); __builtin_amdgcn_s_barrier(); asm volatile("" ::: "memory"); } while (0)
typedef short v4i16_t __attribute__((ext_vector_type(4)));
__device__ __forceinline__ bf16x8 tr8(const LAS unsigned char* img, int ra, int rb, int col0, int lane) {
    const int q = (lane & 15) >> 2, p = lane & 3;
    const v4i16_t lo = __builtin_amdgcn_ds_read_tr16_b64_v4i16((LAS v4i16_t*)(img + ((ra + q) * QP + col0 + 4 * p) * 2));
    const v4i16_t hi = __builtin_amdgcn_ds_read_tr16_b64_v4i16((LAS v4i16_t*)(img + ((rb + q) * QP + col0 + 4 * p) * 2));
    return (bf16x8){lo[0], lo[1], lo[2], lo[3], hi[0], hi[1], hi[2], hi[3]};
}
struct Tile { u32x4 p[2]; };
__device__ __forceinline__ void tile_load(Tile& t, const bf16_t* src, size_t pitch, int tid) {
#pragma unroll
    for (int i = 0; i < 2; ++i) { const int pc = tid + NTHR * i; t.p[i] = *(const u32x4*)(src + (size_t)(pc >> 4) * pitch + (pc & 15) * 8); }
}
__device__ __forceinline__ void tile_put(const Tile& t, LAS unsigned char* img, int tid) {
#pragma unroll
    for (int i = 0; i < 2; ++i) { const int pc = tid + NTHR * i; *(LAS u32x4*)(img + ((pc >> 4) * QP + (pc & 15) * 8) * 2) = t.p[i]; }
}
struct In1 { Tile ke, v; };
__device__ __forceinline__ void load1(In1& r, const Frame& F, const Args& a, int unit) {
    const int bh = unit >> 6, n = unit & 63, b = bh >> 2, h = bh & 3; const size_t t0 = (size_t)b * SEQ + n * 64;
    tile_load(r.ke, (const bf16_t*)a.out + t0 * 512 + h * 128, 512, F.tid);
    tile_load(r.v, (const bf16_t*)(a.ws + WS_PROJ) + t0 * INC + C_IHG + h * 128, INC, F.tid);
}
__device__ __forceinline__ void stage1_unit(const In1& raw, const Frame& F, const Args& a, int unit) {
    const int bh = unit >> 6, n = unit & 63;
    tile_put(raw.ke, F.lds + L_KE, F.tid); tile_put(raw.v, F.lds + L_V, F.tid);
    HG_BAR();
    const int wk = F.wave >> 1, wv = F.wave & 1, fr = F.lane & 15, fq = F.lane >> 4;
    f32x4 acc[2][4];
#pragma unroll
    for (int i = 0; i < 2; ++i)
#pragma unroll
        for (int j = 0; j < 4; ++j) acc[i][j] = (f32x4){0.f, 0.f, 0.f, 0.f};
#pragma unroll
    for (int s2 = 0; s2 < 2; ++s2) {
        bf16x8 af[2], bv[4];
#pragma unroll
        for (int kt = 0; kt < 2; ++kt) af[kt] = tr8(F.lds + L_KE, 32 * s2 + 8 * fq, 32 * s2 + 8 * fq + 4, 32 * wk + 16 * kt, F.lane);
#pragma unroll
        for (int vt = 0; vt < 4; ++vt) bv[vt] = tr8(F.lds + L_V, 32 * s2 + 8 * fq, 32 * s2 + 8 * fq + 4, 64 * wv + 16 * vt, F.lane);
#pragma unroll
        for (int kt = 0; kt < 2; ++kt)
#pragma unroll
            for (int vt = 0; vt < 4; ++vt) acc[kt][vt] = mfma16(af[kt], bv[vt], acc[kt][vt]);
    }
    bf16_t* ds = (bf16_t*)(a.ws + WS_DS) + ((size_t)bh * 64 + n) * 16384;
#pragma unroll
    for (int kt = 0; kt < 2; ++kt)
#pragma unroll
        for (int vt = 0; vt < 4; ++vt) { const int v = 64 * wv + 16 * vt + fr, k = 32 * wk + 16 * kt + 4 * fq;
            u32x2 w; w.x = pk2(acc[kt][vt][0], acc[kt][vt][1]); w.y = pk2(acc[kt][vt][2], acc[kt][vt][3]); *(u32x2*)(ds + v * 128 + k) = w; }
    HG_BAR();
}
__device__ __forceinline__ void stage1_all(const Frame& F, const Args& a) {
    int u = F.bid; if (u >= 1024) return;
    In1 cur, nxt; load1(cur, F, a, u);
    for (; u < 1024; u += F.G) { const int un = (u + F.G < 1024) ? u + F.G : u; load1(nxt, F, a, un); stage1_unit(cur, F, a, u); cur = nxt; }
}
__device__ __forceinline__ void stage2_scan(const Frame& F, const Args& a) {
    unsigned* ds = (unsigned*)(a.ws + WS_DS); const float* dec = (const float*)(a.ws + WS_DEC);
    for (int gt = F.bid * NTHR + F.tid; gt < 16 * 8192; gt += F.G * NTHR) {
        const int bh = gt >> 13, e2 = gt & 8191, k = (2 * e2) & 127;
        unsigned* p = ds + (size_t)bh * 64 * 8192 + e2; const float* dp = dec + (size_t)bh * 64 * 128 + k;
        float s0 = 0.f, s1 = 0.f;
#pragma unroll 8
        for (int n = 0; n < 64; ++n) { const unsigned u = p[(size_t)n * 8192]; const f32x2 d = *(const f32x2*)(dp + n * 128);
            p[(size_t)n * 8192] = pk2(s0, s1); s0 = d.x * s0 + bf2f(u & 0xffffu); s1 = d.y * s1 + bf2f(u >> 16); }
    }
}
struct In3 { Tile qd, kd, v; };
__device__ __forceinline__ void load3(In3& r, const Frame& F, const Args& a, int unit) {
    const int bh = unit >> 6, n = unit & 63, b = bh >> 2, h = bh & 3;
    const bf16_t* base = (const bf16_t*)(a.ws + WS_PROJ) + ((size_t)b * SEQ + n * 64) * INC;
    tile_load(r.qd, base + C_HGT + 256 * h, INC, F.tid); tile_load(r.kd, base + C_HGT + 256 * h + 128, INC, F.tid); tile_load(r.v, base + C_IHG + h * 128, INC, F.tid);
}
__device__ __forceinline__ void stage3_unit(const In3& raw, const Frame& F, const Args& a, int unit) {
    const int bh = unit >> 6, n = unit & 63, b = bh >> 2, h = bh & 3;
    const int tb = F.wave >> 1, vh = F.wave & 1, fr = F.lane & 15, fq = F.lane >> 4;
    const bf16_t* sst = (const bf16_t*)(a.ws + WS_DS) + ((size_t)bh * 64 + n) * 16384;
    bf16x8 sb[4][4];
#pragma unroll
    for (int ks = 0; ks < 4; ++ks)
#pragma unroll
        for (int vt = 0; vt < 4; ++vt) sb[ks][vt] = *(const bf16x8*)(sst + (64 * vh + 16 * vt + fr) * 128 + 32 * ks + 8 * fq);
    const size_t t0 = (size_t)b * SEQ + n * 64 + 16 * tb + 4 * fq;
    const bf16_t* gp = (const bf16_t*)(a.ws + WS_PROJ) + t0 * INC + C_GHG + h * 128 + 64 * vh + fr;
    unsigned short gv[4][4];
#pragma unroll
    for (int r = 0; r < 4; ++r)
#pragma unroll
        for (int vt = 0; vt < 4; ++vt) gv[r][vt] = gp[(size_t)r * INC + 16 * vt];
    tile_put(raw.qd, F.lds + L_QD, F.tid); tile_put(raw.kd, F.lds + L_KD, F.tid); tile_put(raw.v, F.lds + L_V, F.tid);
    HG_BAR();
    bf16x8 qf[4];
#pragma unroll
    for (int ks = 0; ks < 4; ++ks) qf[ks] = *(const LAS bf16x8*)(F.lds + L_QD + ((16 * tb + fr) * QP + 32 * ks + 8 * fq) * 2);
    unsigned pk[4][2];
#pragma unroll
    for (int jt = 0; jt < 4; ++jt) { pk[jt][0] = 0u; pk[jt][1] = 0u;
        if (jt <= tb) { f32x4 sc = (f32x4){0.f, 0.f, 0.f, 0.f};
#pragma unroll
            for (int ks = 0; ks < 4; ++ks) { const bf16x8 kf = *(const LAS bf16x8*)(F.lds + L_KD + ((16 * jt + fr) * QP + 32 * ks + 8 * fq) * 2); sc = mfma16(kf, qf[ks], sc); }
            if (jt == tb) {
#pragma unroll
                for (int r = 0; r < 4; ++r) if (4 * fq + r > fr) sc[r] = 0.f;
            }
            pk[jt][0] = pk2(sc[0], sc[1]); pk[jt][1] = pk2(sc[2], sc[3]); } }
    f32x4 o[4];
#pragma unroll
    for (int vt = 0; vt < 4; ++vt) o[vt] = (f32x4){0.f, 0.f, 0.f, 0.f};
#pragma unroll
    for (int s2 = 0; s2 < 2; ++s2) if (2 * s2 <= tb) {
        const u32x4 aw = (u32x4){pk[2 * s2][0], pk[2 * s2][1], pk[2 * s2 + 1][0], pk[2 * s2 + 1][1]};
        const bf16x8 af = __builtin_bit_cast(bf16x8, aw);
#pragma unroll
        for (int vt = 0; vt < 4; ++vt) o[vt] = mfma16(af, tr8(F.lds + L_V, 32 * s2 + 4 * fq, 32 * s2 + 16 + 4 * fq, 64 * vh + 16 * vt, F.lane), o[vt]);
    }
#pragma unroll
    for (int ks = 0; ks < 4; ++ks)
#pragma unroll
        for (int vt = 0; vt < 4; ++vt) o[vt] = mfma16(qf[ks], sb[ks][vt], o[vt]);
    float ss[4];
#pragma unroll
    for (int r = 0; r < 4; ++r) { float v = 0.f;
#pragma unroll
        for (int vt = 0; vt < 4; ++vt) v += o[vt][r] * o[vt][r];
        v += __shfl_xor(v, 1); v += __shfl_xor(v, 2); v += __shfl_xor(v, 4); v += __shfl_xor(v, 8); ss[r] = v; }
    LAS float* SSQ = (LAS float*)(F.lds + L_SSQ);
    if (fr == 0) {
#pragma unroll
        for (int r = 0; r < 4; ++r) SSQ[(tb * 2 + vh) * 16 + 4 * fq + r] = ss[r]; }
    HG_BAR();
    bf16_t* yp = (bf16_t*)(a.ws + WS_YHG) + t0 * 512 + h * 128 + 64 * vh + fr;
#pragma unroll
    for (int r = 0; r < 4; ++r) { const float tot = SSQ[(tb * 2) * 16 + 4 * fq + r] + SSQ[(tb * 2 + 1) * 16 + 4 * fq + r]; const float rs = rsqrtf(tot * (1.0f / 128.0f) + EPS);
#pragma unroll
        for (int vt = 0; vt < 4; ++vt) { const float g = bf2f(gv[r][vt]); const float ng = a.in[I_HGNG][64 * vh + 16 * vt + fr];
            yp[(size_t)r * 512 + 16 * vt] = (bf16_t)f2bf(o[vt][r] * rs * ng * siluf_(g)); } }
    HG_BAR();
}
__device__ __forceinline__ void stage3_all(const Frame& F, const Args& a) {
    int u = F.bid; if (u >= 1024) return;
    In3 cur, nxt; load3(cur, F, a, u);
    for (; u < 1024; u += F.G) { const int un = (u + F.G < 1024) ? u + F.G : u; load3(nxt, F, a, un); stage3_unit(cur, F, a, u); cur = nxt; }
}
#undef HG_BAR
}

__device__ __forceinline__ float rs4(float a0, float a1, float a2, float a3, int lane) {
    const bool hi = (lane & 32) != 0;
    const float s0 = hi ? a0 : a2, s1 = hi ? a1 : a3;
    const float k0 = (hi ? a2 : a0) + __shfl_xor(s0, 32), k1 = (hi ? a3 : a1) + __shfl_xor(s1, 32);
    const bool b4 = (lane & 16) != 0;
    const float sd = b4 ? k0 : k1;
    float k = (b4 ? k1 : k0) + __shfl_xor(sd, 16);
    k += __shfl_xor(k, 8); k += __shfl_xor(k, 4); k += __shfl_xor(k, 2); k += __shfl_xor(k, 1);
    return k;
}
__device__ __forceinline__ void phase_router(const Frame& F, const Args& a) {
    constexpr int AP = 1032;
    LAS bf16_t* AH = (LAS bf16_t*)F.lds;
    LAS bf16_t* AL = AH + 16 * AP;
    LAS float* PART = (LAS float*)(F.lds + 2 * 16 * AP * 2);
    LAS float* LG = PART + 8 * 16 * 48;
    LAS unsigned* LH = (LAS unsigned*)(LG + 16 * 48);
    LAS unsigned* LB = LH + 32;
    LAS unsigned* LR = LH + 64;
    if (F.tid < NEXP) LH[F.tid] = 0u;
    const float* mod = (const float*)(a.ws + WS_MOD);
    const float* x1 = a.out; bf16_t* H2 = (bf16_t*)(a.ws + WS_ACT);
    unsigned* counts = (unsigned*)(a.ws + WS_CTL) + CW_COUNTS; unsigned* tokinfo = (unsigned*)(a.ws + WS_TOKINFO); int* toklist = (int*)(a.ws + WS_TOKLIST);
    const int rows_per_blk = T / F.G, r0 = F.bid * rows_per_blk, b = r0 / SEQ;
    const int lane = F.lane, w = F.wave, fr = lane & 15, fq = lane >> 4;
    f32x4 v[2][4], vn[2][4];
#define RT_LOAD(V, rb_) do { _Pragma("unroll") for (int q = 0; q < 2; ++q) { const f32x4* xr_ = (const f32x4*)(x1 + (size_t)((rb_) + 2 * w + q) * D) + lane; \
        _Pragma("unroll") for (int j = 0; j < 4; ++j) V[q][j] = xr_[64 * j]; } } while (0)
    RT_LOAD(v, r0);
    bf16x8 Bh[4][3], Bl[4][3];
    {
        const float* wre = a.in[I_WRE]; const float* wrg = a.in[I_WRG];
#pragma unroll
        for (int ks = 0; ks < 4; ++ks)
#pragma unroll
            for (int ct = 0; ct < 3; ++ct) {
                unsigned hw[4], lw[4];
#pragma unroll
                for (int jp = 0; jp < 4; ++jp) { float x[2];
#pragma unroll
                    for (int z = 0; z < 2; ++z) { const int k = 128 * w + 32 * ks + 8 * fq + 2 * jp + z;
                        if (ct == 0) { const float g = wrg[k * 4 + (fr & 3)], e = wre[k * 32 + ((fr + 28) & 31)]; x[z] = fr < 4 ? g : e; }
                        else if (ct == 1) x[z] = wre[k * 32 + 12 + fr];
                        else { const float e = wre[k * 32 + 28 + (fr & 3)]; x[z] = fr < 4 ? e : 0.f; } }
                    const unsigned h0 = f2bf(x[0]), h1 = f2bf(x[1]); hw[jp] = h0 | (h1 << 16);
                    lw[jp] = pk2(x[0] - bf2f(h0), x[1] - bf2f(h1)); }
                Bh[ks][ct] = __builtin_bit_cast(bf16x8, (u32x4){hw[0], hw[1], hw[2], hw[3]}); Bl[ks][ct] = __builtin_bit_cast(bf16x8, (u32x4){lw[0], lw[1], lw[2], lw[3]});
            }
    }
    for (int g = 0; g < rows_per_blk / 16; ++g) {
        const int rg = r0 + 16 * g;
        { const int gn = g + 1 < rows_per_blk / 16 ? g + 1 : g; RT_LOAD(vn, r0 + 16 * gn); }
#pragma unroll
        for (int q = 0; q < 2; ++q) { float sq = 0.f;
#pragma unroll
            for (int j = 0; j < 4; ++j) sq += (v[q][j].x * v[q][j].x + v[q][j].y * v[q][j].y) + (v[q][j].z * v[q][j].z + v[q][j].w * v[q][j].w);
            const float rs = rsqrtf(wave_sum(sq) * (1.0f / D) + EPS); const int row = 2 * w + q;
#pragma unroll
            for (int j = 0; j < 4; ++j) { const int k = 256 * j + 4 * lane;
                const f32x4 gg = *(const f32x4*)(a.in[I_N2G] + k) * (1.0f + *(const f32x4*)(mod + b * 6144 + 4 * 1024 + k)), sh = *(const f32x4*)(mod + b * 6144 + 3 * 1024 + k);
                const f32x4 hv = v[q][j] * rs * gg + sh;
                const unsigned h0 = f2bf(hv.x), h1 = f2bf(hv.y), h2_ = f2bf(hv.z), h3 = f2bf(hv.w);
                const u32x2 hw = (u32x2){h0 | (h1 << 16), h2_ | (h3 << 16)};
                *(u32x2*)(H2 + (size_t)(rg + row) * D + k) = hw;
                *(LAS u32x2*)(AH + row * AP + k) = hw;
                *(LAS u32x2*)(AL + row * AP + k) = (u32x2){pk2(hv.x - bf2f(h0), hv.y - bf2f(h1)), pk2(hv.z - bf2f(h2_), hv.w - bf2f(h3))}; } }
        __syncthreads();
        f32x4 acc[3] = {{0.f, 0.f, 0.f, 0.f}, {0.f, 0.f, 0.f, 0.f}, {0.f, 0.f, 0.f, 0.f}};
#pragma unroll
        for (int ks = 0; ks < 4; ++ks) { const bf16x8 ah = *(const LAS bf16x8*)(AH + fr * AP + 128 * w + 32 * ks + 8 * fq), al = *(const LAS bf16x8*)(AL + fr * AP + 128 * w + 32 * ks + 8 * fq);
#pragma unroll
            for (int ct = 0; ct < 3; ++ct) { acc[ct] = __builtin_amdgcn_mfma_f32_16x16x32_bf16(ah, Bh[ks][ct], acc[ct], 0, 0, 0);
                acc[ct] = __builtin_amdgcn_mfma_f32_16x16x32_bf16(al, Bh[ks][ct], acc[ct], 0, 0, 0); acc[ct] = __builtin_amdgcn_mfma_f32_16x16x32_bf16(ah, Bl[ks][ct], acc[ct], 0, 0, 0); } }
#pragma unroll
        for (int ct = 0; ct < 3; ++ct)
#pragma unroll
            for (int r = 0; r < 4; ++r) PART[(w * 16 + 4 * fq + r) * 48 + 16 * ct + fr] = acc[ct][r];
        __syncthreads();
        for (int t = F.tid; t < 16 * 48; t += NTHR) { const int row = t / 48, o = t % 48; float sacc = 0.f;
#pragma unroll
            for (int ww = 0; ww < 8; ++ww) sacc += PART[(ww * 16 + row) * 48 + o];
            if (o < 36) LG[row * 48 + o] = sacc + (o < 4 ? a.in[I_BRG][o & 3] : a.in[I_BRE][(o + 28) & 31]); }
        __syncthreads();
        if (F.tid < 16) {
            const LAS float* lg = LG + F.tid * 48;
            float gl[4]; int gi = 0;
#pragma unroll
            for (int o = 0; o < 4; ++o) gl[o] = lg[o];
            float gm = gl[0];
#pragma unroll
            for (int o = 1; o < 4; ++o) if (gl[o] > gm) { gm = gl[o]; gi = o; }
            float gsum = 0.f;
#pragma unroll
            for (int o = 0; o < 4; ++o) gsum += expf(gl[o] - gm);
            const float gp = 1.0f / gsum;
            float el[8];
#pragma unroll
            for (int e = 0; e < 8; ++e) el[e] = lg[4 + gi * 8 + e];
            int i0 = 0; float m0 = el[0];
#pragma unroll
            for (int o = 1; o < 8; ++o) if (el[o] > m0) { m0 = el[o]; i0 = o; }
            int i1 = -1; float m1 = -INFINITY;
#pragma unroll
            for (int o = 0; o < 8; ++o) if (o != i0 && el[o] > m1) { m1 = el[o]; i1 = o; }
            const float e1 = expf(m1 - m0); const float w0 = gp / (1.0f + e1), w1 = gp * e1 / (1.0f + e1);
            const int rl = 16 * g + F.tid, ex0 = gi * 8 + i0, ex1 = gi * 8 + i1;
            const unsigned l0 = atomicAdd((unsigned*)(LH + ex0), 1u), l1 = atomicAdd((unsigned*)(LH + ex1), 1u);
            LAS unsigned* ri = LR + rl * 6;
            ri[0] = (unsigned)ex0; ri[1] = l0; ri[2] = (unsigned)ex1; ri[3] = l1; ri[4] = __float_as_uint(w0); ri[5] = __float_as_uint(w1);
        }
#pragma unroll
        for (int q = 0; q < 2; ++q)
#pragma unroll
            for (int j = 0; j < 4; ++j) v[q][j] = vn[q][j];
    }
#undef RT_LOAD
    __syncthreads();
    if (F.tid < NEXP) LB[F.tid] = atomicAdd(counts + 64 * F.tid, LH[F.tid]);
    __syncthreads();
    for (int rl = F.tid; rl < rows_per_blk; rl += NTHR) {
        const LAS unsigned* ri = LR + rl * 6; const int r = r0 + rl;
        const unsigned ex0 = ri[0], ex1 = ri[2], k0 = LB[ex0] + ri[1], k1 = LB[ex1] + ri[3];
        toklist[ex0 * T + k0] = r; toklist[ex1 * T + k1] = r;
        u32x4 t0; t0.x = ex0; t0.y = k0; t0.z = ex1; t0.w = k1;
        *(u32x4*)(tokinfo + (size_t)r * 8) = t0;
        tokinfo[(size_t)r * 8 + 4] = ri[4]; tokinfo[(size_t)r * 8 + 5] = ri[5];
    }
}
__device__ __forceinline__ void build_moe_tab(const Frame& F, const Args& a, LAS MoeTab* tab) {
    if (F.tid == 0) {
        const unsigned* counts = (const unsigned*)(a.ws + WS_CTL) + CW_COUNTS; int nt = 0;
        for (int e = 0; e < NEXP; ++e) { const int c = (int)__hip_atomic_load(counts + 64 * e, __ATOMIC_RELAXED, __HIP_MEMORY_SCOPE_AGENT); tab->cnt[e] = c; tab->tbase[e] = nt;
            const int n = (c + 255) >> 8; for (int m = 0; m < n; ++m) { tab->tile_e[nt] = e; tab->tile_m[nt] = m; ++nt; } }
        tab->tbase[NEXP] = nt; tab->nt = nt;
    }
    __syncthreads();
}
__device__ __forceinline__ void phase_final(const Frame& F, const Args& a, const LAS MoeTab* tab) {
    const float* mod = (const float*)(a.ws + WS_MOD); const unsigned* tokinfo = (const unsigned*)(a.ws + WS_TOKINFO); const bf16_t* Ys = (const bf16_t*)(a.ws + WS_YS);
    const int rows_per_blk = T / F.G, r0 = F.bid * rows_per_blk;
    for (int r = r0 + F.wave; r < r0 + rows_per_blk; r += NWAVES) {
        const int b = r / SEQ;
        const u32x4 ti = *(const u32x4*)(tokinfo + (size_t)r * 8);
        const float w0 = __uint_as_float(tokinfo[(size_t)r * 8 + 4]), w1 = __uint_as_float(tokinfo[(size_t)r * 8 + 5]);
        const size_t s0 = (size_t)tab->tbase[ti.x] * 256 + ti.y, s1 = (size_t)tab->tbase[ti.z] * 256 + ti.w;
        f32x4* xr = (f32x4*)(a.out + (size_t)r * D) + F.lane;
        const u32x2* y0 = (const u32x2*)(Ys + s0 * D) + F.lane; const u32x2* y1 = (const u32x2*)(Ys + s1 * D) + F.lane;
        f32x4 v[4]; float s = 0.f;
#pragma unroll
        for (int j = 0; j < 4; ++j) { const int k = 256 * j + 4 * F.lane;
            const f32x4 gt = *(const f32x4*)(mod + b * 6144 + 5 * 1024 + k); const u32x2 a0 = y0[64 * j], a1 = y1[64 * j];
            f32x4 m; m.x = w0 * bf2f(a0.x & 0xffffu) + w1 * bf2f(a1.x & 0xffffu); m.y = w0 * bf2f(a0.x >> 16) + w1 * bf2f(a1.x >> 16);
            m.z = w0 * bf2f(a0.y & 0xffffu) + w1 * bf2f(a1.y & 0xffffu); m.w = w0 * bf2f(a0.y >> 16) + w1 * bf2f(a1.y >> 16);
            v[j] = xr[64 * j] + gt * m; s += (v[j].x * v[j].x + v[j].y * v[j].y) + (v[j].z * v[j].z + v[j].w * v[j].w); }
        const float rs = rsqrtf(wave_sum(s) * (1.0f / D) + EPS);
#pragma unroll
        for (int j = 0; j < 4; ++j) { const f32x4 g = *(const f32x4*)(a.in[I_FG] + 256 * j + 4 * F.lane); xr[64 * j] = v[j] * rs * g; }
    }
}

#define XB_TMO      128
#define XB_XCNT(j)  (256  + 64 * (j))
#define XB_XSUB(j)  (1280 + 64 * (j))
#define XB_XGEN(j)  (2304 + 64 * (j))
#define XB_TOP      3328
#define XB_TOPGEN   3392
#define XCD_BAR_WORDS 3456
#define XB_SPIN_CAP (1u << 18)
__device__ __forceinline__ unsigned xb_ld(unsigned* p)              { return __hip_atomic_load(p, __ATOMIC_RELAXED, __HIP_MEMORY_SCOPE_AGENT); }
__device__ __forceinline__ unsigned xb_add(unsigned* p, unsigned v) { return __hip_atomic_fetch_add(p, v, __ATOMIC_RELAXED, __HIP_MEMORY_SCOPE_AGENT); }
__device__ __forceinline__ unsigned xb_xcc_id() { return (unsigned)__builtin_amdgcn_s_getreg((3 << 11) | 20) & 0xFu; }
#define XB_SPIN(cond, bar) do { unsigned _sp = 0; while (cond) { __builtin_amdgcn_s_sleep(1); \
    if ((++_sp & 255u) == 0u) { if (xb_ld(&(bar)[XB_TMO])) break; if (_sp > XB_SPIN_CAP) { atomicAdd(&(bar)[XB_TMO], 1u); break; } } } } while (0)
struct XcdBarrier { unsigned* bar; unsigned x; volatile LAS unsigned* st; };
__device__ __forceinline__ XcdBarrier xcd_barrier_post(unsigned* bar, volatile LAS unsigned* st) {
    XcdBarrier b; b.bar = bar; b.x = xb_xcc_id(); b.st = st;
    if (threadIdx.x == 0) (void)xb_add(&bar[XB_XCNT(b.x)], 1u);
    return b;
}
__device__ __forceinline__ void xcd_barrier_complete(unsigned* bar, unsigned x, unsigned& nloc, unsigned& nx) {
    const unsigned G = gridDim.x * gridDim.y * gridDim.z;
    unsigned sum, cnt, mine, sp = 0u;
    for (;;) {
        sum = 0u; cnt = 0u; mine = 0u;
#pragma unroll
        for (unsigned j = 0; j < 16; ++j) { const unsigned c = xb_ld(&bar[XB_XCNT(j)]); sum += c; cnt += (c > 0u) ? 1u : 0u; mine = (j == x) ? c : mine; }
        if (sum == G) break;
        __builtin_amdgcn_s_sleep(1);
        if ((++sp & 255u) == 0u) { if (xb_ld(&bar[XB_TMO])) break; if (sp > XB_SPIN_CAP) { atomicAdd(&bar[XB_TMO], 1u); break; } }
    }
    nloc = mine > 0u ? mine : 1u; nx = cnt > 0u ? cnt : 1u;
}
__device__ __forceinline__ void xcd_barrier(const XcdBarrier& b) {
    asm volatile("s_waitcnt vmcnt(0)" ::: "memory");
    __syncthreads();
    if (threadIdx.x == 0) {
        unsigned* bar = b.bar;
        __builtin_amdgcn_s_waitcnt(0);
        unsigned nloc = b.st[0], nx = b.st[1];
        if (nloc == 0u) { xcd_barrier_complete(bar, b.x, nloc, nx); b.st[0] = nloc; b.st[1] = nx; }
        const unsigned old = xb_add(&bar[XB_XSUB(b.x)], 1u);
        const unsigned gen = old / nloc;
        if (old + 1u == (gen + 1u) * nloc) {
            __builtin_amdgcn_fence(__ATOMIC_RELEASE, "agent");
            asm volatile("s_waitcnt vmcnt(0)" ::: "memory");
            const unsigned og = xb_add(&bar[XB_TOP], 1u);
            const unsigned tg = og / nx;
            if (og + 1u == (tg + 1u) * nx) xb_add(&bar[XB_TOPGEN], 1u);
            else XB_SPIN(xb_ld(&bar[XB_TOPGEN]) == tg, bar);
            __builtin_amdgcn_fence(__ATOMIC_ACQUIRE, "agent");
            xb_add(&bar[XB_XGEN(b.x)], 1u);
            asm volatile("s_waitcnt vmcnt(0)" ::: "memory");
        } else {
            XB_SPIN(xb_ld(&bar[XB_XGEN(b.x)]) == gen, bar);
            __builtin_amdgcn_fence(__ATOMIC_ACQUIRE, "agent");
            asm volatile("s_waitcnt vmcnt(0)" ::: "memory");
        }
    }
    __syncthreads();
}

constexpr int N_PHASES = 11;
__global__ void __launch_bounds__(NTHR, 2) mk_fwd(Args a) {
    extern __shared__ __attribute__((aligned(16))) unsigned char lds_raw[];
    Frame F; F.lds = (LAS unsigned char*)lds_raw; F.tid = threadIdx.x; F.lane = F.tid & 63; F.wave = __builtin_amdgcn_readfirstlane(F.tid >> 6); F.G = gridDim.x; F.bid = blockIdx.x;
    unsigned char* ws = a.ws;
    const int lo = a.ph_lo, hi = a.ph_hi;
#if MK_N_LAUNCHES == 1
    volatile LAS unsigned* MISC = (volatile LAS unsigned*)(F.lds + 152 * 1024);
    if (F.tid < 4) MISC[F.tid] = 0u;
    __syncthreads();
    XcdBarrier xbar = xcd_barrier_post((unsigned*)(ws + WS_CTL) + CW_BAR, MISC);
#ifndef PROBE_TS
#define PROBE_TS -1
#endif
#define STAMP(k) do { if (PROBE_TS >= 0 && F.bid == 0 && F.tid == 0) { const unsigned long long t_ = __builtin_amdgcn_s_memrealtime(); MISC[16 + 2 * (k)] = (unsigned)t_; MISC[17 + 2 * (k)] = (unsigned)(t_ >> 32); } } while (0)
#define SEAM(k) do { if (IN(k) && IN((k) + 1)) xcd_barrier(xbar); STAMP((k) + 1); } while (0)
    STAMP(0);
#else
#define SEAM(k) do { } while (0)
#endif
#ifndef PHASE_MASK
#define PHASE_MASK 0x7ff
#endif
#define IN(k) (((PHASE_MASK >> (k)) & 1) && lo <= (k) && (k) < hi)
    LAS MoeTab* tab = (LAS MoeTab*)(F.lds + 144 * 1024);

#ifndef REPEAT_PHASE
#define REPEAT_PHASE -1
#endif
#if MK_N_LAUNCHES == 1
#define RUNPH(k, ...) if (IN(k)) { F.lane = lane_now(); F.tid = F.wave * 64 + F.lane; __VA_ARGS__ if (REPEAT_PHASE == (k)) { xcd_barrier(xbar); __VA_ARGS__ } }
#else
#define RUNPH(k, ...) if (IN(k)) { F.lane = lane_now(); F.tid = F.wave * 64 + F.lane; __VA_ARGS__ }
#endif
    RUNPH(0, { phase0(F, a); }) SEAM(0);
    RUNPH(1, { phase1(F, a); }) SEAM(1);
    RUNPH(2, {
        DenseOrder S{(const char*)(ws + WS_ACT), (const char*)(ws + WS_WIN), D, T / 256, INC / 256, F.G, F.bid};
        EpiInProj E{(bf16_t*)(ws + WS_PROJ), (bf16_t*)a.out, (float*)(ws + WS_DEC), (const float*)(ws + WS_SMALL) + 16, attn_body::C2};
        pg8::gemm_phase(F.lds, D, S, E);
    }) SEAM(2);
    RUNPH(3, {
        hg::stage1_all(F, a);
        __syncthreads();
        attn_phase(F, a);
    }) SEAM(3);
    RUNPH(4, { hg::stage2_scan(F, a); attn_combine(F, a); }) SEAM(4);
    RUNPH(5, { hg::stage3_all(F, a); }) SEAM(5);
    RUNPH(6, {
        UpOrder S{(const char*)(ws + WS_YDA), (const char*)(ws + WS_YHG), (const char*)(ws + WS_WUPDA), (const char*)(ws + WS_WUPHG), F.G, F.bid};
        EpiUp E{(const bf16_t*)(ws + WS_PROJ), (bf16_t*)(ws + WS_ACT)};
        pg8::gemm_phase(F.lds, 512, S, E);
    }) SEAM(6);
    RUNPH(7, {
        DenseOrder S{(const char*)(ws + WS_ACT), (const char*)(ws + WS_WOUT), D, T / 256, D / 256, F.G, F.bid};
        EpiOut E{a.in[I_X], (const float*)(ws + WS_MOD), a.out};
        pg8::gemm_phase(F.lds, D, S, E);
        moe_weight_convert(F, a);
    }) SEAM(7);
    RUNPH(8, { phase_router(F, a); __syncthreads(); }) SEAM(8);
    RUNPH(9, {
        build_moe_tab(F, a, tab);
        unsigned* done = (unsigned*)(ws + WS_CTL) + CW_TILE;
        { Moe1Order S{tab, (const char*)(ws + WS_ACT), (const char*)(ws + WS_W13), (const int*)(ws + WS_TOKLIST), F.G, F.bid};
          EpiMoe1 E{(bf16_t*)(ws + WS_HS), done};
          pg8::gemm_phase(F.lds, D, S, E); }
        { Moe2Order S{tab, (const char*)(ws + WS_HS), (const char*)(ws + WS_W2), done, (unsigned*)(ws + WS_CTL) + CW_TMO, F.G, F.bid};
          EpiStoreBf16 E{(bf16_t*)(ws + WS_YS), D, 0, 1.0f};
          pg8::gemm_phase(F.lds, DEXP, S, E); }
    }) SEAM(9);
    RUNPH(10, { build_moe_tab(F, a, tab); phase_final(F, a, tab); })
#if MK_N_LAUNCHES == 1
    if (PROBE_TS >= 0) {
        __syncthreads(); STAMP(11);
        if (F.bid == 0 && F.tid == 0) {
            const int ka = PROBE_TS & 15, kb = (PROBE_TS >> 4) & 15;
            const unsigned long long a0 = ((unsigned long long)MISC[17 + 2 * ka] << 32) | MISC[16 + 2 * ka], a1 = ((unsigned long long)MISC[19 + 2 * ka] << 32) | MISC[18 + 2 * ka];
            const unsigned long long b0 = ((unsigned long long)MISC[17 + 2 * kb] << 32) | MISC[16 + 2 * kb], b1 = ((unsigned long long)MISC[19 + 2 * kb] << 32) | MISC[18 + 2 * kb];
            const float da = (float)(a1 - a0) * 0.01f, db = (float)(b1 - b0) * 0.01f;
            asm volatile("s_waitcnt vmcnt(0)" ::: "memory");
            a.out[0] += sqrtf(da * 16.78f); a.out[1] += db * 0.1f;
        }
    }
#endif
#undef IN
#undef SEAM
}

extern "C" void kernel_launch(void* const* d_in, const int* in_sizes, int n_in, void* d_out, int out_size, void* d_ws, size_t ws_size, hipStream_t stream) {
    static int grid = 0;
    if (grid == 0) {
        if (n_in != 25 || in_sizes[0] != T * D || out_size != T * D || ws_size < WS_END) { fprintf(stderr, "kernel_launch: unexpected shapes (n_in %d, in0 %d, out %d, ws %zu)\n", n_in, n_in > 0 ? in_sizes[0] : -1, out_size, ws_size); grid = -1; return; }
        int dev = 0, cus = 0, per_cu = 0;
        if (hipGetDevice(&dev) != hipSuccess || hipDeviceGetAttribute(&cus, hipDeviceAttributeMultiprocessorCount, dev) != hipSuccess) { grid = -1; return; }
        if (hipFuncSetAttribute((const void*)mk_fwd, hipFuncAttributeMaxDynamicSharedMemorySize, LDS_BYTES) != hipSuccess) { fprintf(stderr, "kernel_launch: hipFuncSetAttribute failed\n"); grid = -1; return; }
        if (hipOccupancyMaxActiveBlocksPerMultiprocessor(&per_cu, (const void*)mk_fwd, NTHR, LDS_BYTES) != hipSuccess || per_cu < 1) { fprintf(stderr, "kernel_launch: occupancy query says %d\n", per_cu); per_cu = 1; }
        (void)hipGetLastError();
        grid = cus;
        if (grid > 256) grid = 256;
        while (T % grid) --grid;
    }
    if (grid < 0) return;
    (void)hipMemsetAsync((char*)d_ws + WS_CTL, 0, CTL_ZERO_BYTES, stream);
    Args a{};
    for (int i = 0; i < 25; ++i) a.in[i] = (const float*)d_in[i];
    a.out = (float*)d_out; a.ws = (unsigned char*)d_ws;
#if MK_N_LAUNCHES == 1
    a.ph_lo = 0; a.ph_hi = N_PHASES;
    void* args[] = {&a};
    hipError_t e = hipLaunchCooperativeKernel((const void*)mk_fwd, dim3(grid), dim3(NTHR), args, LDS_BYTES, stream);
    if (e != hipSuccess) fprintf(stderr, "cooperative launch failed: %s (grid %d)\n", hipGetErrorString(e), grid);
#else
    for (int p = 0; p < N_PHASES; ++p) {
        a.ph_lo = p; a.ph_hi = p + 1;
        hipLaunchKernelGGL(mk_fwd, dim3(grid), dim3(NTHR), LDS_BYTES, stream, a);
    }
#endif
}
```

```cpp
#include <hip/hip_runtime.h>
#include <hip/hip_cooperative_groups.h>
#include <cstdio>
#include <cstdint>
namespace cg = cooperative_groups;

#ifndef MK_N_LAUNCHES
#define MK_N_LAUNCHES 1
#endif

#define LAS __attribute__((address_space(3)))
typedef unsigned short bf16_t;
typedef short bf16x8 __attribute__((ext_vector_type(8)));
typedef float f32x4 __attribute__((ext_vector_type(4)));
typedef float f32x2 __attribute__((ext_vector_type(2)));
typedef unsigned u32x4 __attribute__((ext_vector_type(4)));
typedef unsigned u32x2 __attribute__((ext_vector_type(2)));

constexpr int NB = 4, SEQ = 4096, D = 1024, T = NB * SEQ;
constexpr int INC = 5632;
constexpr int C_QDA = 0, C_KDA = 512, C_VDA = 1024, C_QHG = 1536, C_FHG = 2048, C_IHG = 2560, C_GHG = 3072, C_GDA = 3584, C_GHGATE = 4608;
constexpr int C_HGT = 1536;
constexpr int NEXP = 32, DEXP = 512;
constexpr int PMAX = 40960;
constexpr float EPS = 1e-6f;
constexpr int NWAVES = 8, NTHR = 512;

constexpr size_t MiB = 1u << 20;
constexpr size_t WS_CTL = 0, CTL_ZERO_BYTES = 64 * 1024;
constexpr size_t WS_MODP = 1 * MiB;
constexpr size_t WS_MOD = 5 * MiB / 2;
constexpr size_t WS_SMALL = 11 * MiB / 4;
constexpr size_t WS_TOKINFO = 3 * MiB;
constexpr size_t WS_TOKLIST = 4 * MiB;
constexpr size_t WS_DEC = 6 * MiB;
constexpr size_t WS_DS = 24 * MiB;
constexpr size_t WS_WIN = 8 * MiB;
constexpr size_t WS_WUPDA = 20 * MiB, WS_WUPHG = 21 * MiB, WS_WOUT = 22 * MiB;
constexpr size_t WS_ACT = 24 * MiB;
constexpr size_t WS_PROJ = 56 * MiB;
constexpr size_t WS_YDA = 232 * MiB, WS_YHG = 248 * MiB;
constexpr size_t WS_OA = 264 * MiB;
constexpr size_t WS_W13 = 56 * MiB;
constexpr size_t WS_W2 = 120 * MiB;
constexpr size_t WS_HS = 152 * MiB;
constexpr size_t WS_YS = 192 * MiB;
constexpr size_t WS_END = 296 * MiB;
constexpr int CW_COUNTS = 64;
constexpr int CW_BAR = 4096;
constexpr int CW_TILE = 8192;
constexpr int CW_TMO = 32;

constexpr int LDS_BYTES = 160 * 1024;

__device__ __forceinline__ float bf2f(unsigned v) { return __uint_as_float(v << 16); }
__device__ __forceinline__ unsigned f2bf(float f) { unsigned u = __float_as_uint(f); return (u + 0x7fffu + ((u >> 16) & 1u)) >> 16; }
__device__ __forceinline__ unsigned pk2(float lo, float hi) { return f2bf(lo) | (f2bf(hi) << 16); }
__device__ __forceinline__ float sigmoidf_(float x) { return 1.0f / (1.0f + __expf(-x)); }
__device__ __forceinline__ float siluf_(float x) { return x / (1.0f + __expf(-x)); }
__device__ __forceinline__ int lane_now() { int l; asm volatile("v_mbcnt_lo_u32_b32 %0, -1, 0\n\tv_mbcnt_hi_u32_b32 %0, -1, %0" : "=v"(l)); return l; }
__device__ __forceinline__ float wave_sum(float v) {
#pragma unroll
    for (int o = 1; o < 64; o <<= 1) v += __shfl_xor(v, o);
    return v;
}

namespace pg8 {
constexpr int BM = 256, BK = 64, HALF = 128, HTB = HALF * BK * 2, STAGE_BYTES = 8 * HTB;
__host__ __device__ __forceinline__ int lds_byte(int r, int c) { const int st = (r >> 4) * 2 + (c >> 5), rr = r & 15, cc = c & 31, ob = rr * 64 + cc * 2; return st * 1024 + (ob ^ (((ob >> 9) & 1) << 5)); }
__host__ __device__ __forceinline__ void stage_rc(int b, int& R, int& C) { const int st = b / 1024, sb = b % 1024, swz = sb ^ (((sb >> 9) & 1) << 5); R = (st >> 1) * 16 + swz / 64; C = (st & 1) * 32 + (swz % 64) / 2; }
__host__ __device__ __forceinline__ int perm32(int rho) { const int n = rho >> 4, i = rho & 15; return 8 * (i >> 2) + 4 * n + (i & 3); }

struct Unit { int pm, pn; const char* A; const char* B; int aux; };
__device__ __forceinline__ unsigned cvt_pk_bf16(float lo, float hi) { unsigned r; asm volatile("v_cvt_pk_bf16_f32 %0, %1, %2" : "=v"(r) : "v"(lo), "v"(hi)); return r; }

template <class Epi, class Sched>
__device__ __forceinline__ void gemm_phase(LAS unsigned char* lds, const int K, const Sched& S, const Epi& E) {
    const int tid = threadIdx.x, wid = __builtin_amdgcn_readfirstlane(tid >> 6), lane = tid & 63, wr = wid >> 2, wc = wid & 3, fr = lane & 15, fq = lane >> 4;
    const int nt = K / BK;
    unsigned voffB[2];
#define PG8_SETLANE() do { const int _l = lane_now(), _t = wid * 64 + _l; _Pragma("unroll") for (int _i = 0; _i < 2; ++_i) { int _R, _C; stage_rc(_t * 16 + _i * 8192, _R, _C); \
        const int _Rb = Epi::PERM ? ((_R & ~31) + perm32(_R & 31)) : _R; voffB[_i] = (unsigned)(_Rb * K + _C) * 2u; } \
        aoff = lds_byte(wr * 64 + (_l & 15), (_l >> 4) * 8); boff = lds_byte(wc * 32 + (_l & 15), (_l >> 4) * 8); } while (0)
    const size_t kstep = (size_t)(BK * 2);
    const size_t hstep = (size_t)HALF * K * 2;
    const unsigned ldsw = (unsigned)wid * 1024u;
    int aoff, boff; PG8_SETLANE();
#define PG8_SA(b, h) (((b) * 2 + (h)) * HTB)
#define PG8_SB(b, h) ((4 + (b) * 2 + (h)) * HTB)
#define PG8_STAGE(bufoff, gbase, voff) do { _Pragma("unroll") for (int _i = 0; _i < 2; ++_i) \
        __builtin_amdgcn_global_load_lds((const unsigned*)((const char*)(gbase) + (voff)[_i]), (LAS unsigned*)(lds + (bufoff) + ldsw + _i * 8192), 16, 0, 0); } while (0)
#define PG8_LDA(dst, b, h) do { _Pragma("unroll") for (int m = 0; m < 4; ++m) _Pragma("unroll") for (int k = 0; k < 2; ++k) dst[m][k] = *(const LAS bf16x8*)(lds + PG8_SA(b, h) + aoff + m * 2048 + k * 1024); } while (0)
#define PG8_LDB(dst, b, h) do { _Pragma("unroll") for (int n = 0; n < 2; ++n) _Pragma("unroll") for (int k = 0; k < 2; ++k) dst[n][k] = *(const LAS bf16x8*)(lds + PG8_SB(b, h) + boff + n * 2048 + k * 1024); } while (0)
#define PG8_MMA(ai, bj, At, Bt) do { __builtin_amdgcn_s_setprio(1); _Pragma("unroll") for (int m = 0; m < 4; ++m) _Pragma("unroll") for (int n = 0; n < 2; ++n) _Pragma("unroll") for (int k = 0; k < 2; ++k) \
        acc[ai][bj][m][n] = __builtin_amdgcn_mfma_f32_16x16x32_bf16(Bt[n][k], At[m][k], acc[ai][bj][m][n], 0, 0, 0); __builtin_amdgcn_s_setprio(0); } while (0)
#define PG8_WAIT_V(n) asm volatile("s_waitcnt vmcnt(" #n ")" ::: "memory")
#define PG8_WAIT_L(n) asm volatile("s_waitcnt lgkmcnt(" #n ")" ::: "memory")
#define PG8_BAR __builtin_amdgcn_s_barrier()
#define PG8_SCHED __builtin_amdgcn_sched_barrier(0)
#define PG8_SETA(vo, u) do { const int _t = wid * 64 + lane_now(); _Pragma("unroll") for (int _i = 0; _i < 2; ++_i) { int _R, _C; stage_rc(_t * 16 + _i * 8192, _R, _C); \
        _Pragma("unroll") for (int _h = 0; _h < 2; ++_h) vo[_h][_i] = (unsigned)((size_t)S.arow(u, _h * HALF + _R) * (size_t)K + _C) * 2u; } if (Sched::GATHER) PG8_WAIT_V(0); } while (0)
    Unit cur, nxt; int ui = 0;
    if (!S.next(0, cur)) return;
    f32x4 acc[2][2][4][2];
#pragma unroll
    for (int a = 0; a < 2; ++a)
#pragma unroll
        for (int b = 0; b < 2; ++b)
#pragma unroll
            for (int m = 0; m < 4; ++m)
#pragma unroll
                for (int n = 0; n < 2; ++n) acc[a][b][m][n] = (f32x4){0.f, 0.f, 0.f, 0.f};
    bf16x8 At[4][2], B0[2][2], B1[2][2];
    unsigned voC[2][2], voN[2][2];
    S.a_ready(cur);
    PG8_SETA(voC, cur);
    const char* cA = cur.A; const char* cB = cur.B;
    PG8_STAGE(PG8_SB(0, 0), cB, voffB); PG8_STAGE(PG8_SB(0, 1), cB + hstep, voffB); PG8_STAGE(PG8_SA(0, 0), cA, voC[0]); PG8_STAGE(PG8_SA(0, 1), cA, voC[1]);
    if (wr == 1) PG8_BAR;
    PG8_WAIT_V(2); PG8_BAR;
    PG8_STAGE(PG8_SB(1, 0), cB + kstep, voffB); PG8_STAGE(PG8_SA(1, 0), cA + kstep, voC[0]); PG8_STAGE(PG8_SB(1, 1), cB + hstep + kstep, voffB);
    PG8_WAIT_V(6); PG8_BAR;
    for (;;) {
        const bool has_next = S.next(ui + 1, nxt);
        if (has_next) { PG8_SETA(voN, nxt); }
        else {
#pragma unroll
            for (int h = 0; h < 2; ++h)
#pragma unroll
                for (int i = 0; i < 2; ++i) voN[h][i] = voC[h][i];
        }
        const char* nA = has_next ? nxt.A : cA; const char* nB = has_next ? nxt.B : cB;
        for (int t = 0; t < nt; t += 2) {
            const bool last = (t == nt - 2);
            if (last && has_next) S.a_ready(nxt);
            const char* a1 = cA + (size_t)(t + 1) * kstep;
            const char* a2 = last ? nA : cA + (size_t)(t + 2) * kstep; const char* b2 = last ? nB : cB + (size_t)(t + 2) * kstep;
            const char* a3 = a2 + kstep; const char* b3 = b2 + kstep;
            unsigned vo2[2][2];
#pragma unroll
            for (int h = 0; h < 2; ++h)
#pragma unroll
                for (int i = 0; i < 2; ++i) vo2[h][i] = last ? voN[h][i] : voC[h][i];
            PG8_LDB(B0, 0, 0); PG8_LDB(B1, 0, 1); PG8_SCHED; PG8_LDA(At, 0, 0); PG8_STAGE(PG8_SA(1, 1), a1, voC[1]);
            PG8_WAIT_V(8); PG8_WAIT_L(0); PG8_BAR; PG8_MMA(0, 0, At, B0); PG8_MMA(0, 1, At, B1); PG8_BAR; PG8_SCHED;
            PG8_LDA(At, 0, 1); PG8_STAGE(PG8_SB(0, 0), b2, voffB); PG8_STAGE(PG8_SB(0, 1), b2 + hstep, voffB); PG8_STAGE(PG8_SA(0, 0), a2, vo2[0]);
            PG8_WAIT_V(8); PG8_WAIT_L(0); PG8_BAR; PG8_MMA(1, 0, At, B0); PG8_MMA(1, 1, At, B1); PG8_BAR; PG8_SCHED;
            PG8_LDB(B0, 1, 0); PG8_LDB(B1, 1, 1); PG8_SCHED; PG8_LDA(At, 1, 0); PG8_STAGE(PG8_SA(0, 1), a2, vo2[1]);
            PG8_WAIT_V(8); PG8_WAIT_L(0); PG8_BAR; PG8_MMA(0, 0, At, B0); PG8_MMA(0, 1, At, B1); PG8_BAR; PG8_SCHED;
            PG8_LDA(At, 1, 1); PG8_STAGE(PG8_SB(1, 0), b3, voffB); PG8_STAGE(PG8_SB(1, 1), b3 + hstep, voffB); PG8_STAGE(PG8_SA(1, 0), a3, vo2[0]);
            PG8_WAIT_V(8); PG8_WAIT_L(0); PG8_BAR; PG8_MMA(1, 0, At, B0); PG8_MMA(1, 1, At, B1); PG8_BAR; PG8_SCHED;
        }
        if (wr == 0) PG8_BAR;
        const bool keep = E(acc, cur, wr, wc, fr, fq);
        if (!has_next) break;
        if (!keep) {
#pragma unroll
            for (int a = 0; a < 2; ++a)
#pragma unroll
                for (int b = 0; b < 2; ++b)
#pragma unroll
                    for (int m = 0; m < 4; ++m)
#pragma unroll
                        for (int n = 0; n < 2; ++n) acc[a][b][m][n] = (f32x4){0.f, 0.f, 0.f, 0.f};
        }
        cur = nxt; cA = nA; cB = nB; ++ui;
        if (Sched::GATHER) {
#pragma unroll
            for (int h = 0; h < 2; ++h)
#pragma unroll
                for (int i = 0; i < 2; ++i) voC[h][i] = voN[h][i];
        } else { PG8_SETA(voC, cur); }
        PG8_SETLANE();
        if (wr == 1) PG8_BAR;
    }
    PG8_WAIT_V(0);
    PG8_BAR;
#undef PG8_SA
#undef PG8_SB
#undef PG8_STAGE
#undef PG8_LDA
#undef PG8_LDB
#undef PG8_MMA
#undef PG8_WAIT_V
#undef PG8_WAIT_L
#undef PG8_BAR
#undef PG8_SCHED
#undef PG8_SETA
#undef PG8_SETLANE
}
}

struct Args { const float* in[25]; float* out; unsigned char* ws; int ph_lo, ph_hi; };
enum { I_X = 0, I_C, I_WADA, I_BADA, I_N1G, I_WIN, I_LQ1, I_LK1, I_LQ2, I_LK2, I_SUBG, I_LBL, I_HGNG, I_WUPDA, I_WUPHG, I_WOUT, I_N2G, I_WRG, I_BRG, I_WRE, I_BRE, I_W1, I_W3, I_W2, I_FG };

struct DenseOrder {
    static constexpr bool GATHER = false;
    const char* A; const char* Bt; int K, nM, nN, G, c;
    __device__ __forceinline__ bool next(int i, pg8::Unit& u) const {
        const int L = i * G + c, nwg = nM * nN; if (L >= nwg) return false;
        int wgid = L; { const int q = nwg / 8, r = nwg % 8, xcd = wgid % 8, off = wgid / 8; wgid = (xcd < r ? xcd * (q + 1) : r * (q + 1) + (xcd - r) * q) + off; }
        const int nig = 8 * nN, gid = wgid / nig, fm = gid * 8, gsz = (nM - fm) < 8 ? (nM - fm) : 8;
        u.pm = fm + ((wgid % nig) % gsz); u.pn = (wgid % nig) / gsz; u.A = A; u.B = Bt + (size_t)u.pn * 256 * K * 2; u.aux = 0; return true;
    }
    __device__ __forceinline__ void a_ready(const pg8::Unit&) const {}
    __device__ __forceinline__ unsigned arow(const pg8::Unit& u, int r) const { return (unsigned)(u.pm * 256 + r); }
};
struct UpOrder {
    static constexpr bool GATHER = false;
    const char* A0; const char* A1; const char* B0; const char* B1; int G, c;
    __device__ __forceinline__ bool next(int i, pg8::Unit& u) const {
        const int tile = (i >> 1) * G + c; if (tile >= 256) return false;
        u.pm = tile >> 2; u.pn = tile & 3; u.aux = i & 1;
        u.A = (i & 1) ? A1 : A0; u.B = ((i & 1) ? B1 : B0) + (size_t)u.pn * 256 * 512 * 2; return true;
    }
    __device__ __forceinline__ void a_ready(const pg8::Unit&) const {}
    __device__ __forceinline__ unsigned arow(const pg8::Unit& u, int r) const { return (unsigned)(u.pm * 256 + r); }
};
struct MoeTab { int nt; int pad[3]; int tile_e[176]; int tile_m[176]; int cnt[32]; int tbase[33]; };
struct Moe1Order {
    static constexpr bool GATHER = true;
    const LAS MoeTab* tab; const char* A; const char* W; const int* toklist; int G, c;
    __device__ __forceinline__ bool next(int i, pg8::Unit& u) const {
        const int L = i * G + c; if (L >= tab->nt * 4) return false;
        const int ti = L >> 2; u.pm = ti; u.pn = L & 3; u.aux = ti; u.A = A;
        u.B = W + ((size_t)tab->tile_e[ti] * 1024 + (size_t)u.pn * 256) * 1024 * 2; return true;
    }
    __device__ __forceinline__ void a_ready(const pg8::Unit&) const {}
    __device__ __forceinline__ unsigned arow(const pg8::Unit& u, int r) const {
        const int e = tab->tile_e[u.aux], rr = tab->tile_m[u.aux] * 256 + r;
        return rr < tab->cnt[e] ? (unsigned)toklist[e * T + rr] : 0u;
    }
};
struct Moe2Order {
    static constexpr bool GATHER = false;
    const LAS MoeTab* tab; const char* A; const char* W; unsigned* done; unsigned* tmo; int G, c;
    __device__ __forceinline__ bool next(int i, pg8::Unit& u) const {
        const int n1 = tab->nt * 4, r = n1 % G, nl = G - r; int j;
        if (r > 0 && c >= r) { if (i < 2) j = (c - r) + i * nl; else j = 2 * nl + (c - r) + (i - 2) * G; }
        else j = (r > 0 ? 2 * nl : 0) + ((c - r + G) % G) + i * G;
        if (j >= n1) return false;
        const int ti = j >> 2; u.pm = ti; u.pn = j & 3; u.aux = ti; u.A = A;
        u.B = W + ((size_t)tab->tile_e[ti] * 1024 + (size_t)u.pn * 256) * 512 * 2; return true;
    }
    __device__ __forceinline__ unsigned arow(const pg8::Unit& u, int r) const { return (unsigned)(u.pm * 256 + r); }
    __device__ __forceinline__ void a_ready(const pg8::Unit& u) const {
        if (threadIdx.x < 64) {
            unsigned polls = 0;
            while ((unsigned)__builtin_amdgcn_readfirstlane(__hip_atomic_load(done + 16 * u.pm, __ATOMIC_RELAXED, __HIP_MEMORY_SCOPE_AGENT)) < 32u) {
                if (++polls > (1u << 22)) { if (threadIdx.x == 0) __hip_atomic_store(tmo, 1u, __ATOMIC_RELAXED, __HIP_MEMORY_SCOPE_AGENT); break; }
                __builtin_amdgcn_s_sleep(2); }
            __builtin_amdgcn_fence(__ATOMIC_ACQUIRE, "agent");
            asm volatile("s_waitcnt vmcnt(0)" ::: "memory");
        }
        asm volatile("" ::: "memory"); __builtin_amdgcn_s_barrier(); asm volatile("" ::: "memory");
    }
};

using pg8::Unit; using pg8::cvt_pk_bf16;
struct EpiStoreBf16 {
    static constexpr bool PERM = true;
    bf16_t* O; int ldc; int nscale; float scale0;
    __device__ __forceinline__ bool operator()(f32x4 (&acc)[2][2][4][2], const Unit& u, int wr, int wc, int fr, int fq) const {
        const int row0 = u.pm * 256 + wr * 64 + fr, col0 = u.pn * 256 + wc * 32 + 8 * fq;
        const float sc = u.pn < nscale ? scale0 : 1.0f;
#pragma unroll
        for (int ai = 0; ai < 2; ++ai)
#pragma unroll
            for (int m = 0; m < 4; ++m) { bf16_t* rowp = O + (size_t)(row0 + ai * 128 + m * 16) * ldc + col0;
#pragma unroll
                for (int bj = 0; bj < 2; ++bj) { const f32x4 v0 = acc[ai][bj][m][0] * sc, v1 = acc[ai][bj][m][1] * sc;
                    u32x4 w; w.x = cvt_pk_bf16(v0[0], v0[1]); w.y = cvt_pk_bf16(v0[2], v0[3]); w.z = cvt_pk_bf16(v1[0], v1[1]); w.w = cvt_pk_bf16(v1[2], v1[3]);
                    *(u32x4*)(rowp + bj * 128) = w; } }
        return false;
    }
};
template <int N> __device__ __forceinline__ float dpp_shr(float x) { return __builtin_bit_cast(float, __builtin_amdgcn_update_dpp(0, __builtin_bit_cast(int, x), 0x110 + N, 0xf, 0xf, true)); }
__device__ __forceinline__ float scan16(float x) { x += dpp_shr<1>(x); x += dpp_shr<2>(x); x += dpp_shr<4>(x); x += dpp_shr<8>(x); return x; }
struct EpiInProj {
    static constexpr bool PERM = true;
    bf16_t* O; bf16_t* KE; float* DEC; const float* lbv; float scale0;
    __device__ __forceinline__ bool operator()(f32x4 (&acc)[2][2][4][2], const Unit& u, int wr, int wc, int fr, int fq) const {
        { const int l_ = lane_now(); fr = l_ & 15; fq = l_ >> 4; }
        const int row0 = u.pm * 256 + wr * 64 + fr, col0 = u.pn * 256 + wc * 32 + 8 * fq;
        if (u.pn >= 6 && u.pn < 10) {
            const int h = u.pn - 6, lane = 16 * fq + fr, kb = wc * 32 + 8 * fq, bsrc = (lane & 48) | 15;
            const int bb = (u.pm * 256) / SEQ, ch0 = ((u.pm * 256) % SEQ + wr * 64) >> 6;
#pragma unroll
            for (int ai = 0; ai < 2; ++ai) {
                unsigned kep[4][4];
#pragma unroll
                for (int n = 0; n < 2; ++n) {
#pragma unroll
                    for (int ep = 0; ep < 2; ++ep) {
                        float ke2[2][4];
#pragma unroll
                        for (int z = 0; z < 2; ++z) {
                            const int e = 2 * ep + z; const float lb = lbv[h * 128 + kb + 4 * n + e];
                            float f[4], c[4], tot[4];
#pragma unroll
                            for (int m = 0; m < 4; ++m) { const float fl = acc[ai][1][m][n][e]; f[m] = lb + (1.0f - lb) * __builtin_amdgcn_rcpf(1.0f + __builtin_amdgcn_exp2f(-1.4426950408889634f * fl)); c[m] = scan16(__logf(f[m])); }
#pragma unroll
                            for (int m = 0; m < 4; ++m) tot[m] = __shfl(c[m], bsrc);
                            const float alast = (tot[0] + tot[1]) + (tot[2] + tot[3]);
                            float pre = 0.f;
#pragma unroll
                            for (int m = 0; m < 4; ++m) { const float A = c[m] + pre; pre += tot[m]; const float q = acc[ai][0][m][n][e]; const float kk = 1.0f - f[m];
                                acc[ai][0][m][n][e] = q * __builtin_amdgcn_rcpf(1.0f + __builtin_amdgcn_exp2f(-1.4426950408889634f * q)) * __expf(A);
                                acc[ai][1][m][n][e] = kk * __expf(-A); ke2[z][m] = kk * __expf(alast - A); }
                            if (fr == 0) DEC[((size_t)(bb * 4 + h) * 64 + ch0 + 2 * ai) * 128 + kb + 4 * n + e] = __expf(alast);
                        }
#pragma unroll
                        for (int m = 0; m < 4; ++m) kep[m][2 * n + ep] = cvt_pk_bf16(ke2[0][m], ke2[1][m]);
                        __builtin_amdgcn_sched_barrier(0);
                    }
                }
#pragma unroll
                for (int m = 0; m < 4; ++m) *(u32x4*)(KE + (size_t)(row0 + ai * 128 + m * 16) * 512 + h * 128 + kb) = (u32x4){kep[m][0], kep[m][1], kep[m][2], kep[m][3]};
            }
        }
        const float sc = u.pn < 2 ? scale0 : 1.0f;
#pragma unroll
        for (int ai = 0; ai < 2; ++ai)
#pragma unroll
            for (int m = 0; m < 4; ++m) { bf16_t* rowp = O + (size_t)(row0 + ai * 128 + m * 16) * INC + col0;
#pragma unroll
                for (int bj = 0; bj < 2; ++bj) { const f32x4 v0 = acc[ai][bj][m][0] * sc, v1 = acc[ai][bj][m][1] * sc;
                    u32x4 w; w.x = cvt_pk_bf16(v0[0], v0[1]); w.y = cvt_pk_bf16(v0[2], v0[3]); w.z = cvt_pk_bf16(v1[0], v1[1]); w.w = cvt_pk_bf16(v1[2], v1[3]);
                    *(u32x4*)(rowp + bj * 128) = w; } }
        return false;
    }
};
struct EpiUp {
    static constexpr bool PERM = true;
    const bf16_t* proj; bf16_t* O;
    __device__ __forceinline__ bool operator()(f32x4 (&acc)[2][2][4][2], const Unit& u, int wr, int wc, int fr, int fq) const {
        const int row0 = u.pm * 256 + wr * 64 + fr, col0 = u.pn * 256 + wc * 32 + 8 * fq;
#pragma unroll
        for (int ai = 0; ai < 2; ++ai)
#pragma unroll
            for (int m = 0; m < 4; ++m) { const size_t row = (size_t)(row0 + ai * 128 + m * 16);
#pragma unroll
                for (int bj = 0; bj < 2; ++bj) {
                    const int col = col0 + bj * 128;
                    const u32x4 gh = *(const u32x4*)(proj + row * INC + C_GHGATE + col);
                    float sh[8];
#pragma unroll
                    for (int j = 0; j < 4; ++j) { sh[2 * j] = 1.0f + __builtin_amdgcn_exp2f(-1.4426950408889634f * bf2f(gh[j] & 0xffffu)); sh[2 * j + 1] = 1.0f + __builtin_amdgcn_exp2f(-1.4426950408889634f * bf2f(gh[j] >> 16)); }
                    if (u.aux == 0) {
                        const u32x4 gd = *(const u32x4*)(proj + row * INC + C_GDA + col);
#pragma unroll
                        for (int j = 0; j < 4; ++j) {
                            const float d0 = 1.0f + __builtin_amdgcn_exp2f(-1.4426950408889634f * bf2f(gd[j] & 0xffffu)), d1 = 1.0f + __builtin_amdgcn_exp2f(-1.4426950408889634f * bf2f(gd[j] >> 16));
                            const float r0 = sh[2 * j] * __builtin_amdgcn_rcpf(d0), r1 = sh[2 * j + 1] * __builtin_amdgcn_rcpf(d1);
                            if (j < 2) { acc[ai][bj][m][0][2 * j] *= r0; acc[ai][bj][m][0][2 * j + 1] *= r1; }
                            else { acc[ai][bj][m][1][2 * j - 4] *= r0; acc[ai][bj][m][1][2 * j - 3] *= r1; }
                        }
                    } else {
                        const f32x4 v0 = acc[ai][bj][m][0], v1 = acc[ai][bj][m][1];
#pragma unroll
                        for (int j = 0; j < 8; ++j) sh[j] = __builtin_amdgcn_rcpf(sh[j]);
                        u32x4 w; w.x = cvt_pk_bf16(v0[0] * sh[0], v0[1] * sh[1]); w.y = cvt_pk_bf16(v0[2] * sh[2], v0[3] * sh[3]);
                        w.z = cvt_pk_bf16(v1[0] * sh[4], v1[1] * sh[5]); w.w = cvt_pk_bf16(v1[2] * sh[6], v1[3] * sh[7]);
                        *(u32x4*)(O + row * D + col) = w;
                    }
                } }
        return u.aux == 0;
    }
};
struct EpiOut {
    static constexpr bool PERM = false;
    const float* x; const float* mod; float* O;
    __device__ __forceinline__ bool operator()(f32x4 (&acc)[2][2][4][2], const Unit& u, int wr, int wc, int fr, int fq) const {
        const int row0 = u.pm * 256 + wr * 64 + fr, col0 = u.pn * 256 + wc * 32 + 4 * fq;
        const int b = (u.pm * 256) / SEQ;
        f32x4 gt[2][2];
#pragma unroll
        for (int bj = 0; bj < 2; ++bj)
#pragma unroll
            for (int n = 0; n < 2; ++n) gt[bj][n] = *(const f32x4*)(mod + b * 6144 + 2048 + col0 + bj * 128 + n * 16);
#pragma unroll
        for (int ai = 0; ai < 2; ++ai)
#pragma unroll
            for (int m = 0; m < 4; ++m) { const size_t off = (size_t)(row0 + ai * 128 + m * 16) * D + col0;
#pragma unroll
                for (int bj = 0; bj < 2; ++bj)
#pragma unroll
                    for (int n = 0; n < 2; ++n) { const f32x4 xv = *(const f32x4*)(x + off + bj * 128 + n * 16);
                        *(f32x4*)(O + off + bj * 128 + n * 16) = xv + gt[bj][n] * acc[ai][bj][m][n]; } }
        return false;
    }
};
struct EpiMoe1 {
    static constexpr bool PERM = true;
    bf16_t* O; unsigned* done;
    __device__ __forceinline__ bool operator()(f32x4 (&acc)[2][2][4][2], const Unit& u, int wr, int wc, int fr, int fq) const {
        const int row0 = u.pm * 256 + wr * 64 + fr, col0 = u.pn * 128 + wc * 32 + 8 * fq;
#pragma unroll
        for (int ai = 0; ai < 2; ++ai)
#pragma unroll
            for (int m = 0; m < 4; ++m) { bf16_t* rowp = O + (size_t)(row0 + ai * 128 + m * 16) * DEXP + col0;
                float h[8];
#pragma unroll
                for (int n = 0; n < 2; ++n)
#pragma unroll
                    for (int e = 0; e < 4; ++e) { const float x_ = acc[ai][0][m][n][e]; h[n * 4 + e] = x_ * __builtin_amdgcn_rcpf(1.0f + __builtin_amdgcn_exp2f(-1.4426950408889634f * x_)) * acc[ai][1][m][n][e]; }
                u32x4 w; w.x = cvt_pk_bf16(h[0], h[1]); w.y = cvt_pk_bf16(h[2], h[3]); w.z = cvt_pk_bf16(h[4], h[5]); w.w = cvt_pk_bf16(h[6], h[7]);
                asm volatile("global_store_dwordx4 %0, %1, off sc1\n\ts_nop 1" :: "v"(rowp), "v"(w) : "memory"); }
        asm volatile("s_waitcnt vmcnt(0)" ::: "memory");
        if ((threadIdx.x & 63) == 0) __hip_atomic_fetch_add(done + 16 * u.pm, 1u, __ATOMIC_RELAXED, __HIP_MEMORY_SCOPE_AGENT);
        return false;
    }
};

struct Frame { LAS unsigned char* lds; int tid, lane, wave, G, bid; };

__device__ __forceinline__ void transpose_item(const float* Wsrc, int ldw, bf16_t* dst, int ldd, LAS float* scr, int lane) {
#pragma unroll 8
    for (int i = 0; i < 32; ++i) { const int kk = 2 * i + (lane >> 5); scr[kk * 33 + (lane & 31)] = Wsrc[(size_t)kk * ldw + (lane & 31)]; }
    asm volatile("s_waitcnt lgkmcnt(0)" ::: "memory");
    const int c = lane & 7;
#pragma unroll
    for (int j = 0; j < 4; ++j) { const int n = (lane >> 3) + 8 * j; const LAS float* s = scr + (8 * c) * 33 + n;
        u32x4 o; o.x = pk2(s[0 * 33], s[1 * 33]); o.y = pk2(s[2 * 33], s[3 * 33]); o.z = pk2(s[4 * 33], s[5 * 33]); o.w = pk2(s[6 * 33], s[7 * 33]);
        *(u32x4*)(dst + (size_t)n * ldd + 8 * c) = o; }
    asm volatile("s_waitcnt lgkmcnt(0)" ::: "memory");
}
__device__ __forceinline__ void transpose_matrix(const Frame& F, const float* W, int K, int N, bf16_t* WT) {
    LAS float* scr = (LAS float*)(F.lds + F.wave * 8448);
    const int gw = F.bid * NWAVES + F.wave, NGW = F.G * NWAVES, nblk = N / 32, items = (K / 64) * nblk;
    for (int it = gw; it < items; it += NGW) { const int kb = it / nblk, nb = it % nblk;
        transpose_item(W + (size_t)(64 * kb) * N + 32 * nb, N, WT + (size_t)(32 * nb) * K + 64 * kb, K, scr, F.lane); }
}

__device__ __forceinline__ void phase0(const Frame& F, const Args& a) {
    unsigned char* ws = a.ws;
    {
        float* modp = (float*)(ws + WS_MODP);
        const float* c = a.in[I_C]; const float* wada = a.in[I_WADA];
        LAS float* cs = (LAS float*)(F.lds + 72 * 1024);
        for (int i = F.tid; i < 4 * D; i += NTHR) cs[i] = siluf_(c[i]);
        __syncthreads();
        for (int wt = F.bid + 256 * F.wave; wt < 384; wt += 256 * NWAVES) {
            if (F.G != 256) break;
            const int ks = wt / 24, jw = wt % 24, j = jw * 256 + F.lane * 4;
            f32x4 s[4] = {{0, 0, 0, 0}, {0, 0, 0, 0}, {0, 0, 0, 0}, {0, 0, 0, 0}};
#pragma unroll 8
            for (int k = ks * 64; k < ks * 64 + 64; ++k) {
                const f32x4 w = *(const f32x4*)(wada + (size_t)k * 6144 + j);
#pragma unroll
                for (int b = 0; b < 4; ++b) s[b] += w * cs[b * D + k];
            }
#pragma unroll
            for (int b = 0; b < 4; ++b) *(f32x4*)(modp + ((size_t)ks * 4 + b) * 6144 + j) = s[b];
        }
        if (F.G != 256) {
            const int gw = F.bid * NWAVES + F.wave, NGW = F.G * NWAVES;
            for (int wt = gw; wt < 384; wt += NGW) {
                const int ks = wt / 24, jw = wt % 24, j = jw * 256 + F.lane * 4;
                f32x4 s[4] = {{0, 0, 0, 0}, {0, 0, 0, 0}, {0, 0, 0, 0}, {0, 0, 0, 0}};
                for (int k = ks * 64; k < ks * 64 + 64; ++k) {
                    const f32x4 w = *(const f32x4*)(wada + (size_t)k * 6144 + j);
#pragma unroll
                    for (int b = 0; b < 4; ++b) { const float cv = siluf_(c[b * D + k]); s[b] += w * cv; }
                }
#pragma unroll
                for (int b = 0; b < 4; ++b) *(f32x4*)(modp + ((size_t)ks * 4 + b) * 6144 + j) = s[b];
            }
        }
    }
    {
        LAS float* scr = (LAS float*)(F.lds + F.wave * 8448);
        const int gw = F.bid * NWAVES + F.wave, NGW = F.G * NWAVES, nblk = INC / 32, items = (D / 64) * nblk;
        bf16_t* WT = (bf16_t*)(ws + WS_WIN);
        for (int it = gw; it < items; it += NGW) { const int kb = it / nblk, n0 = 32 * (it % nblk); int dr = n0;
            if (n0 >= C_QHG && n0 < C_FHG) dr = C_HGT + 256 * ((n0 - C_QHG) >> 7) + ((n0 - C_QHG) & 127);
            else if (n0 >= C_FHG && n0 < C_IHG) dr = C_HGT + 256 * ((n0 - C_FHG) >> 7) + 128 + ((n0 - C_FHG) & 127);
            transpose_item(a.in[I_WIN] + (size_t)(64 * kb) * INC + n0, INC, WT + (size_t)dr * D + 64 * kb, D, scr, F.lane); }
    }
    transpose_matrix(F, a.in[I_WUPDA], 512, D, (bf16_t*)(ws + WS_WUPDA));
    transpose_matrix(F, a.in[I_WUPHG], 512, D, (bf16_t*)(ws + WS_WUPHG));
    transpose_matrix(F, a.in[I_WOUT], D, D, (bf16_t*)(ws + WS_WOUT));
    if (F.bid == 0) {
        float* sm = (float*)(ws + WS_SMALL);
        if (F.tid == 0) {
            float s1 = 0.f, s2 = 0.f;
            for (int i = 0; i < 64; ++i) { s1 += a.in[I_LQ1][i] * a.in[I_LK1][i]; s2 += a.in[I_LQ2][i] * a.in[I_LK2][i]; }
            sm[0] = expf(s1) - expf(s2) + 0.2f;
        }
        { const float l0 = a.in[I_LBL][F.tid], l1 = a.in[I_LBL][512 + F.tid]; const float mx = fmaxf(l0, l1);
          const float e0 = expf(l0 - mx), e1 = expf(l1 - mx); sm[16 + F.tid] = e0 / (e0 + e1); }
    }
}
__device__ __forceinline__ void moe_weight_convert(const Frame& F, const Args& a) {
    LAS float* scr = (LAS float*)(F.lds + F.wave * 8448);
    const int gw = F.bid * NWAVES + F.wave, NGW = F.G * NWAVES;
    bf16_t* w13 = (bf16_t*)(a.ws + WS_W13); bf16_t* w2t = (bf16_t*)(a.ws + WS_W2);
    for (int it = gw; it < 2 * NEXP * 256; it += NGW) {
        const int which = it / (NEXP * 256), r = it % (NEXP * 256), e = r >> 8, kb = (r >> 4) & 15, nb = r & 15, n0 = 32 * nb;
        const float* W = a.in[which ? I_W3 : I_W1] + (size_t)e * 1024 * 512;
        const int drow = 256 * (n0 >> 7) + (which ? 128 : 0) + (n0 & 127);
        transpose_item(W + (size_t)(64 * kb) * 512 + n0, 512, w13 + ((size_t)e * 1024 + drow) * 1024 + 64 * kb, 1024, scr, F.lane);
    }
    for (int it = gw; it < NEXP * 256; it += NGW) {
        const int e = it >> 8, kb = (it >> 5) & 7, nb = it & 31;
        const float* W = a.in[I_W2] + (size_t)e * 512 * 1024;
        transpose_item(W + (size_t)(64 * kb) * 1024 + 32 * nb, 1024, w2t + ((size_t)e * 1024 + 32 * nb) * 512 + 64 * kb, 512, scr, F.lane);
    }
}

__device__ __forceinline__ void phase1(const Frame& F, const Args& a) {
    const float* modp = (const float*)(a.ws + WS_MODP); float* mod = (float*)(a.ws + WS_MOD);
    for (int i = F.bid * NTHR + F.tid; i < 4 * 6144; i += F.G * NTHR) {
        float s = a.in[I_BADA][i % 6144];
        for (int ks = 0; ks < 16; ++ks) s += modp[(size_t)ks * 4 * 6144 + i];
        mod[i] = s;
    }
    LAS float* Gs = (LAS float*)F.lds;
    LAS float* Ss = Gs + 1024;
    bf16_t* H = (bf16_t*)(a.ws + WS_ACT);
    const int rows_per_blk = T / F.G;
    const int r0 = F.bid * rows_per_blk, b = r0 / SEQ;
    for (int k = F.tid; k < 1024; k += NTHR) {
        float sh = a.in[I_BADA][k], sc = a.in[I_BADA][1024 + k];
        for (int ks = 0; ks < 16; ++ks) { sh += modp[((size_t)ks * 4 + b) * 6144 + k]; sc += modp[((size_t)ks * 4 + b) * 6144 + 1024 + k]; }
        Gs[k] = a.in[I_N1G][k] * (1.0f + sc); Ss[k] = sh;
    }
    __syncthreads();
    for (int r = r0 + F.wave; r < r0 + rows_per_blk; r += NWAVES) {
        const f32x4* xr = (const f32x4*)(a.in[I_X] + (size_t)r * D) + F.lane;
        f32x4 v[4]; float s = 0.f;
#pragma unroll
        for (int j = 0; j < 4; ++j) { v[j] = xr[64 * j]; s += (v[j].x * v[j].x + v[j].y * v[j].y) + (v[j].z * v[j].z + v[j].w * v[j].w); }
        const float rs = rsqrtf(wave_sum(s) * (1.0f / D) + EPS);
        unsigned long long* o8 = (unsigned long long*)(H + (size_t)r * D) + F.lane;
#pragma unroll
        for (int j = 0; j < 4; ++j) { const f32x4 g = *(const LAS f32x4*)(Gs + 256 * j + 4 * F.lane), sh = *(const LAS f32x4*)(Ss + 256 * j + 4 * F.lane);
            const f32x4 h = v[j] * rs * g + sh;
            o8[64 * j] = (unsigned long long)pk2(h.x, h.y) | ((unsigned long long)pk2(h.z, h.w) << 32); }
    }
}

namespace attn_body {
using s16x4=__attribute__((ext_vector_type(4)))short;
using f32x16=__attribute__((ext_vector_type(16)))float;
constexpr int NW=8,QBLK=32,QB=QBLK*NW,KVBLK=64,NQB=SEQ/QB;
constexpr int PIN=INC, POUT=1024;
__device__ __forceinline__ int crow(int r,int hi){return (r&3)+8*(r>>2)+4*hi;}
#define SBAR() __builtin_amdgcn_sched_barrier(0)
__device__ __forceinline__ void bmask(f32x16&p0,f32x16&p1,int jb,int wch,int il,int hi,float s2x2){
  if(jb>wch){
    #pragma unroll
    for(int r=0;r<16;++r){p0[r]=-INFINITY;p1[r]=-INFINITY;}
  } else if(jb==wch){
    float fb=(float)(4*hi-il); asm volatile("":"+v"(fb));
    #pragma unroll
    for(int r=0;r<16;++r){const float c=(float)((r&3)+8*(r>>2)); p0[r]-=s2x2*__builtin_fmaxf(fb+c,0.f); p1[r]-=s2x2*__builtin_fmaxf(fb+(c+32.f),0.f);}
  }
}
constexpr int NSLOT=3, SLOTB=8192, VSLOTB=16384;
constexpr int LDS_K=0, LDS_V=NSLOT*SLOTB, LDS_WS=LDS_V+NSLOT*VSLOTB, LDS_OST=LDS_WS+NW*64*4, ATT_LDS_BYTES=LDS_OST+NW*8192;
constexpr float C2=0.125f*1.4426950408889634f;
__device__ __forceinline__ void glds16(const void*gsrc,unsigned lds_dst){unsigned keep;
  asm volatile("s_mov_b32 %0, m0\n\ts_mov_b32 m0, %2\n\ts_nop 0\n\tglobal_load_lds_dwordx4 %1, off\n\ts_mov_b32 m0, %0":"=&s"(keep):"v"(gsrc),"s"(lds_dst):"memory");}
__device__ __forceinline__ float max3f(float a,float b,float c){float r;asm("v_max3_f32 %0, %1, %2, %3":"=v"(r):"v"(a),"v"(b),"v"(c));return r;}
__device__ __forceinline__ float max2f(float a,float b){float r;asm("v_max_f32_e32 %0, %1, %2":"=v"(r):"v"(a),"v"(b));return r;}
__device__ __forceinline__ float fadd_s(float a,float b){float r;asm("v_add_f32_e32 %0, %1, %2":"=v"(r):"v"(a),"v"(b));return r;}
__device__ __forceinline__ float fsub_s(float a,float b){float r;asm("v_sub_f32_e32 %0, %1, %2":"=v"(r):"v"(a),"v"(b));return r;}
typedef float f32x2_t __attribute__((ext_vector_type(2))); typedef __bf16 bf16x2_t __attribute__((ext_vector_type(2)));
__device__ __forceinline__ unsigned cvtpk_s(float lo,float hi){f32x2_t v={lo,hi};bf16x2_t b=__builtin_convertvector(v,bf16x2_t);return __builtin_bit_cast(unsigned,b);}
#define WAIT_BAR(N) asm volatile("s_waitcnt vmcnt(" #N ") lgkmcnt(0)\n\ts_barrier":::"memory")

__device__ __forceinline__ void qkt(f32x16&p0,f32x16&p1,const char*Kslot,const bf16x8*qr,const f32x16&c0,const f32x16&c1,int r32,int hi){
  const char*kb=Kslot+hi*1024+r32*16;
  #pragma unroll
  for(int d0=0;d0<4;++d0){
    const bf16x8 b0=*reinterpret_cast<const bf16x8*>(kb+d0*2048);
    const bf16x8 b1=*reinterpret_cast<const bf16x8*>(kb+d0*2048+512);
    if(d0==0){p0=__builtin_amdgcn_mfma_f32_32x32x16_bf16(b0,qr[0],c0,0,0,0);p1=__builtin_amdgcn_mfma_f32_32x32x16_bf16(b1,qr[0],c1,0,0,0);}
    else{p0=__builtin_amdgcn_mfma_f32_32x32x16_bf16(b0,qr[d0],p0,0,0,0);p1=__builtin_amdgcn_mfma_f32_32x32x16_bf16(b1,qr[d0],p1,0,0,0);}}
}
typedef __attribute__((address_space(3))) const char* lds_cptr;
typedef short v4i16_t __attribute__((ext_vector_type(4)));
__device__ __forceinline__ void kload8(bf16x8*kf,lds_cptr kp){
  kf[0]=*(const __attribute__((address_space(3))) bf16x8*)(kp);      kf[1]=*(const __attribute__((address_space(3))) bf16x8*)(kp+512);
  kf[2]=*(const __attribute__((address_space(3))) bf16x8*)(kp+2048); kf[3]=*(const __attribute__((address_space(3))) bf16x8*)(kp+2560);
  kf[4]=*(const __attribute__((address_space(3))) bf16x8*)(kp+4096); kf[5]=*(const __attribute__((address_space(3))) bf16x8*)(kp+4608);
  kf[6]=*(const __attribute__((address_space(3))) bf16x8*)(kp+6144); kf[7]=*(const __attribute__((address_space(3))) bf16x8*)(kp+6656);
}
__device__ __forceinline__ void kload2(bf16x8*kf,lds_cptr kp,int j){ kf[2*j]=*(const __attribute__((address_space(3))) bf16x8*)(kp+j*2048); kf[2*j+1]=*(const __attribute__((address_space(3))) bf16x8*)(kp+j*2048+512); }
__device__ __forceinline__ s16x4 vtr(lds_cptr p){ return __builtin_bit_cast(s16x4,__builtin_amdgcn_ds_read_tr16_b64_v4i16((__attribute__((address_space(3))) v4i16_t*)p)); }
__device__ __forceinline__ float rowmax(const f32x16&p0,const f32x16&p1){
  float a=max3f(p0[0],p0[1],p1[0]),b=max3f(p0[2],p0[3],p1[1]);a=max3f(a,p1[2],p1[3]);
  #pragma unroll
  for(int r=4;r<16;r+=4){a=max3f(a,p0[r],p0[r+1]);b=max3f(b,p0[r+2],p0[r+3]);a=max3f(a,p1[r],p1[r+1]);b=max3f(b,p1[r+2],p1[r+3]);}
  const float m=max2f(a,b);
  auto rr=__builtin_amdgcn_permlane32_swap(__float_as_uint(m),__float_as_uint(m),false,false);
  return max2f(__uint_as_float(rr[0]),__uint_as_float(rr[1]));
}
__device__ __forceinline__ void pv(f32x16*o,int vb,bf16x8 pa0,bf16x8 pa1,bf16x8 pa2,bf16x8 pa3){
  #pragma unroll
  for(int d0=0;d0<4;++d0){s16x4 lo[4],hi[4];
    #pragma unroll
    for(int ks=0;ks<4;++ks){
      asm volatile("ds_read_b64_tr_b16 %0,%1 offset:%c2":"=&v"(lo[ks]):"v"(vb),"i"(d0*4096+ks*1024):"memory");
      asm volatile("ds_read_b64_tr_b16 %0,%1 offset:%c2":"=&v"(hi[ks]):"v"(vb),"i"(d0*4096+ks*1024+512):"memory");}
    asm volatile("s_waitcnt lgkmcnt(0)":::"memory");SBAR();
    #define PK(k) (bf16x8){lo[k][0],lo[k][1],lo[k][2],lo[k][3],hi[k][0],hi[k][1],hi[k][2],hi[k][3]}
    o[d0]=__builtin_amdgcn_mfma_f32_32x32x16_bf16(pa0,PK(0),o[d0],0,0,0);
    o[d0]=__builtin_amdgcn_mfma_f32_32x32x16_bf16(pa1,PK(1),o[d0],0,0,0);
    o[d0]=__builtin_amdgcn_mfma_f32_32x32x16_bf16(pa2,PK(2),o[d0],0,0,0);
    o[d0]=__builtin_amdgcn_mfma_f32_32x32x16_bf16(pa3,PK(3),o[d0],0,0,0);
    #undef PK
  }
}
#define ATTN_STORE16(p,v) (*(u32x4*)(p)=(v))
template<int THRL> __device__ __forceinline__ void attn_unit(int qb,const bf16_t*Qb,const bf16_t*__restrict__ Kh,const bf16_t*__restrict__ Vh,bf16_t*Ob,float slope2,char*shm){
  const int wid=__builtin_amdgcn_readfirstlane(threadIdx.x>>6); const int lane=lane_now(),r32=lane&31,hi=lane>>5;
  const int q0=qb*QB;
  const bf16_t*Qw=Qb+(long)(q0+wid*QBLK)*PIN;
  const unsigned lds0=(unsigned)(uintptr_t)shm;
  float*wsf=(float*)(shm+LDS_WS)+wid*64;
  const bf16_t*ksrc=Kh+(long)lane*PIN+wid*8;
  const bf16_t*vsrc=Vh+(long)(16*(wid&3)+(lane>>2))*PIN+(wid>>2)*32+(lane&3)*8;
  const unsigned kdst=lds0+LDS_K+wid*1024, vdst=lds0+LDS_V+(wid>>2)*4096+(wid&3)*1024;
  #define DMA_K(t,slot) glds16(ksrc+(long)(t)*KVBLK*PIN,(unsigned)__builtin_amdgcn_readfirstlane(kdst+(slot)))
  #define DMA_V(t,slot) do{ glds16(vsrc+(long)(t)*KVBLK*PIN,(unsigned)__builtin_amdgcn_readfirstlane(vdst+2*(slot))); glds16(vsrc+(long)(t)*KVBLK*PIN+64,(unsigned)__builtin_amdgcn_readfirstlane(vdst+2*(slot)+8192)); }while(0)
  const int vb0=(int)(lds0+LDS_V)+((lane>>4)&1)*32+(lane&3)*8+(4*hi+((lane&15)>>2))*64;
  const char*Kbase=shm+LDS_K; bf16x8 kf[8];
  const lds_cptr shm3=(lds_cptr)shm; const lds_cptr kp0=shm3+LDS_K+hi*1024+r32*16; const lds_cptr vp0=shm3+LDS_V+((lane>>4)&1)*32+(lane&3)*8+(4*hi+((lane&15)>>2))*64;
  const int NT=(q0+QB)/KVBLK;
  DMA_K(0,0);DMA_V(0,0);DMA_K(1,SLOTB);
  bf16x8 qr[4];
  #pragma unroll
  for(int d0=0;d0<4;++d0)qr[d0]=*reinterpret_cast<const bf16x8*>(&Qw[(long)r32*PIN+d0*16+hi*8]);
  float mhat=0.f,l_reg=0.f;f32x16 o[4];o[0]=f32x16{};o[1]=f32x16{};o[2]=f32x16{};o[3]=f32x16{};
  const float s64=slope2*64.f, s32=slope2*32.f, s2x2=2.f*slope2, s4hi=slope2*4.f*(float)hi;
  const int wch=wid>>1, il=32*(wid&1)+r32;
  #define CMASK(P0,P1,t) do{int jb_=(t)-(NT-4); if(jb_>=0)bmask(P0,P1,jb_,wch,il,hi,s2x2);}while(0)
  #define CINIT0(C0,t) do{ const float bt_=s64*(float)((t)-NT)-mhat+s4hi; _Pragma("unroll") for(int r=0;r<16;++r){C0[r]=__builtin_fmaf(slope2,(float)((r&3)+8*(r>>2)),bt_);} }while(0)
  #define CINIT1(C1,t) do{ const float bu_=s64*(float)((t)-NT)-mhat+s4hi+s32; _Pragma("unroll") for(int r=0;r<16;++r){C1[r]=__builtin_fmaf(slope2,(float)((r&3)+8*(r>>2)),bu_);} }while(0)
  bool resc=false;
  #define START(P0,P1) do{ const float rm=rowmax(P0,P1); resc=false; \
    { const float dl=rm; mhat=fadd_s(mhat,dl); \
      _Pragma("unroll") for(int r=0;r<16;++r){P0[r]=fsub_s(P0[r],dl);P1[r]=fsub_s(P1[r],dl);} } \
    _Pragma("unroll") for(int r=0;r<16;++r)P0[r]=__builtin_amdgcn_exp2f(P0[r]); }while(0)
  #define RESC() do{ if(resc){ asm volatile("s_waitcnt lgkmcnt(0)":::"memory"); \
      _Pragma("unroll") for(int d_=0;d_<4;++d_) _Pragma("unroll") for(int r=0;r<16;++r)o[d_][r]*=wsf[crow(r,hi)]; } }while(0)
  f32x16 cS0,cS1;
  u32x4 pwa0,pwa1,pwa2,pwa3,pwb0,pwb1,pwb2,pwb3;
  int sl_prev=0,sl_cur=0,sl_next=SLOTB;
  #define ROT() do{sl_prev=sl_cur;sl_cur=sl_next;sl_next=(sl_next==(NSLOT-1)*SLOTB)?0:sl_next+SLOTB;}while(0)
  #define PKW(P,B) cvtpk_s(P[B],P[B+1])
  DMA_K(2,2*SLOTB);
  WAIT_BAR(3);
  { f32x16 c0,c1; CINIT0(c0,0); CINIT1(c1,0); qkt(cS0,cS1,Kbase,qr,c0,c1,r32,hi); }
  asm volatile("s_nop 15\n\ts_nop 7":"+v"(cS0),"+v"(cS1));CMASK(cS0,cS1,0);
  START(cS0,cS1);
  _Pragma("unroll") for(int r=0;r<16;++r)cS1[r]=__builtin_amdgcn_exp2f(cS1[r]);
  { float sacc=cS0[0]+cS0[1]; _Pragma("unroll") for(int r=2;r<16;++r)sacc+=cS0[r]; _Pragma("unroll") for(int r=0;r<16;++r)sacc+=cS1[r]; l_reg+=sacc;
    pwa0=(u32x4){PKW(cS0,0),PKW(cS0,2),PKW(cS0,4),PKW(cS0,6)};pwa1=(u32x4){PKW(cS0,8),PKW(cS0,10),PKW(cS0,12),PKW(cS0,14)};pwa2=(u32x4){PKW(cS1,0),PKW(cS1,2),PKW(cS1,4),PKW(cS1,6)};pwa3=(u32x4){PKW(cS1,8),PKW(cS1,10),PKW(cS1,12),PKW(cS1,14)}; }
  WAIT_BAR(0);
  DMA_K(3,0);DMA_V(1,SLOTB);
  ROT();
  kload8(kf,kp0+sl_cur);
  WAIT_BAR(3);
  s16x4 vlo[4],vhi[4];
  #define CAT_(a,b) a##b
  #define CAT(a,b) CAT_(a,b)
  #define PAFC(P,k) __builtin_bit_cast(bf16x8,CAT(P,k))
  #define VFR(k) (bf16x8){vlo[(k)&3][0],vlo[(k)&3][1],vlo[(k)&3][2],vlo[(k)&3][3],vhi[(k)&3][0],vhi[(k)&3][1],vhi[(k)&3][2],vhi[(k)&3][3]}
  #define VOFF(k) ((k)<8 ? (((k)&1)*4096+((k)>>1)*1024) : ((2+((k)&1))*4096+(((k)-8)>>1)*1024))
  #define PIN_(x) asm volatile("":"+v"(x))
  #define MX3(a,b,c) __builtin_fmaxf(__builtin_fmaxf((a),(b)),(c))
  #define QK(MF) do{ MF; SBAR(); }while(0)
  #define EX(v) __builtin_amdgcn_exp2f(v)
  #define VRD(k) do{ vlo[(k)&3]=vtr(vp_+VOFF(k)); vhi[(k)&3]=vtr(vp_+(VOFF(k)+512)); }while(0)
  #define VNX(k) do{ if((k)+4<16){ VRD((k)+4); } SBAR(); }while(0)
  #define GAPB3(MF,X,B,PW,J) do{ MF; X[B]=EX(X[B]); X[B+1]=EX(X[B+1]); sacc+=X[B]; sacc+=X[B+1]; PW[J]=cvtpk_s(X[B],X[B+1]); PIN_(X); PIN_(sacc); PIN_(PW); SBAR(); }while(0)
  #define KRD(G,j) do{ if(G){ kload2(kf,kp0+sl_next,j); SBAR(); } }while(0)
  #define STEP(PC,PN,t,GK,GV,GL) do{ SBAR(); \
    CINIT0(cS0,t); SBAR(); \
    const lds_cptr vp_=vp0+2*sl_prev; \
    VRD(0); SBAR(); QK(cS0=__builtin_amdgcn_mfma_f32_32x32x16_bf16(kf[0],qr[0],cS0,0,0,0)); \
    CINIT1(cS1,t); VRD(1); SBAR(); QK(cS1=__builtin_amdgcn_mfma_f32_32x32x16_bf16(kf[1],qr[0],cS1,0,0,0)); \
    VRD(2); SBAR(); QK(cS0=__builtin_amdgcn_mfma_f32_32x32x16_bf16(kf[2],qr[1],cS0,0,0,0)); \
    VRD(3); SBAR(); QK(cS1=__builtin_amdgcn_mfma_f32_32x32x16_bf16(kf[3],qr[1],cS1,0,0,0)); \
    QK(cS0=__builtin_amdgcn_mfma_f32_32x32x16_bf16(kf[4],qr[2],cS0,0,0,0)); \
    QK(cS1=__builtin_amdgcn_mfma_f32_32x32x16_bf16(kf[5],qr[2],cS1,0,0,0)); \
    QK(cS0=__builtin_amdgcn_mfma_f32_32x32x16_bf16(kf[6],qr[3],cS0,0,0,0)); \
    QK(cS1=__builtin_amdgcn_mfma_f32_32x32x16_bf16(kf[7],qr[3],cS1,0,0,0)); \
    if(GK){DMA_K((t)+3,sl_cur);} if(GV){DMA_V((t)+1,sl_next);} \
    CMASK(cS0,cS1,t); \
    { float a=MX3(cS0[0],cS0[1],cS1[0]),b=MX3(cS0[2],cS0[3],cS1[1]); a=MX3(a,cS1[2],cS1[3]); \
      _Pragma("unroll") for(int r=4;r<16;r+=4){a=MX3(a,cS0[r],cS0[r+1]);b=MX3(b,cS0[r+2],cS0[r+3]);a=MX3(a,cS1[r],cS1[r+1]);b=MX3(b,cS1[r+2],cS1[r+3]);} \
      float rm=__builtin_fmaxf(a,b); { auto rr=__builtin_amdgcn_permlane32_swap(__float_as_uint(rm),__float_as_uint(rm),false,false); rm=__builtin_fmaxf(__uint_as_float(rr[0]),__uint_as_float(rr[1])); } \
      resc=false; \
      if(__builtin_expect(__any(rm>(float)THRL),0)){ const float dl=__builtin_fmaxf(rm,0.f); mhat+=dl; \
        _Pragma("unroll") for(int r=0;r<16;++r){cS0[r]-=dl;cS1[r]-=dl;} \
        const float f=__builtin_amdgcn_exp2f(-dl); l_reg*=f; if(hi==0)wsf[r32]=f; resc=true; } } \
    SBAR(); float sacc=0.f; \
    GAPB3(o[0]=__builtin_amdgcn_mfma_f32_32x32x16_bf16(PAFC(PC,0),VFR(0),o[0],0,0,0), cS0,0, CAT(PN,0),0); VNX(0); \
    GAPB3(o[1]=__builtin_amdgcn_mfma_f32_32x32x16_bf16(PAFC(PC,0),VFR(1),o[1],0,0,0), cS0,2, CAT(PN,0),1); VNX(1); \
    KRD(GL,0); GAPB3(o[0]=__builtin_amdgcn_mfma_f32_32x32x16_bf16(PAFC(PC,1),VFR(2),o[0],0,0,0), cS0,4, CAT(PN,0),2); VNX(2); \
    KRD(GL,1); GAPB3(o[1]=__builtin_amdgcn_mfma_f32_32x32x16_bf16(PAFC(PC,1),VFR(3),o[1],0,0,0), cS0,6, CAT(PN,0),3); VNX(3); \
    KRD(GL,2); GAPB3(o[0]=__builtin_amdgcn_mfma_f32_32x32x16_bf16(PAFC(PC,2),VFR(4),o[0],0,0,0), cS0,8, CAT(PN,1),0); VNX(4); \
    KRD(GL,3); GAPB3(o[1]=__builtin_amdgcn_mfma_f32_32x32x16_bf16(PAFC(PC,2),VFR(5),o[1],0,0,0), cS0,10, CAT(PN,1),1); VNX(5); \
    GAPB3(o[0]=__builtin_amdgcn_mfma_f32_32x32x16_bf16(PAFC(PC,3),VFR(6),o[0],0,0,0), cS0,12, CAT(PN,1),2); VNX(6); \
    GAPB3(o[1]=__builtin_amdgcn_mfma_f32_32x32x16_bf16(PAFC(PC,3),VFR(7),o[1],0,0,0), cS0,14, CAT(PN,1),3); VNX(7); \
    GAPB3(o[2]=__builtin_amdgcn_mfma_f32_32x32x16_bf16(PAFC(PC,0),VFR(8),o[2],0,0,0), cS1,0, CAT(PN,2),0); VNX(8); \
    GAPB3(o[3]=__builtin_amdgcn_mfma_f32_32x32x16_bf16(PAFC(PC,0),VFR(9),o[3],0,0,0), cS1,2, CAT(PN,2),1); VNX(9); \
    GAPB3(o[2]=__builtin_amdgcn_mfma_f32_32x32x16_bf16(PAFC(PC,1),VFR(10),o[2],0,0,0), cS1,4, CAT(PN,2),2); VNX(10); \
    GAPB3(o[3]=__builtin_amdgcn_mfma_f32_32x32x16_bf16(PAFC(PC,1),VFR(11),o[3],0,0,0), cS1,6, CAT(PN,2),3); VNX(11); \
    GAPB3(o[2]=__builtin_amdgcn_mfma_f32_32x32x16_bf16(PAFC(PC,2),VFR(12),o[2],0,0,0), cS1,8, CAT(PN,3),0); VNX(12); \
    GAPB3(o[3]=__builtin_amdgcn_mfma_f32_32x32x16_bf16(PAFC(PC,2),VFR(13),o[3],0,0,0), cS1,10, CAT(PN,3),1); VNX(13); \
    GAPB3(o[2]=__builtin_amdgcn_mfma_f32_32x32x16_bf16(PAFC(PC,3),VFR(14),o[2],0,0,0), cS1,12, CAT(PN,3),2); VNX(14); \
    GAPB3(o[3]=__builtin_amdgcn_mfma_f32_32x32x16_bf16(PAFC(PC,3),VFR(15),o[3],0,0,0), cS1,14, CAT(PN,3),3); VNX(15); \
    l_reg+=sacc; \
    }while(0)
  int t=1;
  #undef CMASK
  #define CMASK(P0,P1,t) do{}while(0)
  for(;t+5<NT;t+=2){
    STEP(pwa,pwb,t,true,true,true);     WAIT_BAR(3); RESC(); ROT();
    STEP(pwb,pwa,t+1,true,true,true);   WAIT_BAR(3); RESC(); ROT();
  }
  #undef CMASK
  #define CMASK(P0,P1,t) do{int jb_=(t)-(NT-4); if(jb_>=0)bmask(P0,P1,jb_,wch,il,hi,s2x2);}while(0)
  #define ENDW(tt) do{ if((tt)+3<NT){WAIT_BAR(3);} else if((tt)+2<NT){WAIT_BAR(2);} else {WAIT_BAR(0);} }while(0)
  for(;t+1<NT;t+=2){
    STEP(pwa,pwb,t,(t+3<NT),(t+1<NT),(t+1<NT));       ENDW(t);   RESC(); ROT();
    STEP(pwb,pwa,t+1,(t+4<NT),(t+2<NT),(t+2<NT));     ENDW(t+1); RESC(); ROT();
  }
  STEP(pwa,pwb,NT-1,false,false,false); RESC();
  SBAR(); pv(o,vb0+2*sl_cur,PAFC(pwb,0),PAFC(pwb,1),PAFC(pwb,2),PAFC(pwb,3));
  #undef PKW
  #undef PAFC
  #undef CAT
  #undef CAT_
  #undef QK
  #undef GAPB3
  #undef VFR
  #undef PIN_
  #undef MX3
  #undef EX
  #undef VRD
  #undef VNX
  #undef VOFF
  #undef GAPB2
  #undef KRD
  #undef STEP
  #undef ENDW
  {auto rr=__builtin_amdgcn_permlane32_swap(__float_as_uint(l_reg),__float_as_uint(l_reg),false,false);l_reg=__uint_as_float(rr[0])+__uint_as_float(rr[1]);}
  {
    const int le=lane_now(), r32e=le&31, hie=le>>5;
    float*wsfe=(float*)(shm+LDS_WS)+wid*64;
    if(hie==0)wsfe[32+r32e]=l_reg;asm volatile("s_waitcnt lgkmcnt(0)":::"memory");
    float rli[16];
    #pragma unroll
    for(int r=0;r<16;++r)rli[r]=__builtin_amdgcn_rcpf(wsfe[32+crow(r,hie)]);
    bf16_t*Ow=Ob+(long)(q0+wid*QBLK)*POUT;
    bf16_t*stg=(bf16_t*)(shm+LDS_OST)+wid*4096;
    #pragma unroll
    for(int r=0;r<16;++r){const int orow=crow(r,hie);
      #pragma unroll
      for(int d0=0;d0<4;++d0)stg[orow*128+d0*32+r32e]=(bf16_t)f2bf(o[d0][r]*rli[r]);}
    asm volatile("s_waitcnt lgkmcnt(0)":::"memory");
    #pragma unroll
    for(int i=0;i<8;++i){const int row=i*4+(le>>4),ch=le&15; const u32x4 v=*(const u32x4*)(stg+row*128+ch*8); ATTN_STORE16(Ow+(long)row*POUT+ch*8,v);} }
  asm volatile("s_waitcnt lgkmcnt(0)\n\ts_barrier":::"memory");
  #undef DMA_K
  #undef DMA_V
  #undef CMASK
  #undef CINIT0
  #undef CINIT1
  #undef START
  #undef RESC
  #undef ROT
}
#undef SBAR
#undef WAIT_BAR
}

__device__ __forceinline__ void attn_phase(const Frame& F, const Args& a) {
    const bf16_t* proj = (const bf16_t*)(a.ws + WS_PROJ); bf16_t* OA = (bf16_t*)(a.ws + WS_OA);
    const int vcu = (F.G % 8 == 0) ? (F.bid % 8) * (F.G / 8) + F.bid / 8 : F.bid;
    for (int i = 0;; ++i) {
        int bhm, qb;
        if (F.G == 256) { if (i >= 2) break; const int s_ = vcu & 7; bhm = vcu >> 3; qb = (i == 0) ? 15 - s_ : s_; }
        else { const int u = i * F.G + F.bid; if (u >= 512) break; bhm = u >> 4; qb = 15 - (u & 15); }
        const int b = bhm >> 3, h = (bhm >> 1) & 3, map = bhm & 1;
        const bf16_t* base = proj + (size_t)b * SEQ * INC;
        const float slope2 = exp2f(-2.0f * (h + 1)) * 1.4426950408889634f;
        attn_body::attn_unit<8>(qb, base + C_QDA + h * 128 + map * 64, base + C_KDA + h * 128 + map * 64, base + C_VDA + h * 128,
                                OA + (size_t)b * SEQ * 1024 + h * 256 + map * 128, slope2, (char*)F.lds);
    }
}
__device__ __forceinline__ void attn_combine(const Frame& F, const Args& a) {
    const bf16_t* OA = (const bf16_t*)(a.ws + WS_OA); bf16_t* Y = (bf16_t*)(a.ws + WS_YDA);
    const float lam = ((const float*)(a.ws + WS_SMALL))[0];
    const float g0 = a.in[I_SUBG][2 * F.lane] * 0.8f, g1 = a.in[I_SUBG][2 * F.lane + 1] * 0.8f;
    const int gw = F.bid * NWAVES + F.wave, NGW = F.G * NWAVES;
    for (int r = gw; r < T; r += NGW) {
        const unsigned* orow = (const unsigned*)(OA + (size_t)r * 1024); unsigned* yrow = (unsigned*)(Y + (size_t)r * 512);
        unsigned w0[4], w1[4];
#pragma unroll
        for (int h = 0; h < 4; ++h) { w0[h] = orow[h * 128 + F.lane]; w1[h] = orow[h * 128 + 64 + F.lane]; }
#pragma unroll
        for (int h = 0; h < 4; ++h) {
            const float x0 = bf2f(w0[h] & 0xffffu) - lam * bf2f(w1[h] & 0xffffu), x1 = bf2f(w0[h] >> 16) - lam * bf2f(w1[h] >> 16);
            const float rs = rsqrtf(wave_sum(x0 * x0 + x1 * x1) * (1.0f / 128.0f) + EPS);
            yrow[h * 64 + F.lane] = pk2(x0 * rs * g0, x1 * rs * g1);
        }
    }
}
namespace hg {
constexpr int QP = 136;
constexpr int L_QD = 0, L_KD = 64 * QP * 2, L_V = 2 * 64 * QP * 2, L_KE = 3 * 64 * QP * 2, L_SSQ = 4 * 64 * QP * 2;
__device__ __forceinline__ f32x4 mfma16(bf16x8 a, bf16x8 b, f32x4 c) { return __builtin_amdgcn_mfma_f32_16x16x32_bf16(a, b, c, 0, 0, 0); }
#define HG_BAR() do { asm volatile("s_waitcnt lgkmcnt(0)" ::: "memory"); __builtin_amdgcn_s_barrier(); asm volatile("" ::: "memory"); } while (0)
typedef short v4i16_t __attribute__((ext_vector_type(4)));
__device__ __forceinline__ bf16x8 tr8(const LAS unsigned char* img, int ra, int rb, int col0, int lane) {
    const int q = (lane & 15) >> 2, p = lane & 3;
    const v4i16_t lo = __builtin_amdgcn_ds_read_tr16_b64_v4i16((LAS v4i16_t*)(img + ((ra + q) * QP + col0 + 4 * p) * 2));
    const v4i16_t hi = __builtin_amdgcn_ds_read_tr16_b64_v4i16((LAS v4i16_t*)(img + ((rb + q) * QP + col0 + 4 * p) * 2));
    return (bf16x8){lo[0], lo[1], lo[2], lo[3], hi[0], hi[1], hi[2], hi[3]};
}
struct Tile { u32x4 p[2]; };
__device__ __forceinline__ void tile_load(Tile& t, const bf16_t* src, size_t pitch, int tid) {
#pragma unroll
    for (int i = 0; i < 2; ++i) { const int pc = tid + NTHR * i; t.p[i] = *(const u32x4*)(src + (size_t)(pc >> 4) * pitch + (pc & 15) * 8); }
}
__device__ __forceinline__ void tile_put(const Tile& t, LAS unsigned char* img, int tid) {
#pragma unroll
    for (int i = 0; i < 2; ++i) { const int pc = tid + NTHR * i; *(LAS u32x4*)(img + ((pc >> 4) * QP + (pc & 15) * 8) * 2) = t.p[i]; }
}
struct In1 { Tile ke, v; };
__device__ __forceinline__ void load1(In1& r, const Frame& F, const Args& a, int unit) {
    const int bh = unit >> 6, n = unit & 63, b = bh >> 2, h = bh & 3; const size_t t0 = (size_t)b * SEQ + n * 64;
    tile_load(r.ke, (const bf16_t*)a.out + t0 * 512 + h * 128, 512, F.tid);
    tile_load(r.v, (const bf16_t*)(a.ws + WS_PROJ) + t0 * INC + C_IHG + h * 128, INC, F.tid);
}
__device__ __forceinline__ void stage1_unit(const In1& raw, const Frame& F, const Args& a, int unit) {
    const int bh = unit >> 6, n = unit & 63;
    tile_put(raw.ke, F.lds + L_KE, F.tid); tile_put(raw.v, F.lds + L_V, F.tid);
    HG_BAR();
    const int wk = F.wave >> 1, wv = F.wave & 1, fr = F.lane & 15, fq = F.lane >> 4;
    f32x4 acc[2][4];
#pragma unroll
    for (int i = 0; i < 2; ++i)
#pragma unroll
        for (int j = 0; j < 4; ++j) acc[i][j] = (f32x4){0.f, 0.f, 0.f, 0.f};
#pragma unroll
    for (int s2 = 0; s2 < 2; ++s2) {
        bf16x8 af[2], bv[4];
#pragma unroll
        for (int kt = 0; kt < 2; ++kt) af[kt] = tr8(F.lds + L_KE, 32 * s2 + 8 * fq, 32 * s2 + 8 * fq + 4, 32 * wk + 16 * kt, F.lane);
#pragma unroll
        for (int vt = 0; vt < 4; ++vt) bv[vt] = tr8(F.lds + L_V, 32 * s2 + 8 * fq, 32 * s2 + 8 * fq + 4, 64 * wv + 16 * vt, F.lane);
#pragma unroll
        for (int kt = 0; kt < 2; ++kt)
#pragma unroll
            for (int vt = 0; vt < 4; ++vt) acc[kt][vt] = mfma16(af[kt], bv[vt], acc[kt][vt]);
    }
    bf16_t* ds = (bf16_t*)(a.ws + WS_DS) + ((size_t)bh * 64 + n) * 16384;
#pragma unroll
    for (int kt = 0; kt < 2; ++kt)
#pragma unroll
        for (int vt = 0; vt < 4; ++vt) { const int v = 64 * wv + 16 * vt + fr, k = 32 * wk + 16 * kt + 4 * fq;
            u32x2 w; w.x = pk2(acc[kt][vt][0], acc[kt][vt][1]); w.y = pk2(acc[kt][vt][2], acc[kt][vt][3]); *(u32x2*)(ds + v * 128 + k) = w; }
    HG_BAR();
}
__device__ __forceinline__ void stage1_all(const Frame& F, const Args& a) {
    int u = F.bid; if (u >= 1024) return;
    In1 cur, nxt; load1(cur, F, a, u);
    for (; u < 1024; u += F.G) { const int un = (u + F.G < 1024) ? u + F.G : u; load1(nxt, F, a, un); stage1_unit(cur, F, a, u); cur = nxt; }
}
__device__ __forceinline__ void stage2_scan(const Frame& F, const Args& a) {
    unsigned* ds = (unsigned*)(a.ws + WS_DS); const float* dec = (const float*)(a.ws + WS_DEC);
    for (int gt = F.bid * NTHR + F.tid; gt < 16 * 8192; gt += F.G * NTHR) {
        const int bh = gt >> 13, e2 = gt & 8191, k = (2 * e2) & 127;
        unsigned* p = ds + (size_t)bh * 64 * 8192 + e2; const float* dp = dec + (size_t)bh * 64 * 128 + k;
        float s0 = 0.f, s1 = 0.f;
#pragma unroll 8
        for (int n = 0; n < 64; ++n) { const unsigned u = p[(size_t)n * 8192]; const f32x2 d = *(const f32x2*)(dp + n * 128);
            p[(size_t)n * 8192] = pk2(s0, s1); s0 = d.x * s0 + bf2f(u & 0xffffu); s1 = d.y * s1 + bf2f(u >> 16); }
    }
}
struct In3 { Tile qd, kd, v; };
__device__ __forceinline__ void load3(In3& r, const Frame& F, const Args& a, int unit) {
    const int bh = unit >> 6, n = unit & 63, b = bh >> 2, h = bh & 3;
    const bf16_t* base = (const bf16_t*)(a.ws + WS_PROJ) + ((size_t)b * SEQ + n * 64) * INC;
    tile_load(r.qd, base + C_HGT + 256 * h, INC, F.tid); tile_load(r.kd, base + C_HGT + 256 * h + 128, INC, F.tid); tile_load(r.v, base + C_IHG + h * 128, INC, F.tid);
}
__device__ __forceinline__ void stage3_unit(const In3& raw, const Frame& F, const Args& a, int unit) {
    const int bh = unit >> 6, n = unit & 63, b = bh >> 2, h = bh & 3;
    const int tb = F.wave >> 1, vh = F.wave & 1, fr = F.lane & 15, fq = F.lane >> 4;
    const bf16_t* sst = (const bf16_t*)(a.ws + WS_DS) + ((size_t)bh * 64 + n) * 16384;
    bf16x8 sb[4][4];
#pragma unroll
    for (int ks = 0; ks < 4; ++ks)
#pragma unroll
        for (int vt = 0; vt < 4; ++vt) sb[ks][vt] = *(const bf16x8*)(sst + (64 * vh + 16 * vt + fr) * 128 + 32 * ks + 8 * fq);
    const size_t t0 = (size_t)b * SEQ + n * 64 + 16 * tb + 4 * fq;
    const bf16_t* gp = (const bf16_t*)(a.ws + WS_PROJ) + t0 * INC + C_GHG + h * 128 + 64 * vh + fr;
    unsigned short gv[4][4];
#pragma unroll
    for (int r = 0; r < 4; ++r)
#pragma unroll
        for (int vt = 0; vt < 4; ++vt) gv[r][vt] = gp[(size_t)r * INC + 16 * vt];
    tile_put(raw.qd, F.lds + L_QD, F.tid); tile_put(raw.kd, F.lds + L_KD, F.tid); tile_put(raw.v, F.lds + L_V, F.tid);
    HG_BAR();
    bf16x8 qf[4];
#pragma unroll
    for (int ks = 0; ks < 4; ++ks) qf[ks] = *(const LAS bf16x8*)(F.lds + L_QD + ((16 * tb + fr) * QP + 32 * ks + 8 * fq) * 2);
    unsigned pk[4][2];
#pragma unroll
    for (int jt = 0; jt < 4; ++jt) { pk[jt][0] = 0u; pk[jt][1] = 0u;
        if (jt <= tb) { f32x4 sc = (f32x4){0.f, 0.f, 0.f, 0.f};
#pragma unroll
            for (int ks = 0; ks < 4; ++ks) { const bf16x8 kf = *(const LAS bf16x8*)(F.lds + L_KD + ((16 * jt + fr) * QP + 32 * ks + 8 * fq) * 2); sc = mfma16(kf, qf[ks], sc); }
            if (jt == tb) {
#pragma unroll
                for (int r = 0; r < 4; ++r) if (4 * fq + r > fr) sc[r] = 0.f;
            }
            pk[jt][0] = pk2(sc[0], sc[1]); pk[jt][1] = pk2(sc[2], sc[3]); } }
    f32x4 o[4];
#pragma unroll
    for (int vt = 0; vt < 4; ++vt) o[vt] = (f32x4){0.f, 0.f, 0.f, 0.f};
#pragma unroll
    for (int s2 = 0; s2 < 2; ++s2) if (2 * s2 <= tb) {
        const u32x4 aw = (u32x4){pk[2 * s2][0], pk[2 * s2][1], pk[2 * s2 + 1][0], pk[2 * s2 + 1][1]};
        const bf16x8 af = __builtin_bit_cast(bf16x8, aw);
#pragma unroll
        for (int vt = 0; vt < 4; ++vt) o[vt] = mfma16(af, tr8(F.lds + L_V, 32 * s2 + 4 * fq, 32 * s2 + 16 + 4 * fq, 64 * vh + 16 * vt, F.lane), o[vt]);
    }
#pragma unroll
    for (int ks = 0; ks < 4; ++ks)
#pragma unroll
        for (int vt = 0; vt < 4; ++vt) o[vt] = mfma16(qf[ks], sb[ks][vt], o[vt]);
    float ss[4];
#pragma unroll
    for (int r = 0; r < 4; ++r) { float v = 0.f;
#pragma unroll
        for (int vt = 0; vt < 4; ++vt) v += o[vt][r] * o[vt][r];
        v += __shfl_xor(v, 1); v += __shfl_xor(v, 2); v += __shfl_xor(v, 4); v += __shfl_xor(v, 8); ss[r] = v; }
    LAS float* SSQ = (LAS float*)(F.lds + L_SSQ);
    if (fr == 0) {
#pragma unroll
        for (int r = 0; r < 4; ++r) SSQ[(tb * 2 + vh) * 16 + 4 * fq + r] = ss[r]; }
    HG_BAR();
    bf16_t* yp = (bf16_t*)(a.ws + WS_YHG) + t0 * 512 + h * 128 + 64 * vh + fr;
#pragma unroll
    for (int r = 0; r < 4; ++r) { const float tot = SSQ[(tb * 2) * 16 + 4 * fq + r] + SSQ[(tb * 2 + 1) * 16 + 4 * fq + r]; const float rs = rsqrtf(tot * (1.0f / 128.0f) + EPS);
#pragma unroll
        for (int vt = 0; vt < 4; ++vt) { const float g = bf2f(gv[r][vt]); const float ng = a.in[I_HGNG][64 * vh + 16 * vt + fr];
            yp[(size_t)r * 512 + 16 * vt] = (bf16_t)f2bf(o[vt][r] * rs * ng * siluf_(g)); } }
    HG_BAR();
}
__device__ __forceinline__ void stage3_all(const Frame& F, const Args& a) {
    int u = F.bid; if (u >= 1024) return;
    In3 cur, nxt; load3(cur, F, a, u);
    for (; u < 1024; u += F.G) { const int un = (u + F.G < 1024) ? u + F.G : u; load3(nxt, F, a, un); stage3_unit(cur, F, a, u); cur = nxt; }
}
#undef HG_BAR
}

__device__ __forceinline__ float rs4(float a0, float a1, float a2, float a3, int lane) {
    const bool hi = (lane & 32) != 0;
    const float s0 = hi ? a0 : a2, s1 = hi ? a1 : a3;
    const float k0 = (hi ? a2 : a0) + __shfl_xor(s0, 32), k1 = (hi ? a3 : a1) + __shfl_xor(s1, 32);
    const bool b4 = (lane & 16) != 0;
    const float sd = b4 ? k0 : k1;
    float k = (b4 ? k1 : k0) + __shfl_xor(sd, 16);
    k += __shfl_xor(k, 8); k += __shfl_xor(k, 4); k += __shfl_xor(k, 2); k += __shfl_xor(k, 1);
    return k;
}
__device__ __forceinline__ void phase_router(const Frame& F, const Args& a) {
    constexpr int AP = 1032;
    LAS bf16_t* AH = (LAS bf16_t*)F.lds;
    LAS bf16_t* AL = AH + 16 * AP;
    LAS float* PART = (LAS float*)(F.lds + 2 * 16 * AP * 2);
    LAS float* LG = PART + 8 * 16 * 48;
    LAS unsigned* LH = (LAS unsigned*)(LG + 16 * 48);
    LAS unsigned* LB = LH + 32;
    LAS unsigned* LR = LH + 64;
    if (F.tid < NEXP) LH[F.tid] = 0u;
    const float* mod = (const float*)(a.ws + WS_MOD);
    const float* x1 = a.out; bf16_t* H2 = (bf16_t*)(a.ws + WS_ACT);
    unsigned* counts = (unsigned*)(a.ws + WS_CTL) + CW_COUNTS; unsigned* tokinfo = (unsigned*)(a.ws + WS_TOKINFO); int* toklist = (int*)(a.ws + WS_TOKLIST);
    const int rows_per_blk = T / F.G, r0 = F.bid * rows_per_blk, b = r0 / SEQ;
    const int lane = F.lane, w = F.wave, fr = lane & 15, fq = lane >> 4;
    f32x4 v[2][4], vn[2][4];
#define RT_LOAD(V, rb_) do { _Pragma("unroll") for (int q = 0; q < 2; ++q) { const f32x4* xr_ = (const f32x4*)(x1 + (size_t)((rb_) + 2 * w + q) * D) + lane; \
        _Pragma("unroll") for (int j = 0; j < 4; ++j) V[q][j] = xr_[64 * j]; } } while (0)
    RT_LOAD(v, r0);
    bf16x8 Bh[4][3], Bl[4][3];
    {
        const float* wre = a.in[I_WRE]; const float* wrg = a.in[I_WRG];
#pragma unroll
        for (int ks = 0; ks < 4; ++ks)
#pragma unroll
            for (int ct = 0; ct < 3; ++ct) {
                unsigned hw[4], lw[4];
#pragma unroll
                for (int jp = 0; jp < 4; ++jp) { float x[2];
#pragma unroll
                    for (int z = 0; z < 2; ++z) { const int k = 128 * w + 32 * ks + 8 * fq + 2 * jp + z;
                        if (ct == 0) { const float g = wrg[k * 4 + (fr & 3)], e = wre[k * 32 + ((fr + 28) & 31)]; x[z] = fr < 4 ? g : e; }
                        else if (ct == 1) x[z] = wre[k * 32 + 12 + fr];
                        else { const float e = wre[k * 32 + 28 + (fr & 3)]; x[z] = fr < 4 ? e : 0.f; } }
                    const unsigned h0 = f2bf(x[0]), h1 = f2bf(x[1]); hw[jp] = h0 | (h1 << 16);
                    lw[jp] = pk2(x[0] - bf2f(h0), x[1] - bf2f(h1)); }
                Bh[ks][ct] = __builtin_bit_cast(bf16x8, (u32x4){hw[0], hw[1], hw[2], hw[3]}); Bl[ks][ct] = __builtin_bit_cast(bf16x8, (u32x4){lw[0], lw[1], lw[2], lw[3]});
            }
    }
    for (int g = 0; g < rows_per_blk / 16; ++g) {
        const int rg = r0 + 16 * g;
        { const int gn = g + 1 < rows_per_blk / 16 ? g + 1 : g; RT_LOAD(vn, r0 + 16 * gn); }
#pragma unroll
        for (int q = 0; q < 2; ++q) { float sq = 0.f;
#pragma unroll
            for (int j = 0; j < 4; ++j) sq += (v[q][j].x * v[q][j].x + v[q][j].y * v[q][j].y) + (v[q][j].z * v[q][j].z + v[q][j].w * v[q][j].w);
            const float rs = rsqrtf(wave_sum(sq) * (1.0f / D) + EPS); const int row = 2 * w + q;
#pragma unroll
            for (int j = 0; j < 4; ++j) { const int k = 256 * j + 4 * lane;
                const f32x4 gg = *(const f32x4*)(a.in[I_N2G] + k) * (1.0f + *(const f32x4*)(mod + b * 6144 + 4 * 1024 + k)), sh = *(const f32x4*)(mod + b * 6144 + 3 * 1024 + k);
                const f32x4 hv = v[q][j] * rs * gg + sh;
                const unsigned h0 = f2bf(hv.x), h1 = f2bf(hv.y), h2_ = f2bf(hv.z), h3 = f2bf(hv.w);
                const u32x2 hw = (u32x2){h0 | (h1 << 16), h2_ | (h3 << 16)};
                *(u32x2*)(H2 + (size_t)(rg + row) * D + k) = hw;
                *(LAS u32x2*)(AH + row * AP + k) = hw;
                *(LAS u32x2*)(AL + row * AP + k) = (u32x2){pk2(hv.x - bf2f(h0), hv.y - bf2f(h1)), pk2(hv.z - bf2f(h2_), hv.w - bf2f(h3))}; } }
        __syncthreads();
        f32x4 acc[3] = {{0.f, 0.f, 0.f, 0.f}, {0.f, 0.f, 0.f, 0.f}, {0.f, 0.f, 0.f, 0.f}};
#pragma unroll
        for (int ks = 0; ks < 4; ++ks) { const bf16x8 ah = *(const LAS bf16x8*)(AH + fr * AP + 128 * w + 32 * ks + 8 * fq), al = *(const LAS bf16x8*)(AL + fr * AP + 128 * w + 32 * ks + 8 * fq);
#pragma unroll
            for (int ct = 0; ct < 3; ++ct) { acc[ct] = __builtin_amdgcn_mfma_f32_16x16x32_bf16(ah, Bh[ks][ct], acc[ct], 0, 0, 0);
                acc[ct] = __builtin_amdgcn_mfma_f32_16x16x32_bf16(al, Bh[ks][ct], acc[ct], 0, 0, 0); acc[ct] = __builtin_amdgcn_mfma_f32_16x16x32_bf16(ah, Bl[ks][ct], acc[ct], 0, 0, 0); } }
#pragma unroll
        for (int ct = 0; ct < 3; ++ct)
#pragma unroll
            for (int r = 0; r < 4; ++r) PART[(w * 16 + 4 * fq + r) * 48 + 16 * ct + fr] = acc[ct][r];
        __syncthreads();
        for (int t = F.tid; t < 16 * 48; t += NTHR) { const int row = t / 48, o = t % 48; float sacc = 0.f;
#pragma unroll
            for (int ww = 0; ww < 8; ++ww) sacc += PART[(ww * 16 + row) * 48 + o];
            if (o < 36) LG[row * 48 + o] = sacc + (o < 4 ? a.in[I_BRG][o & 3] : a.in[I_BRE][(o + 28) & 31]); }
        __syncthreads();
        if (F.tid < 16) {
            const LAS float* lg = LG + F.tid * 48;
            float gl[4]; int gi = 0;
#pragma unroll
            for (int o = 0; o < 4; ++o) gl[o] = lg[o];
            float gm = gl[0];
#pragma unroll
            for (int o = 1; o < 4; ++o) if (gl[o] > gm) { gm = gl[o]; gi = o; }
            float gsum = 0.f;
#pragma unroll
            for (int o = 0; o < 4; ++o) gsum += expf(gl[o] - gm);
            const float gp = 1.0f / gsum;
            float el[8];
#pragma unroll
            for (int e = 0; e < 8; ++e) el[e] = lg[4 + gi * 8 + e];
            int i0 = 0; float m0 = el[0];
#pragma unroll
            for (int o = 1; o < 8; ++o) if (el[o] > m0) { m0 = el[o]; i0 = o; }
            int i1 = -1; float m1 = -INFINITY;
#pragma unroll
            for (int o = 0; o < 8; ++o) if (o != i0 && el[o] > m1) { m1 = el[o]; i1 = o; }
            const float e1 = expf(m1 - m0); const float w0 = gp / (1.0f + e1), w1 = gp * e1 / (1.0f + e1);
            const int rl = 16 * g + F.tid, ex0 = gi * 8 + i0, ex1 = gi * 8 + i1;
            const unsigned l0 = atomicAdd((unsigned*)(LH + ex0), 1u), l1 = atomicAdd((unsigned*)(LH + ex1), 1u);
            LAS unsigned* ri = LR + rl * 6;
            ri[0] = (unsigned)ex0; ri[1] = l0; ri[2] = (unsigned)ex1; ri[3] = l1; ri[4] = __float_as_uint(w0); ri[5] = __float_as_uint(w1);
        }
#pragma unroll
        for (int q = 0; q < 2; ++q)
#pragma unroll
            for (int j = 0; j < 4; ++j) v[q][j] = vn[q][j];
    }
#undef RT_LOAD
    __syncthreads();
    if (F.tid < NEXP) LB[F.tid] = atomicAdd(counts + 64 * F.tid, LH[F.tid]);
    __syncthreads();
    for (int rl = F.tid; rl < rows_per_blk; rl += NTHR) {
        const LAS unsigned* ri = LR + rl * 6; const int r = r0 + rl;
        const unsigned ex0 = ri[0], ex1 = ri[2], k0 = LB[ex0] + ri[1], k1 = LB[ex1] + ri[3];
        toklist[ex0 * T + k0] = r; toklist[ex1 * T + k1] = r;
        u32x4 t0; t0.x = ex0; t0.y = k0; t0.z = ex1; t0.w = k1;
        *(u32x4*)(tokinfo + (size_t)r * 8) = t0;
        tokinfo[(size_t)r * 8 + 4] = ri[4]; tokinfo[(size_t)r * 8 + 5] = ri[5];
    }
}
__device__ __forceinline__ void build_moe_tab(const Frame& F, const Args& a, LAS MoeTab* tab) {
    if (F.tid == 0) {
        const unsigned* counts = (const unsigned*)(a.ws + WS_CTL) + CW_COUNTS; int nt = 0;
        for (int e = 0; e < NEXP; ++e) { const int c = (int)__hip_atomic_load(counts + 64 * e, __ATOMIC_RELAXED, __HIP_MEMORY_SCOPE_AGENT); tab->cnt[e] = c; tab->tbase[e] = nt;
            const int n = (c + 255) >> 8; for (int m = 0; m < n; ++m) { tab->tile_e[nt] = e; tab->tile_m[nt] = m; ++nt; } }
        tab->tbase[NEXP] = nt; tab->nt = nt;
    }
    __syncthreads();
}
__device__ __forceinline__ void phase_final(const Frame& F, const Args& a, const LAS MoeTab* tab) {
    const float* mod = (const float*)(a.ws + WS_MOD); const unsigned* tokinfo = (const unsigned*)(a.ws + WS_TOKINFO); const bf16_t* Ys = (const bf16_t*)(a.ws + WS_YS);
    const int rows_per_blk = T / F.G, r0 = F.bid * rows_per_blk;
    for (int r = r0 + F.wave; r < r0 + rows_per_blk; r += NWAVES) {
        const int b = r / SEQ;
        const u32x4 ti = *(const u32x4*)(tokinfo + (size_t)r * 8);
        const float w0 = __uint_as_float(tokinfo[(size_t)r * 8 + 4]), w1 = __uint_as_float(tokinfo[(size_t)r * 8 + 5]);
        const size_t s0 = (size_t)tab->tbase[ti.x] * 256 + ti.y, s1 = (size_t)tab->tbase[ti.z] * 256 + ti.w;
        f32x4* xr = (f32x4*)(a.out + (size_t)r * D) + F.lane;
        const u32x2* y0 = (const u32x2*)(Ys + s0 * D) + F.lane; const u32x2* y1 = (const u32x2*)(Ys + s1 * D) + F.lane;
        f32x4 v[4]; float s = 0.f;
#pragma unroll
        for (int j = 0; j < 4; ++j) { const int k = 256 * j + 4 * F.lane;
            const f32x4 gt = *(const f32x4*)(mod + b * 6144 + 5 * 1024 + k); const u32x2 a0 = y0[64 * j], a1 = y1[64 * j];
            f32x4 m; m.x = w0 * bf2f(a0.x & 0xffffu) + w1 * bf2f(a1.x & 0xffffu); m.y = w0 * bf2f(a0.x >> 16) + w1 * bf2f(a1.x >> 16);
            m.z = w0 * bf2f(a0.y & 0xffffu) + w1 * bf2f(a1.y & 0xffffu); m.w = w0 * bf2f(a0.y >> 16) + w1 * bf2f(a1.y >> 16);
            v[j] = xr[64 * j] + gt * m; s += (v[j].x * v[j].x + v[j].y * v[j].y) + (v[j].z * v[j].z + v[j].w * v[j].w); }
        const float rs = rsqrtf(wave_sum(s) * (1.0f / D) + EPS);
#pragma unroll
        for (int j = 0; j < 4; ++j) { const f32x4 g = *(const f32x4*)(a.in[I_FG] + 256 * j + 4 * F.lane); xr[64 * j] = v[j] * rs * g; }
    }
}

#define XB_TMO      128
#define XB_XCNT(j)  (256  + 64 * (j))
#define XB_XSUB(j)  (1280 + 64 * (j))
#define XB_XGEN(j)  (2304 + 64 * (j))
#define XB_TOP      3328
#define XB_TOPGEN   3392
#define XCD_BAR_WORDS 3456
#define XB_SPIN_CAP (1u << 18)
__device__ __forceinline__ unsigned xb_ld(unsigned* p)              { return __hip_atomic_load(p, __ATOMIC_RELAXED, __HIP_MEMORY_SCOPE_AGENT); }
__device__ __forceinline__ unsigned xb_add(unsigned* p, unsigned v) { return __hip_atomic_fetch_add(p, v, __ATOMIC_RELAXED, __HIP_MEMORY_SCOPE_AGENT); }
__device__ __forceinline__ unsigned xb_xcc_id() { return (unsigned)__builtin_amdgcn_s_getreg((3 << 11) | 20) & 0xFu; }
#define XB_SPIN(cond, bar) do { unsigned _sp = 0; while (cond) { __builtin_amdgcn_s_sleep(1); \
    if ((++_sp & 255u) == 0u) { if (xb_ld(&(bar)[XB_TMO])) break; if (_sp > XB_SPIN_CAP) { atomicAdd(&(bar)[XB_TMO], 1u); break; } } } } while (0)
struct XcdBarrier { unsigned* bar; unsigned x; volatile LAS unsigned* st; };
__device__ __forceinline__ XcdBarrier xcd_barrier_post(unsigned* bar, volatile LAS unsigned* st) {
    XcdBarrier b; b.bar = bar; b.x = xb_xcc_id(); b.st = st;
    if (threadIdx.x == 0) (void)xb_add(&bar[XB_XCNT(b.x)], 1u);
    return b;
}
__device__ __forceinline__ void xcd_barrier_complete(unsigned* bar, unsigned x, unsigned& nloc, unsigned& nx) {
    const unsigned G = gridDim.x * gridDim.y * gridDim.z;
    unsigned sum, cnt, mine, sp = 0u;
    for (;;) {
        sum = 0u; cnt = 0u; mine = 0u;
#pragma unroll
        for (unsigned j = 0; j < 16; ++j) { const unsigned c = xb_ld(&bar[XB_XCNT(j)]); sum += c; cnt += (c > 0u) ? 1u : 0u; mine = (j == x) ? c : mine; }
        if (sum == G) break;
        __builtin_amdgcn_s_sleep(1);
        if ((++sp & 255u) == 0u) { if (xb_ld(&bar[XB_TMO])) break; if (sp > XB_SPIN_CAP) { atomicAdd(&bar[XB_TMO], 1u); break; } }
    }
    nloc = mine > 0u ? mine : 1u; nx = cnt > 0u ? cnt : 1u;
}
__device__ __forceinline__ void xcd_barrier(const XcdBarrier& b) {
    asm volatile("s_waitcnt vmcnt(0)" ::: "memory");
    __syncthreads();
    if (threadIdx.x == 0) {
        unsigned* bar = b.bar;
        __builtin_amdgcn_s_waitcnt(0);
        unsigned nloc = b.st[0], nx = b.st[1];
        if (nloc == 0u) { xcd_barrier_complete(bar, b.x, nloc, nx); b.st[0] = nloc; b.st[1] = nx; }
        const unsigned old = xb_add(&bar[XB_XSUB(b.x)], 1u);
        const unsigned gen = old / nloc;
        if (old + 1u == (gen + 1u) * nloc) {
            __builtin_amdgcn_fence(__ATOMIC_RELEASE, "agent");
            asm volatile("s_waitcnt vmcnt(0)" ::: "memory");
            const unsigned og = xb_add(&bar[XB_TOP], 1u);
            const unsigned tg = og / nx;
            if (og + 1u == (tg + 1u) * nx) xb_add(&bar[XB_TOPGEN], 1u);
            else XB_SPIN(xb_ld(&bar[XB_TOPGEN]) == tg, bar);
            __builtin_amdgcn_fence(__ATOMIC_ACQUIRE, "agent");
            xb_add(&bar[XB_XGEN(b.x)], 1u);
            asm volatile("s_waitcnt vmcnt(0)" ::: "memory");
        } else {
            XB_SPIN(xb_ld(&bar[XB_XGEN(b.x)]) == gen, bar);
            __builtin_amdgcn_fence(__ATOMIC_ACQUIRE, "agent");
            asm volatile("s_waitcnt vmcnt(0)" ::: "memory");
        }
    }
    __syncthreads();
}

constexpr int N_PHASES = 11;
__global__ void __launch_bounds__(NTHR, 2) mk_fwd(Args a) {
    extern __shared__ __attribute__((aligned(16))) unsigned char lds_raw[];
    Frame F; F.lds = (LAS unsigned char*)lds_raw; F.tid = threadIdx.x; F.lane = F.tid & 63; F.wave = __builtin_amdgcn_readfirstlane(F.tid >> 6); F.G = gridDim.x; F.bid = blockIdx.x;
    unsigned char* ws = a.ws;
    const int lo = a.ph_lo, hi = a.ph_hi;
#if MK_N_LAUNCHES == 1
    volatile LAS unsigned* MISC = (volatile LAS unsigned*)(F.lds + 152 * 1024);
    if (F.tid < 4) MISC[F.tid] = 0u;
    __syncthreads();
    XcdBarrier xbar = xcd_barrier_post((unsigned*)(ws + WS_CTL) + CW_BAR, MISC);
#ifndef PROBE_TS
#define PROBE_TS -1
#endif
#define STAMP(k) do { if (PROBE_TS >= 0 && F.bid == 0 && F.tid == 0) { const unsigned long long t_ = __builtin_amdgcn_s_memrealtime(); MISC[16 + 2 * (k)] = (unsigned)t_; MISC[17 + 2 * (k)] = (unsigned)(t_ >> 32); } } while (0)
#define SEAM(k) do { if (IN(k) && IN((k) + 1)) xcd_barrier(xbar); STAMP((k) + 1); } while (0)
    STAMP(0);
#else
#define SEAM(k) do { } while (0)
#endif
#ifndef PHASE_MASK
#define PHASE_MASK 0x7ff
#endif
#define IN(k) (((PHASE_MASK >> (k)) & 1) && lo <= (k) && (k) < hi)
    LAS MoeTab* tab = (LAS MoeTab*)(F.lds + 144 * 1024);

#ifndef REPEAT_PHASE
#define REPEAT_PHASE -1
#endif
#if MK_N_LAUNCHES == 1
#define RUNPH(k, ...) if (IN(k)) { F.lane = lane_now(); F.tid = F.wave * 64 + F.lane; __VA_ARGS__ if (REPEAT_PHASE == (k)) { xcd_barrier(xbar); __VA_ARGS__ } }
#else
#define RUNPH(k, ...) if (IN(k)) { F.lane = lane_now(); F.tid = F.wave * 64 + F.lane; __VA_ARGS__ }
#endif
    RUNPH(0, { phase0(F, a); }) SEAM(0);
    RUNPH(1, { phase1(F, a); }) SEAM(1);
    RUNPH(2, {
        DenseOrder S{(const char*)(ws + WS_ACT), (const char*)(ws + WS_WIN), D, T / 256, INC / 256, F.G, F.bid};
        EpiInProj E{(bf16_t*)(ws + WS_PROJ), (bf16_t*)a.out, (float*)(ws + WS_DEC), (const float*)(ws + WS_SMALL) + 16, attn_body::C2};
        pg8::gemm_phase(F.lds, D, S, E);
    }) SEAM(2);
    RUNPH(3, {
        hg::stage1_all(F, a);
        __syncthreads();
        attn_phase(F, a);
    }) SEAM(3);
    RUNPH(4, { hg::stage2_scan(F, a); attn_combine(F, a); }) SEAM(4);
    RUNPH(5, { hg::stage3_all(F, a); }) SEAM(5);
    RUNPH(6, {
        UpOrder S{(const char*)(ws + WS_YDA), (const char*)(ws + WS_YHG), (const char*)(ws + WS_WUPDA), (const char*)(ws + WS_WUPHG), F.G, F.bid};
        EpiUp E{(const bf16_t*)(ws + WS_PROJ), (bf16_t*)(ws + WS_ACT)};
        pg8::gemm_phase(F.lds, 512, S, E);
    }) SEAM(6);
    RUNPH(7, {
        DenseOrder S{(const char*)(ws + WS_ACT), (const char*)(ws + WS_WOUT), D, T / 256, D / 256, F.G, F.bid};
        EpiOut E{a.in[I_X], (const float*)(ws + WS_MOD), a.out};
        pg8::gemm_phase(F.lds, D, S, E);
        moe_weight_convert(F, a);
    }) SEAM(7);
    RUNPH(8, { phase_router(F, a); __syncthreads(); }) SEAM(8);
    RUNPH(9, {
        build_moe_tab(F, a, tab);
        unsigned* done = (unsigned*)(ws + WS_CTL) + CW_TILE;
        { Moe1Order S{tab, (const char*)(ws + WS_ACT), (const char*)(ws + WS_W13), (const int*)(ws + WS_TOKLIST), F.G, F.bid};
          EpiMoe1 E{(bf16_t*)(ws + WS_HS), done};
          pg8::gemm_phase(F.lds, D, S, E); }
        { Moe2Order S{tab, (const char*)(ws + WS_HS), (const char*)(ws + WS_W2), done, (unsigned*)(ws + WS_CTL) + CW_TMO, F.G, F.bid};
          EpiStoreBf16 E{(bf16_t*)(ws + WS_YS), D, 0, 1.0f};
          pg8::gemm_phase(F.lds, DEXP, S, E); }
    }) SEAM(9);
    RUNPH(10, { build_moe_tab(F, a, tab); phase_final(F, a, tab); })
#if MK_N_LAUNCHES == 1
    if (PROBE_TS >= 0) {
        __syncthreads(); STAMP(11);
        if (F.bid == 0 && F.tid == 0) {
            const int ka = PROBE_TS & 15, kb = (PROBE_TS >> 4) & 15;
            const unsigned long long a0 = ((unsigned long long)MISC[17 + 2 * ka] << 32) | MISC[16 + 2 * ka], a1 = ((unsigned long long)MISC[19 + 2 * ka] << 32) | MISC[18 + 2 * ka];
            const unsigned long long b0 = ((unsigned long long)MISC[17 + 2 * kb] << 32) | MISC[16 + 2 * kb], b1 = ((unsigned long long)MISC[19 + 2 * kb] << 32) | MISC[18 + 2 * kb];
            const float da = (float)(a1 - a0) * 0.01f, db = (float)(b1 - b0) * 0.01f;
            asm volatile("s_waitcnt vmcnt(0)" ::: "memory");
            a.out[0] += sqrtf(da * 16.78f); a.out[1] += db * 0.1f;
        }
    }
#endif
#undef IN
#undef SEAM
}

extern "C" void kernel_launch(void* const* d_in, const int* in_sizes, int n_in, void* d_out, int out_size, void* d_ws, size_t ws_size, hipStream_t stream) {
    static int grid = 0;
    if (grid == 0) {
        if (n_in != 25 || in_sizes[0] != T * D || out_size != T * D || ws_size < WS_END) { fprintf(stderr, "kernel_launch: unexpected shapes (n_in %d, in0 %d, out %d, ws %zu)\n", n_in, n_in > 0 ? in_sizes[0] : -1, out_size, ws_size); grid = -1; return; }
        int dev = 0, cus = 0, per_cu = 0;
        if (hipGetDevice(&dev) != hipSuccess || hipDeviceGetAttribute(&cus, hipDeviceAttributeMultiprocessorCount, dev) != hipSuccess) { grid = -1; return; }
        if (hipFuncSetAttribute((const void*)mk_fwd, hipFuncAttributeMaxDynamicSharedMemorySize, LDS_BYTES) != hipSuccess) { fprintf(stderr, "kernel_launch: hipFuncSetAttribute failed\n"); grid = -1; return; }
        if (hipOccupancyMaxActiveBlocksPerMultiprocessor(&per_cu, (const void*)mk_fwd, NTHR, LDS_BYTES) != hipSuccess || per_cu < 1) { fprintf(stderr, "kernel_launch: occupancy query says %d\n", per_cu); per_cu = 1; }
        (void)hipGetLastError();
        grid = cus;
        if (grid > 256) grid = 256;
        while (T % grid) --grid;
    }
    if (grid < 0) return;
    (void)hipMemsetAsync((char*)d_ws + WS_CTL, 0, CTL_ZERO_BYTES, stream);
    Args a{};
    for (int i = 0; i < 25; ++i) a.in[i] = (const float*)d_in[i];
    a.out = (float*)d_out; a.ws = (unsigned char*)d_ws;
#if MK_N_LAUNCHES == 1
    a.ph_lo = 0; a.ph_hi = N_PHASES;
    void* args[] = {&a};
    hipError_t e = hipLaunchCooperativeKernel((const void*)mk_fwd, dim3(grid), dim3(NTHR), args, LDS_BYTES, stream);
    if (e != hipSuccess) fprintf(stderr, "cooperative launch failed: %s (grid %d)\n", hipGetErrorString(e), grid);
#else
    for (int p = 0; p < N_PHASES; ++p) {
        a.ph_lo = p; a.ph_hi = p + 1;
        hipLaunchKernelGGL(mk_fwd, dim3(grid), dim3(NTHR), LDS_BYTES, stream, a);
    }
#endif
}
```

```cpp
#include <hip/hip_runtime.h>
#include <hip/hip_cooperative_groups.h>
#include <cstdio>
#include <cstdint>
namespace cg = cooperative_groups;

#ifndef MK_N_LAUNCHES
#define MK_N_LAUNCHES 1
#endif

#define LAS __attribute__((address_space(3)))
typedef unsigned short bf16_t;
typedef short bf16x8 __attribute__((ext_vector_type(8)));
typedef float f32x4 __attribute__((ext_vector_type(4)));
typedef float f32x2 __attribute__((ext_vector_type(2)));
typedef unsigned u32x4 __attribute__((ext_vector_type(4)));
typedef unsigned u32x2 __attribute__((ext_vector_type(2)));

constexpr int NB = 4, SEQ = 4096, D = 1024, T = NB * SEQ;
constexpr int INC = 5632;
constexpr int C_QDA = 0, C_KDA = 512, C_VDA = 1024, C_QHG = 1536, C_FHG = 2048, C_IHG = 2560, C_GHG = 3072, C_GDA = 3584, C_GHGATE = 4608;
constexpr int C_HGT = 1536;
constexpr int NEXP = 32, DEXP = 512;
constexpr int PMAX = 40960;
constexpr float EPS = 1e-6f;
constexpr int NWAVES = 8, NTHR = 512;

constexpr size_t MiB = 1u << 20;
constexpr size_t WS_CTL = 0, CTL_ZERO_BYTES = 64 * 1024;
constexpr size_t WS_MODP = 1 * MiB;
constexpr size_t WS_MOD = 5 * MiB / 2;
constexpr size_t WS_SMALL = 11 * MiB / 4;
constexpr size_t WS_TOKINFO = 3 * MiB;
constexpr size_t WS_TOKLIST = 4 * MiB;
constexpr size_t WS_DEC = 6 * MiB;
constexpr size_t WS_DS = 24 * MiB;
constexpr size_t WS_WIN = 8 * MiB;
constexpr size_t WS_WUPDA = 20 * MiB, WS_WUPHG = 21 * MiB, WS_WOUT = 22 * MiB;
constexpr size_t WS_ACT = 24 * MiB;
constexpr size_t WS_PROJ = 56 * MiB;
constexpr size_t WS_YDA = 232 * MiB, WS_YHG = 248 * MiB;
constexpr size_t WS_OA = 264 * MiB;
constexpr size_t WS_W13 = 56 * MiB;
constexpr size_t WS_W2 = 120 * MiB;
constexpr size_t WS_HS = 152 * MiB;
constexpr size_t WS_YS = 192 * MiB;
constexpr size_t WS_END = 296 * MiB;
constexpr int CW_COUNTS = 64;
constexpr int CW_BAR = 4096;
constexpr int CW_TILE = 8192;
constexpr int CW_TMO = 32;

constexpr int LDS_BYTES = 160 * 1024;

__device__ __forceinline__ float bf2f(unsigned v) { return __uint_as_float(v << 16); }
__device__ __forceinline__ unsigned f2bf(float f) { unsigned u = __float_as_uint(f); return (u + 0x7fffu + ((u >> 16) & 1u)) >> 16; }
__device__ __forceinline__ unsigned pk2(float lo, float hi) { return f2bf(lo) | (f2bf(hi) << 16); }
__device__ __forceinline__ float sigmoidf_(float x) { return 1.0f / (1.0f + __expf(-x)); }
__device__ __forceinline__ float siluf_(float x) { return x / (1.0f + __expf(-x)); }
__device__ __forceinline__ int lane_now() { int l; asm volatile("v_mbcnt_lo_u32_b32 %0, -1, 0\n\tv_mbcnt_hi_u32_b32 %0, -1, %0" : "=v"(l)); return l; }
__device__ __forceinline__ float wave_sum(float v) {
#pragma unroll
    for (int o = 1; o < 64; o <<= 1) v += __shfl_xor(v, o);
    return v;
}

namespace pg8 {
constexpr int BM = 256, BK = 64, HALF = 128, HTB = HALF * BK * 2, STAGE_BYTES = 8 * HTB;
__host__ __device__ __forceinline__ int lds_byte(int r, int c) { const int st = (r >> 4) * 2 + (c >> 5), rr = r & 15, cc = c & 31, ob = rr * 64 + cc * 2; return st * 1024 + (ob ^ (((ob >> 9) & 1) << 5)); }
__host__ __device__ __forceinline__ void stage_rc(int b, int& R, int& C) { const int st = b / 1024, sb = b % 1024, swz = sb ^ (((sb >> 9) & 1) << 5); R = (st >> 1) * 16 + swz / 64; C = (st & 1) * 32 + (swz % 64) / 2; }
__host__ __device__ __forceinline__ int perm32(int rho) { const int n = rho >> 4, i = rho & 15; return 8 * (i >> 2) + 4 * n + (i & 3); }

struct Unit { int pm, pn; const char* A; const char* B; int aux; };
__device__ __forceinline__ unsigned cvt_pk_bf16(float lo, float hi) { unsigned r; asm volatile("v_cvt_pk_bf16_f32 %0, %1, %2" : "=v"(r) : "v"(lo), "v"(hi)); return r; }

template <class Epi, class Sched>
__device__ __forceinline__ void gemm_phase(LAS unsigned char* lds, const int K, const Sched& S, const Epi& E) {
    const int tid = threadIdx.x, wid = __builtin_amdgcn_readfirstlane(tid >> 6), lane = tid & 63, wr = wid >> 2, wc = wid & 3, fr = lane & 15, fq = lane >> 4;
    const int nt = K / BK;
    unsigned voffB[2];
#define PG8_SETLANE() do { const int _l = lane_now(), _t = wid * 64 + _l; _Pragma("unroll") for (int _i = 0; _i < 2; ++_i) { int _R, _C; stage_rc(_t * 16 + _i * 8192, _R, _C); \
        const int _Rb = Epi::PERM ? ((_R & ~31) + perm32(_R & 31)) : _R; voffB[_i] = (unsigned)(_Rb * K + _C) * 2u; } \
        aoff = lds_byte(wr * 64 + (_l & 15), (_l >> 4) * 8); boff = lds_byte(wc * 32 + (_l & 15), (_l >> 4) * 8); } while (0)
    const size_t kstep = (size_t)(BK * 2);
    const size_t hstep = (size_t)HALF * K * 2;
    const unsigned ldsw = (unsigned)wid * 1024u;
    int aoff, boff; PG8_SETLANE();
#define PG8_SA(b, h) (((b) * 2 + (h)) * HTB)
#define PG8_SB(b, h) ((4 + (b) * 2 + (h)) * HTB)
#define PG8_STAGE(bufoff, gbase, voff) do { _Pragma("unroll") for (int _i = 0; _i < 2; ++_i) \
        __builtin_amdgcn_global_load_lds((const unsigned*)((const char*)(gbase) + (voff)[_i]), (LAS unsigned*)(lds + (bufoff) + ldsw + _i * 8192), 16, 0, 0); } while (0)
#define PG8_LDA(dst, b, h) do { _Pragma("unroll") for (int m = 0; m < 4; ++m) _Pragma("unroll") for (int k = 0; k < 2; ++k) dst[m][k] = *(const LAS bf16x8*)(lds + PG8_SA(b, h) + aoff + m * 2048 + k * 1024); } while (0)
#define PG8_LDB(dst, b, h) do { _Pragma("unroll") for (int n = 0; n < 2; ++n) _Pragma("unroll") for (int k = 0; k < 2; ++k) dst[n][k] = *(const LAS bf16x8*)(lds + PG8_SB(b, h) + boff + n * 2048 + k * 1024); } while (0)
#define PG8_MMA(ai, bj, At, Bt) do { __builtin_amdgcn_s_setprio(1); _Pragma("unroll") for (int m = 0; m < 4; ++m) _Pragma("unroll") for (int n = 0; n < 2; ++n) _Pragma("unroll") for (int k = 0; k < 2; ++k) \
        acc[ai][bj][m][n] = __builtin_amdgcn_mfma_f32_16x16x32_bf16(Bt[n][k], At[m][k], acc[ai][bj][m][n], 0, 0, 0); __builtin_amdgcn_s_setprio(0); } while (0)
#define PG8_WAIT_V(n) asm volatile("s_waitcnt vmcnt(" #n ")" ::: "memory")
#define PG8_WAIT_L(n) asm volatile("s_waitcnt lgkmcnt(" #n ")" ::: "memory")
#define PG8_BAR __builtin_amdgcn_s_barrier()
#define PG8_SCHED __builtin_amdgcn_sched_barrier(0)
#define PG8_SETA(vo, u) do { const int _t = wid * 64 + lane_now(); _Pragma("unroll") for (int _i = 0; _i < 2; ++_i) { int _R, _C; stage_rc(_t * 16 + _i * 8192, _R, _C); \
        _Pragma("unroll") for (int _h = 0; _h < 2; ++_h) vo[_h][_i] = (unsigned)((size_t)S.arow(u, _h * HALF + _R) * (size_t)K + _C) * 2u; } if (Sched::GATHER) PG8_WAIT_V(0); } while (0)
    Unit cur, nxt; int ui = 0;
    if (!S.next(0, cur)) return;
    f32x4 acc[2][2][4][2];
#pragma unroll
    for (int a = 0; a < 2; ++a)
#pragma unroll
        for (int b = 0; b < 2; ++b)
#pragma unroll
            for (int m = 0; m < 4; ++m)
#pragma unroll
                for (int n = 0; n < 2; ++n) acc[a][b][m][n] = (f32x4){0.f, 0.f, 0.f, 0.f};
    bf16x8 At[4][2], B0[2][2], B1[2][2];
    unsigned voC[2][2], voN[2][2];
    S.a_ready(cur);
    PG8_SETA(voC, cur);
    const char* cA = cur.A; const char* cB = cur.B;
    PG8_STAGE(PG8_SB(0, 0), cB, voffB); PG8_STAGE(PG8_SB(0, 1), cB + hstep, voffB); PG8_STAGE(PG8_SA(0, 0), cA, voC[0]); PG8_STAGE(PG8_SA(0, 1), cA, voC[1]);
    if (wr == 1) PG8_BAR;
    PG8_WAIT_V(2); PG8_BAR;
    PG8_STAGE(PG8_SB(1, 0), cB + kstep, voffB); PG8_STAGE(PG8_SA(1, 0), cA + kstep, voC[0]); PG8_STAGE(PG8_SB(1, 1), cB + hstep + kstep, voffB);
    PG8_WAIT_V(6); PG8_BAR;
    for (;;) {
        const bool has_next = S.next(ui + 1, nxt);
        if (has_next) { PG8_SETA(voN, nxt); }
        else {
#pragma unroll
            for (int h = 0; h < 2; ++h)
#pragma unroll
                for (int i = 0; i < 2; ++i) voN[h][i] = voC[h][i];
        }
        const char* nA = has_next ? nxt.A : cA; const char* nB = has_next ? nxt.B : cB;
        for (int t = 0; t < nt; t += 2) {
            const bool last = (t == nt - 2);
            if (last && has_next) S.a_ready(nxt);
            const char* a1 = cA + (size_t)(t + 1) * kstep;
            const char* a2 = last ? nA : cA + (size_t)(t + 2) * kstep; const char* b2 = last ? nB : cB + (size_t)(t + 2) * kstep;
            const char* a3 = a2 + kstep; const char* b3 = b2 + kstep;
            unsigned vo2[2][2];
#pragma unroll
            for (int h = 0; h < 2; ++h)
#pragma unroll
                for (int i = 0; i < 2; ++i) vo2[h][i] = last ? voN[h][i] : voC[h][i];
            PG8_LDB(B0, 0, 0); PG8_LDB(B1, 0, 1); PG8_SCHED; PG8_LDA(At, 0, 0); PG8_STAGE(PG8_SA(1, 1), a1, voC[1]);
            PG8_WAIT_V(8); PG8_WAIT_L(0); PG8_BAR; PG8_MMA(0, 0, At, B0); PG8_MMA(0, 1, At, B1); PG8_BAR; PG8_SCHED;
            PG8_LDA(At, 0, 1); PG8_STAGE(PG8_SB(0, 0), b2, voffB); PG8_STAGE(PG8_SB(0, 1), b2 + hstep, voffB); PG8_STAGE(PG8_SA(0, 0), a2, vo2[0]);
            PG8_WAIT_V(8); PG8_WAIT_L(0); PG8_BAR; PG8_MMA(1, 0, At, B0); PG8_MMA(1, 1, At, B1); PG8_BAR; PG8_SCHED;
            PG8_LDB(B0, 1, 0); PG8_LDB(B1, 1, 1); PG8_SCHED; PG8_LDA(At, 1, 0); PG8_STAGE(PG8_SA(0, 1), a2, vo2[1]);
            PG8_WAIT_V(8); PG8_WAIT_L(0); PG8_BAR; PG8_MMA(0, 0, At, B0); PG8_MMA(0, 1, At, B1); PG8_BAR; PG8_SCHED;
            PG8_LDA(At, 1, 1); PG8_STAGE(PG8_SB(1, 0), b3, voffB); PG8_STAGE(PG8_SB(1, 1), b3 + hstep, voffB); PG8_STAGE(PG8_SA(1, 0), a3, vo2[0]);
            PG8_WAIT_V(8); PG8_WAIT_L(0); PG8_BAR; PG8_MMA(1, 0, At, B0); PG8_MMA(1, 1, At, B1); PG8_BAR; PG8_SCHED;
        }
        if (wr == 0) PG8_BAR;
        const bool keep = E(acc, cur, wr, wc, fr, fq);
        if (!has_next) break;
        if (!keep) {
#pragma unroll
            for (int a = 0; a < 2; ++a)
#pragma unroll
                for (int b = 0; b < 2; ++b)
#pragma unroll
                    for (int m = 0; m < 4; ++m)
#pragma unroll
                        for (int n = 0; n < 2; ++n) acc[a][b][m][n] = (f32x4){0.f, 0.f, 0.f, 0.f};
        }
        cur = nxt; cA = nA; cB = nB; ++ui;
        if (Sched::GATHER) {
#pragma unroll
            for (int h = 0; h < 2; ++h)
#pragma unroll
                for (int i = 0; i < 2; ++i) voC[h][i] = voN[h][i];
        } else { PG8_SETA(voC, cur); }
        PG8_SETLANE();
        if (wr == 1) PG8_BAR;
    }
    PG8_WAIT_V(0);
    PG8_BAR;
#undef PG8_SA
#undef PG8_SB
#undef PG8_STAGE
#undef PG8_LDA
#undef PG8_LDB
#undef PG8_MMA
#undef PG8_WAIT_V
#undef PG8_WAIT_L
#undef PG8_BAR
#undef PG8_SCHED
#undef PG8_SETA
#undef PG8_SETLANE
}
}

struct Args { const float* in[25]; float* out; unsigned char* ws; int ph_lo, ph_hi; };
enum { I_X = 0, I_C, I_WADA, I_BADA, I_N1G, I_WIN, I_LQ1, I_LK1, I_LQ2, I_LK2, I_SUBG, I_LBL, I_HGNG, I_WUPDA, I_WUPHG, I_WOUT, I_N2G, I_WRG, I_BRG, I_WRE, I_BRE, I_W1, I_W3, I_W2, I_FG };

struct DenseOrder {
    static constexpr bool GATHER = false;
    const char* A; const char* Bt; int K, nM, nN, G, c;
    __device__ __forceinline__ bool next(int i, pg8::Unit& u) const {
        const int L = i * G + c, nwg = nM * nN; if (L >= nwg) return false;
        int wgid = L; { const int q = nwg / 8, r = nwg % 8, xcd = wgid % 8, off = wgid / 8; wgid = (xcd < r ? xcd * (q + 1) : r * (q + 1) + (xcd - r) * q) + off; }
        const int nig = 8 * nN, gid = wgid / nig, fm = gid * 8, gsz = (nM - fm) < 8 ? (nM - fm) : 8;
        u.pm = fm + ((wgid % nig) % gsz); u.pn = (wgid % nig) / gsz; u.A = A; u.B = Bt + (size_t)u.pn * 256 * K * 2; u.aux = 0; return true;
    }
    __device__ __forceinline__ void a_ready(const pg8::Unit&) const {}
    __device__ __forceinline__ unsigned arow(const pg8::Unit& u, int r) const { return (unsigned)(u.pm * 256 + r); }
};
struct UpOrder {
    static constexpr bool GATHER = false;
    const char* A0; const char* A1; const char* B0; const char* B1; int G, c;
    __device__ __forceinline__ bool next(int i, pg8::Unit& u) const {
        const int tile = (i >> 1) * G + c; if (tile >= 256) return false;
        u.pm = tile >> 2; u.pn = tile & 3; u.aux = i & 1;
        u.A = (i & 1) ? A1 : A0; u.B = ((i & 1) ? B1 : B0) + (size_t)u.pn * 256 * 512 * 2; return true;
    }
    __device__ __forceinline__ void a_ready(const pg8::Unit&) const {}
    __device__ __forceinline__ unsigned arow(const pg8::Unit& u, int r) const { return (unsigned)(u.pm * 256 + r); }
};
struct MoeTab { int nt; int pad[3]; int tile_e[176]; int tile_m[176]; int cnt[32]; int tbase[33]; };
struct Moe1Order {
    static constexpr bool GATHER = true;
    const LAS MoeTab* tab; const char* A; const char* W; const int* toklist; int G, c;
    __device__ __forceinline__ bool next(int i, pg8::Unit& u) const {
        const int L = i * G + c; if (L >= tab->nt * 4) return false;
        const int ti = L >> 2; u.pm = ti; u.pn = L & 3; u.aux = ti; u.A = A;
        u.B = W + ((size_t)tab->tile_e[ti] * 1024 + (size_t)u.pn * 256) * 1024 * 2; return true;
    }
    __device__ __forceinline__ void a_ready(const pg8::Unit&) const {}
    __device__ __forceinline__ unsigned arow(const pg8::Unit& u, int r) const {
        const int e = tab->tile_e[u.aux], rr = tab->tile_m[u.aux] * 256 + r;
        return rr < tab->cnt[e] ? (unsigned)toklist[e * T + rr] : 0u;
    }
};
struct Moe2Order {
    static constexpr bool GATHER = false;
    const LAS MoeTab* tab; const char* A; const char* W; unsigned* done; unsigned* tmo; int G, c;
    __device__ __forceinline__ bool next(int i, pg8::Unit& u) const {
        const int n1 = tab->nt * 4, r = n1 % G, nl = G - r; int j;
        if (r > 0 && c >= r) { if (i < 2) j = (c - r) + i * nl; else j = 2 * nl + (c - r) + (i - 2) * G; }
        else j = (r > 0 ? 2 * nl : 0) + ((c - r + G) % G) + i * G;
        if (j >= n1) return false;
        const int ti = j >> 2; u.pm = ti; u.pn = j & 3; u.aux = ti; u.A = A;
        u.B = W + ((size_t)tab->tile_e[ti] * 1024 + (size_t)u.pn * 256) * 512 * 2; return true;
    }
    __device__ __forceinline__ unsigned arow(const pg8::Unit& u, int r) const { return (unsigned)(u.pm * 256 + r); }
    __device__ __forceinline__ void a_ready(const pg8::Unit& u) const {
        if (threadIdx.x < 64) {
            unsigned polls = 0;
            while ((unsigned)__builtin_amdgcn_readfirstlane(__hip_atomic_load(done + 16 * u.pm, __ATOMIC_RELAXED, __HIP_MEMORY_SCOPE_AGENT)) < 32u) {
                if (++polls > (1u << 22)) { if (threadIdx.x == 0) __hip_atomic_store(tmo, 1u, __ATOMIC_RELAXED, __HIP_MEMORY_SCOPE_AGENT); break; }
                __builtin_amdgcn_s_sleep(2); }
            __builtin_amdgcn_fence(__ATOMIC_ACQUIRE, "agent");
            asm volatile("s_waitcnt vmcnt(0)" ::: "memory");
        }
        asm volatile("" ::: "memory"); __builtin_amdgcn_s_barrier(); asm volatile("" ::: "memory");
    }
};

using pg8::Unit; using pg8::cvt_pk_bf16;
struct EpiStoreBf16 {
    static constexpr bool PERM = true;
    bf16_t* O; int ldc; int nscale; float scale0;
    __device__ __forceinline__ bool operator()(f32x4 (&acc)[2][2][4][2], const Unit& u, int wr, int wc, int fr, int fq) const {
        const int row0 = u.pm * 256 + wr * 64 + fr, col0 = u.pn * 256 + wc * 32 + 8 * fq;
        const float sc = u.pn < nscale ? scale0 : 1.0f;
#pragma unroll
        for (int ai = 0; ai < 2; ++ai)
#pragma unroll
            for (int m = 0; m < 4; ++m) { bf16_t* rowp = O + (size_t)(row0 + ai * 128 + m * 16) * ldc + col0;
#pragma unroll
                for (int bj = 0; bj < 2; ++bj) { const f32x4 v0 = acc[ai][bj][m][0] * sc, v1 = acc[ai][bj][m][1] * sc;
                    u32x4 w; w.x = cvt_pk_bf16(v0[0], v0[1]); w.y = cvt_pk_bf16(v0[2], v0[3]); w.z = cvt_pk_bf16(v1[0], v1[1]); w.w = cvt_pk_bf16(v1[2], v1[3]);
                    *(u32x4*)(rowp + bj * 128) = w; } }
        return false;
    }
};
template <int N> __device__ __forceinline__ float dpp_shr(float x) { return __builtin_bit_cast(float, __builtin_amdgcn_update_dpp(0, __builtin_bit_cast(int, x), 0x110 + N, 0xf, 0xf, true)); }
__device__ __forceinline__ float scan16(float x) { x += dpp_shr<1>(x); x += dpp_shr<2>(x); x += dpp_shr<4>(x); x += dpp_shr<8>(x); return x; }
struct EpiInProj {
    static constexpr bool PERM = true;
    bf16_t* O; bf16_t* KE; float* DEC; const float* lbv; float scale0;
    __device__ __forceinline__ bool operator()(f32x4 (&acc)[2][2][4][2], const Unit& u, int wr, int wc, int fr, int fq) const {
        { const int l_ = lane_now(); fr = l_ & 15; fq = l_ >> 4; }
        const int row0 = u.pm * 256 + wr * 64 + fr, col0 = u.pn * 256 + wc * 32 + 8 * fq;
        if (u.pn >= 6 && u.pn < 10) {
            const int h = u.pn - 6, lane = 16 * fq + fr, kb = wc * 32 + 8 * fq, bsrc = (lane & 48) | 15;
            const int bb = (u.pm * 256) / SEQ, ch0 = ((u.pm * 256) % SEQ + wr * 64) >> 6;
#pragma unroll
            for (int ai = 0; ai < 2; ++ai) {
                unsigned kep[4][4];
#pragma unroll
                for (int n = 0; n < 2; ++n) {
#pragma unroll
                    for (int ep = 0; ep < 2; ++ep) {
                        float ke2[2][4];
#pragma unroll
                        for (int z = 0; z < 2; ++z) {
                            const int e = 2 * ep + z; const float lb = lbv[h * 128 + kb + 4 * n + e];
                            float f[4], c[4], tot[4];
#pragma unroll
                            for (int m = 0; m < 4; ++m) { const float fl = acc[ai][1][m][n][e]; f[m] = lb + (1.0f - lb) * __builtin_amdgcn_rcpf(1.0f + __builtin_amdgcn_exp2f(-1.4426950408889634f * fl)); c[m] = scan16(__logf(f[m])); }
#pragma unroll
                            for (int m = 0; m < 4; ++m) tot[m] = __shfl(c[m], bsrc);
                            const float alast = (tot[0] + tot[1]) + (tot[2] + tot[3]);
                            float pre = 0.f;
#pragma unroll
                            for (int m = 0; m < 4; ++m) { const float A = c[m] + pre; pre += tot[m]; const float q = acc[ai][0][m][n][e]; const float kk = 1.0f - f[m];
                                acc[ai][0][m][n][e] = q * __builtin_amdgcn_rcpf(1.0f + __builtin_amdgcn_exp2f(-1.4426950408889634f * q)) * __expf(A);
                                acc[ai][1][m][n][e] = kk * __expf(-A); ke2[z][m] = kk * __expf(alast - A); }
                            if (fr == 0) DEC[((size_t)(bb * 4 + h) * 64 + ch0 + 2 * ai) * 128 + kb + 4 * n + e] = __expf(alast);
                        }
#pragma unroll
                        for (int m = 0; m < 4; ++m) kep[m][2 * n + ep] = cvt_pk_bf16(ke2[0][m], ke2[1][m]);
                        __builtin_amdgcn_sched_barrier(0);
                    }
                }
#pragma unroll
                for (int m = 0; m < 4; ++m) *(u32x4*)(KE + (size_t)(row0 + ai * 128 + m * 16) * 512 + h * 128 + kb) = (u32x4){kep[m][0], kep[m][1], kep[m][2], kep[m][3]};
            }
        }
        const float sc = u.pn < 2 ? scale0 : 1.0f;
#pragma unroll
        for (int ai = 0; ai < 2; ++ai)
#pragma unroll
            for (int m = 0; m < 4; ++m) { bf16_t* rowp = O + (size_t)(row0 + ai * 128 + m * 16) * INC + col0;
#pragma unroll
                for (int bj = 0; bj < 2; ++bj) { const f32x4 v0 = acc[ai][bj][m][0] * sc, v1 = acc[ai][bj][m][1] * sc;
                    u32x4 w; w.x = cvt_pk_bf16(v0[0], v0[1]); w.y = cvt_pk_bf16(v0[2], v0[3]); w.z = cvt_pk_bf16(v1[0], v1[1]); w.w = cvt_pk_bf16(v1[2], v1[3]);
                    *(u32x4*)(rowp + bj * 128) = w; } }
        return false;
    }
};
struct EpiUp {
    static constexpr bool PERM = true;
    const bf16_t* proj; bf16_t* O;
    __device__ __forceinline__ bool operator()(f32x4 (&acc)[2][2][4][2], const Unit& u, int wr, int wc, int fr, int fq) const {
        const int row0 = u.pm * 256 + wr * 64 + fr, col0 = u.pn * 256 + wc * 32 + 8 * fq;
#pragma unroll
        for (int ai = 0; ai < 2; ++ai)
#pragma unroll
            for (int m = 0; m < 4; ++m) { const size_t row = (size_t)(row0 + ai * 128 + m * 16);
#pragma unroll
                for (int bj = 0; bj < 2; ++bj) {
                    const int col = col0 + bj * 128;
                    const u32x4 gh = *(const u32x4*)(proj + row * INC + C_GHGATE + col);
                    float sh[8];
#pragma unroll
                    for (int j = 0; j < 4; ++j) { sh[2 * j] = 1.0f + __builtin_amdgcn_exp2f(-1.4426950408889634f * bf2f(gh[j] & 0xffffu)); sh[2 * j + 1] = 1.0f + __builtin_amdgcn_exp2f(-1.4426950408889634f * bf2f(gh[j] >> 16)); }
                    if (u.aux == 0) {
                        const u32x4 gd = *(const u32x4*)(proj + row * INC + C_GDA + col);
#pragma unroll
                        for (int j = 0; j < 4; ++j) {
                            const float d0 = 1.0f + __builtin_amdgcn_exp2f(-1.4426950408889634f * bf2f(gd[j] & 0xffffu)), d1 = 1.0f + __builtin_amdgcn_exp2f(-1.4426950408889634f * bf2f(gd[j] >> 16));
                            const float r0 = sh[2 * j] * __builtin_amdgcn_rcpf(d0), r1 = sh[2 * j + 1] * __builtin_amdgcn_rcpf(d1);
                            if (j < 2) { acc[ai][bj][m][0][2 * j] *= r0; acc[ai][bj][m][0][2 * j + 1] *= r1; }
                            else { acc[ai][bj][m][1][2 * j - 4] *= r0; acc[ai][bj][m][1][2 * j - 3] *= r1; }
                        }
                    } else {
                        const f32x4 v0 = acc[ai][bj][m][0], v1 = acc[ai][bj][m][1];
#pragma unroll
                        for (int j = 0; j < 8; ++j) sh[j] = __builtin_amdgcn_rcpf(sh[j]);
                        u32x4 w; w.x = cvt_pk_bf16(v0[0] * sh[0], v0[1] * sh[1]); w.y = cvt_pk_bf16(v0[2] * sh[2], v0[3] * sh[3]);
                        w.z = cvt_pk_bf16(v1[0] * sh[4], v1[1] * sh[5]); w.w = cvt_pk_bf16(v1[2] * sh[6], v1[3] * sh[7]);
                        *(u32x4*)(O + row * D + col) = w;
                    }
                } }
        return u.aux == 0;
    }
};
struct EpiOut {
    static constexpr bool PERM = false;
    const float* x; const float* mod; float* O;
    __device__ __forceinline__ bool operator()(f32x4 (&acc)[2][2][4][2], const Unit& u, int wr, int wc, int fr, int fq) const {
        const int row0 = u.pm * 256 + wr * 64 + fr, col0 = u.pn * 256 + wc * 32 + 4 * fq;
        const int b = (u.pm * 256) / SEQ;
        f32x4 gt[2][2];
#pragma unroll
        for (int bj = 0; bj < 2; ++bj)
#pragma unroll
            for (int n = 0; n < 2; ++n) gt[bj][n] = *(const f32x4*)(mod + b * 6144 + 2048 + col0 + bj * 128 + n * 16);
#pragma unroll
        for (int ai = 0; ai < 2; ++ai)
#pragma unroll
            for (int m = 0; m < 4; ++m) { const size_t off = (size_t)(row0 + ai * 128 + m * 16) * D + col0;
#pragma unroll
                for (int bj = 0; bj < 2; ++bj)
#pragma unroll
                    for (int n = 0; n < 2; ++n) { const f32x4 xv = *(const f32x4*)(x + off + bj * 128 + n * 16);
                        *(f32x4*)(O + off + bj * 128 + n * 16) = xv + gt[bj][n] * acc[ai][bj][m][n]; } }
        return false;
    }
};
struct EpiMoe1 {
    static constexpr bool PERM = true;
    bf16_t* O; unsigned* done;
    __device__ __forceinline__ bool operator()(f32x4 (&acc)[2][2][4][2], const Unit& u, int wr, int wc, int fr, int fq) const {
        const int row0 = u.pm * 256 + wr * 64 + fr, col0 = u.pn * 128 + wc * 32 + 8 * fq;
#pragma unroll
        for (int ai = 0; ai < 2; ++ai)
#pragma unroll
            for (int m = 0; m < 4; ++m) { bf16_t* rowp = O + (size_t)(row0 + ai * 128 + m * 16) * DEXP + col0;
                float h[8];
#pragma unroll
                for (int n = 0; n < 2; ++n)
#pragma unroll
                    for (int e = 0; e < 4; ++e) { const float x_ = acc[ai][0][m][n][e]; h[n * 4 + e] = x_ * __builtin_amdgcn_rcpf(1.0f + __builtin_amdgcn_exp2f(-1.4426950408889634f * x_)) * acc[ai][1][m][n][e]; }
                u32x4 w; w.x = cvt_pk_bf16(h[0], h[1]); w.y = cvt_pk_bf16(h[2], h[3]); w.z = cvt_pk_bf16(h[4], h[5]); w.w = cvt_pk_bf16(h[6], h[7]);
                asm volatile("global_store_dwordx4 %0, %1, off sc1\n\ts_nop 1" :: "v"(rowp), "v"(w) : "memory"); }
        asm volatile("s_waitcnt vmcnt(0)" ::: "memory");
        if ((threadIdx.x & 63) == 0) __hip_atomic_fetch_add(done + 16 * u.pm, 1u, __ATOMIC_RELAXED, __HIP_MEMORY_SCOPE_AGENT);
        return false;
    }
};

struct Frame { LAS unsigned char* lds; int tid, lane, wave, G, bid; };

__device__ __forceinline__ void transpose_item(const float* Wsrc, int ldw, bf16_t* dst, int ldd, LAS float* scr, int lane) {
#pragma unroll 8
    for (int i = 0; i < 32; ++i) { const int kk = 2 * i + (lane >> 5); scr[kk * 33 + (lane & 31)] = Wsrc[(size_t)kk * ldw + (lane & 31)]; }
    asm volatile("s_waitcnt lgkmcnt(0)" ::: "memory");
    const int c = lane & 7;
#pragma unroll
    for (int j = 0; j < 4; ++j) { const int n = (lane >> 3) + 8 * j; const LAS float* s = scr + (8 * c) * 33 + n;
        u32x4 o; o.x = pk2(s[0 * 33], s[1 * 33]); o.y = pk2(s[2 * 33], s[3 * 33]); o.z = pk2(s[4 * 33], s[5 * 33]); o.w = pk2(s[6 * 33], s[7 * 33]);
        *(u32x4*)(dst + (size_t)n * ldd + 8 * c) = o; }
    asm volatile("s_waitcnt lgkmcnt(0)" ::: "memory");
}
__device__ __forceinline__ void transpose_matrix(const Frame& F, const float* W, int K, int N, bf16_t* WT) {
    LAS float* scr = (LAS float*)(F.lds + F.wave * 8448);
    const int gw = F.bid * NWAVES + F.wave, NGW = F.G * NWAVES, nblk = N / 32, items = (K / 64) * nblk;
    for (int it = gw; it < items; it += NGW) { const int kb = it / nblk, nb = it % nblk;
        transpose_item(W + (size_t)(64 * kb) * N + 32 * nb, N, WT + (size_t)(32 * nb) * K + 64 * kb, K, scr, F.lane); }
}

__device__ __forceinline__ void phase0(const Frame& F, const Args& a) {
    unsigned char* ws = a.ws;
    {
        float* modp = (float*)(ws + WS_MODP);
        const float* c = a.in[I_C]; const float* wada = a.in[I_WADA];
        LAS float* cs = (LAS float*)(F.lds + 72 * 1024);
        for (int i = F.tid; i < 4 * D; i += NTHR) cs[i] = siluf_(c[i]);
        __syncthreads();
        for (int wt = F.bid + 256 * F.wave; wt < 384; wt += 256 * NWAVES) {
            if (F.G != 256) break;
            const int ks = wt / 24, jw = wt % 24, j = jw * 256 + F.lane * 4;
            f32x4 s[4] = {{0, 0, 0, 0}, {0, 0, 0, 0}, {0, 0, 0, 0}, {0, 0, 0, 0}};
#pragma unroll 8
            for (int k = ks * 64; k < ks * 64 + 64; ++k) {
                const f32x4 w = *(const f32x4*)(wada + (size_t)k * 6144 + j);
#pragma unroll
                for (int b = 0; b < 4; ++b) s[b] += w * cs[b * D + k];
            }
#pragma unroll
            for (int b = 0; b < 4; ++b) *(f32x4*)(modp + ((size_t)ks * 4 + b) * 6144 + j) = s[b];
        }
        if (F.G != 256) {
            const int gw = F.bid * NWAVES + F.wave, NGW = F.G * NWAVES;
            for (int wt = gw; wt < 384; wt += NGW) {
                const int ks = wt / 24, jw = wt % 24, j = jw * 256 + F.lane * 4;
                f32x4 s[4] = {{0, 0, 0, 0}, {0, 0, 0, 0}, {0, 0, 0, 0}, {0, 0, 0, 0}};
                for (int k = ks * 64; k < ks * 64 + 64; ++k) {
                    const f32x4 w = *(const f32x4*)(wada + (size_t)k * 6144 + j);
#pragma unroll
                    for (int b = 0; b < 4; ++b) { const float cv = siluf_(c[b * D + k]); s[b] += w * cv; }
                }
#pragma unroll
                for (int b = 0; b < 4; ++b) *(f32x4*)(modp + ((size_t)ks * 4 + b) * 6144 + j) = s[b];
            }
        }
    }
    {
        LAS float* scr = (LAS float*)(F.lds + F.wave * 8448);
        const int gw = F.bid * NWAVES + F.wave, NGW = F.G * NWAVES, nblk = INC / 32, items = (D / 64) * nblk;
        bf16_t* WT = (bf16_t*)(ws + WS_WIN);
        for (int it = gw; it < items; it += NGW) { const int kb = it / nblk, n0 = 32 * (it % nblk); int dr = n0;
            if (n0 >= C_QHG && n0 < C_FHG) dr = C_HGT + 256 * ((n0 - C_QHG) >> 7) + ((n0 - C_QHG) & 127);
            else if (n0 >= C_FHG && n0 < C_IHG) dr = C_HGT + 256 * ((n0 - C_FHG) >> 7) + 128 + ((n0 - C_FHG) & 127);
            transpose_item(a.in[I_WIN] + (size_t)(64 * kb) * INC + n0, INC, WT + (size_t)dr * D + 64 * kb, D, scr, F.lane); }
    }
    transpose_matrix(F, a.in[I_WUPDA], 512, D, (bf16_t*)(ws + WS_WUPDA));
    transpose_matrix(F, a.in[I_WUPHG], 512, D, (bf16_t*)(ws + WS_WUPHG));
    transpose_matrix(F, a.in[I_WOUT], D, D, (bf16_t*)(ws + WS_WOUT));
    if (F.bid == 0) {
        float* sm = (float*)(ws + WS_SMALL);
        if (F.tid == 0) {
            float s1 = 0.f, s2 = 0.f;
            for (int i = 0; i < 64; ++i) { s1 += a.in[I_LQ1][i] * a.in[I_LK1][i]; s2 += a.in[I_LQ2][i] * a.in[I_LK2][i]; }
            sm[0] = expf(s1) - expf(s2) + 0.2f;
        }
        { const float l0 = a.in[I_LBL][F.tid], l1 = a.in[I_LBL][512 + F.tid]; const float mx = fmaxf(l0, l1);
          const float e0 = expf(l0 - mx), e1 = expf(l1 - mx); sm[16 + F.tid] = e0 / (e0 + e1); }
    }
}
__device__ __forceinline__ void moe_weight_convert(const Frame& F, const Args& a) {
    LAS float* scr = (LAS float*)(F.lds + F.wave * 8448);
    const int gw = F.bid * NWAVES + F.wave, NGW = F.G * NWAVES;
    bf16_t* w13 = (bf16_t*)(a.ws + WS_W13); bf16_t* w2t = (bf16_t*)(a.ws + WS_W2);
    for (int it = gw; it < 2 * NEXP * 256; it += NGW) {
        const int which = it / (NEXP * 256), r = it % (NEXP * 256), e = r >> 8, kb = (r >> 4) & 15, nb = r & 15, n0 = 32 * nb;
        const float* W = a.in[which ? I_W3 : I_W1] + (size_t)e * 1024 * 512;
        const int drow = 256 * (n0 >> 7) + (which ? 128 : 0) + (n0 & 127);
        transpose_item(W + (size_t)(64 * kb) * 512 + n0, 512, w13 + ((size_t)e * 1024 + drow) * 1024 + 64 * kb, 1024, scr, F.lane);
    }
    for (int it = gw; it < NEXP * 256; it += NGW) {
        const int e = it >> 8, kb = (it >> 5) & 7, nb = it & 31;
        const float* W = a.in[I_W2] + (size_t)e * 512 * 1024;
        transpose_item(W + (size_t)(64 * kb) * 1024 + 32 * nb, 1024, w2t + ((size_t)e * 1024 + 32 * nb) * 512 + 64 * kb, 512, scr, F.lane);
    }
}

__device__ __forceinline__ void phase1(const Frame& F, const Args& a) {
    const float* modp = (const float*)(a.ws + WS_MODP); float* mod = (float*)(a.ws + WS_MOD);
    for (int i = F.bid * NTHR + F.tid; i < 4 * 6144; i += F.G * NTHR) {
        float s = a.in[I_BADA][i % 6144];
        for (int ks = 0; ks < 16; ++ks) s += modp[(size_t)ks * 4 * 6144 + i];
        mod[i] = s;
    }
    LAS float* Gs = (LAS float*)F.lds;
    LAS float* Ss = Gs + 1024;
    bf16_t* H = (bf16_t*)(a.ws + WS_ACT);
    const int rows_per_blk = T / F.G;
    const int r0 = F.bid * rows_per_blk, b = r0 / SEQ;
    for (int k = F.tid; k < 1024; k += NTHR) {
        float sh = a.in[I_BADA][k], sc = a.in[I_BADA][1024 + k];
        for (int ks = 0; ks < 16; ++ks) { sh += modp[((size_t)ks * 4 + b) * 6144 + k]; sc += modp[((size_t)ks * 4 + b) * 6144 + 1024 + k]; }
        Gs[k] = a.in[I_N1G][k] * (1.0f + sc); Ss[k] = sh;
    }
    __syncthreads();
    for (int r = r0 + F.wave; r < r0 + rows_per_blk; r += NWAVES) {
        const f32x4* xr = (const f32x4*)(a.in[I_X] + (size_t)r * D) + F.lane;
        f32x4 v[4]; float s = 0.f;
#pragma unroll
        for (int j = 0; j < 4; ++j) { v[j] = xr[64 * j]; s += (v[j].x * v[j].x + v[j].y * v[j].y) + (v[j].z * v[j].z + v[j].w * v[j].w); }
        const float rs = rsqrtf(wave_sum(s) * (1.0f / D) + EPS);
        unsigned long long* o8 = (unsigned long long*)(H + (size_t)r * D) + F.lane;
#pragma unroll
        for (int j = 0; j < 4; ++j) { const f32x4 g = *(const LAS f32x4*)(Gs + 256 * j + 4 * F.lane), sh = *(const LAS f32x4*)(Ss + 256 * j + 4 * F.lane);
            const f32x4 h = v[j] * rs * g + sh;
            o8[64 * j] = (unsigned long long)pk2(h.x, h.y) | ((unsigned long long)pk2(h.z, h.w) << 32); }
    }
}

namespace attn_body {
using s16x4=__attribute__((ext_vector_type(4)))short;
using f32x16=__attribute__((ext_vector_type(16)))float;
constexpr int NW=8,QBLK=32,QB=QBLK*NW,KVBLK=64,NQB=SEQ/QB;
constexpr int PIN=INC, POUT=1024;
__device__ __forceinline__ int crow(int r,int hi){return (r&3)+8*(r>>2)+4*hi;}
#define SBAR() __builtin_amdgcn_sched_barrier(0)
__device__ __forceinline__ void bmask(f32x16&p0,f32x16&p1,int jb,int wch,int il,int hi,float s2x2){
  if(jb>wch){
    #pragma unroll
    for(int r=0;r<16;++r){p0[r]=-INFINITY;p1[r]=-INFINITY;}
  } else if(jb==wch){
    float fb=(float)(4*hi-il); asm volatile("":"+v"(fb));
    #pragma unroll
    for(int r=0;r<16;++r){const float c=(float)((r&3)+8*(r>>2)); p0[r]-=s2x2*__builtin_fmaxf(fb+c,0.f); p1[r]-=s2x2*__builtin_fmaxf(fb+(c+32.f),0.f);}
  }
}
constexpr int NSLOT=3, SLOTB=8192, VSLOTB=16384;
constexpr int LDS_K=0, LDS_V=NSLOT*SLOTB, LDS_WS=LDS_V+NSLOT*VSLOTB, LDS_OST=LDS_WS+NW*64*4, ATT_LDS_BYTES=LDS_OST+NW*8192;
constexpr float C2=0.125f*1.4426950408889634f;
__device__ __forceinline__ void glds16(const void*gsrc,unsigned lds_dst){unsigned keep;
  asm volatile("s_mov_b32 %0, m0\n\ts_mov_b32 m0, %2\n\ts_nop 0\n\tglobal_load_lds_dwordx4 %1, off\n\ts_mov_b32 m0, %0":"=&s"(keep):"v"(gsrc),"s"(lds_dst):"memory");}
__device__ __forceinline__ float max3f(float a,float b,float c){float r;asm("v_max3_f32 %0, %1, %2, %3":"=v"(r):"v"(a),"v"(b),"v"(c));return r;}
__device__ __forceinline__ float max2f(float a,float b){float r;asm("v_max_f32_e32 %0, %1, %2":"=v"(r):"v"(a),"v"(b));return r;}
__device__ __forceinline__ float fadd_s(float a,float b){float r;asm("v_add_f32_e32 %0, %1, %2":"=v"(r):"v"(a),"v"(b));return r;}
__device__ __forceinline__ float fsub_s(float a,float b){float r;asm("v_sub_f32_e32 %0, %1, %2":"=v"(r):"v"(a),"v"(b));return r;}
typedef float f32x2_t __attribute__((ext_vector_type(2))); typedef __bf16 bf16x2_t __attribute__((ext_vector_type(2)));
__device__ __forceinline__ unsigned cvtpk_s(float lo,float hi){f32x2_t v={lo,hi};bf16x2_t b=__builtin_convertvector(v,bf16x2_t);return __builtin_bit_cast(unsigned,b);}
#define WAIT_BAR(N) asm volatile("s_waitcnt vmcnt(" #N ") lgkmcnt(0)\n\ts_barrier":::"memory")

__device__ __forceinline__ void qkt(f32x16&p0,f32x16&p1,const char*Kslot,const bf16x8*qr,const f32x16&c0,const f32x16&c1,int r32,int hi){
  const char*kb=Kslot+hi*1024+r32*16;
  #pragma unroll
  for(int d0=0;d0<4;++d0){
    const bf16x8 b0=*reinterpret_cast<const bf16x8*>(kb+d0*2048);
    const bf16x8 b1=*reinterpret_cast<const bf16x8*>(kb+d0*2048+512);
    if(d0==0){p0=__builtin_amdgcn_mfma_f32_32x32x16_bf16(b0,qr[0],c0,0,0,0);p1=__builtin_amdgcn_mfma_f32_32x32x16_bf16(b1,qr[0],c1,0,0,0);}
    else{p0=__builtin_amdgcn_mfma_f32_32x32x16_bf16(b0,qr[d0],p0,0,0,0);p1=__builtin_amdgcn_mfma_f32_32x32x16_bf16(b1,qr[d0],p1,0,0,0);}}
}
typedef __attribute__((address_space(3))) const char* lds_cptr;
typedef short v4i16_t __attribute__((ext_vector_type(4)));
__device__ __forceinline__ void kload8(bf16x8*kf,lds_cptr kp){
  kf[0]=*(const __attribute__((address_space(3))) bf16x8*)(kp);      kf[1]=*(const __attribute__((address_space(3))) bf16x8*)(kp+512);
  kf[2]=*(const __attribute__((address_space(3))) bf16x8*)(kp+2048); kf[3]=*(const __attribute__((address_space(3))) bf16x8*)(kp+2560);
  kf[4]=*(const __attribute__((address_space(3))) bf16x8*)(kp+4096); kf[5]=*(const __attribute__((address_space(3))) bf16x8*)(kp+4608);
  kf[6]=*(const __attribute__((address_space(3))) bf16x8*)(kp+6144); kf[7]=*(const __attribute__((address_space(3))) bf16x8*)(kp+6656);
}
__device__ __forceinline__ void kload2(bf16x8*kf,lds_cptr kp,int j){ kf[2*j]=*(const __attribute__((address_space(3))) bf16x8*)(kp+j*2048); kf[2*j+1]=*(const __attribute__((address_space(3))) bf16x8*)(kp+j*2048+512); }
__device__ __forceinline__ s16x4 vtr(lds_cptr p){ return __builtin_bit_cast(s16x4,__builtin_amdgcn_ds_read_tr16_b64_v4i16((__attribute__((address_space(3))) v4i16_t*)p)); }
__device__ __forceinline__ float rowmax(const f32x16&p0,const f32x16&p1){
  float a=max3f(p0[0],p0[1],p1[0]),b=max3f(p0[2],p0[3],p1[1]);a=max3f(a,p1[2],p1[3]);
  #pragma unroll
  for(int r=4;r<16;r+=4){a=max3f(a,p0[r],p0[r+1]);b=max3f(b,p0[r+2],p0[r+3]);a=max3f(a,p1[r],p1[r+1]);b=max3f(b,p1[r+2],p1[r+3]);}
  const float m=max2f(a,b);
  auto rr=__builtin_amdgcn_permlane32_swap(__float_as_uint(m),__float_as_uint(m),false,false);
  return max2f(__uint_as_float(rr[0]),__uint_as_float(rr[1]));
}
__device__ __forceinline__ void pv(f32x16*o,int vb,bf16x8 pa0,bf16x8 pa1,bf16x8 pa2,bf16x8 pa3){
  #pragma unroll
  for(int d0=0;d0<4;++d0){s16x4 lo[4],hi[4];
    #pragma unroll
    for(int ks=0;ks<4;++ks){
      asm volatile("ds_read_b64_tr_b16 %0,%1 offset:%c2":"=&v"(lo[ks]):"v"(vb),"i"(d0*4096+ks*1024):"memory");
      asm volatile("ds_read_b64_tr_b16 %0,%1 offset:%c2":"=&v"(hi[ks]):"v"(vb),"i"(d0*4096+ks*1024+512):"memory");}
    asm volatile("s_waitcnt lgkmcnt(0)":::"memory");SBAR();
    #define PK(k) (bf16x8){lo[k][0],lo[k][1],lo[k][2],lo[k][3],hi[k][0],hi[k][1],hi[k][2],hi[k][3]}
    o[d0]=__builtin_amdgcn_mfma_f32_32x32x16_bf16(pa0,PK(0),o[d0],0,0,0);
    o[d0]=__builtin_amdgcn_mfma_f32_32x32x16_bf16(pa1,PK(1),o[d0],0,0,0);
    o[d0]=__builtin_amdgcn_mfma_f32_32x32x16_bf16(pa2,PK(2),o[d0],0,0,0);
    o[d0]=__builtin_amdgcn_mfma_f32_32x32x16_bf16(pa3,PK(3),o[d0],0,0,0);
    #undef PK
  }
}
#define ATTN_STORE16(p,v) (*(u32x4*)(p)=(v))
template<int THRL> __device__ __forceinline__ void attn_unit(int qb,const bf16_t*Qb,const bf16_t*__restrict__ Kh,const bf16_t*__restrict__ Vh,bf16_t*Ob,float slope2,char*shm){
  const int wid=__builtin_amdgcn_readfirstlane(threadIdx.x>>6); const int lane=lane_now(),r32=lane&31,hi=lane>>5;
  const int q0=qb*QB;
  const bf16_t*Qw=Qb+(long)(q0+wid*QBLK)*PIN;
  const unsigned lds0=(unsigned)(uintptr_t)shm;
  float*wsf=(float*)(shm+LDS_WS)+wid*64;
  const bf16_t*ksrc=Kh+(long)lane*PIN+wid*8;
  const bf16_t*vsrc=Vh+(long)(16*(wid&3)+(lane>>2))*PIN+(wid>>2)*32+(lane&3)*8;
  const unsigned kdst=lds0+LDS_K+wid*1024, vdst=lds0+LDS_V+(wid>>2)*4096+(wid&3)*1024;
  #define DMA_K(t,slot) glds16(ksrc+(long)(t)*KVBLK*PIN,(unsigned)__builtin_amdgcn_readfirstlane(kdst+(slot)))
  #define DMA_V(t,slot) do{ glds16(vsrc+(long)(t)*KVBLK*PIN,(unsigned)__builtin_amdgcn_readfirstlane(vdst+2*(slot))); glds16(vsrc+(long)(t)*KVBLK*PIN+64,(unsigned)__builtin_amdgcn_readfirstlane(vdst+2*(slot)+8192)); }while(0)
  const int vb0=(int)(lds0+LDS_V)+((lane>>4)&1)*32+(lane&3)*8+(4*hi+((lane&15)>>2))*64;
  const char*Kbase=shm+LDS_K; bf16x8 kf[8];
  const lds_cptr shm3=(lds_cptr)shm; const lds_cptr kp0=shm3+LDS_K+hi*1024+r32*16; const lds_cptr vp0=shm3+LDS_V+((lane>>4)&1)*32+(lane&3)*8+(4*hi+((lane&15)>>2))*64;
  const int NT=(q0+QB)/KVBLK;
  DMA_K(0,0);DMA_V(0,0);DMA_K(1,SLOTB);
  bf16x8 qr[4];
  #pragma unroll
  for(int d0=0;d0<4;++d0)qr[d0]=*reinterpret_cast<const bf16x8*>(&Qw[(long)r32*PIN+d0*16+hi*8]);
  float mhat=0.f,l_reg=0.f;f32x16 o[4];o[0]=f32x16{};o[1]=f32x16{};o[2]=f32x16{};o[3]=f32x16{};
  const float s64=slope2*64.f, s32=slope2*32.f, s2x2=2.f*slope2, s4hi=slope2*4.f*(float)hi;
  const int wch=wid>>1, il=32*(wid&1)+r32;
  #define CMASK(P0,P1,t) do{int jb_=(t)-(NT-4); if(jb_>=0)bmask(P0,P1,jb_,wch,il,hi,s2x2);}while(0)
  #define CINIT0(C0,t) do{ const float bt_=s64*(float)((t)-NT)-mhat+s4hi; _Pragma("unroll") for(int r=0;r<16;++r){C0[r]=__builtin_fmaf(slope2,(float)((r&3)+8*(r>>2)),bt_);} }while(0)
  #define CINIT1(C1,t) do{ const float bu_=s64*(float)((t)-NT)-mhat+s4hi+s32; _Pragma("unroll") for(int r=0;r<16;++r){C1[r]=__builtin_fmaf(slope2,(float)((r&3)+8*(r>>2)),bu_);} }while(0)
  bool resc=false;
  #define START(P0,P1) do{ const float rm=rowmax(P0,P1); resc=false; \
    { const float dl=rm; mhat=fadd_s(mhat,dl); \
      _Pragma("unroll") for(int r=0;r<16;++r){P0[r]=fsub_s(P0[r],dl);P1[r]=fsub_s(P1[r],dl);} } \
    _Pragma("unroll") for(int r=0;r<16;++r)P0[r]=__builtin_amdgcn_exp2f(P0[r]); }while(0)
  #define RESC() do{ if(resc){ asm volatile("s_waitcnt lgkmcnt(0)":::"memory"); \
      _Pragma("unroll") for(int d_=0;d_<4;++d_) _Pragma("unroll") for(int r=0;r<16;++r)o[d_][r]*=wsf[crow(r,hi)]; } }while(0)
  f32x16 cS0,cS1;
  u32x4 pwa0,pwa1,pwa2,pwa3,pwb0,pwb1,pwb2,pwb3;
  int sl_prev=0,sl_cur=0,sl_next=SLOTB;
  #define ROT() do{sl_prev=sl_cur;sl_cur=sl_next;sl_next=(sl_next==(NSLOT-1)*SLOTB)?0:sl_next+SLOTB;}while(0)
  #define PKW(P,B) cvtpk_s(P[B],P[B+1])
  DMA_K(2,2*SLOTB);
  WAIT_BAR(3);
  { f32x16 c0,c1; CINIT0(c0,0); CINIT1(c1,0); qkt(cS0,cS1,Kbase,qr,c0,c1,r32,hi); }
  asm volatile("s_nop 15\n\ts_nop 7":"+v"(cS0),"+v"(cS1));CMASK(cS0,cS1,0);
  START(cS0,cS1);
  _Pragma("unroll") for(int r=0;r<16;++r)cS1[r]=__builtin_amdgcn_exp2f(cS1[r]);
  { float sacc=cS0[0]+cS0[1]; _Pragma("unroll") for(int r=2;r<16;++r)sacc+=cS0[r]; _Pragma("unroll") for(int r=0;r<16;++r)sacc+=cS1[r]; l_reg+=sacc;
    pwa0=(u32x4){PKW(cS0,0),PKW(cS0,2),PKW(cS0,4),PKW(cS0,6)};pwa1=(u32x4){PKW(cS0,8),PKW(cS0,10),PKW(cS0,12),PKW(cS0,14)};pwa2=(u32x4){PKW(cS1,0),PKW(cS1,2),PKW(cS1,4),PKW(cS1,6)};pwa3=(u32x4){PKW(cS1,8),PKW(cS1,10),PKW(cS1,12),PKW(cS1,14)}; }
  WAIT_BAR(0);
  DMA_K(3,0);DMA_V(1,SLOTB);
  ROT();
  kload8(kf,kp0+sl_cur);
  WAIT_BAR(3);
  s16x4 vlo[4],vhi[4];
  #define CAT_(a,b) a##b
  #define CAT(a,b) CAT_(a,b)
  #define PAFC(P,k) __builtin_bit_cast(bf16x8,CAT(P,k))
  #define VFR(k) (bf16x8){vlo[(k)&3][0],vlo[(k)&3][1],vlo[(k)&3][2],vlo[(k)&3][3],vhi[(k)&3][0],vhi[(k)&3][1],vhi[(k)&3][2],vhi[(k)&3][3]}
  #define VOFF(k) ((k)<8 ? (((k)&1)*4096+((k)>>1)*1024) : ((2+((k)&1))*4096+(((k)-8)>>1)*1024))
  #define PIN_(x) asm volatile("":"+v"(x))
  #define MX3(a,b,c) __builtin_fmaxf(__builtin_fmaxf((a),(b)),(c))
  #define QK(MF) do{ MF; SBAR(); }while(0)
  #define EX(v) __builtin_amdgcn_exp2f(v)
  #define VRD(k) do{ vlo[(k)&3]=vtr(vp_+VOFF(k)); vhi[(k)&3]=vtr(vp_+(VOFF(k)+512)); }while(0)
  #define VNX(k) do{ if((k)+4<16){ VRD((k)+4); } SBAR(); }while(0)
  #define GAPB3(MF,X,B,PW,J) do{ MF; X[B]=EX(X[B]); X[B+1]=EX(X[B+1]); sacc+=X[B]; sacc+=X[B+1]; PW[J]=cvtpk_s(X[B],X[B+1]); PIN_(X); PIN_(sacc); PIN_(PW); SBAR(); }while(0)
  #define KRD(G,j) do{ if(G){ kload2(kf,kp0+sl_next,j); SBAR(); } }while(0)
  #define STEP(PC,PN,t,GK,GV,GL) do{ SBAR(); \
    CINIT0(cS0,t); SBAR(); \
    const lds_cptr vp_=vp0+2*sl_prev; \
    VRD(0); SBAR(); QK(cS0=__builtin_amdgcn_mfma_f32_32x32x16_bf16(kf[0],qr[0],cS0,0,0,0)); \
    CINIT1(cS1,t); VRD(1); SBAR(); QK(cS1=__builtin_amdgcn_mfma_f32_32x32x16_bf16(kf[1],qr[0],cS1,0,0,0)); \
    VRD(2); SBAR(); QK(cS0=__builtin_amdgcn_mfma_f32_32x32x16_bf16(kf[2],qr[1],cS0,0,0,0)); \
    VRD(3); SBAR(); QK(cS1=__builtin_amdgcn_mfma_f32_32x32x16_bf16(kf[3],qr[1],cS1,0,0,0)); \
    QK(cS0=__builtin_amdgcn_mfma_f32_32x32x16_bf16(kf[4],qr[2],cS0,0,0,0)); \
    QK(cS1=__builtin_amdgcn_mfma_f32_32x32x16_bf16(kf[5],qr[2],cS1,0,0,0)); \
    QK(cS0=__builtin_amdgcn_mfma_f32_32x32x16_bf16(kf[6],qr[3],cS0,0,0,0)); \
    QK(cS1=__builtin_amdgcn_mfma_f32_32x32x16_bf16(kf[7],qr[3],cS1,0,0,0)); \
    if(GK){DMA_K((t)+3,sl_cur);} if(GV){DMA_V((t)+1,sl_next);} \
    CMASK(cS0,cS1,t); \
    { float a=MX3(cS0[0],cS0[1],cS1[0]),b=MX3(cS0[2],cS0[3],cS1[1]); a=MX3(a,cS1[2],cS1[3]); \
      _Pragma("unroll") for(int r=4;r<16;r+=4){a=MX3(a,cS0[r],cS0[r+1]);b=MX3(b,cS0[r+2],cS0[r+3]);a=MX3(a,cS1[r],cS1[r+1]);b=MX3(b,cS1[r+2],cS1[r+3]);} \
      float rm=__builtin_fmaxf(a,b); { auto rr=__builtin_amdgcn_permlane32_swap(__float_as_uint(rm),__float_as_uint(rm),false,false); rm=__builtin_fmaxf(__uint_as_float(rr[0]),__uint_as_float(rr[1])); } \
      resc=false; \
      if(__builtin_expect(__any(rm>(float)THRL),0)){ const float dl=__builtin_fmaxf(rm,0.f); mhat+=dl; \
        _Pragma("unroll") for(int r=0;r<16;++r){cS0[r]-=dl;cS1[r]-=dl;} \
        const float f=__builtin_amdgcn_exp2f(-dl); l_reg*=f; if(hi==0)wsf[r32]=f; resc=true; } } \
    SBAR(); float sacc=0.f; \
    GAPB3(o[0]=__builtin_amdgcn_mfma_f32_32x32x16_bf16(PAFC(PC,0),VFR(0),o[0],0,0,0), cS0,0, CAT(PN,0),0); VNX(0); \
    GAPB3(o[1]=__builtin_amdgcn_mfma_f32_32x32x16_bf16(PAFC(PC,0),VFR(1),o[1],0,0,0), cS0,2, CAT(PN,0),1); VNX(1); \
    KRD(GL,0); GAPB3(o[0]=__builtin_amdgcn_mfma_f32_32x32x16_bf16(PAFC(PC,1),VFR(2),o[0],0,0,0), cS0,4, CAT(PN,0),2); VNX(2); \
    KRD(GL,1); GAPB3(o[1]=__builtin_amdgcn_mfma_f32_32x32x16_bf16(PAFC(PC,1),VFR(3),o[1],0,0,0), cS0,6, CAT(PN,0),3); VNX(3); \
    KRD(GL,2); GAPB3(o[0]=__builtin_amdgcn_mfma_f32_32x32x16_bf16(PAFC(PC,2),VFR(4),o[0],0,0,0), cS0,8, CAT(PN,1),0); VNX(4); \
    KRD(GL,3); GAPB3(o[1]=__builtin_amdgcn_mfma_f32_32x32x16_bf16(PAFC(PC,2),VFR(5),o[1],0,0,0), cS0,10, CAT(PN,1),1); VNX(5); \
    GAPB3(o[0]=__builtin_amdgcn_mfma_f32_32x32x16_bf16(PAFC(PC,3),VFR(6),o[0],0,0,0), cS0,12, CAT(PN,1),2); VNX(6); \
    GAPB3(o[1]=__builtin_amdgcn_mfma_f32_32x32x16_bf16(PAFC(PC,3),VFR(7),o[1],0,0,0), cS0,14, CAT(PN,1),3); VNX(7); \
    GAPB3(o[2]=__builtin_amdgcn_mfma_f32_32x32x16_bf16(PAFC(PC,0),VFR(8),o[2],0,0,0), cS1,0, CAT(PN,2),0); VNX(8); \
    GAPB3(o[3]=__builtin_amdgcn_mfma_f32_32x32x16_bf16(PAFC(PC,0),VFR(9),o[3],0,0,0), cS1,2, CAT(PN,2),1); VNX(9); \
    GAPB3(o[2]=__builtin_amdgcn_mfma_f32_32x32x16_bf16(PAFC(PC,1),VFR(10),o[2],0,0,0), cS1,4, CAT(PN,2),2); VNX(10); \
    GAPB3(o[3]=__builtin_amdgcn_mfma_f32_32x32x16_bf16(PAFC(PC,1),VFR(11),o[3],0,0,0), cS1,6, CAT(PN,2),3); VNX(11); \
    GAPB3(o[2]=__builtin_amdgcn_mfma_f32_32x32x16_bf16(PAFC(PC,2),VFR(12),o[2],0,0,0), cS1,8, CAT(PN,3),0); VNX(12); \
    GAPB3(o[3]=__builtin_amdgcn_mfma_f32_32x32x16_bf16(PAFC(PC,2),VFR(13),o[3],0,0,0), cS1,10, CAT(PN,3),1); VNX(13); \
    GAPB3(o[2]=__builtin_amdgcn_mfma_f32_32x32x16_bf16(PAFC(PC,3),VFR(14),o[2],0,0,0), cS1,12, CAT(PN,3),2); VNX(14); \
    GAPB3(o[3]=__builtin_amdgcn_mfma_f32_32x32x16_bf16(PAFC(PC,3),VFR(15),o[3],0,0,0), cS1,14, CAT(PN,3),3); VNX(15); \
    l_reg+=sacc; \
    }while(0)
  int t=1;
  #undef CMASK
  #define CMASK(P0,P1,t) do{}while(0)
  for(;t+5<NT;t+=2){
    STEP(pwa,pwb,t,true,true,true);     WAIT_BAR(3); RESC(); ROT();
    STEP(pwb,pwa,t+1,true,true,true);   WAIT_BAR(3); RESC(); ROT();
  }
  #undef CMASK
  #define CMASK(P0,P1,t) do{int jb_=(t)-(NT-4); if(jb_>=0)bmask(P0,P1,jb_,wch,il,hi,s2x2);}while(0)
  #define ENDW(tt) do{ if((tt)+3<NT){WAIT_BAR(3);} else if((tt)+2<NT){WAIT_BAR(2);} else {WAIT_BAR(0);} }while(0)
  for(;t+1<NT;t+=2){
    STEP(pwa,pwb,t,(t+3<NT),(t+1<NT),(t+1<NT));       ENDW(t);   RESC(); ROT();
    STEP(pwb,pwa,t+1,(t+4<NT),(t+2<NT),(t+2<NT));     ENDW(t+1); RESC(); ROT();
  }
  STEP(pwa,pwb,NT-1,false,false,false); RESC();
  SBAR(); pv(o,vb0+2*sl_cur,PAFC(pwb,0),PAFC(pwb,1),PAFC(pwb,2),PAFC(pwb,3));
  #undef PKW
  #undef PAFC
  #undef CAT
  #undef CAT_
  #undef QK
  #undef GAPB3
  #undef VFR
  #undef PIN_
  #undef MX3
  #undef EX
  #undef VRD
  #undef VNX
  #undef VOFF
  #undef GAPB2
  #undef KRD
  #undef STEP
  #undef ENDW
  {auto rr=__builtin_amdgcn_permlane32_swap(__float_as_uint(l_reg),__float_as_uint(l_reg),false,false);l_reg=__uint_as_float(rr[0])+__uint_as_float(rr[1]);}
  {
    const int le=lane_now(), r32e=le&31, hie=le>>5;
    float*wsfe=(float*)(shm+LDS_WS)+wid*64;
    if(hie==0)wsfe[32+r32e]=l_reg;asm volatile("s_waitcnt lgkmcnt(0)":::"memory");
    float rli[16];
    #pragma unroll
    for(int r=0;r<16;++r)rli[r]=__builtin_amdgcn_rcpf(wsfe[32+crow(r,hie)]);
    bf16_t*Ow=Ob+(long)(q0+wid*QBLK)*POUT;
    bf16_t*stg=(bf16_t*)(shm+LDS_OST)+wid*4096;
    #pragma unroll
    for(int r=0;r<16;++r){const int orow=crow(r,hie);
      #pragma unroll
      for(int d0=0;d0<4;++d0)stg[orow*128+d0*32+r32e]=(bf16_t)f2bf(o[d0][r]*rli[r]);}
    asm volatile("s_waitcnt lgkmcnt(0)":::"memory");
    #pragma unroll
    for(int i=0;i<8;++i){const int row=i*4+(le>>4),ch=le&15; const u32x4 v=*(const u32x4*)(stg+row*128+ch*8); ATTN_STORE16(Ow+(long)row*POUT+ch*8,v);} }
  asm volatile("s_waitcnt lgkmcnt(0)\n\ts_barrier":::"memory");
  #undef DMA_K
  #undef DMA_V
  #undef CMASK
  #undef CINIT0
  #undef CINIT1
  #undef START
  #undef RESC
  #undef ROT
}
#undef SBAR
#undef WAIT_BAR
}

__device__ __forceinline__ void attn_phase(const Frame& F, const Args& a) {
    const bf16_t* proj = (const bf16_t*)(a.ws + WS_PROJ); bf16_t* OA = (bf16_t*)(a.ws + WS_OA);
    const int vcu = (F.G % 8 == 0) ? (F.bid % 8) * (F.G / 8) + F.bid / 8 : F.bid;
    for (int i = 0;; ++i) {
        int bhm, qb;
        if (F.G == 256) { if (i >= 2) break; const int s_ = vcu & 7; bhm = vcu >> 3; qb = (i == 0) ? 15 - s_ : s_; }
        else { const int u = i * F.G + F.bid; if (u >= 512) break; bhm = u >> 4; qb = 15 - (u & 15); }
        const int b = bhm >> 3, h = (bhm >> 1) & 3, map = bhm & 1;
        const bf16_t* base = proj + (size_t)b * SEQ * INC;
        const float slope2 = exp2f(-2.0f * (h + 1)) * 1.4426950408889634f;
        attn_body::attn_unit<8>(qb, base + C_QDA + h * 128 + map * 64, base + C_KDA + h * 128 + map * 64, base + C_VDA + h * 128,
                                OA + (size_t)b * SEQ * 1024 + h * 256 + map * 128, slope2, (char*)F.lds);
    }
}
__device__ __forceinline__ void attn_combine(const Frame& F, const Args& a) {
    const bf16_t* OA = (const bf16_t*)(a.ws + WS_OA); bf16_t* Y = (bf16_t*)(a.ws + WS_YDA);
    const float lam = ((const float*)(a.ws + WS_SMALL))[0];
    const float g0 = a.in[I_SUBG][2 * F.lane] * 0.8f, g1 = a.in[I_SUBG][2 * F.lane + 1] * 0.8f;
    const int gw = F.bid * NWAVES + F.wave, NGW = F.G * NWAVES;
    for (int r = gw; r < T; r += NGW) {
        const unsigned* orow = (const unsigned*)(OA + (size_t)r * 1024); unsigned* yrow = (unsigned*)(Y + (size_t)r * 512);
        unsigned w0[4], w1[4];
#pragma unroll
        for (int h = 0; h < 4; ++h) { w0[h] = orow[h * 128 + F.lane]; w1[h] = orow[h * 128 + 64 + F.lane]; }
#pragma unroll
        for (int h = 0; h < 4; ++h) {
            const float x0 = bf2f(w0[h] & 0xffffu) - lam * bf2f(w1[h] & 0xffffu), x1 = bf2f(w0[h] >> 16) - lam * bf2f(w1[h] >> 16);
            const float rs = rsqrtf(wave_sum(x0 * x0 + x1 * x1) * (1.0f / 128.0f) + EPS);
            yrow[h * 64 + F.lane] = pk2(x0 * rs * g0, x1 * rs * g1);
        }
    }
}
namespace hg {
constexpr int QP = 136;
constexpr int L_QD = 0, L_KD = 64 * QP * 2, L_V = 2 * 64 * QP * 2, L_KE = 3 * 64 * QP * 2, L_SSQ = 4 * 64 * QP * 2, L_G = L_SSQ + 512, L_ST = L_G + 64 * QP * 2;
__device__ __forceinline__ f32x4 mfma16(bf16x8 a, bf16x8 b, f32x4 c) { return __builtin_amdgcn_mfma_f32_16x16x32_bf16(a, b, c, 0, 0, 0); }
#define HG_BAR() do { asm volatile("s_waitcnt lgkmcnt(0)" ::: "memory"); __builtin_amdgcn_s_barrier(); asm volatile("" ::: "memory"); } while (0)
typedef short v4i16_t __attribute__((ext_vector_type(4)));
__device__ __forceinline__ bf16x8 tr8(const LAS unsigned char* img, int ra, int rb, int col0, int lane) {
    const int q = (lane & 15) >> 2, p = lane & 3;
    const v4i16_t lo = __builtin_amdgcn_ds_read_tr16_b64_v4i16((LAS v4i16_t*)(img + ((ra + q) * QP + col0 + 4 * p) * 2));
    const v4i16_t hi = __builtin_amdgcn_ds_read_tr16_b64_v4i16((LAS v4i16_t*)(img + ((rb + q) * QP + col0 + 4 * p) * 2));
    return (bf16x8){lo[0], lo[1], lo[2], lo[3], hi[0], hi[1], hi[2], hi[3]};
}
struct Tile { u32x4 p[2]; };
__device__ __forceinline__ void tile_load(Tile& t, const bf16_t* src, size_t pitch, int tid) {
#pragma unroll
    for (int i = 0; i < 2; ++i) { const int pc = tid + NTHR * i; t.p[i] = *(const u32x4*)(src + (size_t)(pc >> 4) * pitch + (pc & 15) * 8); }
}
__device__ __forceinline__ void tile_put(const Tile& t, LAS unsigned char* img, int tid) {
#pragma unroll
    for (int i = 0; i < 2; ++i) { const int pc = tid + NTHR * i; *(LAS u32x4*)(img + ((pc >> 4) * QP + (pc & 15) * 8) * 2) = t.p[i]; }
}
struct In1 { Tile ke, v; };
__device__ __forceinline__ void load1(In1& r, const Frame& F, const Args& a, int unit) {
    const int bh = unit >> 6, n = unit & 63, b = bh >> 2, h = bh & 3; const size_t t0 = (size_t)b * SEQ + n * 64;
    tile_load(r.ke, (const bf16_t*)a.out + t0 * 512 + h * 128, 512, F.tid);
    tile_load(r.v, (const bf16_t*)(a.ws + WS_PROJ) + t0 * INC + C_IHG + h * 128, INC, F.tid);
}
__device__ __forceinline__ void stage1_unit(const In1& raw, const Frame& F, const Args& a, int unit) {
    const int bh = unit >> 6, n = unit & 63;
    tile_put(raw.ke, F.lds + L_KE, F.tid); tile_put(raw.v, F.lds + L_V, F.tid);
    HG_BAR();
    const int wk = F.wave >> 1, wv = F.wave & 1, fr = F.lane & 15, fq = F.lane >> 4;
    f32x4 acc[2][4];
#pragma unroll
    for (int i = 0; i < 2; ++i)
#pragma unroll
        for (int j = 0; j < 4; ++j) acc[i][j] = (f32x4){0.f, 0.f, 0.f, 0.f};
#pragma unroll
    for (int s2 = 0; s2 < 2; ++s2) {
        bf16x8 af[2], bv[4];
#pragma unroll
        for (int kt = 0; kt < 2; ++kt) af[kt] = tr8(F.lds + L_KE, 32 * s2 + 8 * fq, 32 * s2 + 8 * fq + 4, 32 * wk + 16 * kt, F.lane);
#pragma unroll
        for (int vt = 0; vt < 4; ++vt) bv[vt] = tr8(F.lds + L_V, 32 * s2 + 8 * fq, 32 * s2 + 8 * fq + 4, 64 * wv + 16 * vt, F.lane);
#pragma unroll
        for (int kt = 0; kt < 2; ++kt)
#pragma unroll
            for (int vt = 0; vt < 4; ++vt) acc[kt][vt] = mfma16(af[kt], bv[vt], acc[kt][vt]);
    }
    bf16_t* ds = (bf16_t*)(a.ws + WS_DS) + ((size_t)bh * 64 + n) * 16384;
#pragma unroll
    for (int kt = 0; kt < 2; ++kt)
#pragma unroll
        for (int vt = 0; vt < 4; ++vt) { const int v = 64 * wv + 16 * vt + fr, k = 32 * wk + 16 * kt + 4 * fq;
            u32x2 w; w.x = pk2(acc[kt][vt][0], acc[kt][vt][1]); w.y = pk2(acc[kt][vt][2], acc[kt][vt][3]); *(u32x2*)(ds + v * 128 + k) = w; }
    HG_BAR();
}
__device__ __forceinline__ void stage1_all(const Frame& F, const Args& a) {
    int u = F.bid; if (u >= 1024) return;
    In1 cur, nxt; load1(cur, F, a, u);
    for (; u < 1024; u += F.G) { const int un = (u + F.G < 1024) ? u + F.G : u; load1(nxt, F, a, un); stage1_unit(cur, F, a, u); cur = nxt; }
}
__device__ __forceinline__ void stage2_scan(const Frame& F, const Args& a) {
    unsigned* ds = (unsigned*)(a.ws + WS_DS); const float* dec = (const float*)(a.ws + WS_DEC);
    for (int gt = F.bid * NTHR + F.tid; gt < 16 * 8192; gt += F.G * NTHR) {
        const int bh = gt >> 13, e2 = gt & 8191, k = (2 * e2) & 127;
        unsigned* p = ds + (size_t)bh * 64 * 8192 + e2; const float* dp = dec + (size_t)bh * 64 * 128 + k;
        float s0 = 0.f, s1 = 0.f;
#pragma unroll 8
        for (int n = 0; n < 64; ++n) { const unsigned u = p[(size_t)n * 8192]; const f32x2 d = *(const f32x2*)(dp + n * 128);
            p[(size_t)n * 8192] = pk2(s0, s1); s0 = d.x * s0 + bf2f(u & 0xffffu); s1 = d.y * s1 + bf2f(u >> 16); }
    }
}
struct In3 { Tile qd, kd, v, g, st0, st1; };
__device__ __forceinline__ void load3(In3& r, const Frame& F, const Args& a, int unit) {
    const int bh = unit >> 6, n = unit & 63, b = bh >> 2, h = bh & 3;
    const bf16_t* base = (const bf16_t*)(a.ws + WS_PROJ) + ((size_t)b * SEQ + n * 64) * INC;
    tile_load(r.qd, base + C_HGT + 256 * h, INC, F.tid); tile_load(r.kd, base + C_HGT + 256 * h + 128, INC, F.tid); tile_load(r.v, base + C_IHG + h * 128, INC, F.tid);
    tile_load(r.g, base + C_GHG + h * 128, INC, F.tid);
    const bf16_t* sst = (const bf16_t*)(a.ws + WS_DS) + ((size_t)bh * 64 + n) * 16384;
    tile_load(r.st0, sst, 128, F.tid); tile_load(r.st1, sst + 64 * 128, 128, F.tid);
}
__device__ __forceinline__ void stage3_unit(const In3& raw, const Frame& F, const Args& a, int unit) {
    const int bh = unit >> 6, n = unit & 63, b = bh >> 2, h = bh & 3;
    const int tb = F.wave >> 1, vh = F.wave & 1, fr = F.lane & 15, fq = F.lane >> 4;
    tile_put(raw.qd, F.lds + L_QD, F.tid); tile_put(raw.kd, F.lds + L_KD, F.tid); tile_put(raw.v, F.lds + L_V, F.tid); tile_put(raw.g, F.lds + L_G, F.tid);
    tile_put(raw.st0, F.lds + L_ST, F.tid); tile_put(raw.st1, F.lds + L_ST + 64 * QP * 2, F.tid);
    HG_BAR();
    bf16x8 qf[4];
#pragma unroll
    for (int ks = 0; ks < 4; ++ks) qf[ks] = *(const LAS bf16x8*)(F.lds + L_QD + ((16 * tb + fr) * QP + 32 * ks + 8 * fq) * 2);
    unsigned pk[4][2];
#pragma unroll
    for (int jt = 0; jt < 4; ++jt) { pk[jt][0] = 0u; pk[jt][1] = 0u;
        if (jt <= tb) { f32x4 sc = (f32x4){0.f, 0.f, 0.f, 0.f};
#pragma unroll
            for (int ks = 0; ks < 4; ++ks) { const bf16x8 kf = *(const LAS bf16x8*)(F.lds + L_KD + ((16 * jt + fr) * QP + 32 * ks + 8 * fq) * 2); sc = mfma16(kf, qf[ks], sc); }
            if (jt == tb) {
#pragma unroll
                for (int r = 0; r < 4; ++r) if (4 * fq + r > fr) sc[r] = 0.f;
            }
            pk[jt][0] = cvt_pk_bf16(sc[0], sc[1]); pk[jt][1] = cvt_pk_bf16(sc[2], sc[3]); } }
    f32x4 o[4];
#pragma unroll
    for (int vt = 0; vt < 4; ++vt) o[vt] = (f32x4){0.f, 0.f, 0.f, 0.f};
#pragma unroll
    for (int s2 = 0; s2 < 2; ++s2) if (2 * s2 <= tb) {
        const u32x4 aw = (u32x4){pk[2 * s2][0], pk[2 * s2][1], pk[2 * s2 + 1][0], pk[2 * s2 + 1][1]};
        const bf16x8 af = __builtin_bit_cast(bf16x8, aw);
#pragma unroll
        for (int vt = 0; vt < 4; ++vt) o[vt] = mfma16(af, tr8(F.lds + L_V, 32 * s2 + 4 * fq, 32 * s2 + 16 + 4 * fq, 64 * vh + 16 * vt, F.lane), o[vt]);
    }
#pragma unroll
    for (int ks = 0; ks < 4; ++ks)
#pragma unroll
        for (int vt = 0; vt < 4; ++vt) { const bf16x8 sb = *(const LAS bf16x8*)(F.lds + L_ST + ((64 * vh + 16 * vt + fr) * QP + 32 * ks + 8 * fq) * 2); o[vt] = mfma16(qf[ks], sb, o[vt]); }
#pragma unroll
    for (int r = 0; r < 4; ++r) { float v = 0.f;
#pragma unroll
        for (int vt = 0; vt < 4; ++vt) v += o[vt][r] * o[vt][r];
        v = scan16(v);
        if (fr == 15) ((LAS float*)(F.lds + L_SSQ))[(tb * 2 + vh) * 16 + 4 * fq + r] = v; }
    HG_BAR();
    LAS float* SSQ = (LAS float*)(F.lds + L_SSQ);
    const size_t t0 = (size_t)b * SEQ + n * 64 + 16 * tb + 4 * fq;
    bf16_t* yp = (bf16_t*)(a.ws + WS_YHG) + t0 * 512 + h * 128 + 64 * vh + fr;
    const f32x4 ta = *(const LAS f32x4*)(SSQ + (tb * 2) * 16 + 4 * fq), tb4 = *(const LAS f32x4*)(SSQ + (tb * 2 + 1) * 16 + 4 * fq);
#pragma unroll
    for (int r = 0; r < 4; ++r) { const float rs = rsqrtf((ta[r] + tb4[r]) * (1.0f / 128.0f) + EPS);
#pragma unroll
        for (int vt = 0; vt < 4; ++vt) { const float g = bf2f(*(const LAS unsigned short*)(F.lds + L_G + ((16 * tb + 4 * fq + r) * QP + 64 * vh + 16 * vt + fr) * 2)); const float ng = a.in[I_HGNG][64 * vh + 16 * vt + fr];
            yp[(size_t)r * 512 + 16 * vt] = (bf16_t)f2bf(o[vt][r] * rs * ng * g * __builtin_amdgcn_rcpf(1.0f + __builtin_amdgcn_exp2f(-1.4426950408889634f * g))); } }
    HG_BAR();
}
__device__ __forceinline__ void stage3_all(const Frame& F, const Args& a) {
    int u = F.bid; if (u >= 1024) return;
    In3 cur, nxt; load3(cur, F, a, u);
    for (; u < 1024; u += F.G) { const int un = (u + F.G < 1024) ? u + F.G : u; load3(nxt, F, a, un); stage3_unit(cur, F, a, u); cur = nxt; }
}
constexpr int PP = 72;
constexpr int G4_L_P = 4 * 64 * QP * 2, G4_L_DEC = G4_L_P + 64 * PP * 2, G4_L_SSQ = G4_L_DEC + 512;
struct InA { Tile qd, kd, ke, v; f32x4 dec; };
__device__ __forceinline__ void loadA(InA& r, const Frame& F, const Args& a, int bh, int n) {
    const int b = bh >> 2, h = bh & 3; const size_t t0 = (size_t)b * SEQ + n * 64;
    const bf16_t* base = (const bf16_t*)(a.ws + WS_PROJ) + t0 * INC;
    tile_load(r.qd, base + C_HGT + 256 * h, INC, F.tid); tile_load(r.kd, base + C_HGT + 256 * h + 128, INC, F.tid);
    tile_load(r.ke, (const bf16_t*)a.out + t0 * 512 + h * 128, 512, F.tid); tile_load(r.v, base + C_IHG + h * 128, INC, F.tid);
    r.dec = *(const f32x4*)((const float*)(a.ws + WS_DEC) + ((size_t)bh * 64 + n) * 128 + 4 * (F.tid & 31));
}
__device__ __forceinline__ void grp_local(const Frame& F, const Args& a, int grp) {
    const int bh = grp >> 4, n0 = 4 * (grp & 15), b = bh >> 2, h = bh & 3, w = F.wave, lane = F.lane, fr = lane & 15, fq = lane >> 4;
    for (int i = F.tid; i < 64 * PP / 2; i += NTHR) ((LAS unsigned*)(F.lds + G4_L_P))[i] = 0u;
    f32x4 S[8];
#pragma unroll
    for (int kt = 0; kt < 8; ++kt) S[kt] = (f32x4){0.f, 0.f, 0.f, 0.f};
    InA cur, nxt; loadA(cur, F, a, bh, n0);
    unsigned short yk[4][4];
#define G4_STORE(nn) do { bf16_t* yp_ = (bf16_t*)(a.ws + WS_YHG) + ((size_t)b * SEQ + (nn) * 64 + 4 * fq) * 512 + h * 128 + 16 * w + fr; \
        _Pragma("unroll") for (int tb = 0; tb < 4; ++tb) _Pragma("unroll") for (int r = 0; r < 4; ++r) yp_[(size_t)(16 * tb + r) * 512] = yk[tb][r]; } while (0)
    for (int j = 0; j < 4; ++j) {
        if (j > 0) G4_STORE(n0 + j - 1);
        loadA(nxt, F, a, bh, n0 + (j < 3 ? j + 1 : 3));
        tile_put(cur.qd, F.lds + L_QD, F.tid); tile_put(cur.kd, F.lds + L_KD, F.tid); tile_put(cur.ke, F.lds + L_KE, F.tid); tile_put(cur.v, F.lds + L_V, F.tid);
        if (F.tid < 32) *(LAS f32x4*)(F.lds + G4_L_DEC + 16 * F.tid) = cur.dec;
        HG_BAR();
#pragma unroll
        for (int rep = 0; rep < 2; ++rep) { const int pi = w + 8 * rep;
            if (pi < 10) { const int tb = pi >= 6 ? 3 : pi >= 3 ? 2 : pi >= 1 ? 1 : 0, jt = pi - (tb * (tb + 1)) / 2;
                f32x4 sc = (f32x4){0.f, 0.f, 0.f, 0.f};
#pragma unroll
                for (int ks = 0; ks < 4; ++ks) { const bf16x8 kf = *(const LAS bf16x8*)(F.lds + L_KD + ((16 * jt + fr) * QP + 32 * ks + 8 * fq) * 2);
                    const bf16x8 qf = *(const LAS bf16x8*)(F.lds + L_QD + ((16 * tb + fr) * QP + 32 * ks + 8 * fq) * 2); sc = mfma16(kf, qf, sc); }
                if (jt == tb) {
#pragma unroll
                    for (int r = 0; r < 4; ++r) if (4 * fq + r > fr) sc[r] = 0.f;
                }
                *(LAS u32x2*)(F.lds + G4_L_P + ((16 * tb + fr) * PP + 16 * jt + 4 * fq) * 2) = (u32x2){cvt_pk_bf16(sc[0], sc[1]), cvt_pk_bf16(sc[2], sc[3])}; } }
        HG_BAR();
        bf16x8 bv[2];
#pragma unroll
        for (int s2 = 0; s2 < 2; ++s2) bv[s2] = tr8(F.lds + L_V, 32 * s2 + 8 * fq, 32 * s2 + 8 * fq + 4, 16 * w, lane);
        bf16x8 Sb[4];
#pragma unroll
        for (int ks = 0; ks < 4; ++ks) { const u32x4 t = (u32x4){cvt_pk_bf16(S[2 * ks][0], S[2 * ks][1]), cvt_pk_bf16(S[2 * ks][2], S[2 * ks][3]), cvt_pk_bf16(S[2 * ks + 1][0], S[2 * ks + 1][1]), cvt_pk_bf16(S[2 * ks + 1][2], S[2 * ks + 1][3])};
            Sb[ks] = __builtin_bit_cast(bf16x8, t); }
#pragma unroll
        for (int tb = 0; tb < 4; ++tb) { f32x4 o = (f32x4){0.f, 0.f, 0.f, 0.f};
#pragma unroll
            for (int s2 = 0; s2 <= (tb >> 1); ++s2) { const bf16x8 pf = *(const LAS bf16x8*)(F.lds + G4_L_P + ((16 * tb + fr) * PP + 32 * s2 + 8 * fq) * 2); o = mfma16(pf, bv[s2], o); }
            if (j > 0) {
#pragma unroll
                for (int ks = 0; ks < 4; ++ks) { const LAS unsigned char* qrow = F.lds + L_QD + ((16 * tb + fr) * QP + 32 * ks + 4 * fq) * 2;
                    const u32x2 lo = *(const LAS u32x2*)qrow, hi = *(const LAS u32x2*)(qrow + 32);
                    const u32x4 aw = (u32x4){lo.x, lo.y, hi.x, hi.y}; o = mfma16(__builtin_bit_cast(bf16x8, aw), Sb[ks], o); } }
#pragma unroll
            for (int r = 0; r < 4; ++r) yk[tb][r] = (unsigned short)f2bf(o[r]); }
#pragma unroll
        for (int kt = 0; kt < 8; ++kt) { S[kt] = S[kt] * *(const LAS f32x4*)(F.lds + G4_L_DEC + (16 * kt + 4 * fq) * 4);
#pragma unroll
            for (int s2 = 0; s2 < 2; ++s2) S[kt] = mfma16(tr8(F.lds + L_KE, 32 * s2 + 8 * fq, 32 * s2 + 8 * fq + 4, 16 * kt, lane), bv[s2], S[kt]); }
        HG_BAR();
        cur = nxt;
    }
    G4_STORE(n0 + 3);
#undef G4_STORE
    f32x4* sg = (f32x4*)(a.ws + WS_DS) + ((size_t)grp * 64 + w * 8) * 64 + lane;
#pragma unroll
    for (int kt = 0; kt < 8; ++kt) sg[kt * 64] = S[kt];
}
__device__ __forceinline__ void grp_scan(const Frame& F, const Args& a) {
    f32x4* sg = (f32x4*)(a.ws + WS_DS); f32x4* si = sg + (size_t)256 * 4096; const float* dec = (const float*)(a.ws + WS_DEC);
    for (int gt = F.bid * NTHR + F.tid; gt < 16 * 4096; gt += F.G * NTHR) {
        const int bh = gt >> 12, slot = gt & 4095, kt = (slot >> 6) & 7, lane = slot & 63, k = 16 * kt + 4 * (lane >> 4);
        f32x4 cur = (f32x4){0.f, 0.f, 0.f, 0.f};
#pragma unroll 4
        for (int g = 0; g < 16; ++g) { const size_t gi = ((size_t)(bh * 16 + g)) * 4096 + slot;
            si[gi] = cur;
            const float* dp = dec + ((size_t)bh * 64 + 4 * g) * 128 + k;
            const f32x4 d = (*(const f32x4*)dp * *(const f32x4*)(dp + 128)) * (*(const f32x4*)(dp + 256) * *(const f32x4*)(dp + 384));
            cur = d * cur + sg[gi]; }
    }
}
struct InC { Tile qd, g, ol; f32x4 dec; };
__device__ __forceinline__ void loadC(InC& r, const Frame& F, const Args& a, int bh, int n) {
    const int b = bh >> 2, h = bh & 3; const size_t t0 = (size_t)b * SEQ + n * 64;
    const bf16_t* base = (const bf16_t*)(a.ws + WS_PROJ) + t0 * INC;
    tile_load(r.qd, base + C_HGT + 256 * h, INC, F.tid); tile_load(r.g, base + C_GHG + h * 128, INC, F.tid);
    tile_load(r.ol, (const bf16_t*)(a.ws + WS_YHG) + t0 * 512 + h * 128, 512, F.tid);
    r.dec = *(const f32x4*)((const float*)(a.ws + WS_DEC) + ((size_t)bh * 64 + n) * 128 + 4 * (F.tid & 31));
}
__device__ __forceinline__ void grp_final(const Frame& F, const Args& a, int grp) {
    const int bh = grp >> 4, n0 = 4 * (grp & 15), b = bh >> 2, h = bh & 3, w = F.wave, lane = F.lane, fr = lane & 15, fq = lane >> 4;
    f32x4 S[8];
    { const f32x4* si = (const f32x4*)(a.ws + WS_DS) + (size_t)256 * 4096 + ((size_t)grp * 64 + w * 8) * 64 + lane;
#pragma unroll
      for (int kt = 0; kt < 8; ++kt) S[kt] = si[kt * 64]; }
    const float ng = a.in[I_HGNG][16 * w + fr];
    LAS float* SSQ = (LAS float*)(F.lds + G4_L_SSQ);
    InC cur, nxt; loadC(cur, F, a, bh, n0);
    unsigned short yk[4][4];
#define G4_STORE(nn) do { bf16_t* yp_ = (bf16_t*)(a.ws + WS_YHG) + ((size_t)b * SEQ + (nn) * 64 + 4 * fq) * 512 + h * 128 + 16 * w + fr; \
        _Pragma("unroll") for (int tb = 0; tb < 4; ++tb) _Pragma("unroll") for (int r = 0; r < 4; ++r) yp_[(size_t)(16 * tb + r) * 512] = yk[tb][r]; } while (0)
    for (int j = 0; j < 4; ++j) {
        if (j > 0) G4_STORE(n0 + j - 1);
        loadC(nxt, F, a, bh, n0 + (j < 3 ? j + 1 : 3));
        tile_put(cur.qd, F.lds + L_QD, F.tid); tile_put(cur.g, F.lds + L_KD, F.tid); tile_put(cur.ol, F.lds + L_V, F.tid);
        if (F.tid < 32) *(LAS f32x4*)(F.lds + G4_L_DEC + 16 * F.tid) = cur.dec;
        HG_BAR();
        bf16x8 Sb[4];
#pragma unroll
        for (int ks = 0; ks < 4; ++ks) { const u32x4 t = (u32x4){cvt_pk_bf16(S[2 * ks][0], S[2 * ks][1]), cvt_pk_bf16(S[2 * ks][2], S[2 * ks][3]), cvt_pk_bf16(S[2 * ks + 1][0], S[2 * ks + 1][1]), cvt_pk_bf16(S[2 * ks + 1][2], S[2 * ks + 1][3])};
            Sb[ks] = __builtin_bit_cast(bf16x8, t); }
        f32x4 o[4];
#pragma unroll
        for (int tb = 0; tb < 4; ++tb) {
#pragma unroll
            for (int r = 0; r < 4; ++r) o[tb][r] = bf2f(*(const LAS unsigned short*)(F.lds + L_V + ((16 * tb + 4 * fq + r) * QP + 16 * w + fr) * 2));
#pragma unroll
            for (int ks = 0; ks < 4; ++ks) { const LAS unsigned char* qrow = F.lds + L_QD + ((16 * tb + fr) * QP + 32 * ks + 4 * fq) * 2;
                const u32x2 lo = *(const LAS u32x2*)qrow, hi = *(const LAS u32x2*)(qrow + 32);
                const u32x4 aw = (u32x4){lo.x, lo.y, hi.x, hi.y}; o[tb] = mfma16(__builtin_bit_cast(bf16x8, aw), Sb[ks], o[tb]); }
#pragma unroll
            for (int r = 0; r < 4; ++r) { const float v = scan16(o[tb][r] * o[tb][r]); if (fr == 15) SSQ[w * 64 + 16 * tb + 4 * fq + r] = v; } }
#pragma unroll
        for (int kt = 0; kt < 8; ++kt) S[kt] = S[kt] * *(const LAS f32x4*)(F.lds + G4_L_DEC + (16 * kt + 4 * fq) * 4);
        HG_BAR();
#pragma unroll
        for (int tb = 0; tb < 4; ++tb) { f32x4 tot = (f32x4){0.f, 0.f, 0.f, 0.f};
#pragma unroll
            for (int ww = 0; ww < 8; ++ww) tot += *(const LAS f32x4*)(SSQ + ww * 64 + 16 * tb + 4 * fq);
#pragma unroll
            for (int r = 0; r < 4; ++r) { const float rs = rsqrtf(tot[r] * (1.0f / 128.0f) + EPS); const float g = bf2f(*(const LAS unsigned short*)(F.lds + L_KD + ((16 * tb + 4 * fq + r) * QP + 16 * w + fr) * 2));
                yk[tb][r] = (unsigned short)f2bf(o[tb][r] * rs * ng * g * __builtin_amdgcn_rcpf(1.0f + __builtin_amdgcn_exp2f(-1.4426950408889634f * g))); } }
        HG_BAR();
        cur = nxt;
    }
    G4_STORE(n0 + 3);
#undef G4_STORE
}
#undef HG_BAR
}

__device__ __forceinline__ float rs4(float a0, float a1, float a2, float a3, int lane) {
    const bool hi = (lane & 32) != 0;
    const float s0 = hi ? a0 : a2, s1 = hi ? a1 : a3;
    const float k0 = (hi ? a2 : a0) + __shfl_xor(s0, 32), k1 = (hi ? a3 : a1) + __shfl_xor(s1, 32);
    const bool b4 = (lane & 16) != 0;
    const float sd = b4 ? k0 : k1;
    float k = (b4 ? k1 : k0) + __shfl_xor(sd, 16);
    k += __shfl_xor(k, 8); k += __shfl_xor(k, 4); k += __shfl_xor(k, 2); k += __shfl_xor(k, 1);
    return k;
}
__device__ __forceinline__ void phase_router(const Frame& F, const Args& a) {
    constexpr int AP = 1032;
    LAS bf16_t* AH = (LAS bf16_t*)F.lds;
    LAS bf16_t* AL = AH + 16 * AP;
    LAS float* PART = (LAS float*)(F.lds + 2 * 16 * AP * 2);
    LAS float* LG = PART + 8 * 16 * 48;
    LAS unsigned* LH = (LAS unsigned*)(LG + 16 * 48);
    LAS unsigned* LB = LH + 32;
    LAS unsigned* LR = LH + 64;
    if (F.tid < NEXP) LH[F.tid] = 0u;
    const float* mod = (const float*)(a.ws + WS_MOD);
    const float* x1 = a.out; bf16_t* H2 = (bf16_t*)(a.ws + WS_ACT);
    unsigned* counts = (unsigned*)(a.ws + WS_CTL) + CW_COUNTS; unsigned* tokinfo = (unsigned*)(a.ws + WS_TOKINFO); int* toklist = (int*)(a.ws + WS_TOKLIST);
    const int rows_per_blk = T / F.G, r0 = F.bid * rows_per_blk, b = r0 / SEQ;
    const int lane = F.lane, w = F.wave, fr = lane & 15, fq = lane >> 4;
    f32x4 v[2][4], vn[2][4];
#define RT_LOAD(V, rb_) do { _Pragma("unroll") for (int q = 0; q < 2; ++q) { const f32x4* xr_ = (const f32x4*)(x1 + (size_t)((rb_) + 2 * w + q) * D) + lane; \
        _Pragma("unroll") for (int j = 0; j < 4; ++j) V[q][j] = xr_[64 * j]; } } while (0)
    RT_LOAD(v, r0);
    bf16x8 Bh[4][3], Bl[4][3];
    {
        const float* wre = a.in[I_WRE]; const float* wrg = a.in[I_WRG];
#pragma unroll
        for (int ks = 0; ks < 4; ++ks)
#pragma unroll
            for (int ct = 0; ct < 3; ++ct) {
                unsigned hw[4], lw[4];
#pragma unroll
                for (int jp = 0; jp < 4; ++jp) { float x[2];
#pragma unroll
                    for (int z = 0; z < 2; ++z) { const int k = 128 * w + 32 * ks + 8 * fq + 2 * jp + z;
                        if (ct == 0) { const float g = wrg[k * 4 + (fr & 3)], e = wre[k * 32 + ((fr + 28) & 31)]; x[z] = fr < 4 ? g : e; }
                        else if (ct == 1) x[z] = wre[k * 32 + 12 + fr];
                        else { const float e = wre[k * 32 + 28 + (fr & 3)]; x[z] = fr < 4 ? e : 0.f; } }
                    const unsigned h0 = f2bf(x[0]), h1 = f2bf(x[1]); hw[jp] = h0 | (h1 << 16);
                    lw[jp] = pk2(x[0] - bf2f(h0), x[1] - bf2f(h1)); }
                Bh[ks][ct] = __builtin_bit_cast(bf16x8, (u32x4){hw[0], hw[1], hw[2], hw[3]}); Bl[ks][ct] = __builtin_bit_cast(bf16x8, (u32x4){lw[0], lw[1], lw[2], lw[3]});
            }
    }
    for (int g = 0; g < rows_per_blk / 16; ++g) {
        const int rg = r0 + 16 * g;
        { const int gn = g + 1 < rows_per_blk / 16 ? g + 1 : g; RT_LOAD(vn, r0 + 16 * gn); }
#pragma unroll
        for (int q = 0; q < 2; ++q) { float sq = 0.f;
#pragma unroll
            for (int j = 0; j < 4; ++j) sq += (v[q][j].x * v[q][j].x + v[q][j].y * v[q][j].y) + (v[q][j].z * v[q][j].z + v[q][j].w * v[q][j].w);
            const float rs = rsqrtf(wave_sum(sq) * (1.0f / D) + EPS); const int row = 2 * w + q;
#pragma unroll
            for (int j = 0; j < 4; ++j) { const int k = 256 * j + 4 * lane;
                const f32x4 gg = *(const f32x4*)(a.in[I_N2G] + k) * (1.0f + *(const f32x4*)(mod + b * 6144 + 4 * 1024 + k)), sh = *(const f32x4*)(mod + b * 6144 + 3 * 1024 + k);
                const f32x4 hv = v[q][j] * rs * gg + sh;
                const unsigned h0 = f2bf(hv.x), h1 = f2bf(hv.y), h2_ = f2bf(hv.z), h3 = f2bf(hv.w);
                const u32x2 hw = (u32x2){h0 | (h1 << 16), h2_ | (h3 << 16)};
                *(u32x2*)(H2 + (size_t)(rg + row) * D + k) = hw;
                *(LAS u32x2*)(AH + row * AP + k) = hw;
                *(LAS u32x2*)(AL + row * AP + k) = (u32x2){pk2(hv.x - bf2f(h0), hv.y - bf2f(h1)), pk2(hv.z - bf2f(h2_), hv.w - bf2f(h3))}; } }
        __syncthreads();
        f32x4 acc[3] = {{0.f, 0.f, 0.f, 0.f}, {0.f, 0.f, 0.f, 0.f}, {0.f, 0.f, 0.f, 0.f}};
#pragma unroll
        for (int ks = 0; ks < 4; ++ks) { const bf16x8 ah = *(const LAS bf16x8*)(AH + fr * AP + 128 * w + 32 * ks + 8 * fq), al = *(const LAS bf16x8*)(AL + fr * AP + 128 * w + 32 * ks + 8 * fq);
#pragma unroll
            for (int ct = 0; ct < 3; ++ct) { acc[ct] = __builtin_amdgcn_mfma_f32_16x16x32_bf16(ah, Bh[ks][ct], acc[ct], 0, 0, 0);
                acc[ct] = __builtin_amdgcn_mfma_f32_16x16x32_bf16(al, Bh[ks][ct], acc[ct], 0, 0, 0); acc[ct] = __builtin_amdgcn_mfma_f32_16x16x32_bf16(ah, Bl[ks][ct], acc[ct], 0, 0, 0); } }
#pragma unroll
        for (int ct = 0; ct < 3; ++ct)
#pragma unroll
            for (int r = 0; r < 4; ++r) PART[(w * 16 + 4 * fq + r) * 48 + 16 * ct + fr] = acc[ct][r];
        __syncthreads();
        for (int t = F.tid; t < 16 * 48; t += NTHR) { const int row = t / 48, o = t % 48; float sacc = 0.f;
#pragma unroll
            for (int ww = 0; ww < 8; ++ww) sacc += PART[(ww * 16 + row) * 48 + o];
            if (o < 36) LG[row * 48 + o] = sacc + (o < 4 ? a.in[I_BRG][o & 3] : a.in[I_BRE][(o + 28) & 31]); }
        __syncthreads();
        if (F.tid < 16) {
            const LAS float* lg = LG + F.tid * 48;
            float gl[4]; int gi = 0;
#pragma unroll
            for (int o = 0; o < 4; ++o) gl[o] = lg[o];
            float gm = gl[0];
#pragma unroll
            for (int o = 1; o < 4; ++o) if (gl[o] > gm) { gm = gl[o]; gi = o; }
            float gsum = 0.f;
#pragma unroll
            for (int o = 0; o < 4; ++o) gsum += expf(gl[o] - gm);
            const float gp = 1.0f / gsum;
            float el[8];
#pragma unroll
            for (int e = 0; e < 8; ++e) el[e] = lg[4 + gi * 8 + e];
            int i0 = 0; float m0 = el[0];
#pragma unroll
            for (int o = 1; o < 8; ++o) if (el[o] > m0) { m0 = el[o]; i0 = o; }
            int i1 = -1; float m1 = -INFINITY;
#pragma unroll
            for (int o = 0; o < 8; ++o) if (o != i0 && el[o] > m1) { m1 = el[o]; i1 = o; }
            const float e1 = expf(m1 - m0); const float w0 = gp / (1.0f + e1), w1 = gp * e1 / (1.0f + e1);
            const int rl = 16 * g + F.tid, ex0 = gi * 8 + i0, ex1 = gi * 8 + i1;
            const unsigned l0 = atomicAdd((unsigned*)(LH + ex0), 1u), l1 = atomicAdd((unsigned*)(LH + ex1), 1u);
            LAS unsigned* ri = LR + rl * 6;
            ri[0] = (unsigned)ex0; ri[1] = l0; ri[2] = (unsigned)ex1; ri[3] = l1; ri[4] = __float_as_uint(w0); ri[5] = __float_as_uint(w1);
        }
#pragma unroll
        for (int q = 0; q < 2; ++q)
#pragma unroll
            for (int j = 0; j < 4; ++j) v[q][j] = vn[q][j];
    }
#undef RT_LOAD
    __syncthreads();
    if (F.tid < NEXP) LB[F.tid] = atomicAdd(counts + 64 * F.tid, LH[F.tid]);
    __syncthreads();
    for (int rl = F.tid; rl < rows_per_blk; rl += NTHR) {
        const LAS unsigned* ri = LR + rl * 6; const int r = r0 + rl;
        const unsigned ex0 = ri[0], ex1 = ri[2], k0 = LB[ex0] + ri[1], k1 = LB[ex1] + ri[3];
        toklist[ex0 * T + k0] = r; toklist[ex1 * T + k1] = r;
        u32x4 t0; t0.x = ex0; t0.y = k0; t0.z = ex1; t0.w = k1;
        *(u32x4*)(tokinfo + (size_t)r * 8) = t0;
        tokinfo[(size_t)r * 8 + 4] = ri[4]; tokinfo[(size_t)r * 8 + 5] = ri[5];
    }
}
__device__ __forceinline__ void build_moe_tab(const Frame& F, const Args& a, LAS MoeTab* tab) {
    if (F.tid == 0) {
        const unsigned* counts = (const unsigned*)(a.ws + WS_CTL) + CW_COUNTS; int nt = 0;
        for (int e = 0; e < NEXP; ++e) { const int c = (int)__hip_atomic_load(counts + 64 * e, __ATOMIC_RELAXED, __HIP_MEMORY_SCOPE_AGENT); tab->cnt[e] = c; tab->tbase[e] = nt;
            const int n = (c + 255) >> 8; for (int m = 0; m < n; ++m) { tab->tile_e[nt] = e; tab->tile_m[nt] = m; ++nt; } }
        tab->tbase[NEXP] = nt; tab->nt = nt;
    }
    __syncthreads();
}
__device__ __forceinline__ void phase_final(const Frame& F, const Args& a, const LAS MoeTab* tab) {
    const float* mod = (const float*)(a.ws + WS_MOD); const unsigned* tokinfo = (const unsigned*)(a.ws + WS_TOKINFO); const bf16_t* Ys = (const bf16_t*)(a.ws + WS_YS);
    const int rows_per_blk = T / F.G, r0 = F.bid * rows_per_blk;
    for (int r = r0 + F.wave; r < r0 + rows_per_blk; r += NWAVES) {
        const int b = r / SEQ;
        const u32x4 ti = *(const u32x4*)(tokinfo + (size_t)r * 8);
        const float w0 = __uint_as_float(tokinfo[(size_t)r * 8 + 4]), w1 = __uint_as_float(tokinfo[(size_t)r * 8 + 5]);
        const size_t s0 = (size_t)tab->tbase[ti.x] * 256 + ti.y, s1 = (size_t)tab->tbase[ti.z] * 256 + ti.w;
        f32x4* xr = (f32x4*)(a.out + (size_t)r * D) + F.lane;
        const u32x2* y0 = (const u32x2*)(Ys + s0 * D) + F.lane; const u32x2* y1 = (const u32x2*)(Ys + s1 * D) + F.lane;
        f32x4 v[4]; float s = 0.f;
#pragma unroll
        for (int j = 0; j < 4; ++j) { const int k = 256 * j + 4 * F.lane;
            const f32x4 gt = *(const f32x4*)(mod + b * 6144 + 5 * 1024 + k); const u32x2 a0 = y0[64 * j], a1 = y1[64 * j];
            f32x4 m; m.x = w0 * bf2f(a0.x & 0xffffu) + w1 * bf2f(a1.x & 0xffffu); m.y = w0 * bf2f(a0.x >> 16) + w1 * bf2f(a1.x >> 16);
            m.z = w0 * bf2f(a0.y & 0xffffu) + w1 * bf2f(a1.y & 0xffffu); m.w = w0 * bf2f(a0.y >> 16) + w1 * bf2f(a1.y >> 16);
            v[j] = xr[64 * j] + gt * m; s += (v[j].x * v[j].x + v[j].y * v[j].y) + (v[j].z * v[j].z + v[j].w * v[j].w); }
        const float rs = rsqrtf(wave_sum(s) * (1.0f / D) + EPS);
#pragma unroll
        for (int j = 0; j < 4; ++j) { const f32x4 g = *(const f32x4*)(a.in[I_FG] + 256 * j + 4 * F.lane); xr[64 * j] = v[j] * rs * g; }
    }
}

#define XB_TMO      128
#define XB_XCNT(j)  (256  + 64 * (j))
#define XB_XSUB(j)  (1280 + 64 * (j))
#define XB_XGEN(j)  (2304 + 64 * (j))
#define XB_TOP      3328
#define XB_TOPGEN   3392
#define XCD_BAR_WORDS 3456
#define XB_SPIN_CAP (1u << 18)
__device__ __forceinline__ unsigned xb_ld(unsigned* p)              { return __hip_atomic_load(p, __ATOMIC_RELAXED, __HIP_MEMORY_SCOPE_AGENT); }
__device__ __forceinline__ unsigned xb_add(unsigned* p, unsigned v) { return __hip_atomic_fetch_add(p, v, __ATOMIC_RELAXED, __HIP_MEMORY_SCOPE_AGENT); }
__device__ __forceinline__ unsigned xb_xcc_id() { return (unsigned)__builtin_amdgcn_s_getreg((3 << 11) | 20) & 0xFu; }
#define XB_SPIN(cond, bar) do { unsigned _sp = 0; while (cond) { __builtin_amdgcn_s_sleep(1); \
    if ((++_sp & 255u) == 0u) { if (xb_ld(&(bar)[XB_TMO])) break; if (_sp > XB_SPIN_CAP) { atomicAdd(&(bar)[XB_TMO], 1u); break; } } } } while (0)
struct XcdBarrier { unsigned* bar; unsigned x; volatile LAS unsigned* st; };
__device__ __forceinline__ XcdBarrier xcd_barrier_post(unsigned* bar, volatile LAS unsigned* st) {
    XcdBarrier b; b.bar = bar; b.x = xb_xcc_id(); b.st = st;
    if (threadIdx.x == 0) (void)xb_add(&bar[XB_XCNT(b.x)], 1u);
    return b;
}
__device__ __forceinline__ void xcd_barrier_complete(unsigned* bar, unsigned x, unsigned& nloc, unsigned& nx) {
    const unsigned G = gridDim.x * gridDim.y * gridDim.z;
    unsigned sum, cnt, mine, sp = 0u;
    for (;;) {
        sum = 0u; cnt = 0u; mine = 0u;
#pragma unroll
        for (unsigned j = 0; j < 16; ++j) { const unsigned c = xb_ld(&bar[XB_XCNT(j)]); sum += c; cnt += (c > 0u) ? 1u : 0u; mine = (j == x) ? c : mine; }
        if (sum == G) break;
        __builtin_amdgcn_s_sleep(1);
        if ((++sp & 255u) == 0u) { if (xb_ld(&bar[XB_TMO])) break; if (sp > XB_SPIN_CAP) { atomicAdd(&bar[XB_TMO], 1u); break; } }
    }
    nloc = mine > 0u ? mine : 1u; nx = cnt > 0u ? cnt : 1u;
}
__device__ __forceinline__ void xcd_barrier(const XcdBarrier& b) {
    asm volatile("s_waitcnt vmcnt(0)" ::: "memory");
    __syncthreads();
    if (threadIdx.x == 0) {
        unsigned* bar = b.bar;
        __builtin_amdgcn_s_waitcnt(0);
        unsigned nloc = b.st[0], nx = b.st[1];
        if (nloc == 0u) { xcd_barrier_complete(bar, b.x, nloc, nx); b.st[0] = nloc; b.st[1] = nx; }
        const unsigned old = xb_add(&bar[XB_XSUB(b.x)], 1u);
        const unsigned gen = old / nloc;
        if (old + 1u == (gen + 1u) * nloc) {
            __builtin_amdgcn_fence(__ATOMIC_RELEASE, "agent");
            asm volatile("s_waitcnt vmcnt(0)" ::: "memory");
            const unsigned og = xb_add(&bar[XB_TOP], 1u);
            const unsigned tg = og / nx;
            if (og + 1u == (tg + 1u) * nx) xb_add(&bar[XB_TOPGEN], 1u);
            else XB_SPIN(xb_ld(&bar[XB_TOPGEN]) == tg, bar);
            __builtin_amdgcn_fence(__ATOMIC_ACQUIRE, "agent");
            xb_add(&bar[XB_XGEN(b.x)], 1u);
            asm volatile("s_waitcnt vmcnt(0)" ::: "memory");
        } else {
            XB_SPIN(xb_ld(&bar[XB_XGEN(b.x)]) == gen, bar);
            __builtin_amdgcn_fence(__ATOMIC_ACQUIRE, "agent");
            asm volatile("s_waitcnt vmcnt(0)" ::: "memory");
        }
    }
    __syncthreads();
}

constexpr int N_PHASES = 11;
__global__ void __launch_bounds__(NTHR, 2) mk_fwd(Args a) {
    extern __shared__ __attribute__((aligned(16))) unsigned char lds_raw[];
    Frame F; F.lds = (LAS unsigned char*)lds_raw; F.tid = threadIdx.x; F.lane = F.tid & 63; F.wave = __builtin_amdgcn_readfirstlane(F.tid >> 6); F.G = gridDim.x; F.bid = blockIdx.x;
    unsigned char* ws = a.ws;
    const int lo = a.ph_lo, hi = a.ph_hi;
#if MK_N_LAUNCHES == 1
    volatile LAS unsigned* MISC = (volatile LAS unsigned*)(F.lds + 152 * 1024);
    if (F.tid < 4) MISC[F.tid] = 0u;
    __syncthreads();
    XcdBarrier xbar = xcd_barrier_post((unsigned*)(ws + WS_CTL) + CW_BAR, MISC);
#ifndef PROBE_TS
#define PROBE_TS -1
#endif
#define STAMP(k) do { if (PROBE_TS >= 0 && F.bid == 0 && F.tid == 0) { const unsigned long long t_ = __builtin_amdgcn_s_memrealtime(); MISC[16 + 2 * (k)] = (unsigned)t_; MISC[17 + 2 * (k)] = (unsigned)(t_ >> 32); } } while (0)
#define SEAM(k) do { if (IN(k) && IN((k) + 1)) xcd_barrier(xbar); STAMP((k) + 1); } while (0)
    STAMP(0);
#else
#define SEAM(k) do { } while (0)
#endif
#ifndef PHASE_MASK
#define PHASE_MASK 0x7ff
#endif
#define IN(k) (((PHASE_MASK >> (k)) & 1) && lo <= (k) && (k) < hi)
    LAS MoeTab* tab = (LAS MoeTab*)(F.lds + 144 * 1024);

#ifndef REPEAT_PHASE
#define REPEAT_PHASE -1
#endif
#if MK_N_LAUNCHES == 1
#define RUNPH(k, ...) if (IN(k)) { F.lane = lane_now(); F.tid = F.wave * 64 + F.lane; __VA_ARGS__ if (REPEAT_PHASE == (k)) { xcd_barrier(xbar); __VA_ARGS__ } }
#else
#define RUNPH(k, ...) if (IN(k)) { F.lane = lane_now(); F.tid = F.wave * 64 + F.lane; __VA_ARGS__ }
#endif
    RUNPH(0, { phase0(F, a); }) SEAM(0);
    RUNPH(1, { phase1(F, a); }) SEAM(1);
    RUNPH(2, {
        DenseOrder S{(const char*)(ws + WS_ACT), (const char*)(ws + WS_WIN), D, T / 256, INC / 256, F.G, F.bid};
        EpiInProj E{(bf16_t*)(ws + WS_PROJ), (bf16_t*)a.out, (float*)(ws + WS_DEC), (const float*)(ws + WS_SMALL) + 16, attn_body::C2};
        pg8::gemm_phase(F.lds, D, S, E);
    }) SEAM(2);
    RUNPH(3, {
        for (int g = F.bid; g < 256; g += F.G) hg::grp_local(F, a, g);
        __syncthreads();
        attn_phase(F, a);
    }) SEAM(3);
    RUNPH(4, { hg::grp_scan(F, a); attn_combine(F, a); }) SEAM(4);
    RUNPH(5, { for (int g = F.bid; g < 256; g += F.G) hg::grp_final(F, a, g); }) SEAM(5);
    RUNPH(6, {
        UpOrder S{(const char*)(ws + WS_YDA), (const char*)(ws + WS_YHG), (const char*)(ws + WS_WUPDA), (const char*)(ws + WS_WUPHG), F.G, F.bid};
        EpiUp E{(const bf16_t*)(ws + WS_PROJ), (bf16_t*)(ws + WS_ACT)};
        pg8::gemm_phase(F.lds, 512, S, E);
    }) SEAM(6);
    RUNPH(7, {
        DenseOrder S{(const char*)(ws + WS_ACT), (const char*)(ws + WS_WOUT), D, T / 256, D / 256, F.G, F.bid};
        EpiOut E{a.in[I_X], (const float*)(ws + WS_MOD), a.out};
        pg8::gemm_phase(F.lds, D, S, E);
        moe_weight_convert(F, a);
    }) SEAM(7);
    RUNPH(8, { phase_router(F, a); __syncthreads(); }) SEAM(8);
    RUNPH(9, {
        build_moe_tab(F, a, tab);
        unsigned* done = (unsigned*)(ws + WS_CTL) + CW_TILE;
        { Moe1Order S{tab, (const char*)(ws + WS_ACT), (const char*)(ws + WS_W13), (const int*)(ws + WS_TOKLIST), F.G, F.bid};
          EpiMoe1 E{(bf16_t*)(ws + WS_HS), done};
          pg8::gemm_phase(F.lds, D, S, E); }
        { Moe2Order S{tab, (const char*)(ws + WS_HS), (const char*)(ws + WS_W2), done, (unsigned*)(ws + WS_CTL) + CW_TMO, F.G, F.bid};
          EpiStoreBf16 E{(bf16_t*)(ws + WS_YS), D, 0, 1.0f};
          pg8::gemm_phase(F.lds, DEXP, S, E); }
    }) SEAM(9);
    RUNPH(10, { build_moe_tab(F, a, tab); phase_final(F, a, tab); })
#if MK_N_LAUNCHES == 1
    if (PROBE_TS >= 0) {
        __syncthreads(); STAMP(11);
        if (F.bid == 0 && F.tid == 0) {
            const int ka = PROBE_TS & 15, kb = (PROBE_TS >> 4) & 15;
            const unsigned long long a0 = ((unsigned long long)MISC[17 + 2 * ka] << 32) | MISC[16 + 2 * ka], a1 = ((unsigned long long)MISC[19 + 2 * ka] << 32) | MISC[18 + 2 * ka];
            const unsigned long long b0 = ((unsigned long long)MISC[17 + 2 * kb] << 32) | MISC[16 + 2 * kb], b1 = ((unsigned long long)MISC[19 + 2 * kb] << 32) | MISC[18 + 2 * kb];
            const float da = (float)(a1 - a0) * 0.01f, db = (float)(b1 - b0) * 0.01f;
            asm volatile("s_waitcnt vmcnt(0)" ::: "memory");
            a.out[0] += sqrtf(da * 16.78f); a.out[1] += db * 0.1f;
        }
    }
#endif
#undef IN
#undef SEAM
}

extern "C" void kernel_launch(void* const* d_in, const int* in_sizes, int n_in, void* d_out, int out_size, void* d_ws, size_t ws_size, hipStream_t stream) {
    static int grid = 0;
    if (grid == 0) {
        if (n_in != 25 || in_sizes[0] != T * D || out_size != T * D || ws_size < WS_END) { fprintf(stderr, "kernel_launch: unexpected shapes (n_in %d, in0 %d, out %d, ws %zu)\n", n_in, n_in > 0 ? in_sizes[0] : -1, out_size, ws_size); grid = -1; return; }
        int dev = 0, cus = 0, per_cu = 0;
        if (hipGetDevice(&dev) != hipSuccess || hipDeviceGetAttribute(&cus, hipDeviceAttributeMultiprocessorCount, dev) != hipSuccess) { grid = -1; return; }
        if (hipFuncSetAttribute((const void*)mk_fwd, hipFuncAttributeMaxDynamicSharedMemorySize, LDS_BYTES) != hipSuccess) { fprintf(stderr, "kernel_launch: hipFuncSetAttribute failed\n"); grid = -1; return; }
        if (hipOccupancyMaxActiveBlocksPerMultiprocessor(&per_cu, (const void*)mk_fwd, NTHR, LDS_BYTES) != hipSuccess || per_cu < 1) { fprintf(stderr, "kernel_launch: occupancy query says %d\n", per_cu); per_cu = 1; }
        (void)hipGetLastError();
        grid = cus;
        if (grid > 256) grid = 256;
        while (T % grid) --grid;
    }
    if (grid < 0) return;
    (void)hipMemsetAsync((char*)d_ws + WS_CTL, 0, CTL_ZERO_BYTES, stream);
    Args a{};
    for (int i = 0; i < 25; ++i) a.in[i] = (const float*)d_in[i];
    a.out = (float*)d_out; a.ws = (unsigned char*)d_ws;
#if MK_N_LAUNCHES == 1
    a.ph_lo = 0; a.ph_hi = N_PHASES;
    void* args[] = {&a};
    hipError_t e = hipLaunchCooperativeKernel((const void*)mk_fwd, dim3(grid), dim3(NTHR), args, LDS_BYTES, stream);
    if (e != hipSuccess) fprintf(stderr, "cooperative launch failed: %s (grid %d)\n", hipGetErrorString(e), grid);
#else
    for (int p = 0; p < N_PHASES; ++p) {
        a.ph_lo = p; a.ph_hi = p + 1;
        hipLaunchKernelGGL(mk_fwd, dim3(grid), dim3(NTHR), LDS_BYTES, stream, a);
    }
#endif
}
```

```cpp
#include <hip/hip_runtime.h>
#include <hip/hip_cooperative_groups.h>
#include <cstdio>
#include <cstdint>
namespace cg = cooperative_groups;

#ifndef MK_N_LAUNCHES
#define MK_N_LAUNCHES 1
#endif

#define LAS __attribute__((address_space(3)))
typedef unsigned short bf16_t;
typedef short bf16x8 __attribute__((ext_vector_type(8)));
typedef float f32x4 __attribute__((ext_vector_type(4)));
typedef float f32x2 __attribute__((ext_vector_type(2)));
typedef unsigned u32x4 __attribute__((ext_vector_type(4)));
typedef unsigned u32x2 __attribute__((ext_vector_type(2)));

constexpr int NB = 4, SEQ = 4096, D = 1024, T = NB * SEQ;
constexpr int INC = 5632;
constexpr int C_QDA = 0, C_KDA = 512, C_VDA = 1024, C_QHG = 1536, C_FHG = 2048, C_IHG = 2560, C_GHG = 3072, C_GDA = 3584, C_GHGATE = 4608;
constexpr int C_HGT = 1536;
constexpr int NEXP = 32, DEXP = 512;
constexpr int PMAX = 40960;
constexpr float EPS = 1e-6f;
constexpr int NWAVES = 8, NTHR = 512;

constexpr size_t MiB = 1u << 20;
constexpr size_t WS_CTL = 0, CTL_ZERO_BYTES = 64 * 1024;
constexpr size_t WS_MODP = 1 * MiB;
constexpr size_t WS_MOD = 5 * MiB / 2;
constexpr size_t WS_SMALL = 11 * MiB / 4;
constexpr size_t WS_TOKINFO = 3 * MiB;
constexpr size_t WS_TOKLIST = 4 * MiB;
constexpr size_t WS_DEC = 6 * MiB;
constexpr size_t WS_DS = 24 * MiB;
constexpr size_t WS_WIN = 8 * MiB;
constexpr size_t WS_WUPDA = 20 * MiB, WS_WUPHG = 21 * MiB, WS_WOUT = 22 * MiB;
constexpr size_t WS_ACT = 24 * MiB;
constexpr size_t WS_PROJ = 56 * MiB;
constexpr size_t WS_YDA = 232 * MiB, WS_YHG = 248 * MiB;
constexpr size_t WS_OA = 264 * MiB;
constexpr size_t WS_W13 = 56 * MiB;
constexpr size_t WS_W2 = 120 * MiB;
constexpr size_t WS_HS = 152 * MiB;
constexpr size_t WS_YS = 192 * MiB;
constexpr size_t WS_END = 296 * MiB;
constexpr int CW_COUNTS = 64;
constexpr int CW_BAR = 4096;
constexpr int CW_TILE = 8192;
constexpr int CW_TMO = 32;

constexpr int LDS_BYTES = 160 * 1024;

__device__ __forceinline__ float bf2f(unsigned v) { return __uint_as_float(v << 16); }
__device__ __forceinline__ unsigned f2bf(float f) { unsigned u = __float_as_uint(f); return (u + 0x7fffu + ((u >> 16) & 1u)) >> 16; }
__device__ __forceinline__ unsigned pk2(float lo, float hi) { return f2bf(lo) | (f2bf(hi) << 16); }
__device__ __forceinline__ float sigmoidf_(float x) { return 1.0f / (1.0f + __expf(-x)); }
__device__ __forceinline__ float siluf_(float x) { return x / (1.0f + __expf(-x)); }
__device__ __forceinline__ int lane_now() { int l; asm volatile("v_mbcnt_lo_u32_b32 %0, -1, 0\n\tv_mbcnt_hi_u32_b32 %0, -1, %0" : "=v"(l)); return l; }
__device__ __forceinline__ float wave_sum(float v) {
#pragma unroll
    for (int o = 1; o < 64; o <<= 1) v += __shfl_xor(v, o);
    return v;
}

namespace pg8 {
constexpr int BM = 256, BK = 64, HALF = 128, HTB = HALF * BK * 2, STAGE_BYTES = 8 * HTB;
__host__ __device__ __forceinline__ int lds_byte(int r, int c) { const int st = (r >> 4) * 2 + (c >> 5), rr = r & 15, cc = c & 31, ob = rr * 64 + cc * 2; return st * 1024 + (ob ^ (((ob >> 9) & 1) << 5)); }
__host__ __device__ __forceinline__ void stage_rc(int b, int& R, int& C) { const int st = b / 1024, sb = b % 1024, swz = sb ^ (((sb >> 9) & 1) << 5); R = (st >> 1) * 16 + swz / 64; C = (st & 1) * 32 + (swz % 64) / 2; }
__host__ __device__ __forceinline__ int perm32(int rho) { const int n = rho >> 4, i = rho & 15; return 8 * (i >> 2) + 4 * n + (i & 3); }

struct Unit { int pm, pn; const char* A; const char* B; int aux; };
__device__ __forceinline__ unsigned cvt_pk_bf16(float lo, float hi) { unsigned r; asm volatile("v_cvt_pk_bf16_f32 %0, %1, %2" : "=v"(r) : "v"(lo), "v"(hi)); return r; }

template <class Epi, class Sched>
__device__ __forceinline__ void gemm_phase(LAS unsigned char* lds, const int K, const Sched& S, const Epi& E) {
    const int tid = threadIdx.x, wid = __builtin_amdgcn_readfirstlane(tid >> 6), lane = tid & 63, wr = wid >> 2, wc = wid & 3, fr = lane & 15, fq = lane >> 4;
    const int nt = K / BK;
    unsigned voffB[2];
#define PG8_SETLANE() do { const int _l = lane_now(), _t = wid * 64 + _l; _Pragma("unroll") for (int _i = 0; _i < 2; ++_i) { int _R, _C; stage_rc(_t * 16 + _i * 8192, _R, _C); \
        const int _Rb = Epi::PERM ? ((_R & ~31) + perm32(_R & 31)) : _R; voffB[_i] = (unsigned)(_Rb * K + _C) * 2u; } \
        aoff = lds_byte(wr * 64 + (_l & 15), (_l >> 4) * 8); boff = lds_byte(wc * 32 + (_l & 15), (_l >> 4) * 8); } while (0)
    const size_t kstep = (size_t)(BK * 2);
    const size_t hstep = (size_t)HALF * K * 2;
    const unsigned ldsw = (unsigned)wid * 1024u;
    int aoff, boff; PG8_SETLANE();
#define PG8_SA(b, h) (((b) * 2 + (h)) * HTB)
#define PG8_SB(b, h) ((4 + (b) * 2 + (h)) * HTB)
#define PG8_STAGE(bufoff, gbase, voff) do { _Pragma("unroll") for (int _i = 0; _i < 2; ++_i) \
        __builtin_amdgcn_global_load_lds((const unsigned*)((const char*)(gbase) + (voff)[_i]), (LAS unsigned*)(lds + (bufoff) + ldsw + _i * 8192), 16, 0, 0); } while (0)
#define PG8_LDA(dst, b, h) do { _Pragma("unroll") for (int m = 0; m < 4; ++m) _Pragma("unroll") for (int k = 0; k < 2; ++k) dst[m][k] = *(const LAS bf16x8*)(lds + PG8_SA(b, h) + aoff + m * 2048 + k * 1024); } while (0)
#define PG8_LDB(dst, b, h) do { _Pragma("unroll") for (int n = 0; n < 2; ++n) _Pragma("unroll") for (int k = 0; k < 2; ++k) dst[n][k] = *(const LAS bf16x8*)(lds + PG8_SB(b, h) + boff + n * 2048 + k * 1024); } while (0)
#define PG8_MMA(ai, bj, At, Bt) do { __builtin_amdgcn_s_setprio(1); _Pragma("unroll") for (int m = 0; m < 4; ++m) _Pragma("unroll") for (int n = 0; n < 2; ++n) _Pragma("unroll") for (int k = 0; k < 2; ++k) \
        acc[ai][bj][m][n] = __builtin_amdgcn_mfma_f32_16x16x32_bf16(Bt[n][k], At[m][k], acc[ai][bj][m][n], 0, 0, 0); __builtin_amdgcn_s_setprio(0); } while (0)
#define PG8_WAIT_V(n) asm volatile("s_waitcnt vmcnt(" #n ")" ::: "memory")
#define PG8_WAIT_L(n) asm volatile("s_waitcnt lgkmcnt(" #n ")" ::: "memory")
#define PG8_BAR __builtin_amdgcn_s_barrier()
#define PG8_SCHED __builtin_amdgcn_sched_barrier(0)
#define PG8_SETA(vo, u) do { const int _t = wid * 64 + lane_now(); _Pragma("unroll") for (int _i = 0; _i < 2; ++_i) { int _R, _C; stage_rc(_t * 16 + _i * 8192, _R, _C); \
        _Pragma("unroll") for (int _h = 0; _h < 2; ++_h) vo[_h][_i] = (unsigned)((size_t)S.arow(u, _h * HALF + _R) * (size_t)K + _C) * 2u; } if (Sched::GATHER) PG8_WAIT_V(0); } while (0)
    Unit cur, nxt; int ui = 0;
    if (!S.next(0, cur)) return;
    f32x4 acc[2][2][4][2];
#pragma unroll
    for (int a = 0; a < 2; ++a)
#pragma unroll
        for (int b = 0; b < 2; ++b)
#pragma unroll
            for (int m = 0; m < 4; ++m)
#pragma unroll
                for (int n = 0; n < 2; ++n) acc[a][b][m][n] = (f32x4){0.f, 0.f, 0.f, 0.f};
    bf16x8 At[4][2], B0[2][2], B1[2][2];
    unsigned voC[2][2], voN[2][2];
    S.a_ready(cur);
    PG8_SETA(voC, cur);
    const char* cA = cur.A; const char* cB = cur.B;
    PG8_STAGE(PG8_SB(0, 0), cB, voffB); PG8_STAGE(PG8_SB(0, 1), cB + hstep, voffB); PG8_STAGE(PG8_SA(0, 0), cA, voC[0]); PG8_STAGE(PG8_SA(0, 1), cA, voC[1]);
    if (wr == 1) PG8_BAR;
    PG8_WAIT_V(2); PG8_BAR;
    PG8_STAGE(PG8_SB(1, 0), cB + kstep, voffB); PG8_STAGE(PG8_SA(1, 0), cA + kstep, voC[0]); PG8_STAGE(PG8_SB(1, 1), cB + hstep + kstep, voffB);
    PG8_WAIT_V(6); PG8_BAR;
    for (;;) {
        const bool has_next = S.next(ui + 1, nxt);
        if (has_next) { PG8_SETA(voN, nxt); }
        else {
#pragma unroll
            for (int h = 0; h < 2; ++h)
#pragma unroll
                for (int i = 0; i < 2; ++i) voN[h][i] = voC[h][i];
        }
        const char* nA = has_next ? nxt.A : cA; const char* nB = has_next ? nxt.B : cB;
        for (int t = 0; t < nt; t += 2) {
            const bool last = (t == nt - 2);
            if (last && has_next) S.a_ready(nxt);
            const char* a1 = cA + (size_t)(t + 1) * kstep;
            const char* a2 = last ? nA : cA + (size_t)(t + 2) * kstep; const char* b2 = last ? nB : cB + (size_t)(t + 2) * kstep;
            const char* a3 = a2 + kstep; const char* b3 = b2 + kstep;
            unsigned vo2[2][2];
#pragma unroll
            for (int h = 0; h < 2; ++h)
#pragma unroll
                for (int i = 0; i < 2; ++i) vo2[h][i] = last ? voN[h][i] : voC[h][i];
            PG8_LDB(B0, 0, 0); PG8_LDB(B1, 0, 1); PG8_SCHED; PG8_LDA(At, 0, 0); PG8_STAGE(PG8_SA(1, 1), a1, voC[1]);
            PG8_WAIT_V(8); PG8_WAIT_L(0); PG8_BAR; PG8_MMA(0, 0, At, B0); PG8_MMA(0, 1, At, B1); PG8_BAR; PG8_SCHED;
            PG8_LDA(At, 0, 1); PG8_STAGE(PG8_SB(0, 0), b2, voffB); PG8_STAGE(PG8_SB(0, 1), b2 + hstep, voffB); PG8_STAGE(PG8_SA(0, 0), a2, vo2[0]);
            PG8_WAIT_V(8); PG8_WAIT_L(0); PG8_BAR; PG8_MMA(1, 0, At, B0); PG8_MMA(1, 1, At, B1); PG8_BAR; PG8_SCHED;
            PG8_LDB(B0, 1, 0); PG8_LDB(B1, 1, 1); PG8_SCHED; PG8_LDA(At, 1, 0); PG8_STAGE(PG8_SA(0, 1), a2, vo2[1]);
            PG8_WAIT_V(8); PG8_WAIT_L(0); PG8_BAR; PG8_MMA(0, 0, At, B0); PG8_MMA(0, 1, At, B1); PG8_BAR; PG8_SCHED;
            PG8_LDA(At, 1, 1); PG8_STAGE(PG8_SB(1, 0), b3, voffB); PG8_STAGE(PG8_SB(1, 1), b3 + hstep, voffB); PG8_STAGE(PG8_SA(1, 0), a3, vo2[0]);
            PG8_WAIT_V(8); PG8_WAIT_L(0); PG8_BAR; PG8_MMA(1, 0, At, B0); PG8_MMA(1, 1, At, B1); PG8_BAR; PG8_SCHED;
        }
        if (wr == 0) PG8_BAR;
        const bool keep = E(acc, cur, wr, wc, fr, fq);
        if (!has_next) break;
        if (!keep) {
#pragma unroll
            for (int a = 0; a < 2; ++a)
#pragma unroll
                for (int b = 0; b < 2; ++b)
#pragma unroll
                    for (int m = 0; m < 4; ++m)
#pragma unroll
                        for (int n = 0; n < 2; ++n) acc[a][b][m][n] = (f32x4){0.f, 0.f, 0.f, 0.f};
        }
        cur = nxt; cA = nA; cB = nB; ++ui;
        if (Sched::GATHER) {
#pragma unroll
            for (int h = 0; h < 2; ++h)
#pragma unroll
                for (int i = 0; i < 2; ++i) voC[h][i] = voN[h][i];
        } else { PG8_SETA(voC, cur); }
        PG8_SETLANE();
        if (wr == 1) PG8_BAR;
    }
    PG8_WAIT_V(0);
    PG8_BAR;
#undef PG8_SA
#undef PG8_SB
#undef PG8_STAGE
#undef PG8_LDA
#undef PG8_LDB
#undef PG8_MMA
#undef PG8_WAIT_V
#undef PG8_WAIT_L
#undef PG8_BAR
#undef PG8_SCHED
#undef PG8_SETA
#undef PG8_SETLANE
}
}

struct Args { const float* in[25]; float* out; unsigned char* ws; int ph_lo, ph_hi; };
enum { I_X = 0, I_C, I_WADA, I_BADA, I_N1G, I_WIN, I_LQ1, I_LK1, I_LQ2, I_LK2, I_SUBG, I_LBL, I_HGNG, I_WUPDA, I_WUPHG, I_WOUT, I_N2G, I_WRG, I_BRG, I_WRE, I_BRE, I_W1, I_W3, I_W2, I_FG };

struct DenseOrder {
    static constexpr bool GATHER = false;
    const char* A; const char* Bt; int K, nM, nN, G, c;
    __device__ __forceinline__ bool next(int i, pg8::Unit& u) const {
        const int L = i * G + c, nwg = nM * nN; if (L >= nwg) return false;
        int wgid = L; { const int q = nwg / 8, r = nwg % 8, xcd = wgid % 8, off = wgid / 8; wgid = (xcd < r ? xcd * (q + 1) : r * (q + 1) + (xcd - r) * q) + off; }
        const int nig = 8 * nN, gid = wgid / nig, fm = gid * 8, gsz = (nM - fm) < 8 ? (nM - fm) : 8;
        u.pm = fm + ((wgid % nig) % gsz); u.pn = (wgid % nig) / gsz; u.A = A; u.B = Bt + (size_t)u.pn * 256 * K * 2; u.aux = 0; return true;
    }
    __device__ __forceinline__ void a_ready(const pg8::Unit&) const {}
    __device__ __forceinline__ unsigned arow(const pg8::Unit& u, int r) const { return (unsigned)(u.pm * 256 + r); }
};
struct UpOrder {
    static constexpr bool GATHER = false;
    const char* A0; const char* A1; const char* B0; const char* B1; int G, c;
    __device__ __forceinline__ bool next(int i, pg8::Unit& u) const {
        const int tile = (i >> 1) * G + c; if (tile >= 256) return false;
        u.pm = tile >> 2; u.pn = tile & 3; u.aux = i & 1;
        u.A = (i & 1) ? A1 : A0; u.B = ((i & 1) ? B1 : B0) + (size_t)u.pn * 256 * 512 * 2; return true;
    }
    __device__ __forceinline__ void a_ready(const pg8::Unit&) const {}
    __device__ __forceinline__ unsigned arow(const pg8::Unit& u, int r) const { return (unsigned)(u.pm * 256 + r); }
};
struct MoeTab { int nt; int pad[3]; int tile_e[176]; int tile_m[176]; int cnt[32]; int tbase[33]; };
struct Moe1Order {
    static constexpr bool GATHER = true;
    const LAS MoeTab* tab; const char* A; const char* W; const int* toklist; int G, c;
    __device__ __forceinline__ bool next(int i, pg8::Unit& u) const {
        const int L = i * G + c; if (L >= tab->nt * 4) return false;
        const int ti = L >> 2; u.pm = ti; u.pn = L & 3; u.aux = ti; u.A = A;
        u.B = W + ((size_t)tab->tile_e[ti] * 1024 + (size_t)u.pn * 256) * 1024 * 2; return true;
    }
    __device__ __forceinline__ void a_ready(const pg8::Unit&) const {}
    __device__ __forceinline__ unsigned arow(const pg8::Unit& u, int r) const {
        const int e = tab->tile_e[u.aux], rr = tab->tile_m[u.aux] * 256 + r;
        return rr < tab->cnt[e] ? (unsigned)toklist[e * T + rr] : 0u;
    }
};
struct Moe2Order {
    static constexpr bool GATHER = false;
    const LAS MoeTab* tab; const char* A; const char* W; unsigned* done; unsigned* tmo; int G, c;
    __device__ __forceinline__ bool next(int i, pg8::Unit& u) const {
        const int n1 = tab->nt * 4, r = n1 % G, nl = G - r; int j;
        if (r > 0 && c >= r) { if (i < 2) j = (c - r) + i * nl; else j = 2 * nl + (c - r) + (i - 2) * G; }
        else j = (r > 0 ? 2 * nl : 0) + ((c - r + G) % G) + i * G;
        if (j >= n1) return false;
        const int ti = j >> 2; u.pm = ti; u.pn = j & 3; u.aux = ti; u.A = A;
        u.B = W + ((size_t)tab->tile_e[ti] * 1024 + (size_t)u.pn * 256) * 512 * 2; return true;
    }
    __device__ __forceinline__ unsigned arow(const pg8::Unit& u, int r) const { return (unsigned)(u.pm * 256 + r); }
    __device__ __forceinline__ void a_ready(const pg8::Unit& u) const {
        if (threadIdx.x < 64) {
            unsigned polls = 0;
            while ((unsigned)__builtin_amdgcn_readfirstlane(__hip_atomic_load(done + 16 * u.pm, __ATOMIC_RELAXED, __HIP_MEMORY_SCOPE_AGENT)) < 32u) {
                if (++polls > (1u << 22)) { if (threadIdx.x == 0) __hip_atomic_store(tmo, 1u, __ATOMIC_RELAXED, __HIP_MEMORY_SCOPE_AGENT); break; }
                __builtin_amdgcn_s_sleep(2); }
            __builtin_amdgcn_fence(__ATOMIC_ACQUIRE, "agent");
            asm volatile("s_waitcnt vmcnt(0)" ::: "memory");
        }
        asm volatile("" ::: "memory"); __builtin_amdgcn_s_barrier(); asm volatile("" ::: "memory");
    }
};

using pg8::Unit; using pg8::cvt_pk_bf16;
struct EpiStoreBf16 {
    static constexpr bool PERM = true;
    bf16_t* O; int ldc; int nscale; float scale0;
    __device__ __forceinline__ bool operator()(f32x4 (&acc)[2][2][4][2], const Unit& u, int wr, int wc, int fr, int fq) const {
        const int row0 = u.pm * 256 + wr * 64 + fr, col0 = u.pn * 256 + wc * 32 + 8 * fq;
        const float sc = u.pn < nscale ? scale0 : 1.0f;
#pragma unroll
        for (int ai = 0; ai < 2; ++ai)
#pragma unroll
            for (int m = 0; m < 4; ++m) { bf16_t* rowp = O + (size_t)(row0 + ai * 128 + m * 16) * ldc + col0;
#pragma unroll
                for (int bj = 0; bj < 2; ++bj) { const f32x4 v0 = acc[ai][bj][m][0] * sc, v1 = acc[ai][bj][m][1] * sc;
                    u32x4 w; w.x = cvt_pk_bf16(v0[0], v0[1]); w.y = cvt_pk_bf16(v0[2], v0[3]); w.z = cvt_pk_bf16(v1[0], v1[1]); w.w = cvt_pk_bf16(v1[2], v1[3]);
                    *(u32x4*)(rowp + bj * 128) = w; } }
        return false;
    }
};
template <int N> __device__ __forceinline__ float dpp_shr(float x) { return __builtin_bit_cast(float, __builtin_amdgcn_update_dpp(0, __builtin_bit_cast(int, x), 0x110 + N, 0xf, 0xf, true)); }
__device__ __forceinline__ float scan16(float x) { x += dpp_shr<1>(x); x += dpp_shr<2>(x); x += dpp_shr<4>(x); x += dpp_shr<8>(x); return x; }
struct EpiInProj {
    static constexpr bool PERM = true;
    bf16_t* O; bf16_t* KE; float* DEC; const float* lbv; float scale0;
    __device__ __forceinline__ bool operator()(f32x4 (&acc)[2][2][4][2], const Unit& u, int wr, int wc, int fr, int fq) const {
        { const int l_ = lane_now(); fr = l_ & 15; fq = l_ >> 4; }
        const int row0 = u.pm * 256 + wr * 64 + fr, col0 = u.pn * 256 + wc * 32 + 8 * fq;
        if (u.pn >= 6 && u.pn < 10) {
            const int h = u.pn - 6, lane = 16 * fq + fr, kb = wc * 32 + 8 * fq, bsrc = (lane & 48) | 15;
            const int bb = (u.pm * 256) / SEQ, ch0 = ((u.pm * 256) % SEQ + wr * 64) >> 6;
#pragma unroll
            for (int ai = 0; ai < 2; ++ai) {
                unsigned kep[4][4];
#pragma unroll
                for (int n = 0; n < 2; ++n) {
#pragma unroll
                    for (int ep = 0; ep < 2; ++ep) {
                        float ke2[2][4];
#pragma unroll
                        for (int z = 0; z < 2; ++z) {
                            const int e = 2 * ep + z; const float lb = lbv[h * 128 + kb + 4 * n + e];
                            float f[4], c[4], tot[4];
#pragma unroll
                            for (int m = 0; m < 4; ++m) { const float fl = acc[ai][1][m][n][e]; f[m] = lb + (1.0f - lb) * __builtin_amdgcn_rcpf(1.0f + __builtin_amdgcn_exp2f(-1.4426950408889634f * fl)); c[m] = scan16(__logf(f[m])); }
#pragma unroll
                            for (int m = 0; m < 4; ++m) tot[m] = __shfl(c[m], bsrc);
                            const float alast = (tot[0] + tot[1]) + (tot[2] + tot[3]);
                            float pre = 0.f;
#pragma unroll
                            for (int m = 0; m < 4; ++m) { const float A = c[m] + pre; pre += tot[m]; const float q = acc[ai][0][m][n][e]; const float kk = 1.0f - f[m];
                                acc[ai][0][m][n][e] = q * __builtin_amdgcn_rcpf(1.0f + __builtin_amdgcn_exp2f(-1.4426950408889634f * q)) * __expf(A);
                                acc[ai][1][m][n][e] = kk * __expf(-A); ke2[z][m] = kk * __expf(alast - A); }
                            if (fr == 0) DEC[((size_t)(bb * 4 + h) * 64 + ch0 + 2 * ai) * 128 + kb + 4 * n + e] = __expf(alast);
                        }
#pragma unroll
                        for (int m = 0; m < 4; ++m) kep[m][2 * n + ep] = cvt_pk_bf16(ke2[0][m], ke2[1][m]);
                        __builtin_amdgcn_sched_barrier(0);
                    }
                }
#pragma unroll
                for (int m = 0; m < 4; ++m) *(u32x4*)(KE + (size_t)(row0 + ai * 128 + m * 16) * 512 + h * 128 + kb) = (u32x4){kep[m][0], kep[m][1], kep[m][2], kep[m][3]};
            }
        }
        const float sc = u.pn < 2 ? scale0 : 1.0f;
#pragma unroll
        for (int ai = 0; ai < 2; ++ai)
#pragma unroll
            for (int m = 0; m < 4; ++m) { bf16_t* rowp = O + (size_t)(row0 + ai * 128 + m * 16) * INC + col0;
#pragma unroll
                for (int bj = 0; bj < 2; ++bj) { const f32x4 v0 = acc[ai][bj][m][0] * sc, v1 = acc[ai][bj][m][1] * sc;
                    u32x4 w; w.x = cvt_pk_bf16(v0[0], v0[1]); w.y = cvt_pk_bf16(v0[2], v0[3]); w.z = cvt_pk_bf16(v1[0], v1[1]); w.w = cvt_pk_bf16(v1[2], v1[3]);
                    *(u32x4*)(rowp + bj * 128) = w; } }
        return false;
    }
};
struct EpiUp {
    static constexpr bool PERM = true;
    const bf16_t* proj; bf16_t* O;
    __device__ __forceinline__ bool operator()(f32x4 (&acc)[2][2][4][2], const Unit& u, int wr, int wc, int fr, int fq) const {
        const int row0 = u.pm * 256 + wr * 64 + fr, col0 = u.pn * 256 + wc * 32 + 8 * fq;
#pragma unroll
        for (int ai = 0; ai < 2; ++ai)
#pragma unroll
            for (int m = 0; m < 4; ++m) { const size_t row = (size_t)(row0 + ai * 128 + m * 16);
#pragma unroll
                for (int bj = 0; bj < 2; ++bj) {
                    const int col = col0 + bj * 128;
                    const u32x4 gh = *(const u32x4*)(proj + row * INC + C_GHGATE + col);
                    float sh[8];
#pragma unroll
                    for (int j = 0; j < 4; ++j) { sh[2 * j] = 1.0f + __builtin_amdgcn_exp2f(-1.4426950408889634f * bf2f(gh[j] & 0xffffu)); sh[2 * j + 1] = 1.0f + __builtin_amdgcn_exp2f(-1.4426950408889634f * bf2f(gh[j] >> 16)); }
                    if (u.aux == 0) {
                        const u32x4 gd = *(const u32x4*)(proj + row * INC + C_GDA + col);
#pragma unroll
                        for (int j = 0; j < 4; ++j) {
                            const float d0 = 1.0f + __builtin_amdgcn_exp2f(-1.4426950408889634f * bf2f(gd[j] & 0xffffu)), d1 = 1.0f + __builtin_amdgcn_exp2f(-1.4426950408889634f * bf2f(gd[j] >> 16));
                            const float r0 = sh[2 * j] * __builtin_amdgcn_rcpf(d0), r1 = sh[2 * j + 1] * __builtin_amdgcn_rcpf(d1);
                            if (j < 2) { acc[ai][bj][m][0][2 * j] *= r0; acc[ai][bj][m][0][2 * j + 1] *= r1; }
                            else { acc[ai][bj][m][1][2 * j - 4] *= r0; acc[ai][bj][m][1][2 * j - 3] *= r1; }
                        }
                    } else {
                        const f32x4 v0 = acc[ai][bj][m][0], v1 = acc[ai][bj][m][1];
#pragma unroll
                        for (int j = 0; j < 8; ++j) sh[j] = __builtin_amdgcn_rcpf(sh[j]);
                        u32x4 w; w.x = cvt_pk_bf16(v0[0] * sh[0], v0[1] * sh[1]); w.y = cvt_pk_bf16(v0[2] * sh[2], v0[3] * sh[3]);
                        w.z = cvt_pk_bf16(v1[0] * sh[4], v1[1] * sh[5]); w.w = cvt_pk_bf16(v1[2] * sh[6], v1[3] * sh[7]);
                        *(u32x4*)(O + row * D + col) = w;
                    }
                } }
        return u.aux == 0;
    }
};
struct EpiOut {
    static constexpr bool PERM = false;
    const float* x; const float* mod; float* O;
    __device__ __forceinline__ bool operator()(f32x4 (&acc)[2][2][4][2], const Unit& u, int wr, int wc, int fr, int fq) const {
        const int row0 = u.pm * 256 + wr * 64 + fr, col0 = u.pn * 256 + wc * 32 + 4 * fq;
        const int b = (u.pm * 256) / SEQ;
        f32x4 gt[2][2];
#pragma unroll
        for (int bj = 0; bj < 2; ++bj)
#pragma unroll
            for (int n = 0; n < 2; ++n) gt[bj][n] = *(const f32x4*)(mod + b * 6144 + 2048 + col0 + bj * 128 + n * 16);
#pragma unroll
        for (int ai = 0; ai < 2; ++ai)
#pragma unroll
            for (int m = 0; m < 4; ++m) { const size_t off = (size_t)(row0 + ai * 128 + m * 16) * D + col0;
#pragma unroll
                for (int bj = 0; bj < 2; ++bj)
#pragma unroll
                    for (int n = 0; n < 2; ++n) { const f32x4 xv = *(const f32x4*)(x + off + bj * 128 + n * 16);
                        *(f32x4*)(O + off + bj * 128 + n * 16) = xv + gt[bj][n] * acc[ai][bj][m][n]; } }
        return false;
    }
};
struct EpiMoe1 {
    static constexpr bool PERM = true;
    bf16_t* O; unsigned* done;
    __device__ __forceinline__ bool operator()(f32x4 (&acc)[2][2][4][2], const Unit& u, int wr, int wc, int fr, int fq) const {
        const int row0 = u.pm * 256 + wr * 64 + fr, col0 = u.pn * 128 + wc * 32 + 8 * fq;
#pragma unroll
        for (int ai = 0; ai < 2; ++ai)
#pragma unroll
            for (int m = 0; m < 4; ++m) { bf16_t* rowp = O + (size_t)(row0 + ai * 128 + m * 16) * DEXP + col0;
                float h[8];
#pragma unroll
                for (int n = 0; n < 2; ++n)
#pragma unroll
                    for (int e = 0; e < 4; ++e) { const float x_ = acc[ai][0][m][n][e]; h[n * 4 + e] = x_ * __builtin_amdgcn_rcpf(1.0f + __builtin_amdgcn_exp2f(-1.4426950408889634f * x_)) * acc[ai][1][m][n][e]; }
                u32x4 w; w.x = cvt_pk_bf16(h[0], h[1]); w.y = cvt_pk_bf16(h[2], h[3]); w.z = cvt_pk_bf16(h[4], h[5]); w.w = cvt_pk_bf16(h[6], h[7]);
                asm volatile("global_store_dwordx4 %0, %1, off sc1\n\ts_nop 1" :: "v"(rowp), "v"(w) : "memory"); }
        asm volatile("s_waitcnt vmcnt(0)" ::: "memory");
        if ((threadIdx.x & 63) == 0) __hip_atomic_fetch_add(done + 16 * u.pm, 1u, __ATOMIC_RELAXED, __HIP_MEMORY_SCOPE_AGENT);
        return false;
    }
};

struct Frame { LAS unsigned char* lds; int tid, lane, wave, G, bid; };

__device__ __forceinline__ void transpose_item(const float* Wsrc, int ldw, bf16_t* dst, int ldd, LAS float* scr, int lane) {
#pragma unroll 8
    for (int i = 0; i < 32; ++i) { const int kk = 2 * i + (lane >> 5); scr[kk * 33 + (lane & 31)] = Wsrc[(size_t)kk * ldw + (lane & 31)]; }
    asm volatile("s_waitcnt lgkmcnt(0)" ::: "memory");
    const int c = lane & 7;
#pragma unroll
    for (int j = 0; j < 4; ++j) { const int n = (lane >> 3) + 8 * j; const LAS float* s = scr + (8 * c) * 33 + n;
        u32x4 o; o.x = pk2(s[0 * 33], s[1 * 33]); o.y = pk2(s[2 * 33], s[3 * 33]); o.z = pk2(s[4 * 33], s[5 * 33]); o.w = pk2(s[6 * 33], s[7 * 33]);
        *(u32x4*)(dst + (size_t)n * ldd + 8 * c) = o; }
    asm volatile("s_waitcnt lgkmcnt(0)" ::: "memory");
}
__device__ __forceinline__ void transpose_matrix(const Frame& F, const float* W, int K, int N, bf16_t* WT) {
    LAS float* scr = (LAS float*)(F.lds + F.wave * 8448);
    const int gw = F.bid * NWAVES + F.wave, NGW = F.G * NWAVES, nblk = N / 32, items = (K / 64) * nblk;
    for (int it = gw; it < items; it += NGW) { const int kb = it / nblk, nb = it % nblk;
        transpose_item(W + (size_t)(64 * kb) * N + 32 * nb, N, WT + (size_t)(32 * nb) * K + 64 * kb, K, scr, F.lane); }
}

__device__ __forceinline__ void phase0(const Frame& F, const Args& a) {
    unsigned char* ws = a.ws;
    {
        float* modp = (float*)(ws + WS_MODP);
        const float* c = a.in[I_C]; const float* wada = a.in[I_WADA];
        LAS float* cs = (LAS float*)(F.lds + 72 * 1024);
        for (int i = F.tid; i < 4 * D; i += NTHR) cs[i] = siluf_(c[i]);
        __syncthreads();
        for (int wt = F.bid + 256 * F.wave; wt < 384; wt += 256 * NWAVES) {
            if (F.G != 256) break;
            const int ks = wt / 24, jw = wt % 24, j = jw * 256 + F.lane * 4;
            f32x4 s[4] = {{0, 0, 0, 0}, {0, 0, 0, 0}, {0, 0, 0, 0}, {0, 0, 0, 0}};
#pragma unroll 8
            for (int k = ks * 64; k < ks * 64 + 64; ++k) {
                const f32x4 w = *(const f32x4*)(wada + (size_t)k * 6144 + j);
#pragma unroll
                for (int b = 0; b < 4; ++b) s[b] += w * cs[b * D + k];
            }
#pragma unroll
            for (int b = 0; b < 4; ++b) *(f32x4*)(modp + ((size_t)ks * 4 + b) * 6144 + j) = s[b];
        }
        if (F.G != 256) {
            const int gw = F.bid * NWAVES + F.wave, NGW = F.G * NWAVES;
            for (int wt = gw; wt < 384; wt += NGW) {
                const int ks = wt / 24, jw = wt % 24, j = jw * 256 + F.lane * 4;
                f32x4 s[4] = {{0, 0, 0, 0}, {0, 0, 0, 0}, {0, 0, 0, 0}, {0, 0, 0, 0}};
                for (int k = ks * 64; k < ks * 64 + 64; ++k) {
                    const f32x4 w = *(const f32x4*)(wada + (size_t)k * 6144 + j);
#pragma unroll
                    for (int b = 0; b < 4; ++b) { const float cv = siluf_(c[b * D + k]); s[b] += w * cv; }
                }
#pragma unroll
                for (int b = 0; b < 4; ++b) *(f32x4*)(modp + ((size_t)ks * 4 + b) * 6144 + j) = s[b];
            }
        }
    }
    if (F.bid == 0) {
        float* sm = (float*)(ws + WS_SMALL);
        if (F.tid == 0) {
            float s1 = 0.f, s2 = 0.f;
            for (int i = 0; i < 64; ++i) { s1 += a.in[I_LQ1][i] * a.in[I_LK1][i]; s2 += a.in[I_LQ2][i] * a.in[I_LK2][i]; }
            sm[0] = expf(s1) - expf(s2) + 0.2f;
        }
        { const float l0 = a.in[I_LBL][F.tid], l1 = a.in[I_LBL][512 + F.tid]; const float mx = fmaxf(l0, l1);
          const float e0 = expf(l0 - mx), e1 = expf(l1 - mx); sm[16 + F.tid] = e0 / (e0 + e1); }
    }
}
__device__ __forceinline__ void moe_weight_convert(const Frame& F, const Args& a) {
    LAS float* scr = (LAS float*)(F.lds + F.wave * 8448);
    const int gw = F.bid * NWAVES + F.wave, NGW = F.G * NWAVES;
    bf16_t* w13 = (bf16_t*)(a.ws + WS_W13); bf16_t* w2t = (bf16_t*)(a.ws + WS_W2);
    for (int it = gw; it < 2 * NEXP * 256; it += NGW) {
        const int which = it / (NEXP * 256), r = it % (NEXP * 256), e = r >> 8, kb = (r >> 4) & 15, nb = r & 15, n0 = 32 * nb;
        const float* W = a.in[which ? I_W3 : I_W1] + (size_t)e * 1024 * 512;
        const int drow = 256 * (n0 >> 7) + (which ? 128 : 0) + (n0 & 127);
        transpose_item(W + (size_t)(64 * kb) * 512 + n0, 512, w13 + ((size_t)e * 1024 + drow) * 1024 + 64 * kb, 1024, scr, F.lane);
    }
    for (int it = gw; it < NEXP * 256; it += NGW) {
        const int e = it >> 8, kb = (it >> 5) & 7, nb = it & 31;
        const float* W = a.in[I_W2] + (size_t)e * 512 * 1024;
        transpose_item(W + (size_t)(64 * kb) * 1024 + 32 * nb, 1024, w2t + ((size_t)e * 1024 + 32 * nb) * 512 + 64 * kb, 512, scr, F.lane);
    }
}

__device__ __forceinline__ void dense_weight_convert(const Frame& F, const Args& a) {
    unsigned char* ws = a.ws;
    {
        LAS float* scr = (LAS float*)(F.lds + F.wave * 8448);
        const int gw = F.bid * NWAVES + F.wave, NGW = F.G * NWAVES, nblk = INC / 32, items = (D / 64) * nblk;
        bf16_t* WT = (bf16_t*)(ws + WS_WIN);
        for (int it = gw; it < items; it += NGW) { const int kb = it / nblk, n0 = 32 * (it % nblk); int dr = n0;
            if (n0 >= C_QHG && n0 < C_FHG) dr = C_HGT + 256 * ((n0 - C_QHG) >> 7) + ((n0 - C_QHG) & 127);
            else if (n0 >= C_FHG && n0 < C_IHG) dr = C_HGT + 256 * ((n0 - C_FHG) >> 7) + 128 + ((n0 - C_FHG) & 127);
            transpose_item(a.in[I_WIN] + (size_t)(64 * kb) * INC + n0, INC, WT + (size_t)dr * D + 64 * kb, D, scr, F.lane); }
    }
    transpose_matrix(F, a.in[I_WUPDA], 512, D, (bf16_t*)(ws + WS_WUPDA));
    transpose_matrix(F, a.in[I_WUPHG], 512, D, (bf16_t*)(ws + WS_WUPHG));
    transpose_matrix(F, a.in[I_WOUT], D, D, (bf16_t*)(ws + WS_WOUT));
}
__device__ __forceinline__ void phase1(const Frame& F, const Args& a) {
    const float* modp = (const float*)(a.ws + WS_MODP); float* mod = (float*)(a.ws + WS_MOD);
    for (int i = F.bid * NTHR + F.tid; i < 4 * 6144; i += F.G * NTHR) {
        float s = a.in[I_BADA][i % 6144];
        for (int ks = 0; ks < 16; ++ks) s += modp[(size_t)ks * 4 * 6144 + i];
        mod[i] = s;
    }
    LAS float* Gs = (LAS float*)F.lds;
    LAS float* Ss = Gs + 1024;
    bf16_t* H = (bf16_t*)(a.ws + WS_ACT);
    const int rows_per_blk = T / F.G;
    const int r0 = F.bid * rows_per_blk, b = r0 / SEQ;
    for (int k = F.tid; k < 1024; k += NTHR) {
        float sh = a.in[I_BADA][k], sc = a.in[I_BADA][1024 + k];
        for (int ks = 0; ks < 16; ++ks) { sh += modp[((size_t)ks * 4 + b) * 6144 + k]; sc += modp[((size_t)ks * 4 + b) * 6144 + 1024 + k]; }
        Gs[k] = a.in[I_N1G][k] * (1.0f + sc); Ss[k] = sh;
    }
    __syncthreads();
    for (int r = r0 + F.wave; r < r0 + rows_per_blk; r += NWAVES) {
        const f32x4* xr = (const f32x4*)(a.in[I_X] + (size_t)r * D) + F.lane;
        f32x4 v[4]; float s = 0.f;
#pragma unroll
        for (int j = 0; j < 4; ++j) { v[j] = xr[64 * j]; s += (v[j].x * v[j].x + v[j].y * v[j].y) + (v[j].z * v[j].z + v[j].w * v[j].w); }
        const float rs = rsqrtf(wave_sum(s) * (1.0f / D) + EPS);
        unsigned long long* o8 = (unsigned long long*)(H + (size_t)r * D) + F.lane;
#pragma unroll
        for (int j = 0; j < 4; ++j) { const f32x4 g = *(const LAS f32x4*)(Gs + 256 * j + 4 * F.lane), sh = *(const LAS f32x4*)(Ss + 256 * j + 4 * F.lane);
            const f32x4 h = v[j] * rs * g + sh;
            o8[64 * j] = (unsigned long long)pk2(h.x, h.y) | ((unsigned long long)pk2(h.z, h.w) << 32); }
    }
}

namespace attn_body {
using s16x4=__attribute__((ext_vector_type(4)))short;
using f32x16=__attribute__((ext_vector_type(16)))float;
constexpr int NW=8,QBLK=32,QB=QBLK*NW,KVBLK=64,NQB=SEQ/QB;
constexpr int PIN=INC, POUT=1024;
__device__ __forceinline__ int crow(int r,int hi){return (r&3)+8*(r>>2)+4*hi;}
#define SBAR() __builtin_amdgcn_sched_barrier(0)
__device__ __forceinline__ void bmask(f32x16&p0,f32x16&p1,int jb,int wch,int il,int hi,float s2x2){
  if(jb>wch){
    #pragma unroll
    for(int r=0;r<16;++r){p0[r]=-INFINITY;p1[r]=-INFINITY;}
  } else if(jb==wch){
    float fb=(float)(4*hi-il); asm volatile("":"+v"(fb));
    #pragma unroll
    for(int r=0;r<16;++r){const float c=(float)((r&3)+8*(r>>2)); p0[r]-=s2x2*__builtin_fmaxf(fb+c,0.f); p1[r]-=s2x2*__builtin_fmaxf(fb+(c+32.f),0.f);}
  }
}
constexpr int NSLOT=3, SLOTB=8192, VSLOTB=16384;
constexpr int LDS_K=0, LDS_V=NSLOT*SLOTB, LDS_WS=LDS_V+NSLOT*VSLOTB, LDS_OST=LDS_WS+NW*64*4, ATT_LDS_BYTES=LDS_OST+NW*8192;
constexpr float C2=0.125f*1.4426950408889634f;
__device__ __forceinline__ void glds16(const void*gsrc,unsigned lds_dst){unsigned keep;
  asm volatile("s_mov_b32 %0, m0\n\ts_mov_b32 m0, %2\n\ts_nop 0\n\tglobal_load_lds_dwordx4 %1, off\n\ts_mov_b32 m0, %0":"=&s"(keep):"v"(gsrc),"s"(lds_dst):"memory");}
__device__ __forceinline__ float max3f(float a,float b,float c){float r;asm("v_max3_f32 %0, %1, %2, %3":"=v"(r):"v"(a),"v"(b),"v"(c));return r;}
__device__ __forceinline__ float max2f(float a,float b){float r;asm("v_max_f32_e32 %0, %1, %2":"=v"(r):"v"(a),"v"(b));return r;}
__device__ __forceinline__ float fadd_s(float a,float b){float r;asm("v_add_f32_e32 %0, %1, %2":"=v"(r):"v"(a),"v"(b));return r;}
__device__ __forceinline__ float fsub_s(float a,float b){float r;asm("v_sub_f32_e32 %0, %1, %2":"=v"(r):"v"(a),"v"(b));return r;}
typedef float f32x2_t __attribute__((ext_vector_type(2))); typedef __bf16 bf16x2_t __attribute__((ext_vector_type(2)));
__device__ __forceinline__ unsigned cvtpk_s(float lo,float hi){f32x2_t v={lo,hi};bf16x2_t b=__builtin_convertvector(v,bf16x2_t);return __builtin_bit_cast(unsigned,b);}
#define WAIT_BAR(N) asm volatile("s_waitcnt vmcnt(" #N ") lgkmcnt(0)\n\ts_barrier":::"memory")

__device__ __forceinline__ void qkt(f32x16&p0,f32x16&p1,const char*Kslot,const bf16x8*qr,const f32x16&c0,const f32x16&c1,int r32,int hi){
  const char*kb=Kslot+hi*1024+r32*16;
  #pragma unroll
  for(int d0=0;d0<4;++d0){
    const bf16x8 b0=*reinterpret_cast<const bf16x8*>(kb+d0*2048);
    const bf16x8 b1=*reinterpret_cast<const bf16x8*>(kb+d0*2048+512);
    if(d0==0){p0=__builtin_amdgcn_mfma_f32_32x32x16_bf16(b0,qr[0],c0,0,0,0);p1=__builtin_amdgcn_mfma_f32_32x32x16_bf16(b1,qr[0],c1,0,0,0);}
    else{p0=__builtin_amdgcn_mfma_f32_32x32x16_bf16(b0,qr[d0],p0,0,0,0);p1=__builtin_amdgcn_mfma_f32_32x32x16_bf16(b1,qr[d0],p1,0,0,0);}}
}
typedef __attribute__((address_space(3))) const char* lds_cptr;
typedef short v4i16_t __attribute__((ext_vector_type(4)));
__device__ __forceinline__ void kload8(bf16x8*kf,lds_cptr kp){
  kf[0]=*(const __attribute__((address_space(3))) bf16x8*)(kp);      kf[1]=*(const __attribute__((address_space(3))) bf16x8*)(kp+512);
  kf[2]=*(const __attribute__((address_space(3))) bf16x8*)(kp+2048); kf[3]=*(const __attribute__((address_space(3))) bf16x8*)(kp+2560);
  kf[4]=*(const __attribute__((address_space(3))) bf16x8*)(kp+4096); kf[5]=*(const __attribute__((address_space(3))) bf16x8*)(kp+4608);
  kf[6]=*(const __attribute__((address_space(3))) bf16x8*)(kp+6144); kf[7]=*(const __attribute__((address_space(3))) bf16x8*)(kp+6656);
}
__device__ __forceinline__ void kload2(bf16x8*kf,lds_cptr kp,int j){ kf[2*j]=*(const __attribute__((address_space(3))) bf16x8*)(kp+j*2048); kf[2*j+1]=*(const __attribute__((address_space(3))) bf16x8*)(kp+j*2048+512); }
__device__ __forceinline__ s16x4 vtr(lds_cptr p){ return __builtin_bit_cast(s16x4,__builtin_amdgcn_ds_read_tr16_b64_v4i16((__attribute__((address_space(3))) v4i16_t*)p)); }
__device__ __forceinline__ float rowmax(const f32x16&p0,const f32x16&p1){
  float a=max3f(p0[0],p0[1],p1[0]),b=max3f(p0[2],p0[3],p1[1]);a=max3f(a,p1[2],p1[3]);
  #pragma unroll
  for(int r=4;r<16;r+=4){a=max3f(a,p0[r],p0[r+1]);b=max3f(b,p0[r+2],p0[r+3]);a=max3f(a,p1[r],p1[r+1]);b=max3f(b,p1[r+2],p1[r+3]);}
  const float m=max2f(a,b);
  auto rr=__builtin_amdgcn_permlane32_swap(__float_as_uint(m),__float_as_uint(m),false,false);
  return max2f(__uint_as_float(rr[0]),__uint_as_float(rr[1]));
}
__device__ __forceinline__ void pv(f32x16*o,int vb,bf16x8 pa0,bf16x8 pa1,bf16x8 pa2,bf16x8 pa3){
  #pragma unroll
  for(int d0=0;d0<4;++d0){s16x4 lo[4],hi[4];
    #pragma unroll
    for(int ks=0;ks<4;++ks){
      asm volatile("ds_read_b64_tr_b16 %0,%1 offset:%c2":"=&v"(lo[ks]):"v"(vb),"i"(d0*4096+ks*1024):"memory");
      asm volatile("ds_read_b64_tr_b16 %0,%1 offset:%c2":"=&v"(hi[ks]):"v"(vb),"i"(d0*4096+ks*1024+512):"memory");}
    asm volatile("s_waitcnt lgkmcnt(0)":::"memory");SBAR();
    #define PK(k) (bf16x8){lo[k][0],lo[k][1],lo[k][2],lo[k][3],hi[k][0],hi[k][1],hi[k][2],hi[k][3]}
    o[d0]=__builtin_amdgcn_mfma_f32_32x32x16_bf16(pa0,PK(0),o[d0],0,0,0);
    o[d0]=__builtin_amdgcn_mfma_f32_32x32x16_bf16(pa1,PK(1),o[d0],0,0,0);
    o[d0]=__builtin_amdgcn_mfma_f32_32x32x16_bf16(pa2,PK(2),o[d0],0,0,0);
    o[d0]=__builtin_amdgcn_mfma_f32_32x32x16_bf16(pa3,PK(3),o[d0],0,0,0);
    #undef PK
  }
}
#define ATTN_STORE16(p,v) (*(u32x4*)(p)=(v))
template<int THRL> __device__ __forceinline__ void attn_unit(int qb,const bf16_t*Qb,const bf16_t*__restrict__ Kh,const bf16_t*__restrict__ Vh,bf16_t*Ob,float slope2,char*shm){
  const int wid=__builtin_amdgcn_readfirstlane(threadIdx.x>>6); const int lane=lane_now(),r32=lane&31,hi=lane>>5;
  const int q0=qb*QB;
  const bf16_t*Qw=Qb+(long)(q0+wid*QBLK)*PIN;
  const unsigned lds0=(unsigned)(uintptr_t)shm;
  float*wsf=(float*)(shm+LDS_WS)+wid*64;
  const bf16_t*ksrc=Kh+(long)lane*PIN+wid*8;
  const bf16_t*vsrc=Vh+(long)(16*(wid&3)+(lane>>2))*PIN+(wid>>2)*32+(lane&3)*8;
  const unsigned kdst=lds0+LDS_K+wid*1024, vdst=lds0+LDS_V+(wid>>2)*4096+(wid&3)*1024;
  #define DMA_K(t,slot) glds16(ksrc+(long)(t)*KVBLK*PIN,(unsigned)__builtin_amdgcn_readfirstlane(kdst+(slot)))
  #define DMA_V(t,slot) do{ glds16(vsrc+(long)(t)*KVBLK*PIN,(unsigned)__builtin_amdgcn_readfirstlane(vdst+2*(slot))); glds16(vsrc+(long)(t)*KVBLK*PIN+64,(unsigned)__builtin_amdgcn_readfirstlane(vdst+2*(slot)+8192)); }while(0)
  const int vb0=(int)(lds0+LDS_V)+((lane>>4)&1)*32+(lane&3)*8+(4*hi+((lane&15)>>2))*64;
  const char*Kbase=shm+LDS_K; bf16x8 kf[8];
  const lds_cptr shm3=(lds_cptr)shm; const lds_cptr kp0=shm3+LDS_K+hi*1024+r32*16; const lds_cptr vp0=shm3+LDS_V+((lane>>4)&1)*32+(lane&3)*8+(4*hi+((lane&15)>>2))*64;
  const int NT=(q0+QB)/KVBLK;
  DMA_K(0,0);DMA_V(0,0);DMA_K(1,SLOTB);
  bf16x8 qr[4];
  #pragma unroll
  for(int d0=0;d0<4;++d0)qr[d0]=*reinterpret_cast<const bf16x8*>(&Qw[(long)r32*PIN+d0*16+hi*8]);
  float mhat=0.f,l_reg=0.f;f32x16 o[4];o[0]=f32x16{};o[1]=f32x16{};o[2]=f32x16{};o[3]=f32x16{};
  const float s64=slope2*64.f, s32=slope2*32.f, s2x2=2.f*slope2, s4hi=slope2*4.f*(float)hi;
  const int wch=wid>>1, il=32*(wid&1)+r32;
  #define CMASK(P0,P1,t) do{int jb_=(t)-(NT-4); if(jb_>=0)bmask(P0,P1,jb_,wch,il,hi,s2x2);}while(0)
  #define CINIT0(C0,t) do{ const float bt_=s64*(float)((t)-NT)-mhat+s4hi; _Pragma("unroll") for(int r=0;r<16;++r){C0[r]=__builtin_fmaf(slope2,(float)((r&3)+8*(r>>2)),bt_);} }while(0)
  #define CINIT1(C1,t) do{ const float bu_=s64*(float)((t)-NT)-mhat+s4hi+s32; _Pragma("unroll") for(int r=0;r<16;++r){C1[r]=__builtin_fmaf(slope2,(float)((r&3)+8*(r>>2)),bu_);} }while(0)
  bool resc=false;
  #define START(P0,P1) do{ const float rm=rowmax(P0,P1); resc=false; \
    { const float dl=rm; mhat=fadd_s(mhat,dl); \
      _Pragma("unroll") for(int r=0;r<16;++r){P0[r]=fsub_s(P0[r],dl);P1[r]=fsub_s(P1[r],dl);} } \
    _Pragma("unroll") for(int r=0;r<16;++r)P0[r]=__builtin_amdgcn_exp2f(P0[r]); }while(0)
  #define RESC() do{ if(resc){ asm volatile("s_waitcnt lgkmcnt(0)":::"memory"); \
      _Pragma("unroll") for(int d_=0;d_<4;++d_) _Pragma("unroll") for(int r=0;r<16;++r)o[d_][r]*=wsf[crow(r,hi)]; } }while(0)
  f32x16 cS0,cS1;
  u32x4 pwa0,pwa1,pwa2,pwa3,pwb0,pwb1,pwb2,pwb3;
  int sl_prev=0,sl_cur=0,sl_next=SLOTB;
  #define ROT() do{sl_prev=sl_cur;sl_cur=sl_next;sl_next=(sl_next==(NSLOT-1)*SLOTB)?0:sl_next+SLOTB;}while(0)
  #define PKW(P,B) cvtpk_s(P[B],P[B+1])
  DMA_K(2,2*SLOTB);
  WAIT_BAR(3);
  { f32x16 c0,c1; CINIT0(c0,0); CINIT1(c1,0); qkt(cS0,cS1,Kbase,qr,c0,c1,r32,hi); }
  asm volatile("s_nop 15\n\ts_nop 7":"+v"(cS0),"+v"(cS1));CMASK(cS0,cS1,0);
  START(cS0,cS1);
  _Pragma("unroll") for(int r=0;r<16;++r)cS1[r]=__builtin_amdgcn_exp2f(cS1[r]);
  { float sacc=cS0[0]+cS0[1]; _Pragma("unroll") for(int r=2;r<16;++r)sacc+=cS0[r]; _Pragma("unroll") for(int r=0;r<16;++r)sacc+=cS1[r]; l_reg+=sacc;
    pwa0=(u32x4){PKW(cS0,0),PKW(cS0,2),PKW(cS0,4),PKW(cS0,6)};pwa1=(u32x4){PKW(cS0,8),PKW(cS0,10),PKW(cS0,12),PKW(cS0,14)};pwa2=(u32x4){PKW(cS1,0),PKW(cS1,2),PKW(cS1,4),PKW(cS1,6)};pwa3=(u32x4){PKW(cS1,8),PKW(cS1,10),PKW(cS1,12),PKW(cS1,14)}; }
  WAIT_BAR(0);
  DMA_K(3,0);DMA_V(1,SLOTB);
  ROT();
  kload8(kf,kp0+sl_cur);
  WAIT_BAR(3);
  s16x4 vlo[4],vhi[4];
  #define CAT_(a,b) a##b
  #define CAT(a,b) CAT_(a,b)
  #define PAFC(P,k) __builtin_bit_cast(bf16x8,CAT(P,k))
  #define VFR(k) (bf16x8){vlo[(k)&3][0],vlo[(k)&3][1],vlo[(k)&3][2],vlo[(k)&3][3],vhi[(k)&3][0],vhi[(k)&3][1],vhi[(k)&3][2],vhi[(k)&3][3]}
  #define VOFF(k) ((k)<8 ? (((k)&1)*4096+((k)>>1)*1024) : ((2+((k)&1))*4096+(((k)-8)>>1)*1024))
  #define PIN_(x) asm volatile("":"+v"(x))
  #define MX3(a,b,c) __builtin_fmaxf(__builtin_fmaxf((a),(b)),(c))
  #define QK(MF) do{ MF; SBAR(); }while(0)
  #define EX(v) __builtin_amdgcn_exp2f(v)
  #define VRD(k) do{ vlo[(k)&3]=vtr(vp_+VOFF(k)); vhi[(k)&3]=vtr(vp_+(VOFF(k)+512)); }while(0)
  #define VNX(k) do{ if((k)+4<16){ VRD((k)+4); } SBAR(); }while(0)
  #define GAPB3(MF,X,B,PW,J) do{ MF; X[B]=EX(X[B]); X[B+1]=EX(X[B+1]); sacc+=X[B]; sacc+=X[B+1]; PW[J]=cvtpk_s(X[B],X[B+1]); PIN_(X); PIN_(sacc); PIN_(PW); SBAR(); }while(0)
  #define KRD(G,j) do{ if(G){ kload2(kf,kp0+sl_next,j); SBAR(); } }while(0)
  #define STEP(PC,PN,t,GK,GV,GL) do{ SBAR(); \
    CINIT0(cS0,t); SBAR(); \
    const lds_cptr vp_=vp0+2*sl_prev; \
    VRD(0); SBAR(); QK(cS0=__builtin_amdgcn_mfma_f32_32x32x16_bf16(kf[0],qr[0],cS0,0,0,0)); \
    CINIT1(cS1,t); VRD(1); SBAR(); QK(cS1=__builtin_amdgcn_mfma_f32_32x32x16_bf16(kf[1],qr[0],cS1,0,0,0)); \
    VRD(2); SBAR(); QK(cS0=__builtin_amdgcn_mfma_f32_32x32x16_bf16(kf[2],qr[1],cS0,0,0,0)); \
    VRD(3); SBAR(); QK(cS1=__builtin_amdgcn_mfma_f32_32x32x16_bf16(kf[3],qr[1],cS1,0,0,0)); \
    QK(cS0=__builtin_amdgcn_mfma_f32_32x32x16_bf16(kf[4],qr[2],cS0,0,0,0)); \
    QK(cS1=__builtin_amdgcn_mfma_f32_32x32x16_bf16(kf[5],qr[2],cS1,0,0,0)); \
    QK(cS0=__builtin_amdgcn_mfma_f32_32x32x16_bf16(kf[6],qr[3],cS0,0,0,0)); \
    QK(cS1=__builtin_amdgcn_mfma_f32_32x32x16_bf16(kf[7],qr[3],cS1,0,0,0)); \
    if(GK){DMA_K((t)+3,sl_cur);} if(GV){DMA_V((t)+1,sl_next);} \
    CMASK(cS0,cS1,t); \
    { float a=MX3(cS0[0],cS0[1],cS1[0]),b=MX3(cS0[2],cS0[3],cS1[1]); a=MX3(a,cS1[2],cS1[3]); \
      _Pragma("unroll") for(int r=4;r<16;r+=4){a=MX3(a,cS0[r],cS0[r+1]);b=MX3(b,cS0[r+2],cS0[r+3]);a=MX3(a,cS1[r],cS1[r+1]);b=MX3(b,cS1[r+2],cS1[r+3]);} \
      float rm=__builtin_fmaxf(a,b); { auto rr=__builtin_amdgcn_permlane32_swap(__float_as_uint(rm),__float_as_uint(rm),false,false); rm=__builtin_fmaxf(__uint_as_float(rr[0]),__uint_as_float(rr[1])); } \
      resc=false; \
      if(__builtin_expect(__any(rm>(float)THRL),0)){ const float dl=__builtin_fmaxf(rm,0.f); mhat+=dl; \
        _Pragma("unroll") for(int r=0;r<16;++r){cS0[r]-=dl;cS1[r]-=dl;} \
        const float f=__builtin_amdgcn_exp2f(-dl); l_reg*=f; if(hi==0)wsf[r32]=f; resc=true; } } \
    SBAR(); float sacc=0.f; \
    GAPB3(o[0]=__builtin_amdgcn_mfma_f32_32x32x16_bf16(PAFC(PC,0),VFR(0),o[0],0,0,0), cS0,0, CAT(PN,0),0); VNX(0); \
    GAPB3(o[1]=__builtin_amdgcn_mfma_f32_32x32x16_bf16(PAFC(PC,0),VFR(1),o[1],0,0,0), cS0,2, CAT(PN,0),1); VNX(1); \
    KRD(GL,0); GAPB3(o[0]=__builtin_amdgcn_mfma_f32_32x32x16_bf16(PAFC(PC,1),VFR(2),o[0],0,0,0), cS0,4, CAT(PN,0),2); VNX(2); \
    KRD(GL,1); GAPB3(o[1]=__builtin_amdgcn_mfma_f32_32x32x16_bf16(PAFC(PC,1),VFR(3),o[1],0,0,0), cS0,6, CAT(PN,0),3); VNX(3); \
    KRD(GL,2); GAPB3(o[0]=__builtin_amdgcn_mfma_f32_32x32x16_bf16(PAFC(PC,2),VFR(4),o[0],0,0,0), cS0,8, CAT(PN,1),0); VNX(4); \
    KRD(GL,3); GAPB3(o[1]=__builtin_amdgcn_mfma_f32_32x32x16_bf16(PAFC(PC,2),VFR(5),o[1],0,0,0), cS0,10, CAT(PN,1),1); VNX(5); \
    GAPB3(o[0]=__builtin_amdgcn_mfma_f32_32x32x16_bf16(PAFC(PC,3),VFR(6),o[0],0,0,0), cS0,12, CAT(PN,1),2); VNX(6); \
    GAPB3(o[1]=__builtin_amdgcn_mfma_f32_32x32x16_bf16(PAFC(PC,3),VFR(7),o[1],0,0,0), cS0,14, CAT(PN,1),3); VNX(7); \
    GAPB3(o[2]=__builtin_amdgcn_mfma_f32_32x32x16_bf16(PAFC(PC,0),VFR(8),o[2],0,0,0), cS1,0, CAT(PN,2),0); VNX(8); \
    GAPB3(o[3]=__builtin_amdgcn_mfma_f32_32x32x16_bf16(PAFC(PC,0),VFR(9),o[3],0,0,0), cS1,2, CAT(PN,2),1); VNX(9); \
    GAPB3(o[2]=__builtin_amdgcn_mfma_f32_32x32x16_bf16(PAFC(PC,1),VFR(10),o[2],0,0,0), cS1,4, CAT(PN,2),2); VNX(10); \
    GAPB3(o[3]=__builtin_amdgcn_mfma_f32_32x32x16_bf16(PAFC(PC,1),VFR(11),o[3],0,0,0), cS1,6, CAT(PN,2),3); VNX(11); \
    GAPB3(o[2]=__builtin_amdgcn_mfma_f32_32x32x16_bf16(PAFC(PC,2),VFR(12),o[2],0,0,0), cS1,8, CAT(PN,3),0); VNX(12); \
    GAPB3(o[3]=__builtin_amdgcn_mfma_f32_32x32x16_bf16(PAFC(PC,2),VFR(13),o[3],0,0,0), cS1,10, CAT(PN,3),1); VNX(13); \
    GAPB3(o[2]=__builtin_amdgcn_mfma_f32_32x32x16_bf16(PAFC(PC,3),VFR(14),o[2],0,0,0), cS1,12, CAT(PN,3),2); VNX(14); \
    GAPB3(o[3]=__builtin_amdgcn_mfma_f32_32x32x16_bf16(PAFC(PC,3),VFR(15),o[3],0,0,0), cS1,14, CAT(PN,3),3); VNX(15); \
    l_reg+=sacc; \
    }while(0)
  int t=1;
  #undef CMASK
  #define CMASK(P0,P1,t) do{}while(0)
  for(;t+5<NT;t+=2){
    STEP(pwa,pwb,t,true,true,true);     WAIT_BAR(3); RESC(); ROT();
    STEP(pwb,pwa,t+1,true,true,true);   WAIT_BAR(3); RESC(); ROT();
  }
  #undef CMASK
  #define CMASK(P0,P1,t) do{int jb_=(t)-(NT-4); if(jb_>=0)bmask(P0,P1,jb_,wch,il,hi,s2x2);}while(0)
  #define ENDW(tt) do{ if((tt)+3<NT){WAIT_BAR(3);} else if((tt)+2<NT){WAIT_BAR(2);} else {WAIT_BAR(0);} }while(0)
  for(;t+1<NT;t+=2){
    STEP(pwa,pwb,t,(t+3<NT),(t+1<NT),(t+1<NT));       ENDW(t);   RESC(); ROT();
    STEP(pwb,pwa,t+1,(t+4<NT),(t+2<NT),(t+2<NT));     ENDW(t+1); RESC(); ROT();
  }
  STEP(pwa,pwb,NT-1,false,false,false); RESC();
  SBAR(); pv(o,vb0+2*sl_cur,PAFC(pwb,0),PAFC(pwb,1),PAFC(pwb,2),PAFC(pwb,3));
  #undef PKW
  #undef PAFC
  #undef CAT
  #undef CAT_
  #undef QK
  #undef GAPB3
  #undef VFR
  #undef PIN_
  #undef MX3
  #undef EX
  #undef VRD
  #undef VNX
  #undef VOFF
  #undef GAPB2
  #undef KRD
  #undef STEP
  #undef ENDW
  {auto rr=__builtin_amdgcn_permlane32_swap(__float_as_uint(l_reg),__float_as_uint(l_reg),false,false);l_reg=__uint_as_float(rr[0])+__uint_as_float(rr[1]);}
  {
    const int le=lane_now(), r32e=le&31, hie=le>>5;
    float*wsfe=(float*)(shm+LDS_WS)+wid*64;
    if(hie==0)wsfe[32+r32e]=l_reg;asm volatile("s_waitcnt lgkmcnt(0)":::"memory");
    float rli[16];
    #pragma unroll
    for(int r=0;r<16;++r)rli[r]=__builtin_amdgcn_rcpf(wsfe[32+crow(r,hie)]);
    bf16_t*Ow=Ob+(long)(q0+wid*QBLK)*POUT;
    bf16_t*stg=(bf16_t*)(shm+LDS_OST)+wid*4096;
    #pragma unroll
    for(int r=0;r<16;++r){const int orow=crow(r,hie);
      #pragma unroll
      for(int d0=0;d0<4;++d0)stg[orow*128+d0*32+r32e]=(bf16_t)f2bf(o[d0][r]*rli[r]);}
    asm volatile("s_waitcnt lgkmcnt(0)":::"memory");
    #pragma unroll
    for(int i=0;i<8;++i){const int row=i*4+(le>>4),ch=le&15; const u32x4 v=*(const u32x4*)(stg+row*128+ch*8); ATTN_STORE16(Ow+(long)row*POUT+ch*8,v);} }
  asm volatile("s_waitcnt lgkmcnt(0)\n\ts_barrier":::"memory");
  #undef DMA_K
  #undef DMA_V
  #undef CMASK
  #undef CINIT0
  #undef CINIT1
  #undef START
  #undef RESC
  #undef ROT
}
#undef SBAR
#undef WAIT_BAR
}

__device__ __forceinline__ void attn_phase(const Frame& F, const Args& a) {
    const bf16_t* proj = (const bf16_t*)(a.ws + WS_PROJ); bf16_t* OA = (bf16_t*)(a.ws + WS_OA);
    const int vcu = (F.G % 8 == 0) ? (F.bid % 8) * (F.G / 8) + F.bid / 8 : F.bid;
    for (int i = 0;; ++i) {
        int bhm, qb;
        if (F.G == 256) { if (i >= 2) break; const int s_ = vcu & 7; bhm = vcu >> 3; qb = (i == 0) ? 15 - s_ : s_; }
        else { const int u = i * F.G + F.bid; if (u >= 512) break; bhm = u >> 4; qb = 15 - (u & 15); }
        const int b = bhm >> 3, h = (bhm >> 1) & 3, map = bhm & 1;
        const bf16_t* base = proj + (size_t)b * SEQ * INC;
        const float slope2 = exp2f(-2.0f * (h + 1)) * 1.4426950408889634f;
        attn_body::attn_unit<8>(qb, base + C_QDA + h * 128 + map * 64, base + C_KDA + h * 128 + map * 64, base + C_VDA + h * 128,
                                OA + (size_t)b * SEQ * 1024 + h * 256 + map * 128, slope2, (char*)F.lds);
    }
}
__device__ __forceinline__ void attn_combine(const Frame& F, const Args& a) {
    const bf16_t* OA = (const bf16_t*)(a.ws + WS_OA); bf16_t* Y = (bf16_t*)(a.ws + WS_YDA);
    const float lam = ((const float*)(a.ws + WS_SMALL))[0];
    const float g0 = a.in[I_SUBG][2 * F.lane] * 0.8f, g1 = a.in[I_SUBG][2 * F.lane + 1] * 0.8f;
    const int gw = F.bid * NWAVES + F.wave, NGW = F.G * NWAVES;
    for (int r = gw; r < T; r += NGW) {
        const unsigned* orow = (const unsigned*)(OA + (size_t)r * 1024); unsigned* yrow = (unsigned*)(Y + (size_t)r * 512);
        unsigned w0[4], w1[4];
#pragma unroll
        for (int h = 0; h < 4; ++h) { w0[h] = orow[h * 128 + F.lane]; w1[h] = orow[h * 128 + 64 + F.lane]; }
#pragma unroll
        for (int h = 0; h < 4; ++h) {
            const float x0 = bf2f(w0[h] & 0xffffu) - lam * bf2f(w1[h] & 0xffffu), x1 = bf2f(w0[h] >> 16) - lam * bf2f(w1[h] >> 16);
            const float rs = rsqrtf(wave_sum(x0 * x0 + x1 * x1) * (1.0f / 128.0f) + EPS);
            yrow[h * 64 + F.lane] = pk2(x0 * rs * g0, x1 * rs * g1);
        }
    }
}
namespace hg {
constexpr int QP = 136;
constexpr int L_QD = 0, L_KD = 64 * QP * 2, L_V = 2 * 64 * QP * 2, L_KE = 3 * 64 * QP * 2, L_SSQ = 4 * 64 * QP * 2, L_G = L_SSQ + 512, L_ST = L_G + 64 * QP * 2;
__device__ __forceinline__ f32x4 mfma16(bf16x8 a, bf16x8 b, f32x4 c) { return __builtin_amdgcn_mfma_f32_16x16x32_bf16(a, b, c, 0, 0, 0); }
#define HG_BAR() do { asm volatile("s_waitcnt lgkmcnt(0)" ::: "memory"); __builtin_amdgcn_s_barrier(); asm volatile("" ::: "memory"); } while (0)
typedef short v4i16_t __attribute__((ext_vector_type(4)));
__device__ __forceinline__ bf16x8 tr8(const LAS unsigned char* img, int ra, int rb, int col0, int lane) {
    const int q = (lane & 15) >> 2, p = lane & 3;
    const v4i16_t lo = __builtin_amdgcn_ds_read_tr16_b64_v4i16((LAS v4i16_t*)(img + ((ra + q) * QP + col0 + 4 * p) * 2));
    const v4i16_t hi = __builtin_amdgcn_ds_read_tr16_b64_v4i16((LAS v4i16_t*)(img + ((rb + q) * QP + col0 + 4 * p) * 2));
    return (bf16x8){lo[0], lo[1], lo[2], lo[3], hi[0], hi[1], hi[2], hi[3]};
}
struct Tile { u32x4 p[2]; };
__device__ __forceinline__ void tile_load(Tile& t, const bf16_t* src, size_t pitch, int tid) {
#pragma unroll
    for (int i = 0; i < 2; ++i) { const int pc = tid + NTHR * i; t.p[i] = *(const u32x4*)(src + (size_t)(pc >> 4) * pitch + (pc & 15) * 8); }
}
__device__ __forceinline__ void tile_put(const Tile& t, LAS unsigned char* img, int tid) {
#pragma unroll
    for (int i = 0; i < 2; ++i) { const int pc = tid + NTHR * i; *(LAS u32x4*)(img + ((pc >> 4) * QP + (pc & 15) * 8) * 2) = t.p[i]; }
}
struct In1 { Tile ke, v; };
__device__ __forceinline__ void load1(In1& r, const Frame& F, const Args& a, int unit) {
    const int bh = unit >> 6, n = unit & 63, b = bh >> 2, h = bh & 3; const size_t t0 = (size_t)b * SEQ + n * 64;
    tile_load(r.ke, (const bf16_t*)a.out + t0 * 512 + h * 128, 512, F.tid);
    tile_load(r.v, (const bf16_t*)(a.ws + WS_PROJ) + t0 * INC + C_IHG + h * 128, INC, F.tid);
}
__device__ __forceinline__ void stage1_unit(const In1& raw, const Frame& F, const Args& a, int unit) {
    const int bh = unit >> 6, n = unit & 63;
    tile_put(raw.ke, F.lds + L_KE, F.tid); tile_put(raw.v, F.lds + L_V, F.tid);
    HG_BAR();
    const int wk = F.wave >> 1, wv = F.wave & 1, fr = F.lane & 15, fq = F.lane >> 4;
    f32x4 acc[2][4];
#pragma unroll
    for (int i = 0; i < 2; ++i)
#pragma unroll
        for (int j = 0; j < 4; ++j) acc[i][j] = (f32x4){0.f, 0.f, 0.f, 0.f};
#pragma unroll
    for (int s2 = 0; s2 < 2; ++s2) {
        bf16x8 af[2], bv[4];
#pragma unroll
        for (int kt = 0; kt < 2; ++kt) af[kt] = tr8(F.lds + L_KE, 32 * s2 + 8 * fq, 32 * s2 + 8 * fq + 4, 32 * wk + 16 * kt, F.lane);
#pragma unroll
        for (int vt = 0; vt < 4; ++vt) bv[vt] = tr8(F.lds + L_V, 32 * s2 + 8 * fq, 32 * s2 + 8 * fq + 4, 64 * wv + 16 * vt, F.lane);
#pragma unroll
        for (int kt = 0; kt < 2; ++kt)
#pragma unroll
            for (int vt = 0; vt < 4; ++vt) acc[kt][vt] = mfma16(af[kt], bv[vt], acc[kt][vt]);
    }
    bf16_t* ds = (bf16_t*)(a.ws + WS_DS) + ((size_t)bh * 64 + n) * 16384;
#pragma unroll
    for (int kt = 0; kt < 2; ++kt)
#pragma unroll
        for (int vt = 0; vt < 4; ++vt) { const int v = 64 * wv + 16 * vt + fr, k = 32 * wk + 16 * kt + 4 * fq;
            u32x2 w; w.x = pk2(acc[kt][vt][0], acc[kt][vt][1]); w.y = pk2(acc[kt][vt][2], acc[kt][vt][3]); *(u32x2*)(ds + v * 128 + k) = w; }
    HG_BAR();
}
__device__ __forceinline__ void stage1_all(const Frame& F, const Args& a) {
    int u = F.bid; if (u >= 1024) return;
    In1 cur, nxt; load1(cur, F, a, u);
    for (; u < 1024; u += F.G) { const int un = (u + F.G < 1024) ? u + F.G : u; load1(nxt, F, a, un); stage1_unit(cur, F, a, u); cur = nxt; }
}
__device__ __forceinline__ void stage2_scan(const Frame& F, const Args& a) {
    unsigned* ds = (unsigned*)(a.ws + WS_DS); const float* dec = (const float*)(a.ws + WS_DEC);
    for (int gt = F.bid * NTHR + F.tid; gt < 16 * 8192; gt += F.G * NTHR) {
        const int bh = gt >> 13, e2 = gt & 8191, k = (2 * e2) & 127;
        unsigned* p = ds + (size_t)bh * 64 * 8192 + e2; const float* dp = dec + (size_t)bh * 64 * 128 + k;
        float s0 = 0.f, s1 = 0.f;
#pragma unroll 8
        for (int n = 0; n < 64; ++n) { const unsigned u = p[(size_t)n * 8192]; const f32x2 d = *(const f32x2*)(dp + n * 128);
            p[(size_t)n * 8192] = pk2(s0, s1); s0 = d.x * s0 + bf2f(u & 0xffffu); s1 = d.y * s1 + bf2f(u >> 16); }
    }
}
struct In3 { Tile qd, kd, v, g, st0, st1; };
__device__ __forceinline__ void load3(In3& r, const Frame& F, const Args& a, int unit) {
    const int bh = unit >> 6, n = unit & 63, b = bh >> 2, h = bh & 3;
    const bf16_t* base = (const bf16_t*)(a.ws + WS_PROJ) + ((size_t)b * SEQ + n * 64) * INC;
    tile_load(r.qd, base + C_HGT + 256 * h, INC, F.tid); tile_load(r.kd, base + C_HGT + 256 * h + 128, INC, F.tid); tile_load(r.v, base + C_IHG + h * 128, INC, F.tid);
    tile_load(r.g, base + C_GHG + h * 128, INC, F.tid);
    const bf16_t* sst = (const bf16_t*)(a.ws + WS_DS) + ((size_t)bh * 64 + n) * 16384;
    tile_load(r.st0, sst, 128, F.tid); tile_load(r.st1, sst + 64 * 128, 128, F.tid);
}
__device__ __forceinline__ void stage3_unit(const In3& raw, const Frame& F, const Args& a, int unit) {
    const int bh = unit >> 6, n = unit & 63, b = bh >> 2, h = bh & 3;
    const int tb = F.wave >> 1, vh = F.wave & 1, fr = F.lane & 15, fq = F.lane >> 4;
    tile_put(raw.qd, F.lds + L_QD, F.tid); tile_put(raw.kd, F.lds + L_KD, F.tid); tile_put(raw.v, F.lds + L_V, F.tid); tile_put(raw.g, F.lds + L_G, F.tid);
    tile_put(raw.st0, F.lds + L_ST, F.tid); tile_put(raw.st1, F.lds + L_ST + 64 * QP * 2, F.tid);
    HG_BAR();
    bf16x8 qf[4];
#pragma unroll
    for (int ks = 0; ks < 4; ++ks) qf[ks] = *(const LAS bf16x8*)(F.lds + L_QD + ((16 * tb + fr) * QP + 32 * ks + 8 * fq) * 2);
    unsigned pk[4][2];
#pragma unroll
    for (int jt = 0; jt < 4; ++jt) { pk[jt][0] = 0u; pk[jt][1] = 0u;
        if (jt <= tb) { f32x4 sc = (f32x4){0.f, 0.f, 0.f, 0.f};
#pragma unroll
            for (int ks = 0; ks < 4; ++ks) { const bf16x8 kf = *(const LAS bf16x8*)(F.lds + L_KD + ((16 * jt + fr) * QP + 32 * ks + 8 * fq) * 2); sc = mfma16(kf, qf[ks], sc); }
            if (jt == tb) {
#pragma unroll
                for (int r = 0; r < 4; ++r) if (4 * fq + r > fr) sc[r] = 0.f;
            }
            pk[jt][0] = cvt_pk_bf16(sc[0], sc[1]); pk[jt][1] = cvt_pk_bf16(sc[2], sc[3]); } }
    f32x4 o[4];
#pragma unroll
    for (int vt = 0; vt < 4; ++vt) o[vt] = (f32x4){0.f, 0.f, 0.f, 0.f};
#pragma unroll
    for (int s2 = 0; s2 < 2; ++s2) if (2 * s2 <= tb) {
        const u32x4 aw = (u32x4){pk[2 * s2][0], pk[2 * s2][1], pk[2 * s2 + 1][0], pk[2 * s2 + 1][1]};
        const bf16x8 af = __builtin_bit_cast(bf16x8, aw);
#pragma unroll
        for (int vt = 0; vt < 4; ++vt) o[vt] = mfma16(af, tr8(F.lds + L_V, 32 * s2 + 4 * fq, 32 * s2 + 16 + 4 * fq, 64 * vh + 16 * vt, F.lane), o[vt]);
    }
#pragma unroll
    for (int ks = 0; ks < 4; ++ks)
#pragma unroll
        for (int vt = 0; vt < 4; ++vt) { const bf16x8 sb = *(const LAS bf16x8*)(F.lds + L_ST + ((64 * vh + 16 * vt + fr) * QP + 32 * ks + 8 * fq) * 2); o[vt] = mfma16(qf[ks], sb, o[vt]); }
#pragma unroll
    for (int r = 0; r < 4; ++r) { float v = 0.f;
#pragma unroll
        for (int vt = 0; vt < 4; ++vt) v += o[vt][r] * o[vt][r];
        v = scan16(v);
        if (fr == 15) ((LAS float*)(F.lds + L_SSQ))[(tb * 2 + vh) * 16 + 4 * fq + r] = v; }
    HG_BAR();
    LAS float* SSQ = (LAS float*)(F.lds + L_SSQ);
    const size_t t0 = (size_t)b * SEQ + n * 64 + 16 * tb + 4 * fq;
    bf16_t* yp = (bf16_t*)(a.ws + WS_YHG) + t0 * 512 + h * 128 + 64 * vh + fr;
    const f32x4 ta = *(const LAS f32x4*)(SSQ + (tb * 2) * 16 + 4 * fq), tb4 = *(const LAS f32x4*)(SSQ + (tb * 2 + 1) * 16 + 4 * fq);
#pragma unroll
    for (int r = 0; r < 4; ++r) { const float rs = rsqrtf((ta[r] + tb4[r]) * (1.0f / 128.0f) + EPS);
#pragma unroll
        for (int vt = 0; vt < 4; ++vt) { const float g = bf2f(*(const LAS unsigned short*)(F.lds + L_G + ((16 * tb + 4 * fq + r) * QP + 64 * vh + 16 * vt + fr) * 2)); const float ng = a.in[I_HGNG][64 * vh + 16 * vt + fr];
            yp[(size_t)r * 512 + 16 * vt] = (bf16_t)f2bf(o[vt][r] * rs * ng * g * __builtin_amdgcn_rcpf(1.0f + __builtin_amdgcn_exp2f(-1.4426950408889634f * g))); } }
    HG_BAR();
}
__device__ __forceinline__ void stage3_all(const Frame& F, const Args& a) {
    int u = F.bid; if (u >= 1024) return;
    In3 cur, nxt; load3(cur, F, a, u);
    for (; u < 1024; u += F.G) { const int un = (u + F.G < 1024) ? u + F.G : u; load3(nxt, F, a, un); stage3_unit(cur, F, a, u); cur = nxt; }
}
constexpr int PP = 72;
constexpr int G4_L_P = 4 * 64 * QP * 2, G4_L_DEC = G4_L_P + 64 * PP * 2, G4_L_SSQ = G4_L_DEC + 512;
struct InA { Tile qd, kd, ke, v; f32x4 dec; };
__device__ __forceinline__ void loadA(InA& r, const Frame& F, const Args& a, int bh, int n) {
    const int b = bh >> 2, h = bh & 3; const size_t t0 = (size_t)b * SEQ + n * 64;
    const bf16_t* base = (const bf16_t*)(a.ws + WS_PROJ) + t0 * INC;
    tile_load(r.qd, base + C_HGT + 256 * h, INC, F.tid); tile_load(r.kd, base + C_HGT + 256 * h + 128, INC, F.tid);
    tile_load(r.ke, (const bf16_t*)a.out + t0 * 512 + h * 128, 512, F.tid); tile_load(r.v, base + C_IHG + h * 128, INC, F.tid);
    r.dec = *(const f32x4*)((const float*)(a.ws + WS_DEC) + ((size_t)bh * 64 + n) * 128 + 4 * (F.tid & 31));
}
__device__ __forceinline__ void grp_local(const Frame& F, const Args& a, int grp) {
    const int bh = grp >> 4, n0 = 4 * (grp & 15), b = bh >> 2, h = bh & 3, w = F.wave, lane = F.lane, fr = lane & 15, fq = lane >> 4;
    for (int i = F.tid; i < 64 * PP / 2; i += NTHR) ((LAS unsigned*)(F.lds + G4_L_P))[i] = 0u;
    f32x4 S[8];
#pragma unroll
    for (int kt = 0; kt < 8; ++kt) S[kt] = (f32x4){0.f, 0.f, 0.f, 0.f};
    InA cur, nxt; loadA(cur, F, a, bh, n0);
    unsigned short yk[4][4];
#define G4_STORE(nn) do { bf16_t* yp_ = (bf16_t*)(a.ws + WS_YHG) + ((size_t)b * SEQ + (nn) * 64 + 4 * fq) * 512 + h * 128 + 16 * w + fr; \
        _Pragma("unroll") for (int tb = 0; tb < 4; ++tb) _Pragma("unroll") for (int r = 0; r < 4; ++r) yp_[(size_t)(16 * tb + r) * 512] = yk[tb][r]; } while (0)
    for (int j = 0; j < 4; ++j) {
        if (j > 0) G4_STORE(n0 + j - 1);
        loadA(nxt, F, a, bh, n0 + (j < 3 ? j + 1 : 3));
        tile_put(cur.qd, F.lds + L_QD, F.tid); tile_put(cur.kd, F.lds + L_KD, F.tid); tile_put(cur.ke, F.lds + L_KE, F.tid); tile_put(cur.v, F.lds + L_V, F.tid);
        if (F.tid < 32) *(LAS f32x4*)(F.lds + G4_L_DEC + 16 * F.tid) = cur.dec;
        HG_BAR();
#pragma unroll
        for (int rep = 0; rep < 2; ++rep) { const int pi = w + 8 * rep;
            if (pi < 10) { const int tb = pi >= 6 ? 3 : pi >= 3 ? 2 : pi >= 1 ? 1 : 0, jt = pi - (tb * (tb + 1)) / 2;
                f32x4 sc = (f32x4){0.f, 0.f, 0.f, 0.f};
#pragma unroll
                for (int ks = 0; ks < 4; ++ks) { const bf16x8 kf = *(const LAS bf16x8*)(F.lds + L_KD + ((16 * jt + fr) * QP + 32 * ks + 8 * fq) * 2);
                    const bf16x8 qf = *(const LAS bf16x8*)(F.lds + L_QD + ((16 * tb + fr) * QP + 32 * ks + 8 * fq) * 2); sc = mfma16(kf, qf, sc); }
                if (jt == tb) {
#pragma unroll
                    for (int r = 0; r < 4; ++r) if (4 * fq + r > fr) sc[r] = 0.f;
                }
                *(LAS u32x2*)(F.lds + G4_L_P + ((16 * tb + fr) * PP + 16 * jt + 4 * fq) * 2) = (u32x2){cvt_pk_bf16(sc[0], sc[1]), cvt_pk_bf16(sc[2], sc[3])}; } }
        HG_BAR();
        bf16x8 bv[2];
#pragma unroll
        for (int s2 = 0; s2 < 2; ++s2) bv[s2] = tr8(F.lds + L_V, 32 * s2 + 8 * fq, 32 * s2 + 8 * fq + 4, 16 * w, lane);
        bf16x8 Sb[4];
#pragma unroll
        for (int ks = 0; ks < 4; ++ks) { const u32x4 t = (u32x4){cvt_pk_bf16(S[2 * ks][0], S[2 * ks][1]), cvt_pk_bf16(S[2 * ks][2], S[2 * ks][3]), cvt_pk_bf16(S[2 * ks + 1][0], S[2 * ks + 1][1]), cvt_pk_bf16(S[2 * ks + 1][2], S[2 * ks + 1][3])};
            Sb[ks] = __builtin_bit_cast(bf16x8, t); }
#pragma unroll
        for (int tb = 0; tb < 4; ++tb) { f32x4 o = (f32x4){0.f, 0.f, 0.f, 0.f};
#pragma unroll
            for (int s2 = 0; s2 <= (tb >> 1); ++s2) { const bf16x8 pf = *(const LAS bf16x8*)(F.lds + G4_L_P + ((16 * tb + fr) * PP + 32 * s2 + 8 * fq) * 2); o = mfma16(pf, bv[s2], o); }
            if (j > 0) {
#pragma unroll
                for (int ks = 0; ks < 4; ++ks) { const LAS unsigned char* qrow = F.lds + L_QD + ((16 * tb + fr) * QP + 32 * ks + 4 * fq) * 2;
                    const u32x2 lo = *(const LAS u32x2*)qrow, hi = *(const LAS u32x2*)(qrow + 32);
                    const u32x4 aw = (u32x4){lo.x, lo.y, hi.x, hi.y}; o = mfma16(__builtin_bit_cast(bf16x8, aw), Sb[ks], o); } }
#pragma unroll
            for (int r = 0; r < 4; ++r) yk[tb][r] = (unsigned short)f2bf(o[r]); }
#pragma unroll
        for (int kt = 0; kt < 8; ++kt) { S[kt] = S[kt] * *(const LAS f32x4*)(F.lds + G4_L_DEC + (16 * kt + 4 * fq) * 4);
#pragma unroll
            for (int s2 = 0; s2 < 2; ++s2) S[kt] = mfma16(tr8(F.lds + L_KE, 32 * s2 + 8 * fq, 32 * s2 + 8 * fq + 4, 16 * kt, lane), bv[s2], S[kt]); }
        HG_BAR();
        cur = nxt;
    }
    G4_STORE(n0 + 3);
#undef G4_STORE
    f32x4* sg = (f32x4*)(a.ws + WS_DS) + ((size_t)grp * 64 + w * 8) * 64 + lane;
#pragma unroll
    for (int kt = 0; kt < 8; ++kt) sg[kt * 64] = S[kt];
}
__device__ __forceinline__ void grp_scan(const Frame& F, const Args& a) {
    f32x4* sg = (f32x4*)(a.ws + WS_DS); f32x4* si = sg + (size_t)256 * 4096; const float* dec = (const float*)(a.ws + WS_DEC);
    for (int gt = F.bid * NTHR + F.tid; gt < 16 * 4096; gt += F.G * NTHR) {
        const int bh = gt >> 12, slot = gt & 4095, kt = (slot >> 6) & 7, lane = slot & 63, k = 16 * kt + 4 * (lane >> 4);
        f32x4 cur = (f32x4){0.f, 0.f, 0.f, 0.f};
#pragma unroll 4
        for (int g = 0; g < 16; ++g) { const size_t gi = ((size_t)(bh * 16 + g)) * 4096 + slot;
            si[gi] = cur;
            const float* dp = dec + ((size_t)bh * 64 + 4 * g) * 128 + k;
            const f32x4 d = (*(const f32x4*)dp * *(const f32x4*)(dp + 128)) * (*(const f32x4*)(dp + 256) * *(const f32x4*)(dp + 384));
            cur = d * cur + sg[gi]; }
    }
}
struct InC { Tile qd, g, ol; f32x4 dec; };
__device__ __forceinline__ void loadC(InC& r, const Frame& F, const Args& a, int bh, int n) {
    const int b = bh >> 2, h = bh & 3; const size_t t0 = (size_t)b * SEQ + n * 64;
    const bf16_t* base = (const bf16_t*)(a.ws + WS_PROJ) + t0 * INC;
    tile_load(r.qd, base + C_HGT + 256 * h, INC, F.tid); tile_load(r.g, base + C_GHG + h * 128, INC, F.tid);
    tile_load(r.ol, (const bf16_t*)(a.ws + WS_YHG) + t0 * 512 + h * 128, 512, F.tid);
    r.dec = *(const f32x4*)((const float*)(a.ws + WS_DEC) + ((size_t)bh * 64 + n) * 128 + 4 * (F.tid & 31));
}
__device__ __forceinline__ void grp_final(const Frame& F, const Args& a, int grp) {
    const int bh = grp >> 4, n0 = 4 * (grp & 15), b = bh >> 2, h = bh & 3, w = F.wave, lane = F.lane, fr = lane & 15, fq = lane >> 4;
    f32x4 S[8];
    { const f32x4* si = (const f32x4*)(a.ws + WS_DS) + (size_t)256 * 4096 + ((size_t)grp * 64 + w * 8) * 64 + lane;
#pragma unroll
      for (int kt = 0; kt < 8; ++kt) S[kt] = si[kt * 64]; }
    const float ng = a.in[I_HGNG][16 * w + fr];
    LAS float* SSQ = (LAS float*)(F.lds + G4_L_SSQ);
    InC cur, nxt; loadC(cur, F, a, bh, n0);
    unsigned short yk[4][4];
#define G4_STORE(nn) do { bf16_t* yp_ = (bf16_t*)(a.ws + WS_YHG) + ((size_t)b * SEQ + (nn) * 64 + 4 * fq) * 512 + h * 128 + 16 * w + fr; \
        _Pragma("unroll") for (int tb = 0; tb < 4; ++tb) _Pragma("unroll") for (int r = 0; r < 4; ++r) yp_[(size_t)(16 * tb + r) * 512] = yk[tb][r]; } while (0)
    for (int j = 0; j < 4; ++j) {
        if (j > 0) G4_STORE(n0 + j - 1);
        loadC(nxt, F, a, bh, n0 + (j < 3 ? j + 1 : 3));
        tile_put(cur.qd, F.lds + L_QD, F.tid); tile_put(cur.g, F.lds + L_KD, F.tid); tile_put(cur.ol, F.lds + L_V, F.tid);
        if (F.tid < 32) *(LAS f32x4*)(F.lds + G4_L_DEC + 16 * F.tid) = cur.dec;
        HG_BAR();
        bf16x8 Sb[4];
#pragma unroll
        for (int ks = 0; ks < 4; ++ks) { const u32x4 t = (u32x4){cvt_pk_bf16(S[2 * ks][0], S[2 * ks][1]), cvt_pk_bf16(S[2 * ks][2], S[2 * ks][3]), cvt_pk_bf16(S[2 * ks + 1][0], S[2 * ks + 1][1]), cvt_pk_bf16(S[2 * ks + 1][2], S[2 * ks + 1][3])};
            Sb[ks] = __builtin_bit_cast(bf16x8, t); }
        f32x4 o[4];
#pragma unroll
        for (int tb = 0; tb < 4; ++tb) {
#pragma unroll
            for (int r = 0; r < 4; ++r) o[tb][r] = bf2f(*(const LAS unsigned short*)(F.lds + L_V + ((16 * tb + 4 * fq + r) * QP + 16 * w + fr) * 2));
#pragma unroll
            for (int ks = 0; ks < 4; ++ks) { const LAS unsigned char* qrow = F.lds + L_QD + ((16 * tb + fr) * QP + 32 * ks + 4 * fq) * 2;
                const u32x2 lo = *(const LAS u32x2*)qrow, hi = *(const LAS u32x2*)(qrow + 32);
                const u32x4 aw = (u32x4){lo.x, lo.y, hi.x, hi.y}; o[tb] = mfma16(__builtin_bit_cast(bf16x8, aw), Sb[ks], o[tb]); }
#pragma unroll
            for (int r = 0; r < 4; ++r) { const float v = scan16(o[tb][r] * o[tb][r]); if (fr == 15) SSQ[w * 64 + 16 * tb + 4 * fq + r] = v; } }
#pragma unroll
        for (int kt = 0; kt < 8; ++kt) S[kt] = S[kt] * *(const LAS f32x4*)(F.lds + G4_L_DEC + (16 * kt + 4 * fq) * 4);
        HG_BAR();
#pragma unroll
        for (int tb = 0; tb < 4; ++tb) { f32x4 tot = (f32x4){0.f, 0.f, 0.f, 0.f};
#pragma unroll
            for (int ww = 0; ww < 8; ++ww) tot += *(const LAS f32x4*)(SSQ + ww * 64 + 16 * tb + 4 * fq);
#pragma unroll
            for (int r = 0; r < 4; ++r) { const float rs = rsqrtf(tot[r] * (1.0f / 128.0f) + EPS); const float g = bf2f(*(const LAS unsigned short*)(F.lds + L_KD + ((16 * tb + 4 * fq + r) * QP + 16 * w + fr) * 2));
                yk[tb][r] = (unsigned short)f2bf(o[tb][r] * rs * ng * g * __builtin_amdgcn_rcpf(1.0f + __builtin_amdgcn_exp2f(-1.4426950408889634f * g))); } }
        HG_BAR();
        cur = nxt;
    }
    G4_STORE(n0 + 3);
#undef G4_STORE
}
#undef HG_BAR
}

__device__ __forceinline__ float rs4(float a0, float a1, float a2, float a3, int lane) {
    const bool hi = (lane & 32) != 0;
    const float s0 = hi ? a0 : a2, s1 = hi ? a1 : a3;
    const float k0 = (hi ? a2 : a0) + __shfl_xor(s0, 32), k1 = (hi ? a3 : a1) + __shfl_xor(s1, 32);
    const bool b4 = (lane & 16) != 0;
    const float sd = b4 ? k0 : k1;
    float k = (b4 ? k1 : k0) + __shfl_xor(sd, 16);
    k += __shfl_xor(k, 8); k += __shfl_xor(k, 4); k += __shfl_xor(k, 2); k += __shfl_xor(k, 1);
    return k;
}
__device__ __forceinline__ void phase_router(const Frame& F, const Args& a) {
    constexpr int AP = 1032;
    LAS bf16_t* AH = (LAS bf16_t*)F.lds;
    LAS bf16_t* AL = AH + 16 * AP;
    LAS float* PART = (LAS float*)(F.lds + 2 * 16 * AP * 2);
    LAS float* LG = PART + 8 * 16 * 48;
    LAS unsigned* LH = (LAS unsigned*)(LG + 16 * 48);
    LAS unsigned* LB = LH + 32;
    LAS unsigned* LR = LH + 64;
    if (F.tid < NEXP) LH[F.tid] = 0u;
    const float* mod = (const float*)(a.ws + WS_MOD);
    const float* x1 = a.out; bf16_t* H2 = (bf16_t*)(a.ws + WS_ACT);
    unsigned* counts = (unsigned*)(a.ws + WS_CTL) + CW_COUNTS; unsigned* tokinfo = (unsigned*)(a.ws + WS_TOKINFO); int* toklist = (int*)(a.ws + WS_TOKLIST);
    const int rows_per_blk = T / F.G, r0 = F.bid * rows_per_blk, b = r0 / SEQ;
    const int lane = F.lane, w = F.wave, fr = lane & 15, fq = lane >> 4;
    f32x4 v[2][4], vn[2][4];
#define RT_LOAD(V, rb_) do { _Pragma("unroll") for (int q = 0; q < 2; ++q) { const f32x4* xr_ = (const f32x4*)(x1 + (size_t)((rb_) + 2 * w + q) * D) + lane; \
        _Pragma("unroll") for (int j = 0; j < 4; ++j) V[q][j] = xr_[64 * j]; } } while (0)
    RT_LOAD(v, r0);
    bf16x8 Bh[4][3], Bl[4][3];
    {
        const float* wre = a.in[I_WRE]; const float* wrg = a.in[I_WRG];
#pragma unroll
        for (int ks = 0; ks < 4; ++ks)
#pragma unroll
            for (int ct = 0; ct < 3; ++ct) {
                unsigned hw[4], lw[4];
#pragma unroll
                for (int jp = 0; jp < 4; ++jp) { float x[2];
#pragma unroll
                    for (int z = 0; z < 2; ++z) { const int k = 128 * w + 32 * ks + 8 * fq + 2 * jp + z;
                        if (ct == 0) { const float g = wrg[k * 4 + (fr & 3)], e = wre[k * 32 + ((fr + 28) & 31)]; x[z] = fr < 4 ? g : e; }
                        else if (ct == 1) x[z] = wre[k * 32 + 12 + fr];
                        else { const float e = wre[k * 32 + 28 + (fr & 3)]; x[z] = fr < 4 ? e : 0.f; } }
                    const unsigned h0 = f2bf(x[0]), h1 = f2bf(x[1]); hw[jp] = h0 | (h1 << 16);
                    lw[jp] = pk2(x[0] - bf2f(h0), x[1] - bf2f(h1)); }
                Bh[ks][ct] = __builtin_bit_cast(bf16x8, (u32x4){hw[0], hw[1], hw[2], hw[3]}); Bl[ks][ct] = __builtin_bit_cast(bf16x8, (u32x4){lw[0], lw[1], lw[2], lw[3]});
            }
    }
    for (int g = 0; g < rows_per_blk / 16; ++g) {
        const int rg = r0 + 16 * g;
        { const int gn = g + 1 < rows_per_blk / 16 ? g + 1 : g; RT_LOAD(vn, r0 + 16 * gn); }
#pragma unroll
        for (int q = 0; q < 2; ++q) { float sq = 0.f;
#pragma unroll
            for (int j = 0; j < 4; ++j) sq += (v[q][j].x * v[q][j].x + v[q][j].y * v[q][j].y) + (v[q][j].z * v[q][j].z + v[q][j].w * v[q][j].w);
            const float rs = rsqrtf(wave_sum(sq) * (1.0f / D) + EPS); const int row = 2 * w + q;
#pragma unroll
            for (int j = 0; j < 4; ++j) { const int k = 256 * j + 4 * lane;
                const f32x4 gg = *(const f32x4*)(a.in[I_N2G] + k) * (1.0f + *(const f32x4*)(mod + b * 6144 + 4 * 1024 + k)), sh = *(const f32x4*)(mod + b * 6144 + 3 * 1024 + k);
                const f32x4 hv = v[q][j] * rs * gg + sh;
                const unsigned h0 = f2bf(hv.x), h1 = f2bf(hv.y), h2_ = f2bf(hv.z), h3 = f2bf(hv.w);
                const u32x2 hw = (u32x2){h0 | (h1 << 16), h2_ | (h3 << 16)};
                *(u32x2*)(H2 + (size_t)(rg + row) * D + k) = hw;
                *(LAS u32x2*)(AH + row * AP + k) = hw;
                *(LAS u32x2*)(AL + row * AP + k) = (u32x2){pk2(hv.x - bf2f(h0), hv.y - bf2f(h1)), pk2(hv.z - bf2f(h2_), hv.w - bf2f(h3))}; } }
        __syncthreads();
        f32x4 acc[3] = {{0.f, 0.f, 0.f, 0.f}, {0.f, 0.f, 0.f, 0.f}, {0.f, 0.f, 0.f, 0.f}};
#pragma unroll
        for (int ks = 0; ks < 4; ++ks) { const bf16x8 ah = *(const LAS bf16x8*)(AH + fr * AP + 128 * w + 32 * ks + 8 * fq), al = *(const LAS bf16x8*)(AL + fr * AP + 128 * w + 32 * ks + 8 * fq);
#pragma unroll
            for (int ct = 0; ct < 3; ++ct) { acc[ct] = __builtin_amdgcn_mfma_f32_16x16x32_bf16(ah, Bh[ks][ct], acc[ct], 0, 0, 0);
                acc[ct] = __builtin_amdgcn_mfma_f32_16x16x32_bf16(al, Bh[ks][ct], acc[ct], 0, 0, 0); acc[ct] = __builtin_amdgcn_mfma_f32_16x16x32_bf16(ah, Bl[ks][ct], acc[ct], 0, 0, 0); } }
#pragma unroll
        for (int ct = 0; ct < 3; ++ct)
#pragma unroll
            for (int r = 0; r < 4; ++r) PART[(w * 16 + 4 * fq + r) * 48 + 16 * ct + fr] = acc[ct][r];
        __syncthreads();
        for (int t = F.tid; t < 16 * 48; t += NTHR) { const int row = t / 48, o = t % 48; float sacc = 0.f;
#pragma unroll
            for (int ww = 0; ww < 8; ++ww) sacc += PART[(ww * 16 + row) * 48 + o];
            if (o < 36) LG[row * 48 + o] = sacc + (o < 4 ? a.in[I_BRG][o & 3] : a.in[I_BRE][(o + 28) & 31]); }
        __syncthreads();
        if (F.tid < 16) {
            const LAS float* lg = LG + F.tid * 48;
            float gl[4]; int gi = 0;
#pragma unroll
            for (int o = 0; o < 4; ++o) gl[o] = lg[o];
            float gm = gl[0];
#pragma unroll
            for (int o = 1; o < 4; ++o) if (gl[o] > gm) { gm = gl[o]; gi = o; }
            float gsum = 0.f;
#pragma unroll
            for (int o = 0; o < 4; ++o) gsum += expf(gl[o] - gm);
            const float gp = 1.0f / gsum;
            float el[8];
#pragma unroll
            for (int e = 0; e < 8; ++e) el[e] = lg[4 + gi * 8 + e];
            int i0 = 0; float m0 = el[0];
#pragma unroll
            for (int o = 1; o < 8; ++o) if (el[o] > m0) { m0 = el[o]; i0 = o; }
            int i1 = -1; float m1 = -INFINITY;
#pragma unroll
            for (int o = 0; o < 8; ++o) if (o != i0 && el[o] > m1) { m1 = el[o]; i1 = o; }
            const float e1 = expf(m1 - m0); const float w0 = gp / (1.0f + e1), w1 = gp * e1 / (1.0f + e1);
            const int rl = 16 * g + F.tid, ex0 = gi * 8 + i0, ex1 = gi * 8 + i1;
            const unsigned l0 = atomicAdd((unsigned*)(LH + ex0), 1u), l1 = atomicAdd((unsigned*)(LH + ex1), 1u);
            LAS unsigned* ri = LR + rl * 6;
            ri[0] = (unsigned)ex0; ri[1] = l0; ri[2] = (unsigned)ex1; ri[3] = l1; ri[4] = __float_as_uint(w0); ri[5] = __float_as_uint(w1);
        }
#pragma unroll
        for (int q = 0; q < 2; ++q)
#pragma unroll
            for (int j = 0; j < 4; ++j) v[q][j] = vn[q][j];
    }
#undef RT_LOAD
    __syncthreads();
    if (F.tid < NEXP) LB[F.tid] = atomicAdd(counts + 64 * F.tid, LH[F.tid]);
    __syncthreads();
    for (int rl = F.tid; rl < rows_per_blk; rl += NTHR) {
        const LAS unsigned* ri = LR + rl * 6; const int r = r0 + rl;
        const unsigned ex0 = ri[0], ex1 = ri[2], k0 = LB[ex0] + ri[1], k1 = LB[ex1] + ri[3];
        toklist[ex0 * T + k0] = r; toklist[ex1 * T + k1] = r;
        u32x4 t0; t0.x = ex0; t0.y = k0; t0.z = ex1; t0.w = k1;
        *(u32x4*)(tokinfo + (size_t)r * 8) = t0;
        tokinfo[(size_t)r * 8 + 4] = ri[4]; tokinfo[(size_t)r * 8 + 5] = ri[5];
    }
}
__device__ __forceinline__ void build_moe_tab(const Frame& F, const Args& a, LAS MoeTab* tab) {
    if (F.tid == 0) {
        const unsigned* counts = (const unsigned*)(a.ws + WS_CTL) + CW_COUNTS; int nt = 0;
        for (int e = 0; e < NEXP; ++e) { const int c = (int)__hip_atomic_load(counts + 64 * e, __ATOMIC_RELAXED, __HIP_MEMORY_SCOPE_AGENT); tab->cnt[e] = c; tab->tbase[e] = nt;
            const int n = (c + 255) >> 8; for (int m = 0; m < n; ++m) { tab->tile_e[nt] = e; tab->tile_m[nt] = m; ++nt; } }
        tab->tbase[NEXP] = nt; tab->nt = nt;
    }
    __syncthreads();
}
__device__ __forceinline__ void phase_final(const Frame& F, const Args& a, const LAS MoeTab* tab) {
    const float* mod = (const float*)(a.ws + WS_MOD); const unsigned* tokinfo = (const unsigned*)(a.ws + WS_TOKINFO); const bf16_t* Ys = (const bf16_t*)(a.ws + WS_YS);
    const int rows_per_blk = T / F.G, r0 = F.bid * rows_per_blk;
    for (int r = r0 + F.wave; r < r0 + rows_per_blk; r += NWAVES) {
        const int b = r / SEQ;
        const u32x4 ti = *(const u32x4*)(tokinfo + (size_t)r * 8);
        const float w0 = __uint_as_float(tokinfo[(size_t)r * 8 + 4]), w1 = __uint_as_float(tokinfo[(size_t)r * 8 + 5]);
        const size_t s0 = (size_t)tab->tbase[ti.x] * 256 + ti.y, s1 = (size_t)tab->tbase[ti.z] * 256 + ti.w;
        f32x4* xr = (f32x4*)(a.out + (size_t)r * D) + F.lane;
        const u32x2* y0 = (const u32x2*)(Ys + s0 * D) + F.lane; const u32x2* y1 = (const u32x2*)(Ys + s1 * D) + F.lane;
        f32x4 v[4]; float s = 0.f;
#pragma unroll
        for (int j = 0; j < 4; ++j) { const int k = 256 * j + 4 * F.lane;
            const f32x4 gt = *(const f32x4*)(mod + b * 6144 + 5 * 1024 + k); const u32x2 a0 = y0[64 * j], a1 = y1[64 * j];
            f32x4 m; m.x = w0 * bf2f(a0.x & 0xffffu) + w1 * bf2f(a1.x & 0xffffu); m.y = w0 * bf2f(a0.x >> 16) + w1 * bf2f(a1.x >> 16);
            m.z = w0 * bf2f(a0.y & 0xffffu) + w1 * bf2f(a1.y & 0xffffu); m.w = w0 * bf2f(a0.y >> 16) + w1 * bf2f(a1.y >> 16);
            v[j] = xr[64 * j] + gt * m; s += (v[j].x * v[j].x + v[j].y * v[j].y) + (v[j].z * v[j].z + v[j].w * v[j].w); }
        const float rs = rsqrtf(wave_sum(s) * (1.0f / D) + EPS);
#pragma unroll
        for (int j = 0; j < 4; ++j) { const f32x4 g = *(const f32x4*)(a.in[I_FG] + 256 * j + 4 * F.lane); xr[64 * j] = v[j] * rs * g; }
    }
}

#define XB_TMO      128
#define XB_XCNT(j)  (256  + 64 * (j))
#define XB_XSUB(j)  (1280 + 64 * (j))
#define XB_XGEN(j)  (2304 + 64 * (j))
#define XB_TOP      3328
#define XB_TOPGEN   3392
#define XCD_BAR_WORDS 3456
#define XB_SPIN_CAP (1u << 18)
__device__ __forceinline__ unsigned xb_ld(unsigned* p)              { return __hip_atomic_load(p, __ATOMIC_RELAXED, __HIP_MEMORY_SCOPE_AGENT); }
__device__ __forceinline__ unsigned xb_add(unsigned* p, unsigned v) { return __hip_atomic_fetch_add(p, v, __ATOMIC_RELAXED, __HIP_MEMORY_SCOPE_AGENT); }
__device__ __forceinline__ unsigned xb_xcc_id() { return (unsigned)__builtin_amdgcn_s_getreg((3 << 11) | 20) & 0xFu; }
#define XB_SPIN(cond, bar) do { unsigned _sp = 0; while (cond) { __builtin_amdgcn_s_sleep(1); \
    if ((++_sp & 255u) == 0u) { if (xb_ld(&(bar)[XB_TMO])) break; if (_sp > XB_SPIN_CAP) { atomicAdd(&(bar)[XB_TMO], 1u); break; } } } } while (0)
struct XcdBarrier { unsigned* bar; unsigned x; volatile LAS unsigned* st; };
__device__ __forceinline__ XcdBarrier xcd_barrier_post(unsigned* bar, volatile LAS unsigned* st) {
    XcdBarrier b; b.bar = bar; b.x = xb_xcc_id(); b.st = st;
    if (threadIdx.x == 0) (void)xb_add(&bar[XB_XCNT(b.x)], 1u);
    return b;
}
__device__ __forceinline__ void xcd_barrier_complete(unsigned* bar, unsigned x, unsigned& nloc, unsigned& nx) {
    const unsigned G = gridDim.x * gridDim.y * gridDim.z;
    unsigned sum, cnt, mine, sp = 0u;
    for (;;) {
        sum = 0u; cnt = 0u; mine = 0u;
#pragma unroll
        for (unsigned j = 0; j < 16; ++j) { const unsigned c = xb_ld(&bar[XB_XCNT(j)]); sum += c; cnt += (c > 0u) ? 1u : 0u; mine = (j == x) ? c : mine; }
        if (sum == G) break;
        __builtin_amdgcn_s_sleep(1);
        if ((++sp & 255u) == 0u) { if (xb_ld(&bar[XB_TMO])) break; if (sp > XB_SPIN_CAP) { atomicAdd(&bar[XB_TMO], 1u); break; } }
    }
    nloc = mine > 0u ? mine : 1u; nx = cnt > 0u ? cnt : 1u;
}
__device__ __forceinline__ void xcd_barrier(const XcdBarrier& b) {
    asm volatile("s_waitcnt vmcnt(0)" ::: "memory");
    __syncthreads();
    if (threadIdx.x == 0) {
        unsigned* bar = b.bar;
        __builtin_amdgcn_s_waitcnt(0);
        unsigned nloc = b.st[0], nx = b.st[1];
        if (nloc == 0u) { xcd_barrier_complete(bar, b.x, nloc, nx); b.st[0] = nloc; b.st[1] = nx; }
        const unsigned old = xb_add(&bar[XB_XSUB(b.x)], 1u);
        const unsigned gen = old / nloc;
        if (old + 1u == (gen + 1u) * nloc) {
            __builtin_amdgcn_fence(__ATOMIC_RELEASE, "agent");
            asm volatile("s_waitcnt vmcnt(0)" ::: "memory");
            const unsigned og = xb_add(&bar[XB_TOP], 1u);
            const unsigned tg = og / nx;
            if (og + 1u == (tg + 1u) * nx) xb_add(&bar[XB_TOPGEN], 1u);
            else XB_SPIN(xb_ld(&bar[XB_TOPGEN]) == tg, bar);
            __builtin_amdgcn_fence(__ATOMIC_ACQUIRE, "agent");
            xb_add(&bar[XB_XGEN(b.x)], 1u);
            asm volatile("s_waitcnt vmcnt(0)" ::: "memory");
        } else {
            XB_SPIN(xb_ld(&bar[XB_XGEN(b.x)]) == gen, bar);
            __builtin_amdgcn_fence(__ATOMIC_ACQUIRE, "agent");
            asm volatile("s_waitcnt vmcnt(0)" ::: "memory");
        }
    }
    __syncthreads();
}

constexpr int N_PHASES = 11;
__global__ void __launch_bounds__(NTHR, 2) mk_fwd(Args a) {
    extern __shared__ __attribute__((aligned(16))) unsigned char lds_raw[];
    Frame F; F.lds = (LAS unsigned char*)lds_raw; F.tid = threadIdx.x; F.lane = F.tid & 63; F.wave = __builtin_amdgcn_readfirstlane(F.tid >> 6); F.G = gridDim.x; F.bid = blockIdx.x;
    unsigned char* ws = a.ws;
    const int lo = a.ph_lo, hi = a.ph_hi;
#if MK_N_LAUNCHES == 1
    volatile LAS unsigned* MISC = (volatile LAS unsigned*)(F.lds + 152 * 1024);
    if (F.tid < 4) MISC[F.tid] = 0u;
    __syncthreads();
    XcdBarrier xbar = xcd_barrier_post((unsigned*)(ws + WS_CTL) + CW_BAR, MISC);
#ifndef PROBE_TS
#define PROBE_TS -1
#endif
#define STAMP(k) do { if (PROBE_TS >= 0 && F.bid == 0 && F.tid == 0) { const unsigned long long t_ = __builtin_amdgcn_s_memrealtime(); MISC[16 + 2 * (k)] = (unsigned)t_; MISC[17 + 2 * (k)] = (unsigned)(t_ >> 32); } } while (0)
#define SEAM(k) do { if (IN(k) && IN((k) + 1)) xcd_barrier(xbar); STAMP((k) + 1); } while (0)
    STAMP(0);
#else
#define SEAM(k) do { } while (0)
#endif
#ifndef PHASE_MASK
#define PHASE_MASK 0x7ff
#endif
#define IN(k) (((PHASE_MASK >> (k)) & 1) && lo <= (k) && (k) < hi)
    LAS MoeTab* tab = (LAS MoeTab*)(F.lds + 144 * 1024);

#ifndef REPEAT_PHASE
#define REPEAT_PHASE -1
#endif
#if MK_N_LAUNCHES == 1
#define RUNPH(k, ...) if (IN(k)) { F.lane = lane_now(); F.tid = F.wave * 64 + F.lane; __VA_ARGS__ if (REPEAT_PHASE == (k)) { xcd_barrier(xbar); __VA_ARGS__ } }
#else
#define RUNPH(k, ...) if (IN(k)) { F.lane = lane_now(); F.tid = F.wave * 64 + F.lane; __VA_ARGS__ }
#endif
    RUNPH(0, { phase0(F, a); }) SEAM(0);
    RUNPH(1, { phase1(F, a); __syncthreads(); dense_weight_convert(F, a); }) SEAM(1);
    RUNPH(2, {
        DenseOrder S{(const char*)(ws + WS_ACT), (const char*)(ws + WS_WIN), D, T / 256, INC / 256, F.G, F.bid};
        EpiInProj E{(bf16_t*)(ws + WS_PROJ), (bf16_t*)a.out, (float*)(ws + WS_DEC), (const float*)(ws + WS_SMALL) + 16, attn_body::C2};
        pg8::gemm_phase(F.lds, D, S, E);
    }) SEAM(2);
    RUNPH(3, {
        for (int g = F.bid; g < 256; g += F.G) hg::grp_local(F, a, g);
        __syncthreads();
        attn_phase(F, a);
    }) SEAM(3);
    RUNPH(4, { hg::grp_scan(F, a); attn_combine(F, a); }) SEAM(4);
    RUNPH(5, { for (int g = F.bid; g < 256; g += F.G) hg::grp_final(F, a, g); }) SEAM(5);
    RUNPH(6, {
        UpOrder S{(const char*)(ws + WS_YDA), (const char*)(ws + WS_YHG), (const char*)(ws + WS_WUPDA), (const char*)(ws + WS_WUPHG), F.G, F.bid};
        EpiUp E{(const bf16_t*)(ws + WS_PROJ), (bf16_t*)(ws + WS_ACT)};
        pg8::gemm_phase(F.lds, 512, S, E);
    }) SEAM(6);
    RUNPH(7, {
        DenseOrder S{(const char*)(ws + WS_ACT), (const char*)(ws + WS_WOUT), D, T / 256, D / 256, F.G, F.bid};
        EpiOut E{a.in[I_X], (const float*)(ws + WS_MOD), a.out};
        pg8::gemm_phase(F.lds, D, S, E);
        moe_weight_convert(F, a);
    }) SEAM(7);
    RUNPH(8, { phase_router(F, a); __syncthreads(); }) SEAM(8);
    RUNPH(9, {
        build_moe_tab(F, a, tab);
        unsigned* done = (unsigned*)(ws + WS_CTL) + CW_TILE;
        { Moe1Order S{tab, (const char*)(ws + WS_ACT), (const char*)(ws + WS_W13), (const int*)(ws + WS_TOKLIST), F.G, F.bid};
          EpiMoe1 E{(bf16_t*)(ws + WS_HS), done};
          pg8::gemm_phase(F.lds, D, S, E); }
        { Moe2Order S{tab, (const char*)(ws + WS_HS), (const char*)(ws + WS_W2), done, (unsigned*)(ws + WS_CTL) + CW_TMO, F.G, F.bid};
          EpiStoreBf16 E{(bf16_t*)(ws + WS_YS), D, 0, 1.0f};
          pg8::gemm_phase(F.lds, DEXP, S, E); }
    }) SEAM(9);
    RUNPH(10, { build_moe_tab(F, a, tab); phase_final(F, a, tab); })
#if MK_N_LAUNCHES == 1
    if (PROBE_TS >= 0) {
        __syncthreads(); STAMP(11);
        if (F.bid == 0 && F.tid == 0) {
            const int ka = PROBE_TS & 15, kb = (PROBE_TS >> 4) & 15;
            const unsigned long long a0 = ((unsigned long long)MISC[17 + 2 * ka] << 32) | MISC[16 + 2 * ka], a1 = ((unsigned long long)MISC[19 + 2 * ka] << 32) | MISC[18 + 2 * ka];
            const unsigned long long b0 = ((unsigned long long)MISC[17 + 2 * kb] << 32) | MISC[16 + 2 * kb], b1 = ((unsigned long long)MISC[19 + 2 * kb] << 32) | MISC[18 + 2 * kb];
            const float da = (float)(a1 - a0) * 0.01f, db = (float)(b1 - b0) * 0.01f;
            asm volatile("s_waitcnt vmcnt(0)" ::: "memory");
            a.out[0] += sqrtf(da * 16.78f); a.out[1] += db * 0.1f;
        }
    }
#endif
#undef IN
#undef SEAM
}

extern "C" void kernel_launch(void* const* d_in, const int* in_sizes, int n_in, void* d_out, int out_size, void* d_ws, size_t ws_size, hipStream_t stream) {
    static int grid = 0;
    if (grid == 0) {
        if (n_in != 25 || in_sizes[0] != T * D || out_size != T * D || ws_size < WS_END) { fprintf(stderr, "kernel_launch: unexpected shapes (n_in %d, in0 %d, out %d, ws %zu)\n", n_in, n_in > 0 ? in_sizes[0] : -1, out_size, ws_size); grid = -1; return; }
        int dev = 0, cus = 0, per_cu = 0;
        if (hipGetDevice(&dev) != hipSuccess || hipDeviceGetAttribute(&cus, hipDeviceAttributeMultiprocessorCount, dev) != hipSuccess) { grid = -1; return; }
        if (hipFuncSetAttribute((const void*)mk_fwd, hipFuncAttributeMaxDynamicSharedMemorySize, LDS_BYTES) != hipSuccess) { fprintf(stderr, "kernel_launch: hipFuncSetAttribute failed\n"); grid = -1; return; }
        if (hipOccupancyMaxActiveBlocksPerMultiprocessor(&per_cu, (const void*)mk_fwd, NTHR, LDS_BYTES) != hipSuccess || per_cu < 1) { fprintf(stderr, "kernel_launch: occupancy query says %d\n", per_cu); per_cu = 1; }
        (void)hipGetLastError();
        grid = cus;
        if (grid > 256) grid = 256;
        while (T % grid) --grid;
    }
    if (grid < 0) return;
    (void)hipMemsetAsync((char*)d_ws + WS_CTL, 0, CTL_ZERO_BYTES, stream);
    Args a{};
    for (int i = 0; i < 25; ++i) a.in[i] = (const float*)d_in[i];
    a.out = (float*)d_out; a.ws = (unsigned char*)d_ws;
#if MK_N_LAUNCHES == 1
    a.ph_lo = 0; a.ph_hi = N_PHASES;
    void* args[] = {&a};
    hipError_t e = hipLaunchCooperativeKernel((const void*)mk_fwd, dim3(grid), dim3(NTHR), args, LDS_BYTES, stream);
    if (e != hipSuccess) fprintf(stderr, "cooperative launch failed: %s (grid %d)\n", hipGetErrorString(e), grid);
#else
    for (int p = 0; p < N_PHASES; ++p) {
        a.ph_lo = p; a.ph_hi = p + 1;
        hipLaunchKernelGGL(mk_fwd, dim3(grid), dim3(NTHR), LDS_BYTES, stream, a);
    }
#endif
}
```

```cpp
#include <hip/hip_runtime.h>
#include <cstdio>
#include <cstdint>

#ifndef MK_N_LAUNCHES
#define MK_N_LAUNCHES 1
#endif

#define LAS __attribute__((address_space(3)))
typedef unsigned short bf16_t;
typedef short bf16x8 __attribute__((ext_vector_type(8)));
typedef float f32x4 __attribute__((ext_vector_type(4)));
typedef float f32x2 __attribute__((ext_vector_type(2)));
typedef unsigned u32x4 __attribute__((ext_vector_type(4)));
typedef unsigned u32x2 __attribute__((ext_vector_type(2)));

constexpr int NB = 4, SEQ = 4096, D = 1024, T = NB * SEQ;
constexpr int INC = 5632;
constexpr int C_QDA = 0, C_KDA = 512, C_VDA = 1024, C_QHG = 1536, C_FHG = 2048, C_IHG = 2560, C_GHG = 3072, C_GDA = 3584, C_GHGATE = 4608;
constexpr int C_HGT = 1536;
constexpr int NEXP = 32, DEXP = 512;
constexpr int PMAX = 40960;
constexpr float EPS = 1e-6f;
constexpr int NWAVES = 8, NTHR = 512;

constexpr size_t MiB = 1u << 20;
constexpr size_t WS_CTL = 0, CTL_ZERO_BYTES = 64 * 1024;
constexpr size_t WS_MODP = 1 * MiB;
constexpr size_t WS_MOD = 5 * MiB / 2;
constexpr size_t WS_SMALL = 11 * MiB / 4;
constexpr size_t WS_TOKINFO = 3 * MiB;
constexpr size_t WS_TOKLIST = 4 * MiB;
constexpr size_t WS_DEC = 6 * MiB;
constexpr size_t WS_DS = 24 * MiB;
constexpr size_t WS_WIN = 8 * MiB;
constexpr size_t WS_WUPDA = 20 * MiB, WS_WUPHG = 21 * MiB, WS_WOUT = 22 * MiB;
constexpr size_t WS_ACT = 24 * MiB;
constexpr size_t WS_PROJ = 56 * MiB;
constexpr size_t WS_YDA = 232 * MiB, WS_YHG = 248 * MiB;
constexpr size_t WS_OA = 264 * MiB;
constexpr size_t WS_W13 = 56 * MiB;
constexpr size_t WS_W2 = 120 * MiB;
constexpr size_t WS_HS = 152 * MiB;
constexpr size_t WS_YS = 192 * MiB;
constexpr size_t WS_END = 296 * MiB;
constexpr int CW_COUNTS = 64;
constexpr int CW_BAR = 4096;
constexpr int CW_TILE = 8192;
constexpr int CW_TMO = 32;

constexpr int LDS_BYTES = 160 * 1024;

__device__ __forceinline__ float bf2f(unsigned v) { return __uint_as_float(v << 16); }
__device__ __forceinline__ unsigned f2bf(float f) { unsigned u = __float_as_uint(f); return (u + 0x7fffu + ((u >> 16) & 1u)) >> 16; }
__device__ __forceinline__ unsigned pk2(float lo, float hi) { return f2bf(lo) | (f2bf(hi) << 16); }
__device__ __forceinline__ float sigmoidf_(float x) { return 1.0f / (1.0f + __expf(-x)); }
__device__ __forceinline__ float siluf_(float x) { return x / (1.0f + __expf(-x)); }
__device__ __forceinline__ int lane_now() { int l; asm volatile("v_mbcnt_lo_u32_b32 %0, -1, 0\n\tv_mbcnt_hi_u32_b32 %0, -1, %0" : "=v"(l)); return l; }
__device__ __forceinline__ float wave_sum(float v) {
#pragma unroll
    for (int o = 1; o < 64; o <<= 1) v += __shfl_xor(v, o);
    return v;
}

namespace pg8 {
constexpr int BM = 256, BK = 64, HALF = 128, HTB = HALF * BK * 2, STAGE_BYTES = 8 * HTB;
__host__ __device__ __forceinline__ int lds_byte(int r, int c) { const int st = (r >> 4) * 2 + (c >> 5), rr = r & 15, cc = c & 31, ob = rr * 64 + cc * 2; return st * 1024 + (ob ^ (((ob >> 9) & 1) << 5)); }
__host__ __device__ __forceinline__ void stage_rc(int b, int& R, int& C) { const int st = b / 1024, sb = b % 1024, swz = sb ^ (((sb >> 9) & 1) << 5); R = (st >> 1) * 16 + swz / 64; C = (st & 1) * 32 + (swz % 64) / 2; }
__host__ __device__ __forceinline__ int perm32(int rho) { const int n = rho >> 4, i = rho & 15; return 8 * (i >> 2) + 4 * n + (i & 3); }

struct Unit { int pm, pn; const char* A; const char* B; int aux; };
__device__ __forceinline__ unsigned cvt_pk_bf16(float lo, float hi) { unsigned r; asm volatile("v_cvt_pk_bf16_f32 %0, %1, %2" : "=v"(r) : "v"(lo), "v"(hi)); return r; }

template <class Epi, class Sched>
__device__ __forceinline__ void gemm_phase(LAS unsigned char* lds, const int K, const Sched& S, const Epi& E) {
    const int tid = threadIdx.x, wid = __builtin_amdgcn_readfirstlane(tid >> 6), lane = tid & 63, wr = wid >> 2, wc = wid & 3, fr = lane & 15, fq = lane >> 4;
    const int nt = K / BK;
    unsigned voffB[2];
#define PG8_SETLANE() do { const int _l = lane_now(), _t = wid * 64 + _l; _Pragma("unroll") for (int _i = 0; _i < 2; ++_i) { int _R, _C; stage_rc(_t * 16 + _i * 8192, _R, _C); \
        const int _Rb = Epi::PERM ? ((_R & ~31) + perm32(_R & 31)) : _R; voffB[_i] = (unsigned)(_Rb * K + _C) * 2u; } \
        aoff = lds_byte(wr * 64 + (_l & 15), (_l >> 4) * 8); boff = lds_byte(wc * 32 + (_l & 15), (_l >> 4) * 8); } while (0)
    const size_t kstep = (size_t)(BK * 2);
    const size_t hstep = (size_t)HALF * K * 2;
    const unsigned ldsw = (unsigned)wid * 1024u;
    int aoff, boff; PG8_SETLANE();
#define PG8_SA(b, h) (((b) * 2 + (h)) * HTB)
#define PG8_SB(b, h) ((4 + (b) * 2 + (h)) * HTB)
#define PG8_STAGE(bufoff, gbase, voff) do { _Pragma("unroll") for (int _i = 0; _i < 2; ++_i) \
        __builtin_amdgcn_global_load_lds((const unsigned*)((const char*)(gbase) + (voff)[_i]), (LAS unsigned*)(lds + (bufoff) + ldsw + _i * 8192), 16, 0, 0); } while (0)
#define PG8_LDA(dst, b, h) do { _Pragma("unroll") for (int m = 0; m < 4; ++m) _Pragma("unroll") for (int k = 0; k < 2; ++k) dst[m][k] = *(const LAS bf16x8*)(lds + PG8_SA(b, h) + aoff + m * 2048 + k * 1024); } while (0)
#define PG8_LDB(dst, b, h) do { _Pragma("unroll") for (int n = 0; n < 2; ++n) _Pragma("unroll") for (int k = 0; k < 2; ++k) dst[n][k] = *(const LAS bf16x8*)(lds + PG8_SB(b, h) + boff + n * 2048 + k * 1024); } while (0)
#define PG8_MMA(ai, bj, At, Bt) do { __builtin_amdgcn_s_setprio(1); _Pragma("unroll") for (int m = 0; m < 4; ++m) _Pragma("unroll") for (int n = 0; n < 2; ++n) _Pragma("unroll") for (int k = 0; k < 2; ++k) \
        acc[ai][bj][m][n] = __builtin_amdgcn_mfma_f32_16x16x32_bf16(Bt[n][k], At[m][k], acc[ai][bj][m][n], 0, 0, 0); __builtin_amdgcn_s_setprio(0); } while (0)
#define PG8_WAIT_V(n) asm volatile("s_waitcnt vmcnt(" #n ")" ::: "memory")
#define PG8_WAIT_L(n) asm volatile("s_waitcnt lgkmcnt(" #n ")" ::: "memory")
#define PG8_BAR __builtin_amdgcn_s_barrier()
#define PG8_SCHED __builtin_amdgcn_sched_barrier(0)
#define PG8_SETA(vo, u) do { const int _t = wid * 64 + lane_now(); _Pragma("unroll") for (int _i = 0; _i < 2; ++_i) { int _R, _C; stage_rc(_t * 16 + _i * 8192, _R, _C); \
        _Pragma("unroll") for (int _h = 0; _h < 2; ++_h) vo[_h][_i] = (unsigned)((size_t)S.arow(u, _h * HALF + _R) * (size_t)K + _C) * 2u; } if (Sched::GATHER) PG8_WAIT_V(0); } while (0)
    Unit cur, nxt; int ui = 0;
    if (!S.next(0, cur)) return;
    f32x4 acc[2][2][4][2];
#pragma unroll
    for (int a = 0; a < 2; ++a)
#pragma unroll
        for (int b = 0; b < 2; ++b)
#pragma unroll
            for (int m = 0; m < 4; ++m)
#pragma unroll
                for (int n = 0; n < 2; ++n) acc[a][b][m][n] = (f32x4){0.f, 0.f, 0.f, 0.f};
    bf16x8 At[4][2], B0[2][2], B1[2][2];
    unsigned voC[2][2], voN[2][2];
    S.a_ready(cur);
    PG8_SETA(voC, cur);
    const char* cA = cur.A; const char* cB = cur.B;
    PG8_STAGE(PG8_SB(0, 0), cB, voffB); PG8_STAGE(PG8_SB(0, 1), cB + hstep, voffB); PG8_STAGE(PG8_SA(0, 0), cA, voC[0]); PG8_STAGE(PG8_SA(0, 1), cA, voC[1]);
    if (wr == 1) PG8_BAR;
    PG8_WAIT_V(2); PG8_BAR;
    PG8_STAGE(PG8_SB(1, 0), cB + kstep, voffB); PG8_STAGE(PG8_SA(1, 0), cA + kstep, voC[0]); PG8_STAGE(PG8_SB(1, 1), cB + hstep + kstep, voffB);
    PG8_WAIT_V(6); PG8_BAR;
    for (;;) {
        const bool has_next = S.next(ui + 1, nxt);
        if (has_next) { PG8_SETA(voN, nxt); }
        else {
#pragma unroll
            for (int h = 0; h < 2; ++h)
#pragma unroll
                for (int i = 0; i < 2; ++i) voN[h][i] = voC[h][i];
        }
        const char* nA = has_next ? nxt.A : cA; const char* nB = has_next ? nxt.B : cB;
        for (int t = 0; t < nt; t += 2) {
            const bool last = (t == nt - 2);
            if (last && has_next) S.a_ready(nxt);
            const char* a1 = cA + (size_t)(t + 1) * kstep;
            const char* a2 = last ? nA : cA + (size_t)(t + 2) * kstep; const char* b2 = last ? nB : cB + (size_t)(t + 2) * kstep;
            const char* a3 = a2 + kstep; const char* b3 = b2 + kstep;
            unsigned vo2[2][2];
#pragma unroll
            for (int h = 0; h < 2; ++h)
#pragma unroll
                for (int i = 0; i < 2; ++i) vo2[h][i] = last ? voN[h][i] : voC[h][i];
            PG8_LDB(B0, 0, 0); PG8_LDB(B1, 0, 1); PG8_SCHED; PG8_LDA(At, 0, 0); PG8_STAGE(PG8_SA(1, 1), a1, voC[1]);
            PG8_WAIT_V(8); PG8_WAIT_L(0); PG8_BAR; PG8_MMA(0, 0, At, B0); PG8_MMA(0, 1, At, B1); PG8_BAR; PG8_SCHED;
            PG8_LDA(At, 0, 1); PG8_STAGE(PG8_SB(0, 0), b2, voffB); PG8_STAGE(PG8_SB(0, 1), b2 + hstep, voffB); PG8_STAGE(PG8_SA(0, 0), a2, vo2[0]);
            PG8_WAIT_V(8); PG8_WAIT_L(0); PG8_BAR; PG8_MMA(1, 0, At, B0); PG8_MMA(1, 1, At, B1); PG8_BAR; PG8_SCHED;
            PG8_LDB(B0, 1, 0); PG8_LDB(B1, 1, 1); PG8_SCHED; PG8_LDA(At, 1, 0); PG8_STAGE(PG8_SA(0, 1), a2, vo2[1]);
            PG8_WAIT_V(8); PG8_WAIT_L(0); PG8_BAR; PG8_MMA(0, 0, At, B0); PG8_MMA(0, 1, At, B1); PG8_BAR; PG8_SCHED;
            PG8_LDA(At, 1, 1); PG8_STAGE(PG8_SB(1, 0), b3, voffB); PG8_STAGE(PG8_SB(1, 1), b3 + hstep, voffB); PG8_STAGE(PG8_SA(1, 0), a3, vo2[0]);
            PG8_WAIT_V(8); PG8_WAIT_L(0); PG8_BAR; PG8_MMA(1, 0, At, B0); PG8_MMA(1, 1, At, B1); PG8_BAR; PG8_SCHED;
        }
        if (wr == 0) PG8_BAR;
        const bool keep = E(acc, cur, wr, wc, fr, fq);
        if (!has_next) break;
        if (!keep) {
#pragma unroll
            for (int a = 0; a < 2; ++a)
#pragma unroll
                for (int b = 0; b < 2; ++b)
#pragma unroll
                    for (int m = 0; m < 4; ++m)
#pragma unroll
                        for (int n = 0; n < 2; ++n) acc[a][b][m][n] = (f32x4){0.f, 0.f, 0.f, 0.f};
        }
        cur = nxt; cA = nA; cB = nB; ++ui;
        if (Sched::GATHER) {
#pragma unroll
            for (int h = 0; h < 2; ++h)
#pragma unroll
                for (int i = 0; i < 2; ++i) voC[h][i] = voN[h][i];
        } else { PG8_SETA(voC, cur); }
        PG8_SETLANE();
        if (wr == 1) PG8_BAR;
    }
    PG8_WAIT_V(0);
    PG8_BAR;
#undef PG8_SA
#undef PG8_SB
#undef PG8_STAGE
#undef PG8_LDA
#undef PG8_LDB
#undef PG8_MMA
#undef PG8_WAIT_V
#undef PG8_WAIT_L
#undef PG8_BAR
#undef PG8_SCHED
#undef PG8_SETA
#undef PG8_SETLANE
}
}

struct Args { const float* in[25]; float* out; unsigned char* ws; int ph_lo, ph_hi; };
enum { I_X = 0, I_C, I_WADA, I_BADA, I_N1G, I_WIN, I_LQ1, I_LK1, I_LQ2, I_LK2, I_SUBG, I_LBL, I_HGNG, I_WUPDA, I_WUPHG, I_WOUT, I_N2G, I_WRG, I_BRG, I_WRE, I_BRE, I_W1, I_W3, I_W2, I_FG };

struct DenseOrder {
    static constexpr bool GATHER = false;
    const char* A; const char* Bt; int K, nM, nN, G, c;
    __device__ __forceinline__ bool next(int i, pg8::Unit& u) const {
        const int L = i * G + c, nwg = nM * nN; if (L >= nwg) return false;
        int wgid = L; { const int q = nwg / 8, r = nwg % 8, xcd = wgid % 8, off = wgid / 8; wgid = (xcd < r ? xcd * (q + 1) : r * (q + 1) + (xcd - r) * q) + off; }
        const int nig = 8 * nN, gid = wgid / nig, fm = gid * 8, gsz = (nM - fm) < 8 ? (nM - fm) : 8;
        u.pm = fm + ((wgid % nig) % gsz); u.pn = (wgid % nig) / gsz; u.A = A; u.B = Bt + (size_t)u.pn * 256 * K * 2; u.aux = 0; return true;
    }
    __device__ __forceinline__ void a_ready(const pg8::Unit&) const {}
    __device__ __forceinline__ unsigned arow(const pg8::Unit& u, int r) const { return (unsigned)(u.pm * 256 + r); }
};
struct UpOrder {
    static constexpr bool GATHER = false;
    const char* A0; const char* A1; const char* B0; const char* B1; int G, c;
    __device__ __forceinline__ bool next(int i, pg8::Unit& u) const {
        const int tile = (i >> 1) * G + c; if (tile >= 256) return false;
        u.pm = tile >> 2; u.pn = tile & 3; u.aux = i & 1;
        u.A = (i & 1) ? A1 : A0; u.B = ((i & 1) ? B1 : B0) + (size_t)u.pn * 256 * 512 * 2; return true;
    }
    __device__ __forceinline__ void a_ready(const pg8::Unit&) const {}
    __device__ __forceinline__ unsigned arow(const pg8::Unit& u, int r) const { return (unsigned)(u.pm * 256 + r); }
};
struct MoeTab { int nt; int pad[3]; int tile_e[176]; int tile_m[176]; int cnt[32]; int tbase[33]; };
struct Moe1Order {
    static constexpr bool GATHER = true;
    const LAS MoeTab* tab; const char* A; const char* W; const int* toklist; int G, c;
    __device__ __forceinline__ bool next(int i, pg8::Unit& u) const {
        const int L = i * G + c; if (L >= tab->nt * 4) return false;
        const int ti = L >> 2; u.pm = ti; u.pn = L & 3; u.aux = ti; u.A = A;
        u.B = W + ((size_t)tab->tile_e[ti] * 1024 + (size_t)u.pn * 256) * 1024 * 2; return true;
    }
    __device__ __forceinline__ void a_ready(const pg8::Unit&) const {}
    __device__ __forceinline__ unsigned arow(const pg8::Unit& u, int r) const {
        const int e = tab->tile_e[u.aux], rr = tab->tile_m[u.aux] * 256 + r;
        return rr < tab->cnt[e] ? (unsigned)toklist[e * T + rr] : 0u;
    }
};
struct Moe2Order {
    static constexpr bool GATHER = false;
    const LAS MoeTab* tab; const char* A; const char* W; unsigned* done; unsigned* tmo; int G, c;
    __device__ __forceinline__ bool next(int i, pg8::Unit& u) const {
        const int n1 = tab->nt * 4, r = n1 % G, nl = G - r; int j;
        if (r > 0 && c >= r) { if (i < 2) j = (c - r) + i * nl; else j = 2 * nl + (c - r) + (i - 2) * G; }
        else j = (r > 0 ? 2 * nl : 0) + ((c - r + G) % G) + i * G;
        if (j >= n1) return false;
        const int ti = j >> 2; u.pm = ti; u.pn = j & 3; u.aux = ti; u.A = A;
        u.B = W + ((size_t)tab->tile_e[ti] * 1024 + (size_t)u.pn * 256) * 512 * 2; return true;
    }
    __device__ __forceinline__ unsigned arow(const pg8::Unit& u, int r) const { return (unsigned)(u.pm * 256 + r); }
    __device__ __forceinline__ void a_ready(const pg8::Unit& u) const {
        if (threadIdx.x < 64) {
            unsigned polls = 0;
            while ((unsigned)__builtin_amdgcn_readfirstlane(__hip_atomic_load(done + 16 * u.pm, __ATOMIC_RELAXED, __HIP_MEMORY_SCOPE_AGENT)) < 32u) {
                if (++polls > (1u << 22)) { if (threadIdx.x == 0) __hip_atomic_store(tmo, 1u, __ATOMIC_RELAXED, __HIP_MEMORY_SCOPE_AGENT); break; }
                __builtin_amdgcn_s_sleep(2); }
            __builtin_amdgcn_fence(__ATOMIC_ACQUIRE, "agent");
            asm volatile("s_waitcnt vmcnt(0)" ::: "memory");
        }
        asm volatile("" ::: "memory"); __builtin_amdgcn_s_barrier(); asm volatile("" ::: "memory");
    }
};

using pg8::Unit; using pg8::cvt_pk_bf16;
struct EpiStoreBf16 {
    static constexpr bool PERM = true;
    bf16_t* O; int ldc; int nscale; float scale0;
    __device__ __forceinline__ bool operator()(f32x4 (&acc)[2][2][4][2], const Unit& u, int wr, int wc, int fr, int fq) const {
        const int row0 = u.pm * 256 + wr * 64 + fr, col0 = u.pn * 256 + wc * 32 + 8 * fq;
        const float sc = u.pn < nscale ? scale0 : 1.0f;
#pragma unroll
        for (int ai = 0; ai < 2; ++ai)
#pragma unroll
            for (int m = 0; m < 4; ++m) { bf16_t* rowp = O + (size_t)(row0 + ai * 128 + m * 16) * ldc + col0;
#pragma unroll
                for (int bj = 0; bj < 2; ++bj) { const f32x4 v0 = acc[ai][bj][m][0] * sc, v1 = acc[ai][bj][m][1] * sc;
                    u32x4 w; w.x = cvt_pk_bf16(v0[0], v0[1]); w.y = cvt_pk_bf16(v0[2], v0[3]); w.z = cvt_pk_bf16(v1[0], v1[1]); w.w = cvt_pk_bf16(v1[2], v1[3]);
                    *(u32x4*)(rowp + bj * 128) = w; } }
        return false;
    }
};
template <int N> __device__ __forceinline__ float dpp_shr(float x) { return __builtin_bit_cast(float, __builtin_amdgcn_update_dpp(0, __builtin_bit_cast(int, x), 0x110 + N, 0xf, 0xf, true)); }
__device__ __forceinline__ float scan16(float x) { x += dpp_shr<1>(x); x += dpp_shr<2>(x); x += dpp_shr<4>(x); x += dpp_shr<8>(x); return x; }
struct EpiInProj {
    static constexpr bool PERM = true;
    bf16_t* O; bf16_t* KE; float* DEC; const float* lbv; float scale0;
    __device__ __forceinline__ bool operator()(f32x4 (&acc)[2][2][4][2], const Unit& u, int wr, int wc, int fr, int fq) const {
        { const int l_ = lane_now(); fr = l_ & 15; fq = l_ >> 4; }
        const int row0 = u.pm * 256 + wr * 64 + fr, col0 = u.pn * 256 + wc * 32 + 8 * fq;
        if (u.pn >= 6 && u.pn < 10) {
            const int h = u.pn - 6, lane = 16 * fq + fr, kb = wc * 32 + 8 * fq, bsrc = (lane & 48) | 15;
            const int bb = (u.pm * 256) / SEQ, ch0 = ((u.pm * 256) % SEQ + wr * 64) >> 6;
#pragma unroll
            for (int ai = 0; ai < 2; ++ai) {
                unsigned kep[4][4];
#pragma unroll
                for (int n = 0; n < 2; ++n) {
#pragma unroll
                    for (int ep = 0; ep < 2; ++ep) {
                        float ke2[2][4];
#pragma unroll
                        for (int z = 0; z < 2; ++z) {
                            const int e = 2 * ep + z; const float lb = lbv[h * 128 + kb + 4 * n + e];
                            float f[4], c[4], tot[4];
#pragma unroll
                            for (int m = 0; m < 4; ++m) { const float fl = acc[ai][1][m][n][e]; f[m] = lb + (1.0f - lb) * __builtin_amdgcn_rcpf(1.0f + __builtin_amdgcn_exp2f(-1.4426950408889634f * fl)); c[m] = scan16(__logf(f[m])); }
#pragma unroll
                            for (int m = 0; m < 4; ++m) tot[m] = __shfl(c[m], bsrc);
                            const float alast = (tot[0] + tot[1]) + (tot[2] + tot[3]);
                            float pre = 0.f;
#pragma unroll
                            for (int m = 0; m < 4; ++m) { const float A = c[m] + pre; pre += tot[m]; const float q = acc[ai][0][m][n][e]; const float kk = 1.0f - f[m];
                                acc[ai][0][m][n][e] = q * __builtin_amdgcn_rcpf(1.0f + __builtin_amdgcn_exp2f(-1.4426950408889634f * q)) * __expf(A);
                                acc[ai][1][m][n][e] = kk * __expf(-A); ke2[z][m] = kk * __expf(alast - A); }
                            if (fr == 0) DEC[((size_t)(bb * 4 + h) * 64 + ch0 + 2 * ai) * 128 + kb + 4 * n + e] = __expf(alast);
                        }
#pragma unroll
                        for (int m = 0; m < 4; ++m) kep[m][2 * n + ep] = cvt_pk_bf16(ke2[0][m], ke2[1][m]);
                        __builtin_amdgcn_sched_barrier(0);
                    }
                }
#pragma unroll
                for (int m = 0; m < 4; ++m) *(u32x4*)(KE + (size_t)(row0 + ai * 128 + m * 16) * 512 + h * 128 + kb) = (u32x4){kep[m][0], kep[m][1], kep[m][2], kep[m][3]};
            }
        }
        const float sc = u.pn < 2 ? scale0 : 1.0f;
#pragma unroll
        for (int ai = 0; ai < 2; ++ai)
#pragma unroll
            for (int m = 0; m < 4; ++m) { bf16_t* rowp = O + (size_t)(row0 + ai * 128 + m * 16) * INC + col0;
#pragma unroll
                for (int bj = 0; bj < 2; ++bj) { const f32x4 v0 = acc[ai][bj][m][0] * sc, v1 = acc[ai][bj][m][1] * sc;
                    u32x4 w; w.x = cvt_pk_bf16(v0[0], v0[1]); w.y = cvt_pk_bf16(v0[2], v0[3]); w.z = cvt_pk_bf16(v1[0], v1[1]); w.w = cvt_pk_bf16(v1[2], v1[3]);
                    *(u32x4*)(rowp + bj * 128) = w; } }
        return false;
    }
};
struct EpiUp {
    static constexpr bool PERM = true;
    const bf16_t* proj; bf16_t* O;
    __device__ __forceinline__ bool operator()(f32x4 (&acc)[2][2][4][2], const Unit& u, int wr, int wc, int fr, int fq) const {
        const int row0 = u.pm * 256 + wr * 64 + fr, col0 = u.pn * 256 + wc * 32 + 8 * fq;
#pragma unroll
        for (int ai = 0; ai < 2; ++ai)
#pragma unroll
            for (int m = 0; m < 4; ++m) { const size_t row = (size_t)(row0 + ai * 128 + m * 16);
#pragma unroll
                for (int bj = 0; bj < 2; ++bj) {
                    const int col = col0 + bj * 128;
                    const u32x4 gh = *(const u32x4*)(proj + row * INC + C_GHGATE + col);
                    float sh[8];
#pragma unroll
                    for (int j = 0; j < 4; ++j) { sh[2 * j] = 1.0f + __builtin_amdgcn_exp2f(-1.4426950408889634f * bf2f(gh[j] & 0xffffu)); sh[2 * j + 1] = 1.0f + __builtin_amdgcn_exp2f(-1.4426950408889634f * bf2f(gh[j] >> 16)); }
                    if (u.aux == 0) {
                        const u32x4 gd = *(const u32x4*)(proj + row * INC + C_GDA + col);
#pragma unroll
                        for (int j = 0; j < 4; ++j) {
                            const float d0 = 1.0f + __builtin_amdgcn_exp2f(-1.4426950408889634f * bf2f(gd[j] & 0xffffu)), d1 = 1.0f + __builtin_amdgcn_exp2f(-1.4426950408889634f * bf2f(gd[j] >> 16));
                            const float r0 = sh[2 * j] * __builtin_amdgcn_rcpf(d0), r1 = sh[2 * j + 1] * __builtin_amdgcn_rcpf(d1);
                            if (j < 2) { acc[ai][bj][m][0][2 * j] *= r0; acc[ai][bj][m][0][2 * j + 1] *= r1; }
                            else { acc[ai][bj][m][1][2 * j - 4] *= r0; acc[ai][bj][m][1][2 * j - 3] *= r1; }
                        }
                    } else {
                        const f32x4 v0 = acc[ai][bj][m][0], v1 = acc[ai][bj][m][1];
#pragma unroll
                        for (int j = 0; j < 8; ++j) sh[j] = __builtin_amdgcn_rcpf(sh[j]);
                        u32x4 w; w.x = cvt_pk_bf16(v0[0] * sh[0], v0[1] * sh[1]); w.y = cvt_pk_bf16(v0[2] * sh[2], v0[3] * sh[3]);
                        w.z = cvt_pk_bf16(v1[0] * sh[4], v1[1] * sh[5]); w.w = cvt_pk_bf16(v1[2] * sh[6], v1[3] * sh[7]);
                        *(u32x4*)(O + row * D + col) = w;
                    }
                } }
        return u.aux == 0;
    }
};
struct EpiOut {
    static constexpr bool PERM = false;
    const float* x; const float* mod; float* O;
    __device__ __forceinline__ bool operator()(f32x4 (&acc)[2][2][4][2], const Unit& u, int wr, int wc, int fr, int fq) const {
        const int row0 = u.pm * 256 + wr * 64 + fr, col0 = u.pn * 256 + wc * 32 + 4 * fq;
        const int b = (u.pm * 256) / SEQ;
        f32x4 gt[2][2];
#pragma unroll
        for (int bj = 0; bj < 2; ++bj)
#pragma unroll
            for (int n = 0; n < 2; ++n) gt[bj][n] = *(const f32x4*)(mod + b * 6144 + 2048 + col0 + bj * 128 + n * 16);
#pragma unroll
        for (int ai = 0; ai < 2; ++ai)
#pragma unroll
            for (int m = 0; m < 4; ++m) { const size_t off = (size_t)(row0 + ai * 128 + m * 16) * D + col0;
#pragma unroll
                for (int bj = 0; bj < 2; ++bj)
#pragma unroll
                    for (int n = 0; n < 2; ++n) { const f32x4 xv = *(const f32x4*)(x + off + bj * 128 + n * 16);
                        *(f32x4*)(O + off + bj * 128 + n * 16) = xv + gt[bj][n] * acc[ai][bj][m][n]; } }
        return false;
    }
};
struct EpiMoe1 {
    static constexpr bool PERM = true;
    bf16_t* O; unsigned* done;
    __device__ __forceinline__ bool operator()(f32x4 (&acc)[2][2][4][2], const Unit& u, int wr, int wc, int fr, int fq) const {
        const int row0 = u.pm * 256 + wr * 64 + fr, col0 = u.pn * 128 + wc * 32 + 8 * fq;
#pragma unroll
        for (int ai = 0; ai < 2; ++ai)
#pragma unroll
            for (int m = 0; m < 4; ++m) { bf16_t* rowp = O + (size_t)(row0 + ai * 128 + m * 16) * DEXP + col0;
                float h[8];
#pragma unroll
                for (int n = 0; n < 2; ++n)
#pragma unroll
                    for (int e = 0; e < 4; ++e) { const float x_ = acc[ai][0][m][n][e]; h[n * 4 + e] = x_ * __builtin_amdgcn_rcpf(1.0f + __builtin_amdgcn_exp2f(-1.4426950408889634f * x_)) * acc[ai][1][m][n][e]; }
                u32x4 w; w.x = cvt_pk_bf16(h[0], h[1]); w.y = cvt_pk_bf16(h[2], h[3]); w.z = cvt_pk_bf16(h[4], h[5]); w.w = cvt_pk_bf16(h[6], h[7]);
                asm volatile("global_store_dwordx4 %0, %1, off sc1\n\ts_nop 1" :: "v"(rowp), "v"(w) : "memory"); }
        asm volatile("s_waitcnt vmcnt(0)" ::: "memory");
        if ((threadIdx.x & 63) == 0) __hip_atomic_fetch_add(done + 16 * u.pm, 1u, __ATOMIC_RELAXED, __HIP_MEMORY_SCOPE_AGENT);
        return false;
    }
};

struct Frame { LAS unsigned char* lds; int tid, lane, wave, G, bid; };

__device__ __forceinline__ void transpose_item(const float* Wsrc, int ldw, bf16_t* dst, int ldd, LAS float* scr, int lane) {
#pragma unroll 8
    for (int i = 0; i < 32; ++i) { const int kk = 2 * i + (lane >> 5); scr[kk * 33 + (lane & 31)] = __builtin_nontemporal_load(Wsrc + (size_t)kk * ldw + (lane & 31)); }
    asm volatile("s_waitcnt lgkmcnt(0)" ::: "memory");
    const int c = lane & 7;
#pragma unroll
    for (int j = 0; j < 4; ++j) { const int n = (lane >> 3) + 8 * j; const LAS float* s = scr + (8 * c) * 33 + n;
        u32x4 o; o.x = pk2(s[0 * 33], s[1 * 33]); o.y = pk2(s[2 * 33], s[3 * 33]); o.z = pk2(s[4 * 33], s[5 * 33]); o.w = pk2(s[6 * 33], s[7 * 33]);
        *(u32x4*)(dst + (size_t)n * ldd + 8 * c) = o; }
    asm volatile("s_waitcnt lgkmcnt(0)" ::: "memory");
}
__device__ __forceinline__ void transpose_matrix(const Frame& F, const float* W, int K, int N, bf16_t* WT) {
    LAS float* scr = (LAS float*)(F.lds + F.wave * 8448);
    const int gw = F.bid * NWAVES + F.wave, NGW = F.G * NWAVES, nblk = N / 32, items = (K / 64) * nblk;
    for (int it = gw; it < items; it += NGW) { const int kb = it / nblk, nb = it % nblk;
        transpose_item(W + (size_t)(64 * kb) * N + 32 * nb, N, WT + (size_t)(32 * nb) * K + 64 * kb, K, scr, F.lane); }
}

__device__ __forceinline__ void phase0(const Frame& F, const Args& a) {
    unsigned char* ws = a.ws;
    {
        float* modp = (float*)(ws + WS_MODP);
        const float* c = a.in[I_C]; const float* wada = a.in[I_WADA];
        LAS float* cs = (LAS float*)(F.lds + 72 * 1024);
        for (int i = F.tid; i < 4 * D; i += NTHR) cs[i] = siluf_(c[i]);
        __syncthreads();
        for (int wt = F.bid + 256 * F.wave; wt < 384; wt += 256 * NWAVES) {
            if (F.G != 256) break;
            const int ks = wt / 24, jw = wt % 24, j = jw * 256 + F.lane * 4;
            f32x4 s[4] = {{0, 0, 0, 0}, {0, 0, 0, 0}, {0, 0, 0, 0}, {0, 0, 0, 0}};
#pragma unroll 8
            for (int k = ks * 64; k < ks * 64 + 64; ++k) {
                const f32x4 w = *(const f32x4*)(wada + (size_t)k * 6144 + j);
#pragma unroll
                for (int b = 0; b < 4; ++b) s[b] += w * cs[b * D + k];
            }
#pragma unroll
            for (int b = 0; b < 4; ++b) *(f32x4*)(modp + ((size_t)ks * 4 + b) * 6144 + j) = s[b];
        }
        if (F.G != 256) {
            const int gw = F.bid * NWAVES + F.wave, NGW = F.G * NWAVES;
            for (int wt = gw; wt < 384; wt += NGW) {
                const int ks = wt / 24, jw = wt % 24, j = jw * 256 + F.lane * 4;
                f32x4 s[4] = {{0, 0, 0, 0}, {0, 0, 0, 0}, {0, 0, 0, 0}, {0, 0, 0, 0}};
                for (int k = ks * 64; k < ks * 64 + 64; ++k) {
                    const f32x4 w = *(const f32x4*)(wada + (size_t)k * 6144 + j);
#pragma unroll
                    for (int b = 0; b < 4; ++b) { const float cv = siluf_(c[b * D + k]); s[b] += w * cv; }
                }
#pragma unroll
                for (int b = 0; b < 4; ++b) *(f32x4*)(modp + ((size_t)ks * 4 + b) * 6144 + j) = s[b];
            }
        }
    }
    if (F.bid == 0) {
        float* sm = (float*)(ws + WS_SMALL);
        if (F.tid == 0) {
            float s1 = 0.f, s2 = 0.f;
            for (int i = 0; i < 64; ++i) { s1 += a.in[I_LQ1][i] * a.in[I_LK1][i]; s2 += a.in[I_LQ2][i] * a.in[I_LK2][i]; }
            sm[0] = expf(s1) - expf(s2) + 0.2f;
        }
        { const float l0 = a.in[I_LBL][F.tid], l1 = a.in[I_LBL][512 + F.tid]; const float mx = fmaxf(l0, l1);
          const float e0 = expf(l0 - mx), e1 = expf(l1 - mx); sm[16 + F.tid] = e0 / (e0 + e1); }
    }
}
__device__ __forceinline__ void moe_weight_convert(const Frame& F, const Args& a) {
    LAS float* scr = (LAS float*)(F.lds + F.wave * 8448);
    const int gw = F.bid * NWAVES + F.wave, NGW = F.G * NWAVES;
    bf16_t* w13 = (bf16_t*)(a.ws + WS_W13); bf16_t* w2t = (bf16_t*)(a.ws + WS_W2);
    for (int it = gw; it < 2 * NEXP * 256; it += NGW) {
        const int which = it / (NEXP * 256), r = it % (NEXP * 256), e = r >> 8, kb = (r >> 4) & 15, nb = r & 15, n0 = 32 * nb;
        const float* W = a.in[which ? I_W3 : I_W1] + (size_t)e * 1024 * 512;
        const int drow = 256 * (n0 >> 7) + (which ? 128 : 0) + (n0 & 127);
        transpose_item(W + (size_t)(64 * kb) * 512 + n0, 512, w13 + ((size_t)e * 1024 + drow) * 1024 + 64 * kb, 1024, scr, F.lane);
    }
    for (int it = gw; it < NEXP * 256; it += NGW) {
        const int e = it >> 8, kb = (it >> 5) & 7, nb = it & 31;
        const float* W = a.in[I_W2] + (size_t)e * 512 * 1024;
        transpose_item(W + (size_t)(64 * kb) * 1024 + 32 * nb, 1024, w2t + ((size_t)e * 1024 + 32 * nb) * 512 + 64 * kb, 512, scr, F.lane);
    }
}

__device__ __forceinline__ void dense_weight_convert(const Frame& F, const Args& a) {
    unsigned char* ws = a.ws;
    {
        LAS float* scr = (LAS float*)(F.lds + F.wave * 8448);
        const int gw = F.bid * NWAVES + F.wave, NGW = F.G * NWAVES, nblk = INC / 32, items = (D / 64) * nblk;
        bf16_t* WT = (bf16_t*)(ws + WS_WIN);
        for (int it = gw; it < items; it += NGW) { const int kb = it / nblk, n0 = 32 * (it % nblk); int dr = n0;
            if (n0 >= C_QHG && n0 < C_FHG) dr = C_HGT + 256 * ((n0 - C_QHG) >> 7) + ((n0 - C_QHG) & 127);
            else if (n0 >= C_FHG && n0 < C_IHG) dr = C_HGT + 256 * ((n0 - C_FHG) >> 7) + 128 + ((n0 - C_FHG) & 127);
            transpose_item(a.in[I_WIN] + (size_t)(64 * kb) * INC + n0, INC, WT + (size_t)dr * D + 64 * kb, D, scr, F.lane); }
    }
    transpose_matrix(F, a.in[I_WUPDA], 512, D, (bf16_t*)(ws + WS_WUPDA));
    transpose_matrix(F, a.in[I_WUPHG], 512, D, (bf16_t*)(ws + WS_WUPHG));
    transpose_matrix(F, a.in[I_WOUT], D, D, (bf16_t*)(ws + WS_WOUT));
}
__device__ __forceinline__ void phase1(const Frame& F, const Args& a) {
    const float* modp = (const float*)(a.ws + WS_MODP); float* mod = (float*)(a.ws + WS_MOD);
    for (int i = F.bid * NTHR + F.tid; i < 4 * 6144; i += F.G * NTHR) {
        float s = a.in[I_BADA][i % 6144];
        for (int ks = 0; ks < 16; ++ks) s += modp[(size_t)ks * 4 * 6144 + i];
        mod[i] = s;
    }
    LAS float* Gs = (LAS float*)F.lds;
    LAS float* Ss = Gs + 1024;
    bf16_t* H = (bf16_t*)(a.ws + WS_ACT);
    const int rows_per_blk = T / F.G;
    const int r0 = F.bid * rows_per_blk, b = r0 / SEQ;
    for (int k = F.tid; k < 1024; k += NTHR) {
        float sh = a.in[I_BADA][k], sc = a.in[I_BADA][1024 + k];
        for (int ks = 0; ks < 16; ++ks) { sh += modp[((size_t)ks * 4 + b) * 6144 + k]; sc += modp[((size_t)ks * 4 + b) * 6144 + 1024 + k]; }
        Gs[k] = a.in[I_N1G][k] * (1.0f + sc); Ss[k] = sh;
    }
    __syncthreads();
    for (int r = r0 + F.wave; r < r0 + rows_per_blk; r += NWAVES) {
        const f32x4* xr = (const f32x4*)(a.in[I_X] + (size_t)r * D) + F.lane;
        f32x4 v[4]; float s = 0.f;
#pragma unroll
        for (int j = 0; j < 4; ++j) { v[j] = xr[64 * j]; s += (v[j].x * v[j].x + v[j].y * v[j].y) + (v[j].z * v[j].z + v[j].w * v[j].w); }
        const float rs = rsqrtf(wave_sum(s) * (1.0f / D) + EPS);
        unsigned long long* o8 = (unsigned long long*)(H + (size_t)r * D) + F.lane;
#pragma unroll
        for (int j = 0; j < 4; ++j) { const f32x4 g = *(const LAS f32x4*)(Gs + 256 * j + 4 * F.lane), sh = *(const LAS f32x4*)(Ss + 256 * j + 4 * F.lane);
            const f32x4 h = v[j] * rs * g + sh;
            o8[64 * j] = (unsigned long long)pk2(h.x, h.y) | ((unsigned long long)pk2(h.z, h.w) << 32); }
    }
}

namespace attn_body {
using s16x4=__attribute__((ext_vector_type(4)))short;
using f32x16=__attribute__((ext_vector_type(16)))float;
constexpr int NW=8,QBLK=32,QB=QBLK*NW,KVBLK=64,NQB=SEQ/QB;
constexpr int PIN=INC, POUT=1024;
__device__ __forceinline__ int crow(int r,int hi){return (r&3)+8*(r>>2)+4*hi;}
#define SBAR() __builtin_amdgcn_sched_barrier(0)
__device__ __forceinline__ void bmask(f32x16&p0,f32x16&p1,int jb,int wch,int il,int hi,float s2x2){
  if(jb>wch){
    #pragma unroll
    for(int r=0;r<16;++r){p0[r]=-INFINITY;p1[r]=-INFINITY;}
  } else if(jb==wch){
    float fb=(float)(4*hi-il); asm volatile("":"+v"(fb));
    #pragma unroll
    for(int r=0;r<16;++r){const float c=(float)((r&3)+8*(r>>2)); p0[r]-=s2x2*__builtin_fmaxf(fb+c,0.f); p1[r]-=s2x2*__builtin_fmaxf(fb+(c+32.f),0.f);}
  }
}
constexpr int NSLOT=3, SLOTB=8192, VSLOTB=16384;
constexpr int LDS_K=0, LDS_V=NSLOT*SLOTB, LDS_WS=LDS_V+NSLOT*VSLOTB, LDS_OST=LDS_WS+NW*64*4, ATT_LDS_BYTES=LDS_OST+NW*8192;
constexpr float C2=0.125f*1.4426950408889634f;
__device__ __forceinline__ void glds16(const void*gsrc,unsigned lds_dst){unsigned keep;
  asm volatile("s_mov_b32 %0, m0\n\ts_mov_b32 m0, %2\n\ts_nop 0\n\tglobal_load_lds_dwordx4 %1, off\n\ts_mov_b32 m0, %0":"=&s"(keep):"v"(gsrc),"s"(lds_dst):"memory");}
__device__ __forceinline__ float max3f(float a,float b,float c){float r;asm("v_max3_f32 %0, %1, %2, %3":"=v"(r):"v"(a),"v"(b),"v"(c));return r;}
__device__ __forceinline__ float max2f(float a,float b){float r;asm("v_max_f32_e32 %0, %1, %2":"=v"(r):"v"(a),"v"(b));return r;}
__device__ __forceinline__ float fadd_s(float a,float b){float r;asm("v_add_f32_e32 %0, %1, %2":"=v"(r):"v"(a),"v"(b));return r;}
__device__ __forceinline__ float fsub_s(float a,float b){float r;asm("v_sub_f32_e32 %0, %1, %2":"=v"(r):"v"(a),"v"(b));return r;}
typedef float f32x2_t __attribute__((ext_vector_type(2))); typedef __bf16 bf16x2_t __attribute__((ext_vector_type(2)));
__device__ __forceinline__ unsigned cvtpk_s(float lo,float hi){f32x2_t v={lo,hi};bf16x2_t b=__builtin_convertvector(v,bf16x2_t);return __builtin_bit_cast(unsigned,b);}
#define WAIT_BAR(N) asm volatile("s_waitcnt vmcnt(" #N ") lgkmcnt(0)\n\ts_barrier":::"memory")

__device__ __forceinline__ void qkt(f32x16&p0,f32x16&p1,const char*Kslot,const bf16x8*qr,const f32x16&c0,const f32x16&c1,int r32,int hi){
  const char*kb=Kslot+hi*1024+r32*16;
  #pragma unroll
  for(int d0=0;d0<4;++d0){
    const bf16x8 b0=*reinterpret_cast<const bf16x8*>(kb+d0*2048);
    const bf16x8 b1=*reinterpret_cast<const bf16x8*>(kb+d0*2048+512);
    if(d0==0){p0=__builtin_amdgcn_mfma_f32_32x32x16_bf16(b0,qr[0],c0,0,0,0);p1=__builtin_amdgcn_mfma_f32_32x32x16_bf16(b1,qr[0],c1,0,0,0);}
    else{p0=__builtin_amdgcn_mfma_f32_32x32x16_bf16(b0,qr[d0],p0,0,0,0);p1=__builtin_amdgcn_mfma_f32_32x32x16_bf16(b1,qr[d0],p1,0,0,0);}}
}
typedef __attribute__((address_space(3))) const char* lds_cptr;
typedef short v4i16_t __attribute__((ext_vector_type(4)));
__device__ __forceinline__ void kload8(bf16x8*kf,lds_cptr kp){
  kf[0]=*(const __attribute__((address_space(3))) bf16x8*)(kp);      kf[1]=*(const __attribute__((address_space(3))) bf16x8*)(kp+512);
  kf[2]=*(const __attribute__((address_space(3))) bf16x8*)(kp+2048); kf[3]=*(const __attribute__((address_space(3))) bf16x8*)(kp+2560);
  kf[4]=*(const __attribute__((address_space(3))) bf16x8*)(kp+4096); kf[5]=*(const __attribute__((address_space(3))) bf16x8*)(kp+4608);
  kf[6]=*(const __attribute__((address_space(3))) bf16x8*)(kp+6144); kf[7]=*(const __attribute__((address_space(3))) bf16x8*)(kp+6656);
}
__device__ __forceinline__ void kload2(bf16x8*kf,lds_cptr kp,int j){ kf[2*j]=*(const __attribute__((address_space(3))) bf16x8*)(kp+j*2048); kf[2*j+1]=*(const __attribute__((address_space(3))) bf16x8*)(kp+j*2048+512); }
__device__ __forceinline__ s16x4 vtr(lds_cptr p){ return __builtin_bit_cast(s16x4,__builtin_amdgcn_ds_read_tr16_b64_v4i16((__attribute__((address_space(3))) v4i16_t*)p)); }
__device__ __forceinline__ float rowmax(const f32x16&p0,const f32x16&p1){
  float a=max3f(p0[0],p0[1],p1[0]),b=max3f(p0[2],p0[3],p1[1]);a=max3f(a,p1[2],p1[3]);
  #pragma unroll
  for(int r=4;r<16;r+=4){a=max3f(a,p0[r],p0[r+1]);b=max3f(b,p0[r+2],p0[r+3]);a=max3f(a,p1[r],p1[r+1]);b=max3f(b,p1[r+2],p1[r+3]);}
  const float m=max2f(a,b);
  auto rr=__builtin_amdgcn_permlane32_swap(__float_as_uint(m),__float_as_uint(m),false,false);
  return max2f(__uint_as_float(rr[0]),__uint_as_float(rr[1]));
}
__device__ __forceinline__ void pv(f32x16*o,int vb,bf16x8 pa0,bf16x8 pa1,bf16x8 pa2,bf16x8 pa3){
  #pragma unroll
  for(int d0=0;d0<4;++d0){s16x4 lo[4],hi[4];
    #pragma unroll
    for(int ks=0;ks<4;++ks){
      asm volatile("ds_read_b64_tr_b16 %0,%1 offset:%c2":"=&v"(lo[ks]):"v"(vb),"i"(d0*4096+ks*1024):"memory");
      asm volatile("ds_read_b64_tr_b16 %0,%1 offset:%c2":"=&v"(hi[ks]):"v"(vb),"i"(d0*4096+ks*1024+512):"memory");}
    asm volatile("s_waitcnt lgkmcnt(0)":::"memory");SBAR();
    #define PK(k) (bf16x8){lo[k][0],lo[k][1],lo[k][2],lo[k][3],hi[k][0],hi[k][1],hi[k][2],hi[k][3]}
    o[d0]=__builtin_amdgcn_mfma_f32_32x32x16_bf16(pa0,PK(0),o[d0],0,0,0);
    o[d0]=__builtin_amdgcn_mfma_f32_32x32x16_bf16(pa1,PK(1),o[d0],0,0,0);
    o[d0]=__builtin_amdgcn_mfma_f32_32x32x16_bf16(pa2,PK(2),o[d0],0,0,0);
    o[d0]=__builtin_amdgcn_mfma_f32_32x32x16_bf16(pa3,PK(3),o[d0],0,0,0);
    #undef PK
  }
}
#define ATTN_STORE16(p,v) (*(u32x4*)(p)=(v))
template<int THRL> __device__ __forceinline__ void attn_unit(int qb,const bf16_t*Qb,const bf16_t*__restrict__ Kh,const bf16_t*__restrict__ Vh,bf16_t*Ob,float slope2,char*shm){
  const int wid=__builtin_amdgcn_readfirstlane(threadIdx.x>>6); const int lane=lane_now(),r32=lane&31,hi=lane>>5;
  const int q0=qb*QB;
  const bf16_t*Qw=Qb+(long)(q0+wid*QBLK)*PIN;
  const unsigned lds0=(unsigned)(uintptr_t)shm;
  float*wsf=(float*)(shm+LDS_WS)+wid*64;
  const bf16_t*ksrc=Kh+(long)lane*PIN+wid*8;
  const bf16_t*vsrc=Vh+(long)(16*(wid&3)+(lane>>2))*PIN+(wid>>2)*32+(lane&3)*8;
  const unsigned kdst=lds0+LDS_K+wid*1024, vdst=lds0+LDS_V+(wid>>2)*4096+(wid&3)*1024;
  #define DMA_K(t,slot) glds16(ksrc+(long)(t)*KVBLK*PIN,(unsigned)__builtin_amdgcn_readfirstlane(kdst+(slot)))
  #define DMA_V(t,slot) do{ glds16(vsrc+(long)(t)*KVBLK*PIN,(unsigned)__builtin_amdgcn_readfirstlane(vdst+2*(slot))); glds16(vsrc+(long)(t)*KVBLK*PIN+64,(unsigned)__builtin_amdgcn_readfirstlane(vdst+2*(slot)+8192)); }while(0)
  const int vb0=(int)(lds0+LDS_V)+((lane>>4)&1)*32+(lane&3)*8+(4*hi+((lane&15)>>2))*64;
  const char*Kbase=shm+LDS_K; bf16x8 kf[8];
  const lds_cptr shm3=(lds_cptr)shm; const lds_cptr kp0=shm3+LDS_K+hi*1024+r32*16; const lds_cptr vp0=shm3+LDS_V+((lane>>4)&1)*32+(lane&3)*8+(4*hi+((lane&15)>>2))*64;
  const int NT=(q0+QB)/KVBLK;
  DMA_K(0,0);DMA_V(0,0);DMA_K(1,SLOTB);
  bf16x8 qr[4];
  #pragma unroll
  for(int d0=0;d0<4;++d0)qr[d0]=*reinterpret_cast<const bf16x8*>(&Qw[(long)r32*PIN+d0*16+hi*8]);
  float mhat=0.f,l_reg=0.f;f32x16 o[4];o[0]=f32x16{};o[1]=f32x16{};o[2]=f32x16{};o[3]=f32x16{};
  const float s64=slope2*64.f, s32=slope2*32.f, s2x2=2.f*slope2, s4hi=slope2*4.f*(float)hi;
  const int wch=wid>>1, il=32*(wid&1)+r32;
  #define CMASK(P0,P1,t) do{int jb_=(t)-(NT-4); if(jb_>=0)bmask(P0,P1,jb_,wch,il,hi,s2x2);}while(0)
  #define CINIT0(C0,t) do{ const float bt_=s64*(float)((t)-NT)-mhat+s4hi; _Pragma("unroll") for(int r=0;r<16;++r){C0[r]=__builtin_fmaf(slope2,(float)((r&3)+8*(r>>2)),bt_);} }while(0)
  #define CINIT1(C1,t) do{ const float bu_=s64*(float)((t)-NT)-mhat+s4hi+s32; _Pragma("unroll") for(int r=0;r<16;++r){C1[r]=__builtin_fmaf(slope2,(float)((r&3)+8*(r>>2)),bu_);} }while(0)
  bool resc=false;
  #define START(P0,P1) do{ const float rm=rowmax(P0,P1); resc=false; \
    { const float dl=rm; mhat=fadd_s(mhat,dl); \
      _Pragma("unroll") for(int r=0;r<16;++r){P0[r]=fsub_s(P0[r],dl);P1[r]=fsub_s(P1[r],dl);} } \
    _Pragma("unroll") for(int r=0;r<16;++r)P0[r]=__builtin_amdgcn_exp2f(P0[r]); }while(0)
  #define RESC() do{ if(resc){ asm volatile("s_waitcnt lgkmcnt(0)":::"memory"); \
      _Pragma("unroll") for(int d_=0;d_<4;++d_) _Pragma("unroll") for(int r=0;r<16;++r)o[d_][r]*=wsf[crow(r,hi)]; } }while(0)
  f32x16 cS0,cS1;
  u32x4 pwa0,pwa1,pwa2,pwa3,pwb0,pwb1,pwb2,pwb3;
  int sl_prev=0,sl_cur=0,sl_next=SLOTB;
  #define ROT() do{sl_prev=sl_cur;sl_cur=sl_next;sl_next=(sl_next==(NSLOT-1)*SLOTB)?0:sl_next+SLOTB;}while(0)
  #define PKW(P,B) cvtpk_s(P[B],P[B+1])
  DMA_K(2,2*SLOTB);
  WAIT_BAR(3);
  { f32x16 c0,c1; CINIT0(c0,0); CINIT1(c1,0); qkt(cS0,cS1,Kbase,qr,c0,c1,r32,hi); }
  asm volatile("s_nop 15\n\ts_nop 7":"+v"(cS0),"+v"(cS1));CMASK(cS0,cS1,0);
  START(cS0,cS1);
  _Pragma("unroll") for(int r=0;r<16;++r)cS1[r]=__builtin_amdgcn_exp2f(cS1[r]);
  { float sacc=cS0[0]+cS0[1]; _Pragma("unroll") for(int r=2;r<16;++r)sacc+=cS0[r]; _Pragma("unroll") for(int r=0;r<16;++r)sacc+=cS1[r]; l_reg+=sacc;
    pwa0=(u32x4){PKW(cS0,0),PKW(cS0,2),PKW(cS0,4),PKW(cS0,6)};pwa1=(u32x4){PKW(cS0,8),PKW(cS0,10),PKW(cS0,12),PKW(cS0,14)};pwa2=(u32x4){PKW(cS1,0),PKW(cS1,2),PKW(cS1,4),PKW(cS1,6)};pwa3=(u32x4){PKW(cS1,8),PKW(cS1,10),PKW(cS1,12),PKW(cS1,14)}; }
  WAIT_BAR(0);
  DMA_K(3,0);DMA_V(1,SLOTB);
  ROT();
  kload8(kf,kp0+sl_cur);
  WAIT_BAR(3);
  s16x4 vlo[4],vhi[4];
  #define CAT_(a,b) a##b
  #define CAT(a,b) CAT_(a,b)
  #define PAFC(P,k) __builtin_bit_cast(bf16x8,CAT(P,k))
  #define VFR(k) (bf16x8){vlo[(k)&3][0],vlo[(k)&3][1],vlo[(k)&3][2],vlo[(k)&3][3],vhi[(k)&3][0],vhi[(k)&3][1],vhi[(k)&3][2],vhi[(k)&3][3]}
  #define VOFF(k) ((k)<8 ? (((k)&1)*4096+((k)>>1)*1024) : ((2+((k)&1))*4096+(((k)-8)>>1)*1024))
  #define PIN_(x) asm volatile("":"+v"(x))
  #define MX3(a,b,c) __builtin_fmaxf(__builtin_fmaxf((a),(b)),(c))
  #define QK(MF) do{ MF; SBAR(); }while(0)
  #define EX(v) __builtin_amdgcn_exp2f(v)
  #define VRD(k) do{ vlo[(k)&3]=vtr(vp_+VOFF(k)); vhi[(k)&3]=vtr(vp_+(VOFF(k)+512)); }while(0)
  #define VNX(k) do{ if((k)+4<16){ VRD((k)+4); } SBAR(); }while(0)
  #define GAPB3(MF,X,B,PW,J) do{ MF; X[B]=EX(X[B]); X[B+1]=EX(X[B+1]); sacc+=X[B]; sacc+=X[B+1]; PW[J]=cvtpk_s(X[B],X[B+1]); PIN_(X); PIN_(sacc); PIN_(PW); SBAR(); }while(0)
  #define KRD(G,j) do{ if(G){ kload2(kf,kp0+sl_next,j); SBAR(); } }while(0)
  #define STEP(PC,PN,t,GK,GV,GL) do{ SBAR(); \
    CINIT0(cS0,t); SBAR(); \
    const lds_cptr vp_=vp0+2*sl_prev; \
    VRD(0); SBAR(); QK(cS0=__builtin_amdgcn_mfma_f32_32x32x16_bf16(kf[0],qr[0],cS0,0,0,0)); \
    CINIT1(cS1,t); VRD(1); SBAR(); QK(cS1=__builtin_amdgcn_mfma_f32_32x32x16_bf16(kf[1],qr[0],cS1,0,0,0)); \
    VRD(2); SBAR(); QK(cS0=__builtin_amdgcn_mfma_f32_32x32x16_bf16(kf[2],qr[1],cS0,0,0,0)); \
    VRD(3); SBAR(); QK(cS1=__builtin_amdgcn_mfma_f32_32x32x16_bf16(kf[3],qr[1],cS1,0,0,0)); \
    QK(cS0=__builtin_amdgcn_mfma_f32_32x32x16_bf16(kf[4],qr[2],cS0,0,0,0)); \
    QK(cS1=__builtin_amdgcn_mfma_f32_32x32x16_bf16(kf[5],qr[2],cS1,0,0,0)); \
    QK(cS0=__builtin_amdgcn_mfma_f32_32x32x16_bf16(kf[6],qr[3],cS0,0,0,0)); \
    QK(cS1=__builtin_amdgcn_mfma_f32_32x32x16_bf16(kf[7],qr[3],cS1,0,0,0)); \
    if(GK){DMA_K((t)+3,sl_cur);} if(GV){DMA_V((t)+1,sl_next);} \
    CMASK(cS0,cS1,t); \
    { float a=MX3(cS0[0],cS0[1],cS1[0]),b=MX3(cS0[2],cS0[3],cS1[1]); a=MX3(a,cS1[2],cS1[3]); \
      _Pragma("unroll") for(int r=4;r<16;r+=4){a=MX3(a,cS0[r],cS0[r+1]);b=MX3(b,cS0[r+2],cS0[r+3]);a=MX3(a,cS1[r],cS1[r+1]);b=MX3(b,cS1[r+2],cS1[r+3]);} \
      float rm=__builtin_fmaxf(a,b); { auto rr=__builtin_amdgcn_permlane32_swap(__float_as_uint(rm),__float_as_uint(rm),false,false); rm=__builtin_fmaxf(__uint_as_float(rr[0]),__uint_as_float(rr[1])); } \
      resc=false; \
      if(__builtin_expect(__any(rm>(float)THRL),0)){ const float dl=__builtin_fmaxf(rm,0.f); mhat+=dl; \
        _Pragma("unroll") for(int r=0;r<16;++r){cS0[r]-=dl;cS1[r]-=dl;} \
        const float f=__builtin_amdgcn_exp2f(-dl); l_reg*=f; if(hi==0)wsf[r32]=f; resc=true; } } \
    SBAR(); float sacc=0.f; \
    GAPB3(o[0]=__builtin_amdgcn_mfma_f32_32x32x16_bf16(PAFC(PC,0),VFR(0),o[0],0,0,0), cS0,0, CAT(PN,0),0); VNX(0); \
    GAPB3(o[1]=__builtin_amdgcn_mfma_f32_32x32x16_bf16(PAFC(PC,0),VFR(1),o[1],0,0,0), cS0,2, CAT(PN,0),1); VNX(1); \
    KRD(GL,0); GAPB3(o[0]=__builtin_amdgcn_mfma_f32_32x32x16_bf16(PAFC(PC,1),VFR(2),o[0],0,0,0), cS0,4, CAT(PN,0),2); VNX(2); \
    KRD(GL,1); GAPB3(o[1]=__builtin_amdgcn_mfma_f32_32x32x16_bf16(PAFC(PC,1),VFR(3),o[1],0,0,0), cS0,6, CAT(PN,0),3); VNX(3); \
    KRD(GL,2); GAPB3(o[0]=__builtin_amdgcn_mfma_f32_32x32x16_bf16(PAFC(PC,2),VFR(4),o[0],0,0,0), cS0,8, CAT(PN,1),0); VNX(4); \
    KRD(GL,3); GAPB3(o[1]=__builtin_amdgcn_mfma_f32_32x32x16_bf16(PAFC(PC,2),VFR(5),o[1],0,0,0), cS0,10, CAT(PN,1),1); VNX(5); \
    GAPB3(o[0]=__builtin_amdgcn_mfma_f32_32x32x16_bf16(PAFC(PC,3),VFR(6),o[0],0,0,0), cS0,12, CAT(PN,1),2); VNX(6); \
    GAPB3(o[1]=__builtin_amdgcn_mfma_f32_32x32x16_bf16(PAFC(PC,3),VFR(7),o[1],0,0,0), cS0,14, CAT(PN,1),3); VNX(7); \
    GAPB3(o[2]=__builtin_amdgcn_mfma_f32_32x32x16_bf16(PAFC(PC,0),VFR(8),o[2],0,0,0), cS1,0, CAT(PN,2),0); VNX(8); \
    GAPB3(o[3]=__builtin_amdgcn_mfma_f32_32x32x16_bf16(PAFC(PC,0),VFR(9),o[3],0,0,0), cS1,2, CAT(PN,2),1); VNX(9); \
    GAPB3(o[2]=__builtin_amdgcn_mfma_f32_32x32x16_bf16(PAFC(PC,1),VFR(10),o[2],0,0,0), cS1,4, CAT(PN,2),2); VNX(10); \
    GAPB3(o[3]=__builtin_amdgcn_mfma_f32_32x32x16_bf16(PAFC(PC,1),VFR(11),o[3],0,0,0), cS1,6, CAT(PN,2),3); VNX(11); \
    GAPB3(o[2]=__builtin_amdgcn_mfma_f32_32x32x16_bf16(PAFC(PC,2),VFR(12),o[2],0,0,0), cS1,8, CAT(PN,3),0); VNX(12); \
    GAPB3(o[3]=__builtin_amdgcn_mfma_f32_32x32x16_bf16(PAFC(PC,2),VFR(13),o[3],0,0,0), cS1,10, CAT(PN,3),1); VNX(13); \
    GAPB3(o[2]=__builtin_amdgcn_mfma_f32_32x32x16_bf16(PAFC(PC,3),VFR(14),o[2],0,0,0), cS1,12, CAT(PN,3),2); VNX(14); \
    GAPB3(o[3]=__builtin_amdgcn_mfma_f32_32x32x16_bf16(PAFC(PC,3),VFR(15),o[3],0,0,0), cS1,14, CAT(PN,3),3); VNX(15); \
    l_reg+=sacc; \
    }while(0)
  int t=1;
  #undef CMASK
  #define CMASK(P0,P1,t) do{}while(0)
  for(;t+5<NT;t+=2){
    STEP(pwa,pwb,t,true,true,true);     WAIT_BAR(3); RESC(); ROT();
    STEP(pwb,pwa,t+1,true,true,true);   WAIT_BAR(3); RESC(); ROT();
  }
  #undef CMASK
  #define CMASK(P0,P1,t) do{int jb_=(t)-(NT-4); if(jb_>=0)bmask(P0,P1,jb_,wch,il,hi,s2x2);}while(0)
  #define ENDW(tt) do{ if((tt)+3<NT){WAIT_BAR(3);} else if((tt)+2<NT){WAIT_BAR(2);} else {WAIT_BAR(0);} }while(0)
  for(;t+1<NT;t+=2){
    STEP(pwa,pwb,t,(t+3<NT),(t+1<NT),(t+1<NT));       ENDW(t);   RESC(); ROT();
    STEP(pwb,pwa,t+1,(t+4<NT),(t+2<NT),(t+2<NT));     ENDW(t+1); RESC(); ROT();
  }
  STEP(pwa,pwb,NT-1,false,false,false); RESC();
  SBAR(); pv(o,vb0+2*sl_cur,PAFC(pwb,0),PAFC(pwb,1),PAFC(pwb,2),PAFC(pwb,3));
  #undef PKW
  #undef PAFC
  #undef CAT
  #undef CAT_
  #undef QK
  #undef GAPB3
  #undef VFR
  #undef PIN_
  #undef MX3
  #undef EX
  #undef VRD
  #undef VNX
  #undef VOFF
  #undef GAPB2
  #undef KRD
  #undef STEP
  #undef ENDW
  {auto rr=__builtin_amdgcn_permlane32_swap(__float_as_uint(l_reg),__float_as_uint(l_reg),false,false);l_reg=__uint_as_float(rr[0])+__uint_as_float(rr[1]);}
  {
    const int le=lane_now(), r32e=le&31, hie=le>>5;
    float*wsfe=(float*)(shm+LDS_WS)+wid*64;
    if(hie==0)wsfe[32+r32e]=l_reg;asm volatile("s_waitcnt lgkmcnt(0)":::"memory");
    float rli[16];
    #pragma unroll
    for(int r=0;r<16;++r)rli[r]=__builtin_amdgcn_rcpf(wsfe[32+crow(r,hie)]);
    bf16_t*Ow=Ob+(long)(q0+wid*QBLK)*POUT;
    bf16_t*stg=(bf16_t*)(shm+LDS_OST)+wid*4096;
    #pragma unroll
    for(int r=0;r<16;++r){const int orow=crow(r,hie);
      #pragma unroll
      for(int d0=0;d0<4;++d0)stg[orow*128+d0*32+r32e]=(bf16_t)f2bf(o[d0][r]*rli[r]);}
    asm volatile("s_waitcnt lgkmcnt(0)":::"memory");
    #pragma unroll
    for(int i=0;i<8;++i){const int row=i*4+(le>>4),ch=le&15; const u32x4 v=*(const u32x4*)(stg+row*128+ch*8); ATTN_STORE16(Ow+(long)row*POUT+ch*8,v);} }
  asm volatile("s_waitcnt lgkmcnt(0)\n\ts_barrier":::"memory");
  #undef DMA_K
  #undef DMA_V
  #undef CMASK
  #undef CINIT0
  #undef CINIT1
  #undef START
  #undef RESC
  #undef ROT
}
#undef SBAR
#undef WAIT_BAR
}

__device__ __forceinline__ void attn_phase(const Frame& F, const Args& a) {
    const bf16_t* proj = (const bf16_t*)(a.ws + WS_PROJ); bf16_t* OA = (bf16_t*)(a.ws + WS_OA);
    const int vcu = (F.G % 8 == 0) ? (F.bid % 8) * (F.G / 8) + F.bid / 8 : F.bid;
    for (int i = 0;; ++i) {
        int bhm, qb;
        if (F.G == 256) { if (i >= 2) break; const int s_ = vcu & 7; bhm = vcu >> 3; qb = (i == 0) ? 15 - s_ : s_; }
        else { const int u = i * F.G + F.bid; if (u >= 512) break; bhm = u >> 4; qb = 15 - (u & 15); }
        const int b = bhm >> 3, h = (bhm >> 1) & 3, map = bhm & 1;
        const bf16_t* base = proj + (size_t)b * SEQ * INC;
        const float slope2 = exp2f(-2.0f * (h + 1)) * 1.4426950408889634f;
        attn_body::attn_unit<8>(qb, base + C_QDA + h * 128 + map * 64, base + C_KDA + h * 128 + map * 64, base + C_VDA + h * 128,
                                OA + (size_t)b * SEQ * 1024 + h * 256 + map * 128, slope2, (char*)F.lds);
    }
}
__device__ __forceinline__ void attn_combine(const Frame& F, const Args& a) {
    const bf16_t* OA = (const bf16_t*)(a.ws + WS_OA); bf16_t* Y = (bf16_t*)(a.ws + WS_YDA);
    const float lam = ((const float*)(a.ws + WS_SMALL))[0];
    const float g0 = a.in[I_SUBG][2 * F.lane] * 0.8f, g1 = a.in[I_SUBG][2 * F.lane + 1] * 0.8f;
    const int gw = F.bid * NWAVES + F.wave, NGW = F.G * NWAVES;
    for (int r = gw; r < T; r += NGW) {
        const unsigned* orow = (const unsigned*)(OA + (size_t)r * 1024); unsigned* yrow = (unsigned*)(Y + (size_t)r * 512);
        unsigned w0[4], w1[4];
#pragma unroll
        for (int h = 0; h < 4; ++h) { w0[h] = orow[h * 128 + F.lane]; w1[h] = orow[h * 128 + 64 + F.lane]; }
#pragma unroll
        for (int h = 0; h < 4; ++h) {
            const float x0 = bf2f(w0[h] & 0xffffu) - lam * bf2f(w1[h] & 0xffffu), x1 = bf2f(w0[h] >> 16) - lam * bf2f(w1[h] >> 16);
            const float rs = rsqrtf(wave_sum(x0 * x0 + x1 * x1) * (1.0f / 128.0f) + EPS);
            yrow[h * 64 + F.lane] = pk2(x0 * rs * g0, x1 * rs * g1);
        }
    }
}
namespace hg {
constexpr int QP = 136;
constexpr int L_QD = 0, L_KD = 64 * QP * 2, L_V = 2 * 64 * QP * 2, L_KE = 3 * 64 * QP * 2, L_SSQ = 4 * 64 * QP * 2, L_G = L_SSQ + 512, L_ST = L_G + 64 * QP * 2;
__device__ __forceinline__ f32x4 mfma16(bf16x8 a, bf16x8 b, f32x4 c) { return __builtin_amdgcn_mfma_f32_16x16x32_bf16(a, b, c, 0, 0, 0); }
#define HG_BAR() do { asm volatile("s_waitcnt lgkmcnt(0)" ::: "memory"); __builtin_amdgcn_s_barrier(); asm volatile("" ::: "memory"); } while (0)
typedef short v4i16_t __attribute__((ext_vector_type(4)));
__device__ __forceinline__ bf16x8 tr8(const LAS unsigned char* img, int ra, int rb, int col0, int lane) {
    const int q = (lane & 15) >> 2, p = lane & 3;
    const v4i16_t lo = __builtin_amdgcn_ds_read_tr16_b64_v4i16((LAS v4i16_t*)(img + ((ra + q) * QP + col0 + 4 * p) * 2));
    const v4i16_t hi = __builtin_amdgcn_ds_read_tr16_b64_v4i16((LAS v4i16_t*)(img + ((rb + q) * QP + col0 + 4 * p) * 2));
    return (bf16x8){lo[0], lo[1], lo[2], lo[3], hi[0], hi[1], hi[2], hi[3]};
}
struct Tile { u32x4 p[2]; };
__device__ __forceinline__ void tile_load(Tile& t, const bf16_t* src, size_t pitch, int tid) {
#pragma unroll
    for (int i = 0; i < 2; ++i) { const int pc = tid + NTHR * i; t.p[i] = *(const u32x4*)(src + (size_t)(pc >> 4) * pitch + (pc & 15) * 8); }
}
__device__ __forceinline__ void tile_put(const Tile& t, LAS unsigned char* img, int tid) {
#pragma unroll
    for (int i = 0; i < 2; ++i) { const int pc = tid + NTHR * i; *(LAS u32x4*)(img + ((pc >> 4) * QP + (pc & 15) * 8) * 2) = t.p[i]; }
}
constexpr int PP = 72;
constexpr int G4_L_P = 4 * 64 * QP * 2, G4_L_DEC = G4_L_P + 64 * PP * 2, G4_L_SSQ = G4_L_DEC + 512;
struct InA { Tile qd, kd, ke, v; f32x4 dec; };
__device__ __forceinline__ void loadA(InA& r, const Frame& F, const Args& a, int bh, int n) {
    const int b = bh >> 2, h = bh & 3; const size_t t0 = (size_t)b * SEQ + n * 64;
    const bf16_t* base = (const bf16_t*)(a.ws + WS_PROJ) + t0 * INC;
    tile_load(r.qd, base + C_HGT + 256 * h, INC, F.tid); tile_load(r.kd, base + C_HGT + 256 * h + 128, INC, F.tid);
    tile_load(r.ke, (const bf16_t*)a.out + t0 * 512 + h * 128, 512, F.tid); tile_load(r.v, base + C_IHG + h * 128, INC, F.tid);
    r.dec = *(const f32x4*)((const float*)(a.ws + WS_DEC) + ((size_t)bh * 64 + n) * 128 + 4 * (F.tid & 31));
}
__device__ __forceinline__ void grp_local(const Frame& F, const Args& a, int grp) {
    const int bh = grp >> 4, n0 = 4 * (grp & 15), b = bh >> 2, h = bh & 3, w = F.wave, lane = F.lane, fr = lane & 15, fq = lane >> 4;
    for (int i = F.tid; i < 64 * PP / 2; i += NTHR) ((LAS unsigned*)(F.lds + G4_L_P))[i] = 0u;
    f32x4 S[8];
#pragma unroll
    for (int kt = 0; kt < 8; ++kt) S[kt] = (f32x4){0.f, 0.f, 0.f, 0.f};
    InA cur, nxt; loadA(cur, F, a, bh, n0);
    unsigned short yk[4][4];
#define G4_STORE(nn) do { bf16_t* yp_ = (bf16_t*)(a.ws + WS_YHG) + ((size_t)b * SEQ + (nn) * 64 + 4 * fq) * 512 + h * 128 + 16 * w + fr; \
        _Pragma("unroll") for (int tb = 0; tb < 4; ++tb) _Pragma("unroll") for (int r = 0; r < 4; ++r) yp_[(size_t)(16 * tb + r) * 512] = yk[tb][r]; } while (0)
    for (int j = 0; j < 4; ++j) {
        if (j > 0) G4_STORE(n0 + j - 1);
        loadA(nxt, F, a, bh, n0 + (j < 3 ? j + 1 : 3));
        tile_put(cur.qd, F.lds + L_QD, F.tid); tile_put(cur.kd, F.lds + L_KD, F.tid); tile_put(cur.ke, F.lds + L_KE, F.tid); tile_put(cur.v, F.lds + L_V, F.tid);
        if (F.tid < 32) *(LAS f32x4*)(F.lds + G4_L_DEC + 16 * F.tid) = cur.dec;
        HG_BAR();
#pragma unroll
        for (int rep = 0; rep < 2; ++rep) { const int pi = w + 8 * rep;
            if (pi < 10) { const int tb = pi >= 6 ? 3 : pi >= 3 ? 2 : pi >= 1 ? 1 : 0, jt = pi - (tb * (tb + 1)) / 2;
                f32x4 sc = (f32x4){0.f, 0.f, 0.f, 0.f};
#pragma unroll
                for (int ks = 0; ks < 4; ++ks) { const bf16x8 kf = *(const LAS bf16x8*)(F.lds + L_KD + ((16 * jt + fr) * QP + 32 * ks + 8 * fq) * 2);
                    const bf16x8 qf = *(const LAS bf16x8*)(F.lds + L_QD + ((16 * tb + fr) * QP + 32 * ks + 8 * fq) * 2); sc = mfma16(kf, qf, sc); }
                if (jt == tb) {
#pragma unroll
                    for (int r = 0; r < 4; ++r) if (4 * fq + r > fr) sc[r] = 0.f;
                }
                *(LAS u32x2*)(F.lds + G4_L_P + ((16 * tb + fr) * PP + 16 * jt + 4 * fq) * 2) = (u32x2){cvt_pk_bf16(sc[0], sc[1]), cvt_pk_bf16(sc[2], sc[3])}; } }
        HG_BAR();
        bf16x8 bv[2];
#pragma unroll
        for (int s2 = 0; s2 < 2; ++s2) bv[s2] = tr8(F.lds + L_V, 32 * s2 + 8 * fq, 32 * s2 + 8 * fq + 4, 16 * w, lane);
        bf16x8 Sb[4];
#pragma unroll
        for (int ks = 0; ks < 4; ++ks) { const u32x4 t = (u32x4){cvt_pk_bf16(S[2 * ks][0], S[2 * ks][1]), cvt_pk_bf16(S[2 * ks][2], S[2 * ks][3]), cvt_pk_bf16(S[2 * ks + 1][0], S[2 * ks + 1][1]), cvt_pk_bf16(S[2 * ks + 1][2], S[2 * ks + 1][3])};
            Sb[ks] = __builtin_bit_cast(bf16x8, t); }
#pragma unroll
        for (int tb = 0; tb < 4; ++tb) { f32x4 o = (f32x4){0.f, 0.f, 0.f, 0.f};
#pragma unroll
            for (int s2 = 0; s2 <= (tb >> 1); ++s2) { const bf16x8 pf = *(const LAS bf16x8*)(F.lds + G4_L_P + ((16 * tb + fr) * PP + 32 * s2 + 8 * fq) * 2); o = mfma16(pf, bv[s2], o); }
            if (j > 0) {
#pragma unroll
                for (int ks = 0; ks < 4; ++ks) { const LAS unsigned char* qrow = F.lds + L_QD + ((16 * tb + fr) * QP + 32 * ks + 4 * fq) * 2;
                    const u32x2 lo = *(const LAS u32x2*)qrow, hi = *(const LAS u32x2*)(qrow + 32);
                    const u32x4 aw = (u32x4){lo.x, lo.y, hi.x, hi.y}; o = mfma16(__builtin_bit_cast(bf16x8, aw), Sb[ks], o); } }
#pragma unroll
            for (int r = 0; r < 4; ++r) yk[tb][r] = (unsigned short)f2bf(o[r]); }
#pragma unroll
        for (int kt = 0; kt < 8; ++kt) { S[kt] = S[kt] * *(const LAS f32x4*)(F.lds + G4_L_DEC + (16 * kt + 4 * fq) * 4);
#pragma unroll
            for (int s2 = 0; s2 < 2; ++s2) S[kt] = mfma16(tr8(F.lds + L_KE, 32 * s2 + 8 * fq, 32 * s2 + 8 * fq + 4, 16 * kt, lane), bv[s2], S[kt]); }
        HG_BAR();
        cur = nxt;
    }
    G4_STORE(n0 + 3);
#undef G4_STORE
    f32x4* sg = (f32x4*)(a.ws + WS_DS) + ((size_t)grp * 64 + w * 8) * 64 + lane;
#pragma unroll
    for (int kt = 0; kt < 8; ++kt) sg[kt * 64] = S[kt];
}
__device__ __forceinline__ void grp_scan(const Frame& F, const Args& a) {
    f32x4* sg = (f32x4*)(a.ws + WS_DS); f32x4* si = sg + (size_t)256 * 4096; const float* dec = (const float*)(a.ws + WS_DEC);
    for (int gt = F.bid * NTHR + F.tid; gt < 16 * 4096; gt += F.G * NTHR) {
        const int bh = gt >> 12, slot = gt & 4095, kt = (slot >> 6) & 7, lane = slot & 63, k = 16 * kt + 4 * (lane >> 4);
        f32x4 cur = (f32x4){0.f, 0.f, 0.f, 0.f};
#pragma unroll 4
        for (int g = 0; g < 16; ++g) { const size_t gi = ((size_t)(bh * 16 + g)) * 4096 + slot;
            si[gi] = cur;
            const float* dp = dec + ((size_t)bh * 64 + 4 * g) * 128 + k;
            const f32x4 d = (*(const f32x4*)dp * *(const f32x4*)(dp + 128)) * (*(const f32x4*)(dp + 256) * *(const f32x4*)(dp + 384));
            cur = d * cur + sg[gi]; }
    }
}
struct InC { Tile qd, g, ol; f32x4 dec; };
__device__ __forceinline__ void loadC(InC& r, const Frame& F, const Args& a, int bh, int n) {
    const int b = bh >> 2, h = bh & 3; const size_t t0 = (size_t)b * SEQ + n * 64;
    const bf16_t* base = (const bf16_t*)(a.ws + WS_PROJ) + t0 * INC;
    tile_load(r.qd, base + C_HGT + 256 * h, INC, F.tid); tile_load(r.g, base + C_GHG + h * 128, INC, F.tid);
    tile_load(r.ol, (const bf16_t*)(a.ws + WS_YHG) + t0 * 512 + h * 128, 512, F.tid);
    r.dec = *(const f32x4*)((const float*)(a.ws + WS_DEC) + ((size_t)bh * 64 + n) * 128 + 4 * (F.tid & 31));
}
__device__ __forceinline__ void grp_final(const Frame& F, const Args& a, int grp) {
    const int bh = grp >> 4, n0 = 4 * (grp & 15), b = bh >> 2, h = bh & 3, w = F.wave, lane = F.lane, fr = lane & 15, fq = lane >> 4;
    f32x4 S[8];
    { const f32x4* si = (const f32x4*)(a.ws + WS_DS) + (size_t)256 * 4096 + ((size_t)grp * 64 + w * 8) * 64 + lane;
#pragma unroll
      for (int kt = 0; kt < 8; ++kt) S[kt] = si[kt * 64]; }
    const float ng = a.in[I_HGNG][16 * w + fr];
    LAS float* SSQ = (LAS float*)(F.lds + G4_L_SSQ);
    InC cur, nxt; loadC(cur, F, a, bh, n0);
    unsigned short yk[4][4];
#define G4_STORE(nn) do { bf16_t* yp_ = (bf16_t*)(a.ws + WS_YHG) + ((size_t)b * SEQ + (nn) * 64 + 4 * fq) * 512 + h * 128 + 16 * w + fr; \
        _Pragma("unroll") for (int tb = 0; tb < 4; ++tb) _Pragma("unroll") for (int r = 0; r < 4; ++r) yp_[(size_t)(16 * tb + r) * 512] = yk[tb][r]; } while (0)
    for (int j = 0; j < 4; ++j) {
        if (j > 0) G4_STORE(n0 + j - 1);
        loadC(nxt, F, a, bh, n0 + (j < 3 ? j + 1 : 3));
        tile_put(cur.qd, F.lds + L_QD, F.tid); tile_put(cur.g, F.lds + L_KD, F.tid); tile_put(cur.ol, F.lds + L_V, F.tid);
        if (F.tid < 32) *(LAS f32x4*)(F.lds + G4_L_DEC + 16 * F.tid) = cur.dec;
        HG_BAR();
        bf16x8 Sb[4];
#pragma unroll
        for (int ks = 0; ks < 4; ++ks) { const u32x4 t = (u32x4){cvt_pk_bf16(S[2 * ks][0], S[2 * ks][1]), cvt_pk_bf16(S[2 * ks][2], S[2 * ks][3]), cvt_pk_bf16(S[2 * ks + 1][0], S[2 * ks + 1][1]), cvt_pk_bf16(S[2 * ks + 1][2], S[2 * ks + 1][3])};
            Sb[ks] = __builtin_bit_cast(bf16x8, t); }
        f32x4 o[4];
#pragma unroll
        for (int tb = 0; tb < 4; ++tb) {
#pragma unroll
            for (int r = 0; r < 4; ++r) o[tb][r] = bf2f(*(const LAS unsigned short*)(F.lds + L_V + ((16 * tb + 4 * fq + r) * QP + 16 * w + fr) * 2));
#pragma unroll
            for (int ks = 0; ks < 4; ++ks) { const LAS unsigned char* qrow = F.lds + L_QD + ((16 * tb + fr) * QP + 32 * ks + 4 * fq) * 2;
                const u32x2 lo = *(const LAS u32x2*)qrow, hi = *(const LAS u32x2*)(qrow + 32);
                const u32x4 aw = (u32x4){lo.x, lo.y, hi.x, hi.y}; o[tb] = mfma16(__builtin_bit_cast(bf16x8, aw), Sb[ks], o[tb]); }
#pragma unroll
            for (int r = 0; r < 4; ++r) { const float v = scan16(o[tb][r] * o[tb][r]); if (fr == 15) SSQ[w * 64 + 16 * tb + 4 * fq + r] = v; } }
#pragma unroll
        for (int kt = 0; kt < 8; ++kt) S[kt] = S[kt] * *(const LAS f32x4*)(F.lds + G4_L_DEC + (16 * kt + 4 * fq) * 4);
        HG_BAR();
#pragma unroll
        for (int tb = 0; tb < 4; ++tb) { f32x4 tot = (f32x4){0.f, 0.f, 0.f, 0.f};
#pragma unroll
            for (int ww = 0; ww < 8; ++ww) tot += *(const LAS f32x4*)(SSQ + ww * 64 + 16 * tb + 4 * fq);
#pragma unroll
            for (int r = 0; r < 4; ++r) { const float rs = rsqrtf(tot[r] * (1.0f / 128.0f) + EPS); const float g = bf2f(*(const LAS unsigned short*)(F.lds + L_KD + ((16 * tb + 4 * fq + r) * QP + 16 * w + fr) * 2));
                yk[tb][r] = (unsigned short)f2bf(o[tb][r] * rs * ng * g * __builtin_amdgcn_rcpf(1.0f + __builtin_amdgcn_exp2f(-1.4426950408889634f * g))); } }
        HG_BAR();
        cur = nxt;
    }
    G4_STORE(n0 + 3);
#undef G4_STORE
}
#undef HG_BAR
}

__device__ __forceinline__ float rs4(float a0, float a1, float a2, float a3, int lane) {
    const bool hi = (lane & 32) != 0;
    const float s0 = hi ? a0 : a2, s1 = hi ? a1 : a3;
    const float k0 = (hi ? a2 : a0) + __shfl_xor(s0, 32), k1 = (hi ? a3 : a1) + __shfl_xor(s1, 32);
    const bool b4 = (lane & 16) != 0;
    const float sd = b4 ? k0 : k1;
    float k = (b4 ? k1 : k0) + __shfl_xor(sd, 16);
    k += __shfl_xor(k, 8); k += __shfl_xor(k, 4); k += __shfl_xor(k, 2); k += __shfl_xor(k, 1);
    return k;
}
__device__ __forceinline__ void phase_router(const Frame& F, const Args& a) {
    constexpr int AP = 1032;
    LAS bf16_t* AH = (LAS bf16_t*)F.lds;
    LAS bf16_t* AL = AH + 16 * AP;
    LAS float* PART = (LAS float*)(F.lds + 2 * 16 * AP * 2);
    LAS float* LG = PART + 8 * 16 * 48;
    LAS unsigned* LH = (LAS unsigned*)(LG + 16 * 48);
    LAS unsigned* LB = LH + 32;
    LAS unsigned* LR = LH + 64;
    if (F.tid < NEXP) LH[F.tid] = 0u;
    const float* mod = (const float*)(a.ws + WS_MOD);
    const float* x1 = a.out; bf16_t* H2 = (bf16_t*)(a.ws + WS_ACT);
    unsigned* counts = (unsigned*)(a.ws + WS_CTL) + CW_COUNTS; unsigned* tokinfo = (unsigned*)(a.ws + WS_TOKINFO); int* toklist = (int*)(a.ws + WS_TOKLIST);
    const int rows_per_blk = T / F.G, r0 = F.bid * rows_per_blk, b = r0 / SEQ;
    const int lane = F.lane, w = F.wave, fr = lane & 15, fq = lane >> 4;
    f32x4 v[2][4], vn[2][4];
#define RT_LOAD(V, rb_) do { _Pragma("unroll") for (int q = 0; q < 2; ++q) { const f32x4* xr_ = (const f32x4*)(x1 + (size_t)((rb_) + 2 * w + q) * D) + lane; \
        _Pragma("unroll") for (int j = 0; j < 4; ++j) V[q][j] = xr_[64 * j]; } } while (0)
    RT_LOAD(v, r0);
    bf16x8 Bh[4][3], Bl[4][3];
    {
        const float* wre = a.in[I_WRE]; const float* wrg = a.in[I_WRG];
#pragma unroll
        for (int ks = 0; ks < 4; ++ks)
#pragma unroll
            for (int ct = 0; ct < 3; ++ct) {
                unsigned hw[4], lw[4];
#pragma unroll
                for (int jp = 0; jp < 4; ++jp) { float x[2];
#pragma unroll
                    for (int z = 0; z < 2; ++z) { const int k = 128 * w + 32 * ks + 8 * fq + 2 * jp + z;
                        if (ct == 0) { const float g = wrg[k * 4 + (fr & 3)], e = wre[k * 32 + ((fr + 28) & 31)]; x[z] = fr < 4 ? g : e; }
                        else if (ct == 1) x[z] = wre[k * 32 + 12 + fr];
                        else { const float e = wre[k * 32 + 28 + (fr & 3)]; x[z] = fr < 4 ? e : 0.f; } }
                    const unsigned h0 = f2bf(x[0]), h1 = f2bf(x[1]); hw[jp] = h0 | (h1 << 16);
                    lw[jp] = pk2(x[0] - bf2f(h0), x[1] - bf2f(h1)); }
                Bh[ks][ct] = __builtin_bit_cast(bf16x8, (u32x4){hw[0], hw[1], hw[2], hw[3]}); Bl[ks][ct] = __builtin_bit_cast(bf16x8, (u32x4){lw[0], lw[1], lw[2], lw[3]});
            }
    }
    for (int g = 0; g < rows_per_blk / 16; ++g) {
        const int rg = r0 + 16 * g;
        { const int gn = g + 1 < rows_per_blk / 16 ? g + 1 : g; RT_LOAD(vn, r0 + 16 * gn); }
#pragma unroll
        for (int q = 0; q < 2; ++q) { float sq = 0.f;
#pragma unroll
            for (int j = 0; j < 4; ++j) sq += (v[q][j].x * v[q][j].x + v[q][j].y * v[q][j].y) + (v[q][j].z * v[q][j].z + v[q][j].w * v[q][j].w);
            const float rs = rsqrtf(wave_sum(sq) * (1.0f / D) + EPS); const int row = 2 * w + q;
#pragma unroll
            for (int j = 0; j < 4; ++j) { const int k = 256 * j + 4 * lane;
                const f32x4 gg = *(const f32x4*)(a.in[I_N2G] + k) * (1.0f + *(const f32x4*)(mod + b * 6144 + 4 * 1024 + k)), sh = *(const f32x4*)(mod + b * 6144 + 3 * 1024 + k);
                const f32x4 hv = v[q][j] * rs * gg + sh;
                const unsigned h0 = f2bf(hv.x), h1 = f2bf(hv.y), h2_ = f2bf(hv.z), h3 = f2bf(hv.w);
                const u32x2 hw = (u32x2){h0 | (h1 << 16), h2_ | (h3 << 16)};
                *(u32x2*)(H2 + (size_t)(rg + row) * D + k) = hw;
                *(LAS u32x2*)(AH + row * AP + k) = hw;
                *(LAS u32x2*)(AL + row * AP + k) = (u32x2){pk2(hv.x - bf2f(h0), hv.y - bf2f(h1)), pk2(hv.z - bf2f(h2_), hv.w - bf2f(h3))}; } }
        __syncthreads();
        f32x4 acc[3] = {{0.f, 0.f, 0.f, 0.f}, {0.f, 0.f, 0.f, 0.f}, {0.f, 0.f, 0.f, 0.f}};
#pragma unroll
        for (int ks = 0; ks < 4; ++ks) { const bf16x8 ah = *(const LAS bf16x8*)(AH + fr * AP + 128 * w + 32 * ks + 8 * fq), al = *(const LAS bf16x8*)(AL + fr * AP + 128 * w + 32 * ks + 8 * fq);
#pragma unroll
            for (int ct = 0; ct < 3; ++ct) { acc[ct] = __builtin_amdgcn_mfma_f32_16x16x32_bf16(ah, Bh[ks][ct], acc[ct], 0, 0, 0);
                acc[ct] = __builtin_amdgcn_mfma_f32_16x16x32_bf16(al, Bh[ks][ct], acc[ct], 0, 0, 0); acc[ct] = __builtin_amdgcn_mfma_f32_16x16x32_bf16(ah, Bl[ks][ct], acc[ct], 0, 0, 0); } }
#pragma unroll
        for (int ct = 0; ct < 3; ++ct)
#pragma unroll
            for (int r = 0; r < 4; ++r) PART[(w * 16 + 4 * fq + r) * 48 + 16 * ct + fr] = acc[ct][r];
        __syncthreads();
        for (int t = F.tid; t < 16 * 48; t += NTHR) { const int row = t / 48, o = t % 48; float sacc = 0.f;
#pragma unroll
            for (int ww = 0; ww < 8; ++ww) sacc += PART[(ww * 16 + row) * 48 + o];
            if (o < 36) LG[row * 48 + o] = sacc + (o < 4 ? a.in[I_BRG][o & 3] : a.in[I_BRE][(o + 28) & 31]); }
        __syncthreads();
        if (F.tid < 16) {
            const LAS float* lg = LG + F.tid * 48;
            float gl[4]; int gi = 0;
#pragma unroll
            for (int o = 0; o < 4; ++o) gl[o] = lg[o];
            float gm = gl[0];
#pragma unroll
            for (int o = 1; o < 4; ++o) if (gl[o] > gm) { gm = gl[o]; gi = o; }
            float gsum = 0.f;
#pragma unroll
            for (int o = 0; o < 4; ++o) gsum += expf(gl[o] - gm);
            const float gp = 1.0f / gsum;
            float el[8];
#pragma unroll
            for (int e = 0; e < 8; ++e) el[e] = lg[4 + gi * 8 + e];
            int i0 = 0; float m0 = el[0];
#pragma unroll
            for (int o = 1; o < 8; ++o) if (el[o] > m0) { m0 = el[o]; i0 = o; }
            int i1 = -1; float m1 = -INFINITY;
#pragma unroll
            for (int o = 0; o < 8; ++o) if (o != i0 && el[o] > m1) { m1 = el[o]; i1 = o; }
            const float e1 = expf(m1 - m0); const float w0 = gp / (1.0f + e1), w1 = gp * e1 / (1.0f + e1);
            const int rl = 16 * g + F.tid, ex0 = gi * 8 + i0, ex1 = gi * 8 + i1;
            const unsigned l0 = atomicAdd((unsigned*)(LH + ex0), 1u), l1 = atomicAdd((unsigned*)(LH + ex1), 1u);
            LAS unsigned* ri = LR + rl * 6;
            ri[0] = (unsigned)ex0; ri[1] = l0; ri[2] = (unsigned)ex1; ri[3] = l1; ri[4] = __float_as_uint(w0); ri[5] = __float_as_uint(w1);
        }
#pragma unroll
        for (int q = 0; q < 2; ++q)
#pragma unroll
            for (int j = 0; j < 4; ++j) v[q][j] = vn[q][j];
    }
#undef RT_LOAD
    __syncthreads();
    if (F.tid < NEXP) LB[F.tid] = atomicAdd(counts + 64 * F.tid, LH[F.tid]);
    __syncthreads();
    for (int rl = F.tid; rl < rows_per_blk; rl += NTHR) {
        const LAS unsigned* ri = LR + rl * 6; const int r = r0 + rl;
        const unsigned ex0 = ri[0], ex1 = ri[2], k0 = LB[ex0] + ri[1], k1 = LB[ex1] + ri[3];
        toklist[ex0 * T + k0] = r; toklist[ex1 * T + k1] = r;
        u32x4 t0; t0.x = ex0; t0.y = k0; t0.z = ex1; t0.w = k1;
        *(u32x4*)(tokinfo + (size_t)r * 8) = t0;
        tokinfo[(size_t)r * 8 + 4] = ri[4]; tokinfo[(size_t)r * 8 + 5] = ri[5];
    }
}
__device__ __forceinline__ void build_moe_tab(const Frame& F, const Args& a, LAS MoeTab* tab) {
    if (F.tid == 0) {
        const unsigned* counts = (const unsigned*)(a.ws + WS_CTL) + CW_COUNTS; int nt = 0;
        for (int e = 0; e < NEXP; ++e) { const int c = (int)__hip_atomic_load(counts + 64 * e, __ATOMIC_RELAXED, __HIP_MEMORY_SCOPE_AGENT); tab->cnt[e] = c; tab->tbase[e] = nt;
            const int n = (c + 255) >> 8; for (int m = 0; m < n; ++m) { tab->tile_e[nt] = e; tab->tile_m[nt] = m; ++nt; } }
        tab->tbase[NEXP] = nt; tab->nt = nt;
    }
    __syncthreads();
}
__device__ __forceinline__ void phase_final(const Frame& F, const Args& a, const LAS MoeTab* tab) {
    const float* mod = (const float*)(a.ws + WS_MOD); const unsigned* tokinfo = (const unsigned*)(a.ws + WS_TOKINFO); const bf16_t* Ys = (const bf16_t*)(a.ws + WS_YS);
    const int rows_per_blk = T / F.G, r0 = F.bid * rows_per_blk;
    for (int r = r0 + F.wave; r < r0 + rows_per_blk; r += NWAVES) {
        const int b = r / SEQ;
        const u32x4 ti = *(const u32x4*)(tokinfo + (size_t)r * 8);
        const float w0 = __uint_as_float(tokinfo[(size_t)r * 8 + 4]), w1 = __uint_as_float(tokinfo[(size_t)r * 8 + 5]);
        const size_t s0 = (size_t)tab->tbase[ti.x] * 256 + ti.y, s1 = (size_t)tab->tbase[ti.z] * 256 + ti.w;
        f32x4* xr = (f32x4*)(a.out + (size_t)r * D) + F.lane;
        const u32x2* y0 = (const u32x2*)(Ys + s0 * D) + F.lane; const u32x2* y1 = (const u32x2*)(Ys + s1 * D) + F.lane;
        f32x4 v[4]; float s = 0.f;
#pragma unroll
        for (int j = 0; j < 4; ++j) { const int k = 256 * j + 4 * F.lane;
            const f32x4 gt = *(const f32x4*)(mod + b * 6144 + 5 * 1024 + k); const u32x2 a0 = y0[64 * j], a1 = y1[64 * j];
            f32x4 m; m.x = w0 * bf2f(a0.x & 0xffffu) + w1 * bf2f(a1.x & 0xffffu); m.y = w0 * bf2f(a0.x >> 16) + w1 * bf2f(a1.x >> 16);
            m.z = w0 * bf2f(a0.y & 0xffffu) + w1 * bf2f(a1.y & 0xffffu); m.w = w0 * bf2f(a0.y >> 16) + w1 * bf2f(a1.y >> 16);
            v[j] = xr[64 * j] + gt * m; s += (v[j].x * v[j].x + v[j].y * v[j].y) + (v[j].z * v[j].z + v[j].w * v[j].w); }
        const float rs = rsqrtf(wave_sum(s) * (1.0f / D) + EPS);
#pragma unroll
        for (int j = 0; j < 4; ++j) { const f32x4 g = *(const f32x4*)(a.in[I_FG] + 256 * j + 4 * F.lane); xr[64 * j] = v[j] * rs * g; }
    }
}

#define XB_TMO      128
#define XB_XCNT(j)  (256  + 64 * (j))
#define XB_XSUB(j)  (1280 + 64 * (j))
#define XB_XGEN(j)  (2304 + 64 * (j))
#define XB_TOP      3328
#define XB_TOPGEN   3392
#define XCD_BAR_WORDS 3456
#define XB_SPIN_CAP (1u << 18)
__device__ __forceinline__ unsigned xb_ld(unsigned* p)              { return __hip_atomic_load(p, __ATOMIC_RELAXED, __HIP_MEMORY_SCOPE_AGENT); }
__device__ __forceinline__ unsigned xb_add(unsigned* p, unsigned v) { return __hip_atomic_fetch_add(p, v, __ATOMIC_RELAXED, __HIP_MEMORY_SCOPE_AGENT); }
__device__ __forceinline__ unsigned xb_xcc_id() { return (unsigned)__builtin_amdgcn_s_getreg((3 << 11) | 20) & 0xFu; }
#define XB_SPIN(cond, bar) do { unsigned _sp = 0; while (cond) { __builtin_amdgcn_s_sleep(1); \
    if ((++_sp & 255u) == 0u) { if (xb_ld(&(bar)[XB_TMO])) break; if (_sp > XB_SPIN_CAP) { atomicAdd(&(bar)[XB_TMO], 1u); break; } } } } while (0)
struct XcdBarrier { unsigned* bar; unsigned x; volatile LAS unsigned* st; };
__device__ __forceinline__ XcdBarrier xcd_barrier_post(unsigned* bar, volatile LAS unsigned* st) {
    XcdBarrier b; b.bar = bar; b.x = xb_xcc_id(); b.st = st;
    if (threadIdx.x == 0) (void)xb_add(&bar[XB_XCNT(b.x)], 1u);
    return b;
}
__device__ __forceinline__ void xcd_barrier_complete(unsigned* bar, unsigned x, unsigned& nloc, unsigned& nx) {
    const unsigned G = gridDim.x * gridDim.y * gridDim.z;
    unsigned sum, cnt, mine, sp = 0u;
    for (;;) {
        sum = 0u; cnt = 0u; mine = 0u;
#pragma unroll
        for (unsigned j = 0; j < 16; ++j) { const unsigned c = xb_ld(&bar[XB_XCNT(j)]); sum += c; cnt += (c > 0u) ? 1u : 0u; mine = (j == x) ? c : mine; }
        if (sum == G) break;
        __builtin_amdgcn_s_sleep(1);
        if ((++sp & 255u) == 0u) { if (xb_ld(&bar[XB_TMO])) break; if (sp > XB_SPIN_CAP) { atomicAdd(&bar[XB_TMO], 1u); break; } }
    }
    nloc = mine > 0u ? mine : 1u; nx = cnt > 0u ? cnt : 1u;
}
__device__ __forceinline__ void xcd_barrier(const XcdBarrier& b) {
    asm volatile("s_waitcnt vmcnt(0)" ::: "memory");
    __syncthreads();
    if (threadIdx.x == 0) {
        unsigned* bar = b.bar;
        __builtin_amdgcn_s_waitcnt(0);
        unsigned nloc = b.st[0], nx = b.st[1];
        if (nloc == 0u) { xcd_barrier_complete(bar, b.x, nloc, nx); b.st[0] = nloc; b.st[1] = nx; }
        const unsigned old = xb_add(&bar[XB_XSUB(b.x)], 1u);
        const unsigned gen = old / nloc;
        if (old + 1u == (gen + 1u) * nloc) {
            __builtin_amdgcn_fence(__ATOMIC_RELEASE, "agent");
            asm volatile("s_waitcnt vmcnt(0)" ::: "memory");
            const unsigned og = xb_add(&bar[XB_TOP], 1u);
            const unsigned tg = og / nx;
            if (og + 1u == (tg + 1u) * nx) xb_add(&bar[XB_TOPGEN], 1u);
            else XB_SPIN(xb_ld(&bar[XB_TOPGEN]) == tg, bar);
            __builtin_amdgcn_fence(__ATOMIC_ACQUIRE, "agent");
            xb_add(&bar[XB_XGEN(b.x)], 1u);
            asm volatile("s_waitcnt vmcnt(0)" ::: "memory");
        } else {
            XB_SPIN(xb_ld(&bar[XB_XGEN(b.x)]) == gen, bar);
            __builtin_amdgcn_fence(__ATOMIC_ACQUIRE, "agent");
            asm volatile("s_waitcnt vmcnt(0)" ::: "memory");
        }
    }
    __syncthreads();
}

constexpr int N_PHASES = 11;
__global__ void __launch_bounds__(NTHR, 2) mk_fwd(Args a) {
    extern __shared__ __attribute__((aligned(16))) unsigned char lds_raw[];
    Frame F; F.lds = (LAS unsigned char*)lds_raw; F.tid = threadIdx.x; F.lane = F.tid & 63; F.wave = __builtin_amdgcn_readfirstlane(F.tid >> 6); F.G = gridDim.x; F.bid = blockIdx.x;
    unsigned char* ws = a.ws;
    const int lo = a.ph_lo, hi = a.ph_hi;
#if MK_N_LAUNCHES == 1
    volatile LAS unsigned* MISC = (volatile LAS unsigned*)(F.lds + 152 * 1024);
    if (F.tid < 4) MISC[F.tid] = 0u;
    __syncthreads();
    XcdBarrier xbar = xcd_barrier_post((unsigned*)(ws + WS_CTL) + CW_BAR, MISC);
#define SEAM(k) do { if (IN(k) && IN((k) + 1)) xcd_barrier(xbar); } while (0)
#else
#define SEAM(k) do { } while (0)
#endif
#define IN(k) (lo <= (k) && (k) < hi)
    LAS MoeTab* tab = (LAS MoeTab*)(F.lds + 144 * 1024);

#define RUNPH(k, ...) if (IN(k)) { F.lane = lane_now(); F.tid = F.wave * 64 + F.lane; __VA_ARGS__ }
    RUNPH(0, { phase0(F, a); }) SEAM(0);
    RUNPH(1, { phase1(F, a); __syncthreads(); dense_weight_convert(F, a); }) SEAM(1);
    RUNPH(2, {
        DenseOrder S{(const char*)(ws + WS_ACT), (const char*)(ws + WS_WIN), D, T / 256, INC / 256, F.G, F.bid};
        EpiInProj E{(bf16_t*)(ws + WS_PROJ), (bf16_t*)a.out, (float*)(ws + WS_DEC), (const float*)(ws + WS_SMALL) + 16, attn_body::C2};
        pg8::gemm_phase(F.lds, D, S, E);
    }) SEAM(2);
    RUNPH(3, {
        for (int g = F.bid; g < 256; g += F.G) hg::grp_local(F, a, g);
        __syncthreads();
        attn_phase(F, a);
    }) SEAM(3);
    RUNPH(4, { hg::grp_scan(F, a); attn_combine(F, a); }) SEAM(4);
    RUNPH(5, { for (int g = F.bid; g < 256; g += F.G) hg::grp_final(F, a, g); }) SEAM(5);
    RUNPH(6, {
        UpOrder S{(const char*)(ws + WS_YDA), (const char*)(ws + WS_YHG), (const char*)(ws + WS_WUPDA), (const char*)(ws + WS_WUPHG), F.G, F.bid};
        EpiUp E{(const bf16_t*)(ws + WS_PROJ), (bf16_t*)(ws + WS_ACT)};
        pg8::gemm_phase(F.lds, 512, S, E);
    }) SEAM(6);
    RUNPH(7, {
        DenseOrder S{(const char*)(ws + WS_ACT), (const char*)(ws + WS_WOUT), D, T / 256, D / 256, F.G, F.bid};
        EpiOut E{a.in[I_X], (const float*)(ws + WS_MOD), a.out};
        pg8::gemm_phase(F.lds, D, S, E);
        moe_weight_convert(F, a);
    }) SEAM(7);
    RUNPH(8, { phase_router(F, a); __syncthreads(); }) SEAM(8);
    RUNPH(9, {
        build_moe_tab(F, a, tab);
        unsigned* done = (unsigned*)(ws + WS_CTL) + CW_TILE;
        { Moe1Order S{tab, (const char*)(ws + WS_ACT), (const char*)(ws + WS_W13), (const int*)(ws + WS_TOKLIST), F.G, F.bid};
          EpiMoe1 E{(bf16_t*)(ws + WS_HS), done};
          pg8::gemm_phase(F.lds, D, S, E); }
        { Moe2Order S{tab, (const char*)(ws + WS_HS), (const char*)(ws + WS_W2), done, (unsigned*)(ws + WS_CTL) + CW_TMO, F.G, F.bid};
          EpiStoreBf16 E{(bf16_t*)(ws + WS_YS), D, 0, 1.0f};
          pg8::gemm_phase(F.lds, DEXP, S, E); }
    }) SEAM(9);
    RUNPH(10, { build_moe_tab(F, a, tab); phase_final(F, a, tab); })
#undef IN
#undef SEAM
}

extern "C" void kernel_launch(void* const* d_in, const int* in_sizes, int n_in, void* d_out, int out_size, void* d_ws, size_t ws_size, hipStream_t stream) {
    static int grid = 0;
    if (grid == 0) {
        if (n_in != 25 || in_sizes[0] != T * D || out_size != T * D || ws_size < WS_END) { fprintf(stderr, "kernel_launch: unexpected shapes (n_in %d, in0 %d, out %d, ws %zu)\n", n_in, n_in > 0 ? in_sizes[0] : -1, out_size, ws_size); grid = -1; return; }
        int dev = 0, cus = 0, per_cu = 0;
        if (hipGetDevice(&dev) != hipSuccess || hipDeviceGetAttribute(&cus, hipDeviceAttributeMultiprocessorCount, dev) != hipSuccess) { grid = -1; return; }
        if (hipFuncSetAttribute((const void*)mk_fwd, hipFuncAttributeMaxDynamicSharedMemorySize, LDS_BYTES) != hipSuccess) { fprintf(stderr, "kernel_launch: hipFuncSetAttribute failed\n"); grid = -1; return; }
        if (hipOccupancyMaxActiveBlocksPerMultiprocessor(&per_cu, (const void*)mk_fwd, NTHR, LDS_BYTES) != hipSuccess || per_cu < 1) { fprintf(stderr, "kernel_launch: occupancy query says %d\n", per_cu); per_cu = 1; }
        (void)hipGetLastError();
        grid = cus;
        if (grid > 256) grid = 256;
        while (T % grid) --grid;
    }
    if (grid < 0) return;
    (void)hipMemsetAsync((char*)d_ws + WS_CTL, 0, CTL_ZERO_BYTES, stream);
    Args a{};
    for (int i = 0; i < 25; ++i) a.in[i] = (const float*)d_in[i];
    a.out = (float*)d_out; a.ws = (unsigned char*)d_ws;
#if MK_N_LAUNCHES == 1
    a.ph_lo = 0; a.ph_hi = N_PHASES;
    void* args[] = {&a};
    hipError_t e = hipLaunchCooperativeKernel((const void*)mk_fwd, dim3(grid), dim3(NTHR), args, LDS_BYTES, stream);
    if (e != hipSuccess) fprintf(stderr, "cooperative launch failed: %s (grid %d)\n", hipGetErrorString(e), grid);
#else
    for (int p = 0; p < N_PHASES; ++p) {
        a.ph_lo = p; a.ph_hi = p + 1;
        hipLaunchKernelGGL(mk_fwd, dim3(grid), dim3(NTHR), LDS_BYTES, stream, a);
    }
#endif
}
```

```cpp
#include <hip/hip_runtime.h>
#include <cstdio>
#include <cstdint>

#ifndef MK_N_LAUNCHES
#define MK_N_LAUNCHES 1
#endif

#define LAS __attribute__((address_space(3)))
typedef unsigned short bf16_t;
typedef short bf16x8 __attribute__((ext_vector_type(8)));
typedef float f32x4 __attribute__((ext_vector_type(4)));
typedef float f32x2 __attribute__((ext_vector_type(2)));
typedef unsigned u32x4 __attribute__((ext_vector_type(4)));
typedef unsigned u32x2 __attribute__((ext_vector_type(2)));

constexpr int NB = 4, SEQ = 4096, D = 1024, T = NB * SEQ;
constexpr int INC = 5632;
constexpr int C_QDA = 0, C_KDA = 512, C_VDA = 1024, C_QHG = 1536, C_FHG = 2048, C_IHG = 2560, C_GHG = 3072, C_GDA = 3584, C_GHGATE = 4608;
constexpr int C_HGT = 1536;
constexpr int NEXP = 32, DEXP = 512;
constexpr int PMAX = 40960;
constexpr float EPS = 1e-6f;
constexpr int NWAVES = 8, NTHR = 512;

constexpr size_t MiB = 1u << 20;
constexpr size_t WS_CTL = 0, CTL_ZERO_BYTES = 64 * 1024;
constexpr size_t WS_MODP = 1 * MiB;
constexpr size_t WS_MOD = 5 * MiB / 2;
constexpr size_t WS_SMALL = 11 * MiB / 4;
constexpr size_t WS_TOKINFO = 3 * MiB;
constexpr size_t WS_TOKLIST = 4 * MiB;
constexpr size_t WS_DEC = 6 * MiB;
constexpr size_t WS_DS = 24 * MiB;
constexpr size_t WS_WIN = 8 * MiB;
constexpr size_t WS_WUPDA = 20 * MiB, WS_WUPHG = 21 * MiB, WS_WOUT = 22 * MiB;
constexpr size_t WS_ACT = 24 * MiB;
constexpr size_t WS_PROJ = 56 * MiB;
constexpr size_t WS_YDA = 232 * MiB, WS_YHG = 248 * MiB;
constexpr size_t WS_OA = 264 * MiB;
constexpr size_t WS_W13 = 56 * MiB;
constexpr size_t WS_W2 = 120 * MiB;
constexpr size_t WS_HS = 152 * MiB;
constexpr size_t WS_YS = 192 * MiB;
constexpr size_t WS_END = 296 * MiB;
constexpr int CW_COUNTS = 64;
constexpr int CW_BAR = 4096;
constexpr int CW_TILE = 8192;
constexpr int CW_TMO = 32;

constexpr int LDS_BYTES = 160 * 1024;

__device__ __forceinline__ float bf2f(unsigned v) { return __uint_as_float(v << 16); }
__device__ __forceinline__ unsigned f2bf(float f) { unsigned u = __float_as_uint(f); return (u + 0x7fffu + ((u >> 16) & 1u)) >> 16; }
__device__ __forceinline__ unsigned pk2(float lo, float hi) { return f2bf(lo) | (f2bf(hi) << 16); }
__device__ __forceinline__ float sigmoidf_(float x) { return 1.0f / (1.0f + __expf(-x)); }
__device__ __forceinline__ float siluf_(float x) { return x / (1.0f + __expf(-x)); }
__device__ __forceinline__ int lane_now() { int l; asm volatile("v_mbcnt_lo_u32_b32 %0, -1, 0\n\tv_mbcnt_hi_u32_b32 %0, -1, %0" : "=v"(l)); return l; }
__device__ __forceinline__ float wave_sum(float v) {
#pragma unroll
    for (int o = 1; o < 64; o <<= 1) v += __shfl_xor(v, o);
    return v;
}

namespace pg8 {
constexpr int BM = 256, BK = 64, HALF = 128, HTB = HALF * BK * 2, STAGE_BYTES = 8 * HTB;
__host__ __device__ __forceinline__ int lds_byte(int r, int c) { const int st = (r >> 4) * 2 + (c >> 5), rr = r & 15, cc = c & 31, ob = rr * 64 + cc * 2; return st * 1024 + (ob ^ (((ob >> 9) & 1) << 5)); }
__host__ __device__ __forceinline__ void stage_rc(int b, int& R, int& C) { const int st = b / 1024, sb = b % 1024, swz = sb ^ (((sb >> 9) & 1) << 5); R = (st >> 1) * 16 + swz / 64; C = (st & 1) * 32 + (swz % 64) / 2; }
__host__ __device__ __forceinline__ int perm32(int rho) { const int n = rho >> 4, i = rho & 15; return 8 * (i >> 2) + 4 * n + (i & 3); }

struct Unit { int pm, pn; const char* A; const char* B; int aux; };
__device__ __forceinline__ unsigned cvt_pk_bf16(float lo, float hi) { unsigned r; asm volatile("v_cvt_pk_bf16_f32 %0, %1, %2" : "=v"(r) : "v"(lo), "v"(hi)); return r; }

template <class Epi, class Sched>
__device__ __forceinline__ void gemm_phase(LAS unsigned char* lds, const int K, const Sched& S, const Epi& E) {
    const int tid = threadIdx.x, wid = __builtin_amdgcn_readfirstlane(tid >> 6), lane = tid & 63, wr = wid >> 2, wc = wid & 3, fr = lane & 15, fq = lane >> 4;
    const int nt = K / BK;
    unsigned voffB[2];
#define PG8_SETLANE() do { const int _l = lane_now(), _t = wid * 64 + _l; _Pragma("unroll") for (int _i = 0; _i < 2; ++_i) { int _R, _C; stage_rc(_t * 16 + _i * 8192, _R, _C); \
        const int _Rb = Epi::PERM ? ((_R & ~31) + perm32(_R & 31)) : _R; voffB[_i] = (unsigned)(_Rb * K + _C) * 2u; } \
        aoff = lds_byte(wr * 64 + (_l & 15), (_l >> 4) * 8); boff = lds_byte(wc * 32 + (_l & 15), (_l >> 4) * 8); } while (0)
    const size_t kstep = (size_t)(BK * 2);
    const size_t hstep = (size_t)HALF * K * 2;
    const unsigned ldsw = (unsigned)wid * 1024u;
    int aoff, boff; PG8_SETLANE();
#define PG8_SA(b, h) (((b) * 2 + (h)) * HTB)
#define PG8_SB(b, h) ((4 + (b) * 2 + (h)) * HTB)
#define PG8_STAGE(bufoff, gbase, voff) do { _Pragma("unroll") for (int _i = 0; _i < 2; ++_i) \
        __builtin_amdgcn_global_load_lds((const unsigned*)((const char*)(gbase) + (voff)[_i]), (LAS unsigned*)(lds + (bufoff) + ldsw + _i * 8192), 16, 0, 0); } while (0)
#define PG8_LDA(dst, b, h) do { _Pragma("unroll") for (int m = 0; m < 4; ++m) _Pragma("unroll") for (int k = 0; k < 2; ++k) dst[m][k] = *(const LAS bf16x8*)(lds + PG8_SA(b, h) + aoff + m * 2048 + k * 1024); } while (0)
#define PG8_LDB(dst, b, h) do { _Pragma("unroll") for (int n = 0; n < 2; ++n) _Pragma("unroll") for (int k = 0; k < 2; ++k) dst[n][k] = *(const LAS bf16x8*)(lds + PG8_SB(b, h) + boff + n * 2048 + k * 1024); } while (0)
#define PG8_MMA(ai, bj, At, Bt) do { __builtin_amdgcn_s_setprio(1); _Pragma("unroll") for (int m = 0; m < 4; ++m) _Pragma("unroll") for (int n = 0; n < 2; ++n) _Pragma("unroll") for (int k = 0; k < 2; ++k) \
        acc[ai][bj][m][n] = __builtin_amdgcn_mfma_f32_16x16x32_bf16(Bt[n][k], At[m][k], acc[ai][bj][m][n], 0, 0, 0); __builtin_amdgcn_s_setprio(0); } while (0)
#define PG8_WAIT_V(n) asm volatile("s_waitcnt vmcnt(" #n ")" ::: "memory")
#define PG8_WAIT_L(n) asm volatile("s_waitcnt lgkmcnt(" #n ")" ::: "memory")
#define PG8_BAR __builtin_amdgcn_s_barrier()
#define PG8_SCHED __builtin_amdgcn_sched_barrier(0)
#define PG8_SETA(vo, u) do { const int _t = wid * 64 + lane_now(); _Pragma("unroll") for (int _i = 0; _i < 2; ++_i) { int _R, _C; stage_rc(_t * 16 + _i * 8192, _R, _C); \
        _Pragma("unroll") for (int _h = 0; _h < 2; ++_h) vo[_h][_i] = (unsigned)((size_t)S.arow(u, _h * HALF + _R) * (size_t)K + _C) * 2u; } if (Sched::GATHER) PG8_WAIT_V(0); } while (0)
    Unit cur, nxt; int ui = 0;
    if (!S.next(0, cur)) return;
    f32x4 acc[2][2][4][2];
#pragma unroll
    for (int a = 0; a < 2; ++a)
#pragma unroll
        for (int b = 0; b < 2; ++b)
#pragma unroll
            for (int m = 0; m < 4; ++m)
#pragma unroll
                for (int n = 0; n < 2; ++n) acc[a][b][m][n] = (f32x4){0.f, 0.f, 0.f, 0.f};
    bf16x8 At[4][2], B0[2][2], B1[2][2];
    unsigned voC[2][2], voN[2][2];
    S.a_ready(cur);
    PG8_SETA(voC, cur);
    const char* cA = cur.A; const char* cB = cur.B;
    PG8_STAGE(PG8_SB(0, 0), cB, voffB); PG8_STAGE(PG8_SB(0, 1), cB + hstep, voffB); PG8_STAGE(PG8_SA(0, 0), cA, voC[0]); PG8_STAGE(PG8_SA(0, 1), cA, voC[1]);
    if (wr == 1) PG8_BAR;
    PG8_WAIT_V(2); PG8_BAR;
    PG8_STAGE(PG8_SB(1, 0), cB + kstep, voffB); PG8_STAGE(PG8_SA(1, 0), cA + kstep, voC[0]); PG8_STAGE(PG8_SB(1, 1), cB + hstep + kstep, voffB);
    PG8_WAIT_V(6); PG8_BAR;
    for (;;) {
        const bool has_next = S.next(ui + 1, nxt);
        if (has_next) { PG8_SETA(voN, nxt); }
        else {
#pragma unroll
            for (int h = 0; h < 2; ++h)
#pragma unroll
                for (int i = 0; i < 2; ++i) voN[h][i] = voC[h][i];
        }
        const char* nA = has_next ? nxt.A : cA; const char* nB = has_next ? nxt.B : cB;
        for (int t = 0; t < nt; t += 2) {
            const bool last = (t == nt - 2);
            if (last && has_next) S.a_ready(nxt);
            const char* a1 = cA + (size_t)(t + 1) * kstep;
            const char* a2 = last ? nA : cA + (size_t)(t + 2) * kstep; const char* b2 = last ? nB : cB + (size_t)(t + 2) * kstep;
            const char* a3 = a2 + kstep; const char* b3 = b2 + kstep;
            unsigned vo2[2][2];
#pragma unroll
            for (int h = 0; h < 2; ++h)
#pragma unroll
                for (int i = 0; i < 2; ++i) vo2[h][i] = last ? voN[h][i] : voC[h][i];
            PG8_LDB(B0, 0, 0); PG8_LDB(B1, 0, 1); PG8_SCHED; PG8_LDA(At, 0, 0); PG8_STAGE(PG8_SA(1, 1), a1, voC[1]);
            PG8_WAIT_V(8); PG8_WAIT_L(0); PG8_BAR; PG8_MMA(0, 0, At, B0); PG8_MMA(0, 1, At, B1); PG8_BAR; PG8_SCHED;
            PG8_LDA(At, 0, 1); PG8_STAGE(PG8_SB(0, 0), b2, voffB); PG8_STAGE(PG8_SB(0, 1), b2 + hstep, voffB); PG8_STAGE(PG8_SA(0, 0), a2, vo2[0]);
            PG8_WAIT_V(8); PG8_WAIT_L(0); PG8_BAR; PG8_MMA(1, 0, At, B0); PG8_MMA(1, 1, At, B1); PG8_BAR; PG8_SCHED;
            PG8_LDB(B0, 1, 0); PG8_LDB(B1, 1, 1); PG8_SCHED; PG8_LDA(At, 1, 0); PG8_STAGE(PG8_SA(0, 1), a2, vo2[1]);
            PG8_WAIT_V(8); PG8_WAIT_L(0); PG8_BAR; PG8_MMA(0, 0, At, B0); PG8_MMA(0, 1, At, B1); PG8_BAR; PG8_SCHED;
            PG8_LDA(At, 1, 1); PG8_STAGE(PG8_SB(1, 0), b3, voffB); PG8_STAGE(PG8_SB(1, 1), b3 + hstep, voffB); PG8_STAGE(PG8_SA(1, 0), a3, vo2[0]);
            PG8_WAIT_V(8); PG8_WAIT_L(0); PG8_BAR; PG8_MMA(1, 0, At, B0); PG8_MMA(1, 1, At, B1); PG8_BAR; PG8_SCHED;
        }
        if (wr == 0) PG8_BAR;
        const bool keep = E(acc, cur, wr, wc, fr, fq);
        if (!has_next) break;
        if (!keep) {
#pragma unroll
            for (int a = 0; a < 2; ++a)
#pragma unroll
                for (int b = 0; b < 2; ++b)
#pragma unroll
                    for (int m = 0; m < 4; ++m)
#pragma unroll
                        for (int n = 0; n < 2; ++n) acc[a][b][m][n] = (f32x4){0.f, 0.f, 0.f, 0.f};
        }
        cur = nxt; cA = nA; cB = nB; ++ui;
        if (Sched::GATHER) {
#pragma unroll
            for (int h = 0; h < 2; ++h)
#pragma unroll
                for (int i = 0; i < 2; ++i) voC[h][i] = voN[h][i];
        } else { PG8_SETA(voC, cur); }
        PG8_SETLANE();
        if (wr == 1) PG8_BAR;
    }
    PG8_WAIT_V(0);
    PG8_BAR;
#undef PG8_SA
#undef PG8_SB
#undef PG8_STAGE
#undef PG8_LDA
#undef PG8_LDB
#undef PG8_MMA
#undef PG8_WAIT_V
#undef PG8_WAIT_L
#undef PG8_BAR
#undef PG8_SCHED
#undef PG8_SETA
#undef PG8_SETLANE
}
}

struct Args { const float* in[25]; float* out; unsigned char* ws; int ph_lo, ph_hi; };
enum { I_X = 0, I_C, I_WADA, I_BADA, I_N1G, I_WIN, I_LQ1, I_LK1, I_LQ2, I_LK2, I_SUBG, I_LBL, I_HGNG, I_WUPDA, I_WUPHG, I_WOUT, I_N2G, I_WRG, I_BRG, I_WRE, I_BRE, I_W1, I_W3, I_W2, I_FG };

struct DenseOrder {
    static constexpr bool GATHER = false;
    const char* A; const char* Bt; int K, nM, nN, G, c;
    __device__ __forceinline__ bool next(int i, pg8::Unit& u) const {
        const int L = i * G + c, nwg = nM * nN; if (L >= nwg) return false;
        int wgid = L; { const int q = nwg / 8, r = nwg % 8, xcd = wgid % 8, off = wgid / 8; wgid = (xcd < r ? xcd * (q + 1) : r * (q + 1) + (xcd - r) * q) + off; }
        const int nig = 8 * nN, gid = wgid / nig, fm = gid * 8, gsz = (nM - fm) < 8 ? (nM - fm) : 8;
        u.pm = fm + ((wgid % nig) % gsz); u.pn = (wgid % nig) / gsz; u.A = A; u.B = Bt + (size_t)u.pn * 256 * K * 2; u.aux = 0; return true;
    }
    __device__ __forceinline__ void a_ready(const pg8::Unit&) const {}
    __device__ __forceinline__ unsigned arow(const pg8::Unit& u, int r) const { return (unsigned)(u.pm * 256 + r); }
};
struct UpOrder {
    static constexpr bool GATHER = false;
    const char* A0; const char* A1; const char* B0; const char* B1; int G, c;
    __device__ __forceinline__ bool next(int i, pg8::Unit& u) const {
        const int tile = (i >> 1) * G + c; if (tile >= 256) return false;
        u.pm = tile >> 2; u.pn = tile & 3; u.aux = i & 1;
        u.A = (i & 1) ? A1 : A0; u.B = ((i & 1) ? B1 : B0) + (size_t)u.pn * 256 * 512 * 2; return true;
    }
    __device__ __forceinline__ void a_ready(const pg8::Unit&) const {}
    __device__ __forceinline__ unsigned arow(const pg8::Unit& u, int r) const { return (unsigned)(u.pm * 256 + r); }
};
struct MoeTab { int nt; int pad[3]; int tile_e[176]; int tile_m[176]; int cnt[32]; int tbase[33]; };
struct Moe1Order {
    static constexpr bool GATHER = true;
    const LAS MoeTab* tab; const char* A; const char* W; const int* toklist; int G, c;
    __device__ __forceinline__ bool next(int i, pg8::Unit& u) const {
        const int L = i * G + c; if (L >= tab->nt * 4) return false;
        const int ti = L >> 2; u.pm = ti; u.pn = L & 3; u.aux = ti; u.A = A;
        u.B = W + ((size_t)tab->tile_e[ti] * 1024 + (size_t)u.pn * 256) * 1024 * 2; return true;
    }
    __device__ __forceinline__ void a_ready(const pg8::Unit&) const {}
    __device__ __forceinline__ unsigned arow(const pg8::Unit& u, int r) const {
        const int e = tab->tile_e[u.aux], rr = tab->tile_m[u.aux] * 256 + r;
        return rr < tab->cnt[e] ? (unsigned)toklist[e * T + rr] : 0u;
    }
};
struct Moe2Order {
    static constexpr bool GATHER = false;
    const LAS MoeTab* tab; const char* A; const char* W; unsigned* done; unsigned* tmo; int G, c;
    __device__ __forceinline__ bool next(int i, pg8::Unit& u) const {
        const int n1 = tab->nt * 4, r = n1 % G, nl = G - r; int j;
        if (r > 0 && c >= r) { if (i < 2) j = (c - r) + i * nl; else j = 2 * nl + (c - r) + (i - 2) * G; }
        else j = (r > 0 ? 2 * nl : 0) + ((c - r + G) % G) + i * G;
        if (j >= n1) return false;
        const int ti = j >> 2; u.pm = ti; u.pn = j & 3; u.aux = ti; u.A = A;
        u.B = W + ((size_t)tab->tile_e[ti] * 1024 + (size_t)u.pn * 256) * 512 * 2; return true;
    }
    __device__ __forceinline__ unsigned arow(const pg8::Unit& u, int r) const { return (unsigned)(u.pm * 256 + r); }
    __device__ __forceinline__ void a_ready(const pg8::Unit& u) const {
        if (threadIdx.x < 64) {
            unsigned polls = 0;
            while ((unsigned)__builtin_amdgcn_readfirstlane(__hip_atomic_load(done + 16 * u.pm, __ATOMIC_RELAXED, __HIP_MEMORY_SCOPE_AGENT)) < 32u) {
                if (++polls > (1u << 22)) { if (threadIdx.x == 0) __hip_atomic_store(tmo, 1u, __ATOMIC_RELAXED, __HIP_MEMORY_SCOPE_AGENT); break; }
                __builtin_amdgcn_s_sleep(2); }
            __builtin_amdgcn_fence(__ATOMIC_ACQUIRE, "agent");
            asm volatile("s_waitcnt vmcnt(0)" ::: "memory");
        }
        asm volatile("" ::: "memory"); __builtin_amdgcn_s_barrier(); asm volatile("" ::: "memory");
    }
};

using pg8::Unit; using pg8::cvt_pk_bf16;
struct EpiStoreBf16 {
    static constexpr bool PERM = true;
    bf16_t* O; int ldc; int nscale; float scale0;
    __device__ __forceinline__ bool operator()(f32x4 (&acc)[2][2][4][2], const Unit& u, int wr, int wc, int fr, int fq) const {
        const int row0 = u.pm * 256 + wr * 64 + fr, col0 = u.pn * 256 + wc * 32 + 8 * fq;
        const float sc = u.pn < nscale ? scale0 : 1.0f;
#pragma unroll
        for (int ai = 0; ai < 2; ++ai)
#pragma unroll
            for (int m = 0; m < 4; ++m) { bf16_t* rowp = O + (size_t)(row0 + ai * 128 + m * 16) * ldc + col0;
#pragma unroll
                for (int bj = 0; bj < 2; ++bj) { const f32x4 v0 = acc[ai][bj][m][0] * sc, v1 = acc[ai][bj][m][1] * sc;
                    u32x4 w; w.x = cvt_pk_bf16(v0[0], v0[1]); w.y = cvt_pk_bf16(v0[2], v0[3]); w.z = cvt_pk_bf16(v1[0], v1[1]); w.w = cvt_pk_bf16(v1[2], v1[3]);
                    *(u32x4*)(rowp + bj * 128) = w; } }
        return false;
    }
};
template <int N> __device__ __forceinline__ float dpp_shr(float x) { return __builtin_bit_cast(float, __builtin_amdgcn_update_dpp(0, __builtin_bit_cast(int, x), 0x110 + N, 0xf, 0xf, true)); }
__device__ __forceinline__ float scan16(float x) { x += dpp_shr<1>(x); x += dpp_shr<2>(x); x += dpp_shr<4>(x); x += dpp_shr<8>(x); return x; }
struct EpiInProj {
    static constexpr bool PERM = true;
    bf16_t* O; bf16_t* KE; float* DEC; const float* lbv; float scale0;
    __device__ __forceinline__ bool operator()(f32x4 (&acc)[2][2][4][2], const Unit& u, int wr, int wc, int fr, int fq) const {
        { const int l_ = lane_now(); fr = l_ & 15; fq = l_ >> 4; }
        const int row0 = u.pm * 256 + wr * 64 + fr, col0 = u.pn * 256 + wc * 32 + 8 * fq;
        if (u.pn >= 6 && u.pn < 10) {
            const int h = u.pn - 6, lane = 16 * fq + fr, kb = wc * 32 + 8 * fq, bsrc = (lane & 48) | 15;
            const int bb = (u.pm * 256) / SEQ, ch0 = ((u.pm * 256) % SEQ + wr * 64) >> 6;
#pragma unroll
            for (int ai = 0; ai < 2; ++ai) {
                unsigned kep[4][4];
#pragma unroll
                for (int n = 0; n < 2; ++n) {
#pragma unroll
                    for (int ep = 0; ep < 2; ++ep) {
                        float ke2[2][4];
#pragma unroll
                        for (int z = 0; z < 2; ++z) {
                            const int e = 2 * ep + z; const float lb = lbv[h * 128 + kb + 4 * n + e];
                            float f[4], c[4], tot[4];
#pragma unroll
                            for (int m = 0; m < 4; ++m) { const float fl = acc[ai][1][m][n][e]; f[m] = lb + (1.0f - lb) * __builtin_amdgcn_rcpf(1.0f + __builtin_amdgcn_exp2f(-1.4426950408889634f * fl)); c[m] = scan16(__logf(f[m])); }
#pragma unroll
                            for (int m = 0; m < 4; ++m) tot[m] = __shfl(c[m], bsrc);
                            const float alast = (tot[0] + tot[1]) + (tot[2] + tot[3]);
                            float pre = 0.f;
#pragma unroll
                            for (int m = 0; m < 4; ++m) { const float A = c[m] + pre; pre += tot[m]; const float q = acc[ai][0][m][n][e]; const float kk = 1.0f - f[m];
                                acc[ai][0][m][n][e] = q * __builtin_amdgcn_rcpf(1.0f + __builtin_amdgcn_exp2f(-1.4426950408889634f * q)) * __expf(A);
                                acc[ai][1][m][n][e] = kk * __expf(-A); ke2[z][m] = kk * __expf(alast - A); }
                            if (fr == 0) DEC[((size_t)(bb * 4 + h) * 64 + ch0 + 2 * ai) * 128 + kb + 4 * n + e] = __expf(alast);
                        }
#pragma unroll
                        for (int m = 0; m < 4; ++m) kep[m][2 * n + ep] = cvt_pk_bf16(ke2[0][m], ke2[1][m]);
                    }
                }
#pragma unroll
                for (int m = 0; m < 4; ++m) *(u32x4*)(KE + (size_t)(row0 + ai * 128 + m * 16) * 512 + h * 128 + kb) = (u32x4){kep[m][0], kep[m][1], kep[m][2], kep[m][3]};
            }
        }
        const float sc = u.pn < 2 ? scale0 : 1.0f;
#pragma unroll
        for (int ai = 0; ai < 2; ++ai)
#pragma unroll
            for (int m = 0; m < 4; ++m) { bf16_t* rowp = O + (size_t)(row0 + ai * 128 + m * 16) * INC + col0;
#pragma unroll
                for (int bj = 0; bj < 2; ++bj) { const f32x4 v0 = acc[ai][bj][m][0] * sc, v1 = acc[ai][bj][m][1] * sc;
                    u32x4 w; w.x = cvt_pk_bf16(v0[0], v0[1]); w.y = cvt_pk_bf16(v0[2], v0[3]); w.z = cvt_pk_bf16(v1[0], v1[1]); w.w = cvt_pk_bf16(v1[2], v1[3]);
                    *(u32x4*)(rowp + bj * 128) = w; } }
        return false;
    }
};
struct EpiUp {
    static constexpr bool PERM = true;
    const bf16_t* proj; bf16_t* O;
    __device__ __forceinline__ bool operator()(f32x4 (&acc)[2][2][4][2], const Unit& u, int wr, int wc, int fr, int fq) const {
        const int row0 = u.pm * 256 + wr * 64 + fr, col0 = u.pn * 256 + wc * 32 + 8 * fq;
#pragma unroll
        for (int ai = 0; ai < 2; ++ai)
#pragma unroll
            for (int m = 0; m < 4; ++m) { const size_t row = (size_t)(row0 + ai * 128 + m * 16);
#pragma unroll
                for (int bj = 0; bj < 2; ++bj) {
                    const int col = col0 + bj * 128;
                    const u32x4 gh = *(const u32x4*)(proj + row * INC + C_GHGATE + col);
                    float sh[8];
#pragma unroll
                    for (int j = 0; j < 4; ++j) { sh[2 * j] = 1.0f + __builtin_amdgcn_exp2f(-1.4426950408889634f * bf2f(gh[j] & 0xffffu)); sh[2 * j + 1] = 1.0f + __builtin_amdgcn_exp2f(-1.4426950408889634f * bf2f(gh[j] >> 16)); }
                    if (u.aux == 0) {
                        const u32x4 gd = *(const u32x4*)(proj + row * INC + C_GDA + col);
#pragma unroll
                        for (int j = 0; j < 4; ++j) {
                            const float d0 = 1.0f + __builtin_amdgcn_exp2f(-1.4426950408889634f * bf2f(gd[j] & 0xffffu)), d1 = 1.0f + __builtin_amdgcn_exp2f(-1.4426950408889634f * bf2f(gd[j] >> 16));
                            const float r0 = sh[2 * j] * __builtin_amdgcn_rcpf(d0), r1 = sh[2 * j + 1] * __builtin_amdgcn_rcpf(d1);
                            if (j < 2) { acc[ai][bj][m][0][2 * j] *= r0; acc[ai][bj][m][0][2 * j + 1] *= r1; }
                            else { acc[ai][bj][m][1][2 * j - 4] *= r0; acc[ai][bj][m][1][2 * j - 3] *= r1; }
                        }
                    } else {
                        const f32x4 v0 = acc[ai][bj][m][0], v1 = acc[ai][bj][m][1];
#pragma unroll
                        for (int j = 0; j < 8; ++j) sh[j] = __builtin_amdgcn_rcpf(sh[j]);
                        u32x4 w; w.x = cvt_pk_bf16(v0[0] * sh[0], v0[1] * sh[1]); w.y = cvt_pk_bf16(v0[2] * sh[2], v0[3] * sh[3]);
                        w.z = cvt_pk_bf16(v1[0] * sh[4], v1[1] * sh[5]); w.w = cvt_pk_bf16(v1[2] * sh[6], v1[3] * sh[7]);
                        *(u32x4*)(O + row * D + col) = w;
                    }
                } }
        return u.aux == 0;
    }
};
struct EpiOut {
    static constexpr bool PERM = false;
    const float* x; const float* mod; float* O;
    __device__ __forceinline__ bool operator()(f32x4 (&acc)[2][2][4][2], const Unit& u, int wr, int wc, int fr, int fq) const {
        const int row0 = u.pm * 256 + wr * 64 + fr, col0 = u.pn * 256 + wc * 32 + 4 * fq;
        const int b = (u.pm * 256) / SEQ;
        f32x4 gt[2][2];
#pragma unroll
        for (int bj = 0; bj < 2; ++bj)
#pragma unroll
            for (int n = 0; n < 2; ++n) gt[bj][n] = *(const f32x4*)(mod + b * 6144 + 2048 + col0 + bj * 128 + n * 16);
#pragma unroll
        for (int ai = 0; ai < 2; ++ai)
#pragma unroll
            for (int m = 0; m < 4; ++m) { const size_t off = (size_t)(row0 + ai * 128 + m * 16) * D + col0;
#pragma unroll
                for (int bj = 0; bj < 2; ++bj)
#pragma unroll
                    for (int n = 0; n < 2; ++n) { const f32x4 xv = *(const f32x4*)(x + off + bj * 128 + n * 16);
                        *(f32x4*)(O + off + bj * 128 + n * 16) = xv + gt[bj][n] * acc[ai][bj][m][n]; } }
        return false;
    }
};
struct EpiMoe1 {
    static constexpr bool PERM = true;
    bf16_t* O; unsigned* done;
    __device__ __forceinline__ bool operator()(f32x4 (&acc)[2][2][4][2], const Unit& u, int wr, int wc, int fr, int fq) const {
        const int row0 = u.pm * 256 + wr * 64 + fr, col0 = u.pn * 128 + wc * 32 + 8 * fq;
#pragma unroll
        for (int ai = 0; ai < 2; ++ai)
#pragma unroll
            for (int m = 0; m < 4; ++m) { bf16_t* rowp = O + (size_t)(row0 + ai * 128 + m * 16) * DEXP + col0;
                float h[8];
#pragma unroll
                for (int n = 0; n < 2; ++n)
#pragma unroll
                    for (int e = 0; e < 4; ++e) { const float x_ = acc[ai][0][m][n][e]; h[n * 4 + e] = x_ * __builtin_amdgcn_rcpf(1.0f + __builtin_amdgcn_exp2f(-1.4426950408889634f * x_)) * acc[ai][1][m][n][e]; }
                u32x4 w; w.x = cvt_pk_bf16(h[0], h[1]); w.y = cvt_pk_bf16(h[2], h[3]); w.z = cvt_pk_bf16(h[4], h[5]); w.w = cvt_pk_bf16(h[6], h[7]);
                asm volatile("global_store_dwordx4 %0, %1, off sc1\n\ts_nop 1" :: "v"(rowp), "v"(w) : "memory"); }
        asm volatile("s_waitcnt vmcnt(0)" ::: "memory");
        if ((threadIdx.x & 63) == 0) __hip_atomic_fetch_add(done + 16 * u.pm, 1u, __ATOMIC_RELAXED, __HIP_MEMORY_SCOPE_AGENT);
        return false;
    }
};

struct Frame { LAS unsigned char* lds; int tid, lane, wave, G, bid; };

__device__ __forceinline__ void transpose_item(const float* Wsrc, int ldw, bf16_t* dst, int ldd, LAS float* scr, int lane) {
#pragma unroll 8
    for (int i = 0; i < 32; ++i) { const int kk = 2 * i + (lane >> 5); scr[kk * 33 + (lane & 31)] = __builtin_nontemporal_load(Wsrc + (size_t)kk * ldw + (lane & 31)); }
    asm volatile("s_waitcnt lgkmcnt(0)" ::: "memory");
    const int c = lane & 7;
#pragma unroll
    for (int j = 0; j < 4; ++j) { const int n = (lane >> 3) + 8 * j; const LAS float* s = scr + (8 * c) * 33 + n;
        u32x4 o; o.x = pk2(s[0 * 33], s[1 * 33]); o.y = pk2(s[2 * 33], s[3 * 33]); o.z = pk2(s[4 * 33], s[5 * 33]); o.w = pk2(s[6 * 33], s[7 * 33]);
        *(u32x4*)(dst + (size_t)n * ldd + 8 * c) = o; }
    asm volatile("s_waitcnt lgkmcnt(0)" ::: "memory");
}
__device__ __forceinline__ void transpose_matrix(const Frame& F, const float* W, int K, int N, bf16_t* WT) {
    LAS float* scr = (LAS float*)(F.lds + F.wave * 8448);
    const int gw = F.bid * NWAVES + F.wave, NGW = F.G * NWAVES, nblk = N / 32, items = (K / 64) * nblk;
    for (int it = gw; it < items; it += NGW) { const int kb = it / nblk, nb = it % nblk;
        transpose_item(W + (size_t)(64 * kb) * N + 32 * nb, N, WT + (size_t)(32 * nb) * K + 64 * kb, K, scr, F.lane); }
}

__device__ __forceinline__ void phase0(const Frame& F, const Args& a) {
    unsigned char* ws = a.ws;
    {
        float* modp = (float*)(ws + WS_MODP);
        const float* c = a.in[I_C]; const float* wada = a.in[I_WADA];
        LAS float* cs = (LAS float*)(F.lds + 72 * 1024);
        for (int i = F.tid; i < 4 * D; i += NTHR) cs[i] = siluf_(c[i]);
        __syncthreads();
        for (int wt = F.bid + 256 * F.wave; wt < 384; wt += 256 * NWAVES) {
            if (F.G != 256) break;
            const int ks = wt / 24, jw = wt % 24, j = jw * 256 + F.lane * 4;
            f32x4 s[4] = {{0, 0, 0, 0}, {0, 0, 0, 0}, {0, 0, 0, 0}, {0, 0, 0, 0}};
#pragma unroll 8
            for (int k = ks * 64; k < ks * 64 + 64; ++k) {
                const f32x4 w = *(const f32x4*)(wada + (size_t)k * 6144 + j);
#pragma unroll
                for (int b = 0; b < 4; ++b) s[b] += w * cs[b * D + k];
            }
#pragma unroll
            for (int b = 0; b < 4; ++b) *(f32x4*)(modp + ((size_t)ks * 4 + b) * 6144 + j) = s[b];
        }
        if (F.G != 256) {
            const int gw = F.bid * NWAVES + F.wave, NGW = F.G * NWAVES;
            for (int wt = gw; wt < 384; wt += NGW) {
                const int ks = wt / 24, jw = wt % 24, j = jw * 256 + F.lane * 4;
                f32x4 s[4] = {{0, 0, 0, 0}, {0, 0, 0, 0}, {0, 0, 0, 0}, {0, 0, 0, 0}};
                for (int k = ks * 64; k < ks * 64 + 64; ++k) {
                    const f32x4 w = *(const f32x4*)(wada + (size_t)k * 6144 + j);
#pragma unroll
                    for (int b = 0; b < 4; ++b) { const float cv = siluf_(c[b * D + k]); s[b] += w * cv; }
                }
#pragma unroll
                for (int b = 0; b < 4; ++b) *(f32x4*)(modp + ((size_t)ks * 4 + b) * 6144 + j) = s[b];
            }
        }
    }
    if (F.bid == 0) {
        float* sm = (float*)(ws + WS_SMALL);
        if (F.tid == 0) {
            float s1 = 0.f, s2 = 0.f;
            for (int i = 0; i < 64; ++i) { s1 += a.in[I_LQ1][i] * a.in[I_LK1][i]; s2 += a.in[I_LQ2][i] * a.in[I_LK2][i]; }
            sm[0] = expf(s1) - expf(s2) + 0.2f;
        }
        { const float l0 = a.in[I_LBL][F.tid], l1 = a.in[I_LBL][512 + F.tid]; const float mx = fmaxf(l0, l1);
          const float e0 = expf(l0 - mx), e1 = expf(l1 - mx); sm[16 + F.tid] = e0 / (e0 + e1); }
    }
}
__device__ __forceinline__ void moe_weight_convert(const Frame& F, const Args& a) {
    LAS float* scr = (LAS float*)(F.lds + F.wave * 8448);
    const int gw = F.bid * NWAVES + F.wave, NGW = F.G * NWAVES;
    bf16_t* w13 = (bf16_t*)(a.ws + WS_W13); bf16_t* w2t = (bf16_t*)(a.ws + WS_W2);
    for (int it = gw; it < 2 * NEXP * 256; it += NGW) {
        const int which = it / (NEXP * 256), r = it % (NEXP * 256), e = r >> 8, kb = (r >> 4) & 15, nb = r & 15, n0 = 32 * nb;
        const float* W = a.in[which ? I_W3 : I_W1] + (size_t)e * 1024 * 512;
        const int drow = 256 * (n0 >> 7) + (which ? 128 : 0) + (n0 & 127);
        transpose_item(W + (size_t)(64 * kb) * 512 + n0, 512, w13 + ((size_t)e * 1024 + drow) * 1024 + 64 * kb, 1024, scr, F.lane);
    }
    for (int it = gw; it < NEXP * 256; it += NGW) {
        const int e = it >> 8, kb = (it >> 5) & 7, nb = it & 31;
        const float* W = a.in[I_W2] + (size_t)e * 512 * 1024;
        transpose_item(W + (size_t)(64 * kb) * 1024 + 32 * nb, 1024, w2t + ((size_t)e * 1024 + 32 * nb) * 512 + 64 * kb, 512, scr, F.lane);
    }
}

__device__ __forceinline__ void dense_weight_convert(const Frame& F, const Args& a) {
    unsigned char* ws = a.ws;
    {
        LAS float* scr = (LAS float*)(F.lds + F.wave * 8448);
        const int gw = F.bid * NWAVES + F.wave, NGW = F.G * NWAVES, nblk = INC / 32, items = (D / 64) * nblk;
        bf16_t* WT = (bf16_t*)(ws + WS_WIN);
        for (int it = gw; it < items; it += NGW) { const int kb = it / nblk, n0 = 32 * (it % nblk); int dr = n0;
            if (n0 >= C_QHG && n0 < C_FHG) dr = C_HGT + 256 * ((n0 - C_QHG) >> 7) + ((n0 - C_QHG) & 127);
            else if (n0 >= C_FHG && n0 < C_IHG) dr = C_HGT + 256 * ((n0 - C_FHG) >> 7) + 128 + ((n0 - C_FHG) & 127);
            transpose_item(a.in[I_WIN] + (size_t)(64 * kb) * INC + n0, INC, WT + (size_t)dr * D + 64 * kb, D, scr, F.lane); }
    }
    transpose_matrix(F, a.in[I_WUPDA], 512, D, (bf16_t*)(ws + WS_WUPDA));
    transpose_matrix(F, a.in[I_WUPHG], 512, D, (bf16_t*)(ws + WS_WUPHG));
    transpose_matrix(F, a.in[I_WOUT], D, D, (bf16_t*)(ws + WS_WOUT));
}
__device__ __forceinline__ void phase1(const Frame& F, const Args& a) {
    const float* modp = (const float*)(a.ws + WS_MODP); float* mod = (float*)(a.ws + WS_MOD);
    for (int i = F.bid * NTHR + F.tid; i < 4 * 6144; i += F.G * NTHR) {
        float s = a.in[I_BADA][i % 6144];
        for (int ks = 0; ks < 16; ++ks) s += modp[(size_t)ks * 4 * 6144 + i];
        mod[i] = s;
    }
    LAS float* Gs = (LAS float*)F.lds;
    LAS float* Ss = Gs + 1024;
    bf16_t* H = (bf16_t*)(a.ws + WS_ACT);
    const int rows_per_blk = T / F.G;
    const int r0 = F.bid * rows_per_blk, b = r0 / SEQ;
    for (int k = F.tid; k < 1024; k += NTHR) {
        float sh = a.in[I_BADA][k], sc = a.in[I_BADA][1024 + k];
        for (int ks = 0; ks < 16; ++ks) { sh += modp[((size_t)ks * 4 + b) * 6144 + k]; sc += modp[((size_t)ks * 4 + b) * 6144 + 1024 + k]; }
        Gs[k] = a.in[I_N1G][k] * (1.0f + sc); Ss[k] = sh;
    }
    __syncthreads();
    for (int r = r0 + F.wave; r < r0 + rows_per_blk; r += NWAVES) {
        const f32x4* xr = (const f32x4*)(a.in[I_X] + (size_t)r * D) + F.lane;
        f32x4 v[4]; float s = 0.f;
#pragma unroll
        for (int j = 0; j < 4; ++j) { v[j] = xr[64 * j]; s += (v[j].x * v[j].x + v[j].y * v[j].y) + (v[j].z * v[j].z + v[j].w * v[j].w); }
        const float rs = rsqrtf(wave_sum(s) * (1.0f / D) + EPS);
        unsigned long long* o8 = (unsigned long long*)(H + (size_t)r * D) + F.lane;
#pragma unroll
        for (int j = 0; j < 4; ++j) { const f32x4 g = *(const LAS f32x4*)(Gs + 256 * j + 4 * F.lane), sh = *(const LAS f32x4*)(Ss + 256 * j + 4 * F.lane);
            const f32x4 h = v[j] * rs * g + sh;
            o8[64 * j] = (unsigned long long)pk2(h.x, h.y) | ((unsigned long long)pk2(h.z, h.w) << 32); }
    }
}

namespace attn_body {
using s16x4=__attribute__((ext_vector_type(4)))short;
using f32x16=__attribute__((ext_vector_type(16)))float;
constexpr int NW=8,QBLK=32,QB=QBLK*NW,KVBLK=64,NQB=SEQ/QB;
constexpr int PIN=INC, POUT=1024;
__device__ __forceinline__ int crow(int r,int hi){return (r&3)+8*(r>>2)+4*hi;}
#define SBAR() __builtin_amdgcn_sched_barrier(0)
__device__ __forceinline__ void bmask(f32x16&p0,f32x16&p1,int jb,int wch,int il,int hi,float s2x2){
  if(jb>wch){
    #pragma unroll
    for(int r=0;r<16;++r){p0[r]=-INFINITY;p1[r]=-INFINITY;}
  } else if(jb==wch){
    float fb=(float)(4*hi-il); asm volatile("":"+v"(fb));
    #pragma unroll
    for(int r=0;r<16;++r){const float c=(float)((r&3)+8*(r>>2)); p0[r]-=s2x2*__builtin_fmaxf(fb+c,0.f); p1[r]-=s2x2*__builtin_fmaxf(fb+(c+32.f),0.f);}
  }
}
constexpr int NSLOT=3, SLOTB=8192, VSLOTB=16384;
constexpr int LDS_K=0, LDS_V=NSLOT*SLOTB, LDS_WS=LDS_V+NSLOT*VSLOTB, LDS_OST=LDS_WS+NW*64*4, ATT_LDS_BYTES=LDS_OST+NW*8192;
constexpr float C2=0.125f*1.4426950408889634f;
__device__ __forceinline__ void glds16(const void*gsrc,unsigned lds_dst){unsigned keep;
  asm volatile("s_mov_b32 %0, m0\n\ts_mov_b32 m0, %2\n\ts_nop 0\n\tglobal_load_lds_dwordx4 %1, off\n\ts_mov_b32 m0, %0":"=&s"(keep):"v"(gsrc),"s"(lds_dst):"memory");}
__device__ __forceinline__ float max3f(float a,float b,float c){float r;asm("v_max3_f32 %0, %1, %2, %3":"=v"(r):"v"(a),"v"(b),"v"(c));return r;}
__device__ __forceinline__ float max2f(float a,float b){float r;asm("v_max_f32_e32 %0, %1, %2":"=v"(r):"v"(a),"v"(b));return r;}
__device__ __forceinline__ float fadd_s(float a,float b){float r;asm("v_add_f32_e32 %0, %1, %2":"=v"(r):"v"(a),"v"(b));return r;}
__device__ __forceinline__ float fsub_s(float a,float b){float r;asm("v_sub_f32_e32 %0, %1, %2":"=v"(r):"v"(a),"v"(b));return r;}
typedef float f32x2_t __attribute__((ext_vector_type(2))); typedef __bf16 bf16x2_t __attribute__((ext_vector_type(2)));
__device__ __forceinline__ unsigned cvtpk_s(float lo,float hi){f32x2_t v={lo,hi};bf16x2_t b=__builtin_convertvector(v,bf16x2_t);return __builtin_bit_cast(unsigned,b);}
#define WAIT_BAR(N) asm volatile("s_waitcnt vmcnt(" #N ") lgkmcnt(0)\n\ts_barrier":::"memory")

__device__ __forceinline__ void qkt(f32x16&p0,f32x16&p1,const char*Kslot,const bf16x8*qr,const f32x16&c0,const f32x16&c1,int r32,int hi){
  const char*kb=Kslot+hi*1024+r32*16;
  #pragma unroll
  for(int d0=0;d0<4;++d0){
    const bf16x8 b0=*reinterpret_cast<const bf16x8*>(kb+d0*2048);
    const bf16x8 b1=*reinterpret_cast<const bf16x8*>(kb+d0*2048+512);
    if(d0==0){p0=__builtin_amdgcn_mfma_f32_32x32x16_bf16(b0,qr[0],c0,0,0,0);p1=__builtin_amdgcn_mfma_f32_32x32x16_bf16(b1,qr[0],c1,0,0,0);}
    else{p0=__builtin_amdgcn_mfma_f32_32x32x16_bf16(b0,qr[d0],p0,0,0,0);p1=__builtin_amdgcn_mfma_f32_32x32x16_bf16(b1,qr[d0],p1,0,0,0);}}
}
typedef __attribute__((address_space(3))) const char* lds_cptr;
typedef short v4i16_t __attribute__((ext_vector_type(4)));
__device__ __forceinline__ void kload8(bf16x8*kf,lds_cptr kp){
  kf[0]=*(const __attribute__((address_space(3))) bf16x8*)(kp);      kf[1]=*(const __attribute__((address_space(3))) bf16x8*)(kp+512);
  kf[2]=*(const __attribute__((address_space(3))) bf16x8*)(kp+2048); kf[3]=*(const __attribute__((address_space(3))) bf16x8*)(kp+2560);
  kf[4]=*(const __attribute__((address_space(3))) bf16x8*)(kp+4096); kf[5]=*(const __attribute__((address_space(3))) bf16x8*)(kp+4608);
  kf[6]=*(const __attribute__((address_space(3))) bf16x8*)(kp+6144); kf[7]=*(const __attribute__((address_space(3))) bf16x8*)(kp+6656);
}
__device__ __forceinline__ void kload2(bf16x8*kf,lds_cptr kp,int j){ kf[2*j]=*(const __attribute__((address_space(3))) bf16x8*)(kp+j*2048); kf[2*j+1]=*(const __attribute__((address_space(3))) bf16x8*)(kp+j*2048+512); }
__device__ __forceinline__ s16x4 vtr(lds_cptr p){ return __builtin_bit_cast(s16x4,__builtin_amdgcn_ds_read_tr16_b64_v4i16((__attribute__((address_space(3))) v4i16_t*)p)); }
__device__ __forceinline__ float rowmax(const f32x16&p0,const f32x16&p1){
  float a=max3f(p0[0],p0[1],p1[0]),b=max3f(p0[2],p0[3],p1[1]);a=max3f(a,p1[2],p1[3]);
  #pragma unroll
  for(int r=4;r<16;r+=4){a=max3f(a,p0[r],p0[r+1]);b=max3f(b,p0[r+2],p0[r+3]);a=max3f(a,p1[r],p1[r+1]);b=max3f(b,p1[r+2],p1[r+3]);}
  const float m=max2f(a,b);
  auto rr=__builtin_amdgcn_permlane32_swap(__float_as_uint(m),__float_as_uint(m),false,false);
  return max2f(__uint_as_float(rr[0]),__uint_as_float(rr[1]));
}
__device__ __forceinline__ void pv(f32x16*o,int vb,bf16x8 pa0,bf16x8 pa1,bf16x8 pa2,bf16x8 pa3){
  #pragma unroll
  for(int d0=0;d0<4;++d0){s16x4 lo[4],hi[4];
    #pragma unroll
    for(int ks=0;ks<4;++ks){
      asm volatile("ds_read_b64_tr_b16 %0,%1 offset:%c2":"=&v"(lo[ks]):"v"(vb),"i"(d0*4096+ks*1024):"memory");
      asm volatile("ds_read_b64_tr_b16 %0,%1 offset:%c2":"=&v"(hi[ks]):"v"(vb),"i"(d0*4096+ks*1024+512):"memory");}
    asm volatile("s_waitcnt lgkmcnt(0)":::"memory");SBAR();
    #define PK(k) (bf16x8){lo[k][0],lo[k][1],lo[k][2],lo[k][3],hi[k][0],hi[k][1],hi[k][2],hi[k][3]}
    o[d0]=__builtin_amdgcn_mfma_f32_32x32x16_bf16(pa0,PK(0),o[d0],0,0,0);
    o[d0]=__builtin_amdgcn_mfma_f32_32x32x16_bf16(pa1,PK(1),o[d0],0,0,0);
    o[d0]=__builtin_amdgcn_mfma_f32_32x32x16_bf16(pa2,PK(2),o[d0],0,0,0);
    o[d0]=__builtin_amdgcn_mfma_f32_32x32x16_bf16(pa3,PK(3),o[d0],0,0,0);
    #undef PK
  }
}
#define ATTN_STORE16(p,v) (*(u32x4*)(p)=(v))
template<int THRL> __device__ __forceinline__ void attn_unit(int qb,const bf16_t*Qb,const bf16_t*__restrict__ Kh,const bf16_t*__restrict__ Vh,bf16_t*Ob,float slope2,char*shm){
  const int wid=__builtin_amdgcn_readfirstlane(threadIdx.x>>6); const int lane=lane_now(),r32=lane&31,hi=lane>>5;
  const int q0=qb*QB;
  const bf16_t*Qw=Qb+(long)(q0+wid*QBLK)*PIN;
  const unsigned lds0=(unsigned)(uintptr_t)shm;
  float*wsf=(float*)(shm+LDS_WS)+wid*64;
  const bf16_t*ksrc=Kh+(long)lane*PIN+wid*8;
  const bf16_t*vsrc=Vh+(long)(16*(wid&3)+(lane>>2))*PIN+(wid>>2)*32+(lane&3)*8;
  const unsigned kdst=lds0+LDS_K+wid*1024, vdst=lds0+LDS_V+(wid>>2)*4096+(wid&3)*1024;
  #define DMA_K(t,slot) glds16(ksrc+(long)(t)*KVBLK*PIN,(unsigned)__builtin_amdgcn_readfirstlane(kdst+(slot)))
  #define DMA_V(t,slot) do{ glds16(vsrc+(long)(t)*KVBLK*PIN,(unsigned)__builtin_amdgcn_readfirstlane(vdst+2*(slot))); glds16(vsrc+(long)(t)*KVBLK*PIN+64,(unsigned)__builtin_amdgcn_readfirstlane(vdst+2*(slot)+8192)); }while(0)
  const int vb0=(int)(lds0+LDS_V)+((lane>>4)&1)*32+(lane&3)*8+(4*hi+((lane&15)>>2))*64;
  const char*Kbase=shm+LDS_K; bf16x8 kf[8];
  const lds_cptr shm3=(lds_cptr)shm; const lds_cptr kp0=shm3+LDS_K+hi*1024+r32*16; const lds_cptr vp0=shm3+LDS_V+((lane>>4)&1)*32+(lane&3)*8+(4*hi+((lane&15)>>2))*64;
  const int NT=(q0+QB)/KVBLK;
  DMA_K(0,0);DMA_V(0,0);DMA_K(1,SLOTB);
  bf16x8 qr[4];
  #pragma unroll
  for(int d0=0;d0<4;++d0)qr[d0]=*reinterpret_cast<const bf16x8*>(&Qw[(long)r32*PIN+d0*16+hi*8]);
  float mhat=0.f,l_reg=0.f;f32x16 o[4];o[0]=f32x16{};o[1]=f32x16{};o[2]=f32x16{};o[3]=f32x16{};
  const float s64=slope2*64.f, s32=slope2*32.f, s2x2=2.f*slope2, s4hi=slope2*4.f*(float)hi;
  const int wch=wid>>1, il=32*(wid&1)+r32;
  #define CMASK(P0,P1,t) do{int jb_=(t)-(NT-4); if(jb_>=0)bmask(P0,P1,jb_,wch,il,hi,s2x2);}while(0)
  #define CINIT0(C0,t) do{ const float bt_=s64*(float)((t)-NT)-mhat+s4hi; _Pragma("unroll") for(int r=0;r<16;++r){C0[r]=__builtin_fmaf(slope2,(float)((r&3)+8*(r>>2)),bt_);} }while(0)
  #define CINIT1(C1,t) do{ const float bu_=s64*(float)((t)-NT)-mhat+s4hi+s32; _Pragma("unroll") for(int r=0;r<16;++r){C1[r]=__builtin_fmaf(slope2,(float)((r&3)+8*(r>>2)),bu_);} }while(0)
  bool resc=false;
  #define START(P0,P1) do{ const float rm=rowmax(P0,P1); resc=false; \
    { const float dl=rm; mhat=fadd_s(mhat,dl); \
      _Pragma("unroll") for(int r=0;r<16;++r){P0[r]=fsub_s(P0[r],dl);P1[r]=fsub_s(P1[r],dl);} } \
    _Pragma("unroll") for(int r=0;r<16;++r)P0[r]=__builtin_amdgcn_exp2f(P0[r]); }while(0)
  #define RESC() do{ if(resc){ asm volatile("s_waitcnt lgkmcnt(0)":::"memory"); \
      _Pragma("unroll") for(int d_=0;d_<4;++d_) _Pragma("unroll") for(int r=0;r<16;++r)o[d_][r]*=wsf[crow(r,hi)]; } }while(0)
  f32x16 cS0,cS1;
  u32x4 pwa0,pwa1,pwa2,pwa3,pwb0,pwb1,pwb2,pwb3;
  int sl_prev=0,sl_cur=0,sl_next=SLOTB;
  #define ROT() do{sl_prev=sl_cur;sl_cur=sl_next;sl_next=(sl_next==(NSLOT-1)*SLOTB)?0:sl_next+SLOTB;}while(0)
  #define PKW(P,B) cvtpk_s(P[B],P[B+1])
  DMA_K(2,2*SLOTB);
  WAIT_BAR(3);
  { f32x16 c0,c1; CINIT0(c0,0); CINIT1(c1,0); qkt(cS0,cS1,Kbase,qr,c0,c1,r32,hi); }
  asm volatile("s_nop 15\n\ts_nop 7":"+v"(cS0),"+v"(cS1));CMASK(cS0,cS1,0);
  START(cS0,cS1);
  _Pragma("unroll") for(int r=0;r<16;++r)cS1[r]=__builtin_amdgcn_exp2f(cS1[r]);
  { float sacc=cS0[0]+cS0[1]; _Pragma("unroll") for(int r=2;r<16;++r)sacc+=cS0[r]; _Pragma("unroll") for(int r=0;r<16;++r)sacc+=cS1[r]; l_reg+=sacc;
    pwa0=(u32x4){PKW(cS0,0),PKW(cS0,2),PKW(cS0,4),PKW(cS0,6)};pwa1=(u32x4){PKW(cS0,8),PKW(cS0,10),PKW(cS0,12),PKW(cS0,14)};pwa2=(u32x4){PKW(cS1,0),PKW(cS1,2),PKW(cS1,4),PKW(cS1,6)};pwa3=(u32x4){PKW(cS1,8),PKW(cS1,10),PKW(cS1,12),PKW(cS1,14)}; }
  WAIT_BAR(0);
  DMA_K(3,0);DMA_V(1,SLOTB);
  ROT();
  kload8(kf,kp0+sl_cur);
  WAIT_BAR(3);
  s16x4 vlo[4],vhi[4];
  #define CAT_(a,b) a##b
  #define CAT(a,b) CAT_(a,b)
  #define PAFC(P,k) __builtin_bit_cast(bf16x8,CAT(P,k))
  #define VFR(k) (bf16x8){vlo[(k)&3][0],vlo[(k)&3][1],vlo[(k)&3][2],vlo[(k)&3][3],vhi[(k)&3][0],vhi[(k)&3][1],vhi[(k)&3][2],vhi[(k)&3][3]}
  #define VOFF(k) ((k)<8 ? (((k)&1)*4096+((k)>>1)*1024) : ((2+((k)&1))*4096+(((k)-8)>>1)*1024))
  #define PIN_(x) asm volatile("":"+v"(x))
  #define MX3(a,b,c) __builtin_fmaxf(__builtin_fmaxf((a),(b)),(c))
  #define QK(MF) do{ MF; SBAR(); }while(0)
  #define EX(v) __builtin_amdgcn_exp2f(v)
  #define VRD(k) do{ vlo[(k)&3]=vtr(vp_+VOFF(k)); vhi[(k)&3]=vtr(vp_+(VOFF(k)+512)); }while(0)
  #define VNX(k) do{ if((k)+4<16){ VRD((k)+4); } SBAR(); }while(0)
  #define GAPB3(MF,X,B,PW,J) do{ MF; X[B]=EX(X[B]); X[B+1]=EX(X[B+1]); sacc+=X[B]; sacc+=X[B+1]; PW[J]=cvtpk_s(X[B],X[B+1]); PIN_(X); PIN_(sacc); PIN_(PW); SBAR(); }while(0)
  #define KRD(G,j) do{ if(G){ kload2(kf,kp0+sl_next,j); SBAR(); } }while(0)
  #define STEP(PC,PN,t,GK,GV,GL) do{ SBAR(); \
    CINIT0(cS0,t); SBAR(); \
    const lds_cptr vp_=vp0+2*sl_prev; \
    VRD(0); SBAR(); QK(cS0=__builtin_amdgcn_mfma_f32_32x32x16_bf16(kf[0],qr[0],cS0,0,0,0)); \
    CINIT1(cS1,t); VRD(1); SBAR(); QK(cS1=__builtin_amdgcn_mfma_f32_32x32x16_bf16(kf[1],qr[0],cS1,0,0,0)); \
    VRD(2); SBAR(); QK(cS0=__builtin_amdgcn_mfma_f32_32x32x16_bf16(kf[2],qr[1],cS0,0,0,0)); \
    VRD(3); SBAR(); QK(cS1=__builtin_amdgcn_mfma_f32_32x32x16_bf16(kf[3],qr[1],cS1,0,0,0)); \
    QK(cS0=__builtin_amdgcn_mfma_f32_32x32x16_bf16(kf[4],qr[2],cS0,0,0,0)); \
    QK(cS1=__builtin_amdgcn_mfma_f32_32x32x16_bf16(kf[5],qr[2],cS1,0,0,0)); \
    QK(cS0=__builtin_amdgcn_mfma_f32_32x32x16_bf16(kf[6],qr[3],cS0,0,0,0)); \
    QK(cS1=__builtin_amdgcn_mfma_f32_32x32x16_bf16(kf[7],qr[3],cS1,0,0,0)); \
    if(GK){DMA_K((t)+3,sl_cur);} if(GV){DMA_V((t)+1,sl_next);} \
    CMASK(cS0,cS1,t); \
    { float a=MX3(cS0[0],cS0[1],cS1[0]),b=MX3(cS0[2],cS0[3],cS1[1]); a=MX3(a,cS1[2],cS1[3]); \
      _Pragma("unroll") for(int r=4;r<16;r+=4){a=MX3(a,cS0[r],cS0[r+1]);b=MX3(b,cS0[r+2],cS0[r+3]);a=MX3(a,cS1[r],cS1[r+1]);b=MX3(b,cS1[r+2],cS1[r+3]);} \
      float rm=__builtin_fmaxf(a,b); { auto rr=__builtin_amdgcn_permlane32_swap(__float_as_uint(rm),__float_as_uint(rm),false,false); rm=__builtin_fmaxf(__uint_as_float(rr[0]),__uint_as_float(rr[1])); } \
      resc=false; \
      if(__builtin_expect(__any(rm>(float)THRL),0)){ const float dl=__builtin_fmaxf(rm,0.f); mhat+=dl; \
        _Pragma("unroll") for(int r=0;r<16;++r){cS0[r]-=dl;cS1[r]-=dl;} \
        const float f=__builtin_amdgcn_exp2f(-dl); l_reg*=f; if(hi==0)wsf[r32]=f; resc=true; } } \
    SBAR(); float sacc=0.f; \
    GAPB3(o[0]=__builtin_amdgcn_mfma_f32_32x32x16_bf16(PAFC(PC,0),VFR(0),o[0],0,0,0), cS0,0, CAT(PN,0),0); VNX(0); \
    GAPB3(o[1]=__builtin_amdgcn_mfma_f32_32x32x16_bf16(PAFC(PC,0),VFR(1),o[1],0,0,0), cS0,2, CAT(PN,0),1); VNX(1); \
    KRD(GL,0); GAPB3(o[0]=__builtin_amdgcn_mfma_f32_32x32x16_bf16(PAFC(PC,1),VFR(2),o[0],0,0,0), cS0,4, CAT(PN,0),2); VNX(2); \
    KRD(GL,1); GAPB3(o[1]=__builtin_amdgcn_mfma_f32_32x32x16_bf16(PAFC(PC,1),VFR(3),o[1],0,0,0), cS0,6, CAT(PN,0),3); VNX(3); \
    KRD(GL,2); GAPB3(o[0]=__builtin_amdgcn_mfma_f32_32x32x16_bf16(PAFC(PC,2),VFR(4),o[0],0,0,0), cS0,8, CAT(PN,1),0); VNX(4); \
    KRD(GL,3); GAPB3(o[1]=__builtin_amdgcn_mfma_f32_32x32x16_bf16(PAFC(PC,2),VFR(5),o[1],0,0,0), cS0,10, CAT(PN,1),1); VNX(5); \
    GAPB3(o[0]=__builtin_amdgcn_mfma_f32_32x32x16_bf16(PAFC(PC,3),VFR(6),o[0],0,0,0), cS0,12, CAT(PN,1),2); VNX(6); \
    GAPB3(o[1]=__builtin_amdgcn_mfma_f32_32x32x16_bf16(PAFC(PC,3),VFR(7),o[1],0,0,0), cS0,14, CAT(PN,1),3); VNX(7); \
    GAPB3(o[2]=__builtin_amdgcn_mfma_f32_32x32x16_bf16(PAFC(PC,0),VFR(8),o[2],0,0,0), cS1,0, CAT(PN,2),0); VNX(8); \
    GAPB3(o[3]=__builtin_amdgcn_mfma_f32_32x32x16_bf16(PAFC(PC,0),VFR(9),o[3],0,0,0), cS1,2, CAT(PN,2),1); VNX(9); \
    GAPB3(o[2]=__builtin_amdgcn_mfma_f32_32x32x16_bf16(PAFC(PC,1),VFR(10),o[2],0,0,0), cS1,4, CAT(PN,2),2); VNX(10); \
    GAPB3(o[3]=__builtin_amdgcn_mfma_f32_32x32x16_bf16(PAFC(PC,1),VFR(11),o[3],0,0,0), cS1,6, CAT(PN,2),3); VNX(11); \
    GAPB3(o[2]=__builtin_amdgcn_mfma_f32_32x32x16_bf16(PAFC(PC,2),VFR(12),o[2],0,0,0), cS1,8, CAT(PN,3),0); VNX(12); \
    GAPB3(o[3]=__builtin_amdgcn_mfma_f32_32x32x16_bf16(PAFC(PC,2),VFR(13),o[3],0,0,0), cS1,10, CAT(PN,3),1); VNX(13); \
    GAPB3(o[2]=__builtin_amdgcn_mfma_f32_32x32x16_bf16(PAFC(PC,3),VFR(14),o[2],0,0,0), cS1,12, CAT(PN,3),2); VNX(14); \
    GAPB3(o[3]=__builtin_amdgcn_mfma_f32_32x32x16_bf16(PAFC(PC,3),VFR(15),o[3],0,0,0), cS1,14, CAT(PN,3),3); VNX(15); \
    l_reg+=sacc; \
    }while(0)
  int t=1;
  #undef CMASK
  #define CMASK(P0,P1,t) do{}while(0)
  for(;t+5<NT;t+=2){
    STEP(pwa,pwb,t,true,true,true);     WAIT_BAR(3); RESC(); ROT();
    STEP(pwb,pwa,t+1,true,true,true);   WAIT_BAR(3); RESC(); ROT();
  }
  #undef CMASK
  #define CMASK(P0,P1,t) do{int jb_=(t)-(NT-4); if(jb_>=0)bmask(P0,P1,jb_,wch,il,hi,s2x2);}while(0)
  #define ENDW(tt) do{ if((tt)+3<NT){WAIT_BAR(3);} else if((tt)+2<NT){WAIT_BAR(2);} else {WAIT_BAR(0);} }while(0)
  for(;t+1<NT;t+=2){
    STEP(pwa,pwb,t,(t+3<NT),(t+1<NT),(t+1<NT));       ENDW(t);   RESC(); ROT();
    STEP(pwb,pwa,t+1,(t+4<NT),(t+2<NT),(t+2<NT));     ENDW(t+1); RESC(); ROT();
  }
  STEP(pwa,pwb,NT-1,false,false,false); RESC();
  SBAR(); pv(o,vb0+2*sl_cur,PAFC(pwb,0),PAFC(pwb,1),PAFC(pwb,2),PAFC(pwb,3));
  #undef PKW
  #undef PAFC
  #undef CAT
  #undef CAT_
  #undef QK
  #undef GAPB3
  #undef VFR
  #undef PIN_
  #undef MX3
  #undef EX
  #undef VRD
  #undef VNX
  #undef VOFF
  #undef GAPB2
  #undef KRD
  #undef STEP
  #undef ENDW
  {auto rr=__builtin_amdgcn_permlane32_swap(__float_as_uint(l_reg),__float_as_uint(l_reg),false,false);l_reg=__uint_as_float(rr[0])+__uint_as_float(rr[1]);}
  {
    const int le=lane_now(), r32e=le&31, hie=le>>5;
    float*wsfe=(float*)(shm+LDS_WS)+wid*64;
    if(hie==0)wsfe[32+r32e]=l_reg;asm volatile("s_waitcnt lgkmcnt(0)":::"memory");
    float rli[16];
    #pragma unroll
    for(int r=0;r<16;++r)rli[r]=__builtin_amdgcn_rcpf(wsfe[32+crow(r,hie)]);
    bf16_t*Ow=Ob+(long)(q0+wid*QBLK)*POUT;
    bf16_t*stg=(bf16_t*)(shm+LDS_OST)+wid*4096;
    #pragma unroll
    for(int r=0;r<16;++r){const int orow=crow(r,hie);
      #pragma unroll
      for(int d0=0;d0<4;++d0)stg[orow*128+d0*32+r32e]=(bf16_t)f2bf(o[d0][r]*rli[r]);}
    asm volatile("s_waitcnt lgkmcnt(0)":::"memory");
    #pragma unroll
    for(int i=0;i<8;++i){const int row=i*4+(le>>4),ch=le&15; const u32x4 v=*(const u32x4*)(stg+row*128+ch*8); ATTN_STORE16(Ow+(long)row*POUT+ch*8,v);} }
  asm volatile("s_waitcnt lgkmcnt(0)\n\ts_barrier":::"memory");
  #undef DMA_K
  #undef DMA_V
  #undef CMASK
  #undef CINIT0
  #undef CINIT1
  #undef START
  #undef RESC
  #undef ROT
}
#undef SBAR
#undef WAIT_BAR
}

__device__ __forceinline__ void attn_phase(const Frame& F, const Args& a) {
    const bf16_t* proj = (const bf16_t*)(a.ws + WS_PROJ); bf16_t* OA = (bf16_t*)(a.ws + WS_OA);
    const int vcu = (F.G % 8 == 0) ? (F.bid % 8) * (F.G / 8) + F.bid / 8 : F.bid;
    for (int i = 0;; ++i) {
        int bhm, qb;
        if (F.G == 256) { if (i >= 2) break; const int s_ = vcu & 7; bhm = vcu >> 3; qb = (i == 0) ? 15 - s_ : s_; }
        else { const int u = i * F.G + F.bid; if (u >= 512) break; bhm = u >> 4; qb = 15 - (u & 15); }
        const int b = bhm >> 3, h = (bhm >> 1) & 3, map = bhm & 1;
        const bf16_t* base = proj + (size_t)b * SEQ * INC;
        const float slope2 = exp2f(-2.0f * (h + 1)) * 1.4426950408889634f;
        attn_body::attn_unit<8>(qb, base + C_QDA + h * 128 + map * 64, base + C_KDA + h * 128 + map * 64, base + C_VDA + h * 128,
                                OA + (size_t)b * SEQ * 1024 + h * 256 + map * 128, slope2, (char*)F.lds);
    }
}
__device__ __forceinline__ void attn_combine(const Frame& F, const Args& a) {
    const bf16_t* OA = (const bf16_t*)(a.ws + WS_OA); bf16_t* Y = (bf16_t*)(a.ws + WS_YDA);
    const float lam = ((const float*)(a.ws + WS_SMALL))[0];
    const float g0 = a.in[I_SUBG][2 * F.lane] * 0.8f, g1 = a.in[I_SUBG][2 * F.lane + 1] * 0.8f;
    const int gw = F.bid * NWAVES + F.wave, NGW = F.G * NWAVES;
    for (int r = gw; r < T; r += NGW) {
        const unsigned* orow = (const unsigned*)(OA + (size_t)r * 1024); unsigned* yrow = (unsigned*)(Y + (size_t)r * 512);
        unsigned w0[4], w1[4];
#pragma unroll
        for (int h = 0; h < 4; ++h) { w0[h] = orow[h * 128 + F.lane]; w1[h] = orow[h * 128 + 64 + F.lane]; }
#pragma unroll
        for (int h = 0; h < 4; ++h) {
            const float x0 = bf2f(w0[h] & 0xffffu) - lam * bf2f(w1[h] & 0xffffu), x1 = bf2f(w0[h] >> 16) - lam * bf2f(w1[h] >> 16);
            const float rs = rsqrtf(wave_sum(x0 * x0 + x1 * x1) * (1.0f / 128.0f) + EPS);
            yrow[h * 64 + F.lane] = pk2(x0 * rs * g0, x1 * rs * g1);
        }
    }
}
namespace hg {
constexpr int QP = 136;
constexpr int L_QD = 0, L_KD = 64 * QP * 2, L_V = 2 * 64 * QP * 2, L_KE = 3 * 64 * QP * 2, L_SSQ = 4 * 64 * QP * 2, L_G = L_SSQ + 512, L_ST = L_G + 64 * QP * 2;
__device__ __forceinline__ f32x4 mfma16(bf16x8 a, bf16x8 b, f32x4 c) { return __builtin_amdgcn_mfma_f32_16x16x32_bf16(a, b, c, 0, 0, 0); }
#define HG_BAR() do { asm volatile("s_waitcnt lgkmcnt(0)" ::: "memory"); __builtin_amdgcn_s_barrier(); asm volatile("" ::: "memory"); } while (0)
typedef short v4i16_t __attribute__((ext_vector_type(4)));
__device__ __forceinline__ bf16x8 tr8(const LAS unsigned char* img, int ra, int rb, int col0, int lane) {
    const int q = (lane & 15) >> 2, p = lane & 3;
    const v4i16_t lo = __builtin_amdgcn_ds_read_tr16_b64_v4i16((LAS v4i16_t*)(img + ((ra + q) * QP + col0 + 4 * p) * 2));
    const v4i16_t hi = __builtin_amdgcn_ds_read_tr16_b64_v4i16((LAS v4i16_t*)(img + ((rb + q) * QP + col0 + 4 * p) * 2));
    return (bf16x8){lo[0], lo[1], lo[2], lo[3], hi[0], hi[1], hi[2], hi[3]};
}
struct Tile { u32x4 p[2]; };
__device__ __forceinline__ void tile_load(Tile& t, const bf16_t* src, size_t pitch, int tid) {
#pragma unroll
    for (int i = 0; i < 2; ++i) { const int pc = tid + NTHR * i; t.p[i] = *(const u32x4*)(src + (size_t)(pc >> 4) * pitch + (pc & 15) * 8); }
}
__device__ __forceinline__ void tile_put(const Tile& t, LAS unsigned char* img, int tid) {
#pragma unroll
    for (int i = 0; i < 2; ++i) { const int pc = tid + NTHR * i; *(LAS u32x4*)(img + ((pc >> 4) * QP + (pc & 15) * 8) * 2) = t.p[i]; }
}
constexpr int PP = 72;
constexpr int G4_L_P = 4 * 64 * QP * 2, G4_L_DEC = G4_L_P + 64 * PP * 2, G4_L_SSQ = G4_L_DEC + 512;
struct InA { Tile qd, kd, ke, v; f32x4 dec; };
__device__ __forceinline__ void loadA(InA& r, const Frame& F, const Args& a, int bh, int n) {
    const int b = bh >> 2, h = bh & 3; const size_t t0 = (size_t)b * SEQ + n * 64;
    const bf16_t* base = (const bf16_t*)(a.ws + WS_PROJ) + t0 * INC;
    tile_load(r.qd, base + C_HGT + 256 * h, INC, F.tid); tile_load(r.kd, base + C_HGT + 256 * h + 128, INC, F.tid);
    tile_load(r.ke, (const bf16_t*)a.out + t0 * 512 + h * 128, 512, F.tid); tile_load(r.v, base + C_IHG + h * 128, INC, F.tid);
    r.dec = *(const f32x4*)((const float*)(a.ws + WS_DEC) + ((size_t)bh * 64 + n) * 128 + 4 * (F.tid & 31));
}
__device__ __forceinline__ void grp_local(const Frame& F, const Args& a, int grp) {
    const int bh = grp >> 4, n0 = 4 * (grp & 15), b = bh >> 2, h = bh & 3, w = F.wave, lane = F.lane, fr = lane & 15, fq = lane >> 4;
    for (int i = F.tid; i < 64 * PP / 2; i += NTHR) ((LAS unsigned*)(F.lds + G4_L_P))[i] = 0u;
    f32x4 S[8];
#pragma unroll
    for (int kt = 0; kt < 8; ++kt) S[kt] = (f32x4){0.f, 0.f, 0.f, 0.f};
    InA cur, nxt; loadA(cur, F, a, bh, n0);
    unsigned short yk[4][4];
#define G4_STORE(nn) do { bf16_t* yp_ = (bf16_t*)(a.ws + WS_YHG) + ((size_t)b * SEQ + (nn) * 64 + 4 * fq) * 512 + h * 128 + 16 * w + fr; \
        _Pragma("unroll") for (int tb = 0; tb < 4; ++tb) _Pragma("unroll") for (int r = 0; r < 4; ++r) yp_[(size_t)(16 * tb + r) * 512] = yk[tb][r]; } while (0)
    for (int j = 0; j < 4; ++j) {
        if (j > 0) G4_STORE(n0 + j - 1);
        loadA(nxt, F, a, bh, n0 + (j < 3 ? j + 1 : 3));
        tile_put(cur.qd, F.lds + L_QD, F.tid); tile_put(cur.kd, F.lds + L_KD, F.tid); tile_put(cur.ke, F.lds + L_KE, F.tid); tile_put(cur.v, F.lds + L_V, F.tid);
        if (F.tid < 32) *(LAS f32x4*)(F.lds + G4_L_DEC + 16 * F.tid) = cur.dec;
        HG_BAR();
#pragma unroll
        for (int rep = 0; rep < 2; ++rep) { const int pi = w + 8 * rep;
            if (pi < 10) { const int tb = pi >= 6 ? 3 : pi >= 3 ? 2 : pi >= 1 ? 1 : 0, jt = pi - (tb * (tb + 1)) / 2;
                f32x4 sc = (f32x4){0.f, 0.f, 0.f, 0.f};
#pragma unroll
                for (int ks = 0; ks < 4; ++ks) { const bf16x8 kf = *(const LAS bf16x8*)(F.lds + L_KD + ((16 * jt + fr) * QP + 32 * ks + 8 * fq) * 2);
                    const bf16x8 qf = *(const LAS bf16x8*)(F.lds + L_QD + ((16 * tb + fr) * QP + 32 * ks + 8 * fq) * 2); sc = mfma16(kf, qf, sc); }
                if (jt == tb) {
#pragma unroll
                    for (int r = 0; r < 4; ++r) if (4 * fq + r > fr) sc[r] = 0.f;
                }
                *(LAS u32x2*)(F.lds + G4_L_P + ((16 * tb + fr) * PP + 16 * jt + 4 * fq) * 2) = (u32x2){cvt_pk_bf16(sc[0], sc[1]), cvt_pk_bf16(sc[2], sc[3])}; } }
        HG_BAR();
        bf16x8 bv[2];
#pragma unroll
        for (int s2 = 0; s2 < 2; ++s2) bv[s2] = tr8(F.lds + L_V, 32 * s2 + 8 * fq, 32 * s2 + 8 * fq + 4, 16 * w, lane);
        bf16x8 Sb[4];
#pragma unroll
        for (int ks = 0; ks < 4; ++ks) { const u32x4 t = (u32x4){cvt_pk_bf16(S[2 * ks][0], S[2 * ks][1]), cvt_pk_bf16(S[2 * ks][2], S[2 * ks][3]), cvt_pk_bf16(S[2 * ks + 1][0], S[2 * ks + 1][1]), cvt_pk_bf16(S[2 * ks + 1][2], S[2 * ks + 1][3])};
            Sb[ks] = __builtin_bit_cast(bf16x8, t); }
#pragma unroll
        for (int tb = 0; tb < 4; ++tb) { f32x4 o = (f32x4){0.f, 0.f, 0.f, 0.f};
#pragma unroll
            for (int s2 = 0; s2 <= (tb >> 1); ++s2) { const bf16x8 pf = *(const LAS bf16x8*)(F.lds + G4_L_P + ((16 * tb + fr) * PP + 32 * s2 + 8 * fq) * 2); o = mfma16(pf, bv[s2], o); }
            if (j > 0) {
#pragma unroll
                for (int ks = 0; ks < 4; ++ks) { const LAS unsigned char* qrow = F.lds + L_QD + ((16 * tb + fr) * QP + 32 * ks + 4 * fq) * 2;
                    const u32x2 lo = *(const LAS u32x2*)qrow, hi = *(const LAS u32x2*)(qrow + 32);
                    const u32x4 aw = (u32x4){lo.x, lo.y, hi.x, hi.y}; o = mfma16(__builtin_bit_cast(bf16x8, aw), Sb[ks], o); } }
#pragma unroll
            for (int r = 0; r < 4; ++r) yk[tb][r] = (unsigned short)f2bf(o[r]); }
#pragma unroll
        for (int kt = 0; kt < 8; ++kt) { S[kt] = S[kt] * *(const LAS f32x4*)(F.lds + G4_L_DEC + (16 * kt + 4 * fq) * 4);
#pragma unroll
            for (int s2 = 0; s2 < 2; ++s2) S[kt] = mfma16(tr8(F.lds + L_KE, 32 * s2 + 8 * fq, 32 * s2 + 8 * fq + 4, 16 * kt, lane), bv[s2], S[kt]); }
        HG_BAR();
        cur = nxt;
    }
    G4_STORE(n0 + 3);
#undef G4_STORE
    f32x4* sg = (f32x4*)(a.ws + WS_DS) + ((size_t)grp * 64 + w * 8) * 64 + lane;
#pragma unroll
    for (int kt = 0; kt < 8; ++kt) sg[kt * 64] = S[kt];
}
__device__ __forceinline__ void grp_scan(const Frame& F, const Args& a) {
    f32x4* sg = (f32x4*)(a.ws + WS_DS); f32x4* si = sg + (size_t)256 * 4096; const float* dec = (const float*)(a.ws + WS_DEC);
    for (int gt = F.bid * NTHR + F.tid; gt < 16 * 4096; gt += F.G * NTHR) {
        const int bh = gt >> 12, slot = gt & 4095, kt = (slot >> 6) & 7, lane = slot & 63, k = 16 * kt + 4 * (lane >> 4);
        f32x4 cur = (f32x4){0.f, 0.f, 0.f, 0.f};
#pragma unroll 4
        for (int g = 0; g < 16; ++g) { const size_t gi = ((size_t)(bh * 16 + g)) * 4096 + slot;
            si[gi] = cur;
            const float* dp = dec + ((size_t)bh * 64 + 4 * g) * 128 + k;
            const f32x4 d = (*(const f32x4*)dp * *(const f32x4*)(dp + 128)) * (*(const f32x4*)(dp + 256) * *(const f32x4*)(dp + 384));
            cur = d * cur + sg[gi]; }
    }
}
struct InC { Tile qd, g, ol; f32x4 dec; };
__device__ __forceinline__ void loadC(InC& r, const Frame& F, const Args& a, int bh, int n) {
    const int b = bh >> 2, h = bh & 3; const size_t t0 = (size_t)b * SEQ + n * 64;
    const bf16_t* base = (const bf16_t*)(a.ws + WS_PROJ) + t0 * INC;
    tile_load(r.qd, base + C_HGT + 256 * h, INC, F.tid); tile_load(r.g, base + C_GHG + h * 128, INC, F.tid);
    tile_load(r.ol, (const bf16_t*)(a.ws + WS_YHG) + t0 * 512 + h * 128, 512, F.tid);
    r.dec = *(const f32x4*)((const float*)(a.ws + WS_DEC) + ((size_t)bh * 64 + n) * 128 + 4 * (F.tid & 31));
}
__device__ __forceinline__ void grp_final(const Frame& F, const Args& a, int grp) {
    const int bh = grp >> 4, n0 = 4 * (grp & 15), b = bh >> 2, h = bh & 3, w = F.wave, lane = F.lane, fr = lane & 15, fq = lane >> 4;
    f32x4 S[8];
    { const f32x4* si = (const f32x4*)(a.ws + WS_DS) + (size_t)256 * 4096 + ((size_t)grp * 64 + w * 8) * 64 + lane;
#pragma unroll
      for (int kt = 0; kt < 8; ++kt) S[kt] = si[kt * 64]; }
    const float ng = a.in[I_HGNG][16 * w + fr];
    LAS float* SSQ = (LAS float*)(F.lds + G4_L_SSQ);
    InC cur, nxt; loadC(cur, F, a, bh, n0);
    unsigned short yk[4][4];
#define G4_STORE(nn) do { bf16_t* yp_ = (bf16_t*)(a.ws + WS_YHG) + ((size_t)b * SEQ + (nn) * 64 + 4 * fq) * 512 + h * 128 + 16 * w + fr; \
        _Pragma("unroll") for (int tb = 0; tb < 4; ++tb) _Pragma("unroll") for (int r = 0; r < 4; ++r) yp_[(size_t)(16 * tb + r) * 512] = yk[tb][r]; } while (0)
    for (int j = 0; j < 4; ++j) {
        if (j > 0) G4_STORE(n0 + j - 1);
        loadC(nxt, F, a, bh, n0 + (j < 3 ? j + 1 : 3));
        tile_put(cur.qd, F.lds + L_QD, F.tid); tile_put(cur.g, F.lds + L_KD, F.tid); tile_put(cur.ol, F.lds + L_V, F.tid);
        if (F.tid < 32) *(LAS f32x4*)(F.lds + G4_L_DEC + 16 * F.tid) = cur.dec;
        HG_BAR();
        bf16x8 Sb[4];
#pragma unroll
        for (int ks = 0; ks < 4; ++ks) { const u32x4 t = (u32x4){cvt_pk_bf16(S[2 * ks][0], S[2 * ks][1]), cvt_pk_bf16(S[2 * ks][2], S[2 * ks][3]), cvt_pk_bf16(S[2 * ks + 1][0], S[2 * ks + 1][1]), cvt_pk_bf16(S[2 * ks + 1][2], S[2 * ks + 1][3])};
            Sb[ks] = __builtin_bit_cast(bf16x8, t); }
        f32x4 o[4];
#pragma unroll
        for (int tb = 0; tb < 4; ++tb) {
#pragma unroll
            for (int r = 0; r < 4; ++r) o[tb][r] = bf2f(*(const LAS unsigned short*)(F.lds + L_V + ((16 * tb + 4 * fq + r) * QP + 16 * w + fr) * 2));
#pragma unroll
            for (int ks = 0; ks < 4; ++ks) { const LAS unsigned char* qrow = F.lds + L_QD + ((16 * tb + fr) * QP + 32 * ks + 4 * fq) * 2;
                const u32x2 lo = *(const LAS u32x2*)qrow, hi = *(const LAS u32x2*)(qrow + 32);
                const u32x4 aw = (u32x4){lo.x, lo.y, hi.x, hi.y}; o[tb] = mfma16(__builtin_bit_cast(bf16x8, aw), Sb[ks], o[tb]); }
#pragma unroll
            for (int r = 0; r < 4; ++r) { const float v = scan16(o[tb][r] * o[tb][r]); if (fr == 15) SSQ[w * 64 + 16 * tb + 4 * fq + r] = v; } }
#pragma unroll
        for (int kt = 0; kt < 8; ++kt) S[kt] = S[kt] * *(const LAS f32x4*)(F.lds + G4_L_DEC + (16 * kt + 4 * fq) * 4);
        HG_BAR();
#pragma unroll
        for (int tb = 0; tb < 4; ++tb) { f32x4 tot = (f32x4){0.f, 0.f, 0.f, 0.f};
#pragma unroll
            for (int ww = 0; ww < 8; ++ww) tot += *(const LAS f32x4*)(SSQ + ww * 64 + 16 * tb + 4 * fq);
#pragma unroll
            for (int r = 0; r < 4; ++r) { const float rs = rsqrtf(tot[r] * (1.0f / 128.0f) + EPS); const float g = bf2f(*(const LAS unsigned short*)(F.lds + L_KD + ((16 * tb + 4 * fq + r) * QP + 16 * w + fr) * 2));
                yk[tb][r] = (unsigned short)f2bf(o[tb][r] * rs * ng * g * __builtin_amdgcn_rcpf(1.0f + __builtin_amdgcn_exp2f(-1.4426950408889634f * g))); } }
        HG_BAR();
        cur = nxt;
    }
    G4_STORE(n0 + 3);
#undef G4_STORE
}
#undef HG_BAR
}

__device__ __forceinline__ float rs4(float a0, float a1, float a2, float a3, int lane) {
    const bool hi = (lane & 32) != 0;
    const float s0 = hi ? a0 : a2, s1 = hi ? a1 : a3;
    const float k0 = (hi ? a2 : a0) + __shfl_xor(s0, 32), k1 = (hi ? a3 : a1) + __shfl_xor(s1, 32);
    const bool b4 = (lane & 16) != 0;
    const float sd = b4 ? k0 : k1;
    float k = (b4 ? k1 : k0) + __shfl_xor(sd, 16);
    k += __shfl_xor(k, 8); k += __shfl_xor(k, 4); k += __shfl_xor(k, 2); k += __shfl_xor(k, 1);
    return k;
}
__device__ __forceinline__ void phase_router(const Frame& F, const Args& a) {
    constexpr int AP = 1032;
    LAS bf16_t* AH = (LAS bf16_t*)F.lds;
    LAS bf16_t* AL = AH + 16 * AP;
    LAS float* PART = (LAS float*)(F.lds + 2 * 16 * AP * 2);
    LAS float* LG = PART + 8 * 16 * 48;
    LAS unsigned* LH = (LAS unsigned*)(LG + 16 * 48);
    LAS unsigned* LB = LH + 32;
    LAS unsigned* LR = LH + 64;
    if (F.tid < NEXP) LH[F.tid] = 0u;
    const float* mod = (const float*)(a.ws + WS_MOD);
    const float* x1 = a.out; bf16_t* H2 = (bf16_t*)(a.ws + WS_ACT);
    unsigned* counts = (unsigned*)(a.ws + WS_CTL) + CW_COUNTS; unsigned* tokinfo = (unsigned*)(a.ws + WS_TOKINFO); int* toklist = (int*)(a.ws + WS_TOKLIST);
    const int rows_per_blk = T / F.G, r0 = F.bid * rows_per_blk, b = r0 / SEQ;
    const int lane = F.lane, w = F.wave, fr = lane & 15, fq = lane >> 4;
    f32x4 v[2][4], vn[2][4];
#define RT_LOAD(V, rb_) do { _Pragma("unroll") for (int q = 0; q < 2; ++q) { const f32x4* xr_ = (const f32x4*)(x1 + (size_t)((rb_) + 2 * w + q) * D) + lane; \
        _Pragma("unroll") for (int j = 0; j < 4; ++j) V[q][j] = xr_[64 * j]; } } while (0)
    RT_LOAD(v, r0);
    bf16x8 Bh[4][3], Bl[4][3];
    {
        const float* wre = a.in[I_WRE]; const float* wrg = a.in[I_WRG];
#pragma unroll
        for (int ks = 0; ks < 4; ++ks)
#pragma unroll
            for (int ct = 0; ct < 3; ++ct) {
                unsigned hw[4], lw[4];
#pragma unroll
                for (int jp = 0; jp < 4; ++jp) { float x[2];
#pragma unroll
                    for (int z = 0; z < 2; ++z) { const int k = 128 * w + 32 * ks + 8 * fq + 2 * jp + z;
                        if (ct == 0) { const float g = wrg[k * 4 + (fr & 3)], e = wre[k * 32 + ((fr + 28) & 31)]; x[z] = fr < 4 ? g : e; }
                        else if (ct == 1) x[z] = wre[k * 32 + 12 + fr];
                        else { const float e = wre[k * 32 + 28 + (fr & 3)]; x[z] = fr < 4 ? e : 0.f; } }
                    const unsigned h0 = f2bf(x[0]), h1 = f2bf(x[1]); hw[jp] = h0 | (h1 << 16);
                    lw[jp] = pk2(x[0] - bf2f(h0), x[1] - bf2f(h1)); }
                Bh[ks][ct] = __builtin_bit_cast(bf16x8, (u32x4){hw[0], hw[1], hw[2], hw[3]}); Bl[ks][ct] = __builtin_bit_cast(bf16x8, (u32x4){lw[0], lw[1], lw[2], lw[3]});
            }
    }
    for (int g = 0; g < rows_per_blk / 16; ++g) {
        const int rg = r0 + 16 * g;
        { const int gn = g + 1 < rows_per_blk / 16 ? g + 1 : g; RT_LOAD(vn, r0 + 16 * gn); }
#pragma unroll
        for (int q = 0; q < 2; ++q) { float sq = 0.f;
#pragma unroll
            for (int j = 0; j < 4; ++j) sq += (v[q][j].x * v[q][j].x + v[q][j].y * v[q][j].y) + (v[q][j].z * v[q][j].z + v[q][j].w * v[q][j].w);
            const float rs = rsqrtf(wave_sum(sq) * (1.0f / D) + EPS); const int row = 2 * w + q;
#pragma unroll
            for (int j = 0; j < 4; ++j) { const int k = 256 * j + 4 * lane;
                const f32x4 gg = *(const f32x4*)(a.in[I_N2G] + k) * (1.0f + *(const f32x4*)(mod + b * 6144 + 4 * 1024 + k)), sh = *(const f32x4*)(mod + b * 6144 + 3 * 1024 + k);
                const f32x4 hv = v[q][j] * rs * gg + sh;
                const unsigned h0 = f2bf(hv.x), h1 = f2bf(hv.y), h2_ = f2bf(hv.z), h3 = f2bf(hv.w);
                const u32x2 hw = (u32x2){h0 | (h1 << 16), h2_ | (h3 << 16)};
                *(u32x2*)(H2 + (size_t)(rg + row) * D + k) = hw;
                *(LAS u32x2*)(AH + row * AP + k) = hw;
                *(LAS u32x2*)(AL + row * AP + k) = (u32x2){pk2(hv.x - bf2f(h0), hv.y - bf2f(h1)), pk2(hv.z - bf2f(h2_), hv.w - bf2f(h3))}; } }
        __syncthreads();
        f32x4 acc[3] = {{0.f, 0.f, 0.f, 0.f}, {0.f, 0.f, 0.f, 0.f}, {0.f, 0.f, 0.f, 0.f}};
#pragma unroll
        for (int ks = 0; ks < 4; ++ks) { const bf16x8 ah = *(const LAS bf16x8*)(AH + fr * AP + 128 * w + 32 * ks + 8 * fq), al = *(const LAS bf16x8*)(AL + fr * AP + 128 * w + 32 * ks + 8 * fq);
#pragma unroll
            for (int ct = 0; ct < 3; ++ct) { acc[ct] = __builtin_amdgcn_mfma_f32_16x16x32_bf16(ah, Bh[ks][ct], acc[ct], 0, 0, 0);
                acc[ct] = __builtin_amdgcn_mfma_f32_16x16x32_bf16(al, Bh[ks][ct], acc[ct], 0, 0, 0); acc[ct] = __builtin_amdgcn_mfma_f32_16x16x32_bf16(ah, Bl[ks][ct], acc[ct], 0, 0, 0); } }
#pragma unroll
        for (int ct = 0; ct < 3; ++ct)
#pragma unroll
            for (int r = 0; r < 4; ++r) PART[(w * 16 + 4 * fq + r) * 48 + 16 * ct + fr] = acc[ct][r];
        __syncthreads();
        for (int t = F.tid; t < 16 * 48; t += NTHR) { const int row = t / 48, o = t % 48; float sacc = 0.f;
#pragma unroll
            for (int ww = 0; ww < 8; ++ww) sacc += PART[(ww * 16 + row) * 48 + o];
            if (o < 36) LG[row * 48 + o] = sacc + (o < 4 ? a.in[I_BRG][o & 3] : a.in[I_BRE][(o + 28) & 31]); }
        __syncthreads();
        if (F.tid < 16) {
            const LAS float* lg = LG + F.tid * 48;
            float gl[4]; int gi = 0;
#pragma unroll
            for (int o = 0; o < 4; ++o) gl[o] = lg[o];
            float gm = gl[0];
#pragma unroll
            for (int o = 1; o < 4; ++o) if (gl[o] > gm) { gm = gl[o]; gi = o; }
            float gsum = 0.f;
#pragma unroll
            for (int o = 0; o < 4; ++o) gsum += expf(gl[o] - gm);
            const float gp = 1.0f / gsum;
            float el[8];
#pragma unroll
            for (int e = 0; e < 8; ++e) el[e] = lg[4 + gi * 8 + e];
            int i0 = 0; float m0 = el[0];
#pragma unroll
            for (int o = 1; o < 8; ++o) if (el[o] > m0) { m0 = el[o]; i0 = o; }
            int i1 = -1; float m1 = -INFINITY;
#pragma unroll
            for (int o = 0; o < 8; ++o) if (o != i0 && el[o] > m1) { m1 = el[o]; i1 = o; }
            const float e1 = expf(m1 - m0); const float w0 = gp / (1.0f + e1), w1 = gp * e1 / (1.0f + e1);
            const int rl = 16 * g + F.tid, ex0 = gi * 8 + i0, ex1 = gi * 8 + i1;
            const unsigned l0 = atomicAdd((unsigned*)(LH + ex0), 1u), l1 = atomicAdd((unsigned*)(LH + ex1), 1u);
            LAS unsigned* ri = LR + rl * 6;
            ri[0] = (unsigned)ex0; ri[1] = l0; ri[2] = (unsigned)ex1; ri[3] = l1; ri[4] = __float_as_uint(w0); ri[5] = __float_as_uint(w1);
        }
#pragma unroll
        for (int q = 0; q < 2; ++q)
#pragma unroll
            for (int j = 0; j < 4; ++j) v[q][j] = vn[q][j];
    }
#undef RT_LOAD
    __syncthreads();
    if (F.tid < NEXP) LB[F.tid] = atomicAdd(counts + 64 * F.tid, LH[F.tid]);
    __syncthreads();
    for (int rl = F.tid; rl < rows_per_blk; rl += NTHR) {
        const LAS unsigned* ri = LR + rl * 6; const int r = r0 + rl;
        const unsigned ex0 = ri[0], ex1 = ri[2], k0 = LB[ex0] + ri[1], k1 = LB[ex1] + ri[3];
        toklist[ex0 * T + k0] = r; toklist[ex1 * T + k1] = r;
        u32x4 t0; t0.x = ex0; t0.y = k0; t0.z = ex1; t0.w = k1;
        *(u32x4*)(tokinfo + (size_t)r * 8) = t0;
        tokinfo[(size_t)r * 8 + 4] = ri[4]; tokinfo[(size_t)r * 8 + 5] = ri[5];
    }
}
__device__ __forceinline__ void build_moe_tab(const Frame& F, const Args& a, LAS MoeTab* tab) {
    if (F.tid == 0) {
        const unsigned* counts = (const unsigned*)(a.ws + WS_CTL) + CW_COUNTS; int nt = 0;
        for (int e = 0; e < NEXP; ++e) { const int c = (int)__hip_atomic_load(counts + 64 * e, __ATOMIC_RELAXED, __HIP_MEMORY_SCOPE_AGENT); tab->cnt[e] = c; tab->tbase[e] = nt;
            const int n = (c + 255) >> 8; for (int m = 0; m < n; ++m) { tab->tile_e[nt] = e; tab->tile_m[nt] = m; ++nt; } }
        tab->tbase[NEXP] = nt; tab->nt = nt;
    }
    __syncthreads();
}
__device__ __forceinline__ void phase_final(const Frame& F, const Args& a, const LAS MoeTab* tab) {
    const float* mod = (const float*)(a.ws + WS_MOD); const unsigned* tokinfo = (const unsigned*)(a.ws + WS_TOKINFO); const bf16_t* Ys = (const bf16_t*)(a.ws + WS_YS);
    const int rows_per_blk = T / F.G, r0 = F.bid * rows_per_blk;
    for (int r = r0 + F.wave; r < r0 + rows_per_blk; r += NWAVES) {
        const int b = r / SEQ;
        const u32x4 ti = *(const u32x4*)(tokinfo + (size_t)r * 8);
        const float w0 = __uint_as_float(tokinfo[(size_t)r * 8 + 4]), w1 = __uint_as_float(tokinfo[(size_t)r * 8 + 5]);
        const size_t s0 = (size_t)tab->tbase[ti.x] * 256 + ti.y, s1 = (size_t)tab->tbase[ti.z] * 256 + ti.w;
        f32x4* xr = (f32x4*)(a.out + (size_t)r * D) + F.lane;
        const u32x2* y0 = (const u32x2*)(Ys + s0 * D) + F.lane; const u32x2* y1 = (const u32x2*)(Ys + s1 * D) + F.lane;
        f32x4 v[4]; float s = 0.f;
#pragma unroll
        for (int j = 0; j < 4; ++j) { const int k = 256 * j + 4 * F.lane;
            const f32x4 gt = *(const f32x4*)(mod + b * 6144 + 5 * 1024 + k); const u32x2 a0 = y0[64 * j], a1 = y1[64 * j];
            f32x4 m; m.x = w0 * bf2f(a0.x & 0xffffu) + w1 * bf2f(a1.x & 0xffffu); m.y = w0 * bf2f(a0.x >> 16) + w1 * bf2f(a1.x >> 16);
            m.z = w0 * bf2f(a0.y & 0xffffu) + w1 * bf2f(a1.y & 0xffffu); m.w = w0 * bf2f(a0.y >> 16) + w1 * bf2f(a1.y >> 16);
            v[j] = xr[64 * j] + gt * m; s += (v[j].x * v[j].x + v[j].y * v[j].y) + (v[j].z * v[j].z + v[j].w * v[j].w); }
        const float rs = rsqrtf(wave_sum(s) * (1.0f / D) + EPS);
#pragma unroll
        for (int j = 0; j < 4; ++j) { const f32x4 g = *(const f32x4*)(a.in[I_FG] + 256 * j + 4 * F.lane); xr[64 * j] = v[j] * rs * g; }
    }
}

#define XB_TMO      128
#define XB_XCNT(j)  (256  + 64 * (j))
#define XB_XSUB(j)  (1280 + 64 * (j))
#define XB_XGEN(j)  (2304 + 64 * (j))
#define XB_TOP      3328
#define XB_TOPGEN   3392
#define XCD_BAR_WORDS 3456
#define XB_SPIN_CAP (1u << 18)
__device__ __forceinline__ unsigned xb_ld(unsigned* p)              { return __hip_atomic_load(p, __ATOMIC_RELAXED, __HIP_MEMORY_SCOPE_AGENT); }
__device__ __forceinline__ unsigned xb_add(unsigned* p, unsigned v) { return __hip_atomic_fetch_add(p, v, __ATOMIC_RELAXED, __HIP_MEMORY_SCOPE_AGENT); }
__device__ __forceinline__ unsigned xb_xcc_id() { return (unsigned)__builtin_amdgcn_s_getreg((3 << 11) | 20) & 0xFu; }
#define XB_SPIN(cond, bar) do { unsigned _sp = 0; while (cond) { __builtin_amdgcn_s_sleep(1); \
    if ((++_sp & 255u) == 0u) { if (xb_ld(&(bar)[XB_TMO])) break; if (_sp > XB_SPIN_CAP) { atomicAdd(&(bar)[XB_TMO], 1u); break; } } } } while (0)
struct XcdBarrier { unsigned* bar; unsigned x; volatile LAS unsigned* st; };
__device__ __forceinline__ XcdBarrier xcd_barrier_post(unsigned* bar, volatile LAS unsigned* st) {
    XcdBarrier b; b.bar = bar; b.x = xb_xcc_id(); b.st = st;
    if (threadIdx.x == 0) (void)xb_add(&bar[XB_XCNT(b.x)], 1u);
    return b;
}
__device__ __forceinline__ void xcd_barrier_complete(unsigned* bar, unsigned x, unsigned& nloc, unsigned& nx) {
    const unsigned G = gridDim.x * gridDim.y * gridDim.z;
    unsigned sum, cnt, mine, sp = 0u;
    for (;;) {
        sum = 0u; cnt = 0u; mine = 0u;
#pragma unroll
        for (unsigned j = 0; j < 16; ++j) { const unsigned c = xb_ld(&bar[XB_XCNT(j)]); sum += c; cnt += (c > 0u) ? 1u : 0u; mine = (j == x) ? c : mine; }
        if (sum == G) break;
        __builtin_amdgcn_s_sleep(1);
        if ((++sp & 255u) == 0u) { if (xb_ld(&bar[XB_TMO])) break; if (sp > XB_SPIN_CAP) { atomicAdd(&bar[XB_TMO], 1u); break; } }
    }
    nloc = mine > 0u ? mine : 1u; nx = cnt > 0u ? cnt : 1u;
}
__device__ __forceinline__ void xcd_barrier(const XcdBarrier& b) {
    asm volatile("s_waitcnt vmcnt(0)" ::: "memory");
    __syncthreads();
    if (threadIdx.x == 0) {
        unsigned* bar = b.bar;
        __builtin_amdgcn_s_waitcnt(0);
        unsigned nloc = b.st[0], nx = b.st[1];
        if (nloc == 0u) { xcd_barrier_complete(bar, b.x, nloc, nx); b.st[0] = nloc; b.st[1] = nx; }
        const unsigned old = xb_add(&bar[XB_XSUB(b.x)], 1u);
        const unsigned gen = old / nloc;
        if (old + 1u == (gen + 1u) * nloc) {
            __builtin_amdgcn_fence(__ATOMIC_RELEASE, "agent");
            asm volatile("s_waitcnt vmcnt(0)" ::: "memory");
            const unsigned og = xb_add(&bar[XB_TOP], 1u);
            const unsigned tg = og / nx;
            if (og + 1u == (tg + 1u) * nx) xb_add(&bar[XB_TOPGEN], 1u);
            else XB_SPIN(xb_ld(&bar[XB_TOPGEN]) == tg, bar);
            __builtin_amdgcn_fence(__ATOMIC_ACQUIRE, "agent");
            xb_add(&bar[XB_XGEN(b.x)], 1u);
            asm volatile("s_waitcnt vmcnt(0)" ::: "memory");
        } else {
            XB_SPIN(xb_ld(&bar[XB_XGEN(b.x)]) == gen, bar);
            __builtin_amdgcn_fence(__ATOMIC_ACQUIRE, "agent");
            asm volatile("s_waitcnt vmcnt(0)" ::: "memory");
        }
    }
    __syncthreads();
}

constexpr int N_PHASES = 11;
__global__ void __launch_bounds__(NTHR, 2) mk_fwd(Args a) {
    extern __shared__ __attribute__((aligned(16))) unsigned char lds_raw[];
    Frame F; F.lds = (LAS unsigned char*)lds_raw; F.tid = threadIdx.x; F.lane = F.tid & 63; F.wave = __builtin_amdgcn_readfirstlane(F.tid >> 6); F.G = gridDim.x; F.bid = blockIdx.x;
    unsigned char* ws = a.ws;
    const int lo = a.ph_lo, hi = a.ph_hi;
#if MK_N_LAUNCHES == 1
    volatile LAS unsigned* MISC = (volatile LAS unsigned*)(F.lds + 152 * 1024);
    if (F.tid < 4) MISC[F.tid] = 0u;
    __syncthreads();
    XcdBarrier xbar = xcd_barrier_post((unsigned*)(ws + WS_CTL) + CW_BAR, MISC);
#define SEAM(k) do { if (IN(k) && IN((k) + 1)) xcd_barrier(xbar); } while (0)
#else
#define SEAM(k) do { } while (0)
#endif
#define IN(k) (lo <= (k) && (k) < hi)
    LAS MoeTab* tab = (LAS MoeTab*)(F.lds + 144 * 1024);

#define RUNPH(k, ...) if (IN(k)) { F.lane = lane_now(); F.tid = F.wave * 64 + F.lane; __VA_ARGS__ }
    RUNPH(0, { phase0(F, a); }) SEAM(0);
    RUNPH(1, { phase1(F, a); __syncthreads(); dense_weight_convert(F, a); }) SEAM(1);
    RUNPH(2, {
        DenseOrder S{(const char*)(ws + WS_ACT), (const char*)(ws + WS_WIN), D, T / 256, INC / 256, F.G, F.bid};
        EpiInProj E{(bf16_t*)(ws + WS_PROJ), (bf16_t*)a.out, (float*)(ws + WS_DEC), (const float*)(ws + WS_SMALL) + 16, attn_body::C2};
        pg8::gemm_phase(F.lds, D, S, E);
    }) SEAM(2);
    RUNPH(3, {
        for (int g = F.bid; g < 256; g += F.G) hg::grp_local(F, a, g);
        __syncthreads();
        attn_phase(F, a);
    }) SEAM(3);
    RUNPH(4, { hg::grp_scan(F, a); attn_combine(F, a); }) SEAM(4);
    RUNPH(5, { for (int g = F.bid; g < 256; g += F.G) hg::grp_final(F, a, g); }) SEAM(5);
    RUNPH(6, {
        UpOrder S{(const char*)(ws + WS_YDA), (const char*)(ws + WS_YHG), (const char*)(ws + WS_WUPDA), (const char*)(ws + WS_WUPHG), F.G, F.bid};
        EpiUp E{(const bf16_t*)(ws + WS_PROJ), (bf16_t*)(ws + WS_ACT)};
        pg8::gemm_phase(F.lds, 512, S, E);
    }) SEAM(6);
    RUNPH(7, {
        DenseOrder S{(const char*)(ws + WS_ACT), (const char*)(ws + WS_WOUT), D, T / 256, D / 256, F.G, F.bid};
        EpiOut E{a.in[I_X], (const float*)(ws + WS_MOD), a.out};
        pg8::gemm_phase(F.lds, D, S, E);
        moe_weight_convert(F, a);
    }) SEAM(7);
    RUNPH(8, { phase_router(F, a); __syncthreads(); }) SEAM(8);
    RUNPH(9, {
        build_moe_tab(F, a, tab);
        unsigned* done = (unsigned*)(ws + WS_CTL) + CW_TILE;
        { Moe1Order S{tab, (const char*)(ws + WS_ACT), (const char*)(ws + WS_W13), (const int*)(ws + WS_TOKLIST), F.G, F.bid};
          EpiMoe1 E{(bf16_t*)(ws + WS_HS), done};
          pg8::gemm_phase(F.lds, D, S, E); }
        { Moe2Order S{tab, (const char*)(ws + WS_HS), (const char*)(ws + WS_W2), done, (unsigned*)(ws + WS_CTL) + CW_TMO, F.G, F.bid};
          EpiStoreBf16 E{(bf16_t*)(ws + WS_YS), D, 0, 1.0f};
          pg8::gemm_phase(F.lds, DEXP, S, E); }
    }) SEAM(9);
    RUNPH(10, { build_moe_tab(F, a, tab); phase_final(F, a, tab); })
#undef IN
#undef SEAM
}

extern "C" void kernel_launch(void* const* d_in, const int* in_sizes, int n_in, void* d_out, int out_size, void* d_ws, size_t ws_size, hipStream_t stream) {
    static int grid = 0;
    if (grid == 0) {
        if (n_in != 25 || in_sizes[0] != T * D || out_size != T * D || ws_size < WS_END) { fprintf(stderr, "kernel_launch: unexpected shapes (n_in %d, in0 %d, out %d, ws %zu)\n", n_in, n_in > 0 ? in_sizes[0] : -1, out_size, ws_size); grid = -1; return; }
        int dev = 0, cus = 0, per_cu = 0;
        if (hipGetDevice(&dev) != hipSuccess || hipDeviceGetAttribute(&cus, hipDeviceAttributeMultiprocessorCount, dev) != hipSuccess) { grid = -1; return; }
        if (hipFuncSetAttribute((const void*)mk_fwd, hipFuncAttributeMaxDynamicSharedMemorySize, LDS_BYTES) != hipSuccess) { fprintf(stderr, "kernel_launch: hipFuncSetAttribute failed\n"); grid = -1; return; }
        if (hipOccupancyMaxActiveBlocksPerMultiprocessor(&per_cu, (const void*)mk_fwd, NTHR, LDS_BYTES) != hipSuccess || per_cu < 1) { fprintf(stderr, "kernel_launch: occupancy query says %d\n", per_cu); per_cu = 1; }
        (void)hipGetLastError();
        grid = cus;
        if (grid > 256) grid = 256;
        while (T % grid) --grid;
    }
    if (grid < 0) return;
    (void)hipMemsetAsync((char*)d_ws + WS_CTL, 0, CTL_ZERO_BYTES, stream);
    Args a{};
    for (int i = 0; i < 25; ++i) a.in[i] = (const float*)d_in[i];
    a.out = (float*)d_out; a.ws = (unsigned char*)d_ws;
#if MK_N_LAUNCHES == 1
    a.ph_lo = 0; a.ph_hi = N_PHASES;
    void* args[] = {&a};
    hipError_t e = hipLaunchCooperativeKernel((const void*)mk_fwd, dim3(grid), dim3(NTHR), args, LDS_BYTES, stream);
    if (e != hipSuccess) fprintf(stderr, "cooperative launch failed: %s (grid %d)\n", hipGetErrorString(e), grid);
#else
    for (int p = 0; p < N_PHASES; ++p) {
        a.ph_lo = p; a.ph_hi = p + 1;
        hipLaunchKernelGGL(mk_fwd, dim3(grid), dim3(NTHR), LDS_BYTES, stream, a);
    }
#endif
}
```

```cpp
#include <hip/hip_runtime.h>
#include <cstdio>
#include <cstdint>

#ifndef MK_N_LAUNCHES
#define MK_N_LAUNCHES 1
#endif

#define LAS __attribute__((address_space(3)))
typedef unsigned short bf16_t;
typedef short bf16x8 __attribute__((ext_vector_type(8)));
typedef float f32x4 __attribute__((ext_vector_type(4)));
typedef float f32x2 __attribute__((ext_vector_type(2)));
typedef unsigned u32x4 __attribute__((ext_vector_type(4)));
typedef unsigned u32x2 __attribute__((ext_vector_type(2)));

constexpr int NB = 4, SEQ = 4096, D = 1024, T = NB * SEQ;
constexpr int INC = 5632;
constexpr int C_QDA = 0, C_KDA = 512, C_VDA = 1024, C_QHG = 1536, C_FHG = 2048, C_IHG = 2560, C_GHG = 3072, C_GDA = 3584, C_GHGATE = 4608;
constexpr int C_HGT = 1536;
constexpr int NEXP = 32, DEXP = 512;
constexpr int PMAX = 40960;
constexpr float EPS = 1e-6f;
constexpr int NWAVES = 8, NTHR = 512;

constexpr size_t MiB = 1u << 20;
constexpr size_t WS_CTL = 0, CTL_ZERO_BYTES = 64 * 1024;
constexpr size_t WS_MODP = 1 * MiB;
constexpr size_t WS_MOD = 5 * MiB / 2;
constexpr size_t WS_SMALL = 11 * MiB / 4;
constexpr size_t WS_TOKINFO = 3 * MiB;
constexpr size_t WS_TOKLIST = 4 * MiB;
constexpr size_t WS_DEC = 6 * MiB;
constexpr size_t WS_DS = 24 * MiB;
constexpr size_t WS_WIN = 8 * MiB;
constexpr size_t WS_WUPDA = 20 * MiB, WS_WUPHG = 21 * MiB, WS_WOUT = 22 * MiB;
constexpr size_t WS_ACT = 24 * MiB;
constexpr size_t WS_PROJ = 56 * MiB;
constexpr size_t WS_YDA = 232 * MiB, WS_YHG = 248 * MiB;
constexpr size_t WS_OA = 264 * MiB;
constexpr size_t WS_W13 = 56 * MiB;
constexpr size_t WS_W2 = 120 * MiB;
constexpr size_t WS_HS = 152 * MiB;
constexpr size_t WS_YS = 192 * MiB;
constexpr size_t WS_END = 296 * MiB;
constexpr int CW_COUNTS = 64;
constexpr int CW_BAR = 4096;
constexpr int CW_TILE = 8192;
constexpr int CW_TMO = 32;

constexpr int LDS_BYTES = 160 * 1024;

__device__ __forceinline__ float bf2f(unsigned v) { return __uint_as_float(v << 16); }
__device__ __forceinline__ unsigned f2bf(float f) { unsigned u = __float_as_uint(f); return (u + 0x7fffu + ((u >> 16) & 1u)) >> 16; }
__device__ __forceinline__ unsigned pk2(float lo, float hi) { return f2bf(lo) | (f2bf(hi) << 16); }
__device__ __forceinline__ float sigmoidf_(float x) { return 1.0f / (1.0f + __expf(-x)); }
__device__ __forceinline__ float siluf_(float x) { return x / (1.0f + __expf(-x)); }
__device__ __forceinline__ int lane_now() { int l; asm volatile("v_mbcnt_lo_u32_b32 %0, -1, 0\n\tv_mbcnt_hi_u32_b32 %0, -1, %0" : "=v"(l)); return l; }
__device__ __forceinline__ float wave_sum(float v) {
#pragma unroll
    for (int o = 1; o < 64; o <<= 1) v += __shfl_xor(v, o);
    return v;
}

namespace pg8 {
constexpr int BM = 256, BK = 64, HALF = 128, HTB = HALF * BK * 2, STAGE_BYTES = 8 * HTB;
__host__ __device__ __forceinline__ int lds_byte(int r, int c) { const int st = (r >> 4) * 2 + (c >> 5), rr = r & 15, cc = c & 31, ob = rr * 64 + cc * 2; return st * 1024 + (ob ^ (((ob >> 9) & 1) << 5)); }
__host__ __device__ __forceinline__ void stage_rc(int b, int& R, int& C) { const int st = b / 1024, sb = b % 1024, swz = sb ^ (((sb >> 9) & 1) << 5); R = (st >> 1) * 16 + swz / 64; C = (st & 1) * 32 + (swz % 64) / 2; }
__host__ __device__ __forceinline__ int perm32(int rho) { const int n = rho >> 4, i = rho & 15; return 8 * (i >> 2) + 4 * n + (i & 3); }

struct Unit { int pm, pn; const char* A; const char* B; int aux; };
__device__ __forceinline__ unsigned cvt_pk_bf16(float lo, float hi) { unsigned r; asm volatile("v_cvt_pk_bf16_f32 %0, %1, %2" : "=v"(r) : "v"(lo), "v"(hi)); return r; }

template <class Epi, class Sched>
__device__ __forceinline__ void gemm_phase(LAS unsigned char* lds, const int K, const Sched& S, const Epi& E) {
    const int tid = threadIdx.x, wid = __builtin_amdgcn_readfirstlane(tid >> 6), lane = tid & 63, wr = wid >> 2, wc = wid & 3, fr = lane & 15, fq = lane >> 4;
    const int nt = K / BK;
    unsigned voffB[2];
#define PG8_SETLANE() do { const int _l = lane_now(), _t = wid * 64 + _l; _Pragma("unroll") for (int _i = 0; _i < 2; ++_i) { int _R, _C; stage_rc(_t * 16 + _i * 8192, _R, _C); \
        const int _Rb = Epi::PERM ? ((_R & ~31) + perm32(_R & 31)) : _R; voffB[_i] = (unsigned)(_Rb * K + _C) * 2u; } \
        aoff = lds_byte(wr * 64 + (_l & 15), (_l >> 4) * 8); boff = lds_byte(wc * 32 + (_l & 15), (_l >> 4) * 8); } while (0)
    const size_t kstep = (size_t)(BK * 2);
    const size_t hstep = (size_t)HALF * K * 2;
    const unsigned ldsw = (unsigned)wid * 1024u;
    int aoff, boff; PG8_SETLANE();
#define PG8_SA(b, h) (((b) * 2 + (h)) * HTB)
#define PG8_SB(b, h) ((4 + (b) * 2 + (h)) * HTB)
#define PG8_STAGE(bufoff, gbase, voff) do { _Pragma("unroll") for (int _i = 0; _i < 2; ++_i) \
        __builtin_amdgcn_global_load_lds((const unsigned*)((const char*)(gbase) + (voff)[_i]), (LAS unsigned*)(lds + (bufoff) + ldsw + _i * 8192), 16, 0, 0); } while (0)
#define PG8_LDA(dst, b, h) do { _Pragma("unroll") for (int m = 0; m < 4; ++m) _Pragma("unroll") for (int k = 0; k < 2; ++k) dst[m][k] = *(const LAS bf16x8*)(lds + PG8_SA(b, h) + aoff + m * 2048 + k * 1024); } while (0)
#define PG8_LDB(dst, b, h) do { _Pragma("unroll") for (int n = 0; n < 2; ++n) _Pragma("unroll") for (int k = 0; k < 2; ++k) dst[n][k] = *(const LAS bf16x8*)(lds + PG8_SB(b, h) + boff + n * 2048 + k * 1024); } while (0)
#define PG8_MMA(ai, bj, At, Bt) do { __builtin_amdgcn_s_setprio(1); _Pragma("unroll") for (int m = 0; m < 4; ++m) _Pragma("unroll") for (int n = 0; n < 2; ++n) _Pragma("unroll") for (int k = 0; k < 2; ++k) \
        acc[ai][bj][m][n] = __builtin_amdgcn_mfma_f32_16x16x32_bf16(Bt[n][k], At[m][k], acc[ai][bj][m][n], 0, 0, 0); __builtin_amdgcn_s_setprio(0); } while (0)
#define PG8_WAIT_V(n) asm volatile("s_waitcnt vmcnt(" #n ")" ::: "memory")
#define PG8_WAIT_L(n) asm volatile("s_waitcnt lgkmcnt(" #n ")" ::: "memory")
#define PG8_BAR __builtin_amdgcn_s_barrier()
#define PG8_SCHED __builtin_amdgcn_sched_barrier(0)
#define PG8_SETA(vo, u) do { const int _t = wid * 64 + lane_now(); _Pragma("unroll") for (int _i = 0; _i < 2; ++_i) { int _R, _C; stage_rc(_t * 16 + _i * 8192, _R, _C); \
        _Pragma("unroll") for (int _h = 0; _h < 2; ++_h) vo[_h][_i] = (unsigned)((size_t)S.arow(u, _h * HALF + _R) * (size_t)K + _C) * 2u; } if (Sched::GATHER) PG8_WAIT_V(0); } while (0)
    Unit cur, nxt; int ui = 0;
    if (!S.next(0, cur)) return;
    f32x4 acc[2][2][4][2];
#pragma unroll
    for (int a = 0; a < 2; ++a)
#pragma unroll
        for (int b = 0; b < 2; ++b)
#pragma unroll
            for (int m = 0; m < 4; ++m)
#pragma unroll
                for (int n = 0; n < 2; ++n) acc[a][b][m][n] = (f32x4){0.f, 0.f, 0.f, 0.f};
    bf16x8 At[4][2], B0[2][2], B1[2][2];
    unsigned voC[2][2], voN[2][2];
    S.a_ready(cur);
    PG8_SETA(voC, cur);
    const char* cA = cur.A; const char* cB = cur.B;
    PG8_STAGE(PG8_SB(0, 0), cB, voffB); PG8_STAGE(PG8_SB(0, 1), cB + hstep, voffB); PG8_STAGE(PG8_SA(0, 0), cA, voC[0]); PG8_STAGE(PG8_SA(0, 1), cA, voC[1]);
    if (wr == 1) PG8_BAR;
    PG8_WAIT_V(2); PG8_BAR;
    PG8_STAGE(PG8_SB(1, 0), cB + kstep, voffB); PG8_STAGE(PG8_SA(1, 0), cA + kstep, voC[0]); PG8_STAGE(PG8_SB(1, 1), cB + hstep + kstep, voffB);
    PG8_WAIT_V(6); PG8_BAR;
    for (;;) {
        const bool has_next = S.next(ui + 1, nxt);
        if (has_next) { PG8_SETA(voN, nxt); }
        else {
#pragma unroll
            for (int h = 0; h < 2; ++h)
#pragma unroll
                for (int i = 0; i < 2; ++i) voN[h][i] = voC[h][i];
        }
        const char* nA = has_next ? nxt.A : cA; const char* nB = has_next ? nxt.B : cB;
        for (int t = 0; t < nt; t += 2) {
            const bool last = (t == nt - 2);
            if (last && has_next) S.a_ready(nxt);
            const char* a1 = cA + (size_t)(t + 1) * kstep;
            const char* a2 = last ? nA : cA + (size_t)(t + 2) * kstep; const char* b2 = last ? nB : cB + (size_t)(t + 2) * kstep;
            const char* a3 = a2 + kstep; const char* b3 = b2 + kstep;
            unsigned vo2[2][2];
#pragma unroll
            for (int h = 0; h < 2; ++h)
#pragma unroll
                for (int i = 0; i < 2; ++i) vo2[h][i] = last ? voN[h][i] : voC[h][i];
            PG8_LDB(B0, 0, 0); PG8_LDB(B1, 0, 1); PG8_SCHED; PG8_LDA(At, 0, 0); PG8_STAGE(PG8_SA(1, 1), a1, voC[1]);
            PG8_WAIT_V(8); PG8_WAIT_L(0); PG8_BAR; PG8_MMA(0, 0, At, B0); PG8_MMA(0, 1, At, B1); PG8_BAR; PG8_SCHED;
            PG8_LDA(At, 0, 1); PG8_STAGE(PG8_SB(0, 0), b2, voffB); PG8_STAGE(PG8_SB(0, 1), b2 + hstep, voffB); PG8_STAGE(PG8_SA(0, 0), a2, vo2[0]);
            PG8_WAIT_V(8); PG8_WAIT_L(0); PG8_BAR; PG8_MMA(1, 0, At, B0); PG8_MMA(1, 1, At, B1); PG8_BAR; PG8_SCHED;
            PG8_LDB(B0, 1, 0); PG8_LDB(B1, 1, 1); PG8_SCHED; PG8_LDA(At, 1, 0); PG8_STAGE(PG8_SA(0, 1), a2, vo2[1]);
            PG8_WAIT_V(8); PG8_WAIT_L(0); PG8_BAR; PG8_MMA(0, 0, At, B0); PG8_MMA(0, 1, At, B1); PG8_BAR; PG8_SCHED;
            PG8_LDA(At, 1, 1); PG8_STAGE(PG8_SB(1, 0), b3, voffB); PG8_STAGE(PG8_SB(1, 1), b3 + hstep, voffB); PG8_STAGE(PG8_SA(1, 0), a3, vo2[0]);
            PG8_WAIT_V(8); PG8_WAIT_L(0); PG8_BAR; PG8_MMA(1, 0, At, B0); PG8_MMA(1, 1, At, B1); PG8_BAR; PG8_SCHED;
        }
        if (wr == 0) PG8_BAR;
        const bool keep = E(acc, cur, wr, wc, fr, fq);
        if (!has_next) break;
        if (!keep) {
#pragma unroll
            for (int a = 0; a < 2; ++a)
#pragma unroll
                for (int b = 0; b < 2; ++b)
#pragma unroll
                    for (int m = 0; m < 4; ++m)
#pragma unroll
                        for (int n = 0; n < 2; ++n) acc[a][b][m][n] = (f32x4){0.f, 0.f, 0.f, 0.f};
        }
        cur = nxt; cA = nA; cB = nB; ++ui;
        if (Sched::GATHER) {
#pragma unroll
            for (int h = 0; h < 2; ++h)
#pragma unroll
                for (int i = 0; i < 2; ++i) voC[h][i] = voN[h][i];
        } else { PG8_SETA(voC, cur); }
        PG8_SETLANE();
        if (wr == 1) PG8_BAR;
    }
    PG8_WAIT_V(0);
    PG8_BAR;
#undef PG8_SA
#undef PG8_SB
#undef PG8_STAGE
#undef PG8_LDA
#undef PG8_LDB
#undef PG8_MMA
#undef PG8_WAIT_V
#undef PG8_WAIT_L
#undef PG8_BAR
#undef PG8_SCHED
#undef PG8_SETA
#undef PG8_SETLANE
}
}

struct Args { const float* in[25]; float* out; unsigned char* ws; int ph_lo, ph_hi; };
enum { I_X = 0, I_C, I_WADA, I_BADA, I_N1G, I_WIN, I_LQ1, I_LK1, I_LQ2, I_LK2, I_SUBG, I_LBL, I_HGNG, I_WUPDA, I_WUPHG, I_WOUT, I_N2G, I_WRG, I_BRG, I_WRE, I_BRE, I_W1, I_W3, I_W2, I_FG };

struct DenseOrder {
    static constexpr bool GATHER = false;
    const char* A; const char* Bt; int K, nM, nN, G, c;
    __device__ __forceinline__ bool next(int i, pg8::Unit& u) const {
        const int L = i * G + c, nwg = nM * nN; if (L >= nwg) return false;
        int wgid = L; { const int q = nwg / 8, r = nwg % 8, xcd = wgid % 8, off = wgid / 8; wgid = (xcd < r ? xcd * (q + 1) : r * (q + 1) + (xcd - r) * q) + off; }
        const int nig = 8 * nN, gid = wgid / nig, fm = gid * 8, gsz = (nM - fm) < 8 ? (nM - fm) : 8;
        u.pm = fm + ((wgid % nig) % gsz); u.pn = (wgid % nig) / gsz; u.A = A; u.B = Bt + (size_t)u.pn * 256 * K * 2; u.aux = 0; return true;
    }
    __device__ __forceinline__ void a_ready(const pg8::Unit&) const {}
    __device__ __forceinline__ unsigned arow(const pg8::Unit& u, int r) const { return (unsigned)(u.pm * 256 + r); }
};
struct UpOrder {
    static constexpr bool GATHER = false;
    const char* A0; const char* A1; const char* B0; const char* B1; int G, c;
    __device__ __forceinline__ bool next(int i, pg8::Unit& u) const {
        const int tile = (i >> 1) * G + c; if (tile >= 256) return false;
        u.pm = tile >> 2; u.pn = tile & 3; u.aux = i & 1;
        u.A = (i & 1) ? A1 : A0; u.B = ((i & 1) ? B1 : B0) + (size_t)u.pn * 256 * 512 * 2; return true;
    }
    __device__ __forceinline__ void a_ready(const pg8::Unit&) const {}
    __device__ __forceinline__ unsigned arow(const pg8::Unit& u, int r) const { return (unsigned)(u.pm * 256 + r); }
};
struct MoeTab { int nt; int pad[3]; int tile_e[176]; int tile_m[176]; int cnt[32]; int tbase[33]; };
struct Moe1Order {
    static constexpr bool GATHER = true;
    const LAS MoeTab* tab; const char* A; const char* W; const int* toklist; int G, c;
    __device__ __forceinline__ bool next(int i, pg8::Unit& u) const {
        const int L = i * G + c; if (L >= tab->nt * 4) return false;
        const int ti = L >> 2; u.pm = ti; u.pn = L & 3; u.aux = ti; u.A = A;
        u.B = W + ((size_t)tab->tile_e[ti] * 1024 + (size_t)u.pn * 256) * 1024 * 2; return true;
    }
    __device__ __forceinline__ void a_ready(const pg8::Unit&) const {}
    __device__ __forceinline__ unsigned arow(const pg8::Unit& u, int r) const {
        const int e = tab->tile_e[u.aux], rr = tab->tile_m[u.aux] * 256 + r;
        return rr < tab->cnt[e] ? (unsigned)toklist[e * T + rr] : 0u;
    }
};
struct Moe2Order {
    static constexpr bool GATHER = false;
    const LAS MoeTab* tab; const char* A; const char* W; unsigned* done; unsigned* tmo; int G, c;
    __device__ __forceinline__ bool next(int i, pg8::Unit& u) const {
        const int n1 = tab->nt * 4, r = n1 % G, nl = G - r; int j;
        if (r > 0 && c >= r) { if (i < 2) j = (c - r) + i * nl; else j = 2 * nl + (c - r) + (i - 2) * G; }
        else j = (r > 0 ? 2 * nl : 0) + ((c - r + G) % G) + i * G;
        if (j >= n1) return false;
        const int ti = j >> 2; u.pm = ti; u.pn = j & 3; u.aux = ti; u.A = A;
        u.B = W + ((size_t)tab->tile_e[ti] * 1024 + (size_t)u.pn * 256) * 512 * 2; return true;
    }
    __device__ __forceinline__ unsigned arow(const pg8::Unit& u, int r) const { return (unsigned)(u.pm * 256 + r); }
    __device__ __forceinline__ void a_ready(const pg8::Unit& u) const {
        if (threadIdx.x < 64) {
            unsigned polls = 0;
            while ((unsigned)__builtin_amdgcn_readfirstlane(__hip_atomic_load(done + 16 * u.pm, __ATOMIC_RELAXED, __HIP_MEMORY_SCOPE_AGENT)) < 32u) {
                if (++polls > (1u << 22)) { if (threadIdx.x == 0) __hip_atomic_store(tmo, 1u, __ATOMIC_RELAXED, __HIP_MEMORY_SCOPE_AGENT); break; }
                __builtin_amdgcn_s_sleep(2); }
            __builtin_amdgcn_fence(__ATOMIC_ACQUIRE, "agent");
            asm volatile("s_waitcnt vmcnt(0)" ::: "memory");
        }
        asm volatile("" ::: "memory"); __builtin_amdgcn_s_barrier(); asm volatile("" ::: "memory");
    }
};

using pg8::Unit; using pg8::cvt_pk_bf16;
struct EpiStoreBf16 {
    static constexpr bool PERM = true;
    bf16_t* O; int ldc; int nscale; float scale0;
    __device__ __forceinline__ bool operator()(f32x4 (&acc)[2][2][4][2], const Unit& u, int wr, int wc, int fr, int fq) const {
        const int row0 = u.pm * 256 + wr * 64 + fr, col0 = u.pn * 256 + wc * 32 + 8 * fq;
        const float sc = u.pn < nscale ? scale0 : 1.0f;
#pragma unroll
        for (int ai = 0; ai < 2; ++ai)
#pragma unroll
            for (int m = 0; m < 4; ++m) { bf16_t* rowp = O + (size_t)(row0 + ai * 128 + m * 16) * ldc + col0;
#pragma unroll
                for (int bj = 0; bj < 2; ++bj) { const f32x4 v0 = acc[ai][bj][m][0] * sc, v1 = acc[ai][bj][m][1] * sc;
                    u32x4 w; w.x = cvt_pk_bf16(v0[0], v0[1]); w.y = cvt_pk_bf16(v0[2], v0[3]); w.z = cvt_pk_bf16(v1[0], v1[1]); w.w = cvt_pk_bf16(v1[2], v1[3]);
                    *(u32x4*)(rowp + bj * 128) = w; } }
        return false;
    }
};
template <int N> __device__ __forceinline__ float dpp_shr(float x) { return __builtin_bit_cast(float, __builtin_amdgcn_update_dpp(0, __builtin_bit_cast(int, x), 0x110 + N, 0xf, 0xf, true)); }
template <int N> __device__ __forceinline__ float dpp_ror(float x) { return __builtin_bit_cast(float, __builtin_amdgcn_update_dpp(0, __builtin_bit_cast(int, x), 0x120 + N, 0xf, 0xf, true)); }
__device__ __forceinline__ float rowsum16(float x) { x += dpp_ror<8>(x); x += dpp_ror<4>(x); x += dpp_ror<2>(x); x += dpp_ror<1>(x); return x; }
__device__ __forceinline__ float scan16(float x) { x += dpp_shr<1>(x); x += dpp_shr<2>(x); x += dpp_shr<4>(x); x += dpp_shr<8>(x); return x; }
struct EpiInProj {
    static constexpr bool PERM = true;
    bf16_t* O; bf16_t* KE; float* DEC; const float* lbv; float scale0;
    __device__ __forceinline__ bool operator()(f32x4 (&acc)[2][2][4][2], const Unit& u, int wr, int wc, int fr, int fq) const {
        { const int l_ = lane_now(); fr = l_ & 15; fq = l_ >> 4; }
        const int row0 = u.pm * 256 + wr * 64 + fr, col0 = u.pn * 256 + wc * 32 + 8 * fq;
        if (u.pn >= 6 && u.pn < 10) {
            const int h = u.pn - 6, lane = 16 * fq + fr, kb = wc * 32 + 8 * fq;
            const int bb = (u.pm * 256) / SEQ, ch0 = ((u.pm * 256) % SEQ + wr * 64) >> 6;
#pragma unroll
            for (int ai = 0; ai < 2; ++ai) {
                unsigned kep[4][4];
#pragma unroll
                for (int n = 0; n < 2; ++n) {
#pragma unroll
                    for (int ep = 0; ep < 2; ++ep) {
                        float ke2[2][4];
#pragma unroll
                        for (int z = 0; z < 2; ++z) {
                            const int e = 2 * ep + z; const float lb = lbv[h * 128 + kb + 4 * n + e];
                            float f[4], c[4], tot[4];
#pragma unroll
                            for (int m = 0; m < 4; ++m) { const float fl = acc[ai][1][m][n][e]; f[m] = lb + (1.0f - lb) * __builtin_amdgcn_rcpf(1.0f + __builtin_amdgcn_exp2f(-1.4426950408889634f * fl)); const float lf = __logf(f[m]); c[m] = scan16(lf); tot[m] = rowsum16(lf); }
                            const float alast = (tot[0] + tot[1]) + (tot[2] + tot[3]); const float eal = __expf(alast);
                            float pre = 0.f;
#pragma unroll
                            for (int m = 0; m < 4; ++m) { const float A = c[m] + pre; pre += tot[m]; const float q = acc[ai][0][m][n][e]; const float kk = 1.0f - f[m];
                                acc[ai][0][m][n][e] = q * __builtin_amdgcn_rcpf(1.0f + __builtin_amdgcn_exp2f(-1.4426950408889634f * q)) * __expf(A);
                                const float kd = kk * __expf(-A); acc[ai][1][m][n][e] = kd; ke2[z][m] = kd * eal; }
                            if (fr == 0) DEC[((size_t)(bb * 4 + h) * 64 + ch0 + 2 * ai) * 128 + kb + 4 * n + e] = eal;
                        }
#pragma unroll
                        for (int m = 0; m < 4; ++m) kep[m][2 * n + ep] = cvt_pk_bf16(ke2[0][m], ke2[1][m]);
                    }
                }
#pragma unroll
                for (int m = 0; m < 4; ++m) *(u32x4*)(KE + (size_t)(row0 + ai * 128 + m * 16) * 512 + h * 128 + kb) = (u32x4){kep[m][0], kep[m][1], kep[m][2], kep[m][3]};
            }
        }
        const float sc = u.pn < 2 ? scale0 : 1.0f;
#pragma unroll
        for (int ai = 0; ai < 2; ++ai)
#pragma unroll
            for (int m = 0; m < 4; ++m) { bf16_t* rowp = O + (size_t)(row0 + ai * 128 + m * 16) * INC + col0;
#pragma unroll
                for (int bj = 0; bj < 2; ++bj) { const f32x4 v0 = acc[ai][bj][m][0] * sc, v1 = acc[ai][bj][m][1] * sc;
                    u32x4 w; w.x = cvt_pk_bf16(v0[0], v0[1]); w.y = cvt_pk_bf16(v0[2], v0[3]); w.z = cvt_pk_bf16(v1[0], v1[1]); w.w = cvt_pk_bf16(v1[2], v1[3]);
                    *(u32x4*)(rowp + bj * 128) = w; } }
        return false;
    }
};
struct EpiUp {
    static constexpr bool PERM = true;
    const bf16_t* proj; bf16_t* O;
    __device__ __forceinline__ bool operator()(f32x4 (&acc)[2][2][4][2], const Unit& u, int wr, int wc, int fr, int fq) const {
        const int row0 = u.pm * 256 + wr * 64 + fr, col0 = u.pn * 256 + wc * 32 + 8 * fq;
#pragma unroll
        for (int ai = 0; ai < 2; ++ai)
#pragma unroll
            for (int m = 0; m < 4; ++m) { const size_t row = (size_t)(row0 + ai * 128 + m * 16);
#pragma unroll
                for (int bj = 0; bj < 2; ++bj) {
                    const int col = col0 + bj * 128;
                    const u32x4 gh = *(const u32x4*)(proj + row * INC + C_GHGATE + col);
                    float sh[8];
#pragma unroll
                    for (int j = 0; j < 4; ++j) { sh[2 * j] = 1.0f + __builtin_amdgcn_exp2f(-1.4426950408889634f * bf2f(gh[j] & 0xffffu)); sh[2 * j + 1] = 1.0f + __builtin_amdgcn_exp2f(-1.4426950408889634f * bf2f(gh[j] >> 16)); }
                    if (u.aux == 0) {
                        const u32x4 gd = *(const u32x4*)(proj + row * INC + C_GDA + col);
#pragma unroll
                        for (int j = 0; j < 4; ++j) {
                            const float d0 = 1.0f + __builtin_amdgcn_exp2f(-1.4426950408889634f * bf2f(gd[j] & 0xffffu)), d1 = 1.0f + __builtin_amdgcn_exp2f(-1.4426950408889634f * bf2f(gd[j] >> 16));
                            const float r0 = sh[2 * j] * __builtin_amdgcn_rcpf(d0), r1 = sh[2 * j + 1] * __builtin_amdgcn_rcpf(d1);
                            if (j < 2) { acc[ai][bj][m][0][2 * j] *= r0; acc[ai][bj][m][0][2 * j + 1] *= r1; }
                            else { acc[ai][bj][m][1][2 * j - 4] *= r0; acc[ai][bj][m][1][2 * j - 3] *= r1; }
                        }
                    } else {
                        const f32x4 v0 = acc[ai][bj][m][0], v1 = acc[ai][bj][m][1];
#pragma unroll
                        for (int j = 0; j < 8; ++j) sh[j] = __builtin_amdgcn_rcpf(sh[j]);
                        u32x4 w; w.x = cvt_pk_bf16(v0[0] * sh[0], v0[1] * sh[1]); w.y = cvt_pk_bf16(v0[2] * sh[2], v0[3] * sh[3]);
                        w.z = cvt_pk_bf16(v1[0] * sh[4], v1[1] * sh[5]); w.w = cvt_pk_bf16(v1[2] * sh[6], v1[3] * sh[7]);
                        *(u32x4*)(O + row * D + col) = w;
                    }
                } }
        return u.aux == 0;
    }
};
struct EpiOut {
    static constexpr bool PERM = false;
    const float* x; const float* mod; float* O;
    __device__ __forceinline__ bool operator()(f32x4 (&acc)[2][2][4][2], const Unit& u, int wr, int wc, int fr, int fq) const {
        const int row0 = u.pm * 256 + wr * 64 + fr, col0 = u.pn * 256 + wc * 32 + 4 * fq;
        const int b = (u.pm * 256) / SEQ;
        f32x4 gt[2][2];
#pragma unroll
        for (int bj = 0; bj < 2; ++bj)
#pragma unroll
            for (int n = 0; n < 2; ++n) gt[bj][n] = *(const f32x4*)(mod + b * 6144 + 2048 + col0 + bj * 128 + n * 16);
#pragma unroll
        for (int ai = 0; ai < 2; ++ai)
#pragma unroll
            for (int m = 0; m < 4; ++m) { const size_t off = (size_t)(row0 + ai * 128 + m * 16) * D + col0;
#pragma unroll
                for (int bj = 0; bj < 2; ++bj)
#pragma unroll
                    for (int n = 0; n < 2; ++n) { const f32x4 xv = *(const f32x4*)(x + off + bj * 128 + n * 16);
                        *(f32x4*)(O + off + bj * 128 + n * 16) = xv + gt[bj][n] * acc[ai][bj][m][n]; } }
        return false;
    }
};
struct EpiMoe1 {
    static constexpr bool PERM = true;
    bf16_t* O; unsigned* done;
    __device__ __forceinline__ bool operator()(f32x4 (&acc)[2][2][4][2], const Unit& u, int wr, int wc, int fr, int fq) const {
        const int row0 = u.pm * 256 + wr * 64 + fr, col0 = u.pn * 128 + wc * 32 + 8 * fq;
#pragma unroll
        for (int ai = 0; ai < 2; ++ai)
#pragma unroll
            for (int m = 0; m < 4; ++m) { bf16_t* rowp = O + (size_t)(row0 + ai * 128 + m * 16) * DEXP + col0;
                float h[8];
#pragma unroll
                for (int n = 0; n < 2; ++n)
#pragma unroll
                    for (int e = 0; e < 4; ++e) { const float x_ = acc[ai][0][m][n][e]; h[n * 4 + e] = x_ * __builtin_amdgcn_rcpf(1.0f + __builtin_amdgcn_exp2f(-1.4426950408889634f * x_)) * acc[ai][1][m][n][e]; }
                u32x4 w; w.x = cvt_pk_bf16(h[0], h[1]); w.y = cvt_pk_bf16(h[2], h[3]); w.z = cvt_pk_bf16(h[4], h[5]); w.w = cvt_pk_bf16(h[6], h[7]);
                asm volatile("global_store_dwordx4 %0, %1, off sc1\n\ts_nop 1" :: "v"(rowp), "v"(w) : "memory"); }
        asm volatile("s_waitcnt vmcnt(0)" ::: "memory");
        if ((threadIdx.x & 63) == 0) __hip_atomic_fetch_add(done + 16 * u.pm, 1u, __ATOMIC_RELAXED, __HIP_MEMORY_SCOPE_AGENT);
        return false;
    }
};

struct Frame { LAS unsigned char* lds; int tid, lane, wave, G, bid; };

__device__ __forceinline__ void transpose_item(const float* Wsrc, int ldw, bf16_t* dst, int ldd, LAS float* scr, int lane) {
#pragma unroll 8
    for (int i = 0; i < 32; ++i) { const int kk = 2 * i + (lane >> 5); scr[kk * 33 + (lane & 31)] = __builtin_nontemporal_load(Wsrc + (size_t)kk * ldw + (lane & 31)); }
    asm volatile("s_waitcnt lgkmcnt(0)" ::: "memory");
    const int c = lane & 7;
#pragma unroll
    for (int j = 0; j < 4; ++j) { const int n = (lane >> 3) + 8 * j; const LAS float* s = scr + (8 * c) * 33 + n;
        u32x4 o; o.x = pk2(s[0 * 33], s[1 * 33]); o.y = pk2(s[2 * 33], s[3 * 33]); o.z = pk2(s[4 * 33], s[5 * 33]); o.w = pk2(s[6 * 33], s[7 * 33]);
        *(u32x4*)(dst + (size_t)n * ldd + 8 * c) = o; }
    asm volatile("s_waitcnt lgkmcnt(0)" ::: "memory");
}
__device__ __forceinline__ void transpose_matrix(const Frame& F, const float* W, int K, int N, bf16_t* WT) {
    LAS float* scr = (LAS float*)(F.lds + F.wave * 8448);
    const int gw = F.bid * NWAVES + F.wave, NGW = F.G * NWAVES, nblk = N / 32, items = (K / 64) * nblk;
    for (int it = gw; it < items; it += NGW) { const int kb = it / nblk, nb = it % nblk;
        transpose_item(W + (size_t)(64 * kb) * N + 32 * nb, N, WT + (size_t)(32 * nb) * K + 64 * kb, K, scr, F.lane); }
}

__device__ __forceinline__ void phase0(const Frame& F, const Args& a) {
    unsigned char* ws = a.ws;
    {
        float* modp = (float*)(ws + WS_MODP);
        const float* c = a.in[I_C]; const float* wada = a.in[I_WADA];
        LAS float* cs = (LAS float*)(F.lds + 72 * 1024);
        for (int i = F.tid; i < 4 * D; i += NTHR) cs[i] = siluf_(c[i]);
        __syncthreads();
        for (int wt = F.bid + 256 * F.wave; wt < 384; wt += 256 * NWAVES) {
            if (F.G != 256) break;
            const int ks = wt / 24, jw = wt % 24, j = jw * 256 + F.lane * 4;
            f32x4 s[4] = {{0, 0, 0, 0}, {0, 0, 0, 0}, {0, 0, 0, 0}, {0, 0, 0, 0}};
#pragma unroll 8
            for (int k = ks * 64; k < ks * 64 + 64; ++k) {
                const f32x4 w = *(const f32x4*)(wada + (size_t)k * 6144 + j);
#pragma unroll
                for (int b = 0; b < 4; ++b) s[b] += w * cs[b * D + k];
            }
#pragma unroll
            for (int b = 0; b < 4; ++b) *(f32x4*)(modp + ((size_t)ks * 4 + b) * 6144 + j) = s[b];
        }
        if (F.G != 256) {
            const int gw = F.bid * NWAVES + F.wave, NGW = F.G * NWAVES;
            for (int wt = gw; wt < 384; wt += NGW) {
                const int ks = wt / 24, jw = wt % 24, j = jw * 256 + F.lane * 4;
                f32x4 s[4] = {{0, 0, 0, 0}, {0, 0, 0, 0}, {0, 0, 0, 0}, {0, 0, 0, 0}};
                for (int k = ks * 64; k < ks * 64 + 64; ++k) {
                    const f32x4 w = *(const f32x4*)(wada + (size_t)k * 6144 + j);
#pragma unroll
                    for (int b = 0; b < 4; ++b) { const float cv = siluf_(c[b * D + k]); s[b] += w * cv; }
                }
#pragma unroll
                for (int b = 0; b < 4; ++b) *(f32x4*)(modp + ((size_t)ks * 4 + b) * 6144 + j) = s[b];
            }
        }
    }
    if (F.bid == 0) {
        float* sm = (float*)(ws + WS_SMALL);
        if (F.tid == 0) {
            float s1 = 0.f, s2 = 0.f;
            for (int i = 0; i < 64; ++i) { s1 += a.in[I_LQ1][i] * a.in[I_LK1][i]; s2 += a.in[I_LQ2][i] * a.in[I_LK2][i]; }
            sm[0] = expf(s1) - expf(s2) + 0.2f;
        }
        { const float l0 = a.in[I_LBL][F.tid], l1 = a.in[I_LBL][512 + F.tid]; const float mx = fmaxf(l0, l1);
          const float e0 = expf(l0 - mx), e1 = expf(l1 - mx); sm[16 + F.tid] = e0 / (e0 + e1); }
    }
}
__device__ __forceinline__ void moe_weight_convert(const Frame& F, const Args& a) {
    LAS float* scr = (LAS float*)(F.lds + F.wave * 8448);
    const int gw = F.bid * NWAVES + F.wave, NGW = F.G * NWAVES;
    bf16_t* w13 = (bf16_t*)(a.ws + WS_W13); bf16_t* w2t = (bf16_t*)(a.ws + WS_W2);
    for (int it = gw; it < 2 * NEXP * 256; it += NGW) {
        const int which = it / (NEXP * 256), r = it % (NEXP * 256), e = r >> 8, kb = (r >> 4) & 15, nb = r & 15, n0 = 32 * nb;
        const float* W = a.in[which ? I_W3 : I_W1] + (size_t)e * 1024 * 512;
        const int drow = 256 * (n0 >> 7) + (which ? 128 : 0) + (n0 & 127);
        transpose_item(W + (size_t)(64 * kb) * 512 + n0, 512, w13 + ((size_t)e * 1024 + drow) * 1024 + 64 * kb, 1024, scr, F.lane);
    }
    for (int it = gw; it < NEXP * 256; it += NGW) {
        const int e = it >> 8, kb = (it >> 5) & 7, nb = it & 31;
        const float* W = a.in[I_W2] + (size_t)e * 512 * 1024;
        transpose_item(W + (size_t)(64 * kb) * 1024 + 32 * nb, 1024, w2t + ((size_t)e * 1024 + 32 * nb) * 512 + 64 * kb, 512, scr, F.lane);
    }
}

__device__ __forceinline__ void dense_weight_convert(const Frame& F, const Args& a) {
    unsigned char* ws = a.ws;
    {
        LAS float* scr = (LAS float*)(F.lds + F.wave * 8448);
        const int gw = F.bid * NWAVES + F.wave, NGW = F.G * NWAVES, nblk = INC / 32, items = (D / 64) * nblk;
        bf16_t* WT = (bf16_t*)(ws + WS_WIN);
        for (int it = gw; it < items; it += NGW) { const int kb = it / nblk, n0 = 32 * (it % nblk); int dr = n0;
            if (n0 >= C_QHG && n0 < C_FHG) dr = C_HGT + 256 * ((n0 - C_QHG) >> 7) + ((n0 - C_QHG) & 127);
            else if (n0 >= C_FHG && n0 < C_IHG) dr = C_HGT + 256 * ((n0 - C_FHG) >> 7) + 128 + ((n0 - C_FHG) & 127);
            transpose_item(a.in[I_WIN] + (size_t)(64 * kb) * INC + n0, INC, WT + (size_t)dr * D + 64 * kb, D, scr, F.lane); }
    }
    transpose_matrix(F, a.in[I_WUPDA], 512, D, (bf16_t*)(ws + WS_WUPDA));
    transpose_matrix(F, a.in[I_WUPHG], 512, D, (bf16_t*)(ws + WS_WUPHG));
    transpose_matrix(F, a.in[I_WOUT], D, D, (bf16_t*)(ws + WS_WOUT));
}
__device__ __forceinline__ void phase1(const Frame& F, const Args& a) {
    const float* modp = (const float*)(a.ws + WS_MODP); float* mod = (float*)(a.ws + WS_MOD);
    for (int i = F.bid * NTHR + F.tid; i < 4 * 6144; i += F.G * NTHR) {
        float s = a.in[I_BADA][i % 6144];
        for (int ks = 0; ks < 16; ++ks) s += modp[(size_t)ks * 4 * 6144 + i];
        mod[i] = s;
    }
    LAS float* Gs = (LAS float*)F.lds;
    LAS float* Ss = Gs + 1024;
    bf16_t* H = (bf16_t*)(a.ws + WS_ACT);
    const int rows_per_blk = T / F.G;
    const int r0 = F.bid * rows_per_blk, b = r0 / SEQ;
    for (int k = F.tid; k < 1024; k += NTHR) {
        float sh = a.in[I_BADA][k], sc = a.in[I_BADA][1024 + k];
        for (int ks = 0; ks < 16; ++ks) { sh += modp[((size_t)ks * 4 + b) * 6144 + k]; sc += modp[((size_t)ks * 4 + b) * 6144 + 1024 + k]; }
        Gs[k] = a.in[I_N1G][k] * (1.0f + sc); Ss[k] = sh;
    }
    __syncthreads();
    for (int r = r0 + F.wave; r < r0 + rows_per_blk; r += NWAVES) {
        const f32x4* xr = (const f32x4*)(a.in[I_X] + (size_t)r * D) + F.lane;
        f32x4 v[4]; float s = 0.f;
#pragma unroll
        for (int j = 0; j < 4; ++j) { v[j] = xr[64 * j]; s += (v[j].x * v[j].x + v[j].y * v[j].y) + (v[j].z * v[j].z + v[j].w * v[j].w); }
        const float rs = rsqrtf(wave_sum(s) * (1.0f / D) + EPS);
        unsigned long long* o8 = (unsigned long long*)(H + (size_t)r * D) + F.lane;
#pragma unroll
        for (int j = 0; j < 4; ++j) { const f32x4 g = *(const LAS f32x4*)(Gs + 256 * j + 4 * F.lane), sh = *(const LAS f32x4*)(Ss + 256 * j + 4 * F.lane);
            const f32x4 h = v[j] * rs * g + sh;
            o8[64 * j] = (unsigned long long)pk2(h.x, h.y) | ((unsigned long long)pk2(h.z, h.w) << 32); }
    }
}

namespace attn_body {
using s16x4=__attribute__((ext_vector_type(4)))short;
using f32x16=__attribute__((ext_vector_type(16)))float;
constexpr int NW=8,QBLK=32,QB=QBLK*NW,KVBLK=64,NQB=SEQ/QB;
constexpr int PIN=INC, POUT=1024;
__device__ __forceinline__ int crow(int r,int hi){return (r&3)+8*(r>>2)+4*hi;}
#define SBAR() __builtin_amdgcn_sched_barrier(0)
__device__ __forceinline__ void bmask(f32x16&p0,f32x16&p1,int jb,int wch,int il,int hi,float s2x2){
  if(jb>wch){
    #pragma unroll
    for(int r=0;r<16;++r){p0[r]=-INFINITY;p1[r]=-INFINITY;}
  } else if(jb==wch){
    float fb=(float)(4*hi-il); asm volatile("":"+v"(fb));
    #pragma unroll
    for(int r=0;r<16;++r){const float c=(float)((r&3)+8*(r>>2)); p0[r]-=s2x2*__builtin_fmaxf(fb+c,0.f); p1[r]-=s2x2*__builtin_fmaxf(fb+(c+32.f),0.f);}
  }
}
constexpr int NSLOT=3, SLOTB=8192, VSLOTB=16384;
constexpr int LDS_K=0, LDS_V=NSLOT*SLOTB, LDS_WS=LDS_V+NSLOT*VSLOTB, LDS_OST=LDS_WS+NW*64*4, ATT_LDS_BYTES=LDS_OST+NW*8192;
constexpr float C2=0.125f*1.4426950408889634f;
__device__ __forceinline__ void glds16(const void*gsrc,unsigned lds_dst){unsigned keep;
  asm volatile("s_mov_b32 %0, m0\n\ts_mov_b32 m0, %2\n\ts_nop 0\n\tglobal_load_lds_dwordx4 %1, off\n\ts_mov_b32 m0, %0":"=&s"(keep):"v"(gsrc),"s"(lds_dst):"memory");}
__device__ __forceinline__ float max3f(float a,float b,float c){float r;asm("v_max3_f32 %0, %1, %2, %3":"=v"(r):"v"(a),"v"(b),"v"(c));return r;}
__device__ __forceinline__ float max2f(float a,float b){float r;asm("v_max_f32_e32 %0, %1, %2":"=v"(r):"v"(a),"v"(b));return r;}
__device__ __forceinline__ float fadd_s(float a,float b){float r;asm("v_add_f32_e32 %0, %1, %2":"=v"(r):"v"(a),"v"(b));return r;}
__device__ __forceinline__ float fsub_s(float a,float b){float r;asm("v_sub_f32_e32 %0, %1, %2":"=v"(r):"v"(a),"v"(b));return r;}
typedef float f32x2_t __attribute__((ext_vector_type(2))); typedef __bf16 bf16x2_t __attribute__((ext_vector_type(2)));
__device__ __forceinline__ unsigned cvtpk_s(float lo,float hi){f32x2_t v={lo,hi};bf16x2_t b=__builtin_convertvector(v,bf16x2_t);return __builtin_bit_cast(unsigned,b);}
#define WAIT_BAR(N) asm volatile("s_waitcnt vmcnt(" #N ") lgkmcnt(0)\n\ts_barrier":::"memory")

__device__ __forceinline__ void qkt(f32x16&p0,f32x16&p1,const char*Kslot,const bf16x8*qr,const f32x16&c0,const f32x16&c1,int r32,int hi){
  const char*kb=Kslot+hi*1024+r32*16;
  #pragma unroll
  for(int d0=0;d0<4;++d0){
    const bf16x8 b0=*reinterpret_cast<const bf16x8*>(kb+d0*2048);
    const bf16x8 b1=*reinterpret_cast<const bf16x8*>(kb+d0*2048+512);
    if(d0==0){p0=__builtin_amdgcn_mfma_f32_32x32x16_bf16(b0,qr[0],c0,0,0,0);p1=__builtin_amdgcn_mfma_f32_32x32x16_bf16(b1,qr[0],c1,0,0,0);}
    else{p0=__builtin_amdgcn_mfma_f32_32x32x16_bf16(b0,qr[d0],p0,0,0,0);p1=__builtin_amdgcn_mfma_f32_32x32x16_bf16(b1,qr[d0],p1,0,0,0);}}
}
typedef __attribute__((address_space(3))) const char* lds_cptr;
typedef short v4i16_t __attribute__((ext_vector_type(4)));
__device__ __forceinline__ void kload8(bf16x8*kf,lds_cptr kp){
  kf[0]=*(const __attribute__((address_space(3))) bf16x8*)(kp);      kf[1]=*(const __attribute__((address_space(3))) bf16x8*)(kp+512);
  kf[2]=*(const __attribute__((address_space(3))) bf16x8*)(kp+2048); kf[3]=*(const __attribute__((address_space(3))) bf16x8*)(kp+2560);
  kf[4]=*(const __attribute__((address_space(3))) bf16x8*)(kp+4096); kf[5]=*(const __attribute__((address_space(3))) bf16x8*)(kp+4608);
  kf[6]=*(const __attribute__((address_space(3))) bf16x8*)(kp+6144); kf[7]=*(const __attribute__((address_space(3))) bf16x8*)(kp+6656);
}
__device__ __forceinline__ void kload2(bf16x8*kf,lds_cptr kp,int j){ kf[2*j]=*(const __attribute__((address_space(3))) bf16x8*)(kp+j*2048); kf[2*j+1]=*(const __attribute__((address_space(3))) bf16x8*)(kp+j*2048+512); }
__device__ __forceinline__ s16x4 vtr(lds_cptr p){ return __builtin_bit_cast(s16x4,__builtin_amdgcn_ds_read_tr16_b64_v4i16((__attribute__((address_space(3))) v4i16_t*)p)); }
__device__ __forceinline__ float rowmax(const f32x16&p0,const f32x16&p1){
  float a=max3f(p0[0],p0[1],p1[0]),b=max3f(p0[2],p0[3],p1[1]);a=max3f(a,p1[2],p1[3]);
  #pragma unroll
  for(int r=4;r<16;r+=4){a=max3f(a,p0[r],p0[r+1]);b=max3f(b,p0[r+2],p0[r+3]);a=max3f(a,p1[r],p1[r+1]);b=max3f(b,p1[r+2],p1[r+3]);}
  const float m=max2f(a,b);
  auto rr=__builtin_amdgcn_permlane32_swap(__float_as_uint(m),__float_as_uint(m),false,false);
  return max2f(__uint_as_float(rr[0]),__uint_as_float(rr[1]));
}
__device__ __forceinline__ void pv(f32x16*o,int vb,bf16x8 pa0,bf16x8 pa1,bf16x8 pa2,bf16x8 pa3){
  #pragma unroll
  for(int d0=0;d0<4;++d0){s16x4 lo[4],hi[4];
    #pragma unroll
    for(int ks=0;ks<4;++ks){
      asm volatile("ds_read_b64_tr_b16 %0,%1 offset:%c2":"=&v"(lo[ks]):"v"(vb),"i"(d0*4096+ks*1024):"memory");
      asm volatile("ds_read_b64_tr_b16 %0,%1 offset:%c2":"=&v"(hi[ks]):"v"(vb),"i"(d0*4096+ks*1024+512):"memory");}
    asm volatile("s_waitcnt lgkmcnt(0)":::"memory");SBAR();
    #define PK(k) (bf16x8){lo[k][0],lo[k][1],lo[k][2],lo[k][3],hi[k][0],hi[k][1],hi[k][2],hi[k][3]}
    o[d0]=__builtin_amdgcn_mfma_f32_32x32x16_bf16(pa0,PK(0),o[d0],0,0,0);
    o[d0]=__builtin_amdgcn_mfma_f32_32x32x16_bf16(pa1,PK(1),o[d0],0,0,0);
    o[d0]=__builtin_amdgcn_mfma_f32_32x32x16_bf16(pa2,PK(2),o[d0],0,0,0);
    o[d0]=__builtin_amdgcn_mfma_f32_32x32x16_bf16(pa3,PK(3),o[d0],0,0,0);
    #undef PK
  }
}
#define ATTN_STORE16(p,v) (*(u32x4*)(p)=(v))
template<int THRL> __device__ __forceinline__ void attn_unit(int qb,const bf16_t*Qb,const bf16_t*__restrict__ Kh,const bf16_t*__restrict__ Vh,bf16_t*Ob,float slope2,char*shm){
  const int wid=__builtin_amdgcn_readfirstlane(threadIdx.x>>6); const int lane=lane_now(),r32=lane&31,hi=lane>>5;
  const int q0=qb*QB;
  const bf16_t*Qw=Qb+(long)(q0+wid*QBLK)*PIN;
  const unsigned lds0=(unsigned)(uintptr_t)shm;
  float*wsf=(float*)(shm+LDS_WS)+wid*64;
  const bf16_t*ksrc=Kh+(long)lane*PIN+wid*8;
  const bf16_t*vsrc=Vh+(long)(16*(wid&3)+(lane>>2))*PIN+(wid>>2)*32+(lane&3)*8;
  const unsigned kdst=lds0+LDS_K+wid*1024, vdst=lds0+LDS_V+(wid>>2)*4096+(wid&3)*1024;
  #define DMA_K(t,slot) glds16(ksrc+(long)(t)*KVBLK*PIN,(unsigned)__builtin_amdgcn_readfirstlane(kdst+(slot)))
  #define DMA_V(t,slot) do{ glds16(vsrc+(long)(t)*KVBLK*PIN,(unsigned)__builtin_amdgcn_readfirstlane(vdst+2*(slot))); glds16(vsrc+(long)(t)*KVBLK*PIN+64,(unsigned)__builtin_amdgcn_readfirstlane(vdst+2*(slot)+8192)); }while(0)
  const int vb0=(int)(lds0+LDS_V)+((lane>>4)&1)*32+(lane&3)*8+(4*hi+((lane&15)>>2))*64;
  const char*Kbase=shm+LDS_K; bf16x8 kf[8];
  const lds_cptr shm3=(lds_cptr)shm; const lds_cptr kp0=shm3+LDS_K+hi*1024+r32*16; const lds_cptr vp0=shm3+LDS_V+((lane>>4)&1)*32+(lane&3)*8+(4*hi+((lane&15)>>2))*64;
  const int NT=(q0+QB)/KVBLK;
  DMA_K(0,0);DMA_V(0,0);DMA_K(1,SLOTB);
  bf16x8 qr[4];
  #pragma unroll
  for(int d0=0;d0<4;++d0)qr[d0]=*reinterpret_cast<const bf16x8*>(&Qw[(long)r32*PIN+d0*16+hi*8]);
  float mhat=0.f,l_reg=0.f;f32x16 o[4];o[0]=f32x16{};o[1]=f32x16{};o[2]=f32x16{};o[3]=f32x16{};
  const float s64=slope2*64.f, s32=slope2*32.f, s2x2=2.f*slope2, s4hi=slope2*4.f*(float)hi;
  const int wch=wid>>1, il=32*(wid&1)+r32;
  #define CMASK(P0,P1,t) do{int jb_=(t)-(NT-4); if(jb_>=0)bmask(P0,P1,jb_,wch,il,hi,s2x2);}while(0)
  #define CINIT0(C0,t) do{ const float bt_=s64*(float)((t)-NT)-mhat+s4hi; _Pragma("unroll") for(int r=0;r<16;++r){C0[r]=__builtin_fmaf(slope2,(float)((r&3)+8*(r>>2)),bt_);} }while(0)
  #define CINIT1(C1,t) do{ const float bu_=s64*(float)((t)-NT)-mhat+s4hi+s32; _Pragma("unroll") for(int r=0;r<16;++r){C1[r]=__builtin_fmaf(slope2,(float)((r&3)+8*(r>>2)),bu_);} }while(0)
  bool resc=false;
  #define START(P0,P1) do{ const float rm=rowmax(P0,P1); resc=false; \
    { const float dl=rm; mhat=fadd_s(mhat,dl); \
      _Pragma("unroll") for(int r=0;r<16;++r){P0[r]=fsub_s(P0[r],dl);P1[r]=fsub_s(P1[r],dl);} } \
    _Pragma("unroll") for(int r=0;r<16;++r)P0[r]=__builtin_amdgcn_exp2f(P0[r]); }while(0)
  #define RESC() do{ if(resc){ asm volatile("s_waitcnt lgkmcnt(0)":::"memory"); \
      _Pragma("unroll") for(int d_=0;d_<4;++d_) _Pragma("unroll") for(int r=0;r<16;++r)o[d_][r]*=wsf[crow(r,hi)]; } }while(0)
  f32x16 cS0,cS1;
  u32x4 pwa0,pwa1,pwa2,pwa3,pwb0,pwb1,pwb2,pwb3;
  int sl_prev=0,sl_cur=0,sl_next=SLOTB;
  #define ROT() do{sl_prev=sl_cur;sl_cur=sl_next;sl_next=(sl_next==(NSLOT-1)*SLOTB)?0:sl_next+SLOTB;}while(0)
  #define PKW(P,B) cvtpk_s(P[B],P[B+1])
  DMA_K(2,2*SLOTB);
  WAIT_BAR(3);
  { f32x16 c0,c1; CINIT0(c0,0); CINIT1(c1,0); qkt(cS0,cS1,Kbase,qr,c0,c1,r32,hi); }
  asm volatile("s_nop 15\n\ts_nop 7":"+v"(cS0),"+v"(cS1));CMASK(cS0,cS1,0);
  START(cS0,cS1);
  _Pragma("unroll") for(int r=0;r<16;++r)cS1[r]=__builtin_amdgcn_exp2f(cS1[r]);
  { float sacc=cS0[0]+cS0[1]; _Pragma("unroll") for(int r=2;r<16;++r)sacc+=cS0[r]; _Pragma("unroll") for(int r=0;r<16;++r)sacc+=cS1[r]; l_reg+=sacc;
    pwa0=(u32x4){PKW(cS0,0),PKW(cS0,2),PKW(cS0,4),PKW(cS0,6)};pwa1=(u32x4){PKW(cS0,8),PKW(cS0,10),PKW(cS0,12),PKW(cS0,14)};pwa2=(u32x4){PKW(cS1,0),PKW(cS1,2),PKW(cS1,4),PKW(cS1,6)};pwa3=(u32x4){PKW(cS1,8),PKW(cS1,10),PKW(cS1,12),PKW(cS1,14)}; }
  WAIT_BAR(0);
  DMA_K(3,0);DMA_V(1,SLOTB);
  ROT();
  kload8(kf,kp0+sl_cur);
  WAIT_BAR(3);
  s16x4 vlo[4],vhi[4];
  #define CAT_(a,b) a##b
  #define CAT(a,b) CAT_(a,b)
  #define PAFC(P,k) __builtin_bit_cast(bf16x8,CAT(P,k))
  #define VFR(k) (bf16x8){vlo[(k)&3][0],vlo[(k)&3][1],vlo[(k)&3][2],vlo[(k)&3][3],vhi[(k)&3][0],vhi[(k)&3][1],vhi[(k)&3][2],vhi[(k)&3][3]}
  #define VOFF(k) ((k)<8 ? (((k)&1)*4096+((k)>>1)*1024) : ((2+((k)&1))*4096+(((k)-8)>>1)*1024))
  #define PIN_(x) asm volatile("":"+v"(x))
  #define MX3(a,b,c) __builtin_fmaxf(__builtin_fmaxf((a),(b)),(c))
  #define QK(MF) do{ MF; SBAR(); }while(0)
  #define EX(v) __builtin_amdgcn_exp2f(v)
  #define VRD(k) do{ vlo[(k)&3]=vtr(vp_+VOFF(k)); vhi[(k)&3]=vtr(vp_+(VOFF(k)+512)); }while(0)
  #define VNX(k) do{ if((k)+4<16){ VRD((k)+4); } SBAR(); }while(0)
  #define GAPB3(MF,X,B,PW,J) do{ MF; X[B]=EX(X[B]); X[B+1]=EX(X[B+1]); sacc+=X[B]; sacc+=X[B+1]; PW[J]=cvtpk_s(X[B],X[B+1]); PIN_(X); PIN_(sacc); PIN_(PW); SBAR(); }while(0)
  #define KRD(G,j) do{ if(G){ kload2(kf,kp0+sl_next,j); SBAR(); } }while(0)
  #define STEP(PC,PN,t,GK,GV,GL) do{ SBAR(); \
    CINIT0(cS0,t); SBAR(); \
    const lds_cptr vp_=vp0+2*sl_prev; \
    VRD(0); SBAR(); QK(cS0=__builtin_amdgcn_mfma_f32_32x32x16_bf16(kf[0],qr[0],cS0,0,0,0)); \
    CINIT1(cS1,t); VRD(1); SBAR(); QK(cS1=__builtin_amdgcn_mfma_f32_32x32x16_bf16(kf[1],qr[0],cS1,0,0,0)); \
    VRD(2); SBAR(); QK(cS0=__builtin_amdgcn_mfma_f32_32x32x16_bf16(kf[2],qr[1],cS0,0,0,0)); \
    VRD(3); SBAR(); QK(cS1=__builtin_amdgcn_mfma_f32_32x32x16_bf16(kf[3],qr[1],cS1,0,0,0)); \
    QK(cS0=__builtin_amdgcn_mfma_f32_32x32x16_bf16(kf[4],qr[2],cS0,0,0,0)); \
    QK(cS1=__builtin_amdgcn_mfma_f32_32x32x16_bf16(kf[5],qr[2],cS1,0,0,0)); \
    QK(cS0=__builtin_amdgcn_mfma_f32_32x32x16_bf16(kf[6],qr[3],cS0,0,0,0)); \
    QK(cS1=__builtin_amdgcn_mfma_f32_32x32x16_bf16(kf[7],qr[3],cS1,0,0,0)); \
    if(GK){DMA_K((t)+3,sl_cur);} if(GV){DMA_V((t)+1,sl_next);} \
    CMASK(cS0,cS1,t); \
    { float a=MX3(cS0[0],cS0[1],cS1[0]),b=MX3(cS0[2],cS0[3],cS1[1]); a=MX3(a,cS1[2],cS1[3]); \
      _Pragma("unroll") for(int r=4;r<16;r+=4){a=MX3(a,cS0[r],cS0[r+1]);b=MX3(b,cS0[r+2],cS0[r+3]);a=MX3(a,cS1[r],cS1[r+1]);b=MX3(b,cS1[r+2],cS1[r+3]);} \
      float rm=__builtin_fmaxf(a,b); { auto rr=__builtin_amdgcn_permlane32_swap(__float_as_uint(rm),__float_as_uint(rm),false,false); rm=__builtin_fmaxf(__uint_as_float(rr[0]),__uint_as_float(rr[1])); } \
      resc=false; \
      if(__builtin_expect(__any(rm>(float)THRL),0)){ const float dl=__builtin_fmaxf(rm,0.f); mhat+=dl; \
        _Pragma("unroll") for(int r=0;r<16;++r){cS0[r]-=dl;cS1[r]-=dl;} \
        const float f=__builtin_amdgcn_exp2f(-dl); l_reg*=f; if(hi==0)wsf[r32]=f; resc=true; } } \
    SBAR(); float sacc=0.f; \
    GAPB3(o[0]=__builtin_amdgcn_mfma_f32_32x32x16_bf16(PAFC(PC,0),VFR(0),o[0],0,0,0), cS0,0, CAT(PN,0),0); VNX(0); \
    GAPB3(o[1]=__builtin_amdgcn_mfma_f32_32x32x16_bf16(PAFC(PC,0),VFR(1),o[1],0,0,0), cS0,2, CAT(PN,0),1); VNX(1); \
    KRD(GL,0); GAPB3(o[0]=__builtin_amdgcn_mfma_f32_32x32x16_bf16(PAFC(PC,1),VFR(2),o[0],0,0,0), cS0,4, CAT(PN,0),2); VNX(2); \
    KRD(GL,1); GAPB3(o[1]=__builtin_amdgcn_mfma_f32_32x32x16_bf16(PAFC(PC,1),VFR(3),o[1],0,0,0), cS0,6, CAT(PN,0),3); VNX(3); \
    KRD(GL,2); GAPB3(o[0]=__builtin_amdgcn_mfma_f32_32x32x16_bf16(PAFC(PC,2),VFR(4),o[0],0,0,0), cS0,8, CAT(PN,1),0); VNX(4); \
    KRD(GL,3); GAPB3(o[1]=__builtin_amdgcn_mfma_f32_32x32x16_bf16(PAFC(PC,2),VFR(5),o[1],0,0,0), cS0,10, CAT(PN,1),1); VNX(5); \
    GAPB3(o[0]=__builtin_amdgcn_mfma_f32_32x32x16_bf16(PAFC(PC,3),VFR(6),o[0],0,0,0), cS0,12, CAT(PN,1),2); VNX(6); \
    GAPB3(o[1]=__builtin_amdgcn_mfma_f32_32x32x16_bf16(PAFC(PC,3),VFR(7),o[1],0,0,0), cS0,14, CAT(PN,1),3); VNX(7); \
    GAPB3(o[2]=__builtin_amdgcn_mfma_f32_32x32x16_bf16(PAFC(PC,0),VFR(8),o[2],0,0,0), cS1,0, CAT(PN,2),0); VNX(8); \
    GAPB3(o[3]=__builtin_amdgcn_mfma_f32_32x32x16_bf16(PAFC(PC,0),VFR(9),o[3],0,0,0), cS1,2, CAT(PN,2),1); VNX(9); \
    GAPB3(o[2]=__builtin_amdgcn_mfma_f32_32x32x16_bf16(PAFC(PC,1),VFR(10),o[2],0,0,0), cS1,4, CAT(PN,2),2); VNX(10); \
    GAPB3(o[3]=__builtin_amdgcn_mfma_f32_32x32x16_bf16(PAFC(PC,1),VFR(11),o[3],0,0,0), cS1,6, CAT(PN,2),3); VNX(11); \
    GAPB3(o[2]=__builtin_amdgcn_mfma_f32_32x32x16_bf16(PAFC(PC,2),VFR(12),o[2],0,0,0), cS1,8, CAT(PN,3),0); VNX(12); \
    GAPB3(o[3]=__builtin_amdgcn_mfma_f32_32x32x16_bf16(PAFC(PC,2),VFR(13),o[3],0,0,0), cS1,10, CAT(PN,3),1); VNX(13); \
    GAPB3(o[2]=__builtin_amdgcn_mfma_f32_32x32x16_bf16(PAFC(PC,3),VFR(14),o[2],0,0,0), cS1,12, CAT(PN,3),2); VNX(14); \
    GAPB3(o[3]=__builtin_amdgcn_mfma_f32_32x32x16_bf16(PAFC(PC,3),VFR(15),o[3],0,0,0), cS1,14, CAT(PN,3),3); VNX(15); \
    l_reg+=sacc; \
    }while(0)
  int t=1;
  #undef CMASK
  #define CMASK(P0,P1,t) do{}while(0)
  for(;t+5<NT;t+=2){
    STEP(pwa,pwb,t,true,true,true);     WAIT_BAR(3); RESC(); ROT();
    STEP(pwb,pwa,t+1,true,true,true);   WAIT_BAR(3); RESC(); ROT();
  }
  #undef CMASK
  #define CMASK(P0,P1,t) do{int jb_=(t)-(NT-4); if(jb_>=0)bmask(P0,P1,jb_,wch,il,hi,s2x2);}while(0)
  #define ENDW(tt) do{ if((tt)+3<NT){WAIT_BAR(3);} else if((tt)+2<NT){WAIT_BAR(2);} else {WAIT_BAR(0);} }while(0)
  for(;t+1<NT;t+=2){
    STEP(pwa,pwb,t,(t+3<NT),(t+1<NT),(t+1<NT));       ENDW(t);   RESC(); ROT();
    STEP(pwb,pwa,t+1,(t+4<NT),(t+2<NT),(t+2<NT));     ENDW(t+1); RESC(); ROT();
  }
  STEP(pwa,pwb,NT-1,false,false,false); RESC();
  SBAR(); pv(o,vb0+2*sl_cur,PAFC(pwb,0),PAFC(pwb,1),PAFC(pwb,2),PAFC(pwb,3));
  #undef PKW
  #undef PAFC
  #undef CAT
  #undef CAT_
  #undef QK
  #undef GAPB3
  #undef VFR
  #undef PIN_
  #undef MX3
  #undef EX
  #undef VRD
  #undef VNX
  #undef VOFF
  #undef GAPB2
  #undef KRD
  #undef STEP
  #undef ENDW
  {auto rr=__builtin_amdgcn_permlane32_swap(__float_as_uint(l_reg),__float_as_uint(l_reg),false,false);l_reg=__uint_as_float(rr[0])+__uint_as_float(rr[1]);}
  {
    const int le=lane_now(), r32e=le&31, hie=le>>5;
    float*wsfe=(float*)(shm+LDS_WS)+wid*64;
    if(hie==0)wsfe[32+r32e]=l_reg;asm volatile("s_waitcnt lgkmcnt(0)":::"memory");
    float rli[16];
    #pragma unroll
    for(int r=0;r<16;++r)rli[r]=__builtin_amdgcn_rcpf(wsfe[32+crow(r,hie)]);
    bf16_t*Ow=Ob+(long)(q0+wid*QBLK)*POUT;
    bf16_t*stg=(bf16_t*)(shm+LDS_OST)+wid*4096;
    #pragma unroll
    for(int r=0;r<16;++r){const int orow=crow(r,hie);
      #pragma unroll
      for(int d0=0;d0<4;++d0)stg[orow*128+d0*32+r32e]=(bf16_t)f2bf(o[d0][r]*rli[r]);}
    asm volatile("s_waitcnt lgkmcnt(0)":::"memory");
    #pragma unroll
    for(int i=0;i<8;++i){const int row=i*4+(le>>4),ch=le&15; const u32x4 v=*(const u32x4*)(stg+row*128+ch*8); ATTN_STORE16(Ow+(long)row*POUT+ch*8,v);} }
  asm volatile("s_waitcnt lgkmcnt(0)\n\ts_barrier":::"memory");
  #undef DMA_K
  #undef DMA_V
  #undef CMASK
  #undef CINIT0
  #undef CINIT1
  #undef START
  #undef RESC
  #undef ROT
}
#undef SBAR
#undef WAIT_BAR
}

__device__ __forceinline__ void attn_phase(const Frame& F, const Args& a) {
    const bf16_t* proj = (const bf16_t*)(a.ws + WS_PROJ); bf16_t* OA = (bf16_t*)(a.ws + WS_OA);
    const int vcu = (F.G % 8 == 0) ? (F.bid % 8) * (F.G / 8) + F.bid / 8 : F.bid;
    for (int i = 0;; ++i) {
        int bhm, qb;
        if (F.G == 256) { if (i >= 2) break; const int s_ = vcu & 7; bhm = vcu >> 3; qb = (i == 0) ? 15 - s_ : s_; }
        else { const int u = i * F.G + F.bid; if (u >= 512) break; bhm = u >> 4; qb = 15 - (u & 15); }
        const int b = bhm >> 3, h = (bhm >> 1) & 3, map = bhm & 1;
        const bf16_t* base = proj + (size_t)b * SEQ * INC;
        const float slope2 = exp2f(-2.0f * (h + 1)) * 1.4426950408889634f;
        attn_body::attn_unit<8>(qb, base + C_QDA + h * 128 + map * 64, base + C_KDA + h * 128 + map * 64, base + C_VDA + h * 128,
                                OA + (size_t)b * SEQ * 1024 + h * 256 + map * 128, slope2, (char*)F.lds);
    }
}
__device__ __forceinline__ void attn_combine(const Frame& F, const Args& a) {
    const bf16_t* OA = (const bf16_t*)(a.ws + WS_OA); bf16_t* Y = (bf16_t*)(a.ws + WS_YDA);
    const float lam = ((const float*)(a.ws + WS_SMALL))[0];
    const float g0 = a.in[I_SUBG][2 * F.lane] * 0.8f, g1 = a.in[I_SUBG][2 * F.lane + 1] * 0.8f;
    const int gw = F.bid * NWAVES + F.wave, NGW = F.G * NWAVES;
    for (int r = gw; r < T; r += NGW) {
        const unsigned* orow = (const unsigned*)(OA + (size_t)r * 1024); unsigned* yrow = (unsigned*)(Y + (size_t)r * 512);
        unsigned w0[4], w1[4];
#pragma unroll
        for (int h = 0; h < 4; ++h) { w0[h] = orow[h * 128 + F.lane]; w1[h] = orow[h * 128 + 64 + F.lane]; }
#pragma unroll
        for (int h = 0; h < 4; ++h) {
            const float x0 = bf2f(w0[h] & 0xffffu) - lam * bf2f(w1[h] & 0xffffu), x1 = bf2f(w0[h] >> 16) - lam * bf2f(w1[h] >> 16);
            const float rs = rsqrtf(wave_sum(x0 * x0 + x1 * x1) * (1.0f / 128.0f) + EPS);
            yrow[h * 64 + F.lane] = pk2(x0 * rs * g0, x1 * rs * g1);
        }
    }
}
namespace hg {
constexpr int QP = 136;
constexpr int L_QD = 0, L_KD = 64 * QP * 2, L_V = 2 * 64 * QP * 2, L_KE = 3 * 64 * QP * 2, L_SSQ = 4 * 64 * QP * 2, L_G = L_SSQ + 512, L_ST = L_G + 64 * QP * 2;
__device__ __forceinline__ f32x4 mfma16(bf16x8 a, bf16x8 b, f32x4 c) { return __builtin_amdgcn_mfma_f32_16x16x32_bf16(a, b, c, 0, 0, 0); }
#define HG_BAR() do { asm volatile("s_waitcnt lgkmcnt(0)" ::: "memory"); __builtin_amdgcn_s_barrier(); asm volatile("" ::: "memory"); } while (0)
typedef short v4i16_t __attribute__((ext_vector_type(4)));
__device__ __forceinline__ bf16x8 tr8(const LAS unsigned char* img, int ra, int rb, int col0, int lane) {
    const int q = (lane & 15) >> 2, p = lane & 3;
    const v4i16_t lo = __builtin_amdgcn_ds_read_tr16_b64_v4i16((LAS v4i16_t*)(img + ((ra + q) * QP + col0 + 4 * p) * 2));
    const v4i16_t hi = __builtin_amdgcn_ds_read_tr16_b64_v4i16((LAS v4i16_t*)(img + ((rb + q) * QP + col0 + 4 * p) * 2));
    return (bf16x8){lo[0], lo[1], lo[2], lo[3], hi[0], hi[1], hi[2], hi[3]};
}
struct Tile { u32x4 p[2]; };
__device__ __forceinline__ void tile_load(Tile& t, const bf16_t* src, size_t pitch, int tid) {
#pragma unroll
    for (int i = 0; i < 2; ++i) { const int pc = tid + NTHR * i; t.p[i] = *(const u32x4*)(src + (size_t)(pc >> 4) * pitch + (pc & 15) * 8); }
}
__device__ __forceinline__ void tile_put(const Tile& t, LAS unsigned char* img, int tid) {
#pragma unroll
    for (int i = 0; i < 2; ++i) { const int pc = tid + NTHR * i; *(LAS u32x4*)(img + ((pc >> 4) * QP + (pc & 15) * 8) * 2) = t.p[i]; }
}
constexpr int PP = 72;
constexpr int G4_L_P = 4 * 64 * QP * 2, G4_L_DEC = G4_L_P + 64 * PP * 2, G4_L_SSQ = G4_L_DEC + 512;
struct InA { Tile qd, kd, ke, v; f32x4 dec; };
__device__ __forceinline__ void loadA(InA& r, const Frame& F, const Args& a, int bh, int n) {
    const int b = bh >> 2, h = bh & 3; const size_t t0 = (size_t)b * SEQ + n * 64;
    const bf16_t* base = (const bf16_t*)(a.ws + WS_PROJ) + t0 * INC;
    tile_load(r.qd, base + C_HGT + 256 * h, INC, F.tid); tile_load(r.kd, base + C_HGT + 256 * h + 128, INC, F.tid);
    tile_load(r.ke, (const bf16_t*)a.out + t0 * 512 + h * 128, 512, F.tid); tile_load(r.v, base + C_IHG + h * 128, INC, F.tid);
    r.dec = *(const f32x4*)((const float*)(a.ws + WS_DEC) + ((size_t)bh * 64 + n) * 128 + 4 * (F.tid & 31));
}
__device__ __forceinline__ void grp_local(const Frame& F, const Args& a, int grp) {
    const int bh = grp >> 4, n0 = 4 * (grp & 15), b = bh >> 2, h = bh & 3, w = F.wave, lane = F.lane, fr = lane & 15, fq = lane >> 4;
    for (int i = F.tid; i < 64 * PP / 2; i += NTHR) ((LAS unsigned*)(F.lds + G4_L_P))[i] = 0u;
    f32x4 S[8];
#pragma unroll
    for (int kt = 0; kt < 8; ++kt) S[kt] = (f32x4){0.f, 0.f, 0.f, 0.f};
    InA cur, nxt; loadA(cur, F, a, bh, n0);
    unsigned short yk[4][4];
#define G4_STORE(nn) do { bf16_t* yp_ = (bf16_t*)(a.ws + WS_YHG) + ((size_t)b * SEQ + (nn) * 64 + 4 * fq) * 512 + h * 128 + 16 * w + fr; \
        _Pragma("unroll") for (int tb = 0; tb < 4; ++tb) _Pragma("unroll") for (int r = 0; r < 4; ++r) yp_[(size_t)(16 * tb + r) * 512] = yk[tb][r]; } while (0)
    for (int j = 0; j < 4; ++j) {
        if (j > 0) G4_STORE(n0 + j - 1);
        loadA(nxt, F, a, bh, n0 + (j < 3 ? j + 1 : 3));
        tile_put(cur.qd, F.lds + L_QD, F.tid); tile_put(cur.kd, F.lds + L_KD, F.tid); tile_put(cur.ke, F.lds + L_KE, F.tid); tile_put(cur.v, F.lds + L_V, F.tid);
        if (F.tid < 32) *(LAS f32x4*)(F.lds + G4_L_DEC + 16 * F.tid) = cur.dec;
        HG_BAR();
#pragma unroll
        for (int rep = 0; rep < 2; ++rep) { const int pi = w + 8 * rep;
            if (pi < 10) { const int tb = pi >= 6 ? 3 : pi >= 3 ? 2 : pi >= 1 ? 1 : 0, jt = pi - (tb * (tb + 1)) / 2;
                f32x4 sc = (f32x4){0.f, 0.f, 0.f, 0.f};
#pragma unroll
                for (int ks = 0; ks < 4; ++ks) { const bf16x8 kf = *(const LAS bf16x8*)(F.lds + L_KD + ((16 * jt + fr) * QP + 32 * ks + 8 * fq) * 2);
                    const bf16x8 qf = *(const LAS bf16x8*)(F.lds + L_QD + ((16 * tb + fr) * QP + 32 * ks + 8 * fq) * 2); sc = mfma16(kf, qf, sc); }
                if (jt == tb) {
#pragma unroll
                    for (int r = 0; r < 4; ++r) if (4 * fq + r > fr) sc[r] = 0.f;
                }
                *(LAS u32x2*)(F.lds + G4_L_P + ((16 * tb + fr) * PP + 16 * jt + 4 * fq) * 2) = (u32x2){cvt_pk_bf16(sc[0], sc[1]), cvt_pk_bf16(sc[2], sc[3])}; } }
        HG_BAR();
        bf16x8 bv[2];
#pragma unroll
        for (int s2 = 0; s2 < 2; ++s2) bv[s2] = tr8(F.lds + L_V, 32 * s2 + 8 * fq, 32 * s2 + 8 * fq + 4, 16 * w, lane);
        bf16x8 Sb[4];
#pragma unroll
        for (int ks = 0; ks < 4; ++ks) { const u32x4 t = (u32x4){cvt_pk_bf16(S[2 * ks][0], S[2 * ks][1]), cvt_pk_bf16(S[2 * ks][2], S[2 * ks][3]), cvt_pk_bf16(S[2 * ks + 1][0], S[2 * ks + 1][1]), cvt_pk_bf16(S[2 * ks + 1][2], S[2 * ks + 1][3])};
            Sb[ks] = __builtin_bit_cast(bf16x8, t); }
#pragma unroll
        for (int tb = 0; tb < 4; ++tb) { f32x4 o = (f32x4){0.f, 0.f, 0.f, 0.f};
#pragma unroll
            for (int s2 = 0; s2 <= (tb >> 1); ++s2) { const bf16x8 pf = *(const LAS bf16x8*)(F.lds + G4_L_P + ((16 * tb + fr) * PP + 32 * s2 + 8 * fq) * 2); o = mfma16(pf, bv[s2], o); }
            if (j > 0) {
#pragma unroll
                for (int ks = 0; ks < 4; ++ks) { const LAS unsigned char* qrow = F.lds + L_QD + ((16 * tb + fr) * QP + 32 * ks + 4 * fq) * 2;
                    const u32x2 lo = *(const LAS u32x2*)qrow, hi = *(const LAS u32x2*)(qrow + 32);
                    const u32x4 aw = (u32x4){lo.x, lo.y, hi.x, hi.y}; o = mfma16(__builtin_bit_cast(bf16x8, aw), Sb[ks], o); } }
#pragma unroll
            for (int r = 0; r < 4; ++r) yk[tb][r] = (unsigned short)f2bf(o[r]); }
#pragma unroll
        for (int kt = 0; kt < 8; ++kt) { S[kt] = S[kt] * *(const LAS f32x4*)(F.lds + G4_L_DEC + (16 * kt + 4 * fq) * 4);
#pragma unroll
            for (int s2 = 0; s2 < 2; ++s2) S[kt] = mfma16(tr8(F.lds + L_KE, 32 * s2 + 8 * fq, 32 * s2 + 8 * fq + 4, 16 * kt, lane), bv[s2], S[kt]); }
        HG_BAR();
        cur = nxt;
    }
    G4_STORE(n0 + 3);
#undef G4_STORE
    f32x4* sg = (f32x4*)(a.ws + WS_DS) + ((size_t)grp * 64 + w * 8) * 64 + lane;
#pragma unroll
    for (int kt = 0; kt < 8; ++kt) sg[kt * 64] = S[kt];
}
__device__ __forceinline__ void grp_scan(const Frame& F, const Args& a) {
    f32x4* sg = (f32x4*)(a.ws + WS_DS); f32x4* si = sg + (size_t)256 * 4096; const float* dec = (const float*)(a.ws + WS_DEC);
    for (int gt = F.bid * NTHR + F.tid; gt < 16 * 4096; gt += F.G * NTHR) {
        const int bh = gt >> 12, slot = gt & 4095, kt = (slot >> 6) & 7, lane = slot & 63, k = 16 * kt + 4 * (lane >> 4);
        f32x4 cur = (f32x4){0.f, 0.f, 0.f, 0.f};
#pragma unroll 4
        for (int g = 0; g < 16; ++g) { const size_t gi = ((size_t)(bh * 16 + g)) * 4096 + slot;
            si[gi] = cur;
            const float* dp = dec + ((size_t)bh * 64 + 4 * g) * 128 + k;
            const f32x4 d = (*(const f32x4*)dp * *(const f32x4*)(dp + 128)) * (*(const f32x4*)(dp + 256) * *(const f32x4*)(dp + 384));
            cur = d * cur + sg[gi]; }
    }
}
struct InC { Tile qd, g, ol; f32x4 dec; };
__device__ __forceinline__ void loadC(InC& r, const Frame& F, const Args& a, int bh, int n) {
    const int b = bh >> 2, h = bh & 3; const size_t t0 = (size_t)b * SEQ + n * 64;
    const bf16_t* base = (const bf16_t*)(a.ws + WS_PROJ) + t0 * INC;
    tile_load(r.qd, base + C_HGT + 256 * h, INC, F.tid); tile_load(r.g, base + C_GHG + h * 128, INC, F.tid);
    tile_load(r.ol, (const bf16_t*)(a.ws + WS_YHG) + t0 * 512 + h * 128, 512, F.tid);
    r.dec = *(const f32x4*)((const float*)(a.ws + WS_DEC) + ((size_t)bh * 64 + n) * 128 + 4 * (F.tid & 31));
}
__device__ __forceinline__ void grp_final(const Frame& F, const Args& a, int grp) {
    const int bh = grp >> 4, n0 = 4 * (grp & 15), b = bh >> 2, h = bh & 3, w = F.wave, lane = F.lane, fr = lane & 15, fq = lane >> 4;
    f32x4 S[8];
    { const f32x4* si = (const f32x4*)(a.ws + WS_DS) + (size_t)256 * 4096 + ((size_t)grp * 64 + w * 8) * 64 + lane;
#pragma unroll
      for (int kt = 0; kt < 8; ++kt) S[kt] = si[kt * 64]; }
    const float ng = a.in[I_HGNG][16 * w + fr];
    LAS float* SSQ = (LAS float*)(F.lds + G4_L_SSQ);
    InC cur, nxt; loadC(cur, F, a, bh, n0);
    unsigned short yk[4][4];
#define G4_STORE(nn) do { bf16_t* yp_ = (bf16_t*)(a.ws + WS_YHG) + ((size_t)b * SEQ + (nn) * 64 + 4 * fq) * 512 + h * 128 + 16 * w + fr; \
        _Pragma("unroll") for (int tb = 0; tb < 4; ++tb) _Pragma("unroll") for (int r = 0; r < 4; ++r) yp_[(size_t)(16 * tb + r) * 512] = yk[tb][r]; } while (0)
    for (int j = 0; j < 4; ++j) {
        if (j > 0) G4_STORE(n0 + j - 1);
        loadC(nxt, F, a, bh, n0 + (j < 3 ? j + 1 : 3));
        tile_put(cur.qd, F.lds + L_QD, F.tid); tile_put(cur.g, F.lds + L_KD, F.tid); tile_put(cur.ol, F.lds + L_V, F.tid);
        if (F.tid < 32) *(LAS f32x4*)(F.lds + G4_L_DEC + 16 * F.tid) = cur.dec;
        HG_BAR();
        bf16x8 Sb[4];
#pragma unroll
        for (int ks = 0; ks < 4; ++ks) { const u32x4 t = (u32x4){cvt_pk_bf16(S[2 * ks][0], S[2 * ks][1]), cvt_pk_bf16(S[2 * ks][2], S[2 * ks][3]), cvt_pk_bf16(S[2 * ks + 1][0], S[2 * ks + 1][1]), cvt_pk_bf16(S[2 * ks + 1][2], S[2 * ks + 1][3])};
            Sb[ks] = __builtin_bit_cast(bf16x8, t); }
        f32x4 o[4];
#pragma unroll
        for (int tb = 0; tb < 4; ++tb) {
#pragma unroll
            for (int r = 0; r < 4; ++r) o[tb][r] = bf2f(*(const LAS unsigned short*)(F.lds + L_V + ((16 * tb + 4 * fq + r) * QP + 16 * w + fr) * 2));
#pragma unroll
            for (int ks = 0; ks < 4; ++ks) { const LAS unsigned char* qrow = F.lds + L_QD + ((16 * tb + fr) * QP + 32 * ks + 4 * fq) * 2;
                const u32x2 lo = *(const LAS u32x2*)qrow, hi = *(const LAS u32x2*)(qrow + 32);
                const u32x4 aw = (u32x4){lo.x, lo.y, hi.x, hi.y}; o[tb] = mfma16(__builtin_bit_cast(bf16x8, aw), Sb[ks], o[tb]); }
#pragma unroll
            for (int r = 0; r < 4; ++r) { const float v = scan16(o[tb][r] * o[tb][r]); if (fr == 15) SSQ[w * 64 + 16 * tb + 4 * fq + r] = v; } }
#pragma unroll
        for (int kt = 0; kt < 8; ++kt) S[kt] = S[kt] * *(const LAS f32x4*)(F.lds + G4_L_DEC + (16 * kt + 4 * fq) * 4);
        HG_BAR();
#pragma unroll
        for (int tb = 0; tb < 4; ++tb) { f32x4 tot = (f32x4){0.f, 0.f, 0.f, 0.f};
#pragma unroll
            for (int ww = 0; ww < 8; ++ww) tot += *(const LAS f32x4*)(SSQ + ww * 64 + 16 * tb + 4 * fq);
#pragma unroll
            for (int r = 0; r < 4; ++r) { const float rs = rsqrtf(tot[r] * (1.0f / 128.0f) + EPS); const float g = bf2f(*(const LAS unsigned short*)(F.lds + L_KD + ((16 * tb + 4 * fq + r) * QP + 16 * w + fr) * 2));
                yk[tb][r] = (unsigned short)f2bf(o[tb][r] * rs * ng * g * __builtin_amdgcn_rcpf(1.0f + __builtin_amdgcn_exp2f(-1.4426950408889634f * g))); } }
        HG_BAR();
        cur = nxt;
    }
    G4_STORE(n0 + 3);
#undef G4_STORE
}
#undef HG_BAR
}

__device__ __forceinline__ float rs4(float a0, float a1, float a2, float a3, int lane) {
    const bool hi = (lane & 32) != 0;
    const float s0 = hi ? a0 : a2, s1 = hi ? a1 : a3;
    const float k0 = (hi ? a2 : a0) + __shfl_xor(s0, 32), k1 = (hi ? a3 : a1) + __shfl_xor(s1, 32);
    const bool b4 = (lane & 16) != 0;
    const float sd = b4 ? k0 : k1;
    float k = (b4 ? k1 : k0) + __shfl_xor(sd, 16);
    k += __shfl_xor(k, 8); k += __shfl_xor(k, 4); k += __shfl_xor(k, 2); k += __shfl_xor(k, 1);
    return k;
}
__device__ __forceinline__ void phase_router(const Frame& F, const Args& a) {
    constexpr int AP = 1032;
    LAS bf16_t* AH = (LAS bf16_t*)F.lds;
    LAS bf16_t* AL = AH + 16 * AP;
    LAS float* PART = (LAS float*)(F.lds + 2 * 16 * AP * 2);
    LAS float* LG = PART + 8 * 16 * 48;
    LAS unsigned* LH = (LAS unsigned*)(LG + 16 * 48);
    LAS unsigned* LB = LH + 32;
    LAS unsigned* LR = LH + 64;
    if (F.tid < NEXP) LH[F.tid] = 0u;
    const float* mod = (const float*)(a.ws + WS_MOD);
    const float* x1 = a.out; bf16_t* H2 = (bf16_t*)(a.ws + WS_ACT);
    unsigned* counts = (unsigned*)(a.ws + WS_CTL) + CW_COUNTS; unsigned* tokinfo = (unsigned*)(a.ws + WS_TOKINFO); int* toklist = (int*)(a.ws + WS_TOKLIST);
    const int rows_per_blk = T / F.G, r0 = F.bid * rows_per_blk, b = r0 / SEQ;
    const int lane = F.lane, w = F.wave, fr = lane & 15, fq = lane >> 4;
    f32x4 v[2][4], vn[2][4];
#define RT_LOAD(V, rb_) do { _Pragma("unroll") for (int q = 0; q < 2; ++q) { const f32x4* xr_ = (const f32x4*)(x1 + (size_t)((rb_) + 2 * w + q) * D) + lane; \
        _Pragma("unroll") for (int j = 0; j < 4; ++j) V[q][j] = xr_[64 * j]; } } while (0)
    RT_LOAD(v, r0);
    bf16x8 Bh[4][3], Bl[4][3];
    {
        const float* wre = a.in[I_WRE]; const float* wrg = a.in[I_WRG];
#pragma unroll
        for (int ks = 0; ks < 4; ++ks)
#pragma unroll
            for (int ct = 0; ct < 3; ++ct) {
                unsigned hw[4], lw[4];
#pragma unroll
                for (int jp = 0; jp < 4; ++jp) { float x[2];
#pragma unroll
                    for (int z = 0; z < 2; ++z) { const int k = 128 * w + 32 * ks + 8 * fq + 2 * jp + z;
                        if (ct == 0) { const float g = wrg[k * 4 + (fr & 3)], e = wre[k * 32 + ((fr + 28) & 31)]; x[z] = fr < 4 ? g : e; }
                        else if (ct == 1) x[z] = wre[k * 32 + 12 + fr];
                        else { const float e = wre[k * 32 + 28 + (fr & 3)]; x[z] = fr < 4 ? e : 0.f; } }
                    const unsigned h0 = f2bf(x[0]), h1 = f2bf(x[1]); hw[jp] = h0 | (h1 << 16);
                    lw[jp] = pk2(x[0] - bf2f(h0), x[1] - bf2f(h1)); }
                Bh[ks][ct] = __builtin_bit_cast(bf16x8, (u32x4){hw[0], hw[1], hw[2], hw[3]}); Bl[ks][ct] = __builtin_bit_cast(bf16x8, (u32x4){lw[0], lw[1], lw[2], lw[3]});
            }
    }
    for (int g = 0; g < rows_per_blk / 16; ++g) {
        const int rg = r0 + 16 * g;
        { const int gn = g + 1 < rows_per_blk / 16 ? g + 1 : g; RT_LOAD(vn, r0 + 16 * gn); }
#pragma unroll
        for (int q = 0; q < 2; ++q) { float sq = 0.f;
#pragma unroll
            for (int j = 0; j < 4; ++j) sq += (v[q][j].x * v[q][j].x + v[q][j].y * v[q][j].y) + (v[q][j].z * v[q][j].z + v[q][j].w * v[q][j].w);
            const float rs = rsqrtf(wave_sum(sq) * (1.0f / D) + EPS); const int row = 2 * w + q;
#pragma unroll
            for (int j = 0; j < 4; ++j) { const int k = 256 * j + 4 * lane;
                const f32x4 gg = *(const f32x4*)(a.in[I_N2G] + k) * (1.0f + *(const f32x4*)(mod + b * 6144 + 4 * 1024 + k)), sh = *(const f32x4*)(mod + b * 6144 + 3 * 1024 + k);
                const f32x4 hv = v[q][j] * rs * gg + sh;
                const unsigned h0 = f2bf(hv.x), h1 = f2bf(hv.y), h2_ = f2bf(hv.z), h3 = f2bf(hv.w);
                const u32x2 hw = (u32x2){h0 | (h1 << 16), h2_ | (h3 << 16)};
                *(u32x2*)(H2 + (size_t)(rg + row) * D + k) = hw;
                *(LAS u32x2*)(AH + row * AP + k) = hw;
                *(LAS u32x2*)(AL + row * AP + k) = (u32x2){pk2(hv.x - bf2f(h0), hv.y - bf2f(h1)), pk2(hv.z - bf2f(h2_), hv.w - bf2f(h3))}; } }
        __syncthreads();
        f32x4 acc[3] = {{0.f, 0.f, 0.f, 0.f}, {0.f, 0.f, 0.f, 0.f}, {0.f, 0.f, 0.f, 0.f}};
#pragma unroll
        for (int ks = 0; ks < 4; ++ks) { const bf16x8 ah = *(const LAS bf16x8*)(AH + fr * AP + 128 * w + 32 * ks + 8 * fq), al = *(const LAS bf16x8*)(AL + fr * AP + 128 * w + 32 * ks + 8 * fq);
#pragma unroll
            for (int ct = 0; ct < 3; ++ct) { acc[ct] = __builtin_amdgcn_mfma_f32_16x16x32_bf16(ah, Bh[ks][ct], acc[ct], 0, 0, 0);
                acc[ct] = __builtin_amdgcn_mfma_f32_16x16x32_bf16(al, Bh[ks][ct], acc[ct], 0, 0, 0); acc[ct] = __builtin_amdgcn_mfma_f32_16x16x32_bf16(ah, Bl[ks][ct], acc[ct], 0, 0, 0); } }
#pragma unroll
        for (int ct = 0; ct < 3; ++ct)
#pragma unroll
            for (int r = 0; r < 4; ++r) PART[(w * 16 + 4 * fq + r) * 48 + 16 * ct + fr] = acc[ct][r];
        __syncthreads();
        for (int t = F.tid; t < 16 * 48; t += NTHR) { const int row = t / 48, o = t % 48; float sacc = 0.f;
#pragma unroll
            for (int ww = 0; ww < 8; ++ww) sacc += PART[(ww * 16 + row) * 48 + o];
            if (o < 36) LG[row * 48 + o] = sacc + (o < 4 ? a.in[I_BRG][o & 3] : a.in[I_BRE][(o + 28) & 31]); }
        __syncthreads();
        if (F.tid < 16) {
            const LAS float* lg = LG + F.tid * 48;
            float gl[4]; int gi = 0;
#pragma unroll
            for (int o = 0; o < 4; ++o) gl[o] = lg[o];
            float gm = gl[0];
#pragma unroll
            for (int o = 1; o < 4; ++o) if (gl[o] > gm) { gm = gl[o]; gi = o; }
            float gsum = 0.f;
#pragma unroll
            for (int o = 0; o < 4; ++o) gsum += expf(gl[o] - gm);
            const float gp = 1.0f / gsum;
            float el[8];
#pragma unroll
            for (int e = 0; e < 8; ++e) el[e] = lg[4 + gi * 8 + e];
            int i0 = 0; float m0 = el[0];
#pragma unroll
            for (int o = 1; o < 8; ++o) if (el[o] > m0) { m0 = el[o]; i0 = o; }
            int i1 = -1; float m1 = -INFINITY;
#pragma unroll
            for (int o = 0; o < 8; ++o) if (o != i0 && el[o] > m1) { m1 = el[o]; i1 = o; }
            const float e1 = expf(m1 - m0); const float w0 = gp / (1.0f + e1), w1 = gp * e1 / (1.0f + e1);
            const int rl = 16 * g + F.tid, ex0 = gi * 8 + i0, ex1 = gi * 8 + i1;
            const unsigned l0 = atomicAdd((unsigned*)(LH + ex0), 1u), l1 = atomicAdd((unsigned*)(LH + ex1), 1u);
            LAS unsigned* ri = LR + rl * 6;
            ri[0] = (unsigned)ex0; ri[1] = l0; ri[2] = (unsigned)ex1; ri[3] = l1; ri[4] = __float_as_uint(w0); ri[5] = __float_as_uint(w1);
        }
#pragma unroll
        for (int q = 0; q < 2; ++q)
#pragma unroll
            for (int j = 0; j < 4; ++j) v[q][j] = vn[q][j];
    }
#undef RT_LOAD
    __syncthreads();
    if (F.tid < NEXP) LB[F.tid] = atomicAdd(counts + 64 * F.tid, LH[F.tid]);
    __syncthreads();
    for (int rl = F.tid; rl < rows_per_blk; rl += NTHR) {
        const LAS unsigned* ri = LR + rl * 6; const int r = r0 + rl;
        const unsigned ex0 = ri[0], ex1 = ri[2], k0 = LB[ex0] + ri[1], k1 = LB[ex1] + ri[3];
        toklist[ex0 * T + k0] = r; toklist[ex1 * T + k1] = r;
        u32x4 t0; t0.x = ex0; t0.y = k0; t0.z = ex1; t0.w = k1;
        *(u32x4*)(tokinfo + (size_t)r * 8) = t0;
        tokinfo[(size_t)r * 8 + 4] = ri[4]; tokinfo[(size_t)r * 8 + 5] = ri[5];
    }
}
__device__ __forceinline__ void build_moe_tab(const Frame& F, const Args& a, LAS MoeTab* tab) {
    if (F.tid == 0) {
        const unsigned* counts = (const unsigned*)(a.ws + WS_CTL) + CW_COUNTS; int nt = 0;
        for (int e = 0; e < NEXP; ++e) { const int c = (int)__hip_atomic_load(counts + 64 * e, __ATOMIC_RELAXED, __HIP_MEMORY_SCOPE_AGENT); tab->cnt[e] = c; tab->tbase[e] = nt;
            const int n = (c + 255) >> 8; for (int m = 0; m < n; ++m) { tab->tile_e[nt] = e; tab->tile_m[nt] = m; ++nt; } }
        tab->tbase[NEXP] = nt; tab->nt = nt;
    }
    __syncthreads();
}
__device__ __forceinline__ void phase_final(const Frame& F, const Args& a, const LAS MoeTab* tab) {
    const float* mod = (const float*)(a.ws + WS_MOD); const unsigned* tokinfo = (const unsigned*)(a.ws + WS_TOKINFO); const bf16_t* Ys = (const bf16_t*)(a.ws + WS_YS);
    const int rows_per_blk = T / F.G, r0 = F.bid * rows_per_blk;
    for (int r = r0 + F.wave; r < r0 + rows_per_blk; r += NWAVES) {
        const int b = r / SEQ;
        const u32x4 ti = *(const u32x4*)(tokinfo + (size_t)r * 8);
        const float w0 = __uint_as_float(tokinfo[(size_t)r * 8 + 4]), w1 = __uint_as_float(tokinfo[(size_t)r * 8 + 5]);
        const size_t s0 = (size_t)tab->tbase[ti.x] * 256 + ti.y, s1 = (size_t)tab->tbase[ti.z] * 256 + ti.w;
        f32x4* xr = (f32x4*)(a.out + (size_t)r * D) + F.lane;
        const u32x2* y0 = (const u32x2*)(Ys + s0 * D) + F.lane; const u32x2* y1 = (const u32x2*)(Ys + s1 * D) + F.lane;
        f32x4 v[4]; float s = 0.f;
#pragma unroll
        for (int j = 0; j < 4; ++j) { const int k = 256 * j + 4 * F.lane;
            const f32x4 gt = *(const f32x4*)(mod + b * 6144 + 5 * 1024 + k); const u32x2 a0 = y0[64 * j], a1 = y1[64 * j];
            f32x4 m; m.x = w0 * bf2f(a0.x & 0xffffu) + w1 * bf2f(a1.x & 0xffffu); m.y = w0 * bf2f(a0.x >> 16) + w1 * bf2f(a1.x >> 16);
            m.z = w0 * bf2f(a0.y & 0xffffu) + w1 * bf2f(a1.y & 0xffffu); m.w = w0 * bf2f(a0.y >> 16) + w1 * bf2f(a1.y >> 16);
            v[j] = xr[64 * j] + gt * m; s += (v[j].x * v[j].x + v[j].y * v[j].y) + (v[j].z * v[j].z + v[j].w * v[j].w); }
        const float rs = rsqrtf(wave_sum(s) * (1.0f / D) + EPS);
#pragma unroll
        for (int j = 0; j < 4; ++j) { const f32x4 g = *(const f32x4*)(a.in[I_FG] + 256 * j + 4 * F.lane); xr[64 * j] = v[j] * rs * g; }
    }
}

#define XB_TMO      128
#define XB_XCNT(j)  (256  + 64 * (j))
#define XB_XSUB(j)  (1280 + 64 * (j))
#define XB_XGEN(j)  (2304 + 64 * (j))
#define XB_TOP      3328
#define XB_TOPGEN   3392
#define XCD_BAR_WORDS 3456
#define XB_SPIN_CAP (1u << 18)
__device__ __forceinline__ unsigned xb_ld(unsigned* p)              { return __hip_atomic_load(p, __ATOMIC_RELAXED, __HIP_MEMORY_SCOPE_AGENT); }
__device__ __forceinline__ unsigned xb_add(unsigned* p, unsigned v) { return __hip_atomic_fetch_add(p, v, __ATOMIC_RELAXED, __HIP_MEMORY_SCOPE_AGENT); }
__device__ __forceinline__ unsigned xb_xcc_id() { return (unsigned)__builtin_amdgcn_s_getreg((3 << 11) | 20) & 0xFu; }
#define XB_SPIN(cond, bar) do { unsigned _sp = 0; while (cond) { __builtin_amdgcn_s_sleep(1); \
    if ((++_sp & 255u) == 0u) { if (xb_ld(&(bar)[XB_TMO])) break; if (_sp > XB_SPIN_CAP) { atomicAdd(&(bar)[XB_TMO], 1u); break; } } } } while (0)
struct XcdBarrier { unsigned* bar; unsigned x; volatile LAS unsigned* st; };
__device__ __forceinline__ XcdBarrier xcd_barrier_post(unsigned* bar, volatile LAS unsigned* st) {
    XcdBarrier b; b.bar = bar; b.x = xb_xcc_id(); b.st = st;
    if (threadIdx.x == 0) (void)xb_add(&bar[XB_XCNT(b.x)], 1u);
    return b;
}
__device__ __forceinline__ void xcd_barrier_complete(unsigned* bar, unsigned x, unsigned& nloc, unsigned& nx) {
    const unsigned G = gridDim.x * gridDim.y * gridDim.z;
    unsigned sum, cnt, mine, sp = 0u;
    for (;;) {
        sum = 0u; cnt = 0u; mine = 0u;
#pragma unroll
        for (unsigned j = 0; j < 16; ++j) { const unsigned c = xb_ld(&bar[XB_XCNT(j)]); sum += c; cnt += (c > 0u) ? 1u : 0u; mine = (j == x) ? c : mine; }
        if (sum == G) break;
        __builtin_amdgcn_s_sleep(1);
        if ((++sp & 255u) == 0u) { if (xb_ld(&bar[XB_TMO])) break; if (sp > XB_SPIN_CAP) { atomicAdd(&bar[XB_TMO], 1u); break; } }
    }
    nloc = mine > 0u ? mine : 1u; nx = cnt > 0u ? cnt : 1u;
}
__device__ __forceinline__ void xcd_barrier(const XcdBarrier& b) {
    asm volatile("s_waitcnt vmcnt(0)" ::: "memory");
    __syncthreads();
    if (threadIdx.x == 0) {
        unsigned* bar = b.bar;
        __builtin_amdgcn_s_waitcnt(0);
        unsigned nloc = b.st[0], nx = b.st[1];
        if (nloc == 0u) { xcd_barrier_complete(bar, b.x, nloc, nx); b.st[0] = nloc; b.st[1] = nx; }
        const unsigned old = xb_add(&bar[XB_XSUB(b.x)], 1u);
        const unsigned gen = old / nloc;
        if (old + 1u == (gen + 1u) * nloc) {
            __builtin_amdgcn_fence(__ATOMIC_RELEASE, "agent");
            asm volatile("s_waitcnt vmcnt(0)" ::: "memory");
            const unsigned og = xb_add(&bar[XB_TOP], 1u);
            const unsigned tg = og / nx;
            if (og + 1u == (tg + 1u) * nx) xb_add(&bar[XB_TOPGEN], 1u);
            else XB_SPIN(xb_ld(&bar[XB_TOPGEN]) == tg, bar);
            __builtin_amdgcn_fence(__ATOMIC_ACQUIRE, "agent");
            xb_add(&bar[XB_XGEN(b.x)], 1u);
            asm volatile("s_waitcnt vmcnt(0)" ::: "memory");
        } else {
            XB_SPIN(xb_ld(&bar[XB_XGEN(b.x)]) == gen, bar);
            __builtin_amdgcn_fence(__ATOMIC_ACQUIRE, "agent");
            asm volatile("s_waitcnt vmcnt(0)" ::: "memory");
        }
    }
    __syncthreads();
}

constexpr int N_PHASES = 11;
__global__ void __launch_bounds__(NTHR, 2) mk_fwd(Args a) {
    extern __shared__ __attribute__((aligned(16))) unsigned char lds_raw[];
    Frame F; F.lds = (LAS unsigned char*)lds_raw; F.tid = threadIdx.x; F.lane = F.tid & 63; F.wave = __builtin_amdgcn_readfirstlane(F.tid >> 6); F.G = gridDim.x; F.bid = blockIdx.x;
    unsigned char* ws = a.ws;
    const int lo = a.ph_lo, hi = a.ph_hi;
#if MK_N_LAUNCHES == 1
    volatile LAS unsigned* MISC = (volatile LAS unsigned*)(F.lds + 152 * 1024);
    if (F.tid < 4) MISC[F.tid] = 0u;
    __syncthreads();
    XcdBarrier xbar = xcd_barrier_post((unsigned*)(ws + WS_CTL) + CW_BAR, MISC);
#define SEAM(k) do { if (IN(k) && IN((k) + 1)) xcd_barrier(xbar); } while (0)
#else
#define SEAM(k) do { } while (0)
#endif
#define IN(k) (lo <= (k) && (k) < hi)
    LAS MoeTab* tab = (LAS MoeTab*)(F.lds + 144 * 1024);

#define RUNPH(k, ...) if (IN(k)) { F.lane = lane_now(); F.tid = F.wave * 64 + F.lane; __VA_ARGS__ }
    RUNPH(0, { phase0(F, a); }) SEAM(0);
    RUNPH(1, { phase1(F, a); __syncthreads(); dense_weight_convert(F, a); }) SEAM(1);
    RUNPH(2, {
        DenseOrder S{(const char*)(ws + WS_ACT), (const char*)(ws + WS_WIN), D, T / 256, INC / 256, F.G, F.bid};
        EpiInProj E{(bf16_t*)(ws + WS_PROJ), (bf16_t*)a.out, (float*)(ws + WS_DEC), (const float*)(ws + WS_SMALL) + 16, attn_body::C2};
        pg8::gemm_phase(F.lds, D, S, E);
    }) SEAM(2);
    RUNPH(3, {
        for (int g = F.bid; g < 256; g += F.G) hg::grp_local(F, a, g);
        __syncthreads();
        attn_phase(F, a);
    }) SEAM(3);
    RUNPH(4, { hg::grp_scan(F, a); attn_combine(F, a); }) SEAM(4);
    RUNPH(5, { for (int g = F.bid; g < 256; g += F.G) hg::grp_final(F, a, g); }) SEAM(5);
    RUNPH(6, {
        UpOrder S{(const char*)(ws + WS_YDA), (const char*)(ws + WS_YHG), (const char*)(ws + WS_WUPDA), (const char*)(ws + WS_WUPHG), F.G, F.bid};
        EpiUp E{(const bf16_t*)(ws + WS_PROJ), (bf16_t*)(ws + WS_ACT)};
        pg8::gemm_phase(F.lds, 512, S, E);
    }) SEAM(6);
    RUNPH(7, {
        DenseOrder S{(const char*)(ws + WS_ACT), (const char*)(ws + WS_WOUT), D, T / 256, D / 256, F.G, F.bid};
        EpiOut E{a.in[I_X], (const float*)(ws + WS_MOD), a.out};
        pg8::gemm_phase(F.lds, D, S, E);
        moe_weight_convert(F, a);
    }) SEAM(7);
    RUNPH(8, { phase_router(F, a); __syncthreads(); }) SEAM(8);
    RUNPH(9, {
        build_moe_tab(F, a, tab);
        unsigned* done = (unsigned*)(ws + WS_CTL) + CW_TILE;
        { Moe1Order S{tab, (const char*)(ws + WS_ACT), (const char*)(ws + WS_W13), (const int*)(ws + WS_TOKLIST), F.G, F.bid};
          EpiMoe1 E{(bf16_t*)(ws + WS_HS), done};
          pg8::gemm_phase(F.lds, D, S, E); }
        { Moe2Order S{tab, (const char*)(ws + WS_HS), (const char*)(ws + WS_W2), done, (unsigned*)(ws + WS_CTL) + CW_TMO, F.G, F.bid};
          EpiStoreBf16 E{(bf16_t*)(ws + WS_YS), D, 0, 1.0f};
          pg8::gemm_phase(F.lds, DEXP, S, E); }
    }) SEAM(9);
    RUNPH(10, { build_moe_tab(F, a, tab); phase_final(F, a, tab); })
#undef IN
#undef SEAM
}

extern "C" void kernel_launch(void* const* d_in, const int* in_sizes, int n_in, void* d_out, int out_size, void* d_ws, size_t ws_size, hipStream_t stream) {
    static int grid = 0;
    if (grid == 0) {
        if (n_in != 25 || in_sizes[0] != T * D || out_size != T * D || ws_size < WS_END) { fprintf(stderr, "kernel_launch: unexpected shapes (n_in %d, in0 %d, out %d, ws %zu)\n", n_in, n_in > 0 ? in_sizes[0] : -1, out_size, ws_size); grid = -1; return; }
        int dev = 0, cus = 0, per_cu = 0;
        if (hipGetDevice(&dev) != hipSuccess || hipDeviceGetAttribute(&cus, hipDeviceAttributeMultiprocessorCount, dev) != hipSuccess) { grid = -1; return; }
        if (hipFuncSetAttribute((const void*)mk_fwd, hipFuncAttributeMaxDynamicSharedMemorySize, LDS_BYTES) != hipSuccess) { fprintf(stderr, "kernel_launch: hipFuncSetAttribute failed\n"); grid = -1; return; }
        if (hipOccupancyMaxActiveBlocksPerMultiprocessor(&per_cu, (const void*)mk_fwd, NTHR, LDS_BYTES) != hipSuccess || per_cu < 1) { fprintf(stderr, "kernel_launch: occupancy query says %d\n", per_cu); per_cu = 1; }
        (void)hipGetLastError();
        grid = cus;
        if (grid > 256) grid = 256;
        while (T % grid) --grid;
    }
    if (grid < 0) return;
    (void)hipMemsetAsync((char*)d_ws + WS_CTL, 0, CTL_ZERO_BYTES, stream);
    Args a{};
    for (int i = 0; i < 25; ++i) a.in[i] = (const float*)d_in[i];
    a.out = (float*)d_out; a.ws = (unsigned char*)d_ws;
#if MK_N_LAUNCHES == 1
    a.ph_lo = 0; a.ph_hi = N_PHASES;
    void* args[] = {&a};
    hipError_t e = hipLaunchCooperativeKernel((const void*)mk_fwd, dim3(grid), dim3(NTHR), args, LDS_BYTES, stream);
    if (e != hipSuccess) fprintf(stderr, "cooperative launch failed: %s (grid %d)\n", hipGetErrorString(e), grid);
#else
    for (int p = 0; p < N_PHASES; ++p) {
        a.ph_lo = p; a.ph_hi = p + 1;
        hipLaunchKernelGGL(mk_fwd, dim3(grid), dim3(NTHR), LDS_BYTES, stream, a);
    }
#endif
}
```

```cpp
#include <hip/hip_runtime.h>
#include <cstdio>
#include <cstdint>

#ifndef MK_N_LAUNCHES
#define MK_N_LAUNCHES 1
#endif

#define LAS __attribute__((address_space(3)))
typedef unsigned short bf16_t;
typedef short bf16x8 __attribute__((ext_vector_type(8)));
typedef float f32x4 __attribute__((ext_vector_type(4)));
typedef float f32x2 __attribute__((ext_vector_type(2)));
typedef unsigned u32x4 __attribute__((ext_vector_type(4)));
typedef unsigned u32x2 __attribute__((ext_vector_type(2)));

constexpr int NB = 4, SEQ = 4096, D = 1024, T = NB * SEQ;
constexpr int INC = 5632;
constexpr int C_QDA = 0, C_KDA = 512, C_VDA = 1024, C_QHG = 1536, C_FHG = 2048, C_IHG = 2560, C_GHG = 3072, C_GDA = 3584, C_GHGATE = 4608;
constexpr int C_HGT = 1536;
constexpr int NEXP = 32, DEXP = 512;
constexpr int PMAX = 40960;
constexpr float EPS = 1e-6f;
constexpr int NWAVES = 8, NTHR = 512;

constexpr size_t MiB = 1u << 20;
constexpr size_t WS_CTL = 0, CTL_ZERO_BYTES = 64 * 1024;
constexpr size_t WS_MODP = 1 * MiB;
constexpr size_t WS_MOD = 5 * MiB / 2;
constexpr size_t WS_SMALL = 11 * MiB / 4;
constexpr size_t WS_TOKINFO = 3 * MiB;
constexpr size_t WS_TOKLIST = 4 * MiB;
constexpr size_t WS_DEC = 6 * MiB;
constexpr size_t WS_DS = 24 * MiB;
constexpr size_t WS_WIN = 8 * MiB;
constexpr size_t WS_WUPDA = 20 * MiB, WS_WUPHG = 21 * MiB, WS_WOUT = 22 * MiB;
constexpr size_t WS_ACT = 24 * MiB;
constexpr size_t WS_PROJ = 56 * MiB;
constexpr size_t WS_YDA = 232 * MiB, WS_YHG = 248 * MiB;
constexpr size_t WS_OA = 264 * MiB;
constexpr size_t WS_W13 = 56 * MiB;
constexpr size_t WS_W2 = 120 * MiB;
constexpr size_t WS_HS = 152 * MiB;
constexpr size_t WS_YS = 192 * MiB;
constexpr size_t WS_END = 296 * MiB;
constexpr int CW_COUNTS = 64;
constexpr int CW_BAR = 4096;
constexpr int CW_TILE = 8192;
constexpr int CW_TMO = 32;

constexpr int LDS_BYTES = 160 * 1024;

__device__ __forceinline__ float bf2f(unsigned v) { return __uint_as_float(v << 16); }
__device__ __forceinline__ unsigned f2bf(float f) { unsigned u = __float_as_uint(f); return (u + 0x7fffu + ((u >> 16) & 1u)) >> 16; }
__device__ __forceinline__ unsigned pk2(float lo, float hi) { return f2bf(lo) | (f2bf(hi) << 16); }
__device__ __forceinline__ float sigmoidf_(float x) { return 1.0f / (1.0f + __expf(-x)); }
__device__ __forceinline__ float siluf_(float x) { return x / (1.0f + __expf(-x)); }
__device__ __forceinline__ int lane_now() { int l; asm volatile("v_mbcnt_lo_u32_b32 %0, -1, 0\n\tv_mbcnt_hi_u32_b32 %0, -1, %0" : "=v"(l)); return l; }
__device__ __forceinline__ float wave_sum(float v) {
#pragma unroll
    for (int o = 1; o < 64; o <<= 1) v += __shfl_xor(v, o);
    return v;
}

namespace pg8 {
constexpr int BM = 256, BK = 64, HALF = 128, HTB = HALF * BK * 2, STAGE_BYTES = 8 * HTB;
__host__ __device__ __forceinline__ int lds_byte(int r, int c) { const int st = (r >> 4) * 2 + (c >> 5), rr = r & 15, cc = c & 31, ob = rr * 64 + cc * 2; return st * 1024 + (ob ^ (((ob >> 9) & 1) << 5)); }
__host__ __device__ __forceinline__ void stage_rc(int b, int& R, int& C) { const int st = b / 1024, sb = b % 1024, swz = sb ^ (((sb >> 9) & 1) << 5); R = (st >> 1) * 16 + swz / 64; C = (st & 1) * 32 + (swz % 64) / 2; }
__host__ __device__ __forceinline__ int perm32(int rho) { const int n = rho >> 4, i = rho & 15; return 8 * (i >> 2) + 4 * n + (i & 3); }

struct Unit { int pm, pn; const char* A; const char* B; int aux; };
__device__ __forceinline__ unsigned cvt_pk_bf16(float lo, float hi) { unsigned r; asm volatile("v_cvt_pk_bf16_f32 %0, %1, %2" : "=v"(r) : "v"(lo), "v"(hi)); return r; }

template <class Epi, class Sched>
__device__ __forceinline__ void gemm_phase(LAS unsigned char* lds, const int K, const Sched& S, const Epi& E) {
    const int tid = threadIdx.x, wid = __builtin_amdgcn_readfirstlane(tid >> 6), lane = tid & 63, wr = wid >> 2, wc = wid & 3, fr = lane & 15, fq = lane >> 4;
    const int nt = K / BK;
    unsigned voffB[2];
#define PG8_SETLANE() do { const int _l = lane_now(), _t = wid * 64 + _l; _Pragma("unroll") for (int _i = 0; _i < 2; ++_i) { int _R, _C; stage_rc(_t * 16 + _i * 8192, _R, _C); \
        const int _Rb = Epi::PERM ? ((_R & ~31) + perm32(_R & 31)) : _R; voffB[_i] = (unsigned)(_Rb * K + _C) * 2u; } \
        aoff = lds_byte(wr * 64 + (_l & 15), (_l >> 4) * 8); boff = lds_byte(wc * 32 + (_l & 15), (_l >> 4) * 8); } while (0)
    const size_t kstep = (size_t)(BK * 2);
    const size_t hstep = (size_t)HALF * K * 2;
    const unsigned ldsw = (unsigned)wid * 1024u;
    int aoff, boff; PG8_SETLANE();
#define PG8_SA(b, h) (((b) * 2 + (h)) * HTB)
#define PG8_SB(b, h) ((4 + (b) * 2 + (h)) * HTB)
#define PG8_STAGE(bufoff, gbase, voff) do { _Pragma("unroll") for (int _i = 0; _i < 2; ++_i) \
        __builtin_amdgcn_global_load_lds((const unsigned*)((const char*)(gbase) + (voff)[_i]), (LAS unsigned*)(lds + (bufoff) + ldsw + _i * 8192), 16, 0, 0); } while (0)
#define PG8_LDA(dst, b, h) do { _Pragma("unroll") for (int m = 0; m < 4; ++m) _Pragma("unroll") for (int k = 0; k < 2; ++k) dst[m][k] = *(const LAS bf16x8*)(lds + PG8_SA(b, h) + aoff + m * 2048 + k * 1024); } while (0)
#define PG8_LDB(dst, b, h) do { _Pragma("unroll") for (int n = 0; n < 2; ++n) _Pragma("unroll") for (int k = 0; k < 2; ++k) dst[n][k] = *(const LAS bf16x8*)(lds + PG8_SB(b, h) + boff + n * 2048 + k * 1024); } while (0)
#define PG8_MMA(ai, bj, At, Bt) do { __builtin_amdgcn_s_setprio(1); _Pragma("unroll") for (int m = 0; m < 4; ++m) _Pragma("unroll") for (int n = 0; n < 2; ++n) _Pragma("unroll") for (int k = 0; k < 2; ++k) \
        acc[ai][bj][m][n] = __builtin_amdgcn_mfma_f32_16x16x32_bf16(Bt[n][k], At[m][k], acc[ai][bj][m][n], 0, 0, 0); __builtin_amdgcn_s_setprio(0); } while (0)
#define PG8_WAIT_V(n) asm volatile("s_waitcnt vmcnt(" #n ")" ::: "memory")
#define PG8_WAIT_L(n) asm volatile("s_waitcnt lgkmcnt(" #n ")" ::: "memory")
#define PG8_BAR __builtin_amdgcn_s_barrier()
#define PG8_SCHED __builtin_amdgcn_sched_barrier(0)
#define PG8_SETA(vo, u) do { const int _t = wid * 64 + lane_now(); _Pragma("unroll") for (int _i = 0; _i < 2; ++_i) { int _R, _C; stage_rc(_t * 16 + _i * 8192, _R, _C); \
        _Pragma("unroll") for (int _h = 0; _h < 2; ++_h) vo[_h][_i] = (unsigned)((size_t)S.arow(u, _h * HALF + _R) * (size_t)K + _C) * 2u; } if (Sched::GATHER) PG8_WAIT_V(0); } while (0)
    Unit cur, nxt; int ui = 0;
    if (!S.next(0, cur)) return;
    f32x4 acc[2][2][4][2];
#pragma unroll
    for (int a = 0; a < 2; ++a)
#pragma unroll
        for (int b = 0; b < 2; ++b)
#pragma unroll
            for (int m = 0; m < 4; ++m)
#pragma unroll
                for (int n = 0; n < 2; ++n) acc[a][b][m][n] = (f32x4){0.f, 0.f, 0.f, 0.f};
    bf16x8 At[4][2], B0[2][2], B1[2][2];
    unsigned voC[2][2], voN[2][2];
    S.a_ready(cur);
    PG8_SETA(voC, cur);
    const char* cA = cur.A; const char* cB = cur.B;
    PG8_STAGE(PG8_SB(0, 0), cB, voffB); PG8_STAGE(PG8_SB(0, 1), cB + hstep, voffB); PG8_STAGE(PG8_SA(0, 0), cA, voC[0]); PG8_STAGE(PG8_SA(0, 1), cA, voC[1]);
    if (wr == 1) PG8_BAR;
    PG8_WAIT_V(2); PG8_BAR;
    PG8_STAGE(PG8_SB(1, 0), cB + kstep, voffB); PG8_STAGE(PG8_SA(1, 0), cA + kstep, voC[0]); PG8_STAGE(PG8_SB(1, 1), cB + hstep + kstep, voffB);
    PG8_WAIT_V(6); PG8_BAR;
    for (;;) {
        const bool has_next = S.next(ui + 1, nxt);
        if (has_next) { PG8_SETA(voN, nxt); }
        else {
#pragma unroll
            for (int h = 0; h < 2; ++h)
#pragma unroll
                for (int i = 0; i < 2; ++i) voN[h][i] = voC[h][i];
        }
        const char* nA = has_next ? nxt.A : cA; const char* nB = has_next ? nxt.B : cB;
        for (int t = 0; t < nt; t += 2) {
            const bool last = (t == nt - 2);
            if (last && has_next) S.a_ready(nxt);
            const char* a1 = cA + (size_t)(t + 1) * kstep;
            const char* a2 = last ? nA : cA + (size_t)(t + 2) * kstep; const char* b2 = last ? nB : cB + (size_t)(t + 2) * kstep;
            const char* a3 = a2 + kstep; const char* b3 = b2 + kstep;
            unsigned vo2[2][2];
#pragma unroll
            for (int h = 0; h < 2; ++h)
#pragma unroll
                for (int i = 0; i < 2; ++i) vo2[h][i] = last ? voN[h][i] : voC[h][i];
            PG8_LDB(B0, 0, 0); PG8_LDB(B1, 0, 1); PG8_SCHED; PG8_LDA(At, 0, 0); PG8_STAGE(PG8_SA(1, 1), a1, voC[1]);
            PG8_WAIT_V(8); PG8_WAIT_L(0); PG8_BAR; PG8_MMA(0, 0, At, B0); PG8_MMA(0, 1, At, B1); PG8_BAR; PG8_SCHED;
            PG8_LDA(At, 0, 1); PG8_STAGE(PG8_SB(0, 0), b2, voffB); PG8_STAGE(PG8_SB(0, 1), b2 + hstep, voffB); PG8_STAGE(PG8_SA(0, 0), a2, vo2[0]);
            PG8_WAIT_V(8); PG8_WAIT_L(0); PG8_BAR; PG8_MMA(1, 0, At, B0); PG8_MMA(1, 1, At, B1); PG8_BAR; PG8_SCHED;
            PG8_LDB(B0, 1, 0); PG8_LDB(B1, 1, 1); PG8_SCHED; PG8_LDA(At, 1, 0); PG8_STAGE(PG8_SA(0, 1), a2, vo2[1]);
            PG8_WAIT_V(8); PG8_WAIT_L(0); PG8_BAR; PG8_MMA(0, 0, At, B0); PG8_MMA(0, 1, At, B1); PG8_BAR; PG8_SCHED;
            PG8_LDA(At, 1, 1); PG8_STAGE(PG8_SB(1, 0), b3, voffB); PG8_STAGE(PG8_SB(1, 1), b3 + hstep, voffB); PG8_STAGE(PG8_SA(1, 0), a3, vo2[0]);
            PG8_WAIT_V(8); PG8_WAIT_L(0); PG8_BAR; PG8_MMA(1, 0, At, B0); PG8_MMA(1, 1, At, B1); PG8_BAR; PG8_SCHED;
        }
        if (wr == 0) PG8_BAR;
        const bool keep = E(acc, cur, wr, wc, fr, fq);
        if (!has_next) break;
        if (!keep) {
#pragma unroll
            for (int a = 0; a < 2; ++a)
#pragma unroll
                for (int b = 0; b < 2; ++b)
#pragma unroll
                    for (int m = 0; m < 4; ++m)
#pragma unroll
                        for (int n = 0; n < 2; ++n) acc[a][b][m][n] = (f32x4){0.f, 0.f, 0.f, 0.f};
        }
        cur = nxt; cA = nA; cB = nB; ++ui;
        if (Sched::GATHER) {
#pragma unroll
            for (int h = 0; h < 2; ++h)
#pragma unroll
                for (int i = 0; i < 2; ++i) voC[h][i] = voN[h][i];
        } else { PG8_SETA(voC, cur); }
        PG8_SETLANE();
        if (wr == 1) PG8_BAR;
    }
    PG8_WAIT_V(0);
    PG8_BAR;
#undef PG8_SA
#undef PG8_SB
#undef PG8_STAGE
#undef PG8_LDA
#undef PG8_LDB
#undef PG8_MMA
#undef PG8_WAIT_V
#undef PG8_WAIT_L
#undef PG8_BAR
#undef PG8_SCHED
#undef PG8_SETA
#undef PG8_SETLANE
}
}

struct Args { const float* in[25]; float* out; unsigned char* ws; int ph_lo, ph_hi; };
enum { I_X = 0, I_C, I_WADA, I_BADA, I_N1G, I_WIN, I_LQ1, I_LK1, I_LQ2, I_LK2, I_SUBG, I_LBL, I_HGNG, I_WUPDA, I_WUPHG, I_WOUT, I_N2G, I_WRG, I_BRG, I_WRE, I_BRE, I_W1, I_W3, I_W2, I_FG };

struct DenseOrder {
    static constexpr bool GATHER = false;
    const char* A; const char* Bt; int K, nM, nN, G, c;
    __device__ __forceinline__ bool next(int i, pg8::Unit& u) const {
        const int L = i * G + c, nwg = nM * nN; if (L >= nwg) return false;
        int wgid = L; { const int q = nwg / 8, r = nwg % 8, xcd = wgid % 8, off = wgid / 8; wgid = (xcd < r ? xcd * (q + 1) : r * (q + 1) + (xcd - r) * q) + off; }
        const int nig = 8 * nN, gid = wgid / nig, fm = gid * 8, gsz = (nM - fm) < 8 ? (nM - fm) : 8;
        u.pm = fm + ((wgid % nig) % gsz); u.pn = (wgid % nig) / gsz; u.A = A; u.B = Bt + (size_t)u.pn * 256 * K * 2; u.aux = 0; return true;
    }
    __device__ __forceinline__ void a_ready(const pg8::Unit&) const {}
    __device__ __forceinline__ unsigned arow(const pg8::Unit& u, int r) const { return (unsigned)(u.pm * 256 + r); }
};
struct UpOrder {
    static constexpr bool GATHER = false;
    const char* A0; const char* A1; const char* B0; const char* B1; int G, c;
    __device__ __forceinline__ bool next(int i, pg8::Unit& u) const {
        const int tile = (i >> 1) * G + c; if (tile >= 256) return false;
        u.pm = tile >> 2; u.pn = tile & 3; u.aux = i & 1;
        u.A = (i & 1) ? A1 : A0; u.B = ((i & 1) ? B1 : B0) + (size_t)u.pn * 256 * 512 * 2; return true;
    }
    __device__ __forceinline__ void a_ready(const pg8::Unit&) const {}
    __device__ __forceinline__ unsigned arow(const pg8::Unit& u, int r) const { return (unsigned)(u.pm * 256 + r); }
};
struct MoeTab { int nt; int pad[3]; int tile_e[176]; int tile_m[176]; int cnt[32]; int tbase[33]; };
struct Moe1Order {
    static constexpr bool GATHER = true;
    const LAS MoeTab* tab; const char* A; const char* W; const int* toklist; int G, c;
    __device__ __forceinline__ bool next(int i, pg8::Unit& u) const {
        const int L = i * G + c; if (L >= tab->nt * 4) return false;
        const int ti = L >> 2; u.pm = ti; u.pn = L & 3; u.aux = ti; u.A = A;
        u.B = W + ((size_t)tab->tile_e[ti] * 1024 + (size_t)u.pn * 256) * 1024 * 2; return true;
    }
    __device__ __forceinline__ void a_ready(const pg8::Unit&) const {}
    __device__ __forceinline__ unsigned arow(const pg8::Unit& u, int r) const {
        const int e = tab->tile_e[u.aux], rr = tab->tile_m[u.aux] * 256 + r;
        return rr < tab->cnt[e] ? (unsigned)toklist[e * T + rr] : 0u;
    }
};
struct Moe2Order {
    static constexpr bool GATHER = false;
    const LAS MoeTab* tab; const char* A; const char* W; unsigned* done; unsigned* tmo; int G, c;
    __device__ __forceinline__ bool next(int i, pg8::Unit& u) const {
        const int n1 = tab->nt * 4, r = n1 % G, nl = G - r; int j;
        if (r > 0 && c >= r) { if (i < 2) j = (c - r) + i * nl; else j = 2 * nl + (c - r) + (i - 2) * G; }
        else j = (r > 0 ? 2 * nl : 0) + ((c - r + G) % G) + i * G;
        if (j >= n1) return false;
        const int ti = j >> 2; u.pm = ti; u.pn = j & 3; u.aux = ti; u.A = A;
        u.B = W + ((size_t)tab->tile_e[ti] * 1024 + (size_t)u.pn * 256) * 512 * 2; return true;
    }
    __device__ __forceinline__ unsigned arow(const pg8::Unit& u, int r) const { return (unsigned)(u.pm * 256 + r); }
    __device__ __forceinline__ void a_ready(const pg8::Unit& u) const {
        if (threadIdx.x < 64) {
            unsigned polls = 0;
            while ((unsigned)__builtin_amdgcn_readfirstlane(__hip_atomic_load(done + 16 * u.pm, __ATOMIC_RELAXED, __HIP_MEMORY_SCOPE_AGENT)) < 32u) {
                if (++polls > (1u << 22)) { if (threadIdx.x == 0) __hip_atomic_store(tmo, 1u, __ATOMIC_RELAXED, __HIP_MEMORY_SCOPE_AGENT); break; }
                __builtin_amdgcn_s_sleep(2); }
            __builtin_amdgcn_fence(__ATOMIC_ACQUIRE, "agent");
            asm volatile("s_waitcnt vmcnt(0)" ::: "memory");
        }
        asm volatile("" ::: "memory"); __builtin_amdgcn_s_barrier(); asm volatile("" ::: "memory");
    }
};

using pg8::Unit; using pg8::cvt_pk_bf16;
struct EpiStoreBf16 {
    static constexpr bool PERM = true;
    bf16_t* O; int ldc; int nscale; float scale0;
    __device__ __forceinline__ bool operator()(f32x4 (&acc)[2][2][4][2], const Unit& u, int wr, int wc, int fr, int fq) const {
        const int row0 = u.pm * 256 + wr * 64 + fr, col0 = u.pn * 256 + wc * 32 + 8 * fq;
        const float sc = u.pn < nscale ? scale0 : 1.0f;
#pragma unroll
        for (int ai = 0; ai < 2; ++ai)
#pragma unroll
            for (int m = 0; m < 4; ++m) { bf16_t* rowp = O + (size_t)(row0 + ai * 128 + m * 16) * ldc + col0;
#pragma unroll
                for (int bj = 0; bj < 2; ++bj) { const f32x4 v0 = acc[ai][bj][m][0] * sc, v1 = acc[ai][bj][m][1] * sc;
                    u32x4 w; w.x = cvt_pk_bf16(v0[0], v0[1]); w.y = cvt_pk_bf16(v0[2], v0[3]); w.z = cvt_pk_bf16(v1[0], v1[1]); w.w = cvt_pk_bf16(v1[2], v1[3]);
                    *(u32x4*)(rowp + bj * 128) = w; } }
        return false;
    }
};
template <int N> __device__ __forceinline__ float dpp_shr(float x) { return __builtin_bit_cast(float, __builtin_amdgcn_update_dpp(0, __builtin_bit_cast(int, x), 0x110 + N, 0xf, 0xf, true)); }
template <int N> __device__ __forceinline__ float dpp_ror(float x) { return __builtin_bit_cast(float, __builtin_amdgcn_update_dpp(0, __builtin_bit_cast(int, x), 0x120 + N, 0xf, 0xf, true)); }
__device__ __forceinline__ float rowsum16(float x) { x += dpp_ror<8>(x); x += dpp_ror<4>(x); x += dpp_ror<2>(x); x += dpp_ror<1>(x); return x; }
__device__ __forceinline__ float scan16(float x) { x += dpp_shr<1>(x); x += dpp_shr<2>(x); x += dpp_shr<4>(x); x += dpp_shr<8>(x); return x; }
struct EpiInProj {
    static constexpr bool PERM = true;
    bf16_t* O; bf16_t* KE; float* DEC; const float* lbv; float scale0;
    __device__ __forceinline__ bool operator()(f32x4 (&acc)[2][2][4][2], const Unit& u, int wr, int wc, int fr, int fq) const {
        { const int l_ = lane_now(); fr = l_ & 15; fq = l_ >> 4; }
        const int row0 = u.pm * 256 + wr * 64 + fr, col0 = u.pn * 256 + wc * 32 + 8 * fq;
        if (u.pn >= 6 && u.pn < 10) {
            const int h = u.pn - 6, lane = 16 * fq + fr, kb = wc * 32 + 8 * fq;
            const int bb = (u.pm * 256) / SEQ, ch0 = ((u.pm * 256) % SEQ + wr * 64) >> 6;
            const f32x4 lb0 = *(const f32x4*)(lbv + h * 128 + kb), lb1 = *(const f32x4*)(lbv + h * 128 + kb + 4);
#pragma unroll
            for (int ai = 0; ai < 2; ++ai) {
                unsigned kep[4][4];
#pragma unroll
                for (int n = 0; n < 2; ++n) {
#pragma unroll
                    for (int ep = 0; ep < 2; ++ep) {
                        float ke2[2][4];
#pragma unroll
                        for (int z = 0; z < 2; ++z) {
                            const int e = 2 * ep + z; const float lb = n ? lb1[e] : lb0[e];
                            float f[4], c[4], tot[4];
#pragma unroll
                            for (int m = 0; m < 4; ++m) { const float fl = acc[ai][1][m][n][e]; f[m] = lb + (1.0f - lb) * __builtin_amdgcn_rcpf(1.0f + __builtin_amdgcn_exp2f(-1.4426950408889634f * fl)); const float lf = __logf(f[m]); c[m] = scan16(lf); tot[m] = rowsum16(lf); }
                            const float alast = (tot[0] + tot[1]) + (tot[2] + tot[3]); const float eal = __expf(alast);
                            float pre = 0.f;
#pragma unroll
                            for (int m = 0; m < 4; ++m) { const float A = c[m] + pre; pre += tot[m]; const float q = acc[ai][0][m][n][e]; const float kk = 1.0f - f[m];
                                acc[ai][0][m][n][e] = q * __builtin_amdgcn_rcpf(1.0f + __builtin_amdgcn_exp2f(-1.4426950408889634f * q)) * __expf(A);
                                const float kd = kk * __expf(-A); acc[ai][1][m][n][e] = kd; ke2[z][m] = kd * eal; }
                            if (fr == 0) DEC[((size_t)(bb * 4 + h) * 64 + ch0 + 2 * ai) * 128 + kb + 4 * n + e] = eal;
                        }
#pragma unroll
                        for (int m = 0; m < 4; ++m) kep[m][2 * n + ep] = cvt_pk_bf16(ke2[0][m], ke2[1][m]);
                    }
                }
#pragma unroll
                for (int m = 0; m < 4; ++m) *(u32x4*)(KE + (size_t)(row0 + ai * 128 + m * 16) * 512 + h * 128 + kb) = (u32x4){kep[m][0], kep[m][1], kep[m][2], kep[m][3]};
            }
        }
        const float sc = u.pn < 2 ? scale0 : 1.0f;
#pragma unroll
        for (int ai = 0; ai < 2; ++ai)
#pragma unroll
            for (int m = 0; m < 4; ++m) { bf16_t* rowp = O + (size_t)(row0 + ai * 128 + m * 16) * INC + col0;
#pragma unroll
                for (int bj = 0; bj < 2; ++bj) { const f32x4 v0 = acc[ai][bj][m][0] * sc, v1 = acc[ai][bj][m][1] * sc;
                    u32x4 w; w.x = cvt_pk_bf16(v0[0], v0[1]); w.y = cvt_pk_bf16(v0[2], v0[3]); w.z = cvt_pk_bf16(v1[0], v1[1]); w.w = cvt_pk_bf16(v1[2], v1[3]);
                    *(u32x4*)(rowp + bj * 128) = w; } }
        return false;
    }
};
struct EpiUp {
    static constexpr bool PERM = true;
    const bf16_t* proj; bf16_t* O;
    __device__ __forceinline__ bool operator()(f32x4 (&acc)[2][2][4][2], const Unit& u, int wr, int wc, int fr, int fq) const {
        const int row0 = u.pm * 256 + wr * 64 + fr, col0 = u.pn * 256 + wc * 32 + 8 * fq;
#pragma unroll
        for (int ai = 0; ai < 2; ++ai)
#pragma unroll
            for (int m = 0; m < 4; ++m) { const size_t row = (size_t)(row0 + ai * 128 + m * 16);
#pragma unroll
                for (int bj = 0; bj < 2; ++bj) {
                    const int col = col0 + bj * 128;
                    const u32x4 gh = *(const u32x4*)(proj + row * INC + C_GHGATE + col);
                    float sh[8];
#pragma unroll
                    for (int j = 0; j < 4; ++j) { sh[2 * j] = 1.0f + __builtin_amdgcn_exp2f(-1.4426950408889634f * bf2f(gh[j] & 0xffffu)); sh[2 * j + 1] = 1.0f + __builtin_amdgcn_exp2f(-1.4426950408889634f * bf2f(gh[j] >> 16)); }
                    if (u.aux == 0) {
                        const u32x4 gd = *(const u32x4*)(proj + row * INC + C_GDA + col);
#pragma unroll
                        for (int j = 0; j < 4; ++j) {
                            const float d0 = 1.0f + __builtin_amdgcn_exp2f(-1.4426950408889634f * bf2f(gd[j] & 0xffffu)), d1 = 1.0f + __builtin_amdgcn_exp2f(-1.4426950408889634f * bf2f(gd[j] >> 16));
                            const float r0 = sh[2 * j] * __builtin_amdgcn_rcpf(d0), r1 = sh[2 * j + 1] * __builtin_amdgcn_rcpf(d1);
                            if (j < 2) { acc[ai][bj][m][0][2 * j] *= r0; acc[ai][bj][m][0][2 * j + 1] *= r1; }
                            else { acc[ai][bj][m][1][2 * j - 4] *= r0; acc[ai][bj][m][1][2 * j - 3] *= r1; }
                        }
                    } else {
                        const f32x4 v0 = acc[ai][bj][m][0], v1 = acc[ai][bj][m][1];
#pragma unroll
                        for (int j = 0; j < 8; ++j) sh[j] = __builtin_amdgcn_rcpf(sh[j]);
                        u32x4 w; w.x = cvt_pk_bf16(v0[0] * sh[0], v0[1] * sh[1]); w.y = cvt_pk_bf16(v0[2] * sh[2], v0[3] * sh[3]);
                        w.z = cvt_pk_bf16(v1[0] * sh[4], v1[1] * sh[5]); w.w = cvt_pk_bf16(v1[2] * sh[6], v1[3] * sh[7]);
                        *(u32x4*)(O + row * D + col) = w;
                    }
                } }
        return u.aux == 0;
    }
};
struct EpiOut {
    static constexpr bool PERM = false;
    const float* x; const float* mod; float* O;
    __device__ __forceinline__ bool operator()(f32x4 (&acc)[2][2][4][2], const Unit& u, int wr, int wc, int fr, int fq) const {
        const int row0 = u.pm * 256 + wr * 64 + fr, col0 = u.pn * 256 + wc * 32 + 4 * fq;
        const int b = (u.pm * 256) / SEQ;
        f32x4 gt[2][2];
#pragma unroll
        for (int bj = 0; bj < 2; ++bj)
#pragma unroll
            for (int n = 0; n < 2; ++n) gt[bj][n] = *(const f32x4*)(mod + b * 6144 + 2048 + col0 + bj * 128 + n * 16);
#pragma unroll
        for (int ai = 0; ai < 2; ++ai)
#pragma unroll
            for (int m = 0; m < 4; ++m) { const size_t off = (size_t)(row0 + ai * 128 + m * 16) * D + col0;
#pragma unroll
                for (int bj = 0; bj < 2; ++bj)
#pragma unroll
                    for (int n = 0; n < 2; ++n) { const f32x4 xv = *(const f32x4*)(x + off + bj * 128 + n * 16);
                        *(f32x4*)(O + off + bj * 128 + n * 16) = xv + gt[bj][n] * acc[ai][bj][m][n]; } }
        return false;
    }
};
struct EpiMoe1 {
    static constexpr bool PERM = true;
    bf16_t* O; unsigned* done;
    __device__ __forceinline__ bool operator()(f32x4 (&acc)[2][2][4][2], const Unit& u, int wr, int wc, int fr, int fq) const {
        const int row0 = u.pm * 256 + wr * 64 + fr, col0 = u.pn * 128 + wc * 32 + 8 * fq;
#pragma unroll
        for (int ai = 0; ai < 2; ++ai)
#pragma unroll
            for (int m = 0; m < 4; ++m) { bf16_t* rowp = O + (size_t)(row0 + ai * 128 + m * 16) * DEXP + col0;
                float h[8];
#pragma unroll
                for (int n = 0; n < 2; ++n)
#pragma unroll
                    for (int e = 0; e < 4; ++e) { const float x_ = acc[ai][0][m][n][e]; h[n * 4 + e] = x_ * __builtin_amdgcn_rcpf(1.0f + __builtin_amdgcn_exp2f(-1.4426950408889634f * x_)) * acc[ai][1][m][n][e]; }
                u32x4 w; w.x = cvt_pk_bf16(h[0], h[1]); w.y = cvt_pk_bf16(h[2], h[3]); w.z = cvt_pk_bf16(h[4], h[5]); w.w = cvt_pk_bf16(h[6], h[7]);
                asm volatile("global_store_dwordx4 %0, %1, off sc1\n\ts_nop 1" :: "v"(rowp), "v"(w) : "memory"); }
        asm volatile("s_waitcnt vmcnt(0)" ::: "memory");
        if ((threadIdx.x & 63) == 0) __hip_atomic_fetch_add(done + 16 * u.pm, 1u, __ATOMIC_RELAXED, __HIP_MEMORY_SCOPE_AGENT);
        return false;
    }
};

struct Frame { LAS unsigned char* lds; int tid, lane, wave, G, bid; };

__device__ __forceinline__ void transpose_item(const float* Wsrc, int ldw, bf16_t* dst, int ldd, LAS float* scr, int lane) {
#pragma unroll 8
    for (int i = 0; i < 32; ++i) { const int kk = 2 * i + (lane >> 5); scr[kk * 33 + (lane & 31)] = __builtin_nontemporal_load(Wsrc + (size_t)kk * ldw + (lane & 31)); }
    asm volatile("s_waitcnt lgkmcnt(0)" ::: "memory");
    const int c = lane & 7;
#pragma unroll
    for (int j = 0; j < 4; ++j) { const int n = (lane >> 3) + 8 * j; const LAS float* s = scr + (8 * c) * 33 + n;
        u32x4 o; o.x = pk2(s[0 * 33], s[1 * 33]); o.y = pk2(s[2 * 33], s[3 * 33]); o.z = pk2(s[4 * 33], s[5 * 33]); o.w = pk2(s[6 * 33], s[7 * 33]);
        *(u32x4*)(dst + (size_t)n * ldd + 8 * c) = o; }
    asm volatile("s_waitcnt lgkmcnt(0)" ::: "memory");
}
__device__ __forceinline__ void transpose_matrix(const Frame& F, const float* W, int K, int N, bf16_t* WT) {
    LAS float* scr = (LAS float*)(F.lds + F.wave * 8448);
    const int gw = F.bid * NWAVES + F.wave, NGW = F.G * NWAVES, nblk = N / 32, items = (K / 64) * nblk;
    for (int it = gw; it < items; it += NGW) { const int kb = it / nblk, nb = it % nblk;
        transpose_item(W + (size_t)(64 * kb) * N + 32 * nb, N, WT + (size_t)(32 * nb) * K + 64 * kb, K, scr, F.lane); }
}

__device__ __forceinline__ void phase0(const Frame& F, const Args& a) {
    unsigned char* ws = a.ws;
    {
        float* modp = (float*)(ws + WS_MODP);
        const float* c = a.in[I_C]; const float* wada = a.in[I_WADA];
        LAS float* cs = (LAS float*)(F.lds + 72 * 1024);
        for (int i = F.tid; i < 4 * D; i += NTHR) cs[i] = siluf_(c[i]);
        __syncthreads();
        for (int wt = F.bid + 256 * F.wave; wt < 384; wt += 256 * NWAVES) {
            if (F.G != 256) break;
            const int ks = wt / 24, jw = wt % 24, j = jw * 256 + F.lane * 4;
            f32x4 s[4] = {{0, 0, 0, 0}, {0, 0, 0, 0}, {0, 0, 0, 0}, {0, 0, 0, 0}};
#pragma unroll 8
            for (int k = ks * 64; k < ks * 64 + 64; ++k) {
                const f32x4 w = *(const f32x4*)(wada + (size_t)k * 6144 + j);
#pragma unroll
                for (int b = 0; b < 4; ++b) s[b] += w * cs[b * D + k];
            }
#pragma unroll
            for (int b = 0; b < 4; ++b) *(f32x4*)(modp + ((size_t)ks * 4 + b) * 6144 + j) = s[b];
        }
        if (F.G != 256) {
            const int gw = F.bid * NWAVES + F.wave, NGW = F.G * NWAVES;
            for (int wt = gw; wt < 384; wt += NGW) {
                const int ks = wt / 24, jw = wt % 24, j = jw * 256 + F.lane * 4;
                f32x4 s[4] = {{0, 0, 0, 0}, {0, 0, 0, 0}, {0, 0, 0, 0}, {0, 0, 0, 0}};
                for (int k = ks * 64; k < ks * 64 + 64; ++k) {
                    const f32x4 w = *(const f32x4*)(wada + (size_t)k * 6144 + j);
#pragma unroll
                    for (int b = 0; b < 4; ++b) { const float cv = siluf_(c[b * D + k]); s[b] += w * cv; }
                }
#pragma unroll
                for (int b = 0; b < 4; ++b) *(f32x4*)(modp + ((size_t)ks * 4 + b) * 6144 + j) = s[b];
            }
        }
    }
    if (F.bid == 0) {
        float* sm = (float*)(ws + WS_SMALL);
        if (F.tid == 0) {
            float s1 = 0.f, s2 = 0.f;
            for (int i = 0; i < 64; ++i) { s1 += a.in[I_LQ1][i] * a.in[I_LK1][i]; s2 += a.in[I_LQ2][i] * a.in[I_LK2][i]; }
            sm[0] = expf(s1) - expf(s2) + 0.2f;
        }
        { const float l0 = a.in[I_LBL][F.tid], l1 = a.in[I_LBL][512 + F.tid]; const float mx = fmaxf(l0, l1);
          const float e0 = expf(l0 - mx), e1 = expf(l1 - mx); sm[16 + F.tid] = e0 / (e0 + e1); }
    }
}
__device__ __forceinline__ void moe_weight_convert(const Frame& F, const Args& a) {
    LAS float* scr = (LAS float*)(F.lds + F.wave * 8448);
    const int gw = F.bid * NWAVES + F.wave, NGW = F.G * NWAVES;
    bf16_t* w13 = (bf16_t*)(a.ws + WS_W13); bf16_t* w2t = (bf16_t*)(a.ws + WS_W2);
    for (int it = gw; it < 2 * NEXP * 256; it += NGW) {
        const int which = it / (NEXP * 256), r = it % (NEXP * 256), e = r >> 8, kb = (r >> 4) & 15, nb = r & 15, n0 = 32 * nb;
        const float* W = a.in[which ? I_W3 : I_W1] + (size_t)e * 1024 * 512;
        const int drow = 256 * (n0 >> 7) + (which ? 128 : 0) + (n0 & 127);
        transpose_item(W + (size_t)(64 * kb) * 512 + n0, 512, w13 + ((size_t)e * 1024 + drow) * 1024 + 64 * kb, 1024, scr, F.lane);
    }
    for (int it = gw; it < NEXP * 256; it += NGW) {
        const int e = it >> 8, kb = (it >> 5) & 7, nb = it & 31;
        const float* W = a.in[I_W2] + (size_t)e * 512 * 1024;
        transpose_item(W + (size_t)(64 * kb) * 1024 + 32 * nb, 1024, w2t + ((size_t)e * 1024 + 32 * nb) * 512 + 64 * kb, 512, scr, F.lane);
    }
}

__device__ __forceinline__ void dense_weight_convert(const Frame& F, const Args& a) {
    unsigned char* ws = a.ws;
    {
        LAS float* scr = (LAS float*)(F.lds + F.wave * 8448);
        const int gw = F.bid * NWAVES + F.wave, NGW = F.G * NWAVES, nblk = INC / 32, items = (D / 64) * nblk;
        bf16_t* WT = (bf16_t*)(ws + WS_WIN);
        for (int it = gw; it < items; it += NGW) { const int kb = it / nblk, n0 = 32 * (it % nblk); int dr = n0;
            if (n0 >= C_QHG && n0 < C_FHG) dr = C_HGT + 256 * ((n0 - C_QHG) >> 7) + ((n0 - C_QHG) & 127);
            else if (n0 >= C_FHG && n0 < C_IHG) dr = C_HGT + 256 * ((n0 - C_FHG) >> 7) + 128 + ((n0 - C_FHG) & 127);
            transpose_item(a.in[I_WIN] + (size_t)(64 * kb) * INC + n0, INC, WT + (size_t)dr * D + 64 * kb, D, scr, F.lane); }
    }
    transpose_matrix(F, a.in[I_WUPDA], 512, D, (bf16_t*)(ws + WS_WUPDA));
    transpose_matrix(F, a.in[I_WUPHG], 512, D, (bf16_t*)(ws + WS_WUPHG));
    transpose_matrix(F, a.in[I_WOUT], D, D, (bf16_t*)(ws + WS_WOUT));
}
__device__ __forceinline__ void phase1(const Frame& F, const Args& a) {
    const float* modp = (const float*)(a.ws + WS_MODP); float* mod = (float*)(a.ws + WS_MOD);
    for (int i = F.bid * NTHR + F.tid; i < 4 * 6144; i += F.G * NTHR) {
        float s = a.in[I_BADA][i % 6144];
        for (int ks = 0; ks < 16; ++ks) s += modp[(size_t)ks * 4 * 6144 + i];
        mod[i] = s;
    }
    LAS float* Gs = (LAS float*)F.lds;
    LAS float* Ss = Gs + 1024;
    bf16_t* H = (bf16_t*)(a.ws + WS_ACT);
    const int rows_per_blk = T / F.G;
    const int r0 = F.bid * rows_per_blk, b = r0 / SEQ;
    for (int k = F.tid; k < 1024; k += NTHR) {
        float sh = a.in[I_BADA][k], sc = a.in[I_BADA][1024 + k];
        for (int ks = 0; ks < 16; ++ks) { sh += modp[((size_t)ks * 4 + b) * 6144 + k]; sc += modp[((size_t)ks * 4 + b) * 6144 + 1024 + k]; }
        Gs[k] = a.in[I_N1G][k] * (1.0f + sc); Ss[k] = sh;
    }
    __syncthreads();
    for (int r = r0 + F.wave; r < r0 + rows_per_blk; r += NWAVES) {
        const f32x4* xr = (const f32x4*)(a.in[I_X] + (size_t)r * D) + F.lane;
        f32x4 v[4]; float s = 0.f;
#pragma unroll
        for (int j = 0; j < 4; ++j) { v[j] = xr[64 * j]; s += (v[j].x * v[j].x + v[j].y * v[j].y) + (v[j].z * v[j].z + v[j].w * v[j].w); }
        const float rs = rsqrtf(wave_sum(s) * (1.0f / D) + EPS);
        unsigned long long* o8 = (unsigned long long*)(H + (size_t)r * D) + F.lane;
#pragma unroll
        for (int j = 0; j < 4; ++j) { const f32x4 g = *(const LAS f32x4*)(Gs + 256 * j + 4 * F.lane), sh = *(const LAS f32x4*)(Ss + 256 * j + 4 * F.lane);
            const f32x4 h = v[j] * rs * g + sh;
            o8[64 * j] = (unsigned long long)pk2(h.x, h.y) | ((unsigned long long)pk2(h.z, h.w) << 32); }
    }
}

namespace attn_body {
using s16x4=__attribute__((ext_vector_type(4)))short;
using f32x16=__attribute__((ext_vector_type(16)))float;
constexpr int NW=8,QBLK=32,QB=QBLK*NW,KVBLK=64,NQB=SEQ/QB;
constexpr int PIN=INC, POUT=1024;
__device__ __forceinline__ int crow(int r,int hi){return (r&3)+8*(r>>2)+4*hi;}
#define SBAR() __builtin_amdgcn_sched_barrier(0)
__device__ __forceinline__ void bmask(f32x16&p0,f32x16&p1,int jb,int wch,int il,int hi,float s2x2){
  if(jb>wch){
    #pragma unroll
    for(int r=0;r<16;++r){p0[r]=-INFINITY;p1[r]=-INFINITY;}
  } else if(jb==wch){
    float fb=(float)(4*hi-il); asm volatile("":"+v"(fb));
    #pragma unroll
    for(int r=0;r<16;++r){const float c=(float)((r&3)+8*(r>>2)); p0[r]-=s2x2*__builtin_fmaxf(fb+c,0.f); p1[r]-=s2x2*__builtin_fmaxf(fb+(c+32.f),0.f);}
  }
}
constexpr int NSLOT=3, SLOTB=8192, VSLOTB=16384;
constexpr int LDS_K=0, LDS_V=NSLOT*SLOTB, LDS_WS=LDS_V+NSLOT*VSLOTB, LDS_OST=LDS_WS+NW*64*4, ATT_LDS_BYTES=LDS_OST+NW*8192;
constexpr float C2=0.125f*1.4426950408889634f;
__device__ __forceinline__ void glds16(const void*gsrc,unsigned lds_dst){unsigned keep;
  asm volatile("s_mov_b32 %0, m0\n\ts_mov_b32 m0, %2\n\ts_nop 0\n\tglobal_load_lds_dwordx4 %1, off\n\ts_mov_b32 m0, %0":"=&s"(keep):"v"(gsrc),"s"(lds_dst):"memory");}
__device__ __forceinline__ float max3f(float a,float b,float c){float r;asm("v_max3_f32 %0, %1, %2, %3":"=v"(r):"v"(a),"v"(b),"v"(c));return r;}
__device__ __forceinline__ float max2f(float a,float b){float r;asm("v_max_f32_e32 %0, %1, %2":"=v"(r):"v"(a),"v"(b));return r;}
__device__ __forceinline__ float fadd_s(float a,float b){float r;asm("v_add_f32_e32 %0, %1, %2":"=v"(r):"v"(a),"v"(b));return r;}
__device__ __forceinline__ float fsub_s(float a,float b){float r;asm("v_sub_f32_e32 %0, %1, %2":"=v"(r):"v"(a),"v"(b));return r;}
typedef float f32x2_t __attribute__((ext_vector_type(2))); typedef __bf16 bf16x2_t __attribute__((ext_vector_type(2)));
__device__ __forceinline__ unsigned cvtpk_s(float lo,float hi){f32x2_t v={lo,hi};bf16x2_t b=__builtin_convertvector(v,bf16x2_t);return __builtin_bit_cast(unsigned,b);}
#define WAIT_BAR(N) asm volatile("s_waitcnt vmcnt(" #N ") lgkmcnt(0)\n\ts_barrier":::"memory")

__device__ __forceinline__ void qkt(f32x16&p0,f32x16&p1,const char*Kslot,const bf16x8*qr,const f32x16&c0,const f32x16&c1,int r32,int hi){
  const char*kb=Kslot+hi*1024+r32*16;
  #pragma unroll
  for(int d0=0;d0<4;++d0){
    const bf16x8 b0=*reinterpret_cast<const bf16x8*>(kb+d0*2048);
    const bf16x8 b1=*reinterpret_cast<const bf16x8*>(kb+d0*2048+512);
    if(d0==0){p0=__builtin_amdgcn_mfma_f32_32x32x16_bf16(b0,qr[0],c0,0,0,0);p1=__builtin_amdgcn_mfma_f32_32x32x16_bf16(b1,qr[0],c1,0,0,0);}
    else{p0=__builtin_amdgcn_mfma_f32_32x32x16_bf16(b0,qr[d0],p0,0,0,0);p1=__builtin_amdgcn_mfma_f32_32x32x16_bf16(b1,qr[d0],p1,0,0,0);}}
}
typedef __attribute__((address_space(3))) const char* lds_cptr;
typedef short v4i16_t __attribute__((ext_vector_type(4)));
__device__ __forceinline__ void kload8(bf16x8*kf,lds_cptr kp){
  kf[0]=*(const __attribute__((address_space(3))) bf16x8*)(kp);      kf[1]=*(const __attribute__((address_space(3))) bf16x8*)(kp+512);
  kf[2]=*(const __attribute__((address_space(3))) bf16x8*)(kp+2048); kf[3]=*(const __attribute__((address_space(3))) bf16x8*)(kp+2560);
  kf[4]=*(const __attribute__((address_space(3))) bf16x8*)(kp+4096); kf[5]=*(const __attribute__((address_space(3))) bf16x8*)(kp+4608);
  kf[6]=*(const __attribute__((address_space(3))) bf16x8*)(kp+6144); kf[7]=*(const __attribute__((address_space(3))) bf16x8*)(kp+6656);
}
__device__ __forceinline__ void kload2(bf16x8*kf,lds_cptr kp,int j){ kf[2*j]=*(const __attribute__((address_space(3))) bf16x8*)(kp+j*2048); kf[2*j+1]=*(const __attribute__((address_space(3))) bf16x8*)(kp+j*2048+512); }
__device__ __forceinline__ s16x4 vtr(lds_cptr p){ return __builtin_bit_cast(s16x4,__builtin_amdgcn_ds_read_tr16_b64_v4i16((__attribute__((address_space(3))) v4i16_t*)p)); }
__device__ __forceinline__ float rowmax(const f32x16&p0,const f32x16&p1){
  float a=max3f(p0[0],p0[1],p1[0]),b=max3f(p0[2],p0[3],p1[1]);a=max3f(a,p1[2],p1[3]);
  #pragma unroll
  for(int r=4;r<16;r+=4){a=max3f(a,p0[r],p0[r+1]);b=max3f(b,p0[r+2],p0[r+3]);a=max3f(a,p1[r],p1[r+1]);b=max3f(b,p1[r+2],p1[r+3]);}
  const float m=max2f(a,b);
  auto rr=__builtin_amdgcn_permlane32_swap(__float_as_uint(m),__float_as_uint(m),false,false);
  return max2f(__uint_as_float(rr[0]),__uint_as_float(rr[1]));
}
__device__ __forceinline__ void pv(f32x16*o,int vb,bf16x8 pa0,bf16x8 pa1,bf16x8 pa2,bf16x8 pa3){
  #pragma unroll
  for(int d0=0;d0<4;++d0){s16x4 lo[4],hi[4];
    #pragma unroll
    for(int ks=0;ks<4;++ks){
      asm volatile("ds_read_b64_tr_b16 %0,%1 offset:%c2":"=&v"(lo[ks]):"v"(vb),"i"(d0*4096+ks*1024):"memory");
      asm volatile("ds_read_b64_tr_b16 %0,%1 offset:%c2":"=&v"(hi[ks]):"v"(vb),"i"(d0*4096+ks*1024+512):"memory");}
    asm volatile("s_waitcnt lgkmcnt(0)":::"memory");SBAR();
    #define PK(k) (bf16x8){lo[k][0],lo[k][1],lo[k][2],lo[k][3],hi[k][0],hi[k][1],hi[k][2],hi[k][3]}
    o[d0]=__builtin_amdgcn_mfma_f32_32x32x16_bf16(pa0,PK(0),o[d0],0,0,0);
    o[d0]=__builtin_amdgcn_mfma_f32_32x32x16_bf16(pa1,PK(1),o[d0],0,0,0);
    o[d0]=__builtin_amdgcn_mfma_f32_32x32x16_bf16(pa2,PK(2),o[d0],0,0,0);
    o[d0]=__builtin_amdgcn_mfma_f32_32x32x16_bf16(pa3,PK(3),o[d0],0,0,0);
    #undef PK
  }
}
#define ATTN_STORE16(p,v) (*(u32x4*)(p)=(v))
template<int THRL> __device__ __forceinline__ void attn_unit(int qb,const bf16_t*Qb,const bf16_t*__restrict__ Kh,const bf16_t*__restrict__ Vh,bf16_t*Ob,float slope2,char*shm){
  const int wid=__builtin_amdgcn_readfirstlane(threadIdx.x>>6); const int lane=lane_now(),r32=lane&31,hi=lane>>5;
  const int q0=qb*QB;
  const bf16_t*Qw=Qb+(long)(q0+wid*QBLK)*PIN;
  const unsigned lds0=(unsigned)(uintptr_t)shm;
  float*wsf=(float*)(shm+LDS_WS)+wid*64;
  const bf16_t*ksrc=Kh+(long)lane*PIN+wid*8;
  const bf16_t*vsrc=Vh+(long)(16*(wid&3)+(lane>>2))*PIN+(wid>>2)*32+(lane&3)*8;
  const unsigned kdst=lds0+LDS_K+wid*1024, vdst=lds0+LDS_V+(wid>>2)*4096+(wid&3)*1024;
  #define DMA_K(t,slot) glds16(ksrc+(long)(t)*KVBLK*PIN,(unsigned)__builtin_amdgcn_readfirstlane(kdst+(slot)))
  #define DMA_V(t,slot) do{ glds16(vsrc+(long)(t)*KVBLK*PIN,(unsigned)__builtin_amdgcn_readfirstlane(vdst+2*(slot))); glds16(vsrc+(long)(t)*KVBLK*PIN+64,(unsigned)__builtin_amdgcn_readfirstlane(vdst+2*(slot)+8192)); }while(0)
  const int vb0=(int)(lds0+LDS_V)+((lane>>4)&1)*32+(lane&3)*8+(4*hi+((lane&15)>>2))*64;
  const char*Kbase=shm+LDS_K; bf16x8 kf[8];
  const lds_cptr shm3=(lds_cptr)shm; const lds_cptr kp0=shm3+LDS_K+hi*1024+r32*16; const lds_cptr vp0=shm3+LDS_V+((lane>>4)&1)*32+(lane&3)*8+(4*hi+((lane&15)>>2))*64;
  const int NT=(q0+QB)/KVBLK;
  DMA_K(0,0);DMA_V(0,0);DMA_K(1,SLOTB);
  bf16x8 qr[4];
  #pragma unroll
  for(int d0=0;d0<4;++d0)qr[d0]=*reinterpret_cast<const bf16x8*>(&Qw[(long)r32*PIN+d0*16+hi*8]);
  float mhat=0.f,l_reg=0.f;f32x16 o[4];o[0]=f32x16{};o[1]=f32x16{};o[2]=f32x16{};o[3]=f32x16{};
  const float s64=slope2*64.f, s32=slope2*32.f, s2x2=2.f*slope2, s4hi=slope2*4.f*(float)hi;
  const int wch=wid>>1, il=32*(wid&1)+r32;
  #define CMASK(P0,P1,t) do{int jb_=(t)-(NT-4); if(jb_>=0)bmask(P0,P1,jb_,wch,il,hi,s2x2);}while(0)
  #define CINIT0(C0,t) do{ const float bt_=s64*(float)((t)-NT)-mhat+s4hi; _Pragma("unroll") for(int r=0;r<16;++r){C0[r]=__builtin_fmaf(slope2,(float)((r&3)+8*(r>>2)),bt_);} }while(0)
  #define CINIT1(C1,t) do{ const float bu_=s64*(float)((t)-NT)-mhat+s4hi+s32; _Pragma("unroll") for(int r=0;r<16;++r){C1[r]=__builtin_fmaf(slope2,(float)((r&3)+8*(r>>2)),bu_);} }while(0)
  bool resc=false;
  #define START(P0,P1) do{ const float rm=rowmax(P0,P1); resc=false; \
    { const float dl=rm; mhat=fadd_s(mhat,dl); \
      _Pragma("unroll") for(int r=0;r<16;++r){P0[r]=fsub_s(P0[r],dl);P1[r]=fsub_s(P1[r],dl);} } \
    _Pragma("unroll") for(int r=0;r<16;++r)P0[r]=__builtin_amdgcn_exp2f(P0[r]); }while(0)
  #define RESC() do{ if(resc){ asm volatile("s_waitcnt lgkmcnt(0)":::"memory"); \
      _Pragma("unroll") for(int d_=0;d_<4;++d_) _Pragma("unroll") for(int r=0;r<16;++r)o[d_][r]*=wsf[crow(r,hi)]; } }while(0)
  f32x16 cS0,cS1;
  u32x4 pwa0,pwa1,pwa2,pwa3,pwb0,pwb1,pwb2,pwb3;
  int sl_prev=0,sl_cur=0,sl_next=SLOTB;
  #define ROT() do{sl_prev=sl_cur;sl_cur=sl_next;sl_next=(sl_next==(NSLOT-1)*SLOTB)?0:sl_next+SLOTB;}while(0)
  #define PKW(P,B) cvtpk_s(P[B],P[B+1])
  DMA_K(2,2*SLOTB);
  WAIT_BAR(3);
  { f32x16 c0,c1; CINIT0(c0,0); CINIT1(c1,0); qkt(cS0,cS1,Kbase,qr,c0,c1,r32,hi); }
  asm volatile("s_nop 15\n\ts_nop 7":"+v"(cS0),"+v"(cS1));CMASK(cS0,cS1,0);
  START(cS0,cS1);
  _Pragma("unroll") for(int r=0;r<16;++r)cS1[r]=__builtin_amdgcn_exp2f(cS1[r]);
  { float sacc=cS0[0]+cS0[1]; _Pragma("unroll") for(int r=2;r<16;++r)sacc+=cS0[r]; _Pragma("unroll") for(int r=0;r<16;++r)sacc+=cS1[r]; l_reg+=sacc;
    pwa0=(u32x4){PKW(cS0,0),PKW(cS0,2),PKW(cS0,4),PKW(cS0,6)};pwa1=(u32x4){PKW(cS0,8),PKW(cS0,10),PKW(cS0,12),PKW(cS0,14)};pwa2=(u32x4){PKW(cS1,0),PKW(cS1,2),PKW(cS1,4),PKW(cS1,6)};pwa3=(u32x4){PKW(cS1,8),PKW(cS1,10),PKW(cS1,12),PKW(cS1,14)}; }
  WAIT_BAR(0);
  DMA_K(3,0);DMA_V(1,SLOTB);
  ROT();
  kload8(kf,kp0+sl_cur);
  WAIT_BAR(3);
  s16x4 vlo[4],vhi[4];
  #define CAT_(a,b) a##b
  #define CAT(a,b) CAT_(a,b)
  #define PAFC(P,k) __builtin_bit_cast(bf16x8,CAT(P,k))
  #define VFR(k) (bf16x8){vlo[(k)&3][0],vlo[(k)&3][1],vlo[(k)&3][2],vlo[(k)&3][3],vhi[(k)&3][0],vhi[(k)&3][1],vhi[(k)&3][2],vhi[(k)&3][3]}
  #define VOFF(k) ((k)<8 ? (((k)&1)*4096+((k)>>1)*1024) : ((2+((k)&1))*4096+(((k)-8)>>1)*1024))
  #define PIN_(x) asm volatile("":"+v"(x))
  #define MX3(a,b,c) __builtin_fmaxf(__builtin_fmaxf((a),(b)),(c))
  #define QK(MF) do{ MF; SBAR(); }while(0)
  #define EX(v) __builtin_amdgcn_exp2f(v)
  #define VRD(k) do{ vlo[(k)&3]=vtr(vp_+VOFF(k)); vhi[(k)&3]=vtr(vp_+(VOFF(k)+512)); }while(0)
  #define VNX(k) do{ if((k)+4<16){ VRD((k)+4); } SBAR(); }while(0)
  #define GAPB3(MF,X,B,PW,J) do{ MF; X[B]=EX(X[B]); X[B+1]=EX(X[B+1]); sacc+=X[B]; sacc+=X[B+1]; PW[J]=cvtpk_s(X[B],X[B+1]); PIN_(X); PIN_(sacc); PIN_(PW); SBAR(); }while(0)
  #define KRD(G,j) do{ if(G){ kload2(kf,kp0+sl_next,j); SBAR(); } }while(0)
  #define STEP(PC,PN,t,GK,GV,GL) do{ SBAR(); \
    CINIT0(cS0,t); SBAR(); \
    const lds_cptr vp_=vp0+2*sl_prev; \
    VRD(0); SBAR(); QK(cS0=__builtin_amdgcn_mfma_f32_32x32x16_bf16(kf[0],qr[0],cS0,0,0,0)); \
    CINIT1(cS1,t); VRD(1); SBAR(); QK(cS1=__builtin_amdgcn_mfma_f32_32x32x16_bf16(kf[1],qr[0],cS1,0,0,0)); \
    VRD(2); SBAR(); QK(cS0=__builtin_amdgcn_mfma_f32_32x32x16_bf16(kf[2],qr[1],cS0,0,0,0)); \
    VRD(3); SBAR(); QK(cS1=__builtin_amdgcn_mfma_f32_32x32x16_bf16(kf[3],qr[1],cS1,0,0,0)); \
    QK(cS0=__builtin_amdgcn_mfma_f32_32x32x16_bf16(kf[4],qr[2],cS0,0,0,0)); \
    QK(cS1=__builtin_amdgcn_mfma_f32_32x32x16_bf16(kf[5],qr[2],cS1,0,0,0)); \
    QK(cS0=__builtin_amdgcn_mfma_f32_32x32x16_bf16(kf[6],qr[3],cS0,0,0,0)); \
    QK(cS1=__builtin_amdgcn_mfma_f32_32x32x16_bf16(kf[7],qr[3],cS1,0,0,0)); \
    if(GK){DMA_K((t)+3,sl_cur);} if(GV){DMA_V((t)+1,sl_next);} \
    CMASK(cS0,cS1,t); \
    { float a=MX3(cS0[0],cS0[1],cS1[0]),b=MX3(cS0[2],cS0[3],cS1[1]); a=MX3(a,cS1[2],cS1[3]); \
      _Pragma("unroll") for(int r=4;r<16;r+=4){a=MX3(a,cS0[r],cS0[r+1]);b=MX3(b,cS0[r+2],cS0[r+3]);a=MX3(a,cS1[r],cS1[r+1]);b=MX3(b,cS1[r+2],cS1[r+3]);} \
      float rm=__builtin_fmaxf(a,b); { auto rr=__builtin_amdgcn_permlane32_swap(__float_as_uint(rm),__float_as_uint(rm),false,false); rm=__builtin_fmaxf(__uint_as_float(rr[0]),__uint_as_float(rr[1])); } \
      resc=false; \
      if(__builtin_expect(__any(rm>(float)THRL),0)){ const float dl=__builtin_fmaxf(rm,0.f); mhat+=dl; \
        _Pragma("unroll") for(int r=0;r<16;++r){cS0[r]-=dl;cS1[r]-=dl;} \
        const float f=__builtin_amdgcn_exp2f(-dl); l_reg*=f; if(hi==0)wsf[r32]=f; resc=true; } } \
    SBAR(); float sacc=0.f; \
    GAPB3(o[0]=__builtin_amdgcn_mfma_f32_32x32x16_bf16(PAFC(PC,0),VFR(0),o[0],0,0,0), cS0,0, CAT(PN,0),0); VNX(0); \
    GAPB3(o[1]=__builtin_amdgcn_mfma_f32_32x32x16_bf16(PAFC(PC,0),VFR(1),o[1],0,0,0), cS0,2, CAT(PN,0),1); VNX(1); \
    KRD(GL,0); GAPB3(o[0]=__builtin_amdgcn_mfma_f32_32x32x16_bf16(PAFC(PC,1),VFR(2),o[0],0,0,0), cS0,4, CAT(PN,0),2); VNX(2); \
    KRD(GL,1); GAPB3(o[1]=__builtin_amdgcn_mfma_f32_32x32x16_bf16(PAFC(PC,1),VFR(3),o[1],0,0,0), cS0,6, CAT(PN,0),3); VNX(3); \
    KRD(GL,2); GAPB3(o[0]=__builtin_amdgcn_mfma_f32_32x32x16_bf16(PAFC(PC,2),VFR(4),o[0],0,0,0), cS0,8, CAT(PN,1),0); VNX(4); \
    KRD(GL,3); GAPB3(o[1]=__builtin_amdgcn_mfma_f32_32x32x16_bf16(PAFC(PC,2),VFR(5),o[1],0,0,0), cS0,10, CAT(PN,1),1); VNX(5); \
    GAPB3(o[0]=__builtin_amdgcn_mfma_f32_32x32x16_bf16(PAFC(PC,3),VFR(6),o[0],0,0,0), cS0,12, CAT(PN,1),2); VNX(6); \
    GAPB3(o[1]=__builtin_amdgcn_mfma_f32_32x32x16_bf16(PAFC(PC,3),VFR(7),o[1],0,0,0), cS0,14, CAT(PN,1),3); VNX(7); \
    GAPB3(o[2]=__builtin_amdgcn_mfma_f32_32x32x16_bf16(PAFC(PC,0),VFR(8),o[2],0,0,0), cS1,0, CAT(PN,2),0); VNX(8); \
    GAPB3(o[3]=__builtin_amdgcn_mfma_f32_32x32x16_bf16(PAFC(PC,0),VFR(9),o[3],0,0,0), cS1,2, CAT(PN,2),1); VNX(9); \
    GAPB3(o[2]=__builtin_amdgcn_mfma_f32_32x32x16_bf16(PAFC(PC,1),VFR(10),o[2],0,0,0), cS1,4, CAT(PN,2),2); VNX(10); \
    GAPB3(o[3]=__builtin_amdgcn_mfma_f32_32x32x16_bf16(PAFC(PC,1),VFR(11),o[3],0,0,0), cS1,6, CAT(PN,2),3); VNX(11); \
    GAPB3(o[2]=__builtin_amdgcn_mfma_f32_32x32x16_bf16(PAFC(PC,2),VFR(12),o[2],0,0,0), cS1,8, CAT(PN,3),0); VNX(12); \
    GAPB3(o[3]=__builtin_amdgcn_mfma_f32_32x32x16_bf16(PAFC(PC,2),VFR(13),o[3],0,0,0), cS1,10, CAT(PN,3),1); VNX(13); \
    GAPB3(o[2]=__builtin_amdgcn_mfma_f32_32x32x16_bf16(PAFC(PC,3),VFR(14),o[2],0,0,0), cS1,12, CAT(PN,3),2); VNX(14); \
    GAPB3(o[3]=__builtin_amdgcn_mfma_f32_32x32x16_bf16(PAFC(PC,3),VFR(15),o[3],0,0,0), cS1,14, CAT(PN,3),3); VNX(15); \
    l_reg+=sacc; \
    }while(0)
  int t=1;
  #undef CMASK
  #define CMASK(P0,P1,t) do{}while(0)
  for(;t+5<NT;t+=2){
    STEP(pwa,pwb,t,true,true,true);     WAIT_BAR(3); RESC(); ROT();
    STEP(pwb,pwa,t+1,true,true,true);   WAIT_BAR(3); RESC(); ROT();
  }
  #undef CMASK
  #define CMASK(P0,P1,t) do{int jb_=(t)-(NT-4); if(jb_>=0)bmask(P0,P1,jb_,wch,il,hi,s2x2);}while(0)
  #define ENDW(tt) do{ if((tt)+3<NT){WAIT_BAR(3);} else if((tt)+2<NT){WAIT_BAR(2);} else {WAIT_BAR(0);} }while(0)
  for(;t+1<NT;t+=2){
    STEP(pwa,pwb,t,(t+3<NT),(t+1<NT),(t+1<NT));       ENDW(t);   RESC(); ROT();
    STEP(pwb,pwa,t+1,(t+4<NT),(t+2<NT),(t+2<NT));     ENDW(t+1); RESC(); ROT();
  }
  STEP(pwa,pwb,NT-1,false,false,false); RESC();
  SBAR(); pv(o,vb0+2*sl_cur,PAFC(pwb,0),PAFC(pwb,1),PAFC(pwb,2),PAFC(pwb,3));
  #undef PKW
  #undef PAFC
  #undef CAT
  #undef CAT_
  #undef QK
  #undef GAPB3
  #undef VFR
  #undef PIN_
  #undef MX3
  #undef EX
  #undef VRD
  #undef VNX
  #undef VOFF
  #undef GAPB2
  #undef KRD
  #undef STEP
  #undef ENDW
  {auto rr=__builtin_amdgcn_permlane32_swap(__float_as_uint(l_reg),__float_as_uint(l_reg),false,false);l_reg=__uint_as_float(rr[0])+__uint_as_float(rr[1]);}
  {
    const int le=lane_now(), r32e=le&31, hie=le>>5;
    float*wsfe=(float*)(shm+LDS_WS)+wid*64;
    if(hie==0)wsfe[32+r32e]=l_reg;asm volatile("s_waitcnt lgkmcnt(0)":::"memory");
    float rli[16];
    #pragma unroll
    for(int r=0;r<16;++r)rli[r]=__builtin_amdgcn_rcpf(wsfe[32+crow(r,hie)]);
    bf16_t*Ow=Ob+(long)(q0+wid*QBLK)*POUT;
    bf16_t*stg=(bf16_t*)(shm+LDS_OST)+wid*4096;
    #pragma unroll
    for(int r=0;r<16;++r){const int orow=crow(r,hie);
      #pragma unroll
      for(int d0=0;d0<4;++d0)stg[orow*128+d0*32+r32e]=(bf16_t)f2bf(o[d0][r]*rli[r]);}
    asm volatile("s_waitcnt lgkmcnt(0)":::"memory");
    #pragma unroll
    for(int i=0;i<8;++i){const int row=i*4+(le>>4),ch=le&15; const u32x4 v=*(const u32x4*)(stg+row*128+ch*8); ATTN_STORE16(Ow+(long)row*POUT+ch*8,v);} }
  asm volatile("s_waitcnt lgkmcnt(0)\n\ts_barrier":::"memory");
  #undef DMA_K
  #undef DMA_V
  #undef CMASK
  #undef CINIT0
  #undef CINIT1
  #undef START
  #undef RESC
  #undef ROT
}
#undef SBAR
#undef WAIT_BAR
}

__device__ __forceinline__ void attn_phase(const Frame& F, const Args& a) {
    const bf16_t* proj = (const bf16_t*)(a.ws + WS_PROJ); bf16_t* OA = (bf16_t*)(a.ws + WS_OA);
    const int vcu = (F.G % 8 == 0) ? (F.bid % 8) * (F.G / 8) + F.bid / 8 : F.bid;
    for (int i = 0;; ++i) {
        int bhm, qb;
        if (F.G == 256) { if (i >= 2) break; const int s_ = vcu & 7; bhm = vcu >> 3; qb = (i == 0) ? 15 - s_ : s_; }
        else { const int u = i * F.G + F.bid; if (u >= 512) break; bhm = u >> 4; qb = 15 - (u & 15); }
        const int b = bhm >> 3, h = (bhm >> 1) & 3, map = bhm & 1;
        const bf16_t* base = proj + (size_t)b * SEQ * INC;
        const float slope2 = exp2f(-2.0f * (h + 1)) * 1.4426950408889634f;
        attn_body::attn_unit<8>(qb, base + C_QDA + h * 128 + map * 64, base + C_KDA + h * 128 + map * 64, base + C_VDA + h * 128,
                                OA + (size_t)b * SEQ * 1024 + h * 256 + map * 128, slope2, (char*)F.lds);
    }
}
__device__ __forceinline__ void attn_combine(const Frame& F, const Args& a) {
    const bf16_t* OA = (const bf16_t*)(a.ws + WS_OA); bf16_t* Y = (bf16_t*)(a.ws + WS_YDA);
    const float lam = ((const float*)(a.ws + WS_SMALL))[0];
    const float g0 = a.in[I_SUBG][2 * F.lane] * 0.8f, g1 = a.in[I_SUBG][2 * F.lane + 1] * 0.8f;
    const int gw = F.bid * NWAVES + F.wave, NGW = F.G * NWAVES;
    for (int r = gw; r < T; r += NGW) {
        const unsigned* orow = (const unsigned*)(OA + (size_t)r * 1024); unsigned* yrow = (unsigned*)(Y + (size_t)r * 512);
        unsigned w0[4], w1[4];
#pragma unroll
        for (int h = 0; h < 4; ++h) { w0[h] = orow[h * 128 + F.lane]; w1[h] = orow[h * 128 + 64 + F.lane]; }
#pragma unroll
        for (int h = 0; h < 4; ++h) {
            const float x0 = bf2f(w0[h] & 0xffffu) - lam * bf2f(w1[h] & 0xffffu), x1 = bf2f(w0[h] >> 16) - lam * bf2f(w1[h] >> 16);
            const float rs = rsqrtf(wave_sum(x0 * x0 + x1 * x1) * (1.0f / 128.0f) + EPS);
            yrow[h * 64 + F.lane] = pk2(x0 * rs * g0, x1 * rs * g1);
        }
    }
}
namespace hg {
constexpr int QP = 136;
constexpr int L_QD = 0, L_KD = 64 * QP * 2, L_V = 2 * 64 * QP * 2, L_KE = 3 * 64 * QP * 2, L_SSQ = 4 * 64 * QP * 2, L_G = L_SSQ + 512, L_ST = L_G + 64 * QP * 2;
__device__ __forceinline__ f32x4 mfma16(bf16x8 a, bf16x8 b, f32x4 c) { return __builtin_amdgcn_mfma_f32_16x16x32_bf16(a, b, c, 0, 0, 0); }
#define HG_BAR() do { asm volatile("s_waitcnt lgkmcnt(0)" ::: "memory"); __builtin_amdgcn_s_barrier(); asm volatile("" ::: "memory"); } while (0)
typedef short v4i16_t __attribute__((ext_vector_type(4)));
__device__ __forceinline__ bf16x8 tr8(const LAS unsigned char* img, int ra, int rb, int col0, int lane) {
    const int q = (lane & 15) >> 2, p = lane & 3;
    const v4i16_t lo = __builtin_amdgcn_ds_read_tr16_b64_v4i16((LAS v4i16_t*)(img + ((ra + q) * QP + col0 + 4 * p) * 2));
    const v4i16_t hi = __builtin_amdgcn_ds_read_tr16_b64_v4i16((LAS v4i16_t*)(img + ((rb + q) * QP + col0 + 4 * p) * 2));
    return (bf16x8){lo[0], lo[1], lo[2], lo[3], hi[0], hi[1], hi[2], hi[3]};
}
struct Tile { u32x4 p[2]; };
__device__ __forceinline__ void tile_load(Tile& t, const bf16_t* src, size_t pitch, int tid) {
#pragma unroll
    for (int i = 0; i < 2; ++i) { const int pc = tid + NTHR * i; t.p[i] = *(const u32x4*)(src + (size_t)(pc >> 4) * pitch + (pc & 15) * 8); }
}
__device__ __forceinline__ void tile_put(const Tile& t, LAS unsigned char* img, int tid) {
#pragma unroll
    for (int i = 0; i < 2; ++i) { const int pc = tid + NTHR * i; *(LAS u32x4*)(img + ((pc >> 4) * QP + (pc & 15) * 8) * 2) = t.p[i]; }
}
constexpr int PP = 72;
constexpr int G4_L_P = 4 * 64 * QP * 2, G4_L_DEC = G4_L_P + 64 * PP * 2, G4_L_SSQ = G4_L_DEC + 512;
struct InA { Tile qd, kd, ke, v; f32x4 dec; };
__device__ __forceinline__ void loadA(InA& r, const Frame& F, const Args& a, int bh, int n) {
    const int b = bh >> 2, h = bh & 3; const size_t t0 = (size_t)b * SEQ + n * 64;
    const bf16_t* base = (const bf16_t*)(a.ws + WS_PROJ) + t0 * INC;
    tile_load(r.qd, base + C_HGT + 256 * h, INC, F.tid); tile_load(r.kd, base + C_HGT + 256 * h + 128, INC, F.tid);
    tile_load(r.ke, (const bf16_t*)a.out + t0 * 512 + h * 128, 512, F.tid); tile_load(r.v, base + C_IHG + h * 128, INC, F.tid);
    r.dec = *(const f32x4*)((const float*)(a.ws + WS_DEC) + ((size_t)bh * 64 + n) * 128 + 4 * (F.tid & 31));
}
__device__ __forceinline__ void grp_local(const Frame& F, const Args& a, int grp) {
    const int bh = grp >> 4, n0 = 4 * (grp & 15), b = bh >> 2, h = bh & 3, w = F.wave, lane = F.lane, fr = lane & 15, fq = lane >> 4;
    for (int i = F.tid; i < 64 * PP / 2; i += NTHR) ((LAS unsigned*)(F.lds + G4_L_P))[i] = 0u;
    f32x4 S[8];
#pragma unroll
    for (int kt = 0; kt < 8; ++kt) S[kt] = (f32x4){0.f, 0.f, 0.f, 0.f};
    InA cur, nxt; loadA(cur, F, a, bh, n0);
    unsigned short yk[4][4];
#define G4_STORE(nn) do { bf16_t* yp_ = (bf16_t*)(a.ws + WS_YHG) + ((size_t)b * SEQ + (nn) * 64 + 4 * fq) * 512 + h * 128 + 16 * w + fr; \
        _Pragma("unroll") for (int tb = 0; tb < 4; ++tb) _Pragma("unroll") for (int r = 0; r < 4; ++r) yp_[(size_t)(16 * tb + r) * 512] = yk[tb][r]; } while (0)
    for (int j = 0; j < 4; ++j) {
        if (j > 0) G4_STORE(n0 + j - 1);
        loadA(nxt, F, a, bh, n0 + (j < 3 ? j + 1 : 3));
        tile_put(cur.qd, F.lds + L_QD, F.tid); tile_put(cur.kd, F.lds + L_KD, F.tid); tile_put(cur.ke, F.lds + L_KE, F.tid); tile_put(cur.v, F.lds + L_V, F.tid);
        if (F.tid < 32) *(LAS f32x4*)(F.lds + G4_L_DEC + 16 * F.tid) = cur.dec;
        HG_BAR();
#pragma unroll
        for (int rep = 0; rep < 2; ++rep) { const int pi = w + 8 * rep;
            if (pi < 10) { const int tb = pi >= 6 ? 3 : pi >= 3 ? 2 : pi >= 1 ? 1 : 0, jt = pi - (tb * (tb + 1)) / 2;
                f32x4 sc = (f32x4){0.f, 0.f, 0.f, 0.f};
#pragma unroll
                for (int ks = 0; ks < 4; ++ks) { const bf16x8 kf = *(const LAS bf16x8*)(F.lds + L_KD + ((16 * jt + fr) * QP + 32 * ks + 8 * fq) * 2);
                    const bf16x8 qf = *(const LAS bf16x8*)(F.lds + L_QD + ((16 * tb + fr) * QP + 32 * ks + 8 * fq) * 2); sc = mfma16(kf, qf, sc); }
                if (jt == tb) {
#pragma unroll
                    for (int r = 0; r < 4; ++r) if (4 * fq + r > fr) sc[r] = 0.f;
                }
                *(LAS u32x2*)(F.lds + G4_L_P + ((16 * tb + fr) * PP + 16 * jt + 4 * fq) * 2) = (u32x2){cvt_pk_bf16(sc[0], sc[1]), cvt_pk_bf16(sc[2], sc[3])}; } }
        HG_BAR();
        bf16x8 bv[2];
#pragma unroll
        for (int s2 = 0; s2 < 2; ++s2) bv[s2] = tr8(F.lds + L_V, 32 * s2 + 8 * fq, 32 * s2 + 8 * fq + 4, 16 * w, lane);
        bf16x8 Sb[4];
#pragma unroll
        for (int ks = 0; ks < 4; ++ks) { const u32x4 t = (u32x4){cvt_pk_bf16(S[2 * ks][0], S[2 * ks][1]), cvt_pk_bf16(S[2 * ks][2], S[2 * ks][3]), cvt_pk_bf16(S[2 * ks + 1][0], S[2 * ks + 1][1]), cvt_pk_bf16(S[2 * ks + 1][2], S[2 * ks + 1][3])};
            Sb[ks] = __builtin_bit_cast(bf16x8, t); }
#pragma unroll
        for (int tb = 0; tb < 4; ++tb) { f32x4 o = (f32x4){0.f, 0.f, 0.f, 0.f};
#pragma unroll
            for (int s2 = 0; s2 <= (tb >> 1); ++s2) { const bf16x8 pf = *(const LAS bf16x8*)(F.lds + G4_L_P + ((16 * tb + fr) * PP + 32 * s2 + 8 * fq) * 2); o = mfma16(pf, bv[s2], o); }
            if (j > 0) {
#pragma unroll
                for (int ks = 0; ks < 4; ++ks) { const LAS unsigned char* qrow = F.lds + L_QD + ((16 * tb + fr) * QP + 32 * ks + 4 * fq) * 2;
                    const u32x2 lo = *(const LAS u32x2*)qrow, hi = *(const LAS u32x2*)(qrow + 32);
                    const u32x4 aw = (u32x4){lo.x, lo.y, hi.x, hi.y}; o = mfma16(__builtin_bit_cast(bf16x8, aw), Sb[ks], o); } }
#pragma unroll
            for (int r = 0; r < 4; ++r) yk[tb][r] = (unsigned short)f2bf(o[r]); }
#pragma unroll
        for (int kt = 0; kt < 8; ++kt) { S[kt] = S[kt] * *(const LAS f32x4*)(F.lds + G4_L_DEC + (16 * kt + 4 * fq) * 4);
#pragma unroll
            for (int s2 = 0; s2 < 2; ++s2) S[kt] = mfma16(tr8(F.lds + L_KE, 32 * s2 + 8 * fq, 32 * s2 + 8 * fq + 4, 16 * kt, lane), bv[s2], S[kt]); }
        HG_BAR();
        cur = nxt;
    }
    G4_STORE(n0 + 3);
#undef G4_STORE
    f32x4* sg = (f32x4*)(a.ws + WS_DS) + ((size_t)grp * 64 + w * 8) * 64 + lane;
#pragma unroll
    for (int kt = 0; kt < 8; ++kt) sg[kt * 64] = S[kt];
}
__device__ __forceinline__ void grp_scan(const Frame& F, const Args& a) {
    f32x4* sg = (f32x4*)(a.ws + WS_DS); f32x4* si = sg + (size_t)256 * 4096; const float* dec = (const float*)(a.ws + WS_DEC);
    for (int gt = F.bid * NTHR + F.tid; gt < 16 * 4096; gt += F.G * NTHR) {
        const int bh = gt >> 12, slot = gt & 4095, kt = (slot >> 6) & 7, lane = slot & 63, k = 16 * kt + 4 * (lane >> 4);
        f32x4 cur = (f32x4){0.f, 0.f, 0.f, 0.f};
#pragma unroll 4
        for (int g = 0; g < 16; ++g) { const size_t gi = ((size_t)(bh * 16 + g)) * 4096 + slot;
            si[gi] = cur;
            const float* dp = dec + ((size_t)bh * 64 + 4 * g) * 128 + k;
            const f32x4 d = (*(const f32x4*)dp * *(const f32x4*)(dp + 128)) * (*(const f32x4*)(dp + 256) * *(const f32x4*)(dp + 384));
            cur = d * cur + sg[gi]; }
    }
}
struct InC { Tile qd, g, ol; f32x4 dec; };
__device__ __forceinline__ void loadC(InC& r, const Frame& F, const Args& a, int bh, int n) {
    const int b = bh >> 2, h = bh & 3; const size_t t0 = (size_t)b * SEQ + n * 64;
    const bf16_t* base = (const bf16_t*)(a.ws + WS_PROJ) + t0 * INC;
    tile_load(r.qd, base + C_HGT + 256 * h, INC, F.tid); tile_load(r.g, base + C_GHG + h * 128, INC, F.tid);
    tile_load(r.ol, (const bf16_t*)(a.ws + WS_YHG) + t0 * 512 + h * 128, 512, F.tid);
    r.dec = *(const f32x4*)((const float*)(a.ws + WS_DEC) + ((size_t)bh * 64 + n) * 128 + 4 * (F.tid & 31));
}
__device__ __forceinline__ void grp_final(const Frame& F, const Args& a, int grp) {
    const int bh = grp >> 4, n0 = 4 * (grp & 15), b = bh >> 2, h = bh & 3, w = F.wave, lane = F.lane, fr = lane & 15, fq = lane >> 4;
    f32x4 S[8];
    { const f32x4* si = (const f32x4*)(a.ws + WS_DS) + (size_t)256 * 4096 + ((size_t)grp * 64 + w * 8) * 64 + lane;
#pragma unroll
      for (int kt = 0; kt < 8; ++kt) S[kt] = si[kt * 64]; }
    const float ng = a.in[I_HGNG][16 * w + fr];
    LAS float* SSQ = (LAS float*)(F.lds + G4_L_SSQ);
    InC cur, nxt; loadC(cur, F, a, bh, n0);
    unsigned short yk[4][4];
#define G4_STORE(nn) do { bf16_t* yp_ = (bf16_t*)(a.ws + WS_YHG) + ((size_t)b * SEQ + (nn) * 64 + 4 * fq) * 512 + h * 128 + 16 * w + fr; \
        _Pragma("unroll") for (int tb = 0; tb < 4; ++tb) _Pragma("unroll") for (int r = 0; r < 4; ++r) yp_[(size_t)(16 * tb + r) * 512] = yk[tb][r]; } while (0)
    for (int j = 0; j < 4; ++j) {
        if (j > 0) G4_STORE(n0 + j - 1);
        loadC(nxt, F, a, bh, n0 + (j < 3 ? j + 1 : 3));
        tile_put(cur.qd, F.lds + L_QD, F.tid); tile_put(cur.g, F.lds + L_KD, F.tid); tile_put(cur.ol, F.lds + L_V, F.tid);
        if (F.tid < 32) *(LAS f32x4*)(F.lds + G4_L_DEC + 16 * F.tid) = cur.dec;
        HG_BAR();
        bf16x8 Sb[4];
#pragma unroll
        for (int ks = 0; ks < 4; ++ks) { const u32x4 t = (u32x4){cvt_pk_bf16(S[2 * ks][0], S[2 * ks][1]), cvt_pk_bf16(S[2 * ks][2], S[2 * ks][3]), cvt_pk_bf16(S[2 * ks + 1][0], S[2 * ks + 1][1]), cvt_pk_bf16(S[2 * ks + 1][2], S[2 * ks + 1][3])};
            Sb[ks] = __builtin_bit_cast(bf16x8, t); }
        f32x4 o[4];
#pragma unroll
        for (int tb = 0; tb < 4; ++tb) {
#pragma unroll
            for (int r = 0; r < 4; ++r) o[tb][r] = bf2f(*(const LAS unsigned short*)(F.lds + L_V + ((16 * tb + 4 * fq + r) * QP + 16 * w + fr) * 2));
#pragma unroll
            for (int ks = 0; ks < 4; ++ks) { const LAS unsigned char* qrow = F.lds + L_QD + ((16 * tb + fr) * QP + 32 * ks + 4 * fq) * 2;
                const u32x2 lo = *(const LAS u32x2*)qrow, hi = *(const LAS u32x2*)(qrow + 32);
                const u32x4 aw = (u32x4){lo.x, lo.y, hi.x, hi.y}; o[tb] = mfma16(__builtin_bit_cast(bf16x8, aw), Sb[ks], o[tb]); }
#pragma unroll
            for (int r = 0; r < 4; ++r) { const float v = scan16(o[tb][r] * o[tb][r]); if (fr == 15) SSQ[w * 64 + 16 * tb + 4 * fq + r] = v; } }
#pragma unroll
        for (int kt = 0; kt < 8; ++kt) S[kt] = S[kt] * *(const LAS f32x4*)(F.lds + G4_L_DEC + (16 * kt + 4 * fq) * 4);
        HG_BAR();
#pragma unroll
        for (int tb = 0; tb < 4; ++tb) { f32x4 tot = (f32x4){0.f, 0.f, 0.f, 0.f};
#pragma unroll
            for (int ww = 0; ww < 8; ++ww) tot += *(const LAS f32x4*)(SSQ + ww * 64 + 16 * tb + 4 * fq);
#pragma unroll
            for (int r = 0; r < 4; ++r) { const float rs = rsqrtf(tot[r] * (1.0f / 128.0f) + EPS); const float g = bf2f(*(const LAS unsigned short*)(F.lds + L_KD + ((16 * tb + 4 * fq + r) * QP + 16 * w + fr) * 2));
                yk[tb][r] = (unsigned short)f2bf(o[tb][r] * rs * ng * g * __builtin_amdgcn_rcpf(1.0f + __builtin_amdgcn_exp2f(-1.4426950408889634f * g))); } }
        HG_BAR();
        cur = nxt;
    }
    G4_STORE(n0 + 3);
#undef G4_STORE
}
#undef HG_BAR
}

__device__ __forceinline__ float rs4(float a0, float a1, float a2, float a3, int lane) {
    const bool hi = (lane & 32) != 0;
    const float s0 = hi ? a0 : a2, s1 = hi ? a1 : a3;
    const float k0 = (hi ? a2 : a0) + __shfl_xor(s0, 32), k1 = (hi ? a3 : a1) + __shfl_xor(s1, 32);
    const bool b4 = (lane & 16) != 0;
    const float sd = b4 ? k0 : k1;
    float k = (b4 ? k1 : k0) + __shfl_xor(sd, 16);
    k += __shfl_xor(k, 8); k += __shfl_xor(k, 4); k += __shfl_xor(k, 2); k += __shfl_xor(k, 1);
    return k;
}
__device__ __forceinline__ void phase_router(const Frame& F, const Args& a) {
    constexpr int AP = 1032;
    LAS bf16_t* AH = (LAS bf16_t*)F.lds;
    LAS bf16_t* AL = AH + 16 * AP;
    LAS float* PART = (LAS float*)(F.lds + 2 * 16 * AP * 2);
    LAS float* LG = PART + 8 * 16 * 48;
    LAS unsigned* LH = (LAS unsigned*)(LG + 16 * 48);
    LAS unsigned* LB = LH + 32;
    LAS unsigned* LR = LH + 64;
    if (F.tid < NEXP) LH[F.tid] = 0u;
    const float* mod = (const float*)(a.ws + WS_MOD);
    const float* x1 = a.out; bf16_t* H2 = (bf16_t*)(a.ws + WS_ACT);
    unsigned* counts = (unsigned*)(a.ws + WS_CTL) + CW_COUNTS; unsigned* tokinfo = (unsigned*)(a.ws + WS_TOKINFO); int* toklist = (int*)(a.ws + WS_TOKLIST);
    const int rows_per_blk = T / F.G, r0 = F.bid * rows_per_blk, b = r0 / SEQ;
    const int lane = F.lane, w = F.wave, fr = lane & 15, fq = lane >> 4;
    f32x4 v[2][4], vn[2][4];
#define RT_LOAD(V, rb_) do { _Pragma("unroll") for (int q = 0; q < 2; ++q) { const f32x4* xr_ = (const f32x4*)(x1 + (size_t)((rb_) + 2 * w + q) * D) + lane; \
        _Pragma("unroll") for (int j = 0; j < 4; ++j) V[q][j] = xr_[64 * j]; } } while (0)
    RT_LOAD(v, r0);
    bf16x8 Bh[4][3], Bl[4][3];
    {
        const float* wre = a.in[I_WRE]; const float* wrg = a.in[I_WRG];
#pragma unroll
        for (int ks = 0; ks < 4; ++ks)
#pragma unroll
            for (int ct = 0; ct < 3; ++ct) {
                unsigned hw[4], lw[4];
#pragma unroll
                for (int jp = 0; jp < 4; ++jp) { float x[2];
#pragma unroll
                    for (int z = 0; z < 2; ++z) { const int k = 128 * w + 32 * ks + 8 * fq + 2 * jp + z;
                        if (ct == 0) { const float g = wrg[k * 4 + (fr & 3)], e = wre[k * 32 + ((fr + 28) & 31)]; x[z] = fr < 4 ? g : e; }
                        else if (ct == 1) x[z] = wre[k * 32 + 12 + fr];
                        else { const float e = wre[k * 32 + 28 + (fr & 3)]; x[z] = fr < 4 ? e : 0.f; } }
                    const unsigned h0 = f2bf(x[0]), h1 = f2bf(x[1]); hw[jp] = h0 | (h1 << 16);
                    lw[jp] = pk2(x[0] - bf2f(h0), x[1] - bf2f(h1)); }
                Bh[ks][ct] = __builtin_bit_cast(bf16x8, (u32x4){hw[0], hw[1], hw[2], hw[3]}); Bl[ks][ct] = __builtin_bit_cast(bf16x8, (u32x4){lw[0], lw[1], lw[2], lw[3]});
            }
    }
    for (int g = 0; g < rows_per_blk / 16; ++g) {
        const int rg = r0 + 16 * g;
        { const int gn = g + 1 < rows_per_blk / 16 ? g + 1 : g; RT_LOAD(vn, r0 + 16 * gn); }
#pragma unroll
        for (int q = 0; q < 2; ++q) { float sq = 0.f;
#pragma unroll
            for (int j = 0; j < 4; ++j) sq += (v[q][j].x * v[q][j].x + v[q][j].y * v[q][j].y) + (v[q][j].z * v[q][j].z + v[q][j].w * v[q][j].w);
            const float rs = rsqrtf(wave_sum(sq) * (1.0f / D) + EPS); const int row = 2 * w + q;
#pragma unroll
            for (int j = 0; j < 4; ++j) { const int k = 256 * j + 4 * lane;
                const f32x4 gg = *(const f32x4*)(a.in[I_N2G] + k) * (1.0f + *(const f32x4*)(mod + b * 6144 + 4 * 1024 + k)), sh = *(const f32x4*)(mod + b * 6144 + 3 * 1024 + k);
                const f32x4 hv = v[q][j] * rs * gg + sh;
                const unsigned h0 = f2bf(hv.x), h1 = f2bf(hv.y), h2_ = f2bf(hv.z), h3 = f2bf(hv.w);
                const u32x2 hw = (u32x2){h0 | (h1 << 16), h2_ | (h3 << 16)};
                *(u32x2*)(H2 + (size_t)(rg + row) * D + k) = hw;
                *(LAS u32x2*)(AH + row * AP + k) = hw;
                *(LAS u32x2*)(AL + row * AP + k) = (u32x2){pk2(hv.x - bf2f(h0), hv.y - bf2f(h1)), pk2(hv.z - bf2f(h2_), hv.w - bf2f(h3))}; } }
        __syncthreads();
        f32x4 acc[3] = {{0.f, 0.f, 0.f, 0.f}, {0.f, 0.f, 0.f, 0.f}, {0.f, 0.f, 0.f, 0.f}};
#pragma unroll
        for (int ks = 0; ks < 4; ++ks) { const bf16x8 ah = *(const LAS bf16x8*)(AH + fr * AP + 128 * w + 32 * ks + 8 * fq), al = *(const LAS bf16x8*)(AL + fr * AP + 128 * w + 32 * ks + 8 * fq);
#pragma unroll
            for (int ct = 0; ct < 3; ++ct) { acc[ct] = __builtin_amdgcn_mfma_f32_16x16x32_bf16(ah, Bh[ks][ct], acc[ct], 0, 0, 0);
                acc[ct] = __builtin_amdgcn_mfma_f32_16x16x32_bf16(al, Bh[ks][ct], acc[ct], 0, 0, 0); acc[ct] = __builtin_amdgcn_mfma_f32_16x16x32_bf16(ah, Bl[ks][ct], acc[ct], 0, 0, 0); } }
#pragma unroll
        for (int ct = 0; ct < 3; ++ct)
#pragma unroll
            for (int r = 0; r < 4; ++r) PART[(w * 16 + 4 * fq + r) * 48 + 16 * ct + fr] = acc[ct][r];
        __syncthreads();
        for (int t = F.tid; t < 16 * 48; t += NTHR) { const int row = t / 48, o = t % 48; float sacc = 0.f;
#pragma unroll
            for (int ww = 0; ww < 8; ++ww) sacc += PART[(ww * 16 + row) * 48 + o];
            if (o < 36) LG[row * 48 + o] = sacc + (o < 4 ? a.in[I_BRG][o & 3] : a.in[I_BRE][(o + 28) & 31]); }
        __syncthreads();
        if (F.tid < 16) {
            const LAS float* lg = LG + F.tid * 48;
            float gl[4]; int gi = 0;
#pragma unroll
            for (int o = 0; o < 4; ++o) gl[o] = lg[o];
            float gm = gl[0];
#pragma unroll
            for (int o = 1; o < 4; ++o) if (gl[o] > gm) { gm = gl[o]; gi = o; }
            float gsum = 0.f;
#pragma unroll
            for (int o = 0; o < 4; ++o) gsum += expf(gl[o] - gm);
            const float gp = 1.0f / gsum;
            float el[8];
#pragma unroll
            for (int e = 0; e < 8; ++e) el[e] = lg[4 + gi * 8 + e];
            int i0 = 0; float m0 = el[0];
#pragma unroll
            for (int o = 1; o < 8; ++o) if (el[o] > m0) { m0 = el[o]; i0 = o; }
            int i1 = -1; float m1 = -INFINITY;
#pragma unroll
            for (int o = 0; o < 8; ++o) if (o != i0 && el[o] > m1) { m1 = el[o]; i1 = o; }
            const float e1 = expf(m1 - m0); const float w0 = gp / (1.0f + e1), w1 = gp * e1 / (1.0f + e1);
            const int rl = 16 * g + F.tid, ex0 = gi * 8 + i0, ex1 = gi * 8 + i1;
            const unsigned l0 = atomicAdd((unsigned*)(LH + ex0), 1u), l1 = atomicAdd((unsigned*)(LH + ex1), 1u);
            LAS unsigned* ri = LR + rl * 6;
            ri[0] = (unsigned)ex0; ri[1] = l0; ri[2] = (unsigned)ex1; ri[3] = l1; ri[4] = __float_as_uint(w0); ri[5] = __float_as_uint(w1);
        }
#pragma unroll
        for (int q = 0; q < 2; ++q)
#pragma unroll
            for (int j = 0; j < 4; ++j) v[q][j] = vn[q][j];
    }
#undef RT_LOAD
    __syncthreads();
    if (F.tid < NEXP) LB[F.tid] = atomicAdd(counts + 64 * F.tid, LH[F.tid]);
    __syncthreads();
    for (int rl = F.tid; rl < rows_per_blk; rl += NTHR) {
        const LAS unsigned* ri = LR + rl * 6; const int r = r0 + rl;
        const unsigned ex0 = ri[0], ex1 = ri[2], k0 = LB[ex0] + ri[1], k1 = LB[ex1] + ri[3];
        toklist[ex0 * T + k0] = r; toklist[ex1 * T + k1] = r;
        u32x4 t0; t0.x = ex0; t0.y = k0; t0.z = ex1; t0.w = k1;
        *(u32x4*)(tokinfo + (size_t)r * 8) = t0;
        tokinfo[(size_t)r * 8 + 4] = ri[4]; tokinfo[(size_t)r * 8 + 5] = ri[5];
    }
}
__device__ __forceinline__ void build_moe_tab(const Frame& F, const Args& a, LAS MoeTab* tab) {
    if (F.tid == 0) {
        const unsigned* counts = (const unsigned*)(a.ws + WS_CTL) + CW_COUNTS; int nt = 0;
        for (int e = 0; e < NEXP; ++e) { const int c = (int)__hip_atomic_load(counts + 64 * e, __ATOMIC_RELAXED, __HIP_MEMORY_SCOPE_AGENT); tab->cnt[e] = c; tab->tbase[e] = nt;
            const int n = (c + 255) >> 8; for (int m = 0; m < n; ++m) { tab->tile_e[nt] = e; tab->tile_m[nt] = m; ++nt; } }
        tab->tbase[NEXP] = nt; tab->nt = nt;
    }
    __syncthreads();
}
__device__ __forceinline__ void phase_final(const Frame& F, const Args& a, const LAS MoeTab* tab) {
    const float* mod = (const float*)(a.ws + WS_MOD); const unsigned* tokinfo = (const unsigned*)(a.ws + WS_TOKINFO); const bf16_t* Ys = (const bf16_t*)(a.ws + WS_YS);
    const int rows_per_blk = T / F.G, r0 = F.bid * rows_per_blk;
    for (int r = r0 + F.wave; r < r0 + rows_per_blk; r += NWAVES) {
        const int b = r / SEQ;
        const u32x4 ti = *(const u32x4*)(tokinfo + (size_t)r * 8);
        const float w0 = __uint_as_float(tokinfo[(size_t)r * 8 + 4]), w1 = __uint_as_float(tokinfo[(size_t)r * 8 + 5]);
        const size_t s0 = (size_t)tab->tbase[ti.x] * 256 + ti.y, s1 = (size_t)tab->tbase[ti.z] * 256 + ti.w;
        f32x4* xr = (f32x4*)(a.out + (size_t)r * D) + F.lane;
        const u32x2* y0 = (const u32x2*)(Ys + s0 * D) + F.lane; const u32x2* y1 = (const u32x2*)(Ys + s1 * D) + F.lane;
        f32x4 v[4]; float s = 0.f;
#pragma unroll
        for (int j = 0; j < 4; ++j) { const int k = 256 * j + 4 * F.lane;
            const f32x4 gt = *(const f32x4*)(mod + b * 6144 + 5 * 1024 + k); const u32x2 a0 = y0[64 * j], a1 = y1[64 * j];
            f32x4 m; m.x = w0 * bf2f(a0.x & 0xffffu) + w1 * bf2f(a1.x & 0xffffu); m.y = w0 * bf2f(a0.x >> 16) + w1 * bf2f(a1.x >> 16);
            m.z = w0 * bf2f(a0.y & 0xffffu) + w1 * bf2f(a1.y & 0xffffu); m.w = w0 * bf2f(a0.y >> 16) + w1 * bf2f(a1.y >> 16);
            v[j] = xr[64 * j] + gt * m; s += (v[j].x * v[j].x + v[j].y * v[j].y) + (v[j].z * v[j].z + v[j].w * v[j].w); }
        const float rs = rsqrtf(wave_sum(s) * (1.0f / D) + EPS);
#pragma unroll
        for (int j = 0; j < 4; ++j) { const f32x4 g = *(const f32x4*)(a.in[I_FG] + 256 * j + 4 * F.lane); xr[64 * j] = v[j] * rs * g; }
    }
}

#define XB_TMO      128
#define XB_XCNT(j)  (256  + 64 * (j))
#define XB_XSUB(j)  (1280 + 64 * (j))
#define XB_XGEN(j)  (2304 + 64 * (j))
#define XB_TOP      3328
#define XB_TOPGEN   3392
#define XCD_BAR_WORDS 3456
#define XB_SPIN_CAP (1u << 18)
__device__ __forceinline__ unsigned xb_ld(unsigned* p)              { return __hip_atomic_load(p, __ATOMIC_RELAXED, __HIP_MEMORY_SCOPE_AGENT); }
__device__ __forceinline__ unsigned xb_add(unsigned* p, unsigned v) { return __hip_atomic_fetch_add(p, v, __ATOMIC_RELAXED, __HIP_MEMORY_SCOPE_AGENT); }
__device__ __forceinline__ unsigned xb_xcc_id() { return (unsigned)__builtin_amdgcn_s_getreg((3 << 11) | 20) & 0xFu; }
#define XB_SPIN(cond, bar) do { unsigned _sp = 0; while (cond) { __builtin_amdgcn_s_sleep(1); \
    if ((++_sp & 255u) == 0u) { if (xb_ld(&(bar)[XB_TMO])) break; if (_sp > XB_SPIN_CAP) { atomicAdd(&(bar)[XB_TMO], 1u); break; } } } } while (0)
struct XcdBarrier { unsigned* bar; unsigned x; volatile LAS unsigned* st; };
__device__ __forceinline__ XcdBarrier xcd_barrier_post(unsigned* bar, volatile LAS unsigned* st) {
    XcdBarrier b; b.bar = bar; b.x = xb_xcc_id(); b.st = st;
    if (threadIdx.x == 0) (void)xb_add(&bar[XB_XCNT(b.x)], 1u);
    return b;
}
__device__ __forceinline__ void xcd_barrier_complete(unsigned* bar, unsigned x, unsigned& nloc, unsigned& nx) {
    const unsigned G = gridDim.x * gridDim.y * gridDim.z;
    unsigned sum, cnt, mine, sp = 0u;
    for (;;) {
        sum = 0u; cnt = 0u; mine = 0u;
#pragma unroll
        for (unsigned j = 0; j < 16; ++j) { const unsigned c = xb_ld(&bar[XB_XCNT(j)]); sum += c; cnt += (c > 0u) ? 1u : 0u; mine = (j == x) ? c : mine; }
        if (sum == G) break;
        __builtin_amdgcn_s_sleep(1);
        if ((++sp & 255u) == 0u) { if (xb_ld(&bar[XB_TMO])) break; if (sp > XB_SPIN_CAP) { atomicAdd(&bar[XB_TMO], 1u); break; } }
    }
    nloc = mine > 0u ? mine : 1u; nx = cnt > 0u ? cnt : 1u;
}
__device__ __forceinline__ void xcd_barrier(const XcdBarrier& b) {
    asm volatile("s_waitcnt vmcnt(0)" ::: "memory");
    __syncthreads();
    if (threadIdx.x == 0) {
        unsigned* bar = b.bar;
        __builtin_amdgcn_s_waitcnt(0);
        unsigned nloc = b.st[0], nx = b.st[1];
        if (nloc == 0u) { xcd_barrier_complete(bar, b.x, nloc, nx); b.st[0] = nloc; b.st[1] = nx; }
        const unsigned old = xb_add(&bar[XB_XSUB(b.x)], 1u);
        const unsigned gen = old / nloc;
        if (old + 1u == (gen + 1u) * nloc) {
            __builtin_amdgcn_fence(__ATOMIC_RELEASE, "agent");
            asm volatile("s_waitcnt vmcnt(0)" ::: "memory");
            const unsigned og = xb_add(&bar[XB_TOP], 1u);
            const unsigned tg = og / nx;
            if (og + 1u == (tg + 1u) * nx) xb_add(&bar[XB_TOPGEN], 1u);
            else XB_SPIN(xb_ld(&bar[XB_TOPGEN]) == tg, bar);
            __builtin_amdgcn_fence(__ATOMIC_ACQUIRE, "agent");
            xb_add(&bar[XB_XGEN(b.x)], 1u);
            asm volatile("s_waitcnt vmcnt(0)" ::: "memory");
        } else {
            XB_SPIN(xb_ld(&bar[XB_XGEN(b.x)]) == gen, bar);
            __builtin_amdgcn_fence(__ATOMIC_ACQUIRE, "agent");
            asm volatile("s_waitcnt vmcnt(0)" ::: "memory");
        }
    }
    __syncthreads();
}

constexpr int N_PHASES = 11;
__global__ void __launch_bounds__(NTHR, 2) mk_fwd(Args a) {
    extern __shared__ __attribute__((aligned(16))) unsigned char lds_raw[];
    Frame F; F.lds = (LAS unsigned char*)lds_raw; F.tid = threadIdx.x; F.lane = F.tid & 63; F.wave = __builtin_amdgcn_readfirstlane(F.tid >> 6); F.G = gridDim.x; F.bid = blockIdx.x;
    unsigned char* ws = a.ws;
    const int lo = a.ph_lo, hi = a.ph_hi;
#if MK_N_LAUNCHES == 1
    volatile LAS unsigned* MISC = (volatile LAS unsigned*)(F.lds + 152 * 1024);
    if (F.tid < 4) MISC[F.tid] = 0u;
    __syncthreads();
    XcdBarrier xbar = xcd_barrier_post((unsigned*)(ws + WS_CTL) + CW_BAR, MISC);
#define SEAM(k) do { if (IN(k) && IN((k) + 1)) xcd_barrier(xbar); } while (0)
#else
#define SEAM(k) do { } while (0)
#endif
#define IN(k) (lo <= (k) && (k) < hi)
    LAS MoeTab* tab = (LAS MoeTab*)(F.lds + 144 * 1024);

#define RUNPH(k, ...) if (IN(k)) { F.lane = lane_now(); F.tid = F.wave * 64 + F.lane; __VA_ARGS__ }
    RUNPH(0, { phase0(F, a); }) SEAM(0);
    RUNPH(1, { phase1(F, a); __syncthreads(); dense_weight_convert(F, a); }) SEAM(1);
    RUNPH(2, {
        DenseOrder S{(const char*)(ws + WS_ACT), (const char*)(ws + WS_WIN), D, T / 256, INC / 256, F.G, F.bid};
        EpiInProj E{(bf16_t*)(ws + WS_PROJ), (bf16_t*)a.out, (float*)(ws + WS_DEC), (const float*)(ws + WS_SMALL) + 16, attn_body::C2};
        pg8::gemm_phase(F.lds, D, S, E);
    }) SEAM(2);
    RUNPH(3, {
        for (int g = F.bid; g < 256; g += F.G) hg::grp_local(F, a, g);
        __syncthreads();
        attn_phase(F, a);
    }) SEAM(3);
    RUNPH(4, { hg::grp_scan(F, a); attn_combine(F, a); }) SEAM(4);
    RUNPH(5, { for (int g = F.bid; g < 256; g += F.G) hg::grp_final(F, a, g); }) SEAM(5);
    RUNPH(6, {
        UpOrder S{(const char*)(ws + WS_YDA), (const char*)(ws + WS_YHG), (const char*)(ws + WS_WUPDA), (const char*)(ws + WS_WUPHG), F.G, F.bid};
        EpiUp E{(const bf16_t*)(ws + WS_PROJ), (bf16_t*)(ws + WS_ACT)};
        pg8::gemm_phase(F.lds, 512, S, E);
    }) SEAM(6);
    RUNPH(7, {
        DenseOrder S{(const char*)(ws + WS_ACT), (const char*)(ws + WS_WOUT), D, T / 256, D / 256, F.G, F.bid};
        EpiOut E{a.in[I_X], (const float*)(ws + WS_MOD), a.out};
        pg8::gemm_phase(F.lds, D, S, E);
        moe_weight_convert(F, a);
    }) SEAM(7);
    RUNPH(8, { phase_router(F, a); __syncthreads(); }) SEAM(8);
    RUNPH(9, {
        build_moe_tab(F, a, tab);
        unsigned* done = (unsigned*)(ws + WS_CTL) + CW_TILE;
        { Moe1Order S{tab, (const char*)(ws + WS_ACT), (const char*)(ws + WS_W13), (const int*)(ws + WS_TOKLIST), F.G, F.bid};
          EpiMoe1 E{(bf16_t*)(ws + WS_HS), done};
          pg8::gemm_phase(F.lds, D, S, E); }
        { Moe2Order S{tab, (const char*)(ws + WS_HS), (const char*)(ws + WS_W2), done, (unsigned*)(ws + WS_CTL) + CW_TMO, F.G, F.bid};
          EpiStoreBf16 E{(bf16_t*)(ws + WS_YS), D, 0, 1.0f};
          pg8::gemm_phase(F.lds, DEXP, S, E); }
    }) SEAM(9);
    RUNPH(10, { build_moe_tab(F, a, tab); phase_final(F, a, tab); })
#undef IN
#undef SEAM
}

extern "C" void kernel_launch(void* const* d_in, const int* in_sizes, int n_in, void* d_out, int out_size, void* d_ws, size_t ws_size, hipStream_t stream) {
    static int grid = 0;
    if (grid == 0) {
        if (n_in != 25 || in_sizes[0] != T * D || out_size != T * D || ws_size < WS_END) { fprintf(stderr, "kernel_launch: unexpected shapes (n_in %d, in0 %d, out %d, ws %zu)\n", n_in, n_in > 0 ? in_sizes[0] : -1, out_size, ws_size); grid = -1; return; }
        int dev = 0, cus = 0, per_cu = 0;
        if (hipGetDevice(&dev) != hipSuccess || hipDeviceGetAttribute(&cus, hipDeviceAttributeMultiprocessorCount, dev) != hipSuccess) { grid = -1; return; }
        if (hipFuncSetAttribute((const void*)mk_fwd, hipFuncAttributeMaxDynamicSharedMemorySize, LDS_BYTES) != hipSuccess) { fprintf(stderr, "kernel_launch: hipFuncSetAttribute failed\n"); grid = -1; return; }
        if (hipOccupancyMaxActiveBlocksPerMultiprocessor(&per_cu, (const void*)mk_fwd, NTHR, LDS_BYTES) != hipSuccess || per_cu < 1) { fprintf(stderr, "kernel_launch: occupancy query says %d\n", per_cu); per_cu = 1; }
        (void)hipGetLastError();
        grid = cus;
        if (grid > 256) grid = 256;
        while (T % grid) --grid;
    }
    if (grid < 0) return;
    (void)hipMemsetAsync((char*)d_ws + WS_CTL, 0, CTL_ZERO_BYTES, stream);
    Args a{};
    for (int i = 0; i < 25; ++i) a.in[i] = (const float*)d_in[i];
    a.out = (float*)d_out; a.ws = (unsigned char*)d_ws;
#if MK_N_LAUNCHES == 1
    a.ph_lo = 0; a.ph_hi = N_PHASES;
    void* args[] = {&a};
    hipError_t e = hipLaunchCooperativeKernel((const void*)mk_fwd, dim3(grid), dim3(NTHR), args, LDS_BYTES, stream);
    if (e != hipSuccess) fprintf(stderr, "cooperative launch failed: %s (grid %d)\n", hipGetErrorString(e), grid);
#else
    for (int p = 0; p < N_PHASES; ++p) {
        a.ph_lo = p; a.ph_hi = p + 1;
        hipLaunchKernelGGL(mk_fwd, dim3(grid), dim3(NTHR), LDS_BYTES, stream, a);
    }
#endif
}
```

```cpp
#include <hip/hip_runtime.h>
#include <cstdio>
#include <cstdint>

#ifndef MK_N_LAUNCHES
#define MK_N_LAUNCHES 1
#endif

#define LAS __attribute__((address_space(3)))
typedef unsigned short bf16_t;
typedef short bf16x8 __attribute__((ext_vector_type(8)));
typedef float f32x4 __attribute__((ext_vector_type(4)));
typedef float f32x2 __attribute__((ext_vector_type(2)));
typedef unsigned u32x4 __attribute__((ext_vector_type(4)));
typedef unsigned u32x2 __attribute__((ext_vector_type(2)));

constexpr int NB = 4, SEQ = 4096, D = 1024, T = NB * SEQ;
constexpr int INC = 5632;
constexpr int C_QDA = 0, C_KDA = 512, C_VDA = 1024, C_QHG = 1536, C_FHG = 2048, C_IHG = 2560, C_GHG = 3072, C_GDA = 3584, C_GHGATE = 4608;
constexpr int C_HGT = 1536;
constexpr int NEXP = 32, DEXP = 512;
constexpr int PMAX = 40960;
constexpr float EPS = 1e-6f;
constexpr int NWAVES = 8, NTHR = 512;

constexpr size_t MiB = 1u << 20;
constexpr size_t WS_CTL = 0, CTL_ZERO_BYTES = 64 * 1024;
constexpr size_t WS_MODP = 1 * MiB;
constexpr size_t WS_MOD = 5 * MiB / 2;
constexpr size_t WS_SMALL = 11 * MiB / 4;
constexpr size_t WS_TOKINFO = 3 * MiB;
constexpr size_t WS_TOKLIST = 4 * MiB;
constexpr size_t WS_DEC = 6 * MiB;
constexpr size_t WS_DS = 24 * MiB;
constexpr size_t WS_WIN = 8 * MiB;
constexpr size_t WS_WUPDA = 20 * MiB, WS_WUPHG = 21 * MiB, WS_WOUT = 22 * MiB;
constexpr size_t WS_ACT = 24 * MiB;
constexpr size_t WS_PROJ = 56 * MiB;
constexpr size_t WS_YDA = 232 * MiB, WS_YHG = 248 * MiB;
constexpr size_t WS_OA = 264 * MiB;
constexpr size_t WS_W13 = 56 * MiB;
constexpr size_t WS_W2 = 120 * MiB;
constexpr size_t WS_HS = 152 * MiB;
constexpr size_t WS_YS = 192 * MiB;
constexpr size_t WS_X1B = 272 * MiB;
constexpr size_t WS_END = 304 * MiB;
constexpr int CW_COUNTS = 64;
constexpr int CW_BAR = 4096;
constexpr int CW_TILE = 8192;
constexpr int CW_TMO = 32;

constexpr int LDS_BYTES = 160 * 1024;

__device__ __forceinline__ float bf2f(unsigned v) { return __uint_as_float(v << 16); }
__device__ __forceinline__ unsigned f2bf(float f) { unsigned u = __float_as_uint(f); return (u + 0x7fffu + ((u >> 16) & 1u)) >> 16; }
__device__ __forceinline__ unsigned pk2(float lo, float hi) { return f2bf(lo) | (f2bf(hi) << 16); }
__device__ __forceinline__ float sigmoidf_(float x) { return 1.0f / (1.0f + __expf(-x)); }
__device__ __forceinline__ float siluf_(float x) { return x / (1.0f + __expf(-x)); }
__device__ __forceinline__ int lane_now() { int l; asm volatile("v_mbcnt_lo_u32_b32 %0, -1, 0\n\tv_mbcnt_hi_u32_b32 %0, -1, %0" : "=v"(l)); return l; }
__device__ __forceinline__ float wave_sum(float v) {
#pragma unroll
    for (int o = 1; o < 64; o <<= 1) v += __shfl_xor(v, o);
    return v;
}

namespace pg8 {
constexpr int BM = 256, BK = 64, HALF = 128, HTB = HALF * BK * 2, STAGE_BYTES = 8 * HTB;
__host__ __device__ __forceinline__ int lds_byte(int r, int c) { const int st = (r >> 4) * 2 + (c >> 5), rr = r & 15, cc = c & 31, ob = rr * 64 + cc * 2; return st * 1024 + (ob ^ (((ob >> 9) & 1) << 5)); }
__host__ __device__ __forceinline__ void stage_rc(int b, int& R, int& C) { const int st = b / 1024, sb = b % 1024, swz = sb ^ (((sb >> 9) & 1) << 5); R = (st >> 1) * 16 + swz / 64; C = (st & 1) * 32 + (swz % 64) / 2; }
__host__ __device__ __forceinline__ int perm32(int rho) { const int n = rho >> 4, i = rho & 15; return 8 * (i >> 2) + 4 * n + (i & 3); }

struct Unit { int pm, pn; const char* A; const char* B; int aux; };
__device__ __forceinline__ unsigned cvt_pk_bf16(float lo, float hi) { unsigned r; asm volatile("v_cvt_pk_bf16_f32 %0, %1, %2" : "=v"(r) : "v"(lo), "v"(hi)); return r; }

template <class Epi, class Sched>
__device__ __forceinline__ void gemm_phase(LAS unsigned char* lds, const int K, const Sched& S, const Epi& E) {
    const int tid = threadIdx.x, wid = __builtin_amdgcn_readfirstlane(tid >> 6), lane = tid & 63, wr = wid >> 2, wc = wid & 3, fr = lane & 15, fq = lane >> 4;
    const int nt = K / BK;
    unsigned voffB[2];
#define PG8_SETLANE() do { const int _l = lane_now(), _t = wid * 64 + _l; _Pragma("unroll") for (int _i = 0; _i < 2; ++_i) { int _R, _C; stage_rc(_t * 16 + _i * 8192, _R, _C); \
        const int _Rb = Epi::PERM ? ((_R & ~31) + perm32(_R & 31)) : _R; voffB[_i] = (unsigned)(_Rb * K + _C) * 2u; } \
        aoff = lds_byte(wr * 64 + (_l & 15), (_l >> 4) * 8); boff = lds_byte(wc * 32 + (_l & 15), (_l >> 4) * 8); } while (0)
    const size_t kstep = (size_t)(BK * 2);
    const size_t hstep = (size_t)HALF * K * 2;
    const unsigned ldsw = (unsigned)wid * 1024u;
    int aoff, boff; PG8_SETLANE();
#define PG8_SA(b, h) (((b) * 2 + (h)) * HTB)
#define PG8_SB(b, h) ((4 + (b) * 2 + (h)) * HTB)
#define PG8_STAGE(bufoff, gbase, voff) do { _Pragma("unroll") for (int _i = 0; _i < 2; ++_i) \
        __builtin_amdgcn_global_load_lds((const unsigned*)((const char*)(gbase) + (voff)[_i]), (LAS unsigned*)(lds + (bufoff) + ldsw + _i * 8192), 16, 0, 0); } while (0)
#define PG8_LDA(dst, b, h) do { _Pragma("unroll") for (int m = 0; m < 4; ++m) _Pragma("unroll") for (int k = 0; k < 2; ++k) dst[m][k] = *(const LAS bf16x8*)(lds + PG8_SA(b, h) + aoff + m * 2048 + k * 1024); } while (0)
#define PG8_LDB(dst, b, h) do { _Pragma("unroll") for (int n = 0; n < 2; ++n) _Pragma("unroll") for (int k = 0; k < 2; ++k) dst[n][k] = *(const LAS bf16x8*)(lds + PG8_SB(b, h) + boff + n * 2048 + k * 1024); } while (0)
#define PG8_MMA(ai, bj, At, Bt) do { __builtin_amdgcn_s_setprio(1); _Pragma("unroll") for (int m = 0; m < 4; ++m) _Pragma("unroll") for (int n = 0; n < 2; ++n) _Pragma("unroll") for (int k = 0; k < 2; ++k) \
        acc[ai][bj][m][n] = __builtin_amdgcn_mfma_f32_16x16x32_bf16(Bt[n][k], At[m][k], acc[ai][bj][m][n], 0, 0, 0); __builtin_amdgcn_s_setprio(0); } while (0)
#define PG8_WAIT_V(n) asm volatile("s_waitcnt vmcnt(" #n ")" ::: "memory")
#define PG8_WAIT_L(n) asm volatile("s_waitcnt lgkmcnt(" #n ")" ::: "memory")
#define PG8_BAR __builtin_amdgcn_s_barrier()
#define PG8_SCHED __builtin_amdgcn_sched_barrier(0)
#define PG8_SETA(vo, u) do { const int _t = wid * 64 + lane_now(); _Pragma("unroll") for (int _i = 0; _i < 2; ++_i) { int _R, _C; stage_rc(_t * 16 + _i * 8192, _R, _C); \
        _Pragma("unroll") for (int _h = 0; _h < 2; ++_h) vo[_h][_i] = (unsigned)((size_t)S.arow(u, _h * HALF + _R) * (size_t)K + _C) * 2u; } if (Sched::GATHER) PG8_WAIT_V(0); } while (0)
    Unit cur, nxt; int ui = 0;
    if (!S.next(0, cur)) return;
    f32x4 acc[2][2][4][2];
#pragma unroll
    for (int a = 0; a < 2; ++a)
#pragma unroll
        for (int b = 0; b < 2; ++b)
#pragma unroll
            for (int m = 0; m < 4; ++m)
#pragma unroll
                for (int n = 0; n < 2; ++n) acc[a][b][m][n] = (f32x4){0.f, 0.f, 0.f, 0.f};
    bf16x8 At[4][2], B0[2][2], B1[2][2];
    unsigned voC[2][2], voN[2][2];
    S.a_ready(cur);
    PG8_SETA(voC, cur);
    const char* cA = cur.A; const char* cB = cur.B;
    PG8_STAGE(PG8_SB(0, 0), cB, voffB); PG8_STAGE(PG8_SB(0, 1), cB + hstep, voffB); PG8_STAGE(PG8_SA(0, 0), cA, voC[0]); PG8_STAGE(PG8_SA(0, 1), cA, voC[1]);
    if (wr == 1) PG8_BAR;
    PG8_WAIT_V(2); PG8_BAR;
    PG8_STAGE(PG8_SB(1, 0), cB + kstep, voffB); PG8_STAGE(PG8_SA(1, 0), cA + kstep, voC[0]); PG8_STAGE(PG8_SB(1, 1), cB + hstep + kstep, voffB);
    PG8_WAIT_V(6); PG8_BAR;
    for (;;) {
        const bool has_next = S.next(ui + 1, nxt);
        if (has_next) { PG8_SETA(voN, nxt); }
        else {
#pragma unroll
            for (int h = 0; h < 2; ++h)
#pragma unroll
                for (int i = 0; i < 2; ++i) voN[h][i] = voC[h][i];
        }
        const char* nA = has_next ? nxt.A : cA; const char* nB = has_next ? nxt.B : cB;
        for (int t = 0; t < nt; t += 2) {
            const bool last = (t == nt - 2);
            if (last && has_next) S.a_ready(nxt);
            const char* a1 = cA + (size_t)(t + 1) * kstep;
            const char* a2 = last ? nA : cA + (size_t)(t + 2) * kstep; const char* b2 = last ? nB : cB + (size_t)(t + 2) * kstep;
            const char* a3 = a2 + kstep; const char* b3 = b2 + kstep;
            unsigned vo2[2][2];
#pragma unroll
            for (int h = 0; h < 2; ++h)
#pragma unroll
                for (int i = 0; i < 2; ++i) vo2[h][i] = last ? voN[h][i] : voC[h][i];
            PG8_LDB(B0, 0, 0); PG8_LDB(B1, 0, 1); PG8_SCHED; PG8_LDA(At, 0, 0); PG8_STAGE(PG8_SA(1, 1), a1, voC[1]);
            PG8_WAIT_V(8); PG8_WAIT_L(0); PG8_BAR; PG8_MMA(0, 0, At, B0); PG8_MMA(0, 1, At, B1); PG8_BAR; PG8_SCHED;
            PG8_LDA(At, 0, 1); PG8_STAGE(PG8_SB(0, 0), b2, voffB); PG8_STAGE(PG8_SB(0, 1), b2 + hstep, voffB); PG8_STAGE(PG8_SA(0, 0), a2, vo2[0]);
            PG8_WAIT_V(8); PG8_WAIT_L(0); PG8_BAR; PG8_MMA(1, 0, At, B0); PG8_MMA(1, 1, At, B1); PG8_BAR; PG8_SCHED;
            PG8_LDB(B0, 1, 0); PG8_LDB(B1, 1, 1); PG8_SCHED; PG8_LDA(At, 1, 0); PG8_STAGE(PG8_SA(0, 1), a2, vo2[1]);
            PG8_WAIT_V(8); PG8_WAIT_L(0); PG8_BAR; PG8_MMA(0, 0, At, B0); PG8_MMA(0, 1, At, B1); PG8_BAR; PG8_SCHED;
            PG8_LDA(At, 1, 1); PG8_STAGE(PG8_SB(1, 0), b3, voffB); PG8_STAGE(PG8_SB(1, 1), b3 + hstep, voffB); PG8_STAGE(PG8_SA(1, 0), a3, vo2[0]);
            PG8_WAIT_V(8); PG8_WAIT_L(0); PG8_BAR; PG8_MMA(1, 0, At, B0); PG8_MMA(1, 1, At, B1); PG8_BAR; PG8_SCHED;
        }
        if (wr == 0) PG8_BAR;
        const bool keep = E(acc, cur, wr, wc, fr, fq);
        if (!has_next) break;
        if (!keep) {
#pragma unroll
            for (int a = 0; a < 2; ++a)
#pragma unroll
                for (int b = 0; b < 2; ++b)
#pragma unroll
                    for (int m = 0; m < 4; ++m)
#pragma unroll
                        for (int n = 0; n < 2; ++n) acc[a][b][m][n] = (f32x4){0.f, 0.f, 0.f, 0.f};
        }
        cur = nxt; cA = nA; cB = nB; ++ui;
        if (Sched::GATHER) {
#pragma unroll
            for (int h = 0; h < 2; ++h)
#pragma unroll
                for (int i = 0; i < 2; ++i) voC[h][i] = voN[h][i];
        } else { PG8_SETA(voC, cur); }
        PG8_SETLANE();
        if (wr == 1) PG8_BAR;
    }
    PG8_WAIT_V(0);
    PG8_BAR;
#undef PG8_SA
#undef PG8_SB
#undef PG8_STAGE
#undef PG8_LDA
#undef PG8_LDB
#undef PG8_MMA
#undef PG8_WAIT_V
#undef PG8_WAIT_L
#undef PG8_BAR
#undef PG8_SCHED
#undef PG8_SETA
#undef PG8_SETLANE
}
}

struct Args { const float* in[25]; float* out; unsigned char* ws; int ph_lo, ph_hi; };
enum { I_X = 0, I_C, I_WADA, I_BADA, I_N1G, I_WIN, I_LQ1, I_LK1, I_LQ2, I_LK2, I_SUBG, I_LBL, I_HGNG, I_WUPDA, I_WUPHG, I_WOUT, I_N2G, I_WRG, I_BRG, I_WRE, I_BRE, I_W1, I_W3, I_W2, I_FG };

struct DenseOrder {
    static constexpr bool GATHER = false;
    const char* A; const char* Bt; int K, nM, nN, G, c;
    __device__ __forceinline__ bool next(int i, pg8::Unit& u) const {
        const int L = i * G + c, nwg = nM * nN; if (L >= nwg) return false;
        int wgid = L; { const int q = nwg / 8, r = nwg % 8, xcd = wgid % 8, off = wgid / 8; wgid = (xcd < r ? xcd * (q + 1) : r * (q + 1) + (xcd - r) * q) + off; }
        const int nig = 8 * nN, gid = wgid / nig, fm = gid * 8, gsz = (nM - fm) < 8 ? (nM - fm) : 8;
        u.pm = fm + ((wgid % nig) % gsz); u.pn = (wgid % nig) / gsz; u.A = A; u.B = Bt + (size_t)u.pn * 256 * K * 2; u.aux = 0; return true;
    }
    __device__ __forceinline__ void a_ready(const pg8::Unit&) const {}
    __device__ __forceinline__ unsigned arow(const pg8::Unit& u, int r) const { return (unsigned)(u.pm * 256 + r); }
};
struct UpOrder {
    static constexpr bool GATHER = false;
    const char* A0; const char* A1; const char* B0; const char* B1; int G, c;
    __device__ __forceinline__ bool next(int i, pg8::Unit& u) const {
        const int tile = (i >> 1) * G + c; if (tile >= 256) return false;
        u.pm = tile >> 2; u.pn = tile & 3; u.aux = i & 1;
        u.A = (i & 1) ? A1 : A0; u.B = ((i & 1) ? B1 : B0) + (size_t)u.pn * 256 * 512 * 2; return true;
    }
    __device__ __forceinline__ void a_ready(const pg8::Unit&) const {}
    __device__ __forceinline__ unsigned arow(const pg8::Unit& u, int r) const { return (unsigned)(u.pm * 256 + r); }
};
struct MoeTab { int nt; int pad[3]; int tile_e[176]; int tile_m[176]; int cnt[32]; int tbase[33]; };
struct Moe1Order {
    static constexpr bool GATHER = true;
    const LAS MoeTab* tab; const char* A; const char* W; const int* toklist; int G, c;
    __device__ __forceinline__ bool next(int i, pg8::Unit& u) const {
        const int L = i * G + c; if (L >= tab->nt * 4) return false;
        const int ti = L >> 2; u.pm = ti; u.pn = L & 3; u.aux = ti; u.A = A;
        u.B = W + ((size_t)tab->tile_e[ti] * 1024 + (size_t)u.pn * 256) * 1024 * 2; return true;
    }
    __device__ __forceinline__ void a_ready(const pg8::Unit&) const {}
    __device__ __forceinline__ unsigned arow(const pg8::Unit& u, int r) const {
        const int e = tab->tile_e[u.aux], rr = tab->tile_m[u.aux] * 256 + r;
        return rr < tab->cnt[e] ? (unsigned)toklist[e * T + rr] : 0u;
    }
};
struct Moe2Order {
    static constexpr bool GATHER = false;
    const LAS MoeTab* tab; const char* A; const char* W; unsigned* done; unsigned* tmo; int G, c;
    __device__ __forceinline__ bool next(int i, pg8::Unit& u) const {
        const int n1 = tab->nt * 4, r = n1 % G, nl = G - r; int j;
        if (r > 0 && c >= r) { if (i < 2) j = (c - r) + i * nl; else j = 2 * nl + (c - r) + (i - 2) * G; }
        else j = (r > 0 ? 2 * nl : 0) + ((c - r + G) % G) + i * G;
        if (j >= n1) return false;
        const int ti = j >> 2; u.pm = ti; u.pn = j & 3; u.aux = ti; u.A = A;
        u.B = W + ((size_t)tab->tile_e[ti] * 1024 + (size_t)u.pn * 256) * 512 * 2; return true;
    }
    __device__ __forceinline__ unsigned arow(const pg8::Unit& u, int r) const { return (unsigned)(u.pm * 256 + r); }
    __device__ __forceinline__ void a_ready(const pg8::Unit& u) const {
        if (threadIdx.x < 64) {
            unsigned polls = 0;
            while ((unsigned)__builtin_amdgcn_readfirstlane(__hip_atomic_load(done + 16 * u.pm, __ATOMIC_RELAXED, __HIP_MEMORY_SCOPE_AGENT)) < 32u) {
                if (++polls > (1u << 22)) { if (threadIdx.x == 0) __hip_atomic_store(tmo, 1u, __ATOMIC_RELAXED, __HIP_MEMORY_SCOPE_AGENT); break; }
                __builtin_amdgcn_s_sleep(2); }
            __builtin_amdgcn_fence(__ATOMIC_ACQUIRE, "agent");
            asm volatile("s_waitcnt vmcnt(0)" ::: "memory");
        }
        asm volatile("" ::: "memory"); __builtin_amdgcn_s_barrier(); asm volatile("" ::: "memory");
    }
};

using pg8::Unit; using pg8::cvt_pk_bf16;
struct EpiStoreBf16 {
    static constexpr bool PERM = true;
    bf16_t* O; int ldc; int nscale; float scale0;
    __device__ __forceinline__ bool operator()(f32x4 (&acc)[2][2][4][2], const Unit& u, int wr, int wc, int fr, int fq) const {
        const int row0 = u.pm * 256 + wr * 64 + fr, col0 = u.pn * 256 + wc * 32 + 8 * fq;
        const float sc = u.pn < nscale ? scale0 : 1.0f;
#pragma unroll
        for (int ai = 0; ai < 2; ++ai)
#pragma unroll
            for (int m = 0; m < 4; ++m) { bf16_t* rowp = O + (size_t)(row0 + ai * 128 + m * 16) * ldc + col0;
#pragma unroll
                for (int bj = 0; bj < 2; ++bj) { const f32x4 v0 = acc[ai][bj][m][0] * sc, v1 = acc[ai][bj][m][1] * sc;
                    u32x4 w; w.x = cvt_pk_bf16(v0[0], v0[1]); w.y = cvt_pk_bf16(v0[2], v0[3]); w.z = cvt_pk_bf16(v1[0], v1[1]); w.w = cvt_pk_bf16(v1[2], v1[3]);
                    *(u32x4*)(rowp + bj * 128) = w; } }
        return false;
    }
};
template <int N> __device__ __forceinline__ float dpp_shr(float x) { return __builtin_bit_cast(float, __builtin_amdgcn_update_dpp(0, __builtin_bit_cast(int, x), 0x110 + N, 0xf, 0xf, true)); }
template <int N> __device__ __forceinline__ float dpp_ror(float x) { return __builtin_bit_cast(float, __builtin_amdgcn_update_dpp(0, __builtin_bit_cast(int, x), 0x120 + N, 0xf, 0xf, true)); }
__device__ __forceinline__ float rowsum16(float x) { x += dpp_ror<8>(x); x += dpp_ror<4>(x); x += dpp_ror<2>(x); x += dpp_ror<1>(x); return x; }
__device__ __forceinline__ float scan16(float x) { x += dpp_shr<1>(x); x += dpp_shr<2>(x); x += dpp_shr<4>(x); x += dpp_shr<8>(x); return x; }
struct EpiInProj {
    static constexpr bool PERM = true;
    bf16_t* O; bf16_t* KE; float* DEC; const float* lbv; float scale0;
    __device__ __forceinline__ bool operator()(f32x4 (&acc)[2][2][4][2], const Unit& u, int wr, int wc, int fr, int fq) const {
        { const int l_ = lane_now(); fr = l_ & 15; fq = l_ >> 4; }
        const int row0 = u.pm * 256 + wr * 64 + fr, col0 = u.pn * 256 + wc * 32 + 8 * fq;
        if (u.pn >= 6 && u.pn < 10) {
            const int h = u.pn - 6, lane = 16 * fq + fr, kb = wc * 32 + 8 * fq;
            const int bb = (u.pm * 256) / SEQ, ch0 = ((u.pm * 256) % SEQ + wr * 64) >> 6;
            const f32x4 lb0 = *(const f32x4*)(lbv + h * 128 + kb), lb1 = *(const f32x4*)(lbv + h * 128 + kb + 4);
#pragma unroll
            for (int ai = 0; ai < 2; ++ai) {
                unsigned kep[4][4];
#pragma unroll
                for (int n = 0; n < 2; ++n) {
#pragma unroll
                    for (int ep = 0; ep < 2; ++ep) {
                        float ke2[2][4];
#pragma unroll
                        for (int z = 0; z < 2; ++z) {
                            const int e = 2 * ep + z; const float lb = n ? lb1[e] : lb0[e];
                            float f[4], c[4], tot[4];
#pragma unroll
                            for (int m = 0; m < 4; ++m) { const float fl = acc[ai][1][m][n][e]; f[m] = lb + (1.0f - lb) * __builtin_amdgcn_rcpf(1.0f + __builtin_amdgcn_exp2f(-1.4426950408889634f * fl)); const float lf = __logf(f[m]); c[m] = scan16(lf); tot[m] = rowsum16(lf); }
                            const float alast = (tot[0] + tot[1]) + (tot[2] + tot[3]); const float eal = __expf(alast);
                            float pre = 0.f;
#pragma unroll
                            for (int m = 0; m < 4; ++m) { const float A = c[m] + pre; pre += tot[m]; const float q = acc[ai][0][m][n][e]; const float kk = 1.0f - f[m];
                                acc[ai][0][m][n][e] = q * __builtin_amdgcn_rcpf(1.0f + __builtin_amdgcn_exp2f(-1.4426950408889634f * q)) * __expf(A);
                                const float kd = kk * __expf(-A); acc[ai][1][m][n][e] = kd; ke2[z][m] = kd * eal; }
                            if (fr == 0) DEC[((size_t)(bb * 4 + h) * 64 + ch0 + 2 * ai) * 128 + kb + 4 * n + e] = eal;
                        }
#pragma unroll
                        for (int m = 0; m < 4; ++m) kep[m][2 * n + ep] = cvt_pk_bf16(ke2[0][m], ke2[1][m]);
                    }
                }
#pragma unroll
                for (int m = 0; m < 4; ++m) *(u32x4*)(KE + (size_t)(row0 + ai * 128 + m * 16) * 512 + h * 128 + kb) = (u32x4){kep[m][0], kep[m][1], kep[m][2], kep[m][3]};
            }
        }
        const float sc = u.pn < 2 ? scale0 : 1.0f;
#pragma unroll
        for (int ai = 0; ai < 2; ++ai)
#pragma unroll
            for (int m = 0; m < 4; ++m) { bf16_t* rowp = O + (size_t)(row0 + ai * 128 + m * 16) * INC + col0;
#pragma unroll
                for (int bj = 0; bj < 2; ++bj) { const f32x4 v0 = acc[ai][bj][m][0] * sc, v1 = acc[ai][bj][m][1] * sc;
                    u32x4 w; w.x = cvt_pk_bf16(v0[0], v0[1]); w.y = cvt_pk_bf16(v0[2], v0[3]); w.z = cvt_pk_bf16(v1[0], v1[1]); w.w = cvt_pk_bf16(v1[2], v1[3]);
                    *(u32x4*)(rowp + bj * 128) = w; } }
        return false;
    }
};
struct EpiUp {
    static constexpr bool PERM = true;
    const bf16_t* proj; bf16_t* O;
    __device__ __forceinline__ bool operator()(f32x4 (&acc)[2][2][4][2], const Unit& u, int wr, int wc, int fr, int fq) const {
        const int row0 = u.pm * 256 + wr * 64 + fr, col0 = u.pn * 256 + wc * 32 + 8 * fq;
#pragma unroll
        for (int ai = 0; ai < 2; ++ai)
#pragma unroll
            for (int m = 0; m < 4; ++m) { const size_t row = (size_t)(row0 + ai * 128 + m * 16);
#pragma unroll
                for (int bj = 0; bj < 2; ++bj) {
                    const int col = col0 + bj * 128;
                    const u32x4 gh = *(const u32x4*)(proj + row * INC + C_GHGATE + col);
                    float sh[8];
#pragma unroll
                    for (int j = 0; j < 4; ++j) { sh[2 * j] = 1.0f + __builtin_amdgcn_exp2f(-1.4426950408889634f * bf2f(gh[j] & 0xffffu)); sh[2 * j + 1] = 1.0f + __builtin_amdgcn_exp2f(-1.4426950408889634f * bf2f(gh[j] >> 16)); }
                    if (u.aux == 0) {
                        const u32x4 gd = *(const u32x4*)(proj + row * INC + C_GDA + col);
#pragma unroll
                        for (int j = 0; j < 4; ++j) {
                            const float d0 = 1.0f + __builtin_amdgcn_exp2f(-1.4426950408889634f * bf2f(gd[j] & 0xffffu)), d1 = 1.0f + __builtin_amdgcn_exp2f(-1.4426950408889634f * bf2f(gd[j] >> 16));
                            const float r0 = sh[2 * j] * __builtin_amdgcn_rcpf(d0), r1 = sh[2 * j + 1] * __builtin_amdgcn_rcpf(d1);
                            if (j < 2) { acc[ai][bj][m][0][2 * j] *= r0; acc[ai][bj][m][0][2 * j + 1] *= r1; }
                            else { acc[ai][bj][m][1][2 * j - 4] *= r0; acc[ai][bj][m][1][2 * j - 3] *= r1; }
                        }
                    } else {
                        const f32x4 v0 = acc[ai][bj][m][0], v1 = acc[ai][bj][m][1];
#pragma unroll
                        for (int j = 0; j < 8; ++j) sh[j] = __builtin_amdgcn_rcpf(sh[j]);
                        u32x4 w; w.x = cvt_pk_bf16(v0[0] * sh[0], v0[1] * sh[1]); w.y = cvt_pk_bf16(v0[2] * sh[2], v0[3] * sh[3]);
                        w.z = cvt_pk_bf16(v1[0] * sh[4], v1[1] * sh[5]); w.w = cvt_pk_bf16(v1[2] * sh[6], v1[3] * sh[7]);
                        *(u32x4*)(O + row * D + col) = w;
                    }
                } }
        return u.aux == 0;
    }
};
struct EpiOut {
    static constexpr bool PERM = true;
    const float* x; const float* mod; bf16_t* O;
    __device__ __forceinline__ bool operator()(f32x4 (&acc)[2][2][4][2], const Unit& u, int wr, int wc, int fr, int fq) const {
        const int row0 = u.pm * 256 + wr * 64 + fr, col0 = u.pn * 256 + wc * 32 + 8 * fq;
        const int b = (u.pm * 256) / SEQ;
        f32x4 gt[2][2];
#pragma unroll
        for (int bj = 0; bj < 2; ++bj)
#pragma unroll
            for (int n = 0; n < 2; ++n) gt[bj][n] = *(const f32x4*)(mod + b * 6144 + 2048 + col0 + bj * 128 + n * 4);
#pragma unroll
        for (int ai = 0; ai < 2; ++ai)
#pragma unroll
            for (int m = 0; m < 4; ++m) { const size_t off = (size_t)(row0 + ai * 128 + m * 16) * D + col0;
#pragma unroll
                for (int bj = 0; bj < 2; ++bj) { const f32x4 x0 = *(const f32x4*)(x + off + bj * 128), x1 = *(const f32x4*)(x + off + bj * 128 + 4);
                    const f32x4 v0 = x0 + gt[bj][0] * acc[ai][bj][m][0], v1 = x1 + gt[bj][1] * acc[ai][bj][m][1];
                    u32x4 w; w.x = cvt_pk_bf16(v0[0], v0[1]); w.y = cvt_pk_bf16(v0[2], v0[3]); w.z = cvt_pk_bf16(v1[0], v1[1]); w.w = cvt_pk_bf16(v1[2], v1[3]);
                    *(u32x4*)(O + off + bj * 128) = w; } }
        return false;
    }
};
struct EpiMoe1 {
    static constexpr bool PERM = true;
    bf16_t* O; unsigned* done;
    __device__ __forceinline__ bool operator()(f32x4 (&acc)[2][2][4][2], const Unit& u, int wr, int wc, int fr, int fq) const {
        const int row0 = u.pm * 256 + wr * 64 + fr, col0 = u.pn * 128 + wc * 32 + 8 * fq;
#pragma unroll
        for (int ai = 0; ai < 2; ++ai)
#pragma unroll
            for (int m = 0; m < 4; ++m) { bf16_t* rowp = O + (size_t)(row0 + ai * 128 + m * 16) * DEXP + col0;
                float h[8];
#pragma unroll
                for (int n = 0; n < 2; ++n)
#pragma unroll
                    for (int e = 0; e < 4; ++e) { const float x_ = acc[ai][0][m][n][e]; h[n * 4 + e] = x_ * __builtin_amdgcn_rcpf(1.0f + __builtin_amdgcn_exp2f(-1.4426950408889634f * x_)) * acc[ai][1][m][n][e]; }
                u32x4 w; w.x = cvt_pk_bf16(h[0], h[1]); w.y = cvt_pk_bf16(h[2], h[3]); w.z = cvt_pk_bf16(h[4], h[5]); w.w = cvt_pk_bf16(h[6], h[7]);
                asm volatile("global_store_dwordx4 %0, %1, off sc1\n\ts_nop 1" :: "v"(rowp), "v"(w) : "memory"); }
        asm volatile("s_waitcnt vmcnt(0)" ::: "memory");
        if ((threadIdx.x & 63) == 0) __hip_atomic_fetch_add(done + 16 * u.pm, 1u, __ATOMIC_RELAXED, __HIP_MEMORY_SCOPE_AGENT);
        return false;
    }
};

struct Frame { LAS unsigned char* lds; int tid, lane, wave, G, bid; };

__device__ __forceinline__ void transpose_item(const float* Wsrc, int ldw, bf16_t* dst, int ldd, LAS float* scr, int lane) {
#pragma unroll 8
    for (int i = 0; i < 32; ++i) { const int kk = 2 * i + (lane >> 5); scr[kk * 33 + (lane & 31)] = __builtin_nontemporal_load(Wsrc + (size_t)kk * ldw + (lane & 31)); }
    asm volatile("s_waitcnt lgkmcnt(0)" ::: "memory");
    const int c = lane & 7;
#pragma unroll
    for (int j = 0; j < 4; ++j) { const int n = (lane >> 3) + 8 * j; const LAS float* s = scr + (8 * c) * 33 + n;
        u32x4 o; o.x = pk2(s[0 * 33], s[1 * 33]); o.y = pk2(s[2 * 33], s[3 * 33]); o.z = pk2(s[4 * 33], s[5 * 33]); o.w = pk2(s[6 * 33], s[7 * 33]);
        *(u32x4*)(dst + (size_t)n * ldd + 8 * c) = o; }
    asm volatile("s_waitcnt lgkmcnt(0)" ::: "memory");
}
__device__ __forceinline__ void transpose_matrix(const Frame& F, const float* W, int K, int N, bf16_t* WT) {
    LAS float* scr = (LAS float*)(F.lds + F.wave * 8448);
    const int gw = F.bid * NWAVES + F.wave, NGW = F.G * NWAVES, nblk = N / 32, items = (K / 64) * nblk;
    for (int it = gw; it < items; it += NGW) { const int kb = it / nblk, nb = it % nblk;
        transpose_item(W + (size_t)(64 * kb) * N + 32 * nb, N, WT + (size_t)(32 * nb) * K + 64 * kb, K, scr, F.lane); }
}

__device__ __forceinline__ void phase0(const Frame& F, const Args& a) {
    unsigned char* ws = a.ws;
    {
        float* modp = (float*)(ws + WS_MODP);
        const float* c = a.in[I_C]; const float* wada = a.in[I_WADA];
        LAS float* cs = (LAS float*)(F.lds + 72 * 1024);
        for (int i = F.tid; i < 4 * D; i += NTHR) cs[i] = siluf_(c[i]);
        __syncthreads();
        for (int wt = F.bid + 256 * F.wave; wt < 384; wt += 256 * NWAVES) {
            if (F.G != 256) break;
            const int ks = wt / 24, jw = wt % 24, j = jw * 256 + F.lane * 4;
            f32x4 s[4] = {{0, 0, 0, 0}, {0, 0, 0, 0}, {0, 0, 0, 0}, {0, 0, 0, 0}};
#pragma unroll 8
            for (int k = ks * 64; k < ks * 64 + 64; ++k) {
                const f32x4 w = *(const f32x4*)(wada + (size_t)k * 6144 + j);
#pragma unroll
                for (int b = 0; b < 4; ++b) s[b] += w * cs[b * D + k];
            }
#pragma unroll
            for (int b = 0; b < 4; ++b) *(f32x4*)(modp + ((size_t)ks * 4 + b) * 6144 + j) = s[b];
        }
        if (F.G != 256) {
            const int gw = F.bid * NWAVES + F.wave, NGW = F.G * NWAVES;
            for (int wt = gw; wt < 384; wt += NGW) {
                const int ks = wt / 24, jw = wt % 24, j = jw * 256 + F.lane * 4;
                f32x4 s[4] = {{0, 0, 0, 0}, {0, 0, 0, 0}, {0, 0, 0, 0}, {0, 0, 0, 0}};
                for (int k = ks * 64; k < ks * 64 + 64; ++k) {
                    const f32x4 w = *(const f32x4*)(wada + (size_t)k * 6144 + j);
#pragma unroll
                    for (int b = 0; b < 4; ++b) { const float cv = siluf_(c[b * D + k]); s[b] += w * cv; }
                }
#pragma unroll
                for (int b = 0; b < 4; ++b) *(f32x4*)(modp + ((size_t)ks * 4 + b) * 6144 + j) = s[b];
            }
        }
    }
    if (F.bid == 0) {
        float* sm = (float*)(ws + WS_SMALL);
        if (F.tid == 0) {
            float s1 = 0.f, s2 = 0.f;
            for (int i = 0; i < 64; ++i) { s1 += a.in[I_LQ1][i] * a.in[I_LK1][i]; s2 += a.in[I_LQ2][i] * a.in[I_LK2][i]; }
            sm[0] = expf(s1) - expf(s2) + 0.2f;
        }
        { const float l0 = a.in[I_LBL][F.tid], l1 = a.in[I_LBL][512 + F.tid]; const float mx = fmaxf(l0, l1);
          const float e0 = expf(l0 - mx), e1 = expf(l1 - mx); sm[16 + F.tid] = e0 / (e0 + e1); }
    }
}
__device__ __forceinline__ void moe_weight_convert(const Frame& F, const Args& a) {
    LAS float* scr = (LAS float*)(F.lds + F.wave * 8448);
    const int gw = F.bid * NWAVES + F.wave, NGW = F.G * NWAVES;
    bf16_t* w13 = (bf16_t*)(a.ws + WS_W13); bf16_t* w2t = (bf16_t*)(a.ws + WS_W2);
    for (int it = gw; it < 2 * NEXP * 256; it += NGW) {
        const int which = it / (NEXP * 256), r = it % (NEXP * 256), e = r >> 8, kb = (r >> 4) & 15, nb = r & 15, n0 = 32 * nb;
        const float* W = a.in[which ? I_W3 : I_W1] + (size_t)e * 1024 * 512;
        const int drow = 256 * (n0 >> 7) + (which ? 128 : 0) + (n0 & 127);
        transpose_item(W + (size_t)(64 * kb) * 512 + n0, 512, w13 + ((size_t)e * 1024 + drow) * 1024 + 64 * kb, 1024, scr, F.lane);
    }
    for (int it = gw; it < NEXP * 256; it += NGW) {
        const int e = it >> 8, kb = (it >> 5) & 7, nb = it & 31;
        const float* W = a.in[I_W2] + (size_t)e * 512 * 1024;
        transpose_item(W + (size_t)(64 * kb) * 1024 + 32 * nb, 1024, w2t + ((size_t)e * 1024 + 32 * nb) * 512 + 64 * kb, 512, scr, F.lane);
    }
}

__device__ __forceinline__ void dense_weight_convert(const Frame& F, const Args& a) {
    unsigned char* ws = a.ws;
    {
        LAS float* scr = (LAS float*)(F.lds + F.wave * 8448);
        const int gw = F.bid * NWAVES + F.wave, NGW = F.G * NWAVES, nblk = INC / 32, items = (D / 64) * nblk;
        bf16_t* WT = (bf16_t*)(ws + WS_WIN);
        for (int it = gw; it < items; it += NGW) { const int kb = it / nblk, n0 = 32 * (it % nblk); int dr = n0;
            if (n0 >= C_QHG && n0 < C_FHG) dr = C_HGT + 256 * ((n0 - C_QHG) >> 7) + ((n0 - C_QHG) & 127);
            else if (n0 >= C_FHG && n0 < C_IHG) dr = C_HGT + 256 * ((n0 - C_FHG) >> 7) + 128 + ((n0 - C_FHG) & 127);
            transpose_item(a.in[I_WIN] + (size_t)(64 * kb) * INC + n0, INC, WT + (size_t)dr * D + 64 * kb, D, scr, F.lane); }
    }
    transpose_matrix(F, a.in[I_WUPDA], 512, D, (bf16_t*)(ws + WS_WUPDA));
    transpose_matrix(F, a.in[I_WUPHG], 512, D, (bf16_t*)(ws + WS_WUPHG));
    transpose_matrix(F, a.in[I_WOUT], D, D, (bf16_t*)(ws + WS_WOUT));
}
__device__ __forceinline__ void phase1(const Frame& F, const Args& a) {
    const float* modp = (const float*)(a.ws + WS_MODP); float* mod = (float*)(a.ws + WS_MOD);
    for (int i = F.bid * NTHR + F.tid; i < 4 * 6144; i += F.G * NTHR) {
        float s = a.in[I_BADA][i % 6144];
        for (int ks = 0; ks < 16; ++ks) s += modp[(size_t)ks * 4 * 6144 + i];
        mod[i] = s;
    }
    LAS float* Gs = (LAS float*)F.lds;
    LAS float* Ss = Gs + 1024;
    bf16_t* H = (bf16_t*)(a.ws + WS_ACT);
    const int rows_per_blk = T / F.G;
    const int r0 = F.bid * rows_per_blk, b = r0 / SEQ;
    for (int k = F.tid; k < 1024; k += NTHR) {
        float sh = a.in[I_BADA][k], sc = a.in[I_BADA][1024 + k];
        for (int ks = 0; ks < 16; ++ks) { sh += modp[((size_t)ks * 4 + b) * 6144 + k]; sc += modp[((size_t)ks * 4 + b) * 6144 + 1024 + k]; }
        Gs[k] = a.in[I_N1G][k] * (1.0f + sc); Ss[k] = sh;
    }
    __syncthreads();
    for (int r = r0 + F.wave; r < r0 + rows_per_blk; r += NWAVES) {
        const f32x4* xr = (const f32x4*)(a.in[I_X] + (size_t)r * D) + F.lane;
        f32x4 v[4]; float s = 0.f;
#pragma unroll
        for (int j = 0; j < 4; ++j) { v[j] = xr[64 * j]; s += (v[j].x * v[j].x + v[j].y * v[j].y) + (v[j].z * v[j].z + v[j].w * v[j].w); }
        const float rs = rsqrtf(wave_sum(s) * (1.0f / D) + EPS);
        unsigned long long* o8 = (unsigned long long*)(H + (size_t)r * D) + F.lane;
#pragma unroll
        for (int j = 0; j < 4; ++j) { const f32x4 g = *(const LAS f32x4*)(Gs + 256 * j + 4 * F.lane), sh = *(const LAS f32x4*)(Ss + 256 * j + 4 * F.lane);
            const f32x4 h = v[j] * rs * g + sh;
            o8[64 * j] = (unsigned long long)pk2(h.x, h.y) | ((unsigned long long)pk2(h.z, h.w) << 32); }
    }
}

namespace attn_body {
using s16x4=__attribute__((ext_vector_type(4)))short;
using f32x16=__attribute__((ext_vector_type(16)))float;
constexpr int NW=8,QBLK=32,QB=QBLK*NW,KVBLK=64,NQB=SEQ/QB;
constexpr int PIN=INC, POUT=1024;
__device__ __forceinline__ int crow(int r,int hi){return (r&3)+8*(r>>2)+4*hi;}
#define SBAR() __builtin_amdgcn_sched_barrier(0)
__device__ __forceinline__ void bmask(f32x16&p0,f32x16&p1,int jb,int wch,int il,int hi,float s2x2){
  if(jb>wch){
    #pragma unroll
    for(int r=0;r<16;++r){p0[r]=-INFINITY;p1[r]=-INFINITY;}
  } else if(jb==wch){
    float fb=(float)(4*hi-il); asm volatile("":"+v"(fb));
    #pragma unroll
    for(int r=0;r<16;++r){const float c=(float)((r&3)+8*(r>>2)); p0[r]-=s2x2*__builtin_fmaxf(fb+c,0.f); p1[r]-=s2x2*__builtin_fmaxf(fb+(c+32.f),0.f);}
  }
}
constexpr int NSLOT=3, SLOTB=8192, VSLOTB=16384;
constexpr int LDS_K=0, LDS_V=NSLOT*SLOTB, LDS_WS=LDS_V+NSLOT*VSLOTB, LDS_OST=LDS_WS+NW*64*4, ATT_LDS_BYTES=LDS_OST+NW*8192;
constexpr float C2=0.125f*1.4426950408889634f;
__device__ __forceinline__ void glds16(const void*gsrc,unsigned lds_dst){unsigned keep;
  asm volatile("s_mov_b32 %0, m0\n\ts_mov_b32 m0, %2\n\ts_nop 0\n\tglobal_load_lds_dwordx4 %1, off\n\ts_mov_b32 m0, %0":"=&s"(keep):"v"(gsrc),"s"(lds_dst):"memory");}
__device__ __forceinline__ float max3f(float a,float b,float c){float r;asm("v_max3_f32 %0, %1, %2, %3":"=v"(r):"v"(a),"v"(b),"v"(c));return r;}
__device__ __forceinline__ float max2f(float a,float b){float r;asm("v_max_f32_e32 %0, %1, %2":"=v"(r):"v"(a),"v"(b));return r;}
__device__ __forceinline__ float fadd_s(float a,float b){float r;asm("v_add_f32_e32 %0, %1, %2":"=v"(r):"v"(a),"v"(b));return r;}
__device__ __forceinline__ float fsub_s(float a,float b){float r;asm("v_sub_f32_e32 %0, %1, %2":"=v"(r):"v"(a),"v"(b));return r;}
typedef float f32x2_t __attribute__((ext_vector_type(2))); typedef __bf16 bf16x2_t __attribute__((ext_vector_type(2)));
__device__ __forceinline__ unsigned cvtpk_s(float lo,float hi){f32x2_t v={lo,hi};bf16x2_t b=__builtin_convertvector(v,bf16x2_t);return __builtin_bit_cast(unsigned,b);}
#define WAIT_BAR(N) asm volatile("s_waitcnt vmcnt(" #N ") lgkmcnt(0)\n\ts_barrier":::"memory")

__device__ __forceinline__ void qkt(f32x16&p0,f32x16&p1,const char*Kslot,const bf16x8*qr,const f32x16&c0,const f32x16&c1,int r32,int hi){
  const char*kb=Kslot+hi*1024+r32*16;
  #pragma unroll
  for(int d0=0;d0<4;++d0){
    const bf16x8 b0=*reinterpret_cast<const bf16x8*>(kb+d0*2048);
    const bf16x8 b1=*reinterpret_cast<const bf16x8*>(kb+d0*2048+512);
    if(d0==0){p0=__builtin_amdgcn_mfma_f32_32x32x16_bf16(b0,qr[0],c0,0,0,0);p1=__builtin_amdgcn_mfma_f32_32x32x16_bf16(b1,qr[0],c1,0,0,0);}
    else{p0=__builtin_amdgcn_mfma_f32_32x32x16_bf16(b0,qr[d0],p0,0,0,0);p1=__builtin_amdgcn_mfma_f32_32x32x16_bf16(b1,qr[d0],p1,0,0,0);}}
}
typedef __attribute__((address_space(3))) const char* lds_cptr;
typedef short v4i16_t __attribute__((ext_vector_type(4)));
__device__ __forceinline__ void kload8(bf16x8*kf,lds_cptr kp){
  kf[0]=*(const __attribute__((address_space(3))) bf16x8*)(kp);      kf[1]=*(const __attribute__((address_space(3))) bf16x8*)(kp+512);
  kf[2]=*(const __attribute__((address_space(3))) bf16x8*)(kp+2048); kf[3]=*(const __attribute__((address_space(3))) bf16x8*)(kp+2560);
  kf[4]=*(const __attribute__((address_space(3))) bf16x8*)(kp+4096); kf[5]=*(const __attribute__((address_space(3))) bf16x8*)(kp+4608);
  kf[6]=*(const __attribute__((address_space(3))) bf16x8*)(kp+6144); kf[7]=*(const __attribute__((address_space(3))) bf16x8*)(kp+6656);
}
__device__ __forceinline__ void kload2(bf16x8*kf,lds_cptr kp,int j){ kf[2*j]=*(const __attribute__((address_space(3))) bf16x8*)(kp+j*2048); kf[2*j+1]=*(const __attribute__((address_space(3))) bf16x8*)(kp+j*2048+512); }
__device__ __forceinline__ s16x4 vtr(lds_cptr p){ return __builtin_bit_cast(s16x4,__builtin_amdgcn_ds_read_tr16_b64_v4i16((__attribute__((address_space(3))) v4i16_t*)p)); }
__device__ __forceinline__ float rowmax(const f32x16&p0,const f32x16&p1){
  float a=max3f(p0[0],p0[1],p1[0]),b=max3f(p0[2],p0[3],p1[1]);a=max3f(a,p1[2],p1[3]);
  #pragma unroll
  for(int r=4;r<16;r+=4){a=max3f(a,p0[r],p0[r+1]);b=max3f(b,p0[r+2],p0[r+3]);a=max3f(a,p1[r],p1[r+1]);b=max3f(b,p1[r+2],p1[r+3]);}
  const float m=max2f(a,b);
  auto rr=__builtin_amdgcn_permlane32_swap(__float_as_uint(m),__float_as_uint(m),false,false);
  return max2f(__uint_as_float(rr[0]),__uint_as_float(rr[1]));
}
__device__ __forceinline__ void pv(f32x16*o,int vb,bf16x8 pa0,bf16x8 pa1,bf16x8 pa2,bf16x8 pa3){
  #pragma unroll
  for(int d0=0;d0<4;++d0){s16x4 lo[4],hi[4];
    #pragma unroll
    for(int ks=0;ks<4;++ks){
      asm volatile("ds_read_b64_tr_b16 %0,%1 offset:%c2":"=&v"(lo[ks]):"v"(vb),"i"(d0*4096+ks*1024):"memory");
      asm volatile("ds_read_b64_tr_b16 %0,%1 offset:%c2":"=&v"(hi[ks]):"v"(vb),"i"(d0*4096+ks*1024+512):"memory");}
    asm volatile("s_waitcnt lgkmcnt(0)":::"memory");SBAR();
    #define PK(k) (bf16x8){lo[k][0],lo[k][1],lo[k][2],lo[k][3],hi[k][0],hi[k][1],hi[k][2],hi[k][3]}
    o[d0]=__builtin_amdgcn_mfma_f32_32x32x16_bf16(pa0,PK(0),o[d0],0,0,0);
    o[d0]=__builtin_amdgcn_mfma_f32_32x32x16_bf16(pa1,PK(1),o[d0],0,0,0);
    o[d0]=__builtin_amdgcn_mfma_f32_32x32x16_bf16(pa2,PK(2),o[d0],0,0,0);
    o[d0]=__builtin_amdgcn_mfma_f32_32x32x16_bf16(pa3,PK(3),o[d0],0,0,0);
    #undef PK
  }
}
#define ATTN_STORE16(p,v) (*(u32x4*)(p)=(v))
template<int THRL> __device__ __forceinline__ void attn_unit(int qb,const bf16_t*Qb,const bf16_t*__restrict__ Kh,const bf16_t*__restrict__ Vh,bf16_t*Ob,float slope2,char*shm){
  const int wid=__builtin_amdgcn_readfirstlane(threadIdx.x>>6); const int lane=lane_now(),r32=lane&31,hi=lane>>5;
  const int q0=qb*QB;
  const bf16_t*Qw=Qb+(long)(q0+wid*QBLK)*PIN;
  const unsigned lds0=(unsigned)(uintptr_t)shm;
  float*wsf=(float*)(shm+LDS_WS)+wid*64;
  const bf16_t*ksrc=Kh+(long)lane*PIN+wid*8;
  const bf16_t*vsrc=Vh+(long)(16*(wid&3)+(lane>>2))*PIN+(wid>>2)*32+(lane&3)*8;
  const unsigned kdst=lds0+LDS_K+wid*1024, vdst=lds0+LDS_V+(wid>>2)*4096+(wid&3)*1024;
  #define DMA_K(t,slot) glds16(ksrc+(long)(t)*KVBLK*PIN,(unsigned)__builtin_amdgcn_readfirstlane(kdst+(slot)))
  #define DMA_V(t,slot) do{ glds16(vsrc+(long)(t)*KVBLK*PIN,(unsigned)__builtin_amdgcn_readfirstlane(vdst+2*(slot))); glds16(vsrc+(long)(t)*KVBLK*PIN+64,(unsigned)__builtin_amdgcn_readfirstlane(vdst+2*(slot)+8192)); }while(0)
  const int vb0=(int)(lds0+LDS_V)+((lane>>4)&1)*32+(lane&3)*8+(4*hi+((lane&15)>>2))*64;
  const char*Kbase=shm+LDS_K; bf16x8 kf[8];
  const lds_cptr shm3=(lds_cptr)shm; const lds_cptr kp0=shm3+LDS_K+hi*1024+r32*16; const lds_cptr vp0=shm3+LDS_V+((lane>>4)&1)*32+(lane&3)*8+(4*hi+((lane&15)>>2))*64;
  const int NT=(q0+QB)/KVBLK;
  DMA_K(0,0);DMA_V(0,0);DMA_K(1,SLOTB);
  bf16x8 qr[4];
  #pragma unroll
  for(int d0=0;d0<4;++d0)qr[d0]=*reinterpret_cast<const bf16x8*>(&Qw[(long)r32*PIN+d0*16+hi*8]);
  float mhat=0.f,l_reg=0.f;f32x16 o[4];o[0]=f32x16{};o[1]=f32x16{};o[2]=f32x16{};o[3]=f32x16{};
  const float s64=slope2*64.f, s32=slope2*32.f, s2x2=2.f*slope2, s4hi=slope2*4.f*(float)hi;
  const int wch=wid>>1, il=32*(wid&1)+r32;
  #define CMASK(P0,P1,t) do{int jb_=(t)-(NT-4); if(jb_>=0)bmask(P0,P1,jb_,wch,il,hi,s2x2);}while(0)
  #define CINIT0(C0,t) do{ const float bt_=s64*(float)((t)-NT)-mhat+s4hi; _Pragma("unroll") for(int r=0;r<16;++r){C0[r]=__builtin_fmaf(slope2,(float)((r&3)+8*(r>>2)),bt_);} }while(0)
  #define CINIT1(C1,t) do{ const float bu_=s64*(float)((t)-NT)-mhat+s4hi+s32; _Pragma("unroll") for(int r=0;r<16;++r){C1[r]=__builtin_fmaf(slope2,(float)((r&3)+8*(r>>2)),bu_);} }while(0)
  bool resc=false;
  #define START(P0,P1) do{ const float rm=rowmax(P0,P1); resc=false; \
    { const float dl=rm; mhat=fadd_s(mhat,dl); \
      _Pragma("unroll") for(int r=0;r<16;++r){P0[r]=fsub_s(P0[r],dl);P1[r]=fsub_s(P1[r],dl);} } \
    _Pragma("unroll") for(int r=0;r<16;++r)P0[r]=__builtin_amdgcn_exp2f(P0[r]); }while(0)
  #define RESC() do{ if(resc){ asm volatile("s_waitcnt lgkmcnt(0)":::"memory"); \
      _Pragma("unroll") for(int d_=0;d_<4;++d_) _Pragma("unroll") for(int r=0;r<16;++r)o[d_][r]*=wsf[crow(r,hi)]; } }while(0)
  f32x16 cS0,cS1;
  u32x4 pwa0,pwa1,pwa2,pwa3,pwb0,pwb1,pwb2,pwb3;
  int sl_prev=0,sl_cur=0,sl_next=SLOTB;
  #define ROT() do{sl_prev=sl_cur;sl_cur=sl_next;sl_next=(sl_next==(NSLOT-1)*SLOTB)?0:sl_next+SLOTB;}while(0)
  #define PKW(P,B) cvtpk_s(P[B],P[B+1])
  DMA_K(2,2*SLOTB);
  WAIT_BAR(3);
  { f32x16 c0,c1; CINIT0(c0,0); CINIT1(c1,0); qkt(cS0,cS1,Kbase,qr,c0,c1,r32,hi); }
  asm volatile("s_nop 15\n\ts_nop 7":"+v"(cS0),"+v"(cS1));CMASK(cS0,cS1,0);
  START(cS0,cS1);
  _Pragma("unroll") for(int r=0;r<16;++r)cS1[r]=__builtin_amdgcn_exp2f(cS1[r]);
  { float sacc=cS0[0]+cS0[1]; _Pragma("unroll") for(int r=2;r<16;++r)sacc+=cS0[r]; _Pragma("unroll") for(int r=0;r<16;++r)sacc+=cS1[r]; l_reg+=sacc;
    pwa0=(u32x4){PKW(cS0,0),PKW(cS0,2),PKW(cS0,4),PKW(cS0,6)};pwa1=(u32x4){PKW(cS0,8),PKW(cS0,10),PKW(cS0,12),PKW(cS0,14)};pwa2=(u32x4){PKW(cS1,0),PKW(cS1,2),PKW(cS1,4),PKW(cS1,6)};pwa3=(u32x4){PKW(cS1,8),PKW(cS1,10),PKW(cS1,12),PKW(cS1,14)}; }
  WAIT_BAR(0);
  DMA_K(3,0);DMA_V(1,SLOTB);
  ROT();
  kload8(kf,kp0+sl_cur);
  WAIT_BAR(3);
  s16x4 vlo[4],vhi[4];
  #define CAT_(a,b) a##b
  #define CAT(a,b) CAT_(a,b)
  #define PAFC(P,k) __builtin_bit_cast(bf16x8,CAT(P,k))
  #define VFR(k) (bf16x8){vlo[(k)&3][0],vlo[(k)&3][1],vlo[(k)&3][2],vlo[(k)&3][3],vhi[(k)&3][0],vhi[(k)&3][1],vhi[(k)&3][2],vhi[(k)&3][3]}
  #define VOFF(k) ((k)<8 ? (((k)&1)*4096+((k)>>1)*1024) : ((2+((k)&1))*4096+(((k)-8)>>1)*1024))
  #define PIN_(x) asm volatile("":"+v"(x))
  #define MX3(a,b,c) __builtin_fmaxf(__builtin_fmaxf((a),(b)),(c))
  #define QK(MF) do{ MF; SBAR(); }while(0)
  #define EX(v) __builtin_amdgcn_exp2f(v)
  #define VRD(k) do{ vlo[(k)&3]=vtr(vp_+VOFF(k)); vhi[(k)&3]=vtr(vp_+(VOFF(k)+512)); }while(0)
  #define VNX(k) do{ if((k)+4<16){ VRD((k)+4); } SBAR(); }while(0)
  #define GAPB3(MF,X,B,PW,J) do{ MF; X[B]=EX(X[B]); X[B+1]=EX(X[B+1]); sacc+=X[B]; sacc+=X[B+1]; PW[J]=cvtpk_s(X[B],X[B+1]); PIN_(X); PIN_(sacc); PIN_(PW); SBAR(); }while(0)
  #define KRD(G,j) do{ if(G){ kload2(kf,kp0+sl_next,j); SBAR(); } }while(0)
  #define STEP(PC,PN,t,GK,GV,GL) do{ SBAR(); \
    CINIT0(cS0,t); SBAR(); \
    const lds_cptr vp_=vp0+2*sl_prev; \
    VRD(0); SBAR(); QK(cS0=__builtin_amdgcn_mfma_f32_32x32x16_bf16(kf[0],qr[0],cS0,0,0,0)); \
    CINIT1(cS1,t); VRD(1); SBAR(); QK(cS1=__builtin_amdgcn_mfma_f32_32x32x16_bf16(kf[1],qr[0],cS1,0,0,0)); \
    VRD(2); SBAR(); QK(cS0=__builtin_amdgcn_mfma_f32_32x32x16_bf16(kf[2],qr[1],cS0,0,0,0)); \
    VRD(3); SBAR(); QK(cS1=__builtin_amdgcn_mfma_f32_32x32x16_bf16(kf[3],qr[1],cS1,0,0,0)); \
    QK(cS0=__builtin_amdgcn_mfma_f32_32x32x16_bf16(kf[4],qr[2],cS0,0,0,0)); \
    QK(cS1=__builtin_amdgcn_mfma_f32_32x32x16_bf16(kf[5],qr[2],cS1,0,0,0)); \
    QK(cS0=__builtin_amdgcn_mfma_f32_32x32x16_bf16(kf[6],qr[3],cS0,0,0,0)); \
    QK(cS1=__builtin_amdgcn_mfma_f32_32x32x16_bf16(kf[7],qr[3],cS1,0,0,0)); \
    if(GK){DMA_K((t)+3,sl_cur);} if(GV){DMA_V((t)+1,sl_next);} \
    CMASK(cS0,cS1,t); \
    { float a=MX3(cS0[0],cS0[1],cS1[0]),b=MX3(cS0[2],cS0[3],cS1[1]); a=MX3(a,cS1[2],cS1[3]); \
      _Pragma("unroll") for(int r=4;r<16;r+=4){a=MX3(a,cS0[r],cS0[r+1]);b=MX3(b,cS0[r+2],cS0[r+3]);a=MX3(a,cS1[r],cS1[r+1]);b=MX3(b,cS1[r+2],cS1[r+3]);} \
      float rm=__builtin_fmaxf(a,b); { auto rr=__builtin_amdgcn_permlane32_swap(__float_as_uint(rm),__float_as_uint(rm),false,false); rm=__builtin_fmaxf(__uint_as_float(rr[0]),__uint_as_float(rr[1])); } \
      resc=false; \
      if(__builtin_expect(__any(rm>(float)THRL),0)){ const float dl=__builtin_fmaxf(rm,0.f); mhat+=dl; \
        _Pragma("unroll") for(int r=0;r<16;++r){cS0[r]-=dl;cS1[r]-=dl;} \
        const float f=__builtin_amdgcn_exp2f(-dl); l_reg*=f; if(hi==0)wsf[r32]=f; resc=true; } } \
    SBAR(); float sacc=0.f; \
    GAPB3(o[0]=__builtin_amdgcn_mfma_f32_32x32x16_bf16(PAFC(PC,0),VFR(0),o[0],0,0,0), cS0,0, CAT(PN,0),0); VNX(0); \
    GAPB3(o[1]=__builtin_amdgcn_mfma_f32_32x32x16_bf16(PAFC(PC,0),VFR(1),o[1],0,0,0), cS0,2, CAT(PN,0),1); VNX(1); \
    KRD(GL,0); GAPB3(o[0]=__builtin_amdgcn_mfma_f32_32x32x16_bf16(PAFC(PC,1),VFR(2),o[0],0,0,0), cS0,4, CAT(PN,0),2); VNX(2); \
    KRD(GL,1); GAPB3(o[1]=__builtin_amdgcn_mfma_f32_32x32x16_bf16(PAFC(PC,1),VFR(3),o[1],0,0,0), cS0,6, CAT(PN,0),3); VNX(3); \
    KRD(GL,2); GAPB3(o[0]=__builtin_amdgcn_mfma_f32_32x32x16_bf16(PAFC(PC,2),VFR(4),o[0],0,0,0), cS0,8, CAT(PN,1),0); VNX(4); \
    KRD(GL,3); GAPB3(o[1]=__builtin_amdgcn_mfma_f32_32x32x16_bf16(PAFC(PC,2),VFR(5),o[1],0,0,0), cS0,10, CAT(PN,1),1); VNX(5); \
    GAPB3(o[0]=__builtin_amdgcn_mfma_f32_32x32x16_bf16(PAFC(PC,3),VFR(6),o[0],0,0,0), cS0,12, CAT(PN,1),2); VNX(6); \
    GAPB3(o[1]=__builtin_amdgcn_mfma_f32_32x32x16_bf16(PAFC(PC,3),VFR(7),o[1],0,0,0), cS0,14, CAT(PN,1),3); VNX(7); \
    GAPB3(o[2]=__builtin_amdgcn_mfma_f32_32x32x16_bf16(PAFC(PC,0),VFR(8),o[2],0,0,0), cS1,0, CAT(PN,2),0); VNX(8); \
    GAPB3(o[3]=__builtin_amdgcn_mfma_f32_32x32x16_bf16(PAFC(PC,0),VFR(9),o[3],0,0,0), cS1,2, CAT(PN,2),1); VNX(9); \
    GAPB3(o[2]=__builtin_amdgcn_mfma_f32_32x32x16_bf16(PAFC(PC,1),VFR(10),o[2],0,0,0), cS1,4, CAT(PN,2),2); VNX(10); \
    GAPB3(o[3]=__builtin_amdgcn_mfma_f32_32x32x16_bf16(PAFC(PC,1),VFR(11),o[3],0,0,0), cS1,6, CAT(PN,2),3); VNX(11); \
    GAPB3(o[2]=__builtin_amdgcn_mfma_f32_32x32x16_bf16(PAFC(PC,2),VFR(12),o[2],0,0,0), cS1,8, CAT(PN,3),0); VNX(12); \
    GAPB3(o[3]=__builtin_amdgcn_mfma_f32_32x32x16_bf16(PAFC(PC,2),VFR(13),o[3],0,0,0), cS1,10, CAT(PN,3),1); VNX(13); \
    GAPB3(o[2]=__builtin_amdgcn_mfma_f32_32x32x16_bf16(PAFC(PC,3),VFR(14),o[2],0,0,0), cS1,12, CAT(PN,3),2); VNX(14); \
    GAPB3(o[3]=__builtin_amdgcn_mfma_f32_32x32x16_bf16(PAFC(PC,3),VFR(15),o[3],0,0,0), cS1,14, CAT(PN,3),3); VNX(15); \
    l_reg+=sacc; \
    }while(0)
  int t=1;
  #undef CMASK
  #define CMASK(P0,P1,t) do{}while(0)
  for(;t+5<NT;t+=2){
    STEP(pwa,pwb,t,true,true,true);     WAIT_BAR(3); RESC(); ROT();
    STEP(pwb,pwa,t+1,true,true,true);   WAIT_BAR(3); RESC(); ROT();
  }
  #undef CMASK
  #define CMASK(P0,P1,t) do{int jb_=(t)-(NT-4); if(jb_>=0)bmask(P0,P1,jb_,wch,il,hi,s2x2);}while(0)
  #define ENDW(tt) do{ if((tt)+3<NT){WAIT_BAR(3);} else if((tt)+2<NT){WAIT_BAR(2);} else {WAIT_BAR(0);} }while(0)
  for(;t+1<NT;t+=2){
    STEP(pwa,pwb,t,(t+3<NT),(t+1<NT),(t+1<NT));       ENDW(t);   RESC(); ROT();
    STEP(pwb,pwa,t+1,(t+4<NT),(t+2<NT),(t+2<NT));     ENDW(t+1); RESC(); ROT();
  }
  STEP(pwa,pwb,NT-1,false,false,false); RESC();
  SBAR(); pv(o,vb0+2*sl_cur,PAFC(pwb,0),PAFC(pwb,1),PAFC(pwb,2),PAFC(pwb,3));
  #undef PKW
  #undef PAFC
  #undef CAT
  #undef CAT_
  #undef QK
  #undef GAPB3
  #undef VFR
  #undef PIN_
  #undef MX3
  #undef EX
  #undef VRD
  #undef VNX
  #undef VOFF
  #undef GAPB2
  #undef KRD
  #undef STEP
  #undef ENDW
  {auto rr=__builtin_amdgcn_permlane32_swap(__float_as_uint(l_reg),__float_as_uint(l_reg),false,false);l_reg=__uint_as_float(rr[0])+__uint_as_float(rr[1]);}
  {
    const int le=lane_now(), r32e=le&31, hie=le>>5;
    float*wsfe=(float*)(shm+LDS_WS)+wid*64;
    if(hie==0)wsfe[32+r32e]=l_reg;asm volatile("s_waitcnt lgkmcnt(0)":::"memory");
    float rli[16];
    #pragma unroll
    for(int r=0;r<16;++r)rli[r]=__builtin_amdgcn_rcpf(wsfe[32+crow(r,hie)]);
    bf16_t*Ow=Ob+(long)(q0+wid*QBLK)*POUT;
    bf16_t*stg=(bf16_t*)(shm+LDS_OST)+wid*4096;
    #pragma unroll
    for(int r=0;r<16;++r){const int orow=crow(r,hie);
      #pragma unroll
      for(int d0=0;d0<4;++d0)stg[orow*128+d0*32+r32e]=(bf16_t)f2bf(o[d0][r]*rli[r]);}
    asm volatile("s_waitcnt lgkmcnt(0)":::"memory");
    #pragma unroll
    for(int i=0;i<8;++i){const int row=i*4+(le>>4),ch=le&15; const u32x4 v=*(const u32x4*)(stg+row*128+ch*8); ATTN_STORE16(Ow+(long)row*POUT+ch*8,v);} }
  asm volatile("s_waitcnt lgkmcnt(0)\n\ts_barrier":::"memory");
  #undef DMA_K
  #undef DMA_V
  #undef CMASK
  #undef CINIT0
  #undef CINIT1
  #undef START
  #undef RESC
  #undef ROT
}
#undef SBAR
#undef WAIT_BAR
}

__device__ __forceinline__ void attn_phase(const Frame& F, const Args& a) {
    const bf16_t* proj = (const bf16_t*)(a.ws + WS_PROJ); bf16_t* OA = (bf16_t*)(a.ws + WS_OA);
    const int vcu = (F.G % 8 == 0) ? (F.bid % 8) * (F.G / 8) + F.bid / 8 : F.bid;
    for (int i = 0;; ++i) {
        int bhm, qb;
        if (F.G == 256) { if (i >= 2) break; const int s_ = vcu & 7; bhm = vcu >> 3; qb = (i == 0) ? 15 - s_ : s_; }
        else { const int u = i * F.G + F.bid; if (u >= 512) break; bhm = u >> 4; qb = 15 - (u & 15); }
        const int b = bhm >> 3, h = (bhm >> 1) & 3, map = bhm & 1;
        const bf16_t* base = proj + (size_t)b * SEQ * INC;
        const float slope2 = exp2f(-2.0f * (h + 1)) * 1.4426950408889634f;
        attn_body::attn_unit<8>(qb, base + C_QDA + h * 128 + map * 64, base + C_KDA + h * 128 + map * 64, base + C_VDA + h * 128,
                                OA + (size_t)b * SEQ * 1024 + h * 256 + map * 128, slope2, (char*)F.lds);
    }
}
__device__ __forceinline__ void attn_combine(const Frame& F, const Args& a) {
    const bf16_t* OA = (const bf16_t*)(a.ws + WS_OA); bf16_t* Y = (bf16_t*)(a.ws + WS_YDA);
    const float lam = ((const float*)(a.ws + WS_SMALL))[0];
    const float g0 = a.in[I_SUBG][2 * F.lane] * 0.8f, g1 = a.in[I_SUBG][2 * F.lane + 1] * 0.8f;
    const int gw = F.bid * NWAVES + F.wave, NGW = F.G * NWAVES;
    for (int r = gw; r < T; r += NGW) {
        const unsigned* orow = (const unsigned*)(OA + (size_t)r * 1024); unsigned* yrow = (unsigned*)(Y + (size_t)r * 512);
        unsigned w0[4], w1[4];
#pragma unroll
        for (int h = 0; h < 4; ++h) { w0[h] = orow[h * 128 + F.lane]; w1[h] = orow[h * 128 + 64 + F.lane]; }
#pragma unroll
        for (int h = 0; h < 4; ++h) {
            const float x0 = bf2f(w0[h] & 0xffffu) - lam * bf2f(w1[h] & 0xffffu), x1 = bf2f(w0[h] >> 16) - lam * bf2f(w1[h] >> 16);
            const float rs = rsqrtf(wave_sum(x0 * x0 + x1 * x1) * (1.0f / 128.0f) + EPS);
            yrow[h * 64 + F.lane] = pk2(x0 * rs * g0, x1 * rs * g1);
        }
    }
}
namespace hg {
constexpr int QP = 136;
constexpr int L_QD = 0, L_KD = 64 * QP * 2, L_V = 2 * 64 * QP * 2, L_KE = 3 * 64 * QP * 2, L_SSQ = 4 * 64 * QP * 2, L_G = L_SSQ + 512, L_ST = L_G + 64 * QP * 2;
__device__ __forceinline__ f32x4 mfma16(bf16x8 a, bf16x8 b, f32x4 c) { return __builtin_amdgcn_mfma_f32_16x16x32_bf16(a, b, c, 0, 0, 0); }
#define HG_BAR() do { asm volatile("s_waitcnt lgkmcnt(0)" ::: "memory"); __builtin_amdgcn_s_barrier(); asm volatile("" ::: "memory"); } while (0)
typedef short v4i16_t __attribute__((ext_vector_type(4)));
__device__ __forceinline__ bf16x8 tr8(const LAS unsigned char* img, int ra, int rb, int col0, int lane) {
    const int q = (lane & 15) >> 2, p = lane & 3;
    const v4i16_t lo = __builtin_amdgcn_ds_read_tr16_b64_v4i16((LAS v4i16_t*)(img + ((ra + q) * QP + col0 + 4 * p) * 2));
    const v4i16_t hi = __builtin_amdgcn_ds_read_tr16_b64_v4i16((LAS v4i16_t*)(img + ((rb + q) * QP + col0 + 4 * p) * 2));
    return (bf16x8){lo[0], lo[1], lo[2], lo[3], hi[0], hi[1], hi[2], hi[3]};
}
struct Tile { u32x4 p[2]; };
__device__ __forceinline__ void tile_load(Tile& t, const bf16_t* src, size_t pitch, int tid) {
#pragma unroll
    for (int i = 0; i < 2; ++i) { const int pc = tid + NTHR * i; t.p[i] = *(const u32x4*)(src + (size_t)(pc >> 4) * pitch + (pc & 15) * 8); }
}
__device__ __forceinline__ void tile_put(const Tile& t, LAS unsigned char* img, int tid) {
#pragma unroll
    for (int i = 0; i < 2; ++i) { const int pc = tid + NTHR * i; *(LAS u32x4*)(img + ((pc >> 4) * QP + (pc & 15) * 8) * 2) = t.p[i]; }
}
constexpr int PP = 72;
constexpr int G4_L_P = 4 * 64 * QP * 2, G4_L_DEC = G4_L_P + 64 * PP * 2, G4_L_SSQ = G4_L_DEC + 512;
struct InA { Tile qd, kd, ke, v; f32x4 dec; };
__device__ __forceinline__ void loadA(InA& r, const Frame& F, const Args& a, int bh, int n) {
    const int b = bh >> 2, h = bh & 3; const size_t t0 = (size_t)b * SEQ + n * 64;
    const bf16_t* base = (const bf16_t*)(a.ws + WS_PROJ) + t0 * INC;
    tile_load(r.qd, base + C_HGT + 256 * h, INC, F.tid); tile_load(r.kd, base + C_HGT + 256 * h + 128, INC, F.tid);
    tile_load(r.ke, (const bf16_t*)a.out + t0 * 512 + h * 128, 512, F.tid); tile_load(r.v, base + C_IHG + h * 128, INC, F.tid);
    r.dec = *(const f32x4*)((const float*)(a.ws + WS_DEC) + ((size_t)bh * 64 + n) * 128 + 4 * (F.tid & 31));
}
__device__ __forceinline__ void grp_local(const Frame& F, const Args& a, int grp) {
    const int bh = grp >> 4, n0 = 4 * (grp & 15), b = bh >> 2, h = bh & 3, w = F.wave, lane = F.lane, fr = lane & 15, fq = lane >> 4;
    for (int i = F.tid; i < 64 * PP / 2; i += NTHR) ((LAS unsigned*)(F.lds + G4_L_P))[i] = 0u;
    f32x4 S[8];
#pragma unroll
    for (int kt = 0; kt < 8; ++kt) S[kt] = (f32x4){0.f, 0.f, 0.f, 0.f};
    InA cur, nxt; loadA(cur, F, a, bh, n0);
    unsigned short yk[4][4];
#define G4_STORE(nn) do { bf16_t* yp_ = (bf16_t*)(a.ws + WS_YHG) + ((size_t)b * SEQ + (nn) * 64 + 4 * fq) * 512 + h * 128 + 16 * w + fr; \
        _Pragma("unroll") for (int tb = 0; tb < 4; ++tb) _Pragma("unroll") for (int r = 0; r < 4; ++r) yp_[(size_t)(16 * tb + r) * 512] = yk[tb][r]; } while (0)
    for (int j = 0; j < 4; ++j) {
        if (j > 0) G4_STORE(n0 + j - 1);
        loadA(nxt, F, a, bh, n0 + (j < 3 ? j + 1 : 3));
        tile_put(cur.qd, F.lds + L_QD, F.tid); tile_put(cur.kd, F.lds + L_KD, F.tid); tile_put(cur.ke, F.lds + L_KE, F.tid); tile_put(cur.v, F.lds + L_V, F.tid);
        if (F.tid < 32) *(LAS f32x4*)(F.lds + G4_L_DEC + 16 * F.tid) = cur.dec;
        HG_BAR();
#pragma unroll
        for (int rep = 0; rep < 2; ++rep) { const int pi = w + 8 * rep;
            if (pi < 10) { const int tb = pi >= 6 ? 3 : pi >= 3 ? 2 : pi >= 1 ? 1 : 0, jt = pi - (tb * (tb + 1)) / 2;
                f32x4 sc = (f32x4){0.f, 0.f, 0.f, 0.f};
#pragma unroll
                for (int ks = 0; ks < 4; ++ks) { const bf16x8 kf = *(const LAS bf16x8*)(F.lds + L_KD + ((16 * jt + fr) * QP + 32 * ks + 8 * fq) * 2);
                    const bf16x8 qf = *(const LAS bf16x8*)(F.lds + L_QD + ((16 * tb + fr) * QP + 32 * ks + 8 * fq) * 2); sc = mfma16(kf, qf, sc); }
                if (jt == tb) {
#pragma unroll
                    for (int r = 0; r < 4; ++r) if (4 * fq + r > fr) sc[r] = 0.f;
                }
                *(LAS u32x2*)(F.lds + G4_L_P + ((16 * tb + fr) * PP + 16 * jt + 4 * fq) * 2) = (u32x2){cvt_pk_bf16(sc[0], sc[1]), cvt_pk_bf16(sc[2], sc[3])}; } }
        HG_BAR();
        bf16x8 bv[2];
#pragma unroll
        for (int s2 = 0; s2 < 2; ++s2) bv[s2] = tr8(F.lds + L_V, 32 * s2 + 8 * fq, 32 * s2 + 8 * fq + 4, 16 * w, lane);
        bf16x8 Sb[4];
#pragma unroll
        for (int ks = 0; ks < 4; ++ks) { const u32x4 t = (u32x4){cvt_pk_bf16(S[2 * ks][0], S[2 * ks][1]), cvt_pk_bf16(S[2 * ks][2], S[2 * ks][3]), cvt_pk_bf16(S[2 * ks + 1][0], S[2 * ks + 1][1]), cvt_pk_bf16(S[2 * ks + 1][2], S[2 * ks + 1][3])};
            Sb[ks] = __builtin_bit_cast(bf16x8, t); }
#pragma unroll
        for (int tb = 0; tb < 4; ++tb) { f32x4 o = (f32x4){0.f, 0.f, 0.f, 0.f};
#pragma unroll
            for (int s2 = 0; s2 <= (tb >> 1); ++s2) { const bf16x8 pf = *(const LAS bf16x8*)(F.lds + G4_L_P + ((16 * tb + fr) * PP + 32 * s2 + 8 * fq) * 2); o = mfma16(pf, bv[s2], o); }
            if (j > 0) {
#pragma unroll
                for (int ks = 0; ks < 4; ++ks) { const LAS unsigned char* qrow = F.lds + L_QD + ((16 * tb + fr) * QP + 32 * ks + 4 * fq) * 2;
                    const u32x2 lo = *(const LAS u32x2*)qrow, hi = *(const LAS u32x2*)(qrow + 32);
                    const u32x4 aw = (u32x4){lo.x, lo.y, hi.x, hi.y}; o = mfma16(__builtin_bit_cast(bf16x8, aw), Sb[ks], o); } }
#pragma unroll
            for (int r = 0; r < 4; ++r) yk[tb][r] = (unsigned short)f2bf(o[r]); }
#pragma unroll
        for (int kt = 0; kt < 8; ++kt) { S[kt] = S[kt] * *(const LAS f32x4*)(F.lds + G4_L_DEC + (16 * kt + 4 * fq) * 4);
#pragma unroll
            for (int s2 = 0; s2 < 2; ++s2) S[kt] = mfma16(tr8(F.lds + L_KE, 32 * s2 + 8 * fq, 32 * s2 + 8 * fq + 4, 16 * kt, lane), bv[s2], S[kt]); }
        HG_BAR();
        cur = nxt;
    }
    G4_STORE(n0 + 3);
#undef G4_STORE
    f32x4* sg = (f32x4*)(a.ws + WS_DS) + ((size_t)grp * 64 + w * 8) * 64 + lane;
#pragma unroll
    for (int kt = 0; kt < 8; ++kt) sg[kt * 64] = S[kt];
}
__device__ __forceinline__ void grp_scan(const Frame& F, const Args& a) {
    f32x4* sg = (f32x4*)(a.ws + WS_DS); f32x4* si = sg + (size_t)256 * 4096; const float* dec = (const float*)(a.ws + WS_DEC);
    for (int gt = F.bid * NTHR + F.tid; gt < 16 * 4096; gt += F.G * NTHR) {
        const int bh = gt >> 12, slot = gt & 4095, kt = (slot >> 6) & 7, lane = slot & 63, k = 16 * kt + 4 * (lane >> 4);
        f32x4 cur = (f32x4){0.f, 0.f, 0.f, 0.f};
#pragma unroll 4
        for (int g = 0; g < 16; ++g) { const size_t gi = ((size_t)(bh * 16 + g)) * 4096 + slot;
            si[gi] = cur;
            const float* dp = dec + ((size_t)bh * 64 + 4 * g) * 128 + k;
            const f32x4 d = (*(const f32x4*)dp * *(const f32x4*)(dp + 128)) * (*(const f32x4*)(dp + 256) * *(const f32x4*)(dp + 384));
            cur = d * cur + sg[gi]; }
    }
}
struct InC { Tile qd, g, ol; f32x4 dec; };
__device__ __forceinline__ void loadC(InC& r, const Frame& F, const Args& a, int bh, int n) {
    const int b = bh >> 2, h = bh & 3; const size_t t0 = (size_t)b * SEQ + n * 64;
    const bf16_t* base = (const bf16_t*)(a.ws + WS_PROJ) + t0 * INC;
    tile_load(r.qd, base + C_HGT + 256 * h, INC, F.tid); tile_load(r.g, base + C_GHG + h * 128, INC, F.tid);
    tile_load(r.ol, (const bf16_t*)(a.ws + WS_YHG) + t0 * 512 + h * 128, 512, F.tid);
    r.dec = *(const f32x4*)((const float*)(a.ws + WS_DEC) + ((size_t)bh * 64 + n) * 128 + 4 * (F.tid & 31));
}
__device__ __forceinline__ void grp_final(const Frame& F, const Args& a, int grp) {
    const int bh = grp >> 4, n0 = 4 * (grp & 15), b = bh >> 2, h = bh & 3, w = F.wave, lane = F.lane, fr = lane & 15, fq = lane >> 4;
    f32x4 S[8];
    { const f32x4* si = (const f32x4*)(a.ws + WS_DS) + (size_t)256 * 4096 + ((size_t)grp * 64 + w * 8) * 64 + lane;
#pragma unroll
      for (int kt = 0; kt < 8; ++kt) S[kt] = si[kt * 64]; }
    const float ng = a.in[I_HGNG][16 * w + fr];
    LAS float* SSQ = (LAS float*)(F.lds + G4_L_SSQ);
    InC cur, nxt; loadC(cur, F, a, bh, n0);
    unsigned short yk[4][4];
#define G4_STORE(nn) do { bf16_t* yp_ = (bf16_t*)(a.ws + WS_YHG) + ((size_t)b * SEQ + (nn) * 64 + 4 * fq) * 512 + h * 128 + 16 * w + fr; \
        _Pragma("unroll") for (int tb = 0; tb < 4; ++tb) _Pragma("unroll") for (int r = 0; r < 4; ++r) yp_[(size_t)(16 * tb + r) * 512] = yk[tb][r]; } while (0)
    for (int j = 0; j < 4; ++j) {
        if (j > 0) G4_STORE(n0 + j - 1);
        loadC(nxt, F, a, bh, n0 + (j < 3 ? j + 1 : 3));
        tile_put(cur.qd, F.lds + L_QD, F.tid); tile_put(cur.g, F.lds + L_KD, F.tid); tile_put(cur.ol, F.lds + L_V, F.tid);
        if (F.tid < 32) *(LAS f32x4*)(F.lds + G4_L_DEC + 16 * F.tid) = cur.dec;
        HG_BAR();
        bf16x8 Sb[4];
#pragma unroll
        for (int ks = 0; ks < 4; ++ks) { const u32x4 t = (u32x4){cvt_pk_bf16(S[2 * ks][0], S[2 * ks][1]), cvt_pk_bf16(S[2 * ks][2], S[2 * ks][3]), cvt_pk_bf16(S[2 * ks + 1][0], S[2 * ks + 1][1]), cvt_pk_bf16(S[2 * ks + 1][2], S[2 * ks + 1][3])};
            Sb[ks] = __builtin_bit_cast(bf16x8, t); }
        f32x4 o[4];
#pragma unroll
        for (int tb = 0; tb < 4; ++tb) {
#pragma unroll
            for (int r = 0; r < 4; ++r) o[tb][r] = bf2f(*(const LAS unsigned short*)(F.lds + L_V + ((16 * tb + 4 * fq + r) * QP + 16 * w + fr) * 2));
#pragma unroll
            for (int ks = 0; ks < 4; ++ks) { const LAS unsigned char* qrow = F.lds + L_QD + ((16 * tb + fr) * QP + 32 * ks + 4 * fq) * 2;
                const u32x2 lo = *(const LAS u32x2*)qrow, hi = *(const LAS u32x2*)(qrow + 32);
                const u32x4 aw = (u32x4){lo.x, lo.y, hi.x, hi.y}; o[tb] = mfma16(__builtin_bit_cast(bf16x8, aw), Sb[ks], o[tb]); }
#pragma unroll
            for (int r = 0; r < 4; ++r) { const float v = scan16(o[tb][r] * o[tb][r]); if (fr == 15) SSQ[w * 64 + 16 * tb + 4 * fq + r] = v; } }
#pragma unroll
        for (int kt = 0; kt < 8; ++kt) S[kt] = S[kt] * *(const LAS f32x4*)(F.lds + G4_L_DEC + (16 * kt + 4 * fq) * 4);
        HG_BAR();
#pragma unroll
        for (int tb = 0; tb < 4; ++tb) { f32x4 tot = (f32x4){0.f, 0.f, 0.f, 0.f};
#pragma unroll
            for (int ww = 0; ww < 8; ++ww) tot += *(const LAS f32x4*)(SSQ + ww * 64 + 16 * tb + 4 * fq);
#pragma unroll
            for (int r = 0; r < 4; ++r) { const float rs = rsqrtf(tot[r] * (1.0f / 128.0f) + EPS); const float g = bf2f(*(const LAS unsigned short*)(F.lds + L_KD + ((16 * tb + 4 * fq + r) * QP + 16 * w + fr) * 2));
                yk[tb][r] = (unsigned short)f2bf(o[tb][r] * rs * ng * g * __builtin_amdgcn_rcpf(1.0f + __builtin_amdgcn_exp2f(-1.4426950408889634f * g))); } }
        HG_BAR();
        cur = nxt;
    }
    G4_STORE(n0 + 3);
#undef G4_STORE
}
#undef HG_BAR
}

__device__ __forceinline__ float rs4(float a0, float a1, float a2, float a3, int lane) {
    const bool hi = (lane & 32) != 0;
    const float s0 = hi ? a0 : a2, s1 = hi ? a1 : a3;
    const float k0 = (hi ? a2 : a0) + __shfl_xor(s0, 32), k1 = (hi ? a3 : a1) + __shfl_xor(s1, 32);
    const bool b4 = (lane & 16) != 0;
    const float sd = b4 ? k0 : k1;
    float k = (b4 ? k1 : k0) + __shfl_xor(sd, 16);
    k += __shfl_xor(k, 8); k += __shfl_xor(k, 4); k += __shfl_xor(k, 2); k += __shfl_xor(k, 1);
    return k;
}
__device__ __forceinline__ void phase_router(const Frame& F, const Args& a) {
    constexpr int AP = 1032;
    LAS bf16_t* AH = (LAS bf16_t*)F.lds;
    LAS bf16_t* AL = AH + 16 * AP;
    LAS float* PART = (LAS float*)(F.lds + 2 * 16 * AP * 2);
    LAS float* LG = PART + 8 * 16 * 48;
    LAS unsigned* LH = (LAS unsigned*)(LG + 16 * 48);
    LAS unsigned* LB = LH + 32;
    LAS unsigned* LR = LH + 64;
    if (F.tid < NEXP) LH[F.tid] = 0u;
    const float* mod = (const float*)(a.ws + WS_MOD);
    const bf16_t* x1 = (const bf16_t*)(a.ws + WS_X1B); bf16_t* H2 = (bf16_t*)(a.ws + WS_ACT);
    unsigned* counts = (unsigned*)(a.ws + WS_CTL) + CW_COUNTS; unsigned* tokinfo = (unsigned*)(a.ws + WS_TOKINFO); int* toklist = (int*)(a.ws + WS_TOKLIST);
    const int rows_per_blk = T / F.G, r0 = F.bid * rows_per_blk, b = r0 / SEQ;
    const int lane = F.lane, w = F.wave, fr = lane & 15, fq = lane >> 4;
    f32x4 v[2][4], vn[2][4];
#define RT_LOAD(V, rb_) do { _Pragma("unroll") for (int q = 0; q < 2; ++q) { const u32x2* xr_ = (const u32x2*)(x1 + (size_t)((rb_) + 2 * w + q) * D) + lane; \
        _Pragma("unroll") for (int j = 0; j < 4; ++j) { const u32x2 t_ = xr_[64 * j]; V[q][j] = (f32x4){bf2f(t_.x & 0xffffu), bf2f(t_.x >> 16), bf2f(t_.y & 0xffffu), bf2f(t_.y >> 16)}; } } } while (0)
    RT_LOAD(v, r0);
    bf16x8 Bh[4][3], Bl[4][3];
    {
        const float* wre = a.in[I_WRE]; const float* wrg = a.in[I_WRG];
#pragma unroll
        for (int ks = 0; ks < 4; ++ks)
#pragma unroll
            for (int ct = 0; ct < 3; ++ct) {
                unsigned hw[4], lw[4];
#pragma unroll
                for (int jp = 0; jp < 4; ++jp) { float x[2];
#pragma unroll
                    for (int z = 0; z < 2; ++z) { const int k = 128 * w + 32 * ks + 8 * fq + 2 * jp + z;
                        if (ct == 0) { const float g = wrg[k * 4 + (fr & 3)], e = wre[k * 32 + ((fr + 28) & 31)]; x[z] = fr < 4 ? g : e; }
                        else if (ct == 1) x[z] = wre[k * 32 + 12 + fr];
                        else { const float e = wre[k * 32 + 28 + (fr & 3)]; x[z] = fr < 4 ? e : 0.f; } }
                    const unsigned h0 = f2bf(x[0]), h1 = f2bf(x[1]); hw[jp] = h0 | (h1 << 16);
                    lw[jp] = pk2(x[0] - bf2f(h0), x[1] - bf2f(h1)); }
                Bh[ks][ct] = __builtin_bit_cast(bf16x8, (u32x4){hw[0], hw[1], hw[2], hw[3]}); Bl[ks][ct] = __builtin_bit_cast(bf16x8, (u32x4){lw[0], lw[1], lw[2], lw[3]});
            }
    }
    for (int g = 0; g < rows_per_blk / 16; ++g) {
        const int rg = r0 + 16 * g;
        { const int gn = g + 1 < rows_per_blk / 16 ? g + 1 : g; RT_LOAD(vn, r0 + 16 * gn); }
#pragma unroll
        for (int q = 0; q < 2; ++q) { float sq = 0.f;
#pragma unroll
            for (int j = 0; j < 4; ++j) sq += (v[q][j].x * v[q][j].x + v[q][j].y * v[q][j].y) + (v[q][j].z * v[q][j].z + v[q][j].w * v[q][j].w);
            const float rs = rsqrtf(wave_sum(sq) * (1.0f / D) + EPS); const int row = 2 * w + q;
#pragma unroll
            for (int j = 0; j < 4; ++j) { const int k = 256 * j + 4 * lane;
                const f32x4 gg = *(const f32x4*)(a.in[I_N2G] + k) * (1.0f + *(const f32x4*)(mod + b * 6144 + 4 * 1024 + k)), sh = *(const f32x4*)(mod + b * 6144 + 3 * 1024 + k);
                const f32x4 hv = v[q][j] * rs * gg + sh;
                const unsigned h0 = f2bf(hv.x), h1 = f2bf(hv.y), h2_ = f2bf(hv.z), h3 = f2bf(hv.w);
                const u32x2 hw = (u32x2){h0 | (h1 << 16), h2_ | (h3 << 16)};
                *(u32x2*)(H2 + (size_t)(rg + row) * D + k) = hw;
                *(LAS u32x2*)(AH + row * AP + k) = hw;
                *(LAS u32x2*)(AL + row * AP + k) = (u32x2){pk2(hv.x - bf2f(h0), hv.y - bf2f(h1)), pk2(hv.z - bf2f(h2_), hv.w - bf2f(h3))}; } }
        __syncthreads();
        f32x4 acc[3] = {{0.f, 0.f, 0.f, 0.f}, {0.f, 0.f, 0.f, 0.f}, {0.f, 0.f, 0.f, 0.f}};
#pragma unroll
        for (int ks = 0; ks < 4; ++ks) { const bf16x8 ah = *(const LAS bf16x8*)(AH + fr * AP + 128 * w + 32 * ks + 8 * fq), al = *(const LAS bf16x8*)(AL + fr * AP + 128 * w + 32 * ks + 8 * fq);
#pragma unroll
            for (int ct = 0; ct < 3; ++ct) { acc[ct] = __builtin_amdgcn_mfma_f32_16x16x32_bf16(ah, Bh[ks][ct], acc[ct], 0, 0, 0);
                acc[ct] = __builtin_amdgcn_mfma_f32_16x16x32_bf16(al, Bh[ks][ct], acc[ct], 0, 0, 0); acc[ct] = __builtin_amdgcn_mfma_f32_16x16x32_bf16(ah, Bl[ks][ct], acc[ct], 0, 0, 0); } }
#pragma unroll
        for (int ct = 0; ct < 3; ++ct)
#pragma unroll
            for (int r = 0; r < 4; ++r) PART[(w * 16 + 4 * fq + r) * 48 + 16 * ct + fr] = acc[ct][r];
        __syncthreads();
        for (int t = F.tid; t < 16 * 48; t += NTHR) { const int row = t / 48, o = t % 48; float sacc = 0.f;
#pragma unroll
            for (int ww = 0; ww < 8; ++ww) sacc += PART[(ww * 16 + row) * 48 + o];
            if (o < 36) LG[row * 48 + o] = sacc + (o < 4 ? a.in[I_BRG][o & 3] : a.in[I_BRE][(o + 28) & 31]); }
        __syncthreads();
        if (F.tid < 16) {
            const LAS float* lg = LG + F.tid * 48;
            float gl[4]; int gi = 0;
#pragma unroll
            for (int o = 0; o < 4; ++o) gl[o] = lg[o];
            float gm = gl[0];
#pragma unroll
            for (int o = 1; o < 4; ++o) if (gl[o] > gm) { gm = gl[o]; gi = o; }
            float gsum = 0.f;
#pragma unroll
            for (int o = 0; o < 4; ++o) gsum += expf(gl[o] - gm);
            const float gp = 1.0f / gsum;
            float el[8];
#pragma unroll
            for (int e = 0; e < 8; ++e) el[e] = lg[4 + gi * 8 + e];
            int i0 = 0; float m0 = el[0];
#pragma unroll
            for (int o = 1; o < 8; ++o) if (el[o] > m0) { m0 = el[o]; i0 = o; }
            int i1 = -1; float m1 = -INFINITY;
#pragma unroll
            for (int o = 0; o < 8; ++o) if (o != i0 && el[o] > m1) { m1 = el[o]; i1 = o; }
            const float e1 = expf(m1 - m0); const float w0 = gp / (1.0f + e1), w1 = gp * e1 / (1.0f + e1);
            const int rl = 16 * g + F.tid, ex0 = gi * 8 + i0, ex1 = gi * 8 + i1;
            const unsigned l0 = atomicAdd((unsigned*)(LH + ex0), 1u), l1 = atomicAdd((unsigned*)(LH + ex1), 1u);
            LAS unsigned* ri = LR + rl * 6;
            ri[0] = (unsigned)ex0; ri[1] = l0; ri[2] = (unsigned)ex1; ri[3] = l1; ri[4] = __float_as_uint(w0); ri[5] = __float_as_uint(w1);
        }
#pragma unroll
        for (int q = 0; q < 2; ++q)
#pragma unroll
            for (int j = 0; j < 4; ++j) v[q][j] = vn[q][j];
    }
#undef RT_LOAD
    __syncthreads();
    if (F.tid < NEXP) LB[F.tid] = atomicAdd(counts + 64 * F.tid, LH[F.tid]);
    __syncthreads();
    for (int rl = F.tid; rl < rows_per_blk; rl += NTHR) {
        const LAS unsigned* ri = LR + rl * 6; const int r = r0 + rl;
        const unsigned ex0 = ri[0], ex1 = ri[2], k0 = LB[ex0] + ri[1], k1 = LB[ex1] + ri[3];
        toklist[ex0 * T + k0] = r; toklist[ex1 * T + k1] = r;
        u32x4 t0; t0.x = ex0; t0.y = k0; t0.z = ex1; t0.w = k1;
        *(u32x4*)(tokinfo + (size_t)r * 8) = t0;
        tokinfo[(size_t)r * 8 + 4] = ri[4]; tokinfo[(size_t)r * 8 + 5] = ri[5];
    }
}
__device__ __forceinline__ void build_moe_tab(const Frame& F, const Args& a, LAS MoeTab* tab) {
    if (F.tid == 0) {
        const unsigned* counts = (const unsigned*)(a.ws + WS_CTL) + CW_COUNTS; int nt = 0;
        for (int e = 0; e < NEXP; ++e) { const int c = (int)__hip_atomic_load(counts + 64 * e, __ATOMIC_RELAXED, __HIP_MEMORY_SCOPE_AGENT); tab->cnt[e] = c; tab->tbase[e] = nt;
            const int n = (c + 255) >> 8; for (int m = 0; m < n; ++m) { tab->tile_e[nt] = e; tab->tile_m[nt] = m; ++nt; } }
        tab->tbase[NEXP] = nt; tab->nt = nt;
    }
    __syncthreads();
}
__device__ __forceinline__ void phase_final(const Frame& F, const Args& a, const LAS MoeTab* tab) {
    const float* mod = (const float*)(a.ws + WS_MOD); const unsigned* tokinfo = (const unsigned*)(a.ws + WS_TOKINFO); const bf16_t* Ys = (const bf16_t*)(a.ws + WS_YS);
    const int rows_per_blk = T / F.G, r0 = F.bid * rows_per_blk;
    for (int r = r0 + F.wave; r < r0 + rows_per_blk; r += NWAVES) {
        const int b = r / SEQ;
        const u32x4 ti = *(const u32x4*)(tokinfo + (size_t)r * 8);
        const float w0 = __uint_as_float(tokinfo[(size_t)r * 8 + 4]), w1 = __uint_as_float(tokinfo[(size_t)r * 8 + 5]);
        const size_t s0 = (size_t)tab->tbase[ti.x] * 256 + ti.y, s1 = (size_t)tab->tbase[ti.z] * 256 + ti.w;
        f32x4* xr = (f32x4*)(a.out + (size_t)r * D) + F.lane; const u32x2* xb = (const u32x2*)((const bf16_t*)(a.ws + WS_X1B) + (size_t)r * D) + F.lane;
        const u32x2* y0 = (const u32x2*)(Ys + s0 * D) + F.lane; const u32x2* y1 = (const u32x2*)(Ys + s1 * D) + F.lane;
        f32x4 v[4]; float s = 0.f;
#pragma unroll
        for (int j = 0; j < 4; ++j) { const int k = 256 * j + 4 * F.lane;
            const f32x4 gt = *(const f32x4*)(mod + b * 6144 + 5 * 1024 + k); const u32x2 a0 = y0[64 * j], a1 = y1[64 * j];
            f32x4 m; m.x = w0 * bf2f(a0.x & 0xffffu) + w1 * bf2f(a1.x & 0xffffu); m.y = w0 * bf2f(a0.x >> 16) + w1 * bf2f(a1.x >> 16);
            m.z = w0 * bf2f(a0.y & 0xffffu) + w1 * bf2f(a1.y & 0xffffu); m.w = w0 * bf2f(a0.y >> 16) + w1 * bf2f(a1.y >> 16);
            const u32x2 xq = xb[64 * j]; const f32x4 xv = (f32x4){bf2f(xq.x & 0xffffu), bf2f(xq.x >> 16), bf2f(xq.y & 0xffffu), bf2f(xq.y >> 16)};
            v[j] = xv + gt * m; s += (v[j].x * v[j].x + v[j].y * v[j].y) + (v[j].z * v[j].z + v[j].w * v[j].w); }
        const float rs = rsqrtf(wave_sum(s) * (1.0f / D) + EPS);
#pragma unroll
        for (int j = 0; j < 4; ++j) { const f32x4 g = *(const f32x4*)(a.in[I_FG] + 256 * j + 4 * F.lane); xr[64 * j] = v[j] * rs * g; }
    }
}

#define XB_TMO      128
#define XB_XCNT(j)  (256  + 64 * (j))
#define XB_XSUB(j)  (1280 + 64 * (j))
#define XB_XGEN(j)  (2304 + 64 * (j))
#define XB_TOP      3328
#define XB_TOPGEN   3392
#define XCD_BAR_WORDS 3456
#define XB_SPIN_CAP (1u << 18)
__device__ __forceinline__ unsigned xb_ld(unsigned* p)              { return __hip_atomic_load(p, __ATOMIC_RELAXED, __HIP_MEMORY_SCOPE_AGENT); }
__device__ __forceinline__ unsigned xb_add(unsigned* p, unsigned v) { return __hip_atomic_fetch_add(p, v, __ATOMIC_RELAXED, __HIP_MEMORY_SCOPE_AGENT); }
__device__ __forceinline__ unsigned xb_xcc_id() { return (unsigned)__builtin_amdgcn_s_getreg((3 << 11) | 20) & 0xFu; }
#define XB_SPIN(cond, bar) do { unsigned _sp = 0; while (cond) { __builtin_amdgcn_s_sleep(1); \
    if ((++_sp & 255u) == 0u) { if (xb_ld(&(bar)[XB_TMO])) break; if (_sp > XB_SPIN_CAP) { atomicAdd(&(bar)[XB_TMO], 1u); break; } } } } while (0)
struct XcdBarrier { unsigned* bar; unsigned x; volatile LAS unsigned* st; };
__device__ __forceinline__ XcdBarrier xcd_barrier_post(unsigned* bar, volatile LAS unsigned* st) {
    XcdBarrier b; b.bar = bar; b.x = xb_xcc_id(); b.st = st;
    if (threadIdx.x == 0) (void)xb_add(&bar[XB_XCNT(b.x)], 1u);
    return b;
}
__device__ __forceinline__ void xcd_barrier_complete(unsigned* bar, unsigned x, unsigned& nloc, unsigned& nx) {
    const unsigned G = gridDim.x * gridDim.y * gridDim.z;
    unsigned sum, cnt, mine, sp = 0u;
    for (;;) {
        sum = 0u; cnt = 0u; mine = 0u;
#pragma unroll
        for (unsigned j = 0; j < 16; ++j) { const unsigned c = xb_ld(&bar[XB_XCNT(j)]); sum += c; cnt += (c > 0u) ? 1u : 0u; mine = (j == x) ? c : mine; }
        if (sum == G) break;
        __builtin_amdgcn_s_sleep(1);
        if ((++sp & 255u) == 0u) { if (xb_ld(&bar[XB_TMO])) break; if (sp > XB_SPIN_CAP) { atomicAdd(&bar[XB_TMO], 1u); break; } }
    }
    nloc = mine > 0u ? mine : 1u; nx = cnt > 0u ? cnt : 1u;
}
__device__ __forceinline__ void xcd_barrier(const XcdBarrier& b) {
    asm volatile("s_waitcnt vmcnt(0)" ::: "memory");
    __syncthreads();
    if (threadIdx.x == 0) {
        unsigned* bar = b.bar;
        __builtin_amdgcn_s_waitcnt(0);
        unsigned nloc = b.st[0], nx = b.st[1];
        if (nloc == 0u) { xcd_barrier_complete(bar, b.x, nloc, nx); b.st[0] = nloc; b.st[1] = nx; }
        const unsigned old = xb_add(&bar[XB_XSUB(b.x)], 1u);
        const unsigned gen = old / nloc;
        if (old + 1u == (gen + 1u) * nloc) {
            __builtin_amdgcn_fence(__ATOMIC_RELEASE, "agent");
            asm volatile("s_waitcnt vmcnt(0)" ::: "memory");
            const unsigned og = xb_add(&bar[XB_TOP], 1u);
            const unsigned tg = og / nx;
            if (og + 1u == (tg + 1u) * nx) xb_add(&bar[XB_TOPGEN], 1u);
            else XB_SPIN(xb_ld(&bar[XB_TOPGEN]) == tg, bar);
            __builtin_amdgcn_fence(__ATOMIC_ACQUIRE, "agent");
            xb_add(&bar[XB_XGEN(b.x)], 1u);
            asm volatile("s_waitcnt vmcnt(0)" ::: "memory");
        } else {
            XB_SPIN(xb_ld(&bar[XB_XGEN(b.x)]) == gen, bar);
            __builtin_amdgcn_fence(__ATOMIC_ACQUIRE, "agent");
            asm volatile("s_waitcnt vmcnt(0)" ::: "memory");
        }
    }
    __syncthreads();
}

constexpr int N_PHASES = 11;
__global__ void __launch_bounds__(NTHR, 2) mk_fwd(Args a) {
    extern __shared__ __attribute__((aligned(16))) unsigned char lds_raw[];
    Frame F; F.lds = (LAS unsigned char*)lds_raw; F.tid = threadIdx.x; F.lane = F.tid & 63; F.wave = __builtin_amdgcn_readfirstlane(F.tid >> 6); F.G = gridDim.x; F.bid = blockIdx.x;
    unsigned char* ws = a.ws;
    const int lo = a.ph_lo, hi = a.ph_hi;
#if MK_N_LAUNCHES == 1
    volatile LAS unsigned* MISC = (volatile LAS unsigned*)(F.lds + 152 * 1024);
    if (F.tid < 4) MISC[F.tid] = 0u;
    __syncthreads();
    XcdBarrier xbar = xcd_barrier_post((unsigned*)(ws + WS_CTL) + CW_BAR, MISC);
#define SEAM(k) do { if (IN(k) && IN((k) + 1)) xcd_barrier(xbar); } while (0)
#else
#define SEAM(k) do { } while (0)
#endif
#define IN(k) (lo <= (k) && (k) < hi)
    LAS MoeTab* tab = (LAS MoeTab*)(F.lds + 144 * 1024);

#define RUNPH(k, ...) if (IN(k)) { F.lane = lane_now(); F.tid = F.wave * 64 + F.lane; __VA_ARGS__ }
    RUNPH(0, { phase0(F, a); }) SEAM(0);
    RUNPH(1, { phase1(F, a); __syncthreads(); dense_weight_convert(F, a); }) SEAM(1);
    RUNPH(2, {
        DenseOrder S{(const char*)(ws + WS_ACT), (const char*)(ws + WS_WIN), D, T / 256, INC / 256, F.G, F.bid};
        EpiInProj E{(bf16_t*)(ws + WS_PROJ), (bf16_t*)a.out, (float*)(ws + WS_DEC), (const float*)(ws + WS_SMALL) + 16, attn_body::C2};
        pg8::gemm_phase(F.lds, D, S, E);
    }) SEAM(2);
    RUNPH(3, {
        for (int g = F.bid; g < 256; g += F.G) hg::grp_local(F, a, g);
        __syncthreads();
        attn_phase(F, a);
    }) SEAM(3);
    RUNPH(4, { hg::grp_scan(F, a); attn_combine(F, a); }) SEAM(4);
    RUNPH(5, { for (int g = F.bid; g < 256; g += F.G) hg::grp_final(F, a, g); }) SEAM(5);
    RUNPH(6, {
        UpOrder S{(const char*)(ws + WS_YDA), (const char*)(ws + WS_YHG), (const char*)(ws + WS_WUPDA), (const char*)(ws + WS_WUPHG), F.G, F.bid};
        EpiUp E{(const bf16_t*)(ws + WS_PROJ), (bf16_t*)(ws + WS_ACT)};
        pg8::gemm_phase(F.lds, 512, S, E);
    }) SEAM(6);
    RUNPH(7, {
        DenseOrder S{(const char*)(ws + WS_ACT), (const char*)(ws + WS_WOUT), D, T / 256, D / 256, F.G, F.bid};
        EpiOut E{a.in[I_X], (const float*)(ws + WS_MOD), (bf16_t*)(ws + WS_X1B)};
        pg8::gemm_phase(F.lds, D, S, E);
        moe_weight_convert(F, a);
    }) SEAM(7);
    RUNPH(8, { phase_router(F, a); __syncthreads(); }) SEAM(8);
    RUNPH(9, {
        build_moe_tab(F, a, tab);
        unsigned* done = (unsigned*)(ws + WS_CTL) + CW_TILE;
        { Moe1Order S{tab, (const char*)(ws + WS_ACT), (const char*)(ws + WS_W13), (const int*)(ws + WS_TOKLIST), F.G, F.bid};
          EpiMoe1 E{(bf16_t*)(ws + WS_HS), done};
          pg8::gemm_phase(F.lds, D, S, E); }
        { Moe2Order S{tab, (const char*)(ws + WS_HS), (const char*)(ws + WS_W2), done, (unsigned*)(ws + WS_CTL) + CW_TMO, F.G, F.bid};
          EpiStoreBf16 E{(bf16_t*)(ws + WS_YS), D, 0, 1.0f};
          pg8::gemm_phase(F.lds, DEXP, S, E); }
    }) SEAM(9);
    RUNPH(10, { build_moe_tab(F, a, tab); phase_final(F, a, tab); })
#undef IN
#undef SEAM
}

extern "C" void kernel_launch(void* const* d_in, const int* in_sizes, int n_in, void* d_out, int out_size, void* d_ws, size_t ws_size, hipStream_t stream) {
    static int grid = 0;
    if (grid == 0) {
        if (n_in != 25 || in_sizes[0] != T * D || out_size != T * D || ws_size < WS_END) { fprintf(stderr, "kernel_launch: unexpected shapes (n_in %d, in0 %d, out %d, ws %zu)\n", n_in, n_in > 0 ? in_sizes[0] : -1, out_size, ws_size); grid = -1; return; }
        int dev = 0, cus = 0, per_cu = 0;
        if (hipGetDevice(&dev) != hipSuccess || hipDeviceGetAttribute(&cus, hipDeviceAttributeMultiprocessorCount, dev) != hipSuccess) { grid = -1; return; }
        if (hipFuncSetAttribute((const void*)mk_fwd, hipFuncAttributeMaxDynamicSharedMemorySize, LDS_BYTES) != hipSuccess) { fprintf(stderr, "kernel_launch: hipFuncSetAttribute failed\n"); grid = -1; return; }
        if (hipOccupancyMaxActiveBlocksPerMultiprocessor(&per_cu, (const void*)mk_fwd, NTHR, LDS_BYTES) != hipSuccess || per_cu < 1) { fprintf(stderr, "kernel_launch: occupancy query says %d\n", per_cu); per_cu = 1; }
        (void)hipGetLastError();
        grid = cus;
        if (grid > 256) grid = 256;
        while (T % grid) --grid;
    }
    if (grid < 0) return;
    (void)hipMemsetAsync((char*)d_ws + WS_CTL, 0, CTL_ZERO_BYTES, stream);
    Args a{};
    for (int i = 0; i < 25; ++i) a.in[i] = (const float*)d_in[i];
    a.out = (float*)d_out; a.ws = (unsigned char*)d_ws;
#if MK_N_LAUNCHES == 1
    a.ph_lo = 0; a.ph_hi = N_PHASES;
    void* args[] = {&a};
    hipError_t e = hipLaunchCooperativeKernel((const void*)mk_fwd, dim3(grid), dim3(NTHR), args, LDS_BYTES, stream);
    if (e != hipSuccess) fprintf(stderr, "cooperative launch failed: %s (grid %d)\n", hipGetErrorString(e), grid);
#else
    for (int p = 0; p < N_PHASES; ++p) {
        a.ph_lo = p; a.ph_hi = p + 1;
        hipLaunchKernelGGL(mk_fwd, dim3(grid), dim3(NTHR), LDS_BYTES, stream, a);
    }
#endif
}
```

```cpp
#include <hip/hip_runtime.h>
#include <cstdio>
#include <cstdint>

#ifndef MK_N_LAUNCHES
#define MK_N_LAUNCHES 1
#endif

#define LAS __attribute__((address_space(3)))
typedef unsigned short bf16_t;
typedef short bf16x8 __attribute__((ext_vector_type(8)));
typedef float f32x4 __attribute__((ext_vector_type(4)));
typedef float f32x2 __attribute__((ext_vector_type(2)));
typedef unsigned u32x4 __attribute__((ext_vector_type(4)));
typedef unsigned u32x2 __attribute__((ext_vector_type(2)));

constexpr int NB = 4, SEQ = 4096, D = 1024, T = NB * SEQ;
constexpr int INC = 5632;
constexpr int C_QDA = 0, C_KDA = 512, C_VDA = 1024, C_QHG = 1536, C_FHG = 2048, C_IHG = 2560, C_GHG = 3072, C_GDA = 3584, C_GHGATE = 4608;
constexpr int C_HGT = 1536;
constexpr int NEXP = 32, DEXP = 512;
constexpr int PMAX = 40960;
constexpr float EPS = 1e-6f;
constexpr int NWAVES = 8, NTHR = 512;

constexpr size_t MiB = 1u << 20;
constexpr size_t WS_CTL = 0, CTL_ZERO_BYTES = 64 * 1024;
constexpr size_t WS_MODP = 1 * MiB;
constexpr size_t WS_MOD = 5 * MiB / 2;
constexpr size_t WS_SMALL = 11 * MiB / 4;
constexpr size_t WS_TOKINFO = 3 * MiB;
constexpr size_t WS_TOKLIST = 4 * MiB;
constexpr size_t WS_DEC = 6 * MiB;
constexpr size_t WS_DS = 24 * MiB;
constexpr size_t WS_WIN = 8 * MiB;
constexpr size_t WS_WUPDA = 20 * MiB, WS_WUPHG = 21 * MiB, WS_WOUT = 22 * MiB;
constexpr size_t WS_ACT = 24 * MiB;
constexpr size_t WS_PROJ = 56 * MiB;
constexpr size_t WS_YDA = 232 * MiB, WS_YHG = 248 * MiB;
constexpr size_t WS_OA = 264 * MiB;
constexpr size_t WS_W13 = 56 * MiB;
constexpr size_t WS_W2 = 120 * MiB;
constexpr size_t WS_HS = 152 * MiB;
constexpr size_t WS_YS = 192 * MiB;
constexpr size_t WS_X1B = 272 * MiB;
constexpr size_t WS_END = 304 * MiB;
constexpr int CW_COUNTS = 64;
constexpr int CW_BAR = 4096;
constexpr int CW_TILE = 8192;
constexpr int CW_TMO = 32;

constexpr int LDS_BYTES = 160 * 1024;

__device__ __forceinline__ float bf2f(unsigned v) { return __uint_as_float(v << 16); }
__device__ __forceinline__ unsigned f2bf(float f) { unsigned u = __float_as_uint(f); return (u + 0x7fffu + ((u >> 16) & 1u)) >> 16; }
__device__ __forceinline__ unsigned pk2(float lo, float hi) { return f2bf(lo) | (f2bf(hi) << 16); }
__device__ __forceinline__ float sigmoidf_(float x) { return 1.0f / (1.0f + __expf(-x)); }
__device__ __forceinline__ float siluf_(float x) { return x / (1.0f + __expf(-x)); }
__device__ __forceinline__ int lane_now() { int l; asm volatile("v_mbcnt_lo_u32_b32 %0, -1, 0\n\tv_mbcnt_hi_u32_b32 %0, -1, %0" : "=v"(l)); return l; }
__device__ __forceinline__ float wave_sum(float v) {
#pragma unroll
    for (int o = 1; o < 64; o <<= 1) v += __shfl_xor(v, o);
    return v;
}

namespace pg8 {
constexpr int BM = 256, BK = 64, HALF = 128, HTB = HALF * BK * 2, STAGE_BYTES = 8 * HTB;
__host__ __device__ __forceinline__ int lds_byte(int r, int c) { const int st = (r >> 4) * 2 + (c >> 5), rr = r & 15, cc = c & 31, ob = rr * 64 + cc * 2; return st * 1024 + (ob ^ (((ob >> 9) & 1) << 5)); }
__host__ __device__ __forceinline__ void stage_rc(int b, int& R, int& C) { const int st = b / 1024, sb = b % 1024, swz = sb ^ (((sb >> 9) & 1) << 5); R = (st >> 1) * 16 + swz / 64; C = (st & 1) * 32 + (swz % 64) / 2; }
__host__ __device__ __forceinline__ int perm32(int rho) { const int n = rho >> 4, i = rho & 15; return 8 * (i >> 2) + 4 * n + (i & 3); }

struct Unit { int pm, pn; const char* A; const char* B; int aux; };
__device__ __forceinline__ unsigned cvt_pk_bf16(float lo, float hi) { unsigned r; asm volatile("v_cvt_pk_bf16_f32 %0, %1, %2" : "=v"(r) : "v"(lo), "v"(hi)); return r; }

template <class Epi, class Sched>
__device__ __forceinline__ void gemm_phase(LAS unsigned char* lds, const int K, const Sched& S, const Epi& E) {
    const int tid = threadIdx.x, wid = __builtin_amdgcn_readfirstlane(tid >> 6), lane = tid & 63, wr = wid >> 2, wc = wid & 3, fr = lane & 15, fq = lane >> 4;
    const int nt = K / BK;
    unsigned voffB[2];
#define PG8_SETLANE() do { const int _l = lane_now(), _t = wid * 64 + _l; _Pragma("unroll") for (int _i = 0; _i < 2; ++_i) { int _R, _C; stage_rc(_t * 16 + _i * 8192, _R, _C); \
        const int _Rb = Epi::PERM ? ((_R & ~31) + perm32(_R & 31)) : _R; voffB[_i] = (unsigned)(_Rb * K + _C) * 2u; } \
        aoff = lds_byte(wr * 64 + (_l & 15), (_l >> 4) * 8); boff = lds_byte(wc * 32 + (_l & 15), (_l >> 4) * 8); } while (0)
    const size_t kstep = (size_t)(BK * 2);
    const size_t hstep = (size_t)HALF * K * 2;
    const unsigned ldsw = (unsigned)wid * 1024u;
    int aoff, boff; PG8_SETLANE();
#define PG8_SA(b, h) (((b) * 2 + (h)) * HTB)
#define PG8_SB(b, h) ((4 + (b) * 2 + (h)) * HTB)
#define PG8_STAGE(bufoff, gbase, voff) do { _Pragma("unroll") for (int _i = 0; _i < 2; ++_i) \
        __builtin_amdgcn_global_load_lds((const unsigned*)((const char*)(gbase) + (voff)[_i]), (LAS unsigned*)(lds + (bufoff) + ldsw + _i * 8192), 16, 0, 0); } while (0)
#define PG8_LDA(dst, b, h) do { _Pragma("unroll") for (int m = 0; m < 4; ++m) _Pragma("unroll") for (int k = 0; k < 2; ++k) dst[m][k] = *(const LAS bf16x8*)(lds + PG8_SA(b, h) + aoff + m * 2048 + k * 1024); } while (0)
#define PG8_LDB(dst, b, h) do { _Pragma("unroll") for (int n = 0; n < 2; ++n) _Pragma("unroll") for (int k = 0; k < 2; ++k) dst[n][k] = *(const LAS bf16x8*)(lds + PG8_SB(b, h) + boff + n * 2048 + k * 1024); } while (0)
#define PG8_MMA(ai, bj, At, Bt) do { __builtin_amdgcn_s_setprio(1); _Pragma("unroll") for (int m = 0; m < 4; ++m) _Pragma("unroll") for (int n = 0; n < 2; ++n) _Pragma("unroll") for (int k = 0; k < 2; ++k) \
        acc[ai][bj][m][n] = __builtin_amdgcn_mfma_f32_16x16x32_bf16(Bt[n][k], At[m][k], acc[ai][bj][m][n], 0, 0, 0); __builtin_amdgcn_s_setprio(0); } while (0)
#define PG8_WAIT_V(n) asm volatile("s_waitcnt vmcnt(" #n ")" ::: "memory")
#define PG8_WAIT_L(n) asm volatile("s_waitcnt lgkmcnt(" #n ")" ::: "memory")
#define PG8_BAR __builtin_amdgcn_s_barrier()
#define PG8_SCHED __builtin_amdgcn_sched_barrier(0)
#define PG8_SETA(vo, u) do { const int _t = wid * 64 + lane_now(); _Pragma("unroll") for (int _i = 0; _i < 2; ++_i) { int _R, _C; stage_rc(_t * 16 + _i * 8192, _R, _C); \
        _Pragma("unroll") for (int _h = 0; _h < 2; ++_h) vo[_h][_i] = (unsigned)((size_t)S.arow(u, _h * HALF + _R) * (size_t)K + _C) * 2u; } if (Sched::GATHER) PG8_WAIT_V(0); } while (0)
    Unit cur, nxt; int ui = 0;
    if (!S.next(0, cur)) return;
    f32x4 acc[2][2][4][2];
#pragma unroll
    for (int a = 0; a < 2; ++a)
#pragma unroll
        for (int b = 0; b < 2; ++b)
#pragma unroll
            for (int m = 0; m < 4; ++m)
#pragma unroll
                for (int n = 0; n < 2; ++n) acc[a][b][m][n] = (f32x4){0.f, 0.f, 0.f, 0.f};
    bf16x8 At[4][2], B0[2][2], B1[2][2];
    unsigned voC[2][2], voN[2][2];
    S.a_ready(cur);
    PG8_SETA(voC, cur);
    const char* cA = cur.A; const char* cB = cur.B;
    PG8_STAGE(PG8_SB(0, 0), cB, voffB); PG8_STAGE(PG8_SB(0, 1), cB + hstep, voffB); PG8_STAGE(PG8_SA(0, 0), cA, voC[0]); PG8_STAGE(PG8_SA(0, 1), cA, voC[1]);
    if (wr == 1) PG8_BAR;
    PG8_WAIT_V(2); PG8_BAR;
    PG8_STAGE(PG8_SB(1, 0), cB + kstep, voffB); PG8_STAGE(PG8_SA(1, 0), cA + kstep, voC[0]); PG8_STAGE(PG8_SB(1, 1), cB + hstep + kstep, voffB);
    PG8_WAIT_V(6); PG8_BAR;
    for (;;) {
        const bool has_next = S.next(ui + 1, nxt);
        if (has_next) { PG8_SETA(voN, nxt); }
        else {
#pragma unroll
            for (int h = 0; h < 2; ++h)
#pragma unroll
                for (int i = 0; i < 2; ++i) voN[h][i] = voC[h][i];
        }
        const char* nA = has_next ? nxt.A : cA; const char* nB = has_next ? nxt.B : cB;
        for (int t = 0; t < nt; t += 2) {
            const bool last = (t == nt - 2);
            if (last && has_next) S.a_ready(nxt);
            const char* a1 = cA + (size_t)(t + 1) * kstep;
            const char* a2 = last ? nA : cA + (size_t)(t + 2) * kstep; const char* b2 = last ? nB : cB + (size_t)(t + 2) * kstep;
            const char* a3 = a2 + kstep; const char* b3 = b2 + kstep;
            unsigned vo2[2][2];
#pragma unroll
            for (int h = 0; h < 2; ++h)
#pragma unroll
                for (int i = 0; i < 2; ++i) vo2[h][i] = last ? voN[h][i] : voC[h][i];
            PG8_LDB(B0, 0, 0); PG8_LDB(B1, 0, 1); PG8_SCHED; PG8_LDA(At, 0, 0); PG8_STAGE(PG8_SA(1, 1), a1, voC[1]);
            PG8_WAIT_V(8); PG8_WAIT_L(0); PG8_BAR; PG8_MMA(0, 0, At, B0); PG8_MMA(0, 1, At, B1); PG8_BAR; PG8_SCHED;
            PG8_LDA(At, 0, 1); PG8_STAGE(PG8_SB(0, 0), b2, voffB); PG8_STAGE(PG8_SB(0, 1), b2 + hstep, voffB); PG8_STAGE(PG8_SA(0, 0), a2, vo2[0]);
            PG8_WAIT_V(8); PG8_WAIT_L(0); PG8_BAR; PG8_MMA(1, 0, At, B0); PG8_MMA(1, 1, At, B1); PG8_BAR; PG8_SCHED;
            PG8_LDB(B0, 1, 0); PG8_LDB(B1, 1, 1); PG8_SCHED; PG8_LDA(At, 1, 0); PG8_STAGE(PG8_SA(0, 1), a2, vo2[1]);
            PG8_WAIT_V(8); PG8_WAIT_L(0); PG8_BAR; PG8_MMA(0, 0, At, B0); PG8_MMA(0, 1, At, B1); PG8_BAR; PG8_SCHED;
            PG8_LDA(At, 1, 1); PG8_STAGE(PG8_SB(1, 0), b3, voffB); PG8_STAGE(PG8_SB(1, 1), b3 + hstep, voffB); PG8_STAGE(PG8_SA(1, 0), a3, vo2[0]);
            PG8_WAIT_V(8); PG8_WAIT_L(0); PG8_BAR; PG8_MMA(1, 0, At, B0); PG8_MMA(1, 1, At, B1); PG8_BAR; PG8_SCHED;
        }
        if (wr == 0) PG8_BAR;
        const bool keep = E(acc, cur, wr, wc, fr, fq);
        if (!has_next) break;
        if (!keep) {
#pragma unroll
            for (int a = 0; a < 2; ++a)
#pragma unroll
                for (int b = 0; b < 2; ++b)
#pragma unroll
                    for (int m = 0; m < 4; ++m)
#pragma unroll
                        for (int n = 0; n < 2; ++n) acc[a][b][m][n] = (f32x4){0.f, 0.f, 0.f, 0.f};
        }
        cur = nxt; cA = nA; cB = nB; ++ui;
        if (Sched::GATHER) {
#pragma unroll
            for (int h = 0; h < 2; ++h)
#pragma unroll
                for (int i = 0; i < 2; ++i) voC[h][i] = voN[h][i];
        } else { PG8_SETA(voC, cur); }
        PG8_SETLANE();
        if (wr == 1) PG8_BAR;
    }
    PG8_WAIT_V(0);
    PG8_BAR;
#undef PG8_SA
#undef PG8_SB
#undef PG8_STAGE
#undef PG8_LDA
#undef PG8_LDB
#undef PG8_MMA
#undef PG8_WAIT_V
#undef PG8_WAIT_L
#undef PG8_BAR
#undef PG8_SCHED
#undef PG8_SETA
#undef PG8_SETLANE
}
}

struct Args { const float* in[25]; float* out; unsigned char* ws; int ph_lo, ph_hi; };
enum { I_X = 0, I_C, I_WADA, I_BADA, I_N1G, I_WIN, I_LQ1, I_LK1, I_LQ2, I_LK2, I_SUBG, I_LBL, I_HGNG, I_WUPDA, I_WUPHG, I_WOUT, I_N2G, I_WRG, I_BRG, I_WRE, I_BRE, I_W1, I_W3, I_W2, I_FG };

struct DenseOrder {
    static constexpr bool GATHER = false;
    const char* A; const char* Bt; int K, nM, nN, G, c;
    __device__ __forceinline__ bool next(int i, pg8::Unit& u) const {
        const int L = i * G + c, nwg = nM * nN; if (L >= nwg) return false;
        int wgid = L; { const int q = nwg / 8, r = nwg % 8, xcd = wgid % 8, off = wgid / 8; wgid = (xcd < r ? xcd * (q + 1) : r * (q + 1) + (xcd - r) * q) + off; }
        const int nig = 8 * nN, gid = wgid / nig, fm = gid * 8, gsz = (nM - fm) < 8 ? (nM - fm) : 8;
        u.pm = fm + ((wgid % nig) % gsz); u.pn = (wgid % nig) / gsz; u.A = A; u.B = Bt + (size_t)u.pn * 256 * K * 2; u.aux = 0; return true;
    }
    __device__ __forceinline__ void a_ready(const pg8::Unit&) const {}
    __device__ __forceinline__ unsigned arow(const pg8::Unit& u, int r) const { return (unsigned)(u.pm * 256 + r); }
};
struct UpOrder {
    static constexpr bool GATHER = false;
    const char* A0; const char* A1; const char* B0; const char* B1; int G, c;
    __device__ __forceinline__ bool next(int i, pg8::Unit& u) const {
        const int tile = (i >> 1) * G + c; if (tile >= 256) return false;
        u.pm = tile >> 2; u.pn = tile & 3; u.aux = i & 1;
        u.A = (i & 1) ? A1 : A0; u.B = ((i & 1) ? B1 : B0) + (size_t)u.pn * 256 * 512 * 2; return true;
    }
    __device__ __forceinline__ void a_ready(const pg8::Unit&) const {}
    __device__ __forceinline__ unsigned arow(const pg8::Unit& u, int r) const { return (unsigned)(u.pm * 256 + r); }
};
struct MoeTab { int nt; int pad[3]; int tile_e[176]; int tile_m[176]; int cnt[32]; int tbase[33]; };
struct Moe1Order {
    static constexpr bool GATHER = true;
    const LAS MoeTab* tab; const char* A; const char* W; const int* toklist; int G, c;
    __device__ __forceinline__ bool next(int i, pg8::Unit& u) const {
        const int L = i * G + c; if (L >= tab->nt * 4) return false;
        const int ti = L >> 2; u.pm = ti; u.pn = L & 3; u.aux = ti; u.A = A;
        u.B = W + ((size_t)tab->tile_e[ti] * 1024 + (size_t)u.pn * 256) * 1024 * 2; return true;
    }
    __device__ __forceinline__ void a_ready(const pg8::Unit&) const {}
    __device__ __forceinline__ unsigned arow(const pg8::Unit& u, int r) const {
        const int e = tab->tile_e[u.aux], rr = tab->tile_m[u.aux] * 256 + r;
        return rr < tab->cnt[e] ? (unsigned)toklist[e * T + rr] : 0u;
    }
};
struct Moe2Order {
    static constexpr bool GATHER = false;
    const LAS MoeTab* tab; const char* A; const char* W; unsigned* done; unsigned* tmo; int G, c;
    __device__ __forceinline__ bool next(int i, pg8::Unit& u) const {
        const int n1 = tab->nt * 4, r = n1 % G, nl = G - r; int j;
        if (r > 0 && c >= r) { if (i < 2) j = (c - r) + i * nl; else j = 2 * nl + (c - r) + (i - 2) * G; }
        else j = (r > 0 ? 2 * nl : 0) + ((c - r + G) % G) + i * G;
        if (j >= n1) return false;
        const int ti = j >> 2; u.pm = ti; u.pn = j & 3; u.aux = ti; u.A = A;
        u.B = W + ((size_t)tab->tile_e[ti] * 1024 + (size_t)u.pn * 256) * 512 * 2; return true;
    }
    __device__ __forceinline__ unsigned arow(const pg8::Unit& u, int r) const { return (unsigned)(u.pm * 256 + r); }
    __device__ __forceinline__ void a_ready(const pg8::Unit& u) const {
        if (threadIdx.x < 64) {
            unsigned polls = 0;
            while ((unsigned)__builtin_amdgcn_readfirstlane(__hip_atomic_load(done + 16 * u.pm, __ATOMIC_RELAXED, __HIP_MEMORY_SCOPE_AGENT)) < 32u) {
                if (++polls > (1u << 22)) { if (threadIdx.x == 0) __hip_atomic_store(tmo, 1u, __ATOMIC_RELAXED, __HIP_MEMORY_SCOPE_AGENT); break; }
                __builtin_amdgcn_s_sleep(2); }
            __builtin_amdgcn_fence(__ATOMIC_ACQUIRE, "agent");
            asm volatile("s_waitcnt vmcnt(0)" ::: "memory");
        }
        asm volatile("" ::: "memory"); __builtin_amdgcn_s_barrier(); asm volatile("" ::: "memory");
    }
};

using pg8::Unit; using pg8::cvt_pk_bf16;
struct EpiStoreBf16 {
    static constexpr bool PERM = true;
    bf16_t* O; int ldc; int nscale; float scale0;
    __device__ __forceinline__ bool operator()(f32x4 (&acc)[2][2][4][2], const Unit& u, int wr, int wc, int fr, int fq) const {
        const int row0 = u.pm * 256 + wr * 64 + fr, col0 = u.pn * 256 + wc * 32 + 8 * fq;
        const float sc = u.pn < nscale ? scale0 : 1.0f;
#pragma unroll
        for (int ai = 0; ai < 2; ++ai)
#pragma unroll
            for (int m = 0; m < 4; ++m) { bf16_t* rowp = O + (size_t)(row0 + ai * 128 + m * 16) * ldc + col0;
#pragma unroll
                for (int bj = 0; bj < 2; ++bj) { const f32x4 v0 = acc[ai][bj][m][0] * sc, v1 = acc[ai][bj][m][1] * sc;
                    u32x4 w; w.x = cvt_pk_bf16(v0[0], v0[1]); w.y = cvt_pk_bf16(v0[2], v0[3]); w.z = cvt_pk_bf16(v1[0], v1[1]); w.w = cvt_pk_bf16(v1[2], v1[3]);
                    *(u32x4*)(rowp + bj * 128) = w; } }
        return false;
    }
};
template <int N> __device__ __forceinline__ float dpp_shr(float x) { return __builtin_bit_cast(float, __builtin_amdgcn_update_dpp(0, __builtin_bit_cast(int, x), 0x110 + N, 0xf, 0xf, true)); }
template <int N> __device__ __forceinline__ float dpp_ror(float x) { return __builtin_bit_cast(float, __builtin_amdgcn_update_dpp(0, __builtin_bit_cast(int, x), 0x120 + N, 0xf, 0xf, true)); }
__device__ __forceinline__ float rowsum16(float x) { x += dpp_ror<8>(x); x += dpp_ror<4>(x); x += dpp_ror<2>(x); x += dpp_ror<1>(x); return x; }
__device__ __forceinline__ float scan16(float x) { x += dpp_shr<1>(x); x += dpp_shr<2>(x); x += dpp_shr<4>(x); x += dpp_shr<8>(x); return x; }
struct EpiInProj {
    static constexpr bool PERM = true;
    bf16_t* O; bf16_t* KE; float* DEC; const float* lbv; float scale0;
    __device__ __forceinline__ bool operator()(f32x4 (&acc)[2][2][4][2], const Unit& u, int wr, int wc, int fr, int fq) const {
        { const int l_ = lane_now(); fr = l_ & 15; fq = l_ >> 4; }
        const int row0 = u.pm * 256 + wr * 64 + fr, col0 = u.pn * 256 + wc * 32 + 8 * fq;
        if (u.pn >= 6 && u.pn < 10) {
            const int h = u.pn - 6, lane = 16 * fq + fr, kb = wc * 32 + 8 * fq;
            const int bb = (u.pm * 256) / SEQ, ch0 = ((u.pm * 256) % SEQ + wr * 64) >> 6;
            const f32x4 lb0 = *(const f32x4*)(lbv + h * 128 + kb), lb1 = *(const f32x4*)(lbv + h * 128 + kb + 4);
#pragma unroll
            for (int ai = 0; ai < 2; ++ai) {
                unsigned kep[4][4];
#pragma unroll
                for (int n = 0; n < 2; ++n) {
#pragma unroll
                    for (int ep = 0; ep < 2; ++ep) {
                        float ke2[2][4];
#pragma unroll
                        for (int z = 0; z < 2; ++z) {
                            const int e = 2 * ep + z; const float lb = n ? lb1[e] : lb0[e];
                            float f[4], c[4], tot[4];
#pragma unroll
                            for (int m = 0; m < 4; ++m) { const float fl = acc[ai][1][m][n][e]; f[m] = lb + (1.0f - lb) * __builtin_amdgcn_rcpf(1.0f + __builtin_amdgcn_exp2f(-1.4426950408889634f * fl)); const float lf = __logf(f[m]); c[m] = scan16(lf); tot[m] = rowsum16(lf); }
                            const float alast = (tot[0] + tot[1]) + (tot[2] + tot[3]); const float eal = __expf(alast);
                            float pre = 0.f;
#pragma unroll
                            for (int m = 0; m < 4; ++m) { const float A = c[m] + pre; pre += tot[m]; const float q = acc[ai][0][m][n][e]; const float kk = 1.0f - f[m];
                                acc[ai][0][m][n][e] = q * __builtin_amdgcn_rcpf(1.0f + __builtin_amdgcn_exp2f(-1.4426950408889634f * q)) * __expf(A);
                                const float kd = kk * __expf(-A); acc[ai][1][m][n][e] = kd; ke2[z][m] = kd * eal; }
                            if (fr == 0) DEC[((size_t)(bb * 4 + h) * 64 + ch0 + 2 * ai) * 128 + kb + 4 * n + e] = eal;
                        }
#pragma unroll
                        for (int m = 0; m < 4; ++m) kep[m][2 * n + ep] = cvt_pk_bf16(ke2[0][m], ke2[1][m]);
                    }
                }
#pragma unroll
                for (int m = 0; m < 4; ++m) *(u32x4*)(KE + (size_t)(row0 + ai * 128 + m * 16) * 512 + h * 128 + kb) = (u32x4){kep[m][0], kep[m][1], kep[m][2], kep[m][3]};
            }
        }
        const float sc = u.pn < 2 ? scale0 : 1.0f;
#pragma unroll
        for (int ai = 0; ai < 2; ++ai)
#pragma unroll
            for (int m = 0; m < 4; ++m) { bf16_t* rowp = O + (size_t)(row0 + ai * 128 + m * 16) * INC + col0;
#pragma unroll
                for (int bj = 0; bj < 2; ++bj) { const f32x4 v0 = acc[ai][bj][m][0] * sc, v1 = acc[ai][bj][m][1] * sc;
                    u32x4 w; w.x = cvt_pk_bf16(v0[0], v0[1]); w.y = cvt_pk_bf16(v0[2], v0[3]); w.z = cvt_pk_bf16(v1[0], v1[1]); w.w = cvt_pk_bf16(v1[2], v1[3]);
                    *(u32x4*)(rowp + bj * 128) = w; } }
        return false;
    }
};
struct EpiUp {
    static constexpr bool PERM = true;
    const bf16_t* proj; bf16_t* O;
    __device__ __forceinline__ bool operator()(f32x4 (&acc)[2][2][4][2], const Unit& u, int wr, int wc, int fr, int fq) const {
        const int row0 = u.pm * 256 + wr * 64 + fr, col0 = u.pn * 256 + wc * 32 + 8 * fq;
#pragma unroll
        for (int ai = 0; ai < 2; ++ai)
#pragma unroll
            for (int m = 0; m < 4; ++m) { const size_t row = (size_t)(row0 + ai * 128 + m * 16);
#pragma unroll
                for (int bj = 0; bj < 2; ++bj) {
                    const int col = col0 + bj * 128;
                    const u32x4 gh = *(const u32x4*)(proj + row * INC + C_GHGATE + col);
                    float sh[8];
#pragma unroll
                    for (int j = 0; j < 4; ++j) { sh[2 * j] = 1.0f + __builtin_amdgcn_exp2f(-1.4426950408889634f * bf2f(gh[j] & 0xffffu)); sh[2 * j + 1] = 1.0f + __builtin_amdgcn_exp2f(-1.4426950408889634f * bf2f(gh[j] >> 16)); }
                    if (u.aux == 0) {
                        const u32x4 gd = *(const u32x4*)(proj + row * INC + C_GDA + col);
#pragma unroll
                        for (int j = 0; j < 4; ++j) {
                            const float d0 = 1.0f + __builtin_amdgcn_exp2f(-1.4426950408889634f * bf2f(gd[j] & 0xffffu)), d1 = 1.0f + __builtin_amdgcn_exp2f(-1.4426950408889634f * bf2f(gd[j] >> 16));
                            const float r0 = sh[2 * j] * __builtin_amdgcn_rcpf(d0), r1 = sh[2 * j + 1] * __builtin_amdgcn_rcpf(d1);
                            if (j < 2) { acc[ai][bj][m][0][2 * j] *= r0; acc[ai][bj][m][0][2 * j + 1] *= r1; }
                            else { acc[ai][bj][m][1][2 * j - 4] *= r0; acc[ai][bj][m][1][2 * j - 3] *= r1; }
                        }
                    } else {
                        const f32x4 v0 = acc[ai][bj][m][0], v1 = acc[ai][bj][m][1];
#pragma unroll
                        for (int j = 0; j < 8; ++j) sh[j] = __builtin_amdgcn_rcpf(sh[j]);
                        u32x4 w; w.x = cvt_pk_bf16(v0[0] * sh[0], v0[1] * sh[1]); w.y = cvt_pk_bf16(v0[2] * sh[2], v0[3] * sh[3]);
                        w.z = cvt_pk_bf16(v1[0] * sh[4], v1[1] * sh[5]); w.w = cvt_pk_bf16(v1[2] * sh[6], v1[3] * sh[7]);
                        *(u32x4*)(O + row * D + col) = w;
                    }
                } }
        return u.aux == 0;
    }
};
struct EpiOut {
    static constexpr bool PERM = true;
    const float* x; const float* mod; bf16_t* O;
    __device__ __forceinline__ bool operator()(f32x4 (&acc)[2][2][4][2], const Unit& u, int wr, int wc, int fr, int fq) const {
        const int row0 = u.pm * 256 + wr * 64 + fr, col0 = u.pn * 256 + wc * 32 + 8 * fq;
        const int b = (u.pm * 256) / SEQ;
        f32x4 gt[2][2];
#pragma unroll
        for (int bj = 0; bj < 2; ++bj)
#pragma unroll
            for (int n = 0; n < 2; ++n) gt[bj][n] = *(const f32x4*)(mod + b * 6144 + 2048 + col0 + bj * 128 + n * 4);
#pragma unroll
        for (int ai = 0; ai < 2; ++ai)
#pragma unroll
            for (int m = 0; m < 4; ++m) { const size_t off = (size_t)(row0 + ai * 128 + m * 16) * D + col0;
#pragma unroll
                for (int bj = 0; bj < 2; ++bj) { const f32x4 x0 = *(const f32x4*)(x + off + bj * 128), x1 = *(const f32x4*)(x + off + bj * 128 + 4);
                    const f32x4 v0 = x0 + gt[bj][0] * acc[ai][bj][m][0], v1 = x1 + gt[bj][1] * acc[ai][bj][m][1];
                    u32x4 w; w.x = cvt_pk_bf16(v0[0], v0[1]); w.y = cvt_pk_bf16(v0[2], v0[3]); w.z = cvt_pk_bf16(v1[0], v1[1]); w.w = cvt_pk_bf16(v1[2], v1[3]);
                    *(u32x4*)(O + off + bj * 128) = w; } }
        return false;
    }
};
struct EpiMoe1 {
    static constexpr bool PERM = true;
    bf16_t* O; unsigned* done;
    __device__ __forceinline__ bool operator()(f32x4 (&acc)[2][2][4][2], const Unit& u, int wr, int wc, int fr, int fq) const {
        const int row0 = u.pm * 256 + wr * 64 + fr, col0 = u.pn * 128 + wc * 32 + 8 * fq;
#pragma unroll
        for (int ai = 0; ai < 2; ++ai)
#pragma unroll
            for (int m = 0; m < 4; ++m) { bf16_t* rowp = O + (size_t)(row0 + ai * 128 + m * 16) * DEXP + col0;
                float h[8];
#pragma unroll
                for (int n = 0; n < 2; ++n)
#pragma unroll
                    for (int e = 0; e < 4; ++e) { const float x_ = acc[ai][0][m][n][e]; h[n * 4 + e] = x_ * __builtin_amdgcn_rcpf(1.0f + __builtin_amdgcn_exp2f(-1.4426950408889634f * x_)) * acc[ai][1][m][n][e]; }
                u32x4 w; w.x = cvt_pk_bf16(h[0], h[1]); w.y = cvt_pk_bf16(h[2], h[3]); w.z = cvt_pk_bf16(h[4], h[5]); w.w = cvt_pk_bf16(h[6], h[7]);
                asm volatile("global_store_dwordx4 %0, %1, off sc1\n\ts_nop 1" :: "v"(rowp), "v"(w) : "memory"); }
        asm volatile("s_waitcnt vmcnt(0)" ::: "memory");
        if ((threadIdx.x & 63) == 0) __hip_atomic_fetch_add(done + 16 * u.pm, 1u, __ATOMIC_RELAXED, __HIP_MEMORY_SCOPE_AGENT);
        return false;
    }
};

struct Frame { LAS unsigned char* lds; int tid, lane, wave, G, bid; };

__device__ __forceinline__ void transpose_item(const float* Wsrc, int ldw, bf16_t* dst, int ldd, LAS float* scr, int lane) {
#pragma unroll 8
    for (int i = 0; i < 32; ++i) { const int kk = 2 * i + (lane >> 5); scr[kk * 33 + (lane & 31)] = __builtin_nontemporal_load(Wsrc + (size_t)kk * ldw + (lane & 31)); }
    asm volatile("s_waitcnt lgkmcnt(0)" ::: "memory");
    const int c = lane & 7;
#pragma unroll
    for (int j = 0; j < 4; ++j) { const int n = (lane >> 3) + 8 * j; const LAS float* s = scr + (8 * c) * 33 + n;
        u32x4 o; o.x = pk2(s[0 * 33], s[1 * 33]); o.y = pk2(s[2 * 33], s[3 * 33]); o.z = pk2(s[4 * 33], s[5 * 33]); o.w = pk2(s[6 * 33], s[7 * 33]);
        *(u32x4*)(dst + (size_t)n * ldd + 8 * c) = o; }
    asm volatile("s_waitcnt lgkmcnt(0)" ::: "memory");
}
__device__ __forceinline__ void transpose_matrix(const Frame& F, const float* W, int K, int N, bf16_t* WT) {
    LAS float* scr = (LAS float*)(F.lds + F.wave * 8448);
    const int gw = F.bid * NWAVES + F.wave, NGW = F.G * NWAVES, nblk = N / 32, items = (K / 64) * nblk;
    for (int it = gw; it < items; it += NGW) { const int kb = it / nblk, nb = it % nblk;
        transpose_item(W + (size_t)(64 * kb) * N + 32 * nb, N, WT + (size_t)(32 * nb) * K + 64 * kb, K, scr, F.lane); }
}

__device__ __forceinline__ void phase0(const Frame& F, const Args& a) {
    unsigned char* ws = a.ws;
    {
        float* modp = (float*)(ws + WS_MODP);
        const float* c = a.in[I_C]; const float* wada = a.in[I_WADA];
        LAS float* cs = (LAS float*)(F.lds + 72 * 1024);
        for (int i = F.tid; i < 4 * D; i += NTHR) cs[i] = siluf_(c[i]);
        __syncthreads();
        for (int wt = F.bid + 256 * F.wave; wt < 384; wt += 256 * NWAVES) {
            if (F.G != 256) break;
            const int ks = wt / 24, jw = wt % 24, j = jw * 256 + F.lane * 4;
            f32x4 s[4] = {{0, 0, 0, 0}, {0, 0, 0, 0}, {0, 0, 0, 0}, {0, 0, 0, 0}};
#pragma unroll 8
            for (int k = ks * 64; k < ks * 64 + 64; ++k) {
                const f32x4 w = *(const f32x4*)(wada + (size_t)k * 6144 + j);
#pragma unroll
                for (int b = 0; b < 4; ++b) s[b] += w * cs[b * D + k];
            }
#pragma unroll
            for (int b = 0; b < 4; ++b) *(f32x4*)(modp + ((size_t)ks * 4 + b) * 6144 + j) = s[b];
        }
        if (F.G != 256) {
            const int gw = F.bid * NWAVES + F.wave, NGW = F.G * NWAVES;
            for (int wt = gw; wt < 384; wt += NGW) {
                const int ks = wt / 24, jw = wt % 24, j = jw * 256 + F.lane * 4;
                f32x4 s[4] = {{0, 0, 0, 0}, {0, 0, 0, 0}, {0, 0, 0, 0}, {0, 0, 0, 0}};
                for (int k = ks * 64; k < ks * 64 + 64; ++k) {
                    const f32x4 w = *(const f32x4*)(wada + (size_t)k * 6144 + j);
#pragma unroll
                    for (int b = 0; b < 4; ++b) { const float cv = siluf_(c[b * D + k]); s[b] += w * cv; }
                }
#pragma unroll
                for (int b = 0; b < 4; ++b) *(f32x4*)(modp + ((size_t)ks * 4 + b) * 6144 + j) = s[b];
            }
        }
    }
    if (F.bid == 0) {
        float* sm = (float*)(ws + WS_SMALL);
        if (F.tid == 0) {
            float s1 = 0.f, s2 = 0.f;
            for (int i = 0; i < 64; ++i) { s1 += a.in[I_LQ1][i] * a.in[I_LK1][i]; s2 += a.in[I_LQ2][i] * a.in[I_LK2][i]; }
            sm[0] = expf(s1) - expf(s2) + 0.2f;
        }
        { const float l0 = a.in[I_LBL][F.tid], l1 = a.in[I_LBL][512 + F.tid]; const float mx = fmaxf(l0, l1);
          const float e0 = expf(l0 - mx), e1 = expf(l1 - mx); sm[16 + F.tid] = e0 / (e0 + e1); }
    }
}
__device__ __forceinline__ void moe_weight_convert(const Frame& F, const Args& a) {
    LAS float* scr = (LAS float*)(F.lds + F.wave * 8448);
    const int gw = F.bid * NWAVES + F.wave, NGW = F.G * NWAVES;
    bf16_t* w13 = (bf16_t*)(a.ws + WS_W13); bf16_t* w2t = (bf16_t*)(a.ws + WS_W2);
    for (int it = gw; it < 2 * NEXP * 256; it += NGW) {
        const int which = it / (NEXP * 256), r = it % (NEXP * 256), e = r >> 8, kb = (r >> 4) & 15, nb = r & 15, n0 = 32 * nb;
        const float* W = a.in[which ? I_W3 : I_W1] + (size_t)e * 1024 * 512;
        const int drow = 256 * (n0 >> 7) + (which ? 128 : 0) + (n0 & 127);
        transpose_item(W + (size_t)(64 * kb) * 512 + n0, 512, w13 + ((size_t)e * 1024 + drow) * 1024 + 64 * kb, 1024, scr, F.lane);
    }
    for (int it = gw; it < NEXP * 256; it += NGW) {
        const int e = it >> 8, kb = (it >> 5) & 7, nb = it & 31;
        const float* W = a.in[I_W2] + (size_t)e * 512 * 1024;
        transpose_item(W + (size_t)(64 * kb) * 1024 + 32 * nb, 1024, w2t + ((size_t)e * 1024 + 32 * nb) * 512 + 64 * kb, 512, scr, F.lane);
    }
}

__device__ __forceinline__ void dense_weight_convert(const Frame& F, const Args& a) {
    unsigned char* ws = a.ws;
    {
        LAS float* scr = (LAS float*)(F.lds + F.wave * 8448);
        const int gw = F.bid * NWAVES + F.wave, NGW = F.G * NWAVES, nblk = INC / 32, items = (D / 64) * nblk;
        bf16_t* WT = (bf16_t*)(ws + WS_WIN);
        for (int it = gw; it < items; it += NGW) { const int kb = it / nblk, n0 = 32 * (it % nblk); int dr = n0;
            if (n0 >= C_QHG && n0 < C_FHG) dr = C_HGT + 256 * ((n0 - C_QHG) >> 7) + ((n0 - C_QHG) & 127);
            else if (n0 >= C_FHG && n0 < C_IHG) dr = C_HGT + 256 * ((n0 - C_FHG) >> 7) + 128 + ((n0 - C_FHG) & 127);
            transpose_item(a.in[I_WIN] + (size_t)(64 * kb) * INC + n0, INC, WT + (size_t)dr * D + 64 * kb, D, scr, F.lane); }
    }
    transpose_matrix(F, a.in[I_WUPDA], 512, D, (bf16_t*)(ws + WS_WUPDA));
    transpose_matrix(F, a.in[I_WUPHG], 512, D, (bf16_t*)(ws + WS_WUPHG));
    transpose_matrix(F, a.in[I_WOUT], D, D, (bf16_t*)(ws + WS_WOUT));
}
__device__ __forceinline__ void phase1(const Frame& F, const Args& a) {
    const float* modp = (const float*)(a.ws + WS_MODP); float* mod = (float*)(a.ws + WS_MOD);
    for (int i = F.bid * NTHR + F.tid; i < 4 * 6144; i += F.G * NTHR) {
        float s = a.in[I_BADA][i % 6144];
        for (int ks = 0; ks < 16; ++ks) s += modp[(size_t)ks * 4 * 6144 + i];
        mod[i] = s;
    }
    LAS float* Gs = (LAS float*)F.lds;
    LAS float* Ss = Gs + 1024;
    bf16_t* H = (bf16_t*)(a.ws + WS_ACT);
    const int rows_per_blk = T / F.G;
    const int r0 = F.bid * rows_per_blk, b = r0 / SEQ;
    for (int k = F.tid; k < 1024; k += NTHR) {
        float sh = a.in[I_BADA][k], sc = a.in[I_BADA][1024 + k];
        for (int ks = 0; ks < 16; ++ks) { sh += modp[((size_t)ks * 4 + b) * 6144 + k]; sc += modp[((size_t)ks * 4 + b) * 6144 + 1024 + k]; }
        Gs[k] = a.in[I_N1G][k] * (1.0f + sc); Ss[k] = sh;
    }
    __syncthreads();
    for (int r = r0 + F.wave; r < r0 + rows_per_blk; r += NWAVES) {
        const f32x4* xr = (const f32x4*)(a.in[I_X] + (size_t)r * D) + F.lane;
        f32x4 v[4]; float s = 0.f;
#pragma unroll
        for (int j = 0; j < 4; ++j) { v[j] = xr[64 * j]; s += (v[j].x * v[j].x + v[j].y * v[j].y) + (v[j].z * v[j].z + v[j].w * v[j].w); }
        const float rs = rsqrtf(wave_sum(s) * (1.0f / D) + EPS);
        unsigned long long* o8 = (unsigned long long*)(H + (size_t)r * D) + F.lane;
#pragma unroll
        for (int j = 0; j < 4; ++j) { const f32x4 g = *(const LAS f32x4*)(Gs + 256 * j + 4 * F.lane), sh = *(const LAS f32x4*)(Ss + 256 * j + 4 * F.lane);
            const f32x4 h = v[j] * rs * g + sh;
            o8[64 * j] = (unsigned long long)pk2(h.x, h.y) | ((unsigned long long)pk2(h.z, h.w) << 32); }
    }
}

namespace attn_body {
using s16x4=__attribute__((ext_vector_type(4)))short;
using f32x16=__attribute__((ext_vector_type(16)))float;
constexpr int NW=8,QBLK=32,QB=QBLK*NW,KVBLK=64,NQB=SEQ/QB;
constexpr int PIN=INC, POUT=1024;
__device__ __forceinline__ int crow(int r,int hi){return (r&3)+8*(r>>2)+4*hi;}
#define SBAR() __builtin_amdgcn_sched_barrier(0)
__device__ __forceinline__ void bmask(f32x16&p0,f32x16&p1,int jb,int wch,int il,int hi,float s2x2){
  if(jb>wch){
    #pragma unroll
    for(int r=0;r<16;++r){p0[r]=-INFINITY;p1[r]=-INFINITY;}
  } else if(jb==wch){
    float fb=(float)(4*hi-il); asm volatile("":"+v"(fb));
    #pragma unroll
    for(int r=0;r<16;++r){const float c=(float)((r&3)+8*(r>>2)); p0[r]-=s2x2*__builtin_fmaxf(fb+c,0.f); p1[r]-=s2x2*__builtin_fmaxf(fb+(c+32.f),0.f);}
  }
}
constexpr int NSLOT=3, SLOTB=8192, VSLOTB=16384;
constexpr int LDS_K=0, LDS_V=NSLOT*SLOTB, LDS_WS=LDS_V+NSLOT*VSLOTB, LDS_OST=LDS_WS+NW*64*4, ATT_LDS_BYTES=LDS_OST+NW*8192;
constexpr float C2=0.125f*1.4426950408889634f;
__device__ __forceinline__ void glds16(const void*gsrc,unsigned lds_dst){unsigned keep;
  asm volatile("s_mov_b32 %0, m0\n\ts_mov_b32 m0, %2\n\ts_nop 0\n\tglobal_load_lds_dwordx4 %1, off\n\ts_mov_b32 m0, %0":"=&s"(keep):"v"(gsrc),"s"(lds_dst):"memory");}
__device__ __forceinline__ float max3f(float a,float b,float c){float r;asm("v_max3_f32 %0, %1, %2, %3":"=v"(r):"v"(a),"v"(b),"v"(c));return r;}
__device__ __forceinline__ float max2f(float a,float b){float r;asm("v_max_f32_e32 %0, %1, %2":"=v"(r):"v"(a),"v"(b));return r;}
__device__ __forceinline__ float fadd_s(float a,float b){float r;asm("v_add_f32_e32 %0, %1, %2":"=v"(r):"v"(a),"v"(b));return r;}
__device__ __forceinline__ float fsub_s(float a,float b){float r;asm("v_sub_f32_e32 %0, %1, %2":"=v"(r):"v"(a),"v"(b));return r;}
typedef float f32x2_t __attribute__((ext_vector_type(2))); typedef __bf16 bf16x2_t __attribute__((ext_vector_type(2)));
__device__ __forceinline__ unsigned cvtpk_s(float lo,float hi){f32x2_t v={lo,hi};bf16x2_t b=__builtin_convertvector(v,bf16x2_t);return __builtin_bit_cast(unsigned,b);}
#define WAIT_BAR(N) asm volatile("s_waitcnt vmcnt(" #N ") lgkmcnt(0)\n\ts_barrier":::"memory")

__device__ __forceinline__ void qkt(f32x16&p0,f32x16&p1,const char*Kslot,const bf16x8*qr,const f32x16&c0,const f32x16&c1,int r32,int hi){
  const char*kb=Kslot+hi*1024+r32*16;
  #pragma unroll
  for(int d0=0;d0<4;++d0){
    const bf16x8 b0=*reinterpret_cast<const bf16x8*>(kb+d0*2048);
    const bf16x8 b1=*reinterpret_cast<const bf16x8*>(kb+d0*2048+512);
    if(d0==0){p0=__builtin_amdgcn_mfma_f32_32x32x16_bf16(b0,qr[0],c0,0,0,0);p1=__builtin_amdgcn_mfma_f32_32x32x16_bf16(b1,qr[0],c1,0,0,0);}
    else{p0=__builtin_amdgcn_mfma_f32_32x32x16_bf16(b0,qr[d0],p0,0,0,0);p1=__builtin_amdgcn_mfma_f32_32x32x16_bf16(b1,qr[d0],p1,0,0,0);}}
}
typedef __attribute__((address_space(3))) const char* lds_cptr;
typedef short v4i16_t __attribute__((ext_vector_type(4)));
__device__ __forceinline__ void kload8(bf16x8*kf,lds_cptr kp){
  kf[0]=*(const __attribute__((address_space(3))) bf16x8*)(kp);      kf[1]=*(const __attribute__((address_space(3))) bf16x8*)(kp+512);
  kf[2]=*(const __attribute__((address_space(3))) bf16x8*)(kp+2048); kf[3]=*(const __attribute__((address_space(3))) bf16x8*)(kp+2560);
  kf[4]=*(const __attribute__((address_space(3))) bf16x8*)(kp+4096); kf[5]=*(const __attribute__((address_space(3))) bf16x8*)(kp+4608);
  kf[6]=*(const __attribute__((address_space(3))) bf16x8*)(kp+6144); kf[7]=*(const __attribute__((address_space(3))) bf16x8*)(kp+6656);
}
__device__ __forceinline__ void kload2(bf16x8*kf,lds_cptr kp,int j){ kf[2*j]=*(const __attribute__((address_space(3))) bf16x8*)(kp+j*2048); kf[2*j+1]=*(const __attribute__((address_space(3))) bf16x8*)(kp+j*2048+512); }
__device__ __forceinline__ s16x4 vtr(lds_cptr p){ return __builtin_bit_cast(s16x4,__builtin_amdgcn_ds_read_tr16_b64_v4i16((__attribute__((address_space(3))) v4i16_t*)p)); }
__device__ __forceinline__ float rowmax(const f32x16&p0,const f32x16&p1){
  float a=max3f(p0[0],p0[1],p1[0]),b=max3f(p0[2],p0[3],p1[1]);a=max3f(a,p1[2],p1[3]);
  #pragma unroll
  for(int r=4;r<16;r+=4){a=max3f(a,p0[r],p0[r+1]);b=max3f(b,p0[r+2],p0[r+3]);a=max3f(a,p1[r],p1[r+1]);b=max3f(b,p1[r+2],p1[r+3]);}
  const float m=max2f(a,b);
  auto rr=__builtin_amdgcn_permlane32_swap(__float_as_uint(m),__float_as_uint(m),false,false);
  return max2f(__uint_as_float(rr[0]),__uint_as_float(rr[1]));
}
__device__ __forceinline__ void pv(f32x16*o,int vb,bf16x8 pa0,bf16x8 pa1,bf16x8 pa2,bf16x8 pa3){
  #pragma unroll
  for(int d0=0;d0<4;++d0){s16x4 lo[4],hi[4];
    #pragma unroll
    for(int ks=0;ks<4;++ks){
      asm volatile("ds_read_b64_tr_b16 %0,%1 offset:%c2":"=&v"(lo[ks]):"v"(vb),"i"(d0*4096+ks*1024):"memory");
      asm volatile("ds_read_b64_tr_b16 %0,%1 offset:%c2":"=&v"(hi[ks]):"v"(vb),"i"(d0*4096+ks*1024+512):"memory");}
    asm volatile("s_waitcnt lgkmcnt(0)":::"memory");SBAR();
    #define PK(k) (bf16x8){lo[k][0],lo[k][1],lo[k][2],lo[k][3],hi[k][0],hi[k][1],hi[k][2],hi[k][3]}
    o[d0]=__builtin_amdgcn_mfma_f32_32x32x16_bf16(pa0,PK(0),o[d0],0,0,0);
    o[d0]=__builtin_amdgcn_mfma_f32_32x32x16_bf16(pa1,PK(1),o[d0],0,0,0);
    o[d0]=__builtin_amdgcn_mfma_f32_32x32x16_bf16(pa2,PK(2),o[d0],0,0,0);
    o[d0]=__builtin_amdgcn_mfma_f32_32x32x16_bf16(pa3,PK(3),o[d0],0,0,0);
    #undef PK
  }
}
#define ATTN_STORE16(p,v) (*(u32x4*)(p)=(v))
template<int THRL> __device__ __forceinline__ void attn_unit(int qb,const bf16_t*Qb,const bf16_t*__restrict__ Kh,const bf16_t*__restrict__ Vh,bf16_t*Ob,float slope2,char*shm){
  const int wid=__builtin_amdgcn_readfirstlane(threadIdx.x>>6); const int lane=lane_now(),r32=lane&31,hi=lane>>5;
  const int q0=qb*QB;
  const bf16_t*Qw=Qb+(long)(q0+wid*QBLK)*PIN;
  const unsigned lds0=(unsigned)(uintptr_t)shm;
  float*wsf=(float*)(shm+LDS_WS)+wid*64;
  const bf16_t*ksrc=Kh+(long)lane*PIN+wid*8;
  const bf16_t*vsrc=Vh+(long)(16*(wid&3)+(lane>>2))*PIN+(wid>>2)*32+(lane&3)*8;
  const unsigned kdst=lds0+LDS_K+wid*1024, vdst=lds0+LDS_V+(wid>>2)*4096+(wid&3)*1024;
  #define DMA_K(t,slot) glds16(ksrc+(long)(t)*KVBLK*PIN,(unsigned)__builtin_amdgcn_readfirstlane(kdst+(slot)))
  #define DMA_V(t,slot) do{ glds16(vsrc+(long)(t)*KVBLK*PIN,(unsigned)__builtin_amdgcn_readfirstlane(vdst+2*(slot))); glds16(vsrc+(long)(t)*KVBLK*PIN+64,(unsigned)__builtin_amdgcn_readfirstlane(vdst+2*(slot)+8192)); }while(0)
  const int vb0=(int)(lds0+LDS_V)+((lane>>4)&1)*32+(lane&3)*8+(4*hi+((lane&15)>>2))*64;
  const char*Kbase=shm+LDS_K; bf16x8 kf[8];
  const lds_cptr shm3=(lds_cptr)shm; const lds_cptr kp0=shm3+LDS_K+hi*1024+r32*16; const lds_cptr vp0=shm3+LDS_V+((lane>>4)&1)*32+(lane&3)*8+(4*hi+((lane&15)>>2))*64;
  const int NT=(q0+QB)/KVBLK;
  DMA_K(0,0);DMA_V(0,0);DMA_K(1,SLOTB);
  bf16x8 qr[4];
  #pragma unroll
  for(int d0=0;d0<4;++d0)qr[d0]=*reinterpret_cast<const bf16x8*>(&Qw[(long)r32*PIN+d0*16+hi*8]);
  float mhat=0.f,l_reg=0.f;f32x16 o[4];o[0]=f32x16{};o[1]=f32x16{};o[2]=f32x16{};o[3]=f32x16{};
  const float s64=slope2*64.f, s32=slope2*32.f, s2x2=2.f*slope2, s4hi=slope2*4.f*(float)hi;
  const int wch=wid>>1, il=32*(wid&1)+r32;
  #define CMASK(P0,P1,t) do{int jb_=(t)-(NT-4); if(jb_>=0)bmask(P0,P1,jb_,wch,il,hi,s2x2);}while(0)
  #define CINIT0(C0,t) do{ const float bt_=s64*(float)((t)-NT)-mhat+s4hi; _Pragma("unroll") for(int r=0;r<16;++r){C0[r]=__builtin_fmaf(slope2,(float)((r&3)+8*(r>>2)),bt_);} }while(0)
  #define CINIT1(C1,t) do{ const float bu_=s64*(float)((t)-NT)-mhat+s4hi+s32; _Pragma("unroll") for(int r=0;r<16;++r){C1[r]=__builtin_fmaf(slope2,(float)((r&3)+8*(r>>2)),bu_);} }while(0)
  bool resc=false;
  #define START(P0,P1) do{ const float rm=rowmax(P0,P1); resc=false; \
    { const float dl=rm; mhat=fadd_s(mhat,dl); \
      _Pragma("unroll") for(int r=0;r<16;++r){P0[r]=fsub_s(P0[r],dl);P1[r]=fsub_s(P1[r],dl);} } \
    _Pragma("unroll") for(int r=0;r<16;++r)P0[r]=__builtin_amdgcn_exp2f(P0[r]); }while(0)
  #define RESC() do{ if(resc){ asm volatile("s_waitcnt lgkmcnt(0)":::"memory"); \
      _Pragma("unroll") for(int d_=0;d_<4;++d_) _Pragma("unroll") for(int r=0;r<16;++r)o[d_][r]*=wsf[crow(r,hi)]; } }while(0)
  f32x16 cS0,cS1;
  u32x4 pwa0,pwa1,pwa2,pwa3,pwb0,pwb1,pwb2,pwb3;
  int sl_prev=0,sl_cur=0,sl_next=SLOTB;
  #define ROT() do{sl_prev=sl_cur;sl_cur=sl_next;sl_next=(sl_next==(NSLOT-1)*SLOTB)?0:sl_next+SLOTB;}while(0)
  #define PKW(P,B) cvtpk_s(P[B],P[B+1])
  DMA_K(2,2*SLOTB);
  WAIT_BAR(3);
  { f32x16 c0,c1; CINIT0(c0,0); CINIT1(c1,0); qkt(cS0,cS1,Kbase,qr,c0,c1,r32,hi); }
  asm volatile("s_nop 15\n\ts_nop 7":"+v"(cS0),"+v"(cS1));CMASK(cS0,cS1,0);
  START(cS0,cS1);
  _Pragma("unroll") for(int r=0;r<16;++r)cS1[r]=__builtin_amdgcn_exp2f(cS1[r]);
  { float sacc=cS0[0]+cS0[1]; _Pragma("unroll") for(int r=2;r<16;++r)sacc+=cS0[r]; _Pragma("unroll") for(int r=0;r<16;++r)sacc+=cS1[r]; l_reg+=sacc;
    pwa0=(u32x4){PKW(cS0,0),PKW(cS0,2),PKW(cS0,4),PKW(cS0,6)};pwa1=(u32x4){PKW(cS0,8),PKW(cS0,10),PKW(cS0,12),PKW(cS0,14)};pwa2=(u32x4){PKW(cS1,0),PKW(cS1,2),PKW(cS1,4),PKW(cS1,6)};pwa3=(u32x4){PKW(cS1,8),PKW(cS1,10),PKW(cS1,12),PKW(cS1,14)}; }
  WAIT_BAR(0);
  DMA_K(3,0);DMA_V(1,SLOTB);
  ROT();
  kload8(kf,kp0+sl_cur);
  WAIT_BAR(3);
  s16x4 vlo[4],vhi[4];
  #define CAT_(a,b) a##b
  #define CAT(a,b) CAT_(a,b)
  #define PAFC(P,k) __builtin_bit_cast(bf16x8,CAT(P,k))
  #define VFR(k) (bf16x8){vlo[(k)&3][0],vlo[(k)&3][1],vlo[(k)&3][2],vlo[(k)&3][3],vhi[(k)&3][0],vhi[(k)&3][1],vhi[(k)&3][2],vhi[(k)&3][3]}
  #define VOFF(k) ((k)<8 ? (((k)&1)*4096+((k)>>1)*1024) : ((2+((k)&1))*4096+(((k)-8)>>1)*1024))
  #define PIN_(x) asm volatile("":"+v"(x))
  #define MX3(a,b,c) __builtin_fmaxf(__builtin_fmaxf((a),(b)),(c))
  #define QK(MF) do{ MF; SBAR(); }while(0)
  #define EX(v) __builtin_amdgcn_exp2f(v)
  #define VRD(k) do{ vlo[(k)&3]=vtr(vp_+VOFF(k)); vhi[(k)&3]=vtr(vp_+(VOFF(k)+512)); }while(0)
  #define VNX(k) do{ if((k)+4<16){ VRD((k)+4); } SBAR(); }while(0)
  #define GAPB3(MF,X,B,PW,J) do{ MF; X[B]=EX(X[B]); X[B+1]=EX(X[B+1]); sacc+=X[B]; sacc+=X[B+1]; PW[J]=cvtpk_s(X[B],X[B+1]); PIN_(X); PIN_(sacc); PIN_(PW); SBAR(); }while(0)
  #define KRD(G,j) do{ if(G){ kload2(kf,kp0+sl_next,j); SBAR(); } }while(0)
  #define STEP(PC,PN,t,GK,GV,GL) do{ SBAR(); \
    CINIT0(cS0,t); SBAR(); \
    const lds_cptr vp_=vp0+2*sl_prev; \
    VRD(0); SBAR(); QK(cS0=__builtin_amdgcn_mfma_f32_32x32x16_bf16(kf[0],qr[0],cS0,0,0,0)); \
    CINIT1(cS1,t); VRD(1); SBAR(); QK(cS1=__builtin_amdgcn_mfma_f32_32x32x16_bf16(kf[1],qr[0],cS1,0,0,0)); \
    VRD(2); SBAR(); QK(cS0=__builtin_amdgcn_mfma_f32_32x32x16_bf16(kf[2],qr[1],cS0,0,0,0)); \
    VRD(3); SBAR(); QK(cS1=__builtin_amdgcn_mfma_f32_32x32x16_bf16(kf[3],qr[1],cS1,0,0,0)); \
    QK(cS0=__builtin_amdgcn_mfma_f32_32x32x16_bf16(kf[4],qr[2],cS0,0,0,0)); \
    QK(cS1=__builtin_amdgcn_mfma_f32_32x32x16_bf16(kf[5],qr[2],cS1,0,0,0)); \
    QK(cS0=__builtin_amdgcn_mfma_f32_32x32x16_bf16(kf[6],qr[3],cS0,0,0,0)); \
    QK(cS1=__builtin_amdgcn_mfma_f32_32x32x16_bf16(kf[7],qr[3],cS1,0,0,0)); \
    if(GK){DMA_K((t)+3,sl_cur);} if(GV){DMA_V((t)+1,sl_next);} \
    CMASK(cS0,cS1,t); \
    { float a=MX3(cS0[0],cS0[1],cS1[0]),b=MX3(cS0[2],cS0[3],cS1[1]); a=MX3(a,cS1[2],cS1[3]); \
      _Pragma("unroll") for(int r=4;r<16;r+=4){a=MX3(a,cS0[r],cS0[r+1]);b=MX3(b,cS0[r+2],cS0[r+3]);a=MX3(a,cS1[r],cS1[r+1]);b=MX3(b,cS1[r+2],cS1[r+3]);} \
      float rm=__builtin_fmaxf(a,b); { auto rr=__builtin_amdgcn_permlane32_swap(__float_as_uint(rm),__float_as_uint(rm),false,false); rm=__builtin_fmaxf(__uint_as_float(rr[0]),__uint_as_float(rr[1])); } \
      resc=false; \
      if(__builtin_expect(__any(rm>(float)THRL),0)){ const float dl=__builtin_fmaxf(rm,0.f); mhat+=dl; \
        _Pragma("unroll") for(int r=0;r<16;++r){cS0[r]-=dl;cS1[r]-=dl;} \
        const float f=__builtin_amdgcn_exp2f(-dl); l_reg*=f; if(hi==0)wsf[r32]=f; resc=true; } } \
    SBAR(); float sacc=0.f; \
    GAPB3(o[0]=__builtin_amdgcn_mfma_f32_32x32x16_bf16(PAFC(PC,0),VFR(0),o[0],0,0,0), cS0,0, CAT(PN,0),0); VNX(0); \
    GAPB3(o[1]=__builtin_amdgcn_mfma_f32_32x32x16_bf16(PAFC(PC,0),VFR(1),o[1],0,0,0), cS0,2, CAT(PN,0),1); VNX(1); \
    KRD(GL,0); GAPB3(o[0]=__builtin_amdgcn_mfma_f32_32x32x16_bf16(PAFC(PC,1),VFR(2),o[0],0,0,0), cS0,4, CAT(PN,0),2); VNX(2); \
    KRD(GL,1); GAPB3(o[1]=__builtin_amdgcn_mfma_f32_32x32x16_bf16(PAFC(PC,1),VFR(3),o[1],0,0,0), cS0,6, CAT(PN,0),3); VNX(3); \
    KRD(GL,2); GAPB3(o[0]=__builtin_amdgcn_mfma_f32_32x32x16_bf16(PAFC(PC,2),VFR(4),o[0],0,0,0), cS0,8, CAT(PN,1),0); VNX(4); \
    KRD(GL,3); GAPB3(o[1]=__builtin_amdgcn_mfma_f32_32x32x16_bf16(PAFC(PC,2),VFR(5),o[1],0,0,0), cS0,10, CAT(PN,1),1); VNX(5); \
    GAPB3(o[0]=__builtin_amdgcn_mfma_f32_32x32x16_bf16(PAFC(PC,3),VFR(6),o[0],0,0,0), cS0,12, CAT(PN,1),2); VNX(6); \
    GAPB3(o[1]=__builtin_amdgcn_mfma_f32_32x32x16_bf16(PAFC(PC,3),VFR(7),o[1],0,0,0), cS0,14, CAT(PN,1),3); VNX(7); \
    GAPB3(o[2]=__builtin_amdgcn_mfma_f32_32x32x16_bf16(PAFC(PC,0),VFR(8),o[2],0,0,0), cS1,0, CAT(PN,2),0); VNX(8); \
    GAPB3(o[3]=__builtin_amdgcn_mfma_f32_32x32x16_bf16(PAFC(PC,0),VFR(9),o[3],0,0,0), cS1,2, CAT(PN,2),1); VNX(9); \
    GAPB3(o[2]=__builtin_amdgcn_mfma_f32_32x32x16_bf16(PAFC(PC,1),VFR(10),o[2],0,0,0), cS1,4, CAT(PN,2),2); VNX(10); \
    GAPB3(o[3]=__builtin_amdgcn_mfma_f32_32x32x16_bf16(PAFC(PC,1),VFR(11),o[3],0,0,0), cS1,6, CAT(PN,2),3); VNX(11); \
    GAPB3(o[2]=__builtin_amdgcn_mfma_f32_32x32x16_bf16(PAFC(PC,2),VFR(12),o[2],0,0,0), cS1,8, CAT(PN,3),0); VNX(12); \
    GAPB3(o[3]=__builtin_amdgcn_mfma_f32_32x32x16_bf16(PAFC(PC,2),VFR(13),o[3],0,0,0), cS1,10, CAT(PN,3),1); VNX(13); \
    GAPB3(o[2]=__builtin_amdgcn_mfma_f32_32x32x16_bf16(PAFC(PC,3),VFR(14),o[2],0,0,0), cS1,12, CAT(PN,3),2); VNX(14); \
    GAPB3(o[3]=__builtin_amdgcn_mfma_f32_32x32x16_bf16(PAFC(PC,3),VFR(15),o[3],0,0,0), cS1,14, CAT(PN,3),3); VNX(15); \
    l_reg+=sacc; \
    }while(0)
  int t=1;
  #undef CMASK
  #define CMASK(P0,P1,t) do{}while(0)
  for(;t+5<NT;t+=2){
    STEP(pwa,pwb,t,true,true,true);     WAIT_BAR(3); RESC(); ROT();
    STEP(pwb,pwa,t+1,true,true,true);   WAIT_BAR(3); RESC(); ROT();
  }
  #undef CMASK
  #define CMASK(P0,P1,t) do{int jb_=(t)-(NT-4); if(jb_>=0)bmask(P0,P1,jb_,wch,il,hi,s2x2);}while(0)
  #define ENDW(tt) do{ if((tt)+3<NT){WAIT_BAR(3);} else if((tt)+2<NT){WAIT_BAR(2);} else {WAIT_BAR(0);} }while(0)
  for(;t+1<NT;t+=2){
    STEP(pwa,pwb,t,(t+3<NT),(t+1<NT),(t+1<NT));       ENDW(t);   RESC(); ROT();
    STEP(pwb,pwa,t+1,(t+4<NT),(t+2<NT),(t+2<NT));     ENDW(t+1); RESC(); ROT();
  }
  STEP(pwa,pwb,NT-1,false,false,false); RESC();
  SBAR(); pv(o,vb0+2*sl_cur,PAFC(pwb,0),PAFC(pwb,1),PAFC(pwb,2),PAFC(pwb,3));
  #undef PKW
  #undef PAFC
  #undef CAT
  #undef CAT_
  #undef QK
  #undef GAPB3
  #undef VFR
  #undef PIN_
  #undef MX3
  #undef EX
  #undef VRD
  #undef VNX
  #undef VOFF
  #undef GAPB2
  #undef KRD
  #undef STEP
  #undef ENDW
  {auto rr=__builtin_amdgcn_permlane32_swap(__float_as_uint(l_reg),__float_as_uint(l_reg),false,false);l_reg=__uint_as_float(rr[0])+__uint_as_float(rr[1]);}
  {
    const int le=lane_now(), r32e=le&31, hie=le>>5;
    float*wsfe=(float*)(shm+LDS_WS)+wid*64;
    if(hie==0)wsfe[32+r32e]=l_reg;asm volatile("s_waitcnt lgkmcnt(0)":::"memory");
    float rli[16];
    #pragma unroll
    for(int r=0;r<16;++r)rli[r]=__builtin_amdgcn_rcpf(wsfe[32+crow(r,hie)]);
    bf16_t*Ow=Ob+(long)(q0+wid*QBLK)*POUT;
    bf16_t*stg=(bf16_t*)(shm+LDS_OST)+wid*4096;
    #pragma unroll
    for(int r=0;r<16;++r){const int orow=crow(r,hie);
      #pragma unroll
      for(int d0=0;d0<4;++d0)stg[orow*128+d0*32+r32e]=(bf16_t)f2bf(o[d0][r]*rli[r]);}
    asm volatile("s_waitcnt lgkmcnt(0)":::"memory");
    #pragma unroll
    for(int i=0;i<8;++i){const int row=i*4+(le>>4),ch=le&15; const u32x4 v=*(const u32x4*)(stg+row*128+ch*8); ATTN_STORE16(Ow+(long)row*POUT+ch*8,v);} }
  asm volatile("s_waitcnt lgkmcnt(0)\n\ts_barrier":::"memory");
  #undef DMA_K
  #undef DMA_V
  #undef CMASK
  #undef CINIT0
  #undef CINIT1
  #undef START
  #undef RESC
  #undef ROT
}
#undef SBAR
#undef WAIT_BAR
}

__device__ __forceinline__ void attn_phase(const Frame& F, const Args& a) {
    const bf16_t* proj = (const bf16_t*)(a.ws + WS_PROJ); bf16_t* OA = (bf16_t*)(a.ws + WS_OA);
    const int vcu = (F.G % 8 == 0) ? (F.bid % 8) * (F.G / 8) + F.bid / 8 : F.bid;
    for (int i = 0;; ++i) {
        int bhm, qb;
        if (F.G == 256) { if (i >= 2) break; const int s_ = vcu & 7; bhm = vcu >> 3; qb = (i == 0) ? 15 - s_ : s_; }
        else { const int u = i * F.G + F.bid; if (u >= 512) break; bhm = u >> 4; qb = 15 - (u & 15); }
        const int b = bhm >> 3, h = (bhm >> 1) & 3, map = bhm & 1;
        const bf16_t* base = proj + (size_t)b * SEQ * INC;
        const float slope2 = exp2f(-2.0f * (h + 1)) * 1.4426950408889634f;
        attn_body::attn_unit<8>(qb, base + C_QDA + h * 128 + map * 64, base + C_KDA + h * 128 + map * 64, base + C_VDA + h * 128,
                                OA + (size_t)b * SEQ * 1024 + h * 256 + map * 128, slope2, (char*)F.lds);
    }
}
__device__ __forceinline__ void attn_combine(const Frame& F, const Args& a) {
    const bf16_t* OA = (const bf16_t*)(a.ws + WS_OA); bf16_t* Y = (bf16_t*)(a.ws + WS_YDA);
    const float lam = ((const float*)(a.ws + WS_SMALL))[0];
    const float g0 = a.in[I_SUBG][2 * F.lane] * 0.8f, g1 = a.in[I_SUBG][2 * F.lane + 1] * 0.8f;
    const int gw = F.bid * NWAVES + F.wave, NGW = F.G * NWAVES;
    for (int r = gw; r < T; r += NGW) {
        const unsigned* orow = (const unsigned*)(OA + (size_t)r * 1024); unsigned* yrow = (unsigned*)(Y + (size_t)r * 512);
        unsigned w0[4], w1[4];
#pragma unroll
        for (int h = 0; h < 4; ++h) { w0[h] = orow[h * 128 + F.lane]; w1[h] = orow[h * 128 + 64 + F.lane]; }
#pragma unroll
        for (int h = 0; h < 4; ++h) {
            const float x0 = bf2f(w0[h] & 0xffffu) - lam * bf2f(w1[h] & 0xffffu), x1 = bf2f(w0[h] >> 16) - lam * bf2f(w1[h] >> 16);
            const float rs = rsqrtf(wave_sum(x0 * x0 + x1 * x1) * (1.0f / 128.0f) + EPS);
            yrow[h * 64 + F.lane] = pk2(x0 * rs * g0, x1 * rs * g1);
        }
    }
}
namespace hg {
constexpr int QP = 136;
constexpr int L_QD = 0, L_KD = 64 * QP * 2, L_V = 2 * 64 * QP * 2, L_KE = 3 * 64 * QP * 2, L_SSQ = 4 * 64 * QP * 2, L_G = L_SSQ + 512, L_ST = L_G + 64 * QP * 2;
__device__ __forceinline__ f32x4 mfma16(bf16x8 a, bf16x8 b, f32x4 c) { return __builtin_amdgcn_mfma_f32_16x16x32_bf16(a, b, c, 0, 0, 0); }
#define HG_BAR() do { asm volatile("s_waitcnt lgkmcnt(0)" ::: "memory"); __builtin_amdgcn_s_barrier(); asm volatile("" ::: "memory"); } while (0)
typedef short v4i16_t __attribute__((ext_vector_type(4)));
__device__ __forceinline__ bf16x8 tr8(const LAS unsigned char* img, int ra, int rb, int col0, int lane) {
    const int q = (lane & 15) >> 2, p = lane & 3;
    const v4i16_t lo = __builtin_amdgcn_ds_read_tr16_b64_v4i16((LAS v4i16_t*)(img + ((ra + q) * QP + col0 + 4 * p) * 2));
    const v4i16_t hi = __builtin_amdgcn_ds_read_tr16_b64_v4i16((LAS v4i16_t*)(img + ((rb + q) * QP + col0 + 4 * p) * 2));
    return (bf16x8){lo[0], lo[1], lo[2], lo[3], hi[0], hi[1], hi[2], hi[3]};
}
struct Tile { u32x4 p[2]; };
__device__ __forceinline__ void tile_load(Tile& t, const bf16_t* src, size_t pitch, int tid) {
#pragma unroll
    for (int i = 0; i < 2; ++i) { const int pc = tid + NTHR * i; t.p[i] = *(const u32x4*)(src + (size_t)(pc >> 4) * pitch + (pc & 15) * 8); }
}
__device__ __forceinline__ void tile_put(const Tile& t, LAS unsigned char* img, int tid) {
#pragma unroll
    for (int i = 0; i < 2; ++i) { const int pc = tid + NTHR * i; *(LAS u32x4*)(img + ((pc >> 4) * QP + (pc & 15) * 8) * 2) = t.p[i]; }
}
constexpr int PP = 72;
constexpr int G4_L_P = 4 * 64 * QP * 2, G4_L_DEC = G4_L_P + 64 * PP * 2, G4_L_SSQ = G4_L_DEC + 512;
struct InA { Tile qd, kd, ke, v; f32x4 dec; };
__device__ __forceinline__ void loadA(InA& r, const Frame& F, const Args& a, int bh, int n) {
    const int b = bh >> 2, h = bh & 3; const size_t t0 = (size_t)b * SEQ + n * 64;
    const bf16_t* base = (const bf16_t*)(a.ws + WS_PROJ) + t0 * INC;
    tile_load(r.qd, base + C_HGT + 256 * h, INC, F.tid); tile_load(r.kd, base + C_HGT + 256 * h + 128, INC, F.tid);
    tile_load(r.ke, (const bf16_t*)a.out + t0 * 512 + h * 128, 512, F.tid); tile_load(r.v, base + C_IHG + h * 128, INC, F.tid);
    r.dec = *(const f32x4*)((const float*)(a.ws + WS_DEC) + ((size_t)bh * 64 + n) * 128 + 4 * (F.tid & 31));
}
__device__ __forceinline__ void grp_local(const Frame& F, const Args& a, int grp) {
    const int bh = grp >> 4, n0 = 4 * (grp & 15), b = bh >> 2, h = bh & 3, w = F.wave, lane = F.lane, fr = lane & 15, fq = lane >> 4;
    for (int i = F.tid; i < 64 * PP / 2; i += NTHR) ((LAS unsigned*)(F.lds + G4_L_P))[i] = 0u;
    f32x4 S[8];
#pragma unroll
    for (int kt = 0; kt < 8; ++kt) S[kt] = (f32x4){0.f, 0.f, 0.f, 0.f};
    InA cur, nxt; loadA(cur, F, a, bh, n0);
    unsigned short yk[4][4];
#define G4_STORE(nn) do { bf16_t* yp_ = (bf16_t*)(a.ws + WS_YHG) + ((size_t)b * SEQ + (nn) * 64 + 4 * fq) * 512 + h * 128 + 16 * w + fr; \
        _Pragma("unroll") for (int tb = 0; tb < 4; ++tb) _Pragma("unroll") for (int r = 0; r < 4; ++r) yp_[(size_t)(16 * tb + r) * 512] = yk[tb][r]; } while (0)
    for (int j = 0; j < 4; ++j) {
        if (j > 0) G4_STORE(n0 + j - 1);
        loadA(nxt, F, a, bh, n0 + (j < 3 ? j + 1 : 3));
        tile_put(cur.qd, F.lds + L_QD, F.tid); tile_put(cur.kd, F.lds + L_KD, F.tid); tile_put(cur.ke, F.lds + L_KE, F.tid); tile_put(cur.v, F.lds + L_V, F.tid);
        if (F.tid < 32) *(LAS f32x4*)(F.lds + G4_L_DEC + 16 * F.tid) = cur.dec;
        HG_BAR();
#pragma unroll
        for (int rep = 0; rep < 2; ++rep) { const int pi = w + 8 * rep;
            if (pi < 10) { const int tb = pi >= 6 ? 3 : pi >= 3 ? 2 : pi >= 1 ? 1 : 0, jt = pi - (tb * (tb + 1)) / 2;
                f32x4 sc = (f32x4){0.f, 0.f, 0.f, 0.f};
#pragma unroll
                for (int ks = 0; ks < 4; ++ks) { const bf16x8 kf = *(const LAS bf16x8*)(F.lds + L_KD + ((16 * jt + fr) * QP + 32 * ks + 8 * fq) * 2);
                    const bf16x8 qf = *(const LAS bf16x8*)(F.lds + L_QD + ((16 * tb + fr) * QP + 32 * ks + 8 * fq) * 2); sc = mfma16(kf, qf, sc); }
                if (jt == tb) {
#pragma unroll
                    for (int r = 0; r < 4; ++r) if (4 * fq + r > fr) sc[r] = 0.f;
                }
                *(LAS u32x2*)(F.lds + G4_L_P + ((16 * tb + fr) * PP + 16 * jt + 4 * fq) * 2) = (u32x2){cvt_pk_bf16(sc[0], sc[1]), cvt_pk_bf16(sc[2], sc[3])}; } }
        HG_BAR();
        bf16x8 bv[2];
#pragma unroll
        for (int s2 = 0; s2 < 2; ++s2) bv[s2] = tr8(F.lds + L_V, 32 * s2 + 8 * fq, 32 * s2 + 8 * fq + 4, 16 * w, lane);
        bf16x8 Sb[4];
#pragma unroll
        for (int ks = 0; ks < 4; ++ks) { const u32x4 t = (u32x4){cvt_pk_bf16(S[2 * ks][0], S[2 * ks][1]), cvt_pk_bf16(S[2 * ks][2], S[2 * ks][3]), cvt_pk_bf16(S[2 * ks + 1][0], S[2 * ks + 1][1]), cvt_pk_bf16(S[2 * ks + 1][2], S[2 * ks + 1][3])};
            Sb[ks] = __builtin_bit_cast(bf16x8, t); }
#pragma unroll
        for (int tb = 0; tb < 4; ++tb) { f32x4 o = (f32x4){0.f, 0.f, 0.f, 0.f};
#pragma unroll
            for (int s2 = 0; s2 <= (tb >> 1); ++s2) { const bf16x8 pf = *(const LAS bf16x8*)(F.lds + G4_L_P + ((16 * tb + fr) * PP + 32 * s2 + 8 * fq) * 2); o = mfma16(pf, bv[s2], o); }
            if (j > 0) {
#pragma unroll
                for (int ks = 0; ks < 4; ++ks) { const LAS unsigned char* qrow = F.lds + L_QD + ((16 * tb + fr) * QP + 32 * ks + 4 * fq) * 2;
                    const u32x2 lo = *(const LAS u32x2*)qrow, hi = *(const LAS u32x2*)(qrow + 32);
                    const u32x4 aw = (u32x4){lo.x, lo.y, hi.x, hi.y}; o = mfma16(__builtin_bit_cast(bf16x8, aw), Sb[ks], o); } }
#pragma unroll
            for (int r = 0; r < 4; ++r) yk[tb][r] = (unsigned short)f2bf(o[r]); }
#pragma unroll
        for (int kt = 0; kt < 8; ++kt) { S[kt] = S[kt] * *(const LAS f32x4*)(F.lds + G4_L_DEC + (16 * kt + 4 * fq) * 4);
#pragma unroll
            for (int s2 = 0; s2 < 2; ++s2) S[kt] = mfma16(tr8(F.lds + L_KE, 32 * s2 + 8 * fq, 32 * s2 + 8 * fq + 4, 16 * kt, lane), bv[s2], S[kt]); }
        HG_BAR();
        cur = nxt;
    }
    G4_STORE(n0 + 3);
#undef G4_STORE
    f32x4* sg = (f32x4*)(a.ws + WS_DS) + ((size_t)grp * 64 + w * 8) * 64 + lane;
#pragma unroll
    for (int kt = 0; kt < 8; ++kt) sg[kt * 64] = S[kt];
}
__device__ __forceinline__ void grp_scan(const Frame& F, const Args& a) {
    f32x4* sg = (f32x4*)(a.ws + WS_DS); f32x4* si = sg + (size_t)256 * 4096; const float* dec = (const float*)(a.ws + WS_DEC);
    for (int gt = F.bid * NTHR + F.tid; gt < 16 * 4096; gt += F.G * NTHR) {
        const int bh = gt >> 12, slot = gt & 4095, kt = (slot >> 6) & 7, lane = slot & 63, k = 16 * kt + 4 * (lane >> 4);
        f32x4 cur = (f32x4){0.f, 0.f, 0.f, 0.f};
#pragma unroll 4
        for (int g = 0; g < 16; ++g) { const size_t gi = ((size_t)(bh * 16 + g)) * 4096 + slot;
            si[gi] = cur;
            const float* dp = dec + ((size_t)bh * 64 + 4 * g) * 128 + k;
            const f32x4 d = (*(const f32x4*)dp * *(const f32x4*)(dp + 128)) * (*(const f32x4*)(dp + 256) * *(const f32x4*)(dp + 384));
            cur = d * cur + sg[gi]; }
    }
}
struct InC { Tile qd, g, ol; f32x4 dec; };
__device__ __forceinline__ void loadC(InC& r, const Frame& F, const Args& a, int bh, int n) {
    const int b = bh >> 2, h = bh & 3; const size_t t0 = (size_t)b * SEQ + n * 64;
    const bf16_t* base = (const bf16_t*)(a.ws + WS_PROJ) + t0 * INC;
    tile_load(r.qd, base + C_HGT + 256 * h, INC, F.tid); tile_load(r.g, base + C_GHG + h * 128, INC, F.tid);
    tile_load(r.ol, (const bf16_t*)(a.ws + WS_YHG) + t0 * 512 + h * 128, 512, F.tid);
    r.dec = *(const f32x4*)((const float*)(a.ws + WS_DEC) + ((size_t)bh * 64 + n) * 128 + 4 * (F.tid & 31));
}
__device__ __forceinline__ void grp_final(const Frame& F, const Args& a, int grp) {
    const int bh = grp >> 4, n0 = 4 * (grp & 15), b = bh >> 2, h = bh & 3, w = F.wave, lane = F.lane, fr = lane & 15, fq = lane >> 4;
    f32x4 S[8];
    { const f32x4* si = (const f32x4*)(a.ws + WS_DS) + (size_t)256 * 4096 + ((size_t)grp * 64 + w * 8) * 64 + lane;
#pragma unroll
      for (int kt = 0; kt < 8; ++kt) S[kt] = si[kt * 64]; }
    const float ng = a.in[I_HGNG][16 * w + fr];
    LAS float* SSQ = (LAS float*)(F.lds + G4_L_SSQ);
    InC cur, nxt; loadC(cur, F, a, bh, n0);
    unsigned short yk[4][4];
#define G4_STORE(nn) do { bf16_t* yp_ = (bf16_t*)(a.ws + WS_YHG) + ((size_t)b * SEQ + (nn) * 64 + 4 * fq) * 512 + h * 128 + 16 * w + fr; \
        _Pragma("unroll") for (int tb = 0; tb < 4; ++tb) _Pragma("unroll") for (int r = 0; r < 4; ++r) yp_[(size_t)(16 * tb + r) * 512] = yk[tb][r]; } while (0)
    for (int j = 0; j < 4; ++j) {
        if (j > 0) G4_STORE(n0 + j - 1);
        loadC(nxt, F, a, bh, n0 + (j < 3 ? j + 1 : 3));
        tile_put(cur.qd, F.lds + L_QD, F.tid); tile_put(cur.g, F.lds + L_KD, F.tid); tile_put(cur.ol, F.lds + L_V, F.tid);
        if (F.tid < 32) *(LAS f32x4*)(F.lds + G4_L_DEC + 16 * F.tid) = cur.dec;
        HG_BAR();
        bf16x8 Sb[4];
#pragma unroll
        for (int ks = 0; ks < 4; ++ks) { const u32x4 t = (u32x4){cvt_pk_bf16(S[2 * ks][0], S[2 * ks][1]), cvt_pk_bf16(S[2 * ks][2], S[2 * ks][3]), cvt_pk_bf16(S[2 * ks + 1][0], S[2 * ks + 1][1]), cvt_pk_bf16(S[2 * ks + 1][2], S[2 * ks + 1][3])};
            Sb[ks] = __builtin_bit_cast(bf16x8, t); }
        f32x4 o[4];
#pragma unroll
        for (int tb = 0; tb < 4; ++tb) {
#pragma unroll
            for (int r = 0; r < 4; ++r) o[tb][r] = bf2f(*(const LAS unsigned short*)(F.lds + L_V + ((16 * tb + 4 * fq + r) * QP + 16 * w + fr) * 2));
#pragma unroll
            for (int ks = 0; ks < 4; ++ks) { const LAS unsigned char* qrow = F.lds + L_QD + ((16 * tb + fr) * QP + 32 * ks + 4 * fq) * 2;
                const u32x2 lo = *(const LAS u32x2*)qrow, hi = *(const LAS u32x2*)(qrow + 32);
                const u32x4 aw = (u32x4){lo.x, lo.y, hi.x, hi.y}; o[tb] = mfma16(__builtin_bit_cast(bf16x8, aw), Sb[ks], o[tb]); }
#pragma unroll
            for (int r = 0; r < 4; ++r) { const float v = scan16(o[tb][r] * o[tb][r]); if (fr == 15) SSQ[w * 64 + 16 * tb + 4 * fq + r] = v; } }
#pragma unroll
        for (int kt = 0; kt < 8; ++kt) S[kt] = S[kt] * *(const LAS f32x4*)(F.lds + G4_L_DEC + (16 * kt + 4 * fq) * 4);
        HG_BAR();
#pragma unroll
        for (int tb = 0; tb < 4; ++tb) { f32x4 tot = (f32x4){0.f, 0.f, 0.f, 0.f};
#pragma unroll
            for (int ww = 0; ww < 8; ++ww) tot += *(const LAS f32x4*)(SSQ + ww * 64 + 16 * tb + 4 * fq);
#pragma unroll
            for (int r = 0; r < 4; ++r) { const float rs = rsqrtf(tot[r] * (1.0f / 128.0f) + EPS); const float g = bf2f(*(const LAS unsigned short*)(F.lds + L_KD + ((16 * tb + 4 * fq + r) * QP + 16 * w + fr) * 2));
                yk[tb][r] = (unsigned short)f2bf(o[tb][r] * rs * ng * g * __builtin_amdgcn_rcpf(1.0f + __builtin_amdgcn_exp2f(-1.4426950408889634f * g))); } }
        HG_BAR();
        cur = nxt;
    }
    G4_STORE(n0 + 3);
#undef G4_STORE
}
#undef HG_BAR
}

__device__ __forceinline__ float rs4(float a0, float a1, float a2, float a3, int lane) {
    const bool hi = (lane & 32) != 0;
    const float s0 = hi ? a0 : a2, s1 = hi ? a1 : a3;
    const float k0 = (hi ? a2 : a0) + __shfl_xor(s0, 32), k1 = (hi ? a3 : a1) + __shfl_xor(s1, 32);
    const bool b4 = (lane & 16) != 0;
    const float sd = b4 ? k0 : k1;
    float k = (b4 ? k1 : k0) + __shfl_xor(sd, 16);
    k += __shfl_xor(k, 8); k += __shfl_xor(k, 4); k += __shfl_xor(k, 2); k += __shfl_xor(k, 1);
    return k;
}
__device__ __forceinline__ void phase_router(const Frame& F, const Args& a) {
    constexpr int AP = 1032;
    LAS bf16_t* AH = (LAS bf16_t*)F.lds;
    LAS bf16_t* AL = AH + 16 * AP;
    LAS float* PART = (LAS float*)(F.lds + 2 * 16 * AP * 2);
    LAS float* LG = PART + 8 * 16 * 48;
    LAS unsigned* LH = (LAS unsigned*)(LG + 16 * 48);
    LAS unsigned* LB = LH + 32;
    LAS unsigned* LR = LH + 64;
    if (F.tid < NEXP) LH[F.tid] = 0u;
    const float* mod = (const float*)(a.ws + WS_MOD);
    const bf16_t* x1 = (const bf16_t*)(a.ws + WS_X1B); bf16_t* H2 = (bf16_t*)(a.ws + WS_ACT);
    unsigned* counts = (unsigned*)(a.ws + WS_CTL) + CW_COUNTS; unsigned* tokinfo = (unsigned*)(a.ws + WS_TOKINFO); int* toklist = (int*)(a.ws + WS_TOKLIST);
    const int rows_per_blk = T / F.G, r0 = F.bid * rows_per_blk, b = r0 / SEQ;
    const int lane = F.lane, w = F.wave, fr = lane & 15, fq = lane >> 4;
    f32x4 v[2][4], vn[2][4];
#define RT_LOAD(V, rb_) do { _Pragma("unroll") for (int q = 0; q < 2; ++q) { const u32x2* xr_ = (const u32x2*)(x1 + (size_t)((rb_) + 2 * w + q) * D) + lane; \
        _Pragma("unroll") for (int j = 0; j < 4; ++j) { const u32x2 t_ = xr_[64 * j]; V[q][j] = (f32x4){bf2f(t_.x & 0xffffu), bf2f(t_.x >> 16), bf2f(t_.y & 0xffffu), bf2f(t_.y >> 16)}; } } } while (0)
    RT_LOAD(v, r0);
    bf16x8 Bh[4][3], Bl[4][3];
    {
        const float* wre = a.in[I_WRE]; const float* wrg = a.in[I_WRG];
#pragma unroll
        for (int ks = 0; ks < 4; ++ks)
#pragma unroll
            for (int ct = 0; ct < 3; ++ct) {
                unsigned hw[4], lw[4];
#pragma unroll
                for (int jp = 0; jp < 4; ++jp) { float x[2];
#pragma unroll
                    for (int z = 0; z < 2; ++z) { const int k = 128 * w + 32 * ks + 8 * fq + 2 * jp + z;
                        if (ct == 0) { const float g = wrg[k * 4 + (fr & 3)], e = wre[k * 32 + ((fr + 28) & 31)]; x[z] = fr < 4 ? g : e; }
                        else if (ct == 1) x[z] = wre[k * 32 + 12 + fr];
                        else { const float e = wre[k * 32 + 28 + (fr & 3)]; x[z] = fr < 4 ? e : 0.f; } }
                    const unsigned h0 = f2bf(x[0]), h1 = f2bf(x[1]); hw[jp] = h0 | (h1 << 16);
                    lw[jp] = pk2(x[0] - bf2f(h0), x[1] - bf2f(h1)); }
                Bh[ks][ct] = __builtin_bit_cast(bf16x8, (u32x4){hw[0], hw[1], hw[2], hw[3]}); Bl[ks][ct] = __builtin_bit_cast(bf16x8, (u32x4){lw[0], lw[1], lw[2], lw[3]});
            }
    }
    for (int g = 0; g < rows_per_blk / 16; ++g) {
        const int rg = r0 + 16 * g;
        { const int gn = g + 1 < rows_per_blk / 16 ? g + 1 : g; RT_LOAD(vn, r0 + 16 * gn); }
#pragma unroll
        for (int q = 0; q < 2; ++q) { float sq = 0.f;
#pragma unroll
            for (int j = 0; j < 4; ++j) sq += (v[q][j].x * v[q][j].x + v[q][j].y * v[q][j].y) + (v[q][j].z * v[q][j].z + v[q][j].w * v[q][j].w);
            const float rs = rsqrtf(wave_sum(sq) * (1.0f / D) + EPS); const int row = 2 * w + q;
#pragma unroll
            for (int j = 0; j < 4; ++j) { const int k = 256 * j + 4 * lane;
                const f32x4 gg = *(const f32x4*)(a.in[I_N2G] + k) * (1.0f + *(const f32x4*)(mod + b * 6144 + 4 * 1024 + k)), sh = *(const f32x4*)(mod + b * 6144 + 3 * 1024 + k);
                const f32x4 hv = v[q][j] * rs * gg + sh;
                const unsigned h0 = f2bf(hv.x), h1 = f2bf(hv.y), h2_ = f2bf(hv.z), h3 = f2bf(hv.w);
                const u32x2 hw = (u32x2){h0 | (h1 << 16), h2_ | (h3 << 16)};
                *(u32x2*)(H2 + (size_t)(rg + row) * D + k) = hw;
                *(LAS u32x2*)(AH + row * AP + k) = hw;
                *(LAS u32x2*)(AL + row * AP + k) = (u32x2){pk2(hv.x - bf2f(h0), hv.y - bf2f(h1)), pk2(hv.z - bf2f(h2_), hv.w - bf2f(h3))}; } }
        __syncthreads();
        f32x4 acc[3] = {{0.f, 0.f, 0.f, 0.f}, {0.f, 0.f, 0.f, 0.f}, {0.f, 0.f, 0.f, 0.f}};
#pragma unroll
        for (int ks = 0; ks < 4; ++ks) { const bf16x8 ah = *(const LAS bf16x8*)(AH + fr * AP + 128 * w + 32 * ks + 8 * fq), al = *(const LAS bf16x8*)(AL + fr * AP + 128 * w + 32 * ks + 8 * fq);
#pragma unroll
            for (int ct = 0; ct < 3; ++ct) { acc[ct] = __builtin_amdgcn_mfma_f32_16x16x32_bf16(ah, Bh[ks][ct], acc[ct], 0, 0, 0);
                acc[ct] = __builtin_amdgcn_mfma_f32_16x16x32_bf16(al, Bh[ks][ct], acc[ct], 0, 0, 0); acc[ct] = __builtin_amdgcn_mfma_f32_16x16x32_bf16(ah, Bl[ks][ct], acc[ct], 0, 0, 0); } }
#pragma unroll
        for (int ct = 0; ct < 3; ++ct)
#pragma unroll
            for (int r = 0; r < 4; ++r) PART[(w * 16 + 4 * fq + r) * 48 + 16 * ct + fr] = acc[ct][r];
        __syncthreads();
        for (int t = F.tid; t < 16 * 48; t += NTHR) { const int row = t / 48, o = t % 48; float sacc = 0.f;
#pragma unroll
            for (int ww = 0; ww < 8; ++ww) sacc += PART[(ww * 16 + row) * 48 + o];
            if (o < 36) LG[row * 48 + o] = sacc + (o < 4 ? a.in[I_BRG][o & 3] : a.in[I_BRE][(o + 28) & 31]); }
        __syncthreads();
        if (F.tid < 16) {
            const LAS float* lg = LG + F.tid * 48;
            float gl[4]; int gi = 0;
#pragma unroll
            for (int o = 0; o < 4; ++o) gl[o] = lg[o];
            float gm = gl[0];
#pragma unroll
            for (int o = 1; o < 4; ++o) if (gl[o] > gm) { gm = gl[o]; gi = o; }
            float gsum = 0.f;
#pragma unroll
            for (int o = 0; o < 4; ++o) gsum += expf(gl[o] - gm);
            const float gp = 1.0f / gsum;
            float el[8];
#pragma unroll
            for (int e = 0; e < 8; ++e) el[e] = lg[4 + gi * 8 + e];
            int i0 = 0; float m0 = el[0];
#pragma unroll
            for (int o = 1; o < 8; ++o) if (el[o] > m0) { m0 = el[o]; i0 = o; }
            int i1 = -1; float m1 = -INFINITY;
#pragma unroll
            for (int o = 0; o < 8; ++o) if (o != i0 && el[o] > m1) { m1 = el[o]; i1 = o; }
            const float e1 = expf(m1 - m0); const float w0 = gp / (1.0f + e1), w1 = gp * e1 / (1.0f + e1);
            const int rl = 16 * g + F.tid, ex0 = gi * 8 + i0, ex1 = gi * 8 + i1;
            const unsigned l0 = atomicAdd((unsigned*)(LH + ex0), 1u), l1 = atomicAdd((unsigned*)(LH + ex1), 1u);
            LAS unsigned* ri = LR + rl * 6;
            ri[0] = (unsigned)ex0; ri[1] = l0; ri[2] = (unsigned)ex1; ri[3] = l1; ri[4] = __float_as_uint(w0); ri[5] = __float_as_uint(w1);
        }
#pragma unroll
        for (int q = 0; q < 2; ++q)
#pragma unroll
            for (int j = 0; j < 4; ++j) v[q][j] = vn[q][j];
    }
#undef RT_LOAD
    __syncthreads();
    if (F.tid < NEXP) LB[F.tid] = atomicAdd(counts + 64 * F.tid, LH[F.tid]);
    __syncthreads();
    for (int rl = F.tid; rl < rows_per_blk; rl += NTHR) {
        const LAS unsigned* ri = LR + rl * 6; const int r = r0 + rl;
        const unsigned ex0 = ri[0], ex1 = ri[2], k0 = LB[ex0] + ri[1], k1 = LB[ex1] + ri[3];
        toklist[ex0 * T + k0] = r; toklist[ex1 * T + k1] = r;
        u32x4 t0; t0.x = ex0; t0.y = k0; t0.z = ex1; t0.w = k1;
        *(u32x4*)(tokinfo + (size_t)r * 8) = t0;
        tokinfo[(size_t)r * 8 + 4] = ri[4]; tokinfo[(size_t)r * 8 + 5] = ri[5];
    }
}
__device__ __forceinline__ void build_moe_tab(const Frame& F, const Args& a, LAS MoeTab* tab) {
    if (F.tid == 0) {
        const unsigned* counts = (const unsigned*)(a.ws + WS_CTL) + CW_COUNTS; int nt = 0;
        for (int e = 0; e < NEXP; ++e) { const int c = (int)__hip_atomic_load(counts + 64 * e, __ATOMIC_RELAXED, __HIP_MEMORY_SCOPE_AGENT); tab->cnt[e] = c; tab->tbase[e] = nt;
            const int n = (c + 255) >> 8; for (int m = 0; m < n; ++m) { tab->tile_e[nt] = e; tab->tile_m[nt] = m; ++nt; } }
        tab->tbase[NEXP] = nt; tab->nt = nt;
    }
    __syncthreads();
}
__device__ __forceinline__ void phase_final(const Frame& F, const Args& a, const LAS MoeTab* tab) {
    const float* mod = (const float*)(a.ws + WS_MOD); const unsigned* tokinfo = (const unsigned*)(a.ws + WS_TOKINFO); const bf16_t* Ys = (const bf16_t*)(a.ws + WS_YS);
    const int rows_per_blk = T / F.G, r0 = F.bid * rows_per_blk;
    for (int r = r0 + F.wave; r < r0 + rows_per_blk; r += NWAVES) {
        const int b = r / SEQ;
        const u32x4 ti = *(const u32x4*)(tokinfo + (size_t)r * 8);
        const float w0 = __uint_as_float(tokinfo[(size_t)r * 8 + 4]), w1 = __uint_as_float(tokinfo[(size_t)r * 8 + 5]);
        const size_t s0 = (size_t)tab->tbase[ti.x] * 256 + ti.y, s1 = (size_t)tab->tbase[ti.z] * 256 + ti.w;
        f32x4* xr = (f32x4*)(a.out + (size_t)r * D) + F.lane; const u32x2* xb = (const u32x2*)((const bf16_t*)(a.ws + WS_X1B) + (size_t)r * D) + F.lane;
        const u32x2* y0 = (const u32x2*)(Ys + s0 * D) + F.lane; const u32x2* y1 = (const u32x2*)(Ys + s1 * D) + F.lane;
        f32x4 v[4]; float s = 0.f;
#pragma unroll
        for (int j = 0; j < 4; ++j) { const int k = 256 * j + 4 * F.lane;
            const f32x4 gt = *(const f32x4*)(mod + b * 6144 + 5 * 1024 + k); const u32x2 a0 = y0[64 * j], a1 = y1[64 * j];
            f32x4 m; m.x = w0 * bf2f(a0.x & 0xffffu) + w1 * bf2f(a1.x & 0xffffu); m.y = w0 * bf2f(a0.x >> 16) + w1 * bf2f(a1.x >> 16);
            m.z = w0 * bf2f(a0.y & 0xffffu) + w1 * bf2f(a1.y & 0xffffu); m.w = w0 * bf2f(a0.y >> 16) + w1 * bf2f(a1.y >> 16);
            const u32x2 xq = xb[64 * j]; const f32x4 xv = (f32x4){bf2f(xq.x & 0xffffu), bf2f(xq.x >> 16), bf2f(xq.y & 0xffffu), bf2f(xq.y >> 16)};
            v[j] = xv + gt * m; s += (v[j].x * v[j].x + v[j].y * v[j].y) + (v[j].z * v[j].z + v[j].w * v[j].w); }
        const float rs = rsqrtf(wave_sum(s) * (1.0f / D) + EPS);
#pragma unroll
        for (int j = 0; j < 4; ++j) { const f32x4 g = *(const f32x4*)(a.in[I_FG] + 256 * j + 4 * F.lane); xr[64 * j] = v[j] * rs * g; }
    }
}

#define XB_TMO      128
#define XB_XCNT(j)  (256  + 64 * (j))
#define XB_XSUB(j)  (1280 + 64 * (j))
#define XB_XGEN(j)  (2304 + 64 * (j))
#define XB_TOP      3328
#define XB_TOPGEN   3392
#define XCD_BAR_WORDS 3456
#define XB_SPIN_CAP (1u << 18)
__device__ __forceinline__ unsigned xb_ld(unsigned* p)              { return __hip_atomic_load(p, __ATOMIC_RELAXED, __HIP_MEMORY_SCOPE_AGENT); }
__device__ __forceinline__ unsigned xb_add(unsigned* p, unsigned v) { return __hip_atomic_fetch_add(p, v, __ATOMIC_RELAXED, __HIP_MEMORY_SCOPE_AGENT); }
__device__ __forceinline__ unsigned xb_xcc_id() { return (unsigned)__builtin_amdgcn_s_getreg((3 << 11) | 20) & 0xFu; }
#define XB_SPIN(cond, bar) do { unsigned _sp = 0; while (cond) { __builtin_amdgcn_s_sleep(1); \
    if ((++_sp & 255u) == 0u) { if (xb_ld(&(bar)[XB_TMO])) break; if (_sp > XB_SPIN_CAP) { atomicAdd(&(bar)[XB_TMO], 1u); break; } } } } while (0)
struct XcdBarrier { unsigned* bar; unsigned x; volatile LAS unsigned* st; };
__device__ __forceinline__ XcdBarrier xcd_barrier_post(unsigned* bar, volatile LAS unsigned* st) {
    XcdBarrier b; b.bar = bar; b.x = xb_xcc_id(); b.st = st;
    if (threadIdx.x == 0) (void)xb_add(&bar[XB_XCNT(b.x)], 1u);
    return b;
}
__device__ __forceinline__ void xcd_barrier_complete(unsigned* bar, unsigned x, unsigned& nloc, unsigned& nx) {
    const unsigned G = gridDim.x * gridDim.y * gridDim.z;
    unsigned sum, cnt, mine, sp = 0u;
    for (;;) {
        sum = 0u; cnt = 0u; mine = 0u;
#pragma unroll
        for (unsigned j = 0; j < 16; ++j) { const unsigned c = xb_ld(&bar[XB_XCNT(j)]); sum += c; cnt += (c > 0u) ? 1u : 0u; mine = (j == x) ? c : mine; }
        if (sum == G) break;
        __builtin_amdgcn_s_sleep(1);
        if ((++sp & 255u) == 0u) { if (xb_ld(&bar[XB_TMO])) break; if (sp > XB_SPIN_CAP) { atomicAdd(&bar[XB_TMO], 1u); break; } }
    }
    nloc = mine > 0u ? mine : 1u; nx = cnt > 0u ? cnt : 1u;
}
__device__ __forceinline__ void xcd_barrier(const XcdBarrier& b) {
    asm volatile("s_waitcnt vmcnt(0)" ::: "memory");
    __syncthreads();
    if (threadIdx.x == 0) {
        unsigned* bar = b.bar;
        __builtin_amdgcn_s_waitcnt(0);
        unsigned nloc = b.st[0], nx = b.st[1];
        if (nloc == 0u) { xcd_barrier_complete(bar, b.x, nloc, nx); b.st[0] = nloc; b.st[1] = nx; }
        const unsigned old = xb_add(&bar[XB_XSUB(b.x)], 1u);
        const unsigned gen = old / nloc;
        if (old + 1u == (gen + 1u) * nloc) {
            __builtin_amdgcn_fence(__ATOMIC_RELEASE, "agent");
            asm volatile("s_waitcnt vmcnt(0)" ::: "memory");
            const unsigned og = xb_add(&bar[XB_TOP], 1u);
            const unsigned tg = og / nx;
            if (og + 1u == (tg + 1u) * nx) xb_add(&bar[XB_TOPGEN], 1u);
            else XB_SPIN(xb_ld(&bar[XB_TOPGEN]) == tg, bar);
            __builtin_amdgcn_fence(__ATOMIC_ACQUIRE, "agent");
            xb_add(&bar[XB_XGEN(b.x)], 1u);
            asm volatile("s_waitcnt vmcnt(0)" ::: "memory");
        } else {
            XB_SPIN(xb_ld(&bar[XB_XGEN(b.x)]) == gen, bar);
            __builtin_amdgcn_fence(__ATOMIC_ACQUIRE, "agent");
            asm volatile("s_waitcnt vmcnt(0)" ::: "memory");
        }
    }
    __syncthreads();
}

constexpr int N_PHASES = 11;
__global__ void __launch_bounds__(NTHR, 2) mk_fwd(Args a) {
    extern __shared__ __attribute__((aligned(16))) unsigned char lds_raw[];
    Frame F; F.lds = (LAS unsigned char*)lds_raw; F.tid = threadIdx.x; F.lane = F.tid & 63; F.wave = __builtin_amdgcn_readfirstlane(F.tid >> 6); F.G = gridDim.x; F.bid = blockIdx.x;
    unsigned char* ws = a.ws;
    const int lo = a.ph_lo, hi = a.ph_hi;
#if MK_N_LAUNCHES == 1
    volatile LAS unsigned* MISC = (volatile LAS unsigned*)(F.lds + 152 * 1024);
    if (F.tid < 4) MISC[F.tid] = 0u;
    __syncthreads();
    XcdBarrier xbar = xcd_barrier_post((unsigned*)(ws + WS_CTL) + CW_BAR, MISC);
#define SEAM(k) do { if (IN(k) && IN((k) + 1)) xcd_barrier(xbar); } while (0)
#else
#define SEAM(k) do { } while (0)
#endif
#define IN(k) (lo <= (k) && (k) < hi)
    LAS MoeTab* tab = (LAS MoeTab*)(F.lds + 144 * 1024);

#define RUNPH(k, ...) if (IN(k)) { F.lane = lane_now(); F.tid = F.wave * 64 + F.lane; __VA_ARGS__ }
    RUNPH(0, { phase0(F, a); }) SEAM(0);
    RUNPH(1, { phase1(F, a); __syncthreads(); dense_weight_convert(F, a); }) SEAM(1);
    RUNPH(2, {
        DenseOrder S{(const char*)(ws + WS_ACT), (const char*)(ws + WS_WIN), D, T / 256, INC / 256, F.G, F.bid};
        EpiInProj E{(bf16_t*)(ws + WS_PROJ), (bf16_t*)a.out, (float*)(ws + WS_DEC), (const float*)(ws + WS_SMALL) + 16, attn_body::C2};
        pg8::gemm_phase(F.lds, D, S, E);
    }) SEAM(2);
    RUNPH(3, {
        for (int g = F.bid; g < 256; g += F.G) hg::grp_local(F, a, g);
        __syncthreads();
        attn_phase(F, a);
    }) SEAM(3);
    RUNPH(4, { hg::grp_scan(F, a); attn_combine(F, a); }) SEAM(4);
    RUNPH(5, { for (int g = F.bid; g < 256; g += F.G) hg::grp_final(F, a, g); }) SEAM(5);
    RUNPH(6, {
        UpOrder S{(const char*)(ws + WS_YDA), (const char*)(ws + WS_YHG), (const char*)(ws + WS_WUPDA), (const char*)(ws + WS_WUPHG), F.G, F.bid};
        EpiUp E{(const bf16_t*)(ws + WS_PROJ), (bf16_t*)(ws + WS_ACT)};
        pg8::gemm_phase(F.lds, 512, S, E);
    }) SEAM(6);
    RUNPH(7, {
        DenseOrder S{(const char*)(ws + WS_ACT), (const char*)(ws + WS_WOUT), D, T / 256, D / 256, F.G, F.bid};
        EpiOut E{a.in[I_X], (const float*)(ws + WS_MOD), (bf16_t*)(ws + WS_X1B)};
        pg8::gemm_phase(F.lds, D, S, E);
        moe_weight_convert(F, a);
    }) SEAM(7);
    RUNPH(8, { phase_router(F, a); __syncthreads(); }) SEAM(8);
    RUNPH(9, {
        build_moe_tab(F, a, tab);
        unsigned* done = (unsigned*)(ws + WS_CTL) + CW_TILE;
        const int vc = (F.G & 7) == 0 ? (F.bid & 7) * (F.G >> 3) + (F.bid >> 3) : F.bid;
        { Moe1Order S{tab, (const char*)(ws + WS_ACT), (const char*)(ws + WS_W13), (const int*)(ws + WS_TOKLIST), F.G, vc};
          EpiMoe1 E{(bf16_t*)(ws + WS_HS), done};
          pg8::gemm_phase(F.lds, D, S, E); }
        { Moe2Order S{tab, (const char*)(ws + WS_HS), (const char*)(ws + WS_W2), done, (unsigned*)(ws + WS_CTL) + CW_TMO, F.G, vc};
          EpiStoreBf16 E{(bf16_t*)(ws + WS_YS), D, 0, 1.0f};
          pg8::gemm_phase(F.lds, DEXP, S, E); }
    }) SEAM(9);
    RUNPH(10, { build_moe_tab(F, a, tab); phase_final(F, a, tab); })
#undef IN
#undef SEAM
}

extern "C" void kernel_launch(void* const* d_in, const int* in_sizes, int n_in, void* d_out, int out_size, void* d_ws, size_t ws_size, hipStream_t stream) {
    static int grid = 0;
    if (grid == 0) {
        if (n_in != 25 || in_sizes[0] != T * D || out_size != T * D || ws_size < WS_END) { fprintf(stderr, "kernel_launch: unexpected shapes (n_in %d, in0 %d, out %d, ws %zu)\n", n_in, n_in > 0 ? in_sizes[0] : -1, out_size, ws_size); grid = -1; return; }
        int dev = 0, cus = 0, per_cu = 0;
        if (hipGetDevice(&dev) != hipSuccess || hipDeviceGetAttribute(&cus, hipDeviceAttributeMultiprocessorCount, dev) != hipSuccess) { grid = -1; return; }
        if (hipFuncSetAttribute((const void*)mk_fwd, hipFuncAttributeMaxDynamicSharedMemorySize, LDS_BYTES) != hipSuccess) { fprintf(stderr, "kernel_launch: hipFuncSetAttribute failed\n"); grid = -1; return; }
        if (hipOccupancyMaxActiveBlocksPerMultiprocessor(&per_cu, (const void*)mk_fwd, NTHR, LDS_BYTES) != hipSuccess || per_cu < 1) { fprintf(stderr, "kernel_launch: occupancy query says %d\n", per_cu); per_cu = 1; }
        (void)hipGetLastError();
        grid = cus;
        if (grid > 256) grid = 256;
        while (T % grid) --grid;
    }
    if (grid < 0) return;
    (void)hipMemsetAsync((char*)d_ws + WS_CTL, 0, CTL_ZERO_BYTES, stream);
    Args a{};
    for (int i = 0; i < 25; ++i) a.in[i] = (const float*)d_in[i];
    a.out = (float*)d_out; a.ws = (unsigned char*)d_ws;
#if MK_N_LAUNCHES == 1
    a.ph_lo = 0; a.ph_hi = N_PHASES;
    void* args[] = {&a};
    hipError_t e = hipLaunchCooperativeKernel((const void*)mk_fwd, dim3(grid), dim3(NTHR), args, LDS_BYTES, stream);
    if (e != hipSuccess) fprintf(stderr, "cooperative launch failed: %s (grid %d)\n", hipGetErrorString(e), grid);
#else
    for (int p = 0; p < N_PHASES; ++p) {
        a.ph_lo = p; a.ph_hi = p + 1;
        hipLaunchKernelGGL(mk_fwd, dim3(grid), dim3(NTHR), LDS_BYTES, stream, a);
    }
#endif
}
```

```cpp
#include <hip/hip_runtime.h>
#include <cstdio>
#include <cstdint>

#ifndef MK_N_LAUNCHES
#define MK_N_LAUNCHES 1
#endif

#define LAS __attribute__((address_space(3)))
typedef unsigned short bf16_t;
typedef short bf16x8 __attribute__((ext_vector_type(8)));
typedef float f32x4 __attribute__((ext_vector_type(4)));
typedef float f32x2 __attribute__((ext_vector_type(2)));
typedef unsigned u32x4 __attribute__((ext_vector_type(4)));
typedef unsigned u32x2 __attribute__((ext_vector_type(2)));

constexpr int NB = 4, SEQ = 4096, D = 1024, T = NB * SEQ;
constexpr int INC = 5632;
constexpr int C_QDA = 0, C_KDA = 512, C_VDA = 1024, C_QHG = 1536, C_FHG = 2048, C_IHG = 2560, C_GHG = 3072, C_GDA = 3584, C_GHGATE = 4608;
constexpr int C_HGT = 1536;
constexpr int NEXP = 32, DEXP = 512;
constexpr int PMAX = 40960;
constexpr float EPS = 1e-6f;
constexpr int NWAVES = 8, NTHR = 512;

constexpr size_t MiB = 1u << 20;
constexpr size_t WS_CTL = 0, CTL_ZERO_BYTES = 64 * 1024;
constexpr size_t WS_MODP = 1 * MiB;
constexpr size_t WS_MOD = 5 * MiB / 2;
constexpr size_t WS_SMALL = 11 * MiB / 4;
constexpr size_t WS_TOKINFO = 3 * MiB;
constexpr size_t WS_TOKLIST = 4 * MiB;
constexpr size_t WS_DEC = 6 * MiB;
constexpr size_t WS_DS = 24 * MiB;
constexpr size_t WS_WIN = 8 * MiB;
constexpr size_t WS_WUPDA = 20 * MiB, WS_WUPHG = 21 * MiB, WS_WOUT = 22 * MiB;
constexpr size_t WS_ACT = 24 * MiB;
constexpr size_t WS_PROJ = 56 * MiB;
constexpr size_t WS_YDA = 232 * MiB, WS_YHG = 248 * MiB;
constexpr size_t WS_OA = 264 * MiB;
constexpr size_t WS_W13 = 56 * MiB;
constexpr size_t WS_W2 = 120 * MiB;
constexpr size_t WS_HS = 152 * MiB;
constexpr size_t WS_YS = 192 * MiB;
constexpr size_t OUT_W2 = 16 * MiB;
constexpr int W2_EARLY = 24;
constexpr size_t WS_X1B = 272 * MiB;
constexpr size_t WS_END = 304 * MiB;
constexpr int CW_COUNTS = 64;
constexpr int CW_BAR = 4096;
constexpr int CW_TILE = 8192;
constexpr int CW_TMO = 32;

constexpr int LDS_BYTES = 160 * 1024;

__device__ __forceinline__ float bf2f(unsigned v) { return __uint_as_float(v << 16); }
__device__ __forceinline__ unsigned f2bf(float f) { unsigned u = __float_as_uint(f); return (u + 0x7fffu + ((u >> 16) & 1u)) >> 16; }
__device__ __forceinline__ unsigned pk2(float lo, float hi) { return f2bf(lo) | (f2bf(hi) << 16); }
__device__ __forceinline__ float sigmoidf_(float x) { return 1.0f / (1.0f + __expf(-x)); }
__device__ __forceinline__ float siluf_(float x) { return x / (1.0f + __expf(-x)); }
__device__ __forceinline__ int lane_now() { int l; asm volatile("v_mbcnt_lo_u32_b32 %0, -1, 0\n\tv_mbcnt_hi_u32_b32 %0, -1, %0" : "=v"(l)); return l; }
__device__ __forceinline__ float wave_sum(float v) {
#pragma unroll
    for (int o = 1; o < 64; o <<= 1) v += __shfl_xor(v, o);
    return v;
}

namespace pg8 {
constexpr int BM = 256, BK = 64, HALF = 128, HTB = HALF * BK * 2, STAGE_BYTES = 8 * HTB;
__host__ __device__ __forceinline__ int lds_byte(int r, int c) { const int st = (r >> 4) * 2 + (c >> 5), rr = r & 15, cc = c & 31, ob = rr * 64 + cc * 2; return st * 1024 + (ob ^ (((ob >> 9) & 1) << 5)); }
__host__ __device__ __forceinline__ void stage_rc(int b, int& R, int& C) { const int st = b / 1024, sb = b % 1024, swz = sb ^ (((sb >> 9) & 1) << 5); R = (st >> 1) * 16 + swz / 64; C = (st & 1) * 32 + (swz % 64) / 2; }
__host__ __device__ __forceinline__ int perm32(int rho) { const int n = rho >> 4, i = rho & 15; return 8 * (i >> 2) + 4 * n + (i & 3); }

struct Unit { int pm, pn; const char* A; const char* B; int aux; };
__device__ __forceinline__ unsigned cvt_pk_bf16(float lo, float hi) { unsigned r; asm volatile("v_cvt_pk_bf16_f32 %0, %1, %2" : "=v"(r) : "v"(lo), "v"(hi)); return r; }

template <class Epi, class Sched>
__device__ __forceinline__ void gemm_phase(LAS unsigned char* lds, const int K, const Sched& S, const Epi& E) {
    const int tid = threadIdx.x, wid = __builtin_amdgcn_readfirstlane(tid >> 6), lane = tid & 63, wr = wid >> 2, wc = wid & 3, fr = lane & 15, fq = lane >> 4;
    const int nt = K / BK;
    unsigned voffB[2];
#define PG8_SETLANE() do { const int _l = lane_now(), _t = wid * 64 + _l; _Pragma("unroll") for (int _i = 0; _i < 2; ++_i) { int _R, _C; stage_rc(_t * 16 + _i * 8192, _R, _C); \
        const int _Rb = Epi::PERM ? ((_R & ~31) + perm32(_R & 31)) : _R; voffB[_i] = (unsigned)(_Rb * K + _C) * 2u; } \
        aoff = lds_byte(wr * 64 + (_l & 15), (_l >> 4) * 8); boff = lds_byte(wc * 32 + (_l & 15), (_l >> 4) * 8); } while (0)
    const size_t kstep = (size_t)(BK * 2);
    const size_t hstep = (size_t)HALF * K * 2;
    const unsigned ldsw = (unsigned)wid * 1024u;
    int aoff, boff; PG8_SETLANE();
#define PG8_SA(b, h) (((b) * 2 + (h)) * HTB)
#define PG8_SB(b, h) ((4 + (b) * 2 + (h)) * HTB)
#define PG8_STAGE(bufoff, gbase, voff) do { _Pragma("unroll") for (int _i = 0; _i < 2; ++_i) \
        __builtin_amdgcn_global_load_lds((const unsigned*)((const char*)(gbase) + (voff)[_i]), (LAS unsigned*)(lds + (bufoff) + ldsw + _i * 8192), 16, 0, 0); } while (0)
#define PG8_LDA(dst, b, h) do { _Pragma("unroll") for (int m = 0; m < 4; ++m) _Pragma("unroll") for (int k = 0; k < 2; ++k) dst[m][k] = *(const LAS bf16x8*)(lds + PG8_SA(b, h) + aoff + m * 2048 + k * 1024); } while (0)
#define PG8_LDB(dst, b, h) do { _Pragma("unroll") for (int n = 0; n < 2; ++n) _Pragma("unroll") for (int k = 0; k < 2; ++k) dst[n][k] = *(const LAS bf16x8*)(lds + PG8_SB(b, h) + boff + n * 2048 + k * 1024); } while (0)
#define PG8_MMA(ai, bj, At, Bt) do { __builtin_amdgcn_s_setprio(1); _Pragma("unroll") for (int m = 0; m < 4; ++m) _Pragma("unroll") for (int n = 0; n < 2; ++n) _Pragma("unroll") for (int k = 0; k < 2; ++k) \
        acc[ai][bj][m][n] = __builtin_amdgcn_mfma_f32_16x16x32_bf16(Bt[n][k], At[m][k], acc[ai][bj][m][n], 0, 0, 0); __builtin_amdgcn_s_setprio(0); } while (0)
#define PG8_WAIT_V(n) asm volatile("s_waitcnt vmcnt(" #n ")" ::: "memory")
#define PG8_WAIT_L(n) asm volatile("s_waitcnt lgkmcnt(" #n ")" ::: "memory")
#define PG8_BAR __builtin_amdgcn_s_barrier()
#define PG8_SCHED __builtin_amdgcn_sched_barrier(0)
#define PG8_SETA(vo, u) do { const int _t = wid * 64 + lane_now(); _Pragma("unroll") for (int _i = 0; _i < 2; ++_i) { int _R, _C; stage_rc(_t * 16 + _i * 8192, _R, _C); \
        _Pragma("unroll") for (int _h = 0; _h < 2; ++_h) vo[_h][_i] = (unsigned)((size_t)S.arow(u, _h * HALF + _R) * (size_t)K + _C) * 2u; } if (Sched::GATHER) PG8_WAIT_V(0); } while (0)
    Unit cur, nxt; int ui = 0;
    if (!S.next(0, cur)) return;
    f32x4 acc[2][2][4][2];
#pragma unroll
    for (int a = 0; a < 2; ++a)
#pragma unroll
        for (int b = 0; b < 2; ++b)
#pragma unroll
            for (int m = 0; m < 4; ++m)
#pragma unroll
                for (int n = 0; n < 2; ++n) acc[a][b][m][n] = (f32x4){0.f, 0.f, 0.f, 0.f};
    bf16x8 At[4][2], B0[2][2], B1[2][2];
    unsigned voC[2][2], voN[2][2];
    S.a_ready(cur);
    PG8_SETA(voC, cur);
    const char* cA = cur.A; const char* cB = cur.B;
    PG8_STAGE(PG8_SB(0, 0), cB, voffB); PG8_STAGE(PG8_SB(0, 1), cB + hstep, voffB); PG8_STAGE(PG8_SA(0, 0), cA, voC[0]); PG8_STAGE(PG8_SA(0, 1), cA, voC[1]);
    if (wr == 1) PG8_BAR;
    PG8_WAIT_V(2); PG8_BAR;
    PG8_STAGE(PG8_SB(1, 0), cB + kstep, voffB); PG8_STAGE(PG8_SA(1, 0), cA + kstep, voC[0]); PG8_STAGE(PG8_SB(1, 1), cB + hstep + kstep, voffB);
    PG8_WAIT_V(6); PG8_BAR;
    for (;;) {
        const bool has_next = S.next(ui + 1, nxt);
        if (has_next) { PG8_SETA(voN, nxt); }
        else {
#pragma unroll
            for (int h = 0; h < 2; ++h)
#pragma unroll
                for (int i = 0; i < 2; ++i) voN[h][i] = voC[h][i];
        }
        const char* nA = has_next ? nxt.A : cA; const char* nB = has_next ? nxt.B : cB;
        for (int t = 0; t < nt; t += 2) {
            const bool last = (t == nt - 2);
            if (last && has_next) S.a_ready(nxt);
            const char* a1 = cA + (size_t)(t + 1) * kstep;
            const char* a2 = last ? nA : cA + (size_t)(t + 2) * kstep; const char* b2 = last ? nB : cB + (size_t)(t + 2) * kstep;
            const char* a3 = a2 + kstep; const char* b3 = b2 + kstep;
            unsigned vo2[2][2];
#pragma unroll
            for (int h = 0; h < 2; ++h)
#pragma unroll
                for (int i = 0; i < 2; ++i) vo2[h][i] = last ? voN[h][i] : voC[h][i];
            PG8_LDB(B0, 0, 0); PG8_LDB(B1, 0, 1); PG8_SCHED; PG8_LDA(At, 0, 0); PG8_STAGE(PG8_SA(1, 1), a1, voC[1]);
            PG8_WAIT_V(8); PG8_WAIT_L(0); PG8_BAR; PG8_MMA(0, 0, At, B0); PG8_MMA(0, 1, At, B1); PG8_BAR; PG8_SCHED;
            PG8_LDA(At, 0, 1); PG8_STAGE(PG8_SB(0, 0), b2, voffB); PG8_STAGE(PG8_SB(0, 1), b2 + hstep, voffB); PG8_STAGE(PG8_SA(0, 0), a2, vo2[0]);
            PG8_WAIT_V(8); PG8_WAIT_L(0); PG8_BAR; PG8_MMA(1, 0, At, B0); PG8_MMA(1, 1, At, B1); PG8_BAR; PG8_SCHED;
            PG8_LDB(B0, 1, 0); PG8_LDB(B1, 1, 1); PG8_SCHED; PG8_LDA(At, 1, 0); PG8_STAGE(PG8_SA(0, 1), a2, vo2[1]);
            PG8_WAIT_V(8); PG8_WAIT_L(0); PG8_BAR; PG8_MMA(0, 0, At, B0); PG8_MMA(0, 1, At, B1); PG8_BAR; PG8_SCHED;
            PG8_LDA(At, 1, 1); PG8_STAGE(PG8_SB(1, 0), b3, voffB); PG8_STAGE(PG8_SB(1, 1), b3 + hstep, voffB); PG8_STAGE(PG8_SA(1, 0), a3, vo2[0]);
            PG8_WAIT_V(8); PG8_WAIT_L(0); PG8_BAR; PG8_MMA(1, 0, At, B0); PG8_MMA(1, 1, At, B1); PG8_BAR; PG8_SCHED;
        }
        if (wr == 0) PG8_BAR;
        const bool keep = E(acc, cur, wr, wc, fr, fq);
        if (!has_next) break;
        if (!keep) {
#pragma unroll
            for (int a = 0; a < 2; ++a)
#pragma unroll
                for (int b = 0; b < 2; ++b)
#pragma unroll
                    for (int m = 0; m < 4; ++m)
#pragma unroll
                        for (int n = 0; n < 2; ++n) acc[a][b][m][n] = (f32x4){0.f, 0.f, 0.f, 0.f};
        }
        cur = nxt; cA = nA; cB = nB; ++ui;
        if (Sched::GATHER) {
#pragma unroll
            for (int h = 0; h < 2; ++h)
#pragma unroll
                for (int i = 0; i < 2; ++i) voC[h][i] = voN[h][i];
        } else { PG8_SETA(voC, cur); }
        PG8_SETLANE();
        if (wr == 1) PG8_BAR;
    }
    PG8_WAIT_V(0);
    PG8_BAR;
#undef PG8_SA
#undef PG8_SB
#undef PG8_STAGE
#undef PG8_LDA
#undef PG8_LDB
#undef PG8_MMA
#undef PG8_WAIT_V
#undef PG8_WAIT_L
#undef PG8_BAR
#undef PG8_SCHED
#undef PG8_SETA
#undef PG8_SETLANE
}
}

struct Args { const float* in[25]; float* out; unsigned char* ws; int ph_lo, ph_hi; };
enum { I_X = 0, I_C, I_WADA, I_BADA, I_N1G, I_WIN, I_LQ1, I_LK1, I_LQ2, I_LK2, I_SUBG, I_LBL, I_HGNG, I_WUPDA, I_WUPHG, I_WOUT, I_N2G, I_WRG, I_BRG, I_WRE, I_BRE, I_W1, I_W3, I_W2, I_FG };

struct DenseOrder {
    static constexpr bool GATHER = false;
    const char* A; const char* Bt; int K, nM, nN, G, c;
    __device__ __forceinline__ bool next(int i, pg8::Unit& u) const {
        const int L = i * G + c, nwg = nM * nN; if (L >= nwg) return false;
        int wgid = L; { const int q = nwg / 8, r = nwg % 8, xcd = wgid % 8, off = wgid / 8; wgid = (xcd < r ? xcd * (q + 1) : r * (q + 1) + (xcd - r) * q) + off; }
        const int nig = 8 * nN, gid = wgid / nig, fm = gid * 8, gsz = (nM - fm) < 8 ? (nM - fm) : 8;
        u.pm = fm + ((wgid % nig) % gsz); u.pn = (wgid % nig) / gsz; u.A = A; u.B = Bt + (size_t)u.pn * 256 * K * 2; u.aux = 0; return true;
    }
    __device__ __forceinline__ void a_ready(const pg8::Unit&) const {}
    __device__ __forceinline__ unsigned arow(const pg8::Unit& u, int r) const { return (unsigned)(u.pm * 256 + r); }
};
struct UpOrder {
    static constexpr bool GATHER = false;
    const char* A0; const char* A1; const char* B0; const char* B1; int G, c;
    __device__ __forceinline__ bool next(int i, pg8::Unit& u) const {
        const int tile = (i >> 1) * G + c; if (tile >= 256) return false;
        u.pm = tile >> 2; u.pn = tile & 3; u.aux = i & 1;
        u.A = (i & 1) ? A1 : A0; u.B = ((i & 1) ? B1 : B0) + (size_t)u.pn * 256 * 512 * 2; return true;
    }
    __device__ __forceinline__ void a_ready(const pg8::Unit&) const {}
    __device__ __forceinline__ unsigned arow(const pg8::Unit& u, int r) const { return (unsigned)(u.pm * 256 + r); }
};
struct MoeTab { int nt; int pad[3]; int tile_e[176]; int tile_m[176]; int cnt[32]; int tbase[33]; };
struct Moe1Order {
    static constexpr bool GATHER = true;
    const LAS MoeTab* tab; const char* A; const char* W; const int* toklist; int G, c;
    __device__ __forceinline__ bool next(int i, pg8::Unit& u) const {
        const int L = i * G + c; if (L >= tab->nt * 4) return false;
        const int ti = L >> 2; u.pm = ti; u.pn = L & 3; u.aux = ti; u.A = A;
        u.B = W + ((size_t)tab->tile_e[ti] * 1024 + (size_t)u.pn * 256) * 1024 * 2; return true;
    }
    __device__ __forceinline__ void a_ready(const pg8::Unit&) const {}
    __device__ __forceinline__ unsigned arow(const pg8::Unit& u, int r) const {
        const int e = tab->tile_e[u.aux], rr = tab->tile_m[u.aux] * 256 + r;
        return rr < tab->cnt[e] ? (unsigned)toklist[e * T + rr] : 0u;
    }
};
struct Moe2Order {
    static constexpr bool GATHER = false;
    const LAS MoeTab* tab; const char* A; const char* W; unsigned* done; unsigned* tmo; int G, c;
    __device__ __forceinline__ bool next(int i, pg8::Unit& u) const {
        const int n1 = tab->nt * 4, r = n1 % G, nl = G - r; int j;
        if (r > 0 && c >= r) { if (i < 2) j = (c - r) + i * nl; else j = 2 * nl + (c - r) + (i - 2) * G; }
        else j = (r > 0 ? 2 * nl : 0) + ((c - r + G) % G) + i * G;
        if (j >= n1) return false;
        const int ti = j >> 2; u.pm = ti; u.pn = j & 3; u.aux = ti; u.A = A;
        u.B = W + ((size_t)tab->tile_e[ti] * 1024 + (size_t)u.pn * 256) * 512 * 2; return true;
    }
    __device__ __forceinline__ unsigned arow(const pg8::Unit& u, int r) const { return (unsigned)(u.pm * 256 + r); }
    __device__ __forceinline__ void a_ready(const pg8::Unit& u) const {
        if (threadIdx.x < 64) {
            unsigned polls = 0;
            while ((unsigned)__builtin_amdgcn_readfirstlane(__hip_atomic_load(done + 16 * u.pm, __ATOMIC_RELAXED, __HIP_MEMORY_SCOPE_AGENT)) < 32u) {
                if (++polls > (1u << 22)) { if (threadIdx.x == 0) __hip_atomic_store(tmo, 1u, __ATOMIC_RELAXED, __HIP_MEMORY_SCOPE_AGENT); break; }
                __builtin_amdgcn_s_sleep(2); }
            __builtin_amdgcn_fence(__ATOMIC_ACQUIRE, "agent");
            asm volatile("s_waitcnt vmcnt(0)" ::: "memory");
        }
        asm volatile("" ::: "memory"); __builtin_amdgcn_s_barrier(); asm volatile("" ::: "memory");
    }
};

using pg8::Unit; using pg8::cvt_pk_bf16;
struct EpiStoreBf16 {
    static constexpr bool PERM = true;
    bf16_t* O; int ldc; int nscale; float scale0;
    __device__ __forceinline__ bool operator()(f32x4 (&acc)[2][2][4][2], const Unit& u, int wr, int wc, int fr, int fq) const {
        const int row0 = u.pm * 256 + wr * 64 + fr, col0 = u.pn * 256 + wc * 32 + 8 * fq;
        const float sc = u.pn < nscale ? scale0 : 1.0f;
#pragma unroll
        for (int ai = 0; ai < 2; ++ai)
#pragma unroll
            for (int m = 0; m < 4; ++m) { bf16_t* rowp = O + (size_t)(row0 + ai * 128 + m * 16) * ldc + col0;
#pragma unroll
                for (int bj = 0; bj < 2; ++bj) { const f32x4 v0 = acc[ai][bj][m][0] * sc, v1 = acc[ai][bj][m][1] * sc;
                    u32x4 w; w.x = cvt_pk_bf16(v0[0], v0[1]); w.y = cvt_pk_bf16(v0[2], v0[3]); w.z = cvt_pk_bf16(v1[0], v1[1]); w.w = cvt_pk_bf16(v1[2], v1[3]);
                    *(u32x4*)(rowp + bj * 128) = w; } }
        return false;
    }
};
template <int N> __device__ __forceinline__ float dpp_shr(float x) { return __builtin_bit_cast(float, __builtin_amdgcn_update_dpp(0, __builtin_bit_cast(int, x), 0x110 + N, 0xf, 0xf, true)); }
template <int N> __device__ __forceinline__ float dpp_ror(float x) { return __builtin_bit_cast(float, __builtin_amdgcn_update_dpp(0, __builtin_bit_cast(int, x), 0x120 + N, 0xf, 0xf, true)); }
__device__ __forceinline__ float rowsum16(float x) { x += dpp_ror<8>(x); x += dpp_ror<4>(x); x += dpp_ror<2>(x); x += dpp_ror<1>(x); return x; }
__device__ __forceinline__ float scan16(float x) { x += dpp_shr<1>(x); x += dpp_shr<2>(x); x += dpp_shr<4>(x); x += dpp_shr<8>(x); return x; }
struct EpiInProj {
    static constexpr bool PERM = true;
    bf16_t* O; bf16_t* KE; float* DEC; const float* lbv; float scale0;
    __device__ __forceinline__ bool operator()(f32x4 (&acc)[2][2][4][2], const Unit& u, int wr, int wc, int fr, int fq) const {
        { const int l_ = lane_now(); fr = l_ & 15; fq = l_ >> 4; }
        const int row0 = u.pm * 256 + wr * 64 + fr, col0 = u.pn * 256 + wc * 32 + 8 * fq;
        if (u.pn >= 6 && u.pn < 10) {
            const int h = u.pn - 6, lane = 16 * fq + fr, kb = wc * 32 + 8 * fq;
            const int bb = (u.pm * 256) / SEQ, ch0 = ((u.pm * 256) % SEQ + wr * 64) >> 6;
            const f32x4 lb0 = *(const f32x4*)(lbv + h * 128 + kb), lb1 = *(const f32x4*)(lbv + h * 128 + kb + 4);
#pragma unroll
            for (int ai = 0; ai < 2; ++ai) {
                unsigned kep[4][4];
#pragma unroll
                for (int n = 0; n < 2; ++n) {
#pragma unroll
                    for (int ep = 0; ep < 2; ++ep) {
                        float ke2[2][4];
#pragma unroll
                        for (int z = 0; z < 2; ++z) {
                            const int e = 2 * ep + z; const float lb = n ? lb1[e] : lb0[e];
                            float f[4], c[4], tot[4];
#pragma unroll
                            for (int m = 0; m < 4; ++m) { const float fl = acc[ai][1][m][n][e]; f[m] = lb + (1.0f - lb) * __builtin_amdgcn_rcpf(1.0f + __builtin_amdgcn_exp2f(-1.4426950408889634f * fl)); const float lf = __logf(f[m]); c[m] = scan16(lf); tot[m] = rowsum16(lf); }
                            const float alast = (tot[0] + tot[1]) + (tot[2] + tot[3]); const float eal = __expf(alast);
                            float pre = 0.f;
#pragma unroll
                            for (int m = 0; m < 4; ++m) { const float A = c[m] + pre; pre += tot[m]; const float q = acc[ai][0][m][n][e]; const float kk = 1.0f - f[m];
                                acc[ai][0][m][n][e] = q * __builtin_amdgcn_rcpf(1.0f + __builtin_amdgcn_exp2f(-1.4426950408889634f * q)) * __expf(A);
                                const float kd = kk * __expf(-A); acc[ai][1][m][n][e] = kd; ke2[z][m] = kd * eal; }
                            if (fr == 0) DEC[((size_t)(bb * 4 + h) * 64 + ch0 + 2 * ai) * 128 + kb + 4 * n + e] = eal;
                        }
#pragma unroll
                        for (int m = 0; m < 4; ++m) kep[m][2 * n + ep] = cvt_pk_bf16(ke2[0][m], ke2[1][m]);
                    }
                }
#pragma unroll
                for (int m = 0; m < 4; ++m) *(u32x4*)(KE + (size_t)(row0 + ai * 128 + m * 16) * 512 + h * 128 + kb) = (u32x4){kep[m][0], kep[m][1], kep[m][2], kep[m][3]};
            }
        }
        const float sc = u.pn < 2 ? scale0 : 1.0f;
#pragma unroll
        for (int ai = 0; ai < 2; ++ai)
#pragma unroll
            for (int m = 0; m < 4; ++m) { bf16_t* rowp = O + (size_t)(row0 + ai * 128 + m * 16) * INC + col0;
#pragma unroll
                for (int bj = 0; bj < 2; ++bj) { const f32x4 v0 = acc[ai][bj][m][0] * sc, v1 = acc[ai][bj][m][1] * sc;
                    u32x4 w; w.x = cvt_pk_bf16(v0[0], v0[1]); w.y = cvt_pk_bf16(v0[2], v0[3]); w.z = cvt_pk_bf16(v1[0], v1[1]); w.w = cvt_pk_bf16(v1[2], v1[3]);
                    *(u32x4*)(rowp + bj * 128) = w; } }
        return false;
    }
};
struct EpiUp {
    static constexpr bool PERM = true;
    const bf16_t* proj; bf16_t* O;
    __device__ __forceinline__ bool operator()(f32x4 (&acc)[2][2][4][2], const Unit& u, int wr, int wc, int fr, int fq) const {
        const int row0 = u.pm * 256 + wr * 64 + fr, col0 = u.pn * 256 + wc * 32 + 8 * fq;
#pragma unroll
        for (int ai = 0; ai < 2; ++ai)
#pragma unroll
            for (int m = 0; m < 4; ++m) { const size_t row = (size_t)(row0 + ai * 128 + m * 16);
#pragma unroll
                for (int bj = 0; bj < 2; ++bj) {
                    const int col = col0 + bj * 128;
                    const u32x4 gh = *(const u32x4*)(proj + row * INC + C_GHGATE + col);
                    float sh[8];
#pragma unroll
                    for (int j = 0; j < 4; ++j) { sh[2 * j] = 1.0f + __builtin_amdgcn_exp2f(-1.4426950408889634f * bf2f(gh[j] & 0xffffu)); sh[2 * j + 1] = 1.0f + __builtin_amdgcn_exp2f(-1.4426950408889634f * bf2f(gh[j] >> 16)); }
                    if (u.aux == 0) {
                        const u32x4 gd = *(const u32x4*)(proj + row * INC + C_GDA + col);
#pragma unroll
                        for (int j = 0; j < 4; ++j) {
                            const float d0 = 1.0f + __builtin_amdgcn_exp2f(-1.4426950408889634f * bf2f(gd[j] & 0xffffu)), d1 = 1.0f + __builtin_amdgcn_exp2f(-1.4426950408889634f * bf2f(gd[j] >> 16));
                            const float r0 = sh[2 * j] * __builtin_amdgcn_rcpf(d0), r1 = sh[2 * j + 1] * __builtin_amdgcn_rcpf(d1);
                            if (j < 2) { acc[ai][bj][m][0][2 * j] *= r0; acc[ai][bj][m][0][2 * j + 1] *= r1; }
                            else { acc[ai][bj][m][1][2 * j - 4] *= r0; acc[ai][bj][m][1][2 * j - 3] *= r1; }
                        }
                    } else {
                        const f32x4 v0 = acc[ai][bj][m][0], v1 = acc[ai][bj][m][1];
#pragma unroll
                        for (int j = 0; j < 8; ++j) sh[j] = __builtin_amdgcn_rcpf(sh[j]);
                        u32x4 w; w.x = cvt_pk_bf16(v0[0] * sh[0], v0[1] * sh[1]); w.y = cvt_pk_bf16(v0[2] * sh[2], v0[3] * sh[3]);
                        w.z = cvt_pk_bf16(v1[0] * sh[4], v1[1] * sh[5]); w.w = cvt_pk_bf16(v1[2] * sh[6], v1[3] * sh[7]);
                        *(u32x4*)(O + row * D + col) = w;
                    }
                } }
        return u.aux == 0;
    }
};
struct EpiOut {
    static constexpr bool PERM = true;
    const float* x; const float* mod; bf16_t* O;
    __device__ __forceinline__ bool operator()(f32x4 (&acc)[2][2][4][2], const Unit& u, int wr, int wc, int fr, int fq) const {
        const int row0 = u.pm * 256 + wr * 64 + fr, col0 = u.pn * 256 + wc * 32 + 8 * fq;
        const int b = (u.pm * 256) / SEQ;
        f32x4 gt[2][2];
#pragma unroll
        for (int bj = 0; bj < 2; ++bj)
#pragma unroll
            for (int n = 0; n < 2; ++n) gt[bj][n] = *(const f32x4*)(mod + b * 6144 + 2048 + col0 + bj * 128 + n * 4);
#pragma unroll
        for (int ai = 0; ai < 2; ++ai)
#pragma unroll
            for (int m = 0; m < 4; ++m) { const size_t off = (size_t)(row0 + ai * 128 + m * 16) * D + col0;
#pragma unroll
                for (int bj = 0; bj < 2; ++bj) { const f32x4 x0 = *(const f32x4*)(x + off + bj * 128), x1 = *(const f32x4*)(x + off + bj * 128 + 4);
                    const f32x4 v0 = x0 + gt[bj][0] * acc[ai][bj][m][0], v1 = x1 + gt[bj][1] * acc[ai][bj][m][1];
                    u32x4 w; w.x = cvt_pk_bf16(v0[0], v0[1]); w.y = cvt_pk_bf16(v0[2], v0[3]); w.z = cvt_pk_bf16(v1[0], v1[1]); w.w = cvt_pk_bf16(v1[2], v1[3]);
                    *(u32x4*)(O + off + bj * 128) = w; } }
        return false;
    }
};
struct EpiMoe1 {
    static constexpr bool PERM = true;
    bf16_t* O; unsigned* done;
    __device__ __forceinline__ bool operator()(f32x4 (&acc)[2][2][4][2], const Unit& u, int wr, int wc, int fr, int fq) const {
        const int row0 = u.pm * 256 + wr * 64 + fr, col0 = u.pn * 128 + wc * 32 + 8 * fq;
#pragma unroll
        for (int ai = 0; ai < 2; ++ai)
#pragma unroll
            for (int m = 0; m < 4; ++m) { bf16_t* rowp = O + (size_t)(row0 + ai * 128 + m * 16) * DEXP + col0;
                float h[8];
#pragma unroll
                for (int n = 0; n < 2; ++n)
#pragma unroll
                    for (int e = 0; e < 4; ++e) { const float x_ = acc[ai][0][m][n][e]; h[n * 4 + e] = x_ * __builtin_amdgcn_rcpf(1.0f + __builtin_amdgcn_exp2f(-1.4426950408889634f * x_)) * acc[ai][1][m][n][e]; }
                u32x4 w; w.x = cvt_pk_bf16(h[0], h[1]); w.y = cvt_pk_bf16(h[2], h[3]); w.z = cvt_pk_bf16(h[4], h[5]); w.w = cvt_pk_bf16(h[6], h[7]);
                asm volatile("global_store_dwordx4 %0, %1, off sc1\n\ts_nop 1" :: "v"(rowp), "v"(w) : "memory"); }
        asm volatile("s_waitcnt vmcnt(0)" ::: "memory");
        if ((threadIdx.x & 63) == 0) __hip_atomic_fetch_add(done + 16 * u.pm, 1u, __ATOMIC_RELAXED, __HIP_MEMORY_SCOPE_AGENT);
        return false;
    }
};

struct Frame { LAS unsigned char* lds; int tid, lane, wave, G, bid; };

__device__ __forceinline__ void transpose_item(const float* Wsrc, int ldw, bf16_t* dst, int ldd, LAS float* scr, int lane) {
#pragma unroll 8
    for (int i = 0; i < 32; ++i) { const int kk = 2 * i + (lane >> 5); scr[kk * 33 + (lane & 31)] = __builtin_nontemporal_load(Wsrc + (size_t)kk * ldw + (lane & 31)); }
    asm volatile("s_waitcnt lgkmcnt(0)" ::: "memory");
    const int c = lane & 7;
#pragma unroll
    for (int j = 0; j < 4; ++j) { const int n = (lane >> 3) + 8 * j; const LAS float* s = scr + (8 * c) * 33 + n;
        u32x4 o; o.x = pk2(s[0 * 33], s[1 * 33]); o.y = pk2(s[2 * 33], s[3 * 33]); o.z = pk2(s[4 * 33], s[5 * 33]); o.w = pk2(s[6 * 33], s[7 * 33]);
        *(u32x4*)(dst + (size_t)n * ldd + 8 * c) = o; }
    asm volatile("s_waitcnt lgkmcnt(0)" ::: "memory");
}
__device__ __forceinline__ void transpose_matrix(const Frame& F, const float* W, int K, int N, bf16_t* WT) {
    LAS float* scr = (LAS float*)(F.lds + F.wave * 8448);
    const int gw = F.bid * NWAVES + F.wave, NGW = F.G * NWAVES, nblk = N / 32, items = (K / 64) * nblk;
    for (int it = gw; it < items; it += NGW) { const int kb = it / nblk, nb = it % nblk;
        transpose_item(W + (size_t)(64 * kb) * N + 32 * nb, N, WT + (size_t)(32 * nb) * K + 64 * kb, K, scr, F.lane); }
}

__device__ __forceinline__ void phase0(const Frame& F, const Args& a) {
    unsigned char* ws = a.ws;
    {
        float* modp = (float*)(ws + WS_MODP);
        const float* c = a.in[I_C]; const float* wada = a.in[I_WADA];
        LAS float* cs = (LAS float*)(F.lds + 72 * 1024);
        for (int i = F.tid; i < 4 * D; i += NTHR) cs[i] = siluf_(c[i]);
        __syncthreads();
        for (int wt = F.bid + 256 * F.wave; wt < 384; wt += 256 * NWAVES) {
            if (F.G != 256) break;
            const int ks = wt / 24, jw = wt % 24, j = jw * 256 + F.lane * 4;
            f32x4 s[4] = {{0, 0, 0, 0}, {0, 0, 0, 0}, {0, 0, 0, 0}, {0, 0, 0, 0}};
#pragma unroll 8
            for (int k = ks * 64; k < ks * 64 + 64; ++k) {
                const f32x4 w = *(const f32x4*)(wada + (size_t)k * 6144 + j);
#pragma unroll
                for (int b = 0; b < 4; ++b) s[b] += w * cs[b * D + k];
            }
#pragma unroll
            for (int b = 0; b < 4; ++b) *(f32x4*)(modp + ((size_t)ks * 4 + b) * 6144 + j) = s[b];
        }
        if (F.G != 256) {
            const int gw = F.bid * NWAVES + F.wave, NGW = F.G * NWAVES;
            for (int wt = gw; wt < 384; wt += NGW) {
                const int ks = wt / 24, jw = wt % 24, j = jw * 256 + F.lane * 4;
                f32x4 s[4] = {{0, 0, 0, 0}, {0, 0, 0, 0}, {0, 0, 0, 0}, {0, 0, 0, 0}};
                for (int k = ks * 64; k < ks * 64 + 64; ++k) {
                    const f32x4 w = *(const f32x4*)(wada + (size_t)k * 6144 + j);
#pragma unroll
                    for (int b = 0; b < 4; ++b) { const float cv = siluf_(c[b * D + k]); s[b] += w * cv; }
                }
#pragma unroll
                for (int b = 0; b < 4; ++b) *(f32x4*)(modp + ((size_t)ks * 4 + b) * 6144 + j) = s[b];
            }
        }
    }
    if (F.bid == 0) {
        float* sm = (float*)(ws + WS_SMALL);
        if (F.tid == 0) {
            float s1 = 0.f, s2 = 0.f;
            for (int i = 0; i < 64; ++i) { s1 += a.in[I_LQ1][i] * a.in[I_LK1][i]; s2 += a.in[I_LQ2][i] * a.in[I_LK2][i]; }
            sm[0] = expf(s1) - expf(s2) + 0.2f;
        }
        { const float l0 = a.in[I_LBL][F.tid], l1 = a.in[I_LBL][512 + F.tid]; const float mx = fmaxf(l0, l1);
          const float e0 = expf(l0 - mx), e1 = expf(l1 - mx); sm[16 + F.tid] = e0 / (e0 + e1); }
    }
}
__device__ __forceinline__ void moe_w2_convert(const Frame& F, const Args& a, int it_lo, int it_hi, int gw, int NGW) {
    LAS float* scr = (LAS float*)(F.lds + F.wave * 8448);
    bf16_t* w2t = (bf16_t*)((unsigned char*)a.out + OUT_W2);
    for (int it = it_lo + gw; it < it_hi; it += NGW) {
        const int e = it >> 8, kb = (it >> 5) & 7, nb = it & 31;
        const float* W = a.in[I_W2] + (size_t)e * 512 * 1024;
        transpose_item(W + (size_t)(64 * kb) * 1024 + 32 * nb, 1024, w2t + ((size_t)e * 1024 + 32 * nb) * 512 + 64 * kb, 512, scr, F.lane);
    }
}
__device__ __forceinline__ int w2_early_items(int G, int& n_light) { const int nwg = (T / 256) * (INC / 256), r = nwg % G; n_light = r ? G - r : 0; return n_light >= 64 ? W2_EARLY * 256 : 0; }
__device__ __forceinline__ void moe_weight_convert(const Frame& F, const Args& a) {
    LAS float* scr = (LAS float*)(F.lds + F.wave * 8448);
    const int gw = F.bid * NWAVES + F.wave, NGW = F.G * NWAVES;
    bf16_t* w13 = (bf16_t*)(a.ws + WS_W13);
    for (int it = gw; it < 2 * NEXP * 256; it += NGW) {
        const int which = it / (NEXP * 256), r = it % (NEXP * 256), e = r >> 8, kb = (r >> 4) & 15, nb = r & 15, n0 = 32 * nb;
        const float* W = a.in[which ? I_W3 : I_W1] + (size_t)e * 1024 * 512;
        const int drow = 256 * (n0 >> 7) + (which ? 128 : 0) + (n0 & 127);
        transpose_item(W + (size_t)(64 * kb) * 512 + n0, 512, w13 + ((size_t)e * 1024 + drow) * 1024 + 64 * kb, 1024, scr, F.lane);
    }
    int nl; const int early = w2_early_items(F.G, nl);
    moe_w2_convert(F, a, early, NEXP * 256, gw, NGW);
}

__device__ __forceinline__ void dense_weight_convert(const Frame& F, const Args& a) {
    unsigned char* ws = a.ws;
    {
        LAS float* scr = (LAS float*)(F.lds + F.wave * 8448);
        const int gw = F.bid * NWAVES + F.wave, NGW = F.G * NWAVES, nblk = INC / 32, items = (D / 64) * nblk;
        bf16_t* WT = (bf16_t*)(ws + WS_WIN);
        for (int it = gw; it < items; it += NGW) { const int kb = it / nblk, n0 = 32 * (it % nblk); int dr = n0;
            if (n0 >= C_QHG && n0 < C_FHG) dr = C_HGT + 256 * ((n0 - C_QHG) >> 7) + ((n0 - C_QHG) & 127);
            else if (n0 >= C_FHG && n0 < C_IHG) dr = C_HGT + 256 * ((n0 - C_FHG) >> 7) + 128 + ((n0 - C_FHG) & 127);
            transpose_item(a.in[I_WIN] + (size_t)(64 * kb) * INC + n0, INC, WT + (size_t)dr * D + 64 * kb, D, scr, F.lane); }
    }
    transpose_matrix(F, a.in[I_WUPDA], 512, D, (bf16_t*)(ws + WS_WUPDA));
    transpose_matrix(F, a.in[I_WUPHG], 512, D, (bf16_t*)(ws + WS_WUPHG));
    transpose_matrix(F, a.in[I_WOUT], D, D, (bf16_t*)(ws + WS_WOUT));
}
__device__ __forceinline__ void phase1(const Frame& F, const Args& a) {
    const float* modp = (const float*)(a.ws + WS_MODP); float* mod = (float*)(a.ws + WS_MOD);
    for (int i = F.bid * NTHR + F.tid; i < 4 * 6144; i += F.G * NTHR) {
        float s = a.in[I_BADA][i % 6144];
        for (int ks = 0; ks < 16; ++ks) s += modp[(size_t)ks * 4 * 6144 + i];
        mod[i] = s;
    }
    LAS float* Gs = (LAS float*)F.lds;
    LAS float* Ss = Gs + 1024;
    bf16_t* H = (bf16_t*)(a.ws + WS_ACT);
    const int rows_per_blk = T / F.G;
    const int r0 = F.bid * rows_per_blk, b = r0 / SEQ;
    for (int k = F.tid; k < 1024; k += NTHR) {
        float sh = a.in[I_BADA][k], sc = a.in[I_BADA][1024 + k];
        for (int ks = 0; ks < 16; ++ks) { sh += modp[((size_t)ks * 4 + b) * 6144 + k]; sc += modp[((size_t)ks * 4 + b) * 6144 + 1024 + k]; }
        Gs[k] = a.in[I_N1G][k] * (1.0f + sc); Ss[k] = sh;
    }
    __syncthreads();
    for (int r = r0 + F.wave; r < r0 + rows_per_blk; r += NWAVES) {
        const f32x4* xr = (const f32x4*)(a.in[I_X] + (size_t)r * D) + F.lane;
        f32x4 v[4]; float s = 0.f;
#pragma unroll
        for (int j = 0; j < 4; ++j) { v[j] = xr[64 * j]; s += (v[j].x * v[j].x + v[j].y * v[j].y) + (v[j].z * v[j].z + v[j].w * v[j].w); }
        const float rs = rsqrtf(wave_sum(s) * (1.0f / D) + EPS);
        unsigned long long* o8 = (unsigned long long*)(H + (size_t)r * D) + F.lane;
#pragma unroll
        for (int j = 0; j < 4; ++j) { const f32x4 g = *(const LAS f32x4*)(Gs + 256 * j + 4 * F.lane), sh = *(const LAS f32x4*)(Ss + 256 * j + 4 * F.lane);
            const f32x4 h = v[j] * rs * g + sh;
            o8[64 * j] = (unsigned long long)pk2(h.x, h.y) | ((unsigned long long)pk2(h.z, h.w) << 32); }
    }
}

namespace attn_body {
using s16x4=__attribute__((ext_vector_type(4)))short;
using f32x16=__attribute__((ext_vector_type(16)))float;
constexpr int NW=8,QBLK=32,QB=QBLK*NW,KVBLK=64,NQB=SEQ/QB;
constexpr int PIN=INC, POUT=1024;
__device__ __forceinline__ int crow(int r,int hi){return (r&3)+8*(r>>2)+4*hi;}
#define SBAR() __builtin_amdgcn_sched_barrier(0)
__device__ __forceinline__ void bmask(f32x16&p0,f32x16&p1,int jb,int wch,int il,int hi,float s2x2){
  if(jb>wch){
    #pragma unroll
    for(int r=0;r<16;++r){p0[r]=-INFINITY;p1[r]=-INFINITY;}
  } else if(jb==wch){
    float fb=(float)(4*hi-il); asm volatile("":"+v"(fb));
    #pragma unroll
    for(int r=0;r<16;++r){const float c=(float)((r&3)+8*(r>>2)); p0[r]-=s2x2*__builtin_fmaxf(fb+c,0.f); p1[r]-=s2x2*__builtin_fmaxf(fb+(c+32.f),0.f);}
  }
}
constexpr int NSLOT=3, SLOTB=8192, VSLOTB=16384;
constexpr int LDS_K=0, LDS_V=NSLOT*SLOTB, LDS_WS=LDS_V+NSLOT*VSLOTB, LDS_OST=LDS_WS+NW*64*4, ATT_LDS_BYTES=LDS_OST+NW*8192;
constexpr float C2=0.125f*1.4426950408889634f;
__device__ __forceinline__ void glds16(const void*gsrc,unsigned lds_dst){unsigned keep;
  asm volatile("s_mov_b32 %0, m0\n\ts_mov_b32 m0, %2\n\ts_nop 0\n\tglobal_load_lds_dwordx4 %1, off\n\ts_mov_b32 m0, %0":"=&s"(keep):"v"(gsrc),"s"(lds_dst):"memory");}
__device__ __forceinline__ float max3f(float a,float b,float c){float r;asm("v_max3_f32 %0, %1, %2, %3":"=v"(r):"v"(a),"v"(b),"v"(c));return r;}
__device__ __forceinline__ float max2f(float a,float b){float r;asm("v_max_f32_e32 %0, %1, %2":"=v"(r):"v"(a),"v"(b));return r;}
__device__ __forceinline__ float fadd_s(float a,float b){float r;asm("v_add_f32_e32 %0, %1, %2":"=v"(r):"v"(a),"v"(b));return r;}
__device__ __forceinline__ float fsub_s(float a,float b){float r;asm("v_sub_f32_e32 %0, %1, %2":"=v"(r):"v"(a),"v"(b));return r;}
typedef float f32x2_t __attribute__((ext_vector_type(2))); typedef __bf16 bf16x2_t __attribute__((ext_vector_type(2)));
__device__ __forceinline__ unsigned cvtpk_s(float lo,float hi){f32x2_t v={lo,hi};bf16x2_t b=__builtin_convertvector(v,bf16x2_t);return __builtin_bit_cast(unsigned,b);}
#define WAIT_BAR(N) asm volatile("s_waitcnt vmcnt(" #N ") lgkmcnt(0)\n\ts_barrier":::"memory")

__device__ __forceinline__ void qkt(f32x16&p0,f32x16&p1,const char*Kslot,const bf16x8*qr,const f32x16&c0,const f32x16&c1,int r32,int hi){
  const char*kb=Kslot+hi*1024+r32*16;
  #pragma unroll
  for(int d0=0;d0<4;++d0){
    const bf16x8 b0=*reinterpret_cast<const bf16x8*>(kb+d0*2048);
    const bf16x8 b1=*reinterpret_cast<const bf16x8*>(kb+d0*2048+512);
    if(d0==0){p0=__builtin_amdgcn_mfma_f32_32x32x16_bf16(b0,qr[0],c0,0,0,0);p1=__builtin_amdgcn_mfma_f32_32x32x16_bf16(b1,qr[0],c1,0,0,0);}
    else{p0=__builtin_amdgcn_mfma_f32_32x32x16_bf16(b0,qr[d0],p0,0,0,0);p1=__builtin_amdgcn_mfma_f32_32x32x16_bf16(b1,qr[d0],p1,0,0,0);}}
}
typedef __attribute__((address_space(3))) const char* lds_cptr;
typedef short v4i16_t __attribute__((ext_vector_type(4)));
__device__ __forceinline__ void kload8(bf16x8*kf,lds_cptr kp){
  kf[0]=*(const __attribute__((address_space(3))) bf16x8*)(kp);      kf[1]=*(const __attribute__((address_space(3))) bf16x8*)(kp+512);
  kf[2]=*(const __attribute__((address_space(3))) bf16x8*)(kp+2048); kf[3]=*(const __attribute__((address_space(3))) bf16x8*)(kp+2560);
  kf[4]=*(const __attribute__((address_space(3))) bf16x8*)(kp+4096); kf[5]=*(const __attribute__((address_space(3))) bf16x8*)(kp+4608);
  kf[6]=*(const __attribute__((address_space(3))) bf16x8*)(kp+6144); kf[7]=*(const __attribute__((address_space(3))) bf16x8*)(kp+6656);
}
__device__ __forceinline__ void kload2(bf16x8*kf,lds_cptr kp,int j){ kf[2*j]=*(const __attribute__((address_space(3))) bf16x8*)(kp+j*2048); kf[2*j+1]=*(const __attribute__((address_space(3))) bf16x8*)(kp+j*2048+512); }
__device__ __forceinline__ s16x4 vtr(lds_cptr p){ return __builtin_bit_cast(s16x4,__builtin_amdgcn_ds_read_tr16_b64_v4i16((__attribute__((address_space(3))) v4i16_t*)p)); }
__device__ __forceinline__ float rowmax(const f32x16&p0,const f32x16&p1){
  float a=max3f(p0[0],p0[1],p1[0]),b=max3f(p0[2],p0[3],p1[1]);a=max3f(a,p1[2],p1[3]);
  #pragma unroll
  for(int r=4;r<16;r+=4){a=max3f(a,p0[r],p0[r+1]);b=max3f(b,p0[r+2],p0[r+3]);a=max3f(a,p1[r],p1[r+1]);b=max3f(b,p1[r+2],p1[r+3]);}
  const float m=max2f(a,b);
  auto rr=__builtin_amdgcn_permlane32_swap(__float_as_uint(m),__float_as_uint(m),false,false);
  return max2f(__uint_as_float(rr[0]),__uint_as_float(rr[1]));
}
__device__ __forceinline__ void pv(f32x16*o,int vb,bf16x8 pa0,bf16x8 pa1,bf16x8 pa2,bf16x8 pa3){
  #pragma unroll
  for(int d0=0;d0<4;++d0){s16x4 lo[4],hi[4];
    #pragma unroll
    for(int ks=0;ks<4;++ks){
      asm volatile("ds_read_b64_tr_b16 %0,%1 offset:%c2":"=&v"(lo[ks]):"v"(vb),"i"(d0*4096+ks*1024):"memory");
      asm volatile("ds_read_b64_tr_b16 %0,%1 offset:%c2":"=&v"(hi[ks]):"v"(vb),"i"(d0*4096+ks*1024+512):"memory");}
    asm volatile("s_waitcnt lgkmcnt(0)":::"memory");SBAR();
    #define PK(k) (bf16x8){lo[k][0],lo[k][1],lo[k][2],lo[k][3],hi[k][0],hi[k][1],hi[k][2],hi[k][3]}
    o[d0]=__builtin_amdgcn_mfma_f32_32x32x16_bf16(pa0,PK(0),o[d0],0,0,0);
    o[d0]=__builtin_amdgcn_mfma_f32_32x32x16_bf16(pa1,PK(1),o[d0],0,0,0);
    o[d0]=__builtin_amdgcn_mfma_f32_32x32x16_bf16(pa2,PK(2),o[d0],0,0,0);
    o[d0]=__builtin_amdgcn_mfma_f32_32x32x16_bf16(pa3,PK(3),o[d0],0,0,0);
    #undef PK
  }
}
#define ATTN_STORE16(p,v) (*(u32x4*)(p)=(v))
template<int THRL> __device__ __forceinline__ void attn_unit(int qb,const bf16_t*Qb,const bf16_t*__restrict__ Kh,const bf16_t*__restrict__ Vh,bf16_t*Ob,float slope2,char*shm){
  const int wid=__builtin_amdgcn_readfirstlane(threadIdx.x>>6); const int lane=lane_now(),r32=lane&31,hi=lane>>5;
  const int q0=qb*QB;
  const bf16_t*Qw=Qb+(long)(q0+wid*QBLK)*PIN;
  const unsigned lds0=(unsigned)(uintptr_t)shm;
  float*wsf=(float*)(shm+LDS_WS)+wid*64;
  const bf16_t*ksrc=Kh+(long)lane*PIN+wid*8;
  const bf16_t*vsrc=Vh+(long)(16*(wid&3)+(lane>>2))*PIN+(wid>>2)*32+(lane&3)*8;
  const unsigned kdst=lds0+LDS_K+wid*1024, vdst=lds0+LDS_V+(wid>>2)*4096+(wid&3)*1024;
  #define DMA_K(t,slot) glds16(ksrc+(long)(t)*KVBLK*PIN,(unsigned)__builtin_amdgcn_readfirstlane(kdst+(slot)))
  #define DMA_V(t,slot) do{ glds16(vsrc+(long)(t)*KVBLK*PIN,(unsigned)__builtin_amdgcn_readfirstlane(vdst+2*(slot))); glds16(vsrc+(long)(t)*KVBLK*PIN+64,(unsigned)__builtin_amdgcn_readfirstlane(vdst+2*(slot)+8192)); }while(0)
  const int vb0=(int)(lds0+LDS_V)+((lane>>4)&1)*32+(lane&3)*8+(4*hi+((lane&15)>>2))*64;
  const char*Kbase=shm+LDS_K; bf16x8 kf[8];
  const lds_cptr shm3=(lds_cptr)shm; const lds_cptr kp0=shm3+LDS_K+hi*1024+r32*16; const lds_cptr vp0=shm3+LDS_V+((lane>>4)&1)*32+(lane&3)*8+(4*hi+((lane&15)>>2))*64;
  const int NT=(q0+QB)/KVBLK;
  DMA_K(0,0);DMA_V(0,0);DMA_K(1,SLOTB);
  bf16x8 qr[4];
  #pragma unroll
  for(int d0=0;d0<4;++d0)qr[d0]=*reinterpret_cast<const bf16x8*>(&Qw[(long)r32*PIN+d0*16+hi*8]);
  float mhat=0.f,l_reg=0.f;f32x16 o[4];o[0]=f32x16{};o[1]=f32x16{};o[2]=f32x16{};o[3]=f32x16{};
  const float s64=slope2*64.f, s32=slope2*32.f, s2x2=2.f*slope2, s4hi=slope2*4.f*(float)hi;
  const int wch=wid>>1, il=32*(wid&1)+r32;
  #define CMASK(P0,P1,t) do{int jb_=(t)-(NT-4); if(jb_>=0)bmask(P0,P1,jb_,wch,il,hi,s2x2);}while(0)
  #define CINIT0(C0,t) do{ const float bt_=s64*(float)((t)-NT)-mhat+s4hi; _Pragma("unroll") for(int r=0;r<16;++r){C0[r]=__builtin_fmaf(slope2,(float)((r&3)+8*(r>>2)),bt_);} }while(0)
  #define CINIT1(C1,t) do{ const float bu_=s64*(float)((t)-NT)-mhat+s4hi+s32; _Pragma("unroll") for(int r=0;r<16;++r){C1[r]=__builtin_fmaf(slope2,(float)((r&3)+8*(r>>2)),bu_);} }while(0)
  bool resc=false;
  #define START(P0,P1) do{ const float rm=rowmax(P0,P1); resc=false; \
    { const float dl=rm; mhat=fadd_s(mhat,dl); \
      _Pragma("unroll") for(int r=0;r<16;++r){P0[r]=fsub_s(P0[r],dl);P1[r]=fsub_s(P1[r],dl);} } \
    _Pragma("unroll") for(int r=0;r<16;++r)P0[r]=__builtin_amdgcn_exp2f(P0[r]); }while(0)
  #define RESC() do{ if(resc){ asm volatile("s_waitcnt lgkmcnt(0)":::"memory"); \
      _Pragma("unroll") for(int d_=0;d_<4;++d_) _Pragma("unroll") for(int r=0;r<16;++r)o[d_][r]*=wsf[crow(r,hi)]; } }while(0)
  f32x16 cS0,cS1;
  u32x4 pwa0,pwa1,pwa2,pwa3,pwb0,pwb1,pwb2,pwb3;
  int sl_prev=0,sl_cur=0,sl_next=SLOTB;
  #define ROT() do{sl_prev=sl_cur;sl_cur=sl_next;sl_next=(sl_next==(NSLOT-1)*SLOTB)?0:sl_next+SLOTB;}while(0)
  #define PKW(P,B) cvtpk_s(P[B],P[B+1])
  DMA_K(2,2*SLOTB);
  WAIT_BAR(3);
  { f32x16 c0,c1; CINIT0(c0,0); CINIT1(c1,0); qkt(cS0,cS1,Kbase,qr,c0,c1,r32,hi); }
  asm volatile("s_nop 15\n\ts_nop 7":"+v"(cS0),"+v"(cS1));CMASK(cS0,cS1,0);
  START(cS0,cS1);
  _Pragma("unroll") for(int r=0;r<16;++r)cS1[r]=__builtin_amdgcn_exp2f(cS1[r]);
  { float sacc=cS0[0]+cS0[1]; _Pragma("unroll") for(int r=2;r<16;++r)sacc+=cS0[r]; _Pragma("unroll") for(int r=0;r<16;++r)sacc+=cS1[r]; l_reg+=sacc;
    pwa0=(u32x4){PKW(cS0,0),PKW(cS0,2),PKW(cS0,4),PKW(cS0,6)};pwa1=(u32x4){PKW(cS0,8),PKW(cS0,10),PKW(cS0,12),PKW(cS0,14)};pwa2=(u32x4){PKW(cS1,0),PKW(cS1,2),PKW(cS1,4),PKW(cS1,6)};pwa3=(u32x4){PKW(cS1,8),PKW(cS1,10),PKW(cS1,12),PKW(cS1,14)}; }
  WAIT_BAR(0);
  DMA_K(3,0);DMA_V(1,SLOTB);
  ROT();
  kload8(kf,kp0+sl_cur);
  WAIT_BAR(3);
  s16x4 vlo[4],vhi[4];
  #define CAT_(a,b) a##b
  #define CAT(a,b) CAT_(a,b)
  #define PAFC(P,k) __builtin_bit_cast(bf16x8,CAT(P,k))
  #define VFR(k) (bf16x8){vlo[(k)&3][0],vlo[(k)&3][1],vlo[(k)&3][2],vlo[(k)&3][3],vhi[(k)&3][0],vhi[(k)&3][1],vhi[(k)&3][2],vhi[(k)&3][3]}
  #define VOFF(k) ((k)<8 ? (((k)&1)*4096+((k)>>1)*1024) : ((2+((k)&1))*4096+(((k)-8)>>1)*1024))
  #define PIN_(x) asm volatile("":"+v"(x))
  #define MX3(a,b,c) __builtin_fmaxf(__builtin_fmaxf((a),(b)),(c))
  #define QK(MF) do{ MF; SBAR(); }while(0)
  #define EX(v) __builtin_amdgcn_exp2f(v)
  #define VRD(k) do{ vlo[(k)&3]=vtr(vp_+VOFF(k)); vhi[(k)&3]=vtr(vp_+(VOFF(k)+512)); }while(0)
  #define VNX(k) do{ if((k)+4<16){ VRD((k)+4); } SBAR(); }while(0)
  #define GAPB3(MF,X,B,PW,J) do{ MF; X[B]=EX(X[B]); X[B+1]=EX(X[B+1]); sacc+=X[B]; sacc+=X[B+1]; PW[J]=cvtpk_s(X[B],X[B+1]); PIN_(X); PIN_(sacc); PIN_(PW); SBAR(); }while(0)
  #define KRD(G,j) do{ if(G){ kload2(kf,kp0+sl_next,j); SBAR(); } }while(0)
  #define STEP(PC,PN,t,GK,GV,GL) do{ SBAR(); \
    CINIT0(cS0,t); SBAR(); \
    const lds_cptr vp_=vp0+2*sl_prev; \
    VRD(0); SBAR(); QK(cS0=__builtin_amdgcn_mfma_f32_32x32x16_bf16(kf[0],qr[0],cS0,0,0,0)); \
    CINIT1(cS1,t); VRD(1); SBAR(); QK(cS1=__builtin_amdgcn_mfma_f32_32x32x16_bf16(kf[1],qr[0],cS1,0,0,0)); \
    VRD(2); SBAR(); QK(cS0=__builtin_amdgcn_mfma_f32_32x32x16_bf16(kf[2],qr[1],cS0,0,0,0)); \
    VRD(3); SBAR(); QK(cS1=__builtin_amdgcn_mfma_f32_32x32x16_bf16(kf[3],qr[1],cS1,0,0,0)); \
    QK(cS0=__builtin_amdgcn_mfma_f32_32x32x16_bf16(kf[4],qr[2],cS0,0,0,0)); \
    QK(cS1=__builtin_amdgcn_mfma_f32_32x32x16_bf16(kf[5],qr[2],cS1,0,0,0)); \
    QK(cS0=__builtin_amdgcn_mfma_f32_32x32x16_bf16(kf[6],qr[3],cS0,0,0,0)); \
    QK(cS1=__builtin_amdgcn_mfma_f32_32x32x16_bf16(kf[7],qr[3],cS1,0,0,0)); \
    if(GK){DMA_K((t)+3,sl_cur);} if(GV){DMA_V((t)+1,sl_next);} \
    CMASK(cS0,cS1,t); \
    { float a=MX3(cS0[0],cS0[1],cS1[0]),b=MX3(cS0[2],cS0[3],cS1[1]); a=MX3(a,cS1[2],cS1[3]); \
      _Pragma("unroll") for(int r=4;r<16;r+=4){a=MX3(a,cS0[r],cS0[r+1]);b=MX3(b,cS0[r+2],cS0[r+3]);a=MX3(a,cS1[r],cS1[r+1]);b=MX3(b,cS1[r+2],cS1[r+3]);} \
      float rm=__builtin_fmaxf(a,b); { auto rr=__builtin_amdgcn_permlane32_swap(__float_as_uint(rm),__float_as_uint(rm),false,false); rm=__builtin_fmaxf(__uint_as_float(rr[0]),__uint_as_float(rr[1])); } \
      resc=false; \
      if(__builtin_expect(__any(rm>(float)THRL),0)){ const float dl=__builtin_fmaxf(rm,0.f); mhat+=dl; \
        _Pragma("unroll") for(int r=0;r<16;++r){cS0[r]-=dl;cS1[r]-=dl;} \
        const float f=__builtin_amdgcn_exp2f(-dl); l_reg*=f; if(hi==0)wsf[r32]=f; resc=true; } } \
    SBAR(); float sacc=0.f; \
    GAPB3(o[0]=__builtin_amdgcn_mfma_f32_32x32x16_bf16(PAFC(PC,0),VFR(0),o[0],0,0,0), cS0,0, CAT(PN,0),0); VNX(0); \
    GAPB3(o[1]=__builtin_amdgcn_mfma_f32_32x32x16_bf16(PAFC(PC,0),VFR(1),o[1],0,0,0), cS0,2, CAT(PN,0),1); VNX(1); \
    KRD(GL,0); GAPB3(o[0]=__builtin_amdgcn_mfma_f32_32x32x16_bf16(PAFC(PC,1),VFR(2),o[0],0,0,0), cS0,4, CAT(PN,0),2); VNX(2); \
    KRD(GL,1); GAPB3(o[1]=__builtin_amdgcn_mfma_f32_32x32x16_bf16(PAFC(PC,1),VFR(3),o[1],0,0,0), cS0,6, CAT(PN,0),3); VNX(3); \
    KRD(GL,2); GAPB3(o[0]=__builtin_amdgcn_mfma_f32_32x32x16_bf16(PAFC(PC,2),VFR(4),o[0],0,0,0), cS0,8, CAT(PN,1),0); VNX(4); \
    KRD(GL,3); GAPB3(o[1]=__builtin_amdgcn_mfma_f32_32x32x16_bf16(PAFC(PC,2),VFR(5),o[1],0,0,0), cS0,10, CAT(PN,1),1); VNX(5); \
    GAPB3(o[0]=__builtin_amdgcn_mfma_f32_32x32x16_bf16(PAFC(PC,3),VFR(6),o[0],0,0,0), cS0,12, CAT(PN,1),2); VNX(6); \
    GAPB3(o[1]=__builtin_amdgcn_mfma_f32_32x32x16_bf16(PAFC(PC,3),VFR(7),o[1],0,0,0), cS0,14, CAT(PN,1),3); VNX(7); \
    GAPB3(o[2]=__builtin_amdgcn_mfma_f32_32x32x16_bf16(PAFC(PC,0),VFR(8),o[2],0,0,0), cS1,0, CAT(PN,2),0); VNX(8); \
    GAPB3(o[3]=__builtin_amdgcn_mfma_f32_32x32x16_bf16(PAFC(PC,0),VFR(9),o[3],0,0,0), cS1,2, CAT(PN,2),1); VNX(9); \
    GAPB3(o[2]=__builtin_amdgcn_mfma_f32_32x32x16_bf16(PAFC(PC,1),VFR(10),o[2],0,0,0), cS1,4, CAT(PN,2),2); VNX(10); \
    GAPB3(o[3]=__builtin_amdgcn_mfma_f32_32x32x16_bf16(PAFC(PC,1),VFR(11),o[3],0,0,0), cS1,6, CAT(PN,2),3); VNX(11); \
    GAPB3(o[2]=__builtin_amdgcn_mfma_f32_32x32x16_bf16(PAFC(PC,2),VFR(12),o[2],0,0,0), cS1,8, CAT(PN,3),0); VNX(12); \
    GAPB3(o[3]=__builtin_amdgcn_mfma_f32_32x32x16_bf16(PAFC(PC,2),VFR(13),o[3],0,0,0), cS1,10, CAT(PN,3),1); VNX(13); \
    GAPB3(o[2]=__builtin_amdgcn_mfma_f32_32x32x16_bf16(PAFC(PC,3),VFR(14),o[2],0,0,0), cS1,12, CAT(PN,3),2); VNX(14); \
    GAPB3(o[3]=__builtin_amdgcn_mfma_f32_32x32x16_bf16(PAFC(PC,3),VFR(15),o[3],0,0,0), cS1,14, CAT(PN,3),3); VNX(15); \
    l_reg+=sacc; \
    }while(0)
  int t=1;
  #undef CMASK
  #define CMASK(P0,P1,t) do{}while(0)
  for(;t+5<NT;t+=2){
    STEP(pwa,pwb,t,true,true,true);     WAIT_BAR(3); RESC(); ROT();
    STEP(pwb,pwa,t+1,true,true,true);   WAIT_BAR(3); RESC(); ROT();
  }
  #undef CMASK
  #define CMASK(P0,P1,t) do{int jb_=(t)-(NT-4); if(jb_>=0)bmask(P0,P1,jb_,wch,il,hi,s2x2);}while(0)
  #define ENDW(tt) do{ if((tt)+3<NT){WAIT_BAR(3);} else if((tt)+2<NT){WAIT_BAR(2);} else {WAIT_BAR(0);} }while(0)
  for(;t+1<NT;t+=2){
    STEP(pwa,pwb,t,(t+3<NT),(t+1<NT),(t+1<NT));       ENDW(t);   RESC(); ROT();
    STEP(pwb,pwa,t+1,(t+4<NT),(t+2<NT),(t+2<NT));     ENDW(t+1); RESC(); ROT();
  }
  STEP(pwa,pwb,NT-1,false,false,false); RESC();
  SBAR(); pv(o,vb0+2*sl_cur,PAFC(pwb,0),PAFC(pwb,1),PAFC(pwb,2),PAFC(pwb,3));
  #undef PKW
  #undef PAFC
  #undef CAT
  #undef CAT_
  #undef QK
  #undef GAPB3
  #undef VFR
  #undef PIN_
  #undef MX3
  #undef EX
  #undef VRD
  #undef VNX
  #undef VOFF
  #undef GAPB2
  #undef KRD
  #undef STEP
  #undef ENDW
  {auto rr=__builtin_amdgcn_permlane32_swap(__float_as_uint(l_reg),__float_as_uint(l_reg),false,false);l_reg=__uint_as_float(rr[0])+__uint_as_float(rr[1]);}
  {
    const int le=lane_now(), r32e=le&31, hie=le>>5;
    float*wsfe=(float*)(shm+LDS_WS)+wid*64;
    if(hie==0)wsfe[32+r32e]=l_reg;asm volatile("s_waitcnt lgkmcnt(0)":::"memory");
    float rli[16];
    #pragma unroll
    for(int r=0;r<16;++r)rli[r]=__builtin_amdgcn_rcpf(wsfe[32+crow(r,hie)]);
    bf16_t*Ow=Ob+(long)(q0+wid*QBLK)*POUT;
    bf16_t*stg=(bf16_t*)(shm+LDS_OST)+wid*4096;
    #pragma unroll
    for(int r=0;r<16;++r){const int orow=crow(r,hie);
      #pragma unroll
      for(int d0=0;d0<4;++d0)stg[orow*128+d0*32+r32e]=(bf16_t)f2bf(o[d0][r]*rli[r]);}
    asm volatile("s_waitcnt lgkmcnt(0)":::"memory");
    #pragma unroll
    for(int i=0;i<8;++i){const int row=i*4+(le>>4),ch=le&15; const u32x4 v=*(const u32x4*)(stg+row*128+ch*8); ATTN_STORE16(Ow+(long)row*POUT+ch*8,v);} }
  asm volatile("s_waitcnt lgkmcnt(0)\n\ts_barrier":::"memory");
  #undef DMA_K
  #undef DMA_V
  #undef CMASK
  #undef CINIT0
  #undef CINIT1
  #undef START
  #undef RESC
  #undef ROT
}
#undef SBAR
#undef WAIT_BAR
}

__device__ __forceinline__ void attn_phase(const Frame& F, const Args& a) {
    const bf16_t* proj = (const bf16_t*)(a.ws + WS_PROJ); bf16_t* OA = (bf16_t*)(a.ws + WS_OA);
    const int vcu = (F.G % 8 == 0) ? (F.bid % 8) * (F.G / 8) + F.bid / 8 : F.bid;
    for (int i = 0;; ++i) {
        int bhm, qb;
        if (F.G == 256) { if (i >= 2) break; const int s_ = vcu & 7; bhm = vcu >> 3; qb = (i == 0) ? 15 - s_ : s_; }
        else { const int u = i * F.G + F.bid; if (u >= 512) break; bhm = u >> 4; qb = 15 - (u & 15); }
        const int b = bhm >> 3, h = (bhm >> 1) & 3, map = bhm & 1;
        const bf16_t* base = proj + (size_t)b * SEQ * INC;
        const float slope2 = exp2f(-2.0f * (h + 1)) * 1.4426950408889634f;
        attn_body::attn_unit<8>(qb, base + C_QDA + h * 128 + map * 64, base + C_KDA + h * 128 + map * 64, base + C_VDA + h * 128,
                                OA + (size_t)b * SEQ * 1024 + h * 256 + map * 128, slope2, (char*)F.lds);
    }
}
__device__ __forceinline__ void attn_combine(const Frame& F, const Args& a) {
    const bf16_t* OA = (const bf16_t*)(a.ws + WS_OA); bf16_t* Y = (bf16_t*)(a.ws + WS_YDA);
    const float lam = ((const float*)(a.ws + WS_SMALL))[0];
    const float g0 = a.in[I_SUBG][2 * F.lane] * 0.8f, g1 = a.in[I_SUBG][2 * F.lane + 1] * 0.8f;
    const int gw = F.bid * NWAVES + F.wave, NGW = F.G * NWAVES;
    for (int r = gw; r < T; r += NGW) {
        const unsigned* orow = (const unsigned*)(OA + (size_t)r * 1024); unsigned* yrow = (unsigned*)(Y + (size_t)r * 512);
        unsigned w0[4], w1[4];
#pragma unroll
        for (int h = 0; h < 4; ++h) { w0[h] = orow[h * 128 + F.lane]; w1[h] = orow[h * 128 + 64 + F.lane]; }
#pragma unroll
        for (int h = 0; h < 4; ++h) {
            const float x0 = bf2f(w0[h] & 0xffffu) - lam * bf2f(w1[h] & 0xffffu), x1 = bf2f(w0[h] >> 16) - lam * bf2f(w1[h] >> 16);
            const float rs = rsqrtf(wave_sum(x0 * x0 + x1 * x1) * (1.0f / 128.0f) + EPS);
            yrow[h * 64 + F.lane] = pk2(x0 * rs * g0, x1 * rs * g1);
        }
    }
}
namespace hg {
constexpr int QP = 136;
constexpr int L_QD = 0, L_KD = 64 * QP * 2, L_V = 2 * 64 * QP * 2, L_KE = 3 * 64 * QP * 2, L_SSQ = 4 * 64 * QP * 2, L_G = L_SSQ + 512, L_ST = L_G + 64 * QP * 2;
__device__ __forceinline__ f32x4 mfma16(bf16x8 a, bf16x8 b, f32x4 c) { return __builtin_amdgcn_mfma_f32_16x16x32_bf16(a, b, c, 0, 0, 0); }
#define HG_BAR() do { asm volatile("s_waitcnt lgkmcnt(0)" ::: "memory"); __builtin_amdgcn_s_barrier(); asm volatile("" ::: "memory"); } while (0)
typedef short v4i16_t __attribute__((ext_vector_type(4)));
__device__ __forceinline__ bf16x8 tr8(const LAS unsigned char* img, int ra, int rb, int col0, int lane) {
    const int q = (lane & 15) >> 2, p = lane & 3;
    const v4i16_t lo = __builtin_amdgcn_ds_read_tr16_b64_v4i16((LAS v4i16_t*)(img + ((ra + q) * QP + col0 + 4 * p) * 2));
    const v4i16_t hi = __builtin_amdgcn_ds_read_tr16_b64_v4i16((LAS v4i16_t*)(img + ((rb + q) * QP + col0 + 4 * p) * 2));
    return (bf16x8){lo[0], lo[1], lo[2], lo[3], hi[0], hi[1], hi[2], hi[3]};
}
struct Tile { u32x4 p[2]; };
__device__ __forceinline__ void tile_load(Tile& t, const bf16_t* src, size_t pitch, int tid) {
#pragma unroll
    for (int i = 0; i < 2; ++i) { const int pc = tid + NTHR * i; t.p[i] = *(const u32x4*)(src + (size_t)(pc >> 4) * pitch + (pc & 15) * 8); }
}
__device__ __forceinline__ void tile_put(const Tile& t, LAS unsigned char* img, int tid) {
#pragma unroll
    for (int i = 0; i < 2; ++i) { const int pc = tid + NTHR * i; *(LAS u32x4*)(img + ((pc >> 4) * QP + (pc & 15) * 8) * 2) = t.p[i]; }
}
constexpr int PP = 72;
constexpr int G4_L_P = 4 * 64 * QP * 2, G4_L_DEC = G4_L_P + 64 * PP * 2, G4_L_SSQ = G4_L_DEC + 512;
struct InA { Tile qd, kd, ke, v; f32x4 dec; };
__device__ __forceinline__ void loadA(InA& r, const Frame& F, const Args& a, int bh, int n) {
    const int b = bh >> 2, h = bh & 3; const size_t t0 = (size_t)b * SEQ + n * 64;
    const bf16_t* base = (const bf16_t*)(a.ws + WS_PROJ) + t0 * INC;
    tile_load(r.qd, base + C_HGT + 256 * h, INC, F.tid); tile_load(r.kd, base + C_HGT + 256 * h + 128, INC, F.tid);
    tile_load(r.ke, (const bf16_t*)a.out + t0 * 512 + h * 128, 512, F.tid); tile_load(r.v, base + C_IHG + h * 128, INC, F.tid);
    r.dec = *(const f32x4*)((const float*)(a.ws + WS_DEC) + ((size_t)bh * 64 + n) * 128 + 4 * (F.tid & 31));
}
__device__ __forceinline__ void grp_local(const Frame& F, const Args& a, int grp) {
    const int bh = grp >> 4, n0 = 4 * (grp & 15), b = bh >> 2, h = bh & 3, w = F.wave, lane = F.lane, fr = lane & 15, fq = lane >> 4;
    for (int i = F.tid; i < 64 * PP / 2; i += NTHR) ((LAS unsigned*)(F.lds + G4_L_P))[i] = 0u;
    f32x4 S[8];
#pragma unroll
    for (int kt = 0; kt < 8; ++kt) S[kt] = (f32x4){0.f, 0.f, 0.f, 0.f};
    InA cur, nxt; loadA(cur, F, a, bh, n0);
    unsigned short yk[4][4];
#define G4_STORE(nn) do { bf16_t* yp_ = (bf16_t*)(a.ws + WS_YHG) + ((size_t)b * SEQ + (nn) * 64 + 4 * fq) * 512 + h * 128 + 16 * w + fr; \
        _Pragma("unroll") for (int tb = 0; tb < 4; ++tb) _Pragma("unroll") for (int r = 0; r < 4; ++r) yp_[(size_t)(16 * tb + r) * 512] = yk[tb][r]; } while (0)
    for (int j = 0; j < 4; ++j) {
        if (j > 0) G4_STORE(n0 + j - 1);
        loadA(nxt, F, a, bh, n0 + (j < 3 ? j + 1 : 3));
        tile_put(cur.qd, F.lds + L_QD, F.tid); tile_put(cur.kd, F.lds + L_KD, F.tid); tile_put(cur.ke, F.lds + L_KE, F.tid); tile_put(cur.v, F.lds + L_V, F.tid);
        if (F.tid < 32) *(LAS f32x4*)(F.lds + G4_L_DEC + 16 * F.tid) = cur.dec;
        HG_BAR();
#pragma unroll
        for (int rep = 0; rep < 2; ++rep) { const int pi = w + 8 * rep;
            if (pi < 10) { const int tb = pi >= 6 ? 3 : pi >= 3 ? 2 : pi >= 1 ? 1 : 0, jt = pi - (tb * (tb + 1)) / 2;
                f32x4 sc = (f32x4){0.f, 0.f, 0.f, 0.f};
#pragma unroll
                for (int ks = 0; ks < 4; ++ks) { const bf16x8 kf = *(const LAS bf16x8*)(F.lds + L_KD + ((16 * jt + fr) * QP + 32 * ks + 8 * fq) * 2);
                    const bf16x8 qf = *(const LAS bf16x8*)(F.lds + L_QD + ((16 * tb + fr) * QP + 32 * ks + 8 * fq) * 2); sc = mfma16(kf, qf, sc); }
                if (jt == tb) {
#pragma unroll
                    for (int r = 0; r < 4; ++r) if (4 * fq + r > fr) sc[r] = 0.f;
                }
                *(LAS u32x2*)(F.lds + G4_L_P + ((16 * tb + fr) * PP + 16 * jt + 4 * fq) * 2) = (u32x2){cvt_pk_bf16(sc[0], sc[1]), cvt_pk_bf16(sc[2], sc[3])}; } }
        HG_BAR();
        bf16x8 bv[2];
#pragma unroll
        for (int s2 = 0; s2 < 2; ++s2) bv[s2] = tr8(F.lds + L_V, 32 * s2 + 8 * fq, 32 * s2 + 8 * fq + 4, 16 * w, lane);
        bf16x8 Sb[4];
#pragma unroll
        for (int ks = 0; ks < 4; ++ks) { const u32x4 t = (u32x4){cvt_pk_bf16(S[2 * ks][0], S[2 * ks][1]), cvt_pk_bf16(S[2 * ks][2], S[2 * ks][3]), cvt_pk_bf16(S[2 * ks + 1][0], S[2 * ks + 1][1]), cvt_pk_bf16(S[2 * ks + 1][2], S[2 * ks + 1][3])};
            Sb[ks] = __builtin_bit_cast(bf16x8, t); }
#pragma unroll
        for (int tb = 0; tb < 4; ++tb) { f32x4 o = (f32x4){0.f, 0.f, 0.f, 0.f};
#pragma unroll
            for (int s2 = 0; s2 <= (tb >> 1); ++s2) { const bf16x8 pf = *(const LAS bf16x8*)(F.lds + G4_L_P + ((16 * tb + fr) * PP + 32 * s2 + 8 * fq) * 2); o = mfma16(pf, bv[s2], o); }
            if (j > 0) {
#pragma unroll
                for (int ks = 0; ks < 4; ++ks) { const LAS unsigned char* qrow = F.lds + L_QD + ((16 * tb + fr) * QP + 32 * ks + 4 * fq) * 2;
                    const u32x2 lo = *(const LAS u32x2*)qrow, hi = *(const LAS u32x2*)(qrow + 32);
                    const u32x4 aw = (u32x4){lo.x, lo.y, hi.x, hi.y}; o = mfma16(__builtin_bit_cast(bf16x8, aw), Sb[ks], o); } }
#pragma unroll
            for (int r = 0; r < 4; ++r) yk[tb][r] = (unsigned short)f2bf(o[r]); }
#pragma unroll
        for (int kt = 0; kt < 8; ++kt) { S[kt] = S[kt] * *(const LAS f32x4*)(F.lds + G4_L_DEC + (16 * kt + 4 * fq) * 4);
#pragma unroll
            for (int s2 = 0; s2 < 2; ++s2) S[kt] = mfma16(tr8(F.lds + L_KE, 32 * s2 + 8 * fq, 32 * s2 + 8 * fq + 4, 16 * kt, lane), bv[s2], S[kt]); }
        HG_BAR();
        cur = nxt;
    }
    G4_STORE(n0 + 3);
#undef G4_STORE
    f32x4* sg = (f32x4*)(a.ws + WS_DS) + ((size_t)grp * 64 + w * 8) * 64 + lane;
#pragma unroll
    for (int kt = 0; kt < 8; ++kt) sg[kt * 64] = S[kt];
}
__device__ __forceinline__ void grp_scan(const Frame& F, const Args& a) {
    f32x4* sg = (f32x4*)(a.ws + WS_DS); f32x4* si = sg + (size_t)256 * 4096; const float* dec = (const float*)(a.ws + WS_DEC);
    for (int gt = F.bid * NTHR + F.tid; gt < 16 * 4096; gt += F.G * NTHR) {
        const int bh = gt >> 12, slot = gt & 4095, kt = (slot >> 6) & 7, lane = slot & 63, k = 16 * kt + 4 * (lane >> 4);
        f32x4 cur = (f32x4){0.f, 0.f, 0.f, 0.f};
#pragma unroll 4
        for (int g = 0; g < 16; ++g) { const size_t gi = ((size_t)(bh * 16 + g)) * 4096 + slot;
            si[gi] = cur;
            const float* dp = dec + ((size_t)bh * 64 + 4 * g) * 128 + k;
            const f32x4 d = (*(const f32x4*)dp * *(const f32x4*)(dp + 128)) * (*(const f32x4*)(dp + 256) * *(const f32x4*)(dp + 384));
            cur = d * cur + sg[gi]; }
    }
}
struct InC { Tile qd, g, ol; f32x4 dec; };
__device__ __forceinline__ void loadC(InC& r, const Frame& F, const Args& a, int bh, int n) {
    const int b = bh >> 2, h = bh & 3; const size_t t0 = (size_t)b * SEQ + n * 64;
    const bf16_t* base = (const bf16_t*)(a.ws + WS_PROJ) + t0 * INC;
    tile_load(r.qd, base + C_HGT + 256 * h, INC, F.tid); tile_load(r.g, base + C_GHG + h * 128, INC, F.tid);
    tile_load(r.ol, (const bf16_t*)(a.ws + WS_YHG) + t0 * 512 + h * 128, 512, F.tid);
    r.dec = *(const f32x4*)((const float*)(a.ws + WS_DEC) + ((size_t)bh * 64 + n) * 128 + 4 * (F.tid & 31));
}
__device__ __forceinline__ void grp_final(const Frame& F, const Args& a, int grp) {
    const int bh = grp >> 4, n0 = 4 * (grp & 15), b = bh >> 2, h = bh & 3, w = F.wave, lane = F.lane, fr = lane & 15, fq = lane >> 4;
    f32x4 S[8];
    { const f32x4* si = (const f32x4*)(a.ws + WS_DS) + (size_t)256 * 4096 + ((size_t)grp * 64 + w * 8) * 64 + lane;
#pragma unroll
      for (int kt = 0; kt < 8; ++kt) S[kt] = si[kt * 64]; }
    const float ng = a.in[I_HGNG][16 * w + fr];
    LAS float* SSQ = (LAS float*)(F.lds + G4_L_SSQ);
    InC cur, nxt; loadC(cur, F, a, bh, n0);
    unsigned short yk[4][4];
#define G4_STORE(nn) do { bf16_t* yp_ = (bf16_t*)(a.ws + WS_YHG) + ((size_t)b * SEQ + (nn) * 64 + 4 * fq) * 512 + h * 128 + 16 * w + fr; \
        _Pragma("unroll") for (int tb = 0; tb < 4; ++tb) _Pragma("unroll") for (int r = 0; r < 4; ++r) yp_[(size_t)(16 * tb + r) * 512] = yk[tb][r]; } while (0)
    for (int j = 0; j < 4; ++j) {
        if (j > 0) G4_STORE(n0 + j - 1);
        loadC(nxt, F, a, bh, n0 + (j < 3 ? j + 1 : 3));
        tile_put(cur.qd, F.lds + L_QD, F.tid); tile_put(cur.g, F.lds + L_KD, F.tid); tile_put(cur.ol, F.lds + L_V, F.tid);
        if (F.tid < 32) *(LAS f32x4*)(F.lds + G4_L_DEC + 16 * F.tid) = cur.dec;
        HG_BAR();
        bf16x8 Sb[4];
#pragma unroll
        for (int ks = 0; ks < 4; ++ks) { const u32x4 t = (u32x4){cvt_pk_bf16(S[2 * ks][0], S[2 * ks][1]), cvt_pk_bf16(S[2 * ks][2], S[2 * ks][3]), cvt_pk_bf16(S[2 * ks + 1][0], S[2 * ks + 1][1]), cvt_pk_bf16(S[2 * ks + 1][2], S[2 * ks + 1][3])};
            Sb[ks] = __builtin_bit_cast(bf16x8, t); }
        f32x4 o[4];
#pragma unroll
        for (int tb = 0; tb < 4; ++tb) {
#pragma unroll
            for (int r = 0; r < 4; ++r) o[tb][r] = bf2f(*(const LAS unsigned short*)(F.lds + L_V + ((16 * tb + 4 * fq + r) * QP + 16 * w + fr) * 2));
#pragma unroll
            for (int ks = 0; ks < 4; ++ks) { const LAS unsigned char* qrow = F.lds + L_QD + ((16 * tb + fr) * QP + 32 * ks + 4 * fq) * 2;
                const u32x2 lo = *(const LAS u32x2*)qrow, hi = *(const LAS u32x2*)(qrow + 32);
                const u32x4 aw = (u32x4){lo.x, lo.y, hi.x, hi.y}; o[tb] = mfma16(__builtin_bit_cast(bf16x8, aw), Sb[ks], o[tb]); }
#pragma unroll
            for (int r = 0; r < 4; ++r) { const float v = scan16(o[tb][r] * o[tb][r]); if (fr == 15) SSQ[w * 64 + 16 * tb + 4 * fq + r] = v; } }
#pragma unroll
        for (int kt = 0; kt < 8; ++kt) S[kt] = S[kt] * *(const LAS f32x4*)(F.lds + G4_L_DEC + (16 * kt + 4 * fq) * 4);
        HG_BAR();
#pragma unroll
        for (int tb = 0; tb < 4; ++tb) { f32x4 tot = (f32x4){0.f, 0.f, 0.f, 0.f};
#pragma unroll
            for (int ww = 0; ww < 8; ++ww) tot += *(const LAS f32x4*)(SSQ + ww * 64 + 16 * tb + 4 * fq);
#pragma unroll
            for (int r = 0; r < 4; ++r) { const float rs = rsqrtf(tot[r] * (1.0f / 128.0f) + EPS); const float g = bf2f(*(const LAS unsigned short*)(F.lds + L_KD + ((16 * tb + 4 * fq + r) * QP + 16 * w + fr) * 2));
                yk[tb][r] = (unsigned short)f2bf(o[tb][r] * rs * ng * g * __builtin_amdgcn_rcpf(1.0f + __builtin_amdgcn_exp2f(-1.4426950408889634f * g))); } }
        HG_BAR();
        cur = nxt;
    }
    G4_STORE(n0 + 3);
#undef G4_STORE
}
#undef HG_BAR
}

__device__ __forceinline__ float rs4(float a0, float a1, float a2, float a3, int lane) {
    const bool hi = (lane & 32) != 0;
    const float s0 = hi ? a0 : a2, s1 = hi ? a1 : a3;
    const float k0 = (hi ? a2 : a0) + __shfl_xor(s0, 32), k1 = (hi ? a3 : a1) + __shfl_xor(s1, 32);
    const bool b4 = (lane & 16) != 0;
    const float sd = b4 ? k0 : k1;
    float k = (b4 ? k1 : k0) + __shfl_xor(sd, 16);
    k += __shfl_xor(k, 8); k += __shfl_xor(k, 4); k += __shfl_xor(k, 2); k += __shfl_xor(k, 1);
    return k;
}
__device__ __forceinline__ void phase_router(const Frame& F, const Args& a) {
    constexpr int AP = 1032;
    LAS bf16_t* AH = (LAS bf16_t*)F.lds;
    LAS bf16_t* AL = AH + 16 * AP;
    LAS float* PART = (LAS float*)(F.lds + 2 * 16 * AP * 2);
    LAS float* LG = PART + 8 * 16 * 48;
    LAS unsigned* LH = (LAS unsigned*)(LG + 16 * 48);
    LAS unsigned* LB = LH + 32;
    LAS unsigned* LR = LH + 64;
    if (F.tid < NEXP) LH[F.tid] = 0u;
    const float* mod = (const float*)(a.ws + WS_MOD);
    const bf16_t* x1 = (const bf16_t*)(a.ws + WS_X1B); bf16_t* H2 = (bf16_t*)(a.ws + WS_ACT);
    unsigned* counts = (unsigned*)(a.ws + WS_CTL) + CW_COUNTS; unsigned* tokinfo = (unsigned*)(a.ws + WS_TOKINFO); int* toklist = (int*)(a.ws + WS_TOKLIST);
    const int rows_per_blk = T / F.G, r0 = F.bid * rows_per_blk, b = r0 / SEQ;
    const int lane = F.lane, w = F.wave, fr = lane & 15, fq = lane >> 4;
    f32x4 v[2][4], vn[2][4];
#define RT_LOAD(V, rb_) do { _Pragma("unroll") for (int q = 0; q < 2; ++q) { const u32x2* xr_ = (const u32x2*)(x1 + (size_t)((rb_) + 2 * w + q) * D) + lane; \
        _Pragma("unroll") for (int j = 0; j < 4; ++j) { const u32x2 t_ = xr_[64 * j]; V[q][j] = (f32x4){bf2f(t_.x & 0xffffu), bf2f(t_.x >> 16), bf2f(t_.y & 0xffffu), bf2f(t_.y >> 16)}; } } } while (0)
    RT_LOAD(v, r0);
    bf16x8 Bh[4][3], Bl[4][3];
    {
        const float* wre = a.in[I_WRE]; const float* wrg = a.in[I_WRG];
#pragma unroll
        for (int ks = 0; ks < 4; ++ks)
#pragma unroll
            for (int ct = 0; ct < 3; ++ct) {
                unsigned hw[4], lw[4];
#pragma unroll
                for (int jp = 0; jp < 4; ++jp) { float x[2];
#pragma unroll
                    for (int z = 0; z < 2; ++z) { const int k = 128 * w + 32 * ks + 8 * fq + 2 * jp + z;
                        if (ct == 0) { const float g = wrg[k * 4 + (fr & 3)], e = wre[k * 32 + ((fr + 28) & 31)]; x[z] = fr < 4 ? g : e; }
                        else if (ct == 1) x[z] = wre[k * 32 + 12 + fr];
                        else { const float e = wre[k * 32 + 28 + (fr & 3)]; x[z] = fr < 4 ? e : 0.f; } }
                    const unsigned h0 = f2bf(x[0]), h1 = f2bf(x[1]); hw[jp] = h0 | (h1 << 16);
                    lw[jp] = pk2(x[0] - bf2f(h0), x[1] - bf2f(h1)); }
                Bh[ks][ct] = __builtin_bit_cast(bf16x8, (u32x4){hw[0], hw[1], hw[2], hw[3]}); Bl[ks][ct] = __builtin_bit_cast(bf16x8, (u32x4){lw[0], lw[1], lw[2], lw[3]});
            }
    }
    for (int g = 0; g < rows_per_blk / 16; ++g) {
        const int rg = r0 + 16 * g;
        { const int gn = g + 1 < rows_per_blk / 16 ? g + 1 : g; RT_LOAD(vn, r0 + 16 * gn); }
#pragma unroll
        for (int q = 0; q < 2; ++q) { float sq = 0.f;
#pragma unroll
            for (int j = 0; j < 4; ++j) sq += (v[q][j].x * v[q][j].x + v[q][j].y * v[q][j].y) + (v[q][j].z * v[q][j].z + v[q][j].w * v[q][j].w);
            const float rs = rsqrtf(wave_sum(sq) * (1.0f / D) + EPS); const int row = 2 * w + q;
#pragma unroll
            for (int j = 0; j < 4; ++j) { const int k = 256 * j + 4 * lane;
                const f32x4 gg = *(const f32x4*)(a.in[I_N2G] + k) * (1.0f + *(const f32x4*)(mod + b * 6144 + 4 * 1024 + k)), sh = *(const f32x4*)(mod + b * 6144 + 3 * 1024 + k);
                const f32x4 hv = v[q][j] * rs * gg + sh;
                const unsigned h0 = f2bf(hv.x), h1 = f2bf(hv.y), h2_ = f2bf(hv.z), h3 = f2bf(hv.w);
                const u32x2 hw = (u32x2){h0 | (h1 << 16), h2_ | (h3 << 16)};
                *(u32x2*)(H2 + (size_t)(rg + row) * D + k) = hw;
                *(LAS u32x2*)(AH + row * AP + k) = hw;
                *(LAS u32x2*)(AL + row * AP + k) = (u32x2){pk2(hv.x - bf2f(h0), hv.y - bf2f(h1)), pk2(hv.z - bf2f(h2_), hv.w - bf2f(h3))}; } }
        __syncthreads();
        f32x4 acc[3] = {{0.f, 0.f, 0.f, 0.f}, {0.f, 0.f, 0.f, 0.f}, {0.f, 0.f, 0.f, 0.f}};
#pragma unroll
        for (int ks = 0; ks < 4; ++ks) { const bf16x8 ah = *(const LAS bf16x8*)(AH + fr * AP + 128 * w + 32 * ks + 8 * fq), al = *(const LAS bf16x8*)(AL + fr * AP + 128 * w + 32 * ks + 8 * fq);
#pragma unroll
            for (int ct = 0; ct < 3; ++ct) { acc[ct] = __builtin_amdgcn_mfma_f32_16x16x32_bf16(ah, Bh[ks][ct], acc[ct], 0, 0, 0);
                acc[ct] = __builtin_amdgcn_mfma_f32_16x16x32_bf16(al, Bh[ks][ct], acc[ct], 0, 0, 0); acc[ct] = __builtin_amdgcn_mfma_f32_16x16x32_bf16(ah, Bl[ks][ct], acc[ct], 0, 0, 0); } }
#pragma unroll
        for (int ct = 0; ct < 3; ++ct)
#pragma unroll
            for (int r = 0; r < 4; ++r) PART[(w * 16 + 4 * fq + r) * 48 + 16 * ct + fr] = acc[ct][r];
        __syncthreads();
        for (int t = F.tid; t < 16 * 48; t += NTHR) { const int row = t / 48, o = t % 48; float sacc = 0.f;
#pragma unroll
            for (int ww = 0; ww < 8; ++ww) sacc += PART[(ww * 16 + row) * 48 + o];
            if (o < 36) LG[row * 48 + o] = sacc + (o < 4 ? a.in[I_BRG][o & 3] : a.in[I_BRE][(o + 28) & 31]); }
        __syncthreads();
        if (F.tid < 16) {
            const LAS float* lg = LG + F.tid * 48;
            float gl[4]; int gi = 0;
#pragma unroll
            for (int o = 0; o < 4; ++o) gl[o] = lg[o];
            float gm = gl[0];
#pragma unroll
            for (int o = 1; o < 4; ++o) if (gl[o] > gm) { gm = gl[o]; gi = o; }
            float gsum = 0.f;
#pragma unroll
            for (int o = 0; o < 4; ++o) gsum += expf(gl[o] - gm);
            const float gp = 1.0f / gsum;
            float el[8];
#pragma unroll
            for (int e = 0; e < 8; ++e) el[e] = lg[4 + gi * 8 + e];
            int i0 = 0; float m0 = el[0];
#pragma unroll
            for (int o = 1; o < 8; ++o) if (el[o] > m0) { m0 = el[o]; i0 = o; }
            int i1 = -1; float m1 = -INFINITY;
#pragma unroll
            for (int o = 0; o < 8; ++o) if (o != i0 && el[o] > m1) { m1 = el[o]; i1 = o; }
            const float e1 = expf(m1 - m0); const float w0 = gp / (1.0f + e1), w1 = gp * e1 / (1.0f + e1);
            const int rl = 16 * g + F.tid, ex0 = gi * 8 + i0, ex1 = gi * 8 + i1;
            const unsigned l0 = atomicAdd((unsigned*)(LH + ex0), 1u), l1 = atomicAdd((unsigned*)(LH + ex1), 1u);
            LAS unsigned* ri = LR + rl * 6;
            ri[0] = (unsigned)ex0; ri[1] = l0; ri[2] = (unsigned)ex1; ri[3] = l1; ri[4] = __float_as_uint(w0); ri[5] = __float_as_uint(w1);
        }
#pragma unroll
        for (int q = 0; q < 2; ++q)
#pragma unroll
            for (int j = 0; j < 4; ++j) v[q][j] = vn[q][j];
    }
#undef RT_LOAD
    __syncthreads();
    if (F.tid < NEXP) LB[F.tid] = atomicAdd(counts + 64 * F.tid, LH[F.tid]);
    __syncthreads();
    for (int rl = F.tid; rl < rows_per_blk; rl += NTHR) {
        const LAS unsigned* ri = LR + rl * 6; const int r = r0 + rl;
        const unsigned ex0 = ri[0], ex1 = ri[2], k0 = LB[ex0] + ri[1], k1 = LB[ex1] + ri[3];
        toklist[ex0 * T + k0] = r; toklist[ex1 * T + k1] = r;
        u32x4 t0; t0.x = ex0; t0.y = k0; t0.z = ex1; t0.w = k1;
        *(u32x4*)(tokinfo + (size_t)r * 8) = t0;
        tokinfo[(size_t)r * 8 + 4] = ri[4]; tokinfo[(size_t)r * 8 + 5] = ri[5];
    }
}
__device__ __forceinline__ void build_moe_tab(const Frame& F, const Args& a, LAS MoeTab* tab) {
    if (F.tid == 0) {
        const unsigned* counts = (const unsigned*)(a.ws + WS_CTL) + CW_COUNTS; int nt = 0;
        for (int e = 0; e < NEXP; ++e) { const int c = (int)__hip_atomic_load(counts + 64 * e, __ATOMIC_RELAXED, __HIP_MEMORY_SCOPE_AGENT); tab->cnt[e] = c; tab->tbase[e] = nt;
            const int n = (c + 255) >> 8; for (int m = 0; m < n; ++m) { tab->tile_e[nt] = e; tab->tile_m[nt] = m; ++nt; } }
        tab->tbase[NEXP] = nt; tab->nt = nt;
    }
    __syncthreads();
}
__device__ __forceinline__ void phase_final(const Frame& F, const Args& a, const LAS MoeTab* tab) {
    const float* mod = (const float*)(a.ws + WS_MOD); const unsigned* tokinfo = (const unsigned*)(a.ws + WS_TOKINFO); const bf16_t* Ys = (const bf16_t*)(a.ws + WS_YS);
    const int rows_per_blk = T / F.G, r0 = F.bid * rows_per_blk;
    for (int r = r0 + F.wave; r < r0 + rows_per_blk; r += NWAVES) {
        const int b = r / SEQ;
        const u32x4 ti = *(const u32x4*)(tokinfo + (size_t)r * 8);
        const float w0 = __uint_as_float(tokinfo[(size_t)r * 8 + 4]), w1 = __uint_as_float(tokinfo[(size_t)r * 8 + 5]);
        const size_t s0 = (size_t)tab->tbase[ti.x] * 256 + ti.y, s1 = (size_t)tab->tbase[ti.z] * 256 + ti.w;
        f32x4* xr = (f32x4*)(a.out + (size_t)r * D) + F.lane; const u32x2* xb = (const u32x2*)((const bf16_t*)(a.ws + WS_X1B) + (size_t)r * D) + F.lane;
        const u32x2* y0 = (const u32x2*)(Ys + s0 * D) + F.lane; const u32x2* y1 = (const u32x2*)(Ys + s1 * D) + F.lane;
        f32x4 v[4]; float s = 0.f;
#pragma unroll
        for (int j = 0; j < 4; ++j) { const int k = 256 * j + 4 * F.lane;
            const f32x4 gt = *(const f32x4*)(mod + b * 6144 + 5 * 1024 + k); const u32x2 a0 = y0[64 * j], a1 = y1[64 * j];
            f32x4 m; m.x = w0 * bf2f(a0.x & 0xffffu) + w1 * bf2f(a1.x & 0xffffu); m.y = w0 * bf2f(a0.x >> 16) + w1 * bf2f(a1.x >> 16);
            m.z = w0 * bf2f(a0.y & 0xffffu) + w1 * bf2f(a1.y & 0xffffu); m.w = w0 * bf2f(a0.y >> 16) + w1 * bf2f(a1.y >> 16);
            const u32x2 xq = xb[64 * j]; const f32x4 xv = (f32x4){bf2f(xq.x & 0xffffu), bf2f(xq.x >> 16), bf2f(xq.y & 0xffffu), bf2f(xq.y >> 16)};
            v[j] = xv + gt * m; s += (v[j].x * v[j].x + v[j].y * v[j].y) + (v[j].z * v[j].z + v[j].w * v[j].w); }
        const float rs = rsqrtf(wave_sum(s) * (1.0f / D) + EPS);
#pragma unroll
        for (int j = 0; j < 4; ++j) { const f32x4 g = *(const f32x4*)(a.in[I_FG] + 256 * j + 4 * F.lane); xr[64 * j] = v[j] * rs * g; }
    }
}

#define XB_TMO      128
#define XB_XCNT(j)  (256  + 64 * (j))
#define XB_XSUB(j)  (1280 + 64 * (j))
#define XB_XGEN(j)  (2304 + 64 * (j))
#define XB_TOP      3328
#define XB_TOPGEN   3392
#define XCD_BAR_WORDS 3456
#define XB_SPIN_CAP (1u << 18)
__device__ __forceinline__ unsigned xb_ld(unsigned* p)              { return __hip_atomic_load(p, __ATOMIC_RELAXED, __HIP_MEMORY_SCOPE_AGENT); }
__device__ __forceinline__ unsigned xb_add(unsigned* p, unsigned v) { return __hip_atomic_fetch_add(p, v, __ATOMIC_RELAXED, __HIP_MEMORY_SCOPE_AGENT); }
__device__ __forceinline__ unsigned xb_xcc_id() { return (unsigned)__builtin_amdgcn_s_getreg((3 << 11) | 20) & 0xFu; }
#define XB_SPIN(cond, bar) do { unsigned _sp = 0; while (cond) { __builtin_amdgcn_s_sleep(1); \
    if ((++_sp & 255u) == 0u) { if (xb_ld(&(bar)[XB_TMO])) break; if (_sp > XB_SPIN_CAP) { atomicAdd(&(bar)[XB_TMO], 1u); break; } } } } while (0)
struct XcdBarrier { unsigned* bar; unsigned x; volatile LAS unsigned* st; };
__device__ __forceinline__ XcdBarrier xcd_barrier_post(unsigned* bar, volatile LAS unsigned* st) {
    XcdBarrier b; b.bar = bar; b.x = xb_xcc_id(); b.st = st;
    if (threadIdx.x == 0) (void)xb_add(&bar[XB_XCNT(b.x)], 1u);
    return b;
}
__device__ __forceinline__ void xcd_barrier_complete(unsigned* bar, unsigned x, unsigned& nloc, unsigned& nx) {
    const unsigned G = gridDim.x * gridDim.y * gridDim.z;
    unsigned sum, cnt, mine, sp = 0u;
    for (;;) {
        sum = 0u; cnt = 0u; mine = 0u;
#pragma unroll
        for (unsigned j = 0; j < 16; ++j) { const unsigned c = xb_ld(&bar[XB_XCNT(j)]); sum += c; cnt += (c > 0u) ? 1u : 0u; mine = (j == x) ? c : mine; }
        if (sum == G) break;
        __builtin_amdgcn_s_sleep(1);
        if ((++sp & 255u) == 0u) { if (xb_ld(&bar[XB_TMO])) break; if (sp > XB_SPIN_CAP) { atomicAdd(&bar[XB_TMO], 1u); break; } }
    }
    nloc = mine > 0u ? mine : 1u; nx = cnt > 0u ? cnt : 1u;
}
__device__ __forceinline__ void xcd_barrier(const XcdBarrier& b) {
    asm volatile("s_waitcnt vmcnt(0)" ::: "memory");
    __syncthreads();
    if (threadIdx.x == 0) {
        unsigned* bar = b.bar;
        __builtin_amdgcn_s_waitcnt(0);
        unsigned nloc = b.st[0], nx = b.st[1];
        if (nloc == 0u) { xcd_barrier_complete(bar, b.x, nloc, nx); b.st[0] = nloc; b.st[1] = nx; }
        const unsigned old = xb_add(&bar[XB_XSUB(b.x)], 1u);
        const unsigned gen = old / nloc;
        if (old + 1u == (gen + 1u) * nloc) {
            __builtin_amdgcn_fence(__ATOMIC_RELEASE, "agent");
            asm volatile("s_waitcnt vmcnt(0)" ::: "memory");
            const unsigned og = xb_add(&bar[XB_TOP], 1u);
            const unsigned tg = og / nx;
            if (og + 1u == (tg + 1u) * nx) xb_add(&bar[XB_TOPGEN], 1u);
            else XB_SPIN(xb_ld(&bar[XB_TOPGEN]) == tg, bar);
            __builtin_amdgcn_fence(__ATOMIC_ACQUIRE, "agent");
            xb_add(&bar[XB_XGEN(b.x)], 1u);
            asm volatile("s_waitcnt vmcnt(0)" ::: "memory");
        } else {
            XB_SPIN(xb_ld(&bar[XB_XGEN(b.x)]) == gen, bar);
            __builtin_amdgcn_fence(__ATOMIC_ACQUIRE, "agent");
            asm volatile("s_waitcnt vmcnt(0)" ::: "memory");
        }
    }
    __syncthreads();
}

constexpr int N_PHASES = 11;
__global__ void __launch_bounds__(NTHR, 2) mk_fwd(Args a) {
    extern __shared__ __attribute__((aligned(16))) unsigned char lds_raw[];
    Frame F; F.lds = (LAS unsigned char*)lds_raw; F.tid = threadIdx.x; F.lane = F.tid & 63; F.wave = __builtin_amdgcn_readfirstlane(F.tid >> 6); F.G = gridDim.x; F.bid = blockIdx.x;
    unsigned char* ws = a.ws;
    const int lo = a.ph_lo, hi = a.ph_hi;
#if MK_N_LAUNCHES == 1
    volatile LAS unsigned* MISC = (volatile LAS unsigned*)(F.lds + 152 * 1024);
    if (F.tid < 4) MISC[F.tid] = 0u;
    __syncthreads();
    XcdBarrier xbar = xcd_barrier_post((unsigned*)(ws + WS_CTL) + CW_BAR, MISC);
#define SEAM(k) do { if (IN(k) && IN((k) + 1)) xcd_barrier(xbar); } while (0)
#else
#define SEAM(k) do { } while (0)
#endif
#define IN(k) (lo <= (k) && (k) < hi)
    LAS MoeTab* tab = (LAS MoeTab*)(F.lds + 144 * 1024);

#define RUNPH(k, ...) if (IN(k)) { F.lane = lane_now(); F.tid = F.wave * 64 + F.lane; __VA_ARGS__ }
    RUNPH(0, { phase0(F, a); }) SEAM(0);
    RUNPH(1, { phase1(F, a); __syncthreads(); dense_weight_convert(F, a); }) SEAM(1);
    RUNPH(2, {
        DenseOrder S{(const char*)(ws + WS_ACT), (const char*)(ws + WS_WIN), D, T / 256, INC / 256, F.G, F.bid};
        EpiInProj E{(bf16_t*)(ws + WS_PROJ), (bf16_t*)a.out, (float*)(ws + WS_DEC), (const float*)(ws + WS_SMALL) + 16, attn_body::C2};
        pg8::gemm_phase(F.lds, D, S, E);
        int nl; const int early = w2_early_items(F.G, nl);
        if (early && F.bid >= F.G - nl) { __syncthreads(); moe_w2_convert(F, a, 0, early, (F.bid - (F.G - nl)) * NWAVES + F.wave, nl * NWAVES); }
    }) SEAM(2);
    RUNPH(3, {
        for (int g = F.bid; g < 256; g += F.G) hg::grp_local(F, a, g);
        __syncthreads();
        attn_phase(F, a);
    }) SEAM(3);
    RUNPH(4, { hg::grp_scan(F, a); attn_combine(F, a); }) SEAM(4);
    RUNPH(5, { for (int g = F.bid; g < 256; g += F.G) hg::grp_final(F, a, g); }) SEAM(5);
    RUNPH(6, {
        UpOrder S{(const char*)(ws + WS_YDA), (const char*)(ws + WS_YHG), (const char*)(ws + WS_WUPDA), (const char*)(ws + WS_WUPHG), F.G, F.bid};
        EpiUp E{(const bf16_t*)(ws + WS_PROJ), (bf16_t*)(ws + WS_ACT)};
        pg8::gemm_phase(F.lds, 512, S, E);
    }) SEAM(6);
    RUNPH(7, {
        DenseOrder S{(const char*)(ws + WS_ACT), (const char*)(ws + WS_WOUT), D, T / 256, D / 256, F.G, F.bid};
        EpiOut E{a.in[I_X], (const float*)(ws + WS_MOD), (bf16_t*)(ws + WS_X1B)};
        pg8::gemm_phase(F.lds, D, S, E);
        moe_weight_convert(F, a);
    }) SEAM(7);
    RUNPH(8, { phase_router(F, a); __syncthreads(); }) SEAM(8);
    RUNPH(9, {
        build_moe_tab(F, a, tab);
        unsigned* done = (unsigned*)(ws + WS_CTL) + CW_TILE;
        const int vc = (F.G & 7) == 0 ? (F.bid & 7) * (F.G >> 3) + (F.bid >> 3) : F.bid;
        { Moe1Order S{tab, (const char*)(ws + WS_ACT), (const char*)(ws + WS_W13), (const int*)(ws + WS_TOKLIST), F.G, vc};
          EpiMoe1 E{(bf16_t*)(ws + WS_HS), done};
          pg8::gemm_phase(F.lds, D, S, E); }
        { Moe2Order S{tab, (const char*)(ws + WS_HS), (const char*)a.out + OUT_W2, done, (unsigned*)(ws + WS_CTL) + CW_TMO, F.G, vc};
          EpiStoreBf16 E{(bf16_t*)(ws + WS_YS), D, 0, 1.0f};
          pg8::gemm_phase(F.lds, DEXP, S, E); }
    }) SEAM(9);
    RUNPH(10, { build_moe_tab(F, a, tab); phase_final(F, a, tab); })
#undef IN
#undef SEAM
}

extern "C" void kernel_launch(void* const* d_in, const int* in_sizes, int n_in, void* d_out, int out_size, void* d_ws, size_t ws_size, hipStream_t stream) {
    static int grid = 0;
    if (grid == 0) {
        if (n_in != 25 || in_sizes[0] != T * D || out_size != T * D || ws_size < WS_END) { fprintf(stderr, "kernel_launch: unexpected shapes (n_in %d, in0 %d, out %d, ws %zu)\n", n_in, n_in > 0 ? in_sizes[0] : -1, out_size, ws_size); grid = -1; return; }
        int dev = 0, cus = 0, per_cu = 0;
        if (hipGetDevice(&dev) != hipSuccess || hipDeviceGetAttribute(&cus, hipDeviceAttributeMultiprocessorCount, dev) != hipSuccess) { grid = -1; return; }
        if (hipFuncSetAttribute((const void*)mk_fwd, hipFuncAttributeMaxDynamicSharedMemorySize, LDS_BYTES) != hipSuccess) { fprintf(stderr, "kernel_launch: hipFuncSetAttribute failed\n"); grid = -1; return; }
        if (hipOccupancyMaxActiveBlocksPerMultiprocessor(&per_cu, (const void*)mk_fwd, NTHR, LDS_BYTES) != hipSuccess || per_cu < 1) { fprintf(stderr, "kernel_launch: occupancy query says %d\n", per_cu); per_cu = 1; }
        (void)hipGetLastError();
        grid = cus;
        if (grid > 256) grid = 256;
        while (T % grid) --grid;
    }
    if (grid < 0) return;
    (void)hipMemsetAsync((char*)d_ws + WS_CTL, 0, CTL_ZERO_BYTES, stream);
    Args a{};
    for (int i = 0; i < 25; ++i) a.in[i] = (const float*)d_in[i];
    a.out = (float*)d_out; a.ws = (unsigned char*)d_ws;
#if MK_N_LAUNCHES == 1
    a.ph_lo = 0; a.ph_hi = N_PHASES;
    void* args[] = {&a};
    hipError_t e = hipLaunchCooperativeKernel((const void*)mk_fwd, dim3(grid), dim3(NTHR), args, LDS_BYTES, stream);
    if (e != hipSuccess) fprintf(stderr, "cooperative launch failed: %s (grid %d)\n", hipGetErrorString(e), grid);
#else
    for (int p = 0; p < N_PHASES; ++p) {
        a.ph_lo = p; a.ph_hi = p + 1;
        hipLaunchKernelGGL(mk_fwd, dim3(grid), dim3(NTHR), LDS_BYTES, stream, a);
    }
#endif
}
```

```cpp
#include <hip/hip_runtime.h>
#include <cstdio>
#include <cstdint>

#ifndef MK_N_LAUNCHES
#define MK_N_LAUNCHES 1
#endif

#define LAS __attribute__((address_space(3)))
typedef unsigned short bf16_t;
typedef short bf16x8 __attribute__((ext_vector_type(8)));
typedef float f32x4 __attribute__((ext_vector_type(4)));
typedef float f32x2 __attribute__((ext_vector_type(2)));
typedef unsigned u32x4 __attribute__((ext_vector_type(4)));
typedef unsigned u32x2 __attribute__((ext_vector_type(2)));

constexpr int NB = 4, SEQ = 4096, D = 1024, T = NB * SEQ;
constexpr int INC = 5632;
constexpr int C_QDA = 0, C_KDA = 512, C_VDA = 1024, C_QHG = 1536, C_FHG = 2048, C_IHG = 2560, C_GHG = 3072, C_GDA = 3584, C_GHGATE = 4608;
constexpr int C_HGT = 1536;
constexpr int NEXP = 32, DEXP = 512;
constexpr int PMAX = 40960;
constexpr float EPS = 1e-6f;
constexpr int NWAVES = 8, NTHR = 512;

constexpr size_t MiB = 1u << 20;
constexpr size_t WS_CTL = 0, CTL_ZERO_BYTES = 64 * 1024;
constexpr size_t WS_MODP = 1 * MiB;
constexpr size_t WS_MOD = 5 * MiB / 2;
constexpr size_t WS_SMALL = 11 * MiB / 4;
constexpr size_t WS_TOKINFO = 3 * MiB;
constexpr size_t WS_TOKLIST = 4 * MiB;
constexpr size_t WS_DEC = 6 * MiB;
constexpr size_t WS_DS = 24 * MiB;
constexpr size_t WS_WIN = 8 * MiB;
constexpr size_t WS_WUPDA = 20 * MiB, WS_WUPHG = 21 * MiB, WS_WOUT = 22 * MiB;
constexpr size_t WS_ACT = 24 * MiB;
constexpr size_t WS_PROJ = 56 * MiB;
constexpr size_t WS_YDA = 232 * MiB, WS_YHG = 248 * MiB;
constexpr size_t WS_OA = 264 * MiB;
constexpr size_t WS_W13 = 56 * MiB;
constexpr size_t WS_W2 = 120 * MiB;
constexpr size_t WS_HS = 152 * MiB;
constexpr size_t WS_YS = 192 * MiB;
constexpr size_t OUT_W2 = 16 * MiB;
constexpr int W2_EARLY = 32;
constexpr size_t WS_X1B = 272 * MiB;
constexpr size_t WS_END = 304 * MiB;
constexpr int CW_COUNTS = 64;
constexpr int CW_BAR = 4096;
constexpr int CW_TILE = 8192;
constexpr int CW_TMO = 32;

constexpr int LDS_BYTES = 160 * 1024;

__device__ __forceinline__ float bf2f(unsigned v) { return __uint_as_float(v << 16); }
__device__ __forceinline__ unsigned f2bf(float f) { unsigned u = __float_as_uint(f); return (u + 0x7fffu + ((u >> 16) & 1u)) >> 16; }
__device__ __forceinline__ unsigned pk2(float lo, float hi) { return f2bf(lo) | (f2bf(hi) << 16); }
__device__ __forceinline__ float sigmoidf_(float x) { return 1.0f / (1.0f + __expf(-x)); }
__device__ __forceinline__ float siluf_(float x) { return x / (1.0f + __expf(-x)); }
__device__ __forceinline__ int lane_now() { int l; asm volatile("v_mbcnt_lo_u32_b32 %0, -1, 0\n\tv_mbcnt_hi_u32_b32 %0, -1, %0" : "=v"(l)); return l; }
__device__ __forceinline__ float wave_sum(float v) {
#pragma unroll
    for (int o = 1; o < 64; o <<= 1) v += __shfl_xor(v, o);
    return v;
}

namespace pg8 {
constexpr int BM = 256, BK = 64, HALF = 128, HTB = HALF * BK * 2, STAGE_BYTES = 8 * HTB;
__host__ __device__ __forceinline__ int lds_byte(int r, int c) { const int st = (r >> 4) * 2 + (c >> 5), rr = r & 15, cc = c & 31, ob = rr * 64 + cc * 2; return st * 1024 + (ob ^ (((ob >> 9) & 1) << 5)); }
__host__ __device__ __forceinline__ void stage_rc(int b, int& R, int& C) { const int st = b / 1024, sb = b % 1024, swz = sb ^ (((sb >> 9) & 1) << 5); R = (st >> 1) * 16 + swz / 64; C = (st & 1) * 32 + (swz % 64) / 2; }
__host__ __device__ __forceinline__ int perm32(int rho) { const int n = rho >> 4, i = rho & 15; return 8 * (i >> 2) + 4 * n + (i & 3); }

struct Unit { int pm, pn; const char* A; const char* B; int aux; };
__device__ __forceinline__ unsigned cvt_pk_bf16(float lo, float hi) { unsigned r; asm volatile("v_cvt_pk_bf16_f32 %0, %1, %2" : "=v"(r) : "v"(lo), "v"(hi)); return r; }

template <class Epi, class Sched>
__device__ __forceinline__ void gemm_phase(LAS unsigned char* lds, const int K, const Sched& S, const Epi& E) {
    const int tid = threadIdx.x, wid = __builtin_amdgcn_readfirstlane(tid >> 6), lane = tid & 63, wr = wid >> 2, wc = wid & 3, fr = lane & 15, fq = lane >> 4;
    const int nt = K / BK;
    unsigned voffB[2];
#define PG8_SETLANE() do { const int _l = lane_now(), _t = wid * 64 + _l; _Pragma("unroll") for (int _i = 0; _i < 2; ++_i) { int _R, _C; stage_rc(_t * 16 + _i * 8192, _R, _C); \
        const int _Rb = Epi::PERM ? ((_R & ~31) + perm32(_R & 31)) : _R; voffB[_i] = (unsigned)(_Rb * K + _C) * 2u; } \
        aoff = lds_byte(wr * 64 + (_l & 15), (_l >> 4) * 8); boff = lds_byte(wc * 32 + (_l & 15), (_l >> 4) * 8); } while (0)
    const size_t kstep = (size_t)(BK * 2);
    const size_t hstep = (size_t)HALF * K * 2;
    const unsigned ldsw = (unsigned)wid * 1024u;
    int aoff, boff; PG8_SETLANE();
#define PG8_SA(b, h) (((b) * 2 + (h)) * HTB)
#define PG8_SB(b, h) ((4 + (b) * 2 + (h)) * HTB)
#define PG8_STAGE(bufoff, gbase, voff) do { _Pragma("unroll") for (int _i = 0; _i < 2; ++_i) \
        __builtin_amdgcn_global_load_lds((const unsigned*)((const char*)(gbase) + (voff)[_i]), (LAS unsigned*)(lds + (bufoff) + ldsw + _i * 8192), 16, 0, 0); } while (0)
#define PG8_LDA(dst, b, h) do { _Pragma("unroll") for (int m = 0; m < 4; ++m) _Pragma("unroll") for (int k = 0; k < 2; ++k) dst[m][k] = *(const LAS bf16x8*)(lds + PG8_SA(b, h) + aoff + m * 2048 + k * 1024); } while (0)
#define PG8_LDB(dst, b, h) do { _Pragma("unroll") for (int n = 0; n < 2; ++n) _Pragma("unroll") for (int k = 0; k < 2; ++k) dst[n][k] = *(const LAS bf16x8*)(lds + PG8_SB(b, h) + boff + n * 2048 + k * 1024); } while (0)
#define PG8_MMA(ai, bj, At, Bt) do { __builtin_amdgcn_s_setprio(1); _Pragma("unroll") for (int m = 0; m < 4; ++m) _Pragma("unroll") for (int n = 0; n < 2; ++n) _Pragma("unroll") for (int k = 0; k < 2; ++k) \
        acc[ai][bj][m][n] = __builtin_amdgcn_mfma_f32_16x16x32_bf16(Bt[n][k], At[m][k], acc[ai][bj][m][n], 0, 0, 0); __builtin_amdgcn_s_setprio(0); } while (0)
#define PG8_WAIT_V(n) asm volatile("s_waitcnt vmcnt(" #n ")" ::: "memory")
#define PG8_WAIT_L(n) asm volatile("s_waitcnt lgkmcnt(" #n ")" ::: "memory")
#define PG8_BAR __builtin_amdgcn_s_barrier()
#define PG8_SCHED __builtin_amdgcn_sched_barrier(0)
#define PG8_SETA(vo, u) do { const int _t = wid * 64 + lane_now(); _Pragma("unroll") for (int _i = 0; _i < 2; ++_i) { int _R, _C; stage_rc(_t * 16 + _i * 8192, _R, _C); \
        _Pragma("unroll") for (int _h = 0; _h < 2; ++_h) vo[_h][_i] = (unsigned)((size_t)S.arow(u, _h * HALF + _R) * (size_t)K + _C) * 2u; } if (Sched::GATHER) PG8_WAIT_V(0); } while (0)
    Unit cur, nxt; int ui = 0;
    if (!S.next(0, cur)) return;
    f32x4 acc[2][2][4][2];
#pragma unroll
    for (int a = 0; a < 2; ++a)
#pragma unroll
        for (int b = 0; b < 2; ++b)
#pragma unroll
            for (int m = 0; m < 4; ++m)
#pragma unroll
                for (int n = 0; n < 2; ++n) acc[a][b][m][n] = (f32x4){0.f, 0.f, 0.f, 0.f};
    bf16x8 At[4][2], B0[2][2], B1[2][2];
    unsigned voC[2][2], voN[2][2];
    S.a_ready(cur);
    PG8_SETA(voC, cur);
    const char* cA = cur.A; const char* cB = cur.B;
    PG8_STAGE(PG8_SB(0, 0), cB, voffB); PG8_STAGE(PG8_SB(0, 1), cB + hstep, voffB); PG8_STAGE(PG8_SA(0, 0), cA, voC[0]); PG8_STAGE(PG8_SA(0, 1), cA, voC[1]);
    if (wr == 1) PG8_BAR;
    PG8_WAIT_V(2); PG8_BAR;
    PG8_STAGE(PG8_SB(1, 0), cB + kstep, voffB); PG8_STAGE(PG8_SA(1, 0), cA + kstep, voC[0]); PG8_STAGE(PG8_SB(1, 1), cB + hstep + kstep, voffB);
    PG8_WAIT_V(6); PG8_BAR;
    for (;;) {
        const bool has_next = S.next(ui + 1, nxt);
        if (has_next) { PG8_SETA(voN, nxt); }
        else {
#pragma unroll
            for (int h = 0; h < 2; ++h)
#pragma unroll
                for (int i = 0; i < 2; ++i) voN[h][i] = voC[h][i];
        }
        const char* nA = has_next ? nxt.A : cA; const char* nB = has_next ? nxt.B : cB;
        for (int t = 0; t < nt; t += 2) {
            const bool last = (t == nt - 2);
            if (last && has_next) S.a_ready(nxt);
            const char* a1 = cA + (size_t)(t + 1) * kstep;
            const char* a2 = last ? nA : cA + (size_t)(t + 2) * kstep; const char* b2 = last ? nB : cB + (size_t)(t + 2) * kstep;
            const char* a3 = a2 + kstep; const char* b3 = b2 + kstep;
            unsigned vo2[2][2];
#pragma unroll
            for (int h = 0; h < 2; ++h)
#pragma unroll
                for (int i = 0; i < 2; ++i) vo2[h][i] = last ? voN[h][i] : voC[h][i];
            PG8_LDB(B0, 0, 0); PG8_LDB(B1, 0, 1); PG8_SCHED; PG8_LDA(At, 0, 0); PG8_STAGE(PG8_SA(1, 1), a1, voC[1]);
            PG8_WAIT_V(8); PG8_WAIT_L(0); PG8_BAR; PG8_MMA(0, 0, At, B0); PG8_MMA(0, 1, At, B1); PG8_BAR; PG8_SCHED;
            PG8_LDA(At, 0, 1); PG8_STAGE(PG8_SB(0, 0), b2, voffB); PG8_STAGE(PG8_SB(0, 1), b2 + hstep, voffB); PG8_STAGE(PG8_SA(0, 0), a2, vo2[0]);
            PG8_WAIT_V(8); PG8_WAIT_L(0); PG8_BAR; PG8_MMA(1, 0, At, B0); PG8_MMA(1, 1, At, B1); PG8_BAR; PG8_SCHED;
            PG8_LDB(B0, 1, 0); PG8_LDB(B1, 1, 1); PG8_SCHED; PG8_LDA(At, 1, 0); PG8_STAGE(PG8_SA(0, 1), a2, vo2[1]);
            PG8_WAIT_V(8); PG8_WAIT_L(0); PG8_BAR; PG8_MMA(0, 0, At, B0); PG8_MMA(0, 1, At, B1); PG8_BAR; PG8_SCHED;
            PG8_LDA(At, 1, 1); PG8_STAGE(PG8_SB(1, 0), b3, voffB); PG8_STAGE(PG8_SB(1, 1), b3 + hstep, voffB); PG8_STAGE(PG8_SA(1, 0), a3, vo2[0]);
            PG8_WAIT_V(8); PG8_WAIT_L(0); PG8_BAR; PG8_MMA(1, 0, At, B0); PG8_MMA(1, 1, At, B1); PG8_BAR; PG8_SCHED;
        }
        if (wr == 0) PG8_BAR;
        const bool keep = E(acc, cur, wr, wc, fr, fq);
        if (!has_next) break;
        if (!keep) {
#pragma unroll
            for (int a = 0; a < 2; ++a)
#pragma unroll
                for (int b = 0; b < 2; ++b)
#pragma unroll
                    for (int m = 0; m < 4; ++m)
#pragma unroll
                        for (int n = 0; n < 2; ++n) acc[a][b][m][n] = (f32x4){0.f, 0.f, 0.f, 0.f};
        }
        cur = nxt; cA = nA; cB = nB; ++ui;
        if (Sched::GATHER) {
#pragma unroll
            for (int h = 0; h < 2; ++h)
#pragma unroll
                for (int i = 0; i < 2; ++i) voC[h][i] = voN[h][i];
        } else { PG8_SETA(voC, cur); }
        PG8_SETLANE();
        if (wr == 1) PG8_BAR;
    }
    PG8_WAIT_V(0);
    PG8_BAR;
#undef PG8_SA
#undef PG8_SB
#undef PG8_STAGE
#undef PG8_LDA
#undef PG8_LDB
#undef PG8_MMA
#undef PG8_WAIT_V
#undef PG8_WAIT_L
#undef PG8_BAR
#undef PG8_SCHED
#undef PG8_SETA
#undef PG8_SETLANE
}
}

struct Args { const float* in[25]; float* out; unsigned char* ws; int ph_lo, ph_hi; };
enum { I_X = 0, I_C, I_WADA, I_BADA, I_N1G, I_WIN, I_LQ1, I_LK1, I_LQ2, I_LK2, I_SUBG, I_LBL, I_HGNG, I_WUPDA, I_WUPHG, I_WOUT, I_N2G, I_WRG, I_BRG, I_WRE, I_BRE, I_W1, I_W3, I_W2, I_FG };

struct DenseOrder {
    static constexpr bool GATHER = false;
    const char* A; const char* Bt; int K, nM, nN, G, c;
    __device__ __forceinline__ bool next(int i, pg8::Unit& u) const {
        const int L = i * G + c, nwg = nM * nN; if (L >= nwg) return false;
        int wgid = L; { const int q = nwg / 8, r = nwg % 8, xcd = wgid % 8, off = wgid / 8; wgid = (xcd < r ? xcd * (q + 1) : r * (q + 1) + (xcd - r) * q) + off; }
        const int nig = 8 * nN, gid = wgid / nig, fm = gid * 8, gsz = (nM - fm) < 8 ? (nM - fm) : 8;
        u.pm = fm + ((wgid % nig) % gsz); u.pn = (wgid % nig) / gsz; u.A = A; u.B = Bt + (size_t)u.pn * 256 * K * 2; u.aux = 0; return true;
    }
    __device__ __forceinline__ void a_ready(const pg8::Unit&) const {}
    __device__ __forceinline__ unsigned arow(const pg8::Unit& u, int r) const { return (unsigned)(u.pm * 256 + r); }
};
struct UpOrder {
    static constexpr bool GATHER = false;
    const char* A0; const char* A1; const char* B0; const char* B1; int G, c;
    __device__ __forceinline__ bool next(int i, pg8::Unit& u) const {
        const int tile = (i >> 1) * G + c; if (tile >= 256) return false;
        u.pm = tile >> 2; u.pn = tile & 3; u.aux = i & 1;
        u.A = (i & 1) ? A1 : A0; u.B = ((i & 1) ? B1 : B0) + (size_t)u.pn * 256 * 512 * 2; return true;
    }
    __device__ __forceinline__ void a_ready(const pg8::Unit&) const {}
    __device__ __forceinline__ unsigned arow(const pg8::Unit& u, int r) const { return (unsigned)(u.pm * 256 + r); }
};
struct MoeTab { int nt; int pad[3]; int tile_e[176]; int tile_m[176]; int cnt[32]; int tbase[33]; };
struct Moe1Order {
    static constexpr bool GATHER = true;
    const LAS MoeTab* tab; const char* A; const char* W; const int* toklist; int G, c;
    __device__ __forceinline__ bool next(int i, pg8::Unit& u) const {
        const int L = i * G + c; if (L >= tab->nt * 4) return false;
        const int ti = L >> 2; u.pm = ti; u.pn = L & 3; u.aux = ti; u.A = A;
        u.B = W + ((size_t)tab->tile_e[ti] * 1024 + (size_t)u.pn * 256) * 1024 * 2; return true;
    }
    __device__ __forceinline__ void a_ready(const pg8::Unit&) const {}
    __device__ __forceinline__ unsigned arow(const pg8::Unit& u, int r) const {
        const int e = tab->tile_e[u.aux], rr = tab->tile_m[u.aux] * 256 + r;
        return rr < tab->cnt[e] ? (unsigned)toklist[e * T + rr] : 0u;
    }
};
struct Moe2Order {
    static constexpr bool GATHER = false;
    const LAS MoeTab* tab; const char* A; const char* W; unsigned* done; unsigned* tmo; int G, c;
    __device__ __forceinline__ bool next(int i, pg8::Unit& u) const {
        const int n1 = tab->nt * 4, r = n1 % G, nl = G - r; int j;
        if (r > 0 && c >= r) { if (i < 2) j = (c - r) + i * nl; else j = 2 * nl + (c - r) + (i - 2) * G; }
        else j = (r > 0 ? 2 * nl : 0) + ((c - r + G) % G) + i * G;
        if (j >= n1) return false;
        const int ti = j >> 2; u.pm = ti; u.pn = j & 3; u.aux = ti; u.A = A;
        u.B = W + ((size_t)tab->tile_e[ti] * 1024 + (size_t)u.pn * 256) * 512 * 2; return true;
    }
    __device__ __forceinline__ unsigned arow(const pg8::Unit& u, int r) const { return (unsigned)(u.pm * 256 + r); }
    __device__ __forceinline__ void a_ready(const pg8::Unit& u) const {
        if (threadIdx.x < 64) {
            unsigned polls = 0;
            while ((unsigned)__builtin_amdgcn_readfirstlane(__hip_atomic_load(done + 16 * u.pm, __ATOMIC_RELAXED, __HIP_MEMORY_SCOPE_AGENT)) < 32u) {
                if (++polls > (1u << 22)) { if (threadIdx.x == 0) __hip_atomic_store(tmo, 1u, __ATOMIC_RELAXED, __HIP_MEMORY_SCOPE_AGENT); break; }
                __builtin_amdgcn_s_sleep(2); }
            __builtin_amdgcn_fence(__ATOMIC_ACQUIRE, "agent");
            asm volatile("s_waitcnt vmcnt(0)" ::: "memory");
        }
        asm volatile("" ::: "memory"); __builtin_amdgcn_s_barrier(); asm volatile("" ::: "memory");
    }
};

using pg8::Unit; using pg8::cvt_pk_bf16;
struct EpiStoreBf16 {
    static constexpr bool PERM = true;
    bf16_t* O; int ldc; int nscale; float scale0;
    __device__ __forceinline__ bool operator()(f32x4 (&acc)[2][2][4][2], const Unit& u, int wr, int wc, int fr, int fq) const {
        const int row0 = u.pm * 256 + wr * 64 + fr, col0 = u.pn * 256 + wc * 32 + 8 * fq;
        const float sc = u.pn < nscale ? scale0 : 1.0f;
#pragma unroll
        for (int ai = 0; ai < 2; ++ai)
#pragma unroll
            for (int m = 0; m < 4; ++m) { bf16_t* rowp = O + (size_t)(row0 + ai * 128 + m * 16) * ldc + col0;
#pragma unroll
                for (int bj = 0; bj < 2; ++bj) { const f32x4 v0 = acc[ai][bj][m][0] * sc, v1 = acc[ai][bj][m][1] * sc;
                    u32x4 w; w.x = cvt_pk_bf16(v0[0], v0[1]); w.y = cvt_pk_bf16(v0[2], v0[3]); w.z = cvt_pk_bf16(v1[0], v1[1]); w.w = cvt_pk_bf16(v1[2], v1[3]);
                    *(u32x4*)(rowp + bj * 128) = w; } }
        return false;
    }
};
template <int N> __device__ __forceinline__ float dpp_shr(float x) { return __builtin_bit_cast(float, __builtin_amdgcn_update_dpp(0, __builtin_bit_cast(int, x), 0x110 + N, 0xf, 0xf, true)); }
template <int N> __device__ __forceinline__ float dpp_ror(float x) { return __builtin_bit_cast(float, __builtin_amdgcn_update_dpp(0, __builtin_bit_cast(int, x), 0x120 + N, 0xf, 0xf, true)); }
__device__ __forceinline__ float rowsum16(float x) { x += dpp_ror<8>(x); x += dpp_ror<4>(x); x += dpp_ror<2>(x); x += dpp_ror<1>(x); return x; }
__device__ __forceinline__ float scan16(float x) { x += dpp_shr<1>(x); x += dpp_shr<2>(x); x += dpp_shr<4>(x); x += dpp_shr<8>(x); return x; }
struct EpiInProj {
    static constexpr bool PERM = true;
    bf16_t* O; bf16_t* KE; float* DEC; const float* lbv; float scale0;
    __device__ __forceinline__ bool operator()(f32x4 (&acc)[2][2][4][2], const Unit& u, int wr, int wc, int fr, int fq) const {
        { const int l_ = lane_now(); fr = l_ & 15; fq = l_ >> 4; }
        const int row0 = u.pm * 256 + wr * 64 + fr, col0 = u.pn * 256 + wc * 32 + 8 * fq;
        if (u.pn >= 6 && u.pn < 10) {
            const int h = u.pn - 6, lane = 16 * fq + fr, kb = wc * 32 + 8 * fq;
            const int bb = (u.pm * 256) / SEQ, ch0 = ((u.pm * 256) % SEQ + wr * 64) >> 6;
            const f32x4 lb0 = *(const f32x4*)(lbv + h * 128 + kb), lb1 = *(const f32x4*)(lbv + h * 128 + kb + 4);
#pragma unroll
            for (int ai = 0; ai < 2; ++ai) {
                unsigned kep[4][4];
#pragma unroll
                for (int n = 0; n < 2; ++n) {
#pragma unroll
                    for (int ep = 0; ep < 2; ++ep) {
                        float ke2[2][4];
#pragma unroll
                        for (int z = 0; z < 2; ++z) {
                            const int e = 2 * ep + z; const float lb = n ? lb1[e] : lb0[e];
                            float f[4], c[4], tot[4];
#pragma unroll
                            for (int m = 0; m < 4; ++m) { const float fl = acc[ai][1][m][n][e]; f[m] = lb + (1.0f - lb) * __builtin_amdgcn_rcpf(1.0f + __builtin_amdgcn_exp2f(-1.4426950408889634f * fl)); const float lf = __logf(f[m]); c[m] = scan16(lf); tot[m] = rowsum16(lf); }
                            const float alast = (tot[0] + tot[1]) + (tot[2] + tot[3]); const float eal = __expf(alast);
                            float pre = 0.f;
#pragma unroll
                            for (int m = 0; m < 4; ++m) { const float A = c[m] + pre; pre += tot[m]; const float q = acc[ai][0][m][n][e]; const float kk = 1.0f - f[m];
                                acc[ai][0][m][n][e] = q * __builtin_amdgcn_rcpf(1.0f + __builtin_amdgcn_exp2f(-1.4426950408889634f * q)) * __expf(A);
                                const float kd = kk * __expf(-A); acc[ai][1][m][n][e] = kd; ke2[z][m] = kd * eal; }
                            if (fr == 0) DEC[((size_t)(bb * 4 + h) * 64 + ch0 + 2 * ai) * 128 + kb + 4 * n + e] = eal;
                        }
#pragma unroll
                        for (int m = 0; m < 4; ++m) kep[m][2 * n + ep] = cvt_pk_bf16(ke2[0][m], ke2[1][m]);
                    }
                }
#pragma unroll
                for (int m = 0; m < 4; ++m) *(u32x4*)(KE + (size_t)(row0 + ai * 128 + m * 16) * 512 + h * 128 + kb) = (u32x4){kep[m][0], kep[m][1], kep[m][2], kep[m][3]};
            }
        }
        const float sc = u.pn < 2 ? scale0 : 1.0f;
#pragma unroll
        for (int ai = 0; ai < 2; ++ai)
#pragma unroll
            for (int m = 0; m < 4; ++m) { bf16_t* rowp = O + (size_t)(row0 + ai * 128 + m * 16) * INC + col0;
#pragma unroll
                for (int bj = 0; bj < 2; ++bj) { const f32x4 v0 = acc[ai][bj][m][0] * sc, v1 = acc[ai][bj][m][1] * sc;
                    u32x4 w; w.x = cvt_pk_bf16(v0[0], v0[1]); w.y = cvt_pk_bf16(v0[2], v0[3]); w.z = cvt_pk_bf16(v1[0], v1[1]); w.w = cvt_pk_bf16(v1[2], v1[3]);
                    *(u32x4*)(rowp + bj * 128) = w; } }
        return false;
    }
};
struct EpiUp {
    static constexpr bool PERM = true;
    const bf16_t* proj; bf16_t* O;
    __device__ __forceinline__ bool operator()(f32x4 (&acc)[2][2][4][2], const Unit& u, int wr, int wc, int fr, int fq) const {
        const int row0 = u.pm * 256 + wr * 64 + fr, col0 = u.pn * 256 + wc * 32 + 8 * fq;
#pragma unroll
        for (int ai = 0; ai < 2; ++ai)
#pragma unroll
            for (int m = 0; m < 4; ++m) { const size_t row = (size_t)(row0 + ai * 128 + m * 16);
#pragma unroll
                for (int bj = 0; bj < 2; ++bj) {
                    const int col = col0 + bj * 128;
                    const u32x4 gh = *(const u32x4*)(proj + row * INC + C_GHGATE + col);
                    float sh[8];
#pragma unroll
                    for (int j = 0; j < 4; ++j) { sh[2 * j] = 1.0f + __builtin_amdgcn_exp2f(-1.4426950408889634f * bf2f(gh[j] & 0xffffu)); sh[2 * j + 1] = 1.0f + __builtin_amdgcn_exp2f(-1.4426950408889634f * bf2f(gh[j] >> 16)); }
                    if (u.aux == 0) {
                        const u32x4 gd = *(const u32x4*)(proj + row * INC + C_GDA + col);
#pragma unroll
                        for (int j = 0; j < 4; ++j) {
                            const float d0 = 1.0f + __builtin_amdgcn_exp2f(-1.4426950408889634f * bf2f(gd[j] & 0xffffu)), d1 = 1.0f + __builtin_amdgcn_exp2f(-1.4426950408889634f * bf2f(gd[j] >> 16));
                            const float r0 = sh[2 * j] * __builtin_amdgcn_rcpf(d0), r1 = sh[2 * j + 1] * __builtin_amdgcn_rcpf(d1);
                            if (j < 2) { acc[ai][bj][m][0][2 * j] *= r0; acc[ai][bj][m][0][2 * j + 1] *= r1; }
                            else { acc[ai][bj][m][1][2 * j - 4] *= r0; acc[ai][bj][m][1][2 * j - 3] *= r1; }
                        }
                    } else {
                        const f32x4 v0 = acc[ai][bj][m][0], v1 = acc[ai][bj][m][1];
#pragma unroll
                        for (int j = 0; j < 8; ++j) sh[j] = __builtin_amdgcn_rcpf(sh[j]);
                        u32x4 w; w.x = cvt_pk_bf16(v0[0] * sh[0], v0[1] * sh[1]); w.y = cvt_pk_bf16(v0[2] * sh[2], v0[3] * sh[3]);
                        w.z = cvt_pk_bf16(v1[0] * sh[4], v1[1] * sh[5]); w.w = cvt_pk_bf16(v1[2] * sh[6], v1[3] * sh[7]);
                        *(u32x4*)(O + row * D + col) = w;
                    }
                } }
        return u.aux == 0;
    }
};
struct EpiOut {
    static constexpr bool PERM = true;
    const float* x; const float* mod; bf16_t* O;
    __device__ __forceinline__ bool operator()(f32x4 (&acc)[2][2][4][2], const Unit& u, int wr, int wc, int fr, int fq) const {
        const int row0 = u.pm * 256 + wr * 64 + fr, col0 = u.pn * 256 + wc * 32 + 8 * fq;
        const int b = (u.pm * 256) / SEQ;
        f32x4 gt[2][2];
#pragma unroll
        for (int bj = 0; bj < 2; ++bj)
#pragma unroll
            for (int n = 0; n < 2; ++n) gt[bj][n] = *(const f32x4*)(mod + b * 6144 + 2048 + col0 + bj * 128 + n * 4);
#pragma unroll
        for (int ai = 0; ai < 2; ++ai)
#pragma unroll
            for (int m = 0; m < 4; ++m) { const size_t off = (size_t)(row0 + ai * 128 + m * 16) * D + col0;
#pragma unroll
                for (int bj = 0; bj < 2; ++bj) { const f32x4 x0 = *(const f32x4*)(x + off + bj * 128), x1 = *(const f32x4*)(x + off + bj * 128 + 4);
                    const f32x4 v0 = x0 + gt[bj][0] * acc[ai][bj][m][0], v1 = x1 + gt[bj][1] * acc[ai][bj][m][1];
                    u32x4 w; w.x = cvt_pk_bf16(v0[0], v0[1]); w.y = cvt_pk_bf16(v0[2], v0[3]); w.z = cvt_pk_bf16(v1[0], v1[1]); w.w = cvt_pk_bf16(v1[2], v1[3]);
                    *(u32x4*)(O + off + bj * 128) = w; } }
        return false;
    }
};
struct EpiMoe1 {
    static constexpr bool PERM = true;
    bf16_t* O; unsigned* done;
    __device__ __forceinline__ bool operator()(f32x4 (&acc)[2][2][4][2], const Unit& u, int wr, int wc, int fr, int fq) const {
        const int row0 = u.pm * 256 + wr * 64 + fr, col0 = u.pn * 128 + wc * 32 + 8 * fq;
#pragma unroll
        for (int ai = 0; ai < 2; ++ai)
#pragma unroll
            for (int m = 0; m < 4; ++m) { bf16_t* rowp = O + (size_t)(row0 + ai * 128 + m * 16) * DEXP + col0;
                float h[8];
#pragma unroll
                for (int n = 0; n < 2; ++n)
#pragma unroll
                    for (int e = 0; e < 4; ++e) { const float x_ = acc[ai][0][m][n][e]; h[n * 4 + e] = x_ * __builtin_amdgcn_rcpf(1.0f + __builtin_amdgcn_exp2f(-1.4426950408889634f * x_)) * acc[ai][1][m][n][e]; }
                u32x4 w; w.x = cvt_pk_bf16(h[0], h[1]); w.y = cvt_pk_bf16(h[2], h[3]); w.z = cvt_pk_bf16(h[4], h[5]); w.w = cvt_pk_bf16(h[6], h[7]);
                asm volatile("global_store_dwordx4 %0, %1, off sc1\n\ts_nop 1" :: "v"(rowp), "v"(w) : "memory"); }
        asm volatile("s_waitcnt vmcnt(0)" ::: "memory");
        if ((threadIdx.x & 63) == 0) __hip_atomic_fetch_add(done + 16 * u.pm, 1u, __ATOMIC_RELAXED, __HIP_MEMORY_SCOPE_AGENT);
        return false;
    }
};

struct Frame { LAS unsigned char* lds; int tid, lane, wave, G, bid; };

__device__ __forceinline__ void transpose_item(const float* Wsrc, int ldw, bf16_t* dst, int ldd, LAS float* scr, int lane) {
#pragma unroll 8
    for (int i = 0; i < 32; ++i) { const int kk = 2 * i + (lane >> 5); scr[kk * 33 + (lane & 31)] = __builtin_nontemporal_load(Wsrc + (size_t)kk * ldw + (lane & 31)); }
    asm volatile("s_waitcnt lgkmcnt(0)" ::: "memory");
    const int c = lane & 7;
#pragma unroll
    for (int j = 0; j < 4; ++j) { const int n = (lane >> 3) + 8 * j; const LAS float* s = scr + (8 * c) * 33 + n;
        u32x4 o; o.x = pk2(s[0 * 33], s[1 * 33]); o.y = pk2(s[2 * 33], s[3 * 33]); o.z = pk2(s[4 * 33], s[5 * 33]); o.w = pk2(s[6 * 33], s[7 * 33]);
        *(u32x4*)(dst + (size_t)n * ldd + 8 * c) = o; }
    asm volatile("s_waitcnt lgkmcnt(0)" ::: "memory");
}
struct TItem { const float* src; bf16_t* dst; int ldw, ldd; };
template <class ItemFn>
__device__ __forceinline__ void transpose_stream(int it_lo, int it_hi, int gw, int NGW, LAS float* scr, int lane, ItemFn item) {
    int it = it_lo + gw; if (it >= it_hi) return;
    TItem cur = item(it);
    float v[32];
    const int l31 = lane & 31, lh = lane >> 5;
#pragma unroll
    for (int i = 0; i < 32; ++i) v[i] = __builtin_nontemporal_load(cur.src + (size_t)(2 * i + lh) * cur.ldw + l31);
    while (true) {
#pragma unroll
        for (int i = 0; i < 32; ++i) scr[(2 * i + lh) * 33 + l31] = v[i];
        const int nx = it + NGW; const bool more = nx < it_hi; TItem nxt = cur;
        if (more) { nxt = item(nx);
#pragma unroll
            for (int i = 0; i < 32; ++i) v[i] = __builtin_nontemporal_load(nxt.src + (size_t)(2 * i + lh) * nxt.ldw + l31); }
        asm volatile("s_waitcnt lgkmcnt(0)" ::: "memory");
        const int c = lane & 7;
#pragma unroll
        for (int j = 0; j < 4; ++j) { const int n = (lane >> 3) + 8 * j; const LAS float* s_ = scr + (8 * c) * 33 + n;
            u32x4 o; o.x = pk2(s_[0 * 33], s_[1 * 33]); o.y = pk2(s_[2 * 33], s_[3 * 33]); o.z = pk2(s_[4 * 33], s_[5 * 33]); o.w = pk2(s_[6 * 33], s_[7 * 33]);
            *(u32x4*)(cur.dst + (size_t)n * cur.ldd + 8 * c) = o; }
        asm volatile("s_waitcnt lgkmcnt(0)" ::: "memory");
        if (!more) break;
        cur = nxt; it = nx;
    }
}
__device__ __forceinline__ void transpose_matrix(const Frame& F, const float* W, int K, int N, bf16_t* WT) {
    LAS float* scr = (LAS float*)(F.lds + F.wave * 8448);
    const int gw = F.bid * NWAVES + F.wave, NGW = F.G * NWAVES, nblk = N / 32, items = (K / 64) * nblk;
    transpose_stream(0, items, gw, NGW, scr, F.lane, [=](int it) { const int kb = it / nblk, nb = it % nblk;
        return TItem{W + (size_t)(64 * kb) * N + 32 * nb, WT + (size_t)(32 * nb) * K + 64 * kb, N, K}; });
}

__device__ __forceinline__ void phase0(const Frame& F, const Args& a) {
    unsigned char* ws = a.ws;
    {
        float* modp = (float*)(ws + WS_MODP);
        const float* c = a.in[I_C]; const float* wada = a.in[I_WADA];
        LAS float* cs = (LAS float*)(F.lds + 72 * 1024);
        for (int i = F.tid; i < 4 * D; i += NTHR) cs[i] = siluf_(c[i]);
        __syncthreads();
        for (int wt = F.bid + 256 * F.wave; wt < 384; wt += 256 * NWAVES) {
            if (F.G != 256) break;
            const int ks = wt / 24, jw = wt % 24, j = jw * 256 + F.lane * 4;
            f32x4 s[4] = {{0, 0, 0, 0}, {0, 0, 0, 0}, {0, 0, 0, 0}, {0, 0, 0, 0}};
#pragma unroll 8
            for (int k = ks * 64; k < ks * 64 + 64; ++k) {
                const f32x4 w = *(const f32x4*)(wada + (size_t)k * 6144 + j);
#pragma unroll
                for (int b = 0; b < 4; ++b) s[b] += w * cs[b * D + k];
            }
#pragma unroll
            for (int b = 0; b < 4; ++b) *(f32x4*)(modp + ((size_t)ks * 4 + b) * 6144 + j) = s[b];
        }
        if (F.G != 256) {
            const int gw = F.bid * NWAVES + F.wave, NGW = F.G * NWAVES;
            for (int wt = gw; wt < 384; wt += NGW) {
                const int ks = wt / 24, jw = wt % 24, j = jw * 256 + F.lane * 4;
                f32x4 s[4] = {{0, 0, 0, 0}, {0, 0, 0, 0}, {0, 0, 0, 0}, {0, 0, 0, 0}};
                for (int k = ks * 64; k < ks * 64 + 64; ++k) {
                    const f32x4 w = *(const f32x4*)(wada + (size_t)k * 6144 + j);
#pragma unroll
                    for (int b = 0; b < 4; ++b) { const float cv = siluf_(c[b * D + k]); s[b] += w * cv; }
                }
#pragma unroll
                for (int b = 0; b < 4; ++b) *(f32x4*)(modp + ((size_t)ks * 4 + b) * 6144 + j) = s[b];
            }
        }
    }
    if (F.bid == 0) {
        float* sm = (float*)(ws + WS_SMALL);
        if (F.tid == 0) {
            float s1 = 0.f, s2 = 0.f;
            for (int i = 0; i < 64; ++i) { s1 += a.in[I_LQ1][i] * a.in[I_LK1][i]; s2 += a.in[I_LQ2][i] * a.in[I_LK2][i]; }
            sm[0] = expf(s1) - expf(s2) + 0.2f;
        }
        { const float l0 = a.in[I_LBL][F.tid], l1 = a.in[I_LBL][512 + F.tid]; const float mx = fmaxf(l0, l1);
          const float e0 = expf(l0 - mx), e1 = expf(l1 - mx); sm[16 + F.tid] = e0 / (e0 + e1); }
    }
}
__device__ __forceinline__ void moe_w2_convert(const Frame& F, const Args& a, int it_lo, int it_hi, int gw, int NGW) {
    LAS float* scr = (LAS float*)(F.lds + F.wave * 8448);
    bf16_t* w2t = (bf16_t*)((unsigned char*)a.out + OUT_W2); const float* w2 = a.in[I_W2];
    transpose_stream(it_lo, it_hi, gw, NGW, scr, F.lane, [=](int it) { const int e = it >> 8, kb = (it >> 5) & 7, nb = it & 31;
        return TItem{w2 + (size_t)e * 512 * 1024 + (size_t)(64 * kb) * 1024 + 32 * nb, w2t + ((size_t)e * 1024 + 32 * nb) * 512 + 64 * kb, 1024, 512}; });
}
__device__ __forceinline__ int w2_early_items(int G, int& n_light) { const int nwg = (T / 256) * (INC / 256), r = nwg % G; n_light = r ? G - r : 0; return n_light >= 64 ? W2_EARLY * 256 : 0; }
__device__ __forceinline__ void moe_weight_convert(const Frame& F, const Args& a) {
    LAS float* scr = (LAS float*)(F.lds + F.wave * 8448);
    const int gw = F.bid * NWAVES + F.wave, NGW = F.G * NWAVES;
    bf16_t* w13 = (bf16_t*)(a.ws + WS_W13);
    const float* w1 = a.in[I_W1]; const float* w3 = a.in[I_W3];
    transpose_stream(0, 2 * NEXP * 256, gw, NGW, scr, F.lane, [=](int it) {
        const int which = it / (NEXP * 256), r = it % (NEXP * 256), e = r >> 8, kb = (r >> 4) & 15, nb = r & 15, n0 = 32 * nb;
        const float* W = (which ? w3 : w1) + (size_t)e * 1024 * 512;
        const int drow = 256 * (n0 >> 7) + (which ? 128 : 0) + (n0 & 127);
        return TItem{W + (size_t)(64 * kb) * 512 + n0, w13 + ((size_t)e * 1024 + drow) * 1024 + 64 * kb, 512, 1024}; });
    int nl; const int early = w2_early_items(F.G, nl);
    moe_w2_convert(F, a, early, NEXP * 256, gw, NGW);
}

__device__ __forceinline__ void dense_weight_convert(const Frame& F, const Args& a) {
    unsigned char* ws = a.ws;
    {
        LAS float* scr = (LAS float*)(F.lds + F.wave * 8448);
        const int gw = F.bid * NWAVES + F.wave, NGW = F.G * NWAVES, nblk = INC / 32, items = (D / 64) * nblk;
        bf16_t* WT = (bf16_t*)(ws + WS_WIN);
        const float* win = a.in[I_WIN];
        transpose_stream(0, items, gw, NGW, scr, F.lane, [=](int it) { const int kb = it / nblk, n0 = 32 * (it % nblk); int dr = n0;
            if (n0 >= C_QHG && n0 < C_FHG) dr = C_HGT + 256 * ((n0 - C_QHG) >> 7) + ((n0 - C_QHG) & 127);
            else if (n0 >= C_FHG && n0 < C_IHG) dr = C_HGT + 256 * ((n0 - C_FHG) >> 7) + 128 + ((n0 - C_FHG) & 127);
            return TItem{win + (size_t)(64 * kb) * INC + n0, WT + (size_t)dr * D + 64 * kb, INC, D}; });
    }
    transpose_matrix(F, a.in[I_WUPDA], 512, D, (bf16_t*)(ws + WS_WUPDA));
    transpose_matrix(F, a.in[I_WUPHG], 512, D, (bf16_t*)(ws + WS_WUPHG));
    transpose_matrix(F, a.in[I_WOUT], D, D, (bf16_t*)(ws + WS_WOUT));
}
__device__ __forceinline__ void phase1(const Frame& F, const Args& a) {
    const float* modp = (const float*)(a.ws + WS_MODP); float* mod = (float*)(a.ws + WS_MOD);
    for (int i = F.bid * NTHR + F.tid; i < 4 * 6144; i += F.G * NTHR) {
        float s = a.in[I_BADA][i % 6144];
        for (int ks = 0; ks < 16; ++ks) s += modp[(size_t)ks * 4 * 6144 + i];
        mod[i] = s;
    }
    LAS float* Gs = (LAS float*)F.lds;
    LAS float* Ss = Gs + 1024;
    bf16_t* H = (bf16_t*)(a.ws + WS_ACT);
    const int rows_per_blk = T / F.G;
    const int r0 = F.bid * rows_per_blk, b = r0 / SEQ;
    for (int k = F.tid; k < 1024; k += NTHR) {
        float sh = a.in[I_BADA][k], sc = a.in[I_BADA][1024 + k];
        for (int ks = 0; ks < 16; ++ks) { sh += modp[((size_t)ks * 4 + b) * 6144 + k]; sc += modp[((size_t)ks * 4 + b) * 6144 + 1024 + k]; }
        Gs[k] = a.in[I_N1G][k] * (1.0f + sc); Ss[k] = sh;
    }
    __syncthreads();
    for (int r = r0 + F.wave; r < r0 + rows_per_blk; r += NWAVES) {
        const f32x4* xr = (const f32x4*)(a.in[I_X] + (size_t)r * D) + F.lane;
        f32x4 v[4]; float s = 0.f;
#pragma unroll
        for (int j = 0; j < 4; ++j) { v[j] = xr[64 * j]; s += (v[j].x * v[j].x + v[j].y * v[j].y) + (v[j].z * v[j].z + v[j].w * v[j].w); }
        const float rs = rsqrtf(wave_sum(s) * (1.0f / D) + EPS);
        unsigned long long* o8 = (unsigned long long*)(H + (size_t)r * D) + F.lane;
#pragma unroll
        for (int j = 0; j < 4; ++j) { const f32x4 g = *(const LAS f32x4*)(Gs + 256 * j + 4 * F.lane), sh = *(const LAS f32x4*)(Ss + 256 * j + 4 * F.lane);
            const f32x4 h = v[j] * rs * g + sh;
            o8[64 * j] = (unsigned long long)pk2(h.x, h.y) | ((unsigned long long)pk2(h.z, h.w) << 32); }
    }
}

namespace attn_body {
using s16x4=__attribute__((ext_vector_type(4)))short;
using f32x16=__attribute__((ext_vector_type(16)))float;
constexpr int NW=8,QBLK=32,QB=QBLK*NW,KVBLK=64,NQB=SEQ/QB;
constexpr int PIN=INC, POUT=1024;
__device__ __forceinline__ int crow(int r,int hi){return (r&3)+8*(r>>2)+4*hi;}
#define SBAR() __builtin_amdgcn_sched_barrier(0)
__device__ __forceinline__ void bmask(f32x16&p0,f32x16&p1,int jb,int wch,int il,int hi,float s2x2){
  if(jb>wch){
    #pragma unroll
    for(int r=0;r<16;++r){p0[r]=-INFINITY;p1[r]=-INFINITY;}
  } else if(jb==wch){
    float fb=(float)(4*hi-il); asm volatile("":"+v"(fb));
    #pragma unroll
    for(int r=0;r<16;++r){const float c=(float)((r&3)+8*(r>>2)); p0[r]-=s2x2*__builtin_fmaxf(fb+c,0.f); p1[r]-=s2x2*__builtin_fmaxf(fb+(c+32.f),0.f);}
  }
}
constexpr int NSLOT=3, SLOTB=8192, VSLOTB=16384;
constexpr int LDS_K=0, LDS_V=NSLOT*SLOTB, LDS_WS=LDS_V+NSLOT*VSLOTB, LDS_OST=LDS_WS+NW*64*4, ATT_LDS_BYTES=LDS_OST+NW*8192;
constexpr float C2=0.125f*1.4426950408889634f;
__device__ __forceinline__ void glds16(const void*gsrc,unsigned lds_dst){unsigned keep;
  asm volatile("s_mov_b32 %0, m0\n\ts_mov_b32 m0, %2\n\ts_nop 0\n\tglobal_load_lds_dwordx4 %1, off\n\ts_mov_b32 m0, %0":"=&s"(keep):"v"(gsrc),"s"(lds_dst):"memory");}
__device__ __forceinline__ float max3f(float a,float b,float c){float r;asm("v_max3_f32 %0, %1, %2, %3":"=v"(r):"v"(a),"v"(b),"v"(c));return r;}
__device__ __forceinline__ float max2f(float a,float b){float r;asm("v_max_f32_e32 %0, %1, %2":"=v"(r):"v"(a),"v"(b));return r;}
__device__ __forceinline__ float fadd_s(float a,float b){float r;asm("v_add_f32_e32 %0, %1, %2":"=v"(r):"v"(a),"v"(b));return r;}
__device__ __forceinline__ float fsub_s(float a,float b){float r;asm("v_sub_f32_e32 %0, %1, %2":"=v"(r):"v"(a),"v"(b));return r;}
typedef float f32x2_t __attribute__((ext_vector_type(2))); typedef __bf16 bf16x2_t __attribute__((ext_vector_type(2)));
__device__ __forceinline__ unsigned cvtpk_s(float lo,float hi){f32x2_t v={lo,hi};bf16x2_t b=__builtin_convertvector(v,bf16x2_t);return __builtin_bit_cast(unsigned,b);}
#define WAIT_BAR(N) asm volatile("s_waitcnt vmcnt(" #N ") lgkmcnt(0)\n\ts_barrier":::"memory")

__device__ __forceinline__ void qkt(f32x16&p0,f32x16&p1,const char*Kslot,const bf16x8*qr,const f32x16&c0,const f32x16&c1,int r32,int hi){
  const char*kb=Kslot+hi*1024+r32*16;
  #pragma unroll
  for(int d0=0;d0<4;++d0){
    const bf16x8 b0=*reinterpret_cast<const bf16x8*>(kb+d0*2048);
    const bf16x8 b1=*reinterpret_cast<const bf16x8*>(kb+d0*2048+512);
    if(d0==0){p0=__builtin_amdgcn_mfma_f32_32x32x16_bf16(b0,qr[0],c0,0,0,0);p1=__builtin_amdgcn_mfma_f32_32x32x16_bf16(b1,qr[0],c1,0,0,0);}
    else{p0=__builtin_amdgcn_mfma_f32_32x32x16_bf16(b0,qr[d0],p0,0,0,0);p1=__builtin_amdgcn_mfma_f32_32x32x16_bf16(b1,qr[d0],p1,0,0,0);}}
}
typedef __attribute__((address_space(3))) const char* lds_cptr;
typedef short v4i16_t __attribute__((ext_vector_type(4)));
__device__ __forceinline__ void kload8(bf16x8*kf,lds_cptr kp){
  kf[0]=*(const __attribute__((address_space(3))) bf16x8*)(kp);      kf[1]=*(const __attribute__((address_space(3))) bf16x8*)(kp+512);
  kf[2]=*(const __attribute__((address_space(3))) bf16x8*)(kp+2048); kf[3]=*(const __attribute__((address_space(3))) bf16x8*)(kp+2560);
  kf[4]=*(const __attribute__((address_space(3))) bf16x8*)(kp+4096); kf[5]=*(const __attribute__((address_space(3))) bf16x8*)(kp+4608);
  kf[6]=*(const __attribute__((address_space(3))) bf16x8*)(kp+6144); kf[7]=*(const __attribute__((address_space(3))) bf16x8*)(kp+6656);
}
__device__ __forceinline__ void kload2(bf16x8*kf,lds_cptr kp,int j){ kf[2*j]=*(const __attribute__((address_space(3))) bf16x8*)(kp+j*2048); kf[2*j+1]=*(const __attribute__((address_space(3))) bf16x8*)(kp+j*2048+512); }
__device__ __forceinline__ s16x4 vtr(lds_cptr p){ return __builtin_bit_cast(s16x4,__builtin_amdgcn_ds_read_tr16_b64_v4i16((__attribute__((address_space(3))) v4i16_t*)p)); }
__device__ __forceinline__ float rowmax(const f32x16&p0,const f32x16&p1){
  float a=max3f(p0[0],p0[1],p1[0]),b=max3f(p0[2],p0[3],p1[1]);a=max3f(a,p1[2],p1[3]);
  #pragma unroll
  for(int r=4;r<16;r+=4){a=max3f(a,p0[r],p0[r+1]);b=max3f(b,p0[r+2],p0[r+3]);a=max3f(a,p1[r],p1[r+1]);b=max3f(b,p1[r+2],p1[r+3]);}
  const float m=max2f(a,b);
  auto rr=__builtin_amdgcn_permlane32_swap(__float_as_uint(m),__float_as_uint(m),false,false);
  return max2f(__uint_as_float(rr[0]),__uint_as_float(rr[1]));
}
__device__ __forceinline__ void pv(f32x16*o,int vb,bf16x8 pa0,bf16x8 pa1,bf16x8 pa2,bf16x8 pa3){
  #pragma unroll
  for(int d0=0;d0<4;++d0){s16x4 lo[4],hi[4];
    #pragma unroll
    for(int ks=0;ks<4;++ks){
      asm volatile("ds_read_b64_tr_b16 %0,%1 offset:%c2":"=&v"(lo[ks]):"v"(vb),"i"(d0*4096+ks*1024):"memory");
      asm volatile("ds_read_b64_tr_b16 %0,%1 offset:%c2":"=&v"(hi[ks]):"v"(vb),"i"(d0*4096+ks*1024+512):"memory");}
    asm volatile("s_waitcnt lgkmcnt(0)":::"memory");SBAR();
    #define PK(k) (bf16x8){lo[k][0],lo[k][1],lo[k][2],lo[k][3],hi[k][0],hi[k][1],hi[k][2],hi[k][3]}
    o[d0]=__builtin_amdgcn_mfma_f32_32x32x16_bf16(pa0,PK(0),o[d0],0,0,0);
    o[d0]=__builtin_amdgcn_mfma_f32_32x32x16_bf16(pa1,PK(1),o[d0],0,0,0);
    o[d0]=__builtin_amdgcn_mfma_f32_32x32x16_bf16(pa2,PK(2),o[d0],0,0,0);
    o[d0]=__builtin_amdgcn_mfma_f32_32x32x16_bf16(pa3,PK(3),o[d0],0,0,0);
    #undef PK
  }
}
#define ATTN_STORE16(p,v) (*(u32x4*)(p)=(v))
template<int THRL> __device__ __forceinline__ void attn_unit(int qb,const bf16_t*Qb,const bf16_t*__restrict__ Kh,const bf16_t*__restrict__ Vh,bf16_t*Ob,float slope2,char*shm){
  const int wid=__builtin_amdgcn_readfirstlane(threadIdx.x>>6); const int lane=lane_now(),r32=lane&31,hi=lane>>5;
  const int q0=qb*QB;
  const bf16_t*Qw=Qb+(long)(q0+wid*QBLK)*PIN;
  const unsigned lds0=(unsigned)(uintptr_t)shm;
  float*wsf=(float*)(shm+LDS_WS)+wid*64;
  const bf16_t*ksrc=Kh+(long)lane*PIN+wid*8;
  const bf16_t*vsrc=Vh+(long)(16*(wid&3)+(lane>>2))*PIN+(wid>>2)*32+(lane&3)*8;
  const unsigned kdst=lds0+LDS_K+wid*1024, vdst=lds0+LDS_V+(wid>>2)*4096+(wid&3)*1024;
  #define DMA_K(t,slot) glds16(ksrc+(long)(t)*KVBLK*PIN,(unsigned)__builtin_amdgcn_readfirstlane(kdst+(slot)))
  #define DMA_V(t,slot) do{ glds16(vsrc+(long)(t)*KVBLK*PIN,(unsigned)__builtin_amdgcn_readfirstlane(vdst+2*(slot))); glds16(vsrc+(long)(t)*KVBLK*PIN+64,(unsigned)__builtin_amdgcn_readfirstlane(vdst+2*(slot)+8192)); }while(0)
  const int vb0=(int)(lds0+LDS_V)+((lane>>4)&1)*32+(lane&3)*8+(4*hi+((lane&15)>>2))*64;
  const char*Kbase=shm+LDS_K; bf16x8 kf[8];
  const lds_cptr shm3=(lds_cptr)shm; const lds_cptr kp0=shm3+LDS_K+hi*1024+r32*16; const lds_cptr vp0=shm3+LDS_V+((lane>>4)&1)*32+(lane&3)*8+(4*hi+((lane&15)>>2))*64;
  const int NT=(q0+QB)/KVBLK;
  DMA_K(0,0);DMA_V(0,0);DMA_K(1,SLOTB);
  bf16x8 qr[4];
  #pragma unroll
  for(int d0=0;d0<4;++d0)qr[d0]=*reinterpret_cast<const bf16x8*>(&Qw[(long)r32*PIN+d0*16+hi*8]);
  float mhat=0.f,l_reg=0.f;f32x16 o[4];o[0]=f32x16{};o[1]=f32x16{};o[2]=f32x16{};o[3]=f32x16{};
  const float s64=slope2*64.f, s32=slope2*32.f, s2x2=2.f*slope2, s4hi=slope2*4.f*(float)hi;
  const int wch=wid>>1, il=32*(wid&1)+r32;
  #define CMASK(P0,P1,t) do{int jb_=(t)-(NT-4); if(jb_>=0)bmask(P0,P1,jb_,wch,il,hi,s2x2);}while(0)
  #define CINIT0(C0,t) do{ const float bt_=s64*(float)((t)-NT)-mhat+s4hi; _Pragma("unroll") for(int r=0;r<16;++r){C0[r]=__builtin_fmaf(slope2,(float)((r&3)+8*(r>>2)),bt_);} }while(0)
  #define CINIT1(C1,t) do{ const float bu_=s64*(float)((t)-NT)-mhat+s4hi+s32; _Pragma("unroll") for(int r=0;r<16;++r){C1[r]=__builtin_fmaf(slope2,(float)((r&3)+8*(r>>2)),bu_);} }while(0)
  bool resc=false;
  #define START(P0,P1) do{ const float rm=rowmax(P0,P1); resc=false; \
    { const float dl=rm; mhat=fadd_s(mhat,dl); \
      _Pragma("unroll") for(int r=0;r<16;++r){P0[r]=fsub_s(P0[r],dl);P1[r]=fsub_s(P1[r],dl);} } \
    _Pragma("unroll") for(int r=0;r<16;++r)P0[r]=__builtin_amdgcn_exp2f(P0[r]); }while(0)
  #define RESC() do{ if(resc){ asm volatile("s_waitcnt lgkmcnt(0)":::"memory"); \
      _Pragma("unroll") for(int d_=0;d_<4;++d_) _Pragma("unroll") for(int r=0;r<16;++r)o[d_][r]*=wsf[crow(r,hi)]; } }while(0)
  f32x16 cS0,cS1;
  u32x4 pwa0,pwa1,pwa2,pwa3,pwb0,pwb1,pwb2,pwb3;
  int sl_prev=0,sl_cur=0,sl_next=SLOTB;
  #define ROT() do{sl_prev=sl_cur;sl_cur=sl_next;sl_next=(sl_next==(NSLOT-1)*SLOTB)?0:sl_next+SLOTB;}while(0)
  #define PKW(P,B) cvtpk_s(P[B],P[B+1])
  DMA_K(2,2*SLOTB);
  WAIT_BAR(3);
  { f32x16 c0,c1; CINIT0(c0,0); CINIT1(c1,0); qkt(cS0,cS1,Kbase,qr,c0,c1,r32,hi); }
  asm volatile("s_nop 15\n\ts_nop 7":"+v"(cS0),"+v"(cS1));CMASK(cS0,cS1,0);
  START(cS0,cS1);
  _Pragma("unroll") for(int r=0;r<16;++r)cS1[r]=__builtin_amdgcn_exp2f(cS1[r]);
  { float sacc=cS0[0]+cS0[1]; _Pragma("unroll") for(int r=2;r<16;++r)sacc+=cS0[r]; _Pragma("unroll") for(int r=0;r<16;++r)sacc+=cS1[r]; l_reg+=sacc;
    pwa0=(u32x4){PKW(cS0,0),PKW(cS0,2),PKW(cS0,4),PKW(cS0,6)};pwa1=(u32x4){PKW(cS0,8),PKW(cS0,10),PKW(cS0,12),PKW(cS0,14)};pwa2=(u32x4){PKW(cS1,0),PKW(cS1,2),PKW(cS1,4),PKW(cS1,6)};pwa3=(u32x4){PKW(cS1,8),PKW(cS1,10),PKW(cS1,12),PKW(cS1,14)}; }
  WAIT_BAR(0);
  DMA_K(3,0);DMA_V(1,SLOTB);
  ROT();
  kload8(kf,kp0+sl_cur);
  WAIT_BAR(3);
  s16x4 vlo[4],vhi[4];
  #define CAT_(a,b) a##b
  #define CAT(a,b) CAT_(a,b)
  #define PAFC(P,k) __builtin_bit_cast(bf16x8,CAT(P,k))
  #define VFR(k) (bf16x8){vlo[(k)&3][0],vlo[(k)&3][1],vlo[(k)&3][2],vlo[(k)&3][3],vhi[(k)&3][0],vhi[(k)&3][1],vhi[(k)&3][2],vhi[(k)&3][3]}
  #define VOFF(k) ((k)<8 ? (((k)&1)*4096+((k)>>1)*1024) : ((2+((k)&1))*4096+(((k)-8)>>1)*1024))
  #define PIN_(x) asm volatile("":"+v"(x))
  #define MX3(a,b,c) __builtin_fmaxf(__builtin_fmaxf((a),(b)),(c))
  #define QK(MF) do{ MF; SBAR(); }while(0)
  #define EX(v) __builtin_amdgcn_exp2f(v)
  #define VRD(k) do{ vlo[(k)&3]=vtr(vp_+VOFF(k)); vhi[(k)&3]=vtr(vp_+(VOFF(k)+512)); }while(0)
  #define VNX(k) do{ if((k)+4<16){ VRD((k)+4); } SBAR(); }while(0)
  #define GAPB3(MF,X,B,PW,J) do{ MF; X[B]=EX(X[B]); X[B+1]=EX(X[B+1]); sacc+=X[B]; sacc+=X[B+1]; PW[J]=cvtpk_s(X[B],X[B+1]); PIN_(X); PIN_(sacc); PIN_(PW); SBAR(); }while(0)
  #define KRD(G,j) do{ if(G){ kload2(kf,kp0+sl_next,j); SBAR(); } }while(0)
  #define STEP(PC,PN,t,GK,GV,GL) do{ SBAR(); \
    CINIT0(cS0,t); SBAR(); \
    const lds_cptr vp_=vp0+2*sl_prev; \
    VRD(0); SBAR(); QK(cS0=__builtin_amdgcn_mfma_f32_32x32x16_bf16(kf[0],qr[0],cS0,0,0,0)); \
    CINIT1(cS1,t); VRD(1); SBAR(); QK(cS1=__builtin_amdgcn_mfma_f32_32x32x16_bf16(kf[1],qr[0],cS1,0,0,0)); \
    VRD(2); SBAR(); QK(cS0=__builtin_amdgcn_mfma_f32_32x32x16_bf16(kf[2],qr[1],cS0,0,0,0)); \
    VRD(3); SBAR(); QK(cS1=__builtin_amdgcn_mfma_f32_32x32x16_bf16(kf[3],qr[1],cS1,0,0,0)); \
    QK(cS0=__builtin_amdgcn_mfma_f32_32x32x16_bf16(kf[4],qr[2],cS0,0,0,0)); \
    QK(cS1=__builtin_amdgcn_mfma_f32_32x32x16_bf16(kf[5],qr[2],cS1,0,0,0)); \
    QK(cS0=__builtin_amdgcn_mfma_f32_32x32x16_bf16(kf[6],qr[3],cS0,0,0,0)); \
    QK(cS1=__builtin_amdgcn_mfma_f32_32x32x16_bf16(kf[7],qr[3],cS1,0,0,0)); \
    if(GK){DMA_K((t)+3,sl_cur);} if(GV){DMA_V((t)+1,sl_next);} \
    CMASK(cS0,cS1,t); \
    { float a=MX3(cS0[0],cS0[1],cS1[0]),b=MX3(cS0[2],cS0[3],cS1[1]); a=MX3(a,cS1[2],cS1[3]); \
      _Pragma("unroll") for(int r=4;r<16;r+=4){a=MX3(a,cS0[r],cS0[r+1]);b=MX3(b,cS0[r+2],cS0[r+3]);a=MX3(a,cS1[r],cS1[r+1]);b=MX3(b,cS1[r+2],cS1[r+3]);} \
      float rm=__builtin_fmaxf(a,b); { auto rr=__builtin_amdgcn_permlane32_swap(__float_as_uint(rm),__float_as_uint(rm),false,false); rm=__builtin_fmaxf(__uint_as_float(rr[0]),__uint_as_float(rr[1])); } \
      resc=false; \
      if(__builtin_expect(__any(rm>(float)THRL),0)){ const float dl=__builtin_fmaxf(rm,0.f); mhat+=dl; \
        _Pragma("unroll") for(int r=0;r<16;++r){cS0[r]-=dl;cS1[r]-=dl;} \
        const float f=__builtin_amdgcn_exp2f(-dl); l_reg*=f; if(hi==0)wsf[r32]=f; resc=true; } } \
    SBAR(); float sacc=0.f; \
    GAPB3(o[0]=__builtin_amdgcn_mfma_f32_32x32x16_bf16(PAFC(PC,0),VFR(0),o[0],0,0,0), cS0,0, CAT(PN,0),0); VNX(0); \
    GAPB3(o[1]=__builtin_amdgcn_mfma_f32_32x32x16_bf16(PAFC(PC,0),VFR(1),o[1],0,0,0), cS0,2, CAT(PN,0),1); VNX(1); \
    KRD(GL,0); GAPB3(o[0]=__builtin_amdgcn_mfma_f32_32x32x16_bf16(PAFC(PC,1),VFR(2),o[0],0,0,0), cS0,4, CAT(PN,0),2); VNX(2); \
    KRD(GL,1); GAPB3(o[1]=__builtin_amdgcn_mfma_f32_32x32x16_bf16(PAFC(PC,1),VFR(3),o[1],0,0,0), cS0,6, CAT(PN,0),3); VNX(3); \
    KRD(GL,2); GAPB3(o[0]=__builtin_amdgcn_mfma_f32_32x32x16_bf16(PAFC(PC,2),VFR(4),o[0],0,0,0), cS0,8, CAT(PN,1),0); VNX(4); \
    KRD(GL,3); GAPB3(o[1]=__builtin_amdgcn_mfma_f32_32x32x16_bf16(PAFC(PC,2),VFR(5),o[1],0,0,0), cS0,10, CAT(PN,1),1); VNX(5); \
    GAPB3(o[0]=__builtin_amdgcn_mfma_f32_32x32x16_bf16(PAFC(PC,3),VFR(6),o[0],0,0,0), cS0,12, CAT(PN,1),2); VNX(6); \
    GAPB3(o[1]=__builtin_amdgcn_mfma_f32_32x32x16_bf16(PAFC(PC,3),VFR(7),o[1],0,0,0), cS0,14, CAT(PN,1),3); VNX(7); \
    GAPB3(o[2]=__builtin_amdgcn_mfma_f32_32x32x16_bf16(PAFC(PC,0),VFR(8),o[2],0,0,0), cS1,0, CAT(PN,2),0); VNX(8); \
    GAPB3(o[3]=__builtin_amdgcn_mfma_f32_32x32x16_bf16(PAFC(PC,0),VFR(9),o[3],0,0,0), cS1,2, CAT(PN,2),1); VNX(9); \
    GAPB3(o[2]=__builtin_amdgcn_mfma_f32_32x32x16_bf16(PAFC(PC,1),VFR(10),o[2],0,0,0), cS1,4, CAT(PN,2),2); VNX(10); \
    GAPB3(o[3]=__builtin_amdgcn_mfma_f32_32x32x16_bf16(PAFC(PC,1),VFR(11),o[3],0,0,0), cS1,6, CAT(PN,2),3); VNX(11); \
    GAPB3(o[2]=__builtin_amdgcn_mfma_f32_32x32x16_bf16(PAFC(PC,2),VFR(12),o[2],0,0,0), cS1,8, CAT(PN,3),0); VNX(12); \
    GAPB3(o[3]=__builtin_amdgcn_mfma_f32_32x32x16_bf16(PAFC(PC,2),VFR(13),o[3],0,0,0), cS1,10, CAT(PN,3),1); VNX(13); \
    GAPB3(o[2]=__builtin_amdgcn_mfma_f32_32x32x16_bf16(PAFC(PC,3),VFR(14),o[2],0,0,0), cS1,12, CAT(PN,3),2); VNX(14); \
    GAPB3(o[3]=__builtin_amdgcn_mfma_f32_32x32x16_bf16(PAFC(PC,3),VFR(15),o[3],0,0,0), cS1,14, CAT(PN,3),3); VNX(15); \
    l_reg+=sacc; \
    }while(0)
  int t=1;
  #undef CMASK
  #define CMASK(P0,P1,t) do{}while(0)
  for(;t+5<NT;t+=2){
    STEP(pwa,pwb,t,true,true,true);     WAIT_BAR(3); RESC(); ROT();
    STEP(pwb,pwa,t+1,true,true,true);   WAIT_BAR(3); RESC(); ROT();
  }
  #undef CMASK
  #define CMASK(P0,P1,t) do{int jb_=(t)-(NT-4); if(jb_>=0)bmask(P0,P1,jb_,wch,il,hi,s2x2);}while(0)
  #define ENDW(tt) do{ if((tt)+3<NT){WAIT_BAR(3);} else if((tt)+2<NT){WAIT_BAR(2);} else {WAIT_BAR(0);} }while(0)
  for(;t+1<NT;t+=2){
    STEP(pwa,pwb,t,(t+3<NT),(t+1<NT),(t+1<NT));       ENDW(t);   RESC(); ROT();
    STEP(pwb,pwa,t+1,(t+4<NT),(t+2<NT),(t+2<NT));     ENDW(t+1); RESC(); ROT();
  }
  STEP(pwa,pwb,NT-1,false,false,false); RESC();
  SBAR(); pv(o,vb0+2*sl_cur,PAFC(pwb,0),PAFC(pwb,1),PAFC(pwb,2),PAFC(pwb,3));
  #undef PKW
  #undef PAFC
  #undef CAT
  #undef CAT_
  #undef QK
  #undef GAPB3
  #undef VFR
  #undef PIN_
  #undef MX3
  #undef EX
  #undef VRD
  #undef VNX
  #undef VOFF
  #undef GAPB2
  #undef KRD
  #undef STEP
  #undef ENDW
  {auto rr=__builtin_amdgcn_permlane32_swap(__float_as_uint(l_reg),__float_as_uint(l_reg),false,false);l_reg=__uint_as_float(rr[0])+__uint_as_float(rr[1]);}
  {
    const int le=lane_now(), r32e=le&31, hie=le>>5;
    float*wsfe=(float*)(shm+LDS_WS)+wid*64;
    if(hie==0)wsfe[32+r32e]=l_reg;asm volatile("s_waitcnt lgkmcnt(0)":::"memory");
    float rli[16];
    #pragma unroll
    for(int r=0;r<16;++r)rli[r]=__builtin_amdgcn_rcpf(wsfe[32+crow(r,hie)]);
    bf16_t*Ow=Ob+(long)(q0+wid*QBLK)*POUT;
    bf16_t*stg=(bf16_t*)(shm+LDS_OST)+wid*4096;
    #pragma unroll
    for(int r=0;r<16;++r){const int orow=crow(r,hie);
      #pragma unroll
      for(int d0=0;d0<4;++d0)stg[orow*128+d0*32+r32e]=(bf16_t)f2bf(o[d0][r]*rli[r]);}
    asm volatile("s_waitcnt lgkmcnt(0)":::"memory");
    #pragma unroll
    for(int i=0;i<8;++i){const int row=i*4+(le>>4),ch=le&15; const u32x4 v=*(const u32x4*)(stg+row*128+ch*8); ATTN_STORE16(Ow+(long)row*POUT+ch*8,v);} }
  asm volatile("s_waitcnt lgkmcnt(0)\n\ts_barrier":::"memory");
  #undef DMA_K
  #undef DMA_V
  #undef CMASK
  #undef CINIT0
  #undef CINIT1
  #undef START
  #undef RESC
  #undef ROT
}
#undef SBAR
#undef WAIT_BAR
}

__device__ __forceinline__ void attn_phase(const Frame& F, const Args& a) {
    const bf16_t* proj = (const bf16_t*)(a.ws + WS_PROJ); bf16_t* OA = (bf16_t*)(a.ws + WS_OA);
    const int vcu = (F.G % 8 == 0) ? (F.bid % 8) * (F.G / 8) + F.bid / 8 : F.bid;
    for (int i = 0;; ++i) {
        int bhm, qb;
        if (F.G == 256) { if (i >= 2) break; const int s_ = vcu & 7; bhm = vcu >> 3; qb = (i == 0) ? 15 - s_ : s_; }
        else { const int u = i * F.G + F.bid; if (u >= 512) break; bhm = u >> 4; qb = 15 - (u & 15); }
        const int b = bhm >> 3, h = (bhm >> 1) & 3, map = bhm & 1;
        const bf16_t* base = proj + (size_t)b * SEQ * INC;
        const float slope2 = exp2f(-2.0f * (h + 1)) * 1.4426950408889634f;
        attn_body::attn_unit<8>(qb, base + C_QDA + h * 128 + map * 64, base + C_KDA + h * 128 + map * 64, base + C_VDA + h * 128,
                                OA + (size_t)b * SEQ * 1024 + h * 256 + map * 128, slope2, (char*)F.lds);
    }
}
__device__ __forceinline__ void attn_combine(const Frame& F, const Args& a) {
    const bf16_t* OA = (const bf16_t*)(a.ws + WS_OA); bf16_t* Y = (bf16_t*)(a.ws + WS_YDA);
    const float lam = ((const float*)(a.ws + WS_SMALL))[0];
    const float g0 = a.in[I_SUBG][2 * F.lane] * 0.8f, g1 = a.in[I_SUBG][2 * F.lane + 1] * 0.8f;
    const int gw = F.bid * NWAVES + F.wave, NGW = F.G * NWAVES;
    for (int r = gw; r < T; r += NGW) {
        const unsigned* orow = (const unsigned*)(OA + (size_t)r * 1024); unsigned* yrow = (unsigned*)(Y + (size_t)r * 512);
        unsigned w0[4], w1[4];
#pragma unroll
        for (int h = 0; h < 4; ++h) { w0[h] = orow[h * 128 + F.lane]; w1[h] = orow[h * 128 + 64 + F.lane]; }
#pragma unroll
        for (int h = 0; h < 4; ++h) {
            const float x0 = bf2f(w0[h] & 0xffffu) - lam * bf2f(w1[h] & 0xffffu), x1 = bf2f(w0[h] >> 16) - lam * bf2f(w1[h] >> 16);
            const float rs = rsqrtf(wave_sum(x0 * x0 + x1 * x1) * (1.0f / 128.0f) + EPS);
            yrow[h * 64 + F.lane] = pk2(x0 * rs * g0, x1 * rs * g1);
        }
    }
}
namespace hg {
constexpr int QP = 136;
constexpr int L_QD = 0, L_KD = 64 * QP * 2, L_V = 2 * 64 * QP * 2, L_KE = 3 * 64 * QP * 2, L_SSQ = 4 * 64 * QP * 2, L_G = L_SSQ + 512, L_ST = L_G + 64 * QP * 2;
__device__ __forceinline__ f32x4 mfma16(bf16x8 a, bf16x8 b, f32x4 c) { return __builtin_amdgcn_mfma_f32_16x16x32_bf16(a, b, c, 0, 0, 0); }
#define HG_BAR() do { asm volatile("s_waitcnt lgkmcnt(0)" ::: "memory"); __builtin_amdgcn_s_barrier(); asm volatile("" ::: "memory"); } while (0)
typedef short v4i16_t __attribute__((ext_vector_type(4)));
__device__ __forceinline__ bf16x8 tr8(const LAS unsigned char* img, int ra, int rb, int col0, int lane) {
    const int q = (lane & 15) >> 2, p = lane & 3;
    const v4i16_t lo = __builtin_amdgcn_ds_read_tr16_b64_v4i16((LAS v4i16_t*)(img + ((ra + q) * QP + col0 + 4 * p) * 2));
    const v4i16_t hi = __builtin_amdgcn_ds_read_tr16_b64_v4i16((LAS v4i16_t*)(img + ((rb + q) * QP + col0 + 4 * p) * 2));
    return (bf16x8){lo[0], lo[1], lo[2], lo[3], hi[0], hi[1], hi[2], hi[3]};
}
struct Tile { u32x4 p[2]; };
__device__ __forceinline__ void tile_load(Tile& t, const bf16_t* src, size_t pitch, int tid) {
#pragma unroll
    for (int i = 0; i < 2; ++i) { const int pc = tid + NTHR * i; t.p[i] = *(const u32x4*)(src + (size_t)(pc >> 4) * pitch + (pc & 15) * 8); }
}
__device__ __forceinline__ void tile_put(const Tile& t, LAS unsigned char* img, int tid) {
#pragma unroll
    for (int i = 0; i < 2; ++i) { const int pc = tid + NTHR * i; *(LAS u32x4*)(img + ((pc >> 4) * QP + (pc & 15) * 8) * 2) = t.p[i]; }
}
constexpr int PP = 72;
constexpr int G4_L_P = 4 * 64 * QP * 2, G4_L_DEC = G4_L_P + 64 * PP * 2, G4_L_SSQ = G4_L_DEC + 512;
struct InA { Tile qd, kd, ke, v; f32x4 dec; };
__device__ __forceinline__ void loadA(InA& r, const Frame& F, const Args& a, int bh, int n) {
    const int b = bh >> 2, h = bh & 3; const size_t t0 = (size_t)b * SEQ + n * 64;
    const bf16_t* base = (const bf16_t*)(a.ws + WS_PROJ) + t0 * INC;
    tile_load(r.qd, base + C_HGT + 256 * h, INC, F.tid); tile_load(r.kd, base + C_HGT + 256 * h + 128, INC, F.tid);
    tile_load(r.ke, (const bf16_t*)a.out + t0 * 512 + h * 128, 512, F.tid); tile_load(r.v, base + C_IHG + h * 128, INC, F.tid);
    r.dec = *(const f32x4*)((const float*)(a.ws + WS_DEC) + ((size_t)bh * 64 + n) * 128 + 4 * (F.tid & 31));
}
__device__ __forceinline__ void grp_local(const Frame& F, const Args& a, int grp) {
    const int bh = grp >> 4, n0 = 4 * (grp & 15), b = bh >> 2, h = bh & 3, w = F.wave, lane = F.lane, fr = lane & 15, fq = lane >> 4;
    for (int i = F.tid; i < 64 * PP / 2; i += NTHR) ((LAS unsigned*)(F.lds + G4_L_P))[i] = 0u;
    f32x4 S[8];
#pragma unroll
    for (int kt = 0; kt < 8; ++kt) S[kt] = (f32x4){0.f, 0.f, 0.f, 0.f};
    InA cur, nxt; loadA(cur, F, a, bh, n0);
    unsigned short yk[4][4];
#define G4_STORE(nn) do { bf16_t* yp_ = (bf16_t*)(a.ws + WS_YHG) + ((size_t)b * SEQ + (nn) * 64 + 4 * fq) * 512 + h * 128 + 16 * w + fr; \
        _Pragma("unroll") for (int tb = 0; tb < 4; ++tb) _Pragma("unroll") for (int r = 0; r < 4; ++r) yp_[(size_t)(16 * tb + r) * 512] = yk[tb][r]; } while (0)
    for (int j = 0; j < 4; ++j) {
        if (j > 0) G4_STORE(n0 + j - 1);
        loadA(nxt, F, a, bh, n0 + (j < 3 ? j + 1 : 3));
        tile_put(cur.qd, F.lds + L_QD, F.tid); tile_put(cur.kd, F.lds + L_KD, F.tid); tile_put(cur.ke, F.lds + L_KE, F.tid); tile_put(cur.v, F.lds + L_V, F.tid);
        if (F.tid < 32) *(LAS f32x4*)(F.lds + G4_L_DEC + 16 * F.tid) = cur.dec;
        HG_BAR();
#pragma unroll
        for (int rep = 0; rep < 2; ++rep) { const int pi = w + 8 * rep;
            if (pi < 10) { const int tb = pi >= 6 ? 3 : pi >= 3 ? 2 : pi >= 1 ? 1 : 0, jt = pi - (tb * (tb + 1)) / 2;
                f32x4 sc = (f32x4){0.f, 0.f, 0.f, 0.f};
#pragma unroll
                for (int ks = 0; ks < 4; ++ks) { const bf16x8 kf = *(const LAS bf16x8*)(F.lds + L_KD + ((16 * jt + fr) * QP + 32 * ks + 8 * fq) * 2);
                    const bf16x8 qf = *(const LAS bf16x8*)(F.lds + L_QD + ((16 * tb + fr) * QP + 32 * ks + 8 * fq) * 2); sc = mfma16(kf, qf, sc); }
                if (jt == tb) {
#pragma unroll
                    for (int r = 0; r < 4; ++r) if (4 * fq + r > fr) sc[r] = 0.f;
                }
                *(LAS u32x2*)(F.lds + G4_L_P + ((16 * tb + fr) * PP + 16 * jt + 4 * fq) * 2) = (u32x2){cvt_pk_bf16(sc[0], sc[1]), cvt_pk_bf16(sc[2], sc[3])}; } }
        HG_BAR();
        bf16x8 bv[2];
#pragma unroll
        for (int s2 = 0; s2 < 2; ++s2) bv[s2] = tr8(F.lds + L_V, 32 * s2 + 8 * fq, 32 * s2 + 8 * fq + 4, 16 * w, lane);
        bf16x8 Sb[4];
#pragma unroll
        for (int ks = 0; ks < 4; ++ks) { const u32x4 t = (u32x4){cvt_pk_bf16(S[2 * ks][0], S[2 * ks][1]), cvt_pk_bf16(S[2 * ks][2], S[2 * ks][3]), cvt_pk_bf16(S[2 * ks + 1][0], S[2 * ks + 1][1]), cvt_pk_bf16(S[2 * ks + 1][2], S[2 * ks + 1][3])};
            Sb[ks] = __builtin_bit_cast(bf16x8, t); }
#pragma unroll
        for (int tb = 0; tb < 4; ++tb) { f32x4 o = (f32x4){0.f, 0.f, 0.f, 0.f};
#pragma unroll
            for (int s2 = 0; s2 <= (tb >> 1); ++s2) { const bf16x8 pf = *(const LAS bf16x8*)(F.lds + G4_L_P + ((16 * tb + fr) * PP + 32 * s2 + 8 * fq) * 2); o = mfma16(pf, bv[s2], o); }
            if (j > 0) {
#pragma unroll
                for (int ks = 0; ks < 4; ++ks) { const LAS unsigned char* qrow = F.lds + L_QD + ((16 * tb + fr) * QP + 32 * ks + 4 * fq) * 2;
                    const u32x2 lo = *(const LAS u32x2*)qrow, hi = *(const LAS u32x2*)(qrow + 32);
                    const u32x4 aw = (u32x4){lo.x, lo.y, hi.x, hi.y}; o = mfma16(__builtin_bit_cast(bf16x8, aw), Sb[ks], o); } }
#pragma unroll
            for (int r = 0; r < 4; ++r) yk[tb][r] = (unsigned short)f2bf(o[r]); }
#pragma unroll
        for (int kt = 0; kt < 8; ++kt) { S[kt] = S[kt] * *(const LAS f32x4*)(F.lds + G4_L_DEC + (16 * kt + 4 * fq) * 4);
#pragma unroll
            for (int s2 = 0; s2 < 2; ++s2) S[kt] = mfma16(tr8(F.lds + L_KE, 32 * s2 + 8 * fq, 32 * s2 + 8 * fq + 4, 16 * kt, lane), bv[s2], S[kt]); }
        HG_BAR();
        cur = nxt;
    }
    G4_STORE(n0 + 3);
#undef G4_STORE
    f32x4* sg = (f32x4*)(a.ws + WS_DS) + ((size_t)grp * 64 + w * 8) * 64 + lane;
#pragma unroll
    for (int kt = 0; kt < 8; ++kt) sg[kt * 64] = S[kt];
}
__device__ __forceinline__ void grp_scan(const Frame& F, const Args& a) {
    f32x4* sg = (f32x4*)(a.ws + WS_DS); f32x4* si = sg + (size_t)256 * 4096; const float* dec = (const float*)(a.ws + WS_DEC);
    for (int gt = F.bid * NTHR + F.tid; gt < 16 * 4096; gt += F.G * NTHR) {
        const int bh = gt >> 12, slot = gt & 4095, kt = (slot >> 6) & 7, lane = slot & 63, k = 16 * kt + 4 * (lane >> 4);
        f32x4 cur = (f32x4){0.f, 0.f, 0.f, 0.f};
#pragma unroll 4
        for (int g = 0; g < 16; ++g) { const size_t gi = ((size_t)(bh * 16 + g)) * 4096 + slot;
            si[gi] = cur;
            const float* dp = dec + ((size_t)bh * 64 + 4 * g) * 128 + k;
            const f32x4 d = (*(const f32x4*)dp * *(const f32x4*)(dp + 128)) * (*(const f32x4*)(dp + 256) * *(const f32x4*)(dp + 384));
            cur = d * cur + sg[gi]; }
    }
}
struct InC { Tile qd, g, ol; f32x4 dec; };
__device__ __forceinline__ void loadC(InC& r, const Frame& F, const Args& a, int bh, int n) {
    const int b = bh >> 2, h = bh & 3; const size_t t0 = (size_t)b * SEQ + n * 64;
    const bf16_t* base = (const bf16_t*)(a.ws + WS_PROJ) + t0 * INC;
    tile_load(r.qd, base + C_HGT + 256 * h, INC, F.tid); tile_load(r.g, base + C_GHG + h * 128, INC, F.tid);
    tile_load(r.ol, (const bf16_t*)(a.ws + WS_YHG) + t0 * 512 + h * 128, 512, F.tid);
    r.dec = *(const f32x4*)((const float*)(a.ws + WS_DEC) + ((size_t)bh * 64 + n) * 128 + 4 * (F.tid & 31));
}
__device__ __forceinline__ void grp_final(const Frame& F, const Args& a, int grp) {
    const int bh = grp >> 4, n0 = 4 * (grp & 15), b = bh >> 2, h = bh & 3, w = F.wave, lane = F.lane, fr = lane & 15, fq = lane >> 4;
    f32x4 S[8];
    { const f32x4* si = (const f32x4*)(a.ws + WS_DS) + (size_t)256 * 4096 + ((size_t)grp * 64 + w * 8) * 64 + lane;
#pragma unroll
      for (int kt = 0; kt < 8; ++kt) S[kt] = si[kt * 64]; }
    const float ng = a.in[I_HGNG][16 * w + fr];
    LAS float* SSQ = (LAS float*)(F.lds + G4_L_SSQ);
    InC cur, nxt; loadC(cur, F, a, bh, n0);
    unsigned short yk[4][4];
#define G4_STORE(nn) do { bf16_t* yp_ = (bf16_t*)(a.ws + WS_YHG) + ((size_t)b * SEQ + (nn) * 64 + 4 * fq) * 512 + h * 128 + 16 * w + fr; \
        _Pragma("unroll") for (int tb = 0; tb < 4; ++tb) _Pragma("unroll") for (int r = 0; r < 4; ++r) yp_[(size_t)(16 * tb + r) * 512] = yk[tb][r]; } while (0)
    for (int j = 0; j < 4; ++j) {
        if (j > 0) G4_STORE(n0 + j - 1);
        loadC(nxt, F, a, bh, n0 + (j < 3 ? j + 1 : 3));
        tile_put(cur.qd, F.lds + L_QD, F.tid); tile_put(cur.g, F.lds + L_KD, F.tid); tile_put(cur.ol, F.lds + L_V, F.tid);
        if (F.tid < 32) *(LAS f32x4*)(F.lds + G4_L_DEC + 16 * F.tid) = cur.dec;
        HG_BAR();
        bf16x8 Sb[4];
#pragma unroll
        for (int ks = 0; ks < 4; ++ks) { const u32x4 t = (u32x4){cvt_pk_bf16(S[2 * ks][0], S[2 * ks][1]), cvt_pk_bf16(S[2 * ks][2], S[2 * ks][3]), cvt_pk_bf16(S[2 * ks + 1][0], S[2 * ks + 1][1]), cvt_pk_bf16(S[2 * ks + 1][2], S[2 * ks + 1][3])};
            Sb[ks] = __builtin_bit_cast(bf16x8, t); }
        f32x4 o[4];
#pragma unroll
        for (int tb = 0; tb < 4; ++tb) {
#pragma unroll
            for (int r = 0; r < 4; ++r) o[tb][r] = bf2f(*(const LAS unsigned short*)(F.lds + L_V + ((16 * tb + 4 * fq + r) * QP + 16 * w + fr) * 2));
#pragma unroll
            for (int ks = 0; ks < 4; ++ks) { const LAS unsigned char* qrow = F.lds + L_QD + ((16 * tb + fr) * QP + 32 * ks + 4 * fq) * 2;
                const u32x2 lo = *(const LAS u32x2*)qrow, hi = *(const LAS u32x2*)(qrow + 32);
                const u32x4 aw = (u32x4){lo.x, lo.y, hi.x, hi.y}; o[tb] = mfma16(__builtin_bit_cast(bf16x8, aw), Sb[ks], o[tb]); }
#pragma unroll
            for (int r = 0; r < 4; ++r) { const float v = scan16(o[tb][r] * o[tb][r]); if (fr == 15) SSQ[w * 64 + 16 * tb + 4 * fq + r] = v; } }
#pragma unroll
        for (int kt = 0; kt < 8; ++kt) S[kt] = S[kt] * *(const LAS f32x4*)(F.lds + G4_L_DEC + (16 * kt + 4 * fq) * 4);
        HG_BAR();
#pragma unroll
        for (int tb = 0; tb < 4; ++tb) { f32x4 tot = (f32x4){0.f, 0.f, 0.f, 0.f};
#pragma unroll
            for (int ww = 0; ww < 8; ++ww) tot += *(const LAS f32x4*)(SSQ + ww * 64 + 16 * tb + 4 * fq);
#pragma unroll
            for (int r = 0; r < 4; ++r) { const float rs = rsqrtf(tot[r] * (1.0f / 128.0f) + EPS); const float g = bf2f(*(const LAS unsigned short*)(F.lds + L_KD + ((16 * tb + 4 * fq + r) * QP + 16 * w + fr) * 2));
                yk[tb][r] = (unsigned short)f2bf(o[tb][r] * rs * ng * g * __builtin_amdgcn_rcpf(1.0f + __builtin_amdgcn_exp2f(-1.4426950408889634f * g))); } }
        HG_BAR();
        cur = nxt;
    }
    G4_STORE(n0 + 3);
#undef G4_STORE
}
#undef HG_BAR
}

__device__ __forceinline__ float rs4(float a0, float a1, float a2, float a3, int lane) {
    const bool hi = (lane & 32) != 0;
    const float s0 = hi ? a0 : a2, s1 = hi ? a1 : a3;
    const float k0 = (hi ? a2 : a0) + __shfl_xor(s0, 32), k1 = (hi ? a3 : a1) + __shfl_xor(s1, 32);
    const bool b4 = (lane & 16) != 0;
    const float sd = b4 ? k0 : k1;
    float k = (b4 ? k1 : k0) + __shfl_xor(sd, 16);
    k += __shfl_xor(k, 8); k += __shfl_xor(k, 4); k += __shfl_xor(k, 2); k += __shfl_xor(k, 1);
    return k;
}
__device__ __forceinline__ void phase_router(const Frame& F, const Args& a) {
    constexpr int AP = 1032;
    LAS bf16_t* AH = (LAS bf16_t*)F.lds;
    LAS bf16_t* AL = AH + 16 * AP;
    LAS float* PART = (LAS float*)(F.lds + 2 * 16 * AP * 2);
    LAS float* LG = PART + 8 * 16 * 48;
    LAS unsigned* LH = (LAS unsigned*)(LG + 16 * 48);
    LAS unsigned* LB = LH + 32;
    LAS unsigned* LR = LH + 64;
    if (F.tid < NEXP) LH[F.tid] = 0u;
    const float* mod = (const float*)(a.ws + WS_MOD);
    const bf16_t* x1 = (const bf16_t*)(a.ws + WS_X1B); bf16_t* H2 = (bf16_t*)(a.ws + WS_ACT);
    unsigned* counts = (unsigned*)(a.ws + WS_CTL) + CW_COUNTS; unsigned* tokinfo = (unsigned*)(a.ws + WS_TOKINFO); int* toklist = (int*)(a.ws + WS_TOKLIST);
    const int rows_per_blk = T / F.G, r0 = F.bid * rows_per_blk, b = r0 / SEQ;
    const int lane = F.lane, w = F.wave, fr = lane & 15, fq = lane >> 4;
    f32x4 v[2][4], vn[2][4];
#define RT_LOAD(V, rb_) do { _Pragma("unroll") for (int q = 0; q < 2; ++q) { const u32x2* xr_ = (const u32x2*)(x1 + (size_t)((rb_) + 2 * w + q) * D) + lane; \
        _Pragma("unroll") for (int j = 0; j < 4; ++j) { const u32x2 t_ = xr_[64 * j]; V[q][j] = (f32x4){bf2f(t_.x & 0xffffu), bf2f(t_.x >> 16), bf2f(t_.y & 0xffffu), bf2f(t_.y >> 16)}; } } } while (0)
    RT_LOAD(v, r0);
    bf16x8 Bh[4][3], Bl[4][3];
    {
        const float* wre = a.in[I_WRE]; const float* wrg = a.in[I_WRG];
#pragma unroll
        for (int ks = 0; ks < 4; ++ks)
#pragma unroll
            for (int ct = 0; ct < 3; ++ct) {
                unsigned hw[4], lw[4];
#pragma unroll
                for (int jp = 0; jp < 4; ++jp) { float x[2];
#pragma unroll
                    for (int z = 0; z < 2; ++z) { const int k = 128 * w + 32 * ks + 8 * fq + 2 * jp + z;
                        if (ct == 0) { const float g = wrg[k * 4 + (fr & 3)], e = wre[k * 32 + ((fr + 28) & 31)]; x[z] = fr < 4 ? g : e; }
                        else if (ct == 1) x[z] = wre[k * 32 + 12 + fr];
                        else { const float e = wre[k * 32 + 28 + (fr & 3)]; x[z] = fr < 4 ? e : 0.f; } }
                    const unsigned h0 = f2bf(x[0]), h1 = f2bf(x[1]); hw[jp] = h0 | (h1 << 16);
                    lw[jp] = pk2(x[0] - bf2f(h0), x[1] - bf2f(h1)); }
                Bh[ks][ct] = __builtin_bit_cast(bf16x8, (u32x4){hw[0], hw[1], hw[2], hw[3]}); Bl[ks][ct] = __builtin_bit_cast(bf16x8, (u32x4){lw[0], lw[1], lw[2], lw[3]});
            }
    }
    for (int g = 0; g < rows_per_blk / 16; ++g) {
        const int rg = r0 + 16 * g;
        { const int gn = g + 1 < rows_per_blk / 16 ? g + 1 : g; RT_LOAD(vn, r0 + 16 * gn); }
#pragma unroll
        for (int q = 0; q < 2; ++q) { float sq = 0.f;
#pragma unroll
            for (int j = 0; j < 4; ++j) sq += (v[q][j].x * v[q][j].x + v[q][j].y * v[q][j].y) + (v[q][j].z * v[q][j].z + v[q][j].w * v[q][j].w);
            const float rs = rsqrtf(wave_sum(sq) * (1.0f / D) + EPS); const int row = 2 * w + q;
#pragma unroll
            for (int j = 0; j < 4; ++j) { const int k = 256 * j + 4 * lane;
                const f32x4 gg = *(const f32x4*)(a.in[I_N2G] + k) * (1.0f + *(const f32x4*)(mod + b * 6144 + 4 * 1024 + k)), sh = *(const f32x4*)(mod + b * 6144 + 3 * 1024 + k);
                const f32x4 hv = v[q][j] * rs * gg + sh;
                const unsigned h0 = f2bf(hv.x), h1 = f2bf(hv.y), h2_ = f2bf(hv.z), h3 = f2bf(hv.w);
                const u32x2 hw = (u32x2){h0 | (h1 << 16), h2_ | (h3 << 16)};
                *(u32x2*)(H2 + (size_t)(rg + row) * D + k) = hw;
                *(LAS u32x2*)(AH + row * AP + k) = hw;
                *(LAS u32x2*)(AL + row * AP + k) = (u32x2){pk2(hv.x - bf2f(h0), hv.y - bf2f(h1)), pk2(hv.z - bf2f(h2_), hv.w - bf2f(h3))}; } }
        __syncthreads();
        f32x4 acc[3] = {{0.f, 0.f, 0.f, 0.f}, {0.f, 0.f, 0.f, 0.f}, {0.f, 0.f, 0.f, 0.f}};
#pragma unroll
        for (int ks = 0; ks < 4; ++ks) { const bf16x8 ah = *(const LAS bf16x8*)(AH + fr * AP + 128 * w + 32 * ks + 8 * fq), al = *(const LAS bf16x8*)(AL + fr * AP + 128 * w + 32 * ks + 8 * fq);
#pragma unroll
            for (int ct = 0; ct < 3; ++ct) { acc[ct] = __builtin_amdgcn_mfma_f32_16x16x32_bf16(ah, Bh[ks][ct], acc[ct], 0, 0, 0);
                acc[ct] = __builtin_amdgcn_mfma_f32_16x16x32_bf16(al, Bh[ks][ct], acc[ct], 0, 0, 0); acc[ct] = __builtin_amdgcn_mfma_f32_16x16x32_bf16(ah, Bl[ks][ct], acc[ct], 0, 0, 0); } }
#pragma unroll
        for (int ct = 0; ct < 3; ++ct)
#pragma unroll
            for (int r = 0; r < 4; ++r) PART[(w * 16 + 4 * fq + r) * 48 + 16 * ct + fr] = acc[ct][r];
        __syncthreads();
        for (int t = F.tid; t < 16 * 48; t += NTHR) { const int row = t / 48, o = t % 48; float sacc = 0.f;
#pragma unroll
            for (int ww = 0; ww < 8; ++ww) sacc += PART[(ww * 16 + row) * 48 + o];
            if (o < 36) LG[row * 48 + o] = sacc + (o < 4 ? a.in[I_BRG][o & 3] : a.in[I_BRE][(o + 28) & 31]); }
        __syncthreads();
        if (F.tid < 16) {
            const LAS float* lg = LG + F.tid * 48;
            float gl[4]; int gi = 0;
#pragma unroll
            for (int o = 0; o < 4; ++o) gl[o] = lg[o];
            float gm = gl[0];
#pragma unroll
            for (int o = 1; o < 4; ++o) if (gl[o] > gm) { gm = gl[o]; gi = o; }
            float gsum = 0.f;
#pragma unroll
            for (int o = 0; o < 4; ++o) gsum += expf(gl[o] - gm);
            const float gp = 1.0f / gsum;
            float el[8];
#pragma unroll
            for (int e = 0; e < 8; ++e) el[e] = lg[4 + gi * 8 + e];
            int i0 = 0; float m0 = el[0];
#pragma unroll
            for (int o = 1; o < 8; ++o) if (el[o] > m0) { m0 = el[o]; i0 = o; }
            int i1 = -1; float m1 = -INFINITY;
#pragma unroll
            for (int o = 0; o < 8; ++o) if (o != i0 && el[o] > m1) { m1 = el[o]; i1 = o; }
            const float e1 = expf(m1 - m0); const float w0 = gp / (1.0f + e1), w1 = gp * e1 / (1.0f + e1);
            const int rl = 16 * g + F.tid, ex0 = gi * 8 + i0, ex1 = gi * 8 + i1;
            const unsigned l0 = atomicAdd((unsigned*)(LH + ex0), 1u), l1 = atomicAdd((unsigned*)(LH + ex1), 1u);
            LAS unsigned* ri = LR + rl * 6;
            ri[0] = (unsigned)ex0; ri[1] = l0; ri[2] = (unsigned)ex1; ri[3] = l1; ri[4] = __float_as_uint(w0); ri[5] = __float_as_uint(w1);
        }
#pragma unroll
        for (int q = 0; q < 2; ++q)
#pragma unroll
            for (int j = 0; j < 4; ++j) v[q][j] = vn[q][j];
    }
#undef RT_LOAD
    __syncthreads();
    if (F.tid < NEXP) LB[F.tid] = atomicAdd(counts + 64 * F.tid, LH[F.tid]);
    __syncthreads();
    for (int rl = F.tid; rl < rows_per_blk; rl += NTHR) {
        const LAS unsigned* ri = LR + rl * 6; const int r = r0 + rl;
        const unsigned ex0 = ri[0], ex1 = ri[2], k0 = LB[ex0] + ri[1], k1 = LB[ex1] + ri[3];
        toklist[ex0 * T + k0] = r; toklist[ex1 * T + k1] = r;
        u32x4 t0; t0.x = ex0; t0.y = k0; t0.z = ex1; t0.w = k1;
        *(u32x4*)(tokinfo + (size_t)r * 8) = t0;
        tokinfo[(size_t)r * 8 + 4] = ri[4]; tokinfo[(size_t)r * 8 + 5] = ri[5];
    }
}
__device__ __forceinline__ void build_moe_tab(const Frame& F, const Args& a, LAS MoeTab* tab) {
    if (F.tid == 0) {
        const unsigned* counts = (const unsigned*)(a.ws + WS_CTL) + CW_COUNTS; int nt = 0;
        for (int e = 0; e < NEXP; ++e) { const int c = (int)__hip_atomic_load(counts + 64 * e, __ATOMIC_RELAXED, __HIP_MEMORY_SCOPE_AGENT); tab->cnt[e] = c; tab->tbase[e] = nt;
            const int n = (c + 255) >> 8; for (int m = 0; m < n; ++m) { tab->tile_e[nt] = e; tab->tile_m[nt] = m; ++nt; } }
        tab->tbase[NEXP] = nt; tab->nt = nt;
    }
    __syncthreads();
}
__device__ __forceinline__ void phase_final(const Frame& F, const Args& a, const LAS MoeTab* tab) {
    const float* mod = (const float*)(a.ws + WS_MOD); const unsigned* tokinfo = (const unsigned*)(a.ws + WS_TOKINFO); const bf16_t* Ys = (const bf16_t*)(a.ws + WS_YS);
    const int rows_per_blk = T / F.G, r0 = F.bid * rows_per_blk;
    for (int r = r0 + F.wave; r < r0 + rows_per_blk; r += NWAVES) {
        const int b = r / SEQ;
        const u32x4 ti = *(const u32x4*)(tokinfo + (size_t)r * 8);
        const float w0 = __uint_as_float(tokinfo[(size_t)r * 8 + 4]), w1 = __uint_as_float(tokinfo[(size_t)r * 8 + 5]);
        const size_t s0 = (size_t)tab->tbase[ti.x] * 256 + ti.y, s1 = (size_t)tab->tbase[ti.z] * 256 + ti.w;
        f32x4* xr = (f32x4*)(a.out + (size_t)r * D) + F.lane; const u32x2* xb = (const u32x2*)((const bf16_t*)(a.ws + WS_X1B) + (size_t)r * D) + F.lane;
        const u32x2* y0 = (const u32x2*)(Ys + s0 * D) + F.lane; const u32x2* y1 = (const u32x2*)(Ys + s1 * D) + F.lane;
        f32x4 v[4]; float s = 0.f;
#pragma unroll
        for (int j = 0; j < 4; ++j) { const int k = 256 * j + 4 * F.lane;
            const f32x4 gt = *(const f32x4*)(mod + b * 6144 + 5 * 1024 + k); const u32x2 a0 = y0[64 * j], a1 = y1[64 * j];
            f32x4 m; m.x = w0 * bf2f(a0.x & 0xffffu) + w1 * bf2f(a1.x & 0xffffu); m.y = w0 * bf2f(a0.x >> 16) + w1 * bf2f(a1.x >> 16);
            m.z = w0 * bf2f(a0.y & 0xffffu) + w1 * bf2f(a1.y & 0xffffu); m.w = w0 * bf2f(a0.y >> 16) + w1 * bf2f(a1.y >> 16);
            const u32x2 xq = xb[64 * j]; const f32x4 xv = (f32x4){bf2f(xq.x & 0xffffu), bf2f(xq.x >> 16), bf2f(xq.y & 0xffffu), bf2f(xq.y >> 16)};
            v[j] = xv + gt * m; s += (v[j].x * v[j].x + v[j].y * v[j].y) + (v[j].z * v[j].z + v[j].w * v[j].w); }
        const float rs = rsqrtf(wave_sum(s) * (1.0f / D) + EPS);
#pragma unroll
        for (int j = 0; j < 4; ++j) { const f32x4 g = *(const f32x4*)(a.in[I_FG] + 256 * j + 4 * F.lane); xr[64 * j] = v[j] * rs * g; }
    }
}

#define XB_TMO      128
#define XB_XCNT(j)  (256  + 64 * (j))
#define XB_XSUB(j)  (1280 + 64 * (j))
#define XB_XGEN(j)  (2304 + 64 * (j))
#define XB_TOP      3328
#define XB_TOPGEN   3392
#define XCD_BAR_WORDS 3456
#define XB_SPIN_CAP (1u << 18)
__device__ __forceinline__ unsigned xb_ld(unsigned* p)              { return __hip_atomic_load(p, __ATOMIC_RELAXED, __HIP_MEMORY_SCOPE_AGENT); }
__device__ __forceinline__ unsigned xb_add(unsigned* p, unsigned v) { return __hip_atomic_fetch_add(p, v, __ATOMIC_RELAXED, __HIP_MEMORY_SCOPE_AGENT); }
__device__ __forceinline__ unsigned xb_xcc_id() { return (unsigned)__builtin_amdgcn_s_getreg((3 << 11) | 20) & 0xFu; }
#define XB_SPIN(cond, bar) do { unsigned _sp = 0; while (cond) { __builtin_amdgcn_s_sleep(1); \
    if ((++_sp & 255u) == 0u) { if (xb_ld(&(bar)[XB_TMO])) break; if (_sp > XB_SPIN_CAP) { atomicAdd(&(bar)[XB_TMO], 1u); break; } } } } while (0)
struct XcdBarrier { unsigned* bar; unsigned x; volatile LAS unsigned* st; };
__device__ __forceinline__ XcdBarrier xcd_barrier_post(unsigned* bar, volatile LAS unsigned* st) {
    XcdBarrier b; b.bar = bar; b.x = xb_xcc_id(); b.st = st;
    if (threadIdx.x == 0) (void)xb_add(&bar[XB_XCNT(b.x)], 1u);
    return b;
}
__device__ __forceinline__ void xcd_barrier_complete(unsigned* bar, unsigned x, unsigned& nloc, unsigned& nx) {
    const unsigned G = gridDim.x * gridDim.y * gridDim.z;
    unsigned sum, cnt, mine, sp = 0u;
    for (;;) {
        sum = 0u; cnt = 0u; mine = 0u;
#pragma unroll
        for (unsigned j = 0; j < 16; ++j) { const unsigned c = xb_ld(&bar[XB_XCNT(j)]); sum += c; cnt += (c > 0u) ? 1u : 0u; mine = (j == x) ? c : mine; }
        if (sum == G) break;
        __builtin_amdgcn_s_sleep(1);
        if ((++sp & 255u) == 0u) { if (xb_ld(&bar[XB_TMO])) break; if (sp > XB_SPIN_CAP) { atomicAdd(&bar[XB_TMO], 1u); break; } }
    }
    nloc = mine > 0u ? mine : 1u; nx = cnt > 0u ? cnt : 1u;
}
__device__ __forceinline__ void xcd_barrier(const XcdBarrier& b) {
    asm volatile("s_waitcnt vmcnt(0)" ::: "memory");
    __syncthreads();
    if (threadIdx.x == 0) {
        unsigned* bar = b.bar;
        __builtin_amdgcn_s_waitcnt(0);
        unsigned nloc = b.st[0], nx = b.st[1];
        if (nloc == 0u) { xcd_barrier_complete(bar, b.x, nloc, nx); b.st[0] = nloc; b.st[1] = nx; }
        const unsigned old = xb_add(&bar[XB_XSUB(b.x)], 1u);
        const unsigned gen = old / nloc;
        if (old + 1u == (gen + 1u) * nloc) {
            __builtin_amdgcn_fence(__ATOMIC_RELEASE, "agent");
            asm volatile("s_waitcnt vmcnt(0)" ::: "memory");
            const unsigned og = xb_add(&bar[XB_TOP], 1u);
            const unsigned tg = og / nx;
            if (og + 1u == (tg + 1u) * nx) xb_add(&bar[XB_TOPGEN], 1u);
            else XB_SPIN(xb_ld(&bar[XB_TOPGEN]) == tg, bar);
            __builtin_amdgcn_fence(__ATOMIC_ACQUIRE, "agent");
            xb_add(&bar[XB_XGEN(b.x)], 1u);
            asm volatile("s_waitcnt vmcnt(0)" ::: "memory");
        } else {
            XB_SPIN(xb_ld(&bar[XB_XGEN(b.x)]) == gen, bar);
            __builtin_amdgcn_fence(__ATOMIC_ACQUIRE, "agent");
            asm volatile("s_waitcnt vmcnt(0)" ::: "memory");
        }
    }
    __syncthreads();
}

constexpr int N_PHASES = 11;
__global__ void __launch_bounds__(NTHR, 2) mk_fwd(Args a) {
    extern __shared__ __attribute__((aligned(16))) unsigned char lds_raw[];
    Frame F; F.lds = (LAS unsigned char*)lds_raw; F.tid = threadIdx.x; F.lane = F.tid & 63; F.wave = __builtin_amdgcn_readfirstlane(F.tid >> 6); F.G = gridDim.x; F.bid = blockIdx.x;
    unsigned char* ws = a.ws;
    const int lo = a.ph_lo, hi = a.ph_hi;
#if MK_N_LAUNCHES == 1
    volatile LAS unsigned* MISC = (volatile LAS unsigned*)(F.lds + 152 * 1024);
    if (F.tid < 4) MISC[F.tid] = 0u;
    __syncthreads();
    XcdBarrier xbar = xcd_barrier_post((unsigned*)(ws + WS_CTL) + CW_BAR, MISC);
#define SEAM(k) do { if (IN(k) && IN((k) + 1)) xcd_barrier(xbar); } while (0)
#else
#define SEAM(k) do { } while (0)
#endif
#define IN(k) (lo <= (k) && (k) < hi)
    LAS MoeTab* tab = (LAS MoeTab*)(F.lds + 144 * 1024);

#define RUNPH(k, ...) if (IN(k)) { F.lane = lane_now(); F.tid = F.wave * 64 + F.lane; __VA_ARGS__ }
    RUNPH(0, { phase0(F, a); }) SEAM(0);
    RUNPH(1, { phase1(F, a); __syncthreads(); dense_weight_convert(F, a); }) SEAM(1);
    RUNPH(2, {
        DenseOrder S{(const char*)(ws + WS_ACT), (const char*)(ws + WS_WIN), D, T / 256, INC / 256, F.G, F.bid};
        EpiInProj E{(bf16_t*)(ws + WS_PROJ), (bf16_t*)a.out, (float*)(ws + WS_DEC), (const float*)(ws + WS_SMALL) + 16, attn_body::C2};
        pg8::gemm_phase(F.lds, D, S, E);
        int nl; const int early = w2_early_items(F.G, nl);
        if (early && F.bid >= F.G - nl) { __syncthreads(); moe_w2_convert(F, a, 0, early, (F.bid - (F.G - nl)) * NWAVES + F.wave, nl * NWAVES); }
    }) SEAM(2);
    RUNPH(3, {
        for (int g = F.bid; g < 256; g += F.G) hg::grp_local(F, a, g);
        __syncthreads();
        attn_phase(F, a);
    }) SEAM(3);
    RUNPH(4, { hg::grp_scan(F, a); attn_combine(F, a); }) SEAM(4);
    RUNPH(5, { for (int g = F.bid; g < 256; g += F.G) hg::grp_final(F, a, g); }) SEAM(5);
    RUNPH(6, {
        UpOrder S{(const char*)(ws + WS_YDA), (const char*)(ws + WS_YHG), (const char*)(ws + WS_WUPDA), (const char*)(ws + WS_WUPHG), F.G, F.bid};
        EpiUp E{(const bf16_t*)(ws + WS_PROJ), (bf16_t*)(ws + WS_ACT)};
        pg8::gemm_phase(F.lds, 512, S, E);
    }) SEAM(6);
    RUNPH(7, {
        DenseOrder S{(const char*)(ws + WS_ACT), (const char*)(ws + WS_WOUT), D, T / 256, D / 256, F.G, F.bid};
        EpiOut E{a.in[I_X], (const float*)(ws + WS_MOD), (bf16_t*)(ws + WS_X1B)};
        pg8::gemm_phase(F.lds, D, S, E);
        moe_weight_convert(F, a);
    }) SEAM(7);
    RUNPH(8, { phase_router(F, a); __syncthreads(); }) SEAM(8);
    RUNPH(9, {
        build_moe_tab(F, a, tab);
        unsigned* done = (unsigned*)(ws + WS_CTL) + CW_TILE;
        const int vc = (F.G & 7) == 0 ? (F.bid & 7) * (F.G >> 3) + (F.bid >> 3) : F.bid;
        { Moe1Order S{tab, (const char*)(ws + WS_ACT), (const char*)(ws + WS_W13), (const int*)(ws + WS_TOKLIST), F.G, vc};
          EpiMoe1 E{(bf16_t*)(ws + WS_HS), done};
          pg8::gemm_phase(F.lds, D, S, E); }
        { Moe2Order S{tab, (const char*)(ws + WS_HS), (const char*)a.out + OUT_W2, done, (unsigned*)(ws + WS_CTL) + CW_TMO, F.G, vc};
          EpiStoreBf16 E{(bf16_t*)(ws + WS_YS), D, 0, 1.0f};
          pg8::gemm_phase(F.lds, DEXP, S, E); }
    }) SEAM(9);
    RUNPH(10, { build_moe_tab(F, a, tab); phase_final(F, a, tab); })
#undef IN
#undef SEAM
}

extern "C" void kernel_launch(void* const* d_in, const int* in_sizes, int n_in, void* d_out, int out_size, void* d_ws, size_t ws_size, hipStream_t stream) {
    static int grid = 0;
    if (grid == 0) {
        if (n_in != 25 || in_sizes[0] != T * D || out_size != T * D || ws_size < WS_END) { fprintf(stderr, "kernel_launch: unexpected shapes (n_in %d, in0 %d, out %d, ws %zu)\n", n_in, n_in > 0 ? in_sizes[0] : -1, out_size, ws_size); grid = -1; return; }
        int dev = 0, cus = 0, per_cu = 0;
        if (hipGetDevice(&dev) != hipSuccess || hipDeviceGetAttribute(&cus, hipDeviceAttributeMultiprocessorCount, dev) != hipSuccess) { grid = -1; return; }
        if (hipFuncSetAttribute((const void*)mk_fwd, hipFuncAttributeMaxDynamicSharedMemorySize, LDS_BYTES) != hipSuccess) { fprintf(stderr, "kernel_launch: hipFuncSetAttribute failed\n"); grid = -1; return; }
        if (hipOccupancyMaxActiveBlocksPerMultiprocessor(&per_cu, (const void*)mk_fwd, NTHR, LDS_BYTES) != hipSuccess || per_cu < 1) { fprintf(stderr, "kernel_launch: occupancy query says %d\n", per_cu); per_cu = 1; }
        (void)hipGetLastError();
        grid = cus;
        if (grid > 256) grid = 256;
        while (T % grid) --grid;
    }
    if (grid < 0) return;
    (void)hipMemsetAsync((char*)d_ws + WS_CTL, 0, CTL_ZERO_BYTES, stream);
    Args a{};
    for (int i = 0; i < 25; ++i) a.in[i] = (const float*)d_in[i];
    a.out = (float*)d_out; a.ws = (unsigned char*)d_ws;
#if MK_N_LAUNCHES == 1
    a.ph_lo = 0; a.ph_hi = N_PHASES;
    void* args[] = {&a};
    hipError_t e = hipLaunchCooperativeKernel((const void*)mk_fwd, dim3(grid), dim3(NTHR), args, LDS_BYTES, stream);
    if (e != hipSuccess) fprintf(stderr, "cooperative launch failed: %s (grid %d)\n", hipGetErrorString(e), grid);
#else
    for (int p = 0; p < N_PHASES; ++p) {
        a.ph_lo = p; a.ph_hi = p + 1;
        hipLaunchKernelGGL(mk_fwd, dim3(grid), dim3(NTHR), LDS_BYTES, stream, a);
    }
#endif
}
```

```cpp
#include <hip/hip_runtime.h>
#include <cstdio>
#include <cstdint>

#ifndef MK_N_LAUNCHES
#define MK_N_LAUNCHES 1
#endif

#define LAS __attribute__((address_space(3)))
typedef unsigned short bf16_t;
typedef short bf16x8 __attribute__((ext_vector_type(8)));
typedef float f32x4 __attribute__((ext_vector_type(4)));
typedef float f32x2 __attribute__((ext_vector_type(2)));
typedef unsigned u32x4 __attribute__((ext_vector_type(4)));
typedef unsigned u32x2 __attribute__((ext_vector_type(2)));

constexpr int NB = 4, SEQ = 4096, D = 1024, T = NB * SEQ;
constexpr int INC = 5632;
constexpr int C_QDA = 0, C_KDA = 512, C_VDA = 1024, C_QHG = 1536, C_FHG = 2048, C_IHG = 2560, C_GHG = 3072, C_GDA = 3584, C_GHGATE = 4608;
constexpr int C_HGT = 1536;
constexpr int NEXP = 32, DEXP = 512;
constexpr int PMAX = 40960;
constexpr float EPS = 1e-6f;
constexpr int NWAVES = 8, NTHR = 512;

constexpr size_t MiB = 1u << 20;
constexpr size_t WS_CTL = 0, CTL_ZERO_BYTES = 64 * 1024;
constexpr size_t WS_MOD = 5 * MiB / 2;
constexpr size_t WS_SMALL = 11 * MiB / 4;
constexpr size_t WS_TOKINFO = 3 * MiB;
constexpr size_t WS_TOKLIST = 4 * MiB;
constexpr size_t WS_DEC = 6 * MiB;
constexpr size_t WS_DS = 24 * MiB;
constexpr size_t WS_WIN = 8 * MiB;
constexpr size_t WS_WUPDA = 20 * MiB, WS_WUPHG = 21 * MiB, WS_WOUT = 22 * MiB;
constexpr size_t WS_ACT = 24 * MiB;
constexpr size_t WS_PROJ = 56 * MiB;
constexpr size_t WS_YDA = 232 * MiB, WS_YHG = 248 * MiB;
constexpr size_t WS_OA = 264 * MiB;
constexpr size_t WS_W13 = 56 * MiB;
constexpr size_t WS_W2 = 120 * MiB;
constexpr size_t WS_HS = 152 * MiB;
constexpr size_t WS_YS = 192 * MiB;
constexpr size_t OUT_W2 = 16 * MiB;
constexpr int W2_EARLY = 32;
constexpr size_t WS_X1B = 272 * MiB;
constexpr size_t WS_END = 304 * MiB;
constexpr int CW_COUNTS = 64;
constexpr int CW_BAR = 4096;
constexpr int CW_TILE = 8192;
constexpr int CW_TMO = 32;

constexpr int LDS_BYTES = 160 * 1024;

__device__ __forceinline__ float bf2f(unsigned v) { return __uint_as_float(v << 16); }
__device__ __forceinline__ unsigned f2bf(float f) { unsigned u = __float_as_uint(f); return (u + 0x7fffu + ((u >> 16) & 1u)) >> 16; }
__device__ __forceinline__ unsigned pk2(float lo, float hi) { return f2bf(lo) | (f2bf(hi) << 16); }
__device__ __forceinline__ float sigmoidf_(float x) { return 1.0f / (1.0f + __expf(-x)); }
__device__ __forceinline__ float siluf_(float x) { return x / (1.0f + __expf(-x)); }
__device__ __forceinline__ int lane_now() { int l; asm volatile("v_mbcnt_lo_u32_b32 %0, -1, 0\n\tv_mbcnt_hi_u32_b32 %0, -1, %0" : "=v"(l)); return l; }
__device__ __forceinline__ float wave_sum(float v) {
#pragma unroll
    for (int o = 1; o < 64; o <<= 1) v += __shfl_xor(v, o);
    return v;
}

namespace pg8 {
constexpr int BM = 256, BK = 64, HALF = 128, HTB = HALF * BK * 2, STAGE_BYTES = 8 * HTB;
__host__ __device__ __forceinline__ int lds_byte(int r, int c) { const int st = (r >> 4) * 2 + (c >> 5), rr = r & 15, cc = c & 31, ob = rr * 64 + cc * 2; return st * 1024 + (ob ^ (((ob >> 9) & 1) << 5)); }
__host__ __device__ __forceinline__ void stage_rc(int b, int& R, int& C) { const int st = b / 1024, sb = b % 1024, swz = sb ^ (((sb >> 9) & 1) << 5); R = (st >> 1) * 16 + swz / 64; C = (st & 1) * 32 + (swz % 64) / 2; }
__host__ __device__ __forceinline__ int perm32(int rho) { const int n = rho >> 4, i = rho & 15; return 8 * (i >> 2) + 4 * n + (i & 3); }

struct Unit { int pm, pn; const char* A; const char* B; int aux; };
__device__ __forceinline__ unsigned cvt_pk_bf16(float lo, float hi) { unsigned r; asm volatile("v_cvt_pk_bf16_f32 %0, %1, %2" : "=v"(r) : "v"(lo), "v"(hi)); return r; }

template <class Epi, class Sched>
__device__ __forceinline__ void gemm_phase(LAS unsigned char* lds, const int K, const Sched& S, const Epi& E) {
    const int tid = threadIdx.x, wid = __builtin_amdgcn_readfirstlane(tid >> 6), lane = tid & 63, wr = wid >> 2, wc = wid & 3, fr = lane & 15, fq = lane >> 4;
    const int nt = K / BK;
    unsigned voffB[2];
#define PG8_SETLANE() do { const int _l = lane_now(), _t = wid * 64 + _l; _Pragma("unroll") for (int _i = 0; _i < 2; ++_i) { int _R, _C; stage_rc(_t * 16 + _i * 8192, _R, _C); \
        const int _Rb = Epi::PERM ? ((_R & ~31) + perm32(_R & 31)) : _R; voffB[_i] = (unsigned)(_Rb * K + _C) * 2u; } \
        aoff = lds_byte(wr * 64 + (_l & 15), (_l >> 4) * 8); boff = lds_byte(wc * 32 + (_l & 15), (_l >> 4) * 8); } while (0)
    const size_t kstep = (size_t)(BK * 2);
    const size_t hstep = (size_t)HALF * K * 2;
    const unsigned ldsw = (unsigned)wid * 1024u;
    int aoff, boff; PG8_SETLANE();
#define PG8_SA(b, h) (((b) * 2 + (h)) * HTB)
#define PG8_SB(b, h) ((4 + (b) * 2 + (h)) * HTB)
#define PG8_STAGE(bufoff, gbase, voff) do { _Pragma("unroll") for (int _i = 0; _i < 2; ++_i) \
        __builtin_amdgcn_global_load_lds((const unsigned*)((const char*)(gbase) + (voff)[_i]), (LAS unsigned*)(lds + (bufoff) + ldsw + _i * 8192), 16, 0, 0); } while (0)
#define PG8_LDA(dst, b, h) do { _Pragma("unroll") for (int m = 0; m < 4; ++m) _Pragma("unroll") for (int k = 0; k < 2; ++k) dst[m][k] = *(const LAS bf16x8*)(lds + PG8_SA(b, h) + aoff + m * 2048 + k * 1024); } while (0)
#define PG8_LDB(dst, b, h) do { _Pragma("unroll") for (int n = 0; n < 2; ++n) _Pragma("unroll") for (int k = 0; k < 2; ++k) dst[n][k] = *(const LAS bf16x8*)(lds + PG8_SB(b, h) + boff + n * 2048 + k * 1024); } while (0)
#define PG8_MMA(ai, bj, At, Bt) do { __builtin_amdgcn_s_setprio(1); _Pragma("unroll") for (int m = 0; m < 4; ++m) _Pragma("unroll") for (int n = 0; n < 2; ++n) _Pragma("unroll") for (int k = 0; k < 2; ++k) \
        acc[ai][bj][m][n] = __builtin_amdgcn_mfma_f32_16x16x32_bf16(Bt[n][k], At[m][k], acc[ai][bj][m][n], 0, 0, 0); __builtin_amdgcn_s_setprio(0); } while (0)
#define PG8_WAIT_V(n) asm volatile("s_waitcnt vmcnt(" #n ")" ::: "memory")
#define PG8_WAIT_L(n) asm volatile("s_waitcnt lgkmcnt(" #n ")" ::: "memory")
#define PG8_BAR __builtin_amdgcn_s_barrier()
#define PG8_SCHED __builtin_amdgcn_sched_barrier(0)
#define PG8_SETA(vo, u) do { const int _t = wid * 64 + lane_now(); _Pragma("unroll") for (int _i = 0; _i < 2; ++_i) { int _R, _C; stage_rc(_t * 16 + _i * 8192, _R, _C); \
        _Pragma("unroll") for (int _h = 0; _h < 2; ++_h) vo[_h][_i] = (unsigned)((size_t)S.arow(u, _h * HALF + _R) * (size_t)K + _C) * 2u; } if (Sched::GATHER) PG8_WAIT_V(0); } while (0)
    Unit cur, nxt; int ui = 0;
    if (!S.next(0, cur)) return;
    f32x4 acc[2][2][4][2];
#pragma unroll
    for (int a = 0; a < 2; ++a)
#pragma unroll
        for (int b = 0; b < 2; ++b)
#pragma unroll
            for (int m = 0; m < 4; ++m)
#pragma unroll
                for (int n = 0; n < 2; ++n) acc[a][b][m][n] = (f32x4){0.f, 0.f, 0.f, 0.f};
    bf16x8 At[4][2], B0[2][2], B1[2][2];
    unsigned voC[2][2], voN[2][2];
    S.a_ready(cur);
    PG8_SETA(voC, cur);
    const char* cA = cur.A; const char* cB = cur.B;
    PG8_STAGE(PG8_SB(0, 0), cB, voffB); PG8_STAGE(PG8_SB(0, 1), cB + hstep, voffB); PG8_STAGE(PG8_SA(0, 0), cA, voC[0]); PG8_STAGE(PG8_SA(0, 1), cA, voC[1]);
    if (wr == 1) PG8_BAR;
    PG8_WAIT_V(2); PG8_BAR;
    PG8_STAGE(PG8_SB(1, 0), cB + kstep, voffB); PG8_STAGE(PG8_SA(1, 0), cA + kstep, voC[0]); PG8_STAGE(PG8_SB(1, 1), cB + hstep + kstep, voffB);
    PG8_WAIT_V(6); PG8_BAR;
    for (;;) {
        const bool has_next = S.next(ui + 1, nxt);
        if (has_next) { PG8_SETA(voN, nxt); }
        else {
#pragma unroll
            for (int h = 0; h < 2; ++h)
#pragma unroll
                for (int i = 0; i < 2; ++i) voN[h][i] = voC[h][i];
        }
        const char* nA = has_next ? nxt.A : cA; const char* nB = has_next ? nxt.B : cB;
        for (int t = 0; t < nt; t += 2) {
            const bool last = (t == nt - 2);
            if (last && has_next) S.a_ready(nxt);
            const char* a1 = cA + (size_t)(t + 1) * kstep;
            const char* a2 = last ? nA : cA + (size_t)(t + 2) * kstep; const char* b2 = last ? nB : cB + (size_t)(t + 2) * kstep;
            const char* a3 = a2 + kstep; const char* b3 = b2 + kstep;
            unsigned vo2[2][2];
#pragma unroll
            for (int h = 0; h < 2; ++h)
#pragma unroll
                for (int i = 0; i < 2; ++i) vo2[h][i] = last ? voN[h][i] : voC[h][i];
            PG8_LDB(B0, 0, 0); PG8_LDB(B1, 0, 1); PG8_SCHED; PG8_LDA(At, 0, 0); PG8_STAGE(PG8_SA(1, 1), a1, voC[1]);
            PG8_WAIT_V(8); PG8_WAIT_L(0); PG8_BAR; PG8_MMA(0, 0, At, B0); PG8_MMA(0, 1, At, B1); PG8_BAR; PG8_SCHED;
            PG8_LDA(At, 0, 1); PG8_STAGE(PG8_SB(0, 0), b2, voffB); PG8_STAGE(PG8_SB(0, 1), b2 + hstep, voffB); PG8_STAGE(PG8_SA(0, 0), a2, vo2[0]);
            PG8_WAIT_V(8); PG8_WAIT_L(0); PG8_BAR; PG8_MMA(1, 0, At, B0); PG8_MMA(1, 1, At, B1); PG8_BAR; PG8_SCHED;
            PG8_LDB(B0, 1, 0); PG8_LDB(B1, 1, 1); PG8_SCHED; PG8_LDA(At, 1, 0); PG8_STAGE(PG8_SA(0, 1), a2, vo2[1]);
            PG8_WAIT_V(8); PG8_WAIT_L(0); PG8_BAR; PG8_MMA(0, 0, At, B0); PG8_MMA(0, 1, At, B1); PG8_BAR; PG8_SCHED;
            PG8_LDA(At, 1, 1); PG8_STAGE(PG8_SB(1, 0), b3, voffB); PG8_STAGE(PG8_SB(1, 1), b3 + hstep, voffB); PG8_STAGE(PG8_SA(1, 0), a3, vo2[0]);
            PG8_WAIT_V(8); PG8_WAIT_L(0); PG8_BAR; PG8_MMA(1, 0, At, B0); PG8_MMA(1, 1, At, B1); PG8_BAR; PG8_SCHED;
        }
        if (wr == 0) PG8_BAR;
        const bool keep = E(acc, cur, wr, wc, fr, fq);
        if (!has_next) break;
        if (!keep) {
#pragma unroll
            for (int a = 0; a < 2; ++a)
#pragma unroll
                for (int b = 0; b < 2; ++b)
#pragma unroll
                    for (int m = 0; m < 4; ++m)
#pragma unroll
                        for (int n = 0; n < 2; ++n) acc[a][b][m][n] = (f32x4){0.f, 0.f, 0.f, 0.f};
        }
        cur = nxt; cA = nA; cB = nB; ++ui;
        if (Sched::GATHER) {
#pragma unroll
            for (int h = 0; h < 2; ++h)
#pragma unroll
                for (int i = 0; i < 2; ++i) voC[h][i] = voN[h][i];
        } else { PG8_SETA(voC, cur); }
        PG8_SETLANE();
        if (wr == 1) PG8_BAR;
    }
    PG8_WAIT_V(0);
    PG8_BAR;
#undef PG8_SA
#undef PG8_SB
#undef PG8_STAGE
#undef PG8_LDA
#undef PG8_LDB
#undef PG8_MMA
#undef PG8_WAIT_V
#undef PG8_WAIT_L
#undef PG8_BAR
#undef PG8_SCHED
#undef PG8_SETA
#undef PG8_SETLANE
}
}

struct Args { const float* in[25]; float* out; unsigned char* ws; int ph_lo, ph_hi; };
enum { I_X = 0, I_C, I_WADA, I_BADA, I_N1G, I_WIN, I_LQ1, I_LK1, I_LQ2, I_LK2, I_SUBG, I_LBL, I_HGNG, I_WUPDA, I_WUPHG, I_WOUT, I_N2G, I_WRG, I_BRG, I_WRE, I_BRE, I_W1, I_W3, I_W2, I_FG };

struct DenseOrder {
    static constexpr bool GATHER = false;
    const char* A; const char* Bt; int K, nM, nN, G, c;
    __device__ __forceinline__ bool next(int i, pg8::Unit& u) const {
        const int L = i * G + c, nwg = nM * nN; if (L >= nwg) return false;
        int wgid = L; { const int q = nwg / 8, r = nwg % 8, xcd = wgid % 8, off = wgid / 8; wgid = (xcd < r ? xcd * (q + 1) : r * (q + 1) + (xcd - r) * q) + off; }
        const int nig = 8 * nN, gid = wgid / nig, fm = gid * 8, gsz = (nM - fm) < 8 ? (nM - fm) : 8;
        u.pm = fm + ((wgid % nig) % gsz); u.pn = (wgid % nig) / gsz; u.A = A; u.B = Bt + (size_t)u.pn * 256 * K * 2; u.aux = 0; return true;
    }
    __device__ __forceinline__ void a_ready(const pg8::Unit&) const {}
    __device__ __forceinline__ unsigned arow(const pg8::Unit& u, int r) const { return (unsigned)(u.pm * 256 + r); }
};
struct UpOrder {
    static constexpr bool GATHER = false;
    const char* A0; const char* A1; const char* B0; const char* B1; int G, c;
    __device__ __forceinline__ bool next(int i, pg8::Unit& u) const {
        const int tile = (i >> 1) * G + c; if (tile >= 256) return false;
        u.pm = tile >> 2; u.pn = tile & 3; u.aux = i & 1;
        u.A = (i & 1) ? A1 : A0; u.B = ((i & 1) ? B1 : B0) + (size_t)u.pn * 256 * 512 * 2; return true;
    }
    __device__ __forceinline__ void a_ready(const pg8::Unit&) const {}
    __device__ __forceinline__ unsigned arow(const pg8::Unit& u, int r) const { return (unsigned)(u.pm * 256 + r); }
};
struct MoeTab { int nt; int pad[3]; int tile_e[176]; int tile_m[176]; int cnt[32]; int tbase[33]; };
struct Moe1Order {
    static constexpr bool GATHER = true;
    const LAS MoeTab* tab; const char* A; const char* W; const int* toklist; int G, c;
    __device__ __forceinline__ bool next(int i, pg8::Unit& u) const {
        const int L = i * G + c; if (L >= tab->nt * 4) return false;
        const int ti = L >> 2; u.pm = ti; u.pn = L & 3; u.aux = ti; u.A = A;
        u.B = W + ((size_t)tab->tile_e[ti] * 1024 + (size_t)u.pn * 256) * 1024 * 2; return true;
    }
    __device__ __forceinline__ void a_ready(const pg8::Unit&) const {}
    __device__ __forceinline__ unsigned arow(const pg8::Unit& u, int r) const {
        const int e = tab->tile_e[u.aux], rr = tab->tile_m[u.aux] * 256 + r;
        return rr < tab->cnt[e] ? (unsigned)toklist[e * T + rr] : 0u;
    }
};
struct Moe2Order {
    static constexpr bool GATHER = false;
    const LAS MoeTab* tab; const char* A; const char* W; unsigned* done; unsigned* tmo; int G, c;
    __device__ __forceinline__ bool next(int i, pg8::Unit& u) const {
        const int n1 = tab->nt * 4, r = n1 % G, nl = G - r; int j;
        if (r > 0 && c >= r) { if (i < 2) j = (c - r) + i * nl; else j = 2 * nl + (c - r) + (i - 2) * G; }
        else j = (r > 0 ? 2 * nl : 0) + ((c - r + G) % G) + i * G;
        if (j >= n1) return false;
        const int ti = j >> 2; u.pm = ti; u.pn = j & 3; u.aux = ti; u.A = A;
        u.B = W + ((size_t)tab->tile_e[ti] * 1024 + (size_t)u.pn * 256) * 512 * 2; return true;
    }
    __device__ __forceinline__ unsigned arow(const pg8::Unit& u, int r) const { return (unsigned)(u.pm * 256 + r); }
    __device__ __forceinline__ void a_ready(const pg8::Unit& u) const {
        if (threadIdx.x < 64) {
            unsigned polls = 0;
            while ((unsigned)__builtin_amdgcn_readfirstlane(__hip_atomic_load(done + 16 * u.pm, __ATOMIC_RELAXED, __HIP_MEMORY_SCOPE_AGENT)) < 32u) {
                if (++polls > (1u << 22)) { if (threadIdx.x == 0) __hip_atomic_store(tmo, 1u, __ATOMIC_RELAXED, __HIP_MEMORY_SCOPE_AGENT); break; }
                __builtin_amdgcn_s_sleep(2); }
            __builtin_amdgcn_fence(__ATOMIC_ACQUIRE, "agent");
            asm volatile("s_waitcnt vmcnt(0)" ::: "memory");
        }
        asm volatile("" ::: "memory"); __builtin_amdgcn_s_barrier(); asm volatile("" ::: "memory");
    }
};

using pg8::Unit; using pg8::cvt_pk_bf16;
struct EpiStoreBf16 {
    static constexpr bool PERM = true;
    bf16_t* O; int ldc; int nscale; float scale0;
    __device__ __forceinline__ bool operator()(f32x4 (&acc)[2][2][4][2], const Unit& u, int wr, int wc, int fr, int fq) const {
        const int row0 = u.pm * 256 + wr * 64 + fr, col0 = u.pn * 256 + wc * 32 + 8 * fq;
        const float sc = u.pn < nscale ? scale0 : 1.0f;
#pragma unroll
        for (int ai = 0; ai < 2; ++ai)
#pragma unroll
            for (int m = 0; m < 4; ++m) { bf16_t* rowp = O + (size_t)(row0 + ai * 128 + m * 16) * ldc + col0;
#pragma unroll
                for (int bj = 0; bj < 2; ++bj) { const f32x4 v0 = acc[ai][bj][m][0] * sc, v1 = acc[ai][bj][m][1] * sc;
                    u32x4 w; w.x = cvt_pk_bf16(v0[0], v0[1]); w.y = cvt_pk_bf16(v0[2], v0[3]); w.z = cvt_pk_bf16(v1[0], v1[1]); w.w = cvt_pk_bf16(v1[2], v1[3]);
                    *(u32x4*)(rowp + bj * 128) = w; } }
        return false;
    }
};
template <int N> __device__ __forceinline__ float dpp_shr(float x) { return __builtin_bit_cast(float, __builtin_amdgcn_update_dpp(0, __builtin_bit_cast(int, x), 0x110 + N, 0xf, 0xf, true)); }
template <int N> __device__ __forceinline__ float dpp_ror(float x) { return __builtin_bit_cast(float, __builtin_amdgcn_update_dpp(0, __builtin_bit_cast(int, x), 0x120 + N, 0xf, 0xf, true)); }
__device__ __forceinline__ float rowsum16(float x) { x += dpp_ror<8>(x); x += dpp_ror<4>(x); x += dpp_ror<2>(x); x += dpp_ror<1>(x); return x; }
__device__ __forceinline__ float scan16(float x) { x += dpp_shr<1>(x); x += dpp_shr<2>(x); x += dpp_shr<4>(x); x += dpp_shr<8>(x); return x; }
struct EpiInProj {
    static constexpr bool PERM = true;
    bf16_t* O; bf16_t* KE; float* DEC; const float* lbv; float scale0;
    __device__ __forceinline__ bool operator()(f32x4 (&acc)[2][2][4][2], const Unit& u, int wr, int wc, int fr, int fq) const {
        { const int l_ = lane_now(); fr = l_ & 15; fq = l_ >> 4; }
        const int row0 = u.pm * 256 + wr * 64 + fr, col0 = u.pn * 256 + wc * 32 + 8 * fq;
        if (u.pn >= 6 && u.pn < 10) {
            const int h = u.pn - 6, lane = 16 * fq + fr, kb = wc * 32 + 8 * fq;
            const int bb = (u.pm * 256) / SEQ, ch0 = ((u.pm * 256) % SEQ + wr * 64) >> 6;
            const f32x4 lb0 = *(const f32x4*)(lbv + h * 128 + kb), lb1 = *(const f32x4*)(lbv + h * 128 + kb + 4);
#pragma unroll
            for (int ai = 0; ai < 2; ++ai) {
                unsigned kep[4][4];
#pragma unroll
                for (int n = 0; n < 2; ++n) {
#pragma unroll
                    for (int ep = 0; ep < 2; ++ep) {
                        float ke2[2][4];
#pragma unroll
                        for (int z = 0; z < 2; ++z) {
                            const int e = 2 * ep + z; const float lb = n ? lb1[e] : lb0[e];
                            float f[4], c[4], tot[4];
#pragma unroll
                            for (int m = 0; m < 4; ++m) { const float fl = acc[ai][1][m][n][e]; f[m] = lb + (1.0f - lb) * __builtin_amdgcn_rcpf(1.0f + __builtin_amdgcn_exp2f(-1.4426950408889634f * fl)); const float lf = __logf(f[m]); c[m] = scan16(lf); tot[m] = rowsum16(lf); }
                            const float alast = (tot[0] + tot[1]) + (tot[2] + tot[3]); const float eal = __expf(alast);
                            float pre = 0.f;
#pragma unroll
                            for (int m = 0; m < 4; ++m) { const float A = c[m] + pre; pre += tot[m]; const float q = acc[ai][0][m][n][e]; const float kk = 1.0f - f[m];
                                acc[ai][0][m][n][e] = q * __builtin_amdgcn_rcpf(1.0f + __builtin_amdgcn_exp2f(-1.4426950408889634f * q)) * __expf(A);
                                const float kd = kk * __expf(-A); acc[ai][1][m][n][e] = kd; ke2[z][m] = kd * eal; }
                            if (fr == 0) DEC[((size_t)(bb * 4 + h) * 64 + ch0 + 2 * ai) * 128 + kb + 4 * n + e] = eal;
                        }
#pragma unroll
                        for (int m = 0; m < 4; ++m) kep[m][2 * n + ep] = cvt_pk_bf16(ke2[0][m], ke2[1][m]);
                    }
                }
#pragma unroll
                for (int m = 0; m < 4; ++m) *(u32x4*)(KE + (size_t)(row0 + ai * 128 + m * 16) * 512 + h * 128 + kb) = (u32x4){kep[m][0], kep[m][1], kep[m][2], kep[m][3]};
            }
        }
        const float sc = u.pn < 2 ? scale0 : 1.0f;
#pragma unroll
        for (int ai = 0; ai < 2; ++ai)
#pragma unroll
            for (int m = 0; m < 4; ++m) { bf16_t* rowp = O + (size_t)(row0 + ai * 128 + m * 16) * INC + col0;
#pragma unroll
                for (int bj = 0; bj < 2; ++bj) { const f32x4 v0 = acc[ai][bj][m][0] * sc, v1 = acc[ai][bj][m][1] * sc;
                    u32x4 w; w.x = cvt_pk_bf16(v0[0], v0[1]); w.y = cvt_pk_bf16(v0[2], v0[3]); w.z = cvt_pk_bf16(v1[0], v1[1]); w.w = cvt_pk_bf16(v1[2], v1[3]);
                    *(u32x4*)(rowp + bj * 128) = w; } }
        return false;
    }
};
struct EpiUp {
    static constexpr bool PERM = true;
    const bf16_t* proj; bf16_t* O;
    __device__ __forceinline__ bool operator()(f32x4 (&acc)[2][2][4][2], const Unit& u, int wr, int wc, int fr, int fq) const {
        const int row0 = u.pm * 256 + wr * 64 + fr, col0 = u.pn * 256 + wc * 32 + 8 * fq;
#pragma unroll
        for (int ai = 0; ai < 2; ++ai)
#pragma unroll
            for (int m = 0; m < 4; ++m) { const size_t row = (size_t)(row0 + ai * 128 + m * 16);
#pragma unroll
                for (int bj = 0; bj < 2; ++bj) {
                    const int col = col0 + bj * 128;
                    const u32x4 gh = *(const u32x4*)(proj + row * INC + C_GHGATE + col);
                    float sh[8];
#pragma unroll
                    for (int j = 0; j < 4; ++j) { sh[2 * j] = 1.0f + __builtin_amdgcn_exp2f(-1.4426950408889634f * bf2f(gh[j] & 0xffffu)); sh[2 * j + 1] = 1.0f + __builtin_amdgcn_exp2f(-1.4426950408889634f * bf2f(gh[j] >> 16)); }
                    if (u.aux == 0) {
                        const u32x4 gd = *(const u32x4*)(proj + row * INC + C_GDA + col);
#pragma unroll
                        for (int j = 0; j < 4; ++j) {
                            const float d0 = 1.0f + __builtin_amdgcn_exp2f(-1.4426950408889634f * bf2f(gd[j] & 0xffffu)), d1 = 1.0f + __builtin_amdgcn_exp2f(-1.4426950408889634f * bf2f(gd[j] >> 16));
                            const float r0 = sh[2 * j] * __builtin_amdgcn_rcpf(d0), r1 = sh[2 * j + 1] * __builtin_amdgcn_rcpf(d1);
                            if (j < 2) { acc[ai][bj][m][0][2 * j] *= r0; acc[ai][bj][m][0][2 * j + 1] *= r1; }
                            else { acc[ai][bj][m][1][2 * j - 4] *= r0; acc[ai][bj][m][1][2 * j - 3] *= r1; }
                        }
                    } else {
                        const f32x4 v0 = acc[ai][bj][m][0], v1 = acc[ai][bj][m][1];
#pragma unroll
                        for (int j = 0; j < 8; ++j) sh[j] = __builtin_amdgcn_rcpf(sh[j]);
                        u32x4 w; w.x = cvt_pk_bf16(v0[0] * sh[0], v0[1] * sh[1]); w.y = cvt_pk_bf16(v0[2] * sh[2], v0[3] * sh[3]);
                        w.z = cvt_pk_bf16(v1[0] * sh[4], v1[1] * sh[5]); w.w = cvt_pk_bf16(v1[2] * sh[6], v1[3] * sh[7]);
                        *(u32x4*)(O + row * D + col) = w;
                    }
                } }
        return u.aux == 0;
    }
};
struct EpiOut {
    static constexpr bool PERM = true;
    const float* x; const float* mod; bf16_t* O;
    __device__ __forceinline__ bool operator()(f32x4 (&acc)[2][2][4][2], const Unit& u, int wr, int wc, int fr, int fq) const {
        const int row0 = u.pm * 256 + wr * 64 + fr, col0 = u.pn * 256 + wc * 32 + 8 * fq;
        const int b = (u.pm * 256) / SEQ;
        f32x4 gt[2][2];
#pragma unroll
        for (int bj = 0; bj < 2; ++bj)
#pragma unroll
            for (int n = 0; n < 2; ++n) gt[bj][n] = *(const f32x4*)(mod + b * 6144 + 2048 + col0 + bj * 128 + n * 4);
#pragma unroll
        for (int ai = 0; ai < 2; ++ai)
#pragma unroll
            for (int m = 0; m < 4; ++m) { const size_t off = (size_t)(row0 + ai * 128 + m * 16) * D + col0;
#pragma unroll
                for (int bj = 0; bj < 2; ++bj) { const f32x4 x0 = *(const f32x4*)(x + off + bj * 128), x1 = *(const f32x4*)(x + off + bj * 128 + 4);
                    const f32x4 v0 = x0 + gt[bj][0] * acc[ai][bj][m][0], v1 = x1 + gt[bj][1] * acc[ai][bj][m][1];
                    u32x4 w; w.x = cvt_pk_bf16(v0[0], v0[1]); w.y = cvt_pk_bf16(v0[2], v0[3]); w.z = cvt_pk_bf16(v1[0], v1[1]); w.w = cvt_pk_bf16(v1[2], v1[3]);
                    *(u32x4*)(O + off + bj * 128) = w; } }
        return false;
    }
};
struct EpiMoe1 {
    static constexpr bool PERM = true;
    bf16_t* O; unsigned* done;
    __device__ __forceinline__ bool operator()(f32x4 (&acc)[2][2][4][2], const Unit& u, int wr, int wc, int fr, int fq) const {
        const int row0 = u.pm * 256 + wr * 64 + fr, col0 = u.pn * 128 + wc * 32 + 8 * fq;
#pragma unroll
        for (int ai = 0; ai < 2; ++ai)
#pragma unroll
            for (int m = 0; m < 4; ++m) { bf16_t* rowp = O + (size_t)(row0 + ai * 128 + m * 16) * DEXP + col0;
                float h[8];
#pragma unroll
                for (int n = 0; n < 2; ++n)
#pragma unroll
                    for (int e = 0; e < 4; ++e) { const float x_ = acc[ai][0][m][n][e]; h[n * 4 + e] = x_ * __builtin_amdgcn_rcpf(1.0f + __builtin_amdgcn_exp2f(-1.4426950408889634f * x_)) * acc[ai][1][m][n][e]; }
                u32x4 w; w.x = cvt_pk_bf16(h[0], h[1]); w.y = cvt_pk_bf16(h[2], h[3]); w.z = cvt_pk_bf16(h[4], h[5]); w.w = cvt_pk_bf16(h[6], h[7]);
                asm volatile("global_store_dwordx4 %0, %1, off sc1\n\ts_nop 1" :: "v"(rowp), "v"(w) : "memory"); }
        asm volatile("s_waitcnt vmcnt(0)" ::: "memory");
        if ((threadIdx.x & 63) == 0) __hip_atomic_fetch_add(done + 16 * u.pm, 1u, __ATOMIC_RELAXED, __HIP_MEMORY_SCOPE_AGENT);
        return false;
    }
};

struct Frame { LAS unsigned char* lds; int tid, lane, wave, G, bid; };

__device__ __forceinline__ void transpose_item(const float* Wsrc, int ldw, bf16_t* dst, int ldd, LAS float* scr, int lane) {
#pragma unroll 8
    for (int i = 0; i < 32; ++i) { const int kk = 2 * i + (lane >> 5); scr[kk * 33 + (lane & 31)] = __builtin_nontemporal_load(Wsrc + (size_t)kk * ldw + (lane & 31)); }
    asm volatile("s_waitcnt lgkmcnt(0)" ::: "memory");
    const int c = lane & 7;
#pragma unroll
    for (int j = 0; j < 4; ++j) { const int n = (lane >> 3) + 8 * j; const LAS float* s = scr + (8 * c) * 33 + n;
        u32x4 o; o.x = pk2(s[0 * 33], s[1 * 33]); o.y = pk2(s[2 * 33], s[3 * 33]); o.z = pk2(s[4 * 33], s[5 * 33]); o.w = pk2(s[6 * 33], s[7 * 33]);
        *(u32x4*)(dst + (size_t)n * ldd + 8 * c) = o; }
    asm volatile("s_waitcnt lgkmcnt(0)" ::: "memory");
}
struct TItem { const float* src; bf16_t* dst; int ldw, ldd; };
template <class ItemFn>
__device__ __forceinline__ void transpose_stream(int it_lo, int it_hi, int gw, int NGW, LAS float* scr, int lane, ItemFn item) {
    int it = it_lo + gw; if (it >= it_hi) return;
    TItem cur = item(it);
    float v[32];
    const int l31 = lane & 31, lh = lane >> 5;
#pragma unroll
    for (int i = 0; i < 32; ++i) v[i] = __builtin_nontemporal_load(cur.src + (size_t)(2 * i + lh) * cur.ldw + l31);
    while (true) {
#pragma unroll
        for (int i = 0; i < 32; ++i) scr[(2 * i + lh) * 33 + l31] = v[i];
        const int nx = it + NGW; const bool more = nx < it_hi; TItem nxt = cur;
        if (more) { nxt = item(nx);
#pragma unroll
            for (int i = 0; i < 32; ++i) v[i] = __builtin_nontemporal_load(nxt.src + (size_t)(2 * i + lh) * nxt.ldw + l31); }
        asm volatile("s_waitcnt lgkmcnt(0)" ::: "memory");
        const int c = lane & 7;
#pragma unroll
        for (int j = 0; j < 4; ++j) { const int n = (lane >> 3) + 8 * j; const LAS float* s_ = scr + (8 * c) * 33 + n;
            u32x4 o; o.x = pk2(s_[0 * 33], s_[1 * 33]); o.y = pk2(s_[2 * 33], s_[3 * 33]); o.z = pk2(s_[4 * 33], s_[5 * 33]); o.w = pk2(s_[6 * 33], s_[7 * 33]);
            *(u32x4*)(cur.dst + (size_t)n * cur.ldd + 8 * c) = o; }
        asm volatile("s_waitcnt lgkmcnt(0)" ::: "memory");
        if (!more) break;
        cur = nxt; it = nx;
    }
}
__device__ __forceinline__ void transpose_matrix(const Frame& F, const float* W, int K, int N, bf16_t* WT) {
    LAS float* scr = (LAS float*)(F.lds + F.wave * 8448);
    const int gw = F.bid * NWAVES + F.wave, NGW = F.G * NWAVES, nblk = N / 32, items = (K / 64) * nblk;
    transpose_stream(0, items, gw, NGW, scr, F.lane, [=](int it) { const int kb = it / nblk, nb = it % nblk;
        return TItem{W + (size_t)(64 * kb) * N + 32 * nb, WT + (size_t)(32 * nb) * K + 64 * kb, N, K}; });
}

__device__ __forceinline__ void phase0(const Frame& F, const Args& a) {
    unsigned char* ws = a.ws;
    {
        float* mod = (float*)(ws + WS_MOD);
        const float* c = a.in[I_C]; const float* wada = a.in[I_WADA]; const float* bada = a.in[I_BADA];
        LAS f32x4* cs4 = (LAS f32x4*)(F.lds + 72 * 1024);
        LAS float* red = (LAS float*)(F.lds + 72 * 1024 + 16 * 1024);
        for (int i = F.tid; i < 4 * D; i += NTHR) ((LAS float*)cs4)[(i & (D - 1)) * 4 + (i >> 10)] = siluf_(c[i]);
        __syncthreads();
        for (int cb = F.bid; cb < 6144 / 32; cb += F.G) {
            const int l15 = F.lane & 15, lq = F.lane >> 4, k0 = 128 * F.wave + lq;
            const float* wp = wada + (size_t)k0 * 6144 + cb * 32 + 2 * l15;
            f32x2 wv[32];
#pragma unroll
            for (int i = 0; i < 32; ++i) wv[i] = __builtin_nontemporal_load((const f32x2*)(wp + (size_t)(4 * i) * 6144));
            f32x2 s[4] = {{0.f, 0.f}, {0.f, 0.f}, {0.f, 0.f}, {0.f, 0.f}};
#pragma unroll
            for (int i = 0; i < 32; ++i) { const f32x4 cv = cs4[k0 + 4 * i];
#pragma unroll
                for (int b = 0; b < 4; ++b) s[b] += wv[i] * cv[b]; }
#pragma unroll
            for (int b = 0; b < 4; ++b) { f32x2 t = s[b];
                t.x += __shfl_xor(t.x, 16); t.y += __shfl_xor(t.y, 16); t.x += __shfl_xor(t.x, 32); t.y += __shfl_xor(t.y, 32);
                if (lq == 0) *(LAS f32x2*)(red + (F.wave * 4 + b) * 32 + 2 * l15) = t; }
            __syncthreads();
            if (F.tid < 128) { const int b = F.tid >> 5, cc = F.tid & 31; float t = bada[cb * 32 + cc];
#pragma unroll
                for (int w = 0; w < 8; ++w) t += red[(w * 4 + b) * 32 + cc];
                mod[b * 6144 + cb * 32 + cc] = t; }
            __syncthreads();
        }
    }
    if (F.bid == 0) {
        float* sm = (float*)(ws + WS_SMALL);
        if (F.tid == 0) {
            float s1 = 0.f, s2 = 0.f;
            for (int i = 0; i < 64; ++i) { s1 += a.in[I_LQ1][i] * a.in[I_LK1][i]; s2 += a.in[I_LQ2][i] * a.in[I_LK2][i]; }
            sm[0] = expf(s1) - expf(s2) + 0.2f;
        }
        { const float l0 = a.in[I_LBL][F.tid], l1 = a.in[I_LBL][512 + F.tid]; const float mx = fmaxf(l0, l1);
          const float e0 = expf(l0 - mx), e1 = expf(l1 - mx); sm[16 + F.tid] = e0 / (e0 + e1); }
    }
}
__device__ __forceinline__ void moe_w2_convert(const Frame& F, const Args& a, int it_lo, int it_hi, int gw, int NGW) {
    LAS float* scr = (LAS float*)(F.lds + F.wave * 8448);
    bf16_t* w2t = (bf16_t*)((unsigned char*)a.out + OUT_W2); const float* w2 = a.in[I_W2];
    transpose_stream(it_lo, it_hi, gw, NGW, scr, F.lane, [=](int it) { const int e = it >> 8, kb = (it >> 5) & 7, nb = it & 31;
        return TItem{w2 + (size_t)e * 512 * 1024 + (size_t)(64 * kb) * 1024 + 32 * nb, w2t + ((size_t)e * 1024 + 32 * nb) * 512 + 64 * kb, 1024, 512}; });
}
__device__ __forceinline__ int w2_early_items(int G, int& n_light) { const int nwg = (T / 256) * (INC / 256), r = nwg % G; n_light = r ? G - r : 0; return n_light >= 64 ? W2_EARLY * 256 : 0; }
__device__ __forceinline__ void moe_weight_convert(const Frame& F, const Args& a) {
    LAS float* scr = (LAS float*)(F.lds + F.wave * 8448);
    const int gw = F.bid * NWAVES + F.wave, NGW = F.G * NWAVES;
    bf16_t* w13 = (bf16_t*)(a.ws + WS_W13);
    const float* w1 = a.in[I_W1]; const float* w3 = a.in[I_W3];
    transpose_stream(0, 2 * NEXP * 256, gw, NGW, scr, F.lane, [=](int it) {
        const int which = it / (NEXP * 256), r = it % (NEXP * 256), e = r >> 8, kb = (r >> 4) & 15, nb = r & 15, n0 = 32 * nb;
        const float* W = (which ? w3 : w1) + (size_t)e * 1024 * 512;
        const int drow = 256 * (n0 >> 7) + (which ? 128 : 0) + (n0 & 127);
        return TItem{W + (size_t)(64 * kb) * 512 + n0, w13 + ((size_t)e * 1024 + drow) * 1024 + 64 * kb, 512, 1024}; });
    int nl; const int early = w2_early_items(F.G, nl);
    moe_w2_convert(F, a, early, NEXP * 256, gw, NGW);
}

__device__ __forceinline__ void dense_weight_convert(const Frame& F, const Args& a) {
    unsigned char* ws = a.ws;
    {
        LAS float* scr = (LAS float*)(F.lds + F.wave * 8448);
        const int gw = F.bid * NWAVES + F.wave, NGW = F.G * NWAVES, nblk = INC / 32, items = (D / 64) * nblk;
        bf16_t* WT = (bf16_t*)(ws + WS_WIN);
        const float* win = a.in[I_WIN];
        transpose_stream(0, items, gw, NGW, scr, F.lane, [=](int it) { const int kb = it / nblk, n0 = 32 * (it % nblk); int dr = n0;
            if (n0 >= C_QHG && n0 < C_FHG) dr = C_HGT + 256 * ((n0 - C_QHG) >> 7) + ((n0 - C_QHG) & 127);
            else if (n0 >= C_FHG && n0 < C_IHG) dr = C_HGT + 256 * ((n0 - C_FHG) >> 7) + 128 + ((n0 - C_FHG) & 127);
            return TItem{win + (size_t)(64 * kb) * INC + n0, WT + (size_t)dr * D + 64 * kb, INC, D}; });
    }
    transpose_matrix(F, a.in[I_WUPDA], 512, D, (bf16_t*)(ws + WS_WUPDA));
    transpose_matrix(F, a.in[I_WUPHG], 512, D, (bf16_t*)(ws + WS_WUPHG));
    transpose_matrix(F, a.in[I_WOUT], D, D, (bf16_t*)(ws + WS_WOUT));
}
__device__ __forceinline__ void phase1(const Frame& F, const Args& a) {
    const float* mod = (const float*)(a.ws + WS_MOD);
    LAS float* Gs = (LAS float*)F.lds;
    LAS float* Ss = Gs + 1024;
    bf16_t* H = (bf16_t*)(a.ws + WS_ACT);
    const int rows_per_blk = T / F.G;
    const int r0 = F.bid * rows_per_blk, b = r0 / SEQ;
    for (int k = F.tid; k < 1024; k += NTHR) { Gs[k] = a.in[I_N1G][k] * (1.0f + mod[b * 6144 + 1024 + k]); Ss[k] = mod[b * 6144 + k]; }
    __syncthreads();
    for (int rb = r0 + F.wave; rb < r0 + rows_per_blk; rb += 4 * NWAVES) {
        f32x4 v[4][4];
#pragma unroll
        for (int q = 0; q < 4; ++q) { const int r = rb + q * NWAVES < r0 + rows_per_blk ? rb + q * NWAVES : rb; const f32x4* xr = (const f32x4*)(a.in[I_X] + (size_t)r * D) + F.lane;
#pragma unroll
            for (int j = 0; j < 4; ++j) v[q][j] = __builtin_nontemporal_load(xr + 64 * j); }
#pragma unroll
        for (int q = 0; q < 4; ++q) { const int r = rb + q * NWAVES; if (r >= r0 + rows_per_blk) break;
            float s = 0.f;
#pragma unroll
            for (int j = 0; j < 4; ++j) s += (v[q][j].x * v[q][j].x + v[q][j].y * v[q][j].y) + (v[q][j].z * v[q][j].z + v[q][j].w * v[q][j].w);
            const float rs = rsqrtf(wave_sum(s) * (1.0f / D) + EPS);
            unsigned long long* o8 = (unsigned long long*)(H + (size_t)r * D) + F.lane;
#pragma unroll
            for (int j = 0; j < 4; ++j) { const f32x4 g = *(const LAS f32x4*)(Gs + 256 * j + 4 * F.lane), sh = *(const LAS f32x4*)(Ss + 256 * j + 4 * F.lane);
                const f32x4 h = v[q][j] * rs * g + sh;
                o8[64 * j] = (unsigned long long)pk2(h.x, h.y) | ((unsigned long long)pk2(h.z, h.w) << 32); } }
    }
}

namespace attn_body {
using s16x4=__attribute__((ext_vector_type(4)))short;
using f32x16=__attribute__((ext_vector_type(16)))float;
constexpr int NW=8,QBLK=32,QB=QBLK*NW,KVBLK=64,NQB=SEQ/QB;
constexpr int PIN=INC, POUT=1024;
__device__ __forceinline__ int crow(int r,int hi){return (r&3)+8*(r>>2)+4*hi;}
#define SBAR() __builtin_amdgcn_sched_barrier(0)
__device__ __forceinline__ void bmask(f32x16&p0,f32x16&p1,int jb,int wch,int il,int hi,float s2x2){
  if(jb>wch){
    #pragma unroll
    for(int r=0;r<16;++r){p0[r]=-INFINITY;p1[r]=-INFINITY;}
  } else if(jb==wch){
    float fb=(float)(4*hi-il); asm volatile("":"+v"(fb));
    #pragma unroll
    for(int r=0;r<16;++r){const float c=(float)((r&3)+8*(r>>2)); p0[r]-=s2x2*__builtin_fmaxf(fb+c,0.f); p1[r]-=s2x2*__builtin_fmaxf(fb+(c+32.f),0.f);}
  }
}
constexpr int NSLOT=3, SLOTB=8192, VSLOTB=16384;
constexpr int LDS_K=0, LDS_V=NSLOT*SLOTB, LDS_WS=LDS_V+NSLOT*VSLOTB, LDS_OST=LDS_WS+NW*64*4, ATT_LDS_BYTES=LDS_OST+NW*8192;
constexpr float C2=0.125f*1.4426950408889634f;
__device__ __forceinline__ void glds16(const void*gsrc,unsigned lds_dst){unsigned keep;
  asm volatile("s_mov_b32 %0, m0\n\ts_mov_b32 m0, %2\n\ts_nop 0\n\tglobal_load_lds_dwordx4 %1, off\n\ts_mov_b32 m0, %0":"=&s"(keep):"v"(gsrc),"s"(lds_dst):"memory");}
__device__ __forceinline__ float max3f(float a,float b,float c){float r;asm("v_max3_f32 %0, %1, %2, %3":"=v"(r):"v"(a),"v"(b),"v"(c));return r;}
__device__ __forceinline__ float max2f(float a,float b){float r;asm("v_max_f32_e32 %0, %1, %2":"=v"(r):"v"(a),"v"(b));return r;}
__device__ __forceinline__ float fadd_s(float a,float b){float r;asm("v_add_f32_e32 %0, %1, %2":"=v"(r):"v"(a),"v"(b));return r;}
__device__ __forceinline__ float fsub_s(float a,float b){float r;asm("v_sub_f32_e32 %0, %1, %2":"=v"(r):"v"(a),"v"(b));return r;}
typedef float f32x2_t __attribute__((ext_vector_type(2))); typedef __bf16 bf16x2_t __attribute__((ext_vector_type(2)));
__device__ __forceinline__ unsigned cvtpk_s(float lo,float hi){f32x2_t v={lo,hi};bf16x2_t b=__builtin_convertvector(v,bf16x2_t);return __builtin_bit_cast(unsigned,b);}
#define WAIT_BAR(N) asm volatile("s_waitcnt vmcnt(" #N ") lgkmcnt(0)\n\ts_barrier":::"memory")

__device__ __forceinline__ void qkt(f32x16&p0,f32x16&p1,const char*Kslot,const bf16x8*qr,const f32x16&c0,const f32x16&c1,int r32,int hi){
  const char*kb=Kslot+hi*1024+r32*16;
  #pragma unroll
  for(int d0=0;d0<4;++d0){
    const bf16x8 b0=*reinterpret_cast<const bf16x8*>(kb+d0*2048);
    const bf16x8 b1=*reinterpret_cast<const bf16x8*>(kb+d0*2048+512);
    if(d0==0){p0=__builtin_amdgcn_mfma_f32_32x32x16_bf16(b0,qr[0],c0,0,0,0);p1=__builtin_amdgcn_mfma_f32_32x32x16_bf16(b1,qr[0],c1,0,0,0);}
    else{p0=__builtin_amdgcn_mfma_f32_32x32x16_bf16(b0,qr[d0],p0,0,0,0);p1=__builtin_amdgcn_mfma_f32_32x32x16_bf16(b1,qr[d0],p1,0,0,0);}}
}
typedef __attribute__((address_space(3))) const char* lds_cptr;
typedef short v4i16_t __attribute__((ext_vector_type(4)));
__device__ __forceinline__ void kload8(bf16x8*kf,lds_cptr kp){
  kf[0]=*(const __attribute__((address_space(3))) bf16x8*)(kp);      kf[1]=*(const __attribute__((address_space(3))) bf16x8*)(kp+512);
  kf[2]=*(const __attribute__((address_space(3))) bf16x8*)(kp+2048); kf[3]=*(const __attribute__((address_space(3))) bf16x8*)(kp+2560);
  kf[4]=*(const __attribute__((address_space(3))) bf16x8*)(kp+4096); kf[5]=*(const __attribute__((address_space(3))) bf16x8*)(kp+4608);
  kf[6]=*(const __attribute__((address_space(3))) bf16x8*)(kp+6144); kf[7]=*(const __attribute__((address_space(3))) bf16x8*)(kp+6656);
}
__device__ __forceinline__ void kload2(bf16x8*kf,lds_cptr kp,int j){ kf[2*j]=*(const __attribute__((address_space(3))) bf16x8*)(kp+j*2048); kf[2*j+1]=*(const __attribute__((address_space(3))) bf16x8*)(kp+j*2048+512); }
__device__ __forceinline__ s16x4 vtr(lds_cptr p){ return __builtin_bit_cast(s16x4,__builtin_amdgcn_ds_read_tr16_b64_v4i16((__attribute__((address_space(3))) v4i16_t*)p)); }
__device__ __forceinline__ float rowmax(const f32x16&p0,const f32x16&p1){
  float a=max3f(p0[0],p0[1],p1[0]),b=max3f(p0[2],p0[3],p1[1]);a=max3f(a,p1[2],p1[3]);
  #pragma unroll
  for(int r=4;r<16;r+=4){a=max3f(a,p0[r],p0[r+1]);b=max3f(b,p0[r+2],p0[r+3]);a=max3f(a,p1[r],p1[r+1]);b=max3f(b,p1[r+2],p1[r+3]);}
  const float m=max2f(a,b);
  auto rr=__builtin_amdgcn_permlane32_swap(__float_as_uint(m),__float_as_uint(m),false,false);
  return max2f(__uint_as_float(rr[0]),__uint_as_float(rr[1]));
}
__device__ __forceinline__ void pv(f32x16*o,int vb,bf16x8 pa0,bf16x8 pa1,bf16x8 pa2,bf16x8 pa3){
  #pragma unroll
  for(int d0=0;d0<4;++d0){s16x4 lo[4],hi[4];
    #pragma unroll
    for(int ks=0;ks<4;++ks){
      asm volatile("ds_read_b64_tr_b16 %0,%1 offset:%c2":"=&v"(lo[ks]):"v"(vb),"i"(d0*4096+ks*1024):"memory");
      asm volatile("ds_read_b64_tr_b16 %0,%1 offset:%c2":"=&v"(hi[ks]):"v"(vb),"i"(d0*4096+ks*1024+512):"memory");}
    asm volatile("s_waitcnt lgkmcnt(0)":::"memory");SBAR();
    #define PK(k) (bf16x8){lo[k][0],lo[k][1],lo[k][2],lo[k][3],hi[k][0],hi[k][1],hi[k][2],hi[k][3]}
    o[d0]=__builtin_amdgcn_mfma_f32_32x32x16_bf16(pa0,PK(0),o[d0],0,0,0);
    o[d0]=__builtin_amdgcn_mfma_f32_32x32x16_bf16(pa1,PK(1),o[d0],0,0,0);
    o[d0]=__builtin_amdgcn_mfma_f32_32x32x16_bf16(pa2,PK(2),o[d0],0,0,0);
    o[d0]=__builtin_amdgcn_mfma_f32_32x32x16_bf16(pa3,PK(3),o[d0],0,0,0);
    #undef PK
  }
}
#define ATTN_STORE16(p,v) (*(u32x4*)(p)=(v))
template<int THRL> __device__ __forceinline__ void attn_unit(int qb,const bf16_t*Qb,const bf16_t*__restrict__ Kh,const bf16_t*__restrict__ Vh,bf16_t*Ob,float slope2,char*shm){
  const int wid=__builtin_amdgcn_readfirstlane(threadIdx.x>>6); const int lane=lane_now(),r32=lane&31,hi=lane>>5;
  const int q0=qb*QB;
  const bf16_t*Qw=Qb+(long)(q0+wid*QBLK)*PIN;
  const unsigned lds0=(unsigned)(uintptr_t)shm;
  float*wsf=(float*)(shm+LDS_WS)+wid*64;
  const bf16_t*ksrc=Kh+(long)lane*PIN+wid*8;
  const bf16_t*vsrc=Vh+(long)(16*(wid&3)+(lane>>2))*PIN+(wid>>2)*32+(lane&3)*8;
  const unsigned kdst=lds0+LDS_K+wid*1024, vdst=lds0+LDS_V+(wid>>2)*4096+(wid&3)*1024;
  #define DMA_K(t,slot) glds16(ksrc+(long)(t)*KVBLK*PIN,(unsigned)__builtin_amdgcn_readfirstlane(kdst+(slot)))
  #define DMA_V(t,slot) do{ glds16(vsrc+(long)(t)*KVBLK*PIN,(unsigned)__builtin_amdgcn_readfirstlane(vdst+2*(slot))); glds16(vsrc+(long)(t)*KVBLK*PIN+64,(unsigned)__builtin_amdgcn_readfirstlane(vdst+2*(slot)+8192)); }while(0)
  const int vb0=(int)(lds0+LDS_V)+((lane>>4)&1)*32+(lane&3)*8+(4*hi+((lane&15)>>2))*64;
  const char*Kbase=shm+LDS_K; bf16x8 kf[8];
  const lds_cptr shm3=(lds_cptr)shm; const lds_cptr kp0=shm3+LDS_K+hi*1024+r32*16; const lds_cptr vp0=shm3+LDS_V+((lane>>4)&1)*32+(lane&3)*8+(4*hi+((lane&15)>>2))*64;
  const int NT=(q0+QB)/KVBLK;
  DMA_K(0,0);DMA_V(0,0);DMA_K(1,SLOTB);
  bf16x8 qr[4];
  #pragma unroll
  for(int d0=0;d0<4;++d0)qr[d0]=*reinterpret_cast<const bf16x8*>(&Qw[(long)r32*PIN+d0*16+hi*8]);
  float mhat=0.f,l_reg=0.f;f32x16 o[4];o[0]=f32x16{};o[1]=f32x16{};o[2]=f32x16{};o[3]=f32x16{};
  const float s64=slope2*64.f, s32=slope2*32.f, s2x2=2.f*slope2, s4hi=slope2*4.f*(float)hi;
  const int wch=wid>>1, il=32*(wid&1)+r32;
  #define CMASK(P0,P1,t) do{int jb_=(t)-(NT-4); if(jb_>=0)bmask(P0,P1,jb_,wch,il,hi,s2x2);}while(0)
  #define CINIT0(C0,t) do{ const float bt_=s64*(float)((t)-NT)-mhat+s4hi; _Pragma("unroll") for(int r=0;r<16;++r){C0[r]=__builtin_fmaf(slope2,(float)((r&3)+8*(r>>2)),bt_);} }while(0)
  #define CINIT1(C1,t) do{ const float bu_=s64*(float)((t)-NT)-mhat+s4hi+s32; _Pragma("unroll") for(int r=0;r<16;++r){C1[r]=__builtin_fmaf(slope2,(float)((r&3)+8*(r>>2)),bu_);} }while(0)
  bool resc=false;
  #define START(P0,P1) do{ const float rm=rowmax(P0,P1); resc=false; \
    { const float dl=rm; mhat=fadd_s(mhat,dl); \
      _Pragma("unroll") for(int r=0;r<16;++r){P0[r]=fsub_s(P0[r],dl);P1[r]=fsub_s(P1[r],dl);} } \
    _Pragma("unroll") for(int r=0;r<16;++r)P0[r]=__builtin_amdgcn_exp2f(P0[r]); }while(0)
  #define RESC() do{ if(resc){ asm volatile("s_waitcnt lgkmcnt(0)":::"memory"); \
      _Pragma("unroll") for(int d_=0;d_<4;++d_) _Pragma("unroll") for(int r=0;r<16;++r)o[d_][r]*=wsf[crow(r,hi)]; } }while(0)
  f32x16 cS0,cS1;
  u32x4 pwa0,pwa1,pwa2,pwa3,pwb0,pwb1,pwb2,pwb3;
  int sl_prev=0,sl_cur=0,sl_next=SLOTB;
  #define ROT() do{sl_prev=sl_cur;sl_cur=sl_next;sl_next=(sl_next==(NSLOT-1)*SLOTB)?0:sl_next+SLOTB;}while(0)
  #define PKW(P,B) cvtpk_s(P[B],P[B+1])
  DMA_K(2,2*SLOTB);
  WAIT_BAR(3);
  { f32x16 c0,c1; CINIT0(c0,0); CINIT1(c1,0); qkt(cS0,cS1,Kbase,qr,c0,c1,r32,hi); }
  asm volatile("s_nop 15\n\ts_nop 7":"+v"(cS0),"+v"(cS1));CMASK(cS0,cS1,0);
  START(cS0,cS1);
  _Pragma("unroll") for(int r=0;r<16;++r)cS1[r]=__builtin_amdgcn_exp2f(cS1[r]);
  { float sacc=cS0[0]+cS0[1]; _Pragma("unroll") for(int r=2;r<16;++r)sacc+=cS0[r]; _Pragma("unroll") for(int r=0;r<16;++r)sacc+=cS1[r]; l_reg+=sacc;
    pwa0=(u32x4){PKW(cS0,0),PKW(cS0,2),PKW(cS0,4),PKW(cS0,6)};pwa1=(u32x4){PKW(cS0,8),PKW(cS0,10),PKW(cS0,12),PKW(cS0,14)};pwa2=(u32x4){PKW(cS1,0),PKW(cS1,2),PKW(cS1,4),PKW(cS1,6)};pwa3=(u32x4){PKW(cS1,8),PKW(cS1,10),PKW(cS1,12),PKW(cS1,14)}; }
  WAIT_BAR(0);
  DMA_K(3,0);DMA_V(1,SLOTB);
  ROT();
  kload8(kf,kp0+sl_cur);
  WAIT_BAR(3);
  s16x4 vlo[4],vhi[4];
  #define CAT_(a,b) a##b
  #define CAT(a,b) CAT_(a,b)
  #define PAFC(P,k) __builtin_bit_cast(bf16x8,CAT(P,k))
  #define VFR(k) (bf16x8){vlo[(k)&3][0],vlo[(k)&3][1],vlo[(k)&3][2],vlo[(k)&3][3],vhi[(k)&3][0],vhi[(k)&3][1],vhi[(k)&3][2],vhi[(k)&3][3]}
  #define VOFF(k) ((k)<8 ? (((k)&1)*4096+((k)>>1)*1024) : ((2+((k)&1))*4096+(((k)-8)>>1)*1024))
  #define PIN_(x) asm volatile("":"+v"(x))
  #define MX3(a,b,c) __builtin_fmaxf(__builtin_fmaxf((a),(b)),(c))
  #define QK(MF) do{ MF; SBAR(); }while(0)
  #define EX(v) __builtin_amdgcn_exp2f(v)
  #define VRD(k) do{ vlo[(k)&3]=vtr(vp_+VOFF(k)); vhi[(k)&3]=vtr(vp_+(VOFF(k)+512)); }while(0)
  #define VNX(k) do{ if((k)+4<16){ VRD((k)+4); } SBAR(); }while(0)
  #define GAPB3(MF,X,B,PW,J) do{ MF; X[B]=EX(X[B]); X[B+1]=EX(X[B+1]); sacc+=X[B]; sacc+=X[B+1]; PW[J]=cvtpk_s(X[B],X[B+1]); PIN_(X); PIN_(sacc); PIN_(PW); SBAR(); }while(0)
  #define KRD(G,j) do{ if(G){ kload2(kf,kp0+sl_next,j); SBAR(); } }while(0)
  #define STEP(PC,PN,t,GK,GV,GL) do{ SBAR(); \
    CINIT0(cS0,t); SBAR(); \
    const lds_cptr vp_=vp0+2*sl_prev; \
    VRD(0); SBAR(); QK(cS0=__builtin_amdgcn_mfma_f32_32x32x16_bf16(kf[0],qr[0],cS0,0,0,0)); \
    CINIT1(cS1,t); VRD(1); SBAR(); QK(cS1=__builtin_amdgcn_mfma_f32_32x32x16_bf16(kf[1],qr[0],cS1,0,0,0)); \
    VRD(2); SBAR(); QK(cS0=__builtin_amdgcn_mfma_f32_32x32x16_bf16(kf[2],qr[1],cS0,0,0,0)); \
    VRD(3); SBAR(); QK(cS1=__builtin_amdgcn_mfma_f32_32x32x16_bf16(kf[3],qr[1],cS1,0,0,0)); \
    QK(cS0=__builtin_amdgcn_mfma_f32_32x32x16_bf16(kf[4],qr[2],cS0,0,0,0)); \
    QK(cS1=__builtin_amdgcn_mfma_f32_32x32x16_bf16(kf[5],qr[2],cS1,0,0,0)); \
    QK(cS0=__builtin_amdgcn_mfma_f32_32x32x16_bf16(kf[6],qr[3],cS0,0,0,0)); \
    QK(cS1=__builtin_amdgcn_mfma_f32_32x32x16_bf16(kf[7],qr[3],cS1,0,0,0)); \
    if(GK){DMA_K((t)+3,sl_cur);} if(GV){DMA_V((t)+1,sl_next);} \
    CMASK(cS0,cS1,t); \
    { float a=MX3(cS0[0],cS0[1],cS1[0]),b=MX3(cS0[2],cS0[3],cS1[1]); a=MX3(a,cS1[2],cS1[3]); \
      _Pragma("unroll") for(int r=4;r<16;r+=4){a=MX3(a,cS0[r],cS0[r+1]);b=MX3(b,cS0[r+2],cS0[r+3]);a=MX3(a,cS1[r],cS1[r+1]);b=MX3(b,cS1[r+2],cS1[r+3]);} \
      float rm=__builtin_fmaxf(a,b); { auto rr=__builtin_amdgcn_permlane32_swap(__float_as_uint(rm),__float_as_uint(rm),false,false); rm=__builtin_fmaxf(__uint_as_float(rr[0]),__uint_as_float(rr[1])); } \
      resc=false; \
      if(__builtin_expect(__any(rm>(float)THRL),0)){ const float dl=__builtin_fmaxf(rm,0.f); mhat+=dl; \
        _Pragma("unroll") for(int r=0;r<16;++r){cS0[r]-=dl;cS1[r]-=dl;} \
        const float f=__builtin_amdgcn_exp2f(-dl); l_reg*=f; if(hi==0)wsf[r32]=f; resc=true; } } \
    SBAR(); float sacc=0.f; \
    GAPB3(o[0]=__builtin_amdgcn_mfma_f32_32x32x16_bf16(PAFC(PC,0),VFR(0),o[0],0,0,0), cS0,0, CAT(PN,0),0); VNX(0); \
    GAPB3(o[1]=__builtin_amdgcn_mfma_f32_32x32x16_bf16(PAFC(PC,0),VFR(1),o[1],0,0,0), cS0,2, CAT(PN,0),1); VNX(1); \
    KRD(GL,0); GAPB3(o[0]=__builtin_amdgcn_mfma_f32_32x32x16_bf16(PAFC(PC,1),VFR(2),o[0],0,0,0), cS0,4, CAT(PN,0),2); VNX(2); \
    KRD(GL,1); GAPB3(o[1]=__builtin_amdgcn_mfma_f32_32x32x16_bf16(PAFC(PC,1),VFR(3),o[1],0,0,0), cS0,6, CAT(PN,0),3); VNX(3); \
    KRD(GL,2); GAPB3(o[0]=__builtin_amdgcn_mfma_f32_32x32x16_bf16(PAFC(PC,2),VFR(4),o[0],0,0,0), cS0,8, CAT(PN,1),0); VNX(4); \
    KRD(GL,3); GAPB3(o[1]=__builtin_amdgcn_mfma_f32_32x32x16_bf16(PAFC(PC,2),VFR(5),o[1],0,0,0), cS0,10, CAT(PN,1),1); VNX(5); \
    GAPB3(o[0]=__builtin_amdgcn_mfma_f32_32x32x16_bf16(PAFC(PC,3),VFR(6),o[0],0,0,0), cS0,12, CAT(PN,1),2); VNX(6); \
    GAPB3(o[1]=__builtin_amdgcn_mfma_f32_32x32x16_bf16(PAFC(PC,3),VFR(7),o[1],0,0,0), cS0,14, CAT(PN,1),3); VNX(7); \
    GAPB3(o[2]=__builtin_amdgcn_mfma_f32_32x32x16_bf16(PAFC(PC,0),VFR(8),o[2],0,0,0), cS1,0, CAT(PN,2),0); VNX(8); \
    GAPB3(o[3]=__builtin_amdgcn_mfma_f32_32x32x16_bf16(PAFC(PC,0),VFR(9),o[3],0,0,0), cS1,2, CAT(PN,2),1); VNX(9); \
    GAPB3(o[2]=__builtin_amdgcn_mfma_f32_32x32x16_bf16(PAFC(PC,1),VFR(10),o[2],0,0,0), cS1,4, CAT(PN,2),2); VNX(10); \
    GAPB3(o[3]=__builtin_amdgcn_mfma_f32_32x32x16_bf16(PAFC(PC,1),VFR(11),o[3],0,0,0), cS1,6, CAT(PN,2),3); VNX(11); \
    GAPB3(o[2]=__builtin_amdgcn_mfma_f32_32x32x16_bf16(PAFC(PC,2),VFR(12),o[2],0,0,0), cS1,8, CAT(PN,3),0); VNX(12); \
    GAPB3(o[3]=__builtin_amdgcn_mfma_f32_32x32x16_bf16(PAFC(PC,2),VFR(13),o[3],0,0,0), cS1,10, CAT(PN,3),1); VNX(13); \
    GAPB3(o[2]=__builtin_amdgcn_mfma_f32_32x32x16_bf16(PAFC(PC,3),VFR(14),o[2],0,0,0), cS1,12, CAT(PN,3),2); VNX(14); \
    GAPB3(o[3]=__builtin_amdgcn_mfma_f32_32x32x16_bf16(PAFC(PC,3),VFR(15),o[3],0,0,0), cS1,14, CAT(PN,3),3); VNX(15); \
    l_reg+=sacc; \
    }while(0)
  int t=1;
  #undef CMASK
  #define CMASK(P0,P1,t) do{}while(0)
  for(;t+5<NT;t+=2){
    STEP(pwa,pwb,t,true,true,true);     WAIT_BAR(3); RESC(); ROT();
    STEP(pwb,pwa,t+1,true,true,true);   WAIT_BAR(3); RESC(); ROT();
  }
  #undef CMASK
  #define CMASK(P0,P1,t) do{int jb_=(t)-(NT-4); if(jb_>=0)bmask(P0,P1,jb_,wch,il,hi,s2x2);}while(0)
  #define ENDW(tt) do{ if((tt)+3<NT){WAIT_BAR(3);} else if((tt)+2<NT){WAIT_BAR(2);} else {WAIT_BAR(0);} }while(0)
  for(;t+1<NT;t+=2){
    STEP(pwa,pwb,t,(t+3<NT),(t+1<NT),(t+1<NT));       ENDW(t);   RESC(); ROT();
    STEP(pwb,pwa,t+1,(t+4<NT),(t+2<NT),(t+2<NT));     ENDW(t+1); RESC(); ROT();
  }
  STEP(pwa,pwb,NT-1,false,false,false); RESC();
  SBAR(); pv(o,vb0+2*sl_cur,PAFC(pwb,0),PAFC(pwb,1),PAFC(pwb,2),PAFC(pwb,3));
  #undef PKW
  #undef PAFC
  #undef CAT
  #undef CAT_
  #undef QK
  #undef GAPB3
  #undef VFR
  #undef PIN_
  #undef MX3
  #undef EX
  #undef VRD
  #undef VNX
  #undef VOFF
  #undef GAPB2
  #undef KRD
  #undef STEP
  #undef ENDW
  {auto rr=__builtin_amdgcn_permlane32_swap(__float_as_uint(l_reg),__float_as_uint(l_reg),false,false);l_reg=__uint_as_float(rr[0])+__uint_as_float(rr[1]);}
  {
    const int le=lane_now(), r32e=le&31, hie=le>>5;
    float*wsfe=(float*)(shm+LDS_WS)+wid*64;
    if(hie==0)wsfe[32+r32e]=l_reg;asm volatile("s_waitcnt lgkmcnt(0)":::"memory");
    float rli[16];
    #pragma unroll
    for(int r=0;r<16;++r)rli[r]=__builtin_amdgcn_rcpf(wsfe[32+crow(r,hie)]);
    bf16_t*Ow=Ob+(long)(q0+wid*QBLK)*POUT;
    bf16_t*stg=(bf16_t*)(shm+LDS_OST)+wid*4096;
    #pragma unroll
    for(int r=0;r<16;++r){const int orow=crow(r,hie);
      #pragma unroll
      for(int d0=0;d0<4;++d0)stg[orow*128+d0*32+r32e]=(bf16_t)f2bf(o[d0][r]*rli[r]);}
    asm volatile("s_waitcnt lgkmcnt(0)":::"memory");
    #pragma unroll
    for(int i=0;i<8;++i){const int row=i*4+(le>>4),ch=le&15; const u32x4 v=*(const u32x4*)(stg+row*128+ch*8); ATTN_STORE16(Ow+(long)row*POUT+ch*8,v);} }
  asm volatile("s_waitcnt lgkmcnt(0)\n\ts_barrier":::"memory");
  #undef DMA_K
  #undef DMA_V
  #undef CMASK
  #undef CINIT0
  #undef CINIT1
  #undef START
  #undef RESC
  #undef ROT
}
#undef SBAR
#undef WAIT_BAR
}

__device__ __forceinline__ void attn_phase(const Frame& F, const Args& a) {
    const bf16_t* proj = (const bf16_t*)(a.ws + WS_PROJ); bf16_t* OA = (bf16_t*)(a.ws + WS_OA);
    const int vcu = (F.G % 8 == 0) ? (F.bid % 8) * (F.G / 8) + F.bid / 8 : F.bid;
    for (int i = 0;; ++i) {
        int bhm, qb;
        if (F.G == 256) { if (i >= 2) break; const int s_ = vcu & 7; bhm = vcu >> 3; qb = (i == 0) ? 15 - s_ : s_; }
        else { const int u = i * F.G + F.bid; if (u >= 512) break; bhm = u >> 4; qb = 15 - (u & 15); }
        const int b = bhm >> 3, h = (bhm >> 1) & 3, map = bhm & 1;
        const bf16_t* base = proj + (size_t)b * SEQ * INC;
        const float slope2 = exp2f(-2.0f * (h + 1)) * 1.4426950408889634f;
        attn_body::attn_unit<8>(qb, base + C_QDA + h * 128 + map * 64, base + C_KDA + h * 128 + map * 64, base + C_VDA + h * 128,
                                OA + (size_t)b * SEQ * 1024 + h * 256 + map * 128, slope2, (char*)F.lds);
    }
}
__device__ __forceinline__ void attn_combine(const Frame& F, const Args& a) {
    const bf16_t* OA = (const bf16_t*)(a.ws + WS_OA); bf16_t* Y = (bf16_t*)(a.ws + WS_YDA);
    const float lam = ((const float*)(a.ws + WS_SMALL))[0];
    const float g0 = a.in[I_SUBG][2 * F.lane] * 0.8f, g1 = a.in[I_SUBG][2 * F.lane + 1] * 0.8f;
    const int gw = F.bid * NWAVES + F.wave, NGW = F.G * NWAVES;
    for (int r = gw; r < T; r += NGW) {
        const unsigned* orow = (const unsigned*)(OA + (size_t)r * 1024); unsigned* yrow = (unsigned*)(Y + (size_t)r * 512);
        unsigned w0[4], w1[4];
#pragma unroll
        for (int h = 0; h < 4; ++h) { w0[h] = orow[h * 128 + F.lane]; w1[h] = orow[h * 128 + 64 + F.lane]; }
#pragma unroll
        for (int h = 0; h < 4; ++h) {
            const float x0 = bf2f(w0[h] & 0xffffu) - lam * bf2f(w1[h] & 0xffffu), x1 = bf2f(w0[h] >> 16) - lam * bf2f(w1[h] >> 16);
            const float rs = rsqrtf(wave_sum(x0 * x0 + x1 * x1) * (1.0f / 128.0f) + EPS);
            yrow[h * 64 + F.lane] = pk2(x0 * rs * g0, x1 * rs * g1);
        }
    }
}
namespace hg {
constexpr int QP = 136;
constexpr int L_QD = 0, L_KD = 64 * QP * 2, L_V = 2 * 64 * QP * 2, L_KE = 3 * 64 * QP * 2, L_SSQ = 4 * 64 * QP * 2, L_G = L_SSQ + 512, L_ST = L_G + 64 * QP * 2;
__device__ __forceinline__ f32x4 mfma16(bf16x8 a, bf16x8 b, f32x4 c) { return __builtin_amdgcn_mfma_f32_16x16x32_bf16(a, b, c, 0, 0, 0); }
#define HG_BAR() do { asm volatile("s_waitcnt lgkmcnt(0)" ::: "memory"); __builtin_amdgcn_s_barrier(); asm volatile("" ::: "memory"); } while (0)
typedef short v4i16_t __attribute__((ext_vector_type(4)));
__device__ __forceinline__ bf16x8 tr8(const LAS unsigned char* img, int ra, int rb, int col0, int lane) {
    const int q = (lane & 15) >> 2, p = lane & 3;
    const v4i16_t lo = __builtin_amdgcn_ds_read_tr16_b64_v4i16((LAS v4i16_t*)(img + ((ra + q) * QP + col0 + 4 * p) * 2));
    const v4i16_t hi = __builtin_amdgcn_ds_read_tr16_b64_v4i16((LAS v4i16_t*)(img + ((rb + q) * QP + col0 + 4 * p) * 2));
    return (bf16x8){lo[0], lo[1], lo[2], lo[3], hi[0], hi[1], hi[2], hi[3]};
}
struct Tile { u32x4 p[2]; };
__device__ __forceinline__ void tile_load(Tile& t, const bf16_t* src, size_t pitch, int tid) {
#pragma unroll
    for (int i = 0; i < 2; ++i) { const int pc = tid + NTHR * i; t.p[i] = *(const u32x4*)(src + (size_t)(pc >> 4) * pitch + (pc & 15) * 8); }
}
__device__ __forceinline__ void tile_put(const Tile& t, LAS unsigned char* img, int tid) {
#pragma unroll
    for (int i = 0; i < 2; ++i) { const int pc = tid + NTHR * i; *(LAS u32x4*)(img + ((pc >> 4) * QP + (pc & 15) * 8) * 2) = t.p[i]; }
}
constexpr int PP = 72;
constexpr int G4_L_P = 4 * 64 * QP * 2, G4_L_DEC = G4_L_P + 64 * PP * 2, G4_L_SSQ = G4_L_DEC + 512;
struct InA { Tile qd, kd, ke, v; f32x4 dec; };
__device__ __forceinline__ void loadA(InA& r, const Frame& F, const Args& a, int bh, int n) {
    const int b = bh >> 2, h = bh & 3; const size_t t0 = (size_t)b * SEQ + n * 64;
    const bf16_t* base = (const bf16_t*)(a.ws + WS_PROJ) + t0 * INC;
    tile_load(r.qd, base + C_HGT + 256 * h, INC, F.tid); tile_load(r.kd, base + C_HGT + 256 * h + 128, INC, F.tid);
    tile_load(r.ke, (const bf16_t*)a.out + t0 * 512 + h * 128, 512, F.tid); tile_load(r.v, base + C_IHG + h * 128, INC, F.tid);
    r.dec = *(const f32x4*)((const float*)(a.ws + WS_DEC) + ((size_t)bh * 64 + n) * 128 + 4 * (F.tid & 31));
}
__device__ __forceinline__ void grp_local(const Frame& F, const Args& a, int grp) {
    const int bh = grp >> 4, n0 = 4 * (grp & 15), b = bh >> 2, h = bh & 3, w = F.wave, lane = F.lane, fr = lane & 15, fq = lane >> 4;
    for (int i = F.tid; i < 64 * PP / 2; i += NTHR) ((LAS unsigned*)(F.lds + G4_L_P))[i] = 0u;
    f32x4 S[8];
#pragma unroll
    for (int kt = 0; kt < 8; ++kt) S[kt] = (f32x4){0.f, 0.f, 0.f, 0.f};
    InA cur, nxt; loadA(cur, F, a, bh, n0);
    unsigned short yk[4][4];
#define G4_STORE(nn) do { bf16_t* yp_ = (bf16_t*)(a.ws + WS_YHG) + ((size_t)b * SEQ + (nn) * 64 + 4 * fq) * 512 + h * 128 + 16 * w + fr; \
        _Pragma("unroll") for (int tb = 0; tb < 4; ++tb) _Pragma("unroll") for (int r = 0; r < 4; ++r) yp_[(size_t)(16 * tb + r) * 512] = yk[tb][r]; } while (0)
    for (int j = 0; j < 4; ++j) {
        if (j > 0) G4_STORE(n0 + j - 1);
        loadA(nxt, F, a, bh, n0 + (j < 3 ? j + 1 : 3));
        tile_put(cur.qd, F.lds + L_QD, F.tid); tile_put(cur.kd, F.lds + L_KD, F.tid); tile_put(cur.ke, F.lds + L_KE, F.tid); tile_put(cur.v, F.lds + L_V, F.tid);
        if (F.tid < 32) *(LAS f32x4*)(F.lds + G4_L_DEC + 16 * F.tid) = cur.dec;
        HG_BAR();
#pragma unroll
        for (int rep = 0; rep < 2; ++rep) { const int pi = w + 8 * rep;
            if (pi < 10) { const int tb = pi >= 6 ? 3 : pi >= 3 ? 2 : pi >= 1 ? 1 : 0, jt = pi - (tb * (tb + 1)) / 2;
                f32x4 sc = (f32x4){0.f, 0.f, 0.f, 0.f};
#pragma unroll
                for (int ks = 0; ks < 4; ++ks) { const bf16x8 kf = *(const LAS bf16x8*)(F.lds + L_KD + ((16 * jt + fr) * QP + 32 * ks + 8 * fq) * 2);
                    const bf16x8 qf = *(const LAS bf16x8*)(F.lds + L_QD + ((16 * tb + fr) * QP + 32 * ks + 8 * fq) * 2); sc = mfma16(kf, qf, sc); }
                if (jt == tb) {
#pragma unroll
                    for (int r = 0; r < 4; ++r) if (4 * fq + r > fr) sc[r] = 0.f;
                }
                *(LAS u32x2*)(F.lds + G4_L_P + ((16 * tb + fr) * PP + 16 * jt + 4 * fq) * 2) = (u32x2){cvt_pk_bf16(sc[0], sc[1]), cvt_pk_bf16(sc[2], sc[3])}; } }
        HG_BAR();
        bf16x8 bv[2];
#pragma unroll
        for (int s2 = 0; s2 < 2; ++s2) bv[s2] = tr8(F.lds + L_V, 32 * s2 + 8 * fq, 32 * s2 + 8 * fq + 4, 16 * w, lane);
        bf16x8 Sb[4];
#pragma unroll
        for (int ks = 0; ks < 4; ++ks) { const u32x4 t = (u32x4){cvt_pk_bf16(S[2 * ks][0], S[2 * ks][1]), cvt_pk_bf16(S[2 * ks][2], S[2 * ks][3]), cvt_pk_bf16(S[2 * ks + 1][0], S[2 * ks + 1][1]), cvt_pk_bf16(S[2 * ks + 1][2], S[2 * ks + 1][3])};
            Sb[ks] = __builtin_bit_cast(bf16x8, t); }
#pragma unroll
        for (int tb = 0; tb < 4; ++tb) { f32x4 o = (f32x4){0.f, 0.f, 0.f, 0.f};
#pragma unroll
            for (int s2 = 0; s2 <= (tb >> 1); ++s2) { const bf16x8 pf = *(const LAS bf16x8*)(F.lds + G4_L_P + ((16 * tb + fr) * PP + 32 * s2 + 8 * fq) * 2); o = mfma16(pf, bv[s2], o); }
            if (j > 0) {
#pragma unroll
                for (int ks = 0; ks < 4; ++ks) { const LAS unsigned char* qrow = F.lds + L_QD + ((16 * tb + fr) * QP + 32 * ks + 4 * fq) * 2;
                    const u32x2 lo = *(const LAS u32x2*)qrow, hi = *(const LAS u32x2*)(qrow + 32);
                    const u32x4 aw = (u32x4){lo.x, lo.y, hi.x, hi.y}; o = mfma16(__builtin_bit_cast(bf16x8, aw), Sb[ks], o); } }
#pragma unroll
            for (int r = 0; r < 4; ++r) yk[tb][r] = (unsigned short)f2bf(o[r]); }
#pragma unroll
        for (int kt = 0; kt < 8; ++kt) { S[kt] = S[kt] * *(const LAS f32x4*)(F.lds + G4_L_DEC + (16 * kt + 4 * fq) * 4);
#pragma unroll
            for (int s2 = 0; s2 < 2; ++s2) S[kt] = mfma16(tr8(F.lds + L_KE, 32 * s2 + 8 * fq, 32 * s2 + 8 * fq + 4, 16 * kt, lane), bv[s2], S[kt]); }
        HG_BAR();
        cur = nxt;
    }
    G4_STORE(n0 + 3);
#undef G4_STORE
    f32x4* sg = (f32x4*)(a.ws + WS_DS) + ((size_t)grp * 64 + w * 8) * 64 + lane;
#pragma unroll
    for (int kt = 0; kt < 8; ++kt) sg[kt * 64] = S[kt];
}
__device__ __forceinline__ void grp_scan(const Frame& F, const Args& a) {
    f32x4* sg = (f32x4*)(a.ws + WS_DS); f32x4* si = sg + (size_t)256 * 4096; const float* dec = (const float*)(a.ws + WS_DEC);
    for (int gt = F.bid * NTHR + F.tid; gt < 16 * 4096; gt += F.G * NTHR) {
        const int bh = gt >> 12, slot = gt & 4095, kt = (slot >> 6) & 7, lane = slot & 63, k = 16 * kt + 4 * (lane >> 4);
        f32x4 cur = (f32x4){0.f, 0.f, 0.f, 0.f};
#pragma unroll 4
        for (int g = 0; g < 16; ++g) { const size_t gi = ((size_t)(bh * 16 + g)) * 4096 + slot;
            si[gi] = cur;
            const float* dp = dec + ((size_t)bh * 64 + 4 * g) * 128 + k;
            const f32x4 d = (*(const f32x4*)dp * *(const f32x4*)(dp + 128)) * (*(const f32x4*)(dp + 256) * *(const f32x4*)(dp + 384));
            cur = d * cur + sg[gi]; }
    }
}
struct InC { Tile qd, g, ol; f32x4 dec; };
__device__ __forceinline__ void loadC(InC& r, const Frame& F, const Args& a, int bh, int n) {
    const int b = bh >> 2, h = bh & 3; const size_t t0 = (size_t)b * SEQ + n * 64;
    const bf16_t* base = (const bf16_t*)(a.ws + WS_PROJ) + t0 * INC;
    tile_load(r.qd, base + C_HGT + 256 * h, INC, F.tid); tile_load(r.g, base + C_GHG + h * 128, INC, F.tid);
    tile_load(r.ol, (const bf16_t*)(a.ws + WS_YHG) + t0 * 512 + h * 128, 512, F.tid);
    r.dec = *(const f32x4*)((const float*)(a.ws + WS_DEC) + ((size_t)bh * 64 + n) * 128 + 4 * (F.tid & 31));
}
__device__ __forceinline__ void grp_final(const Frame& F, const Args& a, int grp) {
    const int bh = grp >> 4, n0 = 4 * (grp & 15), b = bh >> 2, h = bh & 3, w = F.wave, lane = F.lane, fr = lane & 15, fq = lane >> 4;
    f32x4 S[8];
    { const f32x4* si = (const f32x4*)(a.ws + WS_DS) + (size_t)256 * 4096 + ((size_t)grp * 64 + w * 8) * 64 + lane;
#pragma unroll
      for (int kt = 0; kt < 8; ++kt) S[kt] = si[kt * 64]; }
    const float ng = a.in[I_HGNG][16 * w + fr];
    LAS float* SSQ = (LAS float*)(F.lds + G4_L_SSQ);
    InC cur, nxt; loadC(cur, F, a, bh, n0);
    unsigned short yk[4][4];
#define G4_STORE(nn) do { bf16_t* yp_ = (bf16_t*)(a.ws + WS_YHG) + ((size_t)b * SEQ + (nn) * 64 + 4 * fq) * 512 + h * 128 + 16 * w + fr; \
        _Pragma("unroll") for (int tb = 0; tb < 4; ++tb) _Pragma("unroll") for (int r = 0; r < 4; ++r) yp_[(size_t)(16 * tb + r) * 512] = yk[tb][r]; } while (0)
    for (int j = 0; j < 4; ++j) {
        if (j > 0) G4_STORE(n0 + j - 1);
        loadC(nxt, F, a, bh, n0 + (j < 3 ? j + 1 : 3));
        tile_put(cur.qd, F.lds + L_QD, F.tid); tile_put(cur.g, F.lds + L_KD, F.tid); tile_put(cur.ol, F.lds + L_V, F.tid);
        if (F.tid < 32) *(LAS f32x4*)(F.lds + G4_L_DEC + 16 * F.tid) = cur.dec;
        HG_BAR();
        bf16x8 Sb[4];
#pragma unroll
        for (int ks = 0; ks < 4; ++ks) { const u32x4 t = (u32x4){cvt_pk_bf16(S[2 * ks][0], S[2 * ks][1]), cvt_pk_bf16(S[2 * ks][2], S[2 * ks][3]), cvt_pk_bf16(S[2 * ks + 1][0], S[2 * ks + 1][1]), cvt_pk_bf16(S[2 * ks + 1][2], S[2 * ks + 1][3])};
            Sb[ks] = __builtin_bit_cast(bf16x8, t); }
        f32x4 o[4];
#pragma unroll
        for (int tb = 0; tb < 4; ++tb) {
#pragma unroll
            for (int r = 0; r < 4; ++r) o[tb][r] = bf2f(*(const LAS unsigned short*)(F.lds + L_V + ((16 * tb + 4 * fq + r) * QP + 16 * w + fr) * 2));
#pragma unroll
            for (int ks = 0; ks < 4; ++ks) { const LAS unsigned char* qrow = F.lds + L_QD + ((16 * tb + fr) * QP + 32 * ks + 4 * fq) * 2;
                const u32x2 lo = *(const LAS u32x2*)qrow, hi = *(const LAS u32x2*)(qrow + 32);
                const u32x4 aw = (u32x4){lo.x, lo.y, hi.x, hi.y}; o[tb] = mfma16(__builtin_bit_cast(bf16x8, aw), Sb[ks], o[tb]); }
#pragma unroll
            for (int r = 0; r < 4; ++r) { const float v = scan16(o[tb][r] * o[tb][r]); if (fr == 15) SSQ[w * 64 + 16 * tb + 4 * fq + r] = v; } }
#pragma unroll
        for (int kt = 0; kt < 8; ++kt) S[kt] = S[kt] * *(const LAS f32x4*)(F.lds + G4_L_DEC + (16 * kt + 4 * fq) * 4);
        HG_BAR();
#pragma unroll
        for (int tb = 0; tb < 4; ++tb) { f32x4 tot = (f32x4){0.f, 0.f, 0.f, 0.f};
#pragma unroll
            for (int ww = 0; ww < 8; ++ww) tot += *(const LAS f32x4*)(SSQ + ww * 64 + 16 * tb + 4 * fq);
#pragma unroll
            for (int r = 0; r < 4; ++r) { const float rs = rsqrtf(tot[r] * (1.0f / 128.0f) + EPS); const float g = bf2f(*(const LAS unsigned short*)(F.lds + L_KD + ((16 * tb + 4 * fq + r) * QP + 16 * w + fr) * 2));
                yk[tb][r] = (unsigned short)f2bf(o[tb][r] * rs * ng * g * __builtin_amdgcn_rcpf(1.0f + __builtin_amdgcn_exp2f(-1.4426950408889634f * g))); } }
        HG_BAR();
        cur = nxt;
    }
    G4_STORE(n0 + 3);
#undef G4_STORE
}
#undef HG_BAR
}

__device__ __forceinline__ float rs4(float a0, float a1, float a2, float a3, int lane) {
    const bool hi = (lane & 32) != 0;
    const float s0 = hi ? a0 : a2, s1 = hi ? a1 : a3;
    const float k0 = (hi ? a2 : a0) + __shfl_xor(s0, 32), k1 = (hi ? a3 : a1) + __shfl_xor(s1, 32);
    const bool b4 = (lane & 16) != 0;
    const float sd = b4 ? k0 : k1;
    float k = (b4 ? k1 : k0) + __shfl_xor(sd, 16);
    k += __shfl_xor(k, 8); k += __shfl_xor(k, 4); k += __shfl_xor(k, 2); k += __shfl_xor(k, 1);
    return k;
}
__device__ __forceinline__ void phase_router(const Frame& F, const Args& a) {
    constexpr int AP = 1032;
    LAS bf16_t* AH = (LAS bf16_t*)F.lds;
    LAS bf16_t* AL = AH + 16 * AP;
    LAS float* PART = (LAS float*)(F.lds + 2 * 16 * AP * 2);
    LAS float* LG = PART + 8 * 16 * 48;
    LAS unsigned* LH = (LAS unsigned*)(LG + 16 * 48);
    LAS unsigned* LB = LH + 32;
    LAS unsigned* LR = LH + 64;
    if (F.tid < NEXP) LH[F.tid] = 0u;
    const float* mod = (const float*)(a.ws + WS_MOD);
    const bf16_t* x1 = (const bf16_t*)(a.ws + WS_X1B); bf16_t* H2 = (bf16_t*)(a.ws + WS_ACT);
    unsigned* counts = (unsigned*)(a.ws + WS_CTL) + CW_COUNTS; unsigned* tokinfo = (unsigned*)(a.ws + WS_TOKINFO); int* toklist = (int*)(a.ws + WS_TOKLIST);
    const int rows_per_blk = T / F.G, r0 = F.bid * rows_per_blk, b = r0 / SEQ;
    const int lane = F.lane, w = F.wave, fr = lane & 15, fq = lane >> 4;
    f32x4 v[2][4], vn[2][4];
#define RT_LOAD(V, rb_) do { _Pragma("unroll") for (int q = 0; q < 2; ++q) { const u32x2* xr_ = (const u32x2*)(x1 + (size_t)((rb_) + 2 * w + q) * D) + lane; \
        _Pragma("unroll") for (int j = 0; j < 4; ++j) { const u32x2 t_ = xr_[64 * j]; V[q][j] = (f32x4){bf2f(t_.x & 0xffffu), bf2f(t_.x >> 16), bf2f(t_.y & 0xffffu), bf2f(t_.y >> 16)}; } } } while (0)
    RT_LOAD(v, r0);
    bf16x8 Bh[4][3], Bl[4][3];
    {
        const float* wre = a.in[I_WRE]; const float* wrg = a.in[I_WRG];
#pragma unroll
        for (int ks = 0; ks < 4; ++ks)
#pragma unroll
            for (int ct = 0; ct < 3; ++ct) {
                unsigned hw[4], lw[4];
#pragma unroll
                for (int jp = 0; jp < 4; ++jp) { float x[2];
#pragma unroll
                    for (int z = 0; z < 2; ++z) { const int k = 128 * w + 32 * ks + 8 * fq + 2 * jp + z;
                        if (ct == 0) { const float g = wrg[k * 4 + (fr & 3)], e = wre[k * 32 + ((fr + 28) & 31)]; x[z] = fr < 4 ? g : e; }
                        else if (ct == 1) x[z] = wre[k * 32 + 12 + fr];
                        else { const float e = wre[k * 32 + 28 + (fr & 3)]; x[z] = fr < 4 ? e : 0.f; } }
                    const unsigned h0 = f2bf(x[0]), h1 = f2bf(x[1]); hw[jp] = h0 | (h1 << 16);
                    lw[jp] = pk2(x[0] - bf2f(h0), x[1] - bf2f(h1)); }
                Bh[ks][ct] = __builtin_bit_cast(bf16x8, (u32x4){hw[0], hw[1], hw[2], hw[3]}); Bl[ks][ct] = __builtin_bit_cast(bf16x8, (u32x4){lw[0], lw[1], lw[2], lw[3]});
            }
    }
    for (int g = 0; g < rows_per_blk / 16; ++g) {
        const int rg = r0 + 16 * g;
        { const int gn = g + 1 < rows_per_blk / 16 ? g + 1 : g; RT_LOAD(vn, r0 + 16 * gn); }
#pragma unroll
        for (int q = 0; q < 2; ++q) { float sq = 0.f;
#pragma unroll
            for (int j = 0; j < 4; ++j) sq += (v[q][j].x * v[q][j].x + v[q][j].y * v[q][j].y) + (v[q][j].z * v[q][j].z + v[q][j].w * v[q][j].w);
            const float rs = rsqrtf(wave_sum(sq) * (1.0f / D) + EPS); const int row = 2 * w + q;
#pragma unroll
            for (int j = 0; j < 4; ++j) { const int k = 256 * j + 4 * lane;
                const f32x4 gg = *(const f32x4*)(a.in[I_N2G] + k) * (1.0f + *(const f32x4*)(mod + b * 6144 + 4 * 1024 + k)), sh = *(const f32x4*)(mod + b * 6144 + 3 * 1024 + k);
                const f32x4 hv = v[q][j] * rs * gg + sh;
                const unsigned h0 = f2bf(hv.x), h1 = f2bf(hv.y), h2_ = f2bf(hv.z), h3 = f2bf(hv.w);
                const u32x2 hw = (u32x2){h0 | (h1 << 16), h2_ | (h3 << 16)};
                *(u32x2*)(H2 + (size_t)(rg + row) * D + k) = hw;
                *(LAS u32x2*)(AH + row * AP + k) = hw;
                *(LAS u32x2*)(AL + row * AP + k) = (u32x2){pk2(hv.x - bf2f(h0), hv.y - bf2f(h1)), pk2(hv.z - bf2f(h2_), hv.w - bf2f(h3))}; } }
        __syncthreads();
        f32x4 acc[3] = {{0.f, 0.f, 0.f, 0.f}, {0.f, 0.f, 0.f, 0.f}, {0.f, 0.f, 0.f, 0.f}};
#pragma unroll
        for (int ks = 0; ks < 4; ++ks) { const bf16x8 ah = *(const LAS bf16x8*)(AH + fr * AP + 128 * w + 32 * ks + 8 * fq), al = *(const LAS bf16x8*)(AL + fr * AP + 128 * w + 32 * ks + 8 * fq);
#pragma unroll
            for (int ct = 0; ct < 3; ++ct) { acc[ct] = __builtin_amdgcn_mfma_f32_16x16x32_bf16(ah, Bh[ks][ct], acc[ct], 0, 0, 0);
                acc[ct] = __builtin_amdgcn_mfma_f32_16x16x32_bf16(al, Bh[ks][ct], acc[ct], 0, 0, 0); acc[ct] = __builtin_amdgcn_mfma_f32_16x16x32_bf16(ah, Bl[ks][ct], acc[ct], 0, 0, 0); } }
#pragma unroll
        for (int ct = 0; ct < 3; ++ct)
#pragma unroll
            for (int r = 0; r < 4; ++r) PART[(w * 16 + 4 * fq + r) * 48 + 16 * ct + fr] = acc[ct][r];
        __syncthreads();
        for (int t = F.tid; t < 16 * 48; t += NTHR) { const int row = t / 48, o = t % 48; float sacc = 0.f;
#pragma unroll
            for (int ww = 0; ww < 8; ++ww) sacc += PART[(ww * 16 + row) * 48 + o];
            if (o < 36) LG[row * 48 + o] = sacc + (o < 4 ? a.in[I_BRG][o & 3] : a.in[I_BRE][(o + 28) & 31]); }
        __syncthreads();
        if (F.tid < 16) {
            const LAS float* lg = LG + F.tid * 48;
            float gl[4]; int gi = 0;
#pragma unroll
            for (int o = 0; o < 4; ++o) gl[o] = lg[o];
            float gm = gl[0];
#pragma unroll
            for (int o = 1; o < 4; ++o) if (gl[o] > gm) { gm = gl[o]; gi = o; }
            float gsum = 0.f;
#pragma unroll
            for (int o = 0; o < 4; ++o) gsum += expf(gl[o] - gm);
            const float gp = 1.0f / gsum;
            float el[8];
#pragma unroll
            for (int e = 0; e < 8; ++e) el[e] = lg[4 + gi * 8 + e];
            int i0 = 0; float m0 = el[0];
#pragma unroll
            for (int o = 1; o < 8; ++o) if (el[o] > m0) { m0 = el[o]; i0 = o; }
            int i1 = -1; float m1 = -INFINITY;
#pragma unroll
            for (int o = 0; o < 8; ++o) if (o != i0 && el[o] > m1) { m1 = el[o]; i1 = o; }
            const float e1 = expf(m1 - m0); const float w0 = gp / (1.0f + e1), w1 = gp * e1 / (1.0f + e1);
            const int rl = 16 * g + F.tid, ex0 = gi * 8 + i0, ex1 = gi * 8 + i1;
            const unsigned l0 = atomicAdd((unsigned*)(LH + ex0), 1u), l1 = atomicAdd((unsigned*)(LH + ex1), 1u);
            LAS unsigned* ri = LR + rl * 6;
            ri[0] = (unsigned)ex0; ri[1] = l0; ri[2] = (unsigned)ex1; ri[3] = l1; ri[4] = __float_as_uint(w0); ri[5] = __float_as_uint(w1);
        }
#pragma unroll
        for (int q = 0; q < 2; ++q)
#pragma unroll
            for (int j = 0; j < 4; ++j) v[q][j] = vn[q][j];
    }
#undef RT_LOAD
    __syncthreads();
    if (F.tid < NEXP) LB[F.tid] = atomicAdd(counts + 64 * F.tid, LH[F.tid]);
    __syncthreads();
    for (int rl = F.tid; rl < rows_per_blk; rl += NTHR) {
        const LAS unsigned* ri = LR + rl * 6; const int r = r0 + rl;
        const unsigned ex0 = ri[0], ex1 = ri[2], k0 = LB[ex0] + ri[1], k1 = LB[ex1] + ri[3];
        toklist[ex0 * T + k0] = r; toklist[ex1 * T + k1] = r;
        u32x4 t0; t0.x = ex0; t0.y = k0; t0.z = ex1; t0.w = k1;
        *(u32x4*)(tokinfo + (size_t)r * 8) = t0;
        tokinfo[(size_t)r * 8 + 4] = ri[4]; tokinfo[(size_t)r * 8 + 5] = ri[5];
    }
}
__device__ __forceinline__ void build_moe_tab(const Frame& F, const Args& a, LAS MoeTab* tab) {
    if (F.tid == 0) {
        const unsigned* counts = (const unsigned*)(a.ws + WS_CTL) + CW_COUNTS; int nt = 0;
        for (int e = 0; e < NEXP; ++e) { const int c = (int)__hip_atomic_load(counts + 64 * e, __ATOMIC_RELAXED, __HIP_MEMORY_SCOPE_AGENT); tab->cnt[e] = c; tab->tbase[e] = nt;
            const int n = (c + 255) >> 8; for (int m = 0; m < n; ++m) { tab->tile_e[nt] = e; tab->tile_m[nt] = m; ++nt; } }
        tab->tbase[NEXP] = nt; tab->nt = nt;
    }
    __syncthreads();
}
__device__ __forceinline__ void phase_final(const Frame& F, const Args& a, const LAS MoeTab* tab) {
    const float* mod = (const float*)(a.ws + WS_MOD); const unsigned* tokinfo = (const unsigned*)(a.ws + WS_TOKINFO); const bf16_t* Ys = (const bf16_t*)(a.ws + WS_YS);
    const int rows_per_blk = T / F.G, r0 = F.bid * rows_per_blk;
    for (int r = r0 + F.wave; r < r0 + rows_per_blk; r += NWAVES) {
        const int b = r / SEQ;
        const u32x4 ti = *(const u32x4*)(tokinfo + (size_t)r * 8);
        const float w0 = __uint_as_float(tokinfo[(size_t)r * 8 + 4]), w1 = __uint_as_float(tokinfo[(size_t)r * 8 + 5]);
        const size_t s0 = (size_t)tab->tbase[ti.x] * 256 + ti.y, s1 = (size_t)tab->tbase[ti.z] * 256 + ti.w;
        f32x4* xr = (f32x4*)(a.out + (size_t)r * D) + F.lane; const u32x2* xb = (const u32x2*)((const bf16_t*)(a.ws + WS_X1B) + (size_t)r * D) + F.lane;
        const u32x2* y0 = (const u32x2*)(Ys + s0 * D) + F.lane; const u32x2* y1 = (const u32x2*)(Ys + s1 * D) + F.lane;
        f32x4 v[4]; float s = 0.f;
#pragma unroll
        for (int j = 0; j < 4; ++j) { const int k = 256 * j + 4 * F.lane;
            const f32x4 gt = *(const f32x4*)(mod + b * 6144 + 5 * 1024 + k); const u32x2 a0 = y0[64 * j], a1 = y1[64 * j];
            f32x4 m; m.x = w0 * bf2f(a0.x & 0xffffu) + w1 * bf2f(a1.x & 0xffffu); m.y = w0 * bf2f(a0.x >> 16) + w1 * bf2f(a1.x >> 16);
            m.z = w0 * bf2f(a0.y & 0xffffu) + w1 * bf2f(a1.y & 0xffffu); m.w = w0 * bf2f(a0.y >> 16) + w1 * bf2f(a1.y >> 16);
            const u32x2 xq = xb[64 * j]; const f32x4 xv = (f32x4){bf2f(xq.x & 0xffffu), bf2f(xq.x >> 16), bf2f(xq.y & 0xffffu), bf2f(xq.y >> 16)};
            v[j] = xv + gt * m; s += (v[j].x * v[j].x + v[j].y * v[j].y) + (v[j].z * v[j].z + v[j].w * v[j].w); }
        const float rs = rsqrtf(wave_sum(s) * (1.0f / D) + EPS);
#pragma unroll
        for (int j = 0; j < 4; ++j) { const f32x4 g = *(const f32x4*)(a.in[I_FG] + 256 * j + 4 * F.lane); xr[64 * j] = v[j] * rs * g; }
    }
}

#define XB_TMO      128
#define XB_XCNT(j)  (256  + 64 * (j))
#define XB_XSUB(j)  (1280 + 64 * (j))
#define XB_XGEN(j)  (2304 + 64 * (j))
#define XB_TOP      3328
#define XB_TOPGEN   3392
#define XCD_BAR_WORDS 3456
#define XB_SPIN_CAP (1u << 18)
__device__ __forceinline__ unsigned xb_ld(unsigned* p)              { return __hip_atomic_load(p, __ATOMIC_RELAXED, __HIP_MEMORY_SCOPE_AGENT); }
__device__ __forceinline__ unsigned xb_add(unsigned* p, unsigned v) { return __hip_atomic_fetch_add(p, v, __ATOMIC_RELAXED, __HIP_MEMORY_SCOPE_AGENT); }
__device__ __forceinline__ unsigned xb_xcc_id() { return (unsigned)__builtin_amdgcn_s_getreg((3 << 11) | 20) & 0xFu; }
#define XB_SPIN(cond, bar) do { unsigned _sp = 0; while (cond) { __builtin_amdgcn_s_sleep(1); \
    if ((++_sp & 255u) == 0u) { if (xb_ld(&(bar)[XB_TMO])) break; if (_sp > XB_SPIN_CAP) { atomicAdd(&(bar)[XB_TMO], 1u); break; } } } } while (0)
struct XcdBarrier { unsigned* bar; unsigned x; volatile LAS unsigned* st; };
__device__ __forceinline__ XcdBarrier xcd_barrier_post(unsigned* bar, volatile LAS unsigned* st) {
    XcdBarrier b; b.bar = bar; b.x = xb_xcc_id(); b.st = st;
    if (threadIdx.x == 0) (void)xb_add(&bar[XB_XCNT(b.x)], 1u);
    return b;
}
__device__ __forceinline__ void xcd_barrier_complete(unsigned* bar, unsigned x, unsigned& nloc, unsigned& nx) {
    const unsigned G = gridDim.x * gridDim.y * gridDim.z;
    unsigned sum, cnt, mine, sp = 0u;
    for (;;) {
        sum = 0u; cnt = 0u; mine = 0u;
#pragma unroll
        for (unsigned j = 0; j < 16; ++j) { const unsigned c = xb_ld(&bar[XB_XCNT(j)]); sum += c; cnt += (c > 0u) ? 1u : 0u; mine = (j == x) ? c : mine; }
        if (sum == G) break;
        __builtin_amdgcn_s_sleep(1);
        if ((++sp & 255u) == 0u) { if (xb_ld(&bar[XB_TMO])) break; if (sp > XB_SPIN_CAP) { atomicAdd(&bar[XB_TMO], 1u); break; } }
    }
    nloc = mine > 0u ? mine : 1u; nx = cnt > 0u ? cnt : 1u;
}
__device__ __forceinline__ void xcd_barrier(const XcdBarrier& b) {
    asm volatile("s_waitcnt vmcnt(0)" ::: "memory");
    __syncthreads();
    if (threadIdx.x == 0) {
        unsigned* bar = b.bar;
        __builtin_amdgcn_s_waitcnt(0);
        unsigned nloc = b.st[0], nx = b.st[1];
        if (nloc == 0u) { xcd_barrier_complete(bar, b.x, nloc, nx); b.st[0] = nloc; b.st[1] = nx; }
        const unsigned old = xb_add(&bar[XB_XSUB(b.x)], 1u);
        const unsigned gen = old / nloc;
        if (old + 1u == (gen + 1u) * nloc) {
            __builtin_amdgcn_fence(__ATOMIC_RELEASE, "agent");
            asm volatile("s_waitcnt vmcnt(0)" ::: "memory");
            const unsigned og = xb_add(&bar[XB_TOP], 1u);
            const unsigned tg = og / nx;
            if (og + 1u == (tg + 1u) * nx) xb_add(&bar[XB_TOPGEN], 1u);
            else XB_SPIN(xb_ld(&bar[XB_TOPGEN]) == tg, bar);
            __builtin_amdgcn_fence(__ATOMIC_ACQUIRE, "agent");
            xb_add(&bar[XB_XGEN(b.x)], 1u);
            asm volatile("s_waitcnt vmcnt(0)" ::: "memory");
        } else {
            XB_SPIN(xb_ld(&bar[XB_XGEN(b.x)]) == gen, bar);
            __builtin_amdgcn_fence(__ATOMIC_ACQUIRE, "agent");
            asm volatile("s_waitcnt vmcnt(0)" ::: "memory");
        }
    }
    __syncthreads();
}

constexpr int N_PHASES = 11;
__global__ void __launch_bounds__(NTHR, 2) mk_fwd(Args a) {
    extern __shared__ __attribute__((aligned(16))) unsigned char lds_raw[];
    Frame F; F.lds = (LAS unsigned char*)lds_raw; F.tid = threadIdx.x; F.lane = F.tid & 63; F.wave = __builtin_amdgcn_readfirstlane(F.tid >> 6); F.G = gridDim.x; F.bid = blockIdx.x;
    unsigned char* ws = a.ws;
    const int lo = a.ph_lo, hi = a.ph_hi;
#if MK_N_LAUNCHES == 1
    volatile LAS unsigned* MISC = (volatile LAS unsigned*)(F.lds + 152 * 1024);
    if (F.tid < 4) MISC[F.tid] = 0u;
    __syncthreads();
    XcdBarrier xbar = xcd_barrier_post((unsigned*)(ws + WS_CTL) + CW_BAR, MISC);
#define SEAM(k) do { if (IN(k) && IN((k) + 1)) xcd_barrier(xbar); } while (0)
#else
#define SEAM(k) do { } while (0)
#endif
#define IN(k) (lo <= (k) && (k) < hi)
    LAS MoeTab* tab = (LAS MoeTab*)(F.lds + 144 * 1024);

#define RUNPH(k, ...) if (IN(k)) { F.lane = lane_now(); F.tid = F.wave * 64 + F.lane; __VA_ARGS__ }
    RUNPH(0, { phase0(F, a); }) SEAM(0);
    RUNPH(1, { phase1(F, a); __syncthreads(); dense_weight_convert(F, a); }) SEAM(1);
    RUNPH(2, {
        DenseOrder S{(const char*)(ws + WS_ACT), (const char*)(ws + WS_WIN), D, T / 256, INC / 256, F.G, F.bid};
        EpiInProj E{(bf16_t*)(ws + WS_PROJ), (bf16_t*)a.out, (float*)(ws + WS_DEC), (const float*)(ws + WS_SMALL) + 16, attn_body::C2};
        pg8::gemm_phase(F.lds, D, S, E);
        int nl; const int early = w2_early_items(F.G, nl);
        if (early && F.bid >= F.G - nl) { __syncthreads(); moe_w2_convert(F, a, 0, early, (F.bid - (F.G - nl)) * NWAVES + F.wave, nl * NWAVES); }
    }) SEAM(2);
    RUNPH(3, {
        for (int g = F.bid; g < 256; g += F.G) hg::grp_local(F, a, g);
        __syncthreads();
        attn_phase(F, a);
    }) SEAM(3);
    RUNPH(4, { hg::grp_scan(F, a); attn_combine(F, a); }) SEAM(4);
    RUNPH(5, { for (int g = F.bid; g < 256; g += F.G) hg::grp_final(F, a, g); }) SEAM(5);
    RUNPH(6, {
        UpOrder S{(const char*)(ws + WS_YDA), (const char*)(ws + WS_YHG), (const char*)(ws + WS_WUPDA), (const char*)(ws + WS_WUPHG), F.G, F.bid};
        EpiUp E{(const bf16_t*)(ws + WS_PROJ), (bf16_t*)(ws + WS_ACT)};
        pg8::gemm_phase(F.lds, 512, S, E);
    }) SEAM(6);
    RUNPH(7, {
        DenseOrder S{(const char*)(ws + WS_ACT), (const char*)(ws + WS_WOUT), D, T / 256, D / 256, F.G, F.bid};
        EpiOut E{a.in[I_X], (const float*)(ws + WS_MOD), (bf16_t*)(ws + WS_X1B)};
        pg8::gemm_phase(F.lds, D, S, E);
        moe_weight_convert(F, a);
    }) SEAM(7);
    RUNPH(8, { phase_router(F, a); __syncthreads(); }) SEAM(8);
    RUNPH(9, {
        build_moe_tab(F, a, tab);
        unsigned* done = (unsigned*)(ws + WS_CTL) + CW_TILE;
        const int vc = (F.G & 7) == 0 ? (F.bid & 7) * (F.G >> 3) + (F.bid >> 3) : F.bid;
        { Moe1Order S{tab, (const char*)(ws + WS_ACT), (const char*)(ws + WS_W13), (const int*)(ws + WS_TOKLIST), F.G, vc};
          EpiMoe1 E{(bf16_t*)(ws + WS_HS), done};
          pg8::gemm_phase(F.lds, D, S, E); }
        { Moe2Order S{tab, (const char*)(ws + WS_HS), (const char*)a.out + OUT_W2, done, (unsigned*)(ws + WS_CTL) + CW_TMO, F.G, vc};
          EpiStoreBf16 E{(bf16_t*)(ws + WS_YS), D, 0, 1.0f};
          pg8::gemm_phase(F.lds, DEXP, S, E); }
    }) SEAM(9);
    RUNPH(10, { build_moe_tab(F, a, tab); phase_final(F, a, tab); })
#undef IN
#undef SEAM
}

extern "C" void kernel_launch(void* const* d_in, const int* in_sizes, int n_in, void* d_out, int out_size, void* d_ws, size_t ws_size, hipStream_t stream) {
    static int grid = 0;
    if (grid == 0) {
        if (n_in != 25 || in_sizes[0] != T * D || out_size != T * D || ws_size < WS_END) { fprintf(stderr, "kernel_launch: unexpected shapes (n_in %d, in0 %d, out %d, ws %zu)\n", n_in, n_in > 0 ? in_sizes[0] : -1, out_size, ws_size); grid = -1; return; }
        int dev = 0, cus = 0, per_cu = 0;
        if (hipGetDevice(&dev) != hipSuccess || hipDeviceGetAttribute(&cus, hipDeviceAttributeMultiprocessorCount, dev) != hipSuccess) { grid = -1; return; }
        if (hipFuncSetAttribute((const void*)mk_fwd, hipFuncAttributeMaxDynamicSharedMemorySize, LDS_BYTES) != hipSuccess) { fprintf(stderr, "kernel_launch: hipFuncSetAttribute failed\n"); grid = -1; return; }
        if (hipOccupancyMaxActiveBlocksPerMultiprocessor(&per_cu, (const void*)mk_fwd, NTHR, LDS_BYTES) != hipSuccess || per_cu < 1) { fprintf(stderr, "kernel_launch: occupancy query says %d\n", per_cu); per_cu = 1; }
        (void)hipGetLastError();
        grid = cus;
        if (grid > 256) grid = 256;
        while (T % grid) --grid;
    }
    if (grid < 0) return;
    (void)hipMemsetAsync((char*)d_ws + WS_CTL, 0, CTL_ZERO_BYTES, stream);
    Args a{};
    for (int i = 0; i < 25; ++i) a.in[i] = (const float*)d_in[i];
    a.out = (float*)d_out; a.ws = (unsigned char*)d_ws;
#if MK_N_LAUNCHES == 1
    a.ph_lo = 0; a.ph_hi = N_PHASES;
    void* args[] = {&a};
    hipError_t e = hipLaunchCooperativeKernel((const void*)mk_fwd, dim3(grid), dim3(NTHR), args, LDS_BYTES, stream);
    if (e != hipSuccess) fprintf(stderr, "cooperative launch failed: %s (grid %d)\n", hipGetErrorString(e), grid);
#else
    for (int p = 0; p < N_PHASES; ++p) {
        a.ph_lo = p; a.ph_hi = p + 1;
        hipLaunchKernelGGL(mk_fwd, dim3(grid), dim3(NTHR), LDS_BYTES, stream, a);
    }
#endif
}
```

```cpp
#include <hip/hip_runtime.h>
#include <cstdio>
#include <cstdint>

#ifndef MK_N_LAUNCHES
#define MK_N_LAUNCHES 1
#endif

#define LAS __attribute__((address_space(3)))
typedef unsigned short bf16_t;
typedef short bf16x8 __attribute__((ext_vector_type(8)));
typedef float f32x4 __attribute__((ext_vector_type(4)));
typedef float f32x2 __attribute__((ext_vector_type(2)));
typedef unsigned u32x4 __attribute__((ext_vector_type(4)));
typedef unsigned u32x2 __attribute__((ext_vector_type(2)));

constexpr int NB = 4, SEQ = 4096, D = 1024, T = NB * SEQ;
constexpr int INC = 5632;
constexpr int C_QDA = 0, C_KDA = 512, C_VDA = 1024, C_QHG = 1536, C_FHG = 2048, C_IHG = 2560, C_GHG = 3072, C_GDA = 3584, C_GHGATE = 4608;
constexpr int C_HGT = 1536;
constexpr int NEXP = 32, DEXP = 512;
constexpr int PMAX = 40960;
constexpr float EPS = 1e-6f;
constexpr int NWAVES = 8, NTHR = 512;

constexpr size_t MiB = 1u << 20;
constexpr size_t WS_CTL = 0, CTL_ZERO_BYTES = 64 * 1024;
constexpr size_t WS_MOD = 5 * MiB / 2;
constexpr size_t WS_SMALL = 11 * MiB / 4;
constexpr size_t WS_TOKINFO = 3 * MiB;
constexpr size_t WS_TOKLIST = 4 * MiB;
constexpr size_t WS_DEC = 6 * MiB;
constexpr size_t WS_DS = 24 * MiB;
constexpr size_t WS_WIN = 8 * MiB;
constexpr size_t WS_WUPDA = 20 * MiB, WS_WUPHG = 21 * MiB, WS_WOUT = 22 * MiB;
constexpr size_t WS_ACT = 24 * MiB;
constexpr size_t WS_PROJ = 56 * MiB;
constexpr size_t WS_YDA = 232 * MiB, WS_YHG = 248 * MiB;
constexpr size_t WS_OA = 264 * MiB;
constexpr size_t WS_W13 = 56 * MiB;
constexpr size_t WS_W2 = 120 * MiB;
constexpr size_t WS_HS = 152 * MiB;
constexpr size_t WS_YS = 192 * MiB;
constexpr size_t OUT_W2 = 16 * MiB;
constexpr int W2_EARLY = 32;
constexpr size_t WS_X1B = 272 * MiB;
constexpr size_t WS_END = 304 * MiB;
constexpr int CW_COUNTS = 64;
constexpr int CW_BAR = 4096;
constexpr int CW_TILE = 8192;
constexpr int CW_TMO = 32;

constexpr int LDS_BYTES = 160 * 1024;

__device__ __forceinline__ float bf2f(unsigned v) { return __uint_as_float(v << 16); }
__device__ __forceinline__ unsigned f2bf(float f) { unsigned u = __float_as_uint(f); return (u + 0x7fffu + ((u >> 16) & 1u)) >> 16; }
__device__ __forceinline__ unsigned pk2(float lo, float hi) { return f2bf(lo) | (f2bf(hi) << 16); }
__device__ __forceinline__ float sigmoidf_(float x) { return 1.0f / (1.0f + __expf(-x)); }
__device__ __forceinline__ float siluf_(float x) { return x / (1.0f + __expf(-x)); }
__device__ __forceinline__ int lane_now() { int l; asm volatile("v_mbcnt_lo_u32_b32 %0, -1, 0\n\tv_mbcnt_hi_u32_b32 %0, -1, %0" : "=v"(l)); return l; }
__device__ __forceinline__ float wave_sum(float v) {
#pragma unroll
    for (int o = 1; o < 64; o <<= 1) v += __shfl_xor(v, o);
    return v;
}

namespace pg8 {
constexpr int BM = 256, BK = 64, HALF = 128, HTB = HALF * BK * 2, STAGE_BYTES = 8 * HTB;
__host__ __device__ __forceinline__ int lds_byte(int r, int c) { const int st = (r >> 4) * 2 + (c >> 5), rr = r & 15, cc = c & 31, ob = rr * 64 + cc * 2; return st * 1024 + (ob ^ (((ob >> 9) & 1) << 5)); }
__host__ __device__ __forceinline__ void stage_rc(int b, int& R, int& C) { const int st = b / 1024, sb = b % 1024, swz = sb ^ (((sb >> 9) & 1) << 5); R = (st >> 1) * 16 + swz / 64; C = (st & 1) * 32 + (swz % 64) / 2; }
__host__ __device__ __forceinline__ int perm32(int rho) { const int n = rho >> 4, i = rho & 15; return 8 * (i >> 2) + 4 * n + (i & 3); }

struct Unit { int pm, pn; const char* A; const char* B; int aux; };
__device__ __forceinline__ unsigned cvt_pk_bf16(float lo, float hi) { unsigned r; asm volatile("v_cvt_pk_bf16_f32 %0, %1, %2" : "=v"(r) : "v"(lo), "v"(hi)); return r; }

template <class Epi, class Sched>
__device__ __forceinline__ void gemm_phase(LAS unsigned char* lds, const int K, const Sched& S, const Epi& E) {
    const int tid = threadIdx.x, wid = __builtin_amdgcn_readfirstlane(tid >> 6), lane = tid & 63, wr = wid >> 2, wc = wid & 3, fr = lane & 15, fq = lane >> 4;
    const int nt = K / BK;
    unsigned voffB[2];
#define PG8_SETLANE() do { const int _l = lane_now(), _t = wid * 64 + _l; _Pragma("unroll") for (int _i = 0; _i < 2; ++_i) { int _R, _C; stage_rc(_t * 16 + _i * 8192, _R, _C); \
        const int _Rb = Epi::PERM ? ((_R & ~31) + perm32(_R & 31)) : _R; voffB[_i] = (unsigned)(_Rb * K + _C) * 2u; } \
        aoff = lds_byte(wr * 64 + (_l & 15), (_l >> 4) * 8); boff = lds_byte(wc * 32 + (_l & 15), (_l >> 4) * 8); } while (0)
    const size_t kstep = (size_t)(BK * 2);
    const size_t hstep = (size_t)HALF * K * 2;
    const unsigned ldsw = (unsigned)wid * 1024u;
    int aoff, boff; PG8_SETLANE();
#define PG8_SA(b, h) (((b) * 2 + (h)) * HTB)
#define PG8_SB(b, h) ((4 + (b) * 2 + (h)) * HTB)
#define PG8_STAGE(bufoff, gbase, voff) do { _Pragma("unroll") for (int _i = 0; _i < 2; ++_i) \
        __builtin_amdgcn_global_load_lds((const unsigned*)((const char*)(gbase) + (voff)[_i]), (LAS unsigned*)(lds + (bufoff) + ldsw + _i * 8192), 16, 0, 0); } while (0)
#define PG8_LDA(dst, b, h) do { _Pragma("unroll") for (int m = 0; m < 4; ++m) _Pragma("unroll") for (int k = 0; k < 2; ++k) dst[m][k] = *(const LAS bf16x8*)(lds + PG8_SA(b, h) + aoff + m * 2048 + k * 1024); } while (0)
#define PG8_LDB(dst, b, h) do { _Pragma("unroll") for (int n = 0; n < 2; ++n) _Pragma("unroll") for (int k = 0; k < 2; ++k) dst[n][k] = *(const LAS bf16x8*)(lds + PG8_SB(b, h) + boff + n * 2048 + k * 1024); } while (0)
#define PG8_MMA(ai, bj, At, Bt) do { __builtin_amdgcn_s_setprio(1); _Pragma("unroll") for (int m = 0; m < 4; ++m) _Pragma("unroll") for (int n = 0; n < 2; ++n) _Pragma("unroll") for (int k = 0; k < 2; ++k) \
        acc[ai][bj][m][n] = __builtin_amdgcn_mfma_f32_16x16x32_bf16(Bt[n][k], At[m][k], acc[ai][bj][m][n], 0, 0, 0); __builtin_amdgcn_s_setprio(0); } while (0)
#define PG8_WAIT_V(n) asm volatile("s_waitcnt vmcnt(" #n ")" ::: "memory")
#define PG8_WAIT_L(n) asm volatile("s_waitcnt lgkmcnt(" #n ")" ::: "memory")
#define PG8_BAR __builtin_amdgcn_s_barrier()
#define PG8_SCHED __builtin_amdgcn_sched_barrier(0)
#define PG8_SETA(vo, u) do { const int _t = wid * 64 + lane_now(); _Pragma("unroll") for (int _i = 0; _i < 2; ++_i) { int _R, _C; stage_rc(_t * 16 + _i * 8192, _R, _C); \
        _Pragma("unroll") for (int _h = 0; _h < 2; ++_h) vo[_h][_i] = (unsigned)((size_t)S.arow(u, _h * HALF + _R) * (size_t)K + _C) * 2u; } if (Sched::GATHER) PG8_WAIT_V(0); } while (0)
    Unit cur, nxt; int ui = 0;
    if (!S.next(0, cur)) return;
    f32x4 acc[2][2][4][2];
#pragma unroll
    for (int a = 0; a < 2; ++a)
#pragma unroll
        for (int b = 0; b < 2; ++b)
#pragma unroll
            for (int m = 0; m < 4; ++m)
#pragma unroll
                for (int n = 0; n < 2; ++n) acc[a][b][m][n] = (f32x4){0.f, 0.f, 0.f, 0.f};
    bf16x8 At[4][2], B0[2][2], B1[2][2];
    unsigned voC[2][2], voN[2][2];
    S.a_ready(cur);
    PG8_SETA(voC, cur);
    const char* cA = cur.A; const char* cB = cur.B;
    PG8_STAGE(PG8_SB(0, 0), cB, voffB); PG8_STAGE(PG8_SB(0, 1), cB + hstep, voffB); PG8_STAGE(PG8_SA(0, 0), cA, voC[0]); PG8_STAGE(PG8_SA(0, 1), cA, voC[1]);
    if (wr == 1) PG8_BAR;
    PG8_WAIT_V(2); PG8_BAR;
    PG8_STAGE(PG8_SB(1, 0), cB + kstep, voffB); PG8_STAGE(PG8_SA(1, 0), cA + kstep, voC[0]); PG8_STAGE(PG8_SB(1, 1), cB + hstep + kstep, voffB);
    PG8_WAIT_V(6); PG8_BAR;
    for (;;) {
        const bool has_next = S.next(ui + 1, nxt);
        if (has_next) { PG8_SETA(voN, nxt); }
        else {
#pragma unroll
            for (int h = 0; h < 2; ++h)
#pragma unroll
                for (int i = 0; i < 2; ++i) voN[h][i] = voC[h][i];
        }
        const char* nA = has_next ? nxt.A : cA; const char* nB = has_next ? nxt.B : cB;
        for (int t = 0; t < nt; t += 2) {
            const bool last = (t == nt - 2);
            if (last && has_next) S.a_ready(nxt);
            const char* a1 = cA + (size_t)(t + 1) * kstep;
            const char* a2 = last ? nA : cA + (size_t)(t + 2) * kstep; const char* b2 = last ? nB : cB + (size_t)(t + 2) * kstep;
            const char* a3 = a2 + kstep; const char* b3 = b2 + kstep;
            unsigned vo2[2][2];
#pragma unroll
            for (int h = 0; h < 2; ++h)
#pragma unroll
                for (int i = 0; i < 2; ++i) vo2[h][i] = last ? voN[h][i] : voC[h][i];
            PG8_LDB(B0, 0, 0); PG8_LDB(B1, 0, 1); PG8_SCHED; PG8_LDA(At, 0, 0); PG8_STAGE(PG8_SA(1, 1), a1, voC[1]);
            PG8_WAIT_V(8); PG8_WAIT_L(0); PG8_BAR; PG8_MMA(0, 0, At, B0); PG8_MMA(0, 1, At, B1); PG8_BAR; PG8_SCHED;
            PG8_LDA(At, 0, 1); PG8_STAGE(PG8_SB(0, 0), b2, voffB); PG8_STAGE(PG8_SB(0, 1), b2 + hstep, voffB); PG8_STAGE(PG8_SA(0, 0), a2, vo2[0]);
            PG8_WAIT_V(8); PG8_WAIT_L(0); PG8_BAR; PG8_MMA(1, 0, At, B0); PG8_MMA(1, 1, At, B1); PG8_BAR; PG8_SCHED;
            PG8_LDB(B0, 1, 0); PG8_LDB(B1, 1, 1); PG8_SCHED; PG8_LDA(At, 1, 0); PG8_STAGE(PG8_SA(0, 1), a2, vo2[1]);
            PG8_WAIT_V(8); PG8_WAIT_L(0); PG8_BAR; PG8_MMA(0, 0, At, B0); PG8_MMA(0, 1, At, B1); PG8_BAR; PG8_SCHED;
            PG8_LDA(At, 1, 1); PG8_STAGE(PG8_SB(1, 0), b3, voffB); PG8_STAGE(PG8_SB(1, 1), b3 + hstep, voffB); PG8_STAGE(PG8_SA(1, 0), a3, vo2[0]);
            PG8_WAIT_V(8); PG8_WAIT_L(0); PG8_BAR; PG8_MMA(1, 0, At, B0); PG8_MMA(1, 1, At, B1); PG8_BAR; PG8_SCHED;
        }
        if (wr == 0) PG8_BAR;
        const bool keep = E(acc, cur, wr, wc, fr, fq);
        if (!has_next) break;
        if (!keep) {
#pragma unroll
            for (int a = 0; a < 2; ++a)
#pragma unroll
                for (int b = 0; b < 2; ++b)
#pragma unroll
                    for (int m = 0; m < 4; ++m)
#pragma unroll
                        for (int n = 0; n < 2; ++n) acc[a][b][m][n] = (f32x4){0.f, 0.f, 0.f, 0.f};
        }
        cur = nxt; cA = nA; cB = nB; ++ui;
        if (Sched::GATHER) {
#pragma unroll
            for (int h = 0; h < 2; ++h)
#pragma unroll
                for (int i = 0; i < 2; ++i) voC[h][i] = voN[h][i];
        } else { PG8_SETA(voC, cur); }
        PG8_SETLANE();
        if (wr == 1) PG8_BAR;
    }
    PG8_WAIT_V(0);
    PG8_BAR;
#undef PG8_SA
#undef PG8_SB
#undef PG8_STAGE
#undef PG8_LDA
#undef PG8_LDB
#undef PG8_MMA
#undef PG8_WAIT_V
#undef PG8_WAIT_L
#undef PG8_BAR
#undef PG8_SCHED
#undef PG8_SETA
#undef PG8_SETLANE
}
}

struct Args { const float* in[25]; float* out; unsigned char* ws; int ph_lo, ph_hi; };
enum { I_X = 0, I_C, I_WADA, I_BADA, I_N1G, I_WIN, I_LQ1, I_LK1, I_LQ2, I_LK2, I_SUBG, I_LBL, I_HGNG, I_WUPDA, I_WUPHG, I_WOUT, I_N2G, I_WRG, I_BRG, I_WRE, I_BRE, I_W1, I_W3, I_W2, I_FG };

struct DenseOrder {
    static constexpr bool GATHER = false;
    const char* A; const char* Bt; int K, nM, nN, G, c;
    __device__ __forceinline__ bool next(int i, pg8::Unit& u) const {
        const int L = i * G + c, nwg = nM * nN; if (L >= nwg) return false;
        int wgid = L; { const int q = nwg / 8, r = nwg % 8, xcd = wgid % 8, off = wgid / 8; wgid = (xcd < r ? xcd * (q + 1) : r * (q + 1) + (xcd - r) * q) + off; }
        const int nig = 8 * nN, gid = wgid / nig, fm = gid * 8, gsz = (nM - fm) < 8 ? (nM - fm) : 8;
        u.pm = fm + ((wgid % nig) % gsz); u.pn = (wgid % nig) / gsz; u.A = A; u.B = Bt + (size_t)u.pn * 256 * K * 2; u.aux = 0; return true;
    }
    __device__ __forceinline__ void a_ready(const pg8::Unit&) const {}
    __device__ __forceinline__ unsigned arow(const pg8::Unit& u, int r) const { return (unsigned)(u.pm * 256 + r); }
};
struct UpOrder {
    static constexpr bool GATHER = false;
    const char* A0; const char* A1; const char* B0; const char* B1; int G, c;
    __device__ __forceinline__ bool next(int i, pg8::Unit& u) const {
        const int tile = (i >> 1) * G + c; if (tile >= 256) return false;
        u.pm = tile >> 2; u.pn = tile & 3; u.aux = i & 1;
        u.A = (i & 1) ? A1 : A0; u.B = ((i & 1) ? B1 : B0) + (size_t)u.pn * 256 * 512 * 2; return true;
    }
    __device__ __forceinline__ void a_ready(const pg8::Unit&) const {}
    __device__ __forceinline__ unsigned arow(const pg8::Unit& u, int r) const { return (unsigned)(u.pm * 256 + r); }
};
struct MoeTab { int nt; int pad[3]; int tile_e[176]; int tile_m[176]; int cnt[32]; int tbase[33]; };
struct Moe1Order {
    static constexpr bool GATHER = true;
    const LAS MoeTab* tab; const char* A; const char* W; const int* toklist; int G, c;
    __device__ __forceinline__ bool next(int i, pg8::Unit& u) const {
        const int L = i * G + c; if (L >= tab->nt * 4) return false;
        const int ti = L >> 2; u.pm = ti; u.pn = L & 3; u.aux = ti; u.A = A;
        u.B = W + ((size_t)tab->tile_e[ti] * 1024 + (size_t)u.pn * 256) * 1024 * 2; return true;
    }
    __device__ __forceinline__ void a_ready(const pg8::Unit&) const {}
    __device__ __forceinline__ unsigned arow(const pg8::Unit& u, int r) const {
        const int e = tab->tile_e[u.aux], rr = tab->tile_m[u.aux] * 256 + r;
        return rr < tab->cnt[e] ? (unsigned)toklist[e * T + rr] : 0u;
    }
};
struct Moe2Order {
    static constexpr bool GATHER = false;
    const LAS MoeTab* tab; const char* A; const char* W; unsigned* done; unsigned* tmo; int G, c;
    __device__ __forceinline__ bool next(int i, pg8::Unit& u) const {
        const int n1 = tab->nt * 4, r = n1 % G, nl = G - r; int j;
        if (r > 0 && c >= r) { if (i < 2) j = (c - r) + i * nl; else j = 2 * nl + (c - r) + (i - 2) * G; }
        else j = (r > 0 ? 2 * nl : 0) + ((c - r + G) % G) + i * G;
        if (j >= n1) return false;
        const int ti = j >> 2; u.pm = ti; u.pn = j & 3; u.aux = ti; u.A = A;
        u.B = W + ((size_t)tab->tile_e[ti] * 1024 + (size_t)u.pn * 256) * 512 * 2; return true;
    }
    __device__ __forceinline__ unsigned arow(const pg8::Unit& u, int r) const { return (unsigned)(u.pm * 256 + r); }
    __device__ __forceinline__ void a_ready(const pg8::Unit& u) const {
        if (threadIdx.x < 64) {
            unsigned polls = 0;
            while ((unsigned)__builtin_amdgcn_readfirstlane(__hip_atomic_load(done + 16 * u.pm, __ATOMIC_RELAXED, __HIP_MEMORY_SCOPE_AGENT)) < 32u) {
                if (++polls > (1u << 22)) { if (threadIdx.x == 0) __hip_atomic_store(tmo, 1u, __ATOMIC_RELAXED, __HIP_MEMORY_SCOPE_AGENT); break; }
                __builtin_amdgcn_s_sleep(2); }
            __builtin_amdgcn_fence(__ATOMIC_ACQUIRE, "agent");
            asm volatile("s_waitcnt vmcnt(0)" ::: "memory");
        }
        asm volatile("" ::: "memory"); __builtin_amdgcn_s_barrier(); asm volatile("" ::: "memory");
    }
};

using pg8::Unit; using pg8::cvt_pk_bf16;
struct EpiStoreBf16 {
    static constexpr bool PERM = true;
    bf16_t* O; int ldc; int nscale; float scale0;
    __device__ __forceinline__ bool operator()(f32x4 (&acc)[2][2][4][2], const Unit& u, int wr, int wc, int fr, int fq) const {
        const int row0 = u.pm * 256 + wr * 64 + fr, col0 = u.pn * 256 + wc * 32 + 8 * fq;
        const float sc = u.pn < nscale ? scale0 : 1.0f;
#pragma unroll
        for (int ai = 0; ai < 2; ++ai)
#pragma unroll
            for (int m = 0; m < 4; ++m) { bf16_t* rowp = O + (size_t)(row0 + ai * 128 + m * 16) * ldc + col0;
#pragma unroll
                for (int bj = 0; bj < 2; ++bj) { const f32x4 v0 = acc[ai][bj][m][0] * sc, v1 = acc[ai][bj][m][1] * sc;
                    u32x4 w; w.x = cvt_pk_bf16(v0[0], v0[1]); w.y = cvt_pk_bf16(v0[2], v0[3]); w.z = cvt_pk_bf16(v1[0], v1[1]); w.w = cvt_pk_bf16(v1[2], v1[3]);
                    *(u32x4*)(rowp + bj * 128) = w; } }
        return false;
    }
};
template <int N> __device__ __forceinline__ float dpp_shr(float x) { return __builtin_bit_cast(float, __builtin_amdgcn_update_dpp(0, __builtin_bit_cast(int, x), 0x110 + N, 0xf, 0xf, true)); }
template <int N> __device__ __forceinline__ float dpp_ror(float x) { return __builtin_bit_cast(float, __builtin_amdgcn_update_dpp(0, __builtin_bit_cast(int, x), 0x120 + N, 0xf, 0xf, true)); }
__device__ __forceinline__ float rowsum16(float x) { x += dpp_ror<8>(x); x += dpp_ror<4>(x); x += dpp_ror<2>(x); x += dpp_ror<1>(x); return x; }
__device__ __forceinline__ float scan16(float x) { x += dpp_shr<1>(x); x += dpp_shr<2>(x); x += dpp_shr<4>(x); x += dpp_shr<8>(x); return x; }
struct EpiInProj {
    static constexpr bool PERM = true;
    bf16_t* O; bf16_t* KE; float* DEC; const float* lbv; float scale0;
    __device__ __forceinline__ bool operator()(f32x4 (&acc)[2][2][4][2], const Unit& u, int wr, int wc, int fr, int fq) const {
        { const int l_ = lane_now(); fr = l_ & 15; fq = l_ >> 4; }
        const int row0 = u.pm * 256 + wr * 64 + fr, col0 = u.pn * 256 + wc * 32 + 8 * fq;
        if (u.pn >= 6 && u.pn < 10) {
            const int h = u.pn - 6, lane = 16 * fq + fr, kb = wc * 32 + 8 * fq;
            const int bb = (u.pm * 256) / SEQ, ch0 = ((u.pm * 256) % SEQ + wr * 64) >> 6;
            const f32x4 lb0 = *(const f32x4*)(lbv + h * 128 + kb), lb1 = *(const f32x4*)(lbv + h * 128 + kb + 4);
#pragma unroll
            for (int ai = 0; ai < 2; ++ai) {
                unsigned kep[4][4];
#pragma unroll
                for (int n = 0; n < 2; ++n) {
#pragma unroll
                    for (int ep = 0; ep < 2; ++ep) {
                        float ke2[2][4];
#pragma unroll
                        for (int z = 0; z < 2; ++z) {
                            const int e = 2 * ep + z; const float lb = n ? lb1[e] : lb0[e];
                            float f[4], c[4], tot[4];
#pragma unroll
                            for (int m = 0; m < 4; ++m) { const float fl = acc[ai][1][m][n][e]; f[m] = lb + (1.0f - lb) * __builtin_amdgcn_rcpf(1.0f + __builtin_amdgcn_exp2f(-1.4426950408889634f * fl)); const float lf = __logf(f[m]); c[m] = scan16(lf); tot[m] = rowsum16(lf); }
                            const float alast = (tot[0] + tot[1]) + (tot[2] + tot[3]); const float eal = __expf(alast);
                            float pre = 0.f;
#pragma unroll
                            for (int m = 0; m < 4; ++m) { const float A = c[m] + pre; pre += tot[m]; const float q = acc[ai][0][m][n][e]; const float kk = 1.0f - f[m];
                                acc[ai][0][m][n][e] = q * __builtin_amdgcn_rcpf(1.0f + __builtin_amdgcn_exp2f(-1.4426950408889634f * q)) * __expf(A);
                                const float kd = kk * __expf(-A); acc[ai][1][m][n][e] = kd; ke2[z][m] = kd * eal; }
                            if (fr == 0) DEC[((size_t)(bb * 4 + h) * 64 + ch0 + 2 * ai) * 128 + kb + 4 * n + e] = eal;
                        }
#pragma unroll
                        for (int m = 0; m < 4; ++m) kep[m][2 * n + ep] = cvt_pk_bf16(ke2[0][m], ke2[1][m]);
                    }
                }
#pragma unroll
                for (int m = 0; m < 4; ++m) *(u32x4*)(KE + (size_t)(row0 + ai * 128 + m * 16) * 512 + h * 128 + kb) = (u32x4){kep[m][0], kep[m][1], kep[m][2], kep[m][3]};
            }
        }
        const float sc = u.pn < 2 ? scale0 : 1.0f;
#pragma unroll
        for (int ai = 0; ai < 2; ++ai)
#pragma unroll
            for (int m = 0; m < 4; ++m) { bf16_t* rowp = O + (size_t)(row0 + ai * 128 + m * 16) * INC + col0;
#pragma unroll
                for (int bj = 0; bj < 2; ++bj) { const f32x4 v0 = acc[ai][bj][m][0] * sc, v1 = acc[ai][bj][m][1] * sc;
                    u32x4 w; w.x = cvt_pk_bf16(v0[0], v0[1]); w.y = cvt_pk_bf16(v0[2], v0[3]); w.z = cvt_pk_bf16(v1[0], v1[1]); w.w = cvt_pk_bf16(v1[2], v1[3]);
                    *(u32x4*)(rowp + bj * 128) = w; } }
        return false;
    }
};
struct EpiUp {
    static constexpr bool PERM = true;
    const bf16_t* proj; bf16_t* O;
    __device__ __forceinline__ bool operator()(f32x4 (&acc)[2][2][4][2], const Unit& u, int wr, int wc, int fr, int fq) const {
        const int row0 = u.pm * 256 + wr * 64 + fr, col0 = u.pn * 256 + wc * 32 + 8 * fq;
#pragma unroll
        for (int ai = 0; ai < 2; ++ai)
#pragma unroll
            for (int m = 0; m < 4; ++m) { const size_t row = (size_t)(row0 + ai * 128 + m * 16);
#pragma unroll
                for (int bj = 0; bj < 2; ++bj) {
                    const int col = col0 + bj * 128;
                    const u32x4 gh = *(const u32x4*)(proj + row * INC + C_GHGATE + col);
                    float sh[8];
#pragma unroll
                    for (int j = 0; j < 4; ++j) { sh[2 * j] = 1.0f + __builtin_amdgcn_exp2f(-1.4426950408889634f * bf2f(gh[j] & 0xffffu)); sh[2 * j + 1] = 1.0f + __builtin_amdgcn_exp2f(-1.4426950408889634f * bf2f(gh[j] >> 16)); }
                    if (u.aux == 0) {
                        const u32x4 gd = *(const u32x4*)(proj + row * INC + C_GDA + col);
#pragma unroll
                        for (int j = 0; j < 4; ++j) {
                            const float d0 = 1.0f + __builtin_amdgcn_exp2f(-1.4426950408889634f * bf2f(gd[j] & 0xffffu)), d1 = 1.0f + __builtin_amdgcn_exp2f(-1.4426950408889634f * bf2f(gd[j] >> 16));
                            const float r0 = sh[2 * j] * __builtin_amdgcn_rcpf(d0), r1 = sh[2 * j + 1] * __builtin_amdgcn_rcpf(d1);
                            if (j < 2) { acc[ai][bj][m][0][2 * j] *= r0; acc[ai][bj][m][0][2 * j + 1] *= r1; }
                            else { acc[ai][bj][m][1][2 * j - 4] *= r0; acc[ai][bj][m][1][2 * j - 3] *= r1; }
                        }
                    } else {
                        const f32x4 v0 = acc[ai][bj][m][0], v1 = acc[ai][bj][m][1];
#pragma unroll
                        for (int j = 0; j < 8; ++j) sh[j] = __builtin_amdgcn_rcpf(sh[j]);
                        u32x4 w; w.x = cvt_pk_bf16(v0[0] * sh[0], v0[1] * sh[1]); w.y = cvt_pk_bf16(v0[2] * sh[2], v0[3] * sh[3]);
                        w.z = cvt_pk_bf16(v1[0] * sh[4], v1[1] * sh[5]); w.w = cvt_pk_bf16(v1[2] * sh[6], v1[3] * sh[7]);
                        *(u32x4*)(O + row * D + col) = w;
                    }
                } }
        return u.aux == 0;
    }
};
struct EpiOut {
    static constexpr bool PERM = true;
    const float* x; const float* mod; bf16_t* O;
    __device__ __forceinline__ bool operator()(f32x4 (&acc)[2][2][4][2], const Unit& u, int wr, int wc, int fr, int fq) const {
        const int row0 = u.pm * 256 + wr * 64 + fr, col0 = u.pn * 256 + wc * 32 + 8 * fq;
        const int b = (u.pm * 256) / SEQ;
        f32x4 gt[2][2];
#pragma unroll
        for (int bj = 0; bj < 2; ++bj)
#pragma unroll
            for (int n = 0; n < 2; ++n) gt[bj][n] = *(const f32x4*)(mod + b * 6144 + 2048 + col0 + bj * 128 + n * 4);
#pragma unroll
        for (int ai = 0; ai < 2; ++ai)
#pragma unroll
            for (int m = 0; m < 4; ++m) { const size_t off = (size_t)(row0 + ai * 128 + m * 16) * D + col0;
#pragma unroll
                for (int bj = 0; bj < 2; ++bj) { const f32x4 x0 = *(const f32x4*)(x + off + bj * 128), x1 = *(const f32x4*)(x + off + bj * 128 + 4);
                    const f32x4 v0 = x0 + gt[bj][0] * acc[ai][bj][m][0], v1 = x1 + gt[bj][1] * acc[ai][bj][m][1];
                    u32x4 w; w.x = cvt_pk_bf16(v0[0], v0[1]); w.y = cvt_pk_bf16(v0[2], v0[3]); w.z = cvt_pk_bf16(v1[0], v1[1]); w.w = cvt_pk_bf16(v1[2], v1[3]);
                    *(u32x4*)(O + off + bj * 128) = w; } }
        return false;
    }
};
struct EpiMoe1 {
    static constexpr bool PERM = true;
    bf16_t* O; unsigned* done;
    __device__ __forceinline__ bool operator()(f32x4 (&acc)[2][2][4][2], const Unit& u, int wr, int wc, int fr, int fq) const {
        const int row0 = u.pm * 256 + wr * 64 + fr, col0 = u.pn * 128 + wc * 32 + 8 * fq;
#pragma unroll
        for (int ai = 0; ai < 2; ++ai)
#pragma unroll
            for (int m = 0; m < 4; ++m) { bf16_t* rowp = O + (size_t)(row0 + ai * 128 + m * 16) * DEXP + col0;
                float h[8];
#pragma unroll
                for (int n = 0; n < 2; ++n)
#pragma unroll
                    for (int e = 0; e < 4; ++e) { const float x_ = acc[ai][0][m][n][e]; h[n * 4 + e] = x_ * __builtin_amdgcn_rcpf(1.0f + __builtin_amdgcn_exp2f(-1.4426950408889634f * x_)) * acc[ai][1][m][n][e]; }
                u32x4 w; w.x = cvt_pk_bf16(h[0], h[1]); w.y = cvt_pk_bf16(h[2], h[3]); w.z = cvt_pk_bf16(h[4], h[5]); w.w = cvt_pk_bf16(h[6], h[7]);
                asm volatile("global_store_dwordx4 %0, %1, off sc1\n\ts_nop 1" :: "v"(rowp), "v"(w) : "memory"); }
        asm volatile("s_waitcnt vmcnt(0)" ::: "memory");
        if ((threadIdx.x & 63) == 0) __hip_atomic_fetch_add(done + 16 * u.pm, 1u, __ATOMIC_RELAXED, __HIP_MEMORY_SCOPE_AGENT);
        return false;
    }
};

struct Frame { LAS unsigned char* lds; int tid, lane, wave, G, bid; };

__device__ __forceinline__ void transpose_item(const float* Wsrc, int ldw, bf16_t* dst, int ldd, LAS float* scr, int lane) {
#pragma unroll 8
    for (int i = 0; i < 32; ++i) { const int kk = 2 * i + (lane >> 5); scr[kk * 33 + (lane & 31)] = __builtin_nontemporal_load(Wsrc + (size_t)kk * ldw + (lane & 31)); }
    asm volatile("s_waitcnt lgkmcnt(0)" ::: "memory");
    const int c = lane & 7;
#pragma unroll
    for (int j = 0; j < 4; ++j) { const int n = (lane >> 3) + 8 * j; const LAS float* s = scr + (8 * c) * 33 + n;
        u32x4 o; o.x = pk2(s[0 * 33], s[1 * 33]); o.y = pk2(s[2 * 33], s[3 * 33]); o.z = pk2(s[4 * 33], s[5 * 33]); o.w = pk2(s[6 * 33], s[7 * 33]);
        *(u32x4*)(dst + (size_t)n * ldd + 8 * c) = o; }
    asm volatile("s_waitcnt lgkmcnt(0)" ::: "memory");
}
struct TItem { const float* src; bf16_t* dst; int ldw, ldd; };
template <class ItemFn>
__device__ __forceinline__ void transpose_stream(int it_lo, int it_hi, int gw, int NGW, LAS float* scr, int lane, ItemFn item) {
    int it = it_lo + gw; if (it >= it_hi) return;
    TItem cur = item(it);
    float v[32];
    const int l31 = lane & 31, lh = lane >> 5;
#pragma unroll
    for (int i = 0; i < 32; ++i) v[i] = __builtin_nontemporal_load(cur.src + (size_t)(2 * i + lh) * cur.ldw + l31);
    while (true) {
#pragma unroll
        for (int i = 0; i < 32; ++i) scr[(2 * i + lh) * 33 + l31] = v[i];
        const int nx = it + NGW; const bool more = nx < it_hi; TItem nxt = cur;
        if (more) { nxt = item(nx);
#pragma unroll
            for (int i = 0; i < 32; ++i) v[i] = __builtin_nontemporal_load(nxt.src + (size_t)(2 * i + lh) * nxt.ldw + l31); }
        asm volatile("s_waitcnt lgkmcnt(0)" ::: "memory");
        const int c = lane & 7;
#pragma unroll
        for (int j = 0; j < 4; ++j) { const int n = (lane >> 3) + 8 * j; const LAS float* s_ = scr + (8 * c) * 33 + n;
            u32x4 o; o.x = pk2(s_[0 * 33], s_[1 * 33]); o.y = pk2(s_[2 * 33], s_[3 * 33]); o.z = pk2(s_[4 * 33], s_[5 * 33]); o.w = pk2(s_[6 * 33], s_[7 * 33]);
            *(u32x4*)(cur.dst + (size_t)n * cur.ldd + 8 * c) = o; }
        asm volatile("s_waitcnt lgkmcnt(0)" ::: "memory");
        if (!more) break;
        cur = nxt; it = nx;
    }
}
__device__ __forceinline__ void transpose_matrix(const Frame& F, const float* W, int K, int N, bf16_t* WT) {
    LAS float* scr = (LAS float*)(F.lds + F.wave * 8448);
    const int gw = F.bid * NWAVES + F.wave, NGW = F.G * NWAVES, nblk = N / 32, items = (K / 64) * nblk;
    transpose_stream(0, items, gw, NGW, scr, F.lane, [=](int it) { const int kb = it / nblk, nb = it % nblk;
        return TItem{W + (size_t)(64 * kb) * N + 32 * nb, WT + (size_t)(32 * nb) * K + 64 * kb, N, K}; });
}

__device__ __forceinline__ void phase0(const Frame& F, const Args& a) {
    unsigned char* ws = a.ws;
    {
        float* mod = (float*)(ws + WS_MOD);
        const float* c = a.in[I_C]; const float* wada = a.in[I_WADA]; const float* bada = a.in[I_BADA];
        LAS f32x4* cs4 = (LAS f32x4*)(F.lds + 72 * 1024);
        LAS float* red = (LAS float*)(F.lds + 72 * 1024 + 16 * 1024);
        for (int i = F.tid; i < 4 * D; i += NTHR) ((LAS float*)cs4)[(i & (D - 1)) * 4 + (i >> 10)] = siluf_(c[i]);
        __syncthreads();
        for (int cb = F.bid; cb < 6144 / 32; cb += F.G) {
            const int l15 = F.lane & 15, lq = F.lane >> 4, k0 = 128 * F.wave + lq;
            const float* wp = wada + (size_t)k0 * 6144 + cb * 32 + 2 * l15;
            f32x2 wv[32];
#pragma unroll
            for (int i = 0; i < 32; ++i) wv[i] = __builtin_nontemporal_load((const f32x2*)(wp + (size_t)(4 * i) * 6144));
            f32x2 s[4] = {{0.f, 0.f}, {0.f, 0.f}, {0.f, 0.f}, {0.f, 0.f}};
#pragma unroll
            for (int i = 0; i < 32; ++i) { const f32x4 cv = cs4[k0 + 4 * i];
#pragma unroll
                for (int b = 0; b < 4; ++b) s[b] += wv[i] * cv[b]; }
#pragma unroll
            for (int b = 0; b < 4; ++b) { f32x2 t = s[b];
                t.x += __shfl_xor(t.x, 16); t.y += __shfl_xor(t.y, 16); t.x += __shfl_xor(t.x, 32); t.y += __shfl_xor(t.y, 32);
                if (lq == 0) *(LAS f32x2*)(red + (F.wave * 4 + b) * 32 + 2 * l15) = t; }
            __syncthreads();
            if (F.tid < 128) { const int b = F.tid >> 5, cc = F.tid & 31; float t = bada[cb * 32 + cc];
#pragma unroll
                for (int w = 0; w < 8; ++w) t += red[(w * 4 + b) * 32 + cc];
                mod[b * 6144 + cb * 32 + cc] = t; }
            __syncthreads();
        }
    }
    if (F.bid == 0) {
        float* sm = (float*)(ws + WS_SMALL);
        if (F.tid == 0) {
            float s1 = 0.f, s2 = 0.f;
            for (int i = 0; i < 64; ++i) { s1 += a.in[I_LQ1][i] * a.in[I_LK1][i]; s2 += a.in[I_LQ2][i] * a.in[I_LK2][i]; }
            sm[0] = expf(s1) - expf(s2) + 0.2f;
        }
        { const float l0 = a.in[I_LBL][F.tid], l1 = a.in[I_LBL][512 + F.tid]; const float mx = fmaxf(l0, l1);
          const float e0 = expf(l0 - mx), e1 = expf(l1 - mx); sm[16 + F.tid] = e0 / (e0 + e1); }
    }
}
__device__ __forceinline__ void moe_w2_convert(const Frame& F, const Args& a, int it_lo, int it_hi, int gw, int NGW) {
    LAS float* scr = (LAS float*)(F.lds + F.wave * 8448);
    bf16_t* w2t = (bf16_t*)((unsigned char*)a.out + OUT_W2); const float* w2 = a.in[I_W2];
    transpose_stream(it_lo, it_hi, gw, NGW, scr, F.lane, [=](int it) { const int e = it >> 8, kb = (it >> 5) & 7, nb = it & 31;
        return TItem{w2 + (size_t)e * 512 * 1024 + (size_t)(64 * kb) * 1024 + 32 * nb, w2t + ((size_t)e * 1024 + 32 * nb) * 512 + 64 * kb, 1024, 512}; });
}
__device__ __forceinline__ int w2_early_items(int G, int& n_light) { const int nwg = (T / 256) * (INC / 256), r = nwg % G; n_light = r ? G - r : 0; return n_light >= 64 ? W2_EARLY * 256 : 0; }
__device__ __forceinline__ void moe_weight_convert(const Frame& F, const Args& a) {
    LAS float* scr = (LAS float*)(F.lds + F.wave * 8448);
    const int gw = F.bid * NWAVES + F.wave, NGW = F.G * NWAVES;
    bf16_t* w13 = (bf16_t*)(a.ws + WS_W13);
    const float* w1 = a.in[I_W1]; const float* w3 = a.in[I_W3];
    transpose_stream(0, 2 * NEXP * 256, gw, NGW, scr, F.lane, [=](int it) {
        const int which = it / (NEXP * 256), r = it % (NEXP * 256), e = r >> 8, kb = (r >> 4) & 15, nb = r & 15, n0 = 32 * nb;
        const float* W = (which ? w3 : w1) + (size_t)e * 1024 * 512;
        const int drow = 256 * (n0 >> 7) + (which ? 128 : 0) + (n0 & 127);
        return TItem{W + (size_t)(64 * kb) * 512 + n0, w13 + ((size_t)e * 1024 + drow) * 1024 + 64 * kb, 512, 1024}; });
    int nl; const int early = w2_early_items(F.G, nl);
    moe_w2_convert(F, a, early, NEXP * 256, gw, NGW);
}

__device__ __forceinline__ void dense_weight_convert(const Frame& F, const Args& a) {
    unsigned char* ws = a.ws;
    {
        LAS float* scr = (LAS float*)(F.lds + F.wave * 8448);
        const int gw = F.bid * NWAVES + F.wave, NGW = F.G * NWAVES, nblk = INC / 32, items = (D / 64) * nblk;
        bf16_t* WT = (bf16_t*)(ws + WS_WIN);
        const float* win = a.in[I_WIN];
        transpose_stream(0, items, gw, NGW, scr, F.lane, [=](int it) { const int kb = it / nblk, n0 = 32 * (it % nblk); int dr = n0;
            if (n0 >= C_QHG && n0 < C_FHG) dr = C_HGT + 256 * ((n0 - C_QHG) >> 7) + ((n0 - C_QHG) & 127);
            else if (n0 >= C_FHG && n0 < C_IHG) dr = C_HGT + 256 * ((n0 - C_FHG) >> 7) + 128 + ((n0 - C_FHG) & 127);
            return TItem{win + (size_t)(64 * kb) * INC + n0, WT + (size_t)dr * D + 64 * kb, INC, D}; });
    }
    transpose_matrix(F, a.in[I_WUPDA], 512, D, (bf16_t*)(ws + WS_WUPDA));
    transpose_matrix(F, a.in[I_WUPHG], 512, D, (bf16_t*)(ws + WS_WUPHG));
    transpose_matrix(F, a.in[I_WOUT], D, D, (bf16_t*)(ws + WS_WOUT));
}
__device__ __forceinline__ void phase1(const Frame& F, const Args& a) {
    const float* mod = (const float*)(a.ws + WS_MOD);
    LAS float* Gs = (LAS float*)F.lds;
    LAS float* Ss = Gs + 1024;
    bf16_t* H = (bf16_t*)(a.ws + WS_ACT);
    const int rows_per_blk = T / F.G;
    const int r0 = F.bid * rows_per_blk, b = r0 / SEQ;
    for (int k = F.tid; k < 1024; k += NTHR) { Gs[k] = a.in[I_N1G][k] * (1.0f + mod[b * 6144 + 1024 + k]); Ss[k] = mod[b * 6144 + k]; }
    __syncthreads();
    for (int rb = r0 + F.wave; rb < r0 + rows_per_blk; rb += 4 * NWAVES) {
        f32x4 v[4][4];
#pragma unroll
        for (int q = 0; q < 4; ++q) { const int r = rb + q * NWAVES < r0 + rows_per_blk ? rb + q * NWAVES : rb; const f32x4* xr = (const f32x4*)(a.in[I_X] + (size_t)r * D) + F.lane;
#pragma unroll
            for (int j = 0; j < 4; ++j) v[q][j] = __builtin_nontemporal_load(xr + 64 * j); }
#pragma unroll
        for (int q = 0; q < 4; ++q) { const int r = rb + q * NWAVES; if (r >= r0 + rows_per_blk) break;
            float s = 0.f;
#pragma unroll
            for (int j = 0; j < 4; ++j) s += (v[q][j].x * v[q][j].x + v[q][j].y * v[q][j].y) + (v[q][j].z * v[q][j].z + v[q][j].w * v[q][j].w);
            const float rs = rsqrtf(wave_sum(s) * (1.0f / D) + EPS);
            unsigned long long* o8 = (unsigned long long*)(H + (size_t)r * D) + F.lane;
#pragma unroll
            for (int j = 0; j < 4; ++j) { const f32x4 g = *(const LAS f32x4*)(Gs + 256 * j + 4 * F.lane), sh = *(const LAS f32x4*)(Ss + 256 * j + 4 * F.lane);
                const f32x4 h = v[q][j] * rs * g + sh;
                o8[64 * j] = (unsigned long long)pk2(h.x, h.y) | ((unsigned long long)pk2(h.z, h.w) << 32); } }
    }
}

namespace attn_body {
using s16x4=__attribute__((ext_vector_type(4)))short;
using f32x16=__attribute__((ext_vector_type(16)))float;
constexpr int NW=8,QBLK=32,QB=QBLK*NW,KVBLK=64,NQB=SEQ/QB;
constexpr int PIN=INC, POUT=1024;
__device__ __forceinline__ int crow(int r,int hi){return (r&3)+8*(r>>2)+4*hi;}
#define SBAR() __builtin_amdgcn_sched_barrier(0)
__device__ __forceinline__ void bmask(f32x16&p0,f32x16&p1,int jb,int wch,int il,int hi,float s2x2){
  if(jb>wch){
    #pragma unroll
    for(int r=0;r<16;++r){p0[r]=-INFINITY;p1[r]=-INFINITY;}
  } else if(jb==wch){
    float fb=(float)(4*hi-il); asm volatile("":"+v"(fb));
    #pragma unroll
    for(int r=0;r<16;++r){const float c=(float)((r&3)+8*(r>>2)); p0[r]-=s2x2*__builtin_fmaxf(fb+c,0.f); p1[r]-=s2x2*__builtin_fmaxf(fb+(c+32.f),0.f);}
  }
}
constexpr int NSLOT=3, SLOTB=8192, VSLOTB=16384;
constexpr int LDS_K=0, LDS_V=NSLOT*SLOTB, LDS_WS=LDS_V+NSLOT*VSLOTB, LDS_OST=LDS_WS+NW*64*4, ATT_LDS_BYTES=LDS_OST+NW*8192;
constexpr float C2=0.125f*1.4426950408889634f;
__device__ __forceinline__ void glds16(const void*gsrc,unsigned lds_dst){unsigned keep;
  asm volatile("s_mov_b32 %0, m0\n\ts_mov_b32 m0, %2\n\ts_nop 0\n\tglobal_load_lds_dwordx4 %1, off\n\ts_mov_b32 m0, %0":"=&s"(keep):"v"(gsrc),"s"(lds_dst):"memory");}
__device__ __forceinline__ float max3f(float a,float b,float c){float r;asm("v_max3_f32 %0, %1, %2, %3":"=v"(r):"v"(a),"v"(b),"v"(c));return r;}
__device__ __forceinline__ float max2f(float a,float b){float r;asm("v_max_f32_e32 %0, %1, %2":"=v"(r):"v"(a),"v"(b));return r;}
__device__ __forceinline__ float fadd_s(float a,float b){float r;asm("v_add_f32_e32 %0, %1, %2":"=v"(r):"v"(a),"v"(b));return r;}
__device__ __forceinline__ float fsub_s(float a,float b){float r;asm("v_sub_f32_e32 %0, %1, %2":"=v"(r):"v"(a),"v"(b));return r;}
typedef float f32x2_t __attribute__((ext_vector_type(2))); typedef __bf16 bf16x2_t __attribute__((ext_vector_type(2)));
__device__ __forceinline__ unsigned cvtpk_s(float lo,float hi){f32x2_t v={lo,hi};bf16x2_t b=__builtin_convertvector(v,bf16x2_t);return __builtin_bit_cast(unsigned,b);}
#define WAIT_BAR(N) asm volatile("s_waitcnt vmcnt(" #N ") lgkmcnt(0)\n\ts_barrier":::"memory")

__device__ __forceinline__ void qkt(f32x16&p0,f32x16&p1,const char*Kslot,const bf16x8*qr,const f32x16&c0,const f32x16&c1,int r32,int hi){
  const char*kb=Kslot+hi*1024+r32*16;
  #pragma unroll
  for(int d0=0;d0<4;++d0){
    const bf16x8 b0=*reinterpret_cast<const bf16x8*>(kb+d0*2048);
    const bf16x8 b1=*reinterpret_cast<const bf16x8*>(kb+d0*2048+512);
    if(d0==0){p0=__builtin_amdgcn_mfma_f32_32x32x16_bf16(b0,qr[0],c0,0,0,0);p1=__builtin_amdgcn_mfma_f32_32x32x16_bf16(b1,qr[0],c1,0,0,0);}
    else{p0=__builtin_amdgcn_mfma_f32_32x32x16_bf16(b0,qr[d0],p0,0,0,0);p1=__builtin_amdgcn_mfma_f32_32x32x16_bf16(b1,qr[d0],p1,0,0,0);}}
}
typedef __attribute__((address_space(3))) const char* lds_cptr;
typedef short v4i16_t __attribute__((ext_vector_type(4)));
__device__ __forceinline__ void kload8(bf16x8*kf,lds_cptr kp){
  kf[0]=*(const __attribute__((address_space(3))) bf16x8*)(kp);      kf[1]=*(const __attribute__((address_space(3))) bf16x8*)(kp+512);
  kf[2]=*(const __attribute__((address_space(3))) bf16x8*)(kp+2048); kf[3]=*(const __attribute__((address_space(3))) bf16x8*)(kp+2560);
  kf[4]=*(const __attribute__((address_space(3))) bf16x8*)(kp+4096); kf[5]=*(const __attribute__((address_space(3))) bf16x8*)(kp+4608);
  kf[6]=*(const __attribute__((address_space(3))) bf16x8*)(kp+6144); kf[7]=*(const __attribute__((address_space(3))) bf16x8*)(kp+6656);
}
__device__ __forceinline__ void kload2(bf16x8*kf,lds_cptr kp,int j){ kf[2*j]=*(const __attribute__((address_space(3))) bf16x8*)(kp+j*2048); kf[2*j+1]=*(const __attribute__((address_space(3))) bf16x8*)(kp+j*2048+512); }
__device__ __forceinline__ s16x4 vtr(lds_cptr p){ return __builtin_bit_cast(s16x4,__builtin_amdgcn_ds_read_tr16_b64_v4i16((__attribute__((address_space(3))) v4i16_t*)p)); }
__device__ __forceinline__ float rowmax(const f32x16&p0,const f32x16&p1){
  float a=max3f(p0[0],p0[1],p1[0]),b=max3f(p0[2],p0[3],p1[1]);a=max3f(a,p1[2],p1[3]);
  #pragma unroll
  for(int r=4;r<16;r+=4){a=max3f(a,p0[r],p0[r+1]);b=max3f(b,p0[r+2],p0[r+3]);a=max3f(a,p1[r],p1[r+1]);b=max3f(b,p1[r+2],p1[r+3]);}
  const float m=max2f(a,b);
  auto rr=__builtin_amdgcn_permlane32_swap(__float_as_uint(m),__float_as_uint(m),false,false);
  return max2f(__uint_as_float(rr[0]),__uint_as_float(rr[1]));
}
__device__ __forceinline__ void pv(f32x16*o,int vb,bf16x8 pa0,bf16x8 pa1,bf16x8 pa2,bf16x8 pa3){
  #pragma unroll
  for(int d0=0;d0<4;++d0){s16x4 lo[4],hi[4];
    #pragma unroll
    for(int ks=0;ks<4;++ks){
      asm volatile("ds_read_b64_tr_b16 %0,%1 offset:%c2":"=&v"(lo[ks]):"v"(vb),"i"(d0*4096+ks*1024):"memory");
      asm volatile("ds_read_b64_tr_b16 %0,%1 offset:%c2":"=&v"(hi[ks]):"v"(vb),"i"(d0*4096+ks*1024+512):"memory");}
    asm volatile("s_waitcnt lgkmcnt(0)":::"memory");SBAR();
    #define PK(k) (bf16x8){lo[k][0],lo[k][1],lo[k][2],lo[k][3],hi[k][0],hi[k][1],hi[k][2],hi[k][3]}
    o[d0]=__builtin_amdgcn_mfma_f32_32x32x16_bf16(pa0,PK(0),o[d0],0,0,0);
    o[d0]=__builtin_amdgcn_mfma_f32_32x32x16_bf16(pa1,PK(1),o[d0],0,0,0);
    o[d0]=__builtin_amdgcn_mfma_f32_32x32x16_bf16(pa2,PK(2),o[d0],0,0,0);
    o[d0]=__builtin_amdgcn_mfma_f32_32x32x16_bf16(pa3,PK(3),o[d0],0,0,0);
    #undef PK
  }
}
#define ATTN_STORE16(p,v) (*(u32x4*)(p)=(v))
template<int THRL> __device__ __forceinline__ void attn_unit(int qb,const bf16_t*Qb,const bf16_t*__restrict__ Kh,const bf16_t*__restrict__ Vh,bf16_t*Ob,float slope2,char*shm){
  const int wid=__builtin_amdgcn_readfirstlane(threadIdx.x>>6); const int lane=lane_now(),r32=lane&31,hi=lane>>5;
  const int q0=qb*QB;
  const bf16_t*Qw=Qb+(long)(q0+wid*QBLK)*PIN;
  const unsigned lds0=(unsigned)(uintptr_t)shm;
  float*wsf=(float*)(shm+LDS_WS)+wid*64;
  const bf16_t*ksrc=Kh+(long)lane*PIN+wid*8;
  const bf16_t*vsrc=Vh+(long)(16*(wid&3)+(lane>>2))*PIN+(wid>>2)*32+(lane&3)*8;
  const unsigned kdst=lds0+LDS_K+wid*1024, vdst=lds0+LDS_V+(wid>>2)*4096+(wid&3)*1024;
  #define DMA_K(t,slot) glds16(ksrc+(long)(t)*KVBLK*PIN,(unsigned)__builtin_amdgcn_readfirstlane(kdst+(slot)))
  #define DMA_V(t,slot) do{ glds16(vsrc+(long)(t)*KVBLK*PIN,(unsigned)__builtin_amdgcn_readfirstlane(vdst+2*(slot))); glds16(vsrc+(long)(t)*KVBLK*PIN+64,(unsigned)__builtin_amdgcn_readfirstlane(vdst+2*(slot)+8192)); }while(0)
  const int vb0=(int)(lds0+LDS_V)+((lane>>4)&1)*32+(lane&3)*8+(4*hi+((lane&15)>>2))*64;
  const char*Kbase=shm+LDS_K; bf16x8 kf[8];
  const lds_cptr shm3=(lds_cptr)shm; const lds_cptr kp0=shm3+LDS_K+hi*1024+r32*16; const lds_cptr vp0=shm3+LDS_V+((lane>>4)&1)*32+(lane&3)*8+(4*hi+((lane&15)>>2))*64;
  const int NT=(q0+QB)/KVBLK;
  DMA_K(0,0);DMA_V(0,0);DMA_K(1,SLOTB);
  bf16x8 qr[4];
  #pragma unroll
  for(int d0=0;d0<4;++d0)qr[d0]=*reinterpret_cast<const bf16x8*>(&Qw[(long)r32*PIN+d0*16+hi*8]);
  float mhat=0.f,l_reg=0.f;f32x16 o[4];o[0]=f32x16{};o[1]=f32x16{};o[2]=f32x16{};o[3]=f32x16{};
  const float s64=slope2*64.f, s32=slope2*32.f, s2x2=2.f*slope2, s4hi=slope2*4.f*(float)hi;
  const int wch=wid>>1, il=32*(wid&1)+r32;
  #define CMASK(P0,P1,t) do{int jb_=(t)-(NT-4); if(jb_>=0)bmask(P0,P1,jb_,wch,il,hi,s2x2);}while(0)
  #define CINIT0(C0,t) do{ const float bt_=s64*(float)((t)-NT)-mhat+s4hi; _Pragma("unroll") for(int r=0;r<16;++r){C0[r]=__builtin_fmaf(slope2,(float)((r&3)+8*(r>>2)),bt_);} }while(0)
  #define CINIT1(C1,t) do{ const float bu_=s64*(float)((t)-NT)-mhat+s4hi+s32; _Pragma("unroll") for(int r=0;r<16;++r){C1[r]=__builtin_fmaf(slope2,(float)((r&3)+8*(r>>2)),bu_);} }while(0)
  bool resc=false;
  #define START(P0,P1) do{ const float rm=rowmax(P0,P1); resc=false; \
    { const float dl=rm; mhat=fadd_s(mhat,dl); \
      _Pragma("unroll") for(int r=0;r<16;++r){P0[r]=fsub_s(P0[r],dl);P1[r]=fsub_s(P1[r],dl);} } \
    _Pragma("unroll") for(int r=0;r<16;++r)P0[r]=__builtin_amdgcn_exp2f(P0[r]); }while(0)
  #define RESC() do{ if(resc){ asm volatile("s_waitcnt lgkmcnt(0)":::"memory"); \
      _Pragma("unroll") for(int d_=0;d_<4;++d_) _Pragma("unroll") for(int r=0;r<16;++r)o[d_][r]*=wsf[crow(r,hi)]; } }while(0)
  f32x16 cS0,cS1;
  u32x4 pwa0,pwa1,pwa2,pwa3,pwb0,pwb1,pwb2,pwb3;
  int sl_prev=0,sl_cur=0,sl_next=SLOTB;
  #define ROT() do{sl_prev=sl_cur;sl_cur=sl_next;sl_next=(sl_next==(NSLOT-1)*SLOTB)?0:sl_next+SLOTB;}while(0)
  #define PKW(P,B) cvtpk_s(P[B],P[B+1])
  DMA_K(2,2*SLOTB);
  WAIT_BAR(3);
  { f32x16 c0,c1; CINIT0(c0,0); CINIT1(c1,0); qkt(cS0,cS1,Kbase,qr,c0,c1,r32,hi); }
  asm volatile("s_nop 15\n\ts_nop 7":"+v"(cS0),"+v"(cS1));CMASK(cS0,cS1,0);
  START(cS0,cS1);
  _Pragma("unroll") for(int r=0;r<16;++r)cS1[r]=__builtin_amdgcn_exp2f(cS1[r]);
  { float sacc=cS0[0]+cS0[1]; _Pragma("unroll") for(int r=2;r<16;++r)sacc+=cS0[r]; _Pragma("unroll") for(int r=0;r<16;++r)sacc+=cS1[r]; l_reg+=sacc;
    pwa0=(u32x4){PKW(cS0,0),PKW(cS0,2),PKW(cS0,4),PKW(cS0,6)};pwa1=(u32x4){PKW(cS0,8),PKW(cS0,10),PKW(cS0,12),PKW(cS0,14)};pwa2=(u32x4){PKW(cS1,0),PKW(cS1,2),PKW(cS1,4),PKW(cS1,6)};pwa3=(u32x4){PKW(cS1,8),PKW(cS1,10),PKW(cS1,12),PKW(cS1,14)}; }
  WAIT_BAR(0);
  DMA_K(3,0);DMA_V(1,SLOTB);
  ROT();
  kload8(kf,kp0+sl_cur);
  WAIT_BAR(3);
  s16x4 vlo[4],vhi[4];
  #define CAT_(a,b) a##b
  #define CAT(a,b) CAT_(a,b)
  #define PAFC(P,k) __builtin_bit_cast(bf16x8,CAT(P,k))
  #define VFR(k) (bf16x8){vlo[(k)&3][0],vlo[(k)&3][1],vlo[(k)&3][2],vlo[(k)&3][3],vhi[(k)&3][0],vhi[(k)&3][1],vhi[(k)&3][2],vhi[(k)&3][3]}
  #define VOFF(k) ((k)<8 ? (((k)&1)*4096+((k)>>1)*1024) : ((2+((k)&1))*4096+(((k)-8)>>1)*1024))
  #define PIN_(x) asm volatile("":"+v"(x))
  #define MX3(a,b,c) __builtin_fmaxf(__builtin_fmaxf((a),(b)),(c))
  #define QK(MF) do{ MF; SBAR(); }while(0)
  #define EX(v) __builtin_amdgcn_exp2f(v)
  #define VRD(k) do{ vlo[(k)&3]=vtr(vp_+VOFF(k)); vhi[(k)&3]=vtr(vp_+(VOFF(k)+512)); }while(0)
  #define VNX(k) do{ if((k)+4<16){ VRD((k)+4); } SBAR(); }while(0)
  #define GAPB3(MF,X,B,PW,J) do{ MF; X[B]=EX(X[B]); X[B+1]=EX(X[B+1]); sacc+=X[B]; sacc+=X[B+1]; PW[J]=cvtpk_s(X[B],X[B+1]); PIN_(X); PIN_(sacc); PIN_(PW); SBAR(); }while(0)
  #define KRD(G,j) do{ if(G){ kload2(kf,kp0+sl_next,j); SBAR(); } }while(0)
  #define STEP(PC,PN,t,GK,GV,GL) do{ SBAR(); \
    CINIT0(cS0,t); SBAR(); \
    const lds_cptr vp_=vp0+2*sl_prev; \
    VRD(0); SBAR(); QK(cS0=__builtin_amdgcn_mfma_f32_32x32x16_bf16(kf[0],qr[0],cS0,0,0,0)); \
    CINIT1(cS1,t); VRD(1); SBAR(); QK(cS1=__builtin_amdgcn_mfma_f32_32x32x16_bf16(kf[1],qr[0],cS1,0,0,0)); \
    VRD(2); SBAR(); QK(cS0=__builtin_amdgcn_mfma_f32_32x32x16_bf16(kf[2],qr[1],cS0,0,0,0)); \
    VRD(3); SBAR(); QK(cS1=__builtin_amdgcn_mfma_f32_32x32x16_bf16(kf[3],qr[1],cS1,0,0,0)); \
    QK(cS0=__builtin_amdgcn_mfma_f32_32x32x16_bf16(kf[4],qr[2],cS0,0,0,0)); \
    QK(cS1=__builtin_amdgcn_mfma_f32_32x32x16_bf16(kf[5],qr[2],cS1,0,0,0)); \
    QK(cS0=__builtin_amdgcn_mfma_f32_32x32x16_bf16(kf[6],qr[3],cS0,0,0,0)); \
    QK(cS1=__builtin_amdgcn_mfma_f32_32x32x16_bf16(kf[7],qr[3],cS1,0,0,0)); \
    if(GK){DMA_K((t)+3,sl_cur);} if(GV){DMA_V((t)+1,sl_next);} \
    CMASK(cS0,cS1,t); \
    { float a=MX3(cS0[0],cS0[1],cS1[0]),b=MX3(cS0[2],cS0[3],cS1[1]); a=MX3(a,cS1[2],cS1[3]); \
      _Pragma("unroll") for(int r=4;r<16;r+=4){a=MX3(a,cS0[r],cS0[r+1]);b=MX3(b,cS0[r+2],cS0[r+3]);a=MX3(a,cS1[r],cS1[r+1]);b=MX3(b,cS1[r+2],cS1[r+3]);} \
      float rm=__builtin_fmaxf(a,b); { auto rr=__builtin_amdgcn_permlane32_swap(__float_as_uint(rm),__float_as_uint(rm),false,false); rm=__builtin_fmaxf(__uint_as_float(rr[0]),__uint_as_float(rr[1])); } \
      resc=false; \
      if(__builtin_expect(__any(rm>(float)THRL),0)){ const float dl=__builtin_fmaxf(rm,0.f); mhat+=dl; \
        _Pragma("unroll") for(int r=0;r<16;++r){cS0[r]-=dl;cS1[r]-=dl;} \
        const float f=__builtin_amdgcn_exp2f(-dl); l_reg*=f; if(hi==0)wsf[r32]=f; resc=true; } } \
    SBAR(); float sacc=0.f; \
    GAPB3(o[0]=__builtin_amdgcn_mfma_f32_32x32x16_bf16(PAFC(PC,0),VFR(0),o[0],0,0,0), cS0,0, CAT(PN,0),0); VNX(0); \
    GAPB3(o[1]=__builtin_amdgcn_mfma_f32_32x32x16_bf16(PAFC(PC,0),VFR(1),o[1],0,0,0), cS0,2, CAT(PN,0),1); VNX(1); \
    KRD(GL,0); GAPB3(o[0]=__builtin_amdgcn_mfma_f32_32x32x16_bf16(PAFC(PC,1),VFR(2),o[0],0,0,0), cS0,4, CAT(PN,0),2); VNX(2); \
    KRD(GL,1); GAPB3(o[1]=__builtin_amdgcn_mfma_f32_32x32x16_bf16(PAFC(PC,1),VFR(3),o[1],0,0,0), cS0,6, CAT(PN,0),3); VNX(3); \
    KRD(GL,2); GAPB3(o[0]=__builtin_amdgcn_mfma_f32_32x32x16_bf16(PAFC(PC,2),VFR(4),o[0],0,0,0), cS0,8, CAT(PN,1),0); VNX(4); \
    KRD(GL,3); GAPB3(o[1]=__builtin_amdgcn_mfma_f32_32x32x16_bf16(PAFC(PC,2),VFR(5),o[1],0,0,0), cS0,10, CAT(PN,1),1); VNX(5); \
    GAPB3(o[0]=__builtin_amdgcn_mfma_f32_32x32x16_bf16(PAFC(PC,3),VFR(6),o[0],0,0,0), cS0,12, CAT(PN,1),2); VNX(6); \
    GAPB3(o[1]=__builtin_amdgcn_mfma_f32_32x32x16_bf16(PAFC(PC,3),VFR(7),o[1],0,0,0), cS0,14, CAT(PN,1),3); VNX(7); \
    GAPB3(o[2]=__builtin_amdgcn_mfma_f32_32x32x16_bf16(PAFC(PC,0),VFR(8),o[2],0,0,0), cS1,0, CAT(PN,2),0); VNX(8); \
    GAPB3(o[3]=__builtin_amdgcn_mfma_f32_32x32x16_bf16(PAFC(PC,0),VFR(9),o[3],0,0,0), cS1,2, CAT(PN,2),1); VNX(9); \
    GAPB3(o[2]=__builtin_amdgcn_mfma_f32_32x32x16_bf16(PAFC(PC,1),VFR(10),o[2],0,0,0), cS1,4, CAT(PN,2),2); VNX(10); \
    GAPB3(o[3]=__builtin_amdgcn_mfma_f32_32x32x16_bf16(PAFC(PC,1),VFR(11),o[3],0,0,0), cS1,6, CAT(PN,2),3); VNX(11); \
    GAPB3(o[2]=__builtin_amdgcn_mfma_f32_32x32x16_bf16(PAFC(PC,2),VFR(12),o[2],0,0,0), cS1,8, CAT(PN,3),0); VNX(12); \
    GAPB3(o[3]=__builtin_amdgcn_mfma_f32_32x32x16_bf16(PAFC(PC,2),VFR(13),o[3],0,0,0), cS1,10, CAT(PN,3),1); VNX(13); \
    GAPB3(o[2]=__builtin_amdgcn_mfma_f32_32x32x16_bf16(PAFC(PC,3),VFR(14),o[2],0,0,0), cS1,12, CAT(PN,3),2); VNX(14); \
    GAPB3(o[3]=__builtin_amdgcn_mfma_f32_32x32x16_bf16(PAFC(PC,3),VFR(15),o[3],0,0,0), cS1,14, CAT(PN,3),3); VNX(15); \
    l_reg+=sacc; \
    }while(0)
  int t=1;
  #undef CMASK
  #define CMASK(P0,P1,t) do{}while(0)
  for(;t+5<NT;t+=2){
    STEP(pwa,pwb,t,true,true,true);     WAIT_BAR(3); RESC(); ROT();
    STEP(pwb,pwa,t+1,true,true,true);   WAIT_BAR(3); RESC(); ROT();
  }
  #undef CMASK
  #define CMASK(P0,P1,t) do{int jb_=(t)-(NT-4); if(jb_>=0)bmask(P0,P1,jb_,wch,il,hi,s2x2);}while(0)
  #define ENDW(tt) do{ if((tt)+3<NT){WAIT_BAR(3);} else if((tt)+2<NT){WAIT_BAR(2);} else {WAIT_BAR(0);} }while(0)
  for(;t+1<NT;t+=2){
    STEP(pwa,pwb,t,(t+3<NT),(t+1<NT),(t+1<NT));       ENDW(t);   RESC(); ROT();
    STEP(pwb,pwa,t+1,(t+4<NT),(t+2<NT),(t+2<NT));     ENDW(t+1); RESC(); ROT();
  }
  STEP(pwa,pwb,NT-1,false,false,false); RESC();
  SBAR(); pv(o,vb0+2*sl_cur,PAFC(pwb,0),PAFC(pwb,1),PAFC(pwb,2),PAFC(pwb,3));
  #undef PKW
  #undef PAFC
  #undef CAT
  #undef CAT_
  #undef QK
  #undef GAPB3
  #undef VFR
  #undef PIN_
  #undef MX3
  #undef EX
  #undef VRD
  #undef VNX
  #undef VOFF
  #undef GAPB2
  #undef KRD
  #undef STEP
  #undef ENDW
  {auto rr=__builtin_amdgcn_permlane32_swap(__float_as_uint(l_reg),__float_as_uint(l_reg),false,false);l_reg=__uint_as_float(rr[0])+__uint_as_float(rr[1]);}
  {
    const int le=lane_now(), r32e=le&31, hie=le>>5;
    float*wsfe=(float*)(shm+LDS_WS)+wid*64;
    if(hie==0)wsfe[32+r32e]=l_reg;asm volatile("s_waitcnt lgkmcnt(0)":::"memory");
    float rli[16];
    #pragma unroll
    for(int r=0;r<16;++r)rli[r]=__builtin_amdgcn_rcpf(wsfe[32+crow(r,hie)]);
    bf16_t*Ow=Ob+(long)(q0+wid*QBLK)*POUT;
    bf16_t*stg=(bf16_t*)(shm+LDS_OST)+wid*4096;
    #pragma unroll
    for(int r=0;r<16;++r){const int orow=crow(r,hie);
      #pragma unroll
      for(int d0=0;d0<4;++d0)stg[orow*128+d0*32+r32e]=(bf16_t)f2bf(o[d0][r]*rli[r]);}
    asm volatile("s_waitcnt lgkmcnt(0)":::"memory");
    #pragma unroll
    for(int i=0;i<8;++i){const int row=i*4+(le>>4),ch=le&15; const u32x4 v=*(const u32x4*)(stg+row*128+ch*8); ATTN_STORE16(Ow+(long)row*POUT+ch*8,v);} }
  asm volatile("s_waitcnt lgkmcnt(0)\n\ts_barrier":::"memory");
  #undef DMA_K
  #undef DMA_V
  #undef CMASK
  #undef CINIT0
  #undef CINIT1
  #undef START
  #undef RESC
  #undef ROT
}
#undef SBAR
#undef WAIT_BAR
}

__device__ __forceinline__ void attn_phase(const Frame& F, const Args& a) {
    const bf16_t* proj = (const bf16_t*)(a.ws + WS_PROJ); bf16_t* OA = (bf16_t*)(a.ws + WS_OA);
    const int vcu = (F.G % 8 == 0) ? (F.bid % 8) * (F.G / 8) + F.bid / 8 : F.bid;
    for (int i = 0;; ++i) {
        int bhm, qb;
        if (F.G == 256) { if (i >= 2) break; const int s_ = vcu & 7; bhm = vcu >> 3; qb = (i == 0) ? 15 - s_ : s_; }
        else { const int u = i * F.G + F.bid; if (u >= 512) break; bhm = u >> 4; qb = 15 - (u & 15); }
        const int b = bhm >> 3, h = (bhm >> 1) & 3, map = bhm & 1;
        const bf16_t* base = proj + (size_t)b * SEQ * INC;
        const float slope2 = exp2f(-2.0f * (h + 1)) * 1.4426950408889634f;
        attn_body::attn_unit<8>(qb, base + C_QDA + h * 128 + map * 64, base + C_KDA + h * 128 + map * 64, base + C_VDA + h * 128,
                                OA + (size_t)b * SEQ * 1024 + h * 256 + map * 128, slope2, (char*)F.lds);
    }
}
__device__ __forceinline__ void attn_combine(const Frame& F, const Args& a) {
    const bf16_t* OA = (const bf16_t*)(a.ws + WS_OA); bf16_t* Y = (bf16_t*)(a.ws + WS_YDA);
    const float lam = ((const float*)(a.ws + WS_SMALL))[0];
    const float g0 = a.in[I_SUBG][2 * F.lane] * 0.8f, g1 = a.in[I_SUBG][2 * F.lane + 1] * 0.8f;
    const int gw = F.bid * NWAVES + F.wave, NGW = F.G * NWAVES;
    for (int r = gw; r < T; r += NGW) {
        const unsigned* orow = (const unsigned*)(OA + (size_t)r * 1024); unsigned* yrow = (unsigned*)(Y + (size_t)r * 512);
        unsigned w0[4], w1[4];
#pragma unroll
        for (int h = 0; h < 4; ++h) { w0[h] = orow[h * 128 + F.lane]; w1[h] = orow[h * 128 + 64 + F.lane]; }
#pragma unroll
        for (int h = 0; h < 4; ++h) {
            const float x0 = bf2f(w0[h] & 0xffffu) - lam * bf2f(w1[h] & 0xffffu), x1 = bf2f(w0[h] >> 16) - lam * bf2f(w1[h] >> 16);
            const float rs = rsqrtf(wave_sum(x0 * x0 + x1 * x1) * (1.0f / 128.0f) + EPS);
            yrow[h * 64 + F.lane] = pk2(x0 * rs * g0, x1 * rs * g1);
        }
    }
}
namespace hg {
constexpr int QP = 136;
constexpr int L_QD = 0, L_KD = 64 * QP * 2, L_V = 2 * 64 * QP * 2, L_KE = 3 * 64 * QP * 2, L_SSQ = 4 * 64 * QP * 2, L_G = L_SSQ + 512, L_ST = L_G + 64 * QP * 2;
__device__ __forceinline__ f32x4 mfma16(bf16x8 a, bf16x8 b, f32x4 c) { return __builtin_amdgcn_mfma_f32_16x16x32_bf16(a, b, c, 0, 0, 0); }
#define HG_BAR() do { asm volatile("s_waitcnt lgkmcnt(0)" ::: "memory"); __builtin_amdgcn_s_barrier(); asm volatile("" ::: "memory"); } while (0)
typedef short v4i16_t __attribute__((ext_vector_type(4)));
__device__ __forceinline__ bf16x8 tr8(const LAS unsigned char* img, int ra, int rb, int col0, int lane) {
    const int q = (lane & 15) >> 2, p = lane & 3;
    const v4i16_t lo = __builtin_amdgcn_ds_read_tr16_b64_v4i16((LAS v4i16_t*)(img + ((ra + q) * QP + col0 + 4 * p) * 2));
    const v4i16_t hi = __builtin_amdgcn_ds_read_tr16_b64_v4i16((LAS v4i16_t*)(img + ((rb + q) * QP + col0 + 4 * p) * 2));
    return (bf16x8){lo[0], lo[1], lo[2], lo[3], hi[0], hi[1], hi[2], hi[3]};
}
struct Tile { u32x4 p[2]; };
__device__ __forceinline__ void tile_load(Tile& t, const bf16_t* src, size_t pitch, int tid) {
#pragma unroll
    for (int i = 0; i < 2; ++i) { const int pc = tid + NTHR * i; t.p[i] = *(const u32x4*)(src + (size_t)(pc >> 4) * pitch + (pc & 15) * 8); }
}
__device__ __forceinline__ void tile_put(const Tile& t, LAS unsigned char* img, int tid) {
#pragma unroll
    for (int i = 0; i < 2; ++i) { const int pc = tid + NTHR * i; *(LAS u32x4*)(img + ((pc >> 4) * QP + (pc & 15) * 8) * 2) = t.p[i]; }
}
constexpr int PP = 72;
constexpr int G4_L_P = 4 * 64 * QP * 2, G4_L_DEC = G4_L_P + 64 * PP * 2, G4_L_SSQ = G4_L_DEC + 512;
struct InA { Tile qd, kd, ke, v; f32x4 dec; };
__device__ __forceinline__ void loadA(InA& r, const Frame& F, const Args& a, int bh, int n) {
    const int b = bh >> 2, h = bh & 3; const size_t t0 = (size_t)b * SEQ + n * 64;
    const bf16_t* base = (const bf16_t*)(a.ws + WS_PROJ) + t0 * INC;
    tile_load(r.qd, base + C_HGT + 256 * h, INC, F.tid); tile_load(r.kd, base + C_HGT + 256 * h + 128, INC, F.tid);
    tile_load(r.ke, (const bf16_t*)a.out + t0 * 512 + h * 128, 512, F.tid); tile_load(r.v, base + C_IHG + h * 128, INC, F.tid);
    r.dec = *(const f32x4*)((const float*)(a.ws + WS_DEC) + ((size_t)bh * 64 + n) * 128 + 4 * (F.tid & 31));
}
__device__ __forceinline__ void grp_local(const Frame& F, const Args& a, int grp) {
    const int bh = grp >> 4, n0 = 4 * (grp & 15), b = bh >> 2, h = bh & 3, w = F.wave, lane = F.lane, fr = lane & 15, fq = lane >> 4;
    for (int i = F.tid; i < 64 * PP / 2; i += NTHR) ((LAS unsigned*)(F.lds + G4_L_P))[i] = 0u;
    f32x4 S[8];
#pragma unroll
    for (int kt = 0; kt < 8; ++kt) S[kt] = (f32x4){0.f, 0.f, 0.f, 0.f};
    InA cur, nxt; loadA(cur, F, a, bh, n0);
    unsigned short yk[4][4];
#define G4_STORE(nn) do { bf16_t* yp_ = (bf16_t*)(a.ws + WS_YHG) + ((size_t)b * SEQ + (nn) * 64 + 4 * fq) * 512 + h * 128 + 16 * w + fr; \
        _Pragma("unroll") for (int tb = 0; tb < 4; ++tb) _Pragma("unroll") for (int r = 0; r < 4; ++r) yp_[(size_t)(16 * tb + r) * 512] = yk[tb][r]; } while (0)
    for (int j = 0; j < 4; ++j) {
        if (j > 0) G4_STORE(n0 + j - 1);
        loadA(nxt, F, a, bh, n0 + (j < 3 ? j + 1 : 3));
        tile_put(cur.qd, F.lds + L_QD, F.tid); tile_put(cur.kd, F.lds + L_KD, F.tid); tile_put(cur.ke, F.lds + L_KE, F.tid); tile_put(cur.v, F.lds + L_V, F.tid);
        if (F.tid < 32) *(LAS f32x4*)(F.lds + G4_L_DEC + 16 * F.tid) = cur.dec;
        HG_BAR();
#pragma unroll
        for (int rep = 0; rep < 2; ++rep) { const int pi = w + 8 * rep;
            if (pi < 10) { const int tb = pi >= 6 ? 3 : pi >= 3 ? 2 : pi >= 1 ? 1 : 0, jt = pi - (tb * (tb + 1)) / 2;
                f32x4 sc = (f32x4){0.f, 0.f, 0.f, 0.f};
#pragma unroll
                for (int ks = 0; ks < 4; ++ks) { const bf16x8 kf = *(const LAS bf16x8*)(F.lds + L_KD + ((16 * jt + fr) * QP + 32 * ks + 8 * fq) * 2);
                    const bf16x8 qf = *(const LAS bf16x8*)(F.lds + L_QD + ((16 * tb + fr) * QP + 32 * ks + 8 * fq) * 2); sc = mfma16(kf, qf, sc); }
                if (jt == tb) {
#pragma unroll
                    for (int r = 0; r < 4; ++r) if (4 * fq + r > fr) sc[r] = 0.f;
                }
                *(LAS u32x2*)(F.lds + G4_L_P + ((16 * tb + fr) * PP + 16 * jt + 4 * fq) * 2) = (u32x2){cvt_pk_bf16(sc[0], sc[1]), cvt_pk_bf16(sc[2], sc[3])}; } }
        HG_BAR();
        bf16x8 bv[2];
#pragma unroll
        for (int s2 = 0; s2 < 2; ++s2) bv[s2] = tr8(F.lds + L_V, 32 * s2 + 8 * fq, 32 * s2 + 8 * fq + 4, 16 * w, lane);
        bf16x8 Sb[4];
#pragma unroll
        for (int ks = 0; ks < 4; ++ks) { const u32x4 t = (u32x4){cvt_pk_bf16(S[2 * ks][0], S[2 * ks][1]), cvt_pk_bf16(S[2 * ks][2], S[2 * ks][3]), cvt_pk_bf16(S[2 * ks + 1][0], S[2 * ks + 1][1]), cvt_pk_bf16(S[2 * ks + 1][2], S[2 * ks + 1][3])};
            Sb[ks] = __builtin_bit_cast(bf16x8, t); }
#pragma unroll
        for (int tb = 0; tb < 4; ++tb) { f32x4 o = (f32x4){0.f, 0.f, 0.f, 0.f};
#pragma unroll
            for (int s2 = 0; s2 <= (tb >> 1); ++s2) { const bf16x8 pf = *(const LAS bf16x8*)(F.lds + G4_L_P + ((16 * tb + fr) * PP + 32 * s2 + 8 * fq) * 2); o = mfma16(pf, bv[s2], o); }
            if (j > 0) {
#pragma unroll
                for (int ks = 0; ks < 4; ++ks) { const LAS unsigned char* qrow = F.lds + L_QD + ((16 * tb + fr) * QP + 32 * ks + 4 * fq) * 2;
                    const u32x2 lo = *(const LAS u32x2*)qrow, hi = *(const LAS u32x2*)(qrow + 32);
                    const u32x4 aw = (u32x4){lo.x, lo.y, hi.x, hi.y}; o = mfma16(__builtin_bit_cast(bf16x8, aw), Sb[ks], o); } }
#pragma unroll
            for (int r = 0; r < 4; ++r) yk[tb][r] = (unsigned short)f2bf(o[r]); }
#pragma unroll
        for (int kt = 0; kt < 8; ++kt) { S[kt] = S[kt] * *(const LAS f32x4*)(F.lds + G4_L_DEC + (16 * kt + 4 * fq) * 4);
#pragma unroll
            for (int s2 = 0; s2 < 2; ++s2) S[kt] = mfma16(tr8(F.lds + L_KE, 32 * s2 + 8 * fq, 32 * s2 + 8 * fq + 4, 16 * kt, lane), bv[s2], S[kt]); }
        HG_BAR();
        cur = nxt;
    }
    G4_STORE(n0 + 3);
#undef G4_STORE
    f32x4* sg = (f32x4*)(a.ws + WS_DS) + ((size_t)grp * 64 + w * 8) * 64 + lane;
#pragma unroll
    for (int kt = 0; kt < 8; ++kt) sg[kt * 64] = S[kt];
}
__device__ __forceinline__ void grp_scan(const Frame& F, const Args& a) {
    f32x4* sg = (f32x4*)(a.ws + WS_DS); f32x4* si = sg + (size_t)256 * 4096; const float* dec = (const float*)(a.ws + WS_DEC);
    for (int gt = F.bid * NTHR + F.tid; gt < 16 * 4096; gt += F.G * NTHR) {
        const int bh = gt >> 12, slot = gt & 4095, kt = (slot >> 6) & 7, lane = slot & 63, k = 16 * kt + 4 * (lane >> 4);
        f32x4 cur = (f32x4){0.f, 0.f, 0.f, 0.f};
#pragma unroll 4
        for (int g = 0; g < 16; ++g) { const size_t gi = ((size_t)(bh * 16 + g)) * 4096 + slot;
            si[gi] = cur;
            const float* dp = dec + ((size_t)bh * 64 + 4 * g) * 128 + k;
            const f32x4 d = (*(const f32x4*)dp * *(const f32x4*)(dp + 128)) * (*(const f32x4*)(dp + 256) * *(const f32x4*)(dp + 384));
            cur = d * cur + sg[gi]; }
    }
}
struct InC { Tile qd, g, ol; f32x4 dec; };
__device__ __forceinline__ void loadC(InC& r, const Frame& F, const Args& a, int bh, int n) {
    const int b = bh >> 2, h = bh & 3; const size_t t0 = (size_t)b * SEQ + n * 64;
    const bf16_t* base = (const bf16_t*)(a.ws + WS_PROJ) + t0 * INC;
    tile_load(r.qd, base + C_HGT + 256 * h, INC, F.tid); tile_load(r.g, base + C_GHG + h * 128, INC, F.tid);
    tile_load(r.ol, (const bf16_t*)(a.ws + WS_YHG) + t0 * 512 + h * 128, 512, F.tid);
    r.dec = *(const f32x4*)((const float*)(a.ws + WS_DEC) + ((size_t)bh * 64 + n) * 128 + 4 * (F.tid & 31));
}
__device__ __forceinline__ void grp_final(const Frame& F, const Args& a, int grp) {
    const int bh = grp >> 4, n0 = 4 * (grp & 15), b = bh >> 2, h = bh & 3, w = F.wave, lane = F.lane, fr = lane & 15, fq = lane >> 4;
    f32x4 S[8];
    { const f32x4* si = (const f32x4*)(a.ws + WS_DS) + (size_t)256 * 4096 + ((size_t)grp * 64 + w * 8) * 64 + lane;
#pragma unroll
      for (int kt = 0; kt < 8; ++kt) S[kt] = si[kt * 64]; }
    const float ng = a.in[I_HGNG][16 * w + fr];
    LAS float* SSQ = (LAS float*)(F.lds + G4_L_SSQ);
    InC cur, nxt; loadC(cur, F, a, bh, n0);
    unsigned short yk[4][4];
#define G4_STORE(nn) do { bf16_t* yp_ = (bf16_t*)(a.ws + WS_YHG) + ((size_t)b * SEQ + (nn) * 64 + 4 * fq) * 512 + h * 128 + 16 * w + fr; \
        _Pragma("unroll") for (int tb = 0; tb < 4; ++tb) _Pragma("unroll") for (int r = 0; r < 4; ++r) yp_[(size_t)(16 * tb + r) * 512] = yk[tb][r]; } while (0)
    for (int j = 0; j < 4; ++j) {
        if (j > 0) G4_STORE(n0 + j - 1);
        loadC(nxt, F, a, bh, n0 + (j < 3 ? j + 1 : 3));
        tile_put(cur.qd, F.lds + L_QD, F.tid); tile_put(cur.g, F.lds + L_KD, F.tid); tile_put(cur.ol, F.lds + L_V, F.tid);
        if (F.tid < 32) *(LAS f32x4*)(F.lds + G4_L_DEC + 16 * F.tid) = cur.dec;
        HG_BAR();
        bf16x8 Sb[4];
#pragma unroll
        for (int ks = 0; ks < 4; ++ks) { const u32x4 t = (u32x4){cvt_pk_bf16(S[2 * ks][0], S[2 * ks][1]), cvt_pk_bf16(S[2 * ks][2], S[2 * ks][3]), cvt_pk_bf16(S[2 * ks + 1][0], S[2 * ks + 1][1]), cvt_pk_bf16(S[2 * ks + 1][2], S[2 * ks + 1][3])};
            Sb[ks] = __builtin_bit_cast(bf16x8, t); }
        f32x4 o[4];
#pragma unroll
        for (int tb = 0; tb < 4; ++tb) {
#pragma unroll
            for (int r = 0; r < 4; ++r) o[tb][r] = bf2f(*(const LAS unsigned short*)(F.lds + L_V + ((16 * tb + 4 * fq + r) * QP + 16 * w + fr) * 2));
#pragma unroll
            for (int ks = 0; ks < 4; ++ks) { const LAS unsigned char* qrow = F.lds + L_QD + ((16 * tb + fr) * QP + 32 * ks + 4 * fq) * 2;
                const u32x2 lo = *(const LAS u32x2*)qrow, hi = *(const LAS u32x2*)(qrow + 32);
                const u32x4 aw = (u32x4){lo.x, lo.y, hi.x, hi.y}; o[tb] = mfma16(__builtin_bit_cast(bf16x8, aw), Sb[ks], o[tb]); }
#pragma unroll
            for (int r = 0; r < 4; ++r) { const float v = scan16(o[tb][r] * o[tb][r]); if (fr == 15) SSQ[w * 64 + 16 * tb + 4 * fq + r] = v; } }
#pragma unroll
        for (int kt = 0; kt < 8; ++kt) S[kt] = S[kt] * *(const LAS f32x4*)(F.lds + G4_L_DEC + (16 * kt + 4 * fq) * 4);
        HG_BAR();
#pragma unroll
        for (int tb = 0; tb < 4; ++tb) { f32x4 tot = (f32x4){0.f, 0.f, 0.f, 0.f};
#pragma unroll
            for (int ww = 0; ww < 8; ++ww) tot += *(const LAS f32x4*)(SSQ + ww * 64 + 16 * tb + 4 * fq);
#pragma unroll
            for (int r = 0; r < 4; ++r) { const float rs = rsqrtf(tot[r] * (1.0f / 128.0f) + EPS); const float g = bf2f(*(const LAS unsigned short*)(F.lds + L_KD + ((16 * tb + 4 * fq + r) * QP + 16 * w + fr) * 2));
                yk[tb][r] = (unsigned short)f2bf(o[tb][r] * rs * ng * g * __builtin_amdgcn_rcpf(1.0f + __builtin_amdgcn_exp2f(-1.4426950408889634f * g))); } }
        HG_BAR();
        cur = nxt;
    }
    G4_STORE(n0 + 3);
#undef G4_STORE
}
#undef HG_BAR
}

__device__ __forceinline__ float rs4(float a0, float a1, float a2, float a3, int lane) {
    const bool hi = (lane & 32) != 0;
    const float s0 = hi ? a0 : a2, s1 = hi ? a1 : a3;
    const float k0 = (hi ? a2 : a0) + __shfl_xor(s0, 32), k1 = (hi ? a3 : a1) + __shfl_xor(s1, 32);
    const bool b4 = (lane & 16) != 0;
    const float sd = b4 ? k0 : k1;
    float k = (b4 ? k1 : k0) + __shfl_xor(sd, 16);
    k += __shfl_xor(k, 8); k += __shfl_xor(k, 4); k += __shfl_xor(k, 2); k += __shfl_xor(k, 1);
    return k;
}
__device__ __forceinline__ void phase_router(const Frame& F, const Args& a) {
    constexpr int AP = 1032;
    LAS bf16_t* AH = (LAS bf16_t*)F.lds;
    LAS bf16_t* AL = AH + 16 * AP;
    LAS float* PART = (LAS float*)(F.lds + 2 * 16 * AP * 2);
    LAS float* LG = PART + 8 * 16 * 48;
    LAS unsigned* LH = (LAS unsigned*)(LG + 16 * 48);
    LAS unsigned* LB = LH + 32;
    LAS unsigned* LR = LH + 64;
    if (F.tid < NEXP) LH[F.tid] = 0u;
    const float* mod = (const float*)(a.ws + WS_MOD);
    const bf16_t* x1 = (const bf16_t*)(a.ws + WS_X1B); bf16_t* H2 = (bf16_t*)(a.ws + WS_ACT);
    unsigned* counts = (unsigned*)(a.ws + WS_CTL) + CW_COUNTS; unsigned* tokinfo = (unsigned*)(a.ws + WS_TOKINFO); int* toklist = (int*)(a.ws + WS_TOKLIST);
    const int rows_per_blk = T / F.G, r0 = F.bid * rows_per_blk, b = r0 / SEQ;
    const int lane = F.lane, w = F.wave, fr = lane & 15, fq = lane >> 4;
    f32x4 v[2][4], vn[2][4];
#define RT_LOAD(V, rb_) do { _Pragma("unroll") for (int q = 0; q < 2; ++q) { const u32x2* xr_ = (const u32x2*)(x1 + (size_t)((rb_) + 2 * w + q) * D) + lane; \
        _Pragma("unroll") for (int j = 0; j < 4; ++j) { const u32x2 t_ = xr_[64 * j]; V[q][j] = (f32x4){bf2f(t_.x & 0xffffu), bf2f(t_.x >> 16), bf2f(t_.y & 0xffffu), bf2f(t_.y >> 16)}; } } } while (0)
    RT_LOAD(v, r0);
    bf16x8 Bh[4][3], Bl[4][3];
    {
        const float* wre = a.in[I_WRE]; const float* wrg = a.in[I_WRG];
#pragma unroll
        for (int ks = 0; ks < 4; ++ks)
#pragma unroll
            for (int ct = 0; ct < 3; ++ct) {
                unsigned hw[4], lw[4];
#pragma unroll
                for (int jp = 0; jp < 4; ++jp) { float x[2];
#pragma unroll
                    for (int z = 0; z < 2; ++z) { const int k = 128 * w + 32 * ks + 8 * fq + 2 * jp + z;
                        if (ct == 0) { const float g = wrg[k * 4 + (fr & 3)], e = wre[k * 32 + ((fr + 28) & 31)]; x[z] = fr < 4 ? g : e; }
                        else if (ct == 1) x[z] = wre[k * 32 + 12 + fr];
                        else { const float e = wre[k * 32 + 28 + (fr & 3)]; x[z] = fr < 4 ? e : 0.f; } }
                    const unsigned h0 = f2bf(x[0]), h1 = f2bf(x[1]); hw[jp] = h0 | (h1 << 16);
                    lw[jp] = pk2(x[0] - bf2f(h0), x[1] - bf2f(h1)); }
                Bh[ks][ct] = __builtin_bit_cast(bf16x8, (u32x4){hw[0], hw[1], hw[2], hw[3]}); Bl[ks][ct] = __builtin_bit_cast(bf16x8, (u32x4){lw[0], lw[1], lw[2], lw[3]});
            }
    }
    for (int g = 0; g < rows_per_blk / 16; ++g) {
        const int rg = r0 + 16 * g;
        { const int gn = g + 1 < rows_per_blk / 16 ? g + 1 : g; RT_LOAD(vn, r0 + 16 * gn); }
#pragma unroll
        for (int q = 0; q < 2; ++q) { float sq = 0.f;
#pragma unroll
            for (int j = 0; j < 4; ++j) sq += (v[q][j].x * v[q][j].x + v[q][j].y * v[q][j].y) + (v[q][j].z * v[q][j].z + v[q][j].w * v[q][j].w);
            const float rs = rsqrtf(wave_sum(sq) * (1.0f / D) + EPS); const int row = 2 * w + q;
#pragma unroll
            for (int j = 0; j < 4; ++j) { const int k = 256 * j + 4 * lane;
                const f32x4 gg = *(const f32x4*)(a.in[I_N2G] + k) * (1.0f + *(const f32x4*)(mod + b * 6144 + 4 * 1024 + k)), sh = *(const f32x4*)(mod + b * 6144 + 3 * 1024 + k);
                const f32x4 hv = v[q][j] * rs * gg + sh;
                const unsigned h0 = f2bf(hv.x), h1 = f2bf(hv.y), h2_ = f2bf(hv.z), h3 = f2bf(hv.w);
                const u32x2 hw = (u32x2){h0 | (h1 << 16), h2_ | (h3 << 16)};
                *(u32x2*)(H2 + (size_t)(rg + row) * D + k) = hw;
                *(LAS u32x2*)(AH + row * AP + k) = hw;
                *(LAS u32x2*)(AL + row * AP + k) = (u32x2){pk2(hv.x - bf2f(h0), hv.y - bf2f(h1)), pk2(hv.z - bf2f(h2_), hv.w - bf2f(h3))}; } }
        __syncthreads();
        f32x4 acc[3] = {{0.f, 0.f, 0.f, 0.f}, {0.f, 0.f, 0.f, 0.f}, {0.f, 0.f, 0.f, 0.f}};
#pragma unroll
        for (int ks = 0; ks < 4; ++ks) { const bf16x8 ah = *(const LAS bf16x8*)(AH + fr * AP + 128 * w + 32 * ks + 8 * fq), al = *(const LAS bf16x8*)(AL + fr * AP + 128 * w + 32 * ks + 8 * fq);
#pragma unroll
            for (int ct = 0; ct < 3; ++ct) { acc[ct] = __builtin_amdgcn_mfma_f32_16x16x32_bf16(ah, Bh[ks][ct], acc[ct], 0, 0, 0);
                acc[ct] = __builtin_amdgcn_mfma_f32_16x16x32_bf16(al, Bh[ks][ct], acc[ct], 0, 0, 0); acc[ct] = __builtin_amdgcn_mfma_f32_16x16x32_bf16(ah, Bl[ks][ct], acc[ct], 0, 0, 0); } }
#pragma unroll
        for (int ct = 0; ct < 3; ++ct)
#pragma unroll
            for (int r = 0; r < 4; ++r) PART[(w * 16 + 4 * fq + r) * 48 + 16 * ct + fr] = acc[ct][r];
        __syncthreads();
        for (int t = F.tid; t < 16 * 48; t += NTHR) { const int row = t / 48, o = t % 48; float sacc = 0.f;
#pragma unroll
            for (int ww = 0; ww < 8; ++ww) sacc += PART[(ww * 16 + row) * 48 + o];
            if (o < 36) LG[row * 48 + o] = sacc + (o < 4 ? a.in[I_BRG][o & 3] : a.in[I_BRE][(o + 28) & 31]); }
        __syncthreads();
        if (F.tid < 16) {
            const LAS float* lg = LG + F.tid * 48;
            float gl[4]; int gi = 0;
#pragma unroll
            for (int o = 0; o < 4; ++o) gl[o] = lg[o];
            float gm = gl[0];
#pragma unroll
            for (int o = 1; o < 4; ++o) if (gl[o] > gm) { gm = gl[o]; gi = o; }
            float gsum = 0.f;
#pragma unroll
            for (int o = 0; o < 4; ++o) gsum += expf(gl[o] - gm);
            const float gp = 1.0f / gsum;
            float el[8];
#pragma unroll
            for (int e = 0; e < 8; ++e) el[e] = lg[4 + gi * 8 + e];
            int i0 = 0; float m0 = el[0];
#pragma unroll
            for (int o = 1; o < 8; ++o) if (el[o] > m0) { m0 = el[o]; i0 = o; }
            int i1 = -1; float m1 = -INFINITY;
#pragma unroll
            for (int o = 0; o < 8; ++o) if (o != i0 && el[o] > m1) { m1 = el[o]; i1 = o; }
            const float e1 = expf(m1 - m0); const float w0 = gp / (1.0f + e1), w1 = gp * e1 / (1.0f + e1);
            const int rl = 16 * g + F.tid, ex0 = gi * 8 + i0, ex1 = gi * 8 + i1;
            const unsigned l0 = atomicAdd((unsigned*)(LH + ex0), 1u), l1 = atomicAdd((unsigned*)(LH + ex1), 1u);
            LAS unsigned* ri = LR + rl * 6;
            ri[0] = (unsigned)ex0; ri[1] = l0; ri[2] = (unsigned)ex1; ri[3] = l1; ri[4] = __float_as_uint(w0); ri[5] = __float_as_uint(w1);
        }
#pragma unroll
        for (int q = 0; q < 2; ++q)
#pragma unroll
            for (int j = 0; j < 4; ++j) v[q][j] = vn[q][j];
    }
#undef RT_LOAD
    __syncthreads();
    if (F.tid < NEXP) LB[F.tid] = atomicAdd(counts + 64 * F.tid, LH[F.tid]);
    __syncthreads();
    for (int rl = F.tid; rl < rows_per_blk; rl += NTHR) {
        const LAS unsigned* ri = LR + rl * 6; const int r = r0 + rl;
        const unsigned ex0 = ri[0], ex1 = ri[2], k0 = LB[ex0] + ri[1], k1 = LB[ex1] + ri[3];
        toklist[ex0 * T + k0] = r; toklist[ex1 * T + k1] = r;
        u32x4 t0; t0.x = ex0; t0.y = k0; t0.z = ex1; t0.w = k1;
        *(u32x4*)(tokinfo + (size_t)r * 8) = t0;
        tokinfo[(size_t)r * 8 + 4] = ri[4]; tokinfo[(size_t)r * 8 + 5] = ri[5];
    }
}
__device__ __forceinline__ void build_moe_tab(const Frame& F, const Args& a, LAS MoeTab* tab) {
    if (F.wave == 0) {
        const unsigned* counts = (const unsigned*)(a.ws + WS_CTL) + CW_COUNTS;
        const int e = F.lane & 31;
        const int c = (int)__hip_atomic_load(counts + 64 * e, __ATOMIC_RELAXED, __HIP_MEMORY_SCOPE_AGENT);
        const int n = (c + 255) >> 8; int incl = n;
#pragma unroll
        for (int d = 1; d < 32; d <<= 1) { const int t = __shfl_up(incl, d, 32); if (e >= d) incl += t; }
        const int base = incl - n;
        if (F.lane < 32) { tab->cnt[e] = c; tab->tbase[e] = base;
            for (int m = 0; m < n; ++m) { tab->tile_e[base + m] = e; tab->tile_m[base + m] = m; } }
        if (F.lane == 31) { tab->tbase[NEXP] = incl; tab->nt = incl; }
    }
    __syncthreads();
}
__device__ __forceinline__ void phase_final(const Frame& F, const Args& a, const LAS MoeTab* tab) {
    const float* mod = (const float*)(a.ws + WS_MOD); const unsigned* tokinfo = (const unsigned*)(a.ws + WS_TOKINFO); const bf16_t* Ys = (const bf16_t*)(a.ws + WS_YS);
    const int rows_per_blk = T / F.G, r0 = F.bid * rows_per_blk;
    for (int rb = r0 + F.wave; rb < r0 + rows_per_blk; rb += 4 * NWAVES) {
        u32x4 ti[4]; u32x2 tw[4];
#pragma unroll
        for (int q = 0; q < 4; ++q) { const int r = rb + q * NWAVES < r0 + rows_per_blk ? rb + q * NWAVES : rb;
            ti[q] = *(const u32x4*)(tokinfo + (size_t)r * 8); tw[q] = *(const u32x2*)(tokinfo + (size_t)r * 8 + 4); }
        u32x2 xq[4][4], a0[4][4], a1[4][4];
#pragma unroll
        for (int q = 0; q < 4; ++q) { const int r = rb + q * NWAVES < r0 + rows_per_blk ? rb + q * NWAVES : rb;
            const size_t s0 = (size_t)tab->tbase[ti[q].x] * 256 + ti[q].y, s1 = (size_t)tab->tbase[ti[q].z] * 256 + ti[q].w;
            const u32x2* xb = (const u32x2*)((const bf16_t*)(a.ws + WS_X1B) + (size_t)r * D) + F.lane;
            const u32x2* y0 = (const u32x2*)(Ys + s0 * D) + F.lane; const u32x2* y1 = (const u32x2*)(Ys + s1 * D) + F.lane;
#pragma unroll
            for (int j = 0; j < 4; ++j) { xq[q][j] = __builtin_nontemporal_load(xb + 64 * j); a0[q][j] = __builtin_nontemporal_load(y0 + 64 * j); a1[q][j] = __builtin_nontemporal_load(y1 + 64 * j); } }
#pragma unroll
        for (int q = 0; q < 4; ++q) { const int r = rb + q * NWAVES; if (r >= r0 + rows_per_blk) break;
            const int b = r / SEQ; const float w0 = __uint_as_float(tw[q].x), w1 = __uint_as_float(tw[q].y);
            f32x4* xr = (f32x4*)(a.out + (size_t)r * D) + F.lane;
            f32x4 v[4]; float s = 0.f;
#pragma unroll
            for (int j = 0; j < 4; ++j) { const int k = 256 * j + 4 * F.lane;
                const f32x4 gt = *(const f32x4*)(mod + b * 6144 + 5 * 1024 + k); const u32x2 p0 = a0[q][j], p1 = a1[q][j], px = xq[q][j];
                f32x4 m; m.x = w0 * bf2f(p0.x & 0xffffu) + w1 * bf2f(p1.x & 0xffffu); m.y = w0 * bf2f(p0.x >> 16) + w1 * bf2f(p1.x >> 16);
                m.z = w0 * bf2f(p0.y & 0xffffu) + w1 * bf2f(p1.y & 0xffffu); m.w = w0 * bf2f(p0.y >> 16) + w1 * bf2f(p1.y >> 16);
                const f32x4 xv = (f32x4){bf2f(px.x & 0xffffu), bf2f(px.x >> 16), bf2f(px.y & 0xffffu), bf2f(px.y >> 16)};
                v[j] = xv + gt * m; s += (v[j].x * v[j].x + v[j].y * v[j].y) + (v[j].z * v[j].z + v[j].w * v[j].w); }
            const float rs = rsqrtf(wave_sum(s) * (1.0f / D) + EPS);
#pragma unroll
            for (int j = 0; j < 4; ++j) { const f32x4 g = *(const f32x4*)(a.in[I_FG] + 256 * j + 4 * F.lane); __builtin_nontemporal_store(v[j] * rs * g, xr + 64 * j); } }
    }
}

#define XB_TMO      128
#define XB_XCNT(j)  (256  + 64 * (j))
#define XB_XSUB(j)  (1280 + 64 * (j))
#define XB_XGEN(j)  (2304 + 64 * (j))
#define XB_TOP      3328
#define XB_TOPGEN   3392
#define XCD_BAR_WORDS 3456
#define XB_SPIN_CAP (1u << 18)
__device__ __forceinline__ unsigned xb_ld(unsigned* p)              { return __hip_atomic_load(p, __ATOMIC_RELAXED, __HIP_MEMORY_SCOPE_AGENT); }
__device__ __forceinline__ unsigned xb_add(unsigned* p, unsigned v) { return __hip_atomic_fetch_add(p, v, __ATOMIC_RELAXED, __HIP_MEMORY_SCOPE_AGENT); }
__device__ __forceinline__ unsigned xb_xcc_id() { return (unsigned)__builtin_amdgcn_s_getreg((3 << 11) | 20) & 0xFu; }
#define XB_SPIN(cond, bar) do { unsigned _sp = 0; while (cond) { __builtin_amdgcn_s_sleep(1); \
    if ((++_sp & 255u) == 0u) { if (xb_ld(&(bar)[XB_TMO])) break; if (_sp > XB_SPIN_CAP) { atomicAdd(&(bar)[XB_TMO], 1u); break; } } } } while (0)
struct XcdBarrier { unsigned* bar; unsigned x; volatile LAS unsigned* st; };
__device__ __forceinline__ XcdBarrier xcd_barrier_post(unsigned* bar, volatile LAS unsigned* st) {
    XcdBarrier b; b.bar = bar; b.x = xb_xcc_id(); b.st = st;
    if (threadIdx.x == 0) (void)xb_add(&bar[XB_XCNT(b.x)], 1u);
    return b;
}
__device__ __forceinline__ void xcd_barrier_complete(unsigned* bar, unsigned x, unsigned& nloc, unsigned& nx) {
    const unsigned G = gridDim.x * gridDim.y * gridDim.z;
    unsigned sum, cnt, mine, sp = 0u;
    for (;;) {
        sum = 0u; cnt = 0u; mine = 0u;
#pragma unroll
        for (unsigned j = 0; j < 16; ++j) { const unsigned c = xb_ld(&bar[XB_XCNT(j)]); sum += c; cnt += (c > 0u) ? 1u : 0u; mine = (j == x) ? c : mine; }
        if (sum == G) break;
        __builtin_amdgcn_s_sleep(1);
        if ((++sp & 255u) == 0u) { if (xb_ld(&bar[XB_TMO])) break; if (sp > XB_SPIN_CAP) { atomicAdd(&bar[XB_TMO], 1u); break; } }
    }
    nloc = mine > 0u ? mine : 1u; nx = cnt > 0u ? cnt : 1u;
}
__device__ __forceinline__ void xcd_barrier(const XcdBarrier& b) {
    asm volatile("s_waitcnt vmcnt(0)" ::: "memory");
    __syncthreads();
    if (threadIdx.x == 0) {
        unsigned* bar = b.bar;
        __builtin_amdgcn_s_waitcnt(0);
        unsigned nloc = b.st[0], nx = b.st[1];
        if (nloc == 0u) { xcd_barrier_complete(bar, b.x, nloc, nx); b.st[0] = nloc; b.st[1] = nx; }
        const unsigned old = xb_add(&bar[XB_XSUB(b.x)], 1u);
        const unsigned gen = old / nloc;
        if (old + 1u == (gen + 1u) * nloc) {
            __builtin_amdgcn_fence(__ATOMIC_RELEASE, "agent");
            asm volatile("s_waitcnt vmcnt(0)" ::: "memory");
            const unsigned og = xb_add(&bar[XB_TOP], 1u);
            const unsigned tg = og / nx;
            if (og + 1u == (tg + 1u) * nx) xb_add(&bar[XB_TOPGEN], 1u);
            else XB_SPIN(xb_ld(&bar[XB_TOPGEN]) == tg, bar);
            __builtin_amdgcn_fence(__ATOMIC_ACQUIRE, "agent");
            xb_add(&bar[XB_XGEN(b.x)], 1u);
            asm volatile("s_waitcnt vmcnt(0)" ::: "memory");
        } else {
            XB_SPIN(xb_ld(&bar[XB_XGEN(b.x)]) == gen, bar);
            __builtin_amdgcn_fence(__ATOMIC_ACQUIRE, "agent");
            asm volatile("s_waitcnt vmcnt(0)" ::: "memory");
        }
    }
    __syncthreads();
}

constexpr int N_PHASES = 11;
__global__ void __launch_bounds__(NTHR, 2) mk_fwd(Args a) {
    extern __shared__ __attribute__((aligned(16))) unsigned char lds_raw[];
    Frame F; F.lds = (LAS unsigned char*)lds_raw; F.tid = threadIdx.x; F.lane = F.tid & 63; F.wave = __builtin_amdgcn_readfirstlane(F.tid >> 6); F.G = gridDim.x; F.bid = blockIdx.x;
    unsigned char* ws = a.ws;
    const int lo = a.ph_lo, hi = a.ph_hi;
#if MK_N_LAUNCHES == 1
    volatile LAS unsigned* MISC = (volatile LAS unsigned*)(F.lds + 152 * 1024);
    if (F.tid < 4) MISC[F.tid] = 0u;
    __syncthreads();
    XcdBarrier xbar = xcd_barrier_post((unsigned*)(ws + WS_CTL) + CW_BAR, MISC);
#define SEAM(k) do { if (IN(k) && IN((k) + 1)) xcd_barrier(xbar); } while (0)
#else
#define SEAM(k) do { } while (0)
#endif
#define IN(k) (lo <= (k) && (k) < hi)
    LAS MoeTab* tab = (LAS MoeTab*)(F.lds + 144 * 1024);

#define RUNPH(k, ...) if (IN(k)) { F.lane = lane_now(); F.tid = F.wave * 64 + F.lane; __VA_ARGS__ }
    RUNPH(0, { phase0(F, a); }) SEAM(0);
    RUNPH(1, { phase1(F, a); __syncthreads(); dense_weight_convert(F, a); }) SEAM(1);
    RUNPH(2, {
        DenseOrder S{(const char*)(ws + WS_ACT), (const char*)(ws + WS_WIN), D, T / 256, INC / 256, F.G, F.bid};
        EpiInProj E{(bf16_t*)(ws + WS_PROJ), (bf16_t*)a.out, (float*)(ws + WS_DEC), (const float*)(ws + WS_SMALL) + 16, attn_body::C2};
        pg8::gemm_phase(F.lds, D, S, E);
        int nl; const int early = w2_early_items(F.G, nl);
        if (early && F.bid >= F.G - nl) { __syncthreads(); moe_w2_convert(F, a, 0, early, (F.bid - (F.G - nl)) * NWAVES + F.wave, nl * NWAVES); }
    }) SEAM(2);
    RUNPH(3, {
        for (int g = F.bid; g < 256; g += F.G) hg::grp_local(F, a, g);
        __syncthreads();
        attn_phase(F, a);
    }) SEAM(3);
    RUNPH(4, { hg::grp_scan(F, a); attn_combine(F, a); }) SEAM(4);
    RUNPH(5, { for (int g = F.bid; g < 256; g += F.G) hg::grp_final(F, a, g); }) SEAM(5);
    RUNPH(6, {
        UpOrder S{(const char*)(ws + WS_YDA), (const char*)(ws + WS_YHG), (const char*)(ws + WS_WUPDA), (const char*)(ws + WS_WUPHG), F.G, F.bid};
        EpiUp E{(const bf16_t*)(ws + WS_PROJ), (bf16_t*)(ws + WS_ACT)};
        pg8::gemm_phase(F.lds, 512, S, E);
    }) SEAM(6);
    RUNPH(7, {
        DenseOrder S{(const char*)(ws + WS_ACT), (const char*)(ws + WS_WOUT), D, T / 256, D / 256, F.G, F.bid};
        EpiOut E{a.in[I_X], (const float*)(ws + WS_MOD), (bf16_t*)(ws + WS_X1B)};
        pg8::gemm_phase(F.lds, D, S, E);
        moe_weight_convert(F, a);
    }) SEAM(7);
    RUNPH(8, { phase_router(F, a); __syncthreads(); }) SEAM(8);
    RUNPH(9, {
        build_moe_tab(F, a, tab);
        unsigned* done = (unsigned*)(ws + WS_CTL) + CW_TILE;
        const int vc = (F.G & 7) == 0 ? (F.bid & 7) * (F.G >> 3) + (F.bid >> 3) : F.bid;
        { Moe1Order S{tab, (const char*)(ws + WS_ACT), (const char*)(ws + WS_W13), (const int*)(ws + WS_TOKLIST), F.G, vc};
          EpiMoe1 E{(bf16_t*)(ws + WS_HS), done};
          pg8::gemm_phase(F.lds, D, S, E); }
        { Moe2Order S{tab, (const char*)(ws + WS_HS), (const char*)a.out + OUT_W2, done, (unsigned*)(ws + WS_CTL) + CW_TMO, F.G, vc};
          EpiStoreBf16 E{(bf16_t*)(ws + WS_YS), D, 0, 1.0f};
          pg8::gemm_phase(F.lds, DEXP, S, E); }
    }) SEAM(9);
    RUNPH(10, { build_moe_tab(F, a, tab); phase_final(F, a, tab); })
#undef IN
#undef SEAM
}

extern "C" void kernel_launch(void* const* d_in, const int* in_sizes, int n_in, void* d_out, int out_size, void* d_ws, size_t ws_size, hipStream_t stream) {
    static int grid = 0;
    if (grid == 0) {
        if (n_in != 25 || in_sizes[0] != T * D || out_size != T * D || ws_size < WS_END) { fprintf(stderr, "kernel_launch: unexpected shapes (n_in %d, in0 %d, out %d, ws %zu)\n", n_in, n_in > 0 ? in_sizes[0] : -1, out_size, ws_size); grid = -1; return; }
        int dev = 0, cus = 0, per_cu = 0;
        if (hipGetDevice(&dev) != hipSuccess || hipDeviceGetAttribute(&cus, hipDeviceAttributeMultiprocessorCount, dev) != hipSuccess) { grid = -1; return; }
        if (hipFuncSetAttribute((const void*)mk_fwd, hipFuncAttributeMaxDynamicSharedMemorySize, LDS_BYTES) != hipSuccess) { fprintf(stderr, "kernel_launch: hipFuncSetAttribute failed\n"); grid = -1; return; }
        if (hipOccupancyMaxActiveBlocksPerMultiprocessor(&per_cu, (const void*)mk_fwd, NTHR, LDS_BYTES) != hipSuccess || per_cu < 1) { fprintf(stderr, "kernel_launch: occupancy query says %d\n", per_cu); per_cu = 1; }
        (void)hipGetLastError();
        grid = cus;
        if (grid > 256) grid = 256;
        while (T % grid) --grid;
    }
    if (grid < 0) return;
    (void)hipMemsetAsync((char*)d_ws + WS_CTL, 0, CTL_ZERO_BYTES, stream);
    Args a{};
    for (int i = 0; i < 25; ++i) a.in[i] = (const float*)d_in[i];
    a.out = (float*)d_out; a.ws = (unsigned char*)d_ws;
#if MK_N_LAUNCHES == 1
    a.ph_lo = 0; a.ph_hi = N_PHASES;
    void* args[] = {&a};
    hipError_t e = hipLaunchCooperativeKernel((const void*)mk_fwd, dim3(grid), dim3(NTHR), args, LDS_BYTES, stream);
    if (e != hipSuccess) fprintf(stderr, "cooperative launch failed: %s (grid %d)\n", hipGetErrorString(e), grid);
#else
    for (int p = 0; p < N_PHASES; ++p) {
        a.ph_lo = p; a.ph_hi = p + 1;
        hipLaunchKernelGGL(mk_fwd, dim3(grid), dim3(NTHR), LDS_BYTES, stream, a);
    }
#endif
}
```

```cpp
#include <hip/hip_runtime.h>
#include <cstdio>
#include <cstdint>

#ifndef MK_N_LAUNCHES
#define MK_N_LAUNCHES 1
#endif

#define LAS __attribute__((address_space(3)))
typedef unsigned short bf16_t;
typedef short bf16x8 __attribute__((ext_vector_type(8)));
typedef float f32x4 __attribute__((ext_vector_type(4)));
typedef float f32x2 __attribute__((ext_vector_type(2)));
typedef unsigned u32x4 __attribute__((ext_vector_type(4)));
typedef unsigned u32x2 __attribute__((ext_vector_type(2)));

constexpr int NB = 4, SEQ = 4096, D = 1024, T = NB * SEQ;
constexpr int INC = 5632;
constexpr int C_QDA = 0, C_KDA = 512, C_VDA = 1024, C_QHG = 1536, C_FHG = 2048, C_IHG = 2560, C_GHG = 3072, C_GDA = 3584, C_GHGATE = 4608;
constexpr int C_HGT = 1536;
constexpr int NEXP = 32, DEXP = 512;
constexpr int PMAX = 40960;
constexpr float EPS = 1e-6f;
constexpr int NWAVES = 8, NTHR = 512;

constexpr size_t MiB = 1u << 20;
constexpr size_t WS_CTL = 0, CTL_ZERO_BYTES = 64 * 1024;
constexpr size_t WS_MOD = 5 * MiB / 2;
constexpr size_t WS_SMALL = 11 * MiB / 4;
constexpr size_t WS_TOKINFO = 3 * MiB;
constexpr size_t WS_TOKLIST = 4 * MiB;
constexpr size_t WS_DEC = 6 * MiB;
constexpr size_t WS_DS = 24 * MiB;
constexpr size_t WS_WIN = 8 * MiB;
constexpr size_t WS_WUPDA = 20 * MiB, WS_WUPHG = 21 * MiB, WS_WOUT = 22 * MiB;
constexpr size_t WS_ACT = 24 * MiB;
constexpr size_t WS_PROJ = 56 * MiB;
constexpr size_t WS_YDA = 232 * MiB, WS_YHG = 248 * MiB;
constexpr size_t WS_OA = 264 * MiB;
constexpr size_t WS_W13 = 56 * MiB;
constexpr size_t WS_W2 = 120 * MiB;
constexpr size_t WS_HS = 152 * MiB;
constexpr size_t WS_YS = 192 * MiB;
constexpr size_t OUT_W2 = 16 * MiB;
constexpr int W2_EARLY = 32;
constexpr size_t WS_X1B = 272 * MiB;
constexpr size_t WS_END = 304 * MiB;
constexpr int CW_COUNTS = 64;
constexpr int CW_BAR = 4096;
constexpr int CW_TILE = 8192;
constexpr int CW_TMO = 32;

constexpr int LDS_BYTES = 160 * 1024;

__device__ __forceinline__ float bf2f(unsigned v) { return __uint_as_float(v << 16); }
__device__ __forceinline__ unsigned f2bf(float f) { unsigned u = __float_as_uint(f); return (u + 0x7fffu + ((u >> 16) & 1u)) >> 16; }
__device__ __forceinline__ unsigned pk2(float lo, float hi) { return f2bf(lo) | (f2bf(hi) << 16); }
__device__ __forceinline__ float sigmoidf_(float x) { return 1.0f / (1.0f + __expf(-x)); }
__device__ __forceinline__ float siluf_(float x) { return x / (1.0f + __expf(-x)); }
__device__ __forceinline__ int lane_now() { int l; asm volatile("v_mbcnt_lo_u32_b32 %0, -1, 0\n\tv_mbcnt_hi_u32_b32 %0, -1, %0" : "=v"(l)); return l; }
__device__ __forceinline__ float wave_sum(float v) {
#pragma unroll
    for (int o = 1; o < 64; o <<= 1) v += __shfl_xor(v, o);
    return v;
}

namespace pg8 {
constexpr int BM = 256, BK = 64, HALF = 128, HTB = HALF * BK * 2, STAGE_BYTES = 8 * HTB;
__host__ __device__ __forceinline__ int lds_byte(int r, int c) { const int st = (r >> 4) * 2 + (c >> 5), rr = r & 15, cc = c & 31, ob = rr * 64 + cc * 2; return st * 1024 + (ob ^ (((ob >> 9) & 1) << 5)); }
__host__ __device__ __forceinline__ void stage_rc(int b, int& R, int& C) { const int st = b / 1024, sb = b % 1024, swz = sb ^ (((sb >> 9) & 1) << 5); R = (st >> 1) * 16 + swz / 64; C = (st & 1) * 32 + (swz % 64) / 2; }
__host__ __device__ __forceinline__ int perm32(int rho) { const int n = rho >> 4, i = rho & 15; return 8 * (i >> 2) + 4 * n + (i & 3); }

struct Unit { int pm, pn; const char* A; const char* B; int aux; };
__device__ __forceinline__ unsigned cvt_pk_bf16(float lo, float hi) { unsigned r; asm volatile("v_cvt_pk_bf16_f32 %0, %1, %2" : "=v"(r) : "v"(lo), "v"(hi)); return r; }

template <class Epi, class Sched>
__device__ __forceinline__ void gemm_phase(LAS unsigned char* lds, const int K, const Sched& S, const Epi& E) {
    const int tid = threadIdx.x, wid = __builtin_amdgcn_readfirstlane(tid >> 6), lane = tid & 63, wr = wid >> 2, wc = wid & 3, fr = lane & 15, fq = lane >> 4;
    const int nt = K / BK;
    unsigned voffB[2];
#define PG8_SETLANE() do { const int _l = lane_now(), _t = wid * 64 + _l; _Pragma("unroll") for (int _i = 0; _i < 2; ++_i) { int _R, _C; stage_rc(_t * 16 + _i * 8192, _R, _C); \
        const int _Rb = Epi::PERM ? ((_R & ~31) + perm32(_R & 31)) : _R; voffB[_i] = (unsigned)(_Rb * K + _C) * 2u; } \
        aoff = lds_byte(wr * 64 + (_l & 15), (_l >> 4) * 8); boff = lds_byte(wc * 32 + (_l & 15), (_l >> 4) * 8); } while (0)
    const size_t kstep = (size_t)(BK * 2);
    const size_t hstep = (size_t)HALF * K * 2;
    const unsigned ldsw = (unsigned)wid * 1024u;
    int aoff, boff; PG8_SETLANE();
#define PG8_SA(b, h) (((b) * 2 + (h)) * HTB)
#define PG8_SB(b, h) ((4 + (b) * 2 + (h)) * HTB)
#define PG8_STAGE(bufoff, gbase, voff) do { _Pragma("unroll") for (int _i = 0; _i < 2; ++_i) \
        __builtin_amdgcn_global_load_lds((const unsigned*)((const char*)(gbase) + (voff)[_i]), (LAS unsigned*)(lds + (bufoff) + ldsw + _i * 8192), 16, 0, 0); } while (0)
#define PG8_LDA(dst, b, h) do { _Pragma("unroll") for (int m = 0; m < 4; ++m) _Pragma("unroll") for (int k = 0; k < 2; ++k) dst[m][k] = *(const LAS bf16x8*)(lds + PG8_SA(b, h) + aoff + m * 2048 + k * 1024); } while (0)
#define PG8_LDB(dst, b, h) do { _Pragma("unroll") for (int n = 0; n < 2; ++n) _Pragma("unroll") for (int k = 0; k < 2; ++k) dst[n][k] = *(const LAS bf16x8*)(lds + PG8_SB(b, h) + boff + n * 2048 + k * 1024); } while (0)
#define PG8_MMA(ai, bj, At, Bt) do { __builtin_amdgcn_s_setprio(1); _Pragma("unroll") for (int m = 0; m < 4; ++m) _Pragma("unroll") for (int n = 0; n < 2; ++n) _Pragma("unroll") for (int k = 0; k < 2; ++k) \
        acc[ai][bj][m][n] = __builtin_amdgcn_mfma_f32_16x16x32_bf16(Bt[n][k], At[m][k], acc[ai][bj][m][n], 0, 0, 0); __builtin_amdgcn_s_setprio(0); } while (0)
#define PG8_WAIT_V(n) asm volatile("s_waitcnt vmcnt(" #n ")" ::: "memory")
#define PG8_WAIT_L(n) asm volatile("s_waitcnt lgkmcnt(" #n ")" ::: "memory")
#define PG8_BAR __builtin_amdgcn_s_barrier()
#define PG8_SCHED __builtin_amdgcn_sched_barrier(0)
#define PG8_SETA(vo, u) do { const int _t = wid * 64 + lane_now(); _Pragma("unroll") for (int _i = 0; _i < 2; ++_i) { int _R, _C; stage_rc(_t * 16 + _i * 8192, _R, _C); \
        _Pragma("unroll") for (int _h = 0; _h < 2; ++_h) vo[_h][_i] = (unsigned)((size_t)S.arow(u, _h * HALF + _R) * (size_t)K + _C) * 2u; } if (Sched::GATHER) PG8_WAIT_V(0); } while (0)
    Unit cur, nxt; int ui = 0;
    if (!S.next(0, cur)) return;
    f32x4 acc[2][2][4][2];
#pragma unroll
    for (int a = 0; a < 2; ++a)
#pragma unroll
        for (int b = 0; b < 2; ++b)
#pragma unroll
            for (int m = 0; m < 4; ++m)
#pragma unroll
                for (int n = 0; n < 2; ++n) acc[a][b][m][n] = (f32x4){0.f, 0.f, 0.f, 0.f};
    bf16x8 At[4][2], B0[2][2], B1[2][2];
    unsigned voC[2][2], voN[2][2];
    S.a_ready(cur);
    PG8_SETA(voC, cur);
    const char* cA = cur.A; const char* cB = cur.B;
    PG8_STAGE(PG8_SB(0, 0), cB, voffB); PG8_STAGE(PG8_SB(0, 1), cB + hstep, voffB); PG8_STAGE(PG8_SA(0, 0), cA, voC[0]); PG8_STAGE(PG8_SA(0, 1), cA, voC[1]);
    if (wr == 1) PG8_BAR;
    PG8_WAIT_V(2); PG8_BAR;
    PG8_STAGE(PG8_SB(1, 0), cB + kstep, voffB); PG8_STAGE(PG8_SA(1, 0), cA + kstep, voC[0]); PG8_STAGE(PG8_SB(1, 1), cB + hstep + kstep, voffB);
    PG8_WAIT_V(6); PG8_BAR;
    for (;;) {
        const bool has_next = S.next(ui + 1, nxt);
        if (has_next) { PG8_SETA(voN, nxt); }
        else {
#pragma unroll
            for (int h = 0; h < 2; ++h)
#pragma unroll
                for (int i = 0; i < 2; ++i) voN[h][i] = voC[h][i];
        }
        const char* nA = has_next ? nxt.A : cA; const char* nB = has_next ? nxt.B : cB;
        for (int t = 0; t < nt; t += 2) {
            const bool last = (t == nt - 2);
            if (last && has_next) S.a_ready(nxt);
            const char* a1 = cA + (size_t)(t + 1) * kstep;
            const char* a2 = last ? nA : cA + (size_t)(t + 2) * kstep; const char* b2 = last ? nB : cB + (size_t)(t + 2) * kstep;
            const char* a3 = a2 + kstep; const char* b3 = b2 + kstep;
            unsigned vo2[2][2];
#pragma unroll
            for (int h = 0; h < 2; ++h)
#pragma unroll
                for (int i = 0; i < 2; ++i) vo2[h][i] = last ? voN[h][i] : voC[h][i];
            PG8_LDB(B0, 0, 0); PG8_LDB(B1, 0, 1); PG8_SCHED; PG8_LDA(At, 0, 0); PG8_STAGE(PG8_SA(1, 1), a1, voC[1]);
            PG8_WAIT_V(8); PG8_WAIT_L(0); PG8_BAR; PG8_MMA(0, 0, At, B0); PG8_MMA(0, 1, At, B1); PG8_BAR; PG8_SCHED;
            PG8_LDA(At, 0, 1); PG8_STAGE(PG8_SB(0, 0), b2, voffB); PG8_STAGE(PG8_SB(0, 1), b2 + hstep, voffB); PG8_STAGE(PG8_SA(0, 0), a2, vo2[0]);
            PG8_WAIT_V(8); PG8_WAIT_L(0); PG8_BAR; PG8_MMA(1, 0, At, B0); PG8_MMA(1, 1, At, B1); PG8_BAR; PG8_SCHED;
            PG8_LDB(B0, 1, 0); PG8_LDB(B1, 1, 1); PG8_SCHED; PG8_LDA(At, 1, 0); PG8_STAGE(PG8_SA(0, 1), a2, vo2[1]);
            PG8_WAIT_V(8); PG8_WAIT_L(0); PG8_BAR; PG8_MMA(0, 0, At, B0); PG8_MMA(0, 1, At, B1); PG8_BAR; PG8_SCHED;
            PG8_LDA(At, 1, 1); PG8_STAGE(PG8_SB(1, 0), b3, voffB); PG8_STAGE(PG8_SB(1, 1), b3 + hstep, voffB); PG8_STAGE(PG8_SA(1, 0), a3, vo2[0]);
            PG8_WAIT_V(8); PG8_WAIT_L(0); PG8_BAR; PG8_MMA(1, 0, At, B0); PG8_MMA(1, 1, At, B1); PG8_BAR; PG8_SCHED;
        }
        if (wr == 0) PG8_BAR;
        const bool keep = E(acc, cur, wr, wc, fr, fq);
        if (!has_next) break;
        if (!keep) {
#pragma unroll
            for (int a = 0; a < 2; ++a)
#pragma unroll
                for (int b = 0; b < 2; ++b)
#pragma unroll
                    for (int m = 0; m < 4; ++m)
#pragma unroll
                        for (int n = 0; n < 2; ++n) acc[a][b][m][n] = (f32x4){0.f, 0.f, 0.f, 0.f};
        }
        cur = nxt; cA = nA; cB = nB; ++ui;
        if (Sched::GATHER) {
#pragma unroll
            for (int h = 0; h < 2; ++h)
#pragma unroll
                for (int i = 0; i < 2; ++i) voC[h][i] = voN[h][i];
        } else { PG8_SETA(voC, cur); }
        PG8_SETLANE();
        if (wr == 1) PG8_BAR;
    }
    PG8_WAIT_V(0);
    PG8_BAR;
#undef PG8_SA
#undef PG8_SB
#undef PG8_STAGE
#undef PG8_LDA
#undef PG8_LDB
#undef PG8_MMA
#undef PG8_WAIT_V
#undef PG8_WAIT_L
#undef PG8_BAR
#undef PG8_SCHED
#undef PG8_SETA
#undef PG8_SETLANE
}
}

struct Args { const float* in[25]; float* out; unsigned char* ws; int ph_lo, ph_hi; };
enum { I_X = 0, I_C, I_WADA, I_BADA, I_N1G, I_WIN, I_LQ1, I_LK1, I_LQ2, I_LK2, I_SUBG, I_LBL, I_HGNG, I_WUPDA, I_WUPHG, I_WOUT, I_N2G, I_WRG, I_BRG, I_WRE, I_BRE, I_W1, I_W3, I_W2, I_FG };

struct DenseOrder {
    static constexpr bool GATHER = false;
    const char* A; const char* Bt; int K, nM, nN, G, c;
    __device__ __forceinline__ bool next(int i, pg8::Unit& u) const {
        const int L = i * G + c, nwg = nM * nN; if (L >= nwg) return false;
        int wgid = L; { const int q = nwg / 8, r = nwg % 8, xcd = wgid % 8, off = wgid / 8; wgid = (xcd < r ? xcd * (q + 1) : r * (q + 1) + (xcd - r) * q) + off; }
        const int nig = 8 * nN, gid = wgid / nig, fm = gid * 8, gsz = (nM - fm) < 8 ? (nM - fm) : 8;
        u.pm = fm + ((wgid % nig) % gsz); u.pn = (wgid % nig) / gsz; u.A = A; u.B = Bt + (size_t)u.pn * 256 * K * 2; u.aux = 0; return true;
    }
    __device__ __forceinline__ void a_ready(const pg8::Unit&) const {}
    __device__ __forceinline__ unsigned arow(const pg8::Unit& u, int r) const { return (unsigned)(u.pm * 256 + r); }
};
struct UpOrder {
    static constexpr bool GATHER = false;
    const char* A0; const char* A1; const char* B0; const char* B1; int G, c;
    __device__ __forceinline__ bool next(int i, pg8::Unit& u) const {
        const int tile = (i >> 1) * G + c; if (tile >= 256) return false;
        u.pm = tile >> 2; u.pn = tile & 3; u.aux = i & 1;
        u.A = (i & 1) ? A1 : A0; u.B = ((i & 1) ? B1 : B0) + (size_t)u.pn * 256 * 512 * 2; return true;
    }
    __device__ __forceinline__ void a_ready(const pg8::Unit&) const {}
    __device__ __forceinline__ unsigned arow(const pg8::Unit& u, int r) const { return (unsigned)(u.pm * 256 + r); }
};
struct MoeTab { int nt; int pad[3]; int tile_e[176]; int tile_m[176]; int cnt[32]; int tbase[33]; };
struct Moe1Order {
    static constexpr bool GATHER = true;
    const LAS MoeTab* tab; const char* A; const char* W; const int* toklist; int G, c;
    __device__ __forceinline__ bool next(int i, pg8::Unit& u) const {
        const int L = i * G + c; if (L >= tab->nt * 4) return false;
        const int ti = L >> 2; u.pm = ti; u.pn = L & 3; u.aux = ti; u.A = A;
        u.B = W + ((size_t)tab->tile_e[ti] * 1024 + (size_t)u.pn * 256) * 1024 * 2; return true;
    }
    __device__ __forceinline__ void a_ready(const pg8::Unit&) const {}
    __device__ __forceinline__ unsigned arow(const pg8::Unit& u, int r) const {
        const int e = tab->tile_e[u.aux], rr = tab->tile_m[u.aux] * 256 + r;
        return rr < tab->cnt[e] ? (unsigned)toklist[e * T + rr] : 0u;
    }
};
struct Moe2Order {
    static constexpr bool GATHER = false;
    const LAS MoeTab* tab; const char* A; const char* W; unsigned* done; unsigned* tmo; int G, c;
    __device__ __forceinline__ bool next(int i, pg8::Unit& u) const {
        const int n1 = tab->nt * 4, r = n1 % G, nl = G - r; int j;
        if (r > 0 && c >= r) { if (i < 2) j = (c - r) + i * nl; else j = 2 * nl + (c - r) + (i - 2) * G; }
        else j = (r > 0 ? 2 * nl : 0) + ((c - r + G) % G) + i * G;
        if (j >= n1) return false;
        const int ti = j >> 2; u.pm = ti; u.pn = j & 3; u.aux = ti; u.A = A;
        u.B = W + ((size_t)tab->tile_e[ti] * 1024 + (size_t)u.pn * 256) * 512 * 2; return true;
    }
    __device__ __forceinline__ unsigned arow(const pg8::Unit& u, int r) const { return (unsigned)(u.pm * 256 + r); }
    __device__ __forceinline__ void a_ready(const pg8::Unit& u) const {
        if (threadIdx.x < 64) {
            unsigned polls = 0;
            while ((unsigned)__builtin_amdgcn_readfirstlane(__hip_atomic_load(done + 16 * u.pm, __ATOMIC_RELAXED, __HIP_MEMORY_SCOPE_AGENT)) < 32u) {
                if (++polls > (1u << 22)) { if (threadIdx.x == 0) __hip_atomic_store(tmo, 1u, __ATOMIC_RELAXED, __HIP_MEMORY_SCOPE_AGENT); break; }
                __builtin_amdgcn_s_sleep(2); }
            __builtin_amdgcn_fence(__ATOMIC_ACQUIRE, "agent");
            asm volatile("s_waitcnt vmcnt(0)" ::: "memory");
        }
        asm volatile("" ::: "memory"); __builtin_amdgcn_s_barrier(); asm volatile("" ::: "memory");
    }
};

using pg8::Unit; using pg8::cvt_pk_bf16;
struct EpiStoreBf16 {
    static constexpr bool PERM = true;
    bf16_t* O; int ldc; int nscale; float scale0;
    __device__ __forceinline__ bool operator()(f32x4 (&acc)[2][2][4][2], const Unit& u, int wr, int wc, int fr, int fq) const {
        const int row0 = u.pm * 256 + wr * 64 + fr, col0 = u.pn * 256 + wc * 32 + 8 * fq;
        const float sc = u.pn < nscale ? scale0 : 1.0f;
#pragma unroll
        for (int ai = 0; ai < 2; ++ai)
#pragma unroll
            for (int m = 0; m < 4; ++m) { bf16_t* rowp = O + (size_t)(row0 + ai * 128 + m * 16) * ldc + col0;
#pragma unroll
                for (int bj = 0; bj < 2; ++bj) { const f32x4 v0 = acc[ai][bj][m][0] * sc, v1 = acc[ai][bj][m][1] * sc;
                    u32x4 w; w.x = cvt_pk_bf16(v0[0], v0[1]); w.y = cvt_pk_bf16(v0[2], v0[3]); w.z = cvt_pk_bf16(v1[0], v1[1]); w.w = cvt_pk_bf16(v1[2], v1[3]);
                    *(u32x4*)(rowp + bj * 128) = w; } }
        return false;
    }
};
template <int N> __device__ __forceinline__ float dpp_shr(float x) { return __builtin_bit_cast(float, __builtin_amdgcn_update_dpp(0, __builtin_bit_cast(int, x), 0x110 + N, 0xf, 0xf, true)); }
template <int N> __device__ __forceinline__ float dpp_ror(float x) { return __builtin_bit_cast(float, __builtin_amdgcn_update_dpp(0, __builtin_bit_cast(int, x), 0x120 + N, 0xf, 0xf, true)); }
__device__ __forceinline__ float rowsum16(float x) { x += dpp_ror<8>(x); x += dpp_ror<4>(x); x += dpp_ror<2>(x); x += dpp_ror<1>(x); return x; }
__device__ __forceinline__ float scan16(float x) { x += dpp_shr<1>(x); x += dpp_shr<2>(x); x += dpp_shr<4>(x); x += dpp_shr<8>(x); return x; }
struct EpiInProj {
    static constexpr bool PERM = true;
    bf16_t* O; bf16_t* KE; float* DEC; const float* lbv; float scale0;
    __device__ __forceinline__ bool operator()(f32x4 (&acc)[2][2][4][2], const Unit& u, int wr, int wc, int fr, int fq) const {
        { const int l_ = lane_now(); fr = l_ & 15; fq = l_ >> 4; }
        const int row0 = u.pm * 256 + wr * 64 + fr, col0 = u.pn * 256 + wc * 32 + 8 * fq;
        if (u.pn >= 6 && u.pn < 10) {
            const int h = u.pn - 6, lane = 16 * fq + fr, kb = wc * 32 + 8 * fq;
            const int bb = (u.pm * 256) / SEQ, ch0 = ((u.pm * 256) % SEQ + wr * 64) >> 6;
            const f32x4 lb0 = *(const f32x4*)(lbv + h * 128 + kb), lb1 = *(const f32x4*)(lbv + h * 128 + kb + 4);
#pragma unroll
            for (int ai = 0; ai < 2; ++ai) {
                unsigned kep[4][4];
#pragma unroll
                for (int n = 0; n < 2; ++n) {
#pragma unroll
                    for (int ep = 0; ep < 2; ++ep) {
                        float ke2[2][4];
#pragma unroll
                        for (int z = 0; z < 2; ++z) {
                            const int e = 2 * ep + z; const float lb = n ? lb1[e] : lb0[e];
                            float f[4], c[4], tot[4];
#pragma unroll
                            for (int m = 0; m < 4; ++m) { const float fl = acc[ai][1][m][n][e]; f[m] = lb + (1.0f - lb) * __builtin_amdgcn_rcpf(1.0f + __builtin_amdgcn_exp2f(-1.4426950408889634f * fl)); const float lf = __logf(f[m]); c[m] = scan16(lf); tot[m] = rowsum16(lf); }
                            const float alast = (tot[0] + tot[1]) + (tot[2] + tot[3]); const float eal = __expf(alast);
                            float pre = 0.f;
#pragma unroll
                            for (int m = 0; m < 4; ++m) { const float A = c[m] + pre; pre += tot[m]; const float q = acc[ai][0][m][n][e]; const float kk = 1.0f - f[m];
                                acc[ai][0][m][n][e] = q * __builtin_amdgcn_rcpf(1.0f + __builtin_amdgcn_exp2f(-1.4426950408889634f * q)) * __expf(A);
                                const float kd = kk * __expf(-A); acc[ai][1][m][n][e] = kd; ke2[z][m] = kd * eal; }
                            if (fr == 0) DEC[((size_t)(bb * 4 + h) * 64 + ch0 + 2 * ai) * 128 + kb + 4 * n + e] = eal;
                        }
#pragma unroll
                        for (int m = 0; m < 4; ++m) kep[m][2 * n + ep] = cvt_pk_bf16(ke2[0][m], ke2[1][m]);
                    }
                }
#pragma unroll
                for (int m = 0; m < 4; ++m) *(u32x4*)(KE + (size_t)(row0 + ai * 128 + m * 16) * 512 + h * 128 + kb) = (u32x4){kep[m][0], kep[m][1], kep[m][2], kep[m][3]};
            }
        }
        const float sc = u.pn < 2 ? scale0 : 1.0f;
#pragma unroll
        for (int ai = 0; ai < 2; ++ai)
#pragma unroll
            for (int m = 0; m < 4; ++m) { bf16_t* rowp = O + (size_t)(row0 + ai * 128 + m * 16) * INC + col0;
#pragma unroll
                for (int bj = 0; bj < 2; ++bj) { const f32x4 v0 = acc[ai][bj][m][0] * sc, v1 = acc[ai][bj][m][1] * sc;
                    u32x4 w; w.x = cvt_pk_bf16(v0[0], v0[1]); w.y = cvt_pk_bf16(v0[2], v0[3]); w.z = cvt_pk_bf16(v1[0], v1[1]); w.w = cvt_pk_bf16(v1[2], v1[3]);
                    *(u32x4*)(rowp + bj * 128) = w; } }
        return false;
    }
};
struct EpiUp {
    static constexpr bool PERM = true;
    const bf16_t* proj; bf16_t* O;
    __device__ __forceinline__ bool operator()(f32x4 (&acc)[2][2][4][2], const Unit& u, int wr, int wc, int fr, int fq) const {
        const int row0 = u.pm * 256 + wr * 64 + fr, col0 = u.pn * 256 + wc * 32 + 8 * fq;
#pragma unroll
        for (int ai = 0; ai < 2; ++ai)
#pragma unroll
            for (int m = 0; m < 4; ++m) { const size_t row = (size_t)(row0 + ai * 128 + m * 16);
#pragma unroll
                for (int bj = 0; bj < 2; ++bj) {
                    const int col = col0 + bj * 128;
                    const u32x4 gh = *(const u32x4*)(proj + row * INC + C_GHGATE + col);
                    float sh[8];
#pragma unroll
                    for (int j = 0; j < 4; ++j) { sh[2 * j] = 1.0f + __builtin_amdgcn_exp2f(-1.4426950408889634f * bf2f(gh[j] & 0xffffu)); sh[2 * j + 1] = 1.0f + __builtin_amdgcn_exp2f(-1.4426950408889634f * bf2f(gh[j] >> 16)); }
                    if (u.aux == 0) {
                        const u32x4 gd = *(const u32x4*)(proj + row * INC + C_GDA + col);
#pragma unroll
                        for (int j = 0; j < 4; ++j) {
                            const float d0 = 1.0f + __builtin_amdgcn_exp2f(-1.4426950408889634f * bf2f(gd[j] & 0xffffu)), d1 = 1.0f + __builtin_amdgcn_exp2f(-1.4426950408889634f * bf2f(gd[j] >> 16));
                            const float r0 = sh[2 * j] * __builtin_amdgcn_rcpf(d0), r1 = sh[2 * j + 1] * __builtin_amdgcn_rcpf(d1);
                            if (j < 2) { acc[ai][bj][m][0][2 * j] *= r0; acc[ai][bj][m][0][2 * j + 1] *= r1; }
                            else { acc[ai][bj][m][1][2 * j - 4] *= r0; acc[ai][bj][m][1][2 * j - 3] *= r1; }
                        }
                    } else {
                        const f32x4 v0 = acc[ai][bj][m][0], v1 = acc[ai][bj][m][1];
#pragma unroll
                        for (int j = 0; j < 8; ++j) sh[j] = __builtin_amdgcn_rcpf(sh[j]);
                        u32x4 w; w.x = cvt_pk_bf16(v0[0] * sh[0], v0[1] * sh[1]); w.y = cvt_pk_bf16(v0[2] * sh[2], v0[3] * sh[3]);
                        w.z = cvt_pk_bf16(v1[0] * sh[4], v1[1] * sh[5]); w.w = cvt_pk_bf16(v1[2] * sh[6], v1[3] * sh[7]);
                        *(u32x4*)(O + row * D + col) = w;
                    }
                } }
        return u.aux == 0;
    }
};
struct EpiOut {
    static constexpr bool PERM = true;
    const float* x; const float* mod; bf16_t* O;
    __device__ __forceinline__ bool operator()(f32x4 (&acc)[2][2][4][2], const Unit& u, int wr, int wc, int fr, int fq) const {
        const int row0 = u.pm * 256 + wr * 64 + fr, col0 = u.pn * 256 + wc * 32 + 8 * fq;
        const int b = (u.pm * 256) / SEQ;
        f32x4 gt[2][2];
#pragma unroll
        for (int bj = 0; bj < 2; ++bj)
#pragma unroll
            for (int n = 0; n < 2; ++n) gt[bj][n] = *(const f32x4*)(mod + b * 6144 + 2048 + col0 + bj * 128 + n * 4);
#pragma unroll
        for (int ai = 0; ai < 2; ++ai)
#pragma unroll
            for (int m = 0; m < 4; ++m) { const size_t off = (size_t)(row0 + ai * 128 + m * 16) * D + col0;
#pragma unroll
                for (int bj = 0; bj < 2; ++bj) { const f32x4 x0 = *(const f32x4*)(x + off + bj * 128), x1 = *(const f32x4*)(x + off + bj * 128 + 4);
                    const f32x4 v0 = x0 + gt[bj][0] * acc[ai][bj][m][0], v1 = x1 + gt[bj][1] * acc[ai][bj][m][1];
                    u32x4 w; w.x = cvt_pk_bf16(v0[0], v0[1]); w.y = cvt_pk_bf16(v0[2], v0[3]); w.z = cvt_pk_bf16(v1[0], v1[1]); w.w = cvt_pk_bf16(v1[2], v1[3]);
                    *(u32x4*)(O + off + bj * 128) = w; } }
        return false;
    }
};
struct EpiMoe1 {
    static constexpr bool PERM = true;
    bf16_t* O; unsigned* done;
    __device__ __forceinline__ bool operator()(f32x4 (&acc)[2][2][4][2], const Unit& u, int wr, int wc, int fr, int fq) const {
        const int row0 = u.pm * 256 + wr * 64 + fr, col0 = u.pn * 128 + wc * 32 + 8 * fq;
#pragma unroll
        for (int ai = 0; ai < 2; ++ai)
#pragma unroll
            for (int m = 0; m < 4; ++m) { bf16_t* rowp = O + (size_t)(row0 + ai * 128 + m * 16) * DEXP + col0;
                float h[8];
#pragma unroll
                for (int n = 0; n < 2; ++n)
#pragma unroll
                    for (int e = 0; e < 4; ++e) { const float x_ = acc[ai][0][m][n][e]; h[n * 4 + e] = x_ * __builtin_amdgcn_rcpf(1.0f + __builtin_amdgcn_exp2f(-1.4426950408889634f * x_)) * acc[ai][1][m][n][e]; }
                u32x4 w; w.x = cvt_pk_bf16(h[0], h[1]); w.y = cvt_pk_bf16(h[2], h[3]); w.z = cvt_pk_bf16(h[4], h[5]); w.w = cvt_pk_bf16(h[6], h[7]);
                asm volatile("global_store_dwordx4 %0, %1, off sc1\n\ts_nop 1" :: "v"(rowp), "v"(w) : "memory"); }
        asm volatile("s_waitcnt vmcnt(0)" ::: "memory");
        if ((threadIdx.x & 63) == 0) __hip_atomic_fetch_add(done + 16 * u.pm, 1u, __ATOMIC_RELAXED, __HIP_MEMORY_SCOPE_AGENT);
        return false;
    }
};

struct Frame { LAS unsigned char* lds; int tid, lane, wave, G, bid; };

__device__ __forceinline__ void transpose_item(const float* Wsrc, int ldw, bf16_t* dst, int ldd, LAS float* scr, int lane) {
#pragma unroll 8
    for (int i = 0; i < 32; ++i) { const int kk = 2 * i + (lane >> 5); scr[kk * 33 + (lane & 31)] = __builtin_nontemporal_load(Wsrc + (size_t)kk * ldw + (lane & 31)); }
    asm volatile("s_waitcnt lgkmcnt(0)" ::: "memory");
    const int c = lane & 7;
#pragma unroll
    for (int j = 0; j < 4; ++j) { const int n = (lane >> 3) + 8 * j; const LAS float* s = scr + (8 * c) * 33 + n;
        u32x4 o; o.x = pk2(s[0 * 33], s[1 * 33]); o.y = pk2(s[2 * 33], s[3 * 33]); o.z = pk2(s[4 * 33], s[5 * 33]); o.w = pk2(s[6 * 33], s[7 * 33]);
        *(u32x4*)(dst + (size_t)n * ldd + 8 * c) = o; }
    asm volatile("s_waitcnt lgkmcnt(0)" ::: "memory");
}
struct TItem { const float* src; bf16_t* dst; int ldw, ldd; };
template <class ItemFn>
__device__ __forceinline__ void transpose_stream(int it_lo, int it_hi, int gw, int NGW, LAS float* scr, int lane, ItemFn item) {
    int it = it_lo + gw; if (it >= it_hi) return;
    TItem cur = item(it);
    float v[32];
    const int l31 = lane & 31, lh = lane >> 5;
#pragma unroll
    for (int i = 0; i < 32; ++i) v[i] = __builtin_nontemporal_load(cur.src + (size_t)(2 * i + lh) * cur.ldw + l31);
    while (true) {
#pragma unroll
        for (int i = 0; i < 32; ++i) scr[(2 * i + lh) * 33 + l31] = v[i];
        const int nx = it + NGW; const bool more = nx < it_hi; TItem nxt = cur;
        if (more) { nxt = item(nx);
#pragma unroll
            for (int i = 0; i < 32; ++i) v[i] = __builtin_nontemporal_load(nxt.src + (size_t)(2 * i + lh) * nxt.ldw + l31); }
        asm volatile("s_waitcnt lgkmcnt(0)" ::: "memory");
        const int c = lane & 7;
#pragma unroll
        for (int j = 0; j < 4; ++j) { const int n = (lane >> 3) + 8 * j; const LAS float* s_ = scr + (8 * c) * 33 + n;
            u32x4 o; o.x = pk2(s_[0 * 33], s_[1 * 33]); o.y = pk2(s_[2 * 33], s_[3 * 33]); o.z = pk2(s_[4 * 33], s_[5 * 33]); o.w = pk2(s_[6 * 33], s_[7 * 33]);
            *(u32x4*)(cur.dst + (size_t)n * cur.ldd + 8 * c) = o; }
        asm volatile("s_waitcnt lgkmcnt(0)" ::: "memory");
        if (!more) break;
        cur = nxt; it = nx;
    }
}
__device__ __forceinline__ void transpose_matrix(const Frame& F, const float* W, int K, int N, bf16_t* WT) {
    LAS float* scr = (LAS float*)(F.lds + F.wave * 8448);
    const int gw = F.bid * NWAVES + F.wave, NGW = F.G * NWAVES, nblk = N / 32, items = (K / 64) * nblk;
    transpose_stream(0, items, gw, NGW, scr, F.lane, [=](int it) { const int kb = it / nblk, nb = it % nblk;
        return TItem{W + (size_t)(64 * kb) * N + 32 * nb, WT + (size_t)(32 * nb) * K + 64 * kb, N, K}; });
}

__device__ __forceinline__ void phase0(const Frame& F, const Args& a) {
    unsigned char* ws = a.ws;
    {
        float* mod = (float*)(ws + WS_MOD);
        const float* c = a.in[I_C]; const float* wada = a.in[I_WADA]; const float* bada = a.in[I_BADA];
        LAS f32x4* cs4 = (LAS f32x4*)(F.lds + 72 * 1024);
        LAS float* red = (LAS float*)(F.lds + 72 * 1024 + 16 * 1024);
        for (int i = F.tid; i < 4 * D; i += NTHR) ((LAS float*)cs4)[(i & (D - 1)) * 4 + (i >> 10)] = siluf_(c[i]);
        __syncthreads();
        for (int cb = F.bid; cb < 6144 / 32; cb += F.G) {
            const int l15 = F.lane & 15, lq = F.lane >> 4, k0 = 128 * F.wave + lq;
            const float* wp = wada + (size_t)k0 * 6144 + cb * 32 + 2 * l15;
            f32x2 wv[32];
#pragma unroll
            for (int i = 0; i < 32; ++i) wv[i] = __builtin_nontemporal_load((const f32x2*)(wp + (size_t)(4 * i) * 6144));
            f32x2 s[4] = {{0.f, 0.f}, {0.f, 0.f}, {0.f, 0.f}, {0.f, 0.f}};
#pragma unroll
            for (int i = 0; i < 32; ++i) { const f32x4 cv = cs4[k0 + 4 * i];
#pragma unroll
                for (int b = 0; b < 4; ++b) s[b] += wv[i] * cv[b]; }
#pragma unroll
            for (int b = 0; b < 4; ++b) { f32x2 t = s[b];
                t.x += __shfl_xor(t.x, 16); t.y += __shfl_xor(t.y, 16); t.x += __shfl_xor(t.x, 32); t.y += __shfl_xor(t.y, 32);
                if (lq == 0) *(LAS f32x2*)(red + (F.wave * 4 + b) * 32 + 2 * l15) = t; }
            __syncthreads();
            if (F.tid < 128) { const int b = F.tid >> 5, cc = F.tid & 31; float t = bada[cb * 32 + cc];
#pragma unroll
                for (int w = 0; w < 8; ++w) t += red[(w * 4 + b) * 32 + cc];
                mod[b * 6144 + cb * 32 + cc] = t; }
            __syncthreads();
        }
    }
    if (F.bid == 0) {
        float* sm = (float*)(ws + WS_SMALL);
        if (F.tid == 0) {
            float s1 = 0.f, s2 = 0.f;
            for (int i = 0; i < 64; ++i) { s1 += a.in[I_LQ1][i] * a.in[I_LK1][i]; s2 += a.in[I_LQ2][i] * a.in[I_LK2][i]; }
            sm[0] = expf(s1) - expf(s2) + 0.2f;
        }
        { const float l0 = a.in[I_LBL][F.tid], l1 = a.in[I_LBL][512 + F.tid]; const float mx = fmaxf(l0, l1);
          const float e0 = expf(l0 - mx), e1 = expf(l1 - mx); sm[16 + F.tid] = e0 / (e0 + e1); }
    }
}
__device__ __forceinline__ void moe_w2_convert(const Frame& F, const Args& a, int it_lo, int it_hi, int gw, int NGW) {
    LAS float* scr = (LAS float*)(F.lds + F.wave * 8448);
    bf16_t* w2t = (bf16_t*)((unsigned char*)a.out + OUT_W2); const float* w2 = a.in[I_W2];
    transpose_stream(it_lo, it_hi, gw, NGW, scr, F.lane, [=](int it) { const int e = it >> 8, kb = (it >> 5) & 7, nb = it & 31;
        return TItem{w2 + (size_t)e * 512 * 1024 + (size_t)(64 * kb) * 1024 + 32 * nb, w2t + ((size_t)e * 1024 + 32 * nb) * 512 + 64 * kb, 1024, 512}; });
}
__device__ __forceinline__ int w2_early_items(int G, int& n_light) { const int nwg = (T / 256) * (INC / 256), r = nwg % G; n_light = r ? G - r : 0; return n_light >= 64 ? W2_EARLY * 256 : 0; }
__device__ __forceinline__ void moe_weight_convert(const Frame& F, const Args& a) {
    LAS float* scr = (LAS float*)(F.lds + F.wave * 8448);
    const int gw = F.bid * NWAVES + F.wave, NGW = F.G * NWAVES;
    bf16_t* w13 = (bf16_t*)(a.ws + WS_W13);
    const float* w1 = a.in[I_W1]; const float* w3 = a.in[I_W3];
    transpose_stream(0, 2 * NEXP * 256, gw, NGW, scr, F.lane, [=](int it) {
        const int which = it / (NEXP * 256), r = it % (NEXP * 256), e = r >> 8, kb = (r >> 4) & 15, nb = r & 15, n0 = 32 * nb;
        const float* W = (which ? w3 : w1) + (size_t)e * 1024 * 512;
        const int drow = 256 * (n0 >> 7) + (which ? 128 : 0) + (n0 & 127);
        return TItem{W + (size_t)(64 * kb) * 512 + n0, w13 + ((size_t)e * 1024 + drow) * 1024 + 64 * kb, 512, 1024}; });
    int nl; const int early = w2_early_items(F.G, nl);
    moe_w2_convert(F, a, early, NEXP * 256, gw, NGW);
}

__device__ __forceinline__ void dense_weight_convert(const Frame& F, const Args& a) {
    unsigned char* ws = a.ws;
    {
        LAS float* scr = (LAS float*)(F.lds + F.wave * 8448);
        const int gw = F.bid * NWAVES + F.wave, NGW = F.G * NWAVES, nblk = INC / 32, items = (D / 64) * nblk;
        bf16_t* WT = (bf16_t*)(ws + WS_WIN);
        const float* win = a.in[I_WIN];
        transpose_stream(0, items, gw, NGW, scr, F.lane, [=](int it) { const int kb = it / nblk, n0 = 32 * (it % nblk); int dr = n0;
            if (n0 >= C_QHG && n0 < C_FHG) dr = C_HGT + 256 * ((n0 - C_QHG) >> 7) + ((n0 - C_QHG) & 127);
            else if (n0 >= C_FHG && n0 < C_IHG) dr = C_HGT + 256 * ((n0 - C_FHG) >> 7) + 128 + ((n0 - C_FHG) & 127);
            return TItem{win + (size_t)(64 * kb) * INC + n0, WT + (size_t)dr * D + 64 * kb, INC, D}; });
    }
    transpose_matrix(F, a.in[I_WUPDA], 512, D, (bf16_t*)(ws + WS_WUPDA));
    transpose_matrix(F, a.in[I_WUPHG], 512, D, (bf16_t*)(ws + WS_WUPHG));
    transpose_matrix(F, a.in[I_WOUT], D, D, (bf16_t*)(ws + WS_WOUT));
}
__device__ __forceinline__ void phase1(const Frame& F, const Args& a) {
    const float* mod = (const float*)(a.ws + WS_MOD);
    LAS float* Gs = (LAS float*)F.lds;
    LAS float* Ss = Gs + 1024;
    bf16_t* H = (bf16_t*)(a.ws + WS_ACT);
    const int rows_per_blk = T / F.G;
    const int r0 = F.bid * rows_per_blk, b = r0 / SEQ;
    for (int k = F.tid; k < 1024; k += NTHR) { Gs[k] = a.in[I_N1G][k] * (1.0f + mod[b * 6144 + 1024 + k]); Ss[k] = mod[b * 6144 + k]; }
    __syncthreads();
    for (int rb = r0 + F.wave; rb < r0 + rows_per_blk; rb += 4 * NWAVES) {
        f32x4 v[4][4];
#pragma unroll
        for (int q = 0; q < 4; ++q) { const int r = rb + q * NWAVES < r0 + rows_per_blk ? rb + q * NWAVES : rb; const f32x4* xr = (const f32x4*)(a.in[I_X] + (size_t)r * D) + F.lane;
#pragma unroll
            for (int j = 0; j < 4; ++j) v[q][j] = __builtin_nontemporal_load(xr + 64 * j); }
#pragma unroll
        for (int q = 0; q < 4; ++q) { const int r = rb + q * NWAVES; if (r >= r0 + rows_per_blk) break;
            float s = 0.f;
#pragma unroll
            for (int j = 0; j < 4; ++j) s += (v[q][j].x * v[q][j].x + v[q][j].y * v[q][j].y) + (v[q][j].z * v[q][j].z + v[q][j].w * v[q][j].w);
            const float rs = rsqrtf(wave_sum(s) * (1.0f / D) + EPS);
            unsigned long long* o8 = (unsigned long long*)(H + (size_t)r * D) + F.lane;
#pragma unroll
            for (int j = 0; j < 4; ++j) { const f32x4 g = *(const LAS f32x4*)(Gs + 256 * j + 4 * F.lane), sh = *(const LAS f32x4*)(Ss + 256 * j + 4 * F.lane);
                const f32x4 h = v[q][j] * rs * g + sh;
                o8[64 * j] = (unsigned long long)pk2(h.x, h.y) | ((unsigned long long)pk2(h.z, h.w) << 32); } }
    }
}

namespace attn_body {
using s16x4=__attribute__((ext_vector_type(4)))short;
using f32x16=__attribute__((ext_vector_type(16)))float;
constexpr int NW=8,QBLK=32,QB=QBLK*NW,KVBLK=64,NQB=SEQ/QB;
constexpr int PIN=INC, POUT=1024;
__device__ __forceinline__ int crow(int r,int hi){return (r&3)+8*(r>>2)+4*hi;}
#define SBAR() __builtin_amdgcn_sched_barrier(0)
__device__ __forceinline__ void bmask(f32x16&p0,f32x16&p1,int jb,int wch,int il,int hi,float s2x2){
  if(jb>wch){
    #pragma unroll
    for(int r=0;r<16;++r){p0[r]=-INFINITY;p1[r]=-INFINITY;}
  } else if(jb==wch){
    float fb=(float)(4*hi-il); asm volatile("":"+v"(fb));
    #pragma unroll
    for(int r=0;r<16;++r){const float c=(float)((r&3)+8*(r>>2)); p0[r]-=s2x2*__builtin_fmaxf(fb+c,0.f); p1[r]-=s2x2*__builtin_fmaxf(fb+(c+32.f),0.f);}
  }
}
constexpr int NSLOT=3, SLOTB=8192, VSLOTB=16384;
constexpr int LDS_K=0, LDS_V=NSLOT*SLOTB, LDS_WS=LDS_V+NSLOT*VSLOTB, LDS_OST=LDS_WS+NW*64*4, ATT_LDS_BYTES=LDS_OST+NW*8192;
constexpr float C2=0.125f*1.4426950408889634f;
__device__ __forceinline__ void glds16(const void*gsrc,unsigned lds_dst){unsigned keep;
  asm volatile("s_mov_b32 %0, m0\n\ts_mov_b32 m0, %2\n\ts_nop 0\n\tglobal_load_lds_dwordx4 %1, off\n\ts_mov_b32 m0, %0":"=&s"(keep):"v"(gsrc),"s"(lds_dst):"memory");}
__device__ __forceinline__ float max3f(float a,float b,float c){float r;asm("v_max3_f32 %0, %1, %2, %3":"=v"(r):"v"(a),"v"(b),"v"(c));return r;}
__device__ __forceinline__ float max2f(float a,float b){float r;asm("v_max_f32_e32 %0, %1, %2":"=v"(r):"v"(a),"v"(b));return r;}
__device__ __forceinline__ float fadd_s(float a,float b){float r;asm("v_add_f32_e32 %0, %1, %2":"=v"(r):"v"(a),"v"(b));return r;}
__device__ __forceinline__ float fsub_s(float a,float b){float r;asm("v_sub_f32_e32 %0, %1, %2":"=v"(r):"v"(a),"v"(b));return r;}
typedef float f32x2_t __attribute__((ext_vector_type(2))); typedef __bf16 bf16x2_t __attribute__((ext_vector_type(2)));
__device__ __forceinline__ unsigned cvtpk_s(float lo,float hi){f32x2_t v={lo,hi};bf16x2_t b=__builtin_convertvector(v,bf16x2_t);return __builtin_bit_cast(unsigned,b);}
#define WAIT_BAR(N) asm volatile("s_waitcnt vmcnt(" #N ") lgkmcnt(0)\n\ts_barrier":::"memory")

__device__ __forceinline__ void qkt(f32x16&p0,f32x16&p1,const char*Kslot,const bf16x8*qr,const f32x16&c0,const f32x16&c1,int r32,int hi){
  const char*kb=Kslot+hi*1024+r32*16;
  #pragma unroll
  for(int d0=0;d0<4;++d0){
    const bf16x8 b0=*reinterpret_cast<const bf16x8*>(kb+d0*2048);
    const bf16x8 b1=*reinterpret_cast<const bf16x8*>(kb+d0*2048+512);
    if(d0==0){p0=__builtin_amdgcn_mfma_f32_32x32x16_bf16(b0,qr[0],c0,0,0,0);p1=__builtin_amdgcn_mfma_f32_32x32x16_bf16(b1,qr[0],c1,0,0,0);}
    else{p0=__builtin_amdgcn_mfma_f32_32x32x16_bf16(b0,qr[d0],p0,0,0,0);p1=__builtin_amdgcn_mfma_f32_32x32x16_bf16(b1,qr[d0],p1,0,0,0);}}
}
typedef __attribute__((address_space(3))) const char* lds_cptr;
typedef short v4i16_t __attribute__((ext_vector_type(4)));
__device__ __forceinline__ void kload8(bf16x8*kf,lds_cptr kp){
  kf[0]=*(const __attribute__((address_space(3))) bf16x8*)(kp);      kf[1]=*(const __attribute__((address_space(3))) bf16x8*)(kp+512);
  kf[2]=*(const __attribute__((address_space(3))) bf16x8*)(kp+2048); kf[3]=*(const __attribute__((address_space(3))) bf16x8*)(kp+2560);
  kf[4]=*(const __attribute__((address_space(3))) bf16x8*)(kp+4096); kf[5]=*(const __attribute__((address_space(3))) bf16x8*)(kp+4608);
  kf[6]=*(const __attribute__((address_space(3))) bf16x8*)(kp+6144); kf[7]=*(const __attribute__((address_space(3))) bf16x8*)(kp+6656);
}
__device__ __forceinline__ void kload2(bf16x8*kf,lds_cptr kp,int j){ kf[2*j]=*(const __attribute__((address_space(3))) bf16x8*)(kp+j*2048); kf[2*j+1]=*(const __attribute__((address_space(3))) bf16x8*)(kp+j*2048+512); }
__device__ __forceinline__ s16x4 vtr(lds_cptr p){ return __builtin_bit_cast(s16x4,__builtin_amdgcn_ds_read_tr16_b64_v4i16((__attribute__((address_space(3))) v4i16_t*)p)); }
__device__ __forceinline__ float rowmax(const f32x16&p0,const f32x16&p1){
  float a=max3f(p0[0],p0[1],p1[0]),b=max3f(p0[2],p0[3],p1[1]);a=max3f(a,p1[2],p1[3]);
  #pragma unroll
  for(int r=4;r<16;r+=4){a=max3f(a,p0[r],p0[r+1]);b=max3f(b,p0[r+2],p0[r+3]);a=max3f(a,p1[r],p1[r+1]);b=max3f(b,p1[r+2],p1[r+3]);}
  const float m=max2f(a,b);
  auto rr=__builtin_amdgcn_permlane32_swap(__float_as_uint(m),__float_as_uint(m),false,false);
  return max2f(__uint_as_float(rr[0]),__uint_as_float(rr[1]));
}
__device__ __forceinline__ void pv(f32x16*o,int vb,bf16x8 pa0,bf16x8 pa1,bf16x8 pa2,bf16x8 pa3){
  #pragma unroll
  for(int d0=0;d0<4;++d0){s16x4 lo[4],hi[4];
    #pragma unroll
    for(int ks=0;ks<4;++ks){
      asm volatile("ds_read_b64_tr_b16 %0,%1 offset:%c2":"=&v"(lo[ks]):"v"(vb),"i"(d0*4096+ks*1024):"memory");
      asm volatile("ds_read_b64_tr_b16 %0,%1 offset:%c2":"=&v"(hi[ks]):"v"(vb),"i"(d0*4096+ks*1024+512):"memory");}
    asm volatile("s_waitcnt lgkmcnt(0)":::"memory");SBAR();
    #define PK(k) (bf16x8){lo[k][0],lo[k][1],lo[k][2],lo[k][3],hi[k][0],hi[k][1],hi[k][2],hi[k][3]}
    o[d0]=__builtin_amdgcn_mfma_f32_32x32x16_bf16(pa0,PK(0),o[d0],0,0,0);
    o[d0]=__builtin_amdgcn_mfma_f32_32x32x16_bf16(pa1,PK(1),o[d0],0,0,0);
    o[d0]=__builtin_amdgcn_mfma_f32_32x32x16_bf16(pa2,PK(2),o[d0],0,0,0);
    o[d0]=__builtin_amdgcn_mfma_f32_32x32x16_bf16(pa3,PK(3),o[d0],0,0,0);
    #undef PK
  }
}
#define ATTN_STORE16(p,v) (*(u32x4*)(p)=(v))
template<int THRL> __device__ __forceinline__ void attn_unit(int qb,const bf16_t*Qb,const bf16_t*__restrict__ Kh,const bf16_t*__restrict__ Vh,bf16_t*Ob,float slope2,char*shm){
  const int wid=__builtin_amdgcn_readfirstlane(threadIdx.x>>6); const int lane=lane_now(),r32=lane&31,hi=lane>>5;
  const int q0=qb*QB;
  const bf16_t*Qw=Qb+(long)(q0+wid*QBLK)*PIN;
  const unsigned lds0=(unsigned)(uintptr_t)shm;
  float*wsf=(float*)(shm+LDS_WS)+wid*64;
  const bf16_t*ksrc=Kh+(long)lane*PIN+wid*8;
  const bf16_t*vsrc=Vh+(long)(16*(wid&3)+(lane>>2))*PIN+(wid>>2)*32+(lane&3)*8;
  const unsigned kdst=lds0+LDS_K+wid*1024, vdst=lds0+LDS_V+(wid>>2)*4096+(wid&3)*1024;
  #define DMA_K(t,slot) glds16(ksrc+(long)(t)*KVBLK*PIN,(unsigned)__builtin_amdgcn_readfirstlane(kdst+(slot)))
  #define DMA_V(t,slot) do{ glds16(vsrc+(long)(t)*KVBLK*PIN,(unsigned)__builtin_amdgcn_readfirstlane(vdst+2*(slot))); glds16(vsrc+(long)(t)*KVBLK*PIN+64,(unsigned)__builtin_amdgcn_readfirstlane(vdst+2*(slot)+8192)); }while(0)
  const int vb0=(int)(lds0+LDS_V)+((lane>>4)&1)*32+(lane&3)*8+(4*hi+((lane&15)>>2))*64;
  const char*Kbase=shm+LDS_K; bf16x8 kf[8];
  const lds_cptr shm3=(lds_cptr)shm; const lds_cptr kp0=shm3+LDS_K+hi*1024+r32*16; const lds_cptr vp0=shm3+LDS_V+((lane>>4)&1)*32+(lane&3)*8+(4*hi+((lane&15)>>2))*64;
  const int NT=(q0+QB)/KVBLK;
  DMA_K(0,0);DMA_V(0,0);DMA_K(1,SLOTB);
  bf16x8 qr[4];
  #pragma unroll
  for(int d0=0;d0<4;++d0)qr[d0]=*reinterpret_cast<const bf16x8*>(&Qw[(long)r32*PIN+d0*16+hi*8]);
  float mhat=0.f,l_reg=0.f;f32x16 o[4];o[0]=f32x16{};o[1]=f32x16{};o[2]=f32x16{};o[3]=f32x16{};
  const float s64=slope2*64.f, s32=slope2*32.f, s2x2=2.f*slope2, s4hi=slope2*4.f*(float)hi;
  const int wch=wid>>1, il=32*(wid&1)+r32;
  #define CMASK(P0,P1,t) do{int jb_=(t)-(NT-4); if(jb_>=0)bmask(P0,P1,jb_,wch,il,hi,s2x2);}while(0)
  #define CINIT0(C0,t) do{ const float bt_=s64*(float)((t)-NT)-mhat+s4hi; _Pragma("unroll") for(int r=0;r<16;++r){C0[r]=__builtin_fmaf(slope2,(float)((r&3)+8*(r>>2)),bt_);} }while(0)
  #define CINIT1(C1,t) do{ const float bu_=s64*(float)((t)-NT)-mhat+s4hi+s32; _Pragma("unroll") for(int r=0;r<16;++r){C1[r]=__builtin_fmaf(slope2,(float)((r&3)+8*(r>>2)),bu_);} }while(0)
  bool resc=false;
  #define START(P0,P1) do{ const float rm=rowmax(P0,P1); resc=false; \
    { const float dl=rm; mhat=fadd_s(mhat,dl); \
      _Pragma("unroll") for(int r=0;r<16;++r){P0[r]=fsub_s(P0[r],dl);P1[r]=fsub_s(P1[r],dl);} } \
    _Pragma("unroll") for(int r=0;r<16;++r)P0[r]=__builtin_amdgcn_exp2f(P0[r]); }while(0)
  #define RESC() do{ if(resc){ asm volatile("s_waitcnt lgkmcnt(0)":::"memory"); \
      _Pragma("unroll") for(int d_=0;d_<4;++d_) _Pragma("unroll") for(int r=0;r<16;++r)o[d_][r]*=wsf[crow(r,hi)]; } }while(0)
  f32x16 cS0,cS1;
  u32x4 pwa0,pwa1,pwa2,pwa3,pwb0,pwb1,pwb2,pwb3;
  int sl_prev=0,sl_cur=0,sl_next=SLOTB;
  #define ROT() do{sl_prev=sl_cur;sl_cur=sl_next;sl_next=(sl_next==(NSLOT-1)*SLOTB)?0:sl_next+SLOTB;}while(0)
  #define PKW(P,B) cvtpk_s(P[B],P[B+1])
  DMA_K(2,2*SLOTB);
  WAIT_BAR(3);
  { f32x16 c0,c1; CINIT0(c0,0); CINIT1(c1,0); qkt(cS0,cS1,Kbase,qr,c0,c1,r32,hi); }
  asm volatile("s_nop 15\n\ts_nop 7":"+v"(cS0),"+v"(cS1));CMASK(cS0,cS1,0);
  START(cS0,cS1);
  _Pragma("unroll") for(int r=0;r<16;++r)cS1[r]=__builtin_amdgcn_exp2f(cS1[r]);
  { float sacc=cS0[0]+cS0[1]; _Pragma("unroll") for(int r=2;r<16;++r)sacc+=cS0[r]; _Pragma("unroll") for(int r=0;r<16;++r)sacc+=cS1[r]; l_reg+=sacc;
    pwa0=(u32x4){PKW(cS0,0),PKW(cS0,2),PKW(cS0,4),PKW(cS0,6)};pwa1=(u32x4){PKW(cS0,8),PKW(cS0,10),PKW(cS0,12),PKW(cS0,14)};pwa2=(u32x4){PKW(cS1,0),PKW(cS1,2),PKW(cS1,4),PKW(cS1,6)};pwa3=(u32x4){PKW(cS1,8),PKW(cS1,10),PKW(cS1,12),PKW(cS1,14)}; }
  WAIT_BAR(0);
  DMA_K(3,0);DMA_V(1,SLOTB);
  ROT();
  kload8(kf,kp0+sl_cur);
  WAIT_BAR(3);
  s16x4 vlo[4],vhi[4];
  #define CAT_(a,b) a##b
  #define CAT(a,b) CAT_(a,b)
  #define PAFC(P,k) __builtin_bit_cast(bf16x8,CAT(P,k))
  #define VFR(k) (bf16x8){vlo[(k)&3][0],vlo[(k)&3][1],vlo[(k)&3][2],vlo[(k)&3][3],vhi[(k)&3][0],vhi[(k)&3][1],vhi[(k)&3][2],vhi[(k)&3][3]}
  #define VOFF(k) ((k)<8 ? (((k)&1)*4096+((k)>>1)*1024) : ((2+((k)&1))*4096+(((k)-8)>>1)*1024))
  #define PIN_(x) asm volatile("":"+v"(x))
  #define MX3(a,b,c) __builtin_fmaxf(__builtin_fmaxf((a),(b)),(c))
  #define QK(MF) do{ MF; SBAR(); }while(0)
  #define EX(v) __builtin_amdgcn_exp2f(v)
  #define VRD(k) do{ vlo[(k)&3]=vtr(vp_+VOFF(k)); vhi[(k)&3]=vtr(vp_+(VOFF(k)+512)); }while(0)
  #define VNX(k) do{ if((k)+4<16){ VRD((k)+4); } SBAR(); }while(0)
  #define GAPB3(MF,X,B,PW,J) do{ MF; X[B]=EX(X[B]); X[B+1]=EX(X[B+1]); sacc+=X[B]; sacc+=X[B+1]; PW[J]=cvtpk_s(X[B],X[B+1]); PIN_(X); PIN_(sacc); PIN_(PW); SBAR(); }while(0)
  #define KRD(G,j) do{ if(G){ kload2(kf,kp0+sl_next,j); SBAR(); } }while(0)
  #define STEP(PC,PN,t,GK,GV,GL) do{ SBAR(); \
    CINIT0(cS0,t); SBAR(); \
    const lds_cptr vp_=vp0+2*sl_prev; \
    VRD(0); SBAR(); QK(cS0=__builtin_amdgcn_mfma_f32_32x32x16_bf16(kf[0],qr[0],cS0,0,0,0)); \
    CINIT1(cS1,t); VRD(1); SBAR(); QK(cS1=__builtin_amdgcn_mfma_f32_32x32x16_bf16(kf[1],qr[0],cS1,0,0,0)); \
    VRD(2); SBAR(); QK(cS0=__builtin_amdgcn_mfma_f32_32x32x16_bf16(kf[2],qr[1],cS0,0,0,0)); \
    VRD(3); SBAR(); QK(cS1=__builtin_amdgcn_mfma_f32_32x32x16_bf16(kf[3],qr[1],cS1,0,0,0)); \
    QK(cS0=__builtin_amdgcn_mfma_f32_32x32x16_bf16(kf[4],qr[2],cS0,0,0,0)); \
    QK(cS1=__builtin_amdgcn_mfma_f32_32x32x16_bf16(kf[5],qr[2],cS1,0,0,0)); \
    QK(cS0=__builtin_amdgcn_mfma_f32_32x32x16_bf16(kf[6],qr[3],cS0,0,0,0)); \
    QK(cS1=__builtin_amdgcn_mfma_f32_32x32x16_bf16(kf[7],qr[3],cS1,0,0,0)); \
    if(GK){DMA_K((t)+3,sl_cur);} if(GV){DMA_V((t)+1,sl_next);} \
    CMASK(cS0,cS1,t); \
    { float a=MX3(cS0[0],cS0[1],cS1[0]),b=MX3(cS0[2],cS0[3],cS1[1]); a=MX3(a,cS1[2],cS1[3]); \
      _Pragma("unroll") for(int r=4;r<16;r+=4){a=MX3(a,cS0[r],cS0[r+1]);b=MX3(b,cS0[r+2],cS0[r+3]);a=MX3(a,cS1[r],cS1[r+1]);b=MX3(b,cS1[r+2],cS1[r+3]);} \
      float rm=__builtin_fmaxf(a,b); { auto rr=__builtin_amdgcn_permlane32_swap(__float_as_uint(rm),__float_as_uint(rm),false,false); rm=__builtin_fmaxf(__uint_as_float(rr[0]),__uint_as_float(rr[1])); } \
      resc=false; \
      if(__builtin_expect(__any(rm>(float)THRL),0)){ const float dl=__builtin_fmaxf(rm,0.f); mhat+=dl; \
        _Pragma("unroll") for(int r=0;r<16;++r){cS0[r]-=dl;cS1[r]-=dl;} \
        const float f=__builtin_amdgcn_exp2f(-dl); l_reg*=f; if(hi==0)wsf[r32]=f; resc=true; } } \
    SBAR(); float sacc=0.f; \
    GAPB3(o[0]=__builtin_amdgcn_mfma_f32_32x32x16_bf16(PAFC(PC,0),VFR(0),o[0],0,0,0), cS0,0, CAT(PN,0),0); VNX(0); \
    GAPB3(o[1]=__builtin_amdgcn_mfma_f32_32x32x16_bf16(PAFC(PC,0),VFR(1),o[1],0,0,0), cS0,2, CAT(PN,0),1); VNX(1); \
    KRD(GL,0); GAPB3(o[0]=__builtin_amdgcn_mfma_f32_32x32x16_bf16(PAFC(PC,1),VFR(2),o[0],0,0,0), cS0,4, CAT(PN,0),2); VNX(2); \
    KRD(GL,1); GAPB3(o[1]=__builtin_amdgcn_mfma_f32_32x32x16_bf16(PAFC(PC,1),VFR(3),o[1],0,0,0), cS0,6, CAT(PN,0),3); VNX(3); \
    KRD(GL,2); GAPB3(o[0]=__builtin_amdgcn_mfma_f32_32x32x16_bf16(PAFC(PC,2),VFR(4),o[0],0,0,0), cS0,8, CAT(PN,1),0); VNX(4); \
    KRD(GL,3); GAPB3(o[1]=__builtin_amdgcn_mfma_f32_32x32x16_bf16(PAFC(PC,2),VFR(5),o[1],0,0,0), cS0,10, CAT(PN,1),1); VNX(5); \
    GAPB3(o[0]=__builtin_amdgcn_mfma_f32_32x32x16_bf16(PAFC(PC,3),VFR(6),o[0],0,0,0), cS0,12, CAT(PN,1),2); VNX(6); \
    GAPB3(o[1]=__builtin_amdgcn_mfma_f32_32x32x16_bf16(PAFC(PC,3),VFR(7),o[1],0,0,0), cS0,14, CAT(PN,1),3); VNX(7); \
    GAPB3(o[2]=__builtin_amdgcn_mfma_f32_32x32x16_bf16(PAFC(PC,0),VFR(8),o[2],0,0,0), cS1,0, CAT(PN,2),0); VNX(8); \
    GAPB3(o[3]=__builtin_amdgcn_mfma_f32_32x32x16_bf16(PAFC(PC,0),VFR(9),o[3],0,0,0), cS1,2, CAT(PN,2),1); VNX(9); \
    GAPB3(o[2]=__builtin_amdgcn_mfma_f32_32x32x16_bf16(PAFC(PC,1),VFR(10),o[2],0,0,0), cS1,4, CAT(PN,2),2); VNX(10); \
    GAPB3(o[3]=__builtin_amdgcn_mfma_f32_32x32x16_bf16(PAFC(PC,1),VFR(11),o[3],0,0,0), cS1,6, CAT(PN,2),3); VNX(11); \
    GAPB3(o[2]=__builtin_amdgcn_mfma_f32_32x32x16_bf16(PAFC(PC,2),VFR(12),o[2],0,0,0), cS1,8, CAT(PN,3),0); VNX(12); \
    GAPB3(o[3]=__builtin_amdgcn_mfma_f32_32x32x16_bf16(PAFC(PC,2),VFR(13),o[3],0,0,0), cS1,10, CAT(PN,3),1); VNX(13); \
    GAPB3(o[2]=__builtin_amdgcn_mfma_f32_32x32x16_bf16(PAFC(PC,3),VFR(14),o[2],0,0,0), cS1,12, CAT(PN,3),2); VNX(14); \
    GAPB3(o[3]=__builtin_amdgcn_mfma_f32_32x32x16_bf16(PAFC(PC,3),VFR(15),o[3],0,0,0), cS1,14, CAT(PN,3),3); VNX(15); \
    l_reg+=sacc; \
    }while(0)
  int t=1;
  #undef CMASK
  #define CMASK(P0,P1,t) do{}while(0)
  for(;t+5<NT;t+=2){
    STEP(pwa,pwb,t,true,true,true);     WAIT_BAR(3); RESC(); ROT();
    STEP(pwb,pwa,t+1,true,true,true);   WAIT_BAR(3); RESC(); ROT();
  }
  #undef CMASK
  #define CMASK(P0,P1,t) do{int jb_=(t)-(NT-4); if(jb_>=0)bmask(P0,P1,jb_,wch,il,hi,s2x2);}while(0)
  #define ENDW(tt) do{ if((tt)+3<NT){WAIT_BAR(3);} else if((tt)+2<NT){WAIT_BAR(2);} else {WAIT_BAR(0);} }while(0)
  for(;t+1<NT;t+=2){
    STEP(pwa,pwb,t,(t+3<NT),(t+1<NT),(t+1<NT));       ENDW(t);   RESC(); ROT();
    STEP(pwb,pwa,t+1,(t+4<NT),(t+2<NT),(t+2<NT));     ENDW(t+1); RESC(); ROT();
  }
  STEP(pwa,pwb,NT-1,false,false,false); RESC();
  SBAR(); pv(o,vb0+2*sl_cur,PAFC(pwb,0),PAFC(pwb,1),PAFC(pwb,2),PAFC(pwb,3));
  #undef PKW
  #undef PAFC
  #undef CAT
  #undef CAT_
  #undef QK
  #undef GAPB3
  #undef VFR
  #undef PIN_
  #undef MX3
  #undef EX
  #undef VRD
  #undef VNX
  #undef VOFF
  #undef GAPB2
  #undef KRD
  #undef STEP
  #undef ENDW
  {auto rr=__builtin_amdgcn_permlane32_swap(__float_as_uint(l_reg),__float_as_uint(l_reg),false,false);l_reg=__uint_as_float(rr[0])+__uint_as_float(rr[1]);}
  {
    const int le=lane_now(), r32e=le&31, hie=le>>5;
    float*wsfe=(float*)(shm+LDS_WS)+wid*64;
    if(hie==0)wsfe[32+r32e]=l_reg;asm volatile("s_waitcnt lgkmcnt(0)":::"memory");
    float rli[16];
    #pragma unroll
    for(int r=0;r<16;++r)rli[r]=__builtin_amdgcn_rcpf(wsfe[32+crow(r,hie)]);
    bf16_t*Ow=Ob+(long)(q0+wid*QBLK)*POUT;
    bf16_t*stg=(bf16_t*)(shm+LDS_OST)+wid*4096;
    #pragma unroll
    for(int r=0;r<16;++r){const int orow=crow(r,hie);
      #pragma unroll
      for(int d0=0;d0<4;++d0)stg[orow*128+d0*32+r32e]=(bf16_t)f2bf(o[d0][r]*rli[r]);}
    asm volatile("s_waitcnt lgkmcnt(0)":::"memory");
    #pragma unroll
    for(int i=0;i<8;++i){const int row=i*4+(le>>4),ch=le&15; const u32x4 v=*(const u32x4*)(stg+row*128+ch*8); ATTN_STORE16(Ow+(long)row*POUT+ch*8,v);} }
  asm volatile("s_waitcnt lgkmcnt(0)\n\ts_barrier":::"memory");
  #undef DMA_K
  #undef DMA_V
  #undef CMASK
  #undef CINIT0
  #undef CINIT1
  #undef START
  #undef RESC
  #undef ROT
}
#undef SBAR
#undef WAIT_BAR
}

__device__ __forceinline__ void attn_phase(const Frame& F, const Args& a) {
    const bf16_t* proj = (const bf16_t*)(a.ws + WS_PROJ); bf16_t* OA = (bf16_t*)(a.ws + WS_OA);
    const int vcu = (F.G % 8 == 0) ? (F.bid % 8) * (F.G / 8) + F.bid / 8 : F.bid;
    for (int i = 0;; ++i) {
        int bhm, qb;
        if (F.G == 256) { if (i >= 2) break; const int s_ = vcu & 7; bhm = vcu >> 3; qb = (i == 0) ? 15 - s_ : s_; }
        else { const int u = i * F.G + F.bid; if (u >= 512) break; bhm = u >> 4; qb = 15 - (u & 15); }
        const int b = bhm >> 3, h = (bhm >> 1) & 3, map = bhm & 1;
        const bf16_t* base = proj + (size_t)b * SEQ * INC;
        const float slope2 = exp2f(-2.0f * (h + 1)) * 1.4426950408889634f;
        attn_body::attn_unit<8>(qb, base + C_QDA + h * 128 + map * 64, base + C_KDA + h * 128 + map * 64, base + C_VDA + h * 128,
                                OA + (size_t)b * SEQ * 1024 + h * 256 + map * 128, slope2, (char*)F.lds);
    }
}
__device__ __forceinline__ void attn_combine(const Frame& F, const Args& a) {
    const bf16_t* OA = (const bf16_t*)(a.ws + WS_OA); bf16_t* Y = (bf16_t*)(a.ws + WS_YDA);
    const float lam = ((const float*)(a.ws + WS_SMALL))[0];
    const float g0 = a.in[I_SUBG][2 * F.lane] * 0.8f, g1 = a.in[I_SUBG][2 * F.lane + 1] * 0.8f;
    const int gw = F.bid * NWAVES + F.wave, NGW = F.G * NWAVES;
    for (int rb = gw; rb < T; rb += 4 * NGW) {
        unsigned w0[4][4], w1[4][4];
#pragma unroll
        for (int q = 0; q < 4; ++q) { const int r = rb + q * NGW < T ? rb + q * NGW : rb; const unsigned* orow = (const unsigned*)(OA + (size_t)r * 1024);
#pragma unroll
            for (int h = 0; h < 4; ++h) { w0[q][h] = __builtin_nontemporal_load(orow + h * 128 + F.lane); w1[q][h] = __builtin_nontemporal_load(orow + h * 128 + 64 + F.lane); } }
#pragma unroll
        for (int q = 0; q < 4; ++q) { const int r = rb + q * NGW; if (r >= T) break;
            unsigned* yrow = (unsigned*)(Y + (size_t)r * 512);
#pragma unroll
            for (int h = 0; h < 4; ++h) {
                const float x0 = bf2f(w0[q][h] & 0xffffu) - lam * bf2f(w1[q][h] & 0xffffu), x1 = bf2f(w0[q][h] >> 16) - lam * bf2f(w1[q][h] >> 16);
                const float rs = rsqrtf(wave_sum(x0 * x0 + x1 * x1) * (1.0f / 128.0f) + EPS);
                yrow[h * 64 + F.lane] = pk2(x0 * rs * g0, x1 * rs * g1);
            } }
    }
}
namespace hg {
constexpr int QP = 136;
constexpr int L_QD = 0, L_KD = 64 * QP * 2, L_V = 2 * 64 * QP * 2, L_KE = 3 * 64 * QP * 2, L_SSQ = 4 * 64 * QP * 2, L_G = L_SSQ + 512, L_ST = L_G + 64 * QP * 2;
__device__ __forceinline__ f32x4 mfma16(bf16x8 a, bf16x8 b, f32x4 c) { return __builtin_amdgcn_mfma_f32_16x16x32_bf16(a, b, c, 0, 0, 0); }
#define HG_BAR() do { asm volatile("s_waitcnt lgkmcnt(0)" ::: "memory"); __builtin_amdgcn_s_barrier(); asm volatile("" ::: "memory"); } while (0)
typedef short v4i16_t __attribute__((ext_vector_type(4)));
__device__ __forceinline__ bf16x8 tr8(const LAS unsigned char* img, int ra, int rb, int col0, int lane) {
    const int q = (lane & 15) >> 2, p = lane & 3;
    const v4i16_t lo = __builtin_amdgcn_ds_read_tr16_b64_v4i16((LAS v4i16_t*)(img + ((ra + q) * QP + col0 + 4 * p) * 2));
    const v4i16_t hi = __builtin_amdgcn_ds_read_tr16_b64_v4i16((LAS v4i16_t*)(img + ((rb + q) * QP + col0 + 4 * p) * 2));
    return (bf16x8){lo[0], lo[1], lo[2], lo[3], hi[0], hi[1], hi[2], hi[3]};
}
struct Tile { u32x4 p[2]; };
__device__ __forceinline__ void tile_load(Tile& t, const bf16_t* src, size_t pitch, int tid) {
#pragma unroll
    for (int i = 0; i < 2; ++i) { const int pc = tid + NTHR * i; t.p[i] = *(const u32x4*)(src + (size_t)(pc >> 4) * pitch + (pc & 15) * 8); }
}
__device__ __forceinline__ void tile_put(const Tile& t, LAS unsigned char* img, int tid) {
#pragma unroll
    for (int i = 0; i < 2; ++i) { const int pc = tid + NTHR * i; *(LAS u32x4*)(img + ((pc >> 4) * QP + (pc & 15) * 8) * 2) = t.p[i]; }
}
__device__ __forceinline__ void tile_get(Tile& t, const LAS unsigned char* img, int tid) {
#pragma unroll
    for (int i = 0; i < 2; ++i) { const int pc = tid + NTHR * i; t.p[i] = *(const LAS u32x4*)(img + ((pc >> 4) * QP + (pc & 15) * 8) * 2); }
}
__device__ __forceinline__ void tile_store(const Tile& t, bf16_t* dst, size_t pitch, int tid) {
#pragma unroll
    for (int i = 0; i < 2; ++i) { const int pc = tid + NTHR * i; *(u32x4*)(dst + (size_t)(pc >> 4) * pitch + (pc & 15) * 8) = t.p[i]; }
}
constexpr int PP = 72;
constexpr int G4_L_P = 4 * 64 * QP * 2, G4_L_DEC = G4_L_P + 64 * PP * 2, G4_L_SSQ = G4_L_DEC + 512, G4_L_DEC4 = G4_L_SSQ + 2048;
struct InA { Tile qd, kd, ke, v; };
__device__ __forceinline__ void loadA(InA& r, const Frame& F, const Args& a, int bh, int n) {
    const int b = bh >> 2, h = bh & 3; const size_t t0 = (size_t)b * SEQ + n * 64;
    const bf16_t* base = (const bf16_t*)(a.ws + WS_PROJ) + t0 * INC;
    tile_load(r.qd, base + C_HGT + 256 * h, INC, F.tid); tile_load(r.kd, base + C_HGT + 256 * h + 128, INC, F.tid);
    tile_load(r.ke, (const bf16_t*)a.out + t0 * 512 + h * 128, 512, F.tid); tile_load(r.v, base + C_IHG + h * 128, INC, F.tid);
}
#define G4_DEC_LOAD()  const int dcq_ = (F.tid >> 5) & 3; const f32x4 dv_ = *(const f32x4*)((const float*)(a.ws + WS_DEC) + ((size_t)bh * 64 + n0 + dcq_) * 128 + 4 * (F.tid & 31))
#define G4_DEC_PUT()   *(LAS f32x4*)(F.lds + G4_L_DEC4 + dcq_ * 512 + 16 * (F.tid & 31)) = dv_
__device__ __forceinline__ void grp_local(const Frame& F, const Args& a, int grp) {
    const int bh = grp >> 4, n0 = 4 * (grp & 15), b = bh >> 2, h = bh & 3, w = F.wave, lane = F.lane, fr = lane & 15, fq = lane >> 4;
    for (int i = F.tid; i < 64 * PP / 2; i += NTHR) ((LAS unsigned*)(F.lds + G4_L_P))[i] = 0u;
    f32x4 S[8];
#pragma unroll
    for (int kt = 0; kt < 8; ++kt) S[kt] = (f32x4){0.f, 0.f, 0.f, 0.f};
    G4_DEC_LOAD();
    InA c4[3];
    loadA(c4[0], F, a, bh, n0); loadA(c4[1], F, a, bh, n0 + 1);
    G4_DEC_PUT();
#define G4_STORE(nn) do { Tile ot_; tile_get(ot_, F.lds + L_KD, F.tid); tile_store(ot_, (bf16_t*)(a.ws + WS_YHG) + ((size_t)b * SEQ + (nn) * 64) * 512 + h * 128, 512, F.tid); } while (0)
#pragma unroll
    for (int j = 0; j < 4; ++j) {
        InA& cur = c4[j % 3];
        if (j > 0) G4_STORE(n0 + j - 1);
        if (j + 2 < 4) loadA(c4[(j + 2) % 3], F, a, bh, n0 + j + 2);
        tile_put(cur.qd, F.lds + L_QD, F.tid); tile_put(cur.kd, F.lds + L_KD, F.tid); tile_put(cur.ke, F.lds + L_KE, F.tid); tile_put(cur.v, F.lds + L_V, F.tid);
        HG_BAR();
#pragma unroll
        for (int rep = 0; rep < 2; ++rep) { const int pi = w + 8 * rep;
            if (pi < 10) { const int tb = pi >= 6 ? 3 : pi >= 3 ? 2 : pi >= 1 ? 1 : 0, jt = pi - (tb * (tb + 1)) / 2;
                f32x4 sc = (f32x4){0.f, 0.f, 0.f, 0.f};
#pragma unroll
                for (int ks = 0; ks < 4; ++ks) { const bf16x8 kf = *(const LAS bf16x8*)(F.lds + L_KD + ((16 * jt + fr) * QP + 32 * ks + 8 * fq) * 2);
                    const bf16x8 qf = *(const LAS bf16x8*)(F.lds + L_QD + ((16 * tb + fr) * QP + 32 * ks + 8 * fq) * 2); sc = mfma16(kf, qf, sc); }
                if (jt == tb) {
#pragma unroll
                    for (int r = 0; r < 4; ++r) if (4 * fq + r > fr) sc[r] = 0.f;
                }
                *(LAS u32x2*)(F.lds + G4_L_P + ((16 * tb + fr) * PP + 16 * jt + 4 * fq) * 2) = (u32x2){cvt_pk_bf16(sc[0], sc[1]), cvt_pk_bf16(sc[2], sc[3])}; } }
        HG_BAR();
        bf16x8 bv[2];
#pragma unroll
        for (int s2 = 0; s2 < 2; ++s2) bv[s2] = tr8(F.lds + L_V, 32 * s2 + 8 * fq, 32 * s2 + 8 * fq + 4, 16 * w, lane);
        bf16x8 Sb[4];
#pragma unroll
        for (int ks = 0; ks < 4; ++ks) { const u32x4 t = (u32x4){cvt_pk_bf16(S[2 * ks][0], S[2 * ks][1]), cvt_pk_bf16(S[2 * ks][2], S[2 * ks][3]), cvt_pk_bf16(S[2 * ks + 1][0], S[2 * ks + 1][1]), cvt_pk_bf16(S[2 * ks + 1][2], S[2 * ks + 1][3])};
            Sb[ks] = __builtin_bit_cast(bf16x8, t); }
#pragma unroll
        for (int tb = 0; tb < 4; ++tb) { f32x4 o = (f32x4){0.f, 0.f, 0.f, 0.f};
#pragma unroll
            for (int s2 = 0; s2 <= (tb >> 1); ++s2) { const bf16x8 pf = *(const LAS bf16x8*)(F.lds + G4_L_P + ((16 * tb + fr) * PP + 32 * s2 + 8 * fq) * 2); o = mfma16(pf, bv[s2], o); }
            if (j > 0) {
#pragma unroll
                for (int ks = 0; ks < 4; ++ks) { const LAS unsigned char* qrow = F.lds + L_QD + ((16 * tb + fr) * QP + 32 * ks + 4 * fq) * 2;
                    const u32x2 lo = *(const LAS u32x2*)qrow, hi = *(const LAS u32x2*)(qrow + 32);
                    const u32x4 aw = (u32x4){lo.x, lo.y, hi.x, hi.y}; o = mfma16(__builtin_bit_cast(bf16x8, aw), Sb[ks], o); } }
#pragma unroll
            for (int r = 0; r < 4; ++r) *(LAS unsigned short*)(F.lds + L_KD + ((16 * tb + 4 * fq + r) * QP + 16 * w + fr) * 2) = (unsigned short)f2bf(o[r]); }
#pragma unroll
        for (int kt = 0; kt < 8; ++kt) { S[kt] = S[kt] * *(const LAS f32x4*)(F.lds + G4_L_DEC4 + j * 512 + (16 * kt + 4 * fq) * 4);
#pragma unroll
            for (int s2 = 0; s2 < 2; ++s2) S[kt] = mfma16(tr8(F.lds + L_KE, 32 * s2 + 8 * fq, 32 * s2 + 8 * fq + 4, 16 * kt, lane), bv[s2], S[kt]); }
        HG_BAR();
    }
    G4_STORE(n0 + 3);
#undef G4_STORE
    f32x4* sg = (f32x4*)(a.ws + WS_DS) + ((size_t)grp * 64 + w * 8) * 64 + lane;
#pragma unroll
    for (int kt = 0; kt < 8; ++kt) sg[kt * 64] = S[kt];
}
__device__ __forceinline__ void grp_scan(const Frame& F, const Args& a) {
    const f32x2* sg = (const f32x2*)(a.ws + WS_DS); f32x2* si = (f32x2*)(a.ws + WS_DS) + (size_t)256 * 8192; const float* dec = (const float*)(a.ws + WS_DEC);
    for (int gt = F.bid * NTHR + F.tid; gt < 16 * 8192; gt += F.G * NTHR) {
        const int bh = gt >> 13, s2 = gt & 8191, slot = s2 >> 1, kt = (slot >> 6) & 7, lane = slot & 63, k = 16 * kt + 4 * (lane >> 4) + 2 * (s2 & 1);
        f32x2 cur = (f32x2){0.f, 0.f};
#pragma unroll
        for (int gh = 0; gh < 2; ++gh) {
            f32x2 sv[8], d[8];
#pragma unroll
            for (int g8 = 0; g8 < 8; ++g8) { const int g = 8 * gh + g8;
                sv[g8] = __builtin_nontemporal_load(sg + ((size_t)(bh * 16 + g)) * 8192 + s2);
                const float* dp = dec + ((size_t)bh * 64 + 4 * g) * 128 + k;
                d[g8] = (*(const f32x2*)dp * *(const f32x2*)(dp + 128)) * (*(const f32x2*)(dp + 256) * *(const f32x2*)(dp + 384)); }
#pragma unroll
            for (int g8 = 0; g8 < 8; ++g8) { const int g = 8 * gh + g8;
                si[((size_t)(bh * 16 + g)) * 8192 + s2] = cur;
                cur = d[g8] * cur + sv[g8]; }
        }
    }
}
struct InC { Tile qd, g, ol; };
__device__ __forceinline__ void loadC(InC& r, const Frame& F, const Args& a, int bh, int n) {
    const int b = bh >> 2, h = bh & 3; const size_t t0 = (size_t)b * SEQ + n * 64;
    const bf16_t* base = (const bf16_t*)(a.ws + WS_PROJ) + t0 * INC;
    tile_load(r.qd, base + C_HGT + 256 * h, INC, F.tid); tile_load(r.g, base + C_GHG + h * 128, INC, F.tid);
    tile_load(r.ol, (const bf16_t*)(a.ws + WS_YHG) + t0 * 512 + h * 128, 512, F.tid);
}
__device__ __forceinline__ void grp_final(const Frame& F, const Args& a, int grp) {
    const int bh = grp >> 4, n0 = 4 * (grp & 15), b = bh >> 2, h = bh & 3, w = F.wave, lane = F.lane, fr = lane & 15, fq = lane >> 4;
    f32x4 S[8];
    { const f32x4* si = (const f32x4*)(a.ws + WS_DS) + (size_t)256 * 4096 + ((size_t)grp * 64 + w * 8) * 64 + lane;
#pragma unroll
      for (int kt = 0; kt < 8; ++kt) S[kt] = si[kt * 64]; }
    const float ng = a.in[I_HGNG][16 * w + fr];
    LAS float* SSQ = (LAS float*)(F.lds + G4_L_SSQ);
    G4_DEC_LOAD();
    InC cur, nxt; loadC(cur, F, a, bh, n0);
    G4_DEC_PUT();
#define G4_STORE(nn) do { Tile ot_; tile_get(ot_, F.lds + L_V, F.tid); tile_store(ot_, (bf16_t*)(a.ws + WS_YHG) + ((size_t)b * SEQ + (nn) * 64) * 512 + h * 128, 512, F.tid); } while (0)
    for (int j = 0; j < 4; ++j) {
        if (j > 0) G4_STORE(n0 + j - 1);
        loadC(nxt, F, a, bh, n0 + (j < 3 ? j + 1 : 3));
        tile_put(cur.qd, F.lds + L_QD, F.tid); tile_put(cur.g, F.lds + L_KD, F.tid); tile_put(cur.ol, F.lds + L_V, F.tid);
        HG_BAR();
        bf16x8 Sb[4];
#pragma unroll
        for (int ks = 0; ks < 4; ++ks) { const u32x4 t = (u32x4){cvt_pk_bf16(S[2 * ks][0], S[2 * ks][1]), cvt_pk_bf16(S[2 * ks][2], S[2 * ks][3]), cvt_pk_bf16(S[2 * ks + 1][0], S[2 * ks + 1][1]), cvt_pk_bf16(S[2 * ks + 1][2], S[2 * ks + 1][3])};
            Sb[ks] = __builtin_bit_cast(bf16x8, t); }
        f32x4 o[4];
#pragma unroll
        for (int tb = 0; tb < 4; ++tb) {
#pragma unroll
            for (int r = 0; r < 4; ++r) o[tb][r] = bf2f(*(const LAS unsigned short*)(F.lds + L_V + ((16 * tb + 4 * fq + r) * QP + 16 * w + fr) * 2));
#pragma unroll
            for (int ks = 0; ks < 4; ++ks) { const LAS unsigned char* qrow = F.lds + L_QD + ((16 * tb + fr) * QP + 32 * ks + 4 * fq) * 2;
                const u32x2 lo = *(const LAS u32x2*)qrow, hi = *(const LAS u32x2*)(qrow + 32);
                const u32x4 aw = (u32x4){lo.x, lo.y, hi.x, hi.y}; o[tb] = mfma16(__builtin_bit_cast(bf16x8, aw), Sb[ks], o[tb]); }
#pragma unroll
            for (int r = 0; r < 4; ++r) { const float v = scan16(o[tb][r] * o[tb][r]); if (fr == 15) SSQ[w * 64 + 16 * tb + 4 * fq + r] = v; } }
#pragma unroll
        for (int kt = 0; kt < 8; ++kt) S[kt] = S[kt] * *(const LAS f32x4*)(F.lds + G4_L_DEC4 + j * 512 + (16 * kt + 4 * fq) * 4);
        HG_BAR();
#pragma unroll
        for (int tb = 0; tb < 4; ++tb) { f32x4 tot = (f32x4){0.f, 0.f, 0.f, 0.f};
#pragma unroll
            for (int ww = 0; ww < 8; ++ww) tot += *(const LAS f32x4*)(SSQ + ww * 64 + 16 * tb + 4 * fq);
#pragma unroll
            for (int r = 0; r < 4; ++r) { const float rs = rsqrtf(tot[r] * (1.0f / 128.0f) + EPS); const float g = bf2f(*(const LAS unsigned short*)(F.lds + L_KD + ((16 * tb + 4 * fq + r) * QP + 16 * w + fr) * 2));
                *(LAS unsigned short*)(F.lds + L_V + ((16 * tb + 4 * fq + r) * QP + 16 * w + fr) * 2) = (unsigned short)f2bf(o[tb][r] * rs * ng * g * __builtin_amdgcn_rcpf(1.0f + __builtin_amdgcn_exp2f(-1.4426950408889634f * g))); } }
        HG_BAR();
        cur = nxt;
    }
    G4_STORE(n0 + 3);
#undef G4_STORE
}
#undef HG_BAR
}

__device__ __forceinline__ float rs4(float a0, float a1, float a2, float a3, int lane) {
    const bool hi = (lane & 32) != 0;
    const float s0 = hi ? a0 : a2, s1 = hi ? a1 : a3;
    const float k0 = (hi ? a2 : a0) + __shfl_xor(s0, 32), k1 = (hi ? a3 : a1) + __shfl_xor(s1, 32);
    const bool b4 = (lane & 16) != 0;
    const float sd = b4 ? k0 : k1;
    float k = (b4 ? k1 : k0) + __shfl_xor(sd, 16);
    k += __shfl_xor(k, 8); k += __shfl_xor(k, 4); k += __shfl_xor(k, 2); k += __shfl_xor(k, 1);
    return k;
}
__device__ __forceinline__ void phase_router(const Frame& F, const Args& a) {
    constexpr int AP = 1032;
    LAS bf16_t* AH = (LAS bf16_t*)F.lds;
    LAS bf16_t* AL = AH + 16 * AP;
    LAS float* PART = (LAS float*)(F.lds + 2 * 16 * AP * 2);
    LAS float* LG = PART + 8 * 16 * 48;
    LAS unsigned* LH = (LAS unsigned*)(LG + 16 * 48);
    LAS unsigned* LB = LH + 32;
    LAS unsigned* LR = LH + 64;
    if (F.tid < NEXP) LH[F.tid] = 0u;
    const float* mod = (const float*)(a.ws + WS_MOD);
    const bf16_t* x1 = (const bf16_t*)(a.ws + WS_X1B); bf16_t* H2 = (bf16_t*)(a.ws + WS_ACT);
    unsigned* counts = (unsigned*)(a.ws + WS_CTL) + CW_COUNTS; unsigned* tokinfo = (unsigned*)(a.ws + WS_TOKINFO); int* toklist = (int*)(a.ws + WS_TOKLIST);
    const int rows_per_blk = T / F.G, r0 = F.bid * rows_per_blk, b = r0 / SEQ;
    const int lane = F.lane, w = F.wave, fr = lane & 15, fq = lane >> 4;
    f32x4 v[2][4], vn[2][4];
#define RT_LOAD(V, rb_) do { _Pragma("unroll") for (int q = 0; q < 2; ++q) { const u32x2* xr_ = (const u32x2*)(x1 + (size_t)((rb_) + 2 * w + q) * D) + lane; \
        _Pragma("unroll") for (int j = 0; j < 4; ++j) { const u32x2 t_ = xr_[64 * j]; V[q][j] = (f32x4){bf2f(t_.x & 0xffffu), bf2f(t_.x >> 16), bf2f(t_.y & 0xffffu), bf2f(t_.y >> 16)}; } } } while (0)
    RT_LOAD(v, r0);
    bf16x8 Bh[4][3], Bl[4][3];
    {
        const float* wre = a.in[I_WRE]; const float* wrg = a.in[I_WRG];
#pragma unroll
        for (int ks = 0; ks < 4; ++ks)
#pragma unroll
            for (int ct = 0; ct < 3; ++ct) {
                unsigned hw[4], lw[4];
#pragma unroll
                for (int jp = 0; jp < 4; ++jp) { float x[2];
#pragma unroll
                    for (int z = 0; z < 2; ++z) { const int k = 128 * w + 32 * ks + 8 * fq + 2 * jp + z;
                        if (ct == 0) { const float g = wrg[k * 4 + (fr & 3)], e = wre[k * 32 + ((fr + 28) & 31)]; x[z] = fr < 4 ? g : e; }
                        else if (ct == 1) x[z] = wre[k * 32 + 12 + fr];
                        else { const float e = wre[k * 32 + 28 + (fr & 3)]; x[z] = fr < 4 ? e : 0.f; } }
                    const unsigned h0 = f2bf(x[0]), h1 = f2bf(x[1]); hw[jp] = h0 | (h1 << 16);
                    lw[jp] = pk2(x[0] - bf2f(h0), x[1] - bf2f(h1)); }
                Bh[ks][ct] = __builtin_bit_cast(bf16x8, (u32x4){hw[0], hw[1], hw[2], hw[3]}); Bl[ks][ct] = __builtin_bit_cast(bf16x8, (u32x4){lw[0], lw[1], lw[2], lw[3]});
            }
    }
    for (int g = 0; g < rows_per_blk / 16; ++g) {
        const int rg = r0 + 16 * g;
        { const int gn = g + 1 < rows_per_blk / 16 ? g + 1 : g; RT_LOAD(vn, r0 + 16 * gn); }
#pragma unroll
        for (int q = 0; q < 2; ++q) { float sq = 0.f;
#pragma unroll
            for (int j = 0; j < 4; ++j) sq += (v[q][j].x * v[q][j].x + v[q][j].y * v[q][j].y) + (v[q][j].z * v[q][j].z + v[q][j].w * v[q][j].w);
            const float rs = rsqrtf(wave_sum(sq) * (1.0f / D) + EPS); const int row = 2 * w + q;
#pragma unroll
            for (int j = 0; j < 4; ++j) { const int k = 256 * j + 4 * lane;
                const f32x4 gg = *(const f32x4*)(a.in[I_N2G] + k) * (1.0f + *(const f32x4*)(mod + b * 6144 + 4 * 1024 + k)), sh = *(const f32x4*)(mod + b * 6144 + 3 * 1024 + k);
                const f32x4 hv = v[q][j] * rs * gg + sh;
                const unsigned h0 = f2bf(hv.x), h1 = f2bf(hv.y), h2_ = f2bf(hv.z), h3 = f2bf(hv.w);
                const u32x2 hw = (u32x2){h0 | (h1 << 16), h2_ | (h3 << 16)};
                *(u32x2*)(H2 + (size_t)(rg + row) * D + k) = hw;
                *(LAS u32x2*)(AH + row * AP + k) = hw;
                *(LAS u32x2*)(AL + row * AP + k) = (u32x2){pk2(hv.x - bf2f(h0), hv.y - bf2f(h1)), pk2(hv.z - bf2f(h2_), hv.w - bf2f(h3))}; } }
        __syncthreads();
        f32x4 acc[3] = {{0.f, 0.f, 0.f, 0.f}, {0.f, 0.f, 0.f, 0.f}, {0.f, 0.f, 0.f, 0.f}};
#pragma unroll
        for (int ks = 0; ks < 4; ++ks) { const bf16x8 ah = *(const LAS bf16x8*)(AH + fr * AP + 128 * w + 32 * ks + 8 * fq), al = *(const LAS bf16x8*)(AL + fr * AP + 128 * w + 32 * ks + 8 * fq);
#pragma unroll
            for (int ct = 0; ct < 3; ++ct) { acc[ct] = __builtin_amdgcn_mfma_f32_16x16x32_bf16(ah, Bh[ks][ct], acc[ct], 0, 0, 0);
                acc[ct] = __builtin_amdgcn_mfma_f32_16x16x32_bf16(al, Bh[ks][ct], acc[ct], 0, 0, 0); acc[ct] = __builtin_amdgcn_mfma_f32_16x16x32_bf16(ah, Bl[ks][ct], acc[ct], 0, 0, 0); } }
#pragma unroll
        for (int ct = 0; ct < 3; ++ct)
#pragma unroll
            for (int r = 0; r < 4; ++r) PART[(w * 16 + 4 * fq + r) * 48 + 16 * ct + fr] = acc[ct][r];
        __syncthreads();
        for (int t = F.tid; t < 16 * 48; t += NTHR) { const int row = t / 48, o = t % 48; float sacc = 0.f;
#pragma unroll
            for (int ww = 0; ww < 8; ++ww) sacc += PART[(ww * 16 + row) * 48 + o];
            if (o < 36) LG[row * 48 + o] = sacc + (o < 4 ? a.in[I_BRG][o & 3] : a.in[I_BRE][(o + 28) & 31]); }
        __syncthreads();
        if (F.tid < 16) {
            const LAS float* lg = LG + F.tid * 48;
            float gl[4]; int gi = 0;
#pragma unroll
            for (int o = 0; o < 4; ++o) gl[o] = lg[o];
            float gm = gl[0];
#pragma unroll
            for (int o = 1; o < 4; ++o) if (gl[o] > gm) { gm = gl[o]; gi = o; }
            float gsum = 0.f;
#pragma unroll
            for (int o = 0; o < 4; ++o) gsum += expf(gl[o] - gm);
            const float gp = 1.0f / gsum;
            float el[8];
#pragma unroll
            for (int e = 0; e < 8; ++e) el[e] = lg[4 + gi * 8 + e];
            int i0 = 0; float m0 = el[0];
#pragma unroll
            for (int o = 1; o < 8; ++o) if (el[o] > m0) { m0 = el[o]; i0 = o; }
            int i1 = -1; float m1 = -INFINITY;
#pragma unroll
            for (int o = 0; o < 8; ++o) if (o != i0 && el[o] > m1) { m1 = el[o]; i1 = o; }
            const float e1 = expf(m1 - m0); const float w0 = gp / (1.0f + e1), w1 = gp * e1 / (1.0f + e1);
            const int rl = 16 * g + F.tid, ex0 = gi * 8 + i0, ex1 = gi * 8 + i1;
            const unsigned l0 = atomicAdd((unsigned*)(LH + ex0), 1u), l1 = atomicAdd((unsigned*)(LH + ex1), 1u);
            LAS unsigned* ri = LR + rl * 6;
            ri[0] = (unsigned)ex0; ri[1] = l0; ri[2] = (unsigned)ex1; ri[3] = l1; ri[4] = __float_as_uint(w0); ri[5] = __float_as_uint(w1);
        }
#pragma unroll
        for (int q = 0; q < 2; ++q)
#pragma unroll
            for (int j = 0; j < 4; ++j) v[q][j] = vn[q][j];
    }
#undef RT_LOAD
    __syncthreads();
    if (F.tid < NEXP) LB[F.tid] = atomicAdd(counts + 64 * F.tid, LH[F.tid]);
    __syncthreads();
    for (int rl = F.tid; rl < rows_per_blk; rl += NTHR) {
        const LAS unsigned* ri = LR + rl * 6; const int r = r0 + rl;
        const unsigned ex0 = ri[0], ex1 = ri[2], k0 = LB[ex0] + ri[1], k1 = LB[ex1] + ri[3];
        toklist[ex0 * T + k0] = r; toklist[ex1 * T + k1] = r;
        u32x4 t0; t0.x = ex0; t0.y = k0; t0.z = ex1; t0.w = k1;
        *(u32x4*)(tokinfo + (size_t)r * 8) = t0;
        tokinfo[(size_t)r * 8 + 4] = ri[4]; tokinfo[(size_t)r * 8 + 5] = ri[5];
    }
}
__device__ __forceinline__ void build_moe_tab(const Frame& F, const Args& a, LAS MoeTab* tab) {
    if (F.wave == 0) {
        const unsigned* counts = (const unsigned*)(a.ws + WS_CTL) + CW_COUNTS;
        const int e = F.lane & 31;
        const int c = (int)__hip_atomic_load(counts + 64 * e, __ATOMIC_RELAXED, __HIP_MEMORY_SCOPE_AGENT);
        const int n = (c + 255) >> 8; int incl = n;
#pragma unroll
        for (int d = 1; d < 32; d <<= 1) { const int t = __shfl_up(incl, d, 32); if (e >= d) incl += t; }
        const int base = incl - n;
        if (F.lane < 32) { tab->cnt[e] = c; tab->tbase[e] = base;
            for (int m = 0; m < n; ++m) { tab->tile_e[base + m] = e; tab->tile_m[base + m] = m; } }
        if (F.lane == 31) { tab->tbase[NEXP] = incl; tab->nt = incl; }
    }
    __syncthreads();
}
__device__ __forceinline__ void phase_final(const Frame& F, const Args& a, const LAS MoeTab* tab) {
    const float* mod = (const float*)(a.ws + WS_MOD); const unsigned* tokinfo = (const unsigned*)(a.ws + WS_TOKINFO); const bf16_t* Ys = (const bf16_t*)(a.ws + WS_YS);
    const int rows_per_blk = T / F.G, r0 = F.bid * rows_per_blk;
    for (int rb = r0 + F.wave; rb < r0 + rows_per_blk; rb += 4 * NWAVES) {
        u32x4 ti[4]; u32x2 tw[4];
#pragma unroll
        for (int q = 0; q < 4; ++q) { const int r = rb + q * NWAVES < r0 + rows_per_blk ? rb + q * NWAVES : rb;
            ti[q] = *(const u32x4*)(tokinfo + (size_t)r * 8); tw[q] = *(const u32x2*)(tokinfo + (size_t)r * 8 + 4); }
        u32x2 xq[4][4], a0[4][4], a1[4][4];
#pragma unroll
        for (int q = 0; q < 4; ++q) { const int r = rb + q * NWAVES < r0 + rows_per_blk ? rb + q * NWAVES : rb;
            const size_t s0 = (size_t)tab->tbase[ti[q].x] * 256 + ti[q].y, s1 = (size_t)tab->tbase[ti[q].z] * 256 + ti[q].w;
            const u32x2* xb = (const u32x2*)((const bf16_t*)(a.ws + WS_X1B) + (size_t)r * D) + F.lane;
            const u32x2* y0 = (const u32x2*)(Ys + s0 * D) + F.lane; const u32x2* y1 = (const u32x2*)(Ys + s1 * D) + F.lane;
#pragma unroll
            for (int j = 0; j < 4; ++j) { xq[q][j] = __builtin_nontemporal_load(xb + 64 * j); a0[q][j] = __builtin_nontemporal_load(y0 + 64 * j); a1[q][j] = __builtin_nontemporal_load(y1 + 64 * j); } }
#pragma unroll
        for (int q = 0; q < 4; ++q) { const int r = rb + q * NWAVES; if (r >= r0 + rows_per_blk) break;
            const int b = r / SEQ; const float w0 = __uint_as_float(tw[q].x), w1 = __uint_as_float(tw[q].y);
            f32x4* xr = (f32x4*)(a.out + (size_t)r * D) + F.lane;
            f32x4 v[4]; float s = 0.f;
#pragma unroll
            for (int j = 0; j < 4; ++j) { const int k = 256 * j + 4 * F.lane;
                const f32x4 gt = *(const f32x4*)(mod + b * 6144 + 5 * 1024 + k); const u32x2 p0 = a0[q][j], p1 = a1[q][j], px = xq[q][j];
                f32x4 m; m.x = w0 * bf2f(p0.x & 0xffffu) + w1 * bf2f(p1.x & 0xffffu); m.y = w0 * bf2f(p0.x >> 16) + w1 * bf2f(p1.x >> 16);
                m.z = w0 * bf2f(p0.y & 0xffffu) + w1 * bf2f(p1.y & 0xffffu); m.w = w0 * bf2f(p0.y >> 16) + w1 * bf2f(p1.y >> 16);
                const f32x4 xv = (f32x4){bf2f(px.x & 0xffffu), bf2f(px.x >> 16), bf2f(px.y & 0xffffu), bf2f(px.y >> 16)};
                v[j] = xv + gt * m; s += (v[j].x * v[j].x + v[j].y * v[j].y) + (v[j].z * v[j].z + v[j].w * v[j].w); }
            const float rs = rsqrtf(wave_sum(s) * (1.0f / D) + EPS);
#pragma unroll
            for (int j = 0; j < 4; ++j) { const f32x4 g = *(const f32x4*)(a.in[I_FG] + 256 * j + 4 * F.lane); __builtin_nontemporal_store(v[j] * rs * g, xr + 64 * j); } }
    }
}

#define XB_TMO      128
#define XB_XCNT(j)  (256  + 64 * (j))
#define XB_XSUB(j)  (1280 + 64 * (j))
#define XB_XGEN(j)  (2304 + 64 * (j))
#define XB_TOP      3328
#define XB_TOPGEN   3392
#define XCD_BAR_WORDS 3456
#define XB_SPIN_CAP (1u << 18)
__device__ __forceinline__ unsigned xb_ld(unsigned* p)              { return __hip_atomic_load(p, __ATOMIC_RELAXED, __HIP_MEMORY_SCOPE_AGENT); }
__device__ __forceinline__ unsigned xb_add(unsigned* p, unsigned v) { return __hip_atomic_fetch_add(p, v, __ATOMIC_RELAXED, __HIP_MEMORY_SCOPE_AGENT); }
__device__ __forceinline__ unsigned xb_xcc_id() { return (unsigned)__builtin_amdgcn_s_getreg((3 << 11) | 20) & 0xFu; }
#define XB_SPIN(cond, bar) do { unsigned _sp = 0; while (cond) { __builtin_amdgcn_s_sleep(1); \
    if ((++_sp & 255u) == 0u) { if (xb_ld(&(bar)[XB_TMO])) break; if (_sp > XB_SPIN_CAP) { atomicAdd(&(bar)[XB_TMO], 1u); break; } } } } while (0)
struct XcdBarrier { unsigned* bar; unsigned x; volatile LAS unsigned* st; };
__device__ __forceinline__ XcdBarrier xcd_barrier_post(unsigned* bar, volatile LAS unsigned* st) {
    XcdBarrier b; b.bar = bar; b.x = xb_xcc_id(); b.st = st;
    if (threadIdx.x == 0) (void)xb_add(&bar[XB_XCNT(b.x)], 1u);
    return b;
}
__device__ __forceinline__ void xcd_barrier_complete(unsigned* bar, unsigned x, unsigned& nloc, unsigned& nx) {
    const unsigned G = gridDim.x * gridDim.y * gridDim.z;
    unsigned sum, cnt, mine, sp = 0u;
    for (;;) {
        sum = 0u; cnt = 0u; mine = 0u;
#pragma unroll
        for (unsigned j = 0; j < 16; ++j) { const unsigned c = xb_ld(&bar[XB_XCNT(j)]); sum += c; cnt += (c > 0u) ? 1u : 0u; mine = (j == x) ? c : mine; }
        if (sum == G) break;
        __builtin_amdgcn_s_sleep(1);
        if ((++sp & 255u) == 0u) { if (xb_ld(&bar[XB_TMO])) break; if (sp > XB_SPIN_CAP) { atomicAdd(&bar[XB_TMO], 1u); break; } }
    }
    nloc = mine > 0u ? mine : 1u; nx = cnt > 0u ? cnt : 1u;
}
__device__ __forceinline__ void xcd_barrier(const XcdBarrier& b) {
    asm volatile("s_waitcnt vmcnt(0)" ::: "memory");
    __syncthreads();
    if (threadIdx.x == 0) {
        unsigned* bar = b.bar;
        __builtin_amdgcn_s_waitcnt(0);
        unsigned nloc = b.st[0], nx = b.st[1];
        if (nloc == 0u) { xcd_barrier_complete(bar, b.x, nloc, nx); b.st[0] = nloc; b.st[1] = nx; }
        const unsigned old = xb_add(&bar[XB_XSUB(b.x)], 1u);
        const unsigned gen = old / nloc;
        if (old + 1u == (gen + 1u) * nloc) {
            __builtin_amdgcn_fence(__ATOMIC_RELEASE, "agent");
            asm volatile("s_waitcnt vmcnt(0)" ::: "memory");
            const unsigned og = xb_add(&bar[XB_TOP], 1u);
            const unsigned tg = og / nx;
            if (og + 1u == (tg + 1u) * nx) xb_add(&bar[XB_TOPGEN], 1u);
            else XB_SPIN(xb_ld(&bar[XB_TOPGEN]) == tg, bar);
            __builtin_amdgcn_fence(__ATOMIC_ACQUIRE, "agent");
            xb_add(&bar[XB_XGEN(b.x)], 1u);
            asm volatile("s_waitcnt vmcnt(0)" ::: "memory");
        } else {
            XB_SPIN(xb_ld(&bar[XB_XGEN(b.x)]) == gen, bar);
            __builtin_amdgcn_fence(__ATOMIC_ACQUIRE, "agent");
            asm volatile("s_waitcnt vmcnt(0)" ::: "memory");
        }
    }
    __syncthreads();
}

constexpr int N_PHASES = 11;
__global__ void __launch_bounds__(NTHR, 2) mk_fwd(Args a) {
    extern __shared__ __attribute__((aligned(16))) unsigned char lds_raw[];
    Frame F; F.lds = (LAS unsigned char*)lds_raw; F.tid = threadIdx.x; F.lane = F.tid & 63; F.wave = __builtin_amdgcn_readfirstlane(F.tid >> 6); F.G = gridDim.x; F.bid = blockIdx.x;
    unsigned char* ws = a.ws;
    const int lo = a.ph_lo, hi = a.ph_hi;
#if MK_N_LAUNCHES == 1
    volatile LAS unsigned* MISC = (volatile LAS unsigned*)(F.lds + 152 * 1024);
    if (F.tid < 4) MISC[F.tid] = 0u;
    __syncthreads();
    XcdBarrier xbar = xcd_barrier_post((unsigned*)(ws + WS_CTL) + CW_BAR, MISC);
#define SEAM(k) do { if (IN(k) && IN((k) + 1)) xcd_barrier(xbar); } while (0)
#else
#define SEAM(k) do { } while (0)
#endif
#define IN(k) (lo <= (k) && (k) < hi)
    LAS MoeTab* tab = (LAS MoeTab*)(F.lds + 144 * 1024);

#define RUNPH(k, ...) if (IN(k)) { F.lane = lane_now(); F.tid = F.wave * 64 + F.lane; __VA_ARGS__ }
    RUNPH(0, { phase0(F, a); }) SEAM(0);
    RUNPH(1, { phase1(F, a); __syncthreads(); dense_weight_convert(F, a); }) SEAM(1);
    RUNPH(2, {
        DenseOrder S{(const char*)(ws + WS_ACT), (const char*)(ws + WS_WIN), D, T / 256, INC / 256, F.G, F.bid};
        EpiInProj E{(bf16_t*)(ws + WS_PROJ), (bf16_t*)a.out, (float*)(ws + WS_DEC), (const float*)(ws + WS_SMALL) + 16, attn_body::C2};
        pg8::gemm_phase(F.lds, D, S, E);
        int nl; const int early = w2_early_items(F.G, nl);
        if (early && F.bid >= F.G - nl) { __syncthreads(); moe_w2_convert(F, a, 0, early, (F.bid - (F.G - nl)) * NWAVES + F.wave, nl * NWAVES); }
    }) SEAM(2);
    RUNPH(3, {
        for (int g = F.bid; g < 256; g += F.G) hg::grp_local(F, a, g);
        __syncthreads();
        attn_phase(F, a);
    }) SEAM(3);
    RUNPH(4, { hg::grp_scan(F, a); attn_combine(F, a); }) SEAM(4);
    RUNPH(5, { for (int g = F.bid; g < 256; g += F.G) hg::grp_final(F, a, g); }) SEAM(5);
    RUNPH(6, {
        UpOrder S{(const char*)(ws + WS_YDA), (const char*)(ws + WS_YHG), (const char*)(ws + WS_WUPDA), (const char*)(ws + WS_WUPHG), F.G, F.bid};
        EpiUp E{(const bf16_t*)(ws + WS_PROJ), (bf16_t*)(ws + WS_ACT)};
        pg8::gemm_phase(F.lds, 512, S, E);
    }) SEAM(6);
    RUNPH(7, {
        DenseOrder S{(const char*)(ws + WS_ACT), (const char*)(ws + WS_WOUT), D, T / 256, D / 256, F.G, F.bid};
        EpiOut E{a.in[I_X], (const float*)(ws + WS_MOD), (bf16_t*)(ws + WS_X1B)};
        pg8::gemm_phase(F.lds, D, S, E);
        moe_weight_convert(F, a);
    }) SEAM(7);
    RUNPH(8, { phase_router(F, a); __syncthreads(); }) SEAM(8);
    RUNPH(9, {
        build_moe_tab(F, a, tab);
        unsigned* done = (unsigned*)(ws + WS_CTL) + CW_TILE;
        const int vc = (F.G & 7) == 0 ? (F.bid & 7) * (F.G >> 3) + (F.bid >> 3) : F.bid;
        { Moe1Order S{tab, (const char*)(ws + WS_ACT), (const char*)(ws + WS_W13), (const int*)(ws + WS_TOKLIST), F.G, vc};
          EpiMoe1 E{(bf16_t*)(ws + WS_HS), done};
          pg8::gemm_phase(F.lds, D, S, E); }
        { Moe2Order S{tab, (const char*)(ws + WS_HS), (const char*)a.out + OUT_W2, done, (unsigned*)(ws + WS_CTL) + CW_TMO, F.G, vc};
          EpiStoreBf16 E{(bf16_t*)(ws + WS_YS), D, 0, 1.0f};
          pg8::gemm_phase(F.lds, DEXP, S, E); }
    }) SEAM(9);
    RUNPH(10, { build_moe_tab(F, a, tab); phase_final(F, a, tab); })
#undef IN
#undef SEAM
}

extern "C" void kernel_launch(void* const* d_in, const int* in_sizes, int n_in, void* d_out, int out_size, void* d_ws, size_t ws_size, hipStream_t stream) {
    static int grid = 0;
    if (grid == 0) {
        if (n_in != 25 || in_sizes[0] != T * D || out_size != T * D || ws_size < WS_END) { fprintf(stderr, "kernel_launch: unexpected shapes (n_in %d, in0 %d, out %d, ws %zu)\n", n_in, n_in > 0 ? in_sizes[0] : -1, out_size, ws_size); grid = -1; return; }
        int dev = 0, cus = 0, per_cu = 0;
        if (hipGetDevice(&dev) != hipSuccess || hipDeviceGetAttribute(&cus, hipDeviceAttributeMultiprocessorCount, dev) != hipSuccess) { grid = -1; return; }
        if (hipFuncSetAttribute((const void*)mk_fwd, hipFuncAttributeMaxDynamicSharedMemorySize, LDS_BYTES) != hipSuccess) { fprintf(stderr, "kernel_launch: hipFuncSetAttribute failed\n"); grid = -1; return; }
        if (hipOccupancyMaxActiveBlocksPerMultiprocessor(&per_cu, (const void*)mk_fwd, NTHR, LDS_BYTES) != hipSuccess || per_cu < 1) { fprintf(stderr, "kernel_launch: occupancy query says %d\n", per_cu); per_cu = 1; }
        (void)hipGetLastError();
        grid = cus;
        if (grid > 256) grid = 256;
        while (T % grid) --grid;
    }
    if (grid < 0) return;
    (void)hipMemsetAsync((char*)d_ws + WS_CTL, 0, CTL_ZERO_BYTES, stream);
    Args a{};
    for (int i = 0; i < 25; ++i) a.in[i] = (const float*)d_in[i];
    a.out = (float*)d_out; a.ws = (unsigned char*)d_ws;
#if MK_N_LAUNCHES == 1
    a.ph_lo = 0; a.ph_hi = N_PHASES;
    void* args[] = {&a};
    hipError_t e = hipLaunchCooperativeKernel((const void*)mk_fwd, dim3(grid), dim3(NTHR), args, LDS_BYTES, stream);
    if (e != hipSuccess) fprintf(stderr, "cooperative launch failed: %s (grid %d)\n", hipGetErrorString(e), grid);
#else
    for (int p = 0; p < N_PHASES; ++p) {
        a.ph_lo = p; a.ph_hi = p + 1;
        hipLaunchKernelGGL(mk_fwd, dim3(grid), dim3(NTHR), LDS_BYTES, stream, a);
    }
#endif
}
```

```cpp
#include <hip/hip_runtime.h>
#include <cstdio>
#include <cstdint>

#ifndef MK_N_LAUNCHES
#define MK_N_LAUNCHES 1
#endif

#define LAS __attribute__((address_space(3)))
typedef unsigned short bf16_t;
typedef short bf16x8 __attribute__((ext_vector_type(8)));
typedef float f32x4 __attribute__((ext_vector_type(4)));
typedef float f32x2 __attribute__((ext_vector_type(2)));
typedef unsigned u32x4 __attribute__((ext_vector_type(4)));
typedef unsigned u32x2 __attribute__((ext_vector_type(2)));

constexpr int NB = 4, SEQ = 4096, D = 1024, T = NB * SEQ;
constexpr int INC = 5632;
constexpr int C_QDA = 0, C_KDA = 512, C_VDA = 1024, C_QHG = 1536, C_FHG = 2048, C_IHG = 2560, C_GHG = 3072, C_GDA = 3584, C_GHGATE = 4608;
constexpr int C_HGT = 1536;
constexpr int NEXP = 32, DEXP = 512;
constexpr int PMAX = 40960;
constexpr float EPS = 1e-6f;
constexpr int NWAVES = 8, NTHR = 512;

constexpr size_t MiB = 1u << 20;
constexpr size_t WS_CTL = 0, CTL_ZERO_BYTES = 64 * 1024;
constexpr size_t WS_MOD = 5 * MiB / 2;
constexpr size_t WS_SMALL = 11 * MiB / 4;
constexpr size_t WS_TOKINFO = 3 * MiB;
constexpr size_t WS_TOKLIST = 4 * MiB;
constexpr size_t WS_DEC = 6 * MiB;
constexpr size_t WS_DS = 24 * MiB;
constexpr size_t WS_WIN = 8 * MiB;
constexpr size_t WS_WUPDA = 20 * MiB, WS_WUPHG = 21 * MiB, WS_WOUT = 22 * MiB;
constexpr size_t WS_ACT = 24 * MiB;
constexpr size_t WS_PROJ = 56 * MiB;
constexpr size_t WS_YDA = 232 * MiB, WS_YHG = 248 * MiB;
constexpr size_t WS_OA = 264 * MiB;
constexpr size_t WS_W13 = 56 * MiB;
constexpr size_t WS_W2 = 120 * MiB;
constexpr size_t WS_HS = 152 * MiB;
constexpr size_t WS_YS = 192 * MiB;
constexpr size_t OUT_W2 = 16 * MiB;
constexpr int W2_EARLY = 32;
constexpr size_t WS_X1B = 272 * MiB;
constexpr size_t WS_END = 304 * MiB;
constexpr int CW_COUNTS = 64;
constexpr int CW_BAR = 4096;
constexpr int CW_TILE = 8192;
constexpr int CW_TMO = 32;

constexpr int LDS_BYTES = 160 * 1024;

__device__ __forceinline__ float bf2f(unsigned v) { return __uint_as_float(v << 16); }
__device__ __forceinline__ unsigned f2bf(float f) { unsigned u = __float_as_uint(f); return (u + 0x7fffu + ((u >> 16) & 1u)) >> 16; }
__device__ __forceinline__ unsigned pk2(float lo, float hi) { return f2bf(lo) | (f2bf(hi) << 16); }
__device__ __forceinline__ float sigmoidf_(float x) { return 1.0f / (1.0f + __expf(-x)); }
__device__ __forceinline__ float siluf_(float x) { return x / (1.0f + __expf(-x)); }
__device__ __forceinline__ int lane_now() { int l; asm volatile("v_mbcnt_lo_u32_b32 %0, -1, 0\n\tv_mbcnt_hi_u32_b32 %0, -1, %0" : "=v"(l)); return l; }
__device__ __forceinline__ float wave_sum(float v) {
#pragma unroll
    for (int o = 1; o < 64; o <<= 1) v += __shfl_xor(v, o);
    return v;
}

namespace pg8 {
constexpr int BM = 256, BK = 64, HALF = 128, HTB = HALF * BK * 2, STAGE_BYTES = 8 * HTB;
__host__ __device__ __forceinline__ int lds_byte(int r, int c) { const int st = (r >> 4) * 2 + (c >> 5), rr = r & 15, cc = c & 31, ob = rr * 64 + cc * 2; return st * 1024 + (ob ^ (((ob >> 9) & 1) << 5)); }
__host__ __device__ __forceinline__ void stage_rc(int b, int& R, int& C) { const int st = b / 1024, sb = b % 1024, swz = sb ^ (((sb >> 9) & 1) << 5); R = (st >> 1) * 16 + swz / 64; C = (st & 1) * 32 + (swz % 64) / 2; }
__host__ __device__ __forceinline__ int perm32(int rho) { const int n = rho >> 4, i = rho & 15; return 8 * (i >> 2) + 4 * n + (i & 3); }

struct Unit { int pm, pn; const char* A; const char* B; int aux; };
__device__ __forceinline__ unsigned cvt_pk_bf16(float lo, float hi) { unsigned r; asm volatile("v_cvt_pk_bf16_f32 %0, %1, %2" : "=v"(r) : "v"(lo), "v"(hi)); return r; }

template <class Epi, class Sched>
__device__ __forceinline__ void gemm_phase(LAS unsigned char* lds, const int K, const Sched& S, const Epi& E) {
    const int tid = threadIdx.x, wid = __builtin_amdgcn_readfirstlane(tid >> 6), lane = tid & 63, wr = wid >> 2, wc = wid & 3, fr = lane & 15, fq = lane >> 4;
    const int nt = K / BK;
    unsigned voffB[2];
#define PG8_SETLANE() do { const int _l = lane_now(), _t = wid * 64 + _l; _Pragma("unroll") for (int _i = 0; _i < 2; ++_i) { int _R, _C; stage_rc(_t * 16 + _i * 8192, _R, _C); \
        const int _Rb = Epi::PERM ? ((_R & ~31) + perm32(_R & 31)) : _R; voffB[_i] = (unsigned)(_Rb * K + _C) * 2u; } \
        aoff = lds_byte(wr * 64 + (_l & 15), (_l >> 4) * 8); boff = lds_byte(wc * 32 + (_l & 15), (_l >> 4) * 8); } while (0)
    const size_t kstep = (size_t)(BK * 2);
    const size_t hstep = (size_t)HALF * K * 2;
    const unsigned ldsw = (unsigned)wid * 1024u;
    int aoff, boff; PG8_SETLANE();
#define PG8_SA(b, h) (((b) * 2 + (h)) * HTB)
#define PG8_SB(b, h) ((4 + (b) * 2 + (h)) * HTB)
#define PG8_STAGE(bufoff, gbase, voff) do { _Pragma("unroll") for (int _i = 0; _i < 2; ++_i) \
        __builtin_amdgcn_global_load_lds((const unsigned*)((const char*)(gbase) + (voff)[_i]), (LAS unsigned*)(lds + (bufoff) + ldsw + _i * 8192), 16, 0, 0); } while (0)
#define PG8_LDA(dst, b, h) do { _Pragma("unroll") for (int m = 0; m < 4; ++m) _Pragma("unroll") for (int k = 0; k < 2; ++k) dst[m][k] = *(const LAS bf16x8*)(lds + PG8_SA(b, h) + aoff + m * 2048 + k * 1024); } while (0)
#define PG8_LDB(dst, b, h) do { _Pragma("unroll") for (int n = 0; n < 2; ++n) _Pragma("unroll") for (int k = 0; k < 2; ++k) dst[n][k] = *(const LAS bf16x8*)(lds + PG8_SB(b, h) + boff + n * 2048 + k * 1024); } while (0)
#define PG8_MMA(ai, bj, At, Bt) do { __builtin_amdgcn_s_setprio(1); _Pragma("unroll") for (int m = 0; m < 4; ++m) _Pragma("unroll") for (int n = 0; n < 2; ++n) _Pragma("unroll") for (int k = 0; k < 2; ++k) \
        acc[ai][bj][m][n] = __builtin_amdgcn_mfma_f32_16x16x32_bf16(Bt[n][k], At[m][k], acc[ai][bj][m][n], 0, 0, 0); __builtin_amdgcn_s_setprio(0); } while (0)
#define PG8_WAIT_V(n) asm volatile("s_waitcnt vmcnt(" #n ")" ::: "memory")
#define PG8_WAIT_L(n) asm volatile("s_waitcnt lgkmcnt(" #n ")" ::: "memory")
#define PG8_BAR __builtin_amdgcn_s_barrier()
#define PG8_SCHED __builtin_amdgcn_sched_barrier(0)
#define PG8_SETA(vo, u) do { const int _t = wid * 64 + lane_now(); _Pragma("unroll") for (int _i = 0; _i < 2; ++_i) { int _R, _C; stage_rc(_t * 16 + _i * 8192, _R, _C); \
        _Pragma("unroll") for (int _h = 0; _h < 2; ++_h) vo[_h][_i] = (unsigned)((size_t)S.arow(u, _h * HALF + _R) * (size_t)K + _C) * 2u; } if (Sched::GATHER) PG8_WAIT_V(0); } while (0)
    Unit cur, nxt; int ui = 0;
    if (!S.next(0, cur)) return;
    f32x4 acc[2][2][4][2];
#pragma unroll
    for (int a = 0; a < 2; ++a)
#pragma unroll
        for (int b = 0; b < 2; ++b)
#pragma unroll
            for (int m = 0; m < 4; ++m)
#pragma unroll
                for (int n = 0; n < 2; ++n) acc[a][b][m][n] = (f32x4){0.f, 0.f, 0.f, 0.f};
    bf16x8 At[4][2], B0[2][2], B1[2][2];
    unsigned voC[2][2], voN[2][2];
    S.a_ready(cur);
    PG8_SETA(voC, cur);
    const char* cA = cur.A; const char* cB = cur.B;
    PG8_STAGE(PG8_SB(0, 0), cB, voffB); PG8_STAGE(PG8_SB(0, 1), cB + hstep, voffB); PG8_STAGE(PG8_SA(0, 0), cA, voC[0]); PG8_STAGE(PG8_SA(0, 1), cA, voC[1]);
    if (wr == 1) PG8_BAR;
    PG8_WAIT_V(2); PG8_BAR;
    PG8_STAGE(PG8_SB(1, 0), cB + kstep, voffB); PG8_STAGE(PG8_SA(1, 0), cA + kstep, voC[0]); PG8_STAGE(PG8_SB(1, 1), cB + hstep + kstep, voffB);
    PG8_WAIT_V(6); PG8_BAR;
    for (;;) {
        const bool has_next = S.next(ui + 1, nxt);
        if (has_next) { PG8_SETA(voN, nxt); }
        else {
#pragma unroll
            for (int h = 0; h < 2; ++h)
#pragma unroll
                for (int i = 0; i < 2; ++i) voN[h][i] = voC[h][i];
        }
        const char* nA = has_next ? nxt.A : cA; const char* nB = has_next ? nxt.B : cB;
        for (int t = 0; t < nt; t += 2) {
            const bool last = (t == nt - 2);
            if (last && has_next) S.a_ready(nxt);
            const char* a1 = cA + (size_t)(t + 1) * kstep;
            const char* a2 = last ? nA : cA + (size_t)(t + 2) * kstep; const char* b2 = last ? nB : cB + (size_t)(t + 2) * kstep;
            const char* a3 = a2 + kstep; const char* b3 = b2 + kstep;
            unsigned vo2[2][2];
#pragma unroll
            for (int h = 0; h < 2; ++h)
#pragma unroll
                for (int i = 0; i < 2; ++i) vo2[h][i] = last ? voN[h][i] : voC[h][i];
            PG8_LDB(B0, 0, 0); PG8_LDB(B1, 0, 1); PG8_SCHED; PG8_LDA(At, 0, 0); PG8_STAGE(PG8_SA(1, 1), a1, voC[1]);
            PG8_WAIT_V(8); PG8_WAIT_L(0); PG8_BAR; PG8_MMA(0, 0, At, B0); PG8_MMA(0, 1, At, B1); PG8_BAR; PG8_SCHED;
            PG8_LDA(At, 0, 1); PG8_STAGE(PG8_SB(0, 0), b2, voffB); PG8_STAGE(PG8_SB(0, 1), b2 + hstep, voffB); PG8_STAGE(PG8_SA(0, 0), a2, vo2[0]);
            PG8_WAIT_V(8); PG8_WAIT_L(0); PG8_BAR; PG8_MMA(1, 0, At, B0); PG8_MMA(1, 1, At, B1); PG8_BAR; PG8_SCHED;
            PG8_LDB(B0, 1, 0); PG8_LDB(B1, 1, 1); PG8_SCHED; PG8_LDA(At, 1, 0); PG8_STAGE(PG8_SA(0, 1), a2, vo2[1]);
            PG8_WAIT_V(8); PG8_WAIT_L(0); PG8_BAR; PG8_MMA(0, 0, At, B0); PG8_MMA(0, 1, At, B1); PG8_BAR; PG8_SCHED;
            PG8_LDA(At, 1, 1); PG8_STAGE(PG8_SB(1, 0), b3, voffB); PG8_STAGE(PG8_SB(1, 1), b3 + hstep, voffB); PG8_STAGE(PG8_SA(1, 0), a3, vo2[0]);
            PG8_WAIT_V(8); PG8_WAIT_L(0); PG8_BAR; PG8_MMA(1, 0, At, B0); PG8_MMA(1, 1, At, B1); PG8_BAR; PG8_SCHED;
        }
        if (wr == 0) PG8_BAR;
        const bool keep = E(acc, cur, wr, wc, fr, fq);
        if (!has_next) break;
        if (!keep) {
#pragma unroll
            for (int a = 0; a < 2; ++a)
#pragma unroll
                for (int b = 0; b < 2; ++b)
#pragma unroll
                    for (int m = 0; m < 4; ++m)
#pragma unroll
                        for (int n = 0; n < 2; ++n) acc[a][b][m][n] = (f32x4){0.f, 0.f, 0.f, 0.f};
        }
        cur = nxt; cA = nA; cB = nB; ++ui;
        if (Sched::GATHER) {
#pragma unroll
            for (int h = 0; h < 2; ++h)
#pragma unroll
                for (int i = 0; i < 2; ++i) voC[h][i] = voN[h][i];
        } else { PG8_SETA(voC, cur); }
        PG8_SETLANE();
        if (wr == 1) PG8_BAR;
    }
    PG8_WAIT_V(0);
    PG8_BAR;
#undef PG8_SA
#undef PG8_SB
#undef PG8_STAGE
#undef PG8_LDA
#undef PG8_LDB
#undef PG8_MMA
#undef PG8_WAIT_V
#undef PG8_WAIT_L
#undef PG8_BAR
#undef PG8_SCHED
#undef PG8_SETA
#undef PG8_SETLANE
}
}

struct Args { const float* in[25]; float* out; unsigned char* ws; int ph_lo, ph_hi; };
enum { I_X = 0, I_C, I_WADA, I_BADA, I_N1G, I_WIN, I_LQ1, I_LK1, I_LQ2, I_LK2, I_SUBG, I_LBL, I_HGNG, I_WUPDA, I_WUPHG, I_WOUT, I_N2G, I_WRG, I_BRG, I_WRE, I_BRE, I_W1, I_W3, I_W2, I_FG };

struct DenseOrder {
    static constexpr bool GATHER = false;
    const char* A; const char* Bt; int K, nM, nN, G, c;
    __device__ __forceinline__ bool next(int i, pg8::Unit& u) const {
        const int L = i * G + c, nwg = nM * nN; if (L >= nwg) return false;
        int wgid = L; { const int q = nwg / 8, r = nwg % 8, xcd = wgid % 8, off = wgid / 8; wgid = (xcd < r ? xcd * (q + 1) : r * (q + 1) + (xcd - r) * q) + off; }
        const int nig = 8 * nN, gid = wgid / nig, fm = gid * 8, gsz = (nM - fm) < 8 ? (nM - fm) : 8;
        u.pm = fm + ((wgid % nig) % gsz); u.pn = (wgid % nig) / gsz; u.A = A; u.B = Bt + (size_t)u.pn * 256 * K * 2; u.aux = 0; return true;
    }
    __device__ __forceinline__ void a_ready(const pg8::Unit&) const {}
    __device__ __forceinline__ unsigned arow(const pg8::Unit& u, int r) const { return (unsigned)(u.pm * 256 + r); }
};
struct UpOrder {
    static constexpr bool GATHER = false;
    const char* A0; const char* A1; const char* B0; const char* B1; int G, c;
    __device__ __forceinline__ bool next(int i, pg8::Unit& u) const {
        const int tile = (i >> 1) * G + c; if (tile >= 256) return false;
        u.pm = tile >> 2; u.pn = tile & 3; u.aux = i & 1;
        u.A = (i & 1) ? A1 : A0; u.B = ((i & 1) ? B1 : B0) + (size_t)u.pn * 256 * 512 * 2; return true;
    }
    __device__ __forceinline__ void a_ready(const pg8::Unit&) const {}
    __device__ __forceinline__ unsigned arow(const pg8::Unit& u, int r) const { return (unsigned)(u.pm * 256 + r); }
};
struct MoeTab { int nt; int pad[3]; int tile_e[176]; int tile_m[176]; int cnt[32]; int tbase[33]; };
struct Moe1Order {
    static constexpr bool GATHER = true;
    const LAS MoeTab* tab; const char* A; const char* W; const int* toklist; int G, c;
    __device__ __forceinline__ bool next(int i, pg8::Unit& u) const {
        const int L = i * G + c; if (L >= tab->nt * 4) return false;
        const int ti = L >> 2; u.pm = ti; u.pn = L & 3; u.aux = ti; u.A = A;
        u.B = W + ((size_t)tab->tile_e[ti] * 1024 + (size_t)u.pn * 256) * 1024 * 2; return true;
    }
    __device__ __forceinline__ void a_ready(const pg8::Unit&) const {}
    __device__ __forceinline__ unsigned arow(const pg8::Unit& u, int r) const {
        const int e = tab->tile_e[u.aux], rr = tab->tile_m[u.aux] * 256 + r;
        return rr < tab->cnt[e] ? (unsigned)toklist[e * T + rr] : 0u;
    }
};
struct Moe2Order {
    static constexpr bool GATHER = false;
    const LAS MoeTab* tab; const char* A; const char* W; unsigned* done; unsigned* tmo; int G, c;
    __device__ __forceinline__ bool next(int i, pg8::Unit& u) const {
        const int n1 = tab->nt * 4, r = n1 % G, nl = G - r; int j;
        if (r > 0 && c >= r) { if (i < 2) j = (c - r) + i * nl; else j = 2 * nl + (c - r) + (i - 2) * G; }
        else j = (r > 0 ? 2 * nl : 0) + ((c - r + G) % G) + i * G;
        if (j >= n1) return false;
        const int ti = j >> 2; u.pm = ti; u.pn = j & 3; u.aux = ti; u.A = A;
        u.B = W + ((size_t)tab->tile_e[ti] * 1024 + (size_t)u.pn * 256) * 512 * 2; return true;
    }
    __device__ __forceinline__ unsigned arow(const pg8::Unit& u, int r) const { return (unsigned)(u.pm * 256 + r); }
    __device__ __forceinline__ void a_ready(const pg8::Unit& u) const {
        if (threadIdx.x < 64) {
            unsigned polls = 0;
            while ((unsigned)__builtin_amdgcn_readfirstlane(__hip_atomic_load(done + 16 * u.pm, __ATOMIC_RELAXED, __HIP_MEMORY_SCOPE_AGENT)) < 32u) {
                if (++polls > (1u << 22)) { if (threadIdx.x == 0) __hip_atomic_store(tmo, 1u, __ATOMIC_RELAXED, __HIP_MEMORY_SCOPE_AGENT); break; }
                __builtin_amdgcn_s_sleep(2); }
            __builtin_amdgcn_fence(__ATOMIC_ACQUIRE, "agent");
            asm volatile("s_waitcnt vmcnt(0)" ::: "memory");
        }
        asm volatile("" ::: "memory"); __builtin_amdgcn_s_barrier(); asm volatile("" ::: "memory");
    }
};

using pg8::Unit; using pg8::cvt_pk_bf16;
struct EpiStoreBf16 {
    static constexpr bool PERM = true;
    bf16_t* O; int ldc; int nscale; float scale0;
    __device__ __forceinline__ bool operator()(f32x4 (&acc)[2][2][4][2], const Unit& u, int wr, int wc, int fr, int fq) const {
        const int row0 = u.pm * 256 + wr * 64 + fr, col0 = u.pn * 256 + wc * 32 + 8 * fq;
        const float sc = u.pn < nscale ? scale0 : 1.0f;
#pragma unroll
        for (int ai = 0; ai < 2; ++ai)
#pragma unroll
            for (int m = 0; m < 4; ++m) { bf16_t* rowp = O + (size_t)(row0 + ai * 128 + m * 16) * ldc + col0;
#pragma unroll
                for (int bj = 0; bj < 2; ++bj) { const f32x4 v0 = acc[ai][bj][m][0] * sc, v1 = acc[ai][bj][m][1] * sc;
                    u32x4 w; w.x = cvt_pk_bf16(v0[0], v0[1]); w.y = cvt_pk_bf16(v0[2], v0[3]); w.z = cvt_pk_bf16(v1[0], v1[1]); w.w = cvt_pk_bf16(v1[2], v1[3]);
                    *(u32x4*)(rowp + bj * 128) = w; } }
        return false;
    }
};
template <int N> __device__ __forceinline__ float dpp_shr(float x) { return __builtin_bit_cast(float, __builtin_amdgcn_update_dpp(0, __builtin_bit_cast(int, x), 0x110 + N, 0xf, 0xf, true)); }
template <int N> __device__ __forceinline__ float dpp_ror(float x) { return __builtin_bit_cast(float, __builtin_amdgcn_update_dpp(0, __builtin_bit_cast(int, x), 0x120 + N, 0xf, 0xf, true)); }
__device__ __forceinline__ float rowsum16(float x) { x += dpp_ror<8>(x); x += dpp_ror<4>(x); x += dpp_ror<2>(x); x += dpp_ror<1>(x); return x; }
__device__ __forceinline__ float scan16(float x) { x += dpp_shr<1>(x); x += dpp_shr<2>(x); x += dpp_shr<4>(x); x += dpp_shr<8>(x); return x; }
struct EpiInProj {
    static constexpr bool PERM = true;
    bf16_t* O; bf16_t* KE; float* DEC; const float* lbv; float scale0;
    __device__ __forceinline__ bool operator()(f32x4 (&acc)[2][2][4][2], const Unit& u, int wr, int wc, int fr, int fq) const {
        { const int l_ = lane_now(); fr = l_ & 15; fq = l_ >> 4; }
        const int row0 = u.pm * 256 + wr * 64 + fr, col0 = u.pn * 256 + wc * 32 + 8 * fq;
        if (u.pn >= 6 && u.pn < 10) {
            const int h = u.pn - 6, lane = 16 * fq + fr, kb = wc * 32 + 8 * fq;
            const int bb = (u.pm * 256) / SEQ, ch0 = ((u.pm * 256) % SEQ + wr * 64) >> 6;
            const f32x4 lb0 = *(const f32x4*)(lbv + h * 128 + kb), lb1 = *(const f32x4*)(lbv + h * 128 + kb + 4);
#pragma unroll
            for (int ai = 0; ai < 2; ++ai) {
                unsigned kep[4][4];
#pragma unroll
                for (int n = 0; n < 2; ++n) {
#pragma unroll
                    for (int ep = 0; ep < 2; ++ep) {
                        float ke2[2][4];
#pragma unroll
                        for (int z = 0; z < 2; ++z) {
                            const int e = 2 * ep + z; const float lb = n ? lb1[e] : lb0[e];
                            float f[4], c[4], tot[4];
#pragma unroll
                            for (int m = 0; m < 4; ++m) { const float fl = acc[ai][1][m][n][e]; f[m] = lb + (1.0f - lb) * __builtin_amdgcn_rcpf(1.0f + __builtin_amdgcn_exp2f(-1.4426950408889634f * fl)); const float lf = __logf(f[m]); c[m] = scan16(lf); tot[m] = rowsum16(lf); }
                            const float alast = (tot[0] + tot[1]) + (tot[2] + tot[3]); const float eal = __expf(alast);
                            float pre = 0.f;
#pragma unroll
                            for (int m = 0; m < 4; ++m) { const float A = c[m] + pre; pre += tot[m]; const float q = acc[ai][0][m][n][e]; const float kk = 1.0f - f[m];
                                acc[ai][0][m][n][e] = q * __builtin_amdgcn_rcpf(1.0f + __builtin_amdgcn_exp2f(-1.4426950408889634f * q)) * __expf(A);
                                const float kd = kk * __expf(-A); acc[ai][1][m][n][e] = kd; ke2[z][m] = kd * eal; }
                            if (fr == 0) DEC[((size_t)(bb * 4 + h) * 64 + ch0 + 2 * ai) * 128 + kb + 4 * n + e] = eal;
                        }
#pragma unroll
                        for (int m = 0; m < 4; ++m) kep[m][2 * n + ep] = cvt_pk_bf16(ke2[0][m], ke2[1][m]);
                    }
                }
#pragma unroll
                for (int m = 0; m < 4; ++m) *(u32x4*)(KE + (size_t)(row0 + ai * 128 + m * 16) * 512 + h * 128 + kb) = (u32x4){kep[m][0], kep[m][1], kep[m][2], kep[m][3]};
            }
        }
        const float sc = u.pn < 2 ? scale0 : 1.0f;
#pragma unroll
        for (int ai = 0; ai < 2; ++ai)
#pragma unroll
            for (int m = 0; m < 4; ++m) { bf16_t* rowp = O + (size_t)(row0 + ai * 128 + m * 16) * INC + col0;
#pragma unroll
                for (int bj = 0; bj < 2; ++bj) { const f32x4 v0 = acc[ai][bj][m][0] * sc, v1 = acc[ai][bj][m][1] * sc;
                    u32x4 w; w.x = cvt_pk_bf16(v0[0], v0[1]); w.y = cvt_pk_bf16(v0[2], v0[3]); w.z = cvt_pk_bf16(v1[0], v1[1]); w.w = cvt_pk_bf16(v1[2], v1[3]);
                    *(u32x4*)(rowp + bj * 128) = w; } }
        return false;
    }
};
struct EpiUp {
    static constexpr bool PERM = true;
    const bf16_t* proj; bf16_t* O;
    __device__ __forceinline__ bool operator()(f32x4 (&acc)[2][2][4][2], const Unit& u, int wr, int wc, int fr, int fq) const {
        const int row0 = u.pm * 256 + wr * 64 + fr, col0 = u.pn * 256 + wc * 32 + 8 * fq;
#pragma unroll
        for (int ai = 0; ai < 2; ++ai)
#pragma unroll
            for (int m = 0; m < 4; ++m) { const size_t row = (size_t)(row0 + ai * 128 + m * 16);
#pragma unroll
                for (int bj = 0; bj < 2; ++bj) {
                    const int col = col0 + bj * 128;
                    const u32x4 gh = *(const u32x4*)(proj + row * INC + C_GHGATE + col);
                    float sh[8];
#pragma unroll
                    for (int j = 0; j < 4; ++j) { sh[2 * j] = 1.0f + __builtin_amdgcn_exp2f(-1.4426950408889634f * bf2f(gh[j] & 0xffffu)); sh[2 * j + 1] = 1.0f + __builtin_amdgcn_exp2f(-1.4426950408889634f * bf2f(gh[j] >> 16)); }
                    if (u.aux == 0) {
                        const u32x4 gd = *(const u32x4*)(proj + row * INC + C_GDA + col);
#pragma unroll
                        for (int j = 0; j < 4; ++j) {
                            const float d0 = 1.0f + __builtin_amdgcn_exp2f(-1.4426950408889634f * bf2f(gd[j] & 0xffffu)), d1 = 1.0f + __builtin_amdgcn_exp2f(-1.4426950408889634f * bf2f(gd[j] >> 16));
                            const float r0 = sh[2 * j] * __builtin_amdgcn_rcpf(d0), r1 = sh[2 * j + 1] * __builtin_amdgcn_rcpf(d1);
                            if (j < 2) { acc[ai][bj][m][0][2 * j] *= r0; acc[ai][bj][m][0][2 * j + 1] *= r1; }
                            else { acc[ai][bj][m][1][2 * j - 4] *= r0; acc[ai][bj][m][1][2 * j - 3] *= r1; }
                        }
                    } else {
                        const f32x4 v0 = acc[ai][bj][m][0], v1 = acc[ai][bj][m][1];
#pragma unroll
                        for (int j = 0; j < 8; ++j) sh[j] = __builtin_amdgcn_rcpf(sh[j]);
                        u32x4 w; w.x = cvt_pk_bf16(v0[0] * sh[0], v0[1] * sh[1]); w.y = cvt_pk_bf16(v0[2] * sh[2], v0[3] * sh[3]);
                        w.z = cvt_pk_bf16(v1[0] * sh[4], v1[1] * sh[5]); w.w = cvt_pk_bf16(v1[2] * sh[6], v1[3] * sh[7]);
                        *(u32x4*)(O + row * D + col) = w;
                    }
                } }
        return u.aux == 0;
    }
};
struct EpiOut {
    static constexpr bool PERM = true;
    const float* x; const float* mod; bf16_t* O;
    __device__ __forceinline__ bool operator()(f32x4 (&acc)[2][2][4][2], const Unit& u, int wr, int wc, int fr, int fq) const {
        const int row0 = u.pm * 256 + wr * 64 + fr, col0 = u.pn * 256 + wc * 32 + 8 * fq;
        const int b = (u.pm * 256) / SEQ;
        f32x4 gt[2][2];
#pragma unroll
        for (int bj = 0; bj < 2; ++bj)
#pragma unroll
            for (int n = 0; n < 2; ++n) gt[bj][n] = *(const f32x4*)(mod + b * 6144 + 2048 + col0 + bj * 128 + n * 4);
#pragma unroll
        for (int ai = 0; ai < 2; ++ai)
#pragma unroll
            for (int m = 0; m < 4; ++m) { const size_t off = (size_t)(row0 + ai * 128 + m * 16) * D + col0;
#pragma unroll
                for (int bj = 0; bj < 2; ++bj) { const f32x4 x0 = *(const f32x4*)(x + off + bj * 128), x1 = *(const f32x4*)(x + off + bj * 128 + 4);
                    const f32x4 v0 = x0 + gt[bj][0] * acc[ai][bj][m][0], v1 = x1 + gt[bj][1] * acc[ai][bj][m][1];
                    u32x4 w; w.x = cvt_pk_bf16(v0[0], v0[1]); w.y = cvt_pk_bf16(v0[2], v0[3]); w.z = cvt_pk_bf16(v1[0], v1[1]); w.w = cvt_pk_bf16(v1[2], v1[3]);
                    *(u32x4*)(O + off + bj * 128) = w; } }
        return false;
    }
};
struct EpiMoe1 {
    static constexpr bool PERM = true;
    bf16_t* O; unsigned* done;
    __device__ __forceinline__ bool operator()(f32x4 (&acc)[2][2][4][2], const Unit& u, int wr, int wc, int fr, int fq) const {
        const int row0 = u.pm * 256 + wr * 64 + fr, col0 = u.pn * 128 + wc * 32 + 8 * fq;
#pragma unroll
        for (int ai = 0; ai < 2; ++ai)
#pragma unroll
            for (int m = 0; m < 4; ++m) { bf16_t* rowp = O + (size_t)(row0 + ai * 128 + m * 16) * DEXP + col0;
                float h[8];
#pragma unroll
                for (int n = 0; n < 2; ++n)
#pragma unroll
                    for (int e = 0; e < 4; ++e) { const float x_ = acc[ai][0][m][n][e]; h[n * 4 + e] = x_ * __builtin_amdgcn_rcpf(1.0f + __builtin_amdgcn_exp2f(-1.4426950408889634f * x_)) * acc[ai][1][m][n][e]; }
                u32x4 w; w.x = cvt_pk_bf16(h[0], h[1]); w.y = cvt_pk_bf16(h[2], h[3]); w.z = cvt_pk_bf16(h[4], h[5]); w.w = cvt_pk_bf16(h[6], h[7]);
                asm volatile("global_store_dwordx4 %0, %1, off sc1\n\ts_nop 1" :: "v"(rowp), "v"(w) : "memory"); }
        asm volatile("s_waitcnt vmcnt(0)" ::: "memory");
        if ((threadIdx.x & 63) == 0) __hip_atomic_fetch_add(done + 16 * u.pm, 1u, __ATOMIC_RELAXED, __HIP_MEMORY_SCOPE_AGENT);
        return false;
    }
};

struct Frame { LAS unsigned char* lds; int tid, lane, wave, G, bid; };

__device__ __forceinline__ void transpose_item(const float* Wsrc, int ldw, bf16_t* dst, int ldd, LAS float* scr, int lane) {
#pragma unroll 8
    for (int i = 0; i < 32; ++i) { const int kk = 2 * i + (lane >> 5); scr[kk * 33 + (lane & 31)] = __builtin_nontemporal_load(Wsrc + (size_t)kk * ldw + (lane & 31)); }
    asm volatile("s_waitcnt lgkmcnt(0)" ::: "memory");
    const int c = lane & 7;
#pragma unroll
    for (int j = 0; j < 4; ++j) { const int n = (lane >> 3) + 8 * j; const LAS float* s = scr + (8 * c) * 33 + n;
        u32x4 o; o.x = pk2(s[0 * 33], s[1 * 33]); o.y = pk2(s[2 * 33], s[3 * 33]); o.z = pk2(s[4 * 33], s[5 * 33]); o.w = pk2(s[6 * 33], s[7 * 33]);
        *(u32x4*)(dst + (size_t)n * ldd + 8 * c) = o; }
    asm volatile("s_waitcnt lgkmcnt(0)" ::: "memory");
}
struct TItem { const float* src; bf16_t* dst; int ldw, ldd; };
template <class ItemFn>
__device__ __forceinline__ void transpose_stream(int it_lo, int it_hi, int gw, int NGW, LAS float* scr, int lane, ItemFn item) {
    int it = it_lo + gw; if (it >= it_hi) return;
    TItem cur = item(it);
    float v[32];
    const int l31 = lane & 31, lh = lane >> 5;
#pragma unroll
    for (int i = 0; i < 32; ++i) v[i] = __builtin_nontemporal_load(cur.src + (size_t)(2 * i + lh) * cur.ldw + l31);
    while (true) {
#pragma unroll
        for (int i = 0; i < 32; ++i) scr[(2 * i + lh) * 33 + l31] = v[i];
        const int nx = it + NGW; const bool more = nx < it_hi; TItem nxt = cur;
        if (more) { nxt = item(nx);
#pragma unroll
            for (int i = 0; i < 32; ++i) v[i] = __builtin_nontemporal_load(nxt.src + (size_t)(2 * i + lh) * nxt.ldw + l31); }
        asm volatile("s_waitcnt lgkmcnt(0)" ::: "memory");
        const int c = lane & 7;
#pragma unroll
        for (int j = 0; j < 4; ++j) { const int n = (lane >> 3) + 8 * j; const LAS float* s_ = scr + (8 * c) * 33 + n;
            u32x4 o; o.x = pk2(s_[0 * 33], s_[1 * 33]); o.y = pk2(s_[2 * 33], s_[3 * 33]); o.z = pk2(s_[4 * 33], s_[5 * 33]); o.w = pk2(s_[6 * 33], s_[7 * 33]);
            *(u32x4*)(cur.dst + (size_t)n * cur.ldd + 8 * c) = o; }
        asm volatile("s_waitcnt lgkmcnt(0)" ::: "memory");
        if (!more) break;
        cur = nxt; it = nx;
    }
}
__device__ __forceinline__ void transpose_matrix(const Frame& F, const float* W, int K, int N, bf16_t* WT) {
    LAS float* scr = (LAS float*)(F.lds + F.wave * 8448);
    const int gw = F.bid * NWAVES + F.wave, NGW = F.G * NWAVES, nblk = N / 32, items = (K / 64) * nblk;
    transpose_stream(0, items, gw, NGW, scr, F.lane, [=](int it) { const int kb = it / nblk, nb = it % nblk;
        return TItem{W + (size_t)(64 * kb) * N + 32 * nb, WT + (size_t)(32 * nb) * K + 64 * kb, N, K}; });
}

__device__ __forceinline__ void phase0(const Frame& F, const Args& a) {
    unsigned char* ws = a.ws;
    {
        float* mod = (float*)(ws + WS_MOD);
        const float* c = a.in[I_C]; const float* wada = a.in[I_WADA]; const float* bada = a.in[I_BADA];
        LAS f32x4* cs4 = (LAS f32x4*)(F.lds + 72 * 1024);
        LAS float* red = (LAS float*)(F.lds + 72 * 1024 + 16 * 1024);
        for (int i = F.tid; i < 4 * D; i += NTHR) ((LAS float*)cs4)[(i & (D - 1)) * 4 + (i >> 10)] = siluf_(c[i]);
        __syncthreads();
        for (int cb = F.bid; cb < 6144 / 32; cb += F.G) {
            const int l15 = F.lane & 15, lq = F.lane >> 4, k0 = 128 * F.wave + lq;
            const float* wp = wada + (size_t)k0 * 6144 + cb * 32 + 2 * l15;
            f32x2 wv[32];
#pragma unroll
            for (int i = 0; i < 32; ++i) wv[i] = __builtin_nontemporal_load((const f32x2*)(wp + (size_t)(4 * i) * 6144));
            f32x2 s[4] = {{0.f, 0.f}, {0.f, 0.f}, {0.f, 0.f}, {0.f, 0.f}};
#pragma unroll
            for (int i = 0; i < 32; ++i) { const f32x4 cv = cs4[k0 + 4 * i];
#pragma unroll
                for (int b = 0; b < 4; ++b) s[b] += wv[i] * cv[b]; }
#pragma unroll
            for (int b = 0; b < 4; ++b) { f32x2 t = s[b];
                t.x += __shfl_xor(t.x, 16); t.y += __shfl_xor(t.y, 16); t.x += __shfl_xor(t.x, 32); t.y += __shfl_xor(t.y, 32);
                if (lq == 0) *(LAS f32x2*)(red + (F.wave * 4 + b) * 32 + 2 * l15) = t; }
            __syncthreads();
            if (F.tid < 128) { const int b = F.tid >> 5, cc = F.tid & 31; float t = bada[cb * 32 + cc];
#pragma unroll
                for (int w = 0; w < 8; ++w) t += red[(w * 4 + b) * 32 + cc];
                mod[b * 6144 + cb * 32 + cc] = t; }
            __syncthreads();
        }
    }
    if (F.bid == 0) {
        float* sm = (float*)(ws + WS_SMALL);
        if (F.tid == 0) {
            float s1 = 0.f, s2 = 0.f;
            for (int i = 0; i < 64; ++i) { s1 += a.in[I_LQ1][i] * a.in[I_LK1][i]; s2 += a.in[I_LQ2][i] * a.in[I_LK2][i]; }
            sm[0] = expf(s1) - expf(s2) + 0.2f;
        }
        { const float l0 = a.in[I_LBL][F.tid], l1 = a.in[I_LBL][512 + F.tid]; const float mx = fmaxf(l0, l1);
          const float e0 = expf(l0 - mx), e1 = expf(l1 - mx); sm[16 + F.tid] = e0 / (e0 + e1); }
    }
}
__device__ __forceinline__ void moe_w2_convert(const Frame& F, const Args& a, int it_lo, int it_hi, int gw, int NGW) {
    LAS float* scr = (LAS float*)(F.lds + F.wave * 8448);
    bf16_t* w2t = (bf16_t*)((unsigned char*)a.out + OUT_W2); const float* w2 = a.in[I_W2];
    transpose_stream(it_lo, it_hi, gw, NGW, scr, F.lane, [=](int it) { const int e = it >> 8, kb = (it >> 5) & 7, nb = it & 31;
        return TItem{w2 + (size_t)e * 512 * 1024 + (size_t)(64 * kb) * 1024 + 32 * nb, w2t + ((size_t)e * 1024 + 32 * nb) * 512 + 64 * kb, 1024, 512}; });
}
__device__ __forceinline__ int w2_early_items(int G, int& n_light) { const int nwg = (T / 256) * (INC / 256), r = nwg % G; n_light = r ? G - r : 0; return n_light >= 64 ? W2_EARLY * 256 : 0; }
__device__ __forceinline__ void moe_weight_convert(const Frame& F, const Args& a) {
    LAS float* scr = (LAS float*)(F.lds + F.wave * 8448);
    const int gw = F.bid * NWAVES + F.wave, NGW = F.G * NWAVES;
    bf16_t* w13 = (bf16_t*)(a.ws + WS_W13);
    const float* w1 = a.in[I_W1]; const float* w3 = a.in[I_W3];
    transpose_stream(0, 2 * NEXP * 256, gw, NGW, scr, F.lane, [=](int it) {
        const int which = it / (NEXP * 256), r = it % (NEXP * 256), e = r >> 8, kb = (r >> 4) & 15, nb = r & 15, n0 = 32 * nb;
        const float* W = (which ? w3 : w1) + (size_t)e * 1024 * 512;
        const int drow = 256 * (n0 >> 7) + (which ? 128 : 0) + (n0 & 127);
        return TItem{W + (size_t)(64 * kb) * 512 + n0, w13 + ((size_t)e * 1024 + drow) * 1024 + 64 * kb, 512, 1024}; });
    int nl; const int early = w2_early_items(F.G, nl);
    moe_w2_convert(F, a, early, NEXP * 256, gw, NGW);
}

__device__ __forceinline__ void dense_weight_convert(const Frame& F, const Args& a) {
    unsigned char* ws = a.ws;
    {
        LAS float* scr = (LAS float*)(F.lds + F.wave * 8448);
        const int gw = F.bid * NWAVES + F.wave, NGW = F.G * NWAVES, nblk = INC / 32, items = (D / 64) * nblk;
        bf16_t* WT = (bf16_t*)(ws + WS_WIN);
        const float* win = a.in[I_WIN];
        transpose_stream(0, items, gw, NGW, scr, F.lane, [=](int it) { const int kb = it / nblk, n0 = 32 * (it % nblk); int dr = n0;
            if (n0 >= C_QHG && n0 < C_FHG) dr = C_HGT + 256 * ((n0 - C_QHG) >> 7) + ((n0 - C_QHG) & 127);
            else if (n0 >= C_FHG && n0 < C_IHG) dr = C_HGT + 256 * ((n0 - C_FHG) >> 7) + 128 + ((n0 - C_FHG) & 127);
            return TItem{win + (size_t)(64 * kb) * INC + n0, WT + (size_t)dr * D + 64 * kb, INC, D}; });
    }
    transpose_matrix(F, a.in[I_WUPDA], 512, D, (bf16_t*)(ws + WS_WUPDA));
    transpose_matrix(F, a.in[I_WUPHG], 512, D, (bf16_t*)(ws + WS_WUPHG));
    transpose_matrix(F, a.in[I_WOUT], D, D, (bf16_t*)(ws + WS_WOUT));
}
__device__ __forceinline__ void phase1(const Frame& F, const Args& a) {
    const float* mod = (const float*)(a.ws + WS_MOD);
    LAS float* Gs = (LAS float*)F.lds;
    LAS float* Ss = Gs + 1024;
    bf16_t* H = (bf16_t*)(a.ws + WS_ACT);
    const int rows_per_blk = T / F.G;
    const int r0 = F.bid * rows_per_blk, b = r0 / SEQ;
    for (int k = F.tid; k < 1024; k += NTHR) { Gs[k] = a.in[I_N1G][k] * (1.0f + mod[b * 6144 + 1024 + k]); Ss[k] = mod[b * 6144 + k]; }
    __syncthreads();
    for (int rb = r0 + F.wave; rb < r0 + rows_per_blk; rb += 4 * NWAVES) {
        f32x4 v[4][4];
#pragma unroll
        for (int q = 0; q < 4; ++q) { const int r = rb + q * NWAVES < r0 + rows_per_blk ? rb + q * NWAVES : rb; const f32x4* xr = (const f32x4*)(a.in[I_X] + (size_t)r * D) + F.lane;
#pragma unroll
            for (int j = 0; j < 4; ++j) v[q][j] = __builtin_nontemporal_load(xr + 64 * j); }
#pragma unroll
        for (int q = 0; q < 4; ++q) { const int r = rb + q * NWAVES; if (r >= r0 + rows_per_blk) break;
            float s = 0.f;
#pragma unroll
            for (int j = 0; j < 4; ++j) s += (v[q][j].x * v[q][j].x + v[q][j].y * v[q][j].y) + (v[q][j].z * v[q][j].z + v[q][j].w * v[q][j].w);
            const float rs = rsqrtf(wave_sum(s) * (1.0f / D) + EPS);
            unsigned long long* o8 = (unsigned long long*)(H + (size_t)r * D) + F.lane;
#pragma unroll
            for (int j = 0; j < 4; ++j) { const f32x4 g = *(const LAS f32x4*)(Gs + 256 * j + 4 * F.lane), sh = *(const LAS f32x4*)(Ss + 256 * j + 4 * F.lane);
                const f32x4 h = v[q][j] * rs * g + sh;
                o8[64 * j] = (unsigned long long)pk2(h.x, h.y) | ((unsigned long long)pk2(h.z, h.w) << 32); } }
    }
}

namespace attn_body {
using s16x4=__attribute__((ext_vector_type(4)))short;
using f32x16=__attribute__((ext_vector_type(16)))float;
constexpr int NW=8,QBLK=32,QB=QBLK*NW,KVBLK=64,NQB=SEQ/QB;
constexpr int PIN=INC, POUT=1024;
__device__ __forceinline__ int crow(int r,int hi){return (r&3)+8*(r>>2)+4*hi;}
#define SBAR() __builtin_amdgcn_sched_barrier(0)
__device__ __forceinline__ void bmask(f32x16&p0,f32x16&p1,int jb,int wch,int il,int hi,float s2x2){
  if(jb>wch){
    #pragma unroll
    for(int r=0;r<16;++r){p0[r]=-INFINITY;p1[r]=-INFINITY;}
  } else if(jb==wch){
    float fb=(float)(4*hi-il); asm volatile("":"+v"(fb));
    #pragma unroll
    for(int r=0;r<16;++r){const float c=(float)((r&3)+8*(r>>2)); p0[r]-=s2x2*__builtin_fmaxf(fb+c,0.f); p1[r]-=s2x2*__builtin_fmaxf(fb+(c+32.f),0.f);}
  }
}
constexpr int NSLOT=3, SLOTB=8192, VSLOTB=16384;
constexpr int LDS_K=0, LDS_V=NSLOT*SLOTB, LDS_WS=LDS_V+NSLOT*VSLOTB, LDS_OST=LDS_WS+NW*64*4, ATT_LDS_BYTES=LDS_OST+NW*8192;
constexpr float C2=0.125f*1.4426950408889634f;
__device__ __forceinline__ void glds16(const void*gsrc,unsigned lds_dst){unsigned keep;
  asm volatile("s_mov_b32 %0, m0\n\ts_mov_b32 m0, %2\n\ts_nop 0\n\tglobal_load_lds_dwordx4 %1, off\n\ts_mov_b32 m0, %0":"=&s"(keep):"v"(gsrc),"s"(lds_dst):"memory");}
__device__ __forceinline__ float max3f(float a,float b,float c){float r;asm("v_max3_f32 %0, %1, %2, %3":"=v"(r):"v"(a),"v"(b),"v"(c));return r;}
__device__ __forceinline__ float max2f(float a,float b){float r;asm("v_max_f32_e32 %0, %1, %2":"=v"(r):"v"(a),"v"(b));return r;}
__device__ __forceinline__ float fadd_s(float a,float b){float r;asm("v_add_f32_e32 %0, %1, %2":"=v"(r):"v"(a),"v"(b));return r;}
__device__ __forceinline__ float fsub_s(float a,float b){float r;asm("v_sub_f32_e32 %0, %1, %2":"=v"(r):"v"(a),"v"(b));return r;}
typedef float f32x2_t __attribute__((ext_vector_type(2))); typedef __bf16 bf16x2_t __attribute__((ext_vector_type(2)));
__device__ __forceinline__ unsigned cvtpk_s(float lo,float hi){f32x2_t v={lo,hi};bf16x2_t b=__builtin_convertvector(v,bf16x2_t);return __builtin_bit_cast(unsigned,b);}
#define WAIT_BAR(N) asm volatile("s_waitcnt vmcnt(" #N ") lgkmcnt(0)\n\ts_barrier":::"memory")

__device__ __forceinline__ void qkt(f32x16&p0,f32x16&p1,const char*Kslot,const bf16x8*qr,const f32x16&c0,const f32x16&c1,int r32,int hi){
  const char*kb=Kslot+hi*1024+r32*16;
  #pragma unroll
  for(int d0=0;d0<4;++d0){
    const bf16x8 b0=*reinterpret_cast<const bf16x8*>(kb+d0*2048);
    const bf16x8 b1=*reinterpret_cast<const bf16x8*>(kb+d0*2048+512);
    if(d0==0){p0=__builtin_amdgcn_mfma_f32_32x32x16_bf16(b0,qr[0],c0,0,0,0);p1=__builtin_amdgcn_mfma_f32_32x32x16_bf16(b1,qr[0],c1,0,0,0);}
    else{p0=__builtin_amdgcn_mfma_f32_32x32x16_bf16(b0,qr[d0],p0,0,0,0);p1=__builtin_amdgcn_mfma_f32_32x32x16_bf16(b1,qr[d0],p1,0,0,0);}}
}
typedef __attribute__((address_space(3))) const char* lds_cptr;
typedef short v4i16_t __attribute__((ext_vector_type(4)));
__device__ __forceinline__ void kload8(bf16x8*kf,lds_cptr kp){
  kf[0]=*(const __attribute__((address_space(3))) bf16x8*)(kp);      kf[1]=*(const __attribute__((address_space(3))) bf16x8*)(kp+512);
  kf[2]=*(const __attribute__((address_space(3))) bf16x8*)(kp+2048); kf[3]=*(const __attribute__((address_space(3))) bf16x8*)(kp+2560);
  kf[4]=*(const __attribute__((address_space(3))) bf16x8*)(kp+4096); kf[5]=*(const __attribute__((address_space(3))) bf16x8*)(kp+4608);
  kf[6]=*(const __attribute__((address_space(3))) bf16x8*)(kp+6144); kf[7]=*(const __attribute__((address_space(3))) bf16x8*)(kp+6656);
}
__device__ __forceinline__ void kload2(bf16x8*kf,lds_cptr kp,int j){ kf[2*j]=*(const __attribute__((address_space(3))) bf16x8*)(kp+j*2048); kf[2*j+1]=*(const __attribute__((address_space(3))) bf16x8*)(kp+j*2048+512); }
__device__ __forceinline__ s16x4 vtr(lds_cptr p){ return __builtin_bit_cast(s16x4,__builtin_amdgcn_ds_read_tr16_b64_v4i16((__attribute__((address_space(3))) v4i16_t*)p)); }
__device__ __forceinline__ float rowmax(const f32x16&p0,const f32x16&p1){
  float a=max3f(p0[0],p0[1],p1[0]),b=max3f(p0[2],p0[3],p1[1]);a=max3f(a,p1[2],p1[3]);
  #pragma unroll
  for(int r=4;r<16;r+=4){a=max3f(a,p0[r],p0[r+1]);b=max3f(b,p0[r+2],p0[r+3]);a=max3f(a,p1[r],p1[r+1]);b=max3f(b,p1[r+2],p1[r+3]);}
  const float m=max2f(a,b);
  auto rr=__builtin_amdgcn_permlane32_swap(__float_as_uint(m),__float_as_uint(m),false,false);
  return max2f(__uint_as_float(rr[0]),__uint_as_float(rr[1]));
}
__device__ __forceinline__ void pv(f32x16*o,int vb,bf16x8 pa0,bf16x8 pa1,bf16x8 pa2,bf16x8 pa3){
  #pragma unroll
  for(int d0=0;d0<4;++d0){s16x4 lo[4],hi[4];
    #pragma unroll
    for(int ks=0;ks<4;++ks){
      asm volatile("ds_read_b64_tr_b16 %0,%1 offset:%c2":"=&v"(lo[ks]):"v"(vb),"i"(d0*4096+ks*1024):"memory");
      asm volatile("ds_read_b64_tr_b16 %0,%1 offset:%c2":"=&v"(hi[ks]):"v"(vb),"i"(d0*4096+ks*1024+512):"memory");}
    asm volatile("s_waitcnt lgkmcnt(0)":::"memory");SBAR();
    #define PK(k) (bf16x8){lo[k][0],lo[k][1],lo[k][2],lo[k][3],hi[k][0],hi[k][1],hi[k][2],hi[k][3]}
    o[d0]=__builtin_amdgcn_mfma_f32_32x32x16_bf16(pa0,PK(0),o[d0],0,0,0);
    o[d0]=__builtin_amdgcn_mfma_f32_32x32x16_bf16(pa1,PK(1),o[d0],0,0,0);
    o[d0]=__builtin_amdgcn_mfma_f32_32x32x16_bf16(pa2,PK(2),o[d0],0,0,0);
    o[d0]=__builtin_amdgcn_mfma_f32_32x32x16_bf16(pa3,PK(3),o[d0],0,0,0);
    #undef PK
  }
}
#define ATTN_STORE16(p,v) (*(u32x4*)(p)=(v))
template<int THRL> __device__ __forceinline__ void attn_unit(int qb,const bf16_t*Qb,const bf16_t*__restrict__ Kh,const bf16_t*__restrict__ Vh,bf16_t*Ob,float slope2,char*shm){
  const int wid=__builtin_amdgcn_readfirstlane(threadIdx.x>>6); const int lane=lane_now(),r32=lane&31,hi=lane>>5;
  const int q0=qb*QB;
  const bf16_t*Qw=Qb+(long)(q0+wid*QBLK)*PIN;
  const unsigned lds0=(unsigned)(uintptr_t)shm;
  float*wsf=(float*)(shm+LDS_WS)+wid*64;
  const bf16_t*ksrc=Kh+(long)lane*PIN+wid*8;
  const bf16_t*vsrc=Vh+(long)(16*(wid&3)+(lane>>2))*PIN+(wid>>2)*32+(lane&3)*8;
  const unsigned kdst=lds0+LDS_K+wid*1024, vdst=lds0+LDS_V+(wid>>2)*4096+(wid&3)*1024;
  #define DMA_K(t,slot) glds16(ksrc+(long)(t)*KVBLK*PIN,(unsigned)__builtin_amdgcn_readfirstlane(kdst+(slot)))
  #define DMA_V(t,slot) do{ glds16(vsrc+(long)(t)*KVBLK*PIN,(unsigned)__builtin_amdgcn_readfirstlane(vdst+2*(slot))); glds16(vsrc+(long)(t)*KVBLK*PIN+64,(unsigned)__builtin_amdgcn_readfirstlane(vdst+2*(slot)+8192)); }while(0)
  const int vb0=(int)(lds0+LDS_V)+((lane>>4)&1)*32+(lane&3)*8+(4*hi+((lane&15)>>2))*64;
  const char*Kbase=shm+LDS_K; bf16x8 kf[8];
  const lds_cptr shm3=(lds_cptr)shm; const lds_cptr kp0=shm3+LDS_K+hi*1024+r32*16; const lds_cptr vp0=shm3+LDS_V+((lane>>4)&1)*32+(lane&3)*8+(4*hi+((lane&15)>>2))*64;
  const int NT=(q0+QB)/KVBLK;
  DMA_K(0,0);DMA_V(0,0);DMA_K(1,SLOTB);
  bf16x8 qr[4];
  #pragma unroll
  for(int d0=0;d0<4;++d0)qr[d0]=*reinterpret_cast<const bf16x8*>(&Qw[(long)r32*PIN+d0*16+hi*8]);
  float mhat=0.f,l_reg=0.f;f32x16 o[4];o[0]=f32x16{};o[1]=f32x16{};o[2]=f32x16{};o[3]=f32x16{};
  const float s64=slope2*64.f, s32=slope2*32.f, s2x2=2.f*slope2, s4hi=slope2*4.f*(float)hi;
  const int wch=wid>>1, il=32*(wid&1)+r32;
  #define CMASK(P0,P1,t) do{int jb_=(t)-(NT-4); if(jb_>=0)bmask(P0,P1,jb_,wch,il,hi,s2x2);}while(0)
  #define CINIT0(C0,t) do{ const float bt_=s64*(float)((t)-NT)-mhat+s4hi; _Pragma("unroll") for(int r=0;r<16;++r){C0[r]=__builtin_fmaf(slope2,(float)((r&3)+8*(r>>2)),bt_);} }while(0)
  #define CINIT1(C1,t) do{ const float bu_=s64*(float)((t)-NT)-mhat+s4hi+s32; _Pragma("unroll") for(int r=0;r<16;++r){C1[r]=__builtin_fmaf(slope2,(float)((r&3)+8*(r>>2)),bu_);} }while(0)
  bool resc=false;
  #define START(P0,P1) do{ const float rm=rowmax(P0,P1); resc=false; \
    { const float dl=rm; mhat=fadd_s(mhat,dl); \
      _Pragma("unroll") for(int r=0;r<16;++r){P0[r]=fsub_s(P0[r],dl);P1[r]=fsub_s(P1[r],dl);} } \
    _Pragma("unroll") for(int r=0;r<16;++r)P0[r]=__builtin_amdgcn_exp2f(P0[r]); }while(0)
  #define RESC() do{ if(resc){ asm volatile("s_waitcnt lgkmcnt(0)":::"memory"); \
      _Pragma("unroll") for(int d_=0;d_<4;++d_) _Pragma("unroll") for(int r=0;r<16;++r)o[d_][r]*=wsf[crow(r,hi)]; } }while(0)
  f32x16 cS0,cS1;
  u32x4 pwa0,pwa1,pwa2,pwa3,pwb0,pwb1,pwb2,pwb3;
  int sl_prev=0,sl_cur=0,sl_next=SLOTB;
  #define ROT() do{sl_prev=sl_cur;sl_cur=sl_next;sl_next=(sl_next==(NSLOT-1)*SLOTB)?0:sl_next+SLOTB;}while(0)
  #define PKW(P,B) cvtpk_s(P[B],P[B+1])
  DMA_K(2,2*SLOTB);
  WAIT_BAR(3);
  { f32x16 c0,c1; CINIT0(c0,0); CINIT1(c1,0); qkt(cS0,cS1,Kbase,qr,c0,c1,r32,hi); }
  asm volatile("s_nop 15\n\ts_nop 7":"+v"(cS0),"+v"(cS1));CMASK(cS0,cS1,0);
  START(cS0,cS1);
  _Pragma("unroll") for(int r=0;r<16;++r)cS1[r]=__builtin_amdgcn_exp2f(cS1[r]);
  { float sacc=cS0[0]+cS0[1]; _Pragma("unroll") for(int r=2;r<16;++r)sacc+=cS0[r]; _Pragma("unroll") for(int r=0;r<16;++r)sacc+=cS1[r]; l_reg+=sacc;
    pwa0=(u32x4){PKW(cS0,0),PKW(cS0,2),PKW(cS0,4),PKW(cS0,6)};pwa1=(u32x4){PKW(cS0,8),PKW(cS0,10),PKW(cS0,12),PKW(cS0,14)};pwa2=(u32x4){PKW(cS1,0),PKW(cS1,2),PKW(cS1,4),PKW(cS1,6)};pwa3=(u32x4){PKW(cS1,8),PKW(cS1,10),PKW(cS1,12),PKW(cS1,14)}; }
  WAIT_BAR(0);
  DMA_K(3,0);DMA_V(1,SLOTB);
  ROT();
  kload8(kf,kp0+sl_cur);
  WAIT_BAR(3);
  s16x4 vlo[4],vhi[4];
  #define CAT_(a,b) a##b
  #define CAT(a,b) CAT_(a,b)
  #define PAFC(P,k) __builtin_bit_cast(bf16x8,CAT(P,k))
  #define VFR(k) (bf16x8){vlo[(k)&3][0],vlo[(k)&3][1],vlo[(k)&3][2],vlo[(k)&3][3],vhi[(k)&3][0],vhi[(k)&3][1],vhi[(k)&3][2],vhi[(k)&3][3]}
  #define VOFF(k) ((k)<8 ? (((k)&1)*4096+((k)>>1)*1024) : ((2+((k)&1))*4096+(((k)-8)>>1)*1024))
  #define PIN_(x) asm volatile("":"+v"(x))
  #define MX3(a,b,c) __builtin_fmaxf(__builtin_fmaxf((a),(b)),(c))
  #define QK(MF) do{ MF; SBAR(); }while(0)
  #define EX(v) __builtin_amdgcn_exp2f(v)
  #define VRD(k) do{ vlo[(k)&3]=vtr(vp_+VOFF(k)); vhi[(k)&3]=vtr(vp_+(VOFF(k)+512)); }while(0)
  #define VNX(k) do{ if((k)+4<16){ VRD((k)+4); } SBAR(); }while(0)
  #define GAPB3(MF,X,B,PW,J) do{ MF; X[B]=EX(X[B]); X[B+1]=EX(X[B+1]); sacc+=X[B]; sacc+=X[B+1]; PW[J]=cvtpk_s(X[B],X[B+1]); PIN_(X); PIN_(sacc); PIN_(PW); SBAR(); }while(0)
  #define KRD(G,j) do{ if(G){ kload2(kf,kp0+sl_next,j); SBAR(); } }while(0)
  #define STEP(PC,PN,t,GK,GV,GL) do{ SBAR(); \
    CINIT0(cS0,t); SBAR(); \
    const lds_cptr vp_=vp0+2*sl_prev; \
    VRD(0); SBAR(); QK(cS0=__builtin_amdgcn_mfma_f32_32x32x16_bf16(kf[0],qr[0],cS0,0,0,0)); \
    CINIT1(cS1,t); VRD(1); SBAR(); QK(cS1=__builtin_amdgcn_mfma_f32_32x32x16_bf16(kf[1],qr[0],cS1,0,0,0)); \
    VRD(2); SBAR(); QK(cS0=__builtin_amdgcn_mfma_f32_32x32x16_bf16(kf[2],qr[1],cS0,0,0,0)); \
    VRD(3); SBAR(); QK(cS1=__builtin_amdgcn_mfma_f32_32x32x16_bf16(kf[3],qr[1],cS1,0,0,0)); \
    QK(cS0=__builtin_amdgcn_mfma_f32_32x32x16_bf16(kf[4],qr[2],cS0,0,0,0)); \
    QK(cS1=__builtin_amdgcn_mfma_f32_32x32x16_bf16(kf[5],qr[2],cS1,0,0,0)); \
    QK(cS0=__builtin_amdgcn_mfma_f32_32x32x16_bf16(kf[6],qr[3],cS0,0,0,0)); \
    QK(cS1=__builtin_amdgcn_mfma_f32_32x32x16_bf16(kf[7],qr[3],cS1,0,0,0)); \
    if(GK){DMA_K((t)+3,sl_cur);} if(GV){DMA_V((t)+1,sl_next);} \
    CMASK(cS0,cS1,t); \
    { float a=MX3(cS0[0],cS0[1],cS1[0]),b=MX3(cS0[2],cS0[3],cS1[1]); a=MX3(a,cS1[2],cS1[3]); \
      _Pragma("unroll") for(int r=4;r<16;r+=4){a=MX3(a,cS0[r],cS0[r+1]);b=MX3(b,cS0[r+2],cS0[r+3]);a=MX3(a,cS1[r],cS1[r+1]);b=MX3(b,cS1[r+2],cS1[r+3]);} \
      float rm=__builtin_fmaxf(a,b); { auto rr=__builtin_amdgcn_permlane32_swap(__float_as_uint(rm),__float_as_uint(rm),false,false); rm=__builtin_fmaxf(__uint_as_float(rr[0]),__uint_as_float(rr[1])); } \
      resc=false; \
      if(__builtin_expect(__any(rm>(float)THRL),0)){ const float dl=__builtin_fmaxf(rm,0.f); mhat+=dl; \
        _Pragma("unroll") for(int r=0;r<16;++r){cS0[r]-=dl;cS1[r]-=dl;} \
        const float f=__builtin_amdgcn_exp2f(-dl); l_reg*=f; if(hi==0)wsf[r32]=f; resc=true; } } \
    SBAR(); float sacc=0.f; \
    GAPB3(o[0]=__builtin_amdgcn_mfma_f32_32x32x16_bf16(PAFC(PC,0),VFR(0),o[0],0,0,0), cS0,0, CAT(PN,0),0); VNX(0); \
    GAPB3(o[1]=__builtin_amdgcn_mfma_f32_32x32x16_bf16(PAFC(PC,0),VFR(1),o[1],0,0,0), cS0,2, CAT(PN,0),1); VNX(1); \
    KRD(GL,0); GAPB3(o[0]=__builtin_amdgcn_mfma_f32_32x32x16_bf16(PAFC(PC,1),VFR(2),o[0],0,0,0), cS0,4, CAT(PN,0),2); VNX(2); \
    KRD(GL,1); GAPB3(o[1]=__builtin_amdgcn_mfma_f32_32x32x16_bf16(PAFC(PC,1),VFR(3),o[1],0,0,0), cS0,6, CAT(PN,0),3); VNX(3); \
    KRD(GL,2); GAPB3(o[0]=__builtin_amdgcn_mfma_f32_32x32x16_bf16(PAFC(PC,2),VFR(4),o[0],0,0,0), cS0,8, CAT(PN,1),0); VNX(4); \
    KRD(GL,3); GAPB3(o[1]=__builtin_amdgcn_mfma_f32_32x32x16_bf16(PAFC(PC,2),VFR(5),o[1],0,0,0), cS0,10, CAT(PN,1),1); VNX(5); \
    GAPB3(o[0]=__builtin_amdgcn_mfma_f32_32x32x16_bf16(PAFC(PC,3),VFR(6),o[0],0,0,0), cS0,12, CAT(PN,1),2); VNX(6); \
    GAPB3(o[1]=__builtin_amdgcn_mfma_f32_32x32x16_bf16(PAFC(PC,3),VFR(7),o[1],0,0,0), cS0,14, CAT(PN,1),3); VNX(7); \
    GAPB3(o[2]=__builtin_amdgcn_mfma_f32_32x32x16_bf16(PAFC(PC,0),VFR(8),o[2],0,0,0), cS1,0, CAT(PN,2),0); VNX(8); \
    GAPB3(o[3]=__builtin_amdgcn_mfma_f32_32x32x16_bf16(PAFC(PC,0),VFR(9),o[3],0,0,0), cS1,2, CAT(PN,2),1); VNX(9); \
    GAPB3(o[2]=__builtin_amdgcn_mfma_f32_32x32x16_bf16(PAFC(PC,1),VFR(10),o[2],0,0,0), cS1,4, CAT(PN,2),2); VNX(10); \
    GAPB3(o[3]=__builtin_amdgcn_mfma_f32_32x32x16_bf16(PAFC(PC,1),VFR(11),o[3],0,0,0), cS1,6, CAT(PN,2),3); VNX(11); \
    GAPB3(o[2]=__builtin_amdgcn_mfma_f32_32x32x16_bf16(PAFC(PC,2),VFR(12),o[2],0,0,0), cS1,8, CAT(PN,3),0); VNX(12); \
    GAPB3(o[3]=__builtin_amdgcn_mfma_f32_32x32x16_bf16(PAFC(PC,2),VFR(13),o[3],0,0,0), cS1,10, CAT(PN,3),1); VNX(13); \
    GAPB3(o[2]=__builtin_amdgcn_mfma_f32_32x32x16_bf16(PAFC(PC,3),VFR(14),o[2],0,0,0), cS1,12, CAT(PN,3),2); VNX(14); \
    GAPB3(o[3]=__builtin_amdgcn_mfma_f32_32x32x16_bf16(PAFC(PC,3),VFR(15),o[3],0,0,0), cS1,14, CAT(PN,3),3); VNX(15); \
    l_reg+=sacc; \
    }while(0)
  int t=1;
  #undef CMASK
  #define CMASK(P0,P1,t) do{}while(0)
  for(;t+5<NT;t+=2){
    STEP(pwa,pwb,t,true,true,true);     WAIT_BAR(3); RESC(); ROT();
    STEP(pwb,pwa,t+1,true,true,true);   WAIT_BAR(3); RESC(); ROT();
  }
  #undef CMASK
  #define CMASK(P0,P1,t) do{int jb_=(t)-(NT-4); if(jb_>=0)bmask(P0,P1,jb_,wch,il,hi,s2x2);}while(0)
  #define ENDW(tt) do{ if((tt)+3<NT){WAIT_BAR(3);} else if((tt)+2<NT){WAIT_BAR(2);} else {WAIT_BAR(0);} }while(0)
  for(;t+1<NT;t+=2){
    STEP(pwa,pwb,t,(t+3<NT),(t+1<NT),(t+1<NT));       ENDW(t);   RESC(); ROT();
    STEP(pwb,pwa,t+1,(t+4<NT),(t+2<NT),(t+2<NT));     ENDW(t+1); RESC(); ROT();
  }
  STEP(pwa,pwb,NT-1,false,false,false); RESC();
  SBAR(); pv(o,vb0+2*sl_cur,PAFC(pwb,0),PAFC(pwb,1),PAFC(pwb,2),PAFC(pwb,3));
  #undef PKW
  #undef PAFC
  #undef CAT
  #undef CAT_
  #undef QK
  #undef GAPB3
  #undef VFR
  #undef PIN_
  #undef MX3
  #undef EX
  #undef VRD
  #undef VNX
  #undef VOFF
  #undef GAPB2
  #undef KRD
  #undef STEP
  #undef ENDW
  {auto rr=__builtin_amdgcn_permlane32_swap(__float_as_uint(l_reg),__float_as_uint(l_reg),false,false);l_reg=__uint_as_float(rr[0])+__uint_as_float(rr[1]);}
  {
    const int le=lane_now(), r32e=le&31, hie=le>>5;
    float*wsfe=(float*)(shm+LDS_WS)+wid*64;
    if(hie==0)wsfe[32+r32e]=l_reg;asm volatile("s_waitcnt lgkmcnt(0)":::"memory");
    float rli[16];
    #pragma unroll
    for(int r=0;r<16;++r)rli[r]=__builtin_amdgcn_rcpf(wsfe[32+crow(r,hie)]);
    bf16_t*Ow=Ob+(long)(q0+wid*QBLK)*POUT;
    bf16_t*stg=(bf16_t*)(shm+LDS_OST)+wid*4096;
    #pragma unroll
    for(int r=0;r<16;++r){const int orow=crow(r,hie);
      #pragma unroll
      for(int d0=0;d0<4;++d0)stg[orow*128+d0*32+r32e]=(bf16_t)f2bf(o[d0][r]*rli[r]);}
    asm volatile("s_waitcnt lgkmcnt(0)":::"memory");
    #pragma unroll
    for(int i=0;i<8;++i){const int row=i*4+(le>>4),ch=le&15; const u32x4 v=*(const u32x4*)(stg+row*128+ch*8); ATTN_STORE16(Ow+(long)row*POUT+ch*8,v);} }
  asm volatile("s_waitcnt lgkmcnt(0)\n\ts_barrier":::"memory");
  #undef DMA_K
  #undef DMA_V
  #undef CMASK
  #undef CINIT0
  #undef CINIT1
  #undef START
  #undef RESC
  #undef ROT
}
#undef SBAR
#undef WAIT_BAR
}

__device__ __forceinline__ void attn_phase(const Frame& F, const Args& a) {
    const bf16_t* proj = (const bf16_t*)(a.ws + WS_PROJ); bf16_t* OA = (bf16_t*)(a.ws + WS_OA);
    const int vcu = (F.G % 8 == 0) ? (F.bid % 8) * (F.G / 8) + F.bid / 8 : F.bid;
    for (int i = 0;; ++i) {
        int bhm, qb;
        if (F.G == 256) { if (i >= 2) break; const int s_ = vcu & 7; bhm = vcu >> 3; qb = (i == 0) ? 15 - s_ : s_; }
        else { const int u = i * F.G + F.bid; if (u >= 512) break; bhm = u >> 4; qb = 15 - (u & 15); }
        const int b = bhm >> 3, h = (bhm >> 1) & 3, map = bhm & 1;
        const bf16_t* base = proj + (size_t)b * SEQ * INC;
        const float slope2 = exp2f(-2.0f * (h + 1)) * 1.4426950408889634f;
        attn_body::attn_unit<8>(qb, base + C_QDA + h * 128 + map * 64, base + C_KDA + h * 128 + map * 64, base + C_VDA + h * 128,
                                OA + (size_t)b * SEQ * 1024 + h * 256 + map * 128, slope2, (char*)F.lds);
    }
}
__device__ __forceinline__ void attn_combine(const Frame& F, const Args& a) {
    const bf16_t* OA = (const bf16_t*)(a.ws + WS_OA); bf16_t* Y = (bf16_t*)(a.ws + WS_YDA);
    const float lam = ((const float*)(a.ws + WS_SMALL))[0];
    const float g0 = a.in[I_SUBG][2 * F.lane] * 0.8f, g1 = a.in[I_SUBG][2 * F.lane + 1] * 0.8f;
    const int gw = F.bid * NWAVES + F.wave, NGW = F.G * NWAVES;
    for (int rb = gw; rb < T; rb += 4 * NGW) {
        unsigned w0[4][4], w1[4][4];
#pragma unroll
        for (int q = 0; q < 4; ++q) { const int r = rb + q * NGW < T ? rb + q * NGW : rb; const unsigned* orow = (const unsigned*)(OA + (size_t)r * 1024);
#pragma unroll
            for (int h = 0; h < 4; ++h) { w0[q][h] = __builtin_nontemporal_load(orow + h * 128 + F.lane); w1[q][h] = __builtin_nontemporal_load(orow + h * 128 + 64 + F.lane); } }
#pragma unroll
        for (int q = 0; q < 4; ++q) { const int r = rb + q * NGW; if (r >= T) break;
            unsigned* yrow = (unsigned*)(Y + (size_t)r * 512);
#pragma unroll
            for (int h = 0; h < 4; ++h) {
                const float x0 = bf2f(w0[q][h] & 0xffffu) - lam * bf2f(w1[q][h] & 0xffffu), x1 = bf2f(w0[q][h] >> 16) - lam * bf2f(w1[q][h] >> 16);
                const float rs = rsqrtf(wave_sum(x0 * x0 + x1 * x1) * (1.0f / 128.0f) + EPS);
                yrow[h * 64 + F.lane] = pk2(x0 * rs * g0, x1 * rs * g1);
            } }
    }
}
namespace hg {
constexpr int QP = 136;
constexpr int L_QD = 0, L_KD = 64 * QP * 2, L_V = 2 * 64 * QP * 2, L_KE = 3 * 64 * QP * 2, L_SSQ = 4 * 64 * QP * 2, L_G = L_SSQ + 512, L_ST = L_G + 64 * QP * 2;
__device__ __forceinline__ f32x4 mfma16(bf16x8 a, bf16x8 b, f32x4 c) { return __builtin_amdgcn_mfma_f32_16x16x32_bf16(a, b, c, 0, 0, 0); }
#define HG_BAR() do { asm volatile("s_waitcnt lgkmcnt(0)" ::: "memory"); __builtin_amdgcn_s_barrier(); asm volatile("" ::: "memory"); } while (0)
typedef short v4i16_t __attribute__((ext_vector_type(4)));
__device__ __forceinline__ bf16x8 tr8(const LAS unsigned char* img, int ra, int rb, int col0, int lane) {
    const int q = (lane & 15) >> 2, p = lane & 3;
    const v4i16_t lo = __builtin_amdgcn_ds_read_tr16_b64_v4i16((LAS v4i16_t*)(img + ((ra + q) * QP + col0 + 4 * p) * 2));
    const v4i16_t hi = __builtin_amdgcn_ds_read_tr16_b64_v4i16((LAS v4i16_t*)(img + ((rb + q) * QP + col0 + 4 * p) * 2));
    return (bf16x8){lo[0], lo[1], lo[2], lo[3], hi[0], hi[1], hi[2], hi[3]};
}
struct Tile { u32x4 p[2]; };
__device__ __forceinline__ void tile_load(Tile& t, const bf16_t* src, size_t pitch, int tid) {
#pragma unroll
    for (int i = 0; i < 2; ++i) { const int pc = tid + NTHR * i; t.p[i] = *(const u32x4*)(src + (size_t)(pc >> 4) * pitch + (pc & 15) * 8); }
}
__device__ __forceinline__ void tile_put(const Tile& t, LAS unsigned char* img, int tid) {
#pragma unroll
    for (int i = 0; i < 2; ++i) { const int pc = tid + NTHR * i; *(LAS u32x4*)(img + ((pc >> 4) * QP + (pc & 15) * 8) * 2) = t.p[i]; }
}
__device__ __forceinline__ void tile_get(Tile& t, const LAS unsigned char* img, int tid) {
#pragma unroll
    for (int i = 0; i < 2; ++i) { const int pc = tid + NTHR * i; t.p[i] = *(const LAS u32x4*)(img + ((pc >> 4) * QP + (pc & 15) * 8) * 2); }
}
__device__ __forceinline__ void tile_store(const Tile& t, bf16_t* dst, size_t pitch, int tid) {
#pragma unroll
    for (int i = 0; i < 2; ++i) { const int pc = tid + NTHR * i; *(u32x4*)(dst + (size_t)(pc >> 4) * pitch + (pc & 15) * 8) = t.p[i]; }
}
constexpr int PP = 72;
constexpr int G4_L_P = 4 * 64 * QP * 2, G4_L_DEC = G4_L_P + 64 * PP * 2, G4_L_SSQ = G4_L_DEC + 512, G4_L_DEC4 = G4_L_SSQ + 2048;
struct InA { Tile qd, kd, ke, v; };
__device__ __forceinline__ void loadA(InA& r, const Frame& F, const Args& a, int bh, int n) {
    const int b = bh >> 2, h = bh & 3; const size_t t0 = (size_t)b * SEQ + n * 64;
    const bf16_t* base = (const bf16_t*)(a.ws + WS_PROJ) + t0 * INC;
    tile_load(r.qd, base + C_HGT + 256 * h, INC, F.tid); tile_load(r.kd, base + C_HGT + 256 * h + 128, INC, F.tid);
    tile_load(r.ke, (const bf16_t*)a.out + t0 * 512 + h * 128, 512, F.tid); tile_load(r.v, base + C_IHG + h * 128, INC, F.tid);
}
#define G4_DEC_LOAD()  const int dcq_ = (F.tid >> 5) & 3; const f32x4 dv_ = *(const f32x4*)((const float*)(a.ws + WS_DEC) + ((size_t)bh * 64 + n0 + dcq_) * 128 + 4 * (F.tid & 31))
#define G4_DEC_PUT()   *(LAS f32x4*)(F.lds + G4_L_DEC4 + dcq_ * 512 + 16 * (F.tid & 31)) = dv_
__device__ __forceinline__ void grp_local(const Frame& F, const Args& a, int grp) {
    const int bh = grp >> 4, n0 = 4 * (grp & 15), b = bh >> 2, h = bh & 3, w = F.wave, lane = F.lane, fr = lane & 15, fq = lane >> 4;
    for (int i = F.tid; i < 64 * PP / 2; i += NTHR) ((LAS unsigned*)(F.lds + G4_L_P))[i] = 0u;
    f32x4 S[8];
#pragma unroll
    for (int kt = 0; kt < 8; ++kt) S[kt] = (f32x4){0.f, 0.f, 0.f, 0.f};
    G4_DEC_LOAD();
    InA c4[3];
    loadA(c4[0], F, a, bh, n0); loadA(c4[1], F, a, bh, n0 + 1);
    G4_DEC_PUT();
#define G4_STORE(nn) do { Tile ot_; tile_get(ot_, F.lds + L_KD, F.tid); tile_store(ot_, (bf16_t*)(a.ws + WS_YHG) + ((size_t)b * SEQ + (nn) * 64) * 512 + h * 128, 512, F.tid); } while (0)
#pragma unroll
    for (int j = 0; j < 4; ++j) {
        InA& cur = c4[j % 3];
        if (j > 0) G4_STORE(n0 + j - 1);
        if (j + 2 < 4) loadA(c4[(j + 2) % 3], F, a, bh, n0 + j + 2);
        tile_put(cur.qd, F.lds + L_QD, F.tid); tile_put(cur.kd, F.lds + L_KD, F.tid); tile_put(cur.ke, F.lds + L_KE, F.tid); tile_put(cur.v, F.lds + L_V, F.tid);
        HG_BAR();
#pragma unroll
        for (int rep = 0; rep < 2; ++rep) { const int pi = w + 8 * rep;
            if (pi < 10) { const int tb = pi >= 6 ? 3 : pi >= 3 ? 2 : pi >= 1 ? 1 : 0, jt = pi - (tb * (tb + 1)) / 2;
                f32x4 sc = (f32x4){0.f, 0.f, 0.f, 0.f};
#pragma unroll
                for (int ks = 0; ks < 4; ++ks) { const bf16x8 kf = *(const LAS bf16x8*)(F.lds + L_KD + ((16 * jt + fr) * QP + 32 * ks + 8 * fq) * 2);
                    const bf16x8 qf = *(const LAS bf16x8*)(F.lds + L_QD + ((16 * tb + fr) * QP + 32 * ks + 8 * fq) * 2); sc = mfma16(kf, qf, sc); }
                if (jt == tb) {
#pragma unroll
                    for (int r = 0; r < 4; ++r) if (4 * fq + r > fr) sc[r] = 0.f;
                }
                *(LAS u32x2*)(F.lds + G4_L_P + ((16 * tb + fr) * PP + 16 * jt + 4 * fq) * 2) = (u32x2){cvt_pk_bf16(sc[0], sc[1]), cvt_pk_bf16(sc[2], sc[3])}; } }
        HG_BAR();
        bf16x8 bv[2];
#pragma unroll
        for (int s2 = 0; s2 < 2; ++s2) bv[s2] = tr8(F.lds + L_V, 32 * s2 + 8 * fq, 32 * s2 + 8 * fq + 4, 16 * w, lane);
        bf16x8 Sb[4];
#pragma unroll
        for (int ks = 0; ks < 4; ++ks) { const u32x4 t = (u32x4){cvt_pk_bf16(S[2 * ks][0], S[2 * ks][1]), cvt_pk_bf16(S[2 * ks][2], S[2 * ks][3]), cvt_pk_bf16(S[2 * ks + 1][0], S[2 * ks + 1][1]), cvt_pk_bf16(S[2 * ks + 1][2], S[2 * ks + 1][3])};
            Sb[ks] = __builtin_bit_cast(bf16x8, t); }
#pragma unroll
        for (int tb = 0; tb < 4; ++tb) { f32x4 o = (f32x4){0.f, 0.f, 0.f, 0.f};
#pragma unroll
            for (int s2 = 0; s2 <= (tb >> 1); ++s2) { const bf16x8 pf = *(const LAS bf16x8*)(F.lds + G4_L_P + ((16 * tb + fr) * PP + 32 * s2 + 8 * fq) * 2); o = mfma16(pf, bv[s2], o); }
            if (j > 0) {
#pragma unroll
                for (int ks = 0; ks < 4; ++ks) { const LAS unsigned char* qrow = F.lds + L_QD + ((16 * tb + fr) * QP + 32 * ks + 4 * fq) * 2;
                    const u32x2 lo = *(const LAS u32x2*)qrow, hi = *(const LAS u32x2*)(qrow + 32);
                    const u32x4 aw = (u32x4){lo.x, lo.y, hi.x, hi.y}; o = mfma16(__builtin_bit_cast(bf16x8, aw), Sb[ks], o); } }
#pragma unroll
            for (int r = 0; r < 4; ++r) *(LAS unsigned short*)(F.lds + L_KD + ((16 * tb + 4 * fq + r) * QP + 16 * w + fr) * 2) = (unsigned short)f2bf(o[r]); }
#pragma unroll
        for (int kt = 0; kt < 8; ++kt) { S[kt] = S[kt] * *(const LAS f32x4*)(F.lds + G4_L_DEC4 + j * 512 + (16 * kt + 4 * fq) * 4);
#pragma unroll
            for (int s2 = 0; s2 < 2; ++s2) S[kt] = mfma16(tr8(F.lds + L_KE, 32 * s2 + 8 * fq, 32 * s2 + 8 * fq + 4, 16 * kt, lane), bv[s2], S[kt]); }
        HG_BAR();
    }
    G4_STORE(n0 + 3);
#undef G4_STORE
    f32x4* sg = (f32x4*)(a.ws + WS_DS) + ((size_t)grp * 64 + w * 8) * 64 + lane;
#pragma unroll
    for (int kt = 0; kt < 8; ++kt) sg[kt * 64] = S[kt];
}
__device__ __forceinline__ void grp_scan(const Frame& F, const Args& a) {
    const f32x2* sg = (const f32x2*)(a.ws + WS_DS); f32x2* si = (f32x2*)(a.ws + WS_DS) + (size_t)256 * 8192; const float* dec = (const float*)(a.ws + WS_DEC);
    for (int gt = F.bid * NTHR + F.tid; gt < 16 * 8192; gt += F.G * NTHR) {
        const int bh = gt >> 13, s2 = gt & 8191, slot = s2 >> 1, kt = (slot >> 6) & 7, lane = slot & 63, k = 16 * kt + 4 * (lane >> 4) + 2 * (s2 & 1);
        f32x2 cur = (f32x2){0.f, 0.f};
#pragma unroll
        for (int gh = 0; gh < 2; ++gh) {
            f32x2 sv[8], d[8];
#pragma unroll
            for (int g8 = 0; g8 < 8; ++g8) { const int g = 8 * gh + g8;
                sv[g8] = __builtin_nontemporal_load(sg + ((size_t)(bh * 16 + g)) * 8192 + s2);
                const float* dp = dec + ((size_t)bh * 64 + 4 * g) * 128 + k;
                d[g8] = (*(const f32x2*)dp * *(const f32x2*)(dp + 128)) * (*(const f32x2*)(dp + 256) * *(const f32x2*)(dp + 384)); }
#pragma unroll
            for (int g8 = 0; g8 < 8; ++g8) { const int g = 8 * gh + g8;
                si[((size_t)(bh * 16 + g)) * 8192 + s2] = cur;
                cur = d[g8] * cur + sv[g8]; }
        }
    }
}
struct InC { Tile qd, g, ol; };
__device__ __forceinline__ void loadC(InC& r, const Frame& F, const Args& a, int bh, int n) {
    const int b = bh >> 2, h = bh & 3; const size_t t0 = (size_t)b * SEQ + n * 64;
    const bf16_t* base = (const bf16_t*)(a.ws + WS_PROJ) + t0 * INC;
    tile_load(r.qd, base + C_HGT + 256 * h, INC, F.tid); tile_load(r.g, base + C_GHG + h * 128, INC, F.tid);
    tile_load(r.ol, (const bf16_t*)(a.ws + WS_YHG) + t0 * 512 + h * 128, 512, F.tid);
}
__device__ __forceinline__ void grp_final(const Frame& F, const Args& a, int grp) {
    const int bh = grp >> 4, n0 = 4 * (grp & 15), b = bh >> 2, h = bh & 3, w = F.wave, lane = F.lane, fr = lane & 15, fq = lane >> 4;
    f32x4 S[8];
    { const f32x4* si = (const f32x4*)(a.ws + WS_DS) + (size_t)256 * 4096 + ((size_t)grp * 64 + w * 8) * 64 + lane;
#pragma unroll
      for (int kt = 0; kt < 8; ++kt) S[kt] = si[kt * 64]; }
    const float ng = a.in[I_HGNG][16 * w + fr];
    LAS float* SSQ = (LAS float*)(F.lds + G4_L_SSQ);
    G4_DEC_LOAD();
    InC cur, nxt; loadC(cur, F, a, bh, n0);
    G4_DEC_PUT();
#define G4_STORE(nn) do { Tile ot_; tile_get(ot_, F.lds + L_V, F.tid); tile_store(ot_, (bf16_t*)(a.ws + WS_YHG) + ((size_t)b * SEQ + (nn) * 64) * 512 + h * 128, 512, F.tid); } while (0)
    for (int j = 0; j < 4; ++j) {
        if (j > 0) G4_STORE(n0 + j - 1);
        loadC(nxt, F, a, bh, n0 + (j < 3 ? j + 1 : 3));
        tile_put(cur.qd, F.lds + L_QD, F.tid); tile_put(cur.g, F.lds + L_KD, F.tid); tile_put(cur.ol, F.lds + L_V, F.tid);
        HG_BAR();
        bf16x8 Sb[4];
#pragma unroll
        for (int ks = 0; ks < 4; ++ks) { const u32x4 t = (u32x4){cvt_pk_bf16(S[2 * ks][0], S[2 * ks][1]), cvt_pk_bf16(S[2 * ks][2], S[2 * ks][3]), cvt_pk_bf16(S[2 * ks + 1][0], S[2 * ks + 1][1]), cvt_pk_bf16(S[2 * ks + 1][2], S[2 * ks + 1][3])};
            Sb[ks] = __builtin_bit_cast(bf16x8, t); }
        f32x4 o[4];
#pragma unroll
        for (int tb = 0; tb < 4; ++tb) {
#pragma unroll
            for (int r = 0; r < 4; ++r) o[tb][r] = bf2f(*(const LAS unsigned short*)(F.lds + L_V + ((16 * tb + 4 * fq + r) * QP + 16 * w + fr) * 2));
#pragma unroll
            for (int ks = 0; ks < 4; ++ks) { const LAS unsigned char* qrow = F.lds + L_QD + ((16 * tb + fr) * QP + 32 * ks + 4 * fq) * 2;
                const u32x2 lo = *(const LAS u32x2*)qrow, hi = *(const LAS u32x2*)(qrow + 32);
                const u32x4 aw = (u32x4){lo.x, lo.y, hi.x, hi.y}; o[tb] = mfma16(__builtin_bit_cast(bf16x8, aw), Sb[ks], o[tb]); }
#pragma unroll
            for (int r = 0; r < 4; ++r) { const float v = scan16(o[tb][r] * o[tb][r]); if (fr == 15) SSQ[w * 64 + 16 * tb + 4 * fq + r] = v; } }
#pragma unroll
        for (int kt = 0; kt < 8; ++kt) S[kt] = S[kt] * *(const LAS f32x4*)(F.lds + G4_L_DEC4 + j * 512 + (16 * kt + 4 * fq) * 4);
        HG_BAR();
#pragma unroll
        for (int tb = 0; tb < 4; ++tb) { f32x4 tot = (f32x4){0.f, 0.f, 0.f, 0.f};
#pragma unroll
            for (int ww = 0; ww < 8; ++ww) tot += *(const LAS f32x4*)(SSQ + ww * 64 + 16 * tb + 4 * fq);
#pragma unroll
            for (int r = 0; r < 4; ++r) { const float rs = rsqrtf(tot[r] * (1.0f / 128.0f) + EPS); const float g = bf2f(*(const LAS unsigned short*)(F.lds + L_KD + ((16 * tb + 4 * fq + r) * QP + 16 * w + fr) * 2));
                *(LAS unsigned short*)(F.lds + L_V + ((16 * tb + 4 * fq + r) * QP + 16 * w + fr) * 2) = (unsigned short)f2bf(o[tb][r] * rs * ng * g * __builtin_amdgcn_rcpf(1.0f + __builtin_amdgcn_exp2f(-1.4426950408889634f * g))); } }
        HG_BAR();
        cur = nxt;
    }
    G4_STORE(n0 + 3);
#undef G4_STORE
}
#undef HG_BAR
}

__device__ __forceinline__ float rs4(float a0, float a1, float a2, float a3, int lane) {
    const bool hi = (lane & 32) != 0;
    const float s0 = hi ? a0 : a2, s1 = hi ? a1 : a3;
    const float k0 = (hi ? a2 : a0) + __shfl_xor(s0, 32), k1 = (hi ? a3 : a1) + __shfl_xor(s1, 32);
    const bool b4 = (lane & 16) != 0;
    const float sd = b4 ? k0 : k1;
    float k = (b4 ? k1 : k0) + __shfl_xor(sd, 16);
    k += __shfl_xor(k, 8); k += __shfl_xor(k, 4); k += __shfl_xor(k, 2); k += __shfl_xor(k, 1);
    return k;
}
__device__ __forceinline__ void phase_router(const Frame& F, const Args& a) {
    constexpr int AP = 1032;
    LAS bf16_t* AH = (LAS bf16_t*)F.lds;
    LAS bf16_t* AL = AH + 16 * AP;
    LAS float* PART = (LAS float*)(F.lds + 2 * 16 * AP * 2);
    LAS float* LG = PART + 8 * 16 * 48;
    LAS unsigned* LH = (LAS unsigned*)(LG + 16 * 48);
    LAS unsigned* LB = LH + 32;
    LAS unsigned* LR = LH + 64;
    if (F.tid < NEXP) LH[F.tid] = 0u;
    const float* mod = (const float*)(a.ws + WS_MOD);
    const bf16_t* x1 = (const bf16_t*)(a.ws + WS_X1B); bf16_t* H2 = (bf16_t*)(a.ws + WS_ACT);
    unsigned* counts = (unsigned*)(a.ws + WS_CTL) + CW_COUNTS; unsigned* tokinfo = (unsigned*)(a.ws + WS_TOKINFO); int* toklist = (int*)(a.ws + WS_TOKLIST);
    const int rows_per_blk = T / F.G, r0 = F.bid * rows_per_blk, b = r0 / SEQ;
    const int lane = F.lane, w = F.wave, fr = lane & 15, fq = lane >> 4;
    f32x4 v[2][4], vn[2][4];
#define RT_LOAD(V, rb_) do { _Pragma("unroll") for (int q = 0; q < 2; ++q) { const u32x2* xr_ = (const u32x2*)(x1 + (size_t)((rb_) + 2 * w + q) * D) + lane; \
        _Pragma("unroll") for (int j = 0; j < 4; ++j) { const u32x2 t_ = xr_[64 * j]; V[q][j] = (f32x4){bf2f(t_.x & 0xffffu), bf2f(t_.x >> 16), bf2f(t_.y & 0xffffu), bf2f(t_.y >> 16)}; } } } while (0)
    RT_LOAD(v, r0);
    bf16x8 Bh[4][3], Bl[4][3];
    {
        const float* wre = a.in[I_WRE]; const float* wrg = a.in[I_WRG];
#pragma unroll
        for (int ks = 0; ks < 4; ++ks)
#pragma unroll
            for (int ct = 0; ct < 3; ++ct) {
                unsigned hw[4], lw[4];
#pragma unroll
                for (int jp = 0; jp < 4; ++jp) { float x[2];
#pragma unroll
                    for (int z = 0; z < 2; ++z) { const int k = 128 * w + 32 * ks + 8 * fq + 2 * jp + z;
                        if (ct == 0) { const float g = wrg[k * 4 + (fr & 3)], e = wre[k * 32 + ((fr + 28) & 31)]; x[z] = fr < 4 ? g : e; }
                        else if (ct == 1) x[z] = wre[k * 32 + 12 + fr];
                        else { const float e = wre[k * 32 + 28 + (fr & 3)]; x[z] = fr < 4 ? e : 0.f; } }
                    const unsigned h0 = f2bf(x[0]), h1 = f2bf(x[1]); hw[jp] = h0 | (h1 << 16);
                    lw[jp] = pk2(x[0] - bf2f(h0), x[1] - bf2f(h1)); }
                Bh[ks][ct] = __builtin_bit_cast(bf16x8, (u32x4){hw[0], hw[1], hw[2], hw[3]}); Bl[ks][ct] = __builtin_bit_cast(bf16x8, (u32x4){lw[0], lw[1], lw[2], lw[3]});
            }
    }
    for (int g = 0; g < rows_per_blk / 16; ++g) {
        const int rg = r0 + 16 * g;
        { const int gn = g + 1 < rows_per_blk / 16 ? g + 1 : g; RT_LOAD(vn, r0 + 16 * gn); }
#pragma unroll
        for (int q = 0; q < 2; ++q) { float sq = 0.f;
#pragma unroll
            for (int j = 0; j < 4; ++j) sq += (v[q][j].x * v[q][j].x + v[q][j].y * v[q][j].y) + (v[q][j].z * v[q][j].z + v[q][j].w * v[q][j].w);
            const float rs = rsqrtf(wave_sum(sq) * (1.0f / D) + EPS); const int row = 2 * w + q;
#pragma unroll
            for (int j = 0; j < 4; ++j) { const int k = 256 * j + 4 * lane;
                const f32x4 gg = *(const f32x4*)(a.in[I_N2G] + k) * (1.0f + *(const f32x4*)(mod + b * 6144 + 4 * 1024 + k)), sh = *(const f32x4*)(mod + b * 6144 + 3 * 1024 + k);
                const f32x4 hv = v[q][j] * rs * gg + sh;
                const unsigned h0 = f2bf(hv.x), h1 = f2bf(hv.y), h2_ = f2bf(hv.z), h3 = f2bf(hv.w);
                const u32x2 hw = (u32x2){h0 | (h1 << 16), h2_ | (h3 << 16)};
                *(u32x2*)(H2 + (size_t)(rg + row) * D + k) = hw;
                *(LAS u32x2*)(AH + row * AP + k) = hw;
                *(LAS u32x2*)(AL + row * AP + k) = (u32x2){pk2(hv.x - bf2f(h0), hv.y - bf2f(h1)), pk2(hv.z - bf2f(h2_), hv.w - bf2f(h3))}; } }
        __syncthreads();
        f32x4 acc[3] = {{0.f, 0.f, 0.f, 0.f}, {0.f, 0.f, 0.f, 0.f}, {0.f, 0.f, 0.f, 0.f}};
#pragma unroll
        for (int ks = 0; ks < 4; ++ks) { const bf16x8 ah = *(const LAS bf16x8*)(AH + fr * AP + 128 * w + 32 * ks + 8 * fq), al = *(const LAS bf16x8*)(AL + fr * AP + 128 * w + 32 * ks + 8 * fq);
#pragma unroll
            for (int ct = 0; ct < 3; ++ct) { acc[ct] = __builtin_amdgcn_mfma_f32_16x16x32_bf16(ah, Bh[ks][ct], acc[ct], 0, 0, 0);
                acc[ct] = __builtin_amdgcn_mfma_f32_16x16x32_bf16(al, Bh[ks][ct], acc[ct], 0, 0, 0); acc[ct] = __builtin_amdgcn_mfma_f32_16x16x32_bf16(ah, Bl[ks][ct], acc[ct], 0, 0, 0); } }
#pragma unroll
        for (int ct = 0; ct < 3; ++ct)
#pragma unroll
            for (int r = 0; r < 4; ++r) PART[(w * 16 + 4 * fq + r) * 48 + 16 * ct + fr] = acc[ct][r];
        __syncthreads();
        for (int t = F.tid; t < 16 * 48; t += NTHR) { const int row = t / 48, o = t % 48; float sacc = 0.f;
#pragma unroll
            for (int ww = 0; ww < 8; ++ww) sacc += PART[(ww * 16 + row) * 48 + o];
            if (o < 36) LG[row * 48 + o] = sacc + (o < 4 ? a.in[I_BRG][o & 3] : a.in[I_BRE][(o + 28) & 31]); }
        __syncthreads();
        if (F.tid < 16) {
            const LAS float* lg = LG + F.tid * 48;
            float gl[4]; int gi = 0;
#pragma unroll
            for (int o = 0; o < 4; ++o) gl[o] = lg[o];
            float gm = gl[0];
#pragma unroll
            for (int o = 1; o < 4; ++o) if (gl[o] > gm) { gm = gl[o]; gi = o; }
            float gsum = 0.f;
#pragma unroll
            for (int o = 0; o < 4; ++o) gsum += expf(gl[o] - gm);
            const float gp = 1.0f / gsum;
            float el[8];
#pragma unroll
            for (int e = 0; e < 8; ++e) el[e] = lg[4 + gi * 8 + e];
            int i0 = 0; float m0 = el[0];
#pragma unroll
            for (int o = 1; o < 8; ++o) if (el[o] > m0) { m0 = el[o]; i0 = o; }
            int i1 = -1; float m1 = -INFINITY;
#pragma unroll
            for (int o = 0; o < 8; ++o) if (o != i0 && el[o] > m1) { m1 = el[o]; i1 = o; }
            const float e1 = expf(m1 - m0); const float w0 = gp / (1.0f + e1), w1 = gp * e1 / (1.0f + e1);
            const int rl = 16 * g + F.tid, ex0 = gi * 8 + i0, ex1 = gi * 8 + i1;
            const unsigned l0 = atomicAdd((unsigned*)(LH + ex0), 1u), l1 = atomicAdd((unsigned*)(LH + ex1), 1u);
            LAS unsigned* ri = LR + rl * 6;
            ri[0] = (unsigned)ex0; ri[1] = l0; ri[2] = (unsigned)ex1; ri[3] = l1; ri[4] = __float_as_uint(w0); ri[5] = __float_as_uint(w1);
        }
#pragma unroll
        for (int q = 0; q < 2; ++q)
#pragma unroll
            for (int j = 0; j < 4; ++j) v[q][j] = vn[q][j];
    }
#undef RT_LOAD
    __syncthreads();
    if (F.tid < NEXP) LB[F.tid] = atomicAdd(counts + 64 * F.tid, LH[F.tid]);
    __syncthreads();
    for (int rl = F.tid; rl < rows_per_blk; rl += NTHR) {
        const LAS unsigned* ri = LR + rl * 6; const int r = r0 + rl;
        const unsigned ex0 = ri[0], ex1 = ri[2], k0 = LB[ex0] + ri[1], k1 = LB[ex1] + ri[3];
        toklist[ex0 * T + k0] = r; toklist[ex1 * T + k1] = r;
        u32x4 t0; t0.x = ex0; t0.y = k0; t0.z = ex1; t0.w = k1;
        *(u32x4*)(tokinfo + (size_t)r * 8) = t0;
        tokinfo[(size_t)r * 8 + 4] = ri[4]; tokinfo[(size_t)r * 8 + 5] = ri[5];
    }
}
__device__ __forceinline__ void build_moe_tab(const Frame& F, const Args& a, LAS MoeTab* tab) {
    if (F.wave == 0) {
        const unsigned* counts = (const unsigned*)(a.ws + WS_CTL) + CW_COUNTS;
        const int e = F.lane & 31;
        const int c = (int)__hip_atomic_load(counts + 64 * e, __ATOMIC_RELAXED, __HIP_MEMORY_SCOPE_AGENT);
        const int n = (c + 255) >> 8; int incl = n;
#pragma unroll
        for (int d = 1; d < 32; d <<= 1) { const int t = __shfl_up(incl, d, 32); if (e >= d) incl += t; }
        const int base = incl - n;
        if (F.lane < 32) { tab->cnt[e] = c; tab->tbase[e] = base;
            for (int m = 0; m < n; ++m) { tab->tile_e[base + m] = e; tab->tile_m[base + m] = m; } }
        if (F.lane == 31) { tab->tbase[NEXP] = incl; tab->nt = incl; }
    }
    __syncthreads();
}
__device__ __forceinline__ void phase_final(const Frame& F, const Args& a, const LAS MoeTab* tab) {
    const float* mod = (const float*)(a.ws + WS_MOD); const unsigned* tokinfo = (const unsigned*)(a.ws + WS_TOKINFO); const bf16_t* Ys = (const bf16_t*)(a.ws + WS_YS);
    const int rows_per_blk = T / F.G, r0 = F.bid * rows_per_blk;
    for (int rb = r0 + F.wave; rb < r0 + rows_per_blk; rb += 4 * NWAVES) {
        u32x4 ti[4]; u32x2 tw[4];
#pragma unroll
        for (int q = 0; q < 4; ++q) { const int r = rb + q * NWAVES < r0 + rows_per_blk ? rb + q * NWAVES : rb;
            ti[q] = *(const u32x4*)(tokinfo + (size_t)r * 8); tw[q] = *(const u32x2*)(tokinfo + (size_t)r * 8 + 4); }
        u32x2 xq[4][4], a0[4][4], a1[4][4];
#pragma unroll
        for (int q = 0; q < 4; ++q) { const int r = rb + q * NWAVES < r0 + rows_per_blk ? rb + q * NWAVES : rb;
            const size_t s0 = (size_t)tab->tbase[ti[q].x] * 256 + ti[q].y, s1 = (size_t)tab->tbase[ti[q].z] * 256 + ti[q].w;
            const u32x2* xb = (const u32x2*)((const bf16_t*)(a.ws + WS_X1B) + (size_t)r * D) + F.lane;
            const u32x2* y0 = (const u32x2*)(Ys + s0 * D) + F.lane; const u32x2* y1 = (const u32x2*)(Ys + s1 * D) + F.lane;
#pragma unroll
            for (int j = 0; j < 4; ++j) { xq[q][j] = __builtin_nontemporal_load(xb + 64 * j); a0[q][j] = __builtin_nontemporal_load(y0 + 64 * j); a1[q][j] = __builtin_nontemporal_load(y1 + 64 * j); } }
#pragma unroll
        for (int q = 0; q < 4; ++q) { const int r = rb + q * NWAVES; if (r >= r0 + rows_per_blk) break;
            const int b = r / SEQ; const float w0 = __uint_as_float(tw[q].x), w1 = __uint_as_float(tw[q].y);
            f32x4* xr = (f32x4*)(a.out + (size_t)r * D) + F.lane;
            f32x4 v[4]; float s = 0.f;
#pragma unroll
            for (int j = 0; j < 4; ++j) { const int k = 256 * j + 4 * F.lane;
                const f32x4 gt = *(const f32x4*)(mod + b * 6144 + 5 * 1024 + k); const u32x2 p0 = a0[q][j], p1 = a1[q][j], px = xq[q][j];
                f32x4 m; m.x = w0 * bf2f(p0.x & 0xffffu) + w1 * bf2f(p1.x & 0xffffu); m.y = w0 * bf2f(p0.x >> 16) + w1 * bf2f(p1.x >> 16);
                m.z = w0 * bf2f(p0.y & 0xffffu) + w1 * bf2f(p1.y & 0xffffu); m.w = w0 * bf2f(p0.y >> 16) + w1 * bf2f(p1.y >> 16);
                const f32x4 xv = (f32x4){bf2f(px.x & 0xffffu), bf2f(px.x >> 16), bf2f(px.y & 0xffffu), bf2f(px.y >> 16)};
                v[j] = xv + gt * m; s += (v[j].x * v[j].x + v[j].y * v[j].y) + (v[j].z * v[j].z + v[j].w * v[j].w); }
            const float rs = rsqrtf(wave_sum(s) * (1.0f / D) + EPS);
#pragma unroll
            for (int j = 0; j < 4; ++j) { const f32x4 g = *(const f32x4*)(a.in[I_FG] + 256 * j + 4 * F.lane); __builtin_nontemporal_store(v[j] * rs * g, xr + 64 * j); } }
    }
}

#define XB_TMO      128
#define XB_XCNT(j)  (256  + 64 * (j))
#define XB_XSUB(j)  (1280 + 64 * (j))
#define XB_XGEN(j)  (2304 + 64 * (j))
#define XB_TOP      3328
#define XB_TOPGEN   3392
#define XCD_BAR_WORDS 3456
#define XB_SPIN_CAP (1u << 18)
__device__ __forceinline__ unsigned xb_ld(unsigned* p)              { return __hip_atomic_load(p, __ATOMIC_RELAXED, __HIP_MEMORY_SCOPE_AGENT); }
__device__ __forceinline__ unsigned xb_add(unsigned* p, unsigned v) { return __hip_atomic_fetch_add(p, v, __ATOMIC_RELAXED, __HIP_MEMORY_SCOPE_AGENT); }
__device__ __forceinline__ unsigned xb_xcc_id() { return (unsigned)__builtin_amdgcn_s_getreg((3 << 11) | 20) & 0xFu; }
#define XB_SPIN(cond, bar) do { unsigned _sp = 0; while (cond) { __builtin_amdgcn_s_sleep(1); \
    if ((++_sp & 255u) == 0u) { if (xb_ld(&(bar)[XB_TMO])) break; if (_sp > XB_SPIN_CAP) { atomicAdd(&(bar)[XB_TMO], 1u); break; } } } } while (0)
struct XcdBarrier { unsigned* bar; unsigned x; volatile LAS unsigned* st; };
__device__ __forceinline__ XcdBarrier xcd_barrier_post(unsigned* bar, volatile LAS unsigned* st) {
    XcdBarrier b; b.bar = bar; b.x = xb_xcc_id(); b.st = st;
    if (threadIdx.x == 0) (void)xb_add(&bar[XB_XCNT(b.x)], 1u);
    return b;
}
__device__ __forceinline__ void xcd_barrier_complete(unsigned* bar, unsigned x, unsigned& nloc, unsigned& nx) {
    const unsigned G = gridDim.x * gridDim.y * gridDim.z;
    unsigned sum, cnt, mine, sp = 0u;
    for (;;) {
        sum = 0u; cnt = 0u; mine = 0u;
#pragma unroll
        for (unsigned j = 0; j < 16; ++j) { const unsigned c = xb_ld(&bar[XB_XCNT(j)]); sum += c; cnt += (c > 0u) ? 1u : 0u; mine = (j == x) ? c : mine; }
        if (sum == G) break;
        __builtin_amdgcn_s_sleep(1);
        if ((++sp & 255u) == 0u) { if (xb_ld(&bar[XB_TMO])) break; if (sp > XB_SPIN_CAP) { atomicAdd(&bar[XB_TMO], 1u); break; } }
    }
    nloc = mine > 0u ? mine : 1u; nx = cnt > 0u ? cnt : 1u;
}
__device__ __forceinline__ void xcd_barrier(const XcdBarrier& b) {
    asm volatile("s_waitcnt vmcnt(0)" ::: "memory");
    __syncthreads();
    if (threadIdx.x == 0) {
        unsigned* bar = b.bar;
        __builtin_amdgcn_s_waitcnt(0);
        unsigned nloc = b.st[0], nx = b.st[1];
        if (nloc == 0u) { xcd_barrier_complete(bar, b.x, nloc, nx); b.st[0] = nloc; b.st[1] = nx; }
        const unsigned old = xb_add(&bar[XB_XSUB(b.x)], 1u);
        const unsigned gen = old / nloc;
        if (old + 1u == (gen + 1u) * nloc) {
            __builtin_amdgcn_fence(__ATOMIC_RELEASE, "agent");
            asm volatile("s_waitcnt vmcnt(0)" ::: "memory");
            const unsigned og = xb_add(&bar[XB_TOP], 1u);
            const unsigned tg = og / nx;
            if (og + 1u == (tg + 1u) * nx) xb_add(&bar[XB_TOPGEN], 1u);
            else XB_SPIN(xb_ld(&bar[XB_TOPGEN]) == tg, bar);
            __builtin_amdgcn_fence(__ATOMIC_ACQUIRE, "agent");
            xb_add(&bar[XB_XGEN(b.x)], 1u);
            asm volatile("s_waitcnt vmcnt(0)" ::: "memory");
        } else {
            XB_SPIN(xb_ld(&bar[XB_XGEN(b.x)]) == gen, bar);
            __builtin_amdgcn_fence(__ATOMIC_ACQUIRE, "agent");
            asm volatile("s_waitcnt vmcnt(0)" ::: "memory");
        }
    }
    __syncthreads();
}

constexpr int N_PHASES = 11;
__global__ void __launch_bounds__(NTHR, 2) mk_fwd(Args a) {
    extern __shared__ __attribute__((aligned(16))) unsigned char lds_raw[];
    Frame F; F.lds = (LAS unsigned char*)lds_raw; F.tid = threadIdx.x; F.lane = F.tid & 63; F.wave = __builtin_amdgcn_readfirstlane(F.tid >> 6); F.G = gridDim.x; F.bid = blockIdx.x;
    unsigned char* ws = a.ws;
    const int lo = a.ph_lo, hi = a.ph_hi;
#if MK_N_LAUNCHES == 1
    volatile LAS unsigned* MISC = (volatile LAS unsigned*)(F.lds + 152 * 1024);
    if (F.tid < 4) MISC[F.tid] = 0u;
    __syncthreads();
    XcdBarrier xbar = xcd_barrier_post((unsigned*)(ws + WS_CTL) + CW_BAR, MISC);
#define SEAM(k) do { if (IN(k) && IN((k) + 1)) xcd_barrier(xbar); } while (0)
#else
#define SEAM(k) do { } while (0)
#endif
#define IN(k) (lo <= (k) && (k) < hi)
    LAS MoeTab* tab = (LAS MoeTab*)(F.lds + 144 * 1024);

#define RUNPH(k, ...) if (IN(k)) { F.lane = lane_now(); F.tid = F.wave * 64 + F.lane; __VA_ARGS__ }
    RUNPH(0, { phase0(F, a); }) SEAM(0);
    RUNPH(1, { phase1(F, a); __syncthreads(); dense_weight_convert(F, a); }) SEAM(1);
    RUNPH(2, {
        DenseOrder S{(const char*)(ws + WS_ACT), (const char*)(ws + WS_WIN), D, T / 256, INC / 256, F.G, F.bid};
        EpiInProj E{(bf16_t*)(ws + WS_PROJ), (bf16_t*)a.out, (float*)(ws + WS_DEC), (const float*)(ws + WS_SMALL) + 16, attn_body::C2};
        pg8::gemm_phase(F.lds, D, S, E);
        int nl; const int early = w2_early_items(F.G, nl);
        if (early && F.bid >= F.G - nl) { __syncthreads(); moe_w2_convert(F, a, 0, early, (F.bid - (F.G - nl)) * NWAVES + F.wave, nl * NWAVES); }
    }) SEAM(2);
    RUNPH(3, {
        for (int g = F.bid; g < 256; g += F.G) hg::grp_local(F, a, g);
        __syncthreads();
        attn_phase(F, a);
    }) SEAM(3);
    RUNPH(4, { hg::grp_scan(F, a); attn_combine(F, a); }) SEAM(4);
    RUNPH(5, { for (int g = F.bid; g < 256; g += F.G) hg::grp_final(F, a, g); }) SEAM(5);
    RUNPH(6, {
        UpOrder S{(const char*)(ws + WS_YDA), (const char*)(ws + WS_YHG), (const char*)(ws + WS_WUPDA), (const char*)(ws + WS_WUPHG), F.G, F.bid};
        EpiUp E{(const bf16_t*)(ws + WS_PROJ), (bf16_t*)(ws + WS_ACT)};
        pg8::gemm_phase(F.lds, 512, S, E);
    }) SEAM(6);
    RUNPH(7, {
        DenseOrder S{(const char*)(ws + WS_ACT), (const char*)(ws + WS_WOUT), D, T / 256, D / 256, F.G, F.bid};
        EpiOut E{a.in[I_X], (const float*)(ws + WS_MOD), (bf16_t*)(ws + WS_X1B)};
        const bool conv_first = (F.bid >> 3) & 1;
        if (conv_first) { moe_weight_convert(F, a); __syncthreads(); }
        pg8::gemm_phase(F.lds, D, S, E);
        if (!conv_first) { __syncthreads(); moe_weight_convert(F, a); }
    }) SEAM(7);
    RUNPH(8, { phase_router(F, a); __syncthreads(); }) SEAM(8);
    RUNPH(9, {
        build_moe_tab(F, a, tab);
        unsigned* done = (unsigned*)(ws + WS_CTL) + CW_TILE;
        const int vc = (F.G & 7) == 0 ? (F.bid & 7) * (F.G >> 3) + (F.bid >> 3) : F.bid;
        { Moe1Order S{tab, (const char*)(ws + WS_ACT), (const char*)(ws + WS_W13), (const int*)(ws + WS_TOKLIST), F.G, vc};
          EpiMoe1 E{(bf16_t*)(ws + WS_HS), done};
          pg8::gemm_phase(F.lds, D, S, E); }
        { Moe2Order S{tab, (const char*)(ws + WS_HS), (const char*)a.out + OUT_W2, done, (unsigned*)(ws + WS_CTL) + CW_TMO, F.G, vc};
          EpiStoreBf16 E{(bf16_t*)(ws + WS_YS), D, 0, 1.0f};
          pg8::gemm_phase(F.lds, DEXP, S, E); }
    }) SEAM(9);
    RUNPH(10, { build_moe_tab(F, a, tab); phase_final(F, a, tab); })
#undef IN
#undef SEAM
}

extern "C" void kernel_launch(void* const* d_in, const int* in_sizes, int n_in, void* d_out, int out_size, void* d_ws, size_t ws_size, hipStream_t stream) {
    static int grid = 0;
    if (grid == 0) {
        if (n_in != 25 || in_sizes[0] != T * D || out_size != T * D || ws_size < WS_END) { fprintf(stderr, "kernel_launch: unexpected shapes (n_in %d, in0 %d, out %d, ws %zu)\n", n_in, n_in > 0 ? in_sizes[0] : -1, out_size, ws_size); grid = -1; return; }
        int dev = 0, cus = 0, per_cu = 0;
        if (hipGetDevice(&dev) != hipSuccess || hipDeviceGetAttribute(&cus, hipDeviceAttributeMultiprocessorCount, dev) != hipSuccess) { grid = -1; return; }
        if (hipFuncSetAttribute((const void*)mk_fwd, hipFuncAttributeMaxDynamicSharedMemorySize, LDS_BYTES) != hipSuccess) { fprintf(stderr, "kernel_launch: hipFuncSetAttribute failed\n"); grid = -1; return; }
        if (hipOccupancyMaxActiveBlocksPerMultiprocessor(&per_cu, (const void*)mk_fwd, NTHR, LDS_BYTES) != hipSuccess || per_cu < 1) { fprintf(stderr, "kernel_launch: occupancy query says %d\n", per_cu); per_cu = 1; }
        (void)hipGetLastError();
        grid = cus;
        if (grid > 256) grid = 256;
        while (T % grid) --grid;
    }
    if (grid < 0) return;
    (void)hipMemsetAsync((char*)d_ws + WS_CTL, 0, CTL_ZERO_BYTES, stream);
    Args a{};
    for (int i = 0; i < 25; ++i) a.in[i] = (const float*)d_in[i];
    a.out = (float*)d_out; a.ws = (unsigned char*)d_ws;
#if MK_N_LAUNCHES == 1
    a.ph_lo = 0; a.ph_hi = N_PHASES;
    void* args[] = {&a};
    hipError_t e = hipLaunchCooperativeKernel((const void*)mk_fwd, dim3(grid), dim3(NTHR), args, LDS_BYTES, stream);
    if (e != hipSuccess) fprintf(stderr, "cooperative launch failed: %s (grid %d)\n", hipGetErrorString(e), grid);
#else
    for (int p = 0; p < N_PHASES; ++p) {
        a.ph_lo = p; a.ph_hi = p + 1;
        hipLaunchKernelGGL(mk_fwd, dim3(grid), dim3(NTHR), LDS_BYTES, stream, a);
    }
#endif
}
```

```cpp
#include <hip/hip_runtime.h>
#include <cstdio>
#include <cstdint>

#ifndef MK_N_LAUNCHES
#define MK_N_LAUNCHES 1
#endif

#define LAS __attribute__((address_space(3)))
typedef unsigned short bf16_t;
typedef short bf16x8 __attribute__((ext_vector_type(8)));
typedef float f32x4 __attribute__((ext_vector_type(4)));
typedef float f32x2 __attribute__((ext_vector_type(2)));
typedef unsigned u32x4 __attribute__((ext_vector_type(4)));
typedef unsigned u32x2 __attribute__((ext_vector_type(2)));

constexpr int NB = 4, SEQ = 4096, D = 1024, T = NB * SEQ;
constexpr int INC = 5632;
constexpr int C_QDA = 0, C_KDA = 512, C_VDA = 1024, C_QHG = 1536, C_FHG = 2048, C_IHG = 2560, C_GHG = 3072, C_GDA = 3584, C_GHGATE = 4608;
constexpr int C_HGT = 1536;
constexpr int NEXP = 32, DEXP = 512;
constexpr int PMAX = 40960;
constexpr float EPS = 1e-6f;
constexpr int NWAVES = 8, NTHR = 512;

constexpr size_t MiB = 1u << 20;
constexpr size_t WS_CTL = 0, CTL_ZERO_BYTES = 64 * 1024;
constexpr size_t WS_MOD = 5 * MiB / 2;
constexpr size_t WS_SMALL = 11 * MiB / 4;
constexpr size_t WS_TOKINFO = 3 * MiB;
constexpr size_t WS_TOKLIST = 4 * MiB;
constexpr size_t WS_DEC = 6 * MiB;
constexpr size_t WS_DS = 24 * MiB;
constexpr size_t WS_WIN = 8 * MiB;
constexpr size_t WS_WUPDA = 20 * MiB, WS_WUPHG = 21 * MiB, WS_WOUT = 22 * MiB;
constexpr size_t WS_ACT = 24 * MiB;
constexpr size_t WS_PROJ = 56 * MiB;
constexpr size_t WS_YDA = 232 * MiB, WS_YHG = 248 * MiB;
constexpr size_t WS_OA = 264 * MiB;
constexpr size_t WS_W13 = 56 * MiB;
constexpr size_t WS_W2 = 120 * MiB;
constexpr size_t WS_HS = 152 * MiB;
constexpr size_t WS_YS = 192 * MiB;
constexpr size_t OUT_W2 = 16 * MiB;
constexpr int W2_EARLY = 32;
constexpr size_t WS_X1B = 272 * MiB;
constexpr size_t WS_END = 304 * MiB;
constexpr int CW_COUNTS = 64;
constexpr int CW_BAR = 4096;
constexpr int CW_TILE = 8192;
constexpr int CW_TMO = 32;

constexpr int LDS_BYTES = 160 * 1024;

__device__ __forceinline__ float bf2f(unsigned v) { return __uint_as_float(v << 16); }
__device__ __forceinline__ unsigned f2bf(float f) { unsigned u = __float_as_uint(f); return (u + 0x7fffu + ((u >> 16) & 1u)) >> 16; }
__device__ __forceinline__ unsigned pk2(float lo, float hi) { return f2bf(lo) | (f2bf(hi) << 16); }
__device__ __forceinline__ float sigmoidf_(float x) { return 1.0f / (1.0f + __expf(-x)); }
__device__ __forceinline__ float siluf_(float x) { return x / (1.0f + __expf(-x)); }
__device__ __forceinline__ int lane_now() { int l; asm volatile("v_mbcnt_lo_u32_b32 %0, -1, 0\n\tv_mbcnt_hi_u32_b32 %0, -1, %0" : "=v"(l)); return l; }
__device__ __forceinline__ float wave_sum(float v) {
#pragma unroll
    for (int o = 1; o < 64; o <<= 1) v += __shfl_xor(v, o);
    return v;
}

namespace pg8 {
constexpr int BM = 256, BK = 64, HALF = 128, HTB = HALF * BK * 2, STAGE_BYTES = 8 * HTB;
__host__ __device__ __forceinline__ int lds_byte(int r, int c) { const int st = (r >> 4) * 2 + (c >> 5), rr = r & 15, cc = c & 31, ob = rr * 64 + cc * 2; return st * 1024 + (ob ^ (((ob >> 9) & 1) << 5)); }
__host__ __device__ __forceinline__ void stage_rc(int b, int& R, int& C) { const int st = b / 1024, sb = b % 1024, swz = sb ^ (((sb >> 9) & 1) << 5); R = (st >> 1) * 16 + swz / 64; C = (st & 1) * 32 + (swz % 64) / 2; }
__host__ __device__ __forceinline__ int perm32(int rho) { const int n = rho >> 4, i = rho & 15; return 8 * (i >> 2) + 4 * n + (i & 3); }

struct Unit { int pm, pn; const char* A; const char* B; int aux; };
__device__ __forceinline__ unsigned cvt_pk_bf16(float lo, float hi) { unsigned r; asm volatile("v_cvt_pk_bf16_f32 %0, %1, %2" : "=v"(r) : "v"(lo), "v"(hi)); return r; }

template <class Epi, class Sched>
__device__ __forceinline__ void gemm_phase(LAS unsigned char* lds, const int K, const Sched& S, const Epi& E) {
    const int tid = threadIdx.x, wid = __builtin_amdgcn_readfirstlane(tid >> 6), lane = tid & 63, wr = wid >> 2, wc = wid & 3, fr = lane & 15, fq = lane >> 4;
    const int nt = K / BK;
    unsigned voffB[2];
#define PG8_SETLANE() do { const int _l = lane_now(), _t = wid * 64 + _l; _Pragma("unroll") for (int _i = 0; _i < 2; ++_i) { int _R, _C; stage_rc(_t * 16 + _i * 8192, _R, _C); \
        const int _Rb = Epi::PERM ? ((_R & ~31) + perm32(_R & 31)) : _R; voffB[_i] = (unsigned)(_Rb * K + _C) * 2u; } \
        aoff = lds_byte(wr * 64 + (_l & 15), (_l >> 4) * 8); boff = lds_byte(wc * 32 + (_l & 15), (_l >> 4) * 8); } while (0)
    const size_t kstep = (size_t)(BK * 2);
    const size_t hstep = (size_t)HALF * K * 2;
    const unsigned ldsw = (unsigned)wid * 1024u;
    int aoff, boff; PG8_SETLANE();
#define PG8_SA(b, h) (((b) * 2 + (h)) * HTB)
#define PG8_SB(b, h) ((4 + (b) * 2 + (h)) * HTB)
#define PG8_STAGE(bufoff, gbase, voff) do { _Pragma("unroll") for (int _i = 0; _i < 2; ++_i) \
        __builtin_amdgcn_global_load_lds((const unsigned*)((const char*)(gbase) + (voff)[_i]), (LAS unsigned*)(lds + (bufoff) + ldsw + _i * 8192), 16, 0, 0); } while (0)
#define PG8_LDA(dst, b, h) do { _Pragma("unroll") for (int m = 0; m < 4; ++m) _Pragma("unroll") for (int k = 0; k < 2; ++k) dst[m][k] = *(const LAS bf16x8*)(lds + PG8_SA(b, h) + aoff + m * 2048 + k * 1024); } while (0)
#define PG8_LDB(dst, b, h) do { _Pragma("unroll") for (int n = 0; n < 2; ++n) _Pragma("unroll") for (int k = 0; k < 2; ++k) dst[n][k] = *(const LAS bf16x8*)(lds + PG8_SB(b, h) + boff + n * 2048 + k * 1024); } while (0)
#define PG8_MMA(ai, bj, At, Bt) do { __builtin_amdgcn_s_setprio(1); _Pragma("unroll") for (int m = 0; m < 4; ++m) _Pragma("unroll") for (int n = 0; n < 2; ++n) _Pragma("unroll") for (int k = 0; k < 2; ++k) \
        acc[ai][bj][m][n] = __builtin_amdgcn_mfma_f32_16x16x32_bf16(Bt[n][k], At[m][k], acc[ai][bj][m][n], 0, 0, 0); __builtin_amdgcn_s_setprio(0); } while (0)
#define PG8_WAIT_V(n) asm volatile("s_waitcnt vmcnt(" #n ")" ::: "memory")
#define PG8_WAIT_L(n) asm volatile("s_waitcnt lgkmcnt(" #n ")" ::: "memory")
#define PG8_BAR __builtin_amdgcn_s_barrier()
#define PG8_SCHED __builtin_amdgcn_sched_barrier(0)
#define PG8_SETA(vo, u) do { const int _t = wid * 64 + lane_now(); _Pragma("unroll") for (int _i = 0; _i < 2; ++_i) { int _R, _C; stage_rc(_t * 16 + _i * 8192, _R, _C); \
        _Pragma("unroll") for (int _h = 0; _h < 2; ++_h) vo[_h][_i] = (unsigned)((size_t)S.arow(u, _h * HALF + _R) * (size_t)K + _C) * 2u; } if (Sched::GATHER) PG8_WAIT_V(0); } while (0)
    Unit cur, nxt; int ui = 0;
    if (!S.next(0, cur)) return;
    f32x4 acc[2][2][4][2];
#pragma unroll
    for (int a = 0; a < 2; ++a)
#pragma unroll
        for (int b = 0; b < 2; ++b)
#pragma unroll
            for (int m = 0; m < 4; ++m)
#pragma unroll
                for (int n = 0; n < 2; ++n) acc[a][b][m][n] = (f32x4){0.f, 0.f, 0.f, 0.f};
    bf16x8 At[4][2], B0[2][2], B1[2][2];
    unsigned voC[2][2], voN[2][2];
    S.a_ready(cur);
    PG8_SETA(voC, cur);
    const char* cA = cur.A; const char* cB = cur.B;
    PG8_STAGE(PG8_SB(0, 0), cB, voffB); PG8_STAGE(PG8_SB(0, 1), cB + hstep, voffB); PG8_STAGE(PG8_SA(0, 0), cA, voC[0]); PG8_STAGE(PG8_SA(0, 1), cA, voC[1]);
    if (wr == 1) PG8_BAR;
    PG8_WAIT_V(2); PG8_BAR;
    PG8_STAGE(PG8_SB(1, 0), cB + kstep, voffB); PG8_STAGE(PG8_SA(1, 0), cA + kstep, voC[0]); PG8_STAGE(PG8_SB(1, 1), cB + hstep + kstep, voffB);
    PG8_WAIT_V(6); PG8_BAR;
    for (;;) {
        const bool has_next = S.next(ui + 1, nxt);
        if (has_next) { PG8_SETA(voN, nxt); }
        else {
#pragma unroll
            for (int h = 0; h < 2; ++h)
#pragma unroll
                for (int i = 0; i < 2; ++i) voN[h][i] = voC[h][i];
        }
        const char* nA = has_next ? nxt.A : cA; const char* nB = has_next ? nxt.B : cB;
        for (int t = 0; t < nt; t += 2) {
            const bool last = (t == nt - 2);
            if (last && has_next) S.a_ready(nxt);
            const char* a1 = cA + (size_t)(t + 1) * kstep;
            const char* a2 = last ? nA : cA + (size_t)(t + 2) * kstep; const char* b2 = last ? nB : cB + (size_t)(t + 2) * kstep;
            const char* a3 = a2 + kstep; const char* b3 = b2 + kstep;
            unsigned vo2[2][2];
#pragma unroll
            for (int h = 0; h < 2; ++h)
#pragma unroll
                for (int i = 0; i < 2; ++i) vo2[h][i] = last ? voN[h][i] : voC[h][i];
            PG8_LDB(B0, 0, 0); PG8_LDB(B1, 0, 1); PG8_SCHED; PG8_LDA(At, 0, 0); PG8_STAGE(PG8_SA(1, 1), a1, voC[1]);
            PG8_WAIT_V(8); PG8_WAIT_L(0); PG8_BAR; PG8_MMA(0, 0, At, B0); PG8_MMA(0, 1, At, B1); PG8_BAR; PG8_SCHED;
            PG8_LDA(At, 0, 1); PG8_STAGE(PG8_SB(0, 0), b2, voffB); PG8_STAGE(PG8_SB(0, 1), b2 + hstep, voffB); PG8_STAGE(PG8_SA(0, 0), a2, vo2[0]);
            PG8_WAIT_V(8); PG8_WAIT_L(0); PG8_BAR; PG8_MMA(1, 0, At, B0); PG8_MMA(1, 1, At, B1); PG8_BAR; PG8_SCHED;
            PG8_LDB(B0, 1, 0); PG8_LDB(B1, 1, 1); PG8_SCHED; PG8_LDA(At, 1, 0); PG8_STAGE(PG8_SA(0, 1), a2, vo2[1]);
            PG8_WAIT_V(8); PG8_WAIT_L(0); PG8_BAR; PG8_MMA(0, 0, At, B0); PG8_MMA(0, 1, At, B1); PG8_BAR; PG8_SCHED;
            PG8_LDA(At, 1, 1); PG8_STAGE(PG8_SB(1, 0), b3, voffB); PG8_STAGE(PG8_SB(1, 1), b3 + hstep, voffB); PG8_STAGE(PG8_SA(1, 0), a3, vo2[0]);
            PG8_WAIT_V(8); PG8_WAIT_L(0); PG8_BAR; PG8_MMA(1, 0, At, B0); PG8_MMA(1, 1, At, B1); PG8_BAR; PG8_SCHED;
        }
        if (wr == 0) PG8_BAR;
        const bool keep = E(acc, cur, wr, wc, fr, fq);
        if (!has_next) break;
        if (!keep) {
#pragma unroll
            for (int a = 0; a < 2; ++a)
#pragma unroll
                for (int b = 0; b < 2; ++b)
#pragma unroll
                    for (int m = 0; m < 4; ++m)
#pragma unroll
                        for (int n = 0; n < 2; ++n) acc[a][b][m][n] = (f32x4){0.f, 0.f, 0.f, 0.f};
        }
        cur = nxt; cA = nA; cB = nB; ++ui;
        if (Sched::GATHER) {
#pragma unroll
            for (int h = 0; h < 2; ++h)
#pragma unroll
                for (int i = 0; i < 2; ++i) voC[h][i] = voN[h][i];
        } else { PG8_SETA(voC, cur); }
        PG8_SETLANE();
        if (wr == 1) PG8_BAR;
    }
    PG8_WAIT_V(0);
    PG8_BAR;
#undef PG8_SA
#undef PG8_SB
#undef PG8_STAGE
#undef PG8_LDA
#undef PG8_LDB
#undef PG8_MMA
#undef PG8_WAIT_V
#undef PG8_WAIT_L
#undef PG8_BAR
#undef PG8_SCHED
#undef PG8_SETA
#undef PG8_SETLANE
}
}

struct Args { const float* in[25]; float* out; unsigned char* ws; int ph_lo, ph_hi; };
enum { I_X = 0, I_C, I_WADA, I_BADA, I_N1G, I_WIN, I_LQ1, I_LK1, I_LQ2, I_LK2, I_SUBG, I_LBL, I_HGNG, I_WUPDA, I_WUPHG, I_WOUT, I_N2G, I_WRG, I_BRG, I_WRE, I_BRE, I_W1, I_W3, I_W2, I_FG };

struct DenseOrder {
    static constexpr bool GATHER = false;
    const char* A; const char* Bt; int K, nM, nN, G, c;
    __device__ __forceinline__ bool next(int i, pg8::Unit& u) const {
        const int L = i * G + c, nwg = nM * nN; if (L >= nwg) return false;
        int wgid = L; { const int q = nwg / 8, r = nwg % 8, xcd = wgid % 8, off = wgid / 8; wgid = (xcd < r ? xcd * (q + 1) : r * (q + 1) + (xcd - r) * q) + off; }
        const int nig = 8 * nN, gid = wgid / nig, fm = gid * 8, gsz = (nM - fm) < 8 ? (nM - fm) : 8;
        u.pm = fm + ((wgid % nig) % gsz); u.pn = (wgid % nig) / gsz; u.A = A; u.B = Bt + (size_t)u.pn * 256 * K * 2; u.aux = 0; return true;
    }
    __device__ __forceinline__ void a_ready(const pg8::Unit&) const {}
    __device__ __forceinline__ unsigned arow(const pg8::Unit& u, int r) const { return (unsigned)(u.pm * 256 + r); }
};
struct UpOrder {
    static constexpr bool GATHER = false;
    const char* A0; const char* A1; const char* B0; const char* B1; int G, c;
    __device__ __forceinline__ bool next(int i, pg8::Unit& u) const {
        const int tile = (i >> 1) * G + c; if (tile >= 256) return false;
        u.pm = tile >> 2; u.pn = tile & 3; u.aux = i & 1;
        u.A = (i & 1) ? A1 : A0; u.B = ((i & 1) ? B1 : B0) + (size_t)u.pn * 256 * 512 * 2; return true;
    }
    __device__ __forceinline__ void a_ready(const pg8::Unit&) const {}
    __device__ __forceinline__ unsigned arow(const pg8::Unit& u, int r) const { return (unsigned)(u.pm * 256 + r); }
};
struct MoeTab { int nt; int pad[3]; int tile_e[176]; int tile_m[176]; int cnt[32]; int tbase[33]; };
struct Moe1Order {
    static constexpr bool GATHER = true;
    const LAS MoeTab* tab; const char* A; const char* W; const int* toklist; int G, c;
    __device__ __forceinline__ bool next(int i, pg8::Unit& u) const {
        const int L = i * G + c; if (L >= tab->nt * 4) return false;
        const int ti = L >> 2; u.pm = ti; u.pn = L & 3; u.aux = ti; u.A = A;
        u.B = W + ((size_t)tab->tile_e[ti] * 1024 + (size_t)u.pn * 256) * 1024 * 2; return true;
    }
    __device__ __forceinline__ void a_ready(const pg8::Unit&) const {}
    __device__ __forceinline__ unsigned arow(const pg8::Unit& u, int r) const {
        const int e = tab->tile_e[u.aux], rr = tab->tile_m[u.aux] * 256 + r;
        return rr < tab->cnt[e] ? (unsigned)toklist[e * T + rr] : 0u;
    }
};
struct Moe2Order {
    static constexpr bool GATHER = false;
    const LAS MoeTab* tab; const char* A; const char* W; unsigned* done; unsigned* tmo; int G, c;
    __device__ __forceinline__ bool next(int i, pg8::Unit& u) const {
        const int n1 = tab->nt * 4, r = n1 % G, nl = G - r; int j;
        if (r > 0 && c >= r) { if (i < 2) j = (c - r) + i * nl; else j = 2 * nl + (c - r) + (i - 2) * G; }
        else j = (r > 0 ? 2 * nl : 0) + ((c - r + G) % G) + i * G;
        if (j >= n1) return false;
        const int ti = j >> 2; u.pm = ti; u.pn = j & 3; u.aux = ti; u.A = A;
        u.B = W + ((size_t)tab->tile_e[ti] * 1024 + (size_t)u.pn * 256) * 512 * 2; return true;
    }
    __device__ __forceinline__ unsigned arow(const pg8::Unit& u, int r) const { return (unsigned)(u.pm * 256 + r); }
    __device__ __forceinline__ void a_ready(const pg8::Unit& u) const {
        if (threadIdx.x < 64) {
            unsigned polls = 0;
            while ((unsigned)__builtin_amdgcn_readfirstlane(__hip_atomic_load(done + 16 * u.pm, __ATOMIC_RELAXED, __HIP_MEMORY_SCOPE_AGENT)) < 32u) {
                if (++polls > (1u << 22)) { if (threadIdx.x == 0) __hip_atomic_store(tmo, 1u, __ATOMIC_RELAXED, __HIP_MEMORY_SCOPE_AGENT); break; }
                __builtin_amdgcn_s_sleep(2); }
            __builtin_amdgcn_fence(__ATOMIC_ACQUIRE, "agent");
            asm volatile("s_waitcnt vmcnt(0)" ::: "memory");
        }
        asm volatile("" ::: "memory"); __builtin_amdgcn_s_barrier(); asm volatile("" ::: "memory");
    }
};

using pg8::Unit; using pg8::cvt_pk_bf16;
struct EpiStoreBf16 {
    static constexpr bool PERM = true;
    bf16_t* O; int ldc; int nscale; float scale0;
    __device__ __forceinline__ bool operator()(f32x4 (&acc)[2][2][4][2], const Unit& u, int wr, int wc, int fr, int fq) const {
        const int row0 = u.pm * 256 + wr * 64 + fr, col0 = u.pn * 256 + wc * 32 + 8 * fq;
        const float sc = u.pn < nscale ? scale0 : 1.0f;
#pragma unroll
        for (int ai = 0; ai < 2; ++ai)
#pragma unroll
            for (int m = 0; m < 4; ++m) { bf16_t* rowp = O + (size_t)(row0 + ai * 128 + m * 16) * ldc + col0;
#pragma unroll
                for (int bj = 0; bj < 2; ++bj) { const f32x4 v0 = acc[ai][bj][m][0] * sc, v1 = acc[ai][bj][m][1] * sc;
                    u32x4 w; w.x = cvt_pk_bf16(v0[0], v0[1]); w.y = cvt_pk_bf16(v0[2], v0[3]); w.z = cvt_pk_bf16(v1[0], v1[1]); w.w = cvt_pk_bf16(v1[2], v1[3]);
                    *(u32x4*)(rowp + bj * 128) = w; } }
        return false;
    }
};
template <int N> __device__ __forceinline__ float dpp_shr(float x) { return __builtin_bit_cast(float, __builtin_amdgcn_update_dpp(0, __builtin_bit_cast(int, x), 0x110 + N, 0xf, 0xf, true)); }
template <int N> __device__ __forceinline__ float dpp_ror(float x) { return __builtin_bit_cast(float, __builtin_amdgcn_update_dpp(0, __builtin_bit_cast(int, x), 0x120 + N, 0xf, 0xf, true)); }
__device__ __forceinline__ float rowsum16(float x) { x += dpp_ror<8>(x); x += dpp_ror<4>(x); x += dpp_ror<2>(x); x += dpp_ror<1>(x); return x; }
__device__ __forceinline__ float scan16(float x) { x += dpp_shr<1>(x); x += dpp_shr<2>(x); x += dpp_shr<4>(x); x += dpp_shr<8>(x); return x; }
template <int N> __device__ __forceinline__ float dpp_shr1(float x) { return __builtin_bit_cast(float, __builtin_amdgcn_update_dpp(0x3f800000, __builtin_bit_cast(int, x), 0x110 + N, 0xf, 0xf, false)); }
__device__ __forceinline__ float rowprod16(float x) { x *= dpp_ror<8>(x); x *= dpp_ror<4>(x); x *= dpp_ror<2>(x); x *= dpp_ror<1>(x); return x; }
__device__ __forceinline__ float scanmul16(float x) { x *= dpp_shr1<1>(x); x *= dpp_shr1<2>(x); x *= dpp_shr1<4>(x); x *= dpp_shr1<8>(x); return x; }
struct EpiInProj {
    static constexpr bool PERM = true;
    bf16_t* O; bf16_t* KE; float* DEC; const float* lbv; float scale0;
    __device__ __forceinline__ bool operator()(f32x4 (&acc)[2][2][4][2], const Unit& u, int wr, int wc, int fr, int fq) const {
        { const int l_ = lane_now(); fr = l_ & 15; fq = l_ >> 4; }
        const int row0 = u.pm * 256 + wr * 64 + fr, col0 = u.pn * 256 + wc * 32 + 8 * fq;
        if (u.pn >= 6 && u.pn < 10) {
            const int h = u.pn - 6, lane = 16 * fq + fr, kb = wc * 32 + 8 * fq;
            const int bb = (u.pm * 256) / SEQ, ch0 = ((u.pm * 256) % SEQ + wr * 64) >> 6;
            const f32x4 lb0 = *(const f32x4*)(lbv + h * 128 + kb), lb1 = *(const f32x4*)(lbv + h * 128 + kb + 4);
#pragma unroll
            for (int ai = 0; ai < 2; ++ai) {
                unsigned kep[4][4];
#pragma unroll
                for (int n = 0; n < 2; ++n) {
#pragma unroll
                    for (int ep = 0; ep < 2; ++ep) {
                        float ke2[2][4];
#pragma unroll
                        for (int z = 0; z < 2; ++z) {
                            const int e = 2 * ep + z; const float lb = n ? lb1[e] : lb0[e];
                            float f[4], c[4], tot[4];
#pragma unroll
                            for (int m = 0; m < 4; ++m) { const float fl = acc[ai][1][m][n][e]; f[m] = lb + (1.0f - lb) * __builtin_amdgcn_rcpf(1.0f + __builtin_amdgcn_exp2f(-1.4426950408889634f * fl)); c[m] = scanmul16(f[m]); tot[m] = rowprod16(f[m]); }
                            const float eal = (tot[0] * tot[1]) * (tot[2] * tot[3]);
                            float pre = 1.0f;
#pragma unroll
                            for (int m = 0; m < 4; ++m) { const float eA = c[m] * pre; pre *= tot[m]; const float q = acc[ai][0][m][n][e]; const float kk = 1.0f - f[m];
                                acc[ai][0][m][n][e] = q * __builtin_amdgcn_rcpf(1.0f + __builtin_amdgcn_exp2f(-1.4426950408889634f * q)) * eA;
                                const float kd = kk * __builtin_amdgcn_rcpf(eA); acc[ai][1][m][n][e] = kd; ke2[z][m] = kd * eal; }
                            if (fr == 0) DEC[((size_t)(bb * 4 + h) * 64 + ch0 + 2 * ai) * 128 + kb + 4 * n + e] = eal;
                        }
#pragma unroll
                        for (int m = 0; m < 4; ++m) kep[m][2 * n + ep] = cvt_pk_bf16(ke2[0][m], ke2[1][m]);
                    }
                }
#pragma unroll
                for (int m = 0; m < 4; ++m) *(u32x4*)(KE + (size_t)(row0 + ai * 128 + m * 16) * 512 + h * 128 + kb) = (u32x4){kep[m][0], kep[m][1], kep[m][2], kep[m][3]};
            }
        }
        const float sc = u.pn < 2 ? scale0 : 1.0f;
#pragma unroll
        for (int ai = 0; ai < 2; ++ai)
#pragma unroll
            for (int m = 0; m < 4; ++m) { bf16_t* rowp = O + (size_t)(row0 + ai * 128 + m * 16) * INC + col0;
#pragma unroll
                for (int bj = 0; bj < 2; ++bj) { const f32x4 v0 = acc[ai][bj][m][0] * sc, v1 = acc[ai][bj][m][1] * sc;
                    u32x4 w; w.x = cvt_pk_bf16(v0[0], v0[1]); w.y = cvt_pk_bf16(v0[2], v0[3]); w.z = cvt_pk_bf16(v1[0], v1[1]); w.w = cvt_pk_bf16(v1[2], v1[3]);
                    *(u32x4*)(rowp + bj * 128) = w; } }
        return false;
    }
};
struct EpiUp {
    static constexpr bool PERM = true;
    const bf16_t* proj; bf16_t* O;
    __device__ __forceinline__ bool operator()(f32x4 (&acc)[2][2][4][2], const Unit& u, int wr, int wc, int fr, int fq) const {
        const int row0 = u.pm * 256 + wr * 64 + fr, col0 = u.pn * 256 + wc * 32 + 8 * fq;
#pragma unroll
        for (int ai = 0; ai < 2; ++ai)
#pragma unroll
            for (int m = 0; m < 4; ++m) { const size_t row = (size_t)(row0 + ai * 128 + m * 16);
#pragma unroll
                for (int bj = 0; bj < 2; ++bj) {
                    const int col = col0 + bj * 128;
                    const u32x4 gh = *(const u32x4*)(proj + row * INC + C_GHGATE + col);
                    float sh[8];
#pragma unroll
                    for (int j = 0; j < 4; ++j) { sh[2 * j] = 1.0f + __builtin_amdgcn_exp2f(-1.4426950408889634f * bf2f(gh[j] & 0xffffu)); sh[2 * j + 1] = 1.0f + __builtin_amdgcn_exp2f(-1.4426950408889634f * bf2f(gh[j] >> 16)); }
                    if (u.aux == 0) {
                        const u32x4 gd = *(const u32x4*)(proj + row * INC + C_GDA + col);
#pragma unroll
                        for (int j = 0; j < 4; ++j) {
                            const float d0 = 1.0f + __builtin_amdgcn_exp2f(-1.4426950408889634f * bf2f(gd[j] & 0xffffu)), d1 = 1.0f + __builtin_amdgcn_exp2f(-1.4426950408889634f * bf2f(gd[j] >> 16));
                            const float r0 = sh[2 * j] * __builtin_amdgcn_rcpf(d0), r1 = sh[2 * j + 1] * __builtin_amdgcn_rcpf(d1);
                            if (j < 2) { acc[ai][bj][m][0][2 * j] *= r0; acc[ai][bj][m][0][2 * j + 1] *= r1; }
                            else { acc[ai][bj][m][1][2 * j - 4] *= r0; acc[ai][bj][m][1][2 * j - 3] *= r1; }
                        }
                    } else {
                        const f32x4 v0 = acc[ai][bj][m][0], v1 = acc[ai][bj][m][1];
#pragma unroll
                        for (int j = 0; j < 8; ++j) sh[j] = __builtin_amdgcn_rcpf(sh[j]);
                        u32x4 w; w.x = cvt_pk_bf16(v0[0] * sh[0], v0[1] * sh[1]); w.y = cvt_pk_bf16(v0[2] * sh[2], v0[3] * sh[3]);
                        w.z = cvt_pk_bf16(v1[0] * sh[4], v1[1] * sh[5]); w.w = cvt_pk_bf16(v1[2] * sh[6], v1[3] * sh[7]);
                        *(u32x4*)(O + row * D + col) = w;
                    }
                } }
        return u.aux == 0;
    }
};
struct EpiOut {
    static constexpr bool PERM = true;
    const float* x; const float* mod; bf16_t* O;
    __device__ __forceinline__ bool operator()(f32x4 (&acc)[2][2][4][2], const Unit& u, int wr, int wc, int fr, int fq) const {
        const int row0 = u.pm * 256 + wr * 64 + fr, col0 = u.pn * 256 + wc * 32 + 8 * fq;
        const int b = (u.pm * 256) / SEQ;
        f32x4 gt[2][2];
#pragma unroll
        for (int bj = 0; bj < 2; ++bj)
#pragma unroll
            for (int n = 0; n < 2; ++n) gt[bj][n] = *(const f32x4*)(mod + b * 6144 + 2048 + col0 + bj * 128 + n * 4);
#pragma unroll
        for (int ai = 0; ai < 2; ++ai)
#pragma unroll
            for (int m = 0; m < 4; ++m) { const size_t off = (size_t)(row0 + ai * 128 + m * 16) * D + col0;
#pragma unroll
                for (int bj = 0; bj < 2; ++bj) { const f32x4 x0 = *(const f32x4*)(x + off + bj * 128), x1 = *(const f32x4*)(x + off + bj * 128 + 4);
                    const f32x4 v0 = x0 + gt[bj][0] * acc[ai][bj][m][0], v1 = x1 + gt[bj][1] * acc[ai][bj][m][1];
                    u32x4 w; w.x = cvt_pk_bf16(v0[0], v0[1]); w.y = cvt_pk_bf16(v0[2], v0[3]); w.z = cvt_pk_bf16(v1[0], v1[1]); w.w = cvt_pk_bf16(v1[2], v1[3]);
                    *(u32x4*)(O + off + bj * 128) = w; } }
        return false;
    }
};
struct EpiMoe1 {
    static constexpr bool PERM = true;
    bf16_t* O; unsigned* done;
    __device__ __forceinline__ bool operator()(f32x4 (&acc)[2][2][4][2], const Unit& u, int wr, int wc, int fr, int fq) const {
        const int row0 = u.pm * 256 + wr * 64 + fr, col0 = u.pn * 128 + wc * 32 + 8 * fq;
#pragma unroll
        for (int ai = 0; ai < 2; ++ai)
#pragma unroll
            for (int m = 0; m < 4; ++m) { bf16_t* rowp = O + (size_t)(row0 + ai * 128 + m * 16) * DEXP + col0;
                float h[8];
#pragma unroll
                for (int n = 0; n < 2; ++n)
#pragma unroll
                    for (int e = 0; e < 4; ++e) { const float x_ = acc[ai][0][m][n][e]; h[n * 4 + e] = x_ * __builtin_amdgcn_rcpf(1.0f + __builtin_amdgcn_exp2f(-1.4426950408889634f * x_)) * acc[ai][1][m][n][e]; }
                u32x4 w; w.x = cvt_pk_bf16(h[0], h[1]); w.y = cvt_pk_bf16(h[2], h[3]); w.z = cvt_pk_bf16(h[4], h[5]); w.w = cvt_pk_bf16(h[6], h[7]);
                asm volatile("global_store_dwordx4 %0, %1, off sc1\n\ts_nop 1" :: "v"(rowp), "v"(w) : "memory"); }
        asm volatile("s_waitcnt vmcnt(0)" ::: "memory");
        if ((threadIdx.x & 63) == 0) __hip_atomic_fetch_add(done + 16 * u.pm, 1u, __ATOMIC_RELAXED, __HIP_MEMORY_SCOPE_AGENT);
        return false;
    }
};

struct Frame { LAS unsigned char* lds; int tid, lane, wave, G, bid; };

__device__ __forceinline__ void transpose_item(const float* Wsrc, int ldw, bf16_t* dst, int ldd, LAS float* scr, int lane) {
#pragma unroll 8
    for (int i = 0; i < 32; ++i) { const int kk = 2 * i + (lane >> 5); scr[kk * 33 + (lane & 31)] = __builtin_nontemporal_load(Wsrc + (size_t)kk * ldw + (lane & 31)); }
    asm volatile("s_waitcnt lgkmcnt(0)" ::: "memory");
    const int c = lane & 7;
#pragma unroll
    for (int j = 0; j < 4; ++j) { const int n = (lane >> 3) + 8 * j; const LAS float* s = scr + (8 * c) * 33 + n;
        u32x4 o; o.x = pk2(s[0 * 33], s[1 * 33]); o.y = pk2(s[2 * 33], s[3 * 33]); o.z = pk2(s[4 * 33], s[5 * 33]); o.w = pk2(s[6 * 33], s[7 * 33]);
        *(u32x4*)(dst + (size_t)n * ldd + 8 * c) = o; }
    asm volatile("s_waitcnt lgkmcnt(0)" ::: "memory");
}
struct TItem { const float* src; bf16_t* dst; int ldw, ldd; };
template <class ItemFn>
__device__ __forceinline__ void transpose_stream(int it_lo, int it_hi, int gw, int NGW, LAS float* scr, int lane, ItemFn item) {
    int it = it_lo + gw; if (it >= it_hi) return;
    TItem cur = item(it);
    float v[32];
    const int l31 = lane & 31, lh = lane >> 5;
#pragma unroll
    for (int i = 0; i < 32; ++i) v[i] = __builtin_nontemporal_load(cur.src + (size_t)(2 * i + lh) * cur.ldw + l31);
    while (true) {
#pragma unroll
        for (int i = 0; i < 32; ++i) scr[(2 * i + lh) * 33 + l31] = v[i];
        const int nx = it + NGW; const bool more = nx < it_hi; TItem nxt = cur;
        if (more) { nxt = item(nx);
#pragma unroll
            for (int i = 0; i < 32; ++i) v[i] = __builtin_nontemporal_load(nxt.src + (size_t)(2 * i + lh) * nxt.ldw + l31); }
        asm volatile("s_waitcnt lgkmcnt(0)" ::: "memory");
        const int c = lane & 7;
#pragma unroll
        for (int j = 0; j < 4; ++j) { const int n = (lane >> 3) + 8 * j; const LAS float* s_ = scr + (8 * c) * 33 + n;
            u32x4 o; o.x = pk2(s_[0 * 33], s_[1 * 33]); o.y = pk2(s_[2 * 33], s_[3 * 33]); o.z = pk2(s_[4 * 33], s_[5 * 33]); o.w = pk2(s_[6 * 33], s_[7 * 33]);
            *(u32x4*)(cur.dst + (size_t)n * cur.ldd + 8 * c) = o; }
        asm volatile("s_waitcnt lgkmcnt(0)" ::: "memory");
        if (!more) break;
        cur = nxt; it = nx;
    }
}
__device__ __forceinline__ void transpose_matrix(const Frame& F, const float* W, int K, int N, bf16_t* WT) {
    LAS float* scr = (LAS float*)(F.lds + F.wave * 8448);
    const int gw = F.bid * NWAVES + F.wave, NGW = F.G * NWAVES, nblk = N / 32, items = (K / 64) * nblk;
    transpose_stream(0, items, gw, NGW, scr, F.lane, [=](int it) { const int kb = it / nblk, nb = it % nblk;
        return TItem{W + (size_t)(64 * kb) * N + 32 * nb, WT + (size_t)(32 * nb) * K + 64 * kb, N, K}; });
}

__device__ __forceinline__ void phase0(const Frame& F, const Args& a) {
    unsigned char* ws = a.ws;
    {
        float* mod = (float*)(ws + WS_MOD);
        const float* c = a.in[I_C]; const float* wada = a.in[I_WADA]; const float* bada = a.in[I_BADA];
        LAS f32x4* cs4 = (LAS f32x4*)(F.lds + 72 * 1024);
        LAS float* red = (LAS float*)(F.lds + 72 * 1024 + 16 * 1024);
        for (int i = F.tid; i < 4 * D; i += NTHR) ((LAS float*)cs4)[(i & (D - 1)) * 4 + (i >> 10)] = siluf_(c[i]);
        __syncthreads();
        for (int cb = F.bid; cb < 6144 / 32; cb += F.G) {
            const int l15 = F.lane & 15, lq = F.lane >> 4, k0 = 128 * F.wave + lq;
            const float* wp = wada + (size_t)k0 * 6144 + cb * 32 + 2 * l15;
            f32x2 wv[32];
#pragma unroll
            for (int i = 0; i < 32; ++i) wv[i] = __builtin_nontemporal_load((const f32x2*)(wp + (size_t)(4 * i) * 6144));
            f32x2 s[4] = {{0.f, 0.f}, {0.f, 0.f}, {0.f, 0.f}, {0.f, 0.f}};
#pragma unroll
            for (int i = 0; i < 32; ++i) { const f32x4 cv = cs4[k0 + 4 * i];
#pragma unroll
                for (int b = 0; b < 4; ++b) s[b] += wv[i] * cv[b]; }
#pragma unroll
            for (int b = 0; b < 4; ++b) { f32x2 t = s[b];
                t.x += __shfl_xor(t.x, 16); t.y += __shfl_xor(t.y, 16); t.x += __shfl_xor(t.x, 32); t.y += __shfl_xor(t.y, 32);
                if (lq == 0) *(LAS f32x2*)(red + (F.wave * 4 + b) * 32 + 2 * l15) = t; }
            __syncthreads();
            if (F.tid < 128) { const int b = F.tid >> 5, cc = F.tid & 31; float t = bada[cb * 32 + cc];
#pragma unroll
                for (int w = 0; w < 8; ++w) t += red[(w * 4 + b) * 32 + cc];
                mod[b * 6144 + cb * 32 + cc] = t; }
            __syncthreads();
        }
    }
    if (F.bid == 0) {
        float* sm = (float*)(ws + WS_SMALL);
        if (F.tid == 0) {
            float s1 = 0.f, s2 = 0.f;
            for (int i = 0; i < 64; ++i) { s1 += a.in[I_LQ1][i] * a.in[I_LK1][i]; s2 += a.in[I_LQ2][i] * a.in[I_LK2][i]; }
            sm[0] = expf(s1) - expf(s2) + 0.2f;
        }
        { const float l0 = a.in[I_LBL][F.tid], l1 = a.in[I_LBL][512 + F.tid]; const float mx = fmaxf(l0, l1);
          const float e0 = expf(l0 - mx), e1 = expf(l1 - mx); sm[16 + F.tid] = e0 / (e0 + e1); }
    }
}
__device__ __forceinline__ void moe_w2_convert(const Frame& F, const Args& a, int it_lo, int it_hi, int gw, int NGW) {
    LAS float* scr = (LAS float*)(F.lds + F.wave * 8448);
    bf16_t* w2t = (bf16_t*)((unsigned char*)a.out + OUT_W2); const float* w2 = a.in[I_W2];
    transpose_stream(it_lo, it_hi, gw, NGW, scr, F.lane, [=](int it) { const int e = it >> 8, kb = (it >> 5) & 7, nb = it & 31;
        return TItem{w2 + (size_t)e * 512 * 1024 + (size_t)(64 * kb) * 1024 + 32 * nb, w2t + ((size_t)e * 1024 + 32 * nb) * 512 + 64 * kb, 1024, 512}; });
}
__device__ __forceinline__ int w2_early_items(int G, int& n_light) { const int nwg = (T / 256) * (INC / 256), r = nwg % G; n_light = r ? G - r : 0; return n_light >= 64 ? W2_EARLY * 256 : 0; }
__device__ __forceinline__ void moe_weight_convert(const Frame& F, const Args& a) {
    LAS float* scr = (LAS float*)(F.lds + F.wave * 8448);
    const int gw = F.bid * NWAVES + F.wave, NGW = F.G * NWAVES;
    bf16_t* w13 = (bf16_t*)(a.ws + WS_W13);
    const float* w1 = a.in[I_W1]; const float* w3 = a.in[I_W3];
    transpose_stream(0, 2 * NEXP * 256, gw, NGW, scr, F.lane, [=](int it) {
        const int which = it / (NEXP * 256), r = it % (NEXP * 256), e = r >> 8, kb = (r >> 4) & 15, nb = r & 15, n0 = 32 * nb;
        const float* W = (which ? w3 : w1) + (size_t)e * 1024 * 512;
        const int drow = 256 * (n0 >> 7) + (which ? 128 : 0) + (n0 & 127);
        return TItem{W + (size_t)(64 * kb) * 512 + n0, w13 + ((size_t)e * 1024 + drow) * 1024 + 64 * kb, 512, 1024}; });
    int nl; const int early = w2_early_items(F.G, nl);
    moe_w2_convert(F, a, early, NEXP * 256, gw, NGW);
}

__device__ __forceinline__ void dense_weight_convert(const Frame& F, const Args& a) {
    unsigned char* ws = a.ws;
    {
        LAS float* scr = (LAS float*)(F.lds + F.wave * 8448);
        const int gw = F.bid * NWAVES + F.wave, NGW = F.G * NWAVES, nblk = INC / 32, items = (D / 64) * nblk;
        bf16_t* WT = (bf16_t*)(ws + WS_WIN);
        const float* win = a.in[I_WIN];
        transpose_stream(0, items, gw, NGW, scr, F.lane, [=](int it) { const int kb = it / nblk, n0 = 32 * (it % nblk); int dr = n0;
            if (n0 >= C_QHG && n0 < C_FHG) dr = C_HGT + 256 * ((n0 - C_QHG) >> 7) + ((n0 - C_QHG) & 127);
            else if (n0 >= C_FHG && n0 < C_IHG) dr = C_HGT + 256 * ((n0 - C_FHG) >> 7) + 128 + ((n0 - C_FHG) & 127);
            return TItem{win + (size_t)(64 * kb) * INC + n0, WT + (size_t)dr * D + 64 * kb, INC, D}; });
    }
    transpose_matrix(F, a.in[I_WUPDA], 512, D, (bf16_t*)(ws + WS_WUPDA));
    transpose_matrix(F, a.in[I_WUPHG], 512, D, (bf16_t*)(ws + WS_WUPHG));
    transpose_matrix(F, a.in[I_WOUT], D, D, (bf16_t*)(ws + WS_WOUT));
}
__device__ __forceinline__ void phase1(const Frame& F, const Args& a) {
    const float* mod = (const float*)(a.ws + WS_MOD);
    LAS float* Gs = (LAS float*)F.lds;
    LAS float* Ss = Gs + 1024;
    bf16_t* H = (bf16_t*)(a.ws + WS_ACT);
    const int rows_per_blk = T / F.G;
    const int r0 = F.bid * rows_per_blk, b = r0 / SEQ;
    for (int k = F.tid; k < 1024; k += NTHR) { Gs[k] = a.in[I_N1G][k] * (1.0f + mod[b * 6144 + 1024 + k]); Ss[k] = mod[b * 6144 + k]; }
    __syncthreads();
    for (int rb = r0 + F.wave; rb < r0 + rows_per_blk; rb += 4 * NWAVES) {
        f32x4 v[4][4];
#pragma unroll
        for (int q = 0; q < 4; ++q) { const int r = rb + q * NWAVES < r0 + rows_per_blk ? rb + q * NWAVES : rb; const f32x4* xr = (const f32x4*)(a.in[I_X] + (size_t)r * D) + F.lane;
#pragma unroll
            for (int j = 0; j < 4; ++j) v[q][j] = __builtin_nontemporal_load(xr + 64 * j); }
#pragma unroll
        for (int q = 0; q < 4; ++q) { const int r = rb + q * NWAVES; if (r >= r0 + rows_per_blk) break;
            float s = 0.f;
#pragma unroll
            for (int j = 0; j < 4; ++j) s += (v[q][j].x * v[q][j].x + v[q][j].y * v[q][j].y) + (v[q][j].z * v[q][j].z + v[q][j].w * v[q][j].w);
            const float rs = rsqrtf(wave_sum(s) * (1.0f / D) + EPS);
            unsigned long long* o8 = (unsigned long long*)(H + (size_t)r * D) + F.lane;
#pragma unroll
            for (int j = 0; j < 4; ++j) { const f32x4 g = *(const LAS f32x4*)(Gs + 256 * j + 4 * F.lane), sh = *(const LAS f32x4*)(Ss + 256 * j + 4 * F.lane);
                const f32x4 h = v[q][j] * rs * g + sh;
                o8[64 * j] = (unsigned long long)pk2(h.x, h.y) | ((unsigned long long)pk2(h.z, h.w) << 32); } }
    }
}

namespace attn_body {
using s16x4=__attribute__((ext_vector_type(4)))short;
using f32x16=__attribute__((ext_vector_type(16)))float;
constexpr int NW=8,QBLK=32,QB=QBLK*NW,KVBLK=64,NQB=SEQ/QB;
constexpr int PIN=INC, POUT=1024;
__device__ __forceinline__ int crow(int r,int hi){return (r&3)+8*(r>>2)+4*hi;}
#define SBAR() __builtin_amdgcn_sched_barrier(0)
__device__ __forceinline__ void bmask(f32x16&p0,f32x16&p1,int jb,int wch,int il,int hi,float s2x2){
  if(jb>wch){
    #pragma unroll
    for(int r=0;r<16;++r){p0[r]=-INFINITY;p1[r]=-INFINITY;}
  } else if(jb==wch){
    float fb=(float)(4*hi-il); asm volatile("":"+v"(fb));
    #pragma unroll
    for(int r=0;r<16;++r){const float c=(float)((r&3)+8*(r>>2)); p0[r]-=s2x2*__builtin_fmaxf(fb+c,0.f); p1[r]-=s2x2*__builtin_fmaxf(fb+(c+32.f),0.f);}
  }
}
constexpr int NSLOT=3, SLOTB=8192, VSLOTB=16384;
constexpr int LDS_K=0, LDS_V=NSLOT*SLOTB, LDS_WS=LDS_V+NSLOT*VSLOTB, LDS_OST=LDS_WS+NW*64*4, ATT_LDS_BYTES=LDS_OST+NW*8192;
constexpr float C2=0.125f*1.4426950408889634f;
__device__ __forceinline__ void glds16(const void*gsrc,unsigned lds_dst){unsigned keep;
  asm volatile("s_mov_b32 %0, m0\n\ts_mov_b32 m0, %2\n\ts_nop 0\n\tglobal_load_lds_dwordx4 %1, off\n\ts_mov_b32 m0, %0":"=&s"(keep):"v"(gsrc),"s"(lds_dst):"memory");}
__device__ __forceinline__ float max3f(float a,float b,float c){float r;asm("v_max3_f32 %0, %1, %2, %3":"=v"(r):"v"(a),"v"(b),"v"(c));return r;}
__device__ __forceinline__ float max2f(float a,float b){float r;asm("v_max_f32_e32 %0, %1, %2":"=v"(r):"v"(a),"v"(b));return r;}
__device__ __forceinline__ float fadd_s(float a,float b){float r;asm("v_add_f32_e32 %0, %1, %2":"=v"(r):"v"(a),"v"(b));return r;}
__device__ __forceinline__ float fsub_s(float a,float b){float r;asm("v_sub_f32_e32 %0, %1, %2":"=v"(r):"v"(a),"v"(b));return r;}
typedef float f32x2_t __attribute__((ext_vector_type(2))); typedef __bf16 bf16x2_t __attribute__((ext_vector_type(2)));
__device__ __forceinline__ unsigned cvtpk_s(float lo,float hi){f32x2_t v={lo,hi};bf16x2_t b=__builtin_convertvector(v,bf16x2_t);return __builtin_bit_cast(unsigned,b);}
#define WAIT_BAR(N) asm volatile("s_waitcnt vmcnt(" #N ") lgkmcnt(0)\n\ts_barrier":::"memory")

__device__ __forceinline__ void qkt(f32x16&p0,f32x16&p1,const char*Kslot,const bf16x8*qr,const f32x16&c0,const f32x16&c1,int r32,int hi){
  const char*kb=Kslot+hi*1024+r32*16;
  #pragma unroll
  for(int d0=0;d0<4;++d0){
    const bf16x8 b0=*reinterpret_cast<const bf16x8*>(kb+d0*2048);
    const bf16x8 b1=*reinterpret_cast<const bf16x8*>(kb+d0*2048+512);
    if(d0==0){p0=__builtin_amdgcn_mfma_f32_32x32x16_bf16(b0,qr[0],c0,0,0,0);p1=__builtin_amdgcn_mfma_f32_32x32x16_bf16(b1,qr[0],c1,0,0,0);}
    else{p0=__builtin_amdgcn_mfma_f32_32x32x16_bf16(b0,qr[d0],p0,0,0,0);p1=__builtin_amdgcn_mfma_f32_32x32x16_bf16(b1,qr[d0],p1,0,0,0);}}
}
typedef __attribute__((address_space(3))) const char* lds_cptr;
typedef short v4i16_t __attribute__((ext_vector_type(4)));
__device__ __forceinline__ void kload8(bf16x8*kf,lds_cptr kp){
  kf[0]=*(const __attribute__((address_space(3))) bf16x8*)(kp);      kf[1]=*(const __attribute__((address_space(3))) bf16x8*)(kp+512);
  kf[2]=*(const __attribute__((address_space(3))) bf16x8*)(kp+2048); kf[3]=*(const __attribute__((address_space(3))) bf16x8*)(kp+2560);
  kf[4]=*(const __attribute__((address_space(3))) bf16x8*)(kp+4096); kf[5]=*(const __attribute__((address_space(3))) bf16x8*)(kp+4608);
  kf[6]=*(const __attribute__((address_space(3))) bf16x8*)(kp+6144); kf[7]=*(const __attribute__((address_space(3))) bf16x8*)(kp+6656);
}
__device__ __forceinline__ void kload2(bf16x8*kf,lds_cptr kp,int j){ kf[2*j]=*(const __attribute__((address_space(3))) bf16x8*)(kp+j*2048); kf[2*j+1]=*(const __attribute__((address_space(3))) bf16x8*)(kp+j*2048+512); }
__device__ __forceinline__ s16x4 vtr(lds_cptr p){ return __builtin_bit_cast(s16x4,__builtin_amdgcn_ds_read_tr16_b64_v4i16((__attribute__((address_space(3))) v4i16_t*)p)); }
__device__ __forceinline__ float rowmax(const f32x16&p0,const f32x16&p1){
  float a=max3f(p0[0],p0[1],p1[0]),b=max3f(p0[2],p0[3],p1[1]);a=max3f(a,p1[2],p1[3]);
  #pragma unroll
  for(int r=4;r<16;r+=4){a=max3f(a,p0[r],p0[r+1]);b=max3f(b,p0[r+2],p0[r+3]);a=max3f(a,p1[r],p1[r+1]);b=max3f(b,p1[r+2],p1[r+3]);}
  const float m=max2f(a,b);
  auto rr=__builtin_amdgcn_permlane32_swap(__float_as_uint(m),__float_as_uint(m),false,false);
  return max2f(__uint_as_float(rr[0]),__uint_as_float(rr[1]));
}
__device__ __forceinline__ void pv(f32x16*o,int vb,bf16x8 pa0,bf16x8 pa1,bf16x8 pa2,bf16x8 pa3){
  #pragma unroll
  for(int d0=0;d0<4;++d0){s16x4 lo[4],hi[4];
    #pragma unroll
    for(int ks=0;ks<4;++ks){
      asm volatile("ds_read_b64_tr_b16 %0,%1 offset:%c2":"=&v"(lo[ks]):"v"(vb),"i"(d0*4096+ks*1024):"memory");
      asm volatile("ds_read_b64_tr_b16 %0,%1 offset:%c2":"=&v"(hi[ks]):"v"(vb),"i"(d0*4096+ks*1024+512):"memory");}
    asm volatile("s_waitcnt lgkmcnt(0)":::"memory");SBAR();
    #define PK(k) (bf16x8){lo[k][0],lo[k][1],lo[k][2],lo[k][3],hi[k][0],hi[k][1],hi[k][2],hi[k][3]}
    o[d0]=__builtin_amdgcn_mfma_f32_32x32x16_bf16(pa0,PK(0),o[d0],0,0,0);
    o[d0]=__builtin_amdgcn_mfma_f32_32x32x16_bf16(pa1,PK(1),o[d0],0,0,0);
    o[d0]=__builtin_amdgcn_mfma_f32_32x32x16_bf16(pa2,PK(2),o[d0],0,0,0);
    o[d0]=__builtin_amdgcn_mfma_f32_32x32x16_bf16(pa3,PK(3),o[d0],0,0,0);
    #undef PK
  }
}
#define ATTN_STORE16(p,v) (*(u32x4*)(p)=(v))
template<int THRL> __device__ __forceinline__ void attn_unit(int qb,const bf16_t*Qb,const bf16_t*__restrict__ Kh,const bf16_t*__restrict__ Vh,bf16_t*Ob,float slope2,char*shm){
  const int wid=__builtin_amdgcn_readfirstlane(threadIdx.x>>6); const int lane=lane_now(),r32=lane&31,hi=lane>>5;
  const int q0=qb*QB;
  const bf16_t*Qw=Qb+(long)(q0+wid*QBLK)*PIN;
  const unsigned lds0=(unsigned)(uintptr_t)shm;
  float*wsf=(float*)(shm+LDS_WS)+wid*64;
  const bf16_t*ksrc=Kh+(long)lane*PIN+wid*8;
  const bf16_t*vsrc=Vh+(long)(16*(wid&3)+(lane>>2))*PIN+(wid>>2)*32+(lane&3)*8;
  const unsigned kdst=lds0+LDS_K+wid*1024, vdst=lds0+LDS_V+(wid>>2)*4096+(wid&3)*1024;
  #define DMA_K(t,slot) glds16(ksrc+(long)(t)*KVBLK*PIN,(unsigned)__builtin_amdgcn_readfirstlane(kdst+(slot)))
  #define DMA_V(t,slot) do{ glds16(vsrc+(long)(t)*KVBLK*PIN,(unsigned)__builtin_amdgcn_readfirstlane(vdst+2*(slot))); glds16(vsrc+(long)(t)*KVBLK*PIN+64,(unsigned)__builtin_amdgcn_readfirstlane(vdst+2*(slot)+8192)); }while(0)
  const int vb0=(int)(lds0+LDS_V)+((lane>>4)&1)*32+(lane&3)*8+(4*hi+((lane&15)>>2))*64;
  const char*Kbase=shm+LDS_K; bf16x8 kf[8];
  const lds_cptr shm3=(lds_cptr)shm; const lds_cptr kp0=shm3+LDS_K+hi*1024+r32*16; const lds_cptr vp0=shm3+LDS_V+((lane>>4)&1)*32+(lane&3)*8+(4*hi+((lane&15)>>2))*64;
  const int NT=(q0+QB)/KVBLK;
  DMA_K(0,0);DMA_V(0,0);DMA_K(1,SLOTB);
  bf16x8 qr[4];
  #pragma unroll
  for(int d0=0;d0<4;++d0)qr[d0]=*reinterpret_cast<const bf16x8*>(&Qw[(long)r32*PIN+d0*16+hi*8]);
  float mhat=0.f,l_reg=0.f;f32x16 o[4];o[0]=f32x16{};o[1]=f32x16{};o[2]=f32x16{};o[3]=f32x16{};
  const float s64=slope2*64.f, s32=slope2*32.f, s2x2=2.f*slope2, s4hi=slope2*4.f*(float)hi;
  const int wch=wid>>1, il=32*(wid&1)+r32;
  #define CMASK(P0,P1,t) do{int jb_=(t)-(NT-4); if(jb_>=0)bmask(P0,P1,jb_,wch,il,hi,s2x2);}while(0)
  #define CINIT0(C0,t) do{ const float bt_=s64*(float)((t)-NT)-mhat+s4hi; _Pragma("unroll") for(int r=0;r<16;++r){C0[r]=__builtin_fmaf(slope2,(float)((r&3)+8*(r>>2)),bt_);} }while(0)
  #define CINIT1(C1,t) do{ const float bu_=s64*(float)((t)-NT)-mhat+s4hi+s32; _Pragma("unroll") for(int r=0;r<16;++r){C1[r]=__builtin_fmaf(slope2,(float)((r&3)+8*(r>>2)),bu_);} }while(0)
  bool resc=false;
  #define START(P0,P1) do{ const float rm=rowmax(P0,P1); resc=false; \
    { const float dl=rm; mhat=fadd_s(mhat,dl); \
      _Pragma("unroll") for(int r=0;r<16;++r){P0[r]=fsub_s(P0[r],dl);P1[r]=fsub_s(P1[r],dl);} } \
    _Pragma("unroll") for(int r=0;r<16;++r)P0[r]=__builtin_amdgcn_exp2f(P0[r]); }while(0)
  #define RESC() do{ if(resc){ asm volatile("s_waitcnt lgkmcnt(0)":::"memory"); \
      _Pragma("unroll") for(int d_=0;d_<4;++d_) _Pragma("unroll") for(int r=0;r<16;++r)o[d_][r]*=wsf[crow(r,hi)]; } }while(0)
  f32x16 cS0,cS1;
  u32x4 pwa0,pwa1,pwa2,pwa3,pwb0,pwb1,pwb2,pwb3;
  int sl_prev=0,sl_cur=0,sl_next=SLOTB;
  #define ROT() do{sl_prev=sl_cur;sl_cur=sl_next;sl_next=(sl_next==(NSLOT-1)*SLOTB)?0:sl_next+SLOTB;}while(0)
  #define PKW(P,B) cvtpk_s(P[B],P[B+1])
  DMA_K(2,2*SLOTB);
  WAIT_BAR(3);
  { f32x16 c0,c1; CINIT0(c0,0); CINIT1(c1,0); qkt(cS0,cS1,Kbase,qr,c0,c1,r32,hi); }
  asm volatile("s_nop 15\n\ts_nop 7":"+v"(cS0),"+v"(cS1));CMASK(cS0,cS1,0);
  START(cS0,cS1);
  _Pragma("unroll") for(int r=0;r<16;++r)cS1[r]=__builtin_amdgcn_exp2f(cS1[r]);
  { float sacc=cS0[0]+cS0[1]; _Pragma("unroll") for(int r=2;r<16;++r)sacc+=cS0[r]; _Pragma("unroll") for(int r=0;r<16;++r)sacc+=cS1[r]; l_reg+=sacc;
    pwa0=(u32x4){PKW(cS0,0),PKW(cS0,2),PKW(cS0,4),PKW(cS0,6)};pwa1=(u32x4){PKW(cS0,8),PKW(cS0,10),PKW(cS0,12),PKW(cS0,14)};pwa2=(u32x4){PKW(cS1,0),PKW(cS1,2),PKW(cS1,4),PKW(cS1,6)};pwa3=(u32x4){PKW(cS1,8),PKW(cS1,10),PKW(cS1,12),PKW(cS1,14)}; }
  WAIT_BAR(0);
  DMA_K(3,0);DMA_V(1,SLOTB);
  ROT();
  kload8(kf,kp0+sl_cur);
  WAIT_BAR(3);
  s16x4 vlo[4],vhi[4];
  #define CAT_(a,b) a##b
  #define CAT(a,b) CAT_(a,b)
  #define PAFC(P,k) __builtin_bit_cast(bf16x8,CAT(P,k))
  #define VFR(k) (bf16x8){vlo[(k)&3][0],vlo[(k)&3][1],vlo[(k)&3][2],vlo[(k)&3][3],vhi[(k)&3][0],vhi[(k)&3][1],vhi[(k)&3][2],vhi[(k)&3][3]}
  #define VOFF(k) ((k)<8 ? (((k)&1)*4096+((k)>>1)*1024) : ((2+((k)&1))*4096+(((k)-8)>>1)*1024))
  #define PIN_(x) asm volatile("":"+v"(x))
  #define MX3(a,b,c) __builtin_fmaxf(__builtin_fmaxf((a),(b)),(c))
  #define QK(MF) do{ MF; SBAR(); }while(0)
  #define EX(v) __builtin_amdgcn_exp2f(v)
  #define VRD(k) do{ vlo[(k)&3]=vtr(vp_+VOFF(k)); vhi[(k)&3]=vtr(vp_+(VOFF(k)+512)); }while(0)
  #define VNX(k) do{ if((k)+4<16){ VRD((k)+4); } SBAR(); }while(0)
  #define GAPB3(MF,X,B,PW,J) do{ MF; X[B]=EX(X[B]); X[B+1]=EX(X[B+1]); sacc+=X[B]; sacc+=X[B+1]; PW[J]=cvtpk_s(X[B],X[B+1]); PIN_(X); PIN_(sacc); PIN_(PW); SBAR(); }while(0)
  #define KRD(G,j) do{ if(G){ kload2(kf,kp0+sl_next,j); SBAR(); } }while(0)
  #define STEP(PC,PN,t,GK,GV,GL) do{ SBAR(); \
    CINIT0(cS0,t); SBAR(); \
    const lds_cptr vp_=vp0+2*sl_prev; \
    VRD(0); SBAR(); QK(cS0=__builtin_amdgcn_mfma_f32_32x32x16_bf16(kf[0],qr[0],cS0,0,0,0)); \
    CINIT1(cS1,t); VRD(1); SBAR(); QK(cS1=__builtin_amdgcn_mfma_f32_32x32x16_bf16(kf[1],qr[0],cS1,0,0,0)); \
    VRD(2); SBAR(); QK(cS0=__builtin_amdgcn_mfma_f32_32x32x16_bf16(kf[2],qr[1],cS0,0,0,0)); \
    VRD(3); SBAR(); QK(cS1=__builtin_amdgcn_mfma_f32_32x32x16_bf16(kf[3],qr[1],cS1,0,0,0)); \
    QK(cS0=__builtin_amdgcn_mfma_f32_32x32x16_bf16(kf[4],qr[2],cS0,0,0,0)); \
    QK(cS1=__builtin_amdgcn_mfma_f32_32x32x16_bf16(kf[5],qr[2],cS1,0,0,0)); \
    QK(cS0=__builtin_amdgcn_mfma_f32_32x32x16_bf16(kf[6],qr[3],cS0,0,0,0)); \
    QK(cS1=__builtin_amdgcn_mfma_f32_32x32x16_bf16(kf[7],qr[3],cS1,0,0,0)); \
    if(GK){DMA_K((t)+3,sl_cur);} if(GV){DMA_V((t)+1,sl_next);} \
    CMASK(cS0,cS1,t); \
    { float a=MX3(cS0[0],cS0[1],cS1[0]),b=MX3(cS0[2],cS0[3],cS1[1]); a=MX3(a,cS1[2],cS1[3]); \
      _Pragma("unroll") for(int r=4;r<16;r+=4){a=MX3(a,cS0[r],cS0[r+1]);b=MX3(b,cS0[r+2],cS0[r+3]);a=MX3(a,cS1[r],cS1[r+1]);b=MX3(b,cS1[r+2],cS1[r+3]);} \
      float rm=__builtin_fmaxf(a,b); { auto rr=__builtin_amdgcn_permlane32_swap(__float_as_uint(rm),__float_as_uint(rm),false,false); rm=__builtin_fmaxf(__uint_as_float(rr[0]),__uint_as_float(rr[1])); } \
      resc=false; \
      if(__builtin_expect(__any(rm>(float)THRL),0)){ const float dl=__builtin_fmaxf(rm,0.f); mhat+=dl; \
        _Pragma("unroll") for(int r=0;r<16;++r){cS0[r]-=dl;cS1[r]-=dl;} \
        const float f=__builtin_amdgcn_exp2f(-dl); l_reg*=f; if(hi==0)wsf[r32]=f; resc=true; } } \
    SBAR(); float sacc=0.f; \
    GAPB3(o[0]=__builtin_amdgcn_mfma_f32_32x32x16_bf16(PAFC(PC,0),VFR(0),o[0],0,0,0), cS0,0, CAT(PN,0),0); VNX(0); \
    GAPB3(o[1]=__builtin_amdgcn_mfma_f32_32x32x16_bf16(PAFC(PC,0),VFR(1),o[1],0,0,0), cS0,2, CAT(PN,0),1); VNX(1); \
    KRD(GL,0); GAPB3(o[0]=__builtin_amdgcn_mfma_f32_32x32x16_bf16(PAFC(PC,1),VFR(2),o[0],0,0,0), cS0,4, CAT(PN,0),2); VNX(2); \
    KRD(GL,1); GAPB3(o[1]=__builtin_amdgcn_mfma_f32_32x32x16_bf16(PAFC(PC,1),VFR(3),o[1],0,0,0), cS0,6, CAT(PN,0),3); VNX(3); \
    KRD(GL,2); GAPB3(o[0]=__builtin_amdgcn_mfma_f32_32x32x16_bf16(PAFC(PC,2),VFR(4),o[0],0,0,0), cS0,8, CAT(PN,1),0); VNX(4); \
    KRD(GL,3); GAPB3(o[1]=__builtin_amdgcn_mfma_f32_32x32x16_bf16(PAFC(PC,2),VFR(5),o[1],0,0,0), cS0,10, CAT(PN,1),1); VNX(5); \
    GAPB3(o[0]=__builtin_amdgcn_mfma_f32_32x32x16_bf16(PAFC(PC,3),VFR(6),o[0],0,0,0), cS0,12, CAT(PN,1),2); VNX(6); \
    GAPB3(o[1]=__builtin_amdgcn_mfma_f32_32x32x16_bf16(PAFC(PC,3),VFR(7),o[1],0,0,0), cS0,14, CAT(PN,1),3); VNX(7); \
    GAPB3(o[2]=__builtin_amdgcn_mfma_f32_32x32x16_bf16(PAFC(PC,0),VFR(8),o[2],0,0,0), cS1,0, CAT(PN,2),0); VNX(8); \
    GAPB3(o[3]=__builtin_amdgcn_mfma_f32_32x32x16_bf16(PAFC(PC,0),VFR(9),o[3],0,0,0), cS1,2, CAT(PN,2),1); VNX(9); \
    GAPB3(o[2]=__builtin_amdgcn_mfma_f32_32x32x16_bf16(PAFC(PC,1),VFR(10),o[2],0,0,0), cS1,4, CAT(PN,2),2); VNX(10); \
    GAPB3(o[3]=__builtin_amdgcn_mfma_f32_32x32x16_bf16(PAFC(PC,1),VFR(11),o[3],0,0,0), cS1,6, CAT(PN,2),3); VNX(11); \
    GAPB3(o[2]=__builtin_amdgcn_mfma_f32_32x32x16_bf16(PAFC(PC,2),VFR(12),o[2],0,0,0), cS1,8, CAT(PN,3),0); VNX(12); \
    GAPB3(o[3]=__builtin_amdgcn_mfma_f32_32x32x16_bf16(PAFC(PC,2),VFR(13),o[3],0,0,0), cS1,10, CAT(PN,3),1); VNX(13); \
    GAPB3(o[2]=__builtin_amdgcn_mfma_f32_32x32x16_bf16(PAFC(PC,3),VFR(14),o[2],0,0,0), cS1,12, CAT(PN,3),2); VNX(14); \
    GAPB3(o[3]=__builtin_amdgcn_mfma_f32_32x32x16_bf16(PAFC(PC,3),VFR(15),o[3],0,0,0), cS1,14, CAT(PN,3),3); VNX(15); \
    l_reg+=sacc; \
    }while(0)
  int t=1;
  #undef CMASK
  #define CMASK(P0,P1,t) do{}while(0)
  for(;t+5<NT;t+=2){
    STEP(pwa,pwb,t,true,true,true);     WAIT_BAR(3); RESC(); ROT();
    STEP(pwb,pwa,t+1,true,true,true);   WAIT_BAR(3); RESC(); ROT();
  }
  #undef CMASK
  #define CMASK(P0,P1,t) do{int jb_=(t)-(NT-4); if(jb_>=0)bmask(P0,P1,jb_,wch,il,hi,s2x2);}while(0)
  #define ENDW(tt) do{ if((tt)+3<NT){WAIT_BAR(3);} else if((tt)+2<NT){WAIT_BAR(2);} else {WAIT_BAR(0);} }while(0)
  for(;t+1<NT;t+=2){
    STEP(pwa,pwb,t,(t+3<NT),(t+1<NT),(t+1<NT));       ENDW(t);   RESC(); ROT();
    STEP(pwb,pwa,t+1,(t+4<NT),(t+2<NT),(t+2<NT));     ENDW(t+1); RESC(); ROT();
  }
  STEP(pwa,pwb,NT-1,false,false,false); RESC();
  SBAR(); pv(o,vb0+2*sl_cur,PAFC(pwb,0),PAFC(pwb,1),PAFC(pwb,2),PAFC(pwb,3));
  #undef PKW
  #undef PAFC
  #undef CAT
  #undef CAT_
  #undef QK
  #undef GAPB3
  #undef VFR
  #undef PIN_
  #undef MX3
  #undef EX
  #undef VRD
  #undef VNX
  #undef VOFF
  #undef GAPB2
  #undef KRD
  #undef STEP
  #undef ENDW
  {auto rr=__builtin_amdgcn_permlane32_swap(__float_as_uint(l_reg),__float_as_uint(l_reg),false,false);l_reg=__uint_as_float(rr[0])+__uint_as_float(rr[1]);}
  {
    const int le=lane_now(), r32e=le&31, hie=le>>5;
    float*wsfe=(float*)(shm+LDS_WS)+wid*64;
    if(hie==0)wsfe[32+r32e]=l_reg;asm volatile("s_waitcnt lgkmcnt(0)":::"memory");
    float rli[16];
    #pragma unroll
    for(int r=0;r<16;++r)rli[r]=__builtin_amdgcn_rcpf(wsfe[32+crow(r,hie)]);
    bf16_t*Ow=Ob+(long)(q0+wid*QBLK)*POUT;
    bf16_t*stg=(bf16_t*)(shm+LDS_OST)+wid*4096;
    #pragma unroll
    for(int r=0;r<16;++r){const int orow=crow(r,hie);
      #pragma unroll
      for(int d0=0;d0<4;++d0)stg[orow*128+d0*32+r32e]=(bf16_t)f2bf(o[d0][r]*rli[r]);}
    asm volatile("s_waitcnt lgkmcnt(0)":::"memory");
    #pragma unroll
    for(int i=0;i<8;++i){const int row=i*4+(le>>4),ch=le&15; const u32x4 v=*(const u32x4*)(stg+row*128+ch*8); ATTN_STORE16(Ow+(long)row*POUT+ch*8,v);} }
  asm volatile("s_waitcnt lgkmcnt(0)\n\ts_barrier":::"memory");
  #undef DMA_K
  #undef DMA_V
  #undef CMASK
  #undef CINIT0
  #undef CINIT1
  #undef START
  #undef RESC
  #undef ROT
}
#undef SBAR
#undef WAIT_BAR
}

__device__ __forceinline__ void attn_phase(const Frame& F, const Args& a) {
    const bf16_t* proj = (const bf16_t*)(a.ws + WS_PROJ); bf16_t* OA = (bf16_t*)(a.ws + WS_OA);
    const int vcu = (F.G % 8 == 0) ? (F.bid % 8) * (F.G / 8) + F.bid / 8 : F.bid;
    for (int i = 0;; ++i) {
        int bhm, qb;
        if (F.G == 256) { if (i >= 2) break; const int s_ = vcu & 7; bhm = vcu >> 3; qb = (i == 0) ? 15 - s_ : s_; }
        else { const int u = i * F.G + F.bid; if (u >= 512) break; bhm = u >> 4; qb = 15 - (u & 15); }
        const int b = bhm >> 3, h = (bhm >> 1) & 3, map = bhm & 1;
        const bf16_t* base = proj + (size_t)b * SEQ * INC;
        const float slope2 = exp2f(-2.0f * (h + 1)) * 1.4426950408889634f;
        attn_body::attn_unit<8>(qb, base + C_QDA + h * 128 + map * 64, base + C_KDA + h * 128 + map * 64, base + C_VDA + h * 128,
                                OA + (size_t)b * SEQ * 1024 + h * 256 + map * 128, slope2, (char*)F.lds);
    }
}
__device__ __forceinline__ void attn_combine(const Frame& F, const Args& a) {
    const bf16_t* OA = (const bf16_t*)(a.ws + WS_OA); bf16_t* Y = (bf16_t*)(a.ws + WS_YDA);
    const float lam = ((const float*)(a.ws + WS_SMALL))[0];
    const float g0 = a.in[I_SUBG][2 * F.lane] * 0.8f, g1 = a.in[I_SUBG][2 * F.lane + 1] * 0.8f;
    const int gw = F.bid * NWAVES + F.wave, NGW = F.G * NWAVES;
    for (int rb = gw; rb < T; rb += 4 * NGW) {
        unsigned w0[4][4], w1[4][4];
#pragma unroll
        for (int q = 0; q < 4; ++q) { const int r = rb + q * NGW < T ? rb + q * NGW : rb; const unsigned* orow = (const unsigned*)(OA + (size_t)r * 1024);
#pragma unroll
            for (int h = 0; h < 4; ++h) { w0[q][h] = __builtin_nontemporal_load(orow + h * 128 + F.lane); w1[q][h] = __builtin_nontemporal_load(orow + h * 128 + 64 + F.lane); } }
#pragma unroll
        for (int q = 0; q < 4; ++q) { const int r = rb + q * NGW; if (r >= T) break;
            unsigned* yrow = (unsigned*)(Y + (size_t)r * 512);
#pragma unroll
            for (int h = 0; h < 4; ++h) {
                const float x0 = bf2f(w0[q][h] & 0xffffu) - lam * bf2f(w1[q][h] & 0xffffu), x1 = bf2f(w0[q][h] >> 16) - lam * bf2f(w1[q][h] >> 16);
                const float rs = rsqrtf(wave_sum(x0 * x0 + x1 * x1) * (1.0f / 128.0f) + EPS);
                yrow[h * 64 + F.lane] = pk2(x0 * rs * g0, x1 * rs * g1);
            } }
    }
}
namespace hg {
constexpr int QP = 136;
constexpr int L_QD = 0, L_KD = 64 * QP * 2, L_V = 2 * 64 * QP * 2, L_KE = 3 * 64 * QP * 2, L_SSQ = 4 * 64 * QP * 2, L_G = L_SSQ + 512, L_ST = L_G + 64 * QP * 2;
__device__ __forceinline__ f32x4 mfma16(bf16x8 a, bf16x8 b, f32x4 c) { return __builtin_amdgcn_mfma_f32_16x16x32_bf16(a, b, c, 0, 0, 0); }
#define HG_BAR() do { asm volatile("s_waitcnt lgkmcnt(0)" ::: "memory"); __builtin_amdgcn_s_barrier(); asm volatile("" ::: "memory"); } while (0)
typedef short v4i16_t __attribute__((ext_vector_type(4)));
__device__ __forceinline__ bf16x8 tr8(const LAS unsigned char* img, int ra, int rb, int col0, int lane) {
    const int q = (lane & 15) >> 2, p = lane & 3;
    const v4i16_t lo = __builtin_amdgcn_ds_read_tr16_b64_v4i16((LAS v4i16_t*)(img + ((ra + q) * QP + col0 + 4 * p) * 2));
    const v4i16_t hi = __builtin_amdgcn_ds_read_tr16_b64_v4i16((LAS v4i16_t*)(img + ((rb + q) * QP + col0 + 4 * p) * 2));
    return (bf16x8){lo[0], lo[1], lo[2], lo[3], hi[0], hi[1], hi[2], hi[3]};
}
struct Tile { u32x4 p[2]; };
__device__ __forceinline__ void tile_load(Tile& t, const bf16_t* src, size_t pitch, int tid) {
#pragma unroll
    for (int i = 0; i < 2; ++i) { const int pc = tid + NTHR * i; t.p[i] = *(const u32x4*)(src + (size_t)(pc >> 4) * pitch + (pc & 15) * 8); }
}
__device__ __forceinline__ void tile_put(const Tile& t, LAS unsigned char* img, int tid) {
#pragma unroll
    for (int i = 0; i < 2; ++i) { const int pc = tid + NTHR * i; *(LAS u32x4*)(img + ((pc >> 4) * QP + (pc & 15) * 8) * 2) = t.p[i]; }
}
__device__ __forceinline__ void tile_get(Tile& t, const LAS unsigned char* img, int tid) {
#pragma unroll
    for (int i = 0; i < 2; ++i) { const int pc = tid + NTHR * i; t.p[i] = *(const LAS u32x4*)(img + ((pc >> 4) * QP + (pc & 15) * 8) * 2); }
}
__device__ __forceinline__ void tile_store(const Tile& t, bf16_t* dst, size_t pitch, int tid) {
#pragma unroll
    for (int i = 0; i < 2; ++i) { const int pc = tid + NTHR * i; *(u32x4*)(dst + (size_t)(pc >> 4) * pitch + (pc & 15) * 8) = t.p[i]; }
}
constexpr int PP = 72;
constexpr int G4_L_P = 4 * 64 * QP * 2, G4_L_DEC = G4_L_P + 64 * PP * 2, G4_L_SSQ = G4_L_DEC + 512, G4_L_DEC4 = G4_L_SSQ + 2048;
struct InA { Tile qd, kd, ke, v; };
__device__ __forceinline__ void loadA(InA& r, const Frame& F, const Args& a, int bh, int n) {
    const int b = bh >> 2, h = bh & 3; const size_t t0 = (size_t)b * SEQ + n * 64;
    const bf16_t* base = (const bf16_t*)(a.ws + WS_PROJ) + t0 * INC;
    tile_load(r.qd, base + C_HGT + 256 * h, INC, F.tid); tile_load(r.kd, base + C_HGT + 256 * h + 128, INC, F.tid);
    tile_load(r.ke, (const bf16_t*)a.out + t0 * 512 + h * 128, 512, F.tid); tile_load(r.v, base + C_IHG + h * 128, INC, F.tid);
}
#define G4_DEC_LOAD()  const int dcq_ = (F.tid >> 5) & 3; const f32x4 dv_ = *(const f32x4*)((const float*)(a.ws + WS_DEC) + ((size_t)bh * 64 + n0 + dcq_) * 128 + 4 * (F.tid & 31))
#define G4_DEC_PUT()   *(LAS f32x4*)(F.lds + G4_L_DEC4 + dcq_ * 512 + 16 * (F.tid & 31)) = dv_
__device__ __forceinline__ void grp_local(const Frame& F, const Args& a, int grp) {
    const int bh = grp >> 4, n0 = 4 * (grp & 15), b = bh >> 2, h = bh & 3, w = F.wave, lane = F.lane, fr = lane & 15, fq = lane >> 4;
    for (int i = F.tid; i < 64 * PP / 2; i += NTHR) ((LAS unsigned*)(F.lds + G4_L_P))[i] = 0u;
    f32x4 S[8];
#pragma unroll
    for (int kt = 0; kt < 8; ++kt) S[kt] = (f32x4){0.f, 0.f, 0.f, 0.f};
    G4_DEC_LOAD();
    InA c4[3];
    loadA(c4[0], F, a, bh, n0); loadA(c4[1], F, a, bh, n0 + 1);
    G4_DEC_PUT();
#define G4_STORE(nn) do { Tile ot_; tile_get(ot_, F.lds + L_KD, F.tid); tile_store(ot_, (bf16_t*)(a.ws + WS_YHG) + ((size_t)b * SEQ + (nn) * 64) * 512 + h * 128, 512, F.tid); } while (0)
#pragma unroll
    for (int j = 0; j < 4; ++j) {
        InA& cur = c4[j % 3];
        if (j > 0) G4_STORE(n0 + j - 1);
        if (j + 2 < 4) loadA(c4[(j + 2) % 3], F, a, bh, n0 + j + 2);
        tile_put(cur.qd, F.lds + L_QD, F.tid); tile_put(cur.kd, F.lds + L_KD, F.tid); tile_put(cur.ke, F.lds + L_KE, F.tid); tile_put(cur.v, F.lds + L_V, F.tid);
        HG_BAR();
#pragma unroll
        for (int rep = 0; rep < 2; ++rep) { const int pi = w + 8 * rep;
            if (pi < 10) { const int tb = pi >= 6 ? 3 : pi >= 3 ? 2 : pi >= 1 ? 1 : 0, jt = pi - (tb * (tb + 1)) / 2;
                f32x4 sc = (f32x4){0.f, 0.f, 0.f, 0.f};
#pragma unroll
                for (int ks = 0; ks < 4; ++ks) { const bf16x8 kf = *(const LAS bf16x8*)(F.lds + L_KD + ((16 * jt + fr) * QP + 32 * ks + 8 * fq) * 2);
                    const bf16x8 qf = *(const LAS bf16x8*)(F.lds + L_QD + ((16 * tb + fr) * QP + 32 * ks + 8 * fq) * 2); sc = mfma16(kf, qf, sc); }
                if (jt == tb) {
#pragma unroll
                    for (int r = 0; r < 4; ++r) if (4 * fq + r > fr) sc[r] = 0.f;
                }
                *(LAS u32x2*)(F.lds + G4_L_P + ((16 * tb + fr) * PP + 16 * jt + 4 * fq) * 2) = (u32x2){cvt_pk_bf16(sc[0], sc[1]), cvt_pk_bf16(sc[2], sc[3])}; } }
        HG_BAR();
        bf16x8 bv[2];
#pragma unroll
        for (int s2 = 0; s2 < 2; ++s2) bv[s2] = tr8(F.lds + L_V, 32 * s2 + 8 * fq, 32 * s2 + 8 * fq + 4, 16 * w, lane);
        bf16x8 Sb[4];
#pragma unroll
        for (int ks = 0; ks < 4; ++ks) { const u32x4 t = (u32x4){cvt_pk_bf16(S[2 * ks][0], S[2 * ks][1]), cvt_pk_bf16(S[2 * ks][2], S[2 * ks][3]), cvt_pk_bf16(S[2 * ks + 1][0], S[2 * ks + 1][1]), cvt_pk_bf16(S[2 * ks + 1][2], S[2 * ks + 1][3])};
            Sb[ks] = __builtin_bit_cast(bf16x8, t); }
#pragma unroll
        for (int tb = 0; tb < 4; ++tb) { f32x4 o = (f32x4){0.f, 0.f, 0.f, 0.f};
#pragma unroll
            for (int s2 = 0; s2 <= (tb >> 1); ++s2) { const bf16x8 pf = *(const LAS bf16x8*)(F.lds + G4_L_P + ((16 * tb + fr) * PP + 32 * s2 + 8 * fq) * 2); o = mfma16(pf, bv[s2], o); }
            if (j > 0) {
#pragma unroll
                for (int ks = 0; ks < 4; ++ks) { const LAS unsigned char* qrow = F.lds + L_QD + ((16 * tb + fr) * QP + 32 * ks + 4 * fq) * 2;
                    const u32x2 lo = *(const LAS u32x2*)qrow, hi = *(const LAS u32x2*)(qrow + 32);
                    const u32x4 aw = (u32x4){lo.x, lo.y, hi.x, hi.y}; o = mfma16(__builtin_bit_cast(bf16x8, aw), Sb[ks], o); } }
#pragma unroll
            for (int r = 0; r < 4; ++r) *(LAS unsigned short*)(F.lds + L_KD + ((16 * tb + 4 * fq + r) * QP + 16 * w + fr) * 2) = (unsigned short)f2bf(o[r]); }
#pragma unroll
        for (int kt = 0; kt < 8; ++kt) { S[kt] = S[kt] * *(const LAS f32x4*)(F.lds + G4_L_DEC4 + j * 512 + (16 * kt + 4 * fq) * 4);
#pragma unroll
            for (int s2 = 0; s2 < 2; ++s2) S[kt] = mfma16(tr8(F.lds + L_KE, 32 * s2 + 8 * fq, 32 * s2 + 8 * fq + 4, 16 * kt, lane), bv[s2], S[kt]); }
        HG_BAR();
    }
    G4_STORE(n0 + 3);
#undef G4_STORE
    f32x4* sg = (f32x4*)(a.ws + WS_DS) + ((size_t)grp * 64 + w * 8) * 64 + lane;
#pragma unroll
    for (int kt = 0; kt < 8; ++kt) sg[kt * 64] = S[kt];
}
__device__ __forceinline__ void grp_scan(const Frame& F, const Args& a) {
    const f32x2* sg = (const f32x2*)(a.ws + WS_DS); f32x2* si = (f32x2*)(a.ws + WS_DS) + (size_t)256 * 8192; const float* dec = (const float*)(a.ws + WS_DEC);
    for (int gt = F.bid * NTHR + F.tid; gt < 16 * 8192; gt += F.G * NTHR) {
        const int bh = gt >> 13, s2 = gt & 8191, slot = s2 >> 1, kt = (slot >> 6) & 7, lane = slot & 63, k = 16 * kt + 4 * (lane >> 4) + 2 * (s2 & 1);
        f32x2 cur = (f32x2){0.f, 0.f};
#pragma unroll
        for (int gh = 0; gh < 2; ++gh) {
            f32x2 sv[8], d[8];
#pragma unroll
            for (int g8 = 0; g8 < 8; ++g8) { const int g = 8 * gh + g8;
                sv[g8] = __builtin_nontemporal_load(sg + ((size_t)(bh * 16 + g)) * 8192 + s2);
                const float* dp = dec + ((size_t)bh * 64 + 4 * g) * 128 + k;
                d[g8] = (*(const f32x2*)dp * *(const f32x2*)(dp + 128)) * (*(const f32x2*)(dp + 256) * *(const f32x2*)(dp + 384)); }
#pragma unroll
            for (int g8 = 0; g8 < 8; ++g8) { const int g = 8 * gh + g8;
                si[((size_t)(bh * 16 + g)) * 8192 + s2] = cur;
                cur = d[g8] * cur + sv[g8]; }
        }
    }
}
struct InC { Tile qd, g, ol; };
__device__ __forceinline__ void loadC(InC& r, const Frame& F, const Args& a, int bh, int n) {
    const int b = bh >> 2, h = bh & 3; const size_t t0 = (size_t)b * SEQ + n * 64;
    const bf16_t* base = (const bf16_t*)(a.ws + WS_PROJ) + t0 * INC;
    tile_load(r.qd, base + C_HGT + 256 * h, INC, F.tid); tile_load(r.g, base + C_GHG + h * 128, INC, F.tid);
    tile_load(r.ol, (const bf16_t*)(a.ws + WS_YHG) + t0 * 512 + h * 128, 512, F.tid);
}
__device__ __forceinline__ void grp_final(const Frame& F, const Args& a, int grp) {
    const int bh = grp >> 4, n0 = 4 * (grp & 15), b = bh >> 2, h = bh & 3, w = F.wave, lane = F.lane, fr = lane & 15, fq = lane >> 4;
    f32x4 S[8];
    { const f32x4* si = (const f32x4*)(a.ws + WS_DS) + (size_t)256 * 4096 + ((size_t)grp * 64 + w * 8) * 64 + lane;
#pragma unroll
      for (int kt = 0; kt < 8; ++kt) S[kt] = si[kt * 64]; }
    const float ng = a.in[I_HGNG][16 * w + fr];
    LAS float* SSQ = (LAS float*)(F.lds + G4_L_SSQ);
    G4_DEC_LOAD();
    InC cur, nxt; loadC(cur, F, a, bh, n0);
    G4_DEC_PUT();
#define G4_STORE(nn) do { Tile ot_; tile_get(ot_, F.lds + L_V, F.tid); tile_store(ot_, (bf16_t*)(a.ws + WS_YHG) + ((size_t)b * SEQ + (nn) * 64) * 512 + h * 128, 512, F.tid); } while (0)
    for (int j = 0; j < 4; ++j) {
        if (j > 0) G4_STORE(n0 + j - 1);
        loadC(nxt, F, a, bh, n0 + (j < 3 ? j + 1 : 3));
        tile_put(cur.qd, F.lds + L_QD, F.tid); tile_put(cur.g, F.lds + L_KD, F.tid); tile_put(cur.ol, F.lds + L_V, F.tid);
        HG_BAR();
        bf16x8 Sb[4];
#pragma unroll
        for (int ks = 0; ks < 4; ++ks) { const u32x4 t = (u32x4){cvt_pk_bf16(S[2 * ks][0], S[2 * ks][1]), cvt_pk_bf16(S[2 * ks][2], S[2 * ks][3]), cvt_pk_bf16(S[2 * ks + 1][0], S[2 * ks + 1][1]), cvt_pk_bf16(S[2 * ks + 1][2], S[2 * ks + 1][3])};
            Sb[ks] = __builtin_bit_cast(bf16x8, t); }
        f32x4 o[4];
#pragma unroll
        for (int tb = 0; tb < 4; ++tb) {
#pragma unroll
            for (int r = 0; r < 4; ++r) o[tb][r] = bf2f(*(const LAS unsigned short*)(F.lds + L_V + ((16 * tb + 4 * fq + r) * QP + 16 * w + fr) * 2));
#pragma unroll
            for (int ks = 0; ks < 4; ++ks) { const LAS unsigned char* qrow = F.lds + L_QD + ((16 * tb + fr) * QP + 32 * ks + 4 * fq) * 2;
                const u32x2 lo = *(const LAS u32x2*)qrow, hi = *(const LAS u32x2*)(qrow + 32);
                const u32x4 aw = (u32x4){lo.x, lo.y, hi.x, hi.y}; o[tb] = mfma16(__builtin_bit_cast(bf16x8, aw), Sb[ks], o[tb]); }
#pragma unroll
            for (int r = 0; r < 4; ++r) { const float v = scan16(o[tb][r] * o[tb][r]); if (fr == 15) SSQ[w * 64 + 16 * tb + 4 * fq + r] = v; } }
#pragma unroll
        for (int kt = 0; kt < 8; ++kt) S[kt] = S[kt] * *(const LAS f32x4*)(F.lds + G4_L_DEC4 + j * 512 + (16 * kt + 4 * fq) * 4);
        HG_BAR();
#pragma unroll
        for (int tb = 0; tb < 4; ++tb) { f32x4 tot = (f32x4){0.f, 0.f, 0.f, 0.f};
#pragma unroll
            for (int ww = 0; ww < 8; ++ww) tot += *(const LAS f32x4*)(SSQ + ww * 64 + 16 * tb + 4 * fq);
#pragma unroll
            for (int r = 0; r < 4; ++r) { const float rs = rsqrtf(tot[r] * (1.0f / 128.0f) + EPS); const float g = bf2f(*(const LAS unsigned short*)(F.lds + L_KD + ((16 * tb + 4 * fq + r) * QP + 16 * w + fr) * 2));
                *(LAS unsigned short*)(F.lds + L_V + ((16 * tb + 4 * fq + r) * QP + 16 * w + fr) * 2) = (unsigned short)f2bf(o[tb][r] * rs * ng * g * __builtin_amdgcn_rcpf(1.0f + __builtin_amdgcn_exp2f(-1.4426950408889634f * g))); } }
        HG_BAR();
        cur = nxt;
    }
    G4_STORE(n0 + 3);
#undef G4_STORE
}
#undef HG_BAR
}

__device__ __forceinline__ float rs4(float a0, float a1, float a2, float a3, int lane) {
    const bool hi = (lane & 32) != 0;
    const float s0 = hi ? a0 : a2, s1 = hi ? a1 : a3;
    const float k0 = (hi ? a2 : a0) + __shfl_xor(s0, 32), k1 = (hi ? a3 : a1) + __shfl_xor(s1, 32);
    const bool b4 = (lane & 16) != 0;
    const float sd = b4 ? k0 : k1;
    float k = (b4 ? k1 : k0) + __shfl_xor(sd, 16);
    k += __shfl_xor(k, 8); k += __shfl_xor(k, 4); k += __shfl_xor(k, 2); k += __shfl_xor(k, 1);
    return k;
}
__device__ __forceinline__ void phase_router(const Frame& F, const Args& a) {
    constexpr int AP = 1032;
    LAS bf16_t* AH = (LAS bf16_t*)F.lds;
    LAS bf16_t* AL = AH + 16 * AP;
    LAS float* PART = (LAS float*)(F.lds + 2 * 16 * AP * 2);
    LAS float* LG = PART + 8 * 16 * 48;
    LAS unsigned* LH = (LAS unsigned*)(LG + 16 * 48);
    LAS unsigned* LB = LH + 32;
    LAS unsigned* LR = LH + 64;
    if (F.tid < NEXP) LH[F.tid] = 0u;
    const float* mod = (const float*)(a.ws + WS_MOD);
    const bf16_t* x1 = (const bf16_t*)(a.ws + WS_X1B); bf16_t* H2 = (bf16_t*)(a.ws + WS_ACT);
    unsigned* counts = (unsigned*)(a.ws + WS_CTL) + CW_COUNTS; unsigned* tokinfo = (unsigned*)(a.ws + WS_TOKINFO); int* toklist = (int*)(a.ws + WS_TOKLIST);
    const int rows_per_blk = T / F.G, r0 = F.bid * rows_per_blk, b = r0 / SEQ;
    const int lane = F.lane, w = F.wave, fr = lane & 15, fq = lane >> 4;
    f32x4 v[2][4], vn[2][4];
#define RT_LOAD(V, rb_) do { _Pragma("unroll") for (int q = 0; q < 2; ++q) { const u32x2* xr_ = (const u32x2*)(x1 + (size_t)((rb_) + 2 * w + q) * D) + lane; \
        _Pragma("unroll") for (int j = 0; j < 4; ++j) { const u32x2 t_ = xr_[64 * j]; V[q][j] = (f32x4){bf2f(t_.x & 0xffffu), bf2f(t_.x >> 16), bf2f(t_.y & 0xffffu), bf2f(t_.y >> 16)}; } } } while (0)
    RT_LOAD(v, r0);
    bf16x8 Bh[4][3], Bl[4][3];
    {
        const float* wre = a.in[I_WRE]; const float* wrg = a.in[I_WRG];
#pragma unroll
        for (int ks = 0; ks < 4; ++ks)
#pragma unroll
            for (int ct = 0; ct < 3; ++ct) {
                unsigned hw[4], lw[4];
#pragma unroll
                for (int jp = 0; jp < 4; ++jp) { float x[2];
#pragma unroll
                    for (int z = 0; z < 2; ++z) { const int k = 128 * w + 32 * ks + 8 * fq + 2 * jp + z;
                        if (ct == 0) { const float g = wrg[k * 4 + (fr & 3)], e = wre[k * 32 + ((fr + 28) & 31)]; x[z] = fr < 4 ? g : e; }
                        else if (ct == 1) x[z] = wre[k * 32 + 12 + fr];
                        else { const float e = wre[k * 32 + 28 + (fr & 3)]; x[z] = fr < 4 ? e : 0.f; } }
                    const unsigned h0 = f2bf(x[0]), h1 = f2bf(x[1]); hw[jp] = h0 | (h1 << 16);
                    lw[jp] = pk2(x[0] - bf2f(h0), x[1] - bf2f(h1)); }
                Bh[ks][ct] = __builtin_bit_cast(bf16x8, (u32x4){hw[0], hw[1], hw[2], hw[3]}); Bl[ks][ct] = __builtin_bit_cast(bf16x8, (u32x4){lw[0], lw[1], lw[2], lw[3]});
            }
    }
    f32x4 ggv[4], shv[4];
#pragma unroll
    for (int j = 0; j < 4; ++j) { const int k = 256 * j + 4 * lane;
        ggv[j] = *(const f32x4*)(a.in[I_N2G] + k) * (1.0f + *(const f32x4*)(mod + b * 6144 + 4 * 1024 + k)); shv[j] = *(const f32x4*)(mod + b * 6144 + 3 * 1024 + k); }
    for (int g = 0; g < rows_per_blk / 16; ++g) {
        const int rg = r0 + 16 * g;
        { const int gn = g + 1 < rows_per_blk / 16 ? g + 1 : g; RT_LOAD(vn, r0 + 16 * gn); }
#pragma unroll
        for (int q = 0; q < 2; ++q) { float sq = 0.f;
#pragma unroll
            for (int j = 0; j < 4; ++j) sq += (v[q][j].x * v[q][j].x + v[q][j].y * v[q][j].y) + (v[q][j].z * v[q][j].z + v[q][j].w * v[q][j].w);
            const float rs = rsqrtf(wave_sum(sq) * (1.0f / D) + EPS); const int row = 2 * w + q;
#pragma unroll
            for (int j = 0; j < 4; ++j) { const int k = 256 * j + 4 * lane;
                const f32x4 hv = v[q][j] * rs * ggv[j] + shv[j];
                const unsigned h0 = f2bf(hv.x), h1 = f2bf(hv.y), h2_ = f2bf(hv.z), h3 = f2bf(hv.w);
                const u32x2 hw = (u32x2){h0 | (h1 << 16), h2_ | (h3 << 16)};
                *(u32x2*)(H2 + (size_t)(rg + row) * D + k) = hw;
                *(LAS u32x2*)(AH + row * AP + k) = hw;
                *(LAS u32x2*)(AL + row * AP + k) = (u32x2){pk2(hv.x - bf2f(h0), hv.y - bf2f(h1)), pk2(hv.z - bf2f(h2_), hv.w - bf2f(h3))}; } }
        __syncthreads();
        f32x4 acc[3] = {{0.f, 0.f, 0.f, 0.f}, {0.f, 0.f, 0.f, 0.f}, {0.f, 0.f, 0.f, 0.f}};
#pragma unroll
        for (int ks = 0; ks < 4; ++ks) { const bf16x8 ah = *(const LAS bf16x8*)(AH + fr * AP + 128 * w + 32 * ks + 8 * fq), al = *(const LAS bf16x8*)(AL + fr * AP + 128 * w + 32 * ks + 8 * fq);
#pragma unroll
            for (int ct = 0; ct < 3; ++ct) { acc[ct] = __builtin_amdgcn_mfma_f32_16x16x32_bf16(ah, Bh[ks][ct], acc[ct], 0, 0, 0);
                acc[ct] = __builtin_amdgcn_mfma_f32_16x16x32_bf16(al, Bh[ks][ct], acc[ct], 0, 0, 0); acc[ct] = __builtin_amdgcn_mfma_f32_16x16x32_bf16(ah, Bl[ks][ct], acc[ct], 0, 0, 0); } }
#pragma unroll
        for (int ct = 0; ct < 3; ++ct)
#pragma unroll
            for (int r = 0; r < 4; ++r) PART[(w * 16 + 4 * fq + r) * 48 + 16 * ct + fr] = acc[ct][r];
        __syncthreads();
        for (int t = F.tid; t < 16 * 48; t += NTHR) { const int row = t / 48, o = t % 48; float sacc = 0.f;
#pragma unroll
            for (int ww = 0; ww < 8; ++ww) sacc += PART[(ww * 16 + row) * 48 + o];
            if (o < 36) LG[row * 48 + o] = sacc + (o < 4 ? a.in[I_BRG][o & 3] : a.in[I_BRE][(o + 28) & 31]); }
        __syncthreads();
        if (F.tid < 16) {
            const LAS float* lg = LG + F.tid * 48;
            float gl[4]; int gi = 0;
#pragma unroll
            for (int o = 0; o < 4; ++o) gl[o] = lg[o];
            float gm = gl[0];
#pragma unroll
            for (int o = 1; o < 4; ++o) if (gl[o] > gm) { gm = gl[o]; gi = o; }
            float gsum = 0.f;
#pragma unroll
            for (int o = 0; o < 4; ++o) gsum += expf(gl[o] - gm);
            const float gp = 1.0f / gsum;
            float el[8];
#pragma unroll
            for (int e = 0; e < 8; ++e) el[e] = lg[4 + gi * 8 + e];
            int i0 = 0; float m0 = el[0];
#pragma unroll
            for (int o = 1; o < 8; ++o) if (el[o] > m0) { m0 = el[o]; i0 = o; }
            int i1 = -1; float m1 = -INFINITY;
#pragma unroll
            for (int o = 0; o < 8; ++o) if (o != i0 && el[o] > m1) { m1 = el[o]; i1 = o; }
            const float e1 = expf(m1 - m0); const float w0 = gp / (1.0f + e1), w1 = gp * e1 / (1.0f + e1);
            const int rl = 16 * g + F.tid, ex0 = gi * 8 + i0, ex1 = gi * 8 + i1;
            const unsigned l0 = atomicAdd((unsigned*)(LH + ex0), 1u), l1 = atomicAdd((unsigned*)(LH + ex1), 1u);
            LAS unsigned* ri = LR + rl * 6;
            ri[0] = (unsigned)ex0; ri[1] = l0; ri[2] = (unsigned)ex1; ri[3] = l1; ri[4] = __float_as_uint(w0); ri[5] = __float_as_uint(w1);
        }
#pragma unroll
        for (int q = 0; q < 2; ++q)
#pragma unroll
            for (int j = 0; j < 4; ++j) v[q][j] = vn[q][j];
    }
#undef RT_LOAD
    __syncthreads();
    if (F.tid < NEXP) LB[F.tid] = atomicAdd(counts + 64 * F.tid, LH[F.tid]);
    __syncthreads();
    for (int rl = F.tid; rl < rows_per_blk; rl += NTHR) {
        const LAS unsigned* ri = LR + rl * 6; const int r = r0 + rl;
        const unsigned ex0 = ri[0], ex1 = ri[2], k0 = LB[ex0] + ri[1], k1 = LB[ex1] + ri[3];
        toklist[ex0 * T + k0] = r; toklist[ex1 * T + k1] = r;
        u32x4 t0; t0.x = ex0; t0.y = k0; t0.z = ex1; t0.w = k1;
        *(u32x4*)(tokinfo + (size_t)r * 8) = t0;
        tokinfo[(size_t)r * 8 + 4] = ri[4]; tokinfo[(size_t)r * 8 + 5] = ri[5];
    }
}
__device__ __forceinline__ void build_moe_tab(const Frame& F, const Args& a, LAS MoeTab* tab) {
    if (F.wave == 0) {
        const unsigned* counts = (const unsigned*)(a.ws + WS_CTL) + CW_COUNTS;
        const int e = F.lane & 31;
        const int c = (int)__hip_atomic_load(counts + 64 * e, __ATOMIC_RELAXED, __HIP_MEMORY_SCOPE_AGENT);
        const int n = (c + 255) >> 8; int incl = n;
#pragma unroll
        for (int d = 1; d < 32; d <<= 1) { const int t = __shfl_up(incl, d, 32); if (e >= d) incl += t; }
        const int base = incl - n;
        if (F.lane < 32) { tab->cnt[e] = c; tab->tbase[e] = base;
            for (int m = 0; m < n; ++m) { tab->tile_e[base + m] = e; tab->tile_m[base + m] = m; } }
        if (F.lane == 31) { tab->tbase[NEXP] = incl; tab->nt = incl; }
    }
    __syncthreads();
}
__device__ __forceinline__ void phase_final(const Frame& F, const Args& a, const LAS MoeTab* tab) {
    const float* mod = (const float*)(a.ws + WS_MOD); const unsigned* tokinfo = (const unsigned*)(a.ws + WS_TOKINFO); const bf16_t* Ys = (const bf16_t*)(a.ws + WS_YS);
    const int rows_per_blk = T / F.G, r0 = F.bid * rows_per_blk;
    for (int rb = r0 + F.wave; rb < r0 + rows_per_blk; rb += 4 * NWAVES) {
        u32x4 ti[4]; u32x2 tw[4];
#pragma unroll
        for (int q = 0; q < 4; ++q) { const int r = rb + q * NWAVES < r0 + rows_per_blk ? rb + q * NWAVES : rb;
            ti[q] = *(const u32x4*)(tokinfo + (size_t)r * 8); tw[q] = *(const u32x2*)(tokinfo + (size_t)r * 8 + 4); }
        u32x2 xq[4][4], a0[4][4], a1[4][4];
#pragma unroll
        for (int q = 0; q < 4; ++q) { const int r = rb + q * NWAVES < r0 + rows_per_blk ? rb + q * NWAVES : rb;
            const size_t s0 = (size_t)tab->tbase[ti[q].x] * 256 + ti[q].y, s1 = (size_t)tab->tbase[ti[q].z] * 256 + ti[q].w;
            const u32x2* xb = (const u32x2*)((const bf16_t*)(a.ws + WS_X1B) + (size_t)r * D) + F.lane;
            const u32x2* y0 = (const u32x2*)(Ys + s0 * D) + F.lane; const u32x2* y1 = (const u32x2*)(Ys + s1 * D) + F.lane;
#pragma unroll
            for (int j = 0; j < 4; ++j) { xq[q][j] = __builtin_nontemporal_load(xb + 64 * j); a0[q][j] = __builtin_nontemporal_load(y0 + 64 * j); a1[q][j] = __builtin_nontemporal_load(y1 + 64 * j); } }
#pragma unroll
        for (int q = 0; q < 4; ++q) { const int r = rb + q * NWAVES; if (r >= r0 + rows_per_blk) break;
            const int b = r / SEQ; const float w0 = __uint_as_float(tw[q].x), w1 = __uint_as_float(tw[q].y);
            f32x4* xr = (f32x4*)(a.out + (size_t)r * D) + F.lane;
            f32x4 v[4]; float s = 0.f;
#pragma unroll
            for (int j = 0; j < 4; ++j) { const int k = 256 * j + 4 * F.lane;
                const f32x4 gt = *(const f32x4*)(mod + b * 6144 + 5 * 1024 + k); const u32x2 p0 = a0[q][j], p1 = a1[q][j], px = xq[q][j];
                f32x4 m; m.x = w0 * bf2f(p0.x & 0xffffu) + w1 * bf2f(p1.x & 0xffffu); m.y = w0 * bf2f(p0.x >> 16) + w1 * bf2f(p1.x >> 16);
                m.z = w0 * bf2f(p0.y & 0xffffu) + w1 * bf2f(p1.y & 0xffffu); m.w = w0 * bf2f(p0.y >> 16) + w1 * bf2f(p1.y >> 16);
                const f32x4 xv = (f32x4){bf2f(px.x & 0xffffu), bf2f(px.x >> 16), bf2f(px.y & 0xffffu), bf2f(px.y >> 16)};
                v[j] = xv + gt * m; s += (v[j].x * v[j].x + v[j].y * v[j].y) + (v[j].z * v[j].z + v[j].w * v[j].w); }
            const float rs = rsqrtf(wave_sum(s) * (1.0f / D) + EPS);
#pragma unroll
            for (int j = 0; j < 4; ++j) { const f32x4 g = *(const f32x4*)(a.in[I_FG] + 256 * j + 4 * F.lane); __builtin_nontemporal_store(v[j] * rs * g, xr + 64 * j); } }
    }
}

#define XB_TMO      128
#define XB_XCNT(j)  (256  + 64 * (j))
#define XB_XSUB(j)  (1280 + 64 * (j))
#define XB_XGEN(j)  (2304 + 64 * (j))
#define XB_TOP      3328
#define XB_TOPGEN   3392
#define XCD_BAR_WORDS 3456
#define XB_SPIN_CAP (1u << 18)
__device__ __forceinline__ unsigned xb_ld(unsigned* p)              { return __hip_atomic_load(p, __ATOMIC_RELAXED, __HIP_MEMORY_SCOPE_AGENT); }
__device__ __forceinline__ unsigned xb_add(unsigned* p, unsigned v) { return __hip_atomic_fetch_add(p, v, __ATOMIC_RELAXED, __HIP_MEMORY_SCOPE_AGENT); }
__device__ __forceinline__ unsigned xb_xcc_id() { return (unsigned)__builtin_amdgcn_s_getreg((3 << 11) | 20) & 0xFu; }
#define XB_SPIN(cond, bar) do { unsigned _sp = 0; while (cond) { __builtin_amdgcn_s_sleep(1); \
    if ((++_sp & 255u) == 0u) { if (xb_ld(&(bar)[XB_TMO])) break; if (_sp > XB_SPIN_CAP) { atomicAdd(&(bar)[XB_TMO], 1u); break; } } } } while (0)
struct XcdBarrier { unsigned* bar; unsigned x; volatile LAS unsigned* st; };
__device__ __forceinline__ XcdBarrier xcd_barrier_post(unsigned* bar, volatile LAS unsigned* st) {
    XcdBarrier b; b.bar = bar; b.x = xb_xcc_id(); b.st = st;
    if (threadIdx.x == 0) (void)xb_add(&bar[XB_XCNT(b.x)], 1u);
    return b;
}
__device__ __forceinline__ void xcd_barrier_complete(unsigned* bar, unsigned x, unsigned& nloc, unsigned& nx) {
    const unsigned G = gridDim.x * gridDim.y * gridDim.z;
    unsigned sum, cnt, mine, sp = 0u;
    for (;;) {
        sum = 0u; cnt = 0u; mine = 0u;
#pragma unroll
        for (unsigned j = 0; j < 16; ++j) { const unsigned c = xb_ld(&bar[XB_XCNT(j)]); sum += c; cnt += (c > 0u) ? 1u : 0u; mine = (j == x) ? c : mine; }
        if (sum == G) break;
        __builtin_amdgcn_s_sleep(1);
        if ((++sp & 255u) == 0u) { if (xb_ld(&bar[XB_TMO])) break; if (sp > XB_SPIN_CAP) { atomicAdd(&bar[XB_TMO], 1u); break; } }
    }
    nloc = mine > 0u ? mine : 1u; nx = cnt > 0u ? cnt : 1u;
}
__device__ __forceinline__ void xcd_barrier(const XcdBarrier& b) {
    asm volatile("s_waitcnt vmcnt(0)" ::: "memory");
    __syncthreads();
    if (threadIdx.x == 0) {
        unsigned* bar = b.bar;
        __builtin_amdgcn_s_waitcnt(0);
        unsigned nloc = b.st[0], nx = b.st[1];
        if (nloc == 0u) { xcd_barrier_complete(bar, b.x, nloc, nx); b.st[0] = nloc; b.st[1] = nx; }
        const unsigned old = xb_add(&bar[XB_XSUB(b.x)], 1u);
        const unsigned gen = old / nloc;
        if (old + 1u == (gen + 1u) * nloc) {
            __builtin_amdgcn_fence(__ATOMIC_RELEASE, "agent");
            asm volatile("s_waitcnt vmcnt(0)" ::: "memory");
            const unsigned og = xb_add(&bar[XB_TOP], 1u);
            const unsigned tg = og / nx;
            if (og + 1u == (tg + 1u) * nx) xb_add(&bar[XB_TOPGEN], 1u);
            else XB_SPIN(xb_ld(&bar[XB_TOPGEN]) == tg, bar);
            __builtin_amdgcn_fence(__ATOMIC_ACQUIRE, "agent");
            xb_add(&bar[XB_XGEN(b.x)], 1u);
            asm volatile("s_waitcnt vmcnt(0)" ::: "memory");
        } else {
            XB_SPIN(xb_ld(&bar[XB_XGEN(b.x)]) == gen, bar);
            __builtin_amdgcn_fence(__ATOMIC_ACQUIRE, "agent");
            asm volatile("s_waitcnt vmcnt(0)" ::: "memory");
        }
    }
    __syncthreads();
}

constexpr int N_PHASES = 11;
__global__ void __launch_bounds__(NTHR, 2) mk_fwd(Args a) {
    extern __shared__ __attribute__((aligned(16))) unsigned char lds_raw[];
    Frame F; F.lds = (LAS unsigned char*)lds_raw; F.tid = threadIdx.x; F.lane = F.tid & 63; F.wave = __builtin_amdgcn_readfirstlane(F.tid >> 6); F.G = gridDim.x; F.bid = blockIdx.x;
    unsigned char* ws = a.ws;
    const int lo = a.ph_lo, hi = a.ph_hi;
#if MK_N_LAUNCHES == 1
    volatile LAS unsigned* MISC = (volatile LAS unsigned*)(F.lds + 152 * 1024);
    if (F.tid < 4) MISC[F.tid] = 0u;
    __syncthreads();
    XcdBarrier xbar = xcd_barrier_post((unsigned*)(ws + WS_CTL) + CW_BAR, MISC);
#define SEAM(k) do { if (IN(k) && IN((k) + 1)) xcd_barrier(xbar); } while (0)
#else
#define SEAM(k) do { } while (0)
#endif
#define IN(k) (lo <= (k) && (k) < hi)
    LAS MoeTab* tab = (LAS MoeTab*)(F.lds + 144 * 1024);

#define RUNPH(k, ...) if (IN(k)) { F.lane = lane_now(); F.tid = F.wave * 64 + F.lane; __VA_ARGS__ }
    RUNPH(0, { phase0(F, a); }) SEAM(0);
    RUNPH(1, { phase1(F, a); __syncthreads(); dense_weight_convert(F, a); }) SEAM(1);
    RUNPH(2, {
        DenseOrder S{(const char*)(ws + WS_ACT), (const char*)(ws + WS_WIN), D, T / 256, INC / 256, F.G, F.bid};
        EpiInProj E{(bf16_t*)(ws + WS_PROJ), (bf16_t*)a.out, (float*)(ws + WS_DEC), (const float*)(ws + WS_SMALL) + 16, attn_body::C2};
        pg8::gemm_phase(F.lds, D, S, E);
        int nl; const int early = w2_early_items(F.G, nl);
        if (early && F.bid >= F.G - nl) { __syncthreads(); moe_w2_convert(F, a, 0, early, (F.bid - (F.G - nl)) * NWAVES + F.wave, nl * NWAVES); }
    }) SEAM(2);
    RUNPH(3, {
        for (int g = F.bid; g < 256; g += F.G) hg::grp_local(F, a, g);
        __syncthreads();
        attn_phase(F, a);
    }) SEAM(3);
    RUNPH(4, { hg::grp_scan(F, a); attn_combine(F, a); }) SEAM(4);
    RUNPH(5, { for (int g = F.bid; g < 256; g += F.G) hg::grp_final(F, a, g); }) SEAM(5);
    RUNPH(6, {
        UpOrder S{(const char*)(ws + WS_YDA), (const char*)(ws + WS_YHG), (const char*)(ws + WS_WUPDA), (const char*)(ws + WS_WUPHG), F.G, F.bid};
        EpiUp E{(const bf16_t*)(ws + WS_PROJ), (bf16_t*)(ws + WS_ACT)};
        pg8::gemm_phase(F.lds, 512, S, E);
    }) SEAM(6);
    RUNPH(7, {
        DenseOrder S{(const char*)(ws + WS_ACT), (const char*)(ws + WS_WOUT), D, T / 256, D / 256, F.G, F.bid};
        EpiOut E{a.in[I_X], (const float*)(ws + WS_MOD), (bf16_t*)(ws + WS_X1B)};
        const bool conv_first = (F.bid >> 3) & 1;
        if (conv_first) { moe_weight_convert(F, a); __syncthreads(); }
        pg8::gemm_phase(F.lds, D, S, E);
        if (!conv_first) { __syncthreads(); moe_weight_convert(F, a); }
    }) SEAM(7);
    RUNPH(8, { phase_router(F, a); __syncthreads(); }) SEAM(8);
    RUNPH(9, {
        build_moe_tab(F, a, tab);
        unsigned* done = (unsigned*)(ws + WS_CTL) + CW_TILE;
        const int vc = (F.G & 7) == 0 ? (F.bid & 7) * (F.G >> 3) + (F.bid >> 3) : F.bid;
        { Moe1Order S{tab, (const char*)(ws + WS_ACT), (const char*)(ws + WS_W13), (const int*)(ws + WS_TOKLIST), F.G, vc};
          EpiMoe1 E{(bf16_t*)(ws + WS_HS), done};
          pg8::gemm_phase(F.lds, D, S, E); }
        { Moe2Order S{tab, (const char*)(ws + WS_HS), (const char*)a.out + OUT_W2, done, (unsigned*)(ws + WS_CTL) + CW_TMO, F.G, vc};
          EpiStoreBf16 E{(bf16_t*)(ws + WS_YS), D, 0, 1.0f};
          pg8::gemm_phase(F.lds, DEXP, S, E); }
    }) SEAM(9);
    RUNPH(10, { build_moe_tab(F, a, tab); phase_final(F, a, tab); })
#undef IN
#undef SEAM
}

extern "C" void kernel_launch(void* const* d_in, const int* in_sizes, int n_in, void* d_out, int out_size, void* d_ws, size_t ws_size, hipStream_t stream) {
    static int grid = 0;
    if (grid == 0) {
        if (n_in != 25 || in_sizes[0] != T * D || out_size != T * D || ws_size < WS_END) { fprintf(stderr, "kernel_launch: unexpected shapes (n_in %d, in0 %d, out %d, ws %zu)\n", n_in, n_in > 0 ? in_sizes[0] : -1, out_size, ws_size); grid = -1; return; }
        int dev = 0, cus = 0, per_cu = 0;
        if (hipGetDevice(&dev) != hipSuccess || hipDeviceGetAttribute(&cus, hipDeviceAttributeMultiprocessorCount, dev) != hipSuccess) { grid = -1; return; }
        if (hipFuncSetAttribute((const void*)mk_fwd, hipFuncAttributeMaxDynamicSharedMemorySize, LDS_BYTES) != hipSuccess) { fprintf(stderr, "kernel_launch: hipFuncSetAttribute failed\n"); grid = -1; return; }
        if (hipOccupancyMaxActiveBlocksPerMultiprocessor(&per_cu, (const void*)mk_fwd, NTHR, LDS_BYTES) != hipSuccess || per_cu < 1) { fprintf(stderr, "kernel_launch: occupancy query says %d\n", per_cu); per_cu = 1; }
        (void)hipGetLastError();
        grid = cus;
        if (grid > 256) grid = 256;
        while (T % grid) --grid;
    }
    if (grid < 0) return;
    (void)hipMemsetAsync((char*)d_ws + WS_CTL, 0, CTL_ZERO_BYTES, stream);
    Args a{};
    for (int i = 0; i < 25; ++i) a.in[i] = (const float*)d_in[i];
    a.out = (float*)d_out; a.ws = (unsigned char*)d_ws;
#if MK_N_LAUNCHES == 1
    a.ph_lo = 0; a.ph_hi = N_PHASES;
    void* args[] = {&a};
    hipError_t e = hipLaunchCooperativeKernel((const void*)mk_fwd, dim3(grid), dim3(NTHR), args, LDS_BYTES, stream);
    if (e != hipSuccess) fprintf(stderr, "cooperative launch failed: %s (grid %d)\n", hipGetErrorString(e), grid);
#else
    for (int p = 0; p < N_PHASES; ++p) {
        a.ph_lo = p; a.ph_hi = p + 1;
        hipLaunchKernelGGL(mk_fwd, dim3(grid), dim3(NTHR), LDS_BYTES, stream, a);
    }
#endif
}
```

```cpp
#include <hip/hip_runtime.h>
#include <cstdio>
#include <cstdint>

#ifndef MK_N_LAUNCHES
#define MK_N_LAUNCHES 1
#endif

#define LAS __attribute__((address_space(3)))
typedef unsigned short bf16_t;
typedef short bf16x8 __attribute__((ext_vector_type(8)));
typedef float f32x4 __attribute__((ext_vector_type(4)));
typedef float f32x2 __attribute__((ext_vector_type(2)));
typedef unsigned u32x4 __attribute__((ext_vector_type(4)));
typedef unsigned u32x2 __attribute__((ext_vector_type(2)));

constexpr int NB = 4, SEQ = 4096, D = 1024, T = NB * SEQ;
constexpr int INC = 5632;
constexpr int C_QDA = 0, C_KDA = 512, C_VDA = 1024, C_QHG = 1536, C_FHG = 2048, C_IHG = 2560, C_GHG = 3072, C_GDA = 3584, C_GHGATE = 4608;
constexpr int C_HGT = 1536;
constexpr int NEXP = 32, DEXP = 512;
constexpr int PMAX = 40960;
constexpr float EPS = 1e-6f;
constexpr int NWAVES = 8, NTHR = 512;

constexpr size_t MiB = 1u << 20;
constexpr size_t WS_CTL = 0, CTL_ZERO_BYTES = 64 * 1024;
constexpr size_t WS_MOD = 5 * MiB / 2;
constexpr size_t WS_SMALL = 11 * MiB / 4;
constexpr size_t WS_TOKINFO = 3 * MiB;
constexpr size_t WS_TOKLIST = 4 * MiB;
constexpr size_t WS_DEC = 6 * MiB;
constexpr size_t WS_DS = 24 * MiB;
constexpr size_t WS_WIN = 8 * MiB;
constexpr size_t WS_WUPDA = 20 * MiB, WS_WUPHG = 21 * MiB, WS_WOUT = 22 * MiB;
constexpr size_t WS_ACT = 24 * MiB;
constexpr size_t WS_PROJ = 56 * MiB;
constexpr size_t WS_YDA = 232 * MiB, WS_YHG = 248 * MiB;
constexpr size_t WS_OA = 264 * MiB;
constexpr size_t WS_W13 = 56 * MiB;
constexpr size_t WS_W2 = 120 * MiB;
constexpr size_t WS_HS = 152 * MiB;
constexpr size_t WS_YS = 192 * MiB;
constexpr size_t OUT_W2 = 16 * MiB;
constexpr int W2_EARLY = 32;
constexpr size_t WS_X1B = 272 * MiB;
constexpr size_t WS_END = 304 * MiB;
constexpr int CW_COUNTS = 64;
constexpr int CW_BAR = 4096;
constexpr int CW_TILE = 8192;
constexpr int CW_TMO = 32;

constexpr int LDS_BYTES = 160 * 1024;

__device__ __forceinline__ float bf2f(unsigned v) { return __uint_as_float(v << 16); }
__device__ __forceinline__ unsigned f2bf(float f) { unsigned u = __float_as_uint(f); return (u + 0x7fffu + ((u >> 16) & 1u)) >> 16; }
__device__ __forceinline__ unsigned pk2(float lo, float hi) { return f2bf(lo) | (f2bf(hi) << 16); }
__device__ __forceinline__ float sigmoidf_(float x) { return 1.0f / (1.0f + __expf(-x)); }
__device__ __forceinline__ float siluf_(float x) { return x / (1.0f + __expf(-x)); }
__device__ __forceinline__ int lane_now() { int l; asm volatile("v_mbcnt_lo_u32_b32 %0, -1, 0\n\tv_mbcnt_hi_u32_b32 %0, -1, %0" : "=v"(l)); return l; }
__device__ __forceinline__ float wave_sum(float v) {
#pragma unroll
    for (int o = 1; o < 64; o <<= 1) v += __shfl_xor(v, o);
    return v;
}

namespace pg8 {
constexpr int BM = 256, BK = 64, HALF = 128, HTB = HALF * BK * 2, STAGE_BYTES = 8 * HTB;
__host__ __device__ __forceinline__ int lds_byte(int r, int c) { const int st = (r >> 4) * 2 + (c >> 5), rr = r & 15, cc = c & 31, ob = rr * 64 + cc * 2; return st * 1024 + (ob ^ (((ob >> 9) & 1) << 5)); }
__host__ __device__ __forceinline__ void stage_rc(int b, int& R, int& C) { const int st = b / 1024, sb = b % 1024, swz = sb ^ (((sb >> 9) & 1) << 5); R = (st >> 1) * 16 + swz / 64; C = (st & 1) * 32 + (swz % 64) / 2; }
__host__ __device__ __forceinline__ int perm32(int rho) { const int n = rho >> 4, i = rho & 15; return 8 * (i >> 2) + 4 * n + (i & 3); }

struct Unit { int pm, pn; const char* A; const char* B; int aux; };
__device__ __forceinline__ unsigned cvt_pk_bf16(float lo, float hi) { unsigned r; asm volatile("v_cvt_pk_bf16_f32 %0, %1, %2" : "=v"(r) : "v"(lo), "v"(hi)); return r; }

template <class Epi, class Sched>
__device__ __forceinline__ void gemm_phase(LAS unsigned char* lds, const int K, const Sched& S, const Epi& E) {
    const int tid = threadIdx.x, wid = __builtin_amdgcn_readfirstlane(tid >> 6), lane = tid & 63, wr = wid >> 2, wc = wid & 3, fr = lane & 15, fq = lane >> 4;
    const int nt = K / BK;
    unsigned voffB[2];
#define PG8_SETLANE() do { const int _l = lane_now(), _t = wid * 64 + _l; _Pragma("unroll") for (int _i = 0; _i < 2; ++_i) { int _R, _C; stage_rc(_t * 16 + _i * 8192, _R, _C); \
        const int _Rb = Epi::PERM ? ((_R & ~31) + perm32(_R & 31)) : _R; voffB[_i] = (unsigned)(_Rb * K + _C) * 2u; } \
        aoff = lds_byte(wr * 64 + (_l & 15), (_l >> 4) * 8); boff = lds_byte(wc * 32 + (_l & 15), (_l >> 4) * 8); } while (0)
    const size_t kstep = (size_t)(BK * 2);
    const size_t hstep = (size_t)HALF * K * 2;
    const unsigned ldsw = (unsigned)wid * 1024u;
    int aoff, boff; PG8_SETLANE();
#define PG8_SA(b, h) (((b) * 2 + (h)) * HTB)
#define PG8_SB(b, h) ((4 + (b) * 2 + (h)) * HTB)
#define PG8_STAGE(bufoff, gbase, voff) do { _Pragma("unroll") for (int _i = 0; _i < 2; ++_i) \
        __builtin_amdgcn_global_load_lds((const unsigned*)((const char*)(gbase) + (voff)[_i]), (LAS unsigned*)(lds + (bufoff) + ldsw + _i * 8192), 16, 0, 0); } while (0)
#define PG8_LDA(dst, b, h) do { _Pragma("unroll") for (int m = 0; m < 4; ++m) _Pragma("unroll") for (int k = 0; k < 2; ++k) dst[m][k] = *(const LAS bf16x8*)(lds + PG8_SA(b, h) + aoff + m * 2048 + k * 1024); } while (0)
#define PG8_LDB(dst, b, h) do { _Pragma("unroll") for (int n = 0; n < 2; ++n) _Pragma("unroll") for (int k = 0; k < 2; ++k) dst[n][k] = *(const LAS bf16x8*)(lds + PG8_SB(b, h) + boff + n * 2048 + k * 1024); } while (0)
#define PG8_MMA(ai, bj, At, Bt) do { __builtin_amdgcn_s_setprio(1); _Pragma("unroll") for (int m = 0; m < 4; ++m) _Pragma("unroll") for (int n = 0; n < 2; ++n) _Pragma("unroll") for (int k = 0; k < 2; ++k) \
        acc[ai][bj][m][n] = __builtin_amdgcn_mfma_f32_16x16x32_bf16(Bt[n][k], At[m][k], acc[ai][bj][m][n], 0, 0, 0); __builtin_amdgcn_s_setprio(0); } while (0)
#define PG8_WAIT_V(n) asm volatile("s_waitcnt vmcnt(" #n ")" ::: "memory")
#define PG8_WAIT_L(n) asm volatile("s_waitcnt lgkmcnt(" #n ")" ::: "memory")
#define PG8_BAR __builtin_amdgcn_s_barrier()
#define PG8_SCHED __builtin_amdgcn_sched_barrier(0)
#define PG8_SETA(vo, u) do { const int _t = wid * 64 + lane_now(); _Pragma("unroll") for (int _i = 0; _i < 2; ++_i) { int _R, _C; stage_rc(_t * 16 + _i * 8192, _R, _C); \
        _Pragma("unroll") for (int _h = 0; _h < 2; ++_h) vo[_h][_i] = (unsigned)((size_t)S.arow(u, _h * HALF + _R) * (size_t)K + _C) * 2u; } if (Sched::GATHER) PG8_WAIT_V(0); } while (0)
    Unit cur, nxt; int ui = 0;
    if (!S.next(0, cur)) return;
    f32x4 acc[2][2][4][2];
#pragma unroll
    for (int a = 0; a < 2; ++a)
#pragma unroll
        for (int b = 0; b < 2; ++b)
#pragma unroll
            for (int m = 0; m < 4; ++m)
#pragma unroll
                for (int n = 0; n < 2; ++n) acc[a][b][m][n] = (f32x4){0.f, 0.f, 0.f, 0.f};
    bf16x8 At[4][2], B0[2][2], B1[2][2];
    unsigned voC[2][2], voN[2][2];
    S.a_ready(cur);
    PG8_SETA(voC, cur);
    const char* cA = cur.A; const char* cB = cur.B;
    PG8_STAGE(PG8_SB(0, 0), cB, voffB); PG8_STAGE(PG8_SB(0, 1), cB + hstep, voffB); PG8_STAGE(PG8_SA(0, 0), cA, voC[0]); PG8_STAGE(PG8_SA(0, 1), cA, voC[1]);
    if (wr == 1) PG8_BAR;
    PG8_WAIT_V(2); PG8_BAR;
    PG8_STAGE(PG8_SB(1, 0), cB + kstep, voffB); PG8_STAGE(PG8_SA(1, 0), cA + kstep, voC[0]); PG8_STAGE(PG8_SB(1, 1), cB + hstep + kstep, voffB);
    PG8_WAIT_V(6); PG8_BAR;
    for (;;) {
        const bool has_next = S.next(ui + 1, nxt);
        if (has_next) { PG8_SETA(voN, nxt); }
        else {
#pragma unroll
            for (int h = 0; h < 2; ++h)
#pragma unroll
                for (int i = 0; i < 2; ++i) voN[h][i] = voC[h][i];
        }
        const char* nA = has_next ? nxt.A : cA; const char* nB = has_next ? nxt.B : cB;
        for (int t = 0; t < nt; t += 2) {
            const bool last = (t == nt - 2);
            if (last && has_next) S.a_ready(nxt);
            const char* a1 = cA + (size_t)(t + 1) * kstep;
            const char* a2 = last ? nA : cA + (size_t)(t + 2) * kstep; const char* b2 = last ? nB : cB + (size_t)(t + 2) * kstep;
            const char* a3 = a2 + kstep; const char* b3 = b2 + kstep;
            unsigned vo2[2][2];
#pragma unroll
            for (int h = 0; h < 2; ++h)
#pragma unroll
                for (int i = 0; i < 2; ++i) vo2[h][i] = last ? voN[h][i] : voC[h][i];
            PG8_LDB(B0, 0, 0); PG8_LDB(B1, 0, 1); PG8_SCHED; PG8_LDA(At, 0, 0); PG8_STAGE(PG8_SA(1, 1), a1, voC[1]);
            PG8_WAIT_V(8); PG8_WAIT_L(0); PG8_BAR; PG8_MMA(0, 0, At, B0); PG8_MMA(0, 1, At, B1); PG8_BAR; PG8_SCHED;
            PG8_LDA(At, 0, 1); PG8_STAGE(PG8_SB(0, 0), b2, voffB); PG8_STAGE(PG8_SB(0, 1), b2 + hstep, voffB); PG8_STAGE(PG8_SA(0, 0), a2, vo2[0]);
            PG8_WAIT_V(8); PG8_WAIT_L(0); PG8_BAR; PG8_MMA(1, 0, At, B0); PG8_MMA(1, 1, At, B1); PG8_BAR; PG8_SCHED;
            PG8_LDB(B0, 1, 0); PG8_LDB(B1, 1, 1); PG8_SCHED; PG8_LDA(At, 1, 0); PG8_STAGE(PG8_SA(0, 1), a2, vo2[1]);
            PG8_WAIT_V(8); PG8_WAIT_L(0); PG8_BAR; PG8_MMA(0, 0, At, B0); PG8_MMA(0, 1, At, B1); PG8_BAR; PG8_SCHED;
            PG8_LDA(At, 1, 1); PG8_STAGE(PG8_SB(1, 0), b3, voffB); PG8_STAGE(PG8_SB(1, 1), b3 + hstep, voffB); PG8_STAGE(PG8_SA(1, 0), a3, vo2[0]);
            PG8_WAIT_V(8); PG8_WAIT_L(0); PG8_BAR; PG8_MMA(1, 0, At, B0); PG8_MMA(1, 1, At, B1); PG8_BAR; PG8_SCHED;
        }
        if (wr == 0) PG8_BAR;
        const bool keep = E(acc, cur, wr, wc, fr, fq);
        if (!has_next) break;
        if (!keep) {
#pragma unroll
            for (int a = 0; a < 2; ++a)
#pragma unroll
                for (int b = 0; b < 2; ++b)
#pragma unroll
                    for (int m = 0; m < 4; ++m)
#pragma unroll
                        for (int n = 0; n < 2; ++n) acc[a][b][m][n] = (f32x4){0.f, 0.f, 0.f, 0.f};
        }
        cur = nxt; cA = nA; cB = nB; ++ui;
        if (Sched::GATHER) {
#pragma unroll
            for (int h = 0; h < 2; ++h)
#pragma unroll
                for (int i = 0; i < 2; ++i) voC[h][i] = voN[h][i];
        } else { PG8_SETA(voC, cur); }
        PG8_SETLANE();
        if (wr == 1) PG8_BAR;
    }
    PG8_WAIT_V(0);
    PG8_BAR;
#undef PG8_SA
#undef PG8_SB
#undef PG8_STAGE
#undef PG8_LDA
#undef PG8_LDB
#undef PG8_MMA
#undef PG8_WAIT_V
#undef PG8_WAIT_L
#undef PG8_BAR
#undef PG8_SCHED
#undef PG8_SETA
#undef PG8_SETLANE
}
}

struct Args { const float* in[25]; float* out; unsigned char* ws; int ph_lo, ph_hi; };
enum { I_X = 0, I_C, I_WADA, I_BADA, I_N1G, I_WIN, I_LQ1, I_LK1, I_LQ2, I_LK2, I_SUBG, I_LBL, I_HGNG, I_WUPDA, I_WUPHG, I_WOUT, I_N2G, I_WRG, I_BRG, I_WRE, I_BRE, I_W1, I_W3, I_W2, I_FG };

struct DenseOrder {
    static constexpr bool GATHER = false;
    const char* A; const char* Bt; int K, nM, nN, G, c;
    __device__ __forceinline__ bool next(int i, pg8::Unit& u) const {
        const int L = i * G + c, nwg = nM * nN; if (L >= nwg) return false;
        int wgid = L; { const int q = nwg / 8, r = nwg % 8, xcd = wgid % 8, off = wgid / 8; wgid = (xcd < r ? xcd * (q + 1) : r * (q + 1) + (xcd - r) * q) + off; }
        const int nig = 8 * nN, gid = wgid / nig, fm = gid * 8, gsz = (nM - fm) < 8 ? (nM - fm) : 8;
        u.pm = fm + ((wgid % nig) % gsz); u.pn = (wgid % nig) / gsz; u.A = A; u.B = Bt + (size_t)u.pn * 256 * K * 2; u.aux = 0; return true;
    }
    __device__ __forceinline__ void a_ready(const pg8::Unit&) const {}
    __device__ __forceinline__ unsigned arow(const pg8::Unit& u, int r) const { return (unsigned)(u.pm * 256 + r); }
};
struct UpOrder {
    static constexpr bool GATHER = false;
    const char* A0; const char* A1; const char* B0; const char* B1; int G, c;
    __device__ __forceinline__ bool next(int i, pg8::Unit& u) const {
        const int tile = (i >> 1) * G + c; if (tile >= 256) return false;
        u.pm = tile >> 2; u.pn = tile & 3; u.aux = i & 1;
        u.A = (i & 1) ? A1 : A0; u.B = ((i & 1) ? B1 : B0) + (size_t)u.pn * 256 * 512 * 2; return true;
    }
    __device__ __forceinline__ void a_ready(const pg8::Unit&) const {}
    __device__ __forceinline__ unsigned arow(const pg8::Unit& u, int r) const { return (unsigned)(u.pm * 256 + r); }
};
struct MoeTab { int nt; int pad[3]; int tile_e[176]; int tile_m[176]; int cnt[32]; int tbase[33]; };
struct Moe1Order {
    static constexpr bool GATHER = true;
    const LAS MoeTab* tab; const char* A; const char* W; const int* toklist; int G, c;
    __device__ __forceinline__ bool next(int i, pg8::Unit& u) const {
        const int L = i * G + c; if (L >= tab->nt * 4) return false;
        const int ti = L >> 2; u.pm = ti; u.pn = L & 3; u.aux = ti; u.A = A;
        u.B = W + ((size_t)tab->tile_e[ti] * 1024 + (size_t)u.pn * 256) * 1024 * 2; return true;
    }
    __device__ __forceinline__ void a_ready(const pg8::Unit&) const {}
    __device__ __forceinline__ unsigned arow(const pg8::Unit& u, int r) const {
        const int e = tab->tile_e[u.aux], rr = tab->tile_m[u.aux] * 256 + r; const bool ok = rr < tab->cnt[e];
        const unsigned v = (unsigned)toklist[e * T + (ok ? rr : 0)];
        return ok ? v : 0u;
    }
};
struct Moe2Order {
    static constexpr bool GATHER = false;
    const LAS MoeTab* tab; const char* A; const char* W; unsigned* done; unsigned* tmo; int G, c;
    __device__ __forceinline__ bool next(int i, pg8::Unit& u) const {
        const int n1 = tab->nt * 4, r = n1 % G, nl = G - r; int j;
        if (r > 0 && c >= r) { if (i < 2) j = (c - r) + i * nl; else j = 2 * nl + (c - r) + (i - 2) * G; }
        else j = (r > 0 ? 2 * nl : 0) + ((c - r + G) % G) + i * G;
        if (j >= n1) return false;
        const int ti = j >> 2; u.pm = ti; u.pn = j & 3; u.aux = ti; u.A = A;
        u.B = W + ((size_t)tab->tile_e[ti] * 1024 + (size_t)u.pn * 256) * 512 * 2; return true;
    }
    __device__ __forceinline__ unsigned arow(const pg8::Unit& u, int r) const { return (unsigned)(u.pm * 256 + r); }
    __device__ __forceinline__ void a_ready(const pg8::Unit& u) const {
        if (threadIdx.x < 64) {
            unsigned polls = 0;
            while ((unsigned)__builtin_amdgcn_readfirstlane(__hip_atomic_load(done + 16 * u.pm, __ATOMIC_RELAXED, __HIP_MEMORY_SCOPE_AGENT)) < 32u) {
                if (++polls > (1u << 22)) { if (threadIdx.x == 0) __hip_atomic_store(tmo, 1u, __ATOMIC_RELAXED, __HIP_MEMORY_SCOPE_AGENT); break; }
                __builtin_amdgcn_s_sleep(2); }
            __builtin_amdgcn_fence(__ATOMIC_ACQUIRE, "agent");
            asm volatile("s_waitcnt vmcnt(0)" ::: "memory");
        }
        asm volatile("" ::: "memory"); __builtin_amdgcn_s_barrier(); asm volatile("" ::: "memory");
    }
};

using pg8::Unit; using pg8::cvt_pk_bf16;
struct EpiStoreBf16 {
    static constexpr bool PERM = true;
    bf16_t* O; int ldc; int nscale; float scale0;
    __device__ __forceinline__ bool operator()(f32x4 (&acc)[2][2][4][2], const Unit& u, int wr, int wc, int fr, int fq) const {
        const int row0 = u.pm * 256 + wr * 64 + fr, col0 = u.pn * 256 + wc * 32 + 8 * fq;
        const float sc = u.pn < nscale ? scale0 : 1.0f;
#pragma unroll
        for (int ai = 0; ai < 2; ++ai)
#pragma unroll
            for (int m = 0; m < 4; ++m) { bf16_t* rowp = O + (size_t)(row0 + ai * 128 + m * 16) * ldc + col0;
#pragma unroll
                for (int bj = 0; bj < 2; ++bj) { const f32x4 v0 = acc[ai][bj][m][0] * sc, v1 = acc[ai][bj][m][1] * sc;
                    u32x4 w; w.x = cvt_pk_bf16(v0[0], v0[1]); w.y = cvt_pk_bf16(v0[2], v0[3]); w.z = cvt_pk_bf16(v1[0], v1[1]); w.w = cvt_pk_bf16(v1[2], v1[3]);
                    *(u32x4*)(rowp + bj * 128) = w; } }
        return false;
    }
};
template <int N> __device__ __forceinline__ float dpp_shr(float x) { return __builtin_bit_cast(float, __builtin_amdgcn_update_dpp(0, __builtin_bit_cast(int, x), 0x110 + N, 0xf, 0xf, true)); }
template <int N> __device__ __forceinline__ float dpp_ror(float x) { return __builtin_bit_cast(float, __builtin_amdgcn_update_dpp(0, __builtin_bit_cast(int, x), 0x120 + N, 0xf, 0xf, true)); }
__device__ __forceinline__ float rowsum16(float x) { x += dpp_ror<8>(x); x += dpp_ror<4>(x); x += dpp_ror<2>(x); x += dpp_ror<1>(x); return x; }
__device__ __forceinline__ float scan16(float x) { x += dpp_shr<1>(x); x += dpp_shr<2>(x); x += dpp_shr<4>(x); x += dpp_shr<8>(x); return x; }
template <int N> __device__ __forceinline__ float dpp_shr1(float x) { return __builtin_bit_cast(float, __builtin_amdgcn_update_dpp(0x3f800000, __builtin_bit_cast(int, x), 0x110 + N, 0xf, 0xf, false)); }
__device__ __forceinline__ float rowprod16(float x) { x *= dpp_ror<8>(x); x *= dpp_ror<4>(x); x *= dpp_ror<2>(x); x *= dpp_ror<1>(x); return x; }
__device__ __forceinline__ float scanmul16(float x) { x *= dpp_shr1<1>(x); x *= dpp_shr1<2>(x); x *= dpp_shr1<4>(x); x *= dpp_shr1<8>(x); return x; }
struct EpiInProj {
    static constexpr bool PERM = true;
    bf16_t* O; bf16_t* KE; float* DEC; const float* lbv; float scale0;
    __device__ __forceinline__ bool operator()(f32x4 (&acc)[2][2][4][2], const Unit& u, int wr, int wc, int fr, int fq) const {
        { const int l_ = lane_now(); fr = l_ & 15; fq = l_ >> 4; }
        const int row0 = u.pm * 256 + wr * 64 + fr, col0 = u.pn * 256 + wc * 32 + 8 * fq;
        if (u.pn >= 6 && u.pn < 10) {
            const int h = u.pn - 6, lane = 16 * fq + fr, kb = wc * 32 + 8 * fq;
            const int bb = (u.pm * 256) / SEQ, ch0 = ((u.pm * 256) % SEQ + wr * 64) >> 6;
            const f32x4 lb0 = *(const f32x4*)(lbv + h * 128 + kb), lb1 = *(const f32x4*)(lbv + h * 128 + kb + 4);
#pragma unroll
            for (int ai = 0; ai < 2; ++ai) {
                unsigned kep[4][4];
#pragma unroll
                for (int n = 0; n < 2; ++n) {
#pragma unroll
                    for (int ep = 0; ep < 2; ++ep) {
                        float ke2[2][4];
#pragma unroll
                        for (int z = 0; z < 2; ++z) {
                            const int e = 2 * ep + z; const float lb = n ? lb1[e] : lb0[e];
                            float f[4], c[4], tot[4];
#pragma unroll
                            for (int m = 0; m < 4; ++m) { const float fl = acc[ai][1][m][n][e]; f[m] = lb + (1.0f - lb) * __builtin_amdgcn_rcpf(1.0f + __builtin_amdgcn_exp2f(-1.4426950408889634f * fl)); c[m] = scanmul16(f[m]); tot[m] = rowprod16(f[m]); }
                            const float eal = (tot[0] * tot[1]) * (tot[2] * tot[3]);
                            float pre = 1.0f;
#pragma unroll
                            for (int m = 0; m < 4; ++m) { const float eA = c[m] * pre; pre *= tot[m]; const float q = acc[ai][0][m][n][e]; const float kk = 1.0f - f[m];
                                acc[ai][0][m][n][e] = q * __builtin_amdgcn_rcpf(1.0f + __builtin_amdgcn_exp2f(-1.4426950408889634f * q)) * eA;
                                const float kd = kk * __builtin_amdgcn_rcpf(eA); acc[ai][1][m][n][e] = kd; ke2[z][m] = kd * eal; }
                            if (fr == 0) DEC[((size_t)(bb * 4 + h) * 64 + ch0 + 2 * ai) * 128 + kb + 4 * n + e] = eal;
                        }
#pragma unroll
                        for (int m = 0; m < 4; ++m) kep[m][2 * n + ep] = cvt_pk_bf16(ke2[0][m], ke2[1][m]);
                    }
                }
#pragma unroll
                for (int m = 0; m < 4; ++m) *(u32x4*)(KE + (size_t)(row0 + ai * 128 + m * 16) * 512 + h * 128 + kb) = (u32x4){kep[m][0], kep[m][1], kep[m][2], kep[m][3]};
            }
        }
        const float sc = u.pn < 2 ? scale0 : 1.0f;
#pragma unroll
        for (int ai = 0; ai < 2; ++ai)
#pragma unroll
            for (int m = 0; m < 4; ++m) { bf16_t* rowp = O + (size_t)(row0 + ai * 128 + m * 16) * INC + col0;
#pragma unroll
                for (int bj = 0; bj < 2; ++bj) { const f32x4 v0 = acc[ai][bj][m][0] * sc, v1 = acc[ai][bj][m][1] * sc;
                    u32x4 w; w.x = cvt_pk_bf16(v0[0], v0[1]); w.y = cvt_pk_bf16(v0[2], v0[3]); w.z = cvt_pk_bf16(v1[0], v1[1]); w.w = cvt_pk_bf16(v1[2], v1[3]);
                    *(u32x4*)(rowp + bj * 128) = w; } }
        return false;
    }
};
struct EpiUp {
    static constexpr bool PERM = true;
    const bf16_t* proj; bf16_t* O;
    __device__ __forceinline__ bool operator()(f32x4 (&acc)[2][2][4][2], const Unit& u, int wr, int wc, int fr, int fq) const {
        const int row0 = u.pm * 256 + wr * 64 + fr, col0 = u.pn * 256 + wc * 32 + 8 * fq;
#pragma unroll
        for (int ai = 0; ai < 2; ++ai)
#pragma unroll
            for (int mh = 0; mh < 2; ++mh) {
                u32x4 gh[2][2], gd[2][2];
#pragma unroll
                for (int mm = 0; mm < 2; ++mm)
#pragma unroll
                    for (int bj = 0; bj < 2; ++bj) { const size_t row = (size_t)(row0 + ai * 128 + (2 * mh + mm) * 16); const int col = col0 + bj * 128;
                        gh[mm][bj] = *(const u32x4*)(proj + row * INC + C_GHGATE + col);
                        if (u.aux == 0) gd[mm][bj] = *(const u32x4*)(proj + row * INC + C_GDA + col); }
#pragma unroll
                for (int mm = 0; mm < 2; ++mm)
#pragma unroll
                    for (int bj = 0; bj < 2; ++bj) { const int m = 2 * mh + mm; const size_t row = (size_t)(row0 + ai * 128 + m * 16); const int col = col0 + bj * 128;
                        float sh[8];
#pragma unroll
                        for (int j = 0; j < 4; ++j) { sh[2 * j] = 1.0f + __builtin_amdgcn_exp2f(-1.4426950408889634f * bf2f(gh[mm][bj][j] & 0xffffu)); sh[2 * j + 1] = 1.0f + __builtin_amdgcn_exp2f(-1.4426950408889634f * bf2f(gh[mm][bj][j] >> 16)); }
                        if (u.aux == 0) {
#pragma unroll
                            for (int j = 0; j < 4; ++j) {
                                const float d0 = 1.0f + __builtin_amdgcn_exp2f(-1.4426950408889634f * bf2f(gd[mm][bj][j] & 0xffffu)), d1 = 1.0f + __builtin_amdgcn_exp2f(-1.4426950408889634f * bf2f(gd[mm][bj][j] >> 16));
                                const float r0 = sh[2 * j] * __builtin_amdgcn_rcpf(d0), r1 = sh[2 * j + 1] * __builtin_amdgcn_rcpf(d1);
                                if (j < 2) { acc[ai][bj][m][0][2 * j] *= r0; acc[ai][bj][m][0][2 * j + 1] *= r1; }
                                else { acc[ai][bj][m][1][2 * j - 4] *= r0; acc[ai][bj][m][1][2 * j - 3] *= r1; }
                            }
                        } else {
                            const f32x4 v0 = acc[ai][bj][m][0], v1 = acc[ai][bj][m][1];
#pragma unroll
                            for (int j = 0; j < 8; ++j) sh[j] = __builtin_amdgcn_rcpf(sh[j]);
                            u32x4 w; w.x = cvt_pk_bf16(v0[0] * sh[0], v0[1] * sh[1]); w.y = cvt_pk_bf16(v0[2] * sh[2], v0[3] * sh[3]);
                            w.z = cvt_pk_bf16(v1[0] * sh[4], v1[1] * sh[5]); w.w = cvt_pk_bf16(v1[2] * sh[6], v1[3] * sh[7]);
                            *(u32x4*)(O + row * D + col) = w;
                        }
                    }
            }
        return u.aux == 0;
    }
};
struct EpiOut {
    static constexpr bool PERM = true;
    const float* x; const float* mod; bf16_t* O;
    __device__ __forceinline__ bool operator()(f32x4 (&acc)[2][2][4][2], const Unit& u, int wr, int wc, int fr, int fq) const {
        const int row0 = u.pm * 256 + wr * 64 + fr, col0 = u.pn * 256 + wc * 32 + 8 * fq;
        const int b = (u.pm * 256) / SEQ;
        f32x4 gt[2][2];
#pragma unroll
        for (int bj = 0; bj < 2; ++bj)
#pragma unroll
            for (int n = 0; n < 2; ++n) gt[bj][n] = *(const f32x4*)(mod + b * 6144 + 2048 + col0 + bj * 128 + n * 4);
#pragma unroll
        for (int ai = 0; ai < 2; ++ai)
#pragma unroll
            for (int mh = 0; mh < 2; ++mh) {
                f32x4 xv[2][2][2];
#pragma unroll
                for (int mm = 0; mm < 2; ++mm)
#pragma unroll
                    for (int bj = 0; bj < 2; ++bj) { const size_t off = (size_t)(row0 + ai * 128 + (2 * mh + mm) * 16) * D + col0 + bj * 128;
                        xv[mm][bj][0] = __builtin_nontemporal_load((const f32x4*)(x + off)); xv[mm][bj][1] = __builtin_nontemporal_load((const f32x4*)(x + off + 4)); }
#pragma unroll
                for (int mm = 0; mm < 2; ++mm)
#pragma unroll
                    for (int bj = 0; bj < 2; ++bj) { const int m = 2 * mh + mm; const size_t off = (size_t)(row0 + ai * 128 + m * 16) * D + col0 + bj * 128;
                        const f32x4 v0 = xv[mm][bj][0] + gt[bj][0] * acc[ai][bj][m][0], v1 = xv[mm][bj][1] + gt[bj][1] * acc[ai][bj][m][1];
                        u32x4 w; w.x = cvt_pk_bf16(v0[0], v0[1]); w.y = cvt_pk_bf16(v0[2], v0[3]); w.z = cvt_pk_bf16(v1[0], v1[1]); w.w = cvt_pk_bf16(v1[2], v1[3]);
                        *(u32x4*)(O + off) = w; }
            }
        return false;
    }
};
struct EpiMoe1 {
    static constexpr bool PERM = true;
    bf16_t* O; unsigned* done;
    __device__ __forceinline__ bool operator()(f32x4 (&acc)[2][2][4][2], const Unit& u, int wr, int wc, int fr, int fq) const {
        const int row0 = u.pm * 256 + wr * 64 + fr, col0 = u.pn * 128 + wc * 32 + 8 * fq;
#pragma unroll
        for (int ai = 0; ai < 2; ++ai)
#pragma unroll
            for (int m = 0; m < 4; ++m) { bf16_t* rowp = O + (size_t)(row0 + ai * 128 + m * 16) * DEXP + col0;
                float h[8];
#pragma unroll
                for (int n = 0; n < 2; ++n)
#pragma unroll
                    for (int e = 0; e < 4; ++e) { const float x_ = acc[ai][0][m][n][e]; h[n * 4 + e] = x_ * __builtin_amdgcn_rcpf(1.0f + __builtin_amdgcn_exp2f(-1.4426950408889634f * x_)) * acc[ai][1][m][n][e]; }
                u32x4 w; w.x = cvt_pk_bf16(h[0], h[1]); w.y = cvt_pk_bf16(h[2], h[3]); w.z = cvt_pk_bf16(h[4], h[5]); w.w = cvt_pk_bf16(h[6], h[7]);
                asm volatile("global_store_dwordx4 %0, %1, off sc1\n\ts_nop 1" :: "v"(rowp), "v"(w) : "memory"); }
        asm volatile("s_waitcnt vmcnt(0)" ::: "memory");
        if ((threadIdx.x & 63) == 0) __hip_atomic_fetch_add(done + 16 * u.pm, 1u, __ATOMIC_RELAXED, __HIP_MEMORY_SCOPE_AGENT);
        return false;
    }
};

struct Frame { LAS unsigned char* lds; int tid, lane, wave, G, bid; };

__device__ __forceinline__ void transpose_item(const float* Wsrc, int ldw, bf16_t* dst, int ldd, LAS float* scr, int lane) {
#pragma unroll 8
    for (int i = 0; i < 32; ++i) { const int kk = 2 * i + (lane >> 5); scr[kk * 33 + (lane & 31)] = __builtin_nontemporal_load(Wsrc + (size_t)kk * ldw + (lane & 31)); }
    asm volatile("s_waitcnt lgkmcnt(0)" ::: "memory");
    const int c = lane & 7;
#pragma unroll
    for (int j = 0; j < 4; ++j) { const int n = (lane >> 3) + 8 * j; const LAS float* s = scr + (8 * c) * 33 + n;
        u32x4 o; o.x = pk2(s[0 * 33], s[1 * 33]); o.y = pk2(s[2 * 33], s[3 * 33]); o.z = pk2(s[4 * 33], s[5 * 33]); o.w = pk2(s[6 * 33], s[7 * 33]);
        *(u32x4*)(dst + (size_t)n * ldd + 8 * c) = o; }
    asm volatile("s_waitcnt lgkmcnt(0)" ::: "memory");
}
struct TItem { const float* src; bf16_t* dst; int ldw, ldd; };
template <class ItemFn>
__device__ __forceinline__ void transpose_stream(int it_lo, int it_hi, int gw, int NGW, LAS float* scr, int lane, ItemFn item) {
    int it = it_lo + gw; if (it >= it_hi) return;
    TItem cur = item(it);
    float v[32];
    const int l31 = lane & 31, lh = lane >> 5;
#pragma unroll
    for (int i = 0; i < 32; ++i) v[i] = __builtin_nontemporal_load(cur.src + (size_t)(2 * i + lh) * cur.ldw + l31);
    while (true) {
#pragma unroll
        for (int i = 0; i < 32; ++i) scr[(2 * i + lh) * 33 + l31] = v[i];
        const int nx = it + NGW; const bool more = nx < it_hi; TItem nxt = cur;
        if (more) { nxt = item(nx);
#pragma unroll
            for (int i = 0; i < 32; ++i) v[i] = __builtin_nontemporal_load(nxt.src + (size_t)(2 * i + lh) * nxt.ldw + l31); }
        asm volatile("s_waitcnt lgkmcnt(0)" ::: "memory");
        const int c = lane & 7;
#pragma unroll
        for (int j = 0; j < 4; ++j) { const int n = (lane >> 3) + 8 * j; const LAS float* s_ = scr + (8 * c) * 33 + n;
            u32x4 o; o.x = pk2(s_[0 * 33], s_[1 * 33]); o.y = pk2(s_[2 * 33], s_[3 * 33]); o.z = pk2(s_[4 * 33], s_[5 * 33]); o.w = pk2(s_[6 * 33], s_[7 * 33]);
            *(u32x4*)(cur.dst + (size_t)n * cur.ldd + 8 * c) = o; }
        asm volatile("s_waitcnt lgkmcnt(0)" ::: "memory");
        if (!more) break;
        cur = nxt; it = nx;
    }
}
__device__ __forceinline__ void transpose_matrix(const Frame& F, const float* W, int K, int N, bf16_t* WT) {
    LAS float* scr = (LAS float*)(F.lds + F.wave * 8448);
    const int gw = F.bid * NWAVES + F.wave, NGW = F.G * NWAVES, nblk = N / 32, items = (K / 64) * nblk;
    transpose_stream(0, items, gw, NGW, scr, F.lane, [=](int it) { const int kb = it / nblk, nb = it % nblk;
        return TItem{W + (size_t)(64 * kb) * N + 32 * nb, WT + (size_t)(32 * nb) * K + 64 * kb, N, K}; });
}

__device__ __forceinline__ void phase0(const Frame& F, const Args& a) {
    unsigned char* ws = a.ws;
    {
        float* mod = (float*)(ws + WS_MOD);
        const float* c = a.in[I_C]; const float* wada = a.in[I_WADA]; const float* bada = a.in[I_BADA];
        LAS f32x4* cs4 = (LAS f32x4*)(F.lds + 72 * 1024);
        LAS float* red = (LAS float*)(F.lds + 72 * 1024 + 16 * 1024);
        for (int i = F.tid; i < 4 * D; i += NTHR) ((LAS float*)cs4)[(i & (D - 1)) * 4 + (i >> 10)] = siluf_(c[i]);
        __syncthreads();
        for (int cb = F.bid; cb < 6144 / 32; cb += F.G) {
            const int l15 = F.lane & 15, lq = F.lane >> 4, k0 = 128 * F.wave + lq;
            const float* wp = wada + (size_t)k0 * 6144 + cb * 32 + 2 * l15;
            f32x2 wv[32];
#pragma unroll
            for (int i = 0; i < 32; ++i) wv[i] = __builtin_nontemporal_load((const f32x2*)(wp + (size_t)(4 * i) * 6144));
            f32x2 s[4] = {{0.f, 0.f}, {0.f, 0.f}, {0.f, 0.f}, {0.f, 0.f}};
#pragma unroll
            for (int i = 0; i < 32; ++i) { const f32x4 cv = cs4[k0 + 4 * i];
#pragma unroll
                for (int b = 0; b < 4; ++b) s[b] += wv[i] * cv[b]; }
#pragma unroll
            for (int b = 0; b < 4; ++b) { f32x2 t = s[b];
                t.x += __shfl_xor(t.x, 16); t.y += __shfl_xor(t.y, 16); t.x += __shfl_xor(t.x, 32); t.y += __shfl_xor(t.y, 32);
                if (lq == 0) *(LAS f32x2*)(red + (F.wave * 4 + b) * 32 + 2 * l15) = t; }
            __syncthreads();
            if (F.tid < 128) { const int b = F.tid >> 5, cc = F.tid & 31; float t = bada[cb * 32 + cc];
#pragma unroll
                for (int w = 0; w < 8; ++w) t += red[(w * 4 + b) * 32 + cc];
                mod[b * 6144 + cb * 32 + cc] = t; }
            __syncthreads();
        }
    }
    if (F.bid == 0) {
        float* sm = (float*)(ws + WS_SMALL);
        if (F.tid == 0) {
            float s1 = 0.f, s2 = 0.f;
            for (int i = 0; i < 64; ++i) { s1 += a.in[I_LQ1][i] * a.in[I_LK1][i]; s2 += a.in[I_LQ2][i] * a.in[I_LK2][i]; }
            sm[0] = expf(s1) - expf(s2) + 0.2f;
        }
        { const float l0 = a.in[I_LBL][F.tid], l1 = a.in[I_LBL][512 + F.tid]; const float mx = fmaxf(l0, l1);
          const float e0 = expf(l0 - mx), e1 = expf(l1 - mx); sm[16 + F.tid] = e0 / (e0 + e1); }
    }
}
__device__ __forceinline__ void moe_w2_convert(const Frame& F, const Args& a, int it_lo, int it_hi, int gw, int NGW) {
    LAS float* scr = (LAS float*)(F.lds + F.wave * 8448);
    bf16_t* w2t = (bf16_t*)((unsigned char*)a.out + OUT_W2); const float* w2 = a.in[I_W2];
    transpose_stream(it_lo, it_hi, gw, NGW, scr, F.lane, [=](int it) { const int e = it >> 8, kb = (it >> 5) & 7, nb = it & 31;
        return TItem{w2 + (size_t)e * 512 * 1024 + (size_t)(64 * kb) * 1024 + 32 * nb, w2t + ((size_t)e * 1024 + 32 * nb) * 512 + 64 * kb, 1024, 512}; });
}
__device__ __forceinline__ int w2_early_items(int G, int& n_light) { const int nwg = (T / 256) * (INC / 256), r = nwg % G; n_light = r ? G - r : 0; return n_light >= 64 ? W2_EARLY * 256 : 0; }
__device__ __forceinline__ void moe_weight_convert(const Frame& F, const Args& a) {
    LAS float* scr = (LAS float*)(F.lds + F.wave * 8448);
    const int gw = F.bid * NWAVES + F.wave, NGW = F.G * NWAVES;
    bf16_t* w13 = (bf16_t*)(a.ws + WS_W13);
    const float* w1 = a.in[I_W1]; const float* w3 = a.in[I_W3];
    transpose_stream(0, 2 * NEXP * 256, gw, NGW, scr, F.lane, [=](int it) {
        const int which = it / (NEXP * 256), r = it % (NEXP * 256), e = r >> 8, kb = (r >> 4) & 15, nb = r & 15, n0 = 32 * nb;
        const float* W = (which ? w3 : w1) + (size_t)e * 1024 * 512;
        const int drow = 256 * (n0 >> 7) + (which ? 128 : 0) + (n0 & 127);
        return TItem{W + (size_t)(64 * kb) * 512 + n0, w13 + ((size_t)e * 1024 + drow) * 1024 + 64 * kb, 512, 1024}; });
    int nl; const int early = w2_early_items(F.G, nl);
    moe_w2_convert(F, a, early, NEXP * 256, gw, NGW);
}

__device__ __forceinline__ void dense_weight_convert(const Frame& F, const Args& a) {
    unsigned char* ws = a.ws;
    {
        LAS float* scr = (LAS float*)(F.lds + F.wave * 8448);
        const int gw = F.bid * NWAVES + F.wave, NGW = F.G * NWAVES, nblk = INC / 32, items = (D / 64) * nblk;
        bf16_t* WT = (bf16_t*)(ws + WS_WIN);
        const float* win = a.in[I_WIN];
        transpose_stream(0, items, gw, NGW, scr, F.lane, [=](int it) { const int kb = it / nblk, n0 = 32 * (it % nblk); int dr = n0;
            if (n0 >= C_QHG && n0 < C_FHG) dr = C_HGT + 256 * ((n0 - C_QHG) >> 7) + ((n0 - C_QHG) & 127);
            else if (n0 >= C_FHG && n0 < C_IHG) dr = C_HGT + 256 * ((n0 - C_FHG) >> 7) + 128 + ((n0 - C_FHG) & 127);
            return TItem{win + (size_t)(64 * kb) * INC + n0, WT + (size_t)dr * D + 64 * kb, INC, D}; });
    }
    transpose_matrix(F, a.in[I_WUPDA], 512, D, (bf16_t*)(ws + WS_WUPDA));
    transpose_matrix(F, a.in[I_WUPHG], 512, D, (bf16_t*)(ws + WS_WUPHG));
    transpose_matrix(F, a.in[I_WOUT], D, D, (bf16_t*)(ws + WS_WOUT));
}
__device__ __forceinline__ void phase1(const Frame& F, const Args& a) {
    const float* mod = (const float*)(a.ws + WS_MOD);
    LAS float* Gs = (LAS float*)F.lds;
    LAS float* Ss = Gs + 1024;
    bf16_t* H = (bf16_t*)(a.ws + WS_ACT);
    const int rows_per_blk = T / F.G;
    const int r0 = F.bid * rows_per_blk, b = r0 / SEQ;
    for (int k = F.tid; k < 1024; k += NTHR) { Gs[k] = a.in[I_N1G][k] * (1.0f + mod[b * 6144 + 1024 + k]); Ss[k] = mod[b * 6144 + k]; }
    __syncthreads();
    for (int rb = r0 + F.wave; rb < r0 + rows_per_blk; rb += 4 * NWAVES) {
        f32x4 v[4][4];
#pragma unroll
        for (int q = 0; q < 4; ++q) { const int r = rb + q * NWAVES < r0 + rows_per_blk ? rb + q * NWAVES : rb; const f32x4* xr = (const f32x4*)(a.in[I_X] + (size_t)r * D) + F.lane;
#pragma unroll
            for (int j = 0; j < 4; ++j) v[q][j] = __builtin_nontemporal_load(xr + 64 * j); }
#pragma unroll
        for (int q = 0; q < 4; ++q) { const int r = rb + q * NWAVES; if (r >= r0 + rows_per_blk) break;
            float s = 0.f;
#pragma unroll
            for (int j = 0; j < 4; ++j) s += (v[q][j].x * v[q][j].x + v[q][j].y * v[q][j].y) + (v[q][j].z * v[q][j].z + v[q][j].w * v[q][j].w);
            const float rs = rsqrtf(wave_sum(s) * (1.0f / D) + EPS);
            unsigned long long* o8 = (unsigned long long*)(H + (size_t)r * D) + F.lane;
#pragma unroll
            for (int j = 0; j < 4; ++j) { const f32x4 g = *(const LAS f32x4*)(Gs + 256 * j + 4 * F.lane), sh = *(const LAS f32x4*)(Ss + 256 * j + 4 * F.lane);
                const f32x4 h = v[q][j] * rs * g + sh;
                o8[64 * j] = (unsigned long long)pk2(h.x, h.y) | ((unsigned long long)pk2(h.z, h.w) << 32); } }
    }
}

namespace attn_body {
using s16x4=__attribute__((ext_vector_type(4)))short;
using f32x16=__attribute__((ext_vector_type(16)))float;
constexpr int NW=8,QBLK=32,QB=QBLK*NW,KVBLK=64,NQB=SEQ/QB;
constexpr int PIN=INC, POUT=1024;
__device__ __forceinline__ int crow(int r,int hi){return (r&3)+8*(r>>2)+4*hi;}
#define SBAR() __builtin_amdgcn_sched_barrier(0)
__device__ __forceinline__ void bmask(f32x16&p0,f32x16&p1,int jb,int wch,int il,int hi,float s2x2){
  if(jb>wch){
    #pragma unroll
    for(int r=0;r<16;++r){p0[r]=-INFINITY;p1[r]=-INFINITY;}
  } else if(jb==wch){
    float fb=(float)(4*hi-il); asm volatile("":"+v"(fb));
    #pragma unroll
    for(int r=0;r<16;++r){const float c=(float)((r&3)+8*(r>>2)); p0[r]-=s2x2*__builtin_fmaxf(fb+c,0.f); p1[r]-=s2x2*__builtin_fmaxf(fb+(c+32.f),0.f);}
  }
}
constexpr int NSLOT=3, SLOTB=8192, VSLOTB=16384;
constexpr int LDS_K=0, LDS_V=NSLOT*SLOTB, LDS_WS=LDS_V+NSLOT*VSLOTB, LDS_OST=LDS_WS+NW*64*4, ATT_LDS_BYTES=LDS_OST+NW*8192;
constexpr float C2=0.125f*1.4426950408889634f;
__device__ __forceinline__ void glds16(const void*gsrc,unsigned lds_dst){unsigned keep;
  asm volatile("s_mov_b32 %0, m0\n\ts_mov_b32 m0, %2\n\ts_nop 0\n\tglobal_load_lds_dwordx4 %1, off\n\ts_mov_b32 m0, %0":"=&s"(keep):"v"(gsrc),"s"(lds_dst):"memory");}
__device__ __forceinline__ float max3f(float a,float b,float c){float r;asm("v_max3_f32 %0, %1, %2, %3":"=v"(r):"v"(a),"v"(b),"v"(c));return r;}
__device__ __forceinline__ float max2f(float a,float b){float r;asm("v_max_f32_e32 %0, %1, %2":"=v"(r):"v"(a),"v"(b));return r;}
__device__ __forceinline__ float fadd_s(float a,float b){float r;asm("v_add_f32_e32 %0, %1, %2":"=v"(r):"v"(a),"v"(b));return r;}
__device__ __forceinline__ float fsub_s(float a,float b){float r;asm("v_sub_f32_e32 %0, %1, %2":"=v"(r):"v"(a),"v"(b));return r;}
typedef float f32x2_t __attribute__((ext_vector_type(2))); typedef __bf16 bf16x2_t __attribute__((ext_vector_type(2)));
__device__ __forceinline__ unsigned cvtpk_s(float lo,float hi){f32x2_t v={lo,hi};bf16x2_t b=__builtin_convertvector(v,bf16x2_t);return __builtin_bit_cast(unsigned,b);}
#define WAIT_BAR(N) asm volatile("s_waitcnt vmcnt(" #N ") lgkmcnt(0)\n\ts_barrier":::"memory")

__device__ __forceinline__ void qkt(f32x16&p0,f32x16&p1,const char*Kslot,const bf16x8*qr,const f32x16&c0,const f32x16&c1,int r32,int hi){
  const char*kb=Kslot+hi*1024+r32*16;
  #pragma unroll
  for(int d0=0;d0<4;++d0){
    const bf16x8 b0=*reinterpret_cast<const bf16x8*>(kb+d0*2048);
    const bf16x8 b1=*reinterpret_cast<const bf16x8*>(kb+d0*2048+512);
    if(d0==0){p0=__builtin_amdgcn_mfma_f32_32x32x16_bf16(b0,qr[0],c0,0,0,0);p1=__builtin_amdgcn_mfma_f32_32x32x16_bf16(b1,qr[0],c1,0,0,0);}
    else{p0=__builtin_amdgcn_mfma_f32_32x32x16_bf16(b0,qr[d0],p0,0,0,0);p1=__builtin_amdgcn_mfma_f32_32x32x16_bf16(b1,qr[d0],p1,0,0,0);}}
}
typedef __attribute__((address_space(3))) const char* lds_cptr;
typedef short v4i16_t __attribute__((ext_vector_type(4)));
__device__ __forceinline__ void kload8(bf16x8*kf,lds_cptr kp){
  kf[0]=*(const __attribute__((address_space(3))) bf16x8*)(kp);      kf[1]=*(const __attribute__((address_space(3))) bf16x8*)(kp+512);
  kf[2]=*(const __attribute__((address_space(3))) bf16x8*)(kp+2048); kf[3]=*(const __attribute__((address_space(3))) bf16x8*)(kp+2560);
  kf[4]=*(const __attribute__((address_space(3))) bf16x8*)(kp+4096); kf[5]=*(const __attribute__((address_space(3))) bf16x8*)(kp+4608);
  kf[6]=*(const __attribute__((address_space(3))) bf16x8*)(kp+6144); kf[7]=*(const __attribute__((address_space(3))) bf16x8*)(kp+6656);
}
__device__ __forceinline__ void kload2(bf16x8*kf,lds_cptr kp,int j){ kf[2*j]=*(const __attribute__((address_space(3))) bf16x8*)(kp+j*2048); kf[2*j+1]=*(const __attribute__((address_space(3))) bf16x8*)(kp+j*2048+512); }
__device__ __forceinline__ s16x4 vtr(lds_cptr p){ return __builtin_bit_cast(s16x4,__builtin_amdgcn_ds_read_tr16_b64_v4i16((__attribute__((address_space(3))) v4i16_t*)p)); }
__device__ __forceinline__ float rowmax(const f32x16&p0,const f32x16&p1){
  float a=max3f(p0[0],p0[1],p1[0]),b=max3f(p0[2],p0[3],p1[1]);a=max3f(a,p1[2],p1[3]);
  #pragma unroll
  for(int r=4;r<16;r+=4){a=max3f(a,p0[r],p0[r+1]);b=max3f(b,p0[r+2],p0[r+3]);a=max3f(a,p1[r],p1[r+1]);b=max3f(b,p1[r+2],p1[r+3]);}
  const float m=max2f(a,b);
  auto rr=__builtin_amdgcn_permlane32_swap(__float_as_uint(m),__float_as_uint(m),false,false);
  return max2f(__uint_as_float(rr[0]),__uint_as_float(rr[1]));
}
__device__ __forceinline__ void pv(f32x16*o,int vb,bf16x8 pa0,bf16x8 pa1,bf16x8 pa2,bf16x8 pa3){
  #pragma unroll
  for(int d0=0;d0<4;++d0){s16x4 lo[4],hi[4];
    #pragma unroll
    for(int ks=0;ks<4;++ks){
      asm volatile("ds_read_b64_tr_b16 %0,%1 offset:%c2":"=&v"(lo[ks]):"v"(vb),"i"(d0*4096+ks*1024):"memory");
      asm volatile("ds_read_b64_tr_b16 %0,%1 offset:%c2":"=&v"(hi[ks]):"v"(vb),"i"(d0*4096+ks*1024+512):"memory");}
    asm volatile("s_waitcnt lgkmcnt(0)":::"memory");SBAR();
    #define PK(k) (bf16x8){lo[k][0],lo[k][1],lo[k][2],lo[k][3],hi[k][0],hi[k][1],hi[k][2],hi[k][3]}
    o[d0]=__builtin_amdgcn_mfma_f32_32x32x16_bf16(pa0,PK(0),o[d0],0,0,0);
    o[d0]=__builtin_amdgcn_mfma_f32_32x32x16_bf16(pa1,PK(1),o[d0],0,0,0);
    o[d0]=__builtin_amdgcn_mfma_f32_32x32x16_bf16(pa2,PK(2),o[d0],0,0,0);
    o[d0]=__builtin_amdgcn_mfma_f32_32x32x16_bf16(pa3,PK(3),o[d0],0,0,0);
    #undef PK
  }
}
#define ATTN_STORE16(p,v) (*(u32x4*)(p)=(v))
template<int THRL> __device__ __forceinline__ void attn_unit(int qb,const bf16_t*Qb,const bf16_t*__restrict__ Kh,const bf16_t*__restrict__ Vh,bf16_t*Ob,float slope2,char*shm){
  const int wid=__builtin_amdgcn_readfirstlane(threadIdx.x>>6); const int lane=lane_now(),r32=lane&31,hi=lane>>5;
  const int q0=qb*QB;
  const bf16_t*Qw=Qb+(long)(q0+wid*QBLK)*PIN;
  const unsigned lds0=(unsigned)(uintptr_t)shm;
  float*wsf=(float*)(shm+LDS_WS)+wid*64;
  const bf16_t*ksrc=Kh+(long)lane*PIN+wid*8;
  const bf16_t*vsrc=Vh+(long)(16*(wid&3)+(lane>>2))*PIN+(wid>>2)*32+(lane&3)*8;
  const unsigned kdst=lds0+LDS_K+wid*1024, vdst=lds0+LDS_V+(wid>>2)*4096+(wid&3)*1024;
  #define DMA_K(t,slot) glds16(ksrc+(long)(t)*KVBLK*PIN,(unsigned)__builtin_amdgcn_readfirstlane(kdst+(slot)))
  #define DMA_V(t,slot) do{ glds16(vsrc+(long)(t)*KVBLK*PIN,(unsigned)__builtin_amdgcn_readfirstlane(vdst+2*(slot))); glds16(vsrc+(long)(t)*KVBLK*PIN+64,(unsigned)__builtin_amdgcn_readfirstlane(vdst+2*(slot)+8192)); }while(0)
  const int vb0=(int)(lds0+LDS_V)+((lane>>4)&1)*32+(lane&3)*8+(4*hi+((lane&15)>>2))*64;
  const char*Kbase=shm+LDS_K; bf16x8 kf[8];
  const lds_cptr shm3=(lds_cptr)shm; const lds_cptr kp0=shm3+LDS_K+hi*1024+r32*16; const lds_cptr vp0=shm3+LDS_V+((lane>>4)&1)*32+(lane&3)*8+(4*hi+((lane&15)>>2))*64;
  const int NT=(q0+QB)/KVBLK;
  DMA_K(0,0);DMA_V(0,0);DMA_K(1,SLOTB);
  bf16x8 qr[4];
  #pragma unroll
  for(int d0=0;d0<4;++d0)qr[d0]=*reinterpret_cast<const bf16x8*>(&Qw[(long)r32*PIN+d0*16+hi*8]);
  float mhat=0.f,l_reg=0.f;f32x16 o[4];o[0]=f32x16{};o[1]=f32x16{};o[2]=f32x16{};o[3]=f32x16{};
  const float s64=slope2*64.f, s32=slope2*32.f, s2x2=2.f*slope2, s4hi=slope2*4.f*(float)hi;
  const int wch=wid>>1, il=32*(wid&1)+r32;
  #define CMASK(P0,P1,t) do{int jb_=(t)-(NT-4); if(jb_>=0)bmask(P0,P1,jb_,wch,il,hi,s2x2);}while(0)
  #define CINIT0(C0,t) do{ const float bt_=s64*(float)((t)-NT)-mhat+s4hi; _Pragma("unroll") for(int r=0;r<16;++r){C0[r]=__builtin_fmaf(slope2,(float)((r&3)+8*(r>>2)),bt_);} }while(0)
  #define CINIT1(C1,t) do{ const float bu_=s64*(float)((t)-NT)-mhat+s4hi+s32; _Pragma("unroll") for(int r=0;r<16;++r){C1[r]=__builtin_fmaf(slope2,(float)((r&3)+8*(r>>2)),bu_);} }while(0)
  bool resc=false;
  #define START(P0,P1) do{ const float rm=rowmax(P0,P1); resc=false; \
    { const float dl=rm; mhat=fadd_s(mhat,dl); \
      _Pragma("unroll") for(int r=0;r<16;++r){P0[r]=fsub_s(P0[r],dl);P1[r]=fsub_s(P1[r],dl);} } \
    _Pragma("unroll") for(int r=0;r<16;++r)P0[r]=__builtin_amdgcn_exp2f(P0[r]); }while(0)
  #define RESC() do{ if(resc){ asm volatile("s_waitcnt lgkmcnt(0)":::"memory"); \
      _Pragma("unroll") for(int d_=0;d_<4;++d_) _Pragma("unroll") for(int r=0;r<16;++r)o[d_][r]*=wsf[crow(r,hi)]; } }while(0)
  f32x16 cS0,cS1;
  u32x4 pwa0,pwa1,pwa2,pwa3,pwb0,pwb1,pwb2,pwb3;
  int sl_prev=0,sl_cur=0,sl_next=SLOTB;
  #define ROT() do{sl_prev=sl_cur;sl_cur=sl_next;sl_next=(sl_next==(NSLOT-1)*SLOTB)?0:sl_next+SLOTB;}while(0)
  #define PKW(P,B) cvtpk_s(P[B],P[B+1])
  DMA_K(2,2*SLOTB);
  WAIT_BAR(3);
  { f32x16 c0,c1; CINIT0(c0,0); CINIT1(c1,0); qkt(cS0,cS1,Kbase,qr,c0,c1,r32,hi); }
  asm volatile("s_nop 15\n\ts_nop 7":"+v"(cS0),"+v"(cS1));CMASK(cS0,cS1,0);
  START(cS0,cS1);
  _Pragma("unroll") for(int r=0;r<16;++r)cS1[r]=__builtin_amdgcn_exp2f(cS1[r]);
  { float sacc=cS0[0]+cS0[1]; _Pragma("unroll") for(int r=2;r<16;++r)sacc+=cS0[r]; _Pragma("unroll") for(int r=0;r<16;++r)sacc+=cS1[r]; l_reg+=sacc;
    pwa0=(u32x4){PKW(cS0,0),PKW(cS0,2),PKW(cS0,4),PKW(cS0,6)};pwa1=(u32x4){PKW(cS0,8),PKW(cS0,10),PKW(cS0,12),PKW(cS0,14)};pwa2=(u32x4){PKW(cS1,0),PKW(cS1,2),PKW(cS1,4),PKW(cS1,6)};pwa3=(u32x4){PKW(cS1,8),PKW(cS1,10),PKW(cS1,12),PKW(cS1,14)}; }
  WAIT_BAR(0);
  DMA_K(3,0);DMA_V(1,SLOTB);
  ROT();
  kload8(kf,kp0+sl_cur);
  WAIT_BAR(3);
  s16x4 vlo[4],vhi[4];
  #define CAT_(a,b) a##b
  #define CAT(a,b) CAT_(a,b)
  #define PAFC(P,k) __builtin_bit_cast(bf16x8,CAT(P,k))
  #define VFR(k) (bf16x8){vlo[(k)&3][0],vlo[(k)&3][1],vlo[(k)&3][2],vlo[(k)&3][3],vhi[(k)&3][0],vhi[(k)&3][1],vhi[(k)&3][2],vhi[(k)&3][3]}
  #define VOFF(k) ((k)<8 ? (((k)&1)*4096+((k)>>1)*1024) : ((2+((k)&1))*4096+(((k)-8)>>1)*1024))
  #define PIN_(x) asm volatile("":"+v"(x))
  #define MX3(a,b,c) __builtin_fmaxf(__builtin_fmaxf((a),(b)),(c))
  #define QK(MF) do{ MF; SBAR(); }while(0)
  #define EX(v) __builtin_amdgcn_exp2f(v)
  #define VRD(k) do{ vlo[(k)&3]=vtr(vp_+VOFF(k)); vhi[(k)&3]=vtr(vp_+(VOFF(k)+512)); }while(0)
  #define VNX(k) do{ if((k)+4<16){ VRD((k)+4); } SBAR(); }while(0)
  #define GAPB3(MF,X,B,PW,J) do{ MF; X[B]=EX(X[B]); X[B+1]=EX(X[B+1]); sacc+=X[B]; sacc+=X[B+1]; PW[J]=cvtpk_s(X[B],X[B+1]); PIN_(X); PIN_(sacc); PIN_(PW); SBAR(); }while(0)
  #define KRD(G,j) do{ if(G){ kload2(kf,kp0+sl_next,j); SBAR(); } }while(0)
  #define STEP(PC,PN,t,GK,GV,GL) do{ SBAR(); \
    CINIT0(cS0,t); SBAR(); \
    const lds_cptr vp_=vp0+2*sl_prev; \
    VRD(0); SBAR(); QK(cS0=__builtin_amdgcn_mfma_f32_32x32x16_bf16(kf[0],qr[0],cS0,0,0,0)); \
    CINIT1(cS1,t); VRD(1); SBAR(); QK(cS1=__builtin_amdgcn_mfma_f32_32x32x16_bf16(kf[1],qr[0],cS1,0,0,0)); \
    VRD(2); SBAR(); QK(cS0=__builtin_amdgcn_mfma_f32_32x32x16_bf16(kf[2],qr[1],cS0,0,0,0)); \
    VRD(3); SBAR(); QK(cS1=__builtin_amdgcn_mfma_f32_32x32x16_bf16(kf[3],qr[1],cS1,0,0,0)); \
    QK(cS0=__builtin_amdgcn_mfma_f32_32x32x16_bf16(kf[4],qr[2],cS0,0,0,0)); \
    QK(cS1=__builtin_amdgcn_mfma_f32_32x32x16_bf16(kf[5],qr[2],cS1,0,0,0)); \
    QK(cS0=__builtin_amdgcn_mfma_f32_32x32x16_bf16(kf[6],qr[3],cS0,0,0,0)); \
    QK(cS1=__builtin_amdgcn_mfma_f32_32x32x16_bf16(kf[7],qr[3],cS1,0,0,0)); \
    if(GK){DMA_K((t)+3,sl_cur);} if(GV){DMA_V((t)+1,sl_next);} \
    CMASK(cS0,cS1,t); \
    { float a=MX3(cS0[0],cS0[1],cS1[0]),b=MX3(cS0[2],cS0[3],cS1[1]); a=MX3(a,cS1[2],cS1[3]); \
      _Pragma("unroll") for(int r=4;r<16;r+=4){a=MX3(a,cS0[r],cS0[r+1]);b=MX3(b,cS0[r+2],cS0[r+3]);a=MX3(a,cS1[r],cS1[r+1]);b=MX3(b,cS1[r+2],cS1[r+3]);} \
      float rm=__builtin_fmaxf(a,b); { auto rr=__builtin_amdgcn_permlane32_swap(__float_as_uint(rm),__float_as_uint(rm),false,false); rm=__builtin_fmaxf(__uint_as_float(rr[0]),__uint_as_float(rr[1])); } \
      resc=false; \
      if(__builtin_expect(__any(rm>(float)THRL),0)){ const float dl=__builtin_fmaxf(rm,0.f); mhat+=dl; \
        _Pragma("unroll") for(int r=0;r<16;++r){cS0[r]-=dl;cS1[r]-=dl;} \
        const float f=__builtin_amdgcn_exp2f(-dl); l_reg*=f; if(hi==0)wsf[r32]=f; resc=true; } } \
    SBAR(); float sacc=0.f; \
    GAPB3(o[0]=__builtin_amdgcn_mfma_f32_32x32x16_bf16(PAFC(PC,0),VFR(0),o[0],0,0,0), cS0,0, CAT(PN,0),0); VNX(0); \
    GAPB3(o[1]=__builtin_amdgcn_mfma_f32_32x32x16_bf16(PAFC(PC,0),VFR(1),o[1],0,0,0), cS0,2, CAT(PN,0),1); VNX(1); \
    KRD(GL,0); GAPB3(o[0]=__builtin_amdgcn_mfma_f32_32x32x16_bf16(PAFC(PC,1),VFR(2),o[0],0,0,0), cS0,4, CAT(PN,0),2); VNX(2); \
    KRD(GL,1); GAPB3(o[1]=__builtin_amdgcn_mfma_f32_32x32x16_bf16(PAFC(PC,1),VFR(3),o[1],0,0,0), cS0,6, CAT(PN,0),3); VNX(3); \
    KRD(GL,2); GAPB3(o[0]=__builtin_amdgcn_mfma_f32_32x32x16_bf16(PAFC(PC,2),VFR(4),o[0],0,0,0), cS0,8, CAT(PN,1),0); VNX(4); \
    KRD(GL,3); GAPB3(o[1]=__builtin_amdgcn_mfma_f32_32x32x16_bf16(PAFC(PC,2),VFR(5),o[1],0,0,0), cS0,10, CAT(PN,1),1); VNX(5); \
    GAPB3(o[0]=__builtin_amdgcn_mfma_f32_32x32x16_bf16(PAFC(PC,3),VFR(6),o[0],0,0,0), cS0,12, CAT(PN,1),2); VNX(6); \
    GAPB3(o[1]=__builtin_amdgcn_mfma_f32_32x32x16_bf16(PAFC(PC,3),VFR(7),o[1],0,0,0), cS0,14, CAT(PN,1),3); VNX(7); \
    GAPB3(o[2]=__builtin_amdgcn_mfma_f32_32x32x16_bf16(PAFC(PC,0),VFR(8),o[2],0,0,0), cS1,0, CAT(PN,2),0); VNX(8); \
    GAPB3(o[3]=__builtin_amdgcn_mfma_f32_32x32x16_bf16(PAFC(PC,0),VFR(9),o[3],0,0,0), cS1,2, CAT(PN,2),1); VNX(9); \
    GAPB3(o[2]=__builtin_amdgcn_mfma_f32_32x32x16_bf16(PAFC(PC,1),VFR(10),o[2],0,0,0), cS1,4, CAT(PN,2),2); VNX(10); \
    GAPB3(o[3]=__builtin_amdgcn_mfma_f32_32x32x16_bf16(PAFC(PC,1),VFR(11),o[3],0,0,0), cS1,6, CAT(PN,2),3); VNX(11); \
    GAPB3(o[2]=__builtin_amdgcn_mfma_f32_32x32x16_bf16(PAFC(PC,2),VFR(12),o[2],0,0,0), cS1,8, CAT(PN,3),0); VNX(12); \
    GAPB3(o[3]=__builtin_amdgcn_mfma_f32_32x32x16_bf16(PAFC(PC,2),VFR(13),o[3],0,0,0), cS1,10, CAT(PN,3),1); VNX(13); \
    GAPB3(o[2]=__builtin_amdgcn_mfma_f32_32x32x16_bf16(PAFC(PC,3),VFR(14),o[2],0,0,0), cS1,12, CAT(PN,3),2); VNX(14); \
    GAPB3(o[3]=__builtin_amdgcn_mfma_f32_32x32x16_bf16(PAFC(PC,3),VFR(15),o[3],0,0,0), cS1,14, CAT(PN,3),3); VNX(15); \
    l_reg+=sacc; \
    }while(0)
  int t=1;
  #undef CMASK
  #define CMASK(P0,P1,t) do{}while(0)
  for(;t+5<NT;t+=2){
    STEP(pwa,pwb,t,true,true,true);     WAIT_BAR(3); RESC(); ROT();
    STEP(pwb,pwa,t+1,true,true,true);   WAIT_BAR(3); RESC(); ROT();
  }
  #undef CMASK
  #define CMASK(P0,P1,t) do{int jb_=(t)-(NT-4); if(jb_>=0)bmask(P0,P1,jb_,wch,il,hi,s2x2);}while(0)
  #define ENDW(tt) do{ if((tt)+3<NT){WAIT_BAR(3);} else if((tt)+2<NT){WAIT_BAR(2);} else {WAIT_BAR(0);} }while(0)
  for(;t+1<NT;t+=2){
    STEP(pwa,pwb,t,(t+3<NT),(t+1<NT),(t+1<NT));       ENDW(t);   RESC(); ROT();
    STEP(pwb,pwa,t+1,(t+4<NT),(t+2<NT),(t+2<NT));     ENDW(t+1); RESC(); ROT();
  }
  STEP(pwa,pwb,NT-1,false,false,false); RESC();
  SBAR(); pv(o,vb0+2*sl_cur,PAFC(pwb,0),PAFC(pwb,1),PAFC(pwb,2),PAFC(pwb,3));
  #undef PKW
  #undef PAFC
  #undef CAT
  #undef CAT_
  #undef QK
  #undef GAPB3
  #undef VFR
  #undef PIN_
  #undef MX3
  #undef EX
  #undef VRD
  #undef VNX
  #undef VOFF
  #undef GAPB2
  #undef KRD
  #undef STEP
  #undef ENDW
  {auto rr=__builtin_amdgcn_permlane32_swap(__float_as_uint(l_reg),__float_as_uint(l_reg),false,false);l_reg=__uint_as_float(rr[0])+__uint_as_float(rr[1]);}
  {
    const int le=lane_now(), r32e=le&31, hie=le>>5;
    float*wsfe=(float*)(shm+LDS_WS)+wid*64;
    if(hie==0)wsfe[32+r32e]=l_reg;asm volatile("s_waitcnt lgkmcnt(0)":::"memory");
    float rli[16];
    #pragma unroll
    for(int r=0;r<16;++r)rli[r]=__builtin_amdgcn_rcpf(wsfe[32+crow(r,hie)]);
    bf16_t*Ow=Ob+(long)(q0+wid*QBLK)*POUT;
    bf16_t*stg=(bf16_t*)(shm+LDS_OST)+wid*4096;
    #pragma unroll
    for(int r=0;r<16;++r){const int orow=crow(r,hie);
      #pragma unroll
      for(int d0=0;d0<4;++d0)stg[orow*128+d0*32+r32e]=(bf16_t)f2bf(o[d0][r]*rli[r]);}
    asm volatile("s_waitcnt lgkmcnt(0)":::"memory");
    #pragma unroll
    for(int i=0;i<8;++i){const int row=i*4+(le>>4),ch=le&15; const u32x4 v=*(const u32x4*)(stg+row*128+ch*8); ATTN_STORE16(Ow+(long)row*POUT+ch*8,v);} }
  asm volatile("s_waitcnt lgkmcnt(0)\n\ts_barrier":::"memory");
  #undef DMA_K
  #undef DMA_V
  #undef CMASK
  #undef CINIT0
  #undef CINIT1
  #undef START
  #undef RESC
  #undef ROT
}
#undef SBAR
#undef WAIT_BAR
}

__device__ __forceinline__ void attn_phase(const Frame& F, const Args& a) {
    const bf16_t* proj = (const bf16_t*)(a.ws + WS_PROJ); bf16_t* OA = (bf16_t*)(a.ws + WS_OA);
    const int vcu = (F.G % 8 == 0) ? (F.bid % 8) * (F.G / 8) + F.bid / 8 : F.bid;
    for (int i = 0;; ++i) {
        int bhm, qb;
        if (F.G == 256) { if (i >= 2) break; const int s_ = vcu & 7; bhm = vcu >> 3; qb = (i == 0) ? 15 - s_ : s_; }
        else { const int u = i * F.G + F.bid; if (u >= 512) break; bhm = u >> 4; qb = 15 - (u & 15); }
        const int b = bhm >> 3, h = (bhm >> 1) & 3, map = bhm & 1;
        const bf16_t* base = proj + (size_t)b * SEQ * INC;
        const float slope2 = exp2f(-2.0f * (h + 1)) * 1.4426950408889634f;
        attn_body::attn_unit<8>(qb, base + C_QDA + h * 128 + map * 64, base + C_KDA + h * 128 + map * 64, base + C_VDA + h * 128,
                                OA + (size_t)b * SEQ * 1024 + h * 256 + map * 128, slope2, (char*)F.lds);
    }
}
__device__ __forceinline__ void attn_combine(const Frame& F, const Args& a) {
    const bf16_t* OA = (const bf16_t*)(a.ws + WS_OA); bf16_t* Y = (bf16_t*)(a.ws + WS_YDA);
    const float lam = ((const float*)(a.ws + WS_SMALL))[0];
    const float g0 = a.in[I_SUBG][2 * F.lane] * 0.8f, g1 = a.in[I_SUBG][2 * F.lane + 1] * 0.8f;
    const int gw = F.bid * NWAVES + F.wave, NGW = F.G * NWAVES;
    for (int rb = gw; rb < T; rb += 4 * NGW) {
        unsigned w0[4][4], w1[4][4];
#pragma unroll
        for (int q = 0; q < 4; ++q) { const int r = rb + q * NGW < T ? rb + q * NGW : rb; const unsigned* orow = (const unsigned*)(OA + (size_t)r * 1024);
#pragma unroll
            for (int h = 0; h < 4; ++h) { w0[q][h] = __builtin_nontemporal_load(orow + h * 128 + F.lane); w1[q][h] = __builtin_nontemporal_load(orow + h * 128 + 64 + F.lane); } }
#pragma unroll
        for (int q = 0; q < 4; ++q) { const int r = rb + q * NGW; if (r >= T) break;
            unsigned* yrow = (unsigned*)(Y + (size_t)r * 512);
#pragma unroll
            for (int h = 0; h < 4; ++h) {
                const float x0 = bf2f(w0[q][h] & 0xffffu) - lam * bf2f(w1[q][h] & 0xffffu), x1 = bf2f(w0[q][h] >> 16) - lam * bf2f(w1[q][h] >> 16);
                const float rs = rsqrtf(wave_sum(x0 * x0 + x1 * x1) * (1.0f / 128.0f) + EPS);
                yrow[h * 64 + F.lane] = pk2(x0 * rs * g0, x1 * rs * g1);
            } }
    }
}
namespace hg {
constexpr int QP = 136;
constexpr int L_QD = 0, L_KD = 64 * QP * 2, L_V = 2 * 64 * QP * 2, L_KE = 3 * 64 * QP * 2, L_SSQ = 4 * 64 * QP * 2, L_G = L_SSQ + 512, L_ST = L_G + 64 * QP * 2;
__device__ __forceinline__ f32x4 mfma16(bf16x8 a, bf16x8 b, f32x4 c) { return __builtin_amdgcn_mfma_f32_16x16x32_bf16(a, b, c, 0, 0, 0); }
#define HG_BAR() do { asm volatile("s_waitcnt lgkmcnt(0)" ::: "memory"); __builtin_amdgcn_s_barrier(); asm volatile("" ::: "memory"); } while (0)
typedef short v4i16_t __attribute__((ext_vector_type(4)));
__device__ __forceinline__ bf16x8 tr8(const LAS unsigned char* img, int ra, int rb, int col0, int lane) {
    const int q = (lane & 15) >> 2, p = lane & 3;
    const v4i16_t lo = __builtin_amdgcn_ds_read_tr16_b64_v4i16((LAS v4i16_t*)(img + ((ra + q) * QP + col0 + 4 * p) * 2));
    const v4i16_t hi = __builtin_amdgcn_ds_read_tr16_b64_v4i16((LAS v4i16_t*)(img + ((rb + q) * QP + col0 + 4 * p) * 2));
    return (bf16x8){lo[0], lo[1], lo[2], lo[3], hi[0], hi[1], hi[2], hi[3]};
}
struct Tile { u32x4 p[2]; };
__device__ __forceinline__ void tile_load(Tile& t, const bf16_t* src, size_t pitch, int tid) {
#pragma unroll
    for (int i = 0; i < 2; ++i) { const int pc = tid + NTHR * i; t.p[i] = *(const u32x4*)(src + (size_t)(pc >> 4) * pitch + (pc & 15) * 8); }
}
__device__ __forceinline__ void tile_put(const Tile& t, LAS unsigned char* img, int tid) {
#pragma unroll
    for (int i = 0; i < 2; ++i) { const int pc = tid + NTHR * i; *(LAS u32x4*)(img + ((pc >> 4) * QP + (pc & 15) * 8) * 2) = t.p[i]; }
}
__device__ __forceinline__ void tile_get(Tile& t, const LAS unsigned char* img, int tid) {
#pragma unroll
    for (int i = 0; i < 2; ++i) { const int pc = tid + NTHR * i; t.p[i] = *(const LAS u32x4*)(img + ((pc >> 4) * QP + (pc & 15) * 8) * 2); }
}
__device__ __forceinline__ void tile_store(const Tile& t, bf16_t* dst, size_t pitch, int tid) {
#pragma unroll
    for (int i = 0; i < 2; ++i) { const int pc = tid + NTHR * i; *(u32x4*)(dst + (size_t)(pc >> 4) * pitch + (pc & 15) * 8) = t.p[i]; }
}
constexpr int PP = 72;
constexpr int G4_L_P = 4 * 64 * QP * 2, G4_L_DEC = G4_L_P + 64 * PP * 2, G4_L_SSQ = G4_L_DEC + 512, G4_L_DEC4 = G4_L_SSQ + 2048;
struct InA { Tile qd, kd, ke, v; };
__device__ __forceinline__ void loadA(InA& r, const Frame& F, const Args& a, int bh, int n) {
    const int b = bh >> 2, h = bh & 3; const size_t t0 = (size_t)b * SEQ + n * 64;
    const bf16_t* base = (const bf16_t*)(a.ws + WS_PROJ) + t0 * INC;
    tile_load(r.qd, base + C_HGT + 256 * h, INC, F.tid); tile_load(r.kd, base + C_HGT + 256 * h + 128, INC, F.tid);
    tile_load(r.ke, (const bf16_t*)a.out + t0 * 512 + h * 128, 512, F.tid); tile_load(r.v, base + C_IHG + h * 128, INC, F.tid);
}
#define G4_DEC_LOAD()  const int dcq_ = (F.tid >> 5) & 3; const f32x4 dv_ = *(const f32x4*)((const float*)(a.ws + WS_DEC) + ((size_t)bh * 64 + n0 + dcq_) * 128 + 4 * (F.tid & 31))
#define G4_DEC_PUT()   *(LAS f32x4*)(F.lds + G4_L_DEC4 + dcq_ * 512 + 16 * (F.tid & 31)) = dv_
__device__ __forceinline__ void grp_local(const Frame& F, const Args& a, int grp) {
    const int bh = grp >> 4, n0 = 4 * (grp & 15), b = bh >> 2, h = bh & 3, w = F.wave, lane = F.lane, fr = lane & 15, fq = lane >> 4;
    for (int i = F.tid; i < 64 * PP / 2; i += NTHR) ((LAS unsigned*)(F.lds + G4_L_P))[i] = 0u;
    f32x4 S[8];
#pragma unroll
    for (int kt = 0; kt < 8; ++kt) S[kt] = (f32x4){0.f, 0.f, 0.f, 0.f};
    G4_DEC_LOAD();
    InA c4[3];
    loadA(c4[0], F, a, bh, n0); loadA(c4[1], F, a, bh, n0 + 1);
    G4_DEC_PUT();
#define G4_STORE(nn) do { Tile ot_; tile_get(ot_, F.lds + L_KD, F.tid); tile_store(ot_, (bf16_t*)(a.ws + WS_YHG) + ((size_t)b * SEQ + (nn) * 64) * 512 + h * 128, 512, F.tid); } while (0)
#pragma unroll
    for (int j = 0; j < 4; ++j) {
        InA& cur = c4[j % 3];
        if (j > 0) G4_STORE(n0 + j - 1);
        if (j + 2 < 4) loadA(c4[(j + 2) % 3], F, a, bh, n0 + j + 2);
        tile_put(cur.qd, F.lds + L_QD, F.tid); tile_put(cur.kd, F.lds + L_KD, F.tid); tile_put(cur.ke, F.lds + L_KE, F.tid); tile_put(cur.v, F.lds + L_V, F.tid);
        HG_BAR();
#pragma unroll
        for (int rep = 0; rep < 2; ++rep) { const int pi = w + 8 * rep;
            if (pi < 10) { const int tb = pi >= 6 ? 3 : pi >= 3 ? 2 : pi >= 1 ? 1 : 0, jt = pi - (tb * (tb + 1)) / 2;
                f32x4 sc = (f32x4){0.f, 0.f, 0.f, 0.f};
#pragma unroll
                for (int ks = 0; ks < 4; ++ks) { const bf16x8 kf = *(const LAS bf16x8*)(F.lds + L_KD + ((16 * jt + fr) * QP + 32 * ks + 8 * fq) * 2);
                    const bf16x8 qf = *(const LAS bf16x8*)(F.lds + L_QD + ((16 * tb + fr) * QP + 32 * ks + 8 * fq) * 2); sc = mfma16(kf, qf, sc); }
                if (jt == tb) {
#pragma unroll
                    for (int r = 0; r < 4; ++r) if (4 * fq + r > fr) sc[r] = 0.f;
                }
                *(LAS u32x2*)(F.lds + G4_L_P + ((16 * tb + fr) * PP + 16 * jt + 4 * fq) * 2) = (u32x2){cvt_pk_bf16(sc[0], sc[1]), cvt_pk_bf16(sc[2], sc[3])}; } }
        HG_BAR();
        bf16x8 bv[2];
#pragma unroll
        for (int s2 = 0; s2 < 2; ++s2) bv[s2] = tr8(F.lds + L_V, 32 * s2 + 8 * fq, 32 * s2 + 8 * fq + 4, 16 * w, lane);
        bf16x8 Sb[4];
#pragma unroll
        for (int ks = 0; ks < 4; ++ks) { const u32x4 t = (u32x4){cvt_pk_bf16(S[2 * ks][0], S[2 * ks][1]), cvt_pk_bf16(S[2 * ks][2], S[2 * ks][3]), cvt_pk_bf16(S[2 * ks + 1][0], S[2 * ks + 1][1]), cvt_pk_bf16(S[2 * ks + 1][2], S[2 * ks + 1][3])};
            Sb[ks] = __builtin_bit_cast(bf16x8, t); }
#pragma unroll
        for (int tb = 0; tb < 4; ++tb) { f32x4 o = (f32x4){0.f, 0.f, 0.f, 0.f};
#pragma unroll
            for (int s2 = 0; s2 <= (tb >> 1); ++s2) { const bf16x8 pf = *(const LAS bf16x8*)(F.lds + G4_L_P + ((16 * tb + fr) * PP + 32 * s2 + 8 * fq) * 2); o = mfma16(pf, bv[s2], o); }
            if (j > 0) {
#pragma unroll
                for (int ks = 0; ks < 4; ++ks) { const LAS unsigned char* qrow = F.lds + L_QD + ((16 * tb + fr) * QP + 32 * ks + 4 * fq) * 2;
                    const u32x2 lo = *(const LAS u32x2*)qrow, hi = *(const LAS u32x2*)(qrow + 32);
                    const u32x4 aw = (u32x4){lo.x, lo.y, hi.x, hi.y}; o = mfma16(__builtin_bit_cast(bf16x8, aw), Sb[ks], o); } }
#pragma unroll
            for (int r = 0; r < 4; ++r) *(LAS unsigned short*)(F.lds + L_KD + ((16 * tb + 4 * fq + r) * QP + 16 * w + fr) * 2) = (unsigned short)f2bf(o[r]); }
#pragma unroll
        for (int kt = 0; kt < 8; ++kt) { S[kt] = S[kt] * *(const LAS f32x4*)(F.lds + G4_L_DEC4 + j * 512 + (16 * kt + 4 * fq) * 4);
#pragma unroll
            for (int s2 = 0; s2 < 2; ++s2) S[kt] = mfma16(tr8(F.lds + L_KE, 32 * s2 + 8 * fq, 32 * s2 + 8 * fq + 4, 16 * kt, lane), bv[s2], S[kt]); }
        HG_BAR();
    }
    G4_STORE(n0 + 3);
#undef G4_STORE
    f32x4* sg = (f32x4*)(a.ws + WS_DS) + ((size_t)grp * 64 + w * 8) * 64 + lane;
#pragma unroll
    for (int kt = 0; kt < 8; ++kt) sg[kt * 64] = S[kt];
}
__device__ __forceinline__ void grp_scan(const Frame& F, const Args& a) {
    const f32x2* sg = (const f32x2*)(a.ws + WS_DS); f32x2* si = (f32x2*)(a.ws + WS_DS) + (size_t)256 * 8192; const float* dec = (const float*)(a.ws + WS_DEC);
    for (int gt = F.bid * NTHR + F.tid; gt < 16 * 8192; gt += F.G * NTHR) {
        const int bh = gt >> 13, s2 = gt & 8191, slot = s2 >> 1, kt = (slot >> 6) & 7, lane = slot & 63, k = 16 * kt + 4 * (lane >> 4) + 2 * (s2 & 1);
        f32x2 cur = (f32x2){0.f, 0.f};
#pragma unroll
        for (int gh = 0; gh < 2; ++gh) {
            f32x2 sv[8], d[8];
#pragma unroll
            for (int g8 = 0; g8 < 8; ++g8) { const int g = 8 * gh + g8;
                sv[g8] = __builtin_nontemporal_load(sg + ((size_t)(bh * 16 + g)) * 8192 + s2);
                const float* dp = dec + ((size_t)bh * 64 + 4 * g) * 128 + k;
                d[g8] = (*(const f32x2*)dp * *(const f32x2*)(dp + 128)) * (*(const f32x2*)(dp + 256) * *(const f32x2*)(dp + 384)); }
#pragma unroll
            for (int g8 = 0; g8 < 8; ++g8) { const int g = 8 * gh + g8;
                si[((size_t)(bh * 16 + g)) * 8192 + s2] = cur;
                cur = d[g8] * cur + sv[g8]; }
        }
    }
}
struct InC { Tile qd, g, ol; };
__device__ __forceinline__ void loadC(InC& r, const Frame& F, const Args& a, int bh, int n) {
    const int b = bh >> 2, h = bh & 3; const size_t t0 = (size_t)b * SEQ + n * 64;
    const bf16_t* base = (const bf16_t*)(a.ws + WS_PROJ) + t0 * INC;
    tile_load(r.qd, base + C_HGT + 256 * h, INC, F.tid); tile_load(r.g, base + C_GHG + h * 128, INC, F.tid);
    tile_load(r.ol, (const bf16_t*)(a.ws + WS_YHG) + t0 * 512 + h * 128, 512, F.tid);
}
__device__ __forceinline__ void grp_final(const Frame& F, const Args& a, int grp) {
    const int bh = grp >> 4, n0 = 4 * (grp & 15), b = bh >> 2, h = bh & 3, w = F.wave, lane = F.lane, fr = lane & 15, fq = lane >> 4;
    f32x4 S[8];
    { const f32x4* si = (const f32x4*)(a.ws + WS_DS) + (size_t)256 * 4096 + ((size_t)grp * 64 + w * 8) * 64 + lane;
#pragma unroll
      for (int kt = 0; kt < 8; ++kt) S[kt] = si[kt * 64]; }
    const float ng = a.in[I_HGNG][16 * w + fr];
    LAS float* SSQ = (LAS float*)(F.lds + G4_L_SSQ);
    G4_DEC_LOAD();
    InC cur, nxt; loadC(cur, F, a, bh, n0);
    G4_DEC_PUT();
#define G4_STORE(nn) do { Tile ot_; tile_get(ot_, F.lds + L_V, F.tid); tile_store(ot_, (bf16_t*)(a.ws + WS_YHG) + ((size_t)b * SEQ + (nn) * 64) * 512 + h * 128, 512, F.tid); } while (0)
    for (int j = 0; j < 4; ++j) {
        if (j > 0) G4_STORE(n0 + j - 1);
        loadC(nxt, F, a, bh, n0 + (j < 3 ? j + 1 : 3));
        tile_put(cur.qd, F.lds + L_QD, F.tid); tile_put(cur.g, F.lds + L_KD, F.tid); tile_put(cur.ol, F.lds + L_V, F.tid);
        HG_BAR();
        bf16x8 Sb[4];
#pragma unroll
        for (int ks = 0; ks < 4; ++ks) { const u32x4 t = (u32x4){cvt_pk_bf16(S[2 * ks][0], S[2 * ks][1]), cvt_pk_bf16(S[2 * ks][2], S[2 * ks][3]), cvt_pk_bf16(S[2 * ks + 1][0], S[2 * ks + 1][1]), cvt_pk_bf16(S[2 * ks + 1][2], S[2 * ks + 1][3])};
            Sb[ks] = __builtin_bit_cast(bf16x8, t); }
        f32x4 o[4];
#pragma unroll
        for (int tb = 0; tb < 4; ++tb) {
#pragma unroll
            for (int r = 0; r < 4; ++r) o[tb][r] = bf2f(*(const LAS unsigned short*)(F.lds + L_V + ((16 * tb + 4 * fq + r) * QP + 16 * w + fr) * 2));
#pragma unroll
            for (int ks = 0; ks < 4; ++ks) { const LAS unsigned char* qrow = F.lds + L_QD + ((16 * tb + fr) * QP + 32 * ks + 4 * fq) * 2;
                const u32x2 lo = *(const LAS u32x2*)qrow, hi = *(const LAS u32x2*)(qrow + 32);
                const u32x4 aw = (u32x4){lo.x, lo.y, hi.x, hi.y}; o[tb] = mfma16(__builtin_bit_cast(bf16x8, aw), Sb[ks], o[tb]); }
#pragma unroll
            for (int r = 0; r < 4; ++r) { const float v = scan16(o[tb][r] * o[tb][r]); if (fr == 15) SSQ[w * 64 + 16 * tb + 4 * fq + r] = v; } }
#pragma unroll
        for (int kt = 0; kt < 8; ++kt) S[kt] = S[kt] * *(const LAS f32x4*)(F.lds + G4_L_DEC4 + j * 512 + (16 * kt + 4 * fq) * 4);
        HG_BAR();
#pragma unroll
        for (int tb = 0; tb < 4; ++tb) { f32x4 tot = (f32x4){0.f, 0.f, 0.f, 0.f};
#pragma unroll
            for (int ww = 0; ww < 8; ++ww) tot += *(const LAS f32x4*)(SSQ + ww * 64 + 16 * tb + 4 * fq);
#pragma unroll
            for (int r = 0; r < 4; ++r) { const float rs = rsqrtf(tot[r] * (1.0f / 128.0f) + EPS); const float g = bf2f(*(const LAS unsigned short*)(F.lds + L_KD + ((16 * tb + 4 * fq + r) * QP + 16 * w + fr) * 2));
                *(LAS unsigned short*)(F.lds + L_V + ((16 * tb + 4 * fq + r) * QP + 16 * w + fr) * 2) = (unsigned short)f2bf(o[tb][r] * rs * ng * g * __builtin_amdgcn_rcpf(1.0f + __builtin_amdgcn_exp2f(-1.4426950408889634f * g))); } }
        HG_BAR();
        cur = nxt;
    }
    G4_STORE(n0 + 3);
#undef G4_STORE
}
#undef HG_BAR
}

__device__ __forceinline__ float rs4(float a0, float a1, float a2, float a3, int lane) {
    const bool hi = (lane & 32) != 0;
    const float s0 = hi ? a0 : a2, s1 = hi ? a1 : a3;
    const float k0 = (hi ? a2 : a0) + __shfl_xor(s0, 32), k1 = (hi ? a3 : a1) + __shfl_xor(s1, 32);
    const bool b4 = (lane & 16) != 0;
    const float sd = b4 ? k0 : k1;
    float k = (b4 ? k1 : k0) + __shfl_xor(sd, 16);
    k += __shfl_xor(k, 8); k += __shfl_xor(k, 4); k += __shfl_xor(k, 2); k += __shfl_xor(k, 1);
    return k;
}
__device__ __forceinline__ void phase_router(const Frame& F, const Args& a) {
    constexpr int AP = 1032;
    LAS bf16_t* AH = (LAS bf16_t*)F.lds;
    LAS bf16_t* AL = AH + 16 * AP;
    LAS float* PART = (LAS float*)(F.lds + 2 * 16 * AP * 2);
    LAS float* LG = PART + 8 * 16 * 48;
    LAS unsigned* LH = (LAS unsigned*)(LG + 16 * 48);
    LAS unsigned* LB = LH + 32;
    LAS unsigned* LR = LH + 64;
    if (F.tid < NEXP) LH[F.tid] = 0u;
    const float* mod = (const float*)(a.ws + WS_MOD);
    const bf16_t* x1 = (const bf16_t*)(a.ws + WS_X1B); bf16_t* H2 = (bf16_t*)(a.ws + WS_ACT);
    unsigned* counts = (unsigned*)(a.ws + WS_CTL) + CW_COUNTS; unsigned* tokinfo = (unsigned*)(a.ws + WS_TOKINFO); int* toklist = (int*)(a.ws + WS_TOKLIST);
    const int rows_per_blk = T / F.G, r0 = F.bid * rows_per_blk, b = r0 / SEQ;
    const int lane = F.lane, w = F.wave, fr = lane & 15, fq = lane >> 4;
    f32x4 v[2][4], vn[2][4];
#define RT_LOAD(V, rb_) do { _Pragma("unroll") for (int q = 0; q < 2; ++q) { const u32x2* xr_ = (const u32x2*)(x1 + (size_t)((rb_) + 2 * w + q) * D) + lane; \
        _Pragma("unroll") for (int j = 0; j < 4; ++j) { const u32x2 t_ = xr_[64 * j]; V[q][j] = (f32x4){bf2f(t_.x & 0xffffu), bf2f(t_.x >> 16), bf2f(t_.y & 0xffffu), bf2f(t_.y >> 16)}; } } } while (0)
    RT_LOAD(v, r0);
    bf16x8 Bh[4][3], Bl[4][3];
    {
        const float* wre = a.in[I_WRE]; const float* wrg = a.in[I_WRG];
#pragma unroll
        for (int ks = 0; ks < 4; ++ks)
#pragma unroll
            for (int ct = 0; ct < 3; ++ct) {
                unsigned hw[4], lw[4];
#pragma unroll
                for (int jp = 0; jp < 4; ++jp) { float x[2];
#pragma unroll
                    for (int z = 0; z < 2; ++z) { const int k = 128 * w + 32 * ks + 8 * fq + 2 * jp + z;
                        if (ct == 0) { const float g = wrg[k * 4 + (fr & 3)], e = wre[k * 32 + ((fr + 28) & 31)]; x[z] = fr < 4 ? g : e; }
                        else if (ct == 1) x[z] = wre[k * 32 + 12 + fr];
                        else { const float e = wre[k * 32 + 28 + (fr & 3)]; x[z] = fr < 4 ? e : 0.f; } }
                    const unsigned h0 = f2bf(x[0]), h1 = f2bf(x[1]); hw[jp] = h0 | (h1 << 16);
                    lw[jp] = pk2(x[0] - bf2f(h0), x[1] - bf2f(h1)); }
                Bh[ks][ct] = __builtin_bit_cast(bf16x8, (u32x4){hw[0], hw[1], hw[2], hw[3]}); Bl[ks][ct] = __builtin_bit_cast(bf16x8, (u32x4){lw[0], lw[1], lw[2], lw[3]});
            }
    }
    f32x4 ggv[4], shv[4];
#pragma unroll
    for (int j = 0; j < 4; ++j) { const int k = 256 * j + 4 * lane;
        ggv[j] = *(const f32x4*)(a.in[I_N2G] + k) * (1.0f + *(const f32x4*)(mod + b * 6144 + 4 * 1024 + k)); shv[j] = *(const f32x4*)(mod + b * 6144 + 3 * 1024 + k); }
    for (int g = 0; g < rows_per_blk / 16; ++g) {
        const int rg = r0 + 16 * g;
        { const int gn = g + 1 < rows_per_blk / 16 ? g + 1 : g; RT_LOAD(vn, r0 + 16 * gn); }
#pragma unroll
        for (int q = 0; q < 2; ++q) { float sq = 0.f;
#pragma unroll
            for (int j = 0; j < 4; ++j) sq += (v[q][j].x * v[q][j].x + v[q][j].y * v[q][j].y) + (v[q][j].z * v[q][j].z + v[q][j].w * v[q][j].w);
            const float rs = rsqrtf(wave_sum(sq) * (1.0f / D) + EPS); const int row = 2 * w + q;
#pragma unroll
            for (int j = 0; j < 4; ++j) { const int k = 256 * j + 4 * lane;
                const f32x4 hv = v[q][j] * rs * ggv[j] + shv[j];
                const unsigned h0 = f2bf(hv.x), h1 = f2bf(hv.y), h2_ = f2bf(hv.z), h3 = f2bf(hv.w);
                const u32x2 hw = (u32x2){h0 | (h1 << 16), h2_ | (h3 << 16)};
                *(u32x2*)(H2 + (size_t)(rg + row) * D + k) = hw;
                *(LAS u32x2*)(AH + row * AP + k) = hw;
                *(LAS u32x2*)(AL + row * AP + k) = (u32x2){pk2(hv.x - bf2f(h0), hv.y - bf2f(h1)), pk2(hv.z - bf2f(h2_), hv.w - bf2f(h3))}; } }
        __syncthreads();
        f32x4 acc[3] = {{0.f, 0.f, 0.f, 0.f}, {0.f, 0.f, 0.f, 0.f}, {0.f, 0.f, 0.f, 0.f}};
#pragma unroll
        for (int ks = 0; ks < 4; ++ks) { const bf16x8 ah = *(const LAS bf16x8*)(AH + fr * AP + 128 * w + 32 * ks + 8 * fq), al = *(const LAS bf16x8*)(AL + fr * AP + 128 * w + 32 * ks + 8 * fq);
#pragma unroll
            for (int ct = 0; ct < 3; ++ct) { acc[ct] = __builtin_amdgcn_mfma_f32_16x16x32_bf16(ah, Bh[ks][ct], acc[ct], 0, 0, 0);
                acc[ct] = __builtin_amdgcn_mfma_f32_16x16x32_bf16(al, Bh[ks][ct], acc[ct], 0, 0, 0); acc[ct] = __builtin_amdgcn_mfma_f32_16x16x32_bf16(ah, Bl[ks][ct], acc[ct], 0, 0, 0); } }
#pragma unroll
        for (int ct = 0; ct < 3; ++ct)
#pragma unroll
            for (int r = 0; r < 4; ++r) PART[(w * 16 + 4 * fq + r) * 48 + 16 * ct + fr] = acc[ct][r];
        __syncthreads();
        for (int t = F.tid; t < 16 * 48; t += NTHR) { const int row = t / 48, o = t % 48; float sacc = 0.f;
#pragma unroll
            for (int ww = 0; ww < 8; ++ww) sacc += PART[(ww * 16 + row) * 48 + o];
            if (o < 36) LG[row * 48 + o] = sacc + (o < 4 ? a.in[I_BRG][o & 3] : a.in[I_BRE][(o + 28) & 31]); }
        __syncthreads();
        if (F.tid < 16) {
            const LAS float* lg = LG + F.tid * 48;
            float gl[4]; int gi = 0;
#pragma unroll
            for (int o = 0; o < 4; ++o) gl[o] = lg[o];
            float gm = gl[0];
#pragma unroll
            for (int o = 1; o < 4; ++o) if (gl[o] > gm) { gm = gl[o]; gi = o; }
            float gsum = 0.f;
#pragma unroll
            for (int o = 0; o < 4; ++o) gsum += expf(gl[o] - gm);
            const float gp = 1.0f / gsum;
            float el[8];
#pragma unroll
            for (int e = 0; e < 8; ++e) el[e] = lg[4 + gi * 8 + e];
            int i0 = 0; float m0 = el[0];
#pragma unroll
            for (int o = 1; o < 8; ++o) if (el[o] > m0) { m0 = el[o]; i0 = o; }
            int i1 = -1; float m1 = -INFINITY;
#pragma unroll
            for (int o = 0; o < 8; ++o) if (o != i0 && el[o] > m1) { m1 = el[o]; i1 = o; }
            const float e1 = expf(m1 - m0); const float w0 = gp / (1.0f + e1), w1 = gp * e1 / (1.0f + e1);
            const int rl = 16 * g + F.tid, ex0 = gi * 8 + i0, ex1 = gi * 8 + i1;
            const unsigned l0 = atomicAdd((unsigned*)(LH + ex0), 1u), l1 = atomicAdd((unsigned*)(LH + ex1), 1u);
            LAS unsigned* ri = LR + rl * 6;
            ri[0] = (unsigned)ex0; ri[1] = l0; ri[2] = (unsigned)ex1; ri[3] = l1; ri[4] = __float_as_uint(w0); ri[5] = __float_as_uint(w1);
        }
#pragma unroll
        for (int q = 0; q < 2; ++q)
#pragma unroll
            for (int j = 0; j < 4; ++j) v[q][j] = vn[q][j];
    }
#undef RT_LOAD
    __syncthreads();
    if (F.tid < NEXP) LB[F.tid] = atomicAdd(counts + 64 * F.tid, LH[F.tid]);
    __syncthreads();
    for (int rl = F.tid; rl < rows_per_blk; rl += NTHR) {
        const LAS unsigned* ri = LR + rl * 6; const int r = r0 + rl;
        const unsigned ex0 = ri[0], ex1 = ri[2], k0 = LB[ex0] + ri[1], k1 = LB[ex1] + ri[3];
        toklist[ex0 * T + k0] = r; toklist[ex1 * T + k1] = r;
        u32x4 t0; t0.x = ex0; t0.y = k0; t0.z = ex1; t0.w = k1;
        *(u32x4*)(tokinfo + (size_t)r * 8) = t0;
        tokinfo[(size_t)r * 8 + 4] = ri[4]; tokinfo[(size_t)r * 8 + 5] = ri[5];
    }
}
__device__ __forceinline__ void build_moe_tab(const Frame& F, const Args& a, LAS MoeTab* tab) {
    if (F.wave == 0) {
        const unsigned* counts = (const unsigned*)(a.ws + WS_CTL) + CW_COUNTS;
        const int e = F.lane & 31;
        const int c = (int)__hip_atomic_load(counts + 64 * e, __ATOMIC_RELAXED, __HIP_MEMORY_SCOPE_AGENT);
        const int n = (c + 255) >> 8; int incl = n;
#pragma unroll
        for (int d = 1; d < 32; d <<= 1) { const int t = __shfl_up(incl, d, 32); if (e >= d) incl += t; }
        const int base = incl - n;
        if (F.lane < 32) { tab->cnt[e] = c; tab->tbase[e] = base;
            for (int m = 0; m < n; ++m) { tab->tile_e[base + m] = e; tab->tile_m[base + m] = m; } }
        if (F.lane == 31) { tab->tbase[NEXP] = incl; tab->nt = incl; }
    }
    __syncthreads();
}
__device__ __forceinline__ void phase_final(const Frame& F, const Args& a, const LAS MoeTab* tab) {
    const float* mod = (const float*)(a.ws + WS_MOD); const unsigned* tokinfo = (const unsigned*)(a.ws + WS_TOKINFO); const bf16_t* Ys = (const bf16_t*)(a.ws + WS_YS);
    const int rows_per_blk = T / F.G, r0 = F.bid * rows_per_blk;
    f32x4 fgv[4], gtv[4];
#pragma unroll
    for (int j = 0; j < 4; ++j) { const int k = 256 * j + 4 * F.lane; fgv[j] = *(const f32x4*)(a.in[I_FG] + k); gtv[j] = *(const f32x4*)(mod + (r0 / SEQ) * 6144 + 5 * 1024 + k); }
    for (int rb = r0 + F.wave; rb < r0 + rows_per_blk; rb += 4 * NWAVES) {
        u32x4 ti[4]; u32x2 tw[4];
#pragma unroll
        for (int q = 0; q < 4; ++q) { const int r = rb + q * NWAVES < r0 + rows_per_blk ? rb + q * NWAVES : rb;
            ti[q] = *(const u32x4*)(tokinfo + (size_t)r * 8); tw[q] = *(const u32x2*)(tokinfo + (size_t)r * 8 + 4); }
        u32x2 xq[4][4], a0[4][4], a1[4][4];
#pragma unroll
        for (int q = 0; q < 4; ++q) { const int r = rb + q * NWAVES < r0 + rows_per_blk ? rb + q * NWAVES : rb;
            const size_t s0 = (size_t)tab->tbase[ti[q].x] * 256 + ti[q].y, s1 = (size_t)tab->tbase[ti[q].z] * 256 + ti[q].w;
            const u32x2* xb = (const u32x2*)((const bf16_t*)(a.ws + WS_X1B) + (size_t)r * D) + F.lane;
            const u32x2* y0 = (const u32x2*)(Ys + s0 * D) + F.lane; const u32x2* y1 = (const u32x2*)(Ys + s1 * D) + F.lane;
#pragma unroll
            for (int j = 0; j < 4; ++j) { xq[q][j] = __builtin_nontemporal_load(xb + 64 * j); a0[q][j] = __builtin_nontemporal_load(y0 + 64 * j); a1[q][j] = __builtin_nontemporal_load(y1 + 64 * j); } }
#pragma unroll
        for (int q = 0; q < 4; ++q) { const int r = rb + q * NWAVES; if (r >= r0 + rows_per_blk) break;
            const int b = r / SEQ; const float w0 = __uint_as_float(tw[q].x), w1 = __uint_as_float(tw[q].y);
            f32x4* xr = (f32x4*)(a.out + (size_t)r * D) + F.lane;
            f32x4 v[4]; float s = 0.f;
#pragma unroll
            for (int j = 0; j < 4; ++j) { const int k = 256 * j + 4 * F.lane;
                const f32x4 gt = gtv[j]; const u32x2 p0 = a0[q][j], p1 = a1[q][j], px = xq[q][j];
                f32x4 m; m.x = w0 * bf2f(p0.x & 0xffffu) + w1 * bf2f(p1.x & 0xffffu); m.y = w0 * bf2f(p0.x >> 16) + w1 * bf2f(p1.x >> 16);
                m.z = w0 * bf2f(p0.y & 0xffffu) + w1 * bf2f(p1.y & 0xffffu); m.w = w0 * bf2f(p0.y >> 16) + w1 * bf2f(p1.y >> 16);
                const f32x4 xv = (f32x4){bf2f(px.x & 0xffffu), bf2f(px.x >> 16), bf2f(px.y & 0xffffu), bf2f(px.y >> 16)};
                v[j] = xv + gt * m; s += (v[j].x * v[j].x + v[j].y * v[j].y) + (v[j].z * v[j].z + v[j].w * v[j].w); }
            const float rs = rsqrtf(wave_sum(s) * (1.0f / D) + EPS);
#pragma unroll
            for (int j = 0; j < 4; ++j) __builtin_nontemporal_store(v[j] * rs * fgv[j], xr + 64 * j); }
    }
}

#define XB_TMO      128
#define XB_XCNT(j)  (256  + 64 * (j))
#define XB_XSUB(j)  (1280 + 64 * (j))
#define XB_XGEN(j)  (2304 + 64 * (j))
#define XB_TOP      3328
#define XB_TOPGEN   3392
#define XCD_BAR_WORDS 3456
#define XB_SPIN_CAP (1u << 18)
__device__ __forceinline__ unsigned xb_ld(unsigned* p)              { return __hip_atomic_load(p, __ATOMIC_RELAXED, __HIP_MEMORY_SCOPE_AGENT); }
__device__ __forceinline__ unsigned xb_add(unsigned* p, unsigned v) { return __hip_atomic_fetch_add(p, v, __ATOMIC_RELAXED, __HIP_MEMORY_SCOPE_AGENT); }
__device__ __forceinline__ unsigned xb_xcc_id() { return (unsigned)__builtin_amdgcn_s_getreg((3 << 11) | 20) & 0xFu; }
#define XB_SPIN(cond, bar) do { unsigned _sp = 0; while (cond) { __builtin_amdgcn_s_sleep(1); \
    if ((++_sp & 255u) == 0u) { if (xb_ld(&(bar)[XB_TMO])) break; if (_sp > XB_SPIN_CAP) { atomicAdd(&(bar)[XB_TMO], 1u); break; } } } } while (0)
struct XcdBarrier { unsigned* bar; unsigned x; volatile LAS unsigned* st; };
__device__ __forceinline__ XcdBarrier xcd_barrier_post(unsigned* bar, volatile LAS unsigned* st) {
    XcdBarrier b; b.bar = bar; b.x = xb_xcc_id(); b.st = st;
    if (threadIdx.x == 0) (void)xb_add(&bar[XB_XCNT(b.x)], 1u);
    return b;
}
__device__ __forceinline__ void xcd_barrier_complete(unsigned* bar, unsigned x, unsigned& nloc, unsigned& nx) {
    const unsigned G = gridDim.x * gridDim.y * gridDim.z;
    unsigned sum, cnt, mine, sp = 0u;
    for (;;) {
        sum = 0u; cnt = 0u; mine = 0u;
#pragma unroll
        for (unsigned j = 0; j < 16; ++j) { const unsigned c = xb_ld(&bar[XB_XCNT(j)]); sum += c; cnt += (c > 0u) ? 1u : 0u; mine = (j == x) ? c : mine; }
        if (sum == G) break;
        __builtin_amdgcn_s_sleep(1);
        if ((++sp & 255u) == 0u) { if (xb_ld(&bar[XB_TMO])) break; if (sp > XB_SPIN_CAP) { atomicAdd(&bar[XB_TMO], 1u); break; } }
    }
    nloc = mine > 0u ? mine : 1u; nx = cnt > 0u ? cnt : 1u;
}
__device__ __forceinline__ void xcd_barrier(const XcdBarrier& b) {
    asm volatile("s_waitcnt vmcnt(0)" ::: "memory");
    __syncthreads();
    if (threadIdx.x == 0) {
        unsigned* bar = b.bar;
        __builtin_amdgcn_s_waitcnt(0);
        unsigned nloc = b.st[0], nx = b.st[1];
        if (nloc == 0u) { xcd_barrier_complete(bar, b.x, nloc, nx); b.st[0] = nloc; b.st[1] = nx; }
        const unsigned old = xb_add(&bar[XB_XSUB(b.x)], 1u);
        const unsigned gen = old / nloc;
        if (old + 1u == (gen + 1u) * nloc) {
            __builtin_amdgcn_fence(__ATOMIC_RELEASE, "agent");
            asm volatile("s_waitcnt vmcnt(0)" ::: "memory");
            const unsigned og = xb_add(&bar[XB_TOP], 1u);
            const unsigned tg = og / nx;
            if (og + 1u == (tg + 1u) * nx) xb_add(&bar[XB_TOPGEN], 1u);
            else XB_SPIN(xb_ld(&bar[XB_TOPGEN]) == tg, bar);
            __builtin_amdgcn_fence(__ATOMIC_ACQUIRE, "agent");
            xb_add(&bar[XB_XGEN(b.x)], 1u);
            asm volatile("s_waitcnt vmcnt(0)" ::: "memory");
        } else {
            XB_SPIN(xb_ld(&bar[XB_XGEN(b.x)]) == gen, bar);
            __builtin_amdgcn_fence(__ATOMIC_ACQUIRE, "agent");
            asm volatile("s_waitcnt vmcnt(0)" ::: "memory");
        }
    }
    __syncthreads();
}

constexpr int N_PHASES = 11;
__global__ void __launch_bounds__(NTHR, 2) mk_fwd(Args a) {
    extern __shared__ __attribute__((aligned(16))) unsigned char lds_raw[];
    Frame F; F.lds = (LAS unsigned char*)lds_raw; F.tid = threadIdx.x; F.lane = F.tid & 63; F.wave = __builtin_amdgcn_readfirstlane(F.tid >> 6); F.G = gridDim.x; F.bid = blockIdx.x;
    unsigned char* ws = a.ws;
    const int lo = a.ph_lo, hi = a.ph_hi;
#if MK_N_LAUNCHES == 1
    volatile LAS unsigned* MISC = (volatile LAS unsigned*)(F.lds + 152 * 1024);
    if (F.tid < 4) MISC[F.tid] = 0u;
    __syncthreads();
    XcdBarrier xbar = xcd_barrier_post((unsigned*)(ws + WS_CTL) + CW_BAR, MISC);
#define SEAM(k) do { if (IN(k) && IN((k) + 1)) xcd_barrier(xbar); } while (0)
#else
#define SEAM(k) do { } while (0)
#endif
#define IN(k) (lo <= (k) && (k) < hi)
    LAS MoeTab* tab = (LAS MoeTab*)(F.lds + 144 * 1024);

#define RUNPH(k, ...) if (IN(k)) { F.lane = lane_now(); F.tid = F.wave * 64 + F.lane; __VA_ARGS__ }
    RUNPH(0, { phase0(F, a); }) SEAM(0);
    RUNPH(1, { phase1(F, a); __syncthreads(); dense_weight_convert(F, a); }) SEAM(1);
    RUNPH(2, {
        DenseOrder S{(const char*)(ws + WS_ACT), (const char*)(ws + WS_WIN), D, T / 256, INC / 256, F.G, F.bid};
        EpiInProj E{(bf16_t*)(ws + WS_PROJ), (bf16_t*)a.out, (float*)(ws + WS_DEC), (const float*)(ws + WS_SMALL) + 16, attn_body::C2};
        pg8::gemm_phase(F.lds, D, S, E);
        int nl; const int early = w2_early_items(F.G, nl);
        if (early && F.bid >= F.G - nl) { __syncthreads(); moe_w2_convert(F, a, 0, early, (F.bid - (F.G - nl)) * NWAVES + F.wave, nl * NWAVES); }
    }) SEAM(2);
    RUNPH(3, {
        for (int g = F.bid; g < 256; g += F.G) hg::grp_local(F, a, g);
        __syncthreads();
        attn_phase(F, a);
    }) SEAM(3);
    RUNPH(4, { hg::grp_scan(F, a); attn_combine(F, a); }) SEAM(4);
    RUNPH(5, { for (int g = F.bid; g < 256; g += F.G) hg::grp_final(F, a, g); }) SEAM(5);
    RUNPH(6, {
        UpOrder S{(const char*)(ws + WS_YDA), (const char*)(ws + WS_YHG), (const char*)(ws + WS_WUPDA), (const char*)(ws + WS_WUPHG), F.G, F.bid};
        EpiUp E{(const bf16_t*)(ws + WS_PROJ), (bf16_t*)(ws + WS_ACT)};
        pg8::gemm_phase(F.lds, 512, S, E);
    }) SEAM(6);
    RUNPH(7, {
        DenseOrder S{(const char*)(ws + WS_ACT), (const char*)(ws + WS_WOUT), D, T / 256, D / 256, F.G, F.bid};
        EpiOut E{a.in[I_X], (const float*)(ws + WS_MOD), (bf16_t*)(ws + WS_X1B)};
        const bool conv_first = (F.bid >> 3) & 1;
        if (conv_first) { moe_weight_convert(F, a); __syncthreads(); }
        pg8::gemm_phase(F.lds, D, S, E);
        if (!conv_first) { __syncthreads(); moe_weight_convert(F, a); }
    }) SEAM(7);
    RUNPH(8, { phase_router(F, a); __syncthreads(); }) SEAM(8);
    RUNPH(9, {
        build_moe_tab(F, a, tab);
        unsigned* done = (unsigned*)(ws + WS_CTL) + CW_TILE;
        const int vc = (F.G & 7) == 0 ? (F.bid & 7) * (F.G >> 3) + (F.bid >> 3) : F.bid;
        { Moe1Order S{tab, (const char*)(ws + WS_ACT), (const char*)(ws + WS_W13), (const int*)(ws + WS_TOKLIST), F.G, vc};
          EpiMoe1 E{(bf16_t*)(ws + WS_HS), done};
          pg8::gemm_phase(F.lds, D, S, E); }
        { Moe2Order S{tab, (const char*)(ws + WS_HS), (const char*)a.out + OUT_W2, done, (unsigned*)(ws + WS_CTL) + CW_TMO, F.G, vc};
          EpiStoreBf16 E{(bf16_t*)(ws + WS_YS), D, 0, 1.0f};
          pg8::gemm_phase(F.lds, DEXP, S, E); }
    }) SEAM(9);
    RUNPH(10, { build_moe_tab(F, a, tab); phase_final(F, a, tab); })
#undef IN
#undef SEAM
}

extern "C" void kernel_launch(void* const* d_in, const int* in_sizes, int n_in, void* d_out, int out_size, void* d_ws, size_t ws_size, hipStream_t stream) {
    static int grid = 0;
    if (grid == 0) {
        if (n_in != 25 || in_sizes[0] != T * D || out_size != T * D || ws_size < WS_END) { fprintf(stderr, "kernel_launch: unexpected shapes (n_in %d, in0 %d, out %d, ws %zu)\n", n_in, n_in > 0 ? in_sizes[0] : -1, out_size, ws_size); grid = -1; return; }
        int dev = 0, cus = 0, per_cu = 0;
        if (hipGetDevice(&dev) != hipSuccess || hipDeviceGetAttribute(&cus, hipDeviceAttributeMultiprocessorCount, dev) != hipSuccess) { grid = -1; return; }
        if (hipFuncSetAttribute((const void*)mk_fwd, hipFuncAttributeMaxDynamicSharedMemorySize, LDS_BYTES) != hipSuccess) { fprintf(stderr, "kernel_launch: hipFuncSetAttribute failed\n"); grid = -1; return; }
        if (hipOccupancyMaxActiveBlocksPerMultiprocessor(&per_cu, (const void*)mk_fwd, NTHR, LDS_BYTES) != hipSuccess || per_cu < 1) { fprintf(stderr, "kernel_launch: occupancy query says %d\n", per_cu); per_cu = 1; }
        (void)hipGetLastError();
        grid = cus;
        if (grid > 256) grid = 256;
        while (T % grid) --grid;
    }
    if (grid < 0) return;
    (void)hipMemsetAsync((char*)d_ws + WS_CTL, 0, CTL_ZERO_BYTES, stream);
    Args a{};
    for (int i = 0; i < 25; ++i) a.in[i] = (const float*)d_in[i];
    a.out = (float*)d_out; a.ws = (unsigned char*)d_ws;
#if MK_N_LAUNCHES == 1
    a.ph_lo = 0; a.ph_hi = N_PHASES;
    void* args[] = {&a};
    hipError_t e = hipLaunchCooperativeKernel((const void*)mk_fwd, dim3(grid), dim3(NTHR), args, LDS_BYTES, stream);
    if (e != hipSuccess) fprintf(stderr, "cooperative launch failed: %s (grid %d)\n", hipGetErrorString(e), grid);
#else
    for (int p = 0; p < N_PHASES; ++p) {
        a.ph_lo = p; a.ph_hi = p + 1;
        hipLaunchKernelGGL(mk_fwd, dim3(grid), dim3(NTHR), LDS_BYTES, stream, a);
    }
#endif
}
```

```cpp
#include <hip/hip_runtime.h>
#include <cstdio>
#include <cstdint>

#ifndef MK_N_LAUNCHES
#define MK_N_LAUNCHES 1
#endif

#define LAS __attribute__((address_space(3)))
typedef unsigned short bf16_t;
typedef short bf16x8 __attribute__((ext_vector_type(8)));
typedef float f32x4 __attribute__((ext_vector_type(4)));
typedef float f32x2 __attribute__((ext_vector_type(2)));
typedef unsigned u32x4 __attribute__((ext_vector_type(4)));
typedef unsigned u32x2 __attribute__((ext_vector_type(2)));

constexpr int NB = 4, SEQ = 4096, D = 1024, T = NB * SEQ;
constexpr int INC = 5632;
constexpr int C_QDA = 0, C_KDA = 512, C_VDA = 1024, C_QHG = 1536, C_FHG = 2048, C_IHG = 2560, C_GHG = 3072, C_GDA = 3584, C_GHGATE = 4608;
constexpr int C_HGT = 1536;
constexpr int NEXP = 32, DEXP = 512;
constexpr int PMAX = 40960;
constexpr float EPS = 1e-6f;
constexpr int NWAVES = 8, NTHR = 512;

constexpr size_t MiB = 1u << 20;
constexpr size_t WS_CTL = 0, CTL_ZERO_BYTES = 64 * 1024;
constexpr size_t WS_MOD = 5 * MiB / 2;
constexpr size_t WS_SMALL = 11 * MiB / 4;
constexpr size_t WS_TOKINFO = 3 * MiB;
constexpr size_t WS_TOKLIST = 4 * MiB;
constexpr size_t WS_DEC = 6 * MiB;
constexpr size_t WS_DS = 24 * MiB;
constexpr size_t WS_WIN = 8 * MiB;
constexpr size_t WS_WUPDA = 20 * MiB, WS_WUPHG = 21 * MiB, WS_WOUT = 22 * MiB;
constexpr size_t WS_ACT = 24 * MiB;
constexpr size_t WS_PROJ = 56 * MiB;
constexpr size_t WS_YDA = 232 * MiB, WS_YHG = 248 * MiB;
constexpr size_t WS_OA = 264 * MiB;
constexpr size_t WS_W13 = 56 * MiB;
constexpr size_t WS_W2 = 120 * MiB;
constexpr size_t WS_HS = 152 * MiB;
constexpr size_t WS_YS = 192 * MiB;
constexpr size_t OUT_W2 = 16 * MiB;
constexpr int W2_EARLY = 32;
constexpr size_t WS_X1B = 272 * MiB;
constexpr size_t WS_END = 310 * MiB;
constexpr int CW_COUNTS = 64;
constexpr int CW_BAR = 4096;
constexpr int CW_TILE = 8192;
constexpr int CW_TMO = 32;

constexpr int LDS_BYTES = 160 * 1024;

__device__ __forceinline__ float bf2f(unsigned v) { return __uint_as_float(v << 16); }
__device__ __forceinline__ unsigned f2bf(float f) { unsigned u = __float_as_uint(f); return (u + 0x7fffu + ((u >> 16) & 1u)) >> 16; }
__device__ __forceinline__ unsigned pk2(float lo, float hi) { return f2bf(lo) | (f2bf(hi) << 16); }
__device__ __forceinline__ float sigmoidf_(float x) { return 1.0f / (1.0f + __expf(-x)); }
__device__ __forceinline__ float siluf_(float x) { return x / (1.0f + __expf(-x)); }
__device__ __forceinline__ int lane_now() { int l; asm volatile("v_mbcnt_lo_u32_b32 %0, -1, 0\n\tv_mbcnt_hi_u32_b32 %0, -1, %0" : "=v"(l)); return l; }
__device__ __forceinline__ float wave_sum(float v) {
#pragma unroll
    for (int o = 1; o < 64; o <<= 1) v += __shfl_xor(v, o);
    return v;
}

namespace pg8 {
constexpr int BM = 256, BK = 64, HALF = 128, HTB = HALF * BK * 2, STAGE_BYTES = 8 * HTB;
__host__ __device__ __forceinline__ int lds_byte(int r, int c) { const int st = (r >> 4) * 2 + (c >> 5), rr = r & 15, cc = c & 31, ob = rr * 64 + cc * 2; return st * 1024 + (ob ^ (((ob >> 9) & 1) << 5)); }
__host__ __device__ __forceinline__ void stage_rc(int b, int& R, int& C) { const int st = b / 1024, sb = b % 1024, swz = sb ^ (((sb >> 9) & 1) << 5); R = (st >> 1) * 16 + swz / 64; C = (st & 1) * 32 + (swz % 64) / 2; }
__host__ __device__ __forceinline__ int perm32(int rho) { const int n = rho >> 4, i = rho & 15; return 8 * (i >> 2) + 4 * n + (i & 3); }

struct Unit { int pm, pn; const char* A; const char* B; int aux; };
__device__ __forceinline__ unsigned cvt_pk_bf16(float lo, float hi) { unsigned r; asm volatile("v_cvt_pk_bf16_f32 %0, %1, %2" : "=v"(r) : "v"(lo), "v"(hi)); return r; }

template <class Epi, class Sched>
__device__ __forceinline__ void gemm_phase(LAS unsigned char* lds, const int K, const Sched& S, const Epi& E) {
    const int tid = threadIdx.x, wid = __builtin_amdgcn_readfirstlane(tid >> 6), lane = tid & 63, wr = wid >> 2, wc = wid & 3, fr = lane & 15, fq = lane >> 4;
    const int nt = K / BK;
    unsigned voffB[2];
#define PG8_SETLANE() do { const int _l = lane_now(), _t = wid * 64 + _l; _Pragma("unroll") for (int _i = 0; _i < 2; ++_i) { int _R, _C; stage_rc(_t * 16 + _i * 8192, _R, _C); \
        const int _Rb = Epi::PERM ? ((_R & ~31) + perm32(_R & 31)) : _R; voffB[_i] = (unsigned)(_Rb * K + _C) * 2u; } \
        aoff = lds_byte(wr * 64 + (_l & 15), (_l >> 4) * 8); boff = lds_byte(wc * 32 + (_l & 15), (_l >> 4) * 8); } while (0)
    const size_t kstep = (size_t)(BK * 2);
    const size_t hstep = (size_t)HALF * K * 2;
    const unsigned ldsw = (unsigned)wid * 1024u;
    int aoff, boff; PG8_SETLANE();
#define PG8_SA(b, h) (((b) * 2 + (h)) * HTB)
#define PG8_SB(b, h) ((4 + (b) * 2 + (h)) * HTB)
#define PG8_STAGE(bufoff, gbase, voff) do { _Pragma("unroll") for (int _i = 0; _i < 2; ++_i) \
        __builtin_amdgcn_global_load_lds((const unsigned*)((const char*)(gbase) + (voff)[_i]), (LAS unsigned*)(lds + (bufoff) + ldsw + _i * 8192), 16, 0, 0); } while (0)
#define PG8_LDA(dst, b, h) do { _Pragma("unroll") for (int m = 0; m < 4; ++m) _Pragma("unroll") for (int k = 0; k < 2; ++k) dst[m][k] = *(const LAS bf16x8*)(lds + PG8_SA(b, h) + aoff + m * 2048 + k * 1024); } while (0)
#define PG8_LDB(dst, b, h) do { _Pragma("unroll") for (int n = 0; n < 2; ++n) _Pragma("unroll") for (int k = 0; k < 2; ++k) dst[n][k] = *(const LAS bf16x8*)(lds + PG8_SB(b, h) + boff + n * 2048 + k * 1024); } while (0)
#define PG8_MMA(ai, bj, At, Bt) do { __builtin_amdgcn_s_setprio(1); _Pragma("unroll") for (int m = 0; m < 4; ++m) _Pragma("unroll") for (int n = 0; n < 2; ++n) _Pragma("unroll") for (int k = 0; k < 2; ++k) \
        acc[ai][bj][m][n] = __builtin_amdgcn_mfma_f32_16x16x32_bf16(Bt[n][k], At[m][k], acc[ai][bj][m][n], 0, 0, 0); __builtin_amdgcn_s_setprio(0); } while (0)
#define PG8_WAIT_V(n) asm volatile("s_waitcnt vmcnt(" #n ")" ::: "memory")
#define PG8_WAIT_L(n) asm volatile("s_waitcnt lgkmcnt(" #n ")" ::: "memory")
#define PG8_BAR __builtin_amdgcn_s_barrier()
#define PG8_SCHED __builtin_amdgcn_sched_barrier(0)
#define PG8_SETA(vo, u) do { const int _t = wid * 64 + lane_now(); _Pragma("unroll") for (int _i = 0; _i < 2; ++_i) { int _R, _C; stage_rc(_t * 16 + _i * 8192, _R, _C); \
        _Pragma("unroll") for (int _h = 0; _h < 2; ++_h) vo[_h][_i] = (unsigned)((size_t)S.arow(u, _h * HALF + _R) * (size_t)K + _C) * 2u; } if (Sched::GATHER) PG8_WAIT_V(0); } while (0)
    Unit cur, nxt; int ui = 0;
    if (!S.next(0, cur)) return;
    f32x4 acc[2][2][4][2];
#pragma unroll
    for (int a = 0; a < 2; ++a)
#pragma unroll
        for (int b = 0; b < 2; ++b)
#pragma unroll
            for (int m = 0; m < 4; ++m)
#pragma unroll
                for (int n = 0; n < 2; ++n) acc[a][b][m][n] = (f32x4){0.f, 0.f, 0.f, 0.f};
    bf16x8 At[4][2], B0[2][2], B1[2][2];
    unsigned voC[2][2], voN[2][2];
    S.a_ready(cur);
    PG8_SETA(voC, cur);
    const char* cA = cur.A; const char* cB = cur.B;
    PG8_STAGE(PG8_SB(0, 0), cB, voffB); PG8_STAGE(PG8_SB(0, 1), cB + hstep, voffB); PG8_STAGE(PG8_SA(0, 0), cA, voC[0]); PG8_STAGE(PG8_SA(0, 1), cA, voC[1]);
    if (wr == 1) PG8_BAR;
    PG8_WAIT_V(2); PG8_BAR;
    PG8_STAGE(PG8_SB(1, 0), cB + kstep, voffB); PG8_STAGE(PG8_SA(1, 0), cA + kstep, voC[0]); PG8_STAGE(PG8_SB(1, 1), cB + hstep + kstep, voffB);
    PG8_WAIT_V(6); PG8_BAR;
    for (;;) {
        const bool has_next = S.next(ui + 1, nxt);
        if (has_next) { PG8_SETA(voN, nxt); }
        else {
#pragma unroll
            for (int h = 0; h < 2; ++h)
#pragma unroll
                for (int i = 0; i < 2; ++i) voN[h][i] = voC[h][i];
        }
        const char* nA = has_next ? nxt.A : cA; const char* nB = has_next ? nxt.B : cB;
        for (int t = 0; t < nt; t += 2) {
            const bool last = (t == nt - 2);
            if (last && has_next) S.a_ready(nxt);
            const char* a1 = cA + (size_t)(t + 1) * kstep;
            const char* a2 = last ? nA : cA + (size_t)(t + 2) * kstep; const char* b2 = last ? nB : cB + (size_t)(t + 2) * kstep;
            const char* a3 = a2 + kstep; const char* b3 = b2 + kstep;
            unsigned vo2[2][2];
#pragma unroll
            for (int h = 0; h < 2; ++h)
#pragma unroll
                for (int i = 0; i < 2; ++i) vo2[h][i] = last ? voN[h][i] : voC[h][i];
            PG8_LDB(B0, 0, 0); PG8_LDB(B1, 0, 1); PG8_SCHED; PG8_LDA(At, 0, 0); PG8_STAGE(PG8_SA(1, 1), a1, voC[1]);
            PG8_WAIT_V(8); PG8_WAIT_L(0); PG8_BAR; PG8_MMA(0, 0, At, B0); PG8_MMA(0, 1, At, B1); PG8_BAR; PG8_SCHED;
            PG8_LDA(At, 0, 1); PG8_STAGE(PG8_SB(0, 0), b2, voffB); PG8_STAGE(PG8_SB(0, 1), b2 + hstep, voffB); PG8_STAGE(PG8_SA(0, 0), a2, vo2[0]);
            PG8_WAIT_V(8); PG8_WAIT_L(0); PG8_BAR; PG8_MMA(1, 0, At, B0); PG8_MMA(1, 1, At, B1); PG8_BAR; PG8_SCHED;
            PG8_LDB(B0, 1, 0); PG8_LDB(B1, 1, 1); PG8_SCHED; PG8_LDA(At, 1, 0); PG8_STAGE(PG8_SA(0, 1), a2, vo2[1]);
            PG8_WAIT_V(8); PG8_WAIT_L(0); PG8_BAR; PG8_MMA(0, 0, At, B0); PG8_MMA(0, 1, At, B1); PG8_BAR; PG8_SCHED;
            PG8_LDA(At, 1, 1); PG8_STAGE(PG8_SB(1, 0), b3, voffB); PG8_STAGE(PG8_SB(1, 1), b3 + hstep, voffB); PG8_STAGE(PG8_SA(1, 0), a3, vo2[0]);
            PG8_WAIT_V(8); PG8_WAIT_L(0); PG8_BAR; PG8_MMA(1, 0, At, B0); PG8_MMA(1, 1, At, B1); PG8_BAR; PG8_SCHED;
        }
        if (wr == 0) PG8_BAR;
        const bool keep = E(acc, cur, wr, wc, fr, fq);
        if (!has_next) break;
        if (!keep) {
#pragma unroll
            for (int a = 0; a < 2; ++a)
#pragma unroll
                for (int b = 0; b < 2; ++b)
#pragma unroll
                    for (int m = 0; m < 4; ++m)
#pragma unroll
                        for (int n = 0; n < 2; ++n) acc[a][b][m][n] = (f32x4){0.f, 0.f, 0.f, 0.f};
        }
        cur = nxt; cA = nA; cB = nB; ++ui;
        if (Sched::GATHER) {
#pragma unroll
            for (int h = 0; h < 2; ++h)
#pragma unroll
                for (int i = 0; i < 2; ++i) voC[h][i] = voN[h][i];
        } else { PG8_SETA(voC, cur); }
        PG8_SETLANE();
        if (wr == 1) PG8_BAR;
    }
    PG8_WAIT_V(0);
    PG8_BAR;
#undef PG8_SA
#undef PG8_SB
#undef PG8_STAGE
#undef PG8_LDA
#undef PG8_LDB
#undef PG8_MMA
#undef PG8_WAIT_V
#undef PG8_WAIT_L
#undef PG8_BAR
#undef PG8_SCHED
#undef PG8_SETA
#undef PG8_SETLANE
}
}

struct Args { const float* in[25]; float* out; unsigned char* ws; int ph_lo, ph_hi; };
enum { I_X = 0, I_C, I_WADA, I_BADA, I_N1G, I_WIN, I_LQ1, I_LK1, I_LQ2, I_LK2, I_SUBG, I_LBL, I_HGNG, I_WUPDA, I_WUPHG, I_WOUT, I_N2G, I_WRG, I_BRG, I_WRE, I_BRE, I_W1, I_W3, I_W2, I_FG };

struct DenseOrder {
    static constexpr bool GATHER = false;
    const char* A; const char* Bt; int K, nM, nN, G, c;
    __device__ __forceinline__ bool next(int i, pg8::Unit& u) const {
        const int L = i * G + c, nwg = nM * nN; if (L >= nwg) return false;
        int wgid = L; { const int q = nwg / 8, r = nwg % 8, xcd = wgid % 8, off = wgid / 8; wgid = (xcd < r ? xcd * (q + 1) : r * (q + 1) + (xcd - r) * q) + off; }
        const int nig = 8 * nN, gid = wgid / nig, fm = gid * 8, gsz = (nM - fm) < 8 ? (nM - fm) : 8;
        u.pm = fm + ((wgid % nig) % gsz); u.pn = (wgid % nig) / gsz; u.A = A; u.B = Bt + (size_t)u.pn * 256 * K * 2; u.aux = 0; return true;
    }
    __device__ __forceinline__ void a_ready(const pg8::Unit&) const {}
    __device__ __forceinline__ unsigned arow(const pg8::Unit& u, int r) const { return (unsigned)(u.pm * 256 + r); }
};
struct UpOrder {
    static constexpr bool GATHER = false;
    const char* A0; const char* A1; const char* B0; const char* B1; int G, c;
    __device__ __forceinline__ bool next(int i, pg8::Unit& u) const {
        const int tile = (i >> 1) * G + c; if (tile >= 256) return false;
        u.pm = tile >> 2; u.pn = tile & 3; u.aux = i & 1;
        u.A = (i & 1) ? A1 : A0; u.B = ((i & 1) ? B1 : B0) + (size_t)u.pn * 256 * 512 * 2; return true;
    }
    __device__ __forceinline__ void a_ready(const pg8::Unit&) const {}
    __device__ __forceinline__ unsigned arow(const pg8::Unit& u, int r) const { return (unsigned)(u.pm * 256 + r); }
};
struct MoeTab { int nt; int pad[3]; int tile_e[176]; int tile_m[176]; int cnt[32]; int tbase[33]; };
struct Moe1Order {
    static constexpr bool GATHER = true;
    const LAS MoeTab* tab; const char* A; const char* W; const char* Wo; const int* toklist; int G, c;
    __device__ __forceinline__ bool next(int i, pg8::Unit& u) const {
        const int L = i * G + c; if (L >= tab->nt * 4) return false;
        const int ti = L >> 2; u.pm = ti; u.pn = L & 3; u.aux = ti; u.A = A; const int e = tab->tile_e[ti];
        const int off_mib = e < 8 ? 48 + 2 * e : e < 11 ? 288 + 2 * e : e < 16 ? 2 * e - 14 : e < 24 ? 2 * e - 32 : 2 * e + 8; const bool in_out = e < 8 || (e >= 16 && e < 24);
        const char* base = (in_out ? Wo : W) + (size_t)off_mib * MiB;
        u.B = base + (size_t)u.pn * 256 * 1024 * 2; return true;
    }
    __device__ __forceinline__ void a_ready(const pg8::Unit&) const {}
    __device__ __forceinline__ unsigned arow(const pg8::Unit& u, int r) const {
        const int e = tab->tile_e[u.aux], rr = tab->tile_m[u.aux] * 256 + r; const bool ok = rr < tab->cnt[e];
        const unsigned v = (unsigned)toklist[e * T + (ok ? rr : 0)];
        return ok ? v : 0u;
    }
};
struct Moe2Order {
    static constexpr bool GATHER = false;
    const LAS MoeTab* tab; const char* A; const char* W; unsigned* done; unsigned* tmo; int G, c;
    __device__ __forceinline__ bool next(int i, pg8::Unit& u) const {
        const int n1 = tab->nt * 4, r = n1 % G, nl = G - r; int j;
        if (r > 0 && c >= r) { if (i < 2) j = (c - r) + i * nl; else j = 2 * nl + (c - r) + (i - 2) * G; }
        else j = (r > 0 ? 2 * nl : 0) + ((c - r + G) % G) + i * G;
        if (j >= n1) return false;
        const int ti = j >> 2; u.pm = ti; u.pn = j & 3; u.aux = ti; u.A = A;
        u.B = W + ((size_t)tab->tile_e[ti] * 1024 + (size_t)u.pn * 256) * 512 * 2; return true;
    }
    __device__ __forceinline__ unsigned arow(const pg8::Unit& u, int r) const { return (unsigned)(u.pm * 256 + r); }
    __device__ __forceinline__ void a_ready(const pg8::Unit& u) const {
        if (threadIdx.x < 64) {
            unsigned polls = 0;
            while ((unsigned)__builtin_amdgcn_readfirstlane(__hip_atomic_load(done + 16 * u.pm, __ATOMIC_RELAXED, __HIP_MEMORY_SCOPE_AGENT)) < 32u) {
                if (++polls > (1u << 22)) { if (threadIdx.x == 0) __hip_atomic_store(tmo, 1u, __ATOMIC_RELAXED, __HIP_MEMORY_SCOPE_AGENT); break; }
                __builtin_amdgcn_s_sleep(2); }
            __builtin_amdgcn_fence(__ATOMIC_ACQUIRE, "agent");
            asm volatile("s_waitcnt vmcnt(0)" ::: "memory");
        }
        asm volatile("" ::: "memory"); __builtin_amdgcn_s_barrier(); asm volatile("" ::: "memory");
    }
};

using pg8::Unit; using pg8::cvt_pk_bf16;
struct EpiStoreBf16 {
    static constexpr bool PERM = true;
    bf16_t* O; int ldc; int nscale; float scale0;
    __device__ __forceinline__ bool operator()(f32x4 (&acc)[2][2][4][2], const Unit& u, int wr, int wc, int fr, int fq) const {
        const int row0 = u.pm * 256 + wr * 64 + fr, col0 = u.pn * 256 + wc * 32 + 8 * fq;
        const float sc = u.pn < nscale ? scale0 : 1.0f;
#pragma unroll
        for (int ai = 0; ai < 2; ++ai)
#pragma unroll
            for (int m = 0; m < 4; ++m) { bf16_t* rowp = O + (size_t)(row0 + ai * 128 + m * 16) * ldc + col0;
#pragma unroll
                for (int bj = 0; bj < 2; ++bj) { const f32x4 v0 = acc[ai][bj][m][0] * sc, v1 = acc[ai][bj][m][1] * sc;
                    u32x4 w; w.x = cvt_pk_bf16(v0[0], v0[1]); w.y = cvt_pk_bf16(v0[2], v0[3]); w.z = cvt_pk_bf16(v1[0], v1[1]); w.w = cvt_pk_bf16(v1[2], v1[3]);
                    *(u32x4*)(rowp + bj * 128) = w; } }
        return false;
    }
};
template <int N> __device__ __forceinline__ float dpp_shr(float x) { return __builtin_bit_cast(float, __builtin_amdgcn_update_dpp(0, __builtin_bit_cast(int, x), 0x110 + N, 0xf, 0xf, true)); }
template <int N> __device__ __forceinline__ float dpp_ror(float x) { return __builtin_bit_cast(float, __builtin_amdgcn_update_dpp(0, __builtin_bit_cast(int, x), 0x120 + N, 0xf, 0xf, true)); }
__device__ __forceinline__ float rowsum16(float x) { x += dpp_ror<8>(x); x += dpp_ror<4>(x); x += dpp_ror<2>(x); x += dpp_ror<1>(x); return x; }
__device__ __forceinline__ float scan16(float x) { x += dpp_shr<1>(x); x += dpp_shr<2>(x); x += dpp_shr<4>(x); x += dpp_shr<8>(x); return x; }
template <int N> __device__ __forceinline__ float dpp_shr1(float x) { return __builtin_bit_cast(float, __builtin_amdgcn_update_dpp(0x3f800000, __builtin_bit_cast(int, x), 0x110 + N, 0xf, 0xf, false)); }
__device__ __forceinline__ float rowprod16(float x) { x *= dpp_ror<8>(x); x *= dpp_ror<4>(x); x *= dpp_ror<2>(x); x *= dpp_ror<1>(x); return x; }
__device__ __forceinline__ float scanmul16(float x) { x *= dpp_shr1<1>(x); x *= dpp_shr1<2>(x); x *= dpp_shr1<4>(x); x *= dpp_shr1<8>(x); return x; }
struct EpiInProj {
    static constexpr bool PERM = true;
    bf16_t* O; bf16_t* KE; float* DEC; const float* lbv; float scale0;
    __device__ __forceinline__ bool operator()(f32x4 (&acc)[2][2][4][2], const Unit& u, int wr, int wc, int fr, int fq) const {
        { const int l_ = lane_now(); fr = l_ & 15; fq = l_ >> 4; }
        const int row0 = u.pm * 256 + wr * 64 + fr, col0 = u.pn * 256 + wc * 32 + 8 * fq;
        if (u.pn >= 6 && u.pn < 10) {
            const int h = u.pn - 6, lane = 16 * fq + fr, kb = wc * 32 + 8 * fq;
            const int bb = (u.pm * 256) / SEQ, ch0 = ((u.pm * 256) % SEQ + wr * 64) >> 6;
            const f32x4 lb0 = *(const f32x4*)(lbv + h * 128 + kb), lb1 = *(const f32x4*)(lbv + h * 128 + kb + 4);
#pragma unroll
            for (int ai = 0; ai < 2; ++ai) {
                unsigned kep[4][4];
#pragma unroll
                for (int n = 0; n < 2; ++n) {
#pragma unroll
                    for (int ep = 0; ep < 2; ++ep) {
                        float ke2[2][4];
#pragma unroll
                        for (int z = 0; z < 2; ++z) {
                            const int e = 2 * ep + z; const float lb = n ? lb1[e] : lb0[e];
                            float f[4], c[4], tot[4];
#pragma unroll
                            for (int m = 0; m < 4; ++m) { const float fl = acc[ai][1][m][n][e]; f[m] = lb + (1.0f - lb) * __builtin_amdgcn_rcpf(1.0f + __builtin_amdgcn_exp2f(-1.4426950408889634f * fl)); c[m] = scanmul16(f[m]); tot[m] = rowprod16(f[m]); }
                            const float eal = (tot[0] * tot[1]) * (tot[2] * tot[3]);
                            float pre = 1.0f;
#pragma unroll
                            for (int m = 0; m < 4; ++m) { const float eA = c[m] * pre; pre *= tot[m]; const float q = acc[ai][0][m][n][e]; const float kk = 1.0f - f[m];
                                acc[ai][0][m][n][e] = q * __builtin_amdgcn_rcpf(1.0f + __builtin_amdgcn_exp2f(-1.4426950408889634f * q)) * eA;
                                const float kd = kk * __builtin_amdgcn_rcpf(eA); acc[ai][1][m][n][e] = kd; ke2[z][m] = kd * eal; }
                            if (fr == 0) DEC[((size_t)(bb * 4 + h) * 64 + ch0 + 2 * ai) * 128 + kb + 4 * n + e] = eal;
                        }
#pragma unroll
                        for (int m = 0; m < 4; ++m) kep[m][2 * n + ep] = cvt_pk_bf16(ke2[0][m], ke2[1][m]);
                    }
                }
#pragma unroll
                for (int m = 0; m < 4; ++m) *(u32x4*)(KE + (size_t)(row0 + ai * 128 + m * 16) * 512 + h * 128 + kb) = (u32x4){kep[m][0], kep[m][1], kep[m][2], kep[m][3]};
            }
        }
        const float sc = u.pn < 2 ? scale0 : 1.0f;
#pragma unroll
        for (int ai = 0; ai < 2; ++ai)
#pragma unroll
            for (int m = 0; m < 4; ++m) { bf16_t* rowp = O + (size_t)(row0 + ai * 128 + m * 16) * INC + col0;
#pragma unroll
                for (int bj = 0; bj < 2; ++bj) { const f32x4 v0 = acc[ai][bj][m][0] * sc, v1 = acc[ai][bj][m][1] * sc;
                    u32x4 w; w.x = cvt_pk_bf16(v0[0], v0[1]); w.y = cvt_pk_bf16(v0[2], v0[3]); w.z = cvt_pk_bf16(v1[0], v1[1]); w.w = cvt_pk_bf16(v1[2], v1[3]);
                    *(u32x4*)(rowp + bj * 128) = w; } }
        return false;
    }
};
struct EpiUp {
    static constexpr bool PERM = true;
    const bf16_t* proj; bf16_t* O;
    __device__ __forceinline__ bool operator()(f32x4 (&acc)[2][2][4][2], const Unit& u, int wr, int wc, int fr, int fq) const {
        const int row0 = u.pm * 256 + wr * 64 + fr, col0 = u.pn * 256 + wc * 32 + 8 * fq;
#pragma unroll
        for (int ai = 0; ai < 2; ++ai)
#pragma unroll
            for (int mh = 0; mh < 2; ++mh) {
                u32x4 gh[2][2], gd[2][2];
#pragma unroll
                for (int mm = 0; mm < 2; ++mm)
#pragma unroll
                    for (int bj = 0; bj < 2; ++bj) { const size_t row = (size_t)(row0 + ai * 128 + (2 * mh + mm) * 16); const int col = col0 + bj * 128;
                        gh[mm][bj] = *(const u32x4*)(proj + row * INC + C_GHGATE + col);
                        if (u.aux == 0) gd[mm][bj] = *(const u32x4*)(proj + row * INC + C_GDA + col); }
#pragma unroll
                for (int mm = 0; mm < 2; ++mm)
#pragma unroll
                    for (int bj = 0; bj < 2; ++bj) { const int m = 2 * mh + mm; const size_t row = (size_t)(row0 + ai * 128 + m * 16); const int col = col0 + bj * 128;
                        float sh[8];
#pragma unroll
                        for (int j = 0; j < 4; ++j) { sh[2 * j] = 1.0f + __builtin_amdgcn_exp2f(-1.4426950408889634f * bf2f(gh[mm][bj][j] & 0xffffu)); sh[2 * j + 1] = 1.0f + __builtin_amdgcn_exp2f(-1.4426950408889634f * bf2f(gh[mm][bj][j] >> 16)); }
                        if (u.aux == 0) {
#pragma unroll
                            for (int j = 0; j < 4; ++j) {
                                const float d0 = 1.0f + __builtin_amdgcn_exp2f(-1.4426950408889634f * bf2f(gd[mm][bj][j] & 0xffffu)), d1 = 1.0f + __builtin_amdgcn_exp2f(-1.4426950408889634f * bf2f(gd[mm][bj][j] >> 16));
                                const float r0 = sh[2 * j] * __builtin_amdgcn_rcpf(d0), r1 = sh[2 * j + 1] * __builtin_amdgcn_rcpf(d1);
                                if (j < 2) { acc[ai][bj][m][0][2 * j] *= r0; acc[ai][bj][m][0][2 * j + 1] *= r1; }
                                else { acc[ai][bj][m][1][2 * j - 4] *= r0; acc[ai][bj][m][1][2 * j - 3] *= r1; }
                            }
                        } else {
                            const f32x4 v0 = acc[ai][bj][m][0], v1 = acc[ai][bj][m][1];
#pragma unroll
                            for (int j = 0; j < 8; ++j) sh[j] = __builtin_amdgcn_rcpf(sh[j]);
                            u32x4 w; w.x = cvt_pk_bf16(v0[0] * sh[0], v0[1] * sh[1]); w.y = cvt_pk_bf16(v0[2] * sh[2], v0[3] * sh[3]);
                            w.z = cvt_pk_bf16(v1[0] * sh[4], v1[1] * sh[5]); w.w = cvt_pk_bf16(v1[2] * sh[6], v1[3] * sh[7]);
                            *(u32x4*)(O + row * D + col) = w;
                        }
                    }
            }
        return u.aux == 0;
    }
};
struct EpiOut {
    static constexpr bool PERM = true;
    const float* x; const float* mod; bf16_t* O;
    __device__ __forceinline__ bool operator()(f32x4 (&acc)[2][2][4][2], const Unit& u, int wr, int wc, int fr, int fq) const {
        const int row0 = u.pm * 256 + wr * 64 + fr, col0 = u.pn * 256 + wc * 32 + 8 * fq;
        const int b = (u.pm * 256) / SEQ;
        f32x4 gt[2][2];
#pragma unroll
        for (int bj = 0; bj < 2; ++bj)
#pragma unroll
            for (int n = 0; n < 2; ++n) gt[bj][n] = *(const f32x4*)(mod + b * 6144 + 2048 + col0 + bj * 128 + n * 4);
#pragma unroll
        for (int ai = 0; ai < 2; ++ai)
#pragma unroll
            for (int mh = 0; mh < 2; ++mh) {
                f32x4 xv[2][2][2];
#pragma unroll
                for (int mm = 0; mm < 2; ++mm)
#pragma unroll
                    for (int bj = 0; bj < 2; ++bj) { const size_t off = (size_t)(row0 + ai * 128 + (2 * mh + mm) * 16) * D + col0 + bj * 128;
                        xv[mm][bj][0] = __builtin_nontemporal_load((const f32x4*)(x + off)); xv[mm][bj][1] = __builtin_nontemporal_load((const f32x4*)(x + off + 4)); }
#pragma unroll
                for (int mm = 0; mm < 2; ++mm)
#pragma unroll
                    for (int bj = 0; bj < 2; ++bj) { const int m = 2 * mh + mm; const size_t off = (size_t)(row0 + ai * 128 + m * 16) * D + col0 + bj * 128;
                        const f32x4 v0 = xv[mm][bj][0] + gt[bj][0] * acc[ai][bj][m][0], v1 = xv[mm][bj][1] + gt[bj][1] * acc[ai][bj][m][1];
                        u32x4 w; w.x = cvt_pk_bf16(v0[0], v0[1]); w.y = cvt_pk_bf16(v0[2], v0[3]); w.z = cvt_pk_bf16(v1[0], v1[1]); w.w = cvt_pk_bf16(v1[2], v1[3]);
                        *(u32x4*)(O + off) = w; }
            }
        return false;
    }
};
struct EpiMoe1 {
    static constexpr bool PERM = true;
    bf16_t* O; unsigned* done;
    __device__ __forceinline__ bool operator()(f32x4 (&acc)[2][2][4][2], const Unit& u, int wr, int wc, int fr, int fq) const {
        const int row0 = u.pm * 256 + wr * 64 + fr, col0 = u.pn * 128 + wc * 32 + 8 * fq;
#pragma unroll
        for (int ai = 0; ai < 2; ++ai)
#pragma unroll
            for (int m = 0; m < 4; ++m) { bf16_t* rowp = O + (size_t)(row0 + ai * 128 + m * 16) * DEXP + col0;
                float h[8];
#pragma unroll
                for (int n = 0; n < 2; ++n)
#pragma unroll
                    for (int e = 0; e < 4; ++e) { const float x_ = acc[ai][0][m][n][e]; h[n * 4 + e] = x_ * __builtin_amdgcn_rcpf(1.0f + __builtin_amdgcn_exp2f(-1.4426950408889634f * x_)) * acc[ai][1][m][n][e]; }
                u32x4 w; w.x = cvt_pk_bf16(h[0], h[1]); w.y = cvt_pk_bf16(h[2], h[3]); w.z = cvt_pk_bf16(h[4], h[5]); w.w = cvt_pk_bf16(h[6], h[7]);
                asm volatile("global_store_dwordx4 %0, %1, off sc1\n\ts_nop 1" :: "v"(rowp), "v"(w) : "memory"); }
        asm volatile("s_waitcnt vmcnt(0)" ::: "memory");
        if ((threadIdx.x & 63) == 0) __hip_atomic_fetch_add(done + 16 * u.pm, 1u, __ATOMIC_RELAXED, __HIP_MEMORY_SCOPE_AGENT);
        return false;
    }
};

struct Frame { LAS unsigned char* lds; int tid, lane, wave, G, bid; };

__device__ __forceinline__ void transpose_item(const float* Wsrc, int ldw, bf16_t* dst, int ldd, LAS float* scr, int lane) {
#pragma unroll 8
    for (int i = 0; i < 32; ++i) { const int kk = 2 * i + (lane >> 5); scr[kk * 33 + (lane & 31)] = __builtin_nontemporal_load(Wsrc + (size_t)kk * ldw + (lane & 31)); }
    asm volatile("s_waitcnt lgkmcnt(0)" ::: "memory");
    const int c = lane & 7;
#pragma unroll
    for (int j = 0; j < 4; ++j) { const int n = (lane >> 3) + 8 * j; const LAS float* s = scr + (8 * c) * 33 + n;
        u32x4 o; o.x = pk2(s[0 * 33], s[1 * 33]); o.y = pk2(s[2 * 33], s[3 * 33]); o.z = pk2(s[4 * 33], s[5 * 33]); o.w = pk2(s[6 * 33], s[7 * 33]);
        *(u32x4*)(dst + (size_t)n * ldd + 8 * c) = o; }
    asm volatile("s_waitcnt lgkmcnt(0)" ::: "memory");
}
struct TItem { const float* src; bf16_t* dst; int ldw, ldd; };
template <class ItemFn>
__device__ __forceinline__ void transpose_stream(int it_lo, int it_hi, int gw, int NGW, LAS float* scr, int lane, ItemFn item) {
    int it = it_lo + gw; if (it >= it_hi) return;
    TItem cur = item(it);
    float v[32];
    const int l31 = lane & 31, lh = lane >> 5;
#pragma unroll
    for (int i = 0; i < 32; ++i) v[i] = __builtin_nontemporal_load(cur.src + (size_t)(2 * i + lh) * cur.ldw + l31);
    while (true) {
#pragma unroll
        for (int i = 0; i < 32; ++i) scr[(2 * i + lh) * 33 + l31] = v[i];
        const int nx = it + NGW; const bool more = nx < it_hi; TItem nxt = cur;
        if (more) { nxt = item(nx);
#pragma unroll
            for (int i = 0; i < 32; ++i) v[i] = __builtin_nontemporal_load(nxt.src + (size_t)(2 * i + lh) * nxt.ldw + l31); }
        asm volatile("s_waitcnt lgkmcnt(0)" ::: "memory");
        const int c = lane & 7;
#pragma unroll
        for (int j = 0; j < 4; ++j) { const int n = (lane >> 3) + 8 * j; const LAS float* s_ = scr + (8 * c) * 33 + n;
            u32x4 o; o.x = pk2(s_[0 * 33], s_[1 * 33]); o.y = pk2(s_[2 * 33], s_[3 * 33]); o.z = pk2(s_[4 * 33], s_[5 * 33]); o.w = pk2(s_[6 * 33], s_[7 * 33]);
            *(u32x4*)(cur.dst + (size_t)n * cur.ldd + 8 * c) = o; }
        asm volatile("s_waitcnt lgkmcnt(0)" ::: "memory");
        if (!more) break;
        cur = nxt; it = nx;
    }
}
__device__ __forceinline__ void transpose_matrix(const Frame& F, const float* W, int K, int N, bf16_t* WT) {
    LAS float* scr = (LAS float*)(F.lds + F.wave * 8448);
    const int gw = F.bid * NWAVES + F.wave, NGW = F.G * NWAVES, nblk = N / 32, items = (K / 64) * nblk;
    transpose_stream(0, items, gw, NGW, scr, F.lane, [=](int it) { const int kb = it / nblk, nb = it % nblk;
        return TItem{W + (size_t)(64 * kb) * N + 32 * nb, WT + (size_t)(32 * nb) * K + 64 * kb, N, K}; });
}

__device__ __forceinline__ void phase0(const Frame& F, const Args& a) {
    unsigned char* ws = a.ws;
    {
        float* mod = (float*)(ws + WS_MOD);
        const float* c = a.in[I_C]; const float* wada = a.in[I_WADA]; const float* bada = a.in[I_BADA];
        LAS f32x4* cs4 = (LAS f32x4*)(F.lds + 72 * 1024);
        LAS float* red = (LAS float*)(F.lds + 72 * 1024 + 16 * 1024);
        for (int i = F.tid; i < 4 * D; i += NTHR) ((LAS float*)cs4)[(i & (D - 1)) * 4 + (i >> 10)] = siluf_(c[i]);
        __syncthreads();
        for (int cb = F.bid; cb < 6144 / 32; cb += F.G) {
            const int l15 = F.lane & 15, lq = F.lane >> 4, k0 = 128 * F.wave + lq;
            const float* wp = wada + (size_t)k0 * 6144 + cb * 32 + 2 * l15;
            f32x2 wv[32];
#pragma unroll
            for (int i = 0; i < 32; ++i) wv[i] = __builtin_nontemporal_load((const f32x2*)(wp + (size_t)(4 * i) * 6144));
            f32x2 s[4] = {{0.f, 0.f}, {0.f, 0.f}, {0.f, 0.f}, {0.f, 0.f}};
#pragma unroll
            for (int i = 0; i < 32; ++i) { const f32x4 cv = cs4[k0 + 4 * i];
#pragma unroll
                for (int b = 0; b < 4; ++b) s[b] += wv[i] * cv[b]; }
#pragma unroll
            for (int b = 0; b < 4; ++b) { f32x2 t = s[b];
                t.x += __shfl_xor(t.x, 16); t.y += __shfl_xor(t.y, 16); t.x += __shfl_xor(t.x, 32); t.y += __shfl_xor(t.y, 32);
                if (lq == 0) *(LAS f32x2*)(red + (F.wave * 4 + b) * 32 + 2 * l15) = t; }
            __syncthreads();
            if (F.tid < 128) { const int b = F.tid >> 5, cc = F.tid & 31; float t = bada[cb * 32 + cc];
#pragma unroll
                for (int w = 0; w < 8; ++w) t += red[(w * 4 + b) * 32 + cc];
                mod[b * 6144 + cb * 32 + cc] = t; }
            __syncthreads();
        }
    }
    if (F.bid == 0) {
        float* sm = (float*)(ws + WS_SMALL);
        if (F.tid == 0) {
            float s1 = 0.f, s2 = 0.f;
            for (int i = 0; i < 64; ++i) { s1 += a.in[I_LQ1][i] * a.in[I_LK1][i]; s2 += a.in[I_LQ2][i] * a.in[I_LK2][i]; }
            sm[0] = expf(s1) - expf(s2) + 0.2f;
        }
        { const float l0 = a.in[I_LBL][F.tid], l1 = a.in[I_LBL][512 + F.tid]; const float mx = fmaxf(l0, l1);
          const float e0 = expf(l0 - mx), e1 = expf(l1 - mx); sm[16 + F.tid] = e0 / (e0 + e1); }
    }
}
__device__ __forceinline__ void moe_w2_convert(const Frame& F, const Args& a, int it_lo, int it_hi, int gw, int NGW) {
    LAS float* scr = (LAS float*)(F.lds + F.wave * 8448);
    bf16_t* w2t = (bf16_t*)((unsigned char*)a.out + OUT_W2); const float* w2 = a.in[I_W2];
    transpose_stream(it_lo, it_hi, gw, NGW, scr, F.lane, [=](int it) { const int e = it >> 8, kb = (it >> 5) & 7, nb = it & 31;
        return TItem{w2 + (size_t)e * 512 * 1024 + (size_t)(64 * kb) * 1024 + 32 * nb, w2t + ((size_t)e * 1024 + 32 * nb) * 512 + 64 * kb, 1024, 512}; });
}
__device__ __forceinline__ int w2_early_items(int G, int& n_light) { const int nwg = (T / 256) * (INC / 256), r = nwg % G; n_light = r ? G - r : 0; return n_light >= 64 ? W2_EARLY * 256 : 0; }
__device__ __forceinline__ unsigned char* w13_home(const Args& a, int e) {
    const int off_mib = e < 8 ? 48 + 2 * e : e < 11 ? 288 + 2 * e : e < 16 ? 2 * e - 14 : e < 24 ? 2 * e - 32 : 2 * e + 8; const bool in_out = e < 8 || (e >= 16 && e < 24);
    return (in_out ? (unsigned char*)a.out : a.ws) + (size_t)off_mib * MiB;
}
__device__ __forceinline__ void moe_w13_convert(const Frame& F, const Args& a, int e_lo, int e_hi, int gw, int NGW) {
    if (e_hi <= e_lo) return;
    LAS float* scr = (LAS float*)(F.lds + F.wave * 8448);
    const float* w1 = a.in[I_W1]; const float* w3 = a.in[I_W3]; const int per = (e_hi - e_lo) * 256;
    transpose_stream(0, 2 * per, gw, NGW, scr, F.lane, [=](int it) {
        const int which = it / per, r = it % per, e = e_lo + (r >> 8), kb = (r >> 4) & 15, nb = r & 15, n0 = 32 * nb;
        const float* W = (which ? w3 : w1) + (size_t)e * 1024 * 512;
        const int drow = 256 * (n0 >> 7) + (which ? 128 : 0) + (n0 & 127);
        return TItem{W + (size_t)(64 * kb) * 512 + n0, (bf16_t*)w13_home(a, e) + (size_t)drow * 1024 + 64 * kb, 512, 1024}; });
}
__device__ __forceinline__ void w13_seam_range(int k, int& lo, int& hi) {
    lo = hi = 0;
    if (k == 0) { lo = 0; hi = 4; } else if (k == 1) { lo = 4; hi = 8; } else if (k == 2) { lo = 8; hi = 11; } else if (k == 3) { lo = 11; hi = 15; } else if (k == 4) { lo = 15; hi = 19; } else if (k == 5) { lo = 19; hi = 23; } else if (k == 6) { lo = 23; hi = 24; } else if (k == 7) { lo = 24; hi = 28; }
}

__device__ __forceinline__ void dense_weight_convert(const Frame& F, const Args& a) {
    unsigned char* ws = a.ws;
    {
        LAS float* scr = (LAS float*)(F.lds + F.wave * 8448);
        const int gw = F.bid * NWAVES + F.wave, NGW = F.G * NWAVES, nblk = INC / 32, items = (D / 64) * nblk;
        bf16_t* WT = (bf16_t*)(ws + WS_WIN);
        const float* win = a.in[I_WIN];
        transpose_stream(0, items, gw, NGW, scr, F.lane, [=](int it) { const int kb = it / nblk, n0 = 32 * (it % nblk); int dr = n0;
            if (n0 >= C_QHG && n0 < C_FHG) dr = C_HGT + 256 * ((n0 - C_QHG) >> 7) + ((n0 - C_QHG) & 127);
            else if (n0 >= C_FHG && n0 < C_IHG) dr = C_HGT + 256 * ((n0 - C_FHG) >> 7) + 128 + ((n0 - C_FHG) & 127);
            return TItem{win + (size_t)(64 * kb) * INC + n0, WT + (size_t)dr * D + 64 * kb, INC, D}; });
    }
    transpose_matrix(F, a.in[I_WUPDA], 512, D, (bf16_t*)(ws + WS_WUPDA));
    transpose_matrix(F, a.in[I_WUPHG], 512, D, (bf16_t*)(ws + WS_WUPHG));
    transpose_matrix(F, a.in[I_WOUT], D, D, (bf16_t*)(ws + WS_WOUT));
}
__device__ __forceinline__ void phase1(const Frame& F, const Args& a) {
    const float* mod = (const float*)(a.ws + WS_MOD);
    LAS float* Gs = (LAS float*)F.lds;
    LAS float* Ss = Gs + 1024;
    bf16_t* H = (bf16_t*)(a.ws + WS_ACT);
    const int rows_per_blk = T / F.G;
    const int r0 = F.bid * rows_per_blk, b = r0 / SEQ;
    for (int k = F.tid; k < 1024; k += NTHR) { Gs[k] = a.in[I_N1G][k] * (1.0f + mod[b * 6144 + 1024 + k]); Ss[k] = mod[b * 6144 + k]; }
    __syncthreads();
    for (int rb = r0 + F.wave; rb < r0 + rows_per_blk; rb += 4 * NWAVES) {
        f32x4 v[4][4];
#pragma unroll
        for (int q = 0; q < 4; ++q) { const int r = rb + q * NWAVES < r0 + rows_per_blk ? rb + q * NWAVES : rb; const f32x4* xr = (const f32x4*)(a.in[I_X] + (size_t)r * D) + F.lane;
#pragma unroll
            for (int j = 0; j < 4; ++j) v[q][j] = __builtin_nontemporal_load(xr + 64 * j); }
#pragma unroll
        for (int q = 0; q < 4; ++q) { const int r = rb + q * NWAVES; if (r >= r0 + rows_per_blk) break;
            float s = 0.f;
#pragma unroll
            for (int j = 0; j < 4; ++j) s += (v[q][j].x * v[q][j].x + v[q][j].y * v[q][j].y) + (v[q][j].z * v[q][j].z + v[q][j].w * v[q][j].w);
            const float rs = rsqrtf(wave_sum(s) * (1.0f / D) + EPS);
            unsigned long long* o8 = (unsigned long long*)(H + (size_t)r * D) + F.lane;
#pragma unroll
            for (int j = 0; j < 4; ++j) { const f32x4 g = *(const LAS f32x4*)(Gs + 256 * j + 4 * F.lane), sh = *(const LAS f32x4*)(Ss + 256 * j + 4 * F.lane);
                const f32x4 h = v[q][j] * rs * g + sh;
                o8[64 * j] = (unsigned long long)pk2(h.x, h.y) | ((unsigned long long)pk2(h.z, h.w) << 32); } }
    }
}

namespace attn_body {
using s16x4=__attribute__((ext_vector_type(4)))short;
using f32x16=__attribute__((ext_vector_type(16)))float;
constexpr int NW=8,QBLK=32,QB=QBLK*NW,KVBLK=64,NQB=SEQ/QB;
constexpr int PIN=INC, POUT=1024;
__device__ __forceinline__ int crow(int r,int hi){return (r&3)+8*(r>>2)+4*hi;}
#define SBAR() __builtin_amdgcn_sched_barrier(0)
__device__ __forceinline__ void bmask(f32x16&p0,f32x16&p1,int jb,int wch,int il,int hi,float s2x2){
  if(jb>wch){
    #pragma unroll
    for(int r=0;r<16;++r){p0[r]=-INFINITY;p1[r]=-INFINITY;}
  } else if(jb==wch){
    float fb=(float)(4*hi-il); asm volatile("":"+v"(fb));
    #pragma unroll
    for(int r=0;r<16;++r){const float c=(float)((r&3)+8*(r>>2)); p0[r]-=s2x2*__builtin_fmaxf(fb+c,0.f); p1[r]-=s2x2*__builtin_fmaxf(fb+(c+32.f),0.f);}
  }
}
constexpr int NSLOT=3, SLOTB=8192, VSLOTB=16384;
constexpr int LDS_K=0, LDS_V=NSLOT*SLOTB, LDS_WS=LDS_V+NSLOT*VSLOTB, LDS_OST=LDS_WS+NW*64*4, ATT_LDS_BYTES=LDS_OST+NW*8192;
constexpr float C2=0.125f*1.4426950408889634f;
__device__ __forceinline__ void glds16(const void*gsrc,unsigned lds_dst){unsigned keep;
  asm volatile("s_mov_b32 %0, m0\n\ts_mov_b32 m0, %2\n\ts_nop 0\n\tglobal_load_lds_dwordx4 %1, off\n\ts_mov_b32 m0, %0":"=&s"(keep):"v"(gsrc),"s"(lds_dst):"memory");}
__device__ __forceinline__ float max3f(float a,float b,float c){float r;asm("v_max3_f32 %0, %1, %2, %3":"=v"(r):"v"(a),"v"(b),"v"(c));return r;}
__device__ __forceinline__ float max2f(float a,float b){float r;asm("v_max_f32_e32 %0, %1, %2":"=v"(r):"v"(a),"v"(b));return r;}
__device__ __forceinline__ float fadd_s(float a,float b){float r;asm("v_add_f32_e32 %0, %1, %2":"=v"(r):"v"(a),"v"(b));return r;}
__device__ __forceinline__ float fsub_s(float a,float b){float r;asm("v_sub_f32_e32 %0, %1, %2":"=v"(r):"v"(a),"v"(b));return r;}
typedef float f32x2_t __attribute__((ext_vector_type(2))); typedef __bf16 bf16x2_t __attribute__((ext_vector_type(2)));
__device__ __forceinline__ unsigned cvtpk_s(float lo,float hi){f32x2_t v={lo,hi};bf16x2_t b=__builtin_convertvector(v,bf16x2_t);return __builtin_bit_cast(unsigned,b);}
#define WAIT_BAR(N) asm volatile("s_waitcnt vmcnt(" #N ") lgkmcnt(0)\n\ts_barrier":::"memory")

__device__ __forceinline__ void qkt(f32x16&p0,f32x16&p1,const char*Kslot,const bf16x8*qr,const f32x16&c0,const f32x16&c1,int r32,int hi){
  const char*kb=Kslot+hi*1024+r32*16;
  #pragma unroll
  for(int d0=0;d0<4;++d0){
    const bf16x8 b0=*reinterpret_cast<const bf16x8*>(kb+d0*2048);
    const bf16x8 b1=*reinterpret_cast<const bf16x8*>(kb+d0*2048+512);
    if(d0==0){p0=__builtin_amdgcn_mfma_f32_32x32x16_bf16(b0,qr[0],c0,0,0,0);p1=__builtin_amdgcn_mfma_f32_32x32x16_bf16(b1,qr[0],c1,0,0,0);}
    else{p0=__builtin_amdgcn_mfma_f32_32x32x16_bf16(b0,qr[d0],p0,0,0,0);p1=__builtin_amdgcn_mfma_f32_32x32x16_bf16(b1,qr[d0],p1,0,0,0);}}
}
typedef __attribute__((address_space(3))) const char* lds_cptr;
typedef short v4i16_t __attribute__((ext_vector_type(4)));
__device__ __forceinline__ void kload8(bf16x8*kf,lds_cptr kp){
  kf[0]=*(const __attribute__((address_space(3))) bf16x8*)(kp);      kf[1]=*(const __attribute__((address_space(3))) bf16x8*)(kp+512);
  kf[2]=*(const __attribute__((address_space(3))) bf16x8*)(kp+2048); kf[3]=*(const __attribute__((address_space(3))) bf16x8*)(kp+2560);
  kf[4]=*(const __attribute__((address_space(3))) bf16x8*)(kp+4096); kf[5]=*(const __attribute__((address_space(3))) bf16x8*)(kp+4608);
  kf[6]=*(const __attribute__((address_space(3))) bf16x8*)(kp+6144); kf[7]=*(const __attribute__((address_space(3))) bf16x8*)(kp+6656);
}
__device__ __forceinline__ void kload2(bf16x8*kf,lds_cptr kp,int j){ kf[2*j]=*(const __attribute__((address_space(3))) bf16x8*)(kp+j*2048); kf[2*j+1]=*(const __attribute__((address_space(3))) bf16x8*)(kp+j*2048+512); }
__device__ __forceinline__ s16x4 vtr(lds_cptr p){ return __builtin_bit_cast(s16x4,__builtin_amdgcn_ds_read_tr16_b64_v4i16((__attribute__((address_space(3))) v4i16_t*)p)); }
__device__ __forceinline__ float rowmax(const f32x16&p0,const f32x16&p1){
  float a=max3f(p0[0],p0[1],p1[0]),b=max3f(p0[2],p0[3],p1[1]);a=max3f(a,p1[2],p1[3]);
  #pragma unroll
  for(int r=4;r<16;r+=4){a=max3f(a,p0[r],p0[r+1]);b=max3f(b,p0[r+2],p0[r+3]);a=max3f(a,p1[r],p1[r+1]);b=max3f(b,p1[r+2],p1[r+3]);}
  const float m=max2f(a,b);
  auto rr=__builtin_amdgcn_permlane32_swap(__float_as_uint(m),__float_as_uint(m),false,false);
  return max2f(__uint_as_float(rr[0]),__uint_as_float(rr[1]));
}
__device__ __forceinline__ void pv(f32x16*o,int vb,bf16x8 pa0,bf16x8 pa1,bf16x8 pa2,bf16x8 pa3){
  #pragma unroll
  for(int d0=0;d0<4;++d0){s16x4 lo[4],hi[4];
    #pragma unroll
    for(int ks=0;ks<4;++ks){
      asm volatile("ds_read_b64_tr_b16 %0,%1 offset:%c2":"=&v"(lo[ks]):"v"(vb),"i"(d0*4096+ks*1024):"memory");
      asm volatile("ds_read_b64_tr_b16 %0,%1 offset:%c2":"=&v"(hi[ks]):"v"(vb),"i"(d0*4096+ks*1024+512):"memory");}
    asm volatile("s_waitcnt lgkmcnt(0)":::"memory");SBAR();
    #define PK(k) (bf16x8){lo[k][0],lo[k][1],lo[k][2],lo[k][3],hi[k][0],hi[k][1],hi[k][2],hi[k][3]}
    o[d0]=__builtin_amdgcn_mfma_f32_32x32x16_bf16(pa0,PK(0),o[d0],0,0,0);
    o[d0]=__builtin_amdgcn_mfma_f32_32x32x16_bf16(pa1,PK(1),o[d0],0,0,0);
    o[d0]=__builtin_amdgcn_mfma_f32_32x32x16_bf16(pa2,PK(2),o[d0],0,0,0);
    o[d0]=__builtin_amdgcn_mfma_f32_32x32x16_bf16(pa3,PK(3),o[d0],0,0,0);
    #undef PK
  }
}
#define ATTN_STORE16(p,v) (*(u32x4*)(p)=(v))
template<int THRL> __device__ __forceinline__ void attn_unit(int qb,const bf16_t*Qb,const bf16_t*__restrict__ Kh,const bf16_t*__restrict__ Vh,bf16_t*Ob,float slope2,char*shm){
  const int wid=__builtin_amdgcn_readfirstlane(threadIdx.x>>6); const int lane=lane_now(),r32=lane&31,hi=lane>>5;
  const int q0=qb*QB;
  const bf16_t*Qw=Qb+(long)(q0+wid*QBLK)*PIN;
  const unsigned lds0=(unsigned)(uintptr_t)shm;
  float*wsf=(float*)(shm+LDS_WS)+wid*64;
  const bf16_t*ksrc=Kh+(long)lane*PIN+wid*8;
  const bf16_t*vsrc=Vh+(long)(16*(wid&3)+(lane>>2))*PIN+(wid>>2)*32+(lane&3)*8;
  const unsigned kdst=lds0+LDS_K+wid*1024, vdst=lds0+LDS_V+(wid>>2)*4096+(wid&3)*1024;
  #define DMA_K(t,slot) glds16(ksrc+(long)(t)*KVBLK*PIN,(unsigned)__builtin_amdgcn_readfirstlane(kdst+(slot)))
  #define DMA_V(t,slot) do{ glds16(vsrc+(long)(t)*KVBLK*PIN,(unsigned)__builtin_amdgcn_readfirstlane(vdst+2*(slot))); glds16(vsrc+(long)(t)*KVBLK*PIN+64,(unsigned)__builtin_amdgcn_readfirstlane(vdst+2*(slot)+8192)); }while(0)
  const int vb0=(int)(lds0+LDS_V)+((lane>>4)&1)*32+(lane&3)*8+(4*hi+((lane&15)>>2))*64;
  const char*Kbase=shm+LDS_K; bf16x8 kf[8];
  const lds_cptr shm3=(lds_cptr)shm; const lds_cptr kp0=shm3+LDS_K+hi*1024+r32*16; const lds_cptr vp0=shm3+LDS_V+((lane>>4)&1)*32+(lane&3)*8+(4*hi+((lane&15)>>2))*64;
  const int NT=(q0+QB)/KVBLK;
  DMA_K(0,0);DMA_V(0,0);DMA_K(1,SLOTB);
  bf16x8 qr[4];
  #pragma unroll
  for(int d0=0;d0<4;++d0)qr[d0]=*reinterpret_cast<const bf16x8*>(&Qw[(long)r32*PIN+d0*16+hi*8]);
  float mhat=0.f,l_reg=0.f;f32x16 o[4];o[0]=f32x16{};o[1]=f32x16{};o[2]=f32x16{};o[3]=f32x16{};
  const float s64=slope2*64.f, s32=slope2*32.f, s2x2=2.f*slope2, s4hi=slope2*4.f*(float)hi;
  const int wch=wid>>1, il=32*(wid&1)+r32;
  #define CMASK(P0,P1,t) do{int jb_=(t)-(NT-4); if(jb_>=0)bmask(P0,P1,jb_,wch,il,hi,s2x2);}while(0)
  #define CINIT0(C0,t) do{ const float bt_=s64*(float)((t)-NT)-mhat+s4hi; _Pragma("unroll") for(int r=0;r<16;++r){C0[r]=__builtin_fmaf(slope2,(float)((r&3)+8*(r>>2)),bt_);} }while(0)
  #define CINIT1(C1,t) do{ const float bu_=s64*(float)((t)-NT)-mhat+s4hi+s32; _Pragma("unroll") for(int r=0;r<16;++r){C1[r]=__builtin_fmaf(slope2,(float)((r&3)+8*(r>>2)),bu_);} }while(0)
  bool resc=false;
  #define START(P0,P1) do{ const float rm=rowmax(P0,P1); resc=false; \
    { const float dl=rm; mhat=fadd_s(mhat,dl); \
      _Pragma("unroll") for(int r=0;r<16;++r){P0[r]=fsub_s(P0[r],dl);P1[r]=fsub_s(P1[r],dl);} } \
    _Pragma("unroll") for(int r=0;r<16;++r)P0[r]=__builtin_amdgcn_exp2f(P0[r]); }while(0)
  #define RESC() do{ if(resc){ asm volatile("s_waitcnt lgkmcnt(0)":::"memory"); \
      _Pragma("unroll") for(int d_=0;d_<4;++d_) _Pragma("unroll") for(int r=0;r<16;++r)o[d_][r]*=wsf[crow(r,hi)]; } }while(0)
  f32x16 cS0,cS1;
  u32x4 pwa0,pwa1,pwa2,pwa3,pwb0,pwb1,pwb2,pwb3;
  int sl_prev=0,sl_cur=0,sl_next=SLOTB;
  #define ROT() do{sl_prev=sl_cur;sl_cur=sl_next;sl_next=(sl_next==(NSLOT-1)*SLOTB)?0:sl_next+SLOTB;}while(0)
  #define PKW(P,B) cvtpk_s(P[B],P[B+1])
  DMA_K(2,2*SLOTB);
  WAIT_BAR(3);
  { f32x16 c0,c1; CINIT0(c0,0); CINIT1(c1,0); qkt(cS0,cS1,Kbase,qr,c0,c1,r32,hi); }
  asm volatile("s_nop 15\n\ts_nop 7":"+v"(cS0),"+v"(cS1));CMASK(cS0,cS1,0);
  START(cS0,cS1);
  _Pragma("unroll") for(int r=0;r<16;++r)cS1[r]=__builtin_amdgcn_exp2f(cS1[r]);
  { float sacc=cS0[0]+cS0[1]; _Pragma("unroll") for(int r=2;r<16;++r)sacc+=cS0[r]; _Pragma("unroll") for(int r=0;r<16;++r)sacc+=cS1[r]; l_reg+=sacc;
    pwa0=(u32x4){PKW(cS0,0),PKW(cS0,2),PKW(cS0,4),PKW(cS0,6)};pwa1=(u32x4){PKW(cS0,8),PKW(cS0,10),PKW(cS0,12),PKW(cS0,14)};pwa2=(u32x4){PKW(cS1,0),PKW(cS1,2),PKW(cS1,4),PKW(cS1,6)};pwa3=(u32x4){PKW(cS1,8),PKW(cS1,10),PKW(cS1,12),PKW(cS1,14)}; }
  WAIT_BAR(0);
  DMA_K(3,0);DMA_V(1,SLOTB);
  ROT();
  kload8(kf,kp0+sl_cur);
  WAIT_BAR(3);
  s16x4 vlo[4],vhi[4];
  #define CAT_(a,b) a##b
  #define CAT(a,b) CAT_(a,b)
  #define PAFC(P,k) __builtin_bit_cast(bf16x8,CAT(P,k))
  #define VFR(k) (bf16x8){vlo[(k)&3][0],vlo[(k)&3][1],vlo[(k)&3][2],vlo[(k)&3][3],vhi[(k)&3][0],vhi[(k)&3][1],vhi[(k)&3][2],vhi[(k)&3][3]}
  #define VOFF(k) ((k)<8 ? (((k)&1)*4096+((k)>>1)*1024) : ((2+((k)&1))*4096+(((k)-8)>>1)*1024))
  #define PIN_(x) asm volatile("":"+v"(x))
  #define MX3(a,b,c) __builtin_fmaxf(__builtin_fmaxf((a),(b)),(c))
  #define QK(MF) do{ MF; SBAR(); }while(0)
  #define EX(v) __builtin_amdgcn_exp2f(v)
  #define VRD(k) do{ vlo[(k)&3]=vtr(vp_+VOFF(k)); vhi[(k)&3]=vtr(vp_+(VOFF(k)+512)); }while(0)
  #define VNX(k) do{ if((k)+4<16){ VRD((k)+4); } SBAR(); }while(0)
  #define GAPB3(MF,X,B,PW,J) do{ MF; X[B]=EX(X[B]); X[B+1]=EX(X[B+1]); sacc+=X[B]; sacc+=X[B+1]; PW[J]=cvtpk_s(X[B],X[B+1]); PIN_(X); PIN_(sacc); PIN_(PW); SBAR(); }while(0)
  #define KRD(G,j) do{ if(G){ kload2(kf,kp0+sl_next,j); SBAR(); } }while(0)
  #define STEP(PC,PN,t,GK,GV,GL) do{ SBAR(); \
    CINIT0(cS0,t); SBAR(); \
    const lds_cptr vp_=vp0+2*sl_prev; \
    VRD(0); SBAR(); QK(cS0=__builtin_amdgcn_mfma_f32_32x32x16_bf16(kf[0],qr[0],cS0,0,0,0)); \
    CINIT1(cS1,t); VRD(1); SBAR(); QK(cS1=__builtin_amdgcn_mfma_f32_32x32x16_bf16(kf[1],qr[0],cS1,0,0,0)); \
    VRD(2); SBAR(); QK(cS0=__builtin_amdgcn_mfma_f32_32x32x16_bf16(kf[2],qr[1],cS0,0,0,0)); \
    VRD(3); SBAR(); QK(cS1=__builtin_amdgcn_mfma_f32_32x32x16_bf16(kf[3],qr[1],cS1,0,0,0)); \
    QK(cS0=__builtin_amdgcn_mfma_f32_32x32x16_bf16(kf[4],qr[2],cS0,0,0,0)); \
    QK(cS1=__builtin_amdgcn_mfma_f32_32x32x16_bf16(kf[5],qr[2],cS1,0,0,0)); \
    QK(cS0=__builtin_amdgcn_mfma_f32_32x32x16_bf16(kf[6],qr[3],cS0,0,0,0)); \
    QK(cS1=__builtin_amdgcn_mfma_f32_32x32x16_bf16(kf[7],qr[3],cS1,0,0,0)); \
    if(GK){DMA_K((t)+3,sl_cur);} if(GV){DMA_V((t)+1,sl_next);} \
    CMASK(cS0,cS1,t); \
    { float a=MX3(cS0[0],cS0[1],cS1[0]),b=MX3(cS0[2],cS0[3],cS1[1]); a=MX3(a,cS1[2],cS1[3]); \
      _Pragma("unroll") for(int r=4;r<16;r+=4){a=MX3(a,cS0[r],cS0[r+1]);b=MX3(b,cS0[r+2],cS0[r+3]);a=MX3(a,cS1[r],cS1[r+1]);b=MX3(b,cS1[r+2],cS1[r+3]);} \
      float rm=__builtin_fmaxf(a,b); { auto rr=__builtin_amdgcn_permlane32_swap(__float_as_uint(rm),__float_as_uint(rm),false,false); rm=__builtin_fmaxf(__uint_as_float(rr[0]),__uint_as_float(rr[1])); } \
      resc=false; \
      if(__builtin_expect(__any(rm>(float)THRL),0)){ const float dl=__builtin_fmaxf(rm,0.f); mhat+=dl; \
        _Pragma("unroll") for(int r=0;r<16;++r){cS0[r]-=dl;cS1[r]-=dl;} \
        const float f=__builtin_amdgcn_exp2f(-dl); l_reg*=f; if(hi==0)wsf[r32]=f; resc=true; } } \
    SBAR(); float sacc=0.f; \
    GAPB3(o[0]=__builtin_amdgcn_mfma_f32_32x32x16_bf16(PAFC(PC,0),VFR(0),o[0],0,0,0), cS0,0, CAT(PN,0),0); VNX(0); \
    GAPB3(o[1]=__builtin_amdgcn_mfma_f32_32x32x16_bf16(PAFC(PC,0),VFR(1),o[1],0,0,0), cS0,2, CAT(PN,0),1); VNX(1); \
    KRD(GL,0); GAPB3(o[0]=__builtin_amdgcn_mfma_f32_32x32x16_bf16(PAFC(PC,1),VFR(2),o[0],0,0,0), cS0,4, CAT(PN,0),2); VNX(2); \
    KRD(GL,1); GAPB3(o[1]=__builtin_amdgcn_mfma_f32_32x32x16_bf16(PAFC(PC,1),VFR(3),o[1],0,0,0), cS0,6, CAT(PN,0),3); VNX(3); \
    KRD(GL,2); GAPB3(o[0]=__builtin_amdgcn_mfma_f32_32x32x16_bf16(PAFC(PC,2),VFR(4),o[0],0,0,0), cS0,8, CAT(PN,1),0); VNX(4); \
    KRD(GL,3); GAPB3(o[1]=__builtin_amdgcn_mfma_f32_32x32x16_bf16(PAFC(PC,2),VFR(5),o[1],0,0,0), cS0,10, CAT(PN,1),1); VNX(5); \
    GAPB3(o[0]=__builtin_amdgcn_mfma_f32_32x32x16_bf16(PAFC(PC,3),VFR(6),o[0],0,0,0), cS0,12, CAT(PN,1),2); VNX(6); \
    GAPB3(o[1]=__builtin_amdgcn_mfma_f32_32x32x16_bf16(PAFC(PC,3),VFR(7),o[1],0,0,0), cS0,14, CAT(PN,1),3); VNX(7); \
    GAPB3(o[2]=__builtin_amdgcn_mfma_f32_32x32x16_bf16(PAFC(PC,0),VFR(8),o[2],0,0,0), cS1,0, CAT(PN,2),0); VNX(8); \
    GAPB3(o[3]=__builtin_amdgcn_mfma_f32_32x32x16_bf16(PAFC(PC,0),VFR(9),o[3],0,0,0), cS1,2, CAT(PN,2),1); VNX(9); \
    GAPB3(o[2]=__builtin_amdgcn_mfma_f32_32x32x16_bf16(PAFC(PC,1),VFR(10),o[2],0,0,0), cS1,4, CAT(PN,2),2); VNX(10); \
    GAPB3(o[3]=__builtin_amdgcn_mfma_f32_32x32x16_bf16(PAFC(PC,1),VFR(11),o[3],0,0,0), cS1,6, CAT(PN,2),3); VNX(11); \
    GAPB3(o[2]=__builtin_amdgcn_mfma_f32_32x32x16_bf16(PAFC(PC,2),VFR(12),o[2],0,0,0), cS1,8, CAT(PN,3),0); VNX(12); \
    GAPB3(o[3]=__builtin_amdgcn_mfma_f32_32x32x16_bf16(PAFC(PC,2),VFR(13),o[3],0,0,0), cS1,10, CAT(PN,3),1); VNX(13); \
    GAPB3(o[2]=__builtin_amdgcn_mfma_f32_32x32x16_bf16(PAFC(PC,3),VFR(14),o[2],0,0,0), cS1,12, CAT(PN,3),2); VNX(14); \
    GAPB3(o[3]=__builtin_amdgcn_mfma_f32_32x32x16_bf16(PAFC(PC,3),VFR(15),o[3],0,0,0), cS1,14, CAT(PN,3),3); VNX(15); \
    l_reg+=sacc; \
    }while(0)
  int t=1;
  #undef CMASK
  #define CMASK(P0,P1,t) do{}while(0)
  for(;t+5<NT;t+=2){
    STEP(pwa,pwb,t,true,true,true);     WAIT_BAR(3); RESC(); ROT();
    STEP(pwb,pwa,t+1,true,true,true);   WAIT_BAR(3); RESC(); ROT();
  }
  #undef CMASK
  #define CMASK(P0,P1,t) do{int jb_=(t)-(NT-4); if(jb_>=0)bmask(P0,P1,jb_,wch,il,hi,s2x2);}while(0)
  #define ENDW(tt) do{ if((tt)+3<NT){WAIT_BAR(3);} else if((tt)+2<NT){WAIT_BAR(2);} else {WAIT_BAR(0);} }while(0)
  for(;t+1<NT;t+=2){
    STEP(pwa,pwb,t,(t+3<NT),(t+1<NT),(t+1<NT));       ENDW(t);   RESC(); ROT();
    STEP(pwb,pwa,t+1,(t+4<NT),(t+2<NT),(t+2<NT));     ENDW(t+1); RESC(); ROT();
  }
  STEP(pwa,pwb,NT-1,false,false,false); RESC();
  SBAR(); pv(o,vb0+2*sl_cur,PAFC(pwb,0),PAFC(pwb,1),PAFC(pwb,2),PAFC(pwb,3));
  #undef PKW
  #undef PAFC
  #undef CAT
  #undef CAT_
  #undef QK
  #undef GAPB3
  #undef VFR
  #undef PIN_
  #undef MX3
  #undef EX
  #undef VRD
  #undef VNX
  #undef VOFF
  #undef GAPB2
  #undef KRD
  #undef STEP
  #undef ENDW
  {auto rr=__builtin_amdgcn_permlane32_swap(__float_as_uint(l_reg),__float_as_uint(l_reg),false,false);l_reg=__uint_as_float(rr[0])+__uint_as_float(rr[1]);}
  {
    const int le=lane_now(), r32e=le&31, hie=le>>5;
    float*wsfe=(float*)(shm+LDS_WS)+wid*64;
    if(hie==0)wsfe[32+r32e]=l_reg;asm volatile("s_waitcnt lgkmcnt(0)":::"memory");
    float rli[16];
    #pragma unroll
    for(int r=0;r<16;++r)rli[r]=__builtin_amdgcn_rcpf(wsfe[32+crow(r,hie)]);
    bf16_t*Ow=Ob+(long)(q0+wid*QBLK)*POUT;
    bf16_t*stg=(bf16_t*)(shm+LDS_OST)+wid*4096;
    #pragma unroll
    for(int r=0;r<16;++r){const int orow=crow(r,hie);
      #pragma unroll
      for(int d0=0;d0<4;++d0)stg[orow*128+d0*32+r32e]=(bf16_t)f2bf(o[d0][r]*rli[r]);}
    asm volatile("s_waitcnt lgkmcnt(0)":::"memory");
    #pragma unroll
    for(int i=0;i<8;++i){const int row=i*4+(le>>4),ch=le&15; const u32x4 v=*(const u32x4*)(stg+row*128+ch*8); ATTN_STORE16(Ow+(long)row*POUT+ch*8,v);} }
  asm volatile("s_waitcnt lgkmcnt(0)\n\ts_barrier":::"memory");
  #undef DMA_K
  #undef DMA_V
  #undef CMASK
  #undef CINIT0
  #undef CINIT1
  #undef START
  #undef RESC
  #undef ROT
}
#undef SBAR
#undef WAIT_BAR
}

__device__ __forceinline__ void attn_phase(const Frame& F, const Args& a) {
    const bf16_t* proj = (const bf16_t*)(a.ws + WS_PROJ); bf16_t* OA = (bf16_t*)(a.ws + WS_OA);
    const int vcu = (F.G % 8 == 0) ? (F.bid % 8) * (F.G / 8) + F.bid / 8 : F.bid;
    for (int i = 0;; ++i) {
        int bhm, qb;
        if (F.G == 256) { if (i >= 2) break; const int s_ = vcu & 7; bhm = vcu >> 3; qb = (i == 0) ? 15 - s_ : s_; }
        else { const int u = i * F.G + F.bid; if (u >= 512) break; bhm = u >> 4; qb = 15 - (u & 15); }
        const int b = bhm >> 3, h = (bhm >> 1) & 3, map = bhm & 1;
        const bf16_t* base = proj + (size_t)b * SEQ * INC;
        const float slope2 = exp2f(-2.0f * (h + 1)) * 1.4426950408889634f;
        attn_body::attn_unit<8>(qb, base + C_QDA + h * 128 + map * 64, base + C_KDA + h * 128 + map * 64, base + C_VDA + h * 128,
                                OA + (size_t)b * SEQ * 1024 + h * 256 + map * 128, slope2, (char*)F.lds);
    }
}
__device__ __forceinline__ void attn_combine(const Frame& F, const Args& a) {
    const bf16_t* OA = (const bf16_t*)(a.ws + WS_OA); bf16_t* Y = (bf16_t*)(a.ws + WS_YDA);
    const float lam = ((const float*)(a.ws + WS_SMALL))[0];
    const float g0 = a.in[I_SUBG][2 * F.lane] * 0.8f, g1 = a.in[I_SUBG][2 * F.lane + 1] * 0.8f;
    const int gw = F.bid * NWAVES + F.wave, NGW = F.G * NWAVES;
    for (int rb = gw; rb < T; rb += 4 * NGW) {
        unsigned w0[4][4], w1[4][4];
#pragma unroll
        for (int q = 0; q < 4; ++q) { const int r = rb + q * NGW < T ? rb + q * NGW : rb; const unsigned* orow = (const unsigned*)(OA + (size_t)r * 1024);
#pragma unroll
            for (int h = 0; h < 4; ++h) { w0[q][h] = __builtin_nontemporal_load(orow + h * 128 + F.lane); w1[q][h] = __builtin_nontemporal_load(orow + h * 128 + 64 + F.lane); } }
#pragma unroll
        for (int q = 0; q < 4; ++q) { const int r = rb + q * NGW; if (r >= T) break;
            unsigned* yrow = (unsigned*)(Y + (size_t)r * 512);
#pragma unroll
            for (int h = 0; h < 4; ++h) {
                const float x0 = bf2f(w0[q][h] & 0xffffu) - lam * bf2f(w1[q][h] & 0xffffu), x1 = bf2f(w0[q][h] >> 16) - lam * bf2f(w1[q][h] >> 16);
                const float rs = rsqrtf(wave_sum(x0 * x0 + x1 * x1) * (1.0f / 128.0f) + EPS);
                yrow[h * 64 + F.lane] = pk2(x0 * rs * g0, x1 * rs * g1);
            } }
    }
}
namespace hg {
constexpr int QP = 136;
constexpr int L_QD = 0, L_KD = 64 * QP * 2, L_V = 2 * 64 * QP * 2, L_KE = 3 * 64 * QP * 2, L_SSQ = 4 * 64 * QP * 2, L_G = L_SSQ + 512, L_ST = L_G + 64 * QP * 2;
__device__ __forceinline__ f32x4 mfma16(bf16x8 a, bf16x8 b, f32x4 c) { return __builtin_amdgcn_mfma_f32_16x16x32_bf16(a, b, c, 0, 0, 0); }
#define HG_BAR() do { asm volatile("s_waitcnt lgkmcnt(0)" ::: "memory"); __builtin_amdgcn_s_barrier(); asm volatile("" ::: "memory"); } while (0)
typedef short v4i16_t __attribute__((ext_vector_type(4)));
__device__ __forceinline__ bf16x8 tr8(const LAS unsigned char* img, int ra, int rb, int col0, int lane) {
    const int q = (lane & 15) >> 2, p = lane & 3;
    const v4i16_t lo = __builtin_amdgcn_ds_read_tr16_b64_v4i16((LAS v4i16_t*)(img + ((ra + q) * QP + col0 + 4 * p) * 2));
    const v4i16_t hi = __builtin_amdgcn_ds_read_tr16_b64_v4i16((LAS v4i16_t*)(img + ((rb + q) * QP + col0 + 4 * p) * 2));
    return (bf16x8){lo[0], lo[1], lo[2], lo[3], hi[0], hi[1], hi[2], hi[3]};
}
struct Tile { u32x4 p[2]; };
__device__ __forceinline__ void tile_load(Tile& t, const bf16_t* src, size_t pitch, int tid) {
#pragma unroll
    for (int i = 0; i < 2; ++i) { const int pc = tid + NTHR * i; t.p[i] = *(const u32x4*)(src + (size_t)(pc >> 4) * pitch + (pc & 15) * 8); }
}
__device__ __forceinline__ void tile_put(const Tile& t, LAS unsigned char* img, int tid) {
#pragma unroll
    for (int i = 0; i < 2; ++i) { const int pc = tid + NTHR * i; *(LAS u32x4*)(img + ((pc >> 4) * QP + (pc & 15) * 8) * 2) = t.p[i]; }
}
__device__ __forceinline__ void tile_get(Tile& t, const LAS unsigned char* img, int tid) {
#pragma unroll
    for (int i = 0; i < 2; ++i) { const int pc = tid + NTHR * i; t.p[i] = *(const LAS u32x4*)(img + ((pc >> 4) * QP + (pc & 15) * 8) * 2); }
}
__device__ __forceinline__ void tile_store(const Tile& t, bf16_t* dst, size_t pitch, int tid) {
#pragma unroll
    for (int i = 0; i < 2; ++i) { const int pc = tid + NTHR * i; *(u32x4*)(dst + (size_t)(pc >> 4) * pitch + (pc & 15) * 8) = t.p[i]; }
}
constexpr int PP = 72;
constexpr int G4_L_P = 4 * 64 * QP * 2, G4_L_DEC = G4_L_P + 64 * PP * 2, G4_L_SSQ = G4_L_DEC + 512, G4_L_DEC4 = G4_L_SSQ + 2048;
struct InA { Tile qd, kd, ke, v; };
__device__ __forceinline__ void loadA(InA& r, const Frame& F, const Args& a, int bh, int n) {
    const int b = bh >> 2, h = bh & 3; const size_t t0 = (size_t)b * SEQ + n * 64;
    const bf16_t* base = (const bf16_t*)(a.ws + WS_PROJ) + t0 * INC;
    tile_load(r.qd, base + C_HGT + 256 * h, INC, F.tid); tile_load(r.kd, base + C_HGT + 256 * h + 128, INC, F.tid);
    tile_load(r.ke, (const bf16_t*)a.out + t0 * 512 + h * 128, 512, F.tid); tile_load(r.v, base + C_IHG + h * 128, INC, F.tid);
}
#define G4_DEC_LOAD()  const int dcq_ = (F.tid >> 5) & 3; const f32x4 dv_ = *(const f32x4*)((const float*)(a.ws + WS_DEC) + ((size_t)bh * 64 + n0 + dcq_) * 128 + 4 * (F.tid & 31))
#define G4_DEC_PUT()   *(LAS f32x4*)(F.lds + G4_L_DEC4 + dcq_ * 512 + 16 * (F.tid & 31)) = dv_
__device__ __forceinline__ void grp_local(const Frame& F, const Args& a, int grp) {
    const int bh = grp >> 4, n0 = 4 * (grp & 15), b = bh >> 2, h = bh & 3, w = F.wave, lane = F.lane, fr = lane & 15, fq = lane >> 4;
    for (int i = F.tid; i < 64 * PP / 2; i += NTHR) ((LAS unsigned*)(F.lds + G4_L_P))[i] = 0u;
    f32x4 S[8];
#pragma unroll
    for (int kt = 0; kt < 8; ++kt) S[kt] = (f32x4){0.f, 0.f, 0.f, 0.f};
    G4_DEC_LOAD();
    InA c4[3];
    loadA(c4[0], F, a, bh, n0); loadA(c4[1], F, a, bh, n0 + 1);
    G4_DEC_PUT();
#define G4_STORE(nn) do { Tile ot_; tile_get(ot_, F.lds + L_KD, F.tid); tile_store(ot_, (bf16_t*)(a.ws + WS_YHG) + ((size_t)b * SEQ + (nn) * 64) * 512 + h * 128, 512, F.tid); } while (0)
#pragma unroll
    for (int j = 0; j < 4; ++j) {
        InA& cur = c4[j % 3];
        if (j > 0) G4_STORE(n0 + j - 1);
        if (j + 2 < 4) loadA(c4[(j + 2) % 3], F, a, bh, n0 + j + 2);
        tile_put(cur.qd, F.lds + L_QD, F.tid); tile_put(cur.kd, F.lds + L_KD, F.tid); tile_put(cur.ke, F.lds + L_KE, F.tid); tile_put(cur.v, F.lds + L_V, F.tid);
        HG_BAR();
#pragma unroll
        for (int rep = 0; rep < 2; ++rep) { const int pi = w + 8 * rep;
            if (pi < 10) { const int tb = pi >= 6 ? 3 : pi >= 3 ? 2 : pi >= 1 ? 1 : 0, jt = pi - (tb * (tb + 1)) / 2;
                f32x4 sc = (f32x4){0.f, 0.f, 0.f, 0.f};
#pragma unroll
                for (int ks = 0; ks < 4; ++ks) { const bf16x8 kf = *(const LAS bf16x8*)(F.lds + L_KD + ((16 * jt + fr) * QP + 32 * ks + 8 * fq) * 2);
                    const bf16x8 qf = *(const LAS bf16x8*)(F.lds + L_QD + ((16 * tb + fr) * QP + 32 * ks + 8 * fq) * 2); sc = mfma16(kf, qf, sc); }
                if (jt == tb) {
#pragma unroll
                    for (int r = 0; r < 4; ++r) if (4 * fq + r > fr) sc[r] = 0.f;
                }
                *(LAS u32x2*)(F.lds + G4_L_P + ((16 * tb + fr) * PP + 16 * jt + 4 * fq) * 2) = (u32x2){cvt_pk_bf16(sc[0], sc[1]), cvt_pk_bf16(sc[2], sc[3])}; } }
        HG_BAR();
        bf16x8 bv[2];
#pragma unroll
        for (int s2 = 0; s2 < 2; ++s2) bv[s2] = tr8(F.lds + L_V, 32 * s2 + 8 * fq, 32 * s2 + 8 * fq + 4, 16 * w, lane);
        bf16x8 Sb[4];
#pragma unroll
        for (int ks = 0; ks < 4; ++ks) { const u32x4 t = (u32x4){cvt_pk_bf16(S[2 * ks][0], S[2 * ks][1]), cvt_pk_bf16(S[2 * ks][2], S[2 * ks][3]), cvt_pk_bf16(S[2 * ks + 1][0], S[2 * ks + 1][1]), cvt_pk_bf16(S[2 * ks + 1][2], S[2 * ks + 1][3])};
            Sb[ks] = __builtin_bit_cast(bf16x8, t); }
#pragma unroll
        for (int tb = 0; tb < 4; ++tb) { f32x4 o = (f32x4){0.f, 0.f, 0.f, 0.f};
#pragma unroll
            for (int s2 = 0; s2 <= (tb >> 1); ++s2) { const bf16x8 pf = *(const LAS bf16x8*)(F.lds + G4_L_P + ((16 * tb + fr) * PP + 32 * s2 + 8 * fq) * 2); o = mfma16(pf, bv[s2], o); }
            if (j > 0) {
#pragma unroll
                for (int ks = 0; ks < 4; ++ks) { const LAS unsigned char* qrow = F.lds + L_QD + ((16 * tb + fr) * QP + 32 * ks + 4 * fq) * 2;
                    const u32x2 lo = *(const LAS u32x2*)qrow, hi = *(const LAS u32x2*)(qrow + 32);
                    const u32x4 aw = (u32x4){lo.x, lo.y, hi.x, hi.y}; o = mfma16(__builtin_bit_cast(bf16x8, aw), Sb[ks], o); } }
#pragma unroll
            for (int r = 0; r < 4; ++r) *(LAS unsigned short*)(F.lds + L_KD + ((16 * tb + 4 * fq + r) * QP + 16 * w + fr) * 2) = (unsigned short)f2bf(o[r]); }
#pragma unroll
        for (int kt = 0; kt < 8; ++kt) { S[kt] = S[kt] * *(const LAS f32x4*)(F.lds + G4_L_DEC4 + j * 512 + (16 * kt + 4 * fq) * 4);
#pragma unroll
            for (int s2 = 0; s2 < 2; ++s2) S[kt] = mfma16(tr8(F.lds + L_KE, 32 * s2 + 8 * fq, 32 * s2 + 8 * fq + 4, 16 * kt, lane), bv[s2], S[kt]); }
        HG_BAR();
    }
    G4_STORE(n0 + 3);
#undef G4_STORE
    f32x4* sg = (f32x4*)(a.ws + WS_DS) + ((size_t)grp * 64 + w * 8) * 64 + lane;
#pragma unroll
    for (int kt = 0; kt < 8; ++kt) sg[kt * 64] = S[kt];
}
__device__ __forceinline__ void grp_scan(const Frame& F, const Args& a) {
    const f32x2* sg = (const f32x2*)(a.ws + WS_DS); f32x2* si = (f32x2*)(a.ws + WS_DS) + (size_t)256 * 8192; const float* dec = (const float*)(a.ws + WS_DEC);
    for (int gt = F.bid * NTHR + F.tid; gt < 16 * 8192; gt += F.G * NTHR) {
        const int bh = gt >> 13, s2 = gt & 8191, slot = s2 >> 1, kt = (slot >> 6) & 7, lane = slot & 63, k = 16 * kt + 4 * (lane >> 4) + 2 * (s2 & 1);
        f32x2 cur = (f32x2){0.f, 0.f};
#pragma unroll
        for (int gh = 0; gh < 2; ++gh) {
            f32x2 sv[8], d[8];
#pragma unroll
            for (int g8 = 0; g8 < 8; ++g8) { const int g = 8 * gh + g8;
                sv[g8] = __builtin_nontemporal_load(sg + ((size_t)(bh * 16 + g)) * 8192 + s2);
                const float* dp = dec + ((size_t)bh * 64 + 4 * g) * 128 + k;
                d[g8] = (*(const f32x2*)dp * *(const f32x2*)(dp + 128)) * (*(const f32x2*)(dp + 256) * *(const f32x2*)(dp + 384)); }
#pragma unroll
            for (int g8 = 0; g8 < 8; ++g8) { const int g = 8 * gh + g8;
                si[((size_t)(bh * 16 + g)) * 8192 + s2] = cur;
                cur = d[g8] * cur + sv[g8]; }
        }
    }
}
struct InC { Tile qd, g, ol; };
__device__ __forceinline__ void loadC(InC& r, const Frame& F, const Args& a, int bh, int n) {
    const int b = bh >> 2, h = bh & 3; const size_t t0 = (size_t)b * SEQ + n * 64;
    const bf16_t* base = (const bf16_t*)(a.ws + WS_PROJ) + t0 * INC;
    tile_load(r.qd, base + C_HGT + 256 * h, INC, F.tid); tile_load(r.g, base + C_GHG + h * 128, INC, F.tid);
    tile_load(r.ol, (const bf16_t*)(a.ws + WS_YHG) + t0 * 512 + h * 128, 512, F.tid);
}
__device__ __forceinline__ void grp_final(const Frame& F, const Args& a, int grp) {
    const int bh = grp >> 4, n0 = 4 * (grp & 15), b = bh >> 2, h = bh & 3, w = F.wave, lane = F.lane, fr = lane & 15, fq = lane >> 4;
    f32x4 S[8];
    { const f32x4* si = (const f32x4*)(a.ws + WS_DS) + (size_t)256 * 4096 + ((size_t)grp * 64 + w * 8) * 64 + lane;
#pragma unroll
      for (int kt = 0; kt < 8; ++kt) S[kt] = si[kt * 64]; }
    const float ng = a.in[I_HGNG][16 * w + fr];
    LAS float* SSQ = (LAS float*)(F.lds + G4_L_SSQ);
    G4_DEC_LOAD();
    InC cur, nxt; loadC(cur, F, a, bh, n0);
    G4_DEC_PUT();
#define G4_STORE(nn) do { Tile ot_; tile_get(ot_, F.lds + L_V, F.tid); tile_store(ot_, (bf16_t*)(a.ws + WS_YHG) + ((size_t)b * SEQ + (nn) * 64) * 512 + h * 128, 512, F.tid); } while (0)
    for (int j = 0; j < 4; ++j) {
        if (j > 0) G4_STORE(n0 + j - 1);
        loadC(nxt, F, a, bh, n0 + (j < 3 ? j + 1 : 3));
        tile_put(cur.qd, F.lds + L_QD, F.tid); tile_put(cur.g, F.lds + L_KD, F.tid); tile_put(cur.ol, F.lds + L_V, F.tid);
        HG_BAR();
        bf16x8 Sb[4];
#pragma unroll
        for (int ks = 0; ks < 4; ++ks) { const u32x4 t = (u32x4){cvt_pk_bf16(S[2 * ks][0], S[2 * ks][1]), cvt_pk_bf16(S[2 * ks][2], S[2 * ks][3]), cvt_pk_bf16(S[2 * ks + 1][0], S[2 * ks + 1][1]), cvt_pk_bf16(S[2 * ks + 1][2], S[2 * ks + 1][3])};
            Sb[ks] = __builtin_bit_cast(bf16x8, t); }
        f32x4 o[4];
#pragma unroll
        for (int tb = 0; tb < 4; ++tb) {
#pragma unroll
            for (int r = 0; r < 4; ++r) o[tb][r] = bf2f(*(const LAS unsigned short*)(F.lds + L_V + ((16 * tb + 4 * fq + r) * QP + 16 * w + fr) * 2));
#pragma unroll
            for (int ks = 0; ks < 4; ++ks) { const LAS unsigned char* qrow = F.lds + L_QD + ((16 * tb + fr) * QP + 32 * ks + 4 * fq) * 2;
                const u32x2 lo = *(const LAS u32x2*)qrow, hi = *(const LAS u32x2*)(qrow + 32);
                const u32x4 aw = (u32x4){lo.x, lo.y, hi.x, hi.y}; o[tb] = mfma16(__builtin_bit_cast(bf16x8, aw), Sb[ks], o[tb]); }
#pragma unroll
            for (int r = 0; r < 4; ++r) { const float v = scan16(o[tb][r] * o[tb][r]); if (fr == 15) SSQ[w * 64 + 16 * tb + 4 * fq + r] = v; } }
#pragma unroll
        for (int kt = 0; kt < 8; ++kt) S[kt] = S[kt] * *(const LAS f32x4*)(F.lds + G4_L_DEC4 + j * 512 + (16 * kt + 4 * fq) * 4);
        HG_BAR();
#pragma unroll
        for (int tb = 0; tb < 4; ++tb) { f32x4 tot = (f32x4){0.f, 0.f, 0.f, 0.f};
#pragma unroll
            for (int ww = 0; ww < 8; ++ww) tot += *(const LAS f32x4*)(SSQ + ww * 64 + 16 * tb + 4 * fq);
#pragma unroll
            for (int r = 0; r < 4; ++r) { const float rs = rsqrtf(tot[r] * (1.0f / 128.0f) + EPS); const float g = bf2f(*(const LAS unsigned short*)(F.lds + L_KD + ((16 * tb + 4 * fq + r) * QP + 16 * w + fr) * 2));
                *(LAS unsigned short*)(F.lds + L_V + ((16 * tb + 4 * fq + r) * QP + 16 * w + fr) * 2) = (unsigned short)f2bf(o[tb][r] * rs * ng * g * __builtin_amdgcn_rcpf(1.0f + __builtin_amdgcn_exp2f(-1.4426950408889634f * g))); } }
        HG_BAR();
        cur = nxt;
    }
    G4_STORE(n0 + 3);
#undef G4_STORE
}
#undef HG_BAR
}

__device__ __forceinline__ float rs4(float a0, float a1, float a2, float a3, int lane) {
    const bool hi = (lane & 32) != 0;
    const float s0 = hi ? a0 : a2, s1 = hi ? a1 : a3;
    const float k0 = (hi ? a2 : a0) + __shfl_xor(s0, 32), k1 = (hi ? a3 : a1) + __shfl_xor(s1, 32);
    const bool b4 = (lane & 16) != 0;
    const float sd = b4 ? k0 : k1;
    float k = (b4 ? k1 : k0) + __shfl_xor(sd, 16);
    k += __shfl_xor(k, 8); k += __shfl_xor(k, 4); k += __shfl_xor(k, 2); k += __shfl_xor(k, 1);
    return k;
}
__device__ __forceinline__ void phase_router(const Frame& F, const Args& a) {
    constexpr int AP = 1032;
    LAS bf16_t* AH = (LAS bf16_t*)F.lds;
    LAS bf16_t* AL = AH + 16 * AP;
    LAS float* PART = (LAS float*)(F.lds + 2 * 16 * AP * 2);
    LAS float* LG = PART + 8 * 16 * 48;
    LAS unsigned* LH = (LAS unsigned*)(LG + 16 * 48);
    LAS unsigned* LB = LH + 32;
    LAS unsigned* LR = LH + 64;
    if (F.tid < NEXP) LH[F.tid] = 0u;
    const float* mod = (const float*)(a.ws + WS_MOD);
    const bf16_t* x1 = (const bf16_t*)(a.ws + WS_X1B); bf16_t* H2 = (bf16_t*)(a.ws + WS_ACT);
    unsigned* counts = (unsigned*)(a.ws + WS_CTL) + CW_COUNTS; unsigned* tokinfo = (unsigned*)(a.ws + WS_TOKINFO); int* toklist = (int*)(a.ws + WS_TOKLIST);
    const int rows_per_blk = T / F.G, r0 = F.bid * rows_per_blk, b = r0 / SEQ;
    const int lane = F.lane, w = F.wave, fr = lane & 15, fq = lane >> 4;
    f32x4 v[2][4], vn[2][4];
#define RT_LOAD(V, rb_) do { _Pragma("unroll") for (int q = 0; q < 2; ++q) { const u32x2* xr_ = (const u32x2*)(x1 + (size_t)((rb_) + 2 * w + q) * D) + lane; \
        _Pragma("unroll") for (int j = 0; j < 4; ++j) { const u32x2 t_ = xr_[64 * j]; V[q][j] = (f32x4){bf2f(t_.x & 0xffffu), bf2f(t_.x >> 16), bf2f(t_.y & 0xffffu), bf2f(t_.y >> 16)}; } } } while (0)
    RT_LOAD(v, r0);
    bf16x8 Bh[4][3], Bl[4][3];
    {
        const float* wre = a.in[I_WRE]; const float* wrg = a.in[I_WRG];
#pragma unroll
        for (int ks = 0; ks < 4; ++ks)
#pragma unroll
            for (int ct = 0; ct < 3; ++ct) {
                unsigned hw[4], lw[4];
#pragma unroll
                for (int jp = 0; jp < 4; ++jp) { float x[2];
#pragma unroll
                    for (int z = 0; z < 2; ++z) { const int k = 128 * w + 32 * ks + 8 * fq + 2 * jp + z;
                        if (ct == 0) { const float g = wrg[k * 4 + (fr & 3)], e = wre[k * 32 + ((fr + 28) & 31)]; x[z] = fr < 4 ? g : e; }
                        else if (ct == 1) x[z] = wre[k * 32 + 12 + fr];
                        else { const float e = wre[k * 32 + 28 + (fr & 3)]; x[z] = fr < 4 ? e : 0.f; } }
                    const unsigned h0 = f2bf(x[0]), h1 = f2bf(x[1]); hw[jp] = h0 | (h1 << 16);
                    lw[jp] = pk2(x[0] - bf2f(h0), x[1] - bf2f(h1)); }
                Bh[ks][ct] = __builtin_bit_cast(bf16x8, (u32x4){hw[0], hw[1], hw[2], hw[3]}); Bl[ks][ct] = __builtin_bit_cast(bf16x8, (u32x4){lw[0], lw[1], lw[2], lw[3]});
            }
    }
    f32x4 ggv[4], shv[4];
#pragma unroll
    for (int j = 0; j < 4; ++j) { const int k = 256 * j + 4 * lane;
        ggv[j] = *(const f32x4*)(a.in[I_N2G] + k) * (1.0f + *(const f32x4*)(mod + b * 6144 + 4 * 1024 + k)); shv[j] = *(const f32x4*)(mod + b * 6144 + 3 * 1024 + k); }
    for (int g = 0; g < rows_per_blk / 16; ++g) {
        const int rg = r0 + 16 * g;
        { const int gn = g + 1 < rows_per_blk / 16 ? g + 1 : g; RT_LOAD(vn, r0 + 16 * gn); }
#pragma unroll
        for (int q = 0; q < 2; ++q) { float sq = 0.f;
#pragma unroll
            for (int j = 0; j < 4; ++j) sq += (v[q][j].x * v[q][j].x + v[q][j].y * v[q][j].y) + (v[q][j].z * v[q][j].z + v[q][j].w * v[q][j].w);
            const float rs = rsqrtf(wave_sum(sq) * (1.0f / D) + EPS); const int row = 2 * w + q;
#pragma unroll
            for (int j = 0; j < 4; ++j) { const int k = 256 * j + 4 * lane;
                const f32x4 hv = v[q][j] * rs * ggv[j] + shv[j];
                const unsigned h0 = f2bf(hv.x), h1 = f2bf(hv.y), h2_ = f2bf(hv.z), h3 = f2bf(hv.w);
                const u32x2 hw = (u32x2){h0 | (h1 << 16), h2_ | (h3 << 16)};
                *(u32x2*)(H2 + (size_t)(rg + row) * D + k) = hw;
                *(LAS u32x2*)(AH + row * AP + k) = hw;
                *(LAS u32x2*)(AL + row * AP + k) = (u32x2){pk2(hv.x - bf2f(h0), hv.y - bf2f(h1)), pk2(hv.z - bf2f(h2_), hv.w - bf2f(h3))}; } }
        __syncthreads();
        f32x4 acc[3] = {{0.f, 0.f, 0.f, 0.f}, {0.f, 0.f, 0.f, 0.f}, {0.f, 0.f, 0.f, 0.f}};
#pragma unroll
        for (int ks = 0; ks < 4; ++ks) { const bf16x8 ah = *(const LAS bf16x8*)(AH + fr * AP + 128 * w + 32 * ks + 8 * fq), al = *(const LAS bf16x8*)(AL + fr * AP + 128 * w + 32 * ks + 8 * fq);
#pragma unroll
            for (int ct = 0; ct < 3; ++ct) { acc[ct] = __builtin_amdgcn_mfma_f32_16x16x32_bf16(ah, Bh[ks][ct], acc[ct], 0, 0, 0);
                acc[ct] = __builtin_amdgcn_mfma_f32_16x16x32_bf16(al, Bh[ks][ct], acc[ct], 0, 0, 0); acc[ct] = __builtin_amdgcn_mfma_f32_16x16x32_bf16(ah, Bl[ks][ct], acc[ct], 0, 0, 0); } }
#pragma unroll
        for (int ct = 0; ct < 3; ++ct)
#pragma unroll
            for (int r = 0; r < 4; ++r) PART[(w * 16 + 4 * fq + r) * 48 + 16 * ct + fr] = acc[ct][r];
        __syncthreads();
        for (int t = F.tid; t < 16 * 48; t += NTHR) { const int row = t / 48, o = t % 48; float sacc = 0.f;
#pragma unroll
            for (int ww = 0; ww < 8; ++ww) sacc += PART[(ww * 16 + row) * 48 + o];
            if (o < 36) LG[row * 48 + o] = sacc + (o < 4 ? a.in[I_BRG][o & 3] : a.in[I_BRE][(o + 28) & 31]); }
        __syncthreads();
        if (F.tid < 16) {
            const LAS float* lg = LG + F.tid * 48;
            float gl[4]; int gi = 0;
#pragma unroll
            for (int o = 0; o < 4; ++o) gl[o] = lg[o];
            float gm = gl[0];
#pragma unroll
            for (int o = 1; o < 4; ++o) if (gl[o] > gm) { gm = gl[o]; gi = o; }
            float gsum = 0.f;
#pragma unroll
            for (int o = 0; o < 4; ++o) gsum += expf(gl[o] - gm);
            const float gp = 1.0f / gsum;
            float el[8];
#pragma unroll
            for (int e = 0; e < 8; ++e) el[e] = lg[4 + gi * 8 + e];
            int i0 = 0; float m0 = el[0];
#pragma unroll
            for (int o = 1; o < 8; ++o) if (el[o] > m0) { m0 = el[o]; i0 = o; }
            int i1 = -1; float m1 = -INFINITY;
#pragma unroll
            for (int o = 0; o < 8; ++o) if (o != i0 && el[o] > m1) { m1 = el[o]; i1 = o; }
            const float e1 = expf(m1 - m0); const float w0 = gp / (1.0f + e1), w1 = gp * e1 / (1.0f + e1);
            const int rl = 16 * g + F.tid, ex0 = gi * 8 + i0, ex1 = gi * 8 + i1;
            const unsigned l0 = atomicAdd((unsigned*)(LH + ex0), 1u), l1 = atomicAdd((unsigned*)(LH + ex1), 1u);
            LAS unsigned* ri = LR + rl * 6;
            ri[0] = (unsigned)ex0; ri[1] = l0; ri[2] = (unsigned)ex1; ri[3] = l1; ri[4] = __float_as_uint(w0); ri[5] = __float_as_uint(w1);
        }
#pragma unroll
        for (int q = 0; q < 2; ++q)
#pragma unroll
            for (int j = 0; j < 4; ++j) v[q][j] = vn[q][j];
    }
#undef RT_LOAD
    __syncthreads();
    if (F.tid < NEXP) LB[F.tid] = atomicAdd(counts + 64 * F.tid, LH[F.tid]);
    __syncthreads();
    for (int rl = F.tid; rl < rows_per_blk; rl += NTHR) {
        const LAS unsigned* ri = LR + rl * 6; const int r = r0 + rl;
        const unsigned ex0 = ri[0], ex1 = ri[2], k0 = LB[ex0] + ri[1], k1 = LB[ex1] + ri[3];
        toklist[ex0 * T + k0] = r; toklist[ex1 * T + k1] = r;
        u32x4 t0; t0.x = ex0; t0.y = k0; t0.z = ex1; t0.w = k1;
        *(u32x4*)(tokinfo + (size_t)r * 8) = t0;
        tokinfo[(size_t)r * 8 + 4] = ri[4]; tokinfo[(size_t)r * 8 + 5] = ri[5];
    }
}
__device__ __forceinline__ void build_moe_tab(const Frame& F, const Args& a, LAS MoeTab* tab) {
    if (F.wave == 0) {
        const unsigned* counts = (const unsigned*)(a.ws + WS_CTL) + CW_COUNTS;
        const int e = F.lane & 31;
        const int c = (int)__hip_atomic_load(counts + 64 * e, __ATOMIC_RELAXED, __HIP_MEMORY_SCOPE_AGENT);
        const int n = (c + 255) >> 8; int incl = n;
#pragma unroll
        for (int d = 1; d < 32; d <<= 1) { const int t = __shfl_up(incl, d, 32); if (e >= d) incl += t; }
        const int base = incl - n;
        if (F.lane < 32) { tab->cnt[e] = c; tab->tbase[e] = base;
            for (int m = 0; m < n; ++m) { tab->tile_e[base + m] = e; tab->tile_m[base + m] = m; } }
        if (F.lane == 31) { tab->tbase[NEXP] = incl; tab->nt = incl; }
    }
    __syncthreads();
}
__device__ __forceinline__ void phase_final(const Frame& F, const Args& a, const LAS MoeTab* tab) {
    const float* mod = (const float*)(a.ws + WS_MOD); const unsigned* tokinfo = (const unsigned*)(a.ws + WS_TOKINFO); const bf16_t* Ys = (const bf16_t*)(a.ws + WS_YS);
    const int rows_per_blk = T / F.G, r0 = F.bid * rows_per_blk;
    f32x4 fgv[4], gtv[4];
#pragma unroll
    for (int j = 0; j < 4; ++j) { const int k = 256 * j + 4 * F.lane; fgv[j] = *(const f32x4*)(a.in[I_FG] + k); gtv[j] = *(const f32x4*)(mod + (r0 / SEQ) * 6144 + 5 * 1024 + k); }
    for (int rb = r0 + F.wave; rb < r0 + rows_per_blk; rb += 4 * NWAVES) {
        u32x4 ti[4]; u32x2 tw[4];
#pragma unroll
        for (int q = 0; q < 4; ++q) { const int r = rb + q * NWAVES < r0 + rows_per_blk ? rb + q * NWAVES : rb;
            ti[q] = *(const u32x4*)(tokinfo + (size_t)r * 8); tw[q] = *(const u32x2*)(tokinfo + (size_t)r * 8 + 4); }
        u32x2 xq[4][4], a0[4][4], a1[4][4];
#pragma unroll
        for (int q = 0; q < 4; ++q) { const int r = rb + q * NWAVES < r0 + rows_per_blk ? rb + q * NWAVES : rb;
            const size_t s0 = (size_t)tab->tbase[ti[q].x] * 256 + ti[q].y, s1 = (size_t)tab->tbase[ti[q].z] * 256 + ti[q].w;
            const u32x2* xb = (const u32x2*)((const bf16_t*)(a.ws + WS_X1B) + (size_t)r * D) + F.lane;
            const u32x2* y0 = (const u32x2*)(Ys + s0 * D) + F.lane; const u32x2* y1 = (const u32x2*)(Ys + s1 * D) + F.lane;
#pragma unroll
            for (int j = 0; j < 4; ++j) { xq[q][j] = __builtin_nontemporal_load(xb + 64 * j); a0[q][j] = __builtin_nontemporal_load(y0 + 64 * j); a1[q][j] = __builtin_nontemporal_load(y1 + 64 * j); } }
#pragma unroll
        for (int q = 0; q < 4; ++q) { const int r = rb + q * NWAVES; if (r >= r0 + rows_per_blk) break;
            const int b = r / SEQ; const float w0 = __uint_as_float(tw[q].x), w1 = __uint_as_float(tw[q].y);
            f32x4* xr = (f32x4*)(a.out + (size_t)r * D) + F.lane;
            f32x4 v[4]; float s = 0.f;
#pragma unroll
            for (int j = 0; j < 4; ++j) { const int k = 256 * j + 4 * F.lane;
                const f32x4 gt = gtv[j]; const u32x2 p0 = a0[q][j], p1 = a1[q][j], px = xq[q][j];
                f32x4 m; m.x = w0 * bf2f(p0.x & 0xffffu) + w1 * bf2f(p1.x & 0xffffu); m.y = w0 * bf2f(p0.x >> 16) + w1 * bf2f(p1.x >> 16);
                m.z = w0 * bf2f(p0.y & 0xffffu) + w1 * bf2f(p1.y & 0xffffu); m.w = w0 * bf2f(p0.y >> 16) + w1 * bf2f(p1.y >> 16);
                const f32x4 xv = (f32x4){bf2f(px.x & 0xffffu), bf2f(px.x >> 16), bf2f(px.y & 0xffffu), bf2f(px.y >> 16)};
                v[j] = xv + gt * m; s += (v[j].x * v[j].x + v[j].y * v[j].y) + (v[j].z * v[j].z + v[j].w * v[j].w); }
            const float rs = rsqrtf(wave_sum(s) * (1.0f / D) + EPS);
#pragma unroll
            for (int j = 0; j < 4; ++j) __builtin_nontemporal_store(v[j] * rs * fgv[j], xr + 64 * j); }
    }
}

#define XB_TMO      128
#define XB_XCNT(j)  (256  + 64 * (j))
#define XB_XSUB(j)  (1280 + 64 * (j))
#define XB_XGEN(j)  (2304 + 64 * (j))
#define XB_TOP      3328
#define XB_TOPGEN   3392
#define XCD_BAR_WORDS 3456
#define XB_SPIN_CAP (1u << 18)
__device__ __forceinline__ unsigned xb_ld(unsigned* p)              { return __hip_atomic_load(p, __ATOMIC_RELAXED, __HIP_MEMORY_SCOPE_AGENT); }
__device__ __forceinline__ unsigned xb_add(unsigned* p, unsigned v) { return __hip_atomic_fetch_add(p, v, __ATOMIC_RELAXED, __HIP_MEMORY_SCOPE_AGENT); }
__device__ __forceinline__ unsigned xb_xcc_id() { return (unsigned)__builtin_amdgcn_s_getreg((3 << 11) | 20) & 0xFu; }
#define XB_SPIN(cond, bar) do { unsigned _sp = 0; while (cond) { __builtin_amdgcn_s_sleep(1); \
    if ((++_sp & 255u) == 0u) { if (xb_ld(&(bar)[XB_TMO])) break; if (_sp > XB_SPIN_CAP) { atomicAdd(&(bar)[XB_TMO], 1u); break; } } } } while (0)
struct XcdBarrier { unsigned* bar; unsigned x; volatile LAS unsigned* st; };
__device__ __forceinline__ XcdBarrier xcd_barrier_post(unsigned* bar, volatile LAS unsigned* st) {
    XcdBarrier b; b.bar = bar; b.x = xb_xcc_id(); b.st = st;
    if (threadIdx.x == 0) (void)xb_add(&bar[XB_XCNT(b.x)], 1u);
    return b;
}
__device__ __forceinline__ void xcd_barrier_complete(unsigned* bar, unsigned x, unsigned& nloc, unsigned& nx) {
    const unsigned G = gridDim.x * gridDim.y * gridDim.z;
    unsigned sum, cnt, mine, sp = 0u;
    for (;;) {
        sum = 0u; cnt = 0u; mine = 0u;
#pragma unroll
        for (unsigned j = 0; j < 16; ++j) { const unsigned c = xb_ld(&bar[XB_XCNT(j)]); sum += c; cnt += (c > 0u) ? 1u : 0u; mine = (j == x) ? c : mine; }
        if (sum == G) break;
        __builtin_amdgcn_s_sleep(1);
        if ((++sp & 255u) == 0u) { if (xb_ld(&bar[XB_TMO])) break; if (sp > XB_SPIN_CAP) { atomicAdd(&bar[XB_TMO], 1u); break; } }
    }
    nloc = mine > 0u ? mine : 1u; nx = cnt > 0u ? cnt : 1u;
}
__device__ __forceinline__ void xcd_barrier_t0(const XcdBarrier& b) {
    {
        unsigned* bar = b.bar;
        __builtin_amdgcn_s_waitcnt(0);
        unsigned nloc = b.st[0], nx = b.st[1];
        if (nloc == 0u) { xcd_barrier_complete(bar, b.x, nloc, nx); b.st[0] = nloc; b.st[1] = nx; }
        const unsigned old = xb_add(&bar[XB_XSUB(b.x)], 1u);
        const unsigned gen = old / nloc;
        if (old + 1u == (gen + 1u) * nloc) {
            __builtin_amdgcn_fence(__ATOMIC_RELEASE, "agent");
            asm volatile("s_waitcnt vmcnt(0)" ::: "memory");
            const unsigned og = xb_add(&bar[XB_TOP], 1u);
            const unsigned tg = og / nx;
            if (og + 1u == (tg + 1u) * nx) xb_add(&bar[XB_TOPGEN], 1u);
            else XB_SPIN(xb_ld(&bar[XB_TOPGEN]) == tg, bar);
            __builtin_amdgcn_fence(__ATOMIC_ACQUIRE, "agent");
            xb_add(&bar[XB_XGEN(b.x)], 1u);
            asm volatile("s_waitcnt vmcnt(0)" ::: "memory");
        } else {
            XB_SPIN(xb_ld(&bar[XB_XGEN(b.x)]) == gen, bar);
            __builtin_amdgcn_fence(__ATOMIC_ACQUIRE, "agent");
            asm volatile("s_waitcnt vmcnt(0)" ::: "memory");
        }
    }
}
__device__ __forceinline__ void xcd_barrier(const XcdBarrier& b) {
    asm volatile("s_waitcnt vmcnt(0)" ::: "memory");
    __syncthreads();
    if (threadIdx.x == 0) xcd_barrier_t0(b);
    __syncthreads();
}

constexpr int N_PHASES = 11;
__global__ void __launch_bounds__(NTHR, 2) mk_fwd(Args a) {
    extern __shared__ __attribute__((aligned(16))) unsigned char lds_raw[];
    Frame F; F.lds = (LAS unsigned char*)lds_raw; F.tid = threadIdx.x; F.lane = F.tid & 63; F.wave = __builtin_amdgcn_readfirstlane(F.tid >> 6); F.G = gridDim.x; F.bid = blockIdx.x;
    unsigned char* ws = a.ws;
    const int lo = a.ph_lo, hi = a.ph_hi;
#if MK_N_LAUNCHES == 1
    volatile LAS unsigned* MISC = (volatile LAS unsigned*)(F.lds + 152 * 1024);
    if (F.tid < 4) MISC[F.tid] = 0u;
    __syncthreads();
    XcdBarrier xbar = xcd_barrier_post((unsigned*)(ws + WS_CTL) + CW_BAR, MISC);
#define SEAM(k) do { if (IN(k) && IN((k) + 1)) { asm volatile("s_waitcnt vmcnt(0)" ::: "memory"); __syncthreads(); \
        if (F.wave == 0) { if (threadIdx.x == 0) xcd_barrier_t0(xbar); } else { int lo_, hi_; w13_seam_range((k), lo_, hi_); moe_w13_convert(F, a, lo_, hi_, F.bid * 7 + F.wave - 1, F.G * 7); } \
        asm volatile("s_waitcnt vmcnt(0)" ::: "memory"); __syncthreads(); } } while (0)
#else
#define SEAM(k) do { if (IN(k)) { int lo_, hi_; w13_seam_range((k), lo_, hi_); __syncthreads(); moe_w13_convert(F, a, lo_, hi_, F.bid * NWAVES + F.wave, F.G * NWAVES); __syncthreads(); } } while (0)
#endif
#define IN(k) (lo <= (k) && (k) < hi)
    LAS MoeTab* tab = (LAS MoeTab*)(F.lds + 144 * 1024);

#define RUNPH(k, ...) if (IN(k)) { F.lane = lane_now(); F.tid = F.wave * 64 + F.lane; __VA_ARGS__ }
    RUNPH(0, { phase0(F, a); }) SEAM(0);
    RUNPH(1, { phase1(F, a); __syncthreads(); dense_weight_convert(F, a); }) SEAM(1);
    RUNPH(2, {
        DenseOrder S{(const char*)(ws + WS_ACT), (const char*)(ws + WS_WIN), D, T / 256, INC / 256, F.G, F.bid};
        EpiInProj E{(bf16_t*)(ws + WS_PROJ), (bf16_t*)a.out, (float*)(ws + WS_DEC), (const float*)(ws + WS_SMALL) + 16, attn_body::C2};
        pg8::gemm_phase(F.lds, D, S, E);
        int nl; const int early = w2_early_items(F.G, nl);
        if (early && F.bid >= F.G - nl) { __syncthreads(); moe_w2_convert(F, a, 0, early, (F.bid - (F.G - nl)) * NWAVES + F.wave, nl * NWAVES); }
    }) SEAM(2);
    RUNPH(3, {
        for (int g = F.bid; g < 256; g += F.G) hg::grp_local(F, a, g);
        __syncthreads();
        attn_phase(F, a);
    }) SEAM(3);
    RUNPH(4, { hg::grp_scan(F, a); attn_combine(F, a); }) SEAM(4);
    RUNPH(5, { for (int g = F.bid; g < 256; g += F.G) hg::grp_final(F, a, g); }) SEAM(5);
    RUNPH(6, {
        UpOrder S{(const char*)(ws + WS_YDA), (const char*)(ws + WS_YHG), (const char*)(ws + WS_WUPDA), (const char*)(ws + WS_WUPHG), F.G, F.bid};
        EpiUp E{(const bf16_t*)(ws + WS_PROJ), (bf16_t*)(ws + WS_ACT)};
        pg8::gemm_phase(F.lds, 512, S, E);
    }) SEAM(6);
    RUNPH(7, {
        DenseOrder S{(const char*)(ws + WS_ACT), (const char*)(ws + WS_WOUT), D, T / 256, D / 256, F.G, F.bid};
        EpiOut E{a.in[I_X], (const float*)(ws + WS_MOD), (bf16_t*)(ws + WS_X1B)};
        const bool conv_first = (F.bid >> 3) & 1;
        if (conv_first) { moe_w13_convert(F, a, 28, 32, F.bid * NWAVES + F.wave, F.G * NWAVES); __syncthreads(); }
        pg8::gemm_phase(F.lds, D, S, E);
        if (!conv_first) { __syncthreads(); moe_w13_convert(F, a, 28, 32, F.bid * NWAVES + F.wave, F.G * NWAVES); }
        { int nl; const int early = w2_early_items(F.G, nl); if (early < NEXP * 256) { __syncthreads(); moe_w2_convert(F, a, early, NEXP * 256, F.bid * NWAVES + F.wave, F.G * NWAVES); } }
    }) SEAM(7);
    RUNPH(8, { phase_router(F, a); __syncthreads(); }) SEAM(8);
    RUNPH(9, {
        build_moe_tab(F, a, tab);
        unsigned* done = (unsigned*)(ws + WS_CTL) + CW_TILE;
        const int vc = (F.G & 7) == 0 ? (F.bid & 7) * (F.G >> 3) + (F.bid >> 3) : F.bid;
        { Moe1Order S{tab, (const char*)(ws + WS_ACT), (const char*)ws, (const char*)a.out, (const int*)(ws + WS_TOKLIST), F.G, vc};
          EpiMoe1 E{(bf16_t*)(ws + WS_HS), done};
          pg8::gemm_phase(F.lds, D, S, E); }
        { Moe2Order S{tab, (const char*)(ws + WS_HS), (const char*)a.out + OUT_W2, done, (unsigned*)(ws + WS_CTL) + CW_TMO, F.G, vc};
          EpiStoreBf16 E{(bf16_t*)(ws + WS_YS), D, 0, 1.0f};
          pg8::gemm_phase(F.lds, DEXP, S, E); }
    }) SEAM(9);
    RUNPH(10, { build_moe_tab(F, a, tab); phase_final(F, a, tab); })
#undef IN
#undef SEAM
}

extern "C" void kernel_launch(void* const* d_in, const int* in_sizes, int n_in, void* d_out, int out_size, void* d_ws, size_t ws_size, hipStream_t stream) {
    static int grid = 0;
    if (grid == 0) {
        if (n_in != 25 || in_sizes[0] != T * D || out_size != T * D || ws_size < WS_END) { fprintf(stderr, "kernel_launch: unexpected shapes (n_in %d, in0 %d, out %d, ws %zu)\n", n_in, n_in > 0 ? in_sizes[0] : -1, out_size, ws_size); grid = -1; return; }
        int dev = 0, cus = 0, per_cu = 0;
        if (hipGetDevice(&dev) != hipSuccess || hipDeviceGetAttribute(&cus, hipDeviceAttributeMultiprocessorCount, dev) != hipSuccess) { grid = -1; return; }
        if (hipFuncSetAttribute((const void*)mk_fwd, hipFuncAttributeMaxDynamicSharedMemorySize, LDS_BYTES) != hipSuccess) { fprintf(stderr, "kernel_launch: hipFuncSetAttribute failed\n"); grid = -1; return; }
        if (hipOccupancyMaxActiveBlocksPerMultiprocessor(&per_cu, (const void*)mk_fwd, NTHR, LDS_BYTES) != hipSuccess || per_cu < 1) { fprintf(stderr, "kernel_launch: occupancy query says %d\n", per_cu); per_cu = 1; }
        (void)hipGetLastError();
        grid = cus;
        if (grid > 256) grid = 256;
        while (T % grid) --grid;
    }
    if (grid < 0) return;
    (void)hipMemsetAsync((char*)d_ws + WS_CTL, 0, CTL_ZERO_BYTES, stream);
    Args a{};
    for (int i = 0; i < 25; ++i) a.in[i] = (const float*)d_in[i];
    a.out = (float*)d_out; a.ws = (unsigned char*)d_ws;
#if MK_N_LAUNCHES == 1
    a.ph_lo = 0; a.ph_hi = N_PHASES;
    void* args[] = {&a};
    hipError_t e = hipLaunchCooperativeKernel((const void*)mk_fwd, dim3(grid), dim3(NTHR), args, LDS_BYTES, stream);
    if (e != hipSuccess) fprintf(stderr, "cooperative launch failed: %s (grid %d)\n", hipGetErrorString(e), grid);
#else
    for (int p = 0; p < N_PHASES; ++p) {
        a.ph_lo = p; a.ph_hi = p + 1;
        hipLaunchKernelGGL(mk_fwd, dim3(grid), dim3(NTHR), LDS_BYTES, stream, a);
    }
#endif
}
```
